# Optimizing an MI355X kernel written in HIP

```python
import math
import jax
import jax.numpy as jnp
from jax import lax
import numpy as np

D_MODEL = 1024
BATCH = 16
SEQ = 2048
DEPTH = 1

CHUNK = 64
Q_BLOCK = 128
N_MEM = 256
EPS = 1e-5
NEG_INF = -1e30

D_MIX = D_MODEL
MLA_HEADS = 8
MLA_NOPE = 64
MLA_ROPE = 32
MLA_V = 64
MLA_Q_RANK = 256
MLA_KV_RANK = 128
ROPE_THETA = 10000.0

SSD_HEADS = 8
SSD_HEADDIM = 64
SSD_INNER = SSD_HEADS * SSD_HEADDIM
SSD_GROUPS = 2
SSD_STATE = 128
SSD_CONV = 4
SSD_CONV_DIM = SSD_INNER + 2 * SSD_GROUPS * SSD_STATE
DT_MIN = 0.001
DT_MAX = 0.1

IN_COLS = MLA_Q_RANK + MLA_KV_RANK + MLA_ROPE + SSD_INNER + SSD_CONV_DIM + SSD_HEADS

XA_HEADS = 4
XA_HEAD_DIM = D_MODEL // XA_HEADS

N_EXPERT_GROUPS = 4
EXPERTS_PER_GROUP = 8
N_EXPERTS = N_EXPERT_GROUPS * EXPERTS_PER_GROUP
TOP_K = 2
D_EXPERT = 256

DEEPNORM_ALPHA = (2.0 * DEPTH) ** 0.25
DEEPNORM_BETA = (8.0 * DEPTH) ** -0.25

kernel_name = "hybrid_mla_ssd_hmoe_deepnorm"


def layer_norm(x, g, b):
    xf = x.astype(jnp.float32)
    mu = jnp.mean(xf, axis=-1, keepdims=True)
    var = jnp.mean(jnp.square(xf - mu), axis=-1, keepdims=True)
    return ((xf - mu) * lax.rsqrt(var + EPS) * g + b).astype(x.dtype)


def rms_norm(x, g):
    xf = x.astype(jnp.float32)
    return (xf * lax.rsqrt(jnp.mean(jnp.square(xf), axis=-1, keepdims=True) + EPS) * g).astype(x.dtype)


def rotary_tables(seq, dim, dtype):
    pos = jnp.arange(seq, dtype=jnp.float32)
    inv_freq = ROPE_THETA ** (-jnp.arange(0, dim, 2, dtype=jnp.float32) / dim)
    ang = pos[:, None] * inv_freq[None, :]
    return jnp.cos(ang).astype(dtype), jnp.sin(ang).astype(dtype)


def apply_rope(u, cos, sin):
    u1, u2 = jnp.split(u, 2, axis=-1)
    return jnp.concatenate([u1 * cos - u2 * sin, u2 * cos + u1 * sin], axis=-1)


def chunk_causal_attention(q, k, v):
    b, s, h, dqk = q.shape
    nb = s // Q_BLOCK
    scale = dqk ** -0.5
    q_blocks = q.reshape(b, nb, Q_BLOCK, h, dqk).transpose(1, 0, 2, 3, 4)
    k_chunk = jnp.arange(s) // CHUNK

    def one_block(args):
        q_blk, blk = args
        q_chunk = (blk * Q_BLOCK + jnp.arange(Q_BLOCK)) // CHUNK
        scores = jnp.einsum("bqhd,bkhd->bhqk", q_blk, k).astype(jnp.float32) * scale
        allowed = k_chunk[None, :] <= q_chunk[:, None]
        scores = jnp.where(allowed, scores, NEG_INF)
        p = jax.nn.softmax(scores, axis=-1).astype(v.dtype)
        return jnp.einsum("bhqk,bkhd->bqhd", p, v)

    out = lax.map(one_block, (q_blocks, jnp.arange(nb)))
    return out.transpose(1, 0, 2, 3, 4).reshape(b, s, h, v.shape[-1])


def causal_depthwise_conv(u, w, bias):
    out = lax.conv_general_dilated(
        u, w[:, None, :], window_strides=(1,), padding=((SSD_CONV - 1, 0),),
        dimension_numbers=("NWC", "WIO", "NWC"), feature_group_count=u.shape[-1])
    return out + bias


def ssd_chunked_scan(xh, dt, a, bm, cm):
    b, s, h, p = xh.shape
    g, n = bm.shape[2], bm.shape[3]
    r = h // g
    nc = s // CHUNK
    x = (xh * dt[..., None]).reshape(b, nc, CHUNK, g, r, p)
    adt = (dt * a).reshape(b, nc, CHUNK, g, r)
    bm = bm.reshape(b, nc, CHUNK, g, n)
    cm = cm.reshape(b, nc, CHUNK, g, n)
    acs = jnp.cumsum(adt, axis=2)
    acs_t = acs.transpose(0, 1, 3, 4, 2)
    seg = acs_t[..., :, None] - acs_t[..., None, :]
    causal = jnp.tril(jnp.ones((CHUNK, CHUNK), dtype=bool))
    decay_in = jnp.exp(jnp.where(causal, seg, -jnp.inf))
    cb = jnp.einsum("bclgn,bcsgn->bcgls", cm, bm)
    y_diag = jnp.einsum("bcgls,bcgrls,bcsgrp->bclgrp", cb, decay_in, x)
    decay_to_end = jnp.exp(acs[:, :, -1:] - acs)
    states = jnp.einsum("bclgn,bclgr,bclgrp->bcgrpn", bm, decay_to_end, x)
    chunk_decay = jnp.exp(acs[:, :, -1])

    def step(state, inp):
        s_c, d_c = inp
        return d_c[..., None, None] * state + s_c, state

    h0 = jnp.zeros((b, g, r, p, n), x.dtype)
    _, prev = lax.scan(step, h0, (states.transpose(1, 0, 2, 3, 4, 5),
                                  chunk_decay.transpose(1, 0, 2, 3)))
    prev = prev.transpose(1, 0, 2, 3, 4, 5)
    y_off = jnp.einsum("bclgn,bcgrpn,bclgr->bclgrp", cm, prev, jnp.exp(acs))
    return (y_diag + y_off).reshape(b, s, h, p)


def hybrid_mixer(x, cos, sin, w_in, mla_q_norm, w_q_up, mla_kv_norm, w_kv_up,
                 ssd_conv_w, ssd_conv_b, ssd_dt_bias, ssd_a_log, ssd_d, ssd_norm, w_out):
    b, s, _ = x.shape
    proj = x @ w_in
    o1 = MLA_Q_RANK
    o2 = o1 + MLA_KV_RANK
    o3 = o2 + MLA_ROPE
    o4 = o3 + SSD_INNER
    o5 = o4 + SSD_CONV_DIM
    c_q, c_kv, k_rope, z, xbc, dt_raw = jnp.split(proj, [o1, o2, o3, o4, o5], axis=-1)

    q = (rms_norm(c_q, mla_q_norm) @ w_q_up).reshape(b, s, MLA_HEADS, MLA_NOPE + MLA_ROPE)
    q_nope, q_pe = q[..., :MLA_NOPE], q[..., MLA_NOPE:]
    kv = (rms_norm(c_kv, mla_kv_norm) @ w_kv_up).reshape(b, s, MLA_HEADS, MLA_NOPE + MLA_V)
    k_nope, v = kv[..., :MLA_NOPE], kv[..., MLA_NOPE:]
    q_pe = apply_rope(q_pe, cos[None, :, None, :], sin[None, :, None, :])
    k_pe = apply_rope(k_rope, cos[None], sin[None])
    q_full = jnp.concatenate([q_nope, q_pe], axis=-1)
    k_full = jnp.concatenate(
        [k_nope, jnp.broadcast_to(k_pe[:, :, None, :], (b, s, MLA_HEADS, MLA_ROPE))], axis=-1)
    attn = chunk_causal_attention(q_full, k_full, v).reshape(b, s, MLA_HEADS * MLA_V)

    xbc = jax.nn.silu(causal_depthwise_conv(xbc, ssd_conv_w, ssd_conv_b))
    xs, bm, cm = jnp.split(xbc, [SSD_INNER, SSD_INNER + SSD_GROUPS * SSD_STATE], axis=-1)
    xh = xs.reshape(b, s, SSD_HEADS, SSD_HEADDIM).astype(jnp.float32)
    dt = jax.nn.softplus(dt_raw.astype(jnp.float32) + ssd_dt_bias)
    a = -jnp.exp(ssd_a_log.astype(jnp.float32))
    y = ssd_chunked_scan(xh, dt, a,
                         bm.reshape(b, s, SSD_GROUPS, SSD_STATE).astype(jnp.float32),
                         cm.reshape(b, s, SSD_GROUPS, SSD_STATE).astype(jnp.float32))
    y = y + ssd_d.astype(jnp.float32)[None, None, :, None] * xh
    yz = (y.reshape(b, s, SSD_INNER) * jax.nn.silu(z.astype(jnp.float32)))
    yz = yz.reshape(b, s, SSD_GROUPS, SSD_INNER // SSD_GROUPS)
    yz = yz * lax.rsqrt(jnp.mean(jnp.square(yz), axis=-1, keepdims=True) + EPS)
    ssd_out = (yz.reshape(b, s, SSD_INNER) * ssd_norm).astype(x.dtype)

    return jnp.concatenate([attn, ssd_out], axis=-1) @ w_out


def memory_cross_attention(x, mem, wq, wk, wv, wo):
    b, s, _ = x.shape
    m = mem.shape[1]
    q = (x @ wq).reshape(b, s, XA_HEADS, XA_HEAD_DIM)
    k = (mem @ wk).reshape(b, m, XA_HEADS, XA_HEAD_DIM)
    v = (mem @ wv).reshape(b, m, XA_HEADS, XA_HEAD_DIM)
    scores = jnp.einsum("bshd,bmhd->bhsm", q, k).astype(jnp.float32) * (XA_HEAD_DIM ** -0.5)
    p = jax.nn.softmax(scores, axis=-1).astype(x.dtype)
    o = jnp.einsum("bhsm,bmhd->bshd", p, v).reshape(b, s, D_MODEL)
    return o @ wo


def hierarchical_moe(x, group_w, group_b, expert_w, expert_b, w_gate, w_up, w_down):
    b, s, d = x.shape
    t = x.reshape(b * s, d)
    n_tok = t.shape[0]
    group_logits = (t @ group_w).astype(jnp.float32) + group_b
    group_probs = jax.nn.softmax(group_logits, axis=-1)
    g_idx = jnp.argmax(group_logits, axis=-1)
    g_gate = jnp.take_along_axis(group_probs, g_idx[:, None], axis=-1)
    e_logits = ((t @ expert_w).astype(jnp.float32) + expert_b).reshape(
        n_tok, N_EXPERT_GROUPS, EXPERTS_PER_GROUP)
    in_group = jnp.take_along_axis(e_logits, g_idx[:, None, None], axis=1)[:, 0]
    top_vals, top_idx = lax.top_k(in_group, TOP_K)
    gates = jax.nn.softmax(top_vals, axis=-1) * g_gate
    expert_id = g_idx[:, None] * EXPERTS_PER_GROUP + top_idx
    combine = jnp.sum(jax.nn.one_hot(expert_id, N_EXPERTS, dtype=jnp.float32)
                      * gates[..., None], axis=1).astype(t.dtype)
    acc = jnp.zeros_like(t)
    for e in range(N_EXPERTS):
        hdn = jax.nn.silu(t @ w_gate[e]) * (t @ w_up[e])
        acc = acc + (hdn @ w_down[e]) * combine[:, e:e + 1]
    return acc.reshape(b, s, d)


def setup_inputs(seed: int = 0) -> dict:
    key = jax.random.key(seed)
    ks = jax.random.split(key, 40)
    L = DEPTH

    def nrm(k, shape, fan_in, scale=1.0):
        return jax.random.normal(k, shape, jnp.float32) * (scale * fan_in ** -0.5)

    def gain(k, n):
        return 1.0 + 0.02 * jax.random.normal(k, (L, n), jnp.float32)

    def small(k, shape):
        return 0.01 * jax.random.normal(k, shape, jnp.float32)

    dt0 = jnp.exp(jax.random.uniform(ks[9], (L, SSD_HEADS), jnp.float32,
                                     minval=math.log(DT_MIN), maxval=math.log(DT_MAX)))
    return {
        "x": jax.random.normal(ks[0], (BATCH, SEQ, D_MODEL), jnp.float32),
        "mem": jax.random.normal(ks[1], (BATCH, N_MEM, D_MODEL), jnp.float32),
        "w_in": nrm(ks[2], (L, D_MODEL, IN_COLS), D_MODEL),
        "mla_q_norm": gain(ks[3], MLA_Q_RANK),
        "w_q_up": nrm(ks[4], (L, MLA_Q_RANK, MLA_HEADS * (MLA_NOPE + MLA_ROPE)), MLA_Q_RANK),
        "mla_kv_norm": gain(ks[5], MLA_KV_RANK),
        "w_kv_up": nrm(ks[6], (L, MLA_KV_RANK, MLA_HEADS * (MLA_NOPE + MLA_V)), MLA_KV_RANK),
        "ssd_conv_w": nrm(ks[7], (L, SSD_CONV, SSD_CONV_DIM), SSD_CONV),
        "ssd_conv_b": small(ks[8], (L, SSD_CONV_DIM)),
        "ssd_dt_bias": dt0 + jnp.log(-jnp.expm1(-dt0)),
        "ssd_a_log": jnp.log(jax.random.uniform(ks[10], (L, SSD_HEADS), jnp.float32,
                                                minval=1.0, maxval=16.0)),
        "ssd_d": 1.0 + 0.1 * jax.random.normal(ks[11], (L, SSD_HEADS), jnp.float32),
        "ssd_norm": gain(ks[12], SSD_INNER),
        "w_out": nrm(ks[13], (L, D_MIX, D_MODEL), D_MIX, DEEPNORM_BETA),
        "ln1_g": gain(ks[14], D_MODEL),
        "ln1_b": small(ks[15], (L, D_MODEL)),
        "xa_wq": nrm(ks[16], (L, D_MODEL, D_MODEL), D_MODEL),
        "xa_wk": nrm(ks[17], (L, D_MODEL, D_MODEL), D_MODEL),
        "xa_wv": nrm(ks[18], (L, D_MODEL, D_MODEL), D_MODEL, DEEPNORM_BETA),
        "xa_wo": nrm(ks[19], (L, D_MODEL, D_MODEL), D_MODEL, DEEPNORM_BETA),
        "ln2_g": gain(ks[20], D_MODEL),
        "ln2_b": small(ks[21], (L, D_MODEL)),
        "router_group_w": nrm(ks[22], (L, D_MODEL, N_EXPERT_GROUPS), D_MODEL),
        "router_group_b": small(ks[23], (L, N_EXPERT_GROUPS)),
        "router_expert_w": nrm(ks[24], (L, D_MODEL, N_EXPERTS), D_MODEL),
        "router_expert_b": small(ks[25], (L, N_EXPERTS)),
        "expert_w_gate": nrm(ks[26], (L, N_EXPERTS, D_MODEL, D_EXPERT), D_MODEL),
        "expert_w_up": nrm(ks[27], (L, N_EXPERTS, D_MODEL, D_EXPERT), D_MODEL),
        "expert_w_down": nrm(ks[28], (L, N_EXPERTS, D_EXPERT, D_MODEL), D_EXPERT, DEEPNORM_BETA),
        "ln3_g": gain(ks[29], D_MODEL),
        "ln3_b": small(ks[30], (L, D_MODEL)),
    }


def reference(x, mem, w_in, mla_q_norm, w_q_up, mla_kv_norm, w_kv_up,
              ssd_conv_w, ssd_conv_b, ssd_dt_bias, ssd_a_log, ssd_d, ssd_norm, w_out,
              ln1_g, ln1_b, xa_wq, xa_wk, xa_wv, xa_wo, ln2_g, ln2_b,
              router_group_w, router_group_b, router_expert_w, router_expert_b,
              expert_w_gate, expert_w_up, expert_w_down, ln3_g, ln3_b):
    cos, sin = rotary_tables(x.shape[1], MLA_ROPE, x.dtype)
    h = x
    for l in range(DEPTH):
        mix = hybrid_mixer(h, cos, sin, w_in[l], mla_q_norm[l], w_q_up[l], mla_kv_norm[l],
                           w_kv_up[l], ssd_conv_w[l], ssd_conv_b[l], ssd_dt_bias[l],
                           ssd_a_log[l], ssd_d[l], ssd_norm[l], w_out[l])
        h = layer_norm(DEEPNORM_ALPHA * h + mix, ln1_g[l], ln1_b[l])
        xa = memory_cross_attention(h, mem, xa_wq[l], xa_wk[l], xa_wv[l], xa_wo[l])
        h = layer_norm(DEEPNORM_ALPHA * h + xa, ln2_g[l], ln2_b[l])
        ffn = hierarchical_moe(h, router_group_w[l], router_group_b[l], router_expert_w[l],
                               router_expert_b[l], expert_w_gate[l], expert_w_up[l],
                               expert_w_down[l])
        h = layer_norm(DEEPNORM_ALPHA * h + ffn, ln3_g[l], ln3_b[l])
    return h
```

```cpp
#include <hip/hip_runtime.h>
#include <stdint.h>
#include <stdio.h>

#ifndef MEGA
#define MEGA 0
#endif
#ifndef GEMM_DIRECT
#define GEMM_DIRECT 0
#endif

typedef unsigned short bf16_t;
typedef short bf16x8 __attribute__((ext_vector_type(8)));
typedef float f32x16 __attribute__((ext_vector_type(16)));
#define DI __device__ __forceinline__
#define MFMA32(a, b, c) __builtin_amdgcn_mfma_f32_32x32x16_bf16((a), (b), (c), 0, 0, 0)

constexpr int Bn = 16, S = 2048, T = Bn * S, D = 1024;
constexpr int NMEM = 256;
constexpr float EPS = 1e-5f;
constexpr float ALPHA = 1.189207115002721f;
constexpr float LOG2E = 1.4426950408889634f;
constexpr float QSCALE = 0.10206207261596577f * LOG2E;
constexpr float XSCALE = 0.0625f * LOG2E;
constexpr int NEXP = 32;
constexpr int MAXSLOTS = 69632;

constexpr size_t MiB = 1u << 20;
constexpr size_t W_IN = 0;
constexpr size_t W_QUP = W_IN + 4 * MiB;
constexpr size_t W_KVUP = W_QUP + 768 * 256 * 2;
constexpr size_t W_OUT = W_KVUP + 1024 * 128 * 2;
constexpr size_t W_XQ = W_OUT + 2 * MiB;
constexpr size_t W_XKV = W_XQ + 2 * MiB;
constexpr size_t W_XO = W_XKV + 4 * MiB;
constexpr size_t W_GU = W_XO + 2 * MiB;
constexpr size_t W_DN = W_GU + 32 * MiB;
constexpr size_t W_RT = W_DN + 16 * MiB;
constexpr size_t ROPE_C = W_RT + 48 * 1024 * 4;
constexpr size_t ROPE_S = ROPE_C + 2048 * 16 * 4;
constexpr size_t TOK_GATE = ROPE_S + 2048 * 16 * 4;
constexpr size_t CTL = TOK_GATE + (size_t)T * 2 * 4;
constexpr size_t CTL_BYTES = 32768;
constexpr size_t CTL_CNT = 16384;
static_assert(CTL + CTL_BYTES <= 64 * MiB, "weights region overflow");
constexpr size_t RA = 64 * MiB, RB = 192 * MiB, RC = 320 * MiB, RD = 448 * MiB, WS_NEED = 512 * MiB;
constexpr size_t XBC = RA;
constexpr size_t KX = RA + 64 * MiB;
constexpr size_t VXT = KX + 8 * MiB;
constexpr size_t YB = RA;
constexpr size_t QB = RB;
constexpr size_t KNB = RB + 48 * MiB;
constexpr size_t VTB = KNB + 32 * MiB;
constexpr size_t H1 = RB;
constexpr size_t H2 = RB;
constexpr size_t XBCA = RC;
constexpr size_t MIX = RC + 64 * MiB;
constexpr size_t H1B = RC;
constexpr size_t QX = RC + 64 * MiB;
constexpr size_t OX = RC;
constexpr size_t H2B = RC;
constexpr size_t HDN = RC + 64 * MiB;
constexpr size_t CQ = RD;
constexpr size_t CKV = CQ + 16 * MiB;
constexpr size_t KROPE = CKV + 8 * MiB;
constexpr size_t DTB = KROPE + 2 * MiB;
constexpr size_t ZB = DTB + 1 * MiB;
constexpr size_t LISTS = RD;
static_assert(ZB + 32 * MiB <= WS_NEED, "region D overflow");

struct P {
    const float* in[31];
    float* out;
    unsigned char* ws;
};

DI bf16_t f2bf(float x) { unsigned u = __float_as_uint(x); u += 0x7fffu + ((u >> 16) & 1u); return (bf16_t)(u >> 16); }
DI float bf2f(bf16_t b) { return __uint_as_float(((unsigned)b) << 16); }
DI float bflo(unsigned w) { return __uint_as_float(w << 16); }
DI float bfhi(unsigned w) { return __uint_as_float(w & 0xffff0000u); }
DI unsigned pack2(float a, float b) { return (unsigned)f2bf(a) | ((unsigned)f2bf(b) << 16); }
DI float siluf(float x) { return x / (1.f + __expf(-x)); }
DI float softplusf(float x) { return x > 20.f ? x : log1pf(__expf(x)); }
DI int crow(int reg, int h) { return (reg & 3) + 8 * (reg >> 2) + 4 * h; }
DI float wave_sum(float v) {
#pragma unroll
    for (int o = 32; o >= 1; o >>= 1) v += __shfl_xor(v, o);
    return v;
}
DI float wave_max(float v) {
#pragma unroll
    for (int o = 32; o >= 1; o >>= 1) v = fmaxf(v, __shfl_xor(v, o));
    return v;
}

constexpr int LDS_ROW = 144;
constexpr int TILE_BYTES = 128 * LDS_ROW;
constexpr int GEMM_LDS = 4 * TILE_BYTES;
constexpr int SMEM_BYTES = GEMM_LDS + 2048;

struct GemmArgs {
    const bf16_t* A; int lda;
    const bf16_t* Bt; int ldb;
    int K;
    const int* lrows;
};

template <class Epi>
DI void gemm_tile(const GemmArgs& g, int m0, int n0, Epi& epi, unsigned char* smem) {
    const int tid = threadIdx.x, lane = tid & 63, wave = tid >> 6, wr = wave >> 1, wc = wave & 1;
    const int r = lane & 31, h = lane >> 5;
    f32x16 acc[2][2];
#pragma unroll
    for (int i = 0; i < 2; ++i)
#pragma unroll
        for (int j = 0; j < 2; ++j)
#pragma unroll
            for (int e = 0; e < 16; ++e) acc[i][j][e] = 0.f;
    const int nk = g.K >> 6;
#if GEMM_DIRECT
    {
        const bf16_t* ap[2]; const bf16_t* bp[2];
#pragma unroll
        for (int i = 0; i < 2; ++i) {
            const int lr = wr * 64 + i * 32 + r;
            const int grow = g.lrows ? g.lrows[lr] : (m0 + lr);
            ap[i] = g.A + (size_t)grow * g.lda + 8 * h;
            bp[i] = g.Bt + (size_t)(n0 + wc * 64 + i * 32 + r) * g.ldb + 8 * h;
        }
        for (int k = 0; k < g.K; k += 16) {
            bf16x8 a[2], b[2];
#pragma unroll
            for (int i = 0; i < 2; ++i) { a[i] = *(const bf16x8*)(ap[i] + k); b[i] = *(const bf16x8*)(bp[i] + k); }
#pragma unroll
            for (int i = 0; i < 2; ++i)
#pragma unroll
                for (int j = 0; j < 2; ++j) acc[i][j] = MFMA32(a[i], b[j], acc[i][j]);
        }
    }
#else
    {
        const int srow = tid >> 3, sch = tid & 7;
        const bf16_t* ag[4]; const bf16_t* bg[4];
#pragma unroll
        for (int i = 0; i < 4; ++i) {
            const int lr = srow + 32 * i;
            const int grow = g.lrows ? g.lrows[lr] : (m0 + lr);
            ag[i] = g.A + (size_t)grow * g.lda + sch * 8;
            bg[i] = g.Bt + (size_t)(n0 + lr) * g.ldb + sch * 8;
        }
        const int soff = srow * LDS_ROW + sch * 16;
        uint4 ra0, ra1, ra2, ra3, rb0, rb1, rb2, rb3;
#define G_LOAD(KO) do { ra0 = *(const uint4*)(ag[0] + (KO)); ra1 = *(const uint4*)(ag[1] + (KO)); ra2 = *(const uint4*)(ag[2] + (KO)); ra3 = *(const uint4*)(ag[3] + (KO)); \
                        rb0 = *(const uint4*)(bg[0] + (KO)); rb1 = *(const uint4*)(bg[1] + (KO)); rb2 = *(const uint4*)(bg[2] + (KO)); rb3 = *(const uint4*)(bg[3] + (KO)); } while (0)
#define L_STORE(BUF) do { unsigned char* _d = (BUF) + soff; \
        *(uint4*)(_d) = ra0; *(uint4*)(_d + 32 * LDS_ROW) = ra1; *(uint4*)(_d + 64 * LDS_ROW) = ra2; *(uint4*)(_d + 96 * LDS_ROW) = ra3; \
        *(uint4*)(_d + TILE_BYTES) = rb0; *(uint4*)(_d + TILE_BYTES + 32 * LDS_ROW) = rb1; *(uint4*)(_d + TILE_BYTES + 64 * LDS_ROW) = rb2; *(uint4*)(_d + TILE_BYTES + 96 * LDS_ROW) = rb3; } while (0)
        G_LOAD(0);
        __syncthreads();
        L_STORE(smem);
        __syncthreads();
        const int aoff = (wr * 64 + r) * LDS_ROW + h * 16;
        const int boff = TILE_BYTES + (wc * 64 + r) * LDS_ROW + h * 16;
        for (int kt = 0; kt < nk; ++kt) {
            const unsigned char* cur = smem + (kt & 1) * 2 * TILE_BYTES;
            unsigned char* nxt = smem + ((kt + 1) & 1) * 2 * TILE_BYTES;
            const bool more = (kt + 1 < nk);
            if (more) G_LOAD((kt + 1) * 64);
#pragma unroll
            for (int ks = 0; ks < 4; ++ks) {
                const bf16x8 a0 = *(const bf16x8*)(cur + aoff + ks * 32);
                const bf16x8 a1 = *(const bf16x8*)(cur + aoff + 32 * LDS_ROW + ks * 32);
                const bf16x8 b0 = *(const bf16x8*)(cur + boff + ks * 32);
                const bf16x8 b1 = *(const bf16x8*)(cur + boff + 32 * LDS_ROW + ks * 32);
                acc[0][0] = MFMA32(a0, b0, acc[0][0]); acc[0][1] = MFMA32(a0, b1, acc[0][1]);
                acc[1][0] = MFMA32(a1, b0, acc[1][0]); acc[1][1] = MFMA32(a1, b1, acc[1][1]);
            }
            if (more) L_STORE(nxt);
            __syncthreads();
        }
#undef G_LOAD
#undef L_STORE
    }
#endif
    epi(acc, m0 + wr * 64, n0 + wc * 64, lane);
}

DI int vbid(int bid, int nb) { return (nb % 8 == 0) ? (bid % 8) * (nb / 8) + bid / 8 : bid; }

DI int colmap_in(int n) {
    if (n < 384) return n;
    if (n < 896) return 416 + (n - 384);
    if (n < 1920) return 928 + (n - 896);
    if (n < 1952) return 384 + (n - 1920);
    if (n < 1960) return n;
    return -1;
}
template <int KIND>
DI void tconv_tile(const float* src, const float* src2, int ldsrc, bf16_t* dst, int K, int k0, int n0, const float* scale, int scale_from, unsigned char* smem) {
    float* tile = (float*)smem;
    const int t = threadIdx.x;
    __syncthreads();
#pragma unroll 4
    for (int i = 0; i < 16; ++i) {
        const int k = i * 4 + (t >> 6), n = t & 63;
        const int nd = n0 + n;
        float v = 0.f;
        if (KIND == 1) { const int c = colmap_in(nd); if (c >= 0) v = src[(size_t)(k0 + k) * ldsrc + c]; }
        else if (KIND == 2) {
            const int j = nd >> 7, wc = (nd >> 6) & 1, isup = (nd >> 5) & 1, ii = nd & 31;
            const int c = 64 * j + 32 * wc + ii;
            v = (isup ? src2 : src)[(size_t)(k0 + k) * ldsrc + c];
        } else v = src[(size_t)(k0 + k) * ldsrc + nd];
        if (scale && (k0 + k) >= scale_from) v *= scale[k0 + k - scale_from];
        tile[k * 65 + n] = v;
    }
    __syncthreads();
#pragma unroll 4
    for (int i = 0; i < 16; ++i) {
        const int n = i * 4 + (t >> 6), k = t & 63;
        dst[(size_t)(n0 + n) * K + k0 + k] = f2bf(tile[k * 65 + n]);
    }
}

DI void phase_prep(const P& p, int bid, int nb, unsigned char* smem) {
    unsigned char* ws = p.ws;
    const int tid = threadIdx.x;
    constexpr int J0 = 512, J1 = J0 + 48, J2 = J1 + 32, J3 = J2 + 256, J4 = J3 + 256, J5 = J4 + 256, J6 = J5 + 256, J7 = J6 + 256, J8 = J7 + 4096, J9 = J8 + 2048;
    for (int t = bid; t < J9; t += nb) {
        if (t < J0) { const int kt = t >> 5, ntl = t & 31; tconv_tile<1>(p.in[2], nullptr, 1960, (bf16_t*)(ws + W_IN), 1024, kt * 64, ntl * 64, nullptr, 0, smem); }
        else if (t < J1) { const int u = t - J0, kt = u / 12, ntl = u % 12; tconv_tile<0>(p.in[4], nullptr, 768, (bf16_t*)(ws + W_QUP), 256, kt * 64, ntl * 64, p.in[3], 0, smem); }
        else if (t < J2) { const int u = t - J1, kt = u >> 4, ntl = u & 15; tconv_tile<0>(p.in[6], nullptr, 1024, (bf16_t*)(ws + W_KVUP), 128, kt * 64, ntl * 64, p.in[5], 0, smem); }
        else if (t < J3) { const int u = t - J2, kt = u >> 4, ntl = u & 15; tconv_tile<0>(p.in[13], nullptr, 1024, (bf16_t*)(ws + W_OUT), 1024, kt * 64, ntl * 64, p.in[12], 512, smem); }
        else if (t < J4) { const int u = t - J3, kt = u >> 4, ntl = u & 15; tconv_tile<0>(p.in[16], nullptr, 1024, (bf16_t*)(ws + W_XQ), 1024, kt * 64, ntl * 64, nullptr, 0, smem); }
        else if (t < J5) { const int u = t - J4, kt = u >> 4, ntl = u & 15; tconv_tile<0>(p.in[17], nullptr, 1024, (bf16_t*)(ws + W_XKV), 1024, kt * 64, ntl * 64, nullptr, 0, smem); }
        else if (t < J6) { const int u = t - J5, kt = u >> 4, ntl = u & 15; tconv_tile<0>(p.in[18], nullptr, 1024, (bf16_t*)(ws + W_XKV) + (size_t)1024 * 1024, 1024, kt * 64, ntl * 64, nullptr, 0, smem); }
        else if (t < J7) { const int u = t - J6, kt = u >> 4, ntl = u & 15; tconv_tile<0>(p.in[19], nullptr, 1024, (bf16_t*)(ws + W_XO), 1024, kt * 64, ntl * 64, nullptr, 0, smem); }
        else if (t < J8) { const int u = t - J7, e = u >> 7, v = u & 127, kt = v >> 3, ntl = v & 7;
            tconv_tile<2>(p.in[26] + (size_t)e * 1024 * 256, p.in[27] + (size_t)e * 1024 * 256, 256, (bf16_t*)(ws + W_GU) + (size_t)e * 512 * 1024, 1024, kt * 64, ntl * 64, nullptr, 0, smem); }
        else { const int u = t - J8, e = u >> 6, v = u & 63, kt = v >> 4, ntl = v & 15;
            tconv_tile<0>(p.in[28] + (size_t)e * 256 * 1024, nullptr, 1024, (bf16_t*)(ws + W_DN) + (size_t)e * 1024 * 256, 256, kt * 64, ntl * 64, nullptr, 0, smem); }
    }
    {
        const size_t gsz = (size_t)nb * 256, g0 = (size_t)bid * 256 + tid;
        bf16_t* xb = (bf16_t*)p.out;
        const float4* x4 = (const float4*)p.in[0];
        for (size_t i = g0; i < (size_t)T * D / 4; i += gsz) { const float4 v = x4[i]; uint2 o; o.x = pack2(v.x, v.y); o.y = pack2(v.z, v.w); ((uint2*)xb)[i] = o; }
        bf16_t* mb = xb + (size_t)T * D;
        const float4* m4 = (const float4*)p.in[1];
        for (size_t i = g0; i < (size_t)Bn * NMEM * D / 4; i += gsz) { const float4 v = m4[i]; uint2 o; o.x = pack2(v.x, v.y); o.y = pack2(v.z, v.w); ((uint2*)mb)[i] = o; }
        float* wrt = (float*)(ws + W_RT);
        for (size_t i = g0; i < 48 * 1024; i += gsz) {
            const int j = (int)(i >> 10), k = (int)(i & 1023);
            float v = 0.f;
            if (j < 4) v = p.in[22][k * 4 + j]; else if (j < 36) v = p.in[24][k * 32 + (j - 4)];
            wrt[i] = v;
        }
        float* rc = (float*)(ws + ROPE_C); float* rs = (float*)(ws + ROPE_S);
        for (size_t i = g0; i < 2048 * 16; i += gsz) {
            const int pos = (int)(i >> 4), f = (int)(i & 15);
            const float inv = powf(10000.f, -(float)f / 16.f);
            const float ang = (float)pos * inv;
            const double a = (double)ang;
            const double k2 = rint(a * 0.15915494309189535);
            const float rr = (float)(a - k2 * 6.283185307179586);
            rc[i] = cosf(rr); rs[i] = sinf(rr);
        }
    }
}

struct EpiProj {
    bf16_t *cq, *ckv, *z, *xbc, *krope; float* dt; const float *rc, *rs, *dtb;
    DI void operator()(const f32x16 (&acc)[2][2], int rb, int cb, int lane) const {
        const int r = lane & 31, h = lane >> 5;
#pragma unroll
        for (int i = 0; i < 2; ++i)
#pragma unroll
            for (int j = 0; j < 2; ++j) {
                const int col = cb + j * 32 + r;
                const int colb = cb + j * 32;
#pragma unroll
                for (int e = 0; e < 16; ++e) {
                    const int row = rb + i * 32 + crow(e, h);
                    const float v = acc[i][j][e];
                    if (colb < 256) cq[(size_t)row * 256 + col] = f2bf(v);
                    else if (colb < 384) ckv[(size_t)row * 128 + col - 256] = f2bf(v);
                    else if (colb < 896) z[(size_t)row * 512 + col - 384] = f2bf(v);
                    else if (colb < 1920) xbc[(size_t)row * 1024 + col - 896] = f2bf(v);
                    else if (colb == 1920) {
                        const float pv = __shfl_xor(v, 16);
                        const int pos = row & 2047, f = r & 15;
                        const float c = rc[pos * 16 + f], s = rs[pos * 16 + f];
                        const float o = (r < 16) ? (v * c - pv * s) : (v * c + pv * s);
                        krope[(size_t)row * 32 + r] = f2bf(o);
                    } else if (colb == 1952) {
                        if (r < 8) dt[(size_t)row * 8 + r] = softplusf(v + dtb[r]);
                    }
                }
            }
    }
};
struct EpiMemKV {
    bf16_t *kx, *vxt;
    DI void operator()(const f32x16 (&acc)[2][2], int rb, int cb, int lane) const {
        const int r = lane & 31, h = lane >> 5;
#pragma unroll
        for (int i = 0; i < 2; ++i)
#pragma unroll
            for (int j = 0; j < 2; ++j) {
                const int col = cb + j * 32 + r;
#pragma unroll
                for (int e = 0; e < 16; ++e) {
                    const int row = rb + i * 32 + crow(e, h);
                    const int b = row >> 8, m = row & 255;
                    const float v = acc[i][j][e];
                    if (col < 1024) { const int hd = col >> 8, d = col & 255; kx[((size_t)(b * 4 + hd) * 256 + m) * 256 + d] = f2bf(v); }
                    else { const int c2 = col - 1024, hd = c2 >> 8, d = c2 & 255; vxt[((size_t)(b * 4 + hd) * 256 + d) * 256 + m] = f2bf(v); }
                }
            }
    }
};
DI void phase_proj(const P& p, int bid, int nb, unsigned char* smem) {
    unsigned char* ws = p.ws;
    const int v = vbid(bid, nb);
    const bf16_t* xb = (const bf16_t*)p.out;
    EpiProj e1{(bf16_t*)(ws + CQ), (bf16_t*)(ws + CKV), (bf16_t*)(ws + ZB), (bf16_t*)(ws + XBC), (bf16_t*)(ws + KROPE), (float*)(ws + DTB),
               (const float*)(ws + ROPE_C), (const float*)(ws + ROPE_S), p.in[9]};
    EpiMemKV e2{(bf16_t*)(ws + KX), (bf16_t*)(ws + VXT)};
    constexpr int NT1 = 256 * 16, NT2 = 32 * 16;
    for (int t = v; t < NT1 + NT2; t += nb) {
        if (t < NT1) { GemmArgs g{xb, 1024, (const bf16_t*)(ws + W_IN), 1024, 1024, nullptr}; gemm_tile(g, (t >> 4) * 128, (t & 15) * 128, e1, smem); }
        else { const int u = t - NT1; GemmArgs g{xb + (size_t)T * D, 1024, (const bf16_t*)(ws + W_XKV), 1024, 1024, nullptr}; gemm_tile(g, (u >> 4) * 128, (u & 15) * 128, e2, smem); }
    }
}

struct EpiQup {
    bf16_t* q; const float *rc, *rs; const float* rms;
    int m0;
    DI void operator()(const f32x16 (&acc)[2][2], int rb, int cb, int lane) const {
        const int r = lane & 31, h = lane >> 5;
#pragma unroll
        for (int i = 0; i < 2; ++i)
#pragma unroll
            for (int j = 0; j < 2; ++j) {
                const int blk = (cb >> 5) + j, head = blk / 3, part = blk % 3;
#pragma unroll
                for (int e = 0; e < 16; ++e) {
                    const int row = rb + i * 32 + crow(e, h);
                    float v = acc[i][j][e] * rms[row - m0];
                    if (part == 2) {
                        const float pv = __shfl_xor(v, 16);
                        const int pos = row & 2047, f = r & 15;
                        const float c = rc[pos * 16 + f], s = rs[pos * 16 + f];
                        v = (r < 16) ? (v * c - pv * s) : (v * c + pv * s);
                    }
                    const int b = row >> 11, s_ = row & 2047;
                    q[((size_t)(b * 8 + head) * 2048 + s_) * 96 + part * 32 + r] = f2bf(v * QSCALE);
                }
            }
    }
};
struct EpiKVup {
    bf16_t *kn, *vt; const float* rms; int m0;
    DI void operator()(const f32x16 (&acc)[2][2], int rb, int cb, int lane) const {
        const int r = lane & 31, h = lane >> 5;
        const int head = cb >> 7, isv = (cb >> 6) & 1;
#pragma unroll
        for (int i = 0; i < 2; ++i)
#pragma unroll
            for (int j = 0; j < 2; ++j) {
                const int d = j * 32 + r;
#pragma unroll
                for (int e = 0; e < 16; ++e) {
                    const int row = rb + i * 32 + crow(e, h);
                    const float v = acc[i][j][e] * rms[row - m0];
                    const int b = row >> 11, s_ = row & 2047;
                    if (!isv) kn[((size_t)(b * 8 + head) * 2048 + s_) * 64 + d] = f2bf(v);
                    else vt[((size_t)(b * 8 + head) * 64 + d) * 2048 + s_] = f2bf(v);
                }
            }
    }
};
template <int K>
DI void row_rms(const bf16_t* src, int m0, float* rms) {
    const int t = threadIdx.x, row = t >> 1, half = t & 1;
    const uint4* s4 = (const uint4*)(src + (size_t)(m0 + row) * K + half * (K / 2));
    float ss = 0.f;
#pragma unroll
    for (int i = 0; i < K / 16; ++i) {
        const uint4 w = s4[i];
        const unsigned ww[4] = {w.x, w.y, w.z, w.w};
#pragma unroll
        for (int k = 0; k < 4; ++k) { const float a = bflo(ww[k]), b = bfhi(ww[k]); ss += a * a + b * b; }
    }
    ss += __shfl_xor(ss, 1);
    __syncthreads();
    if (half == 0) rms[row] = rsqrtf(ss * (1.f / K) + EPS);
    __syncthreads();
}
DI void phase_up(const P& p, int bid, int nb, unsigned char* smem) {
    unsigned char* ws = p.ws;
    const int v = vbid(bid, nb);
    float* rms = (float*)(smem + GEMM_LDS);
    constexpr int NTQ = 256 * 6, NTKV = 256 * 8;
    for (int t = v; t < NTQ + NTKV; t += nb) {
        if (t < NTQ) {
            const int mt = t / 6, ntl = t % 6;
            row_rms<256>((const bf16_t*)(ws + CQ), mt * 128, rms);
            EpiQup e{(bf16_t*)(ws + QB), (const float*)(ws + ROPE_C), (const float*)(ws + ROPE_S), rms, mt * 128};
            GemmArgs g{(const bf16_t*)(ws + CQ), 256, (const bf16_t*)(ws + W_QUP), 256, 256, nullptr};
            gemm_tile(g, mt * 128, ntl * 128, e, smem);
        } else {
            const int u = t - NTQ, mt = u >> 3, ntl = u & 7;
            row_rms<128>((const bf16_t*)(ws + CKV), mt * 128, rms);
            EpiKVup e{(bf16_t*)(ws + KNB), (bf16_t*)(ws + VTB), rms, mt * 128};
            GemmArgs g{(const bf16_t*)(ws + CKV), 128, (const bf16_t*)(ws + W_KVUP), 128, 128, nullptr};
            gemm_tile(g, mt * 128, ntl * 128, e, smem);
        }
    }
    {
        const bf16_t* xbc = (const bf16_t*)(ws + XBC); bf16_t* xa = (bf16_t*)(ws + XBCA);
        const float* cw = p.in[7]; const float* cb = p.in[8];
        const size_t gsz = (size_t)nb * 256;
        for (size_t i = (size_t)bid * 256 + threadIdx.x; i < (size_t)T * 128; i += gsz) {
            const int tkn = (int)(i >> 7), c0 = (int)(i & 127) * 8, s_ = tkn & 2047;
            float accv[8];
#pragma unroll
            for (int k = 0; k < 8; ++k) accv[k] = cb[c0 + k];
#pragma unroll
            for (int j = 0; j < 4; ++j) {
                if (s_ + j - 3 >= 0) {
                    const uint4 w = *(const uint4*)(xbc + (size_t)(tkn + j - 3) * 1024 + c0);
                    const unsigned ww[4] = {w.x, w.y, w.z, w.w};
#pragma unroll
                    for (int k = 0; k < 4; ++k) {
                        accv[2 * k] += cw[j * 1024 + c0 + 2 * k] * bflo(ww[k]);
                        accv[2 * k + 1] += cw[j * 1024 + c0 + 2 * k + 1] * bfhi(ww[k]);
                    }
                }
            }
            uint4 o;
            o.x = pack2(siluf(accv[0]), siluf(accv[1])); o.y = pack2(siluf(accv[2]), siluf(accv[3]));
            o.z = pack2(siluf(accv[4]), siluf(accv[5])); o.w = pack2(siluf(accv[6]), siluf(accv[7]));
            *(uint4*)(xa + (size_t)tkn * 1024 + c0) = o;
        }
    }
}

DI void attn_naive(const P& p, int bid, int nb) {
    unsigned char* ws = p.ws;
    const bf16_t* Q = (const bf16_t*)(ws + QB); const bf16_t* Kn = (const bf16_t*)(ws + KNB); const bf16_t* Vt = (const bf16_t*)(ws + VTB);
    const bf16_t* Kr = (const bf16_t*)(ws + KROPE); bf16_t* mix = (bf16_t*)(ws + MIX);
    for (int item = bid; item < 128 * 8; item += nb) {
        const int bh = item >> 3, s_ = (item & 7) * 256 + threadIdx.x, b = bh >> 3, hd = bh & 7;
        float q[96];
        {
            const uint4* q4 = (const uint4*)(Q + ((size_t)bh * 2048 + s_) * 96);
#pragma unroll
            for (int i = 0; i < 12; ++i) { const uint4 w = q4[i]; q[8 * i] = bflo(w.x); q[8 * i + 1] = bfhi(w.x); q[8 * i + 2] = bflo(w.y); q[8 * i + 3] = bfhi(w.y);
                q[8 * i + 4] = bflo(w.z); q[8 * i + 5] = bfhi(w.z); q[8 * i + 6] = bflo(w.w); q[8 * i + 7] = bfhi(w.w); }
        }
        float o[64];
#pragma unroll
        for (int d = 0; d < 64; ++d) o[d] = 0.f;
        float m = -1e30f, l = 0.f;
        const int nkeys = __builtin_amdgcn_readfirstlane(((s_ >> 6) + 1) * 64);
        for (int j0 = 0; j0 < nkeys; j0 += 8) {
            float sc[8];
#pragma unroll
            for (int jj = 0; jj < 8; ++jj) {
                const int j = j0 + jj;
                const uint4* k4 = (const uint4*)(Kn + ((size_t)bh * 2048 + j) * 64);
                const uint4* r4 = (const uint4*)(Kr + ((size_t)b * 2048 + j) * 32);
                float a = 0.f;
#pragma unroll
                for (int i = 0; i < 8; ++i) { const uint4 w = k4[i]; a += q[8 * i] * bflo(w.x) + q[8 * i + 1] * bfhi(w.x) + q[8 * i + 2] * bflo(w.y) + q[8 * i + 3] * bfhi(w.y)
                    + q[8 * i + 4] * bflo(w.z) + q[8 * i + 5] * bfhi(w.z) + q[8 * i + 6] * bflo(w.w) + q[8 * i + 7] * bfhi(w.w); }
#pragma unroll
                for (int i = 0; i < 4; ++i) { const uint4 w = r4[i]; const int o8 = 64 + 8 * i; a += q[o8] * bflo(w.x) + q[o8 + 1] * bfhi(w.x) + q[o8 + 2] * bflo(w.y) + q[o8 + 3] * bfhi(w.y)
                    + q[o8 + 4] * bflo(w.z) + q[o8 + 5] * bfhi(w.z) + q[o8 + 6] * bflo(w.w) + q[o8 + 7] * bfhi(w.w); }
                sc[jj] = a;
            }
            float mx = m;
#pragma unroll
            for (int jj = 0; jj < 8; ++jj) mx = fmaxf(mx, sc[jj]);
            const float al = exp2f(m - mx);
            float ps = 0.f;
#pragma unroll
            for (int jj = 0; jj < 8; ++jj) { sc[jj] = exp2f(sc[jj] - mx); ps += sc[jj]; }
            l = l * al + ps; m = mx;
#pragma unroll
            for (int d = 0; d < 64; ++d) {
                const uint4 w = *(const uint4*)(Vt + ((size_t)bh * 64 + d) * 2048 + j0);
                o[d] = o[d] * al + sc[0] * bflo(w.x) + sc[1] * bfhi(w.x) + sc[2] * bflo(w.y) + sc[3] * bfhi(w.y) + sc[4] * bflo(w.z) + sc[5] * bfhi(w.z) + sc[6] * bflo(w.w) + sc[7] * bfhi(w.w);
            }
        }
        const float il = 1.f / l;
        bf16_t* dst = mix + ((size_t)b * 2048 + s_) * 1024 + hd * 64;
#pragma unroll
        for (int d = 0; d < 64; d += 2) *(unsigned*)(dst + d) = pack2(o[d] * il, o[d + 1] * il);
    }
}
DI void ssd_naive(const P& p, int bid, int nb) {
    unsigned char* ws = p.ws;
    const bf16_t* xa = (const bf16_t*)(ws + XBCA); const float* dt = (const float*)(ws + DTB); const bf16_t* z = (const bf16_t*)(ws + ZB);
    bf16_t* mix = (bf16_t*)(ws + MIX);
    const int wave = threadIdx.x >> 6, pp = threadIdx.x & 63;
    for (int item = bid; item < 32; item += nb) {
        const int bh = item * 4 + wave, b = bh >> 3, hd = bh & 7, g = hd >> 2;
        const float a = -__expf(p.in[10][hd]), Dh = p.in[11][hd];
        float st[128];
#pragma unroll
        for (int n = 0; n < 128; ++n) st[n] = 0.f;
        for (int t = 0; t < 2048; ++t) {
            const size_t row = (size_t)b * 2048 + t;
            const float dtv = dt[row * 8 + hd];
            const float da = __expf(dtv * a);
            const float xv = bf2f(xa[row * 1024 + hd * 64 + pp]);
            const float xd = dtv * xv;
            const uint4* b4 = (const uint4*)(xa + row * 1024 + 512 + g * 128);
            const uint4* c4 = (const uint4*)(xa + row * 1024 + 768 + g * 128);
            float y = 0.f;
#pragma unroll
            for (int i = 0; i < 16; ++i) {
                const uint4 bw = b4[i], cw = c4[i];
                const unsigned bb[4] = {bw.x, bw.y, bw.z, bw.w}, cc[4] = {cw.x, cw.y, cw.z, cw.w};
#pragma unroll
                for (int k = 0; k < 4; ++k) {
                    const int n = 8 * i + 2 * k;
                    st[n] = da * st[n] + xd * bflo(bb[k]); y += bflo(cc[k]) * st[n];
                    st[n + 1] = da * st[n + 1] + xd * bfhi(bb[k]); y += bfhi(cc[k]) * st[n + 1];
                }
            }
            y += Dh * xv;
            const float zv = bf2f(z[row * 512 + hd * 64 + pp]);
            mix[row * 1024 + 512 + hd * 64 + pp] = f2bf(y * siluf(zv));
        }
    }
}
DI void phase_mixer(const P& p, int bid, int nb, unsigned char* smem) {
    ssd_naive(p, bid, nb);
    attn_naive(p, bid, nb);
}

DI void phase_ssdnorm(const P& p, int bid, int nb, unsigned char* smem) {
    bf16_t* mix = (bf16_t*)(p.ws + MIX);
    const int lane = threadIdx.x & 63, wave = threadIdx.x >> 6;
    for (int tk = bid * 4 + wave; tk < T; tk += nb * 4) {
        uint4* ptr = (uint4*)(mix + (size_t)tk * 1024 + 512 + lane * 8);
        const uint4 w = *ptr;
        const unsigned ww[4] = {w.x, w.y, w.z, w.w};
        float v[8]; float ss = 0.f;
#pragma unroll
        for (int k = 0; k < 4; ++k) { v[2 * k] = bflo(ww[k]); v[2 * k + 1] = bfhi(ww[k]); ss += v[2 * k] * v[2 * k] + v[2 * k + 1] * v[2 * k + 1]; }
#pragma unroll
        for (int o = 16; o >= 1; o >>= 1) ss += __shfl_xor(ss, o);
        const float rr = rsqrtf(ss * (1.f / 256.f) + EPS);
        uint4 o4; o4.x = pack2(v[0] * rr, v[1] * rr); o4.y = pack2(v[2] * rr, v[3] * rr); o4.z = pack2(v[4] * rr, v[5] * rr); o4.w = pack2(v[6] * rr, v[7] * rr);
        *ptr = o4;
    }
}

struct EpiResid {
    float* pre; const float* res;
    DI void operator()(const f32x16 (&acc)[2][2], int rb, int cb, int lane) const {
        const int r = lane & 31, h = lane >> 5;
#pragma unroll
        for (int i = 0; i < 2; ++i)
#pragma unroll
            for (int j = 0; j < 2; ++j) {
                const int col = cb + j * 32 + r;
#pragma unroll
                for (int e = 0; e < 16; ++e) {
                    const size_t idx = (size_t)(rb + i * 32 + crow(e, h)) * 1024 + col;
                    pre[idx] = ALPHA * res[idx] + acc[i][j][e];
                }
            }
    }
};
DI void phase_wout(const P& p, int bid, int nb, unsigned char* smem) {
    const int v = vbid(bid, nb);
    EpiResid e{p.out, p.in[0]};
    GemmArgs g{(const bf16_t*)(p.ws + MIX), 1024, (const bf16_t*)(p.ws + W_OUT), 1024, 1024, nullptr};
    for (int t = v; t < 256 * 8; t += nb) gemm_tile(g, (t >> 3) * 128, (t & 7) * 128, e, smem);
}
DI void ln_row(const float* src, const float* gam, const float* bet, int lane, float (&o)[16]) {
    float v[16];
#pragma unroll
    for (int i = 0; i < 4; ++i) { const float4 t4 = *(const float4*)(src + i * 256 + lane * 4); v[4 * i] = t4.x; v[4 * i + 1] = t4.y; v[4 * i + 2] = t4.z; v[4 * i + 3] = t4.w; }
    float s = 0.f;
#pragma unroll
    for (int i = 0; i < 16; ++i) s += v[i];
    const float mu = wave_sum(s) * (1.f / 1024.f);
    float q = 0.f;
#pragma unroll
    for (int i = 0; i < 16; ++i) { const float d = v[i] - mu; q += d * d; }
    const float rstd = rsqrtf(wave_sum(q) * (1.f / 1024.f) + EPS);
#pragma unroll
    for (int i = 0; i < 4; ++i) {
        const float4 g4 = *(const float4*)(gam + i * 256 + lane * 4), b4 = *(const float4*)(bet + i * 256 + lane * 4);
        o[4 * i] = (v[4 * i] - mu) * rstd * g4.x + b4.x; o[4 * i + 1] = (v[4 * i + 1] - mu) * rstd * g4.y + b4.y;
        o[4 * i + 2] = (v[4 * i + 2] - mu) * rstd * g4.z + b4.z; o[4 * i + 3] = (v[4 * i + 3] - mu) * rstd * g4.w + b4.w;
    }
}
DI void phase_ln1(const P& p, int bid, int nb, unsigned char* smem) {
    const int lane = threadIdx.x & 63, wave = threadIdx.x >> 6;
    float* hf = (float*)(p.ws + H1); bf16_t* hb = (bf16_t*)(p.ws + H1B);
    for (int tk = bid * 4 + wave; tk < T; tk += nb * 4) {
        float o[16];
        ln_row(p.out + (size_t)tk * 1024, p.in[14], p.in[15], lane, o);
#pragma unroll
        for (int i = 0; i < 4; ++i) {
            *(float4*)(hf + (size_t)tk * 1024 + i * 256 + lane * 4) = make_float4(o[4 * i], o[4 * i + 1], o[4 * i + 2], o[4 * i + 3]);
            uint2 w; w.x = pack2(o[4 * i], o[4 * i + 1]); w.y = pack2(o[4 * i + 2], o[4 * i + 3]);
            *(uint2*)(hb + (size_t)tk * 1024 + i * 256 + lane * 4) = w;
        }
    }
}
struct EpiXq {
    bf16_t* qx;
    DI void operator()(const f32x16 (&acc)[2][2], int rb, int cb, int lane) const {
        const int r = lane & 31, h = lane >> 5;
#pragma unroll
        for (int i = 0; i < 2; ++i)
#pragma unroll
            for (int j = 0; j < 2; ++j) {
                const int col = cb + j * 32 + r, hd = col >> 8, d = col & 255;
#pragma unroll
                for (int e = 0; e < 16; ++e) {
                    const int row = rb + i * 32 + crow(e, h), b = row >> 11, s_ = row & 2047;
                    qx[((size_t)(b * 4 + hd) * 2048 + s_) * 256 + d] = f2bf(acc[i][j][e] * XSCALE);
                }
            }
    }
};
DI void phase_xq(const P& p, int bid, int nb, unsigned char* smem) {
    const int v = vbid(bid, nb);
    EpiXq e{(bf16_t*)(p.ws + QX)};
    GemmArgs g{(const bf16_t*)(p.ws + H1B), 1024, (const bf16_t*)(p.ws + W_XQ), 1024, 1024, nullptr};
    for (int t = v; t < 256 * 8; t += nb) gemm_tile(g, (t >> 3) * 128, (t & 7) * 128, e, smem);
}
DI void phase_xattn(const P& p, int bid, int nb, unsigned char* smem) {
    unsigned char* ws = p.ws;
    const bf16_t* qx = (const bf16_t*)(ws + QX); const bf16_t* kx = (const bf16_t*)(ws + KX); const bf16_t* vxt = (const bf16_t*)(ws + VXT);
    bf16_t* ox = (bf16_t*)(ws + OX);
    const int lane = threadIdx.x & 63, hd = threadIdx.x >> 6;
    float* qs = (float*)smem + hd * 512; float* ps = qs + 256;
    for (int tk = bid; tk < T; tk += nb) {
        const int b = tk >> 11, s_ = tk & 2047;
        __syncthreads();
        {
            const uint2 w = *(const uint2*)(qx + ((size_t)(b * 4 + hd) * 2048 + s_) * 256 + lane * 4);
            qs[lane * 4] = bflo(w.x); qs[lane * 4 + 1] = bfhi(w.x); qs[lane * 4 + 2] = bflo(w.y); qs[lane * 4 + 3] = bfhi(w.y);
        }
        __syncthreads();
        float sc[4];
#pragma unroll
        for (int i = 0; i < 4; ++i) {
            const int m = lane + 64 * i;
            const uint4* k4 = (const uint4*)(kx + ((size_t)(b * 4 + hd) * 256 + m) * 256);
            float a = 0.f;
#pragma unroll 8
            for (int c = 0; c < 32; ++c) {
                const uint4 w = k4[c];
                const float4 q0 = *(const float4*)(qs + 8 * c), q1 = *(const float4*)(qs + 8 * c + 4);
                a += q0.x * bflo(w.x) + q0.y * bfhi(w.x) + q0.z * bflo(w.y) + q0.w * bfhi(w.y) + q1.x * bflo(w.z) + q1.y * bfhi(w.z) + q1.z * bflo(w.w) + q1.w * bfhi(w.w);
            }
            sc[i] = a;
        }
        const float mx = wave_max(fmaxf(fmaxf(sc[0], sc[1]), fmaxf(sc[2], sc[3])));
        float sum = 0.f;
#pragma unroll
        for (int i = 0; i < 4; ++i) { sc[i] = exp2f(sc[i] - mx); sum += sc[i]; }
        const float il = 1.f / wave_sum(sum);
#pragma unroll
        for (int i = 0; i < 4; ++i) ps[lane + 64 * i] = sc[i] * il;
        __syncthreads();
        float o[4];
#pragma unroll
        for (int dd = 0; dd < 4; ++dd) {
            const int d = lane * 4 + dd;
            const uint4* v4 = (const uint4*)(vxt + ((size_t)(b * 4 + hd) * 256 + d) * 256);
            float a = 0.f;
#pragma unroll 8
            for (int c = 0; c < 32; ++c) {
                const uint4 w = v4[c];
                const float4 q0 = *(const float4*)(ps + 8 * c), q1 = *(const float4*)(ps + 8 * c + 4);
                a += q0.x * bflo(w.x) + q0.y * bfhi(w.x) + q0.z * bflo(w.y) + q0.w * bfhi(w.y) + q1.x * bflo(w.z) + q1.y * bfhi(w.z) + q1.z * bflo(w.w) + q1.w * bfhi(w.w);
            }
            o[dd] = a;
        }
        uint2 w; w.x = pack2(o[0], o[1]); w.y = pack2(o[2], o[3]);
        *(uint2*)(ox + (size_t)tk * 1024 + hd * 256 + lane * 4) = w;
    }
}
DI void phase_xo(const P& p, int bid, int nb, unsigned char* smem) {
    const int v = vbid(bid, nb);
    EpiResid e{p.out, (const float*)(p.ws + H1)};
    GemmArgs g{(const bf16_t*)(p.ws + OX), 1024, (const bf16_t*)(p.ws + W_XO), 1024, 1024, nullptr};
    for (int t = v; t < 256 * 8; t += nb) gemm_tile(g, (t >> 3) * 128, (t & 7) * 128, e, smem);
}
DI void phase_ln2_router(const P& p, int bid, int nb, unsigned char* smem) {
    unsigned char* ws = p.ws;
    const int lane = threadIdx.x & 63, wave = threadIdx.x >> 6;
    float* hf = (float*)(ws + H2); bf16_t* hb = (bf16_t*)(ws + H2B);
    const float* wrt = (const float*)(ws + W_RT);
    unsigned* cnt = (unsigned*)(ws + CTL + CTL_CNT); int* lists = (int*)(ws + LISTS); float* tgate = (float*)(ws + TOK_GATE);
    for (int tk = bid * 4 + wave; tk < T; tk += nb * 4) {
        float o[16];
        ln_row(p.out + (size_t)tk * 1024, p.in[20], p.in[21], lane, o);
#pragma unroll
        for (int i = 0; i < 4; ++i) {
            *(float4*)(hf + (size_t)tk * 1024 + i * 256 + lane * 4) = make_float4(o[4 * i], o[4 * i + 1], o[4 * i + 2], o[4 * i + 3]);
            uint2 w; w.x = pack2(o[4 * i], o[4 * i + 1]); w.y = pack2(o[4 * i + 2], o[4 * i + 3]);
            *(uint2*)(hb + (size_t)tk * 1024 + i * 256 + lane * 4) = w;
        }
        float* lg = (float*)smem + wave * 64;
#pragma unroll 1
        for (int j = 0; j < 36; ++j) {
            float a = 0.f;
#pragma unroll
            for (int i = 0; i < 4; ++i) {
                const float4 w4 = *(const float4*)(wrt + j * 1024 + i * 256 + lane * 4);
                a += o[4 * i] * w4.x + o[4 * i + 1] * w4.y + o[4 * i + 2] * w4.z + o[4 * i + 3] * w4.w;
            }
            a = wave_sum(a);
            if (lane == 0) lg[j] = a;
        }
        __builtin_amdgcn_wave_barrier();
        float gl[4], el[32];
#pragma unroll
        for (int j = 0; j < 4; ++j) gl[j] = lg[j] + p.in[23][j];
#pragma unroll
        for (int j = 0; j < 32; ++j) el[j] = lg[4 + j] + p.in[25][j];
        __builtin_amdgcn_wave_barrier();
        int gi = 0; float gm = gl[0];
#pragma unroll
        for (int j = 1; j < 4; ++j) if (gl[j] > gm) { gm = gl[j]; gi = j; }
        float gs = 0.f;
#pragma unroll
        for (int j = 0; j < 4; ++j) gs += __expf(gl[j] - gm);
        const float ggate = 1.f / gs;
        float ev[8];
#pragma unroll
        for (int j = 0; j < 8; ++j) ev[j] = gi == 0 ? el[j] : gi == 1 ? el[8 + j] : gi == 2 ? el[16 + j] : el[24 + j];
        int i1 = 0; float v1 = ev[0];
#pragma unroll
        for (int j = 1; j < 8; ++j) if (ev[j] > v1) { v1 = ev[j]; i1 = j; }
        int i2 = -1; float v2 = -3.0e38f;
#pragma unroll
        for (int j = 0; j < 8; ++j) if (j != i1 && ev[j] > v2) { v2 = ev[j]; i2 = j; }
        const float e2 = __expf(v2 - v1);
        const float g1 = ggate / (1.f + e2), g2 = ggate * e2 / (1.f + e2);
        if (lane == 0) {
            const int ex1 = gi * 8 + i1, ex2 = gi * 8 + i2;
            const unsigned p1 = atomicAdd(&cnt[ex1], 1u); lists[(size_t)ex1 * T + p1] = tk * 2;
            const unsigned p2 = atomicAdd(&cnt[ex2], 1u); lists[(size_t)ex2 * T + p2] = tk * 2 + 1;
            tgate[tk * 2] = g1; tgate[tk * 2 + 1] = g2;
        }
    }
}
struct MoeMap { int off[33]; };
DI int moe_tiles(const unsigned* cnt, int* offs  ) {
    __syncthreads();
    if (threadIdx.x == 0) { int o = 0; for (int e = 0; e < 32; ++e) { offs[e] = o; o += (((int)cnt[e] + 127) >> 7) << 7; } offs[32] = o; }
    __syncthreads();
    return offs[32] >> 7;
}
struct EpiGU {
    bf16_t* hdn;
    DI void operator()(const f32x16 (&acc)[2][2], int rb, int cb, int lane) const {
        const int r = lane & 31, h = lane >> 5;
        const int hc = ((cb & 511) >> 7) * 64 + ((cb >> 6) & 1) * 32 + r;
#pragma unroll
        for (int i = 0; i < 2; ++i)
#pragma unroll
            for (int e = 0; e < 16; ++e) {
                const int slot = rb + i * 32 + crow(e, h);
                hdn[(size_t)slot * 256 + hc] = f2bf(siluf(acc[i][0][e]) * acc[i][1][e]);
            }
    }
};
struct EpiDown {
    bf16_t* y; const int* ltok; const float* lgate; int m0;
    DI void operator()(const f32x16 (&acc)[2][2], int rb, int cb, int lane) const {
        const int r = lane & 31, h = lane >> 5;
#pragma unroll
        for (int i = 0; i < 2; ++i)
#pragma unroll
            for (int e = 0; e < 16; ++e) {
                const int lr = rb - m0 + i * 32 + crow(e, h);
                const int tk2 = ltok[lr];
                if (tk2 >= 0) {
                    const float gt = lgate[lr];
#pragma unroll
                    for (int j = 0; j < 2; ++j) y[(size_t)tk2 * 1024 + cb + j * 32 + r] = f2bf(gt * acc[i][j][e]);
                }
            }
    }
};
template <int WHICH>
DI void phase_moe(const P& p, int bid, int nb, unsigned char* smem) {
    unsigned char* ws = p.ws;
    const unsigned* cnt = (const unsigned*)(ws + CTL + CTL_CNT); const int* lists = (const int*)(ws + LISTS); const float* tgate = (const float*)(ws + TOK_GATE);
    int* offs = (int*)(smem + GEMM_LDS); int* ltok = offs + 64; int* lrow = ltok + 128; float* lgate = (float*)(lrow + 128);
    const int nmt = moe_tiles(cnt, offs);
    constexpr int NNT = WHICH == 0 ? 4 : 8;
    const int v = vbid(bid, nb);
    for (int t = v; t < nmt * NNT; t += nb) {
        const int mt = t / NNT, ntl = t % NNT;
        const int slot0 = mt * 128;
        int e = 0;
        while (offs[e + 1] <= slot0) ++e;
        __syncthreads();
        if (threadIdx.x < 128) {
            const int pos = slot0 - offs[e] + threadIdx.x;
            const int tk2 = pos < (int)cnt[e] ? lists[(size_t)e * T + pos] : -1;
            ltok[threadIdx.x] = tk2; lrow[threadIdx.x] = tk2 < 0 ? 0 : (tk2 >> 1); lgate[threadIdx.x] = tk2 < 0 ? 0.f : tgate[tk2];
        }
        __syncthreads();
        if (WHICH == 0) {
            EpiGU ep{(bf16_t*)(ws + HDN)};
            GemmArgs g{(const bf16_t*)(ws + H2B), 1024, (const bf16_t*)(ws + W_GU) + (size_t)e * 512 * 1024, 1024, 1024, lrow};
            gemm_tile(g, slot0, ntl * 128, ep, smem);
        } else {
            EpiDown ep{(bf16_t*)(ws + YB), ltok, lgate, slot0};
            GemmArgs g{(const bf16_t*)(ws + HDN), 256, (const bf16_t*)(ws + W_DN) + (size_t)e * 1024 * 256, 256, 256, nullptr};
            gemm_tile(g, slot0, ntl * 128, ep, smem);
        }
    }
}
DI void phase_final(const P& p, int bid, int nb, unsigned char* smem) {
    const int lane = threadIdx.x & 63, wave = threadIdx.x >> 6;
    const float* hf = (const float*)(p.ws + H2); const bf16_t* y = (const bf16_t*)(p.ws + YB);
    const float* gam = p.in[29]; const float* bet = p.in[30];
    for (int tk = bid * 4 + wave; tk < T; tk += nb * 4) {
        float v[16];
#pragma unroll
        for (int i = 0; i < 4; ++i) {
            const float4 t4 = *(const float4*)(hf + (size_t)tk * 1024 + i * 256 + lane * 4);
            const uint2 a = *(const uint2*)(y + (size_t)(tk * 2) * 1024 + i * 256 + lane * 4), b = *(const uint2*)(y + (size_t)(tk * 2 + 1) * 1024 + i * 256 + lane * 4);
            v[4 * i] = ALPHA * t4.x + bflo(a.x) + bflo(b.x); v[4 * i + 1] = ALPHA * t4.y + bfhi(a.x) + bfhi(b.x);
            v[4 * i + 2] = ALPHA * t4.z + bflo(a.y) + bflo(b.y); v[4 * i + 3] = ALPHA * t4.w + bfhi(a.y) + bfhi(b.y);
        }
        float s = 0.f;
#pragma unroll
        for (int i = 0; i < 16; ++i) s += v[i];
        const float mu = wave_sum(s) * (1.f / 1024.f);
        float q = 0.f;
#pragma unroll
        for (int i = 0; i < 16; ++i) { const float d = v[i] - mu; q += d * d; }
        const float rstd = rsqrtf(wave_sum(q) * (1.f / 1024.f) + EPS);
#pragma unroll
        for (int i = 0; i < 4; ++i) {
            const float4 g4 = *(const float4*)(gam + i * 256 + lane * 4), b4 = *(const float4*)(bet + i * 256 + lane * 4);
            *(float4*)(p.out + (size_t)tk * 1024 + i * 256 + lane * 4) = make_float4((v[4 * i] - mu) * rstd * g4.x + b4.x, (v[4 * i + 1] - mu) * rstd * g4.y + b4.y,
                                                                                    (v[4 * i + 2] - mu) * rstd * g4.z + b4.z, (v[4 * i + 3] - mu) * rstd * g4.w + b4.w);
        }
    }
}

constexpr int NPHASE = 14;
template <int PH>
DI void run_phase(const P& p, int bid, int nb, unsigned char* smem) {
    if (PH == 0) phase_prep(p, bid, nb, smem);
    else if (PH == 1) phase_proj(p, bid, nb, smem);
    else if (PH == 2) phase_up(p, bid, nb, smem);
    else if (PH == 3) phase_mixer(p, bid, nb, smem);
    else if (PH == 4) phase_ssdnorm(p, bid, nb, smem);
    else if (PH == 5) phase_wout(p, bid, nb, smem);
    else if (PH == 6) phase_ln1(p, bid, nb, smem);
    else if (PH == 7) phase_xq(p, bid, nb, smem);
    else if (PH == 8) phase_xattn(p, bid, nb, smem);
    else if (PH == 9) phase_xo(p, bid, nb, smem);
    else if (PH == 10) phase_ln2_router(p, bid, nb, smem);
    else if (PH == 11) phase_moe<0>(p, bid, nb, smem);
    else if (PH == 12) phase_moe<1>(p, bid, nb, smem);
    else if (PH == 13) phase_final(p, bid, nb, smem);
}
template <int PH>
__global__ void __launch_bounds__(256, 2) k_phase(P p) {
    __shared__ __attribute__((aligned(16))) unsigned char smem[SMEM_BYTES];
    run_phase<PH>(p, blockIdx.x, gridDim.x, smem);
}

template <int PH>
__global__ void __launch_bounds__(256, 1) k_phase_big(P p) {
    __shared__ __attribute__((aligned(16))) unsigned char smem[SMEM_BYTES];
    run_phase<PH>(p, blockIdx.x, gridDim.x, smem);
}
template <int PH>
static void launch_phase(const P& p, int grid, hipStream_t st) {
    if constexpr (PH == 3) hipLaunchKernelGGL((k_phase_big<PH>), dim3(grid), dim3(256), 0, st, p);
    else hipLaunchKernelGGL((k_phase<PH>), dim3(grid), dim3(256), 0, st, p);
}

extern "C" void kernel_launch(void* const* d_in, const int* in_sizes, int n_in, void* d_out, int out_size, void* d_ws, size_t ws_size, hipStream_t stream) {
    if (n_in != 31 || out_size != T * D || ws_size < WS_NEED) {
        fprintf(stderr, "kernel_launch: unexpected shapes: n_in %d out %d ws %zu (need %zu)\n", n_in, out_size, ws_size, (size_t)WS_NEED);
        return;
    }
    P p{};
    for (int i = 0; i < 31; ++i) p.in[i] = (const float*)d_in[i];
    p.out = (float*)d_out; p.ws = (unsigned char*)d_ws;
    (void)hipMemsetAsync((unsigned char*)d_ws + CTL, 0, CTL_BYTES, stream);
    const int grid = 1024;
    launch_phase<0>(p, grid, stream); launch_phase<1>(p, grid, stream); launch_phase<2>(p, grid, stream); launch_phase<3>(p, grid, stream);
    launch_phase<4>(p, grid, stream); launch_phase<5>(p, grid, stream); launch_phase<6>(p, grid, stream); launch_phase<7>(p, grid, stream);
    launch_phase<8>(p, grid, stream); launch_phase<9>(p, grid, stream); launch_phase<10>(p, grid, stream); launch_phase<11>(p, grid, stream);
    launch_phase<12>(p, grid, stream); launch_phase<13>(p, grid, stream);
}
```

```cpp
#include <hip/hip_runtime.h>
#include <stdint.h>
#include <stdio.h>

#ifndef MEGA
#define MEGA 1
#endif
#ifndef GEMM_DIRECT
#define GEMM_DIRECT 0
#endif

typedef unsigned short bf16_t;
typedef short bf16x8 __attribute__((ext_vector_type(8)));
typedef float f32x16 __attribute__((ext_vector_type(16)));
#define DI __device__ __forceinline__
#define MFMA32(a, b, c) __builtin_amdgcn_mfma_f32_32x32x16_bf16((a), (b), (c), 0, 0, 0)

constexpr int Bn = 16, S = 2048, T = Bn * S, D = 1024;
constexpr int NMEM = 256;
constexpr float EPS = 1e-5f;
constexpr float ALPHA = 1.189207115002721f;
constexpr float LOG2E = 1.4426950408889634f;
constexpr float QSCALE = 0.10206207261596577f * LOG2E;
constexpr float XSCALE = 0.0625f * LOG2E;
constexpr int NEXP = 32;
constexpr int MAXSLOTS = 69632;

constexpr size_t MiB = 1u << 20;
constexpr size_t W_IN = 0;
constexpr size_t W_QUP = W_IN + 4 * MiB;
constexpr size_t W_KVUP = W_QUP + 768 * 256 * 2;
constexpr size_t W_OUT = W_KVUP + 1024 * 128 * 2;
constexpr size_t W_XQ = W_OUT + 2 * MiB;
constexpr size_t W_XKV = W_XQ + 2 * MiB;
constexpr size_t W_XO = W_XKV + 4 * MiB;
constexpr size_t W_GU = W_XO + 2 * MiB;
constexpr size_t W_DN = W_GU + 32 * MiB;
constexpr size_t W_RT = W_DN + 16 * MiB;
constexpr size_t ROPE_C = W_RT + 48 * 1024 * 4;
constexpr size_t ROPE_S = ROPE_C + 2048 * 16 * 4;
constexpr size_t TOK_GATE = ROPE_S + 2048 * 16 * 4;
constexpr size_t CTL = TOK_GATE + (size_t)T * 2 * 4;
constexpr size_t CTL_BYTES = 32768;
constexpr size_t CTL_CNT = 16384;
static_assert(CTL + CTL_BYTES <= 64 * MiB, "weights region overflow");
constexpr size_t RA = 64 * MiB, RB = 192 * MiB, RC = 320 * MiB, RD = 448 * MiB, WS_NEED = 512 * MiB;
constexpr size_t XBC = RA;
constexpr size_t KX = RA + 64 * MiB;
constexpr size_t VXT = KX + 8 * MiB;
constexpr size_t YB = RA;
constexpr size_t QB = RB;
constexpr size_t KNB = RB + 48 * MiB;
constexpr size_t VTB = KNB + 32 * MiB;
constexpr size_t H1 = RB;
constexpr size_t H2 = RB;
constexpr size_t XBCA = RC;
constexpr size_t MIX = RC + 64 * MiB;
constexpr size_t H1B = RC;
constexpr size_t QX = RC + 64 * MiB;
constexpr size_t OX = RC;
constexpr size_t H2B = RC;
constexpr size_t HDN = RC + 64 * MiB;
constexpr size_t CQ = RD;
constexpr size_t CKV = CQ + 16 * MiB;
constexpr size_t KROPE = CKV + 8 * MiB;
constexpr size_t DTB = KROPE + 2 * MiB;
constexpr size_t ZB = DTB + 1 * MiB;
constexpr size_t LISTS = RD;
static_assert(ZB + 32 * MiB <= WS_NEED, "region D overflow");

struct P {
    const float* in[31];
    float* out;
    unsigned char* ws;
};

DI bf16_t f2bf(float x) { unsigned u = __float_as_uint(x); u += 0x7fffu + ((u >> 16) & 1u); return (bf16_t)(u >> 16); }
DI float bf2f(bf16_t b) { return __uint_as_float(((unsigned)b) << 16); }
DI float bflo(unsigned w) { return __uint_as_float(w << 16); }
DI float bfhi(unsigned w) { return __uint_as_float(w & 0xffff0000u); }
DI unsigned pack2(float a, float b) { return (unsigned)f2bf(a) | ((unsigned)f2bf(b) << 16); }
DI float siluf(float x) { return x / (1.f + __expf(-x)); }
DI float softplusf(float x) { return x > 20.f ? x : log1pf(__expf(x)); }
DI int crow(int reg, int h) { return (reg & 3) + 8 * (reg >> 2) + 4 * h; }
DI float wave_sum(float v) {
#pragma unroll
    for (int o = 32; o >= 1; o >>= 1) v += __shfl_xor(v, o);
    return v;
}
DI float wave_max(float v) {
#pragma unroll
    for (int o = 32; o >= 1; o >>= 1) v = fmaxf(v, __shfl_xor(v, o));
    return v;
}

constexpr int LDS_ROW = 144;
constexpr int TILE_BYTES = 128 * LDS_ROW;
constexpr int GEMM_LDS = 4 * TILE_BYTES;
constexpr int SMEM_BYTES = GEMM_LDS + 2048;

struct GemmArgs {
    const bf16_t* A; int lda;
    const bf16_t* Bt; int ldb;
    int K;
    const int* lrows;
};

template <class Epi>
DI void gemm_tile(const GemmArgs& g, int m0, int n0, Epi& epi, unsigned char* smem) {
    const int tid = threadIdx.x, lane = tid & 63, wave = tid >> 6, wr = wave >> 1, wc = wave & 1;
    const int r = lane & 31, h = lane >> 5;
    f32x16 acc[2][2];
#pragma unroll
    for (int i = 0; i < 2; ++i)
#pragma unroll
        for (int j = 0; j < 2; ++j)
#pragma unroll
            for (int e = 0; e < 16; ++e) acc[i][j][e] = 0.f;
    const int nk = g.K >> 6;
#if GEMM_DIRECT
    {
        const bf16_t* ap[2]; const bf16_t* bp[2];
#pragma unroll
        for (int i = 0; i < 2; ++i) {
            const int lr = wr * 64 + i * 32 + r;
            const int grow = g.lrows ? g.lrows[lr] : (m0 + lr);
            ap[i] = g.A + (size_t)grow * g.lda + 8 * h;
            bp[i] = g.Bt + (size_t)(n0 + wc * 64 + i * 32 + r) * g.ldb + 8 * h;
        }
        for (int k = 0; k < g.K; k += 16) {
            bf16x8 a[2], b[2];
#pragma unroll
            for (int i = 0; i < 2; ++i) { a[i] = *(const bf16x8*)(ap[i] + k); b[i] = *(const bf16x8*)(bp[i] + k); }
#pragma unroll
            for (int i = 0; i < 2; ++i)
#pragma unroll
                for (int j = 0; j < 2; ++j) acc[i][j] = MFMA32(a[i], b[j], acc[i][j]);
        }
    }
#else
    {
        const int srow = tid >> 3, sch = tid & 7;
        const bf16_t* ag[4]; const bf16_t* bg[4];
#pragma unroll
        for (int i = 0; i < 4; ++i) {
            const int lr = srow + 32 * i;
            const int grow = g.lrows ? g.lrows[lr] : (m0 + lr);
            ag[i] = g.A + (size_t)grow * g.lda + sch * 8;
            bg[i] = g.Bt + (size_t)(n0 + lr) * g.ldb + sch * 8;
        }
        const int soff = srow * LDS_ROW + sch * 16;
        uint4 ra0, ra1, ra2, ra3, rb0, rb1, rb2, rb3;
#define G_LOAD(KO) do { ra0 = *(const uint4*)(ag[0] + (KO)); ra1 = *(const uint4*)(ag[1] + (KO)); ra2 = *(const uint4*)(ag[2] + (KO)); ra3 = *(const uint4*)(ag[3] + (KO)); \
                        rb0 = *(const uint4*)(bg[0] + (KO)); rb1 = *(const uint4*)(bg[1] + (KO)); rb2 = *(const uint4*)(bg[2] + (KO)); rb3 = *(const uint4*)(bg[3] + (KO)); } while (0)
#define L_STORE(BUF) do { unsigned char* _d = (BUF) + soff; \
        *(uint4*)(_d) = ra0; *(uint4*)(_d + 32 * LDS_ROW) = ra1; *(uint4*)(_d + 64 * LDS_ROW) = ra2; *(uint4*)(_d + 96 * LDS_ROW) = ra3; \
        *(uint4*)(_d + TILE_BYTES) = rb0; *(uint4*)(_d + TILE_BYTES + 32 * LDS_ROW) = rb1; *(uint4*)(_d + TILE_BYTES + 64 * LDS_ROW) = rb2; *(uint4*)(_d + TILE_BYTES + 96 * LDS_ROW) = rb3; } while (0)
        G_LOAD(0);
        __syncthreads();
        L_STORE(smem);
        __syncthreads();
        const int aoff = (wr * 64 + r) * LDS_ROW + h * 16;
        const int boff = TILE_BYTES + (wc * 64 + r) * LDS_ROW + h * 16;
        for (int kt = 0; kt < nk; ++kt) {
            const unsigned char* cur = smem + (kt & 1) * 2 * TILE_BYTES;
            unsigned char* nxt = smem + ((kt + 1) & 1) * 2 * TILE_BYTES;
            const bool more = (kt + 1 < nk);
            if (more) G_LOAD((kt + 1) * 64);
#pragma unroll
            for (int ks = 0; ks < 4; ++ks) {
                const bf16x8 a0 = *(const bf16x8*)(cur + aoff + ks * 32);
                const bf16x8 a1 = *(const bf16x8*)(cur + aoff + 32 * LDS_ROW + ks * 32);
                const bf16x8 b0 = *(const bf16x8*)(cur + boff + ks * 32);
                const bf16x8 b1 = *(const bf16x8*)(cur + boff + 32 * LDS_ROW + ks * 32);
                acc[0][0] = MFMA32(a0, b0, acc[0][0]); acc[0][1] = MFMA32(a0, b1, acc[0][1]);
                acc[1][0] = MFMA32(a1, b0, acc[1][0]); acc[1][1] = MFMA32(a1, b1, acc[1][1]);
            }
            if (more) L_STORE(nxt);
            __syncthreads();
        }
#undef G_LOAD
#undef L_STORE
    }
#endif
    epi(acc, m0 + wr * 64, n0 + wc * 64, lane);
}

DI int vbid(int bid, int nb) { return (nb % 8 == 0) ? (bid % 8) * (nb / 8) + bid / 8 : bid; }

DI int colmap_in(int n) {
    if (n < 384) return n;
    if (n < 896) return 416 + (n - 384);
    if (n < 1920) return 928 + (n - 896);
    if (n < 1952) return 384 + (n - 1920);
    if (n < 1960) return n;
    return -1;
}
template <int KIND>
DI void tconv_tile(const float* src, const float* src2, int ldsrc, bf16_t* dst, int K, int k0, int n0, const float* scale, int scale_from, unsigned char* smem) {
    float* tile = (float*)smem;
    const int t = threadIdx.x;
    __syncthreads();
#pragma unroll 4
    for (int i = 0; i < 16; ++i) {
        const int k = i * 4 + (t >> 6), n = t & 63;
        const int nd = n0 + n;
        float v = 0.f;
        if (KIND == 1) { const int c = colmap_in(nd); if (c >= 0) v = src[(size_t)(k0 + k) * ldsrc + c]; }
        else if (KIND == 2) {
            const int j = nd >> 7, wc = (nd >> 6) & 1, isup = (nd >> 5) & 1, ii = nd & 31;
            const int c = 64 * j + 32 * wc + ii;
            v = (isup ? src2 : src)[(size_t)(k0 + k) * ldsrc + c];
        } else v = src[(size_t)(k0 + k) * ldsrc + nd];
        if (scale && (k0 + k) >= scale_from) v *= scale[k0 + k - scale_from];
        tile[k * 65 + n] = v;
    }
    __syncthreads();
#pragma unroll 4
    for (int i = 0; i < 16; ++i) {
        const int n = i * 4 + (t >> 6), k = t & 63;
        dst[(size_t)(n0 + n) * K + k0 + k] = f2bf(tile[k * 65 + n]);
    }
}

DI void phase_prep(const P& p, int bid, int nb, unsigned char* smem) {
    unsigned char* ws = p.ws;
    const int tid = threadIdx.x;
    constexpr int J0 = 512, J1 = J0 + 48, J2 = J1 + 32, J3 = J2 + 256, J4 = J3 + 256, J5 = J4 + 256, J6 = J5 + 256, J7 = J6 + 256, J8 = J7 + 4096, J9 = J8 + 2048;
    for (int t = bid; t < J9; t += nb) {
        if (t < J0) { const int kt = t >> 5, ntl = t & 31; tconv_tile<1>(p.in[2], nullptr, 1960, (bf16_t*)(ws + W_IN), 1024, kt * 64, ntl * 64, nullptr, 0, smem); }
        else if (t < J1) { const int u = t - J0, kt = u / 12, ntl = u % 12; tconv_tile<0>(p.in[4], nullptr, 768, (bf16_t*)(ws + W_QUP), 256, kt * 64, ntl * 64, p.in[3], 0, smem); }
        else if (t < J2) { const int u = t - J1, kt = u >> 4, ntl = u & 15; tconv_tile<0>(p.in[6], nullptr, 1024, (bf16_t*)(ws + W_KVUP), 128, kt * 64, ntl * 64, p.in[5], 0, smem); }
        else if (t < J3) { const int u = t - J2, kt = u >> 4, ntl = u & 15; tconv_tile<0>(p.in[13], nullptr, 1024, (bf16_t*)(ws + W_OUT), 1024, kt * 64, ntl * 64, p.in[12], 512, smem); }
        else if (t < J4) { const int u = t - J3, kt = u >> 4, ntl = u & 15; tconv_tile<0>(p.in[16], nullptr, 1024, (bf16_t*)(ws + W_XQ), 1024, kt * 64, ntl * 64, nullptr, 0, smem); }
        else if (t < J5) { const int u = t - J4, kt = u >> 4, ntl = u & 15; tconv_tile<0>(p.in[17], nullptr, 1024, (bf16_t*)(ws + W_XKV), 1024, kt * 64, ntl * 64, nullptr, 0, smem); }
        else if (t < J6) { const int u = t - J5, kt = u >> 4, ntl = u & 15; tconv_tile<0>(p.in[18], nullptr, 1024, (bf16_t*)(ws + W_XKV) + (size_t)1024 * 1024, 1024, kt * 64, ntl * 64, nullptr, 0, smem); }
        else if (t < J7) { const int u = t - J6, kt = u >> 4, ntl = u & 15; tconv_tile<0>(p.in[19], nullptr, 1024, (bf16_t*)(ws + W_XO), 1024, kt * 64, ntl * 64, nullptr, 0, smem); }
        else if (t < J8) { const int u = t - J7, e = u >> 7, v = u & 127, kt = v >> 3, ntl = v & 7;
            tconv_tile<2>(p.in[26] + (size_t)e * 1024 * 256, p.in[27] + (size_t)e * 1024 * 256, 256, (bf16_t*)(ws + W_GU) + (size_t)e * 512 * 1024, 1024, kt * 64, ntl * 64, nullptr, 0, smem); }
        else { const int u = t - J8, e = u >> 6, v = u & 63, kt = v >> 4, ntl = v & 15;
            tconv_tile<0>(p.in[28] + (size_t)e * 256 * 1024, nullptr, 1024, (bf16_t*)(ws + W_DN) + (size_t)e * 1024 * 256, 256, kt * 64, ntl * 64, nullptr, 0, smem); }
    }
    {
        const size_t gsz = (size_t)nb * 256, g0 = (size_t)bid * 256 + tid;
        bf16_t* xb = (bf16_t*)p.out;
        const float4* x4 = (const float4*)p.in[0];
        for (size_t i = g0; i < (size_t)T * D / 4; i += gsz) { const float4 v = x4[i]; uint2 o; o.x = pack2(v.x, v.y); o.y = pack2(v.z, v.w); ((uint2*)xb)[i] = o; }
        bf16_t* mb = xb + (size_t)T * D;
        const float4* m4 = (const float4*)p.in[1];
        for (size_t i = g0; i < (size_t)Bn * NMEM * D / 4; i += gsz) { const float4 v = m4[i]; uint2 o; o.x = pack2(v.x, v.y); o.y = pack2(v.z, v.w); ((uint2*)mb)[i] = o; }
        float* wrt = (float*)(ws + W_RT);
        for (size_t i = g0; i < 48 * 1024; i += gsz) {
            const int j = (int)(i >> 10), k = (int)(i & 1023);
            float v = 0.f;
            if (j < 4) v = p.in[22][k * 4 + j]; else if (j < 36) v = p.in[24][k * 32 + (j - 4)];
            wrt[i] = v;
        }
        float* rc = (float*)(ws + ROPE_C); float* rs = (float*)(ws + ROPE_S);
        for (size_t i = g0; i < 2048 * 16; i += gsz) {
            const int pos = (int)(i >> 4), f = (int)(i & 15);
            const float inv = powf(10000.f, -(float)f / 16.f);
            const float ang = (float)pos * inv;
            const double a = (double)ang;
            const double k2 = rint(a * 0.15915494309189535);
            const float rr = (float)(a - k2 * 6.283185307179586);
            rc[i] = cosf(rr); rs[i] = sinf(rr);
        }
    }
}

struct EpiProj {
    bf16_t *cq, *ckv, *z, *xbc, *krope; float* dt; const float *rc, *rs, *dtb;
    DI void operator()(const f32x16 (&acc)[2][2], int rb, int cb, int lane) const {
        const int r = lane & 31, h = lane >> 5;
#pragma unroll
        for (int i = 0; i < 2; ++i)
#pragma unroll
            for (int j = 0; j < 2; ++j) {
                const int col = cb + j * 32 + r;
                const int colb = cb + j * 32;
#pragma unroll
                for (int e = 0; e < 16; ++e) {
                    const int row = rb + i * 32 + crow(e, h);
                    const float v = acc[i][j][e];
                    if (colb < 256) cq[(size_t)row * 256 + col] = f2bf(v);
                    else if (colb < 384) ckv[(size_t)row * 128 + col - 256] = f2bf(v);
                    else if (colb < 896) z[(size_t)row * 512 + col - 384] = f2bf(v);
                    else if (colb < 1920) xbc[(size_t)row * 1024 + col - 896] = f2bf(v);
                    else if (colb == 1920) {
                        const float pv = __shfl_xor(v, 16);
                        const int pos = row & 2047, f = r & 15;
                        const float c = rc[pos * 16 + f], s = rs[pos * 16 + f];
                        const float o = (r < 16) ? (v * c - pv * s) : (v * c + pv * s);
                        krope[(size_t)row * 32 + r] = f2bf(o);
                    } else if (colb == 1952) {
                        if (r < 8) dt[(size_t)row * 8 + r] = softplusf(v + dtb[r]);
                    }
                }
            }
    }
};
struct EpiMemKV {
    bf16_t *kx, *vxt;
    DI void operator()(const f32x16 (&acc)[2][2], int rb, int cb, int lane) const {
        const int r = lane & 31, h = lane >> 5;
#pragma unroll
        for (int i = 0; i < 2; ++i)
#pragma unroll
            for (int j = 0; j < 2; ++j) {
                const int col = cb + j * 32 + r;
#pragma unroll
                for (int e = 0; e < 16; ++e) {
                    const int row = rb + i * 32 + crow(e, h);
                    const int b = row >> 8, m = row & 255;
                    const float v = acc[i][j][e];
                    if (col < 1024) { const int hd = col >> 8, d = col & 255; kx[((size_t)(b * 4 + hd) * 256 + m) * 256 + d] = f2bf(v); }
                    else { const int c2 = col - 1024, hd = c2 >> 8, d = c2 & 255; vxt[((size_t)(b * 4 + hd) * 256 + d) * 256 + m] = f2bf(v); }
                }
            }
    }
};
DI void phase_proj(const P& p, int bid, int nb, unsigned char* smem) {
    unsigned char* ws = p.ws;
    const int v = vbid(bid, nb);
    const bf16_t* xb = (const bf16_t*)p.out;
    EpiProj e1{(bf16_t*)(ws + CQ), (bf16_t*)(ws + CKV), (bf16_t*)(ws + ZB), (bf16_t*)(ws + XBC), (bf16_t*)(ws + KROPE), (float*)(ws + DTB),
               (const float*)(ws + ROPE_C), (const float*)(ws + ROPE_S), p.in[9]};
    EpiMemKV e2{(bf16_t*)(ws + KX), (bf16_t*)(ws + VXT)};
    constexpr int NT1 = 256 * 16, NT2 = 32 * 16;
    for (int t = v; t < NT1 + NT2; t += nb) {
        if (t < NT1) { GemmArgs g{xb, 1024, (const bf16_t*)(ws + W_IN), 1024, 1024, nullptr}; gemm_tile(g, (t >> 4) * 128, (t & 15) * 128, e1, smem); }
        else { const int u = t - NT1; GemmArgs g{xb + (size_t)T * D, 1024, (const bf16_t*)(ws + W_XKV), 1024, 1024, nullptr}; gemm_tile(g, (u >> 4) * 128, (u & 15) * 128, e2, smem); }
    }
}

struct EpiQup {
    bf16_t* q; const float *rc, *rs; const float* rms;
    int m0;
    DI void operator()(const f32x16 (&acc)[2][2], int rb, int cb, int lane) const {
        const int r = lane & 31, h = lane >> 5;
#pragma unroll
        for (int i = 0; i < 2; ++i)
#pragma unroll
            for (int j = 0; j < 2; ++j) {
                const int blk = (cb >> 5) + j, head = blk / 3, part = blk % 3;
#pragma unroll
                for (int e = 0; e < 16; ++e) {
                    const int row = rb + i * 32 + crow(e, h);
                    float v = acc[i][j][e] * rms[row - m0];
                    if (part == 2) {
                        const float pv = __shfl_xor(v, 16);
                        const int pos = row & 2047, f = r & 15;
                        const float c = rc[pos * 16 + f], s = rs[pos * 16 + f];
                        v = (r < 16) ? (v * c - pv * s) : (v * c + pv * s);
                    }
                    const int b = row >> 11, s_ = row & 2047;
                    q[((size_t)(b * 8 + head) * 2048 + s_) * 96 + part * 32 + r] = f2bf(v * QSCALE);
                }
            }
    }
};
struct EpiKVup {
    bf16_t *kn, *vt; const float* rms; int m0;
    DI void operator()(const f32x16 (&acc)[2][2], int rb, int cb, int lane) const {
        const int r = lane & 31, h = lane >> 5;
        const int head = cb >> 7, isv = (cb >> 6) & 1;
#pragma unroll
        for (int i = 0; i < 2; ++i)
#pragma unroll
            for (int j = 0; j < 2; ++j) {
                const int d = j * 32 + r;
#pragma unroll
                for (int e = 0; e < 16; ++e) {
                    const int row = rb + i * 32 + crow(e, h);
                    const float v = acc[i][j][e] * rms[row - m0];
                    const int b = row >> 11, s_ = row & 2047;
                    if (!isv) kn[((size_t)(b * 8 + head) * 2048 + s_) * 64 + d] = f2bf(v);
                    else vt[((size_t)(b * 8 + head) * 64 + d) * 2048 + s_] = f2bf(v);
                }
            }
    }
};
template <int K>
DI void row_rms(const bf16_t* src, int m0, float* rms) {
    const int t = threadIdx.x, row = t >> 1, half = t & 1;
    const uint4* s4 = (const uint4*)(src + (size_t)(m0 + row) * K + half * (K / 2));
    float ss = 0.f;
#pragma unroll
    for (int i = 0; i < K / 16; ++i) {
        const uint4 w = s4[i];
        const unsigned ww[4] = {w.x, w.y, w.z, w.w};
#pragma unroll
        for (int k = 0; k < 4; ++k) { const float a = bflo(ww[k]), b = bfhi(ww[k]); ss += a * a + b * b; }
    }
    ss += __shfl_xor(ss, 1);
    __syncthreads();
    if (half == 0) rms[row] = rsqrtf(ss * (1.f / K) + EPS);
    __syncthreads();
}
DI void phase_up(const P& p, int bid, int nb, unsigned char* smem) {
    unsigned char* ws = p.ws;
    const int v = vbid(bid, nb);
    float* rms = (float*)(smem + GEMM_LDS);
    constexpr int NTQ = 256 * 6, NTKV = 256 * 8;
    for (int t = v; t < NTQ + NTKV; t += nb) {
        if (t < NTQ) {
            const int mt = t / 6, ntl = t % 6;
            row_rms<256>((const bf16_t*)(ws + CQ), mt * 128, rms);
            EpiQup e{(bf16_t*)(ws + QB), (const float*)(ws + ROPE_C), (const float*)(ws + ROPE_S), rms, mt * 128};
            GemmArgs g{(const bf16_t*)(ws + CQ), 256, (const bf16_t*)(ws + W_QUP), 256, 256, nullptr};
            gemm_tile(g, mt * 128, ntl * 128, e, smem);
        } else {
            const int u = t - NTQ, mt = u >> 3, ntl = u & 7;
            row_rms<128>((const bf16_t*)(ws + CKV), mt * 128, rms);
            EpiKVup e{(bf16_t*)(ws + KNB), (bf16_t*)(ws + VTB), rms, mt * 128};
            GemmArgs g{(const bf16_t*)(ws + CKV), 128, (const bf16_t*)(ws + W_KVUP), 128, 128, nullptr};
            gemm_tile(g, mt * 128, ntl * 128, e, smem);
        }
    }
    {
        const bf16_t* xbc = (const bf16_t*)(ws + XBC); bf16_t* xa = (bf16_t*)(ws + XBCA);
        const float* cw = p.in[7]; const float* cb = p.in[8];
        const size_t gsz = (size_t)nb * 256;
        for (size_t i = (size_t)bid * 256 + threadIdx.x; i < (size_t)T * 128; i += gsz) {
            const int tkn = (int)(i >> 7), c0 = (int)(i & 127) * 8, s_ = tkn & 2047;
            float accv[8];
#pragma unroll
            for (int k = 0; k < 8; ++k) accv[k] = cb[c0 + k];
#pragma unroll
            for (int j = 0; j < 4; ++j) {
                if (s_ + j - 3 >= 0) {
                    const uint4 w = *(const uint4*)(xbc + (size_t)(tkn + j - 3) * 1024 + c0);
                    const unsigned ww[4] = {w.x, w.y, w.z, w.w};
#pragma unroll
                    for (int k = 0; k < 4; ++k) {
                        accv[2 * k] += cw[j * 1024 + c0 + 2 * k] * bflo(ww[k]);
                        accv[2 * k + 1] += cw[j * 1024 + c0 + 2 * k + 1] * bfhi(ww[k]);
                    }
                }
            }
            uint4 o;
            o.x = pack2(siluf(accv[0]), siluf(accv[1])); o.y = pack2(siluf(accv[2]), siluf(accv[3]));
            o.z = pack2(siluf(accv[4]), siluf(accv[5])); o.w = pack2(siluf(accv[6]), siluf(accv[7]));
            *(uint4*)(xa + (size_t)tkn * 1024 + c0) = o;
        }
    }
}

DI void attn_naive(const P& p, int bid, int nb) {
    unsigned char* ws = p.ws;
    const bf16_t* Q = (const bf16_t*)(ws + QB); const bf16_t* Kn = (const bf16_t*)(ws + KNB); const bf16_t* Vt = (const bf16_t*)(ws + VTB);
    const bf16_t* Kr = (const bf16_t*)(ws + KROPE); bf16_t* mix = (bf16_t*)(ws + MIX);
    for (int item = bid; item < 128 * 8; item += nb) {
        const int bh = item >> 3, s_ = (item & 7) * 256 + threadIdx.x, b = bh >> 3, hd = bh & 7;
        float q[96];
        {
            const uint4* q4 = (const uint4*)(Q + ((size_t)bh * 2048 + s_) * 96);
#pragma unroll
            for (int i = 0; i < 12; ++i) { const uint4 w = q4[i]; q[8 * i] = bflo(w.x); q[8 * i + 1] = bfhi(w.x); q[8 * i + 2] = bflo(w.y); q[8 * i + 3] = bfhi(w.y);
                q[8 * i + 4] = bflo(w.z); q[8 * i + 5] = bfhi(w.z); q[8 * i + 6] = bflo(w.w); q[8 * i + 7] = bfhi(w.w); }
        }
        float o[64];
#pragma unroll
        for (int d = 0; d < 64; ++d) o[d] = 0.f;
        float m = -1e30f, l = 0.f;
        const int nkeys = __builtin_amdgcn_readfirstlane(((s_ >> 6) + 1) * 64);
        for (int j0 = 0; j0 < nkeys; j0 += 8) {
            float sc[8];
#pragma unroll
            for (int jj = 0; jj < 8; ++jj) {
                const int j = j0 + jj;
                const uint4* k4 = (const uint4*)(Kn + ((size_t)bh * 2048 + j) * 64);
                const uint4* r4 = (const uint4*)(Kr + ((size_t)b * 2048 + j) * 32);
                float a = 0.f;
#pragma unroll
                for (int i = 0; i < 8; ++i) { const uint4 w = k4[i]; a += q[8 * i] * bflo(w.x) + q[8 * i + 1] * bfhi(w.x) + q[8 * i + 2] * bflo(w.y) + q[8 * i + 3] * bfhi(w.y)
                    + q[8 * i + 4] * bflo(w.z) + q[8 * i + 5] * bfhi(w.z) + q[8 * i + 6] * bflo(w.w) + q[8 * i + 7] * bfhi(w.w); }
#pragma unroll
                for (int i = 0; i < 4; ++i) { const uint4 w = r4[i]; const int o8 = 64 + 8 * i; a += q[o8] * bflo(w.x) + q[o8 + 1] * bfhi(w.x) + q[o8 + 2] * bflo(w.y) + q[o8 + 3] * bfhi(w.y)
                    + q[o8 + 4] * bflo(w.z) + q[o8 + 5] * bfhi(w.z) + q[o8 + 6] * bflo(w.w) + q[o8 + 7] * bfhi(w.w); }
                sc[jj] = a;
            }
            float mx = m;
#pragma unroll
            for (int jj = 0; jj < 8; ++jj) mx = fmaxf(mx, sc[jj]);
            const float al = exp2f(m - mx);
            float ps = 0.f;
#pragma unroll
            for (int jj = 0; jj < 8; ++jj) { sc[jj] = exp2f(sc[jj] - mx); ps += sc[jj]; }
            l = l * al + ps; m = mx;
#pragma unroll
            for (int d = 0; d < 64; ++d) {
                const uint4 w = *(const uint4*)(Vt + ((size_t)bh * 64 + d) * 2048 + j0);
                o[d] = o[d] * al + sc[0] * bflo(w.x) + sc[1] * bfhi(w.x) + sc[2] * bflo(w.y) + sc[3] * bfhi(w.y) + sc[4] * bflo(w.z) + sc[5] * bfhi(w.z) + sc[6] * bflo(w.w) + sc[7] * bfhi(w.w);
            }
        }
        const float il = 1.f / l;
        bf16_t* dst = mix + ((size_t)b * 2048 + s_) * 1024 + hd * 64;
#pragma unroll
        for (int d = 0; d < 64; d += 2) *(unsigned*)(dst + d) = pack2(o[d] * il, o[d + 1] * il);
    }
}
DI void ssd_naive(const P& p, int bid, int nb) {
    unsigned char* ws = p.ws;
    const bf16_t* xa = (const bf16_t*)(ws + XBCA); const float* dt = (const float*)(ws + DTB); const bf16_t* z = (const bf16_t*)(ws + ZB);
    bf16_t* mix = (bf16_t*)(ws + MIX);
    const int wave = threadIdx.x >> 6, pp = threadIdx.x & 63;
    for (int item = bid; item < 32; item += nb) {
        const int bh = item * 4 + wave, b = bh >> 3, hd = bh & 7, g = hd >> 2;
        const float a = -__expf(p.in[10][hd]), Dh = p.in[11][hd];
        float st[128];
#pragma unroll
        for (int n = 0; n < 128; ++n) st[n] = 0.f;
        for (int t = 0; t < 2048; ++t) {
            const size_t row = (size_t)b * 2048 + t;
            const float dtv = dt[row * 8 + hd];
            const float da = __expf(dtv * a);
            const float xv = bf2f(xa[row * 1024 + hd * 64 + pp]);
            const float xd = dtv * xv;
            const uint4* b4 = (const uint4*)(xa + row * 1024 + 512 + g * 128);
            const uint4* c4 = (const uint4*)(xa + row * 1024 + 768 + g * 128);
            float y = 0.f;
#pragma unroll
            for (int i = 0; i < 16; ++i) {
                const uint4 bw = b4[i], cw = c4[i];
                const unsigned bb[4] = {bw.x, bw.y, bw.z, bw.w}, cc[4] = {cw.x, cw.y, cw.z, cw.w};
#pragma unroll
                for (int k = 0; k < 4; ++k) {
                    const int n = 8 * i + 2 * k;
                    st[n] = da * st[n] + xd * bflo(bb[k]); y += bflo(cc[k]) * st[n];
                    st[n + 1] = da * st[n + 1] + xd * bfhi(bb[k]); y += bfhi(cc[k]) * st[n + 1];
                }
            }
            y += Dh * xv;
            const float zv = bf2f(z[row * 512 + hd * 64 + pp]);
            mix[row * 1024 + 512 + hd * 64 + pp] = f2bf(y * siluf(zv));
        }
    }
}
DI void phase_mixer(const P& p, int bid, int nb, unsigned char* smem) {
    ssd_naive(p, bid, nb);
    attn_naive(p, bid, nb);
}

DI void phase_ssdnorm(const P& p, int bid, int nb, unsigned char* smem) {
    bf16_t* mix = (bf16_t*)(p.ws + MIX);
    const int lane = threadIdx.x & 63, wave = threadIdx.x >> 6;
    for (int tk = bid * 4 + wave; tk < T; tk += nb * 4) {
        uint4* ptr = (uint4*)(mix + (size_t)tk * 1024 + 512 + lane * 8);
        const uint4 w = *ptr;
        const unsigned ww[4] = {w.x, w.y, w.z, w.w};
        float v[8]; float ss = 0.f;
#pragma unroll
        for (int k = 0; k < 4; ++k) { v[2 * k] = bflo(ww[k]); v[2 * k + 1] = bfhi(ww[k]); ss += v[2 * k] * v[2 * k] + v[2 * k + 1] * v[2 * k + 1]; }
#pragma unroll
        for (int o = 16; o >= 1; o >>= 1) ss += __shfl_xor(ss, o);
        const float rr = rsqrtf(ss * (1.f / 256.f) + EPS);
        uint4 o4; o4.x = pack2(v[0] * rr, v[1] * rr); o4.y = pack2(v[2] * rr, v[3] * rr); o4.z = pack2(v[4] * rr, v[5] * rr); o4.w = pack2(v[6] * rr, v[7] * rr);
        *ptr = o4;
    }
}

struct EpiResid {
    float* pre; const float* res;
    DI void operator()(const f32x16 (&acc)[2][2], int rb, int cb, int lane) const {
        const int r = lane & 31, h = lane >> 5;
#pragma unroll
        for (int i = 0; i < 2; ++i)
#pragma unroll
            for (int j = 0; j < 2; ++j) {
                const int col = cb + j * 32 + r;
#pragma unroll
                for (int e = 0; e < 16; ++e) {
                    const size_t idx = (size_t)(rb + i * 32 + crow(e, h)) * 1024 + col;
                    pre[idx] = ALPHA * res[idx] + acc[i][j][e];
                }
            }
    }
};
DI void phase_wout(const P& p, int bid, int nb, unsigned char* smem) {
    const int v = vbid(bid, nb);
    EpiResid e{p.out, p.in[0]};
    GemmArgs g{(const bf16_t*)(p.ws + MIX), 1024, (const bf16_t*)(p.ws + W_OUT), 1024, 1024, nullptr};
    for (int t = v; t < 256 * 8; t += nb) gemm_tile(g, (t >> 3) * 128, (t & 7) * 128, e, smem);
}
DI void ln_row(const float* src, const float* gam, const float* bet, int lane, float (&o)[16]) {
    float v[16];
#pragma unroll
    for (int i = 0; i < 4; ++i) { const float4 t4 = *(const float4*)(src + i * 256 + lane * 4); v[4 * i] = t4.x; v[4 * i + 1] = t4.y; v[4 * i + 2] = t4.z; v[4 * i + 3] = t4.w; }
    float s = 0.f;
#pragma unroll
    for (int i = 0; i < 16; ++i) s += v[i];
    const float mu = wave_sum(s) * (1.f / 1024.f);
    float q = 0.f;
#pragma unroll
    for (int i = 0; i < 16; ++i) { const float d = v[i] - mu; q += d * d; }
    const float rstd = rsqrtf(wave_sum(q) * (1.f / 1024.f) + EPS);
#pragma unroll
    for (int i = 0; i < 4; ++i) {
        const float4 g4 = *(const float4*)(gam + i * 256 + lane * 4), b4 = *(const float4*)(bet + i * 256 + lane * 4);
        o[4 * i] = (v[4 * i] - mu) * rstd * g4.x + b4.x; o[4 * i + 1] = (v[4 * i + 1] - mu) * rstd * g4.y + b4.y;
        o[4 * i + 2] = (v[4 * i + 2] - mu) * rstd * g4.z + b4.z; o[4 * i + 3] = (v[4 * i + 3] - mu) * rstd * g4.w + b4.w;
    }
}
DI void phase_ln1(const P& p, int bid, int nb, unsigned char* smem) {
    const int lane = threadIdx.x & 63, wave = threadIdx.x >> 6;
    float* hf = (float*)(p.ws + H1); bf16_t* hb = (bf16_t*)(p.ws + H1B);
    for (int tk = bid * 4 + wave; tk < T; tk += nb * 4) {
        float o[16];
        ln_row(p.out + (size_t)tk * 1024, p.in[14], p.in[15], lane, o);
#pragma unroll
        for (int i = 0; i < 4; ++i) {
            *(float4*)(hf + (size_t)tk * 1024 + i * 256 + lane * 4) = make_float4(o[4 * i], o[4 * i + 1], o[4 * i + 2], o[4 * i + 3]);
            uint2 w; w.x = pack2(o[4 * i], o[4 * i + 1]); w.y = pack2(o[4 * i + 2], o[4 * i + 3]);
            *(uint2*)(hb + (size_t)tk * 1024 + i * 256 + lane * 4) = w;
        }
    }
}
struct EpiXq {
    bf16_t* qx;
    DI void operator()(const f32x16 (&acc)[2][2], int rb, int cb, int lane) const {
        const int r = lane & 31, h = lane >> 5;
#pragma unroll
        for (int i = 0; i < 2; ++i)
#pragma unroll
            for (int j = 0; j < 2; ++j) {
                const int col = cb + j * 32 + r, hd = col >> 8, d = col & 255;
#pragma unroll
                for (int e = 0; e < 16; ++e) {
                    const int row = rb + i * 32 + crow(e, h), b = row >> 11, s_ = row & 2047;
                    qx[((size_t)(b * 4 + hd) * 2048 + s_) * 256 + d] = f2bf(acc[i][j][e] * XSCALE);
                }
            }
    }
};
DI void phase_xq(const P& p, int bid, int nb, unsigned char* smem) {
    const int v = vbid(bid, nb);
    EpiXq e{(bf16_t*)(p.ws + QX)};
    GemmArgs g{(const bf16_t*)(p.ws + H1B), 1024, (const bf16_t*)(p.ws + W_XQ), 1024, 1024, nullptr};
    for (int t = v; t < 256 * 8; t += nb) gemm_tile(g, (t >> 3) * 128, (t & 7) * 128, e, smem);
}
DI void phase_xattn(const P& p, int bid, int nb, unsigned char* smem) {
    unsigned char* ws = p.ws;
    const bf16_t* qx = (const bf16_t*)(ws + QX); const bf16_t* kx = (const bf16_t*)(ws + KX); const bf16_t* vxt = (const bf16_t*)(ws + VXT);
    bf16_t* ox = (bf16_t*)(ws + OX);
    const int lane = threadIdx.x & 63, hd = threadIdx.x >> 6;
    float* qs = (float*)smem + hd * 512; float* ps = qs + 256;
    for (int tk = bid; tk < T; tk += nb) {
        const int b = tk >> 11, s_ = tk & 2047;
        __syncthreads();
        {
            const uint2 w = *(const uint2*)(qx + ((size_t)(b * 4 + hd) * 2048 + s_) * 256 + lane * 4);
            qs[lane * 4] = bflo(w.x); qs[lane * 4 + 1] = bfhi(w.x); qs[lane * 4 + 2] = bflo(w.y); qs[lane * 4 + 3] = bfhi(w.y);
        }
        __syncthreads();
        float sc[4];
#pragma unroll
        for (int i = 0; i < 4; ++i) {
            const int m = lane + 64 * i;
            const uint4* k4 = (const uint4*)(kx + ((size_t)(b * 4 + hd) * 256 + m) * 256);
            float a = 0.f;
#pragma unroll 8
            for (int c = 0; c < 32; ++c) {
                const uint4 w = k4[c];
                const float4 q0 = *(const float4*)(qs + 8 * c), q1 = *(const float4*)(qs + 8 * c + 4);
                a += q0.x * bflo(w.x) + q0.y * bfhi(w.x) + q0.z * bflo(w.y) + q0.w * bfhi(w.y) + q1.x * bflo(w.z) + q1.y * bfhi(w.z) + q1.z * bflo(w.w) + q1.w * bfhi(w.w);
            }
            sc[i] = a;
        }
        const float mx = wave_max(fmaxf(fmaxf(sc[0], sc[1]), fmaxf(sc[2], sc[3])));
        float sum = 0.f;
#pragma unroll
        for (int i = 0; i < 4; ++i) { sc[i] = exp2f(sc[i] - mx); sum += sc[i]; }
        const float il = 1.f / wave_sum(sum);
#pragma unroll
        for (int i = 0; i < 4; ++i) ps[lane + 64 * i] = sc[i] * il;
        __syncthreads();
        float o[4];
#pragma unroll
        for (int dd = 0; dd < 4; ++dd) {
            const int d = lane * 4 + dd;
            const uint4* v4 = (const uint4*)(vxt + ((size_t)(b * 4 + hd) * 256 + d) * 256);
            float a = 0.f;
#pragma unroll 8
            for (int c = 0; c < 32; ++c) {
                const uint4 w = v4[c];
                const float4 q0 = *(const float4*)(ps + 8 * c), q1 = *(const float4*)(ps + 8 * c + 4);
                a += q0.x * bflo(w.x) + q0.y * bfhi(w.x) + q0.z * bflo(w.y) + q0.w * bfhi(w.y) + q1.x * bflo(w.z) + q1.y * bfhi(w.z) + q1.z * bflo(w.w) + q1.w * bfhi(w.w);
            }
            o[dd] = a;
        }
        uint2 w; w.x = pack2(o[0], o[1]); w.y = pack2(o[2], o[3]);
        *(uint2*)(ox + (size_t)tk * 1024 + hd * 256 + lane * 4) = w;
    }
}
DI void phase_xo(const P& p, int bid, int nb, unsigned char* smem) {
    const int v = vbid(bid, nb);
    EpiResid e{p.out, (const float*)(p.ws + H1)};
    GemmArgs g{(const bf16_t*)(p.ws + OX), 1024, (const bf16_t*)(p.ws + W_XO), 1024, 1024, nullptr};
    for (int t = v; t < 256 * 8; t += nb) gemm_tile(g, (t >> 3) * 128, (t & 7) * 128, e, smem);
}
DI void phase_ln2_router(const P& p, int bid, int nb, unsigned char* smem) {
    unsigned char* ws = p.ws;
    const int lane = threadIdx.x & 63, wave = threadIdx.x >> 6;
    float* hf = (float*)(ws + H2); bf16_t* hb = (bf16_t*)(ws + H2B);
    const float* wrt = (const float*)(ws + W_RT);
    unsigned* cnt = (unsigned*)(ws + CTL + CTL_CNT); int* lists = (int*)(ws + LISTS); float* tgate = (float*)(ws + TOK_GATE);
    for (int tk = bid * 4 + wave; tk < T; tk += nb * 4) {
        float o[16];
        ln_row(p.out + (size_t)tk * 1024, p.in[20], p.in[21], lane, o);
#pragma unroll
        for (int i = 0; i < 4; ++i) {
            *(float4*)(hf + (size_t)tk * 1024 + i * 256 + lane * 4) = make_float4(o[4 * i], o[4 * i + 1], o[4 * i + 2], o[4 * i + 3]);
            uint2 w; w.x = pack2(o[4 * i], o[4 * i + 1]); w.y = pack2(o[4 * i + 2], o[4 * i + 3]);
            *(uint2*)(hb + (size_t)tk * 1024 + i * 256 + lane * 4) = w;
        }
        float* lg = (float*)smem + wave * 64;
#pragma unroll 1
        for (int j = 0; j < 36; ++j) {
            float a = 0.f;
#pragma unroll
            for (int i = 0; i < 4; ++i) {
                const float4 w4 = *(const float4*)(wrt + j * 1024 + i * 256 + lane * 4);
                a += o[4 * i] * w4.x + o[4 * i + 1] * w4.y + o[4 * i + 2] * w4.z + o[4 * i + 3] * w4.w;
            }
            a = wave_sum(a);
            if (lane == 0) lg[j] = a;
        }
        __builtin_amdgcn_wave_barrier();
        float gl[4], el[32];
#pragma unroll
        for (int j = 0; j < 4; ++j) gl[j] = lg[j] + p.in[23][j];
#pragma unroll
        for (int j = 0; j < 32; ++j) el[j] = lg[4 + j] + p.in[25][j];
        __builtin_amdgcn_wave_barrier();
        int gi = 0; float gm = gl[0];
#pragma unroll
        for (int j = 1; j < 4; ++j) if (gl[j] > gm) { gm = gl[j]; gi = j; }
        float gs = 0.f;
#pragma unroll
        for (int j = 0; j < 4; ++j) gs += __expf(gl[j] - gm);
        const float ggate = 1.f / gs;
        float ev[8];
#pragma unroll
        for (int j = 0; j < 8; ++j) ev[j] = gi == 0 ? el[j] : gi == 1 ? el[8 + j] : gi == 2 ? el[16 + j] : el[24 + j];
        int i1 = 0; float v1 = ev[0];
#pragma unroll
        for (int j = 1; j < 8; ++j) if (ev[j] > v1) { v1 = ev[j]; i1 = j; }
        int i2 = -1; float v2 = -3.0e38f;
#pragma unroll
        for (int j = 0; j < 8; ++j) if (j != i1 && ev[j] > v2) { v2 = ev[j]; i2 = j; }
        const float e2 = __expf(v2 - v1);
        const float g1 = ggate / (1.f + e2), g2 = ggate * e2 / (1.f + e2);
        if (lane == 0) {
            const int ex1 = gi * 8 + i1, ex2 = gi * 8 + i2;
            const unsigned p1 = atomicAdd(&cnt[ex1], 1u); lists[(size_t)ex1 * T + p1] = tk * 2;
            const unsigned p2 = atomicAdd(&cnt[ex2], 1u); lists[(size_t)ex2 * T + p2] = tk * 2 + 1;
            tgate[tk * 2] = g1; tgate[tk * 2 + 1] = g2;
        }
    }
}
struct MoeMap { int off[33]; };
DI int moe_tiles(const unsigned* cnt, int* offs  ) {
    __syncthreads();
    if (threadIdx.x == 0) { int o = 0; for (int e = 0; e < 32; ++e) { offs[e] = o; o += (((int)cnt[e] + 127) >> 7) << 7; } offs[32] = o; }
    __syncthreads();
    return offs[32] >> 7;
}
struct EpiGU {
    bf16_t* hdn;
    DI void operator()(const f32x16 (&acc)[2][2], int rb, int cb, int lane) const {
        const int r = lane & 31, h = lane >> 5;
        const int hc = ((cb & 511) >> 7) * 64 + ((cb >> 6) & 1) * 32 + r;
#pragma unroll
        for (int i = 0; i < 2; ++i)
#pragma unroll
            for (int e = 0; e < 16; ++e) {
                const int slot = rb + i * 32 + crow(e, h);
                hdn[(size_t)slot * 256 + hc] = f2bf(siluf(acc[i][0][e]) * acc[i][1][e]);
            }
    }
};
struct EpiDown {
    bf16_t* y; const int* ltok; const float* lgate; int m0;
    DI void operator()(const f32x16 (&acc)[2][2], int rb, int cb, int lane) const {
        const int r = lane & 31, h = lane >> 5;
#pragma unroll
        for (int i = 0; i < 2; ++i)
#pragma unroll
            for (int e = 0; e < 16; ++e) {
                const int lr = rb - m0 + i * 32 + crow(e, h);
                const int tk2 = ltok[lr];
                if (tk2 >= 0) {
                    const float gt = lgate[lr];
#pragma unroll
                    for (int j = 0; j < 2; ++j) y[(size_t)tk2 * 1024 + cb + j * 32 + r] = f2bf(gt * acc[i][j][e]);
                }
            }
    }
};
template <int WHICH>
DI void phase_moe(const P& p, int bid, int nb, unsigned char* smem) {
    unsigned char* ws = p.ws;
    const unsigned* cnt = (const unsigned*)(ws + CTL + CTL_CNT); const int* lists = (const int*)(ws + LISTS); const float* tgate = (const float*)(ws + TOK_GATE);
    int* offs = (int*)(smem + GEMM_LDS); int* ltok = offs + 64; int* lrow = ltok + 128; float* lgate = (float*)(lrow + 128);
    const int nmt = moe_tiles(cnt, offs);
    constexpr int NNT = WHICH == 0 ? 4 : 8;
    const int v = vbid(bid, nb);
    for (int t = v; t < nmt * NNT; t += nb) {
        const int mt = t / NNT, ntl = t % NNT;
        const int slot0 = mt * 128;
        int e = 0;
        while (offs[e + 1] <= slot0) ++e;
        __syncthreads();
        if (threadIdx.x < 128) {
            const int pos = slot0 - offs[e] + threadIdx.x;
            const int tk2 = pos < (int)cnt[e] ? lists[(size_t)e * T + pos] : -1;
            ltok[threadIdx.x] = tk2; lrow[threadIdx.x] = tk2 < 0 ? 0 : (tk2 >> 1); lgate[threadIdx.x] = tk2 < 0 ? 0.f : tgate[tk2];
        }
        __syncthreads();
        if (WHICH == 0) {
            EpiGU ep{(bf16_t*)(ws + HDN)};
            GemmArgs g{(const bf16_t*)(ws + H2B), 1024, (const bf16_t*)(ws + W_GU) + (size_t)e * 512 * 1024, 1024, 1024, lrow};
            gemm_tile(g, slot0, ntl * 128, ep, smem);
        } else {
            EpiDown ep{(bf16_t*)(ws + YB), ltok, lgate, slot0};
            GemmArgs g{(const bf16_t*)(ws + HDN), 256, (const bf16_t*)(ws + W_DN) + (size_t)e * 1024 * 256, 256, 256, nullptr};
            gemm_tile(g, slot0, ntl * 128, ep, smem);
        }
    }
}
DI void phase_final(const P& p, int bid, int nb, unsigned char* smem) {
    const int lane = threadIdx.x & 63, wave = threadIdx.x >> 6;
    const float* hf = (const float*)(p.ws + H2); const bf16_t* y = (const bf16_t*)(p.ws + YB);
    const float* gam = p.in[29]; const float* bet = p.in[30];
    for (int tk = bid * 4 + wave; tk < T; tk += nb * 4) {
        float v[16];
#pragma unroll
        for (int i = 0; i < 4; ++i) {
            const float4 t4 = *(const float4*)(hf + (size_t)tk * 1024 + i * 256 + lane * 4);
            const uint2 a = *(const uint2*)(y + (size_t)(tk * 2) * 1024 + i * 256 + lane * 4), b = *(const uint2*)(y + (size_t)(tk * 2 + 1) * 1024 + i * 256 + lane * 4);
            v[4 * i] = ALPHA * t4.x + bflo(a.x) + bflo(b.x); v[4 * i + 1] = ALPHA * t4.y + bfhi(a.x) + bfhi(b.x);
            v[4 * i + 2] = ALPHA * t4.z + bflo(a.y) + bflo(b.y); v[4 * i + 3] = ALPHA * t4.w + bfhi(a.y) + bfhi(b.y);
        }
        float s = 0.f;
#pragma unroll
        for (int i = 0; i < 16; ++i) s += v[i];
        const float mu = wave_sum(s) * (1.f / 1024.f);
        float q = 0.f;
#pragma unroll
        for (int i = 0; i < 16; ++i) { const float d = v[i] - mu; q += d * d; }
        const float rstd = rsqrtf(wave_sum(q) * (1.f / 1024.f) + EPS);
#pragma unroll
        for (int i = 0; i < 4; ++i) {
            const float4 g4 = *(const float4*)(gam + i * 256 + lane * 4), b4 = *(const float4*)(bet + i * 256 + lane * 4);
            *(float4*)(p.out + (size_t)tk * 1024 + i * 256 + lane * 4) = make_float4((v[4 * i] - mu) * rstd * g4.x + b4.x, (v[4 * i + 1] - mu) * rstd * g4.y + b4.y,
                                                                                    (v[4 * i + 2] - mu) * rstd * g4.z + b4.z, (v[4 * i + 3] - mu) * rstd * g4.w + b4.w);
        }
    }
}

#define XB_TMO      128
#define XB_XCNT(j)  (256  + 64 * (j))
#define XB_XSUB(j)  (1280 + 64 * (j))
#define XB_XGEN(j)  (2304 + 64 * (j))
#define XB_TOP      3328
#define XB_TOPGEN   3392
#define XCD_BAR_WORDS 3456
#define XB_SPIN_CAP (1u << 25)
#define LAS __attribute__((address_space(3)))
DI unsigned xb_ld(unsigned* p) { return __hip_atomic_load(p, __ATOMIC_RELAXED, __HIP_MEMORY_SCOPE_AGENT); }
DI unsigned xb_add(unsigned* p, unsigned v) { return __hip_atomic_fetch_add(p, v, __ATOMIC_RELAXED, __HIP_MEMORY_SCOPE_AGENT); }
DI unsigned xb_xcc_id() { return (unsigned)__builtin_amdgcn_s_getreg((3 << 11) | 20) & 0xFu; }
#define XB_SPIN(cond, bar) do { unsigned _sp = 0; while (cond) { __builtin_amdgcn_s_sleep(1); \
    if ((++_sp & 255u) == 0u) { if (xb_ld(&(bar)[XB_TMO])) break; if (_sp > XB_SPIN_CAP) { atomicAdd(&(bar)[XB_TMO], 1u); break; } } } } while (0)
struct XcdBarrier { unsigned* bar; unsigned x; volatile LAS unsigned* st; };
DI XcdBarrier xcd_barrier_post(unsigned* bar, volatile LAS unsigned* st) {
    XcdBarrier b; b.bar = bar; b.x = xb_xcc_id(); b.st = st;
    if (threadIdx.x == 0) (void)xb_add(&bar[XB_XCNT(b.x)], 1u);
    return b;
}
DI void xcd_barrier_complete(unsigned* bar, unsigned x, unsigned& nloc, unsigned& nx) {
    const unsigned G = gridDim.x * gridDim.y * gridDim.z;
    unsigned sum, cnt, mine, sp = 0u;
    for (;;) {
        sum = 0u; cnt = 0u; mine = 0u;
#pragma unroll
        for (unsigned j = 0; j < 16; ++j) { const unsigned c = xb_ld(&bar[XB_XCNT(j)]); sum += c; cnt += (c > 0u) ? 1u : 0u; mine = (j == x) ? c : mine; }
        if (sum == G) break;
        __builtin_amdgcn_s_sleep(1);
        if ((++sp & 255u) == 0u) { if (xb_ld(&bar[XB_TMO])) break; if (sp > XB_SPIN_CAP) { atomicAdd(&bar[XB_TMO], 1u); break; } }
    }
    nloc = mine > 0u ? mine : 1u; nx = cnt > 0u ? cnt : 1u;
}
DI void xcd_barrier(const XcdBarrier& b) {
    asm volatile("s_waitcnt vmcnt(0)" ::: "memory");
    __syncthreads();
    if (threadIdx.x == 0) {
        unsigned* bar = b.bar;
        __builtin_amdgcn_s_waitcnt(0);
        unsigned nloc = b.st[0], nx = b.st[1];
        if (nloc == 0u) { xcd_barrier_complete(bar, b.x, nloc, nx); b.st[0] = nloc; b.st[1] = nx; }
        const unsigned old = xb_add(&bar[XB_XSUB(b.x)], 1u);
        const unsigned gen = old / nloc;
        if (old + 1u == (gen + 1u) * nloc) {
            __builtin_amdgcn_fence(__ATOMIC_RELEASE, "agent");
            asm volatile("s_waitcnt vmcnt(0)" ::: "memory");
            const unsigned og = xb_add(&bar[XB_TOP], 1u);
            const unsigned tg = og / nx;
            if (og + 1u == (tg + 1u) * nx) xb_add(&bar[XB_TOPGEN], 1u);
            else XB_SPIN(xb_ld(&bar[XB_TOPGEN]) == tg, bar);
            __builtin_amdgcn_fence(__ATOMIC_ACQUIRE, "agent");
            xb_add(&bar[XB_XGEN(b.x)], 1u);
            asm volatile("s_waitcnt vmcnt(0)" ::: "memory");
        } else {
            XB_SPIN(xb_ld(&bar[XB_XGEN(b.x)]) == gen, bar);
            __builtin_amdgcn_fence(__ATOMIC_ACQUIRE, "agent");
            asm volatile("s_waitcnt vmcnt(0)" ::: "memory");
        }
    }
    __syncthreads();
}

constexpr int NPHASE = 14;
template <int PH>
DI void run_phase(const P& p, int bid, int nb, unsigned char* smem) {
    if (PH == 0) phase_prep(p, bid, nb, smem);
    else if (PH == 1) phase_proj(p, bid, nb, smem);
    else if (PH == 2) phase_up(p, bid, nb, smem);
    else if (PH == 3) phase_mixer(p, bid, nb, smem);
    else if (PH == 4) phase_ssdnorm(p, bid, nb, smem);
    else if (PH == 5) phase_wout(p, bid, nb, smem);
    else if (PH == 6) phase_ln1(p, bid, nb, smem);
    else if (PH == 7) phase_xq(p, bid, nb, smem);
    else if (PH == 8) phase_xattn(p, bid, nb, smem);
    else if (PH == 9) phase_xo(p, bid, nb, smem);
    else if (PH == 10) phase_ln2_router(p, bid, nb, smem);
    else if (PH == 11) phase_moe<0>(p, bid, nb, smem);
    else if (PH == 12) phase_moe<1>(p, bid, nb, smem);
    else if (PH == 13) phase_final(p, bid, nb, smem);
}
template <int PH>
__global__ void __launch_bounds__(256, 2) k_phase(P p) {
    __shared__ __attribute__((aligned(16))) unsigned char smem[SMEM_BYTES];
    run_phase<PH>(p, blockIdx.x, gridDim.x, smem);
}

#if MEGA
#ifndef MEGA_WAVES
#define MEGA_WAVES 1
#endif
template <int PH>
DI void mega_steps(const P& p, const XcdBarrier& bar, unsigned char* smem) {
    run_phase<PH>(p, blockIdx.x, gridDim.x, smem);
    if constexpr (PH + 1 < NPHASE) { xcd_barrier(bar); mega_steps<PH + 1>(p, bar, smem); }
}
__global__ void __launch_bounds__(256, MEGA_WAVES) k_mega(P p) {
    __shared__ __attribute__((aligned(16))) unsigned char smem[SMEM_BYTES];
    volatile LAS unsigned* st = (volatile LAS unsigned*)(smem + SMEM_BYTES - 16);
    if (threadIdx.x < 4) st[threadIdx.x] = 0u;
    __syncthreads();
    const XcdBarrier bar = xcd_barrier_post((unsigned*)(p.ws + CTL), st);
    mega_steps<0>(p, bar, smem);
}
#endif
template <int PH>
__global__ void __launch_bounds__(256, 1) k_phase_big(P p) {
    __shared__ __attribute__((aligned(16))) unsigned char smem[SMEM_BYTES];
    run_phase<PH>(p, blockIdx.x, gridDim.x, smem);
}
template <int PH>
static void launch_phase(const P& p, int grid, hipStream_t st) {
    if constexpr (PH == 3) hipLaunchKernelGGL((k_phase_big<PH>), dim3(grid), dim3(256), 0, st, p);
    else hipLaunchKernelGGL((k_phase<PH>), dim3(grid), dim3(256), 0, st, p);
}

extern "C" void kernel_launch(void* const* d_in, const int* in_sizes, int n_in, void* d_out, int out_size, void* d_ws, size_t ws_size, hipStream_t stream) {
    if (n_in != 31 || out_size != T * D || ws_size < WS_NEED) {
        fprintf(stderr, "kernel_launch: unexpected shapes: n_in %d out %d ws %zu (need %zu)\n", n_in, out_size, ws_size, (size_t)WS_NEED);
        return;
    }
    P p{};
    for (int i = 0; i < 31; ++i) p.in[i] = (const float*)d_in[i];
    p.out = (float*)d_out; p.ws = (unsigned char*)d_ws;
    (void)hipMemsetAsync((unsigned char*)d_ws + CTL, 0, CTL_BYTES, stream);
#if MEGA
    static int grid = 0;
    if (grid == 0) {
        int dev = 0, cus = 0, per_cu = 0;
        (void)hipGetDevice(&dev);
        (void)hipDeviceGetAttribute(&cus, hipDeviceAttributeMultiprocessorCount, dev);
        if (hipOccupancyMaxActiveBlocksPerMultiprocessor(&per_cu, (const void*)k_mega, 256, 0) != hipSuccess || per_cu < 1) { fprintf(stderr, "kernel_launch: occupancy query failed\n"); per_cu = 1; }
        if (per_cu > 2) per_cu = 2;
        grid = cus * per_cu;
        fprintf(stderr, "kernel_launch: mega grid %d (%d CUs x %d)\n", grid, cus, per_cu);
    }
    void* args[] = {(void*)&p};
    const hipError_t le = hipLaunchCooperativeKernel((const void*)k_mega, dim3(grid), dim3(256), args, 0, stream);
    if (le != hipSuccess) fprintf(stderr, "kernel_launch: cooperative launch failed: %s (grid %d)\n", hipGetErrorString(le), grid);
#else
    const int grid = 1024;
    launch_phase<0>(p, grid, stream); launch_phase<1>(p, grid, stream); launch_phase<2>(p, grid, stream); launch_phase<3>(p, grid, stream);
    launch_phase<4>(p, grid, stream); launch_phase<5>(p, grid, stream); launch_phase<6>(p, grid, stream); launch_phase<7>(p, grid, stream);
    launch_phase<8>(p, grid, stream); launch_phase<9>(p, grid, stream); launch_phase<10>(p, grid, stream); launch_phase<11>(p, grid, stream);
    launch_phase<12>(p, grid, stream); launch_phase<13>(p, grid, stream);
#endif
}
```

```cpp
#include <hip/hip_runtime.h>
#include <stdint.h>
#include <stdio.h>

#ifndef MEGA
#define MEGA 1
#endif
#ifndef ATTN_NAIVE
#define ATTN_NAIVE 0
#endif
#ifndef XATTN_NAIVE
#define XATTN_NAIVE 0
#endif
#ifndef GEMM_DIRECT
#define GEMM_DIRECT 0
#endif

typedef unsigned short bf16_t;
typedef short bf16x8 __attribute__((ext_vector_type(8)));
typedef float f32x16 __attribute__((ext_vector_type(16)));
#define DI __device__ __forceinline__
#define MFMA32(a, b, c) __builtin_amdgcn_mfma_f32_32x32x16_bf16((a), (b), (c), 0, 0, 0)

constexpr int Bn = 16, S = 2048, T = Bn * S, D = 1024;
constexpr int NMEM = 256;
constexpr float EPS = 1e-5f;
constexpr float ALPHA = 1.189207115002721f;
constexpr float LOG2E = 1.4426950408889634f;
constexpr float QSCALE = 0.10206207261596577f * LOG2E;
constexpr float XSCALE = 0.0625f * LOG2E;
constexpr int NEXP = 32;
constexpr int MAXSLOTS = 69632;

constexpr size_t MiB = 1u << 20;
constexpr size_t W_IN = 0;
constexpr size_t W_QUP = W_IN + 4 * MiB;
constexpr size_t W_KVUP = W_QUP + 768 * 256 * 2;
constexpr size_t W_OUT = W_KVUP + 1024 * 128 * 2;
constexpr size_t W_XQ = W_OUT + 2 * MiB;
constexpr size_t W_XKV = W_XQ + 2 * MiB;
constexpr size_t W_XO = W_XKV + 4 * MiB;
constexpr size_t W_GU = W_XO + 2 * MiB;
constexpr size_t W_DN = W_GU + 32 * MiB;
constexpr size_t W_RT = W_DN + 16 * MiB;
constexpr size_t ROPE_C = W_RT + 48 * 1024 * 4;
constexpr size_t ROPE_S = ROPE_C + 2048 * 16 * 4;
constexpr size_t TOK_GATE = ROPE_S + 2048 * 16 * 4;
constexpr size_t CTL = TOK_GATE + (size_t)T * 2 * 4;
constexpr size_t CTL_BYTES = 32768;
constexpr size_t CTL_CNT = 16384;
static_assert(CTL + CTL_BYTES <= 64 * MiB, "weights region overflow");
constexpr size_t RA = 64 * MiB, RB = 192 * MiB, RC = 320 * MiB, RD = 448 * MiB, WS_NEED = 512 * MiB;
constexpr size_t XBC = RA;
constexpr size_t KX = RA + 64 * MiB;
constexpr size_t VXT = KX + 8 * MiB;
constexpr size_t YB = RA;
constexpr size_t QB = RB;
constexpr size_t KNB = RB + 48 * MiB;
constexpr size_t VTB = KNB + 32 * MiB;
constexpr size_t H1 = RB;
constexpr size_t H2 = RB;
constexpr size_t XBCA = RC;
constexpr size_t MIX = RC + 64 * MiB;
constexpr size_t H1B = RC;
constexpr size_t QX = RC + 64 * MiB;
constexpr size_t OX = RC;
constexpr size_t H2B = RC;
constexpr size_t HDN = RC + 64 * MiB;
constexpr size_t CQ = RD;
constexpr size_t CKV = CQ + 16 * MiB;
constexpr size_t KROPE = CKV + 8 * MiB;
constexpr size_t DTB = KROPE + 2 * MiB;
constexpr size_t ZB = DTB + 1 * MiB;
constexpr size_t LISTS = RD;
static_assert(ZB + 32 * MiB <= WS_NEED, "region D overflow");

struct P {
    const float* in[31];
    float* out;
    unsigned char* ws;
};

typedef __bf16 hbf16x2 __attribute__((ext_vector_type(2)));
typedef float f32x2 __attribute__((ext_vector_type(2)));
DI bf16_t f2bf(float x) { return __builtin_bit_cast(bf16_t, (__bf16)x); }
DI float bf2f(bf16_t b) { return __uint_as_float(((unsigned)b) << 16); }
DI float bflo(unsigned w) { return __uint_as_float(w << 16); }
DI float bfhi(unsigned w) { return __uint_as_float(w & 0xffff0000u); }
DI unsigned pack2(float a, float b) { f32x2 v = {a, b}; return __builtin_bit_cast(unsigned, __builtin_convertvector(v, hbf16x2)); }
DI float siluf(float x) { return x / (1.f + __expf(-x)); }
DI float softplusf(float x) { return x > 20.f ? x : log1pf(__expf(x)); }
DI int crow(int reg, int h) { return (reg & 3) + 8 * (reg >> 2) + 4 * h; }
DI float wave_sum(float v) {
#pragma unroll
    for (int o = 32; o >= 1; o >>= 1) v += __shfl_xor(v, o);
    return v;
}
DI float wave_max(float v) {
#pragma unroll
    for (int o = 32; o >= 1; o >>= 1) v = fmaxf(v, __shfl_xor(v, o));
    return v;
}

constexpr int LDS_ROW = 144;
constexpr int TILE_BYTES = 128 * LDS_ROW;
constexpr int GEMM_LDS = 4 * TILE_BYTES;
constexpr int SMEM_BYTES = GEMM_LDS + 2048;

struct GemmArgs {
    const bf16_t* A; int lda;
    const bf16_t* Bt; int ldb;
    int K;
    const int* lrows;
};

template <class Epi>
DI void gemm_tile(const GemmArgs& g, int m0, int n0, Epi& epi, unsigned char* smem) {
    const int tid = threadIdx.x, lane = tid & 63, wave = tid >> 6, wr = wave >> 1, wc = wave & 1;
    const int r = lane & 31, h = lane >> 5;
    f32x16 acc[2][2];
#pragma unroll
    for (int i = 0; i < 2; ++i)
#pragma unroll
        for (int j = 0; j < 2; ++j)
#pragma unroll
            for (int e = 0; e < 16; ++e) acc[i][j][e] = 0.f;
    const int nk = g.K >> 6;
#if GEMM_DIRECT
    {
        const bf16_t* ap[2]; const bf16_t* bp[2];
#pragma unroll
        for (int i = 0; i < 2; ++i) {
            const int lr = wr * 64 + i * 32 + r;
            const int grow = g.lrows ? g.lrows[lr] : (m0 + lr);
            ap[i] = g.A + (size_t)grow * g.lda + 8 * h;
            bp[i] = g.Bt + (size_t)(n0 + wc * 64 + i * 32 + r) * g.ldb + 8 * h;
        }
        for (int k = 0; k < g.K; k += 16) {
            bf16x8 a[2], b[2];
#pragma unroll
            for (int i = 0; i < 2; ++i) { a[i] = *(const bf16x8*)(ap[i] + k); b[i] = *(const bf16x8*)(bp[i] + k); }
#pragma unroll
            for (int i = 0; i < 2; ++i)
#pragma unroll
                for (int j = 0; j < 2; ++j) acc[i][j] = MFMA32(a[i], b[j], acc[i][j]);
        }
    }
#else
    {
        const int srow = tid >> 3, sch = tid & 7;
        const bf16_t* ag[4]; const bf16_t* bg[4];
#pragma unroll
        for (int i = 0; i < 4; ++i) {
            const int lr = srow + 32 * i;
            const int grow = g.lrows ? g.lrows[lr] : (m0 + lr);
            ag[i] = g.A + (size_t)grow * g.lda + sch * 8;
            bg[i] = g.Bt + (size_t)(n0 + lr) * g.ldb + sch * 8;
        }
        const int soff = srow * LDS_ROW + sch * 16;
        uint4 ra0, ra1, ra2, ra3, rb0, rb1, rb2, rb3;
#define G_LOAD(KO) do { ra0 = *(const uint4*)(ag[0] + (KO)); ra1 = *(const uint4*)(ag[1] + (KO)); ra2 = *(const uint4*)(ag[2] + (KO)); ra3 = *(const uint4*)(ag[3] + (KO)); \
                        rb0 = *(const uint4*)(bg[0] + (KO)); rb1 = *(const uint4*)(bg[1] + (KO)); rb2 = *(const uint4*)(bg[2] + (KO)); rb3 = *(const uint4*)(bg[3] + (KO)); } while (0)
#define L_STORE(BUF) do { unsigned char* _d = (BUF) + soff; \
        *(uint4*)(_d) = ra0; *(uint4*)(_d + 32 * LDS_ROW) = ra1; *(uint4*)(_d + 64 * LDS_ROW) = ra2; *(uint4*)(_d + 96 * LDS_ROW) = ra3; \
        *(uint4*)(_d + TILE_BYTES) = rb0; *(uint4*)(_d + TILE_BYTES + 32 * LDS_ROW) = rb1; *(uint4*)(_d + TILE_BYTES + 64 * LDS_ROW) = rb2; *(uint4*)(_d + TILE_BYTES + 96 * LDS_ROW) = rb3; } while (0)
        G_LOAD(0);
        __syncthreads();
        L_STORE(smem);
        __syncthreads();
        const int aoff = (wr * 64 + r) * LDS_ROW + h * 16;
        const int boff = TILE_BYTES + (wc * 64 + r) * LDS_ROW + h * 16;
        for (int kt = 0; kt < nk; ++kt) {
            const unsigned char* cur = smem + (kt & 1) * 2 * TILE_BYTES;
            unsigned char* nxt = smem + ((kt + 1) & 1) * 2 * TILE_BYTES;
            const bool more = (kt + 1 < nk);
            if (more) G_LOAD((kt + 1) * 64);
#pragma unroll
            for (int ks = 0; ks < 4; ++ks) {
                const bf16x8 a0 = *(const bf16x8*)(cur + aoff + ks * 32);
                const bf16x8 a1 = *(const bf16x8*)(cur + aoff + 32 * LDS_ROW + ks * 32);
                const bf16x8 b0 = *(const bf16x8*)(cur + boff + ks * 32);
                const bf16x8 b1 = *(const bf16x8*)(cur + boff + 32 * LDS_ROW + ks * 32);
                acc[0][0] = MFMA32(a0, b0, acc[0][0]); acc[0][1] = MFMA32(a0, b1, acc[0][1]);
                acc[1][0] = MFMA32(a1, b0, acc[1][0]); acc[1][1] = MFMA32(a1, b1, acc[1][1]);
            }
            if (more) L_STORE(nxt);
            __syncthreads();
        }
#undef G_LOAD
#undef L_STORE
    }
#endif
    epi(acc, m0 + wr * 64, n0 + wc * 64, lane);
}

DI int vbid(int bid, int nb) { return (nb % 8 == 0) ? (bid % 8) * (nb / 8) + bid / 8 : bid; }

DI int colmap_in(int n) {
    if (n < 384) return n;
    if (n < 896) return 416 + (n - 384);
    if (n < 1920) return 928 + (n - 896);
    if (n < 1952) return 384 + (n - 1920);
    if (n < 1960) return n;
    return -1;
}
template <int KIND>
DI void tconv_tile(const float* src, const float* src2, int ldsrc, bf16_t* dst, int K, int k0, int n0, const float* scale, int scale_from, unsigned char* smem) {
    float* tile = (float*)smem;
    const int t = threadIdx.x;
    __syncthreads();
#pragma unroll 4
    for (int i = 0; i < 16; ++i) {
        const int k = i * 4 + (t >> 6), n = t & 63;
        const int nd = n0 + n;
        float v = 0.f;
        if (KIND == 1) { const int c = colmap_in(nd); if (c >= 0) v = src[(size_t)(k0 + k) * ldsrc + c]; }
        else if (KIND == 2) {
            const int j = nd >> 7, wc = (nd >> 6) & 1, isup = (nd >> 5) & 1, ii = nd & 31;
            const int c = 64 * j + 32 * wc + ii;
            v = (isup ? src2 : src)[(size_t)(k0 + k) * ldsrc + c];
        } else v = src[(size_t)(k0 + k) * ldsrc + nd];
        if (scale && (k0 + k) >= scale_from) v *= scale[k0 + k - scale_from];
        tile[k * 65 + n] = v;
    }
    __syncthreads();
#pragma unroll 4
    for (int i = 0; i < 16; ++i) {
        const int n = i * 4 + (t >> 6), k = t & 63;
        dst[(size_t)(n0 + n) * K + k0 + k] = f2bf(tile[k * 65 + n]);
    }
}

DI void phase_prep(const P& p, int bid, int nb, unsigned char* smem) {
    unsigned char* ws = p.ws;
    const int tid = threadIdx.x;
    constexpr int J0 = 512, J1 = J0 + 48, J2 = J1 + 32, J3 = J2 + 256, J4 = J3 + 256, J5 = J4 + 256, J6 = J5 + 256, J7 = J6 + 256, J8 = J7 + 4096, J9 = J8 + 2048;
    for (int t = bid; t < J9; t += nb) {
        if (t < J0) { const int kt = t >> 5, ntl = t & 31; tconv_tile<1>(p.in[2], nullptr, 1960, (bf16_t*)(ws + W_IN), 1024, kt * 64, ntl * 64, nullptr, 0, smem); }
        else if (t < J1) { const int u = t - J0, kt = u / 12, ntl = u % 12; tconv_tile<0>(p.in[4], nullptr, 768, (bf16_t*)(ws + W_QUP), 256, kt * 64, ntl * 64, p.in[3], 0, smem); }
        else if (t < J2) { const int u = t - J1, kt = u >> 4, ntl = u & 15; tconv_tile<0>(p.in[6], nullptr, 1024, (bf16_t*)(ws + W_KVUP), 128, kt * 64, ntl * 64, p.in[5], 0, smem); }
        else if (t < J3) { const int u = t - J2, kt = u >> 4, ntl = u & 15; tconv_tile<0>(p.in[13], nullptr, 1024, (bf16_t*)(ws + W_OUT), 1024, kt * 64, ntl * 64, p.in[12], 512, smem); }
        else if (t < J4) { const int u = t - J3, kt = u >> 4, ntl = u & 15; tconv_tile<0>(p.in[16], nullptr, 1024, (bf16_t*)(ws + W_XQ), 1024, kt * 64, ntl * 64, nullptr, 0, smem); }
        else if (t < J5) { const int u = t - J4, kt = u >> 4, ntl = u & 15; tconv_tile<0>(p.in[17], nullptr, 1024, (bf16_t*)(ws + W_XKV), 1024, kt * 64, ntl * 64, nullptr, 0, smem); }
        else if (t < J6) { const int u = t - J5, kt = u >> 4, ntl = u & 15; tconv_tile<0>(p.in[18], nullptr, 1024, (bf16_t*)(ws + W_XKV) + (size_t)1024 * 1024, 1024, kt * 64, ntl * 64, nullptr, 0, smem); }
        else if (t < J7) { const int u = t - J6, kt = u >> 4, ntl = u & 15; tconv_tile<0>(p.in[19], nullptr, 1024, (bf16_t*)(ws + W_XO), 1024, kt * 64, ntl * 64, nullptr, 0, smem); }
        else if (t < J8) { const int u = t - J7, e = u >> 7, v = u & 127, kt = v >> 3, ntl = v & 7;
            tconv_tile<2>(p.in[26] + (size_t)e * 1024 * 256, p.in[27] + (size_t)e * 1024 * 256, 256, (bf16_t*)(ws + W_GU) + (size_t)e * 512 * 1024, 1024, kt * 64, ntl * 64, nullptr, 0, smem); }
        else { const int u = t - J8, e = u >> 6, v = u & 63, kt = v >> 4, ntl = v & 15;
            tconv_tile<0>(p.in[28] + (size_t)e * 256 * 1024, nullptr, 1024, (bf16_t*)(ws + W_DN) + (size_t)e * 1024 * 256, 256, kt * 64, ntl * 64, nullptr, 0, smem); }
    }
    {
        const size_t gsz = (size_t)nb * 256, g0 = (size_t)bid * 256 + tid;
        bf16_t* xb = (bf16_t*)p.out;
        const float4* x4 = (const float4*)p.in[0];
        for (size_t i = g0; i < (size_t)T * D / 4; i += gsz) { const float4 v = x4[i]; uint2 o; o.x = pack2(v.x, v.y); o.y = pack2(v.z, v.w); ((uint2*)xb)[i] = o; }
        bf16_t* mb = xb + (size_t)T * D;
        const float4* m4 = (const float4*)p.in[1];
        for (size_t i = g0; i < (size_t)Bn * NMEM * D / 4; i += gsz) { const float4 v = m4[i]; uint2 o; o.x = pack2(v.x, v.y); o.y = pack2(v.z, v.w); ((uint2*)mb)[i] = o; }
        float* wrt = (float*)(ws + W_RT);
        for (size_t i = g0; i < 48 * 1024; i += gsz) {
            const int j = (int)(i >> 10), k = (int)(i & 1023);
            float v = 0.f;
            if (j < 4) v = p.in[22][k * 4 + j]; else if (j < 36) v = p.in[24][k * 32 + (j - 4)];
            wrt[i] = v;
        }
        float* rc = (float*)(ws + ROPE_C); float* rs = (float*)(ws + ROPE_S);
        for (size_t i = g0; i < 2048 * 16; i += gsz) {
            const int pos = (int)(i >> 4), f = (int)(i & 15);
            const float inv = powf(10000.f, -(float)f / 16.f);
            const float ang = (float)pos * inv;
            const double a = (double)ang;
            const double k2 = rint(a * 0.15915494309189535);
            const float rr = (float)(a - k2 * 6.283185307179586);
            rc[i] = cosf(rr); rs[i] = sinf(rr);
        }
    }
}

struct EpiProj {
    bf16_t *cq, *ckv, *z, *xbc, *krope; float* dt; const float *rc, *rs, *dtb;
    DI void operator()(const f32x16 (&acc)[2][2], int rb, int cb, int lane) const {
        const int r = lane & 31, h = lane >> 5;
#pragma unroll
        for (int i = 0; i < 2; ++i)
#pragma unroll
            for (int j = 0; j < 2; ++j) {
                const int col = cb + j * 32 + r;
                const int colb = cb + j * 32;
#pragma unroll
                for (int e = 0; e < 16; ++e) {
                    const int row = rb + i * 32 + crow(e, h);
                    const float v = acc[i][j][e];
                    if (colb < 256) cq[(size_t)row * 256 + col] = f2bf(v);
                    else if (colb < 384) ckv[(size_t)row * 128 + col - 256] = f2bf(v);
                    else if (colb < 896) z[(size_t)row * 512 + col - 384] = f2bf(v);
                    else if (colb < 1920) xbc[(size_t)row * 1024 + col - 896] = f2bf(v);
                    else if (colb == 1920) {
                        const float pv = __shfl_xor(v, 16);
                        const int pos = row & 2047, f = r & 15;
                        const float c = rc[pos * 16 + f], s = rs[pos * 16 + f];
                        const float o = (r < 16) ? (v * c - pv * s) : (v * c + pv * s);
                        krope[(size_t)row * 32 + r] = f2bf(o);
                    } else if (colb == 1952) {
                        if (r < 8) dt[(size_t)row * 8 + r] = softplusf(v + dtb[r]);
                    }
                }
            }
    }
};
struct EpiMemKV {
    bf16_t *kx, *vxt;
    DI void operator()(const f32x16 (&acc)[2][2], int rb, int cb, int lane) const {
        const int r = lane & 31, h = lane >> 5;
#pragma unroll
        for (int i = 0; i < 2; ++i)
#pragma unroll
            for (int j = 0; j < 2; ++j) {
                const int col = cb + j * 32 + r;
#pragma unroll
                for (int e = 0; e < 16; ++e) {
                    const int row = rb + i * 32 + crow(e, h);
                    const int b = row >> 8, m = row & 255;
                    const float v = acc[i][j][e];
                    if (col < 1024) { const int hd = col >> 8, d = col & 255; kx[((size_t)(b * 4 + hd) * 256 + m) * 256 + d] = f2bf(v); }
                    else { const int c2 = col - 1024, hd = c2 >> 8, d = c2 & 255; vxt[((size_t)(b * 4 + hd) * 256 + d) * 256 + m] = f2bf(v); }
                }
            }
    }
};
DI void phase_proj(const P& p, int bid, int nb, unsigned char* smem) {
    unsigned char* ws = p.ws;
    const int v = vbid(bid, nb);
    const bf16_t* xb = (const bf16_t*)p.out;
    EpiProj e1{(bf16_t*)(ws + CQ), (bf16_t*)(ws + CKV), (bf16_t*)(ws + ZB), (bf16_t*)(ws + XBC), (bf16_t*)(ws + KROPE), (float*)(ws + DTB),
               (const float*)(ws + ROPE_C), (const float*)(ws + ROPE_S), p.in[9]};
    EpiMemKV e2{(bf16_t*)(ws + KX), (bf16_t*)(ws + VXT)};
    constexpr int NT1 = 256 * 16, NT2 = 32 * 16;
    for (int t = v; t < NT1 + NT2; t += nb) {
        if (t < NT1) { GemmArgs g{xb, 1024, (const bf16_t*)(ws + W_IN), 1024, 1024, nullptr}; gemm_tile(g, (t >> 4) * 128, (t & 15) * 128, e1, smem); }
        else { const int u = t - NT1; GemmArgs g{xb + (size_t)T * D, 1024, (const bf16_t*)(ws + W_XKV), 1024, 1024, nullptr}; gemm_tile(g, (u >> 4) * 128, (u & 15) * 128, e2, smem); }
    }
}

struct EpiQup {
    bf16_t* q; const float *rc, *rs; const float* rms;
    int m0;
    DI void operator()(const f32x16 (&acc)[2][2], int rb, int cb, int lane) const {
        const int r = lane & 31, h = lane >> 5;
#pragma unroll
        for (int i = 0; i < 2; ++i)
#pragma unroll
            for (int j = 0; j < 2; ++j) {
                const int blk = (cb >> 5) + j, head = blk / 3, part = blk % 3;
#pragma unroll
                for (int e = 0; e < 16; ++e) {
                    const int row = rb + i * 32 + crow(e, h);
                    float v = acc[i][j][e] * rms[row - m0];
                    if (part == 2) {
                        const float pv = __shfl_xor(v, 16);
                        const int pos = row & 2047, f = r & 15;
                        const float c = rc[pos * 16 + f], s = rs[pos * 16 + f];
                        v = (r < 16) ? (v * c - pv * s) : (v * c + pv * s);
                    }
                    const int b = row >> 11, s_ = row & 2047;
                    q[((size_t)(b * 8 + head) * 2048 + s_) * 96 + part * 32 + r] = f2bf(v * QSCALE);
                }
            }
    }
};
struct EpiKVup {
    bf16_t *kn, *vt; const float* rms; int m0;
    DI void operator()(const f32x16 (&acc)[2][2], int rb, int cb, int lane) const {
        const int r = lane & 31, h = lane >> 5;
        const int head = cb >> 7, isv = (cb >> 6) & 1;
#pragma unroll
        for (int i = 0; i < 2; ++i)
#pragma unroll
            for (int j = 0; j < 2; ++j) {
                const int d = j * 32 + r;
#pragma unroll
                for (int e = 0; e < 16; ++e) {
                    const int row = rb + i * 32 + crow(e, h);
                    const float v = acc[i][j][e] * rms[row - m0];
                    const int b = row >> 11, s_ = row & 2047;
                    if (!isv) kn[((size_t)(b * 8 + head) * 2048 + s_) * 64 + d] = f2bf(v);
                    else vt[((size_t)(b * 8 + head) * 64 + d) * 2048 + s_] = f2bf(v);
                }
            }
    }
};
template <int K>
DI void row_rms(const bf16_t* src, int m0, float* rms) {
    const int t = threadIdx.x, row = t >> 1, half = t & 1;
    const uint4* s4 = (const uint4*)(src + (size_t)(m0 + row) * K + half * (K / 2));
    float ss = 0.f;
#pragma unroll
    for (int i = 0; i < K / 16; ++i) {
        const uint4 w = s4[i];
        const unsigned ww[4] = {w.x, w.y, w.z, w.w};
#pragma unroll
        for (int k = 0; k < 4; ++k) { const float a = bflo(ww[k]), b = bfhi(ww[k]); ss += a * a + b * b; }
    }
    ss += __shfl_xor(ss, 1);
    __syncthreads();
    if (half == 0) rms[row] = rsqrtf(ss * (1.f / K) + EPS);
    __syncthreads();
}
DI void phase_up(const P& p, int bid, int nb, unsigned char* smem) {
    unsigned char* ws = p.ws;
    const int v = vbid(bid, nb);
    float* rms = (float*)(smem + GEMM_LDS);
    constexpr int NTQ = 256 * 6, NTKV = 256 * 8;
    for (int t = v; t < NTQ + NTKV; t += nb) {
        if (t < NTQ) {
            const int mt = t / 6, ntl = t % 6;
            row_rms<256>((const bf16_t*)(ws + CQ), mt * 128, rms);
            EpiQup e{(bf16_t*)(ws + QB), (const float*)(ws + ROPE_C), (const float*)(ws + ROPE_S), rms, mt * 128};
            GemmArgs g{(const bf16_t*)(ws + CQ), 256, (const bf16_t*)(ws + W_QUP), 256, 256, nullptr};
            gemm_tile(g, mt * 128, ntl * 128, e, smem);
        } else {
            const int u = t - NTQ, mt = u >> 3, ntl = u & 7;
            row_rms<128>((const bf16_t*)(ws + CKV), mt * 128, rms);
            EpiKVup e{(bf16_t*)(ws + KNB), (bf16_t*)(ws + VTB), rms, mt * 128};
            GemmArgs g{(const bf16_t*)(ws + CKV), 128, (const bf16_t*)(ws + W_KVUP), 128, 128, nullptr};
            gemm_tile(g, mt * 128, ntl * 128, e, smem);
        }
    }
    {
        const bf16_t* xbc = (const bf16_t*)(ws + XBC); bf16_t* xa = (bf16_t*)(ws + XBCA);
        const float* cw = p.in[7]; const float* cb = p.in[8];
        const size_t gsz = (size_t)nb * 256;
        for (size_t i = (size_t)bid * 256 + threadIdx.x; i < (size_t)T * 128; i += gsz) {
            const int tkn = (int)(i >> 7), c0 = (int)(i & 127) * 8, s_ = tkn & 2047;
            float accv[8];
#pragma unroll
            for (int k = 0; k < 8; ++k) accv[k] = cb[c0 + k];
#pragma unroll
            for (int j = 0; j < 4; ++j) {
                if (s_ + j - 3 >= 0) {
                    const uint4 w = *(const uint4*)(xbc + (size_t)(tkn + j - 3) * 1024 + c0);
                    const unsigned ww[4] = {w.x, w.y, w.z, w.w};
#pragma unroll
                    for (int k = 0; k < 4; ++k) {
                        accv[2 * k] += cw[j * 1024 + c0 + 2 * k] * bflo(ww[k]);
                        accv[2 * k + 1] += cw[j * 1024 + c0 + 2 * k + 1] * bfhi(ww[k]);
                    }
                }
            }
            uint4 o;
            o.x = pack2(siluf(accv[0]), siluf(accv[1])); o.y = pack2(siluf(accv[2]), siluf(accv[3]));
            o.z = pack2(siluf(accv[4]), siluf(accv[5])); o.w = pack2(siluf(accv[6]), siluf(accv[7]));
            *(uint4*)(xa + (size_t)tkn * 1024 + c0) = o;
        }
    }
}

DI int perm16(int k) { return (k & ~12) | ((k & 4) << 1) | ((k & 8) >> 1); }
template <int DQK, int DVW, int KT, int NQG, int NDV>
struct FlashCfg {
    static constexpr int KSTR = (DQK + 8) * 2;
    static constexpr int VSTR = (KT + 8) * 2;
    static constexpr int DV = DVW * NDV;
    static constexpr int KBYTES = KT * KSTR, VBYTES = DV * VSTR, STAGE = KBYTES + VBYTES;
    static constexpr int KCH = KT * DQK / 8 / 256;
    static constexpr int VCH = DV * KT / 8 / 256;
    static_assert(KT * DQK / 8 % 256 == 0 && DV * KT / 8 % 256 == 0, "chunk split");
    static_assert(2 * STAGE <= GEMM_LDS + 2048 - 16, "flash LDS");
};
template <int DQK, int DVW, int KT, int NQG, int NDV, class Src>
DI void flash_item(const Src& src, int ntiles, int nskip  , unsigned char* smem) {
    typedef FlashCfg<DQK, DVW, KT, NQG, NDV> C;
    constexpr int NKS = DQK / 16, NKB = KT / 32, NDB = DVW / 32;
    const int tid = threadIdx.x, lane = tid & 63, wave = tid >> 6, r = lane & 31, h = lane >> 5;
    const int qg = wave / NDV, dvh = wave % NDV;
    bf16x8 qf[NKS];
    {
        const bf16_t* qp = src.qrow(qg * 32 + r) + 8 * h;
#pragma unroll
        for (int ks = 0; ks < NKS; ++ks) qf[ks] = *(const bf16x8*)(qp + 16 * ks);
    }
    f32x16 o[NDB];
#pragma unroll
    for (int d = 0; d < NDB; ++d)
#pragma unroll
        for (int e = 0; e < 16; ++e) o[d][e] = 0.f;
    float m = -1e30f, l = 0.f;
    uint4 kr[C::KCH], vr[C::VCH];
    auto gload = [&](int t) {
#pragma unroll
        for (int i = 0; i < C::KCH; ++i) { const int idx = tid + 256 * i; kr[i] = src.kload(t, idx / (DQK / 8), idx % (DQK / 8)); }
#pragma unroll
        for (int i = 0; i < C::VCH; ++i) { const int idx = tid + 256 * i; vr[i] = src.vload(t, idx / (KT / 8), idx % (KT / 8)); }
    };
    auto lstore = [&](unsigned char* buf) {
#pragma unroll
        for (int i = 0; i < C::KCH; ++i) { const int idx = tid + 256 * i; *(uint4*)(buf + (idx / (DQK / 8)) * C::KSTR + (idx % (DQK / 8)) * 16) = kr[i]; }
#pragma unroll
        for (int i = 0; i < C::VCH; ++i) {
            const int idx = tid + 256 * i, dv = idx / (KT / 8), c = idx % (KT / 8);
            unsigned char* row = buf + C::KBYTES + dv * C::VSTR + (c >> 1) * 32;
            const int a = c & 1;
            *(uint2*)(row + (4 * a) * 2) = make_uint2(vr[i].x, vr[i].y);
            *(uint2*)(row + (8 + 4 * a) * 2) = make_uint2(vr[i].z, vr[i].w);
        }
    };
    gload(0);
    __syncthreads();
    lstore(smem);
    __syncthreads();
    for (int t = 0; t < ntiles; ++t) {
        const unsigned char* cur = smem + (t & 1) * C::STAGE;
        const bool more = (t + 1 < ntiles);
        if (more) gload(t + 1);
        if (!(t == ntiles - 1 && qg < nskip)) {
            f32x16 s[NKB];
#pragma unroll
            for (int kb = 0; kb < NKB; ++kb) {
#pragma unroll
                for (int e = 0; e < 16; ++e) s[kb][e] = 0.f;
                const unsigned char* kp = cur + (kb * 32 + r) * C::KSTR + h * 16;
#pragma unroll
                for (int ks = 0; ks < NKS; ++ks) s[kb] = MFMA32(*(const bf16x8*)(kp + ks * 32), qf[ks], s[kb]);
            }
            float mx = s[0][0];
#pragma unroll
            for (int kb = 0; kb < NKB; ++kb)
#pragma unroll
                for (int e = 0; e < 16; ++e) mx = fmaxf(mx, s[kb][e]);
            mx = fmaxf(mx, __shfl_xor(mx, 32));
            const float mn = fmaxf(m, mx);
            const float alpha = exp2f(m - mn);
            m = mn;
            float ps = 0.f;
#pragma unroll
            for (int kb = 0; kb < NKB; ++kb)
#pragma unroll
                for (int e = 0; e < 16; ++e) { const float pv = exp2f(s[kb][e] - mn); s[kb][e] = pv; ps += pv; }
            l = l * alpha + ps;
#pragma unroll
            for (int d = 0; d < NDB; ++d)
#pragma unroll
                for (int e = 0; e < 16; ++e) o[d][e] *= alpha;
#pragma unroll
            for (int kb = 0; kb < NKB; ++kb)
#pragma unroll
                for (int s2 = 0; s2 < 2; ++s2) {
                    uint4 pk;
                    pk.x = pack2(s[kb][8 * s2], s[kb][8 * s2 + 1]); pk.y = pack2(s[kb][8 * s2 + 2], s[kb][8 * s2 + 3]);
                    pk.z = pack2(s[kb][8 * s2 + 4], s[kb][8 * s2 + 5]); pk.w = pack2(s[kb][8 * s2 + 6], s[kb][8 * s2 + 7]);
                    const bf16x8 pf = __builtin_bit_cast(bf16x8, pk);
                    const unsigned char* vp = cur + C::KBYTES + (dvh * DVW + r) * C::VSTR + (kb * 32 + s2 * 16 + 8 * h) * 2;
#pragma unroll
                    for (int d = 0; d < NDB; ++d) o[d] = MFMA32(*(const bf16x8*)(vp + d * 32 * C::VSTR), pf, o[d]);
                }
        }
        if (more) lstore(smem + ((t + 1) & 1) * C::STAGE);
        __syncthreads();
    }
    l += __shfl_xor(l, 32);
    const float il = 1.f / l;
#pragma unroll
    for (int d = 0; d < NDB; ++d)
#pragma unroll
        for (int g4 = 0; g4 < 4; ++g4) {
            uint2 w; w.x = pack2(o[d][4 * g4] * il, o[d][4 * g4 + 1] * il); w.y = pack2(o[d][4 * g4 + 2] * il, o[d][4 * g4 + 3] * il);
            src.store(qg * 32 + r, dvh * DVW + d * 32 + 8 * g4 + 4 * h, w);
        }
}
struct SelfSrc {
    const bf16_t *q, *kn, *kr, *vt; bf16_t* mix; int b, hd, bh, q0;
    DI const bf16_t* qrow(int rr) const { return q + ((size_t)bh * 2048 + q0 + rr) * 96; }
    DI uint4 kload(int t, int key, int c) const {
        const int kg = t * 64 + key;
        return c < 8 ? *(const uint4*)(kn + ((size_t)bh * 2048 + kg) * 64 + c * 8) : *(const uint4*)(kr + ((size_t)b * 2048 + kg) * 32 + (c - 8) * 8);
    }
    DI uint4 vload(int t, int dv, int c) const { return *(const uint4*)(vt + ((size_t)bh * 64 + dv) * 2048 + t * 64 + c * 8); }
    DI void store(int rr, int dv, uint2 w) const { *(uint2*)(mix + ((size_t)b * 2048 + q0 + rr) * 1024 + hd * 64 + dv) = w; }
};
struct CrossSrc {
    const bf16_t *qx, *kx, *vxt; bf16_t* ox; int b, hd, q0;
    DI const bf16_t* qrow(int rr) const { return qx + ((size_t)(b * 4 + hd) * 2048 + q0 + rr) * 256; }
    DI uint4 kload(int t, int key, int c) const { return *(const uint4*)(kx + ((size_t)(b * 4 + hd) * 256 + t * 32 + key) * 256 + c * 8); }
    DI uint4 vload(int t, int dv, int c) const { return *(const uint4*)(vxt + ((size_t)(b * 4 + hd) * 256 + dv) * 256 + t * 32 + c * 8); }
    DI void store(int rr, int dv, uint2 w) const { *(uint2*)(ox + ((size_t)b * 2048 + q0 + rr) * 1024 + hd * 256 + dv) = w; }
};
DI void attn_fast(const P& p, int bid, int nb, unsigned char* smem) {
    unsigned char* ws = p.ws;
    const int nround = (2048 + nb - 1) / nb;
    for (int rd = 0; rd < nround; ++rd) {
        const int idx = rd * nb + ((rd & 1) ? (nb - 1 - bid) : bid);
        if (idx >= 2048) continue;
        const int qb = 15 - (idx >> 7), bh = idx & 127;
        SelfSrc s{(const bf16_t*)(ws + QB), (const bf16_t*)(ws + KNB), (const bf16_t*)(ws + KROPE), (const bf16_t*)(ws + VTB), (bf16_t*)(ws + MIX), bh >> 3, bh & 7, bh, qb * 128};
        flash_item<96, 64, 64, 4, 1>(s, 2 * qb + 2, 2, smem);
    }
}
DI void xattn_fast(const P& p, int bid, int nb, unsigned char* smem) {
    unsigned char* ws = p.ws;
    for (int it = bid; it < 2048; it += nb) {
        const int bhd = it >> 5, qt = it & 31;
        CrossSrc s{(const bf16_t*)(ws + QX), (const bf16_t*)(ws + KX), (const bf16_t*)(ws + VXT), (bf16_t*)(ws + OX), bhd >> 2, bhd & 3, qt * 64};
        flash_item<256, 128, 32, 2, 2>(s, 8, 0, smem);
    }
}

DI void attn_naive(const P& p, int bid, int nb) {
    unsigned char* ws = p.ws;
    const bf16_t* Q = (const bf16_t*)(ws + QB); const bf16_t* Kn = (const bf16_t*)(ws + KNB); const bf16_t* Vt = (const bf16_t*)(ws + VTB);
    const bf16_t* Kr = (const bf16_t*)(ws + KROPE); bf16_t* mix = (bf16_t*)(ws + MIX);
    for (int item = bid; item < 128 * 8; item += nb) {
        const int bh = item >> 3, s_ = (item & 7) * 256 + threadIdx.x, b = bh >> 3, hd = bh & 7;
        float q[96];
        {
            const uint4* q4 = (const uint4*)(Q + ((size_t)bh * 2048 + s_) * 96);
#pragma unroll
            for (int i = 0; i < 12; ++i) { const uint4 w = q4[i]; q[8 * i] = bflo(w.x); q[8 * i + 1] = bfhi(w.x); q[8 * i + 2] = bflo(w.y); q[8 * i + 3] = bfhi(w.y);
                q[8 * i + 4] = bflo(w.z); q[8 * i + 5] = bfhi(w.z); q[8 * i + 6] = bflo(w.w); q[8 * i + 7] = bfhi(w.w); }
        }
        float o[64];
#pragma unroll
        for (int d = 0; d < 64; ++d) o[d] = 0.f;
        float m = -1e30f, l = 0.f;
        const int nkeys = __builtin_amdgcn_readfirstlane(((s_ >> 6) + 1) * 64);
        for (int j0 = 0; j0 < nkeys; j0 += 8) {
            float sc[8];
#pragma unroll
            for (int jj = 0; jj < 8; ++jj) {
                const int j = j0 + jj;
                const uint4* k4 = (const uint4*)(Kn + ((size_t)bh * 2048 + j) * 64);
                const uint4* r4 = (const uint4*)(Kr + ((size_t)b * 2048 + j) * 32);
                float a = 0.f;
#pragma unroll
                for (int i = 0; i < 8; ++i) { const uint4 w = k4[i]; a += q[8 * i] * bflo(w.x) + q[8 * i + 1] * bfhi(w.x) + q[8 * i + 2] * bflo(w.y) + q[8 * i + 3] * bfhi(w.y)
                    + q[8 * i + 4] * bflo(w.z) + q[8 * i + 5] * bfhi(w.z) + q[8 * i + 6] * bflo(w.w) + q[8 * i + 7] * bfhi(w.w); }
#pragma unroll
                for (int i = 0; i < 4; ++i) { const uint4 w = r4[i]; const int o8 = 64 + 8 * i; a += q[o8] * bflo(w.x) + q[o8 + 1] * bfhi(w.x) + q[o8 + 2] * bflo(w.y) + q[o8 + 3] * bfhi(w.y)
                    + q[o8 + 4] * bflo(w.z) + q[o8 + 5] * bfhi(w.z) + q[o8 + 6] * bflo(w.w) + q[o8 + 7] * bfhi(w.w); }
                sc[jj] = a;
            }
            float mx = m;
#pragma unroll
            for (int jj = 0; jj < 8; ++jj) mx = fmaxf(mx, sc[jj]);
            const float al = exp2f(m - mx);
            float ps = 0.f;
#pragma unroll
            for (int jj = 0; jj < 8; ++jj) { sc[jj] = exp2f(sc[jj] - mx); ps += sc[jj]; }
            l = l * al + ps; m = mx;
#pragma unroll
            for (int d = 0; d < 64; ++d) {
                const uint4 w = *(const uint4*)(Vt + ((size_t)bh * 64 + d) * 2048 + j0);
                o[d] = o[d] * al + sc[0] * bflo(w.x) + sc[1] * bfhi(w.x) + sc[2] * bflo(w.y) + sc[3] * bfhi(w.y) + sc[4] * bflo(w.z) + sc[5] * bfhi(w.z) + sc[6] * bflo(w.w) + sc[7] * bfhi(w.w);
            }
        }
        const float il = 1.f / l;
        bf16_t* dst = mix + ((size_t)b * 2048 + s_) * 1024 + hd * 64;
#pragma unroll
        for (int d = 0; d < 64; d += 2) *(unsigned*)(dst + d) = pack2(o[d] * il, o[d + 1] * il);
    }
}
DI void ssd_naive(const P& p, int bid, int nb) {
    unsigned char* ws = p.ws;
    const bf16_t* xa = (const bf16_t*)(ws + XBCA); const float* dt = (const float*)(ws + DTB); const bf16_t* z = (const bf16_t*)(ws + ZB);
    bf16_t* mix = (bf16_t*)(ws + MIX);
    const int wave = threadIdx.x >> 6, pp = threadIdx.x & 63;
    for (int item = bid; item < 32; item += nb) {
        const int bh = item * 4 + wave, b = bh >> 3, hd = bh & 7, g = hd >> 2;
        const float a = -__expf(p.in[10][hd]), Dh = p.in[11][hd];
        float st[128];
#pragma unroll
        for (int n = 0; n < 128; ++n) st[n] = 0.f;
        for (int t = 0; t < 2048; ++t) {
            const size_t row = (size_t)b * 2048 + t;
            const float dtv = dt[row * 8 + hd];
            const float da = __expf(dtv * a);
            const float xv = bf2f(xa[row * 1024 + hd * 64 + pp]);
            const float xd = dtv * xv;
            const uint4* b4 = (const uint4*)(xa + row * 1024 + 512 + g * 128);
            const uint4* c4 = (const uint4*)(xa + row * 1024 + 768 + g * 128);
            float y = 0.f;
#pragma unroll
            for (int i = 0; i < 16; ++i) {
                const uint4 bw = b4[i], cw = c4[i];
                const unsigned bb[4] = {bw.x, bw.y, bw.z, bw.w}, cc[4] = {cw.x, cw.y, cw.z, cw.w};
#pragma unroll
                for (int k = 0; k < 4; ++k) {
                    const int n = 8 * i + 2 * k;
                    st[n] = da * st[n] + xd * bflo(bb[k]); y += bflo(cc[k]) * st[n];
                    st[n + 1] = da * st[n + 1] + xd * bfhi(bb[k]); y += bfhi(cc[k]) * st[n + 1];
                }
            }
            y += Dh * xv;
            const float zv = bf2f(z[row * 512 + hd * 64 + pp]);
            mix[row * 1024 + 512 + hd * 64 + pp] = f2bf(y * siluf(zv));
        }
    }
}
DI void phase_mixer(const P& p, int bid, int nb, unsigned char* smem) {
    ssd_naive(p, bid, nb);
#if ATTN_NAIVE
    attn_naive(p, bid, nb);
#else
    attn_fast(p, bid, nb, smem);
#endif
}

DI void phase_ssdnorm(const P& p, int bid, int nb, unsigned char* smem) {
    bf16_t* mix = (bf16_t*)(p.ws + MIX);
    const int lane = threadIdx.x & 63, wave = threadIdx.x >> 6;
    for (int tk = bid * 4 + wave; tk < T; tk += nb * 4) {
        uint4* ptr = (uint4*)(mix + (size_t)tk * 1024 + 512 + lane * 8);
        const uint4 w = *ptr;
        const unsigned ww[4] = {w.x, w.y, w.z, w.w};
        float v[8]; float ss = 0.f;
#pragma unroll
        for (int k = 0; k < 4; ++k) { v[2 * k] = bflo(ww[k]); v[2 * k + 1] = bfhi(ww[k]); ss += v[2 * k] * v[2 * k] + v[2 * k + 1] * v[2 * k + 1]; }
#pragma unroll
        for (int o = 16; o >= 1; o >>= 1) ss += __shfl_xor(ss, o);
        const float rr = rsqrtf(ss * (1.f / 256.f) + EPS);
        uint4 o4; o4.x = pack2(v[0] * rr, v[1] * rr); o4.y = pack2(v[2] * rr, v[3] * rr); o4.z = pack2(v[4] * rr, v[5] * rr); o4.w = pack2(v[6] * rr, v[7] * rr);
        *ptr = o4;
    }
}

struct EpiResid {
    float* pre; const float* res;
    DI void operator()(const f32x16 (&acc)[2][2], int rb, int cb, int lane) const {
        const int r = lane & 31, h = lane >> 5;
#pragma unroll
        for (int i = 0; i < 2; ++i)
#pragma unroll
            for (int j = 0; j < 2; ++j) {
                const int col = cb + j * 32 + r;
#pragma unroll
                for (int e = 0; e < 16; ++e) {
                    const size_t idx = (size_t)(rb + i * 32 + crow(e, h)) * 1024 + col;
                    pre[idx] = ALPHA * res[idx] + acc[i][j][e];
                }
            }
    }
};
DI void phase_wout(const P& p, int bid, int nb, unsigned char* smem) {
    const int v = vbid(bid, nb);
    EpiResid e{p.out, p.in[0]};
    GemmArgs g{(const bf16_t*)(p.ws + MIX), 1024, (const bf16_t*)(p.ws + W_OUT), 1024, 1024, nullptr};
    for (int t = v; t < 256 * 8; t += nb) gemm_tile(g, (t >> 3) * 128, (t & 7) * 128, e, smem);
}
DI void ln_row(const float* src, const float* gam, const float* bet, int lane, float (&o)[16]) {
    float v[16];
#pragma unroll
    for (int i = 0; i < 4; ++i) { const float4 t4 = *(const float4*)(src + i * 256 + lane * 4); v[4 * i] = t4.x; v[4 * i + 1] = t4.y; v[4 * i + 2] = t4.z; v[4 * i + 3] = t4.w; }
    float s = 0.f;
#pragma unroll
    for (int i = 0; i < 16; ++i) s += v[i];
    const float mu = wave_sum(s) * (1.f / 1024.f);
    float q = 0.f;
#pragma unroll
    for (int i = 0; i < 16; ++i) { const float d = v[i] - mu; q += d * d; }
    const float rstd = rsqrtf(wave_sum(q) * (1.f / 1024.f) + EPS);
#pragma unroll
    for (int i = 0; i < 4; ++i) {
        const float4 g4 = *(const float4*)(gam + i * 256 + lane * 4), b4 = *(const float4*)(bet + i * 256 + lane * 4);
        o[4 * i] = (v[4 * i] - mu) * rstd * g4.x + b4.x; o[4 * i + 1] = (v[4 * i + 1] - mu) * rstd * g4.y + b4.y;
        o[4 * i + 2] = (v[4 * i + 2] - mu) * rstd * g4.z + b4.z; o[4 * i + 3] = (v[4 * i + 3] - mu) * rstd * g4.w + b4.w;
    }
}
DI void phase_ln1(const P& p, int bid, int nb, unsigned char* smem) {
    const int lane = threadIdx.x & 63, wave = threadIdx.x >> 6;
    float* hf = (float*)(p.ws + H1); bf16_t* hb = (bf16_t*)(p.ws + H1B);
    for (int tk = bid * 4 + wave; tk < T; tk += nb * 4) {
        float o[16];
        ln_row(p.out + (size_t)tk * 1024, p.in[14], p.in[15], lane, o);
#pragma unroll
        for (int i = 0; i < 4; ++i) {
            *(float4*)(hf + (size_t)tk * 1024 + i * 256 + lane * 4) = make_float4(o[4 * i], o[4 * i + 1], o[4 * i + 2], o[4 * i + 3]);
            uint2 w; w.x = pack2(o[4 * i], o[4 * i + 1]); w.y = pack2(o[4 * i + 2], o[4 * i + 3]);
            *(uint2*)(hb + (size_t)tk * 1024 + i * 256 + lane * 4) = w;
        }
    }
}
struct EpiXq {
    bf16_t* qx;
    DI void operator()(const f32x16 (&acc)[2][2], int rb, int cb, int lane) const {
        const int r = lane & 31, h = lane >> 5;
#pragma unroll
        for (int i = 0; i < 2; ++i)
#pragma unroll
            for (int j = 0; j < 2; ++j) {
                const int col = cb + j * 32 + r, hd = col >> 8, d = col & 255;
#pragma unroll
                for (int e = 0; e < 16; ++e) {
                    const int row = rb + i * 32 + crow(e, h), b = row >> 11, s_ = row & 2047;
                    qx[((size_t)(b * 4 + hd) * 2048 + s_) * 256 + d] = f2bf(acc[i][j][e] * XSCALE);
                }
            }
    }
};
DI void phase_xq(const P& p, int bid, int nb, unsigned char* smem) {
    const int v = vbid(bid, nb);
    EpiXq e{(bf16_t*)(p.ws + QX)};
    GemmArgs g{(const bf16_t*)(p.ws + H1B), 1024, (const bf16_t*)(p.ws + W_XQ), 1024, 1024, nullptr};
    for (int t = v; t < 256 * 8; t += nb) gemm_tile(g, (t >> 3) * 128, (t & 7) * 128, e, smem);
}
DI void phase_xattn(const P& p, int bid, int nb, unsigned char* smem) {
#if !XATTN_NAIVE
    xattn_fast(p, bid, nb, smem); return;
#endif
    unsigned char* ws = p.ws;
    const bf16_t* qx = (const bf16_t*)(ws + QX); const bf16_t* kx = (const bf16_t*)(ws + KX); const bf16_t* vxt = (const bf16_t*)(ws + VXT);
    bf16_t* ox = (bf16_t*)(ws + OX);
    const int lane = threadIdx.x & 63, hd = threadIdx.x >> 6;
    float* qs = (float*)smem + hd * 512; float* ps = qs + 256;
    for (int tk = bid; tk < T; tk += nb) {
        const int b = tk >> 11, s_ = tk & 2047;
        __syncthreads();
        {
            const uint2 w = *(const uint2*)(qx + ((size_t)(b * 4 + hd) * 2048 + s_) * 256 + lane * 4);
            qs[lane * 4] = bflo(w.x); qs[lane * 4 + 1] = bfhi(w.x); qs[lane * 4 + 2] = bflo(w.y); qs[lane * 4 + 3] = bfhi(w.y);
        }
        __syncthreads();
        float sc[4];
#pragma unroll
        for (int i = 0; i < 4; ++i) {
            const int m = lane + 64 * i;
            const uint4* k4 = (const uint4*)(kx + ((size_t)(b * 4 + hd) * 256 + m) * 256);
            float a = 0.f;
#pragma unroll 8
            for (int c = 0; c < 32; ++c) {
                const uint4 w = k4[c];
                const float4 q0 = *(const float4*)(qs + 8 * c), q1 = *(const float4*)(qs + 8 * c + 4);
                a += q0.x * bflo(w.x) + q0.y * bfhi(w.x) + q0.z * bflo(w.y) + q0.w * bfhi(w.y) + q1.x * bflo(w.z) + q1.y * bfhi(w.z) + q1.z * bflo(w.w) + q1.w * bfhi(w.w);
            }
            sc[i] = a;
        }
        const float mx = wave_max(fmaxf(fmaxf(sc[0], sc[1]), fmaxf(sc[2], sc[3])));
        float sum = 0.f;
#pragma unroll
        for (int i = 0; i < 4; ++i) { sc[i] = exp2f(sc[i] - mx); sum += sc[i]; }
        const float il = 1.f / wave_sum(sum);
#pragma unroll
        for (int i = 0; i < 4; ++i) ps[lane + 64 * i] = sc[i] * il;
        __syncthreads();
        float o[4];
#pragma unroll
        for (int dd = 0; dd < 4; ++dd) {
            const int d = lane * 4 + dd;
            const uint4* v4 = (const uint4*)(vxt + ((size_t)(b * 4 + hd) * 256 + d) * 256);
            float a = 0.f;
#pragma unroll 8
            for (int c = 0; c < 32; ++c) {
                const uint4 w = v4[c];
                const float4 q0 = *(const float4*)(ps + 8 * c), q1 = *(const float4*)(ps + 8 * c + 4);
                a += q0.x * bflo(w.x) + q0.y * bfhi(w.x) + q0.z * bflo(w.y) + q0.w * bfhi(w.y) + q1.x * bflo(w.z) + q1.y * bfhi(w.z) + q1.z * bflo(w.w) + q1.w * bfhi(w.w);
            }
            o[dd] = a;
        }
        uint2 w; w.x = pack2(o[0], o[1]); w.y = pack2(o[2], o[3]);
        *(uint2*)(ox + (size_t)tk * 1024 + hd * 256 + lane * 4) = w;
    }
}
DI void phase_xo(const P& p, int bid, int nb, unsigned char* smem) {
    const int v = vbid(bid, nb);
    EpiResid e{p.out, (const float*)(p.ws + H1)};
    GemmArgs g{(const bf16_t*)(p.ws + OX), 1024, (const bf16_t*)(p.ws + W_XO), 1024, 1024, nullptr};
    for (int t = v; t < 256 * 8; t += nb) gemm_tile(g, (t >> 3) * 128, (t & 7) * 128, e, smem);
}
DI void phase_ln2_router(const P& p, int bid, int nb, unsigned char* smem) {
    unsigned char* ws = p.ws;
    const int lane = threadIdx.x & 63, wave = threadIdx.x >> 6;
    float* hf = (float*)(ws + H2); bf16_t* hb = (bf16_t*)(ws + H2B);
    const float* wrt = (const float*)(ws + W_RT);
    unsigned* cnt = (unsigned*)(ws + CTL + CTL_CNT); int* lists = (int*)(ws + LISTS); float* tgate = (float*)(ws + TOK_GATE);
    for (int tk = bid * 4 + wave; tk < T; tk += nb * 4) {
        float o[16];
        ln_row(p.out + (size_t)tk * 1024, p.in[20], p.in[21], lane, o);
#pragma unroll
        for (int i = 0; i < 4; ++i) {
            *(float4*)(hf + (size_t)tk * 1024 + i * 256 + lane * 4) = make_float4(o[4 * i], o[4 * i + 1], o[4 * i + 2], o[4 * i + 3]);
            uint2 w; w.x = pack2(o[4 * i], o[4 * i + 1]); w.y = pack2(o[4 * i + 2], o[4 * i + 3]);
            *(uint2*)(hb + (size_t)tk * 1024 + i * 256 + lane * 4) = w;
        }
        float* lg = (float*)smem + wave * 64;
#pragma unroll 1
        for (int j = 0; j < 36; ++j) {
            float a = 0.f;
#pragma unroll
            for (int i = 0; i < 4; ++i) {
                const float4 w4 = *(const float4*)(wrt + j * 1024 + i * 256 + lane * 4);
                a += o[4 * i] * w4.x + o[4 * i + 1] * w4.y + o[4 * i + 2] * w4.z + o[4 * i + 3] * w4.w;
            }
            a = wave_sum(a);
            if (lane == 0) lg[j] = a;
        }
        __builtin_amdgcn_wave_barrier();
        float gl[4], el[32];
#pragma unroll
        for (int j = 0; j < 4; ++j) gl[j] = lg[j] + p.in[23][j];
#pragma unroll
        for (int j = 0; j < 32; ++j) el[j] = lg[4 + j] + p.in[25][j];
        __builtin_amdgcn_wave_barrier();
        int gi = 0; float gm = gl[0];
#pragma unroll
        for (int j = 1; j < 4; ++j) if (gl[j] > gm) { gm = gl[j]; gi = j; }
        float gs = 0.f;
#pragma unroll
        for (int j = 0; j < 4; ++j) gs += __expf(gl[j] - gm);
        const float ggate = 1.f / gs;
        float ev[8];
#pragma unroll
        for (int j = 0; j < 8; ++j) ev[j] = gi == 0 ? el[j] : gi == 1 ? el[8 + j] : gi == 2 ? el[16 + j] : el[24 + j];
        int i1 = 0; float v1 = ev[0];
#pragma unroll
        for (int j = 1; j < 8; ++j) if (ev[j] > v1) { v1 = ev[j]; i1 = j; }
        int i2 = -1; float v2 = -3.0e38f;
#pragma unroll
        for (int j = 0; j < 8; ++j) if (j != i1 && ev[j] > v2) { v2 = ev[j]; i2 = j; }
        const float e2 = __expf(v2 - v1);
        const float g1 = ggate / (1.f + e2), g2 = ggate * e2 / (1.f + e2);
        if (lane == 0) {
            const int ex1 = gi * 8 + i1, ex2 = gi * 8 + i2;
            const unsigned p1 = atomicAdd(&cnt[ex1], 1u); lists[(size_t)ex1 * T + p1] = tk * 2;
            const unsigned p2 = atomicAdd(&cnt[ex2], 1u); lists[(size_t)ex2 * T + p2] = tk * 2 + 1;
            tgate[tk * 2] = g1; tgate[tk * 2 + 1] = g2;
        }
    }
}
struct MoeMap { int off[33]; };
DI int moe_tiles(const unsigned* cnt, int* offs  ) {
    __syncthreads();
    if (threadIdx.x == 0) { int o = 0; for (int e = 0; e < 32; ++e) { offs[e] = o; o += (((int)cnt[e] + 127) >> 7) << 7; } offs[32] = o; }
    __syncthreads();
    return offs[32] >> 7;
}
struct EpiGU {
    bf16_t* hdn;
    DI void operator()(const f32x16 (&acc)[2][2], int rb, int cb, int lane) const {
        const int r = lane & 31, h = lane >> 5;
        const int hc = ((cb & 511) >> 7) * 64 + ((cb >> 6) & 1) * 32 + r;
#pragma unroll
        for (int i = 0; i < 2; ++i)
#pragma unroll
            for (int e = 0; e < 16; ++e) {
                const int slot = rb + i * 32 + crow(e, h);
                hdn[(size_t)slot * 256 + hc] = f2bf(siluf(acc[i][0][e]) * acc[i][1][e]);
            }
    }
};
struct EpiDown {
    bf16_t* y; const int* ltok; const float* lgate; int m0;
    DI void operator()(const f32x16 (&acc)[2][2], int rb, int cb, int lane) const {
        const int r = lane & 31, h = lane >> 5;
#pragma unroll
        for (int i = 0; i < 2; ++i)
#pragma unroll
            for (int e = 0; e < 16; ++e) {
                const int lr = rb - m0 + i * 32 + crow(e, h);
                const int tk2 = ltok[lr];
                if (tk2 >= 0) {
                    const float gt = lgate[lr];
#pragma unroll
                    for (int j = 0; j < 2; ++j) y[(size_t)tk2 * 1024 + cb + j * 32 + r] = f2bf(gt * acc[i][j][e]);
                }
            }
    }
};
template <int WHICH>
DI void phase_moe(const P& p, int bid, int nb, unsigned char* smem) {
    unsigned char* ws = p.ws;
    const unsigned* cnt = (const unsigned*)(ws + CTL + CTL_CNT); const int* lists = (const int*)(ws + LISTS); const float* tgate = (const float*)(ws + TOK_GATE);
    int* offs = (int*)(smem + GEMM_LDS); int* ltok = offs + 64; int* lrow = ltok + 128; float* lgate = (float*)(lrow + 128);
    const int nmt = moe_tiles(cnt, offs);
    constexpr int NNT = WHICH == 0 ? 4 : 8;
    const int v = vbid(bid, nb);
    for (int t = v; t < nmt * NNT; t += nb) {
        const int mt = t / NNT, ntl = t % NNT;
        const int slot0 = mt * 128;
        int e = 0;
        while (offs[e + 1] <= slot0) ++e;
        __syncthreads();
        if (threadIdx.x < 128) {
            const int pos = slot0 - offs[e] + threadIdx.x;
            const int tk2 = pos < (int)cnt[e] ? lists[(size_t)e * T + pos] : -1;
            ltok[threadIdx.x] = tk2; lrow[threadIdx.x] = tk2 < 0 ? 0 : (tk2 >> 1); lgate[threadIdx.x] = tk2 < 0 ? 0.f : tgate[tk2];
        }
        __syncthreads();
        if (WHICH == 0) {
            EpiGU ep{(bf16_t*)(ws + HDN)};
            GemmArgs g{(const bf16_t*)(ws + H2B), 1024, (const bf16_t*)(ws + W_GU) + (size_t)e * 512 * 1024, 1024, 1024, lrow};
            gemm_tile(g, slot0, ntl * 128, ep, smem);
        } else {
            EpiDown ep{(bf16_t*)(ws + YB), ltok, lgate, slot0};
            GemmArgs g{(const bf16_t*)(ws + HDN), 256, (const bf16_t*)(ws + W_DN) + (size_t)e * 1024 * 256, 256, 256, nullptr};
            gemm_tile(g, slot0, ntl * 128, ep, smem);
        }
    }
}
DI void phase_final(const P& p, int bid, int nb, unsigned char* smem) {
    const int lane = threadIdx.x & 63, wave = threadIdx.x >> 6;
    const float* hf = (const float*)(p.ws + H2); const bf16_t* y = (const bf16_t*)(p.ws + YB);
    const float* gam = p.in[29]; const float* bet = p.in[30];
    for (int tk = bid * 4 + wave; tk < T; tk += nb * 4) {
        float v[16];
#pragma unroll
        for (int i = 0; i < 4; ++i) {
            const float4 t4 = *(const float4*)(hf + (size_t)tk * 1024 + i * 256 + lane * 4);
            const uint2 a = *(const uint2*)(y + (size_t)(tk * 2) * 1024 + i * 256 + lane * 4), b = *(const uint2*)(y + (size_t)(tk * 2 + 1) * 1024 + i * 256 + lane * 4);
            v[4 * i] = ALPHA * t4.x + bflo(a.x) + bflo(b.x); v[4 * i + 1] = ALPHA * t4.y + bfhi(a.x) + bfhi(b.x);
            v[4 * i + 2] = ALPHA * t4.z + bflo(a.y) + bflo(b.y); v[4 * i + 3] = ALPHA * t4.w + bfhi(a.y) + bfhi(b.y);
        }
        float s = 0.f;
#pragma unroll
        for (int i = 0; i < 16; ++i) s += v[i];
        const float mu = wave_sum(s) * (1.f / 1024.f);
        float q = 0.f;
#pragma unroll
        for (int i = 0; i < 16; ++i) { const float d = v[i] - mu; q += d * d; }
        const float rstd = rsqrtf(wave_sum(q) * (1.f / 1024.f) + EPS);
#pragma unroll
        for (int i = 0; i < 4; ++i) {
            const float4 g4 = *(const float4*)(gam + i * 256 + lane * 4), b4 = *(const float4*)(bet + i * 256 + lane * 4);
            *(float4*)(p.out + (size_t)tk * 1024 + i * 256 + lane * 4) = make_float4((v[4 * i] - mu) * rstd * g4.x + b4.x, (v[4 * i + 1] - mu) * rstd * g4.y + b4.y,
                                                                                    (v[4 * i + 2] - mu) * rstd * g4.z + b4.z, (v[4 * i + 3] - mu) * rstd * g4.w + b4.w);
        }
    }
}

#define XB_TMO      128
#define XB_XCNT(j)  (256  + 64 * (j))
#define XB_XSUB(j)  (1280 + 64 * (j))
#define XB_XGEN(j)  (2304 + 64 * (j))
#define XB_TOP      3328
#define XB_TOPGEN   3392
#define XCD_BAR_WORDS 3456
#define XB_SPIN_CAP (1u << 25)
#define LAS __attribute__((address_space(3)))
DI unsigned xb_ld(unsigned* p) { return __hip_atomic_load(p, __ATOMIC_RELAXED, __HIP_MEMORY_SCOPE_AGENT); }
DI unsigned xb_add(unsigned* p, unsigned v) { return __hip_atomic_fetch_add(p, v, __ATOMIC_RELAXED, __HIP_MEMORY_SCOPE_AGENT); }
DI unsigned xb_xcc_id() { return (unsigned)__builtin_amdgcn_s_getreg((3 << 11) | 20) & 0xFu; }
#define XB_SPIN(cond, bar) do { unsigned _sp = 0; while (cond) { __builtin_amdgcn_s_sleep(1); \
    if ((++_sp & 255u) == 0u) { if (xb_ld(&(bar)[XB_TMO])) break; if (_sp > XB_SPIN_CAP) { atomicAdd(&(bar)[XB_TMO], 1u); break; } } } } while (0)
struct XcdBarrier { unsigned* bar; unsigned x; volatile LAS unsigned* st; };
DI XcdBarrier xcd_barrier_post(unsigned* bar, volatile LAS unsigned* st) {
    XcdBarrier b; b.bar = bar; b.x = xb_xcc_id(); b.st = st;
    if (threadIdx.x == 0) (void)xb_add(&bar[XB_XCNT(b.x)], 1u);
    return b;
}
DI void xcd_barrier_complete(unsigned* bar, unsigned x, unsigned& nloc, unsigned& nx) {
    const unsigned G = gridDim.x * gridDim.y * gridDim.z;
    unsigned sum, cnt, mine, sp = 0u;
    for (;;) {
        sum = 0u; cnt = 0u; mine = 0u;
#pragma unroll
        for (unsigned j = 0; j < 16; ++j) { const unsigned c = xb_ld(&bar[XB_XCNT(j)]); sum += c; cnt += (c > 0u) ? 1u : 0u; mine = (j == x) ? c : mine; }
        if (sum == G) break;
        __builtin_amdgcn_s_sleep(1);
        if ((++sp & 255u) == 0u) { if (xb_ld(&bar[XB_TMO])) break; if (sp > XB_SPIN_CAP) { atomicAdd(&bar[XB_TMO], 1u); break; } }
    }
    nloc = mine > 0u ? mine : 1u; nx = cnt > 0u ? cnt : 1u;
}
DI void xcd_barrier(const XcdBarrier& b) {
    asm volatile("s_waitcnt vmcnt(0)" ::: "memory");
    __syncthreads();
    if (threadIdx.x == 0) {
        unsigned* bar = b.bar;
        __builtin_amdgcn_s_waitcnt(0);
        unsigned nloc = b.st[0], nx = b.st[1];
        if (nloc == 0u) { xcd_barrier_complete(bar, b.x, nloc, nx); b.st[0] = nloc; b.st[1] = nx; }
        const unsigned old = xb_add(&bar[XB_XSUB(b.x)], 1u);
        const unsigned gen = old / nloc;
        if (old + 1u == (gen + 1u) * nloc) {
            __builtin_amdgcn_fence(__ATOMIC_RELEASE, "agent");
            asm volatile("s_waitcnt vmcnt(0)" ::: "memory");
            const unsigned og = xb_add(&bar[XB_TOP], 1u);
            const unsigned tg = og / nx;
            if (og + 1u == (tg + 1u) * nx) xb_add(&bar[XB_TOPGEN], 1u);
            else XB_SPIN(xb_ld(&bar[XB_TOPGEN]) == tg, bar);
            __builtin_amdgcn_fence(__ATOMIC_ACQUIRE, "agent");
            xb_add(&bar[XB_XGEN(b.x)], 1u);
            asm volatile("s_waitcnt vmcnt(0)" ::: "memory");
        } else {
            XB_SPIN(xb_ld(&bar[XB_XGEN(b.x)]) == gen, bar);
            __builtin_amdgcn_fence(__ATOMIC_ACQUIRE, "agent");
            asm volatile("s_waitcnt vmcnt(0)" ::: "memory");
        }
    }
    __syncthreads();
}

constexpr int NPHASE = 14;
template <int PH>
DI void run_phase(const P& p, int bid, int nb, unsigned char* smem) {
    if (PH == 0) phase_prep(p, bid, nb, smem);
    else if (PH == 1) phase_proj(p, bid, nb, smem);
    else if (PH == 2) phase_up(p, bid, nb, smem);
    else if (PH == 3) phase_mixer(p, bid, nb, smem);
    else if (PH == 4) phase_ssdnorm(p, bid, nb, smem);
    else if (PH == 5) phase_wout(p, bid, nb, smem);
    else if (PH == 6) phase_ln1(p, bid, nb, smem);
    else if (PH == 7) phase_xq(p, bid, nb, smem);
    else if (PH == 8) phase_xattn(p, bid, nb, smem);
    else if (PH == 9) phase_xo(p, bid, nb, smem);
    else if (PH == 10) phase_ln2_router(p, bid, nb, smem);
    else if (PH == 11) phase_moe<0>(p, bid, nb, smem);
    else if (PH == 12) phase_moe<1>(p, bid, nb, smem);
    else if (PH == 13) phase_final(p, bid, nb, smem);
}
template <int PH>
__global__ void __launch_bounds__(256, 2) k_phase(P p) {
    __shared__ __attribute__((aligned(16))) unsigned char smem[SMEM_BYTES];
    run_phase<PH>(p, blockIdx.x, gridDim.x, smem);
}

#if MEGA
#ifndef MEGA_WAVES
#define MEGA_WAVES 1
#endif
template <int PH>
DI void mega_steps(const P& p, const XcdBarrier& bar, unsigned char* smem) {
    run_phase<PH>(p, blockIdx.x, gridDim.x, smem);
    if constexpr (PH + 1 < NPHASE) { xcd_barrier(bar); mega_steps<PH + 1>(p, bar, smem); }
}
__global__ void __launch_bounds__(256, MEGA_WAVES) k_mega(P p) {
    __shared__ __attribute__((aligned(16))) unsigned char smem[SMEM_BYTES];
    volatile LAS unsigned* st = (volatile LAS unsigned*)(smem + SMEM_BYTES - 16);
    if (threadIdx.x < 4) st[threadIdx.x] = 0u;
    __syncthreads();
    const XcdBarrier bar = xcd_barrier_post((unsigned*)(p.ws + CTL), st);
    mega_steps<0>(p, bar, smem);
}
#endif
template <int PH>
__global__ void __launch_bounds__(256, 1) k_phase_big(P p) {
    __shared__ __attribute__((aligned(16))) unsigned char smem[SMEM_BYTES];
    run_phase<PH>(p, blockIdx.x, gridDim.x, smem);
}
template <int PH>
static void launch_phase(const P& p, int grid, hipStream_t st) {
    if constexpr (PH == 3) hipLaunchKernelGGL((k_phase_big<PH>), dim3(grid), dim3(256), 0, st, p);
    else hipLaunchKernelGGL((k_phase<PH>), dim3(grid), dim3(256), 0, st, p);
}

extern "C" void kernel_launch(void* const* d_in, const int* in_sizes, int n_in, void* d_out, int out_size, void* d_ws, size_t ws_size, hipStream_t stream) {
    if (n_in != 31 || out_size != T * D || ws_size < WS_NEED) {
        fprintf(stderr, "kernel_launch: unexpected shapes: n_in %d out %d ws %zu (need %zu)\n", n_in, out_size, ws_size, (size_t)WS_NEED);
        return;
    }
    P p{};
    for (int i = 0; i < 31; ++i) p.in[i] = (const float*)d_in[i];
    p.out = (float*)d_out; p.ws = (unsigned char*)d_ws;
    (void)hipMemsetAsync((unsigned char*)d_ws + CTL, 0, CTL_BYTES, stream);
#if MEGA
    static int grid = 0;
    if (grid == 0) {
        int dev = 0, cus = 0, per_cu = 0;
        (void)hipGetDevice(&dev);
        (void)hipDeviceGetAttribute(&cus, hipDeviceAttributeMultiprocessorCount, dev);
        if (hipOccupancyMaxActiveBlocksPerMultiprocessor(&per_cu, (const void*)k_mega, 256, 0) != hipSuccess || per_cu < 1) { fprintf(stderr, "kernel_launch: occupancy query failed\n"); per_cu = 1; }
        if (per_cu > 2) per_cu = 2;
        grid = cus * per_cu;
        fprintf(stderr, "kernel_launch: mega grid %d (%d CUs x %d)\n", grid, cus, per_cu);
    }
    void* args[] = {(void*)&p};
    const hipError_t le = hipLaunchCooperativeKernel((const void*)k_mega, dim3(grid), dim3(256), args, 0, stream);
    if (le != hipSuccess) fprintf(stderr, "kernel_launch: cooperative launch failed: %s (grid %d)\n", hipGetErrorString(le), grid);
#else
    const int grid = 1024;
    launch_phase<0>(p, grid, stream); launch_phase<1>(p, grid, stream); launch_phase<2>(p, grid, stream); launch_phase<3>(p, grid, stream);
    launch_phase<4>(p, grid, stream); launch_phase<5>(p, grid, stream); launch_phase<6>(p, grid, stream); launch_phase<7>(p, grid, stream);
    launch_phase<8>(p, grid, stream); launch_phase<9>(p, grid, stream); launch_phase<10>(p, grid, stream); launch_phase<11>(p, grid, stream);
    launch_phase<12>(p, grid, stream); launch_phase<13>(p, grid, stream);
#endif
}
```

```cpp
#include <hip/hip_runtime.h>
#include <stdint.h>
#include <stdio.h>

#ifndef MEGA
#define MEGA 1
#endif
#ifndef ATTN_NAIVE
#define ATTN_NAIVE 0
#endif
#ifndef XATTN_NAIVE
#define XATTN_NAIVE 0
#endif
#ifndef SSD_NAIVE
#define SSD_NAIVE 0
#endif
#ifndef P3_SMALL
#define P3_SMALL 1
#endif
#ifndef NO_SSD
#define NO_SSD 0
#endif
#ifndef NO_FLASH
#define NO_FLASH 0
#endif
#ifndef GEMM_DIRECT
#define GEMM_DIRECT 0
#endif

typedef unsigned short bf16_t;
typedef short bf16x8 __attribute__((ext_vector_type(8)));
typedef float f32x16 __attribute__((ext_vector_type(16)));
#define DI __device__ __forceinline__
#define MFMA32(a, b, c) __builtin_amdgcn_mfma_f32_32x32x16_bf16((a), (b), (c), 0, 0, 0)

constexpr int Bn = 16, S = 2048, T = Bn * S, D = 1024;
constexpr int NMEM = 256;
constexpr float EPS = 1e-5f;
constexpr float ALPHA = 1.189207115002721f;
constexpr float LOG2E = 1.4426950408889634f;
constexpr float QSCALE = 0.10206207261596577f * LOG2E;
constexpr float XSCALE = 0.0625f * LOG2E;
constexpr int NEXP = 32;
constexpr int MAXSLOTS = 69632;

constexpr size_t MiB = 1u << 20;
constexpr size_t W_IN = 0;
constexpr size_t W_QUP = W_IN + 4 * MiB;
constexpr size_t W_KVUP = W_QUP + 768 * 256 * 2;
constexpr size_t W_OUT = W_KVUP + 1024 * 128 * 2;
constexpr size_t W_XQ = W_OUT + 2 * MiB;
constexpr size_t W_XKV = W_XQ + 2 * MiB;
constexpr size_t W_XO = W_XKV + 4 * MiB;
constexpr size_t W_GU = W_XO + 2 * MiB;
constexpr size_t W_DN = W_GU + 32 * MiB;
constexpr size_t W_RT = W_DN + 16 * MiB;
constexpr size_t ROPE_C = W_RT + 48 * 1024 * 4;
constexpr size_t ROPE_S = ROPE_C + 2048 * 16 * 4;
constexpr size_t TOK_GATE = ROPE_S + 2048 * 16 * 4;
constexpr size_t CTL = TOK_GATE + (size_t)T * 2 * 4;
constexpr size_t CTL_BYTES = 32768;
constexpr size_t CTL_CNT = 16384;
static_assert(CTL + CTL_BYTES <= 64 * MiB, "weights region overflow");
constexpr size_t RA = 64 * MiB, RB = 192 * MiB, RC = 320 * MiB, RD = 448 * MiB, WS_NEED = 512 * MiB;
constexpr size_t XBC = RA;
constexpr size_t KX = RA + 64 * MiB;
constexpr size_t VXT = KX + 8 * MiB;
constexpr size_t YB = RA;
constexpr size_t QB = RB;
constexpr size_t KNB = RB + 48 * MiB;
constexpr size_t VTB = KNB + 32 * MiB;
constexpr size_t H1 = RB;
constexpr size_t H2 = RB;
constexpr size_t XBCA = RC;
constexpr size_t MIX = RC + 64 * MiB;
constexpr size_t H1B = RC;
constexpr size_t QX = RC + 64 * MiB;
constexpr size_t OX = RC;
constexpr size_t H2B = RC;
constexpr size_t HDN = RC + 64 * MiB;
constexpr size_t CQ = RD;
constexpr size_t CKV = CQ + 16 * MiB;
constexpr size_t KROPE = CKV + 8 * MiB;
constexpr size_t DTB = KROPE + 2 * MiB;
constexpr size_t ZB = DTB + 1 * MiB;
constexpr size_t LISTS = RD;
static_assert(ZB + 32 * MiB <= WS_NEED, "region D overflow");

struct P {
    const float* in[31];
    float* out;
    unsigned char* ws;
};

typedef __bf16 hbf16x2 __attribute__((ext_vector_type(2)));
typedef float f32x2 __attribute__((ext_vector_type(2)));
DI bf16_t f2bf(float x) { return __builtin_bit_cast(bf16_t, (__bf16)x); }
DI float bf2f(bf16_t b) { return __uint_as_float(((unsigned)b) << 16); }
DI float bflo(unsigned w) { return __uint_as_float(w << 16); }
DI float bfhi(unsigned w) { return __uint_as_float(w & 0xffff0000u); }
DI unsigned pack2(float a, float b) { f32x2 v = {a, b}; return __builtin_bit_cast(unsigned, __builtin_convertvector(v, hbf16x2)); }
DI float siluf(float x) { return x / (1.f + __expf(-x)); }
DI float softplusf(float x) { return x > 20.f ? x : log1pf(__expf(x)); }
DI int crow(int reg, int h) { return (reg & 3) + 8 * (reg >> 2) + 4 * h; }
DI float wave_sum(float v) {
#pragma unroll
    for (int o = 32; o >= 1; o >>= 1) v += __shfl_xor(v, o);
    return v;
}
DI float wave_max(float v) {
#pragma unroll
    for (int o = 32; o >= 1; o >>= 1) v = fmaxf(v, __shfl_xor(v, o));
    return v;
}

constexpr int LDS_ROW = 144;
constexpr int TILE_BYTES = 128 * LDS_ROW;
constexpr int GEMM_LDS = 4 * TILE_BYTES;
constexpr int SMEM_BYTES = GEMM_LDS + 2048;

struct GemmArgs {
    const bf16_t* A; int lda;
    const bf16_t* Bt; int ldb;
    int K;
    const int* lrows;
};

template <class Epi>
DI void gemm_tile(const GemmArgs& g, int m0, int n0, Epi& epi, unsigned char* smem) {
    const int tid = threadIdx.x, lane = tid & 63, wave = tid >> 6, wr = wave >> 1, wc = wave & 1;
    const int r = lane & 31, h = lane >> 5;
    f32x16 acc[2][2];
#pragma unroll
    for (int i = 0; i < 2; ++i)
#pragma unroll
        for (int j = 0; j < 2; ++j)
#pragma unroll
            for (int e = 0; e < 16; ++e) acc[i][j][e] = 0.f;
    const int nk = g.K >> 6;
#if GEMM_DIRECT
    {
        const bf16_t* ap[2]; const bf16_t* bp[2];
#pragma unroll
        for (int i = 0; i < 2; ++i) {
            const int lr = wr * 64 + i * 32 + r;
            const int grow = g.lrows ? g.lrows[lr] : (m0 + lr);
            ap[i] = g.A + (size_t)grow * g.lda + 8 * h;
            bp[i] = g.Bt + (size_t)(n0 + wc * 64 + i * 32 + r) * g.ldb + 8 * h;
        }
        for (int k = 0; k < g.K; k += 16) {
            bf16x8 a[2], b[2];
#pragma unroll
            for (int i = 0; i < 2; ++i) { a[i] = *(const bf16x8*)(ap[i] + k); b[i] = *(const bf16x8*)(bp[i] + k); }
#pragma unroll
            for (int i = 0; i < 2; ++i)
#pragma unroll
                for (int j = 0; j < 2; ++j) acc[i][j] = MFMA32(a[i], b[j], acc[i][j]);
        }
    }
#else
    {
        const int srow = tid >> 3, sch = tid & 7;
        const bf16_t* ag[4]; const bf16_t* bg[4];
#pragma unroll
        for (int i = 0; i < 4; ++i) {
            const int lr = srow + 32 * i;
            const int grow = g.lrows ? g.lrows[lr] : (m0 + lr);
            ag[i] = g.A + (size_t)grow * g.lda + sch * 8;
            bg[i] = g.Bt + (size_t)(n0 + lr) * g.ldb + sch * 8;
        }
        const int soff = srow * LDS_ROW + sch * 16;
        uint4 ra0, ra1, ra2, ra3, rb0, rb1, rb2, rb3;
#define G_LOAD(KO) do { ra0 = *(const uint4*)(ag[0] + (KO)); ra1 = *(const uint4*)(ag[1] + (KO)); ra2 = *(const uint4*)(ag[2] + (KO)); ra3 = *(const uint4*)(ag[3] + (KO)); \
                        rb0 = *(const uint4*)(bg[0] + (KO)); rb1 = *(const uint4*)(bg[1] + (KO)); rb2 = *(const uint4*)(bg[2] + (KO)); rb3 = *(const uint4*)(bg[3] + (KO)); } while (0)
#define L_STORE(BUF) do { unsigned char* _d = (BUF) + soff; \
        *(uint4*)(_d) = ra0; *(uint4*)(_d + 32 * LDS_ROW) = ra1; *(uint4*)(_d + 64 * LDS_ROW) = ra2; *(uint4*)(_d + 96 * LDS_ROW) = ra3; \
        *(uint4*)(_d + TILE_BYTES) = rb0; *(uint4*)(_d + TILE_BYTES + 32 * LDS_ROW) = rb1; *(uint4*)(_d + TILE_BYTES + 64 * LDS_ROW) = rb2; *(uint4*)(_d + TILE_BYTES + 96 * LDS_ROW) = rb3; } while (0)
        G_LOAD(0);
        __syncthreads();
        L_STORE(smem);
        __syncthreads();
        const int aoff = (wr * 64 + r) * LDS_ROW + h * 16;
        const int boff = TILE_BYTES + (wc * 64 + r) * LDS_ROW + h * 16;
        for (int kt = 0; kt < nk; ++kt) {
            const unsigned char* cur = smem + (kt & 1) * 2 * TILE_BYTES;
            unsigned char* nxt = smem + ((kt + 1) & 1) * 2 * TILE_BYTES;
            const bool more = (kt + 1 < nk);
            if (more) G_LOAD((kt + 1) * 64);
#pragma unroll
            for (int ks = 0; ks < 4; ++ks) {
                const bf16x8 a0 = *(const bf16x8*)(cur + aoff + ks * 32);
                const bf16x8 a1 = *(const bf16x8*)(cur + aoff + 32 * LDS_ROW + ks * 32);
                const bf16x8 b0 = *(const bf16x8*)(cur + boff + ks * 32);
                const bf16x8 b1 = *(const bf16x8*)(cur + boff + 32 * LDS_ROW + ks * 32);
                acc[0][0] = MFMA32(a0, b0, acc[0][0]); acc[0][1] = MFMA32(a0, b1, acc[0][1]);
                acc[1][0] = MFMA32(a1, b0, acc[1][0]); acc[1][1] = MFMA32(a1, b1, acc[1][1]);
            }
            if (more) L_STORE(nxt);
            __syncthreads();
        }
#undef G_LOAD
#undef L_STORE
    }
#endif
    epi(acc, m0 + wr * 64, n0 + wc * 64, lane);
}

DI int vbid(int bid, int nb) { return (nb % 8 == 0) ? (bid % 8) * (nb / 8) + bid / 8 : bid; }

DI int colmap_in(int n) {
    if (n < 384) return n;
    if (n < 896) return 416 + (n - 384);
    if (n < 1920) return 928 + (n - 896);
    if (n < 1952) return 384 + (n - 1920);
    if (n < 1960) return n;
    return -1;
}
template <int KIND>
DI void tconv_tile(const float* src, const float* src2, int ldsrc, bf16_t* dst, int K, int k0, int n0, const float* scale, int scale_from, unsigned char* smem) {
    float* tile = (float*)smem;
    const int t = threadIdx.x;
    __syncthreads();
#pragma unroll 4
    for (int i = 0; i < 16; ++i) {
        const int k = i * 4 + (t >> 6), n = t & 63;
        const int nd = n0 + n;
        float v = 0.f;
        if (KIND == 1) { const int c = colmap_in(nd); if (c >= 0) v = src[(size_t)(k0 + k) * ldsrc + c]; }
        else if (KIND == 2) {
            const int j = nd >> 7, wc = (nd >> 6) & 1, isup = (nd >> 5) & 1, ii = nd & 31;
            const int c = 64 * j + 32 * wc + ii;
            v = (isup ? src2 : src)[(size_t)(k0 + k) * ldsrc + c];
        } else v = src[(size_t)(k0 + k) * ldsrc + nd];
        if (scale && (k0 + k) >= scale_from) v *= scale[k0 + k - scale_from];
        tile[k * 65 + n] = v;
    }
    __syncthreads();
#pragma unroll 4
    for (int i = 0; i < 16; ++i) {
        const int n = i * 4 + (t >> 6), k = t & 63;
        dst[(size_t)(n0 + n) * K + k0 + k] = f2bf(tile[k * 65 + n]);
    }
}

DI void phase_prep(const P& p, int bid, int nb, unsigned char* smem) {
    unsigned char* ws = p.ws;
    const int tid = threadIdx.x;
    constexpr int J0 = 512, J1 = J0 + 48, J2 = J1 + 32, J3 = J2 + 256, J4 = J3 + 256, J5 = J4 + 256, J6 = J5 + 256, J7 = J6 + 256, J8 = J7 + 4096, J9 = J8 + 2048;
    for (int t = bid; t < J9; t += nb) {
        if (t < J0) { const int kt = t >> 5, ntl = t & 31; tconv_tile<1>(p.in[2], nullptr, 1960, (bf16_t*)(ws + W_IN), 1024, kt * 64, ntl * 64, nullptr, 0, smem); }
        else if (t < J1) { const int u = t - J0, kt = u / 12, ntl = u % 12; tconv_tile<0>(p.in[4], nullptr, 768, (bf16_t*)(ws + W_QUP), 256, kt * 64, ntl * 64, p.in[3], 0, smem); }
        else if (t < J2) { const int u = t - J1, kt = u >> 4, ntl = u & 15; tconv_tile<0>(p.in[6], nullptr, 1024, (bf16_t*)(ws + W_KVUP), 128, kt * 64, ntl * 64, p.in[5], 0, smem); }
        else if (t < J3) { const int u = t - J2, kt = u >> 4, ntl = u & 15; tconv_tile<0>(p.in[13], nullptr, 1024, (bf16_t*)(ws + W_OUT), 1024, kt * 64, ntl * 64, p.in[12], 512, smem); }
        else if (t < J4) { const int u = t - J3, kt = u >> 4, ntl = u & 15; tconv_tile<0>(p.in[16], nullptr, 1024, (bf16_t*)(ws + W_XQ), 1024, kt * 64, ntl * 64, nullptr, 0, smem); }
        else if (t < J5) { const int u = t - J4, kt = u >> 4, ntl = u & 15; tconv_tile<0>(p.in[17], nullptr, 1024, (bf16_t*)(ws + W_XKV), 1024, kt * 64, ntl * 64, nullptr, 0, smem); }
        else if (t < J6) { const int u = t - J5, kt = u >> 4, ntl = u & 15; tconv_tile<0>(p.in[18], nullptr, 1024, (bf16_t*)(ws + W_XKV) + (size_t)1024 * 1024, 1024, kt * 64, ntl * 64, nullptr, 0, smem); }
        else if (t < J7) { const int u = t - J6, kt = u >> 4, ntl = u & 15; tconv_tile<0>(p.in[19], nullptr, 1024, (bf16_t*)(ws + W_XO), 1024, kt * 64, ntl * 64, nullptr, 0, smem); }
        else if (t < J8) { const int u = t - J7, e = u >> 7, v = u & 127, kt = v >> 3, ntl = v & 7;
            tconv_tile<2>(p.in[26] + (size_t)e * 1024 * 256, p.in[27] + (size_t)e * 1024 * 256, 256, (bf16_t*)(ws + W_GU) + (size_t)e * 512 * 1024, 1024, kt * 64, ntl * 64, nullptr, 0, smem); }
        else { const int u = t - J8, e = u >> 6, v = u & 63, kt = v >> 4, ntl = v & 15;
            tconv_tile<0>(p.in[28] + (size_t)e * 256 * 1024, nullptr, 1024, (bf16_t*)(ws + W_DN) + (size_t)e * 1024 * 256, 256, kt * 64, ntl * 64, nullptr, 0, smem); }
    }
    {
        const size_t gsz = (size_t)nb * 256, g0 = (size_t)bid * 256 + tid;
        bf16_t* xb = (bf16_t*)p.out;
        const float4* x4 = (const float4*)p.in[0];
        for (size_t i = g0; i < (size_t)T * D / 4; i += gsz) { const float4 v = x4[i]; uint2 o; o.x = pack2(v.x, v.y); o.y = pack2(v.z, v.w); ((uint2*)xb)[i] = o; }
        bf16_t* mb = xb + (size_t)T * D;
        const float4* m4 = (const float4*)p.in[1];
        for (size_t i = g0; i < (size_t)Bn * NMEM * D / 4; i += gsz) { const float4 v = m4[i]; uint2 o; o.x = pack2(v.x, v.y); o.y = pack2(v.z, v.w); ((uint2*)mb)[i] = o; }
        float* wrt = (float*)(ws + W_RT);
        for (size_t i = g0; i < 48 * 1024; i += gsz) {
            const int j = (int)(i >> 10), k = (int)(i & 1023);
            float v = 0.f;
            if (j < 4) v = p.in[22][k * 4 + j]; else if (j < 36) v = p.in[24][k * 32 + (j - 4)];
            wrt[i] = v;
        }
        float* rc = (float*)(ws + ROPE_C); float* rs = (float*)(ws + ROPE_S);
        for (size_t i = g0; i < 2048 * 16; i += gsz) {
            const int pos = (int)(i >> 4), f = (int)(i & 15);
            const float inv = powf(10000.f, -(float)f / 16.f);
            const float ang = (float)pos * inv;
            const double a = (double)ang;
            const double k2 = rint(a * 0.15915494309189535);
            const float rr = (float)(a - k2 * 6.283185307179586);
            rc[i] = cosf(rr); rs[i] = sinf(rr);
        }
    }
}

struct EpiProj {
    bf16_t *cq, *ckv, *z, *xbc, *krope; float* dt; const float *rc, *rs, *dtb;
    DI void operator()(const f32x16 (&acc)[2][2], int rb, int cb, int lane) const {
        const int r = lane & 31, h = lane >> 5;
#pragma unroll
        for (int i = 0; i < 2; ++i)
#pragma unroll
            for (int j = 0; j < 2; ++j) {
                const int col = cb + j * 32 + r;
                const int colb = cb + j * 32;
#pragma unroll
                for (int e = 0; e < 16; ++e) {
                    const int row = rb + i * 32 + crow(e, h);
                    const float v = acc[i][j][e];
                    if (colb < 256) cq[(size_t)row * 256 + col] = f2bf(v);
                    else if (colb < 384) ckv[(size_t)row * 128 + col - 256] = f2bf(v);
                    else if (colb < 896) z[(size_t)row * 512 + col - 384] = f2bf(v);
                    else if (colb < 1920) xbc[(size_t)row * 1024 + col - 896] = f2bf(v);
                    else if (colb == 1920) {
                        const float pv = __shfl_xor(v, 16);
                        const int pos = row & 2047, f = r & 15;
                        const float c = rc[pos * 16 + f], s = rs[pos * 16 + f];
                        const float o = (r < 16) ? (v * c - pv * s) : (v * c + pv * s);
                        krope[(size_t)row * 32 + r] = f2bf(o);
                    } else if (colb == 1952) {
                        if (r < 8) dt[(size_t)row * 8 + r] = softplusf(v + dtb[r]);
                    }
                }
            }
    }
};
struct EpiMemKV {
    bf16_t *kx, *vxt;
    DI void operator()(const f32x16 (&acc)[2][2], int rb, int cb, int lane) const {
        const int r = lane & 31, h = lane >> 5;
#pragma unroll
        for (int i = 0; i < 2; ++i)
#pragma unroll
            for (int j = 0; j < 2; ++j) {
                const int col = cb + j * 32 + r;
#pragma unroll
                for (int e = 0; e < 16; ++e) {
                    const int row = rb + i * 32 + crow(e, h);
                    const int b = row >> 8, m = row & 255;
                    const float v = acc[i][j][e];
                    if (col < 1024) { const int hd = col >> 8, d = col & 255; kx[((size_t)(b * 4 + hd) * 256 + m) * 256 + d] = f2bf(v); }
                    else { const int c2 = col - 1024, hd = c2 >> 8, d = c2 & 255; vxt[((size_t)(b * 4 + hd) * 256 + d) * 256 + m] = f2bf(v); }
                }
            }
    }
};
DI void phase_proj(const P& p, int bid, int nb, unsigned char* smem) {
    unsigned char* ws = p.ws;
    const int v = vbid(bid, nb);
    const bf16_t* xb = (const bf16_t*)p.out;
    EpiProj e1{(bf16_t*)(ws + CQ), (bf16_t*)(ws + CKV), (bf16_t*)(ws + ZB), (bf16_t*)(ws + XBC), (bf16_t*)(ws + KROPE), (float*)(ws + DTB),
               (const float*)(ws + ROPE_C), (const float*)(ws + ROPE_S), p.in[9]};
    EpiMemKV e2{(bf16_t*)(ws + KX), (bf16_t*)(ws + VXT)};
    constexpr int NT1 = 256 * 16, NT2 = 32 * 16;
    for (int t = v; t < NT1 + NT2; t += nb) {
        if (t < NT1) { GemmArgs g{xb, 1024, (const bf16_t*)(ws + W_IN), 1024, 1024, nullptr}; gemm_tile(g, (t >> 4) * 128, (t & 15) * 128, e1, smem); }
        else { const int u = t - NT1; GemmArgs g{xb + (size_t)T * D, 1024, (const bf16_t*)(ws + W_XKV), 1024, 1024, nullptr}; gemm_tile(g, (u >> 4) * 128, (u & 15) * 128, e2, smem); }
    }
}

struct EpiQup {
    bf16_t* q; const float *rc, *rs; const float* rms;
    int m0;
    DI void operator()(const f32x16 (&acc)[2][2], int rb, int cb, int lane) const {
        const int r = lane & 31, h = lane >> 5;
#pragma unroll
        for (int i = 0; i < 2; ++i)
#pragma unroll
            for (int j = 0; j < 2; ++j) {
                const int blk = (cb >> 5) + j, head = blk / 3, part = blk % 3;
#pragma unroll
                for (int e = 0; e < 16; ++e) {
                    const int row = rb + i * 32 + crow(e, h);
                    float v = acc[i][j][e] * rms[row - m0];
                    if (part == 2) {
                        const float pv = __shfl_xor(v, 16);
                        const int pos = row & 2047, f = r & 15;
                        const float c = rc[pos * 16 + f], s = rs[pos * 16 + f];
                        v = (r < 16) ? (v * c - pv * s) : (v * c + pv * s);
                    }
                    const int b = row >> 11, s_ = row & 2047;
                    q[((size_t)(b * 8 + head) * 2048 + s_) * 96 + part * 32 + r] = f2bf(v * QSCALE);
                }
            }
    }
};
struct EpiKVup {
    bf16_t *kn, *vt; const float* rms; int m0;
    DI void operator()(const f32x16 (&acc)[2][2], int rb, int cb, int lane) const {
        const int r = lane & 31, h = lane >> 5;
        const int head = cb >> 7, isv = (cb >> 6) & 1;
#pragma unroll
        for (int i = 0; i < 2; ++i)
#pragma unroll
            for (int j = 0; j < 2; ++j) {
                const int d = j * 32 + r;
#pragma unroll
                for (int e = 0; e < 16; ++e) {
                    const int row = rb + i * 32 + crow(e, h);
                    const float v = acc[i][j][e] * rms[row - m0];
                    const int b = row >> 11, s_ = row & 2047;
                    if (!isv) kn[((size_t)(b * 8 + head) * 2048 + s_) * 64 + d] = f2bf(v);
                    else vt[((size_t)(b * 8 + head) * 64 + d) * 2048 + s_] = f2bf(v);
                }
            }
    }
};
template <int K>
DI void row_rms(const bf16_t* src, int m0, float* rms) {
    const int t = threadIdx.x, row = t >> 1, half = t & 1;
    const uint4* s4 = (const uint4*)(src + (size_t)(m0 + row) * K + half * (K / 2));
    float ss = 0.f;
#pragma unroll
    for (int i = 0; i < K / 16; ++i) {
        const uint4 w = s4[i];
        const unsigned ww[4] = {w.x, w.y, w.z, w.w};
#pragma unroll
        for (int k = 0; k < 4; ++k) { const float a = bflo(ww[k]), b = bfhi(ww[k]); ss += a * a + b * b; }
    }
    ss += __shfl_xor(ss, 1);
    __syncthreads();
    if (half == 0) rms[row] = rsqrtf(ss * (1.f / K) + EPS);
    __syncthreads();
}
DI void phase_up(const P& p, int bid, int nb, unsigned char* smem) {
    unsigned char* ws = p.ws;
    const int v = vbid(bid, nb);
    float* rms = (float*)(smem + GEMM_LDS);
    constexpr int NTQ = 256 * 6, NTKV = 256 * 8;
    for (int t = v; t < NTQ + NTKV; t += nb) {
        if (t < NTQ) {
            const int mt = t / 6, ntl = t % 6;
            row_rms<256>((const bf16_t*)(ws + CQ), mt * 128, rms);
            EpiQup e{(bf16_t*)(ws + QB), (const float*)(ws + ROPE_C), (const float*)(ws + ROPE_S), rms, mt * 128};
            GemmArgs g{(const bf16_t*)(ws + CQ), 256, (const bf16_t*)(ws + W_QUP), 256, 256, nullptr};
            gemm_tile(g, mt * 128, ntl * 128, e, smem);
        } else {
            const int u = t - NTQ, mt = u >> 3, ntl = u & 7;
            row_rms<128>((const bf16_t*)(ws + CKV), mt * 128, rms);
            EpiKVup e{(bf16_t*)(ws + KNB), (bf16_t*)(ws + VTB), rms, mt * 128};
            GemmArgs g{(const bf16_t*)(ws + CKV), 128, (const bf16_t*)(ws + W_KVUP), 128, 128, nullptr};
            gemm_tile(g, mt * 128, ntl * 128, e, smem);
        }
    }
    {
        const bf16_t* xbc = (const bf16_t*)(ws + XBC); bf16_t* xa = (bf16_t*)(ws + XBCA);
        const float* cw = p.in[7]; const float* cb = p.in[8];
        const size_t gsz = (size_t)nb * 256;
        for (size_t i = (size_t)bid * 256 + threadIdx.x; i < (size_t)T * 128; i += gsz) {
            const int tkn = (int)(i >> 7), c0 = (int)(i & 127) * 8, s_ = tkn & 2047;
            float accv[8];
#pragma unroll
            for (int k = 0; k < 8; ++k) accv[k] = cb[c0 + k];
#pragma unroll
            for (int j = 0; j < 4; ++j) {
                if (s_ + j - 3 >= 0) {
                    const uint4 w = *(const uint4*)(xbc + (size_t)(tkn + j - 3) * 1024 + c0);
                    const unsigned ww[4] = {w.x, w.y, w.z, w.w};
#pragma unroll
                    for (int k = 0; k < 4; ++k) {
                        accv[2 * k] += cw[j * 1024 + c0 + 2 * k] * bflo(ww[k]);
                        accv[2 * k + 1] += cw[j * 1024 + c0 + 2 * k + 1] * bfhi(ww[k]);
                    }
                }
            }
            uint4 o;
            o.x = pack2(siluf(accv[0]), siluf(accv[1])); o.y = pack2(siluf(accv[2]), siluf(accv[3]));
            o.z = pack2(siluf(accv[4]), siluf(accv[5])); o.w = pack2(siluf(accv[6]), siluf(accv[7]));
            *(uint4*)(xa + (size_t)tkn * 1024 + c0) = o;
        }
    }
}

DI int perm16(int k) { return (k & ~12) | ((k & 4) << 1) | ((k & 8) >> 1); }
template <int DQK, int DVW, int KT, int NQG, int NDV>
struct FlashCfg {
    static constexpr int KSTR = (DQK + 8) * 2;
    static constexpr int VSTR = (KT + 8) * 2;
    static constexpr int DV = DVW * NDV;
    static constexpr int KBYTES = KT * KSTR, VBYTES = DV * VSTR, STAGE = KBYTES + VBYTES;
    static constexpr int KCH = KT * DQK / 8 / 256;
    static constexpr int VCH = DV * KT / 8 / 256;
    static_assert(KT * DQK / 8 % 256 == 0 && DV * KT / 8 % 256 == 0, "chunk split");
    static_assert(2 * STAGE <= GEMM_LDS + 2048 - 16, "flash LDS");
};
template <int DQK, int DVW, int KT, int NQG, int NDV, class Src>
DI void flash_item(const Src& src, int ntiles, int nskip  , unsigned char* smem) {
    typedef FlashCfg<DQK, DVW, KT, NQG, NDV> C;
    constexpr int NKS = DQK / 16, NKB = KT / 32, NDB = DVW / 32;
    int tid = threadIdx.x; asm volatile("" : "+v"(tid));
    const int lane = tid & 63, wave = __builtin_amdgcn_readfirstlane(tid >> 6), r = lane & 31, h = lane >> 5;
    const int qg = wave / NDV, dvh = wave % NDV;
    bf16x8 qf[NKS];
    {
        const bf16_t* qp = src.qrow(qg * 32 + r) + 8 * h;
#pragma unroll
        for (int ks = 0; ks < NKS; ++ks) qf[ks] = *(const bf16x8*)(qp + 16 * ks);
    }
    f32x16 o[NDB];
#pragma unroll
    for (int d = 0; d < NDB; ++d)
#pragma unroll
        for (int e = 0; e < 16; ++e) o[d][e] = 0.f;
    float m = -1e30f, l = 0.f;
    uint4 kr[C::KCH], vr[C::VCH];
    auto gload = [&](int t) {
#pragma unroll
        for (int i = 0; i < C::KCH; ++i) { const int idx = tid + 256 * i; kr[i] = src.kload(t, idx / (DQK / 8), idx % (DQK / 8)); }
#pragma unroll
        for (int i = 0; i < C::VCH; ++i) { const int idx = tid + 256 * i; vr[i] = src.vload(t, idx / (KT / 8), idx % (KT / 8)); }
    };
    auto lstore = [&](unsigned char* buf) {
#pragma unroll
        for (int i = 0; i < C::KCH; ++i) { const int idx = tid + 256 * i; *(uint4*)(buf + (idx / (DQK / 8)) * C::KSTR + (idx % (DQK / 8)) * 16) = kr[i]; }
#pragma unroll
        for (int i = 0; i < C::VCH; ++i) {
            const int idx = tid + 256 * i, dv = idx / (KT / 8), c = idx % (KT / 8);
            unsigned char* row = buf + C::KBYTES + dv * C::VSTR + (c >> 1) * 32;
            const int a = c & 1;
            *(uint2*)(row + (4 * a) * 2) = make_uint2(vr[i].x, vr[i].y);
            *(uint2*)(row + (8 + 4 * a) * 2) = make_uint2(vr[i].z, vr[i].w);
        }
    };
    gload(0);
    __syncthreads();
    lstore(smem);
    __syncthreads();
    for (int t = 0; t < ntiles; ++t) {
        const unsigned char* cur = smem + (t & 1) * C::STAGE;
        const bool more = (t + 1 < ntiles);
        if (more) gload(t + 1);
        if (!(t == ntiles - 1 && qg < nskip)) {
            f32x16 s[NKB];
#pragma unroll
            for (int kb = 0; kb < NKB; ++kb) {
#pragma unroll
                for (int e = 0; e < 16; ++e) s[kb][e] = 0.f;
                const unsigned char* kp = cur + (kb * 32 + r) * C::KSTR + h * 16;
#pragma unroll
                for (int ks = 0; ks < NKS; ++ks) s[kb] = MFMA32(*(const bf16x8*)(kp + ks * 32), qf[ks], s[kb]);
            }
            float mx = s[0][0];
#pragma unroll
            for (int kb = 0; kb < NKB; ++kb)
#pragma unroll
                for (int e = 0; e < 16; ++e) mx = fmaxf(mx, s[kb][e]);
            mx = fmaxf(mx, __shfl_xor(mx, 32));
            const float mn = fmaxf(m, mx);
            const float alpha = exp2f(m - mn);
            m = mn;
            float ps = 0.f;
#pragma unroll
            for (int kb = 0; kb < NKB; ++kb)
#pragma unroll
                for (int e = 0; e < 16; ++e) { const float pv = exp2f(s[kb][e] - mn); s[kb][e] = pv; ps += pv; }
            l = l * alpha + ps;
#pragma unroll
            for (int d = 0; d < NDB; ++d)
#pragma unroll
                for (int e = 0; e < 16; ++e) o[d][e] *= alpha;
#pragma unroll
            for (int kb = 0; kb < NKB; ++kb)
#pragma unroll
                for (int s2 = 0; s2 < 2; ++s2) {
                    uint4 pk;
                    pk.x = pack2(s[kb][8 * s2], s[kb][8 * s2 + 1]); pk.y = pack2(s[kb][8 * s2 + 2], s[kb][8 * s2 + 3]);
                    pk.z = pack2(s[kb][8 * s2 + 4], s[kb][8 * s2 + 5]); pk.w = pack2(s[kb][8 * s2 + 6], s[kb][8 * s2 + 7]);
                    const bf16x8 pf = __builtin_bit_cast(bf16x8, pk);
                    const unsigned char* vp = cur + C::KBYTES + (dvh * DVW + r) * C::VSTR + (kb * 32 + s2 * 16 + 8 * h) * 2;
#pragma unroll
                    for (int d = 0; d < NDB; ++d) o[d] = MFMA32(*(const bf16x8*)(vp + d * 32 * C::VSTR), pf, o[d]);
                }
        }
        if (more) lstore(smem + ((t + 1) & 1) * C::STAGE);
        __syncthreads();
    }
    l += __shfl_xor(l, 32);
    const float il = 1.f / l;
#pragma unroll
    for (int d = 0; d < NDB; ++d)
#pragma unroll
        for (int g4 = 0; g4 < 4; ++g4) {
            uint2 w; w.x = pack2(o[d][4 * g4] * il, o[d][4 * g4 + 1] * il); w.y = pack2(o[d][4 * g4 + 2] * il, o[d][4 * g4 + 3] * il);
            src.store(qg * 32 + r, dvh * DVW + d * 32 + 8 * g4 + 4 * h, w);
        }
}
struct SelfSrc {
    const bf16_t *q, *kn, *kr, *vt; bf16_t* mix; int b, hd, bh, q0;
    DI const bf16_t* qrow(int rr) const { return q + ((size_t)bh * 2048 + q0 + rr) * 96; }
    DI uint4 kload(int t, int key, int c) const {
        const int kg = t * 64 + key;
        return c < 8 ? *(const uint4*)(kn + ((size_t)bh * 2048 + kg) * 64 + c * 8) : *(const uint4*)(kr + ((size_t)b * 2048 + kg) * 32 + (c - 8) * 8);
    }
    DI uint4 vload(int t, int dv, int c) const { return *(const uint4*)(vt + ((size_t)bh * 64 + dv) * 2048 + t * 64 + c * 8); }
    DI void store(int rr, int dv, uint2 w) const { *(uint2*)(mix + ((size_t)b * 2048 + q0 + rr) * 1024 + hd * 64 + dv) = w; }
};
struct CrossSrc {
    const bf16_t *qx, *kx, *vxt; bf16_t* ox; int b, hd, q0;
    DI const bf16_t* qrow(int rr) const { return qx + ((size_t)(b * 4 + hd) * 2048 + q0 + rr) * 256; }
    DI uint4 kload(int t, int key, int c) const { return *(const uint4*)(kx + ((size_t)(b * 4 + hd) * 256 + t * 32 + key) * 256 + c * 8); }
    DI uint4 vload(int t, int dv, int c) const { return *(const uint4*)(vxt + ((size_t)(b * 4 + hd) * 256 + dv) * 256 + t * 32 + c * 8); }
    DI void store(int rr, int dv, uint2 w) const { *(uint2*)(ox + ((size_t)b * 2048 + q0 + rr) * 1024 + hd * 256 + dv) = w; }
};
DI void attn_fast(const P& p, int bid, int nb, unsigned char* smem) {
    unsigned char* ws = p.ws;
    const int nround = (2048 + nb - 1) / nb;
    for (int rd = 0; rd < nround; ++rd) {
        const int idx = rd * nb + ((rd & 1) ? (nb - 1 - bid) : bid);
        if (idx >= 2048) continue;
        const int qb = 15 - (idx >> 7), bh = idx & 127;
        SelfSrc s{(const bf16_t*)(ws + QB), (const bf16_t*)(ws + KNB), (const bf16_t*)(ws + KROPE), (const bf16_t*)(ws + VTB), (bf16_t*)(ws + MIX), bh >> 3, bh & 7, bh, qb * 128};
        flash_item<96, 64, 64, 4, 1>(s, 2 * qb + 2, 2, smem);
    }
}
DI void xattn_fast(const P& p, int bid, int nb, unsigned char* smem) {
    unsigned char* ws = p.ws;
    for (int it = bid; it < 2048; it += nb) {
        const int bhd = it >> 5, qt = it & 31;
        CrossSrc s{(const bf16_t*)(ws + QX), (const bf16_t*)(ws + KX), (const bf16_t*)(ws + VXT), (bf16_t*)(ws + OX), bhd >> 2, bhd & 3, qt * 64};
        flash_item<256, 128, 32, 2, 2>(s, 8, 0, smem);
    }
}

constexpr int SSD_XT = 0, SSD_BM = 8192, SSD_CM = SSD_BM + 16384, SSD_BWT = SSD_CM + 16384, SSD_PS = SSD_BWT + 16384, SSD_F = SSD_PS + 16384;
static_assert(SSD_F + 1024 <= GEMM_LDS + 2048 - 16, "ssd LDS");
DI int off256(int row, int el) { return row * 256 + (((el >> 3) ^ (row & 15)) << 4) + ((el & 7) << 1); }
DI int off128(int row, int el) { return row * 128 + (((el >> 3) ^ ((row >> 1) & 7)) << 4) + ((el & 7) << 1); }
DI void ssd_item(const P& p, int bh, unsigned char* smem) {
    unsigned char* ws = p.ws;
    const bf16_t* xa = (const bf16_t*)(ws + XBCA); const float* dtg = (const float*)(ws + DTB); const bf16_t* zg = (const bf16_t*)(ws + ZB);
    bf16_t* mix = (bf16_t*)(ws + MIX);
    int tid0 = threadIdx.x; asm volatile("" : "+v"(tid0));
    const int wave = __builtin_amdgcn_readfirstlane(tid0 >> 6);
    const int b = bh >> 3, hd = bh & 7, g = hd >> 2;
    const int lb = wave >> 1, pb = wave & 1;
    const float a_h = -__expf(p.in[10][hd]), Dh = p.in[11][hd];
    float* F = (float*)(smem + SSD_F);
    __syncthreads();
    for (int i = tid0; i < 16384 / 16; i += 256) *(uint4*)(smem + SSD_PS + i * 16) = make_uint4(0u, 0u, 0u, 0u);
    f32x16 st[2];
#pragma unroll
    for (int i = 0; i < 2; ++i)
#pragma unroll
        for (int e = 0; e < 16; ++e) st[i][e] = 0.f;
    uint4 xr0, xr1, br0, br1, br2, br3, cr0, cr1, cr2, cr3; float dtr = 0.f;
#define SSD_XLD(i) (*(const uint4*)(xa + (t0_ + ((tid + 256 * (i)) >> 3)) * 1024 + hd * 64 + ((tid + 256 * (i)) & 7) * 8))
#define SSD_BLD(i, o) (*(const uint4*)(xa + (t0_ + ((tid + 256 * (i)) >> 4)) * 1024 + (o) + g * 128 + ((tid + 256 * (i)) & 15) * 8))
#define SSD_GLOAD(c_) do { const size_t t0_ = (size_t)b * 2048 + (c_) * 64; xr0 = SSD_XLD(0); xr1 = SSD_XLD(1); \
        br0 = SSD_BLD(0, 512); br1 = SSD_BLD(1, 512); br2 = SSD_BLD(2, 512); br3 = SSD_BLD(3, 512); \
        cr0 = SSD_BLD(0, 768); cr1 = SSD_BLD(1, 768); cr2 = SSD_BLD(2, 768); cr3 = SSD_BLD(3, 768); \
        if (tid < 64) dtr = dtg[(t0_ + tid) * 8 + hd]; } while (0)
    { const int tid = tid0; SSD_GLOAD(0); }
    for (int c = 0; c < 32; ++c) {
        int tid = tid0; asm volatile("" : "+v"(tid));
        const int lane = tid & 63, r = lane & 31, h = lane >> 5;
        const size_t t0 = (size_t)b * 2048 + c * 64;
        if (wave == 0) {
            float v = dtr * a_h;
#pragma unroll
            for (int o = 1; o < 64; o <<= 1) { const float u = __shfl_up(v, o); if (lane >= o) v += u; }
            const float a63 = __shfl(v, 63);
            F[lane] = v; F[64 + lane] = __expf(v); F[128 + lane] = dtr; F[192 + lane] = __expf(a63 - v) * dtr;
        }
        __syncthreads();
#define SSD_XIMG(i, XR) do { const int idx = tid + 256 * (i), l = idx >> 3, p0 = (idx & 7) * 8, lp = perm16(l); \
            const unsigned ww[4] = {XR.x, XR.y, XR.z, XR.w}; \
            _Pragma("unroll") for (int k = 0; k < 4; ++k) { \
                *(bf16_t*)(smem + SSD_XT + off128(p0 + 2 * k, lp)) = (bf16_t)(ww[k] & 0xffffu); \
                *(bf16_t*)(smem + SSD_XT + off128(p0 + 2 * k + 1, lp)) = (bf16_t)(ww[k] >> 16); } } while (0)
#define SSD_BIMG(i, BR, CR) do { const int idx = tid + 256 * (i), l = idx >> 4, n0 = (idx & 15) * 8, lp = perm16(l); \
            *(uint4*)(smem + SSD_BM + off256(l, n0)) = BR; *(uint4*)(smem + SSD_CM + off256(l, n0)) = CR; \
            const float wl = F[192 + l]; const unsigned ww[4] = {BR.x, BR.y, BR.z, BR.w}; \
            _Pragma("unroll") for (int k = 0; k < 4; ++k) { \
                *(bf16_t*)(smem + SSD_BWT + off128(n0 + 2 * k, lp)) = f2bf(bflo(ww[k]) * wl); \
                *(bf16_t*)(smem + SSD_BWT + off128(n0 + 2 * k + 1, lp)) = f2bf(bfhi(ww[k]) * wl); } } while (0)
        SSD_XIMG(0, xr0); SSD_XIMG(1, xr1);
        SSD_BIMG(0, br0, cr0); SSD_BIMG(1, br1, cr1); SSD_BIMG(2, br2, cr2); SSD_BIMG(3, br3, cr3);
        __syncthreads();
        if (c + 1 < 32) SSD_GLOAD(c + 1);
        bf16_t zr[16];
        {
            const bf16_t* zp = zg + (t0 + lb * 32 + 4 * h) * 512 + hd * 64 + pb * 32 + r;
#pragma unroll
            for (int e = 0; e < 16; ++e) zr[e] = zp[(size_t)((e & 3) + 8 * (e >> 2)) * 512];
        }
        f32x16 yd;
#pragma unroll
        for (int e = 0; e < 16; ++e) yd[e] = 0.f;
        const float acs_l = F[lb * 32 + r];
        const int lrow = lb * 32 + r;
        for (int sb = 0; sb <= lb; ++sb) {
            f32x16 cb;
#pragma unroll
            for (int e = 0; e < 16; ++e) cb[e] = 0.f;
#pragma unroll
            for (int ks = 0; ks < 8; ++ks) {
                const bf16x8 av = *(const bf16x8*)(smem + SSD_BM + off256(sb * 32 + r, 16 * ks + 8 * h));
                const bf16x8 bv = *(const bf16x8*)(smem + SSD_CM + off256(lb * 32 + r, 16 * ks + 8 * h));
                cb = MFMA32(av, bv, cb);
            }
            float mv[16];
#pragma unroll
            for (int q4 = 0; q4 < 4; ++q4) {
                const int s0 = sb * 32 + 8 * q4 + 4 * h;
                const float4 as4 = *(const float4*)(F + s0), dt4 = *(const float4*)(F + 128 + s0);
                const float asv[4] = {as4.x, as4.y, as4.z, as4.w}, dtv[4] = {dt4.x, dt4.y, dt4.z, dt4.w};
#pragma unroll
                for (int k = 0; k < 4; ++k) mv[4 * q4 + k] = (s0 + k <= lrow) ? cb[4 * q4 + k] * __expf(acs_l - asv[k]) * dtv[k] : 0.f;
            }
#pragma unroll
            for (int s2 = 0; s2 < 2; ++s2) {
                uint4 pk;
                pk.x = pack2(mv[8 * s2], mv[8 * s2 + 1]); pk.y = pack2(mv[8 * s2 + 2], mv[8 * s2 + 3]);
                pk.z = pack2(mv[8 * s2 + 4], mv[8 * s2 + 5]); pk.w = pack2(mv[8 * s2 + 6], mv[8 * s2 + 7]);
                const bf16x8 xb = *(const bf16x8*)(smem + SSD_XT + off128(pb * 32 + r, sb * 32 + 16 * s2 + 8 * h));
                yd = MFMA32(__builtin_bit_cast(bf16x8, pk), xb, yd);
            }
        }
        f32x16 yo;
#pragma unroll
        for (int e = 0; e < 16; ++e) yo[e] = 0.f;
#pragma unroll
        for (int ks = 0; ks < 8; ++ks) {
            const bf16x8 av = *(const bf16x8*)(smem + SSD_CM + off256(lb * 32 + r, 16 * ks + 8 * h));
            const bf16x8 bv = *(const bf16x8*)(smem + SSD_PS + off256(pb * 32 + r, 16 * ks + 8 * h));
            yo = MFMA32(av, bv, yo);
        }
        {
            const uint4 x0 = *(const uint4*)(smem + SSD_XT + off128(pb * 32 + r, lb * 32 + 8 * h));
            const uint4 x1 = *(const uint4*)(smem + SSD_XT + off128(pb * 32 + r, lb * 32 + 16 + 8 * h));
            const unsigned xw[8] = {x0.x, x0.y, x0.z, x0.w, x1.x, x1.y, x1.z, x1.w};
            bf16_t* op = mix + (t0 + lb * 32 + 4 * h) * 1024 + 512 + hd * 64 + pb * 32 + r;
#pragma unroll
            for (int q4 = 0; q4 < 4; ++q4) {
                const float4 ea4 = *(const float4*)(F + 64 + lb * 32 + 8 * q4 + 4 * h);
                const float eav[4] = {ea4.x, ea4.y, ea4.z, ea4.w};
#pragma unroll
                for (int k = 0; k < 4; ++k) {
                    const int e = 4 * q4 + k;
                    const float xv = (e & 1) ? bfhi(xw[e >> 1]) : bflo(xw[e >> 1]);
                    const float y = yd[e] + eav[k] * yo[e] + Dh * xv;
                    op[(size_t)(k + 8 * q4) * 1024] = f2bf(y * siluf(bf2f(zr[e])));
                }
            }
        }
        {
            const float dec = F[64 + 63];
#pragma unroll
            for (int i = 0; i < 2; ++i) {
#pragma unroll
                for (int e = 0; e < 16; ++e) st[i][e] *= dec;
                const int nblk = 2 * (wave >> 1) + i;
#pragma unroll
                for (int ks = 0; ks < 4; ++ks) {
                    const bf16x8 av = *(const bf16x8*)(smem + SSD_XT + off128(pb * 32 + r, 16 * ks + 8 * h));
                    const bf16x8 bv = *(const bf16x8*)(smem + SSD_BWT + off128(nblk * 32 + r, 16 * ks + 8 * h));
                    st[i] = MFMA32(av, bv, st[i]);
                }
            }
        }
        __syncthreads();
#pragma unroll
        for (int i = 0; i < 2; ++i) {
            const int n = (2 * (wave >> 1) + i) * 32 + r;
#pragma unroll
            for (int e = 0; e < 16; ++e) *(bf16_t*)(smem + SSD_PS + off256(pb * 32 + crow(e, h), n)) = f2bf(st[i][e]);
        }
    }
    __syncthreads();
}

#if ATTN_NAIVE
DI void attn_naive(const P& p, int bid, int nb) {
    unsigned char* ws = p.ws;
    const bf16_t* Q = (const bf16_t*)(ws + QB); const bf16_t* Kn = (const bf16_t*)(ws + KNB); const bf16_t* Vt = (const bf16_t*)(ws + VTB);
    const bf16_t* Kr = (const bf16_t*)(ws + KROPE); bf16_t* mix = (bf16_t*)(ws + MIX);
    for (int item = bid; item < 128 * 8; item += nb) {
        const int bh = item >> 3, s_ = (item & 7) * 256 + threadIdx.x, b = bh >> 3, hd = bh & 7;
        float q[96];
        {
            const uint4* q4 = (const uint4*)(Q + ((size_t)bh * 2048 + s_) * 96);
#pragma unroll
            for (int i = 0; i < 12; ++i) { const uint4 w = q4[i]; q[8 * i] = bflo(w.x); q[8 * i + 1] = bfhi(w.x); q[8 * i + 2] = bflo(w.y); q[8 * i + 3] = bfhi(w.y);
                q[8 * i + 4] = bflo(w.z); q[8 * i + 5] = bfhi(w.z); q[8 * i + 6] = bflo(w.w); q[8 * i + 7] = bfhi(w.w); }
        }
        float o[64];
#pragma unroll
        for (int d = 0; d < 64; ++d) o[d] = 0.f;
        float m = -1e30f, l = 0.f;
        const int nkeys = __builtin_amdgcn_readfirstlane(((s_ >> 6) + 1) * 64);
        for (int j0 = 0; j0 < nkeys; j0 += 8) {
            float sc[8];
#pragma unroll
            for (int jj = 0; jj < 8; ++jj) {
                const int j = j0 + jj;
                const uint4* k4 = (const uint4*)(Kn + ((size_t)bh * 2048 + j) * 64);
                const uint4* r4 = (const uint4*)(Kr + ((size_t)b * 2048 + j) * 32);
                float a = 0.f;
#pragma unroll
                for (int i = 0; i < 8; ++i) { const uint4 w = k4[i]; a += q[8 * i] * bflo(w.x) + q[8 * i + 1] * bfhi(w.x) + q[8 * i + 2] * bflo(w.y) + q[8 * i + 3] * bfhi(w.y)
                    + q[8 * i + 4] * bflo(w.z) + q[8 * i + 5] * bfhi(w.z) + q[8 * i + 6] * bflo(w.w) + q[8 * i + 7] * bfhi(w.w); }
#pragma unroll
                for (int i = 0; i < 4; ++i) { const uint4 w = r4[i]; const int o8 = 64 + 8 * i; a += q[o8] * bflo(w.x) + q[o8 + 1] * bfhi(w.x) + q[o8 + 2] * bflo(w.y) + q[o8 + 3] * bfhi(w.y)
                    + q[o8 + 4] * bflo(w.z) + q[o8 + 5] * bfhi(w.z) + q[o8 + 6] * bflo(w.w) + q[o8 + 7] * bfhi(w.w); }
                sc[jj] = a;
            }
            float mx = m;
#pragma unroll
            for (int jj = 0; jj < 8; ++jj) mx = fmaxf(mx, sc[jj]);
            const float al = exp2f(m - mx);
            float ps = 0.f;
#pragma unroll
            for (int jj = 0; jj < 8; ++jj) { sc[jj] = exp2f(sc[jj] - mx); ps += sc[jj]; }
            l = l * al + ps; m = mx;
#pragma unroll
            for (int d = 0; d < 64; ++d) {
                const uint4 w = *(const uint4*)(Vt + ((size_t)bh * 64 + d) * 2048 + j0);
                o[d] = o[d] * al + sc[0] * bflo(w.x) + sc[1] * bfhi(w.x) + sc[2] * bflo(w.y) + sc[3] * bfhi(w.y) + sc[4] * bflo(w.z) + sc[5] * bfhi(w.z) + sc[6] * bflo(w.w) + sc[7] * bfhi(w.w);
            }
        }
        const float il = 1.f / l;
        bf16_t* dst = mix + ((size_t)b * 2048 + s_) * 1024 + hd * 64;
#pragma unroll
        for (int d = 0; d < 64; d += 2) *(unsigned*)(dst + d) = pack2(o[d] * il, o[d + 1] * il);
    }
}
#endif
#if SSD_NAIVE
DI void ssd_naive(const P& p, int bid, int nb) {
    unsigned char* ws = p.ws;
    const bf16_t* xa = (const bf16_t*)(ws + XBCA); const float* dt = (const float*)(ws + DTB); const bf16_t* z = (const bf16_t*)(ws + ZB);
    bf16_t* mix = (bf16_t*)(ws + MIX);
    const int wave = threadIdx.x >> 6, pp = threadIdx.x & 63;
    for (int item = bid; item < 32; item += nb) {
        const int bh = item * 4 + wave, b = bh >> 3, hd = bh & 7, g = hd >> 2;
        const float a = -__expf(p.in[10][hd]), Dh = p.in[11][hd];
        float st[128];
#pragma unroll
        for (int n = 0; n < 128; ++n) st[n] = 0.f;
        for (int t = 0; t < 2048; ++t) {
            const size_t row = (size_t)b * 2048 + t;
            const float dtv = dt[row * 8 + hd];
            const float da = __expf(dtv * a);
            const float xv = bf2f(xa[row * 1024 + hd * 64 + pp]);
            const float xd = dtv * xv;
            const uint4* b4 = (const uint4*)(xa + row * 1024 + 512 + g * 128);
            const uint4* c4 = (const uint4*)(xa + row * 1024 + 768 + g * 128);
            float y = 0.f;
#pragma unroll
            for (int i = 0; i < 16; ++i) {
                const uint4 bw = b4[i], cw = c4[i];
                const unsigned bb[4] = {bw.x, bw.y, bw.z, bw.w}, cc[4] = {cw.x, cw.y, cw.z, cw.w};
#pragma unroll
                for (int k = 0; k < 4; ++k) {
                    const int n = 8 * i + 2 * k;
                    st[n] = da * st[n] + xd * bflo(bb[k]); y += bflo(cc[k]) * st[n];
                    st[n + 1] = da * st[n + 1] + xd * bfhi(bb[k]); y += bfhi(cc[k]) * st[n + 1];
                }
            }
            y += Dh * xv;
            const float zv = bf2f(z[row * 512 + hd * 64 + pp]);
            mix[row * 1024 + 512 + hd * 64 + pp] = f2bf(y * siluf(zv));
        }
    }
}
#endif
DI void phase_mixer(const P& p, int bid, int nb, unsigned char* smem) {
#if SSD_NAIVE
    ssd_naive(p, bid, nb);
    attn_fast(p, bid, nb, smem);
#else
    unsigned* ctr = (unsigned*)(p.ws + CTL + CTL_CNT + 256);
    int* slot = (int*)(smem + GEMM_LDS + 2048 - 32);
    for (;;) {
        __syncthreads();
        if (threadIdx.x == 0) *slot = (int)atomicAdd(ctr, 1u);
        __syncthreads();
        const int it = *slot;
        if (it >= 128 + 2048) break;
        if (it < 128) { if (!NO_SSD) ssd_item(p, it, smem); }
        else {
            const int idx = it - 128, qb = 15 - (idx >> 7), bh = idx & 127;
            unsigned char* ws = p.ws;
            SelfSrc s{(const bf16_t*)(ws + QB), (const bf16_t*)(ws + KNB), (const bf16_t*)(ws + KROPE), (const bf16_t*)(ws + VTB), (bf16_t*)(ws + MIX), bh >> 3, bh & 7, bh, qb * 128};
            if (!NO_FLASH) flash_item<96, 64, 64, 4, 1>(s, 2 * qb + 2, 2, smem);
        }
    }
#endif
}

DI void phase_ssdnorm(const P& p, int bid, int nb, unsigned char* smem) {
    bf16_t* mix = (bf16_t*)(p.ws + MIX);
    const int lane = threadIdx.x & 63, wave = threadIdx.x >> 6;
    for (int tk = bid * 4 + wave; tk < T; tk += nb * 4) {
        uint4* ptr = (uint4*)(mix + (size_t)tk * 1024 + 512 + lane * 8);
        const uint4 w = *ptr;
        const unsigned ww[4] = {w.x, w.y, w.z, w.w};
        float v[8]; float ss = 0.f;
#pragma unroll
        for (int k = 0; k < 4; ++k) { v[2 * k] = bflo(ww[k]); v[2 * k + 1] = bfhi(ww[k]); ss += v[2 * k] * v[2 * k] + v[2 * k + 1] * v[2 * k + 1]; }
#pragma unroll
        for (int o = 16; o >= 1; o >>= 1) ss += __shfl_xor(ss, o);
        const float rr = rsqrtf(ss * (1.f / 256.f) + EPS);
        uint4 o4; o4.x = pack2(v[0] * rr, v[1] * rr); o4.y = pack2(v[2] * rr, v[3] * rr); o4.z = pack2(v[4] * rr, v[5] * rr); o4.w = pack2(v[6] * rr, v[7] * rr);
        *ptr = o4;
    }
}

struct EpiResid {
    float* pre; const float* res;
    DI void operator()(const f32x16 (&acc)[2][2], int rb, int cb, int lane) const {
        const int r = lane & 31, h = lane >> 5;
#pragma unroll
        for (int i = 0; i < 2; ++i)
#pragma unroll
            for (int j = 0; j < 2; ++j) {
                const int col = cb + j * 32 + r;
#pragma unroll
                for (int e = 0; e < 16; ++e) {
                    const size_t idx = (size_t)(rb + i * 32 + crow(e, h)) * 1024 + col;
                    pre[idx] = ALPHA * res[idx] + acc[i][j][e];
                }
            }
    }
};
DI void phase_wout(const P& p, int bid, int nb, unsigned char* smem) {
    const int v = vbid(bid, nb);
    EpiResid e{p.out, p.in[0]};
    GemmArgs g{(const bf16_t*)(p.ws + MIX), 1024, (const bf16_t*)(p.ws + W_OUT), 1024, 1024, nullptr};
    for (int t = v; t < 256 * 8; t += nb) gemm_tile(g, (t >> 3) * 128, (t & 7) * 128, e, smem);
}
DI void ln_row(const float* src, const float* gam, const float* bet, int lane, float (&o)[16]) {
    float v[16];
#pragma unroll
    for (int i = 0; i < 4; ++i) { const float4 t4 = *(const float4*)(src + i * 256 + lane * 4); v[4 * i] = t4.x; v[4 * i + 1] = t4.y; v[4 * i + 2] = t4.z; v[4 * i + 3] = t4.w; }
    float s = 0.f;
#pragma unroll
    for (int i = 0; i < 16; ++i) s += v[i];
    const float mu = wave_sum(s) * (1.f / 1024.f);
    float q = 0.f;
#pragma unroll
    for (int i = 0; i < 16; ++i) { const float d = v[i] - mu; q += d * d; }
    const float rstd = rsqrtf(wave_sum(q) * (1.f / 1024.f) + EPS);
#pragma unroll
    for (int i = 0; i < 4; ++i) {
        const float4 g4 = *(const float4*)(gam + i * 256 + lane * 4), b4 = *(const float4*)(bet + i * 256 + lane * 4);
        o[4 * i] = (v[4 * i] - mu) * rstd * g4.x + b4.x; o[4 * i + 1] = (v[4 * i + 1] - mu) * rstd * g4.y + b4.y;
        o[4 * i + 2] = (v[4 * i + 2] - mu) * rstd * g4.z + b4.z; o[4 * i + 3] = (v[4 * i + 3] - mu) * rstd * g4.w + b4.w;
    }
}
DI void phase_ln1(const P& p, int bid, int nb, unsigned char* smem) {
    const int lane = threadIdx.x & 63, wave = threadIdx.x >> 6;
    float* hf = (float*)(p.ws + H1); bf16_t* hb = (bf16_t*)(p.ws + H1B);
    for (int tk = bid * 4 + wave; tk < T; tk += nb * 4) {
        float o[16];
        ln_row(p.out + (size_t)tk * 1024, p.in[14], p.in[15], lane, o);
#pragma unroll
        for (int i = 0; i < 4; ++i) {
            *(float4*)(hf + (size_t)tk * 1024 + i * 256 + lane * 4) = make_float4(o[4 * i], o[4 * i + 1], o[4 * i + 2], o[4 * i + 3]);
            uint2 w; w.x = pack2(o[4 * i], o[4 * i + 1]); w.y = pack2(o[4 * i + 2], o[4 * i + 3]);
            *(uint2*)(hb + (size_t)tk * 1024 + i * 256 + lane * 4) = w;
        }
    }
}
struct EpiXq {
    bf16_t* qx;
    DI void operator()(const f32x16 (&acc)[2][2], int rb, int cb, int lane) const {
        const int r = lane & 31, h = lane >> 5;
#pragma unroll
        for (int i = 0; i < 2; ++i)
#pragma unroll
            for (int j = 0; j < 2; ++j) {
                const int col = cb + j * 32 + r, hd = col >> 8, d = col & 255;
#pragma unroll
                for (int e = 0; e < 16; ++e) {
                    const int row = rb + i * 32 + crow(e, h), b = row >> 11, s_ = row & 2047;
                    qx[((size_t)(b * 4 + hd) * 2048 + s_) * 256 + d] = f2bf(acc[i][j][e] * XSCALE);
                }
            }
    }
};
DI void phase_xq(const P& p, int bid, int nb, unsigned char* smem) {
    const int v = vbid(bid, nb);
    EpiXq e{(bf16_t*)(p.ws + QX)};
    GemmArgs g{(const bf16_t*)(p.ws + H1B), 1024, (const bf16_t*)(p.ws + W_XQ), 1024, 1024, nullptr};
    for (int t = v; t < 256 * 8; t += nb) gemm_tile(g, (t >> 3) * 128, (t & 7) * 128, e, smem);
}
DI void phase_xattn(const P& p, int bid, int nb, unsigned char* smem) {
#if !XATTN_NAIVE
    xattn_fast(p, bid, nb, smem); return;
#endif
    unsigned char* ws = p.ws;
    const bf16_t* qx = (const bf16_t*)(ws + QX); const bf16_t* kx = (const bf16_t*)(ws + KX); const bf16_t* vxt = (const bf16_t*)(ws + VXT);
    bf16_t* ox = (bf16_t*)(ws + OX);
    const int lane = threadIdx.x & 63, hd = threadIdx.x >> 6;
    float* qs = (float*)smem + hd * 512; float* ps = qs + 256;
    for (int tk = bid; tk < T; tk += nb) {
        const int b = tk >> 11, s_ = tk & 2047;
        __syncthreads();
        {
            const uint2 w = *(const uint2*)(qx + ((size_t)(b * 4 + hd) * 2048 + s_) * 256 + lane * 4);
            qs[lane * 4] = bflo(w.x); qs[lane * 4 + 1] = bfhi(w.x); qs[lane * 4 + 2] = bflo(w.y); qs[lane * 4 + 3] = bfhi(w.y);
        }
        __syncthreads();
        float sc[4];
#pragma unroll
        for (int i = 0; i < 4; ++i) {
            const int m = lane + 64 * i;
            const uint4* k4 = (const uint4*)(kx + ((size_t)(b * 4 + hd) * 256 + m) * 256);
            float a = 0.f;
#pragma unroll 8
            for (int c = 0; c < 32; ++c) {
                const uint4 w = k4[c];
                const float4 q0 = *(const float4*)(qs + 8 * c), q1 = *(const float4*)(qs + 8 * c + 4);
                a += q0.x * bflo(w.x) + q0.y * bfhi(w.x) + q0.z * bflo(w.y) + q0.w * bfhi(w.y) + q1.x * bflo(w.z) + q1.y * bfhi(w.z) + q1.z * bflo(w.w) + q1.w * bfhi(w.w);
            }
            sc[i] = a;
        }
        const float mx = wave_max(fmaxf(fmaxf(sc[0], sc[1]), fmaxf(sc[2], sc[3])));
        float sum = 0.f;
#pragma unroll
        for (int i = 0; i < 4; ++i) { sc[i] = exp2f(sc[i] - mx); sum += sc[i]; }
        const float il = 1.f / wave_sum(sum);
#pragma unroll
        for (int i = 0; i < 4; ++i) ps[lane + 64 * i] = sc[i] * il;
        __syncthreads();
        float o[4];
#pragma unroll
        for (int dd = 0; dd < 4; ++dd) {
            const int d = lane * 4 + dd;
            const uint4* v4 = (const uint4*)(vxt + ((size_t)(b * 4 + hd) * 256 + d) * 256);
            float a = 0.f;
#pragma unroll 8
            for (int c = 0; c < 32; ++c) {
                const uint4 w = v4[c];
                const float4 q0 = *(const float4*)(ps + 8 * c), q1 = *(const float4*)(ps + 8 * c + 4);
                a += q0.x * bflo(w.x) + q0.y * bfhi(w.x) + q0.z * bflo(w.y) + q0.w * bfhi(w.y) + q1.x * bflo(w.z) + q1.y * bfhi(w.z) + q1.z * bflo(w.w) + q1.w * bfhi(w.w);
            }
            o[dd] = a;
        }
        uint2 w; w.x = pack2(o[0], o[1]); w.y = pack2(o[2], o[3]);
        *(uint2*)(ox + (size_t)tk * 1024 + hd * 256 + lane * 4) = w;
    }
}
DI void phase_xo(const P& p, int bid, int nb, unsigned char* smem) {
    const int v = vbid(bid, nb);
    EpiResid e{p.out, (const float*)(p.ws + H1)};
    GemmArgs g{(const bf16_t*)(p.ws + OX), 1024, (const bf16_t*)(p.ws + W_XO), 1024, 1024, nullptr};
    for (int t = v; t < 256 * 8; t += nb) gemm_tile(g, (t >> 3) * 128, (t & 7) * 128, e, smem);
}
DI void phase_ln2_router(const P& p, int bid, int nb, unsigned char* smem) {
    unsigned char* ws = p.ws;
    const int lane = threadIdx.x & 63, wave = threadIdx.x >> 6;
    float* hf = (float*)(ws + H2); bf16_t* hb = (bf16_t*)(ws + H2B);
    const float* wrt = (const float*)(ws + W_RT);
    unsigned* cnt = (unsigned*)(ws + CTL + CTL_CNT); int* lists = (int*)(ws + LISTS); float* tgate = (float*)(ws + TOK_GATE);
    for (int tk = bid * 4 + wave; tk < T; tk += nb * 4) {
        float o[16];
        ln_row(p.out + (size_t)tk * 1024, p.in[20], p.in[21], lane, o);
#pragma unroll
        for (int i = 0; i < 4; ++i) {
            *(float4*)(hf + (size_t)tk * 1024 + i * 256 + lane * 4) = make_float4(o[4 * i], o[4 * i + 1], o[4 * i + 2], o[4 * i + 3]);
            uint2 w; w.x = pack2(o[4 * i], o[4 * i + 1]); w.y = pack2(o[4 * i + 2], o[4 * i + 3]);
            *(uint2*)(hb + (size_t)tk * 1024 + i * 256 + lane * 4) = w;
        }
        float* lg = (float*)smem + wave * 64;
#pragma unroll 1
        for (int j = 0; j < 36; ++j) {
            float a = 0.f;
#pragma unroll
            for (int i = 0; i < 4; ++i) {
                const float4 w4 = *(const float4*)(wrt + j * 1024 + i * 256 + lane * 4);
                a += o[4 * i] * w4.x + o[4 * i + 1] * w4.y + o[4 * i + 2] * w4.z + o[4 * i + 3] * w4.w;
            }
            a = wave_sum(a);
            if (lane == 0) lg[j] = a;
        }
        __builtin_amdgcn_wave_barrier();
        float gl[4], el[32];
#pragma unroll
        for (int j = 0; j < 4; ++j) gl[j] = lg[j] + p.in[23][j];
#pragma unroll
        for (int j = 0; j < 32; ++j) el[j] = lg[4 + j] + p.in[25][j];
        __builtin_amdgcn_wave_barrier();
        int gi = 0; float gm = gl[0];
#pragma unroll
        for (int j = 1; j < 4; ++j) if (gl[j] > gm) { gm = gl[j]; gi = j; }
        float gs = 0.f;
#pragma unroll
        for (int j = 0; j < 4; ++j) gs += __expf(gl[j] - gm);
        const float ggate = 1.f / gs;
        float ev[8];
#pragma unroll
        for (int j = 0; j < 8; ++j) ev[j] = gi == 0 ? el[j] : gi == 1 ? el[8 + j] : gi == 2 ? el[16 + j] : el[24 + j];
        int i1 = 0; float v1 = ev[0];
#pragma unroll
        for (int j = 1; j < 8; ++j) if (ev[j] > v1) { v1 = ev[j]; i1 = j; }
        int i2 = -1; float v2 = -3.0e38f;
#pragma unroll
        for (int j = 0; j < 8; ++j) if (j != i1 && ev[j] > v2) { v2 = ev[j]; i2 = j; }
        const float e2 = __expf(v2 - v1);
        const float g1 = ggate / (1.f + e2), g2 = ggate * e2 / (1.f + e2);
        if (lane == 0) {
            const int ex1 = gi * 8 + i1, ex2 = gi * 8 + i2;
            const unsigned p1 = atomicAdd(&cnt[ex1], 1u); lists[(size_t)ex1 * T + p1] = tk * 2;
            const unsigned p2 = atomicAdd(&cnt[ex2], 1u); lists[(size_t)ex2 * T + p2] = tk * 2 + 1;
            tgate[tk * 2] = g1; tgate[tk * 2 + 1] = g2;
        }
    }
}
struct MoeMap { int off[33]; };
DI int moe_tiles(const unsigned* cnt, int* offs  ) {
    __syncthreads();
    if (threadIdx.x == 0) { int o = 0; for (int e = 0; e < 32; ++e) { offs[e] = o; o += (((int)cnt[e] + 127) >> 7) << 7; } offs[32] = o; }
    __syncthreads();
    return offs[32] >> 7;
}
struct EpiGU {
    bf16_t* hdn;
    DI void operator()(const f32x16 (&acc)[2][2], int rb, int cb, int lane) const {
        const int r = lane & 31, h = lane >> 5;
        const int hc = ((cb & 511) >> 7) * 64 + ((cb >> 6) & 1) * 32 + r;
#pragma unroll
        for (int i = 0; i < 2; ++i)
#pragma unroll
            for (int e = 0; e < 16; ++e) {
                const int slot = rb + i * 32 + crow(e, h);
                hdn[(size_t)slot * 256 + hc] = f2bf(siluf(acc[i][0][e]) * acc[i][1][e]);
            }
    }
};
struct EpiDown {
    bf16_t* y; const int* ltok; const float* lgate; int m0;
    DI void operator()(const f32x16 (&acc)[2][2], int rb, int cb, int lane) const {
        const int r = lane & 31, h = lane >> 5;
#pragma unroll
        for (int i = 0; i < 2; ++i)
#pragma unroll
            for (int e = 0; e < 16; ++e) {
                const int lr = rb - m0 + i * 32 + crow(e, h);
                const int tk2 = ltok[lr];
                if (tk2 >= 0) {
                    const float gt = lgate[lr];
#pragma unroll
                    for (int j = 0; j < 2; ++j) y[(size_t)tk2 * 1024 + cb + j * 32 + r] = f2bf(gt * acc[i][j][e]);
                }
            }
    }
};
template <int WHICH>
DI void phase_moe(const P& p, int bid, int nb, unsigned char* smem) {
    unsigned char* ws = p.ws;
    const unsigned* cnt = (const unsigned*)(ws + CTL + CTL_CNT); const int* lists = (const int*)(ws + LISTS); const float* tgate = (const float*)(ws + TOK_GATE);
    int* offs = (int*)(smem + GEMM_LDS); int* ltok = offs + 64; int* lrow = ltok + 128; float* lgate = (float*)(lrow + 128);
    const int nmt = moe_tiles(cnt, offs);
    constexpr int NNT = WHICH == 0 ? 4 : 8;
    const int v = vbid(bid, nb);
    for (int t = v; t < nmt * NNT; t += nb) {
        const int mt = t / NNT, ntl = t % NNT;
        const int slot0 = mt * 128;
        int e = 0;
        while (offs[e + 1] <= slot0) ++e;
        __syncthreads();
        if (threadIdx.x < 128) {
            const int pos = slot0 - offs[e] + threadIdx.x;
            const int tk2 = pos < (int)cnt[e] ? lists[(size_t)e * T + pos] : -1;
            ltok[threadIdx.x] = tk2; lrow[threadIdx.x] = tk2 < 0 ? 0 : (tk2 >> 1); lgate[threadIdx.x] = tk2 < 0 ? 0.f : tgate[tk2];
        }
        __syncthreads();
        if (WHICH == 0) {
            EpiGU ep{(bf16_t*)(ws + HDN)};
            GemmArgs g{(const bf16_t*)(ws + H2B), 1024, (const bf16_t*)(ws + W_GU) + (size_t)e * 512 * 1024, 1024, 1024, lrow};
            gemm_tile(g, slot0, ntl * 128, ep, smem);
        } else {
            EpiDown ep{(bf16_t*)(ws + YB), ltok, lgate, slot0};
            GemmArgs g{(const bf16_t*)(ws + HDN), 256, (const bf16_t*)(ws + W_DN) + (size_t)e * 1024 * 256, 256, 256, nullptr};
            gemm_tile(g, slot0, ntl * 128, ep, smem);
        }
    }
}
DI void phase_final(const P& p, int bid, int nb, unsigned char* smem) {
    const int lane = threadIdx.x & 63, wave = threadIdx.x >> 6;
    const float* hf = (const float*)(p.ws + H2); const bf16_t* y = (const bf16_t*)(p.ws + YB);
    const float* gam = p.in[29]; const float* bet = p.in[30];
    for (int tk = bid * 4 + wave; tk < T; tk += nb * 4) {
        float v[16];
#pragma unroll
        for (int i = 0; i < 4; ++i) {
            const float4 t4 = *(const float4*)(hf + (size_t)tk * 1024 + i * 256 + lane * 4);
            const uint2 a = *(const uint2*)(y + (size_t)(tk * 2) * 1024 + i * 256 + lane * 4), b = *(const uint2*)(y + (size_t)(tk * 2 + 1) * 1024 + i * 256 + lane * 4);
            v[4 * i] = ALPHA * t4.x + bflo(a.x) + bflo(b.x); v[4 * i + 1] = ALPHA * t4.y + bfhi(a.x) + bfhi(b.x);
            v[4 * i + 2] = ALPHA * t4.z + bflo(a.y) + bflo(b.y); v[4 * i + 3] = ALPHA * t4.w + bfhi(a.y) + bfhi(b.y);
        }
        float s = 0.f;
#pragma unroll
        for (int i = 0; i < 16; ++i) s += v[i];
        const float mu = wave_sum(s) * (1.f / 1024.f);
        float q = 0.f;
#pragma unroll
        for (int i = 0; i < 16; ++i) { const float d = v[i] - mu; q += d * d; }
        const float rstd = rsqrtf(wave_sum(q) * (1.f / 1024.f) + EPS);
#pragma unroll
        for (int i = 0; i < 4; ++i) {
            const float4 g4 = *(const float4*)(gam + i * 256 + lane * 4), b4 = *(const float4*)(bet + i * 256 + lane * 4);
            *(float4*)(p.out + (size_t)tk * 1024 + i * 256 + lane * 4) = make_float4((v[4 * i] - mu) * rstd * g4.x + b4.x, (v[4 * i + 1] - mu) * rstd * g4.y + b4.y,
                                                                                    (v[4 * i + 2] - mu) * rstd * g4.z + b4.z, (v[4 * i + 3] - mu) * rstd * g4.w + b4.w);
        }
    }
}

#define XB_TMO      128
#define XB_XCNT(j)  (256  + 64 * (j))
#define XB_XSUB(j)  (1280 + 64 * (j))
#define XB_XGEN(j)  (2304 + 64 * (j))
#define XB_TOP      3328
#define XB_TOPGEN   3392
#define XCD_BAR_WORDS 3456
#define XB_SPIN_CAP (1u << 25)
#define LAS __attribute__((address_space(3)))
DI unsigned xb_ld(unsigned* p) { return __hip_atomic_load(p, __ATOMIC_RELAXED, __HIP_MEMORY_SCOPE_AGENT); }
DI unsigned xb_add(unsigned* p, unsigned v) { return __hip_atomic_fetch_add(p, v, __ATOMIC_RELAXED, __HIP_MEMORY_SCOPE_AGENT); }
DI unsigned xb_xcc_id() { return (unsigned)__builtin_amdgcn_s_getreg((3 << 11) | 20) & 0xFu; }
#define XB_SPIN(cond, bar) do { unsigned _sp = 0; while (cond) { __builtin_amdgcn_s_sleep(1); \
    if ((++_sp & 255u) == 0u) { if (xb_ld(&(bar)[XB_TMO])) break; if (_sp > XB_SPIN_CAP) { atomicAdd(&(bar)[XB_TMO], 1u); break; } } } } while (0)
struct XcdBarrier { unsigned* bar; unsigned x; volatile LAS unsigned* st; };
DI XcdBarrier xcd_barrier_post(unsigned* bar, volatile LAS unsigned* st) {
    XcdBarrier b; b.bar = bar; b.x = xb_xcc_id(); b.st = st;
    if (threadIdx.x == 0) (void)xb_add(&bar[XB_XCNT(b.x)], 1u);
    return b;
}
DI void xcd_barrier_complete(unsigned* bar, unsigned x, unsigned& nloc, unsigned& nx) {
    const unsigned G = gridDim.x * gridDim.y * gridDim.z;
    unsigned sum, cnt, mine, sp = 0u;
    for (;;) {
        sum = 0u; cnt = 0u; mine = 0u;
#pragma unroll
        for (unsigned j = 0; j < 16; ++j) { const unsigned c = xb_ld(&bar[XB_XCNT(j)]); sum += c; cnt += (c > 0u) ? 1u : 0u; mine = (j == x) ? c : mine; }
        if (sum == G) break;
        __builtin_amdgcn_s_sleep(1);
        if ((++sp & 255u) == 0u) { if (xb_ld(&bar[XB_TMO])) break; if (sp > XB_SPIN_CAP) { atomicAdd(&bar[XB_TMO], 1u); break; } }
    }
    nloc = mine > 0u ? mine : 1u; nx = cnt > 0u ? cnt : 1u;
}
DI void xcd_barrier(const XcdBarrier& b) {
    asm volatile("s_waitcnt vmcnt(0)" ::: "memory");
    __syncthreads();
    if (threadIdx.x == 0) {
        unsigned* bar = b.bar;
        __builtin_amdgcn_s_waitcnt(0);
        unsigned nloc = b.st[0], nx = b.st[1];
        if (nloc == 0u) { xcd_barrier_complete(bar, b.x, nloc, nx); b.st[0] = nloc; b.st[1] = nx; }
        const unsigned old = xb_add(&bar[XB_XSUB(b.x)], 1u);
        const unsigned gen = old / nloc;
        if (old + 1u == (gen + 1u) * nloc) {
            __builtin_amdgcn_fence(__ATOMIC_RELEASE, "agent");
            asm volatile("s_waitcnt vmcnt(0)" ::: "memory");
            const unsigned og = xb_add(&bar[XB_TOP], 1u);
            const unsigned tg = og / nx;
            if (og + 1u == (tg + 1u) * nx) xb_add(&bar[XB_TOPGEN], 1u);
            else XB_SPIN(xb_ld(&bar[XB_TOPGEN]) == tg, bar);
            __builtin_amdgcn_fence(__ATOMIC_ACQUIRE, "agent");
            xb_add(&bar[XB_XGEN(b.x)], 1u);
            asm volatile("s_waitcnt vmcnt(0)" ::: "memory");
        } else {
            XB_SPIN(xb_ld(&bar[XB_XGEN(b.x)]) == gen, bar);
            __builtin_amdgcn_fence(__ATOMIC_ACQUIRE, "agent");
            asm volatile("s_waitcnt vmcnt(0)" ::: "memory");
        }
    }
    __syncthreads();
}

constexpr int NPHASE = 14;
template <int PH>
DI void run_phase(const P& p, int bid, int nb, unsigned char* smem) {
    if (PH == 0) phase_prep(p, bid, nb, smem);
    else if (PH == 1) phase_proj(p, bid, nb, smem);
    else if (PH == 2) phase_up(p, bid, nb, smem);
    else if (PH == 3) phase_mixer(p, bid, nb, smem);
    else if (PH == 4) phase_ssdnorm(p, bid, nb, smem);
    else if (PH == 5) phase_wout(p, bid, nb, smem);
    else if (PH == 6) phase_ln1(p, bid, nb, smem);
    else if (PH == 7) phase_xq(p, bid, nb, smem);
    else if (PH == 8) phase_xattn(p, bid, nb, smem);
    else if (PH == 9) phase_xo(p, bid, nb, smem);
    else if (PH == 10) phase_ln2_router(p, bid, nb, smem);
    else if (PH == 11) phase_moe<0>(p, bid, nb, smem);
    else if (PH == 12) phase_moe<1>(p, bid, nb, smem);
    else if (PH == 13) phase_final(p, bid, nb, smem);
}
template <int PH>
__global__ void __launch_bounds__(256, 2) k_phase(P p) {
    __shared__ __attribute__((aligned(16))) unsigned char smem[SMEM_BYTES];
    run_phase<PH>(p, blockIdx.x, gridDim.x, smem);
}

#if MEGA
#ifndef MEGA_WAVES
#define MEGA_WAVES 2
#endif
template <int PH>
DI void mega_steps(const P& p, const XcdBarrier& bar, unsigned char* smem) {
    run_phase<PH>(p, blockIdx.x, gridDim.x, smem);
    if constexpr (PH + 1 < NPHASE) { xcd_barrier(bar); mega_steps<PH + 1>(p, bar, smem); }
}
__global__ void __launch_bounds__(256, MEGA_WAVES) k_mega(P p) {
    __shared__ __attribute__((aligned(16))) unsigned char smem[SMEM_BYTES];
    volatile LAS unsigned* st = (volatile LAS unsigned*)(smem + SMEM_BYTES - 16);
    if (threadIdx.x < 4) st[threadIdx.x] = 0u;
    __syncthreads();
    const XcdBarrier bar = xcd_barrier_post((unsigned*)(p.ws + CTL), st);
    mega_steps<0>(p, bar, smem);
}
#endif
template <int PH>
__global__ void __launch_bounds__(256, 1) k_phase_big(P p) {
    __shared__ __attribute__((aligned(16))) unsigned char smem[SMEM_BYTES];
    run_phase<PH>(p, blockIdx.x, gridDim.x, smem);
}
template <int PH>
static void launch_phase(const P& p, int grid, hipStream_t st) {
    if constexpr (PH == 3 && !P3_SMALL) hipLaunchKernelGGL((k_phase_big<PH>), dim3(grid), dim3(256), 0, st, p);
    else hipLaunchKernelGGL((k_phase<PH>), dim3(grid), dim3(256), 0, st, p);
}

extern "C" void kernel_launch(void* const* d_in, const int* in_sizes, int n_in, void* d_out, int out_size, void* d_ws, size_t ws_size, hipStream_t stream) {
    if (n_in != 31 || out_size != T * D || ws_size < WS_NEED) {
        fprintf(stderr, "kernel_launch: unexpected shapes: n_in %d out %d ws %zu (need %zu)\n", n_in, out_size, ws_size, (size_t)WS_NEED);
        return;
    }
    P p{};
    for (int i = 0; i < 31; ++i) p.in[i] = (const float*)d_in[i];
    p.out = (float*)d_out; p.ws = (unsigned char*)d_ws;
    (void)hipMemsetAsync((unsigned char*)d_ws + CTL, 0, CTL_BYTES, stream);
#if MEGA
    static int grid = 0;
    if (grid == 0) {
        int dev = 0, cus = 0, per_cu = 0;
        (void)hipGetDevice(&dev);
        (void)hipDeviceGetAttribute(&cus, hipDeviceAttributeMultiprocessorCount, dev);
        if (hipOccupancyMaxActiveBlocksPerMultiprocessor(&per_cu, (const void*)k_mega, 256, 0) != hipSuccess || per_cu < 1) { fprintf(stderr, "kernel_launch: occupancy query failed\n"); per_cu = 1; }
        if (per_cu > 2) per_cu = 2;
        grid = cus * per_cu;
        fprintf(stderr, "kernel_launch: mega grid %d (%d CUs x %d)\n", grid, cus, per_cu);
    }
    void* args[] = {(void*)&p};
    const hipError_t le = hipLaunchCooperativeKernel((const void*)k_mega, dim3(grid), dim3(256), args, 0, stream);
    if (le != hipSuccess) fprintf(stderr, "kernel_launch: cooperative launch failed: %s (grid %d)\n", hipGetErrorString(le), grid);
#else
    const int grid = 1024;
    launch_phase<0>(p, grid, stream); launch_phase<1>(p, grid, stream); launch_phase<2>(p, grid, stream); launch_phase<3>(p, grid, stream);
    launch_phase<4>(p, grid, stream); launch_phase<5>(p, grid, stream); launch_phase<6>(p, grid, stream); launch_phase<7>(p, grid, stream);
    launch_phase<8>(p, grid, stream); launch_phase<9>(p, grid, stream); launch_phase<10>(p, grid, stream); launch_phase<11>(p, grid, stream);
    launch_phase<12>(p, grid, stream); launch_phase<13>(p, grid, stream);
#endif
}
```

```cpp
#include <hip/hip_runtime.h>
#include <stdint.h>
#include <stdio.h>

#ifndef MEGA
#define MEGA 1
#endif
#ifndef ATTN_NAIVE
#define ATTN_NAIVE 0
#endif
#ifndef XATTN_NAIVE
#define XATTN_NAIVE 0
#endif
#ifndef SSD_NAIVE
#define SSD_NAIVE 0
#endif
#ifndef P3_SMALL
#define P3_SMALL 1
#endif
#ifndef NO_SSD
#define NO_SSD 0
#endif
#ifndef NO_FLASH
#define NO_FLASH 0
#endif
#ifndef GEMM_GLDS
#define GEMM_GLDS 1
#endif
#ifndef REPEAT_MASK
#define REPEAT_MASK 0
#endif
#ifndef GEMM_DIRECT
#define GEMM_DIRECT 0
#endif

typedef unsigned short bf16_t;
typedef short bf16x8 __attribute__((ext_vector_type(8)));
typedef float f32x16 __attribute__((ext_vector_type(16)));
#define DI __device__ __forceinline__
#define LAS __attribute__((address_space(3)))
#define MFMA32(a, b, c) __builtin_amdgcn_mfma_f32_32x32x16_bf16((a), (b), (c), 0, 0, 0)

constexpr int Bn = 16, S = 2048, T = Bn * S, D = 1024;
constexpr int NMEM = 256;
constexpr float EPS = 1e-5f;
constexpr float ALPHA = 1.189207115002721f;
constexpr float LOG2E = 1.4426950408889634f;
constexpr float QSCALE = 0.10206207261596577f * LOG2E;
constexpr float XSCALE = 0.0625f * LOG2E;
constexpr int NEXP = 32;
constexpr int MAXSLOTS = 69632;

constexpr size_t MiB = 1u << 20;
constexpr size_t W_IN = 0;
constexpr size_t W_QUP = W_IN + 4 * MiB;
constexpr size_t W_KVUP = W_QUP + 768 * 256 * 2;
constexpr size_t W_OUT = W_KVUP + 1024 * 128 * 2;
constexpr size_t W_XQ = W_OUT + 2 * MiB;
constexpr size_t W_XKV = W_XQ + 2 * MiB;
constexpr size_t W_XO = W_XKV + 4 * MiB;
constexpr size_t W_GU = W_XO + 2 * MiB;
constexpr size_t W_DN = W_GU + 32 * MiB;
constexpr size_t W_RT = W_DN + 16 * MiB;
constexpr size_t ROPE_C = W_RT + 48 * 1024 * 4;
constexpr size_t ROPE_S = ROPE_C + 2048 * 16 * 4;
constexpr size_t TOK_GATE = ROPE_S + 2048 * 16 * 4;
constexpr size_t CTL = TOK_GATE + (size_t)T * 2 * 4;
constexpr size_t CTL_BYTES = 32768;
constexpr size_t CTL_CNT = 16384;
static_assert(CTL + CTL_BYTES <= 64 * MiB, "weights region overflow");
constexpr size_t RA = 64 * MiB, RB = 192 * MiB, RC = 320 * MiB, RD = 448 * MiB, WS_NEED = 512 * MiB;
constexpr size_t XBC = RA;
constexpr size_t KX = RA + 64 * MiB;
constexpr size_t VXT = KX + 8 * MiB;
constexpr size_t YB = RA;
constexpr size_t QB = RB;
constexpr size_t KNB = RB + 48 * MiB;
constexpr size_t VTB = KNB + 32 * MiB;
constexpr size_t H1 = RB;
constexpr size_t H2 = RB;
constexpr size_t XBCA = RC;
constexpr size_t MIX = RC + 64 * MiB;
constexpr size_t H1B = RC;
constexpr size_t QX = RC + 64 * MiB;
constexpr size_t OX = RC;
constexpr size_t H2B = RC;
constexpr size_t HDN = RC + 64 * MiB;
constexpr size_t CQ = RD;
constexpr size_t CKV = CQ + 16 * MiB;
constexpr size_t KROPE = CKV + 8 * MiB;
constexpr size_t DTB = KROPE + 2 * MiB;
constexpr size_t ZB = DTB + 1 * MiB;
constexpr size_t LISTS = RD;
static_assert(ZB + 32 * MiB <= WS_NEED, "region D overflow");

struct P {
    const float* in[31];
    float* out;
    unsigned char* ws;
};

typedef __bf16 hbf16x2 __attribute__((ext_vector_type(2)));
typedef float f32x2 __attribute__((ext_vector_type(2)));
DI bf16_t f2bf(float x) { return __builtin_bit_cast(bf16_t, (__bf16)x); }
DI float bf2f(bf16_t b) { return __uint_as_float(((unsigned)b) << 16); }
DI float bflo(unsigned w) { return __uint_as_float(w << 16); }
DI float bfhi(unsigned w) { return __uint_as_float(w & 0xffff0000u); }
DI unsigned pack2(float a, float b) { f32x2 v = {a, b}; return __builtin_bit_cast(unsigned, __builtin_convertvector(v, hbf16x2)); }
DI float siluf(float x) { return x / (1.f + __expf(-x)); }
DI float softplusf(float x) { return x > 20.f ? x : log1pf(__expf(x)); }
DI int tidx() { int t = __builtin_amdgcn_workitem_id_x(); asm volatile("" : "+v"(t)); return t; }
DI int crow(int reg, int h) { return (reg & 3) + 8 * (reg >> 2) + 4 * h; }
DI float wave_sum(float v) {
#pragma unroll
    for (int o = 32; o >= 1; o >>= 1) v += __shfl_xor(v, o);
    return v;
}
DI float wave_max(float v) {
#pragma unroll
    for (int o = 32; o >= 1; o >>= 1) v = fmaxf(v, __shfl_xor(v, o));
    return v;
}

constexpr int LDS_ROW = 144;
constexpr int TILE_BYTES = 128 * LDS_ROW;
constexpr int GEMM_LDS = 4 * TILE_BYTES;
constexpr int SMEM_BYTES = GEMM_LDS + 2048;

struct GemmArgs {
    const bf16_t* A; int lda;
    const bf16_t* Bt; int ldb;
    int K;
    const int* lrows;
};

template <class Epi>
DI void gemm_tile(const GemmArgs& g, int m0, int n0, Epi& epi, unsigned char* smem) {
    const int tid = tidx(), lane = tid & 63, wave = tid >> 6, wr = wave >> 1, wc = wave & 1;
    const int r = lane & 31, h = lane >> 5;
    f32x16 acc[2][2];
#pragma unroll
    for (int i = 0; i < 2; ++i)
#pragma unroll
        for (int j = 0; j < 2; ++j)
#pragma unroll
            for (int e = 0; e < 16; ++e) acc[i][j][e] = 0.f;
    const int nk = g.K >> 6;
#if GEMM_DIRECT
    {
        const bf16_t* ap[2]; const bf16_t* bp[2];
#pragma unroll
        for (int i = 0; i < 2; ++i) {
            const int lr = wr * 64 + i * 32 + r;
            const int grow = g.lrows ? g.lrows[lr] : (m0 + lr);
            ap[i] = g.A + (size_t)grow * g.lda + 8 * h;
            bp[i] = g.Bt + (size_t)(n0 + wc * 64 + i * 32 + r) * g.ldb + 8 * h;
        }
        for (int k = 0; k < g.K; k += 16) {
            bf16x8 a[2], b[2];
#pragma unroll
            for (int i = 0; i < 2; ++i) { a[i] = *(const bf16x8*)(ap[i] + k); b[i] = *(const bf16x8*)(bp[i] + k); }
#pragma unroll
            for (int i = 0; i < 2; ++i)
#pragma unroll
                for (int j = 0; j < 2; ++j) acc[i][j] = MFMA32(a[i], b[j], acc[i][j]);
        }
    }
#elif GEMM_GLDS
    {
        constexpr int STG = 32768, TB = 16384;
        const int srow = tid >> 3, sch = (tid & 7) ^ ((srow >> 1) & 7);
        const bf16_t* ag[4]; const bf16_t* bg[4];
#pragma unroll
        for (int i = 0; i < 4; ++i) {
            const int lr = srow + 32 * i;
            const int grow = g.lrows ? g.lrows[lr] : (m0 + lr);
            ag[i] = g.A + (size_t)grow * g.lda + sch * 8;
            bg[i] = g.Bt + (size_t)(n0 + lr) * g.ldb + sch * 8;
        }
#define GLDS_STAGE(BUF, KO) do { unsigned char* _d = (BUF) + wave * 1024; \
        _Pragma("unroll") for (int i = 0; i < 4; ++i) { \
            __builtin_amdgcn_global_load_lds((const unsigned*)(ag[i] + (KO)), (LAS unsigned*)(_d + i * 4096), 16, 0, 0); \
            __builtin_amdgcn_global_load_lds((const unsigned*)(bg[i] + (KO)), (LAS unsigned*)(_d + TB + i * 4096), 16, 0, 0); } } while (0)
        __syncthreads();
        GLDS_STAGE(smem, 0);
        const int y16 = (h ^ ((r >> 1) & 7)) << 4;
        const int o0 = y16, o1 = 32 ^ y16, o2 = 64 ^ y16, o3 = 96 ^ y16;
        const int arow = (wr * 64 + r) * 128, brow = TB + (wc * 64 + r) * 128;
        __syncthreads();
        for (int kt = 0; kt < nk; ++kt) {
            const unsigned char* cur = smem + (kt & 1) * STG;
            if (kt + 1 < nk) GLDS_STAGE(smem + ((kt + 1) & 1) * STG, (kt + 1) * 64);
#define KSTEP(OFF) do { \
                const bf16x8 a0 = *(const bf16x8*)(cur + arow + (OFF)); \
                const bf16x8 a1 = *(const bf16x8*)(cur + arow + 32 * 128 + (OFF)); \
                const bf16x8 b0 = *(const bf16x8*)(cur + brow + (OFF)); \
                const bf16x8 b1 = *(const bf16x8*)(cur + brow + 32 * 128 + (OFF)); \
                acc[0][0] = MFMA32(a0, b0, acc[0][0]); acc[0][1] = MFMA32(a0, b1, acc[0][1]); \
                acc[1][0] = MFMA32(a1, b0, acc[1][0]); acc[1][1] = MFMA32(a1, b1, acc[1][1]); } while (0)
            KSTEP(o0); KSTEP(o1); KSTEP(o2); KSTEP(o3);
#undef KSTEP
            __syncthreads();
        }
#undef GLDS_STAGE
    }
#else
    {
        const int srow = tid >> 3, sch = tid & 7;
        const bf16_t* ag[4]; const bf16_t* bg[4];
#pragma unroll
        for (int i = 0; i < 4; ++i) {
            const int lr = srow + 32 * i;
            const int grow = g.lrows ? g.lrows[lr] : (m0 + lr);
            ag[i] = g.A + (size_t)grow * g.lda + sch * 8;
            bg[i] = g.Bt + (size_t)(n0 + lr) * g.ldb + sch * 8;
        }
        const int soff = srow * LDS_ROW + sch * 16;
        uint4 ra0, ra1, ra2, ra3, rb0, rb1, rb2, rb3;
#define G_LOAD(KO) do { ra0 = *(const uint4*)(ag[0] + (KO)); ra1 = *(const uint4*)(ag[1] + (KO)); ra2 = *(const uint4*)(ag[2] + (KO)); ra3 = *(const uint4*)(ag[3] + (KO)); \
                        rb0 = *(const uint4*)(bg[0] + (KO)); rb1 = *(const uint4*)(bg[1] + (KO)); rb2 = *(const uint4*)(bg[2] + (KO)); rb3 = *(const uint4*)(bg[3] + (KO)); } while (0)
#define L_STORE(BUF) do { unsigned char* _d = (BUF) + soff; \
        *(uint4*)(_d) = ra0; *(uint4*)(_d + 32 * LDS_ROW) = ra1; *(uint4*)(_d + 64 * LDS_ROW) = ra2; *(uint4*)(_d + 96 * LDS_ROW) = ra3; \
        *(uint4*)(_d + TILE_BYTES) = rb0; *(uint4*)(_d + TILE_BYTES + 32 * LDS_ROW) = rb1; *(uint4*)(_d + TILE_BYTES + 64 * LDS_ROW) = rb2; *(uint4*)(_d + TILE_BYTES + 96 * LDS_ROW) = rb3; } while (0)
        G_LOAD(0);
        __syncthreads();
        L_STORE(smem);
        __syncthreads();
        const int aoff = (wr * 64 + r) * LDS_ROW + h * 16;
        const int boff = TILE_BYTES + (wc * 64 + r) * LDS_ROW + h * 16;
        for (int kt = 0; kt < nk; ++kt) {
            const unsigned char* cur = smem + (kt & 1) * 2 * TILE_BYTES;
            unsigned char* nxt = smem + ((kt + 1) & 1) * 2 * TILE_BYTES;
            const bool more = (kt + 1 < nk);
            if (more) G_LOAD((kt + 1) * 64);
#pragma unroll
            for (int ks = 0; ks < 4; ++ks) {
                const bf16x8 a0 = *(const bf16x8*)(cur + aoff + ks * 32);
                const bf16x8 a1 = *(const bf16x8*)(cur + aoff + 32 * LDS_ROW + ks * 32);
                const bf16x8 b0 = *(const bf16x8*)(cur + boff + ks * 32);
                const bf16x8 b1 = *(const bf16x8*)(cur + boff + 32 * LDS_ROW + ks * 32);
                acc[0][0] = MFMA32(a0, b0, acc[0][0]); acc[0][1] = MFMA32(a0, b1, acc[0][1]);
                acc[1][0] = MFMA32(a1, b0, acc[1][0]); acc[1][1] = MFMA32(a1, b1, acc[1][1]);
            }
            if (more) L_STORE(nxt);
            __syncthreads();
        }
#undef G_LOAD
#undef L_STORE
    }
#endif
    epi(acc, m0 + wr * 64, n0 + wc * 64, lane);
}

DI int vbid(int bid, int nb) { return (nb % 8 == 0) ? (bid % 8) * (nb / 8) + bid / 8 : bid; }

DI int colmap_in(int n) {
    if (n < 384) return n;
    if (n < 896) return 416 + (n - 384);
    if (n < 1920) return 928 + (n - 896);
    if (n < 1952) return 384 + (n - 1920);
    if (n < 1960) return n;
    return -1;
}
template <int KIND>
DI void tconv_tile(const float* src, const float* src2, int ldsrc, bf16_t* dst, int K, int k0, int n0, const float* scale, int scale_from, unsigned char* smem) {
    float* tile = (float*)smem;
    const int t = tidx();
    __syncthreads();
#pragma unroll 4
    for (int i = 0; i < 16; ++i) {
        const int k = i * 4 + (t >> 6), n = t & 63;
        const int nd = n0 + n;
        float v = 0.f;
        if (KIND == 1) { const int c = colmap_in(nd); if (c >= 0) v = src[(size_t)(k0 + k) * ldsrc + c]; }
        else if (KIND == 2) {
            const int j = nd >> 7, wc = (nd >> 6) & 1, isup = (nd >> 5) & 1, ii = nd & 31;
            const int c = 64 * j + 32 * wc + ii;
            v = (isup ? src2 : src)[(size_t)(k0 + k) * ldsrc + c];
        } else v = src[(size_t)(k0 + k) * ldsrc + nd];
        if (scale && (k0 + k) >= scale_from) v *= scale[k0 + k - scale_from];
        tile[k * 65 + n] = v;
    }
    __syncthreads();
#pragma unroll 4
    for (int i = 0; i < 16; ++i) {
        const int n = i * 4 + (t >> 6), k = t & 63;
        dst[(size_t)(n0 + n) * K + k0 + k] = f2bf(tile[k * 65 + n]);
    }
}

DI void phase_prep(const P& p, int bid, int nb, unsigned char* smem) {
    unsigned char* ws = p.ws;
    const int tid = tidx();
    constexpr int J0 = 512, J1 = J0 + 48, J2 = J1 + 32, J3 = J2 + 256, J4 = J3 + 256, J5 = J4 + 256, J6 = J5 + 256, J7 = J6 + 256, J8 = J7 + 4096, J9 = J8 + 2048;
    for (int t = bid; t < J9; t += nb) {
        if (t < J0) { const int kt = t >> 5, ntl = t & 31; tconv_tile<1>(p.in[2], nullptr, 1960, (bf16_t*)(ws + W_IN), 1024, kt * 64, ntl * 64, nullptr, 0, smem); }
        else if (t < J1) { const int u = t - J0, kt = u / 12, ntl = u % 12; tconv_tile<0>(p.in[4], nullptr, 768, (bf16_t*)(ws + W_QUP), 256, kt * 64, ntl * 64, p.in[3], 0, smem); }
        else if (t < J2) { const int u = t - J1, kt = u >> 4, ntl = u & 15; tconv_tile<0>(p.in[6], nullptr, 1024, (bf16_t*)(ws + W_KVUP), 128, kt * 64, ntl * 64, p.in[5], 0, smem); }
        else if (t < J3) { const int u = t - J2, kt = u >> 4, ntl = u & 15; tconv_tile<0>(p.in[13], nullptr, 1024, (bf16_t*)(ws + W_OUT), 1024, kt * 64, ntl * 64, p.in[12], 512, smem); }
        else if (t < J4) { const int u = t - J3, kt = u >> 4, ntl = u & 15; tconv_tile<0>(p.in[16], nullptr, 1024, (bf16_t*)(ws + W_XQ), 1024, kt * 64, ntl * 64, nullptr, 0, smem); }
        else if (t < J5) { const int u = t - J4, kt = u >> 4, ntl = u & 15; tconv_tile<0>(p.in[17], nullptr, 1024, (bf16_t*)(ws + W_XKV), 1024, kt * 64, ntl * 64, nullptr, 0, smem); }
        else if (t < J6) { const int u = t - J5, kt = u >> 4, ntl = u & 15; tconv_tile<0>(p.in[18], nullptr, 1024, (bf16_t*)(ws + W_XKV) + (size_t)1024 * 1024, 1024, kt * 64, ntl * 64, nullptr, 0, smem); }
        else if (t < J7) { const int u = t - J6, kt = u >> 4, ntl = u & 15; tconv_tile<0>(p.in[19], nullptr, 1024, (bf16_t*)(ws + W_XO), 1024, kt * 64, ntl * 64, nullptr, 0, smem); }
        else if (t < J8) { const int u = t - J7, e = u >> 7, v = u & 127, kt = v >> 3, ntl = v & 7;
            tconv_tile<2>(p.in[26] + (size_t)e * 1024 * 256, p.in[27] + (size_t)e * 1024 * 256, 256, (bf16_t*)(ws + W_GU) + (size_t)e * 512 * 1024, 1024, kt * 64, ntl * 64, nullptr, 0, smem); }
        else { const int u = t - J8, e = u >> 6, v = u & 63, kt = v >> 4, ntl = v & 15;
            tconv_tile<0>(p.in[28] + (size_t)e * 256 * 1024, nullptr, 1024, (bf16_t*)(ws + W_DN) + (size_t)e * 1024 * 256, 256, kt * 64, ntl * 64, nullptr, 0, smem); }
    }
    {
        const size_t gsz = (size_t)nb * 256, g0 = (size_t)bid * 256 + tid;
        bf16_t* xb = (bf16_t*)p.out;
        const float4* x4 = (const float4*)p.in[0];
        for (size_t i = g0; i < (size_t)T * D / 4; i += gsz) { const float4 v = x4[i]; uint2 o; o.x = pack2(v.x, v.y); o.y = pack2(v.z, v.w); ((uint2*)xb)[i] = o; }
        bf16_t* mb = xb + (size_t)T * D;
        const float4* m4 = (const float4*)p.in[1];
        for (size_t i = g0; i < (size_t)Bn * NMEM * D / 4; i += gsz) { const float4 v = m4[i]; uint2 o; o.x = pack2(v.x, v.y); o.y = pack2(v.z, v.w); ((uint2*)mb)[i] = o; }
        float* wrt = (float*)(ws + W_RT);
        for (size_t i = g0; i < 48 * 1024; i += gsz) {
            const int j = (int)(i >> 10), k = (int)(i & 1023);
            float v = 0.f;
            if (j < 4) v = p.in[22][k * 4 + j]; else if (j < 36) v = p.in[24][k * 32 + (j - 4)];
            wrt[i] = v;
        }
        float* rc = (float*)(ws + ROPE_C); float* rs = (float*)(ws + ROPE_S);
        for (size_t i = g0; i < 2048 * 16; i += gsz) {
            const int pos = (int)(i >> 4), f = (int)(i & 15);
            const float inv = powf(10000.f, -(float)f / 16.f);
            const float ang = (float)pos * inv;
            const double a = (double)ang;
            const double k2 = rint(a * 0.15915494309189535);
            const float rr = (float)(a - k2 * 6.283185307179586);
            rc[i] = cosf(rr); rs[i] = sinf(rr);
        }
    }
}

struct EpiProj {
    bf16_t *cq, *ckv, *z, *xbc, *krope; float* dt; const float *rc, *rs, *dtb;
    DI void operator()(const f32x16 (&acc)[2][2], int rb, int cb, int lane) const {
        const int r = lane & 31, h = lane >> 5;
#pragma unroll
        for (int i = 0; i < 2; ++i)
#pragma unroll
            for (int j = 0; j < 2; ++j) {
                const int col = cb + j * 32 + r;
                const int colb = cb + j * 32;
#pragma unroll
                for (int e = 0; e < 16; ++e) {
                    const int row = rb + i * 32 + crow(e, h);
                    const float v = acc[i][j][e];
                    if (colb < 256) cq[(size_t)row * 256 + col] = f2bf(v);
                    else if (colb < 384) ckv[(size_t)row * 128 + col - 256] = f2bf(v);
                    else if (colb < 896) z[(size_t)row * 512 + col - 384] = f2bf(v);
                    else if (colb < 1920) xbc[(size_t)row * 1024 + col - 896] = f2bf(v);
                    else if (colb == 1920) {
                        const float pv = __shfl_xor(v, 16);
                        const int pos = row & 2047, f = r & 15;
                        const float c = rc[pos * 16 + f], s = rs[pos * 16 + f];
                        const float o = (r < 16) ? (v * c - pv * s) : (v * c + pv * s);
                        krope[(size_t)row * 32 + r] = f2bf(o);
                    } else if (colb == 1952) {
                        if (r < 8) dt[(size_t)row * 8 + r] = softplusf(v + dtb[r]);
                    }
                }
            }
    }
};
struct EpiMemKV {
    bf16_t *kx, *vxt;
    DI void operator()(const f32x16 (&acc)[2][2], int rb, int cb, int lane) const {
        const int r = lane & 31, h = lane >> 5;
#pragma unroll
        for (int i = 0; i < 2; ++i)
#pragma unroll
            for (int j = 0; j < 2; ++j) {
                const int col = cb + j * 32 + r;
#pragma unroll
                for (int e = 0; e < 16; ++e) {
                    const int row = rb + i * 32 + crow(e, h);
                    const int b = row >> 8, m = row & 255;
                    const float v = acc[i][j][e];
                    if (col < 1024) { const int hd = col >> 8, d = col & 255; kx[((size_t)(b * 4 + hd) * 256 + m) * 256 + d] = f2bf(v); }
                    else { const int c2 = col - 1024, hd = c2 >> 8, d = c2 & 255; vxt[((size_t)(b * 4 + hd) * 256 + d) * 256 + m] = f2bf(v); }
                }
            }
    }
};
DI void phase_proj(const P& p, int bid, int nb, unsigned char* smem) {
    unsigned char* ws = p.ws;
    const int v = vbid(bid, nb);
    const bf16_t* xb = (const bf16_t*)p.out;
    EpiProj e1{(bf16_t*)(ws + CQ), (bf16_t*)(ws + CKV), (bf16_t*)(ws + ZB), (bf16_t*)(ws + XBC), (bf16_t*)(ws + KROPE), (float*)(ws + DTB),
               (const float*)(ws + ROPE_C), (const float*)(ws + ROPE_S), p.in[9]};
    EpiMemKV e2{(bf16_t*)(ws + KX), (bf16_t*)(ws + VXT)};
    constexpr int NT1 = 256 * 16, NT2 = 32 * 16;
    for (int t = v; t < NT1 + NT2; t += nb) {
        if (t < NT1) { GemmArgs g{xb, 1024, (const bf16_t*)(ws + W_IN), 1024, 1024, nullptr}; gemm_tile(g, (t >> 4) * 128, (t & 15) * 128, e1, smem); }
        else { const int u = t - NT1; GemmArgs g{xb + (size_t)T * D, 1024, (const bf16_t*)(ws + W_XKV), 1024, 1024, nullptr}; gemm_tile(g, (u >> 4) * 128, (u & 15) * 128, e2, smem); }
    }
}

struct EpiQup {
    bf16_t* q; const float *rc, *rs; const float* rms;
    int m0;
    DI void operator()(const f32x16 (&acc)[2][2], int rb, int cb, int lane) const {
        const int r = lane & 31, h = lane >> 5;
#pragma unroll
        for (int i = 0; i < 2; ++i)
#pragma unroll
            for (int j = 0; j < 2; ++j) {
                const int blk = (cb >> 5) + j, head = blk / 3, part = blk % 3;
#pragma unroll
                for (int e = 0; e < 16; ++e) {
                    const int row = rb + i * 32 + crow(e, h);
                    float v = acc[i][j][e] * rms[row - m0];
                    if (part == 2) {
                        const float pv = __shfl_xor(v, 16);
                        const int pos = row & 2047, f = r & 15;
                        const float c = rc[pos * 16 + f], s = rs[pos * 16 + f];
                        v = (r < 16) ? (v * c - pv * s) : (v * c + pv * s);
                    }
                    const int b = row >> 11, s_ = row & 2047;
                    q[((size_t)(b * 8 + head) * 2048 + s_) * 96 + part * 32 + r] = f2bf(v * QSCALE);
                }
            }
    }
};
struct EpiKVup {
    bf16_t *kn, *vt; const float* rms; int m0;
    DI void operator()(const f32x16 (&acc)[2][2], int rb, int cb, int lane) const {
        const int r = lane & 31, h = lane >> 5;
        const int head = cb >> 7, isv = (cb >> 6) & 1;
#pragma unroll
        for (int i = 0; i < 2; ++i)
#pragma unroll
            for (int j = 0; j < 2; ++j) {
                const int d = j * 32 + r;
#pragma unroll
                for (int e = 0; e < 16; ++e) {
                    const int row = rb + i * 32 + crow(e, h);
                    const float v = acc[i][j][e] * rms[row - m0];
                    const int b = row >> 11, s_ = row & 2047;
                    if (!isv) kn[((size_t)(b * 8 + head) * 2048 + s_) * 64 + d] = f2bf(v);
                    else vt[((size_t)(b * 8 + head) * 64 + d) * 2048 + s_] = f2bf(v);
                }
            }
    }
};
template <int K>
DI void row_rms(const bf16_t* src, int m0, float* rms) {
    const int t = tidx(), row = t >> 1, half = t & 1;
    const uint4* s4 = (const uint4*)(src + (size_t)(m0 + row) * K + half * (K / 2));
    float ss = 0.f;
#pragma unroll
    for (int i = 0; i < K / 16; ++i) {
        const uint4 w = s4[i];
        const unsigned ww[4] = {w.x, w.y, w.z, w.w};
#pragma unroll
        for (int k = 0; k < 4; ++k) { const float a = bflo(ww[k]), b = bfhi(ww[k]); ss += a * a + b * b; }
    }
    ss += __shfl_xor(ss, 1);
    __syncthreads();
    if (half == 0) rms[row] = rsqrtf(ss * (1.f / K) + EPS);
    __syncthreads();
}
DI void phase_up(const P& p, int bid, int nb, unsigned char* smem) {
    unsigned char* ws = p.ws;
    const int v = vbid(bid, nb);
    float* rms = (float*)(smem + GEMM_LDS);
    constexpr int NTQ = 256 * 6, NTKV = 256 * 8;
    for (int t = v; t < NTQ + NTKV; t += nb) {
        if (t < NTQ) {
            const int mt = t / 6, ntl = t % 6;
            row_rms<256>((const bf16_t*)(ws + CQ), mt * 128, rms);
            EpiQup e{(bf16_t*)(ws + QB), (const float*)(ws + ROPE_C), (const float*)(ws + ROPE_S), rms, mt * 128};
            GemmArgs g{(const bf16_t*)(ws + CQ), 256, (const bf16_t*)(ws + W_QUP), 256, 256, nullptr};
            gemm_tile(g, mt * 128, ntl * 128, e, smem);
        } else {
            const int u = t - NTQ, mt = u >> 3, ntl = u & 7;
            row_rms<128>((const bf16_t*)(ws + CKV), mt * 128, rms);
            EpiKVup e{(bf16_t*)(ws + KNB), (bf16_t*)(ws + VTB), rms, mt * 128};
            GemmArgs g{(const bf16_t*)(ws + CKV), 128, (const bf16_t*)(ws + W_KVUP), 128, 128, nullptr};
            gemm_tile(g, mt * 128, ntl * 128, e, smem);
        }
    }
    {
        const bf16_t* xbc = (const bf16_t*)(ws + XBC); bf16_t* xa = (bf16_t*)(ws + XBCA);
        const float* cw = p.in[7]; const float* cb = p.in[8];
        const size_t gsz = (size_t)nb * 256;
        for (size_t i = (size_t)bid * 256 + tidx(); i < (size_t)T * 128; i += gsz) {
            const int tkn = (int)(i >> 7), c0 = (int)(i & 127) * 8, s_ = tkn & 2047;
            float accv[8];
#pragma unroll
            for (int k = 0; k < 8; ++k) accv[k] = cb[c0 + k];
#pragma unroll
            for (int j = 0; j < 4; ++j) {
                if (s_ + j - 3 >= 0) {
                    const uint4 w = *(const uint4*)(xbc + (size_t)(tkn + j - 3) * 1024 + c0);
                    const unsigned ww[4] = {w.x, w.y, w.z, w.w};
#pragma unroll
                    for (int k = 0; k < 4; ++k) {
                        accv[2 * k] += cw[j * 1024 + c0 + 2 * k] * bflo(ww[k]);
                        accv[2 * k + 1] += cw[j * 1024 + c0 + 2 * k + 1] * bfhi(ww[k]);
                    }
                }
            }
            uint4 o;
            o.x = pack2(siluf(accv[0]), siluf(accv[1])); o.y = pack2(siluf(accv[2]), siluf(accv[3]));
            o.z = pack2(siluf(accv[4]), siluf(accv[5])); o.w = pack2(siluf(accv[6]), siluf(accv[7]));
            *(uint4*)(xa + (size_t)tkn * 1024 + c0) = o;
        }
    }
}

DI int perm16(int k) { return (k & ~12) | ((k & 4) << 1) | ((k & 8) >> 1); }
template <int DQK, int DVW, int KT, int NQG, int NDV>
struct FlashCfg {
    static constexpr int KSTR = (DQK + 8) * 2;
    static constexpr int VSTR = (KT + 8) * 2;
    static constexpr int DV = DVW * NDV;
    static constexpr int KBYTES = KT * KSTR, VBYTES = DV * VSTR, STAGE = KBYTES + VBYTES;
    static constexpr int KCH = KT * DQK / 8 / 256;
    static constexpr int VCH = DV * KT / 8 / 256;
    static_assert(KT * DQK / 8 % 256 == 0 && DV * KT / 8 % 256 == 0, "chunk split");
    static_assert(2 * STAGE <= GEMM_LDS + 2048 - 16, "flash LDS");
};
template <int DQK, int DVW, int KT, int NQG, int NDV, class Src>
DI void flash_item(const Src& src, int ntiles, int nskip  , unsigned char* smem) {
    typedef FlashCfg<DQK, DVW, KT, NQG, NDV> C;
    constexpr int NKS = DQK / 16, NKB = KT / 32, NDB = DVW / 32;
    int tid = tidx(); asm volatile("" : "+v"(tid));
    const int lane = tid & 63, wave = __builtin_amdgcn_readfirstlane(tid >> 6), r = lane & 31, h = lane >> 5;
    const int qg = wave / NDV, dvh = wave % NDV;
    bf16x8 qf[NKS];
    {
        const bf16_t* qp = src.qrow(qg * 32 + r) + 8 * h;
#pragma unroll
        for (int ks = 0; ks < NKS; ++ks) qf[ks] = *(const bf16x8*)(qp + 16 * ks);
    }
    f32x16 o[NDB];
#pragma unroll
    for (int d = 0; d < NDB; ++d)
#pragma unroll
        for (int e = 0; e < 16; ++e) o[d][e] = 0.f;
    float m = -1e30f, l = 0.f;
    uint4 kr[C::KCH], vr[C::VCH];
    auto gload = [&](int t) {
#pragma unroll
        for (int i = 0; i < C::KCH; ++i) { const int idx = tid + 256 * i; kr[i] = src.kload(t, idx / (DQK / 8), idx % (DQK / 8)); }
#pragma unroll
        for (int i = 0; i < C::VCH; ++i) { const int idx = tid + 256 * i; vr[i] = src.vload(t, idx / (KT / 8), idx % (KT / 8)); }
    };
    auto lstore = [&](unsigned char* buf) {
#pragma unroll
        for (int i = 0; i < C::KCH; ++i) { const int idx = tid + 256 * i; *(uint4*)(buf + (idx / (DQK / 8)) * C::KSTR + (idx % (DQK / 8)) * 16) = kr[i]; }
#pragma unroll
        for (int i = 0; i < C::VCH; ++i) {
            const int idx = tid + 256 * i, dv = idx / (KT / 8), c = idx % (KT / 8);
            unsigned char* row = buf + C::KBYTES + dv * C::VSTR + (c >> 1) * 32;
            const int a = c & 1;
            *(uint2*)(row + (4 * a) * 2) = make_uint2(vr[i].x, vr[i].y);
            *(uint2*)(row + (8 + 4 * a) * 2) = make_uint2(vr[i].z, vr[i].w);
        }
    };
    gload(0);
    __syncthreads();
    lstore(smem);
    __syncthreads();
    for (int t = 0; t < ntiles; ++t) {
        const unsigned char* cur = smem + (t & 1) * C::STAGE;
        const bool more = (t + 1 < ntiles);
        if (more) gload(t + 1);
        if (!(t == ntiles - 1 && qg < nskip)) {
            f32x16 s[NKB];
#pragma unroll
            for (int kb = 0; kb < NKB; ++kb) {
#pragma unroll
                for (int e = 0; e < 16; ++e) s[kb][e] = 0.f;
                const unsigned char* kp = cur + (kb * 32 + r) * C::KSTR + h * 16;
#pragma unroll
                for (int ks = 0; ks < NKS; ++ks) s[kb] = MFMA32(*(const bf16x8*)(kp + ks * 32), qf[ks], s[kb]);
            }
            float mx = s[0][0];
#pragma unroll
            for (int kb = 0; kb < NKB; ++kb)
#pragma unroll
                for (int e = 0; e < 16; ++e) mx = fmaxf(mx, s[kb][e]);
            mx = fmaxf(mx, __shfl_xor(mx, 32));
            const float mn = fmaxf(m, mx);
            const float alpha = exp2f(m - mn);
            m = mn;
            float ps = 0.f;
#pragma unroll
            for (int kb = 0; kb < NKB; ++kb)
#pragma unroll
                for (int e = 0; e < 16; ++e) { const float pv = exp2f(s[kb][e] - mn); s[kb][e] = pv; ps += pv; }
            l = l * alpha + ps;
#pragma unroll
            for (int d = 0; d < NDB; ++d)
#pragma unroll
                for (int e = 0; e < 16; ++e) o[d][e] *= alpha;
#pragma unroll
            for (int kb = 0; kb < NKB; ++kb)
#pragma unroll
                for (int s2 = 0; s2 < 2; ++s2) {
                    uint4 pk;
                    pk.x = pack2(s[kb][8 * s2], s[kb][8 * s2 + 1]); pk.y = pack2(s[kb][8 * s2 + 2], s[kb][8 * s2 + 3]);
                    pk.z = pack2(s[kb][8 * s2 + 4], s[kb][8 * s2 + 5]); pk.w = pack2(s[kb][8 * s2 + 6], s[kb][8 * s2 + 7]);
                    const bf16x8 pf = __builtin_bit_cast(bf16x8, pk);
                    const unsigned char* vp = cur + C::KBYTES + (dvh * DVW + r) * C::VSTR + (kb * 32 + s2 * 16 + 8 * h) * 2;
#pragma unroll
                    for (int d = 0; d < NDB; ++d) o[d] = MFMA32(*(const bf16x8*)(vp + d * 32 * C::VSTR), pf, o[d]);
                }
        }
        if (more) lstore(smem + ((t + 1) & 1) * C::STAGE);
        __syncthreads();
    }
    l += __shfl_xor(l, 32);
    const float il = 1.f / l;
#pragma unroll
    for (int d = 0; d < NDB; ++d)
#pragma unroll
        for (int g4 = 0; g4 < 4; ++g4) {
            uint2 w; w.x = pack2(o[d][4 * g4] * il, o[d][4 * g4 + 1] * il); w.y = pack2(o[d][4 * g4 + 2] * il, o[d][4 * g4 + 3] * il);
            src.store(qg * 32 + r, dvh * DVW + d * 32 + 8 * g4 + 4 * h, w);
        }
}
struct SelfSrc {
    const bf16_t *q, *kn, *kr, *vt; bf16_t* mix; int b, hd, bh, q0;
    DI const bf16_t* qrow(int rr) const { return q + ((size_t)bh * 2048 + q0 + rr) * 96; }
    DI uint4 kload(int t, int key, int c) const {
        const int kg = t * 64 + key;
        return c < 8 ? *(const uint4*)(kn + ((size_t)bh * 2048 + kg) * 64 + c * 8) : *(const uint4*)(kr + ((size_t)b * 2048 + kg) * 32 + (c - 8) * 8);
    }
    DI uint4 vload(int t, int dv, int c) const { return *(const uint4*)(vt + ((size_t)bh * 64 + dv) * 2048 + t * 64 + c * 8); }
    DI void store(int rr, int dv, uint2 w) const { *(uint2*)(mix + ((size_t)b * 2048 + q0 + rr) * 1024 + hd * 64 + dv) = w; }
};
struct CrossSrc {
    const bf16_t *qx, *kx, *vxt; bf16_t* ox; int b, hd, q0;
    DI const bf16_t* qrow(int rr) const { return qx + ((size_t)(b * 4 + hd) * 2048 + q0 + rr) * 256; }
    DI uint4 kload(int t, int key, int c) const { return *(const uint4*)(kx + ((size_t)(b * 4 + hd) * 256 + t * 32 + key) * 256 + c * 8); }
    DI uint4 vload(int t, int dv, int c) const { return *(const uint4*)(vxt + ((size_t)(b * 4 + hd) * 256 + dv) * 256 + t * 32 + c * 8); }
    DI void store(int rr, int dv, uint2 w) const { *(uint2*)(ox + ((size_t)b * 2048 + q0 + rr) * 1024 + hd * 256 + dv) = w; }
};
DI void attn_fast(const P& p, int bid, int nb, unsigned char* smem) {
    unsigned char* ws = p.ws;
    const int nround = (2048 + nb - 1) / nb;
    for (int rd = 0; rd < nround; ++rd) {
        const int idx = rd * nb + ((rd & 1) ? (nb - 1 - bid) : bid);
        if (idx >= 2048) continue;
        const int qb = 15 - (idx >> 7), bh = idx & 127;
        SelfSrc s{(const bf16_t*)(ws + QB), (const bf16_t*)(ws + KNB), (const bf16_t*)(ws + KROPE), (const bf16_t*)(ws + VTB), (bf16_t*)(ws + MIX), bh >> 3, bh & 7, bh, qb * 128};
        flash_item<96, 64, 64, 4, 1>(s, 2 * qb + 2, 2, smem);
    }
}
DI void xattn_fast(const P& p, int bid, int nb, unsigned char* smem) {
    unsigned char* ws = p.ws;
    for (int it = bid; it < 2048; it += nb) {
        const int bhd = it >> 5, qt = it & 31;
        CrossSrc s{(const bf16_t*)(ws + QX), (const bf16_t*)(ws + KX), (const bf16_t*)(ws + VXT), (bf16_t*)(ws + OX), bhd >> 2, bhd & 3, qt * 64};
        flash_item<256, 128, 32, 2, 2>(s, 8, 0, smem);
    }
}

constexpr int SSD_XT = 0, SSD_BM = 8192, SSD_CM = SSD_BM + 16384, SSD_BWT = SSD_CM + 16384, SSD_PS = SSD_BWT + 16384, SSD_F = SSD_PS + 16384;
static_assert(SSD_F + 1024 <= GEMM_LDS + 2048 - 16, "ssd LDS");
DI int off256(int row, int el) { return row * 256 + (((el >> 3) ^ (row & 15)) << 4) + ((el & 7) << 1); }
DI int off128(int row, int el) { return row * 128 + (((el >> 3) ^ ((row >> 1) & 7)) << 4) + ((el & 7) << 1); }
DI void ssd_item(const P& p, int bh, unsigned char* smem) {
    unsigned char* ws = p.ws;
    const bf16_t* xa = (const bf16_t*)(ws + XBCA); const float* dtg = (const float*)(ws + DTB); const bf16_t* zg = (const bf16_t*)(ws + ZB);
    bf16_t* mix = (bf16_t*)(ws + MIX);
    int tid0 = tidx(); asm volatile("" : "+v"(tid0));
    const int wave = __builtin_amdgcn_readfirstlane(tid0 >> 6);
    const int b = bh >> 3, hd = bh & 7, g = hd >> 2;
    const int lb = wave >> 1, pb = wave & 1;
    const float a_h = -__expf(p.in[10][hd]), Dh = p.in[11][hd];
    float* F = (float*)(smem + SSD_F);
    __syncthreads();
    for (int i = tid0; i < 16384 / 16; i += 256) *(uint4*)(smem + SSD_PS + i * 16) = make_uint4(0u, 0u, 0u, 0u);
    f32x16 st[2];
#pragma unroll
    for (int i = 0; i < 2; ++i)
#pragma unroll
        for (int e = 0; e < 16; ++e) st[i][e] = 0.f;
    uint4 xr0, xr1, br0, br1, br2, br3, cr0, cr1, cr2, cr3; float dtr = 0.f;
#define SSD_XLD(i) (*(const uint4*)(xa + (t0_ + ((tid + 256 * (i)) >> 3)) * 1024 + hd * 64 + ((tid + 256 * (i)) & 7) * 8))
#define SSD_BLD(i, o) (*(const uint4*)(xa + (t0_ + ((tid + 256 * (i)) >> 4)) * 1024 + (o) + g * 128 + ((tid + 256 * (i)) & 15) * 8))
#define SSD_GLOAD(c_) do { const size_t t0_ = (size_t)b * 2048 + (c_) * 64; xr0 = SSD_XLD(0); xr1 = SSD_XLD(1); \
        br0 = SSD_BLD(0, 512); br1 = SSD_BLD(1, 512); br2 = SSD_BLD(2, 512); br3 = SSD_BLD(3, 512); \
        cr0 = SSD_BLD(0, 768); cr1 = SSD_BLD(1, 768); cr2 = SSD_BLD(2, 768); cr3 = SSD_BLD(3, 768); \
        if (tid < 64) dtr = dtg[(t0_ + tid) * 8 + hd]; } while (0)
    { const int tid = tid0; SSD_GLOAD(0); }
    for (int c = 0; c < 32; ++c) {
        int tid = tid0; asm volatile("" : "+v"(tid));
        const int lane = tid & 63, r = lane & 31, h = lane >> 5;
        const size_t t0 = (size_t)b * 2048 + c * 64;
        if (wave == 0) {
            float v = dtr * a_h;
#pragma unroll
            for (int o = 1; o < 64; o <<= 1) { const float u = __shfl_up(v, o); if (lane >= o) v += u; }
            const float a63 = __shfl(v, 63);
            F[lane] = v; F[64 + lane] = __expf(v); F[128 + lane] = dtr; F[192 + lane] = __expf(a63 - v) * dtr;
        }
        __syncthreads();
#define SSD_XIMG(i, XR) do { const int idx = tid + 256 * (i), l = idx >> 3, p0 = (idx & 7) * 8, lp = perm16(l); \
            const unsigned ww[4] = {XR.x, XR.y, XR.z, XR.w}; \
            _Pragma("unroll") for (int k = 0; k < 4; ++k) { \
                *(bf16_t*)(smem + SSD_XT + off128(p0 + 2 * k, lp)) = (bf16_t)(ww[k] & 0xffffu); \
                *(bf16_t*)(smem + SSD_XT + off128(p0 + 2 * k + 1, lp)) = (bf16_t)(ww[k] >> 16); } } while (0)
#define SSD_BIMG(i, BR, CR) do { const int idx = tid + 256 * (i), l = idx >> 4, n0 = (idx & 15) * 8, lp = perm16(l); \
            *(uint4*)(smem + SSD_BM + off256(l, n0)) = BR; *(uint4*)(smem + SSD_CM + off256(l, n0)) = CR; \
            const float wl = F[192 + l]; const unsigned ww[4] = {BR.x, BR.y, BR.z, BR.w}; \
            _Pragma("unroll") for (int k = 0; k < 4; ++k) { \
                *(bf16_t*)(smem + SSD_BWT + off128(n0 + 2 * k, lp)) = f2bf(bflo(ww[k]) * wl); \
                *(bf16_t*)(smem + SSD_BWT + off128(n0 + 2 * k + 1, lp)) = f2bf(bfhi(ww[k]) * wl); } } while (0)
        SSD_XIMG(0, xr0); SSD_XIMG(1, xr1);
        SSD_BIMG(0, br0, cr0); SSD_BIMG(1, br1, cr1); SSD_BIMG(2, br2, cr2); SSD_BIMG(3, br3, cr3);
        __syncthreads();
        if (c + 1 < 32) SSD_GLOAD(c + 1);
        bf16_t zr[16];
        {
            const bf16_t* zp = zg + (t0 + lb * 32 + 4 * h) * 512 + hd * 64 + pb * 32 + r;
#pragma unroll
            for (int e = 0; e < 16; ++e) zr[e] = zp[(size_t)((e & 3) + 8 * (e >> 2)) * 512];
        }
        f32x16 yd;
#pragma unroll
        for (int e = 0; e < 16; ++e) yd[e] = 0.f;
        const float acs_l = F[lb * 32 + r];
        const int lrow = lb * 32 + r;
        for (int sb = 0; sb <= lb; ++sb) {
            f32x16 cb;
#pragma unroll
            for (int e = 0; e < 16; ++e) cb[e] = 0.f;
#pragma unroll
            for (int ks = 0; ks < 8; ++ks) {
                const bf16x8 av = *(const bf16x8*)(smem + SSD_BM + off256(sb * 32 + r, 16 * ks + 8 * h));
                const bf16x8 bv = *(const bf16x8*)(smem + SSD_CM + off256(lb * 32 + r, 16 * ks + 8 * h));
                cb = MFMA32(av, bv, cb);
            }
            float mv[16];
#pragma unroll
            for (int q4 = 0; q4 < 4; ++q4) {
                const int s0 = sb * 32 + 8 * q4 + 4 * h;
                const float4 as4 = *(const float4*)(F + s0), dt4 = *(const float4*)(F + 128 + s0);
                const float asv[4] = {as4.x, as4.y, as4.z, as4.w}, dtv[4] = {dt4.x, dt4.y, dt4.z, dt4.w};
#pragma unroll
                for (int k = 0; k < 4; ++k) mv[4 * q4 + k] = (s0 + k <= lrow) ? cb[4 * q4 + k] * __expf(acs_l - asv[k]) * dtv[k] : 0.f;
            }
#pragma unroll
            for (int s2 = 0; s2 < 2; ++s2) {
                uint4 pk;
                pk.x = pack2(mv[8 * s2], mv[8 * s2 + 1]); pk.y = pack2(mv[8 * s2 + 2], mv[8 * s2 + 3]);
                pk.z = pack2(mv[8 * s2 + 4], mv[8 * s2 + 5]); pk.w = pack2(mv[8 * s2 + 6], mv[8 * s2 + 7]);
                const bf16x8 xb = *(const bf16x8*)(smem + SSD_XT + off128(pb * 32 + r, sb * 32 + 16 * s2 + 8 * h));
                yd = MFMA32(__builtin_bit_cast(bf16x8, pk), xb, yd);
            }
        }
        f32x16 yo;
#pragma unroll
        for (int e = 0; e < 16; ++e) yo[e] = 0.f;
#pragma unroll
        for (int ks = 0; ks < 8; ++ks) {
            const bf16x8 av = *(const bf16x8*)(smem + SSD_CM + off256(lb * 32 + r, 16 * ks + 8 * h));
            const bf16x8 bv = *(const bf16x8*)(smem + SSD_PS + off256(pb * 32 + r, 16 * ks + 8 * h));
            yo = MFMA32(av, bv, yo);
        }
        {
            const uint4 x0 = *(const uint4*)(smem + SSD_XT + off128(pb * 32 + r, lb * 32 + 8 * h));
            const uint4 x1 = *(const uint4*)(smem + SSD_XT + off128(pb * 32 + r, lb * 32 + 16 + 8 * h));
            const unsigned xw[8] = {x0.x, x0.y, x0.z, x0.w, x1.x, x1.y, x1.z, x1.w};
            bf16_t* op = mix + (t0 + lb * 32 + 4 * h) * 1024 + 512 + hd * 64 + pb * 32 + r;
#pragma unroll
            for (int q4 = 0; q4 < 4; ++q4) {
                const float4 ea4 = *(const float4*)(F + 64 + lb * 32 + 8 * q4 + 4 * h);
                const float eav[4] = {ea4.x, ea4.y, ea4.z, ea4.w};
#pragma unroll
                for (int k = 0; k < 4; ++k) {
                    const int e = 4 * q4 + k;
                    const float xv = (e & 1) ? bfhi(xw[e >> 1]) : bflo(xw[e >> 1]);
                    const float y = yd[e] + eav[k] * yo[e] + Dh * xv;
                    op[(size_t)(k + 8 * q4) * 1024] = f2bf(y * siluf(bf2f(zr[e])));
                }
            }
        }
        {
            const float dec = F[64 + 63];
#pragma unroll
            for (int i = 0; i < 2; ++i) {
#pragma unroll
                for (int e = 0; e < 16; ++e) st[i][e] *= dec;
                const int nblk = 2 * (wave >> 1) + i;
#pragma unroll
                for (int ks = 0; ks < 4; ++ks) {
                    const bf16x8 av = *(const bf16x8*)(smem + SSD_XT + off128(pb * 32 + r, 16 * ks + 8 * h));
                    const bf16x8 bv = *(const bf16x8*)(smem + SSD_BWT + off128(nblk * 32 + r, 16 * ks + 8 * h));
                    st[i] = MFMA32(av, bv, st[i]);
                }
            }
        }
        __syncthreads();
#pragma unroll
        for (int i = 0; i < 2; ++i) {
            const int n = (2 * (wave >> 1) + i) * 32 + r;
#pragma unroll
            for (int e = 0; e < 16; ++e) *(bf16_t*)(smem + SSD_PS + off256(pb * 32 + crow(e, h), n)) = f2bf(st[i][e]);
        }
    }
    __syncthreads();
}

#if ATTN_NAIVE
DI void attn_naive(const P& p, int bid, int nb) {
    unsigned char* ws = p.ws;
    const bf16_t* Q = (const bf16_t*)(ws + QB); const bf16_t* Kn = (const bf16_t*)(ws + KNB); const bf16_t* Vt = (const bf16_t*)(ws + VTB);
    const bf16_t* Kr = (const bf16_t*)(ws + KROPE); bf16_t* mix = (bf16_t*)(ws + MIX);
    for (int item = bid; item < 128 * 8; item += nb) {
        const int bh = item >> 3, s_ = (item & 7) * 256 + tidx(), b = bh >> 3, hd = bh & 7;
        float q[96];
        {
            const uint4* q4 = (const uint4*)(Q + ((size_t)bh * 2048 + s_) * 96);
#pragma unroll
            for (int i = 0; i < 12; ++i) { const uint4 w = q4[i]; q[8 * i] = bflo(w.x); q[8 * i + 1] = bfhi(w.x); q[8 * i + 2] = bflo(w.y); q[8 * i + 3] = bfhi(w.y);
                q[8 * i + 4] = bflo(w.z); q[8 * i + 5] = bfhi(w.z); q[8 * i + 6] = bflo(w.w); q[8 * i + 7] = bfhi(w.w); }
        }
        float o[64];
#pragma unroll
        for (int d = 0; d < 64; ++d) o[d] = 0.f;
        float m = -1e30f, l = 0.f;
        const int nkeys = __builtin_amdgcn_readfirstlane(((s_ >> 6) + 1) * 64);
        for (int j0 = 0; j0 < nkeys; j0 += 8) {
            float sc[8];
#pragma unroll
            for (int jj = 0; jj < 8; ++jj) {
                const int j = j0 + jj;
                const uint4* k4 = (const uint4*)(Kn + ((size_t)bh * 2048 + j) * 64);
                const uint4* r4 = (const uint4*)(Kr + ((size_t)b * 2048 + j) * 32);
                float a = 0.f;
#pragma unroll
                for (int i = 0; i < 8; ++i) { const uint4 w = k4[i]; a += q[8 * i] * bflo(w.x) + q[8 * i + 1] * bfhi(w.x) + q[8 * i + 2] * bflo(w.y) + q[8 * i + 3] * bfhi(w.y)
                    + q[8 * i + 4] * bflo(w.z) + q[8 * i + 5] * bfhi(w.z) + q[8 * i + 6] * bflo(w.w) + q[8 * i + 7] * bfhi(w.w); }
#pragma unroll
                for (int i = 0; i < 4; ++i) { const uint4 w = r4[i]; const int o8 = 64 + 8 * i; a += q[o8] * bflo(w.x) + q[o8 + 1] * bfhi(w.x) + q[o8 + 2] * bflo(w.y) + q[o8 + 3] * bfhi(w.y)
                    + q[o8 + 4] * bflo(w.z) + q[o8 + 5] * bfhi(w.z) + q[o8 + 6] * bflo(w.w) + q[o8 + 7] * bfhi(w.w); }
                sc[jj] = a;
            }
            float mx = m;
#pragma unroll
            for (int jj = 0; jj < 8; ++jj) mx = fmaxf(mx, sc[jj]);
            const float al = exp2f(m - mx);
            float ps = 0.f;
#pragma unroll
            for (int jj = 0; jj < 8; ++jj) { sc[jj] = exp2f(sc[jj] - mx); ps += sc[jj]; }
            l = l * al + ps; m = mx;
#pragma unroll
            for (int d = 0; d < 64; ++d) {
                const uint4 w = *(const uint4*)(Vt + ((size_t)bh * 64 + d) * 2048 + j0);
                o[d] = o[d] * al + sc[0] * bflo(w.x) + sc[1] * bfhi(w.x) + sc[2] * bflo(w.y) + sc[3] * bfhi(w.y) + sc[4] * bflo(w.z) + sc[5] * bfhi(w.z) + sc[6] * bflo(w.w) + sc[7] * bfhi(w.w);
            }
        }
        const float il = 1.f / l;
        bf16_t* dst = mix + ((size_t)b * 2048 + s_) * 1024 + hd * 64;
#pragma unroll
        for (int d = 0; d < 64; d += 2) *(unsigned*)(dst + d) = pack2(o[d] * il, o[d + 1] * il);
    }
}
#endif
#if SSD_NAIVE
DI void ssd_naive(const P& p, int bid, int nb) {
    unsigned char* ws = p.ws;
    const bf16_t* xa = (const bf16_t*)(ws + XBCA); const float* dt = (const float*)(ws + DTB); const bf16_t* z = (const bf16_t*)(ws + ZB);
    bf16_t* mix = (bf16_t*)(ws + MIX);
    const int wave = tidx() >> 6, pp = tidx() & 63;
    for (int item = bid; item < 32; item += nb) {
        const int bh = item * 4 + wave, b = bh >> 3, hd = bh & 7, g = hd >> 2;
        const float a = -__expf(p.in[10][hd]), Dh = p.in[11][hd];
        float st[128];
#pragma unroll
        for (int n = 0; n < 128; ++n) st[n] = 0.f;
        for (int t = 0; t < 2048; ++t) {
            const size_t row = (size_t)b * 2048 + t;
            const float dtv = dt[row * 8 + hd];
            const float da = __expf(dtv * a);
            const float xv = bf2f(xa[row * 1024 + hd * 64 + pp]);
            const float xd = dtv * xv;
            const uint4* b4 = (const uint4*)(xa + row * 1024 + 512 + g * 128);
            const uint4* c4 = (const uint4*)(xa + row * 1024 + 768 + g * 128);
            float y = 0.f;
#pragma unroll
            for (int i = 0; i < 16; ++i) {
                const uint4 bw = b4[i], cw = c4[i];
                const unsigned bb[4] = {bw.x, bw.y, bw.z, bw.w}, cc[4] = {cw.x, cw.y, cw.z, cw.w};
#pragma unroll
                for (int k = 0; k < 4; ++k) {
                    const int n = 8 * i + 2 * k;
                    st[n] = da * st[n] + xd * bflo(bb[k]); y += bflo(cc[k]) * st[n];
                    st[n + 1] = da * st[n + 1] + xd * bfhi(bb[k]); y += bfhi(cc[k]) * st[n + 1];
                }
            }
            y += Dh * xv;
            const float zv = bf2f(z[row * 512 + hd * 64 + pp]);
            mix[row * 1024 + 512 + hd * 64 + pp] = f2bf(y * siluf(zv));
        }
    }
}
#endif
DI void phase_mixer(const P& p, int bid, int nb, unsigned char* smem, int rep = 0) {
#if SSD_NAIVE
    ssd_naive(p, bid, nb);
    attn_fast(p, bid, nb, smem);
#else
    unsigned* ctr = (unsigned*)(p.ws + CTL + CTL_CNT + 256) + 64 * rep;
    int* slot = (int*)(smem + GEMM_LDS + 2048 - 32);
    for (;;) {
        __syncthreads();
        if (tidx() == 0) *slot = (int)atomicAdd(ctr, 1u);
        __syncthreads();
        const int it = *slot;
        if (it >= 128 + 2048) break;
        if (it < 128) { if (!NO_SSD) ssd_item(p, it, smem); }
        else {
            const int idx = it - 128, qb = 15 - (idx >> 7), bh = idx & 127;
            unsigned char* ws = p.ws;
            SelfSrc s{(const bf16_t*)(ws + QB), (const bf16_t*)(ws + KNB), (const bf16_t*)(ws + KROPE), (const bf16_t*)(ws + VTB), (bf16_t*)(ws + MIX), bh >> 3, bh & 7, bh, qb * 128};
            if (!NO_FLASH) flash_item<96, 64, 64, 4, 1>(s, 2 * qb + 2, 2, smem);
        }
    }
#endif
}

DI void phase_ssdnorm(const P& p, int bid, int nb, unsigned char* smem) {
    bf16_t* mix = (bf16_t*)(p.ws + MIX);
    const int lane = tidx() & 63, wave = tidx() >> 6;
    for (int tk = bid * 4 + wave; tk < T; tk += nb * 4) {
        uint4* ptr = (uint4*)(mix + (size_t)tk * 1024 + 512 + lane * 8);
        const uint4 w = *ptr;
        const unsigned ww[4] = {w.x, w.y, w.z, w.w};
        float v[8]; float ss = 0.f;
#pragma unroll
        for (int k = 0; k < 4; ++k) { v[2 * k] = bflo(ww[k]); v[2 * k + 1] = bfhi(ww[k]); ss += v[2 * k] * v[2 * k] + v[2 * k + 1] * v[2 * k + 1]; }
#pragma unroll
        for (int o = 16; o >= 1; o >>= 1) ss += __shfl_xor(ss, o);
        const float rr = rsqrtf(ss * (1.f / 256.f) + EPS);
        uint4 o4; o4.x = pack2(v[0] * rr, v[1] * rr); o4.y = pack2(v[2] * rr, v[3] * rr); o4.z = pack2(v[4] * rr, v[5] * rr); o4.w = pack2(v[6] * rr, v[7] * rr);
        *ptr = o4;
    }
}

struct EpiResid {
    float* pre; const float* res;
    DI void operator()(const f32x16 (&acc)[2][2], int rb, int cb, int lane) const {
        const int r = lane & 31, h = lane >> 5;
#pragma unroll
        for (int i = 0; i < 2; ++i)
#pragma unroll
            for (int j = 0; j < 2; ++j) {
                const int col = cb + j * 32 + r;
#pragma unroll
                for (int e = 0; e < 16; ++e) {
                    const size_t idx = (size_t)(rb + i * 32 + crow(e, h)) * 1024 + col;
                    pre[idx] = ALPHA * res[idx] + acc[i][j][e];
                }
            }
    }
};
DI void phase_wout(const P& p, int bid, int nb, unsigned char* smem) {
    const int v = vbid(bid, nb);
    EpiResid e{p.out, p.in[0]};
    GemmArgs g{(const bf16_t*)(p.ws + MIX), 1024, (const bf16_t*)(p.ws + W_OUT), 1024, 1024, nullptr};
    for (int t = v; t < 256 * 8; t += nb) gemm_tile(g, (t >> 3) * 128, (t & 7) * 128, e, smem);
}
DI void ln_row(const float* src, const float* gam, const float* bet, int lane, float (&o)[16]) {
    float v[16];
#pragma unroll
    for (int i = 0; i < 4; ++i) { const float4 t4 = *(const float4*)(src + i * 256 + lane * 4); v[4 * i] = t4.x; v[4 * i + 1] = t4.y; v[4 * i + 2] = t4.z; v[4 * i + 3] = t4.w; }
    float s = 0.f;
#pragma unroll
    for (int i = 0; i < 16; ++i) s += v[i];
    const float mu = wave_sum(s) * (1.f / 1024.f);
    float q = 0.f;
#pragma unroll
    for (int i = 0; i < 16; ++i) { const float d = v[i] - mu; q += d * d; }
    const float rstd = rsqrtf(wave_sum(q) * (1.f / 1024.f) + EPS);
#pragma unroll
    for (int i = 0; i < 4; ++i) {
        const float4 g4 = *(const float4*)(gam + i * 256 + lane * 4), b4 = *(const float4*)(bet + i * 256 + lane * 4);
        o[4 * i] = (v[4 * i] - mu) * rstd * g4.x + b4.x; o[4 * i + 1] = (v[4 * i + 1] - mu) * rstd * g4.y + b4.y;
        o[4 * i + 2] = (v[4 * i + 2] - mu) * rstd * g4.z + b4.z; o[4 * i + 3] = (v[4 * i + 3] - mu) * rstd * g4.w + b4.w;
    }
}
DI void phase_ln1(const P& p, int bid, int nb, unsigned char* smem) {
    const int lane = tidx() & 63, wave = tidx() >> 6;
    float* hf = (float*)(p.ws + H1); bf16_t* hb = (bf16_t*)(p.ws + H1B);
    for (int tk = bid * 4 + wave; tk < T; tk += nb * 4) {
        float o[16];
        ln_row(p.out + (size_t)tk * 1024, p.in[14], p.in[15], lane, o);
#pragma unroll
        for (int i = 0; i < 4; ++i) {
            *(float4*)(hf + (size_t)tk * 1024 + i * 256 + lane * 4) = make_float4(o[4 * i], o[4 * i + 1], o[4 * i + 2], o[4 * i + 3]);
            uint2 w; w.x = pack2(o[4 * i], o[4 * i + 1]); w.y = pack2(o[4 * i + 2], o[4 * i + 3]);
            *(uint2*)(hb + (size_t)tk * 1024 + i * 256 + lane * 4) = w;
        }
    }
}
struct EpiXq {
    bf16_t* qx;
    DI void operator()(const f32x16 (&acc)[2][2], int rb, int cb, int lane) const {
        const int r = lane & 31, h = lane >> 5;
#pragma unroll
        for (int i = 0; i < 2; ++i)
#pragma unroll
            for (int j = 0; j < 2; ++j) {
                const int col = cb + j * 32 + r, hd = col >> 8, d = col & 255;
#pragma unroll
                for (int e = 0; e < 16; ++e) {
                    const int row = rb + i * 32 + crow(e, h), b = row >> 11, s_ = row & 2047;
                    qx[((size_t)(b * 4 + hd) * 2048 + s_) * 256 + d] = f2bf(acc[i][j][e] * XSCALE);
                }
            }
    }
};
DI void phase_xq(const P& p, int bid, int nb, unsigned char* smem) {
    const int v = vbid(bid, nb);
    EpiXq e{(bf16_t*)(p.ws + QX)};
    GemmArgs g{(const bf16_t*)(p.ws + H1B), 1024, (const bf16_t*)(p.ws + W_XQ), 1024, 1024, nullptr};
    for (int t = v; t < 256 * 8; t += nb) gemm_tile(g, (t >> 3) * 128, (t & 7) * 128, e, smem);
}
DI void phase_xattn(const P& p, int bid, int nb, unsigned char* smem) {
#if !XATTN_NAIVE
    xattn_fast(p, bid, nb, smem); return;
#endif
    unsigned char* ws = p.ws;
    const bf16_t* qx = (const bf16_t*)(ws + QX); const bf16_t* kx = (const bf16_t*)(ws + KX); const bf16_t* vxt = (const bf16_t*)(ws + VXT);
    bf16_t* ox = (bf16_t*)(ws + OX);
    const int lane = tidx() & 63, hd = tidx() >> 6;
    float* qs = (float*)smem + hd * 512; float* ps = qs + 256;
    for (int tk = bid; tk < T; tk += nb) {
        const int b = tk >> 11, s_ = tk & 2047;
        __syncthreads();
        {
            const uint2 w = *(const uint2*)(qx + ((size_t)(b * 4 + hd) * 2048 + s_) * 256 + lane * 4);
            qs[lane * 4] = bflo(w.x); qs[lane * 4 + 1] = bfhi(w.x); qs[lane * 4 + 2] = bflo(w.y); qs[lane * 4 + 3] = bfhi(w.y);
        }
        __syncthreads();
        float sc[4];
#pragma unroll
        for (int i = 0; i < 4; ++i) {
            const int m = lane + 64 * i;
            const uint4* k4 = (const uint4*)(kx + ((size_t)(b * 4 + hd) * 256 + m) * 256);
            float a = 0.f;
#pragma unroll 8
            for (int c = 0; c < 32; ++c) {
                const uint4 w = k4[c];
                const float4 q0 = *(const float4*)(qs + 8 * c), q1 = *(const float4*)(qs + 8 * c + 4);
                a += q0.x * bflo(w.x) + q0.y * bfhi(w.x) + q0.z * bflo(w.y) + q0.w * bfhi(w.y) + q1.x * bflo(w.z) + q1.y * bfhi(w.z) + q1.z * bflo(w.w) + q1.w * bfhi(w.w);
            }
            sc[i] = a;
        }
        const float mx = wave_max(fmaxf(fmaxf(sc[0], sc[1]), fmaxf(sc[2], sc[3])));
        float sum = 0.f;
#pragma unroll
        for (int i = 0; i < 4; ++i) { sc[i] = exp2f(sc[i] - mx); sum += sc[i]; }
        const float il = 1.f / wave_sum(sum);
#pragma unroll
        for (int i = 0; i < 4; ++i) ps[lane + 64 * i] = sc[i] * il;
        __syncthreads();
        float o[4];
#pragma unroll
        for (int dd = 0; dd < 4; ++dd) {
            const int d = lane * 4 + dd;
            const uint4* v4 = (const uint4*)(vxt + ((size_t)(b * 4 + hd) * 256 + d) * 256);
            float a = 0.f;
#pragma unroll 8
            for (int c = 0; c < 32; ++c) {
                const uint4 w = v4[c];
                const float4 q0 = *(const float4*)(ps + 8 * c), q1 = *(const float4*)(ps + 8 * c + 4);
                a += q0.x * bflo(w.x) + q0.y * bfhi(w.x) + q0.z * bflo(w.y) + q0.w * bfhi(w.y) + q1.x * bflo(w.z) + q1.y * bfhi(w.z) + q1.z * bflo(w.w) + q1.w * bfhi(w.w);
            }
            o[dd] = a;
        }
        uint2 w; w.x = pack2(o[0], o[1]); w.y = pack2(o[2], o[3]);
        *(uint2*)(ox + (size_t)tk * 1024 + hd * 256 + lane * 4) = w;
    }
}
DI void phase_xo(const P& p, int bid, int nb, unsigned char* smem) {
    const int v = vbid(bid, nb);
    EpiResid e{p.out, (const float*)(p.ws + H1)};
    GemmArgs g{(const bf16_t*)(p.ws + OX), 1024, (const bf16_t*)(p.ws + W_XO), 1024, 1024, nullptr};
    for (int t = v; t < 256 * 8; t += nb) gemm_tile(g, (t >> 3) * 128, (t & 7) * 128, e, smem);
}
typedef float f32x4v __attribute__((ext_vector_type(4)));
DI void phase_ln2_router(const P& p, int bid, int nb, unsigned char* smem) {
    unsigned char* ws = p.ws;
    const int lane = tidx() & 63, wave = tidx() >> 6;
    float* hf = (float*)(ws + H2); bf16_t* hb = (bf16_t*)(ws + H2B);
    const float* wrt = (const float*)(ws + W_RT);
    const float* gam = p.in[20]; const float* bet = p.in[21];
    unsigned* cnt = (unsigned*)(ws + CTL + CTL_CNT); int* lists = (int*)(ws + LISTS); float* tgate = (float*)(ws + TOK_GATE);
    float* lg = (float*)smem + wave * (16 * 52 + 32);
    float* stt = lg + 16 * 52;
    for (int grp = bid; grp < T / 64; grp += nb) {
        const int t0 = grp * 64 + wave * 16;
        for (int rr = 0; rr < 16; ++rr) {
            const int tk = t0 + rr;
            const float* srcp = p.out + (size_t)tk * 1024;
            float v[16];
#pragma unroll
            for (int i = 0; i < 4; ++i) { const float4 t4 = *(const float4*)(srcp + i * 256 + lane * 4); v[4 * i] = t4.x; v[4 * i + 1] = t4.y; v[4 * i + 2] = t4.z; v[4 * i + 3] = t4.w; }
            float s = 0.f;
#pragma unroll
            for (int i = 0; i < 16; ++i) s += v[i];
            const float mu = wave_sum(s) * (1.f / 1024.f);
            float q = 0.f;
#pragma unroll
            for (int i = 0; i < 16; ++i) { const float d = v[i] - mu; q += d * d; }
            const float rstd = rsqrtf(wave_sum(q) * (1.f / 1024.f) + EPS);
            if (lane == 0) { stt[2 * rr] = mu; stt[2 * rr + 1] = rstd; }
#pragma unroll
            for (int i = 0; i < 4; ++i) {
                const float4 g4 = *(const float4*)(gam + i * 256 + lane * 4), b4 = *(const float4*)(bet + i * 256 + lane * 4);
                const float o0 = (v[4 * i] - mu) * rstd * g4.x + b4.x, o1 = (v[4 * i + 1] - mu) * rstd * g4.y + b4.y;
                const float o2 = (v[4 * i + 2] - mu) * rstd * g4.z + b4.z, o3 = (v[4 * i + 3] - mu) * rstd * g4.w + b4.w;
                *(float4*)(hf + (size_t)tk * 1024 + i * 256 + lane * 4) = make_float4(o0, o1, o2, o3);
                uint2 w; w.x = pack2(o0, o1); w.y = pack2(o2, o3);
                *(uint2*)(hb + (size_t)tk * 1024 + i * 256 + lane * 4) = w;
            }
        }
        __builtin_amdgcn_wave_barrier();
        {
            const int i16 = lane & 15, g4i = lane >> 4;
            const float mu = stt[2 * i16], rstd = stt[2 * i16 + 1];
            const float* arow = p.out + (size_t)(t0 + i16) * 1024 + 4 * g4i;
            const float* brow = wrt + (size_t)i16 * 1024 + 4 * g4i;
            const float* grow = gam + 4 * g4i; const float* berow = bet + 4 * g4i;
            f32x4v acc0 = {0.f, 0.f, 0.f, 0.f}, acc1 = acc0, acc2 = acc0;
#pragma unroll 2
            for (int S = 0; S < 64; ++S) {
                const float4 x4 = *(const float4*)(arow + 16 * S), g4 = *(const float4*)(grow + 16 * S), e4 = *(const float4*)(berow + 16 * S);
                const float4 b0 = *(const float4*)(brow + 16 * S), b1 = *(const float4*)(brow + 16 * 1024 + 16 * S), b2 = *(const float4*)(brow + 32 * 1024 + 16 * S);
                const float a0 = (x4.x - mu) * rstd * g4.x + e4.x, a1 = (x4.y - mu) * rstd * g4.y + e4.y, a2 = (x4.z - mu) * rstd * g4.z + e4.z, a3 = (x4.w - mu) * rstd * g4.w + e4.w;
                acc0 = __builtin_amdgcn_mfma_f32_16x16x4f32(a0, b0.x, acc0, 0, 0, 0); acc1 = __builtin_amdgcn_mfma_f32_16x16x4f32(a0, b1.x, acc1, 0, 0, 0); acc2 = __builtin_amdgcn_mfma_f32_16x16x4f32(a0, b2.x, acc2, 0, 0, 0);
                acc0 = __builtin_amdgcn_mfma_f32_16x16x4f32(a1, b0.y, acc0, 0, 0, 0); acc1 = __builtin_amdgcn_mfma_f32_16x16x4f32(a1, b1.y, acc1, 0, 0, 0); acc2 = __builtin_amdgcn_mfma_f32_16x16x4f32(a1, b2.y, acc2, 0, 0, 0);
                acc0 = __builtin_amdgcn_mfma_f32_16x16x4f32(a2, b0.z, acc0, 0, 0, 0); acc1 = __builtin_amdgcn_mfma_f32_16x16x4f32(a2, b1.z, acc1, 0, 0, 0); acc2 = __builtin_amdgcn_mfma_f32_16x16x4f32(a2, b2.z, acc2, 0, 0, 0);
                acc0 = __builtin_amdgcn_mfma_f32_16x16x4f32(a3, b0.w, acc0, 0, 0, 0); acc1 = __builtin_amdgcn_mfma_f32_16x16x4f32(a3, b1.w, acc1, 0, 0, 0); acc2 = __builtin_amdgcn_mfma_f32_16x16x4f32(a3, b2.w, acc2, 0, 0, 0);
            }
#pragma unroll
            for (int e = 0; e < 4; ++e) {
                float* rowp = lg + (4 * g4i + e) * 52 + i16;
                rowp[0] = acc0[e]; rowp[16] = acc1[e]; rowp[32] = acc2[e];
            }
        }
        __builtin_amdgcn_wave_barrier();
        if (lane < 16) {
            const int tk = t0 + lane;
            const float* lr = lg + lane * 52;
            float gl[4], el[32];
#pragma unroll
            for (int j = 0; j < 4; ++j) gl[j] = lr[j] + p.in[23][j];
#pragma unroll
            for (int j = 0; j < 32; ++j) el[j] = lr[4 + j] + p.in[25][j];
            int gi = 0; float gm = gl[0];
#pragma unroll
            for (int j = 1; j < 4; ++j) if (gl[j] > gm) { gm = gl[j]; gi = j; }
            float gs = 0.f;
#pragma unroll
            for (int j = 0; j < 4; ++j) gs += __expf(gl[j] - gm);
            const float ggate = 1.f / gs;
            float ev[8];
#pragma unroll
            for (int j = 0; j < 8; ++j) ev[j] = gi == 0 ? el[j] : gi == 1 ? el[8 + j] : gi == 2 ? el[16 + j] : el[24 + j];
            int i1 = 0; float v1 = ev[0];
#pragma unroll
            for (int j = 1; j < 8; ++j) if (ev[j] > v1) { v1 = ev[j]; i1 = j; }
            int i2 = -1; float v2 = -3.0e38f;
#pragma unroll
            for (int j = 0; j < 8; ++j) if (j != i1 && ev[j] > v2) { v2 = ev[j]; i2 = j; }
            const float e2 = __expf(v2 - v1);
            const float g1 = ggate / (1.f + e2), g2 = ggate * e2 / (1.f + e2);
            const int ex1 = gi * 8 + i1, ex2 = gi * 8 + i2;
            const unsigned p1 = atomicAdd(&cnt[ex1], 1u); lists[(size_t)ex1 * T + p1] = tk * 2;
            const unsigned p2 = atomicAdd(&cnt[ex2], 1u); lists[(size_t)ex2 * T + p2] = tk * 2 + 1;
            tgate[tk * 2] = g1; tgate[tk * 2 + 1] = g2;
        }
        __builtin_amdgcn_wave_barrier();
    }
}
struct MoeMap { int off[33]; };
DI int moe_tiles(const unsigned* cnt, int* offs  ) {
    __syncthreads();
    if (tidx() == 0) { int o = 0; for (int e = 0; e < 32; ++e) { offs[e] = o; o += (((int)cnt[e] + 127) >> 7) << 7; } offs[32] = o; }
    __syncthreads();
    return offs[32] >> 7;
}
struct EpiGU {
    bf16_t* hdn;
    DI void operator()(const f32x16 (&acc)[2][2], int rb, int cb, int lane) const {
        const int r = lane & 31, h = lane >> 5;
        const int hc = ((cb & 511) >> 7) * 64 + ((cb >> 6) & 1) * 32 + r;
#pragma unroll
        for (int i = 0; i < 2; ++i)
#pragma unroll
            for (int e = 0; e < 16; ++e) {
                const int slot = rb + i * 32 + crow(e, h);
                hdn[(size_t)slot * 256 + hc] = f2bf(siluf(acc[i][0][e]) * acc[i][1][e]);
            }
    }
};
struct EpiDown {
    bf16_t* y; const int* ltok; const float* lgate; int m0;
    DI void operator()(const f32x16 (&acc)[2][2], int rb, int cb, int lane) const {
        const int r = lane & 31, h = lane >> 5;
#pragma unroll
        for (int i = 0; i < 2; ++i)
#pragma unroll
            for (int e = 0; e < 16; ++e) {
                const int lr = rb - m0 + i * 32 + crow(e, h);
                const int tk2 = ltok[lr];
                if (tk2 >= 0) {
                    const float gt = lgate[lr];
#pragma unroll
                    for (int j = 0; j < 2; ++j) y[(size_t)tk2 * 1024 + cb + j * 32 + r] = f2bf(gt * acc[i][j][e]);
                }
            }
    }
};
template <int WHICH>
DI void phase_moe(const P& p, int bid, int nb, unsigned char* smem) {
    unsigned char* ws = p.ws;
    const unsigned* cnt = (const unsigned*)(ws + CTL + CTL_CNT); const int* lists = (const int*)(ws + LISTS); const float* tgate = (const float*)(ws + TOK_GATE);
    int* offs = (int*)(smem + GEMM_LDS); int* ltok = offs + 64; int* lrow = ltok + 128; float* lgate = (float*)(lrow + 128);
    const int nmt = moe_tiles(cnt, offs);
    constexpr int NNT = WHICH == 0 ? 4 : 8;
    const int v = vbid(bid, nb);
    for (int t = v; t < nmt * NNT; t += nb) {
        const int mt = t / NNT, ntl = t % NNT;
        const int slot0 = mt * 128;
        int e = 0;
        while (offs[e + 1] <= slot0) ++e;
        __syncthreads();
        if (tidx() < 128) {
            const int pos = slot0 - offs[e] + tidx();
            const int tk2 = pos < (int)cnt[e] ? lists[(size_t)e * T + pos] : -1;
            ltok[tidx()] = tk2; lrow[tidx()] = tk2 < 0 ? 0 : (tk2 >> 1); lgate[tidx()] = tk2 < 0 ? 0.f : tgate[tk2];
        }
        __syncthreads();
        if (WHICH == 0) {
            EpiGU ep{(bf16_t*)(ws + HDN)};
            GemmArgs g{(const bf16_t*)(ws + H2B), 1024, (const bf16_t*)(ws + W_GU) + (size_t)e * 512 * 1024, 1024, 1024, lrow};
            gemm_tile(g, slot0, ntl * 128, ep, smem);
        } else {
            EpiDown ep{(bf16_t*)(ws + YB), ltok, lgate, slot0};
            GemmArgs g{(const bf16_t*)(ws + HDN), 256, (const bf16_t*)(ws + W_DN) + (size_t)e * 1024 * 256, 256, 256, nullptr};
            gemm_tile(g, slot0, ntl * 128, ep, smem);
        }
    }
}
DI void phase_final(const P& p, int bid, int nb, unsigned char* smem) {
    const int lane = tidx() & 63, wave = tidx() >> 6;
    const float* hf = (const float*)(p.ws + H2); const bf16_t* y = (const bf16_t*)(p.ws + YB);
    const float* gam = p.in[29]; const float* bet = p.in[30];
    for (int tk = bid * 4 + wave; tk < T; tk += nb * 4) {
        float v[16];
#pragma unroll
        for (int i = 0; i < 4; ++i) {
            const float4 t4 = *(const float4*)(hf + (size_t)tk * 1024 + i * 256 + lane * 4);
            const uint2 a = *(const uint2*)(y + (size_t)(tk * 2) * 1024 + i * 256 + lane * 4), b = *(const uint2*)(y + (size_t)(tk * 2 + 1) * 1024 + i * 256 + lane * 4);
            v[4 * i] = ALPHA * t4.x + bflo(a.x) + bflo(b.x); v[4 * i + 1] = ALPHA * t4.y + bfhi(a.x) + bfhi(b.x);
            v[4 * i + 2] = ALPHA * t4.z + bflo(a.y) + bflo(b.y); v[4 * i + 3] = ALPHA * t4.w + bfhi(a.y) + bfhi(b.y);
        }
        float s = 0.f;
#pragma unroll
        for (int i = 0; i < 16; ++i) s += v[i];
        const float mu = wave_sum(s) * (1.f / 1024.f);
        float q = 0.f;
#pragma unroll
        for (int i = 0; i < 16; ++i) { const float d = v[i] - mu; q += d * d; }
        const float rstd = rsqrtf(wave_sum(q) * (1.f / 1024.f) + EPS);
#pragma unroll
        for (int i = 0; i < 4; ++i) {
            const float4 g4 = *(const float4*)(gam + i * 256 + lane * 4), b4 = *(const float4*)(bet + i * 256 + lane * 4);
            *(float4*)(p.out + (size_t)tk * 1024 + i * 256 + lane * 4) = make_float4((v[4 * i] - mu) * rstd * g4.x + b4.x, (v[4 * i + 1] - mu) * rstd * g4.y + b4.y,
                                                                                    (v[4 * i + 2] - mu) * rstd * g4.z + b4.z, (v[4 * i + 3] - mu) * rstd * g4.w + b4.w);
        }
    }
}

#define XB_TMO      128
#define XB_XCNT(j)  (256  + 64 * (j))
#define XB_XSUB(j)  (1280 + 64 * (j))
#define XB_XGEN(j)  (2304 + 64 * (j))
#define XB_TOP      3328
#define XB_TOPGEN   3392
#define XCD_BAR_WORDS 3456
#define XB_SPIN_CAP (1u << 25)
DI unsigned xb_ld(unsigned* p) { return __hip_atomic_load(p, __ATOMIC_RELAXED, __HIP_MEMORY_SCOPE_AGENT); }
DI unsigned xb_add(unsigned* p, unsigned v) { return __hip_atomic_fetch_add(p, v, __ATOMIC_RELAXED, __HIP_MEMORY_SCOPE_AGENT); }
DI unsigned xb_xcc_id() { return (unsigned)__builtin_amdgcn_s_getreg((3 << 11) | 20) & 0xFu; }
#define XB_SPIN(cond, bar) do { unsigned _sp = 0; while (cond) { __builtin_amdgcn_s_sleep(1); \
    if ((++_sp & 255u) == 0u) { if (xb_ld(&(bar)[XB_TMO])) break; if (_sp > XB_SPIN_CAP) { atomicAdd(&(bar)[XB_TMO], 1u); break; } } } } while (0)
struct XcdBarrier { unsigned* bar; unsigned x; volatile LAS unsigned* st; };
DI XcdBarrier xcd_barrier_post(unsigned* bar, volatile LAS unsigned* st) {
    XcdBarrier b; b.bar = bar; b.x = xb_xcc_id(); b.st = st;
    if (threadIdx.x == 0) (void)xb_add(&bar[XB_XCNT(b.x)], 1u);
    return b;
}
DI void xcd_barrier_complete(unsigned* bar, unsigned x, unsigned& nloc, unsigned& nx) {
    const unsigned G = gridDim.x * gridDim.y * gridDim.z;
    unsigned sum, cnt, mine, sp = 0u;
    for (;;) {
        sum = 0u; cnt = 0u; mine = 0u;
#pragma unroll
        for (unsigned j = 0; j < 16; ++j) { const unsigned c = xb_ld(&bar[XB_XCNT(j)]); sum += c; cnt += (c > 0u) ? 1u : 0u; mine = (j == x) ? c : mine; }
        if (sum == G) break;
        __builtin_amdgcn_s_sleep(1);
        if ((++sp & 255u) == 0u) { if (xb_ld(&bar[XB_TMO])) break; if (sp > XB_SPIN_CAP) { atomicAdd(&bar[XB_TMO], 1u); break; } }
    }
    nloc = mine > 0u ? mine : 1u; nx = cnt > 0u ? cnt : 1u;
}
DI void xcd_barrier(const XcdBarrier& b) {
    asm volatile("s_waitcnt vmcnt(0)" ::: "memory");
    __syncthreads();
    if (threadIdx.x == 0) {
        unsigned* bar = b.bar;
        __builtin_amdgcn_s_waitcnt(0);
        unsigned nloc = b.st[0], nx = b.st[1];
        if (nloc == 0u) { xcd_barrier_complete(bar, b.x, nloc, nx); b.st[0] = nloc; b.st[1] = nx; }
        const unsigned old = xb_add(&bar[XB_XSUB(b.x)], 1u);
        const unsigned gen = old / nloc;
        if (old + 1u == (gen + 1u) * nloc) {
            __builtin_amdgcn_fence(__ATOMIC_RELEASE, "agent");
            asm volatile("s_waitcnt vmcnt(0)" ::: "memory");
            const unsigned og = xb_add(&bar[XB_TOP], 1u);
            const unsigned tg = og / nx;
            if (og + 1u == (tg + 1u) * nx) xb_add(&bar[XB_TOPGEN], 1u);
            else XB_SPIN(xb_ld(&bar[XB_TOPGEN]) == tg, bar);
            __builtin_amdgcn_fence(__ATOMIC_ACQUIRE, "agent");
            xb_add(&bar[XB_XGEN(b.x)], 1u);
            asm volatile("s_waitcnt vmcnt(0)" ::: "memory");
        } else {
            XB_SPIN(xb_ld(&bar[XB_XGEN(b.x)]) == gen, bar);
            __builtin_amdgcn_fence(__ATOMIC_ACQUIRE, "agent");
            asm volatile("s_waitcnt vmcnt(0)" ::: "memory");
        }
    }
    __syncthreads();
}

constexpr int NPHASE = 14;
template <int PH>
DI void run_phase(const P& p, int bid, int nb, unsigned char* smem, int rep = 0) {
    if (PH == 0) phase_prep(p, bid, nb, smem);
    else if (PH == 1) phase_proj(p, bid, nb, smem);
    else if (PH == 2) phase_up(p, bid, nb, smem);
    else if (PH == 3) phase_mixer(p, bid, nb, smem, rep);
    else if (PH == 4) phase_ssdnorm(p, bid, nb, smem);
    else if (PH == 5) phase_wout(p, bid, nb, smem);
    else if (PH == 6) phase_ln1(p, bid, nb, smem);
    else if (PH == 7) phase_xq(p, bid, nb, smem);
    else if (PH == 8) phase_xattn(p, bid, nb, smem);
    else if (PH == 9) phase_xo(p, bid, nb, smem);
    else if (PH == 10) phase_ln2_router(p, bid, nb, smem);
    else if (PH == 11) phase_moe<0>(p, bid, nb, smem);
    else if (PH == 12) phase_moe<1>(p, bid, nb, smem);
    else if (PH == 13) phase_final(p, bid, nb, smem);
}
template <int PH>
__global__ void __launch_bounds__(256, 2) k_phase(P p) {
    __shared__ __attribute__((aligned(16))) unsigned char smem[SMEM_BYTES];
    run_phase<PH>(p, blockIdx.x, gridDim.x, smem);
}

#if MEGA
#ifndef MEGA_WAVES
#define MEGA_WAVES 2
#endif
template <int PH>
DI void mega_steps(const P& p, const XcdBarrier& bar, unsigned char* smem) {
    run_phase<PH>(p, blockIdx.x, gridDim.x, smem);
    if constexpr (((REPEAT_MASK >> PH) & 1) != 0) { xcd_barrier(bar); run_phase<PH>(p, blockIdx.x, gridDim.x, smem, 1); }
    if constexpr (PH + 1 < NPHASE) { xcd_barrier(bar); mega_steps<PH + 1>(p, bar, smem); }
}
__global__ void __launch_bounds__(256, MEGA_WAVES) k_mega(P p) {
    __shared__ __attribute__((aligned(16))) unsigned char smem[SMEM_BYTES];
    volatile LAS unsigned* st = (volatile LAS unsigned*)(smem + SMEM_BYTES - 16);
    if (threadIdx.x < 4) st[threadIdx.x] = 0u;
    __syncthreads();
    const XcdBarrier bar = xcd_barrier_post((unsigned*)(p.ws + CTL), st);
    mega_steps<0>(p, bar, smem);
}
#endif
template <int PH>
__global__ void __launch_bounds__(256, 1) k_phase_big(P p) {
    __shared__ __attribute__((aligned(16))) unsigned char smem[SMEM_BYTES];
    run_phase<PH>(p, blockIdx.x, gridDim.x, smem);
}
template <int PH>
static void launch_phase(const P& p, int grid, hipStream_t st) {
    if constexpr (PH == 3 && !P3_SMALL) hipLaunchKernelGGL((k_phase_big<PH>), dim3(grid), dim3(256), 0, st, p);
    else hipLaunchKernelGGL((k_phase<PH>), dim3(grid), dim3(256), 0, st, p);
}

extern "C" void kernel_launch(void* const* d_in, const int* in_sizes, int n_in, void* d_out, int out_size, void* d_ws, size_t ws_size, hipStream_t stream) {
    if (n_in != 31 || out_size != T * D || ws_size < WS_NEED) {
        fprintf(stderr, "kernel_launch: unexpected shapes: n_in %d out %d ws %zu (need %zu)\n", n_in, out_size, ws_size, (size_t)WS_NEED);
        return;
    }
    P p{};
    for (int i = 0; i < 31; ++i) p.in[i] = (const float*)d_in[i];
    p.out = (float*)d_out; p.ws = (unsigned char*)d_ws;
    (void)hipMemsetAsync((unsigned char*)d_ws + CTL, 0, CTL_BYTES, stream);
#if MEGA
    static int grid = 0;
    if (grid == 0) {
        int dev = 0, cus = 0, per_cu = 0;
        (void)hipGetDevice(&dev);
        (void)hipDeviceGetAttribute(&cus, hipDeviceAttributeMultiprocessorCount, dev);
        if (hipOccupancyMaxActiveBlocksPerMultiprocessor(&per_cu, (const void*)k_mega, 256, 0) != hipSuccess || per_cu < 1) { fprintf(stderr, "kernel_launch: occupancy query failed\n"); per_cu = 1; }
        if (per_cu > 2) per_cu = 2;
        grid = cus * per_cu;
        fprintf(stderr, "kernel_launch: mega grid %d (%d CUs x %d)\n", grid, cus, per_cu);
    }
    void* args[] = {(void*)&p};
    const hipError_t le = hipLaunchCooperativeKernel((const void*)k_mega, dim3(grid), dim3(256), args, 0, stream);
    if (le != hipSuccess) fprintf(stderr, "kernel_launch: cooperative launch failed: %s (grid %d)\n", hipGetErrorString(le), grid);
#else
    const int grid = 1024;
    launch_phase<0>(p, grid, stream); launch_phase<1>(p, grid, stream); launch_phase<2>(p, grid, stream); launch_phase<3>(p, grid, stream);
    launch_phase<4>(p, grid, stream); launch_phase<5>(p, grid, stream); launch_phase<6>(p, grid, stream); launch_phase<7>(p, grid, stream);
    launch_phase<8>(p, grid, stream); launch_phase<9>(p, grid, stream); launch_phase<10>(p, grid, stream); launch_phase<11>(p, grid, stream);
    launch_phase<12>(p, grid, stream); launch_phase<13>(p, grid, stream);
#endif
}
```

```cpp
#include <hip/hip_runtime.h>
#include <stdint.h>
#include <stdio.h>

#ifndef MEGA
#define MEGA 1
#endif
#ifndef ATTN_NAIVE
#define ATTN_NAIVE 0
#endif
#ifndef XATTN_NAIVE
#define XATTN_NAIVE 0
#endif
#ifndef SSD_NAIVE
#define SSD_NAIVE 0
#endif
#ifndef P3_SMALL
#define P3_SMALL 1
#endif
#ifndef NO_SSD
#define NO_SSD 0
#endif
#ifndef NO_FLASH
#define NO_FLASH 0
#endif
#ifndef GEMM_GLDS
#define GEMM_GLDS 1
#endif
#ifndef REPEAT_MASK
#define REPEAT_MASK 0
#endif
#ifndef REP_MODE
#define REP_MODE 0
#endif
#ifndef GEMM_DIRECT
#define GEMM_DIRECT 0
#endif

typedef unsigned short bf16_t;
typedef short bf16x8 __attribute__((ext_vector_type(8)));
typedef float f32x16 __attribute__((ext_vector_type(16)));
#define DI __device__ __forceinline__
#define LAS __attribute__((address_space(3)))
#define MFMA32(a, b, c) __builtin_amdgcn_mfma_f32_32x32x16_bf16((a), (b), (c), 0, 0, 0)

constexpr int Bn = 16, S = 2048, T = Bn * S, D = 1024;
constexpr int NMEM = 256;
constexpr float EPS = 1e-5f;
constexpr float ALPHA = 1.189207115002721f;
constexpr float LOG2E = 1.4426950408889634f;
constexpr float QSCALE = 0.10206207261596577f * LOG2E;
constexpr float XSCALE = 0.0625f * LOG2E;
constexpr int NEXP = 32;
constexpr int MAXSLOTS = 69632;

constexpr size_t MiB = 1u << 20;
constexpr size_t W_IN = 0;
constexpr size_t W_QUP = W_IN + 4 * MiB;
constexpr size_t W_KVUP = W_QUP + 768 * 256 * 2;
constexpr size_t W_OUT = W_KVUP + 1024 * 128 * 2;
constexpr size_t W_XQ = W_OUT + 2 * MiB;
constexpr size_t W_XKV = W_XQ + 2 * MiB;
constexpr size_t W_XO = W_XKV + 4 * MiB;
constexpr size_t W_GU = W_XO + 2 * MiB;
constexpr size_t W_DN = W_GU + 32 * MiB;
constexpr size_t W_RT = W_DN + 16 * MiB;
constexpr size_t ROPE_C = W_RT + 48 * 1024 * 4;
constexpr size_t ROPE_S = ROPE_C + 2048 * 16 * 4;
constexpr size_t TOK_GATE = ROPE_S + 2048 * 16 * 4;
constexpr size_t CTL = TOK_GATE + (size_t)T * 2 * 4;
constexpr size_t CTL_BYTES = 32768;
constexpr size_t CTL_CNT = 16384;
static_assert(CTL + CTL_BYTES <= 64 * MiB, "weights region overflow");
constexpr size_t RA = 64 * MiB, RB = 192 * MiB, RC = 320 * MiB, RD = 448 * MiB, WS_NEED = 512 * MiB;
constexpr size_t XBC = RA;
constexpr size_t KX = RA + 64 * MiB;
constexpr size_t VXT = KX + 8 * MiB;
constexpr size_t YB = RA;
constexpr size_t QB = RB;
constexpr size_t KNB = RB + 48 * MiB;
constexpr size_t VTB = KNB + 32 * MiB;
constexpr size_t H1 = RB;
constexpr size_t H2 = RB;
constexpr size_t XB = RC;
constexpr size_t MEMB = RB;
constexpr size_t XBCA = RC;
constexpr size_t MIX = RC + 64 * MiB;
constexpr size_t H1B = RC;
constexpr size_t QX = RC + 64 * MiB;
constexpr size_t OX = RC;
constexpr size_t H2B = RC;
constexpr size_t HDN = RC + 64 * MiB;
constexpr size_t CQ = RD;
constexpr size_t CKV = CQ + 16 * MiB;
constexpr size_t KROPE = CKV + 8 * MiB;
constexpr size_t DTB = KROPE + 2 * MiB;
constexpr size_t ZB = DTB + 1 * MiB;
constexpr size_t LISTS = RD;
static_assert(ZB + 32 * MiB <= WS_NEED, "region D overflow");

struct P {
    const float* in[31];
    float* out;
    unsigned char* ws;
};

typedef __bf16 hbf16x2 __attribute__((ext_vector_type(2)));
typedef float f32x2 __attribute__((ext_vector_type(2)));
DI bf16_t f2bf(float x) { return __builtin_bit_cast(bf16_t, (__bf16)x); }
DI float bf2f(bf16_t b) { return __uint_as_float(((unsigned)b) << 16); }
DI float bflo(unsigned w) { return __uint_as_float(w << 16); }
DI float bfhi(unsigned w) { return __uint_as_float(w & 0xffff0000u); }
DI unsigned pack2(float a, float b) { f32x2 v = {a, b}; return __builtin_bit_cast(unsigned, __builtin_convertvector(v, hbf16x2)); }
DI float siluf(float x) { return x / (1.f + __expf(-x)); }
DI float softplusf(float x) {
    const float zz = __expf(-fabsf(x));
    const float l1p = zz < 0.01f ? zz * (1.f - zz * (0.5f - zz * (1.f / 3.f))) : __logf(1.f + zz);
    return fmaxf(x, 0.f) + l1p;
}
DI int tidx() { int t = __builtin_amdgcn_workitem_id_x(); asm volatile("" : "+v"(t)); return t; }
DI int crow(int reg, int h) { return (reg & 3) + 8 * (reg >> 2) + 4 * h; }
constexpr int CS_LD = 132;
DI float4 cs4(const float* Cs, int row, int col) { return *(const float4*)(Cs + row * CS_LD + col); }
DI uint2 pack4(float4 v) { uint2 w; w.x = pack2(v.x, v.y); w.y = pack2(v.z, v.w); return w; }
DI float wave_sum(float v) {
#pragma unroll
    for (int o = 32; o >= 1; o >>= 1) v += __shfl_xor(v, o);
    return v;
}
DI float wave_max(float v) {
#pragma unroll
    for (int o = 32; o >= 1; o >>= 1) v = fmaxf(v, __shfl_xor(v, o));
    return v;
}

constexpr int LDS_ROW = 144;
constexpr int TILE_BYTES = 128 * LDS_ROW;
constexpr int GEMM_LDS = 4 * TILE_BYTES;
constexpr int SMEM_BYTES = GEMM_LDS + 2048;
static_assert(128 * CS_LD * 4 <= GEMM_LDS, "epilogue tile");

struct GemmArgs {
    const bf16_t* A; int lda;
    const bf16_t* Bt; int ldb;
    int K;
    const int* lrows;
};

template <class Epi>
DI void gemm_tile(const GemmArgs& g, int m0, int n0, Epi& epi, unsigned char* smem) {
    const int tid = tidx(), lane = tid & 63, wave = tid >> 6, wr = wave >> 1, wc = wave & 1;
    const int r = lane & 31, h = lane >> 5;
    f32x16 acc[2][2];
#pragma unroll
    for (int i = 0; i < 2; ++i)
#pragma unroll
        for (int j = 0; j < 2; ++j)
#pragma unroll
            for (int e = 0; e < 16; ++e) acc[i][j][e] = 0.f;
    const int nk = g.K >> 6;
#if GEMM_DIRECT
    {
        const bf16_t* ap[2]; const bf16_t* bp[2];
#pragma unroll
        for (int i = 0; i < 2; ++i) {
            const int lr = wr * 64 + i * 32 + r;
            const int grow = g.lrows ? g.lrows[lr] : (m0 + lr);
            ap[i] = g.A + (size_t)grow * g.lda + 8 * h;
            bp[i] = g.Bt + (size_t)(n0 + wc * 64 + i * 32 + r) * g.ldb + 8 * h;
        }
        for (int k = 0; k < g.K; k += 16) {
            bf16x8 a[2], b[2];
#pragma unroll
            for (int i = 0; i < 2; ++i) { a[i] = *(const bf16x8*)(ap[i] + k); b[i] = *(const bf16x8*)(bp[i] + k); }
#pragma unroll
            for (int i = 0; i < 2; ++i)
#pragma unroll
                for (int j = 0; j < 2; ++j) acc[i][j] = MFMA32(a[i], b[j], acc[i][j]);
        }
    }
#elif GEMM_GLDS
    {
        constexpr int STG = 32768, TB = 16384;
        const int srow = tid >> 3, sch = (tid & 7) ^ ((srow >> 1) & 7);
        const bf16_t* ag[4]; const bf16_t* bg[4];
#pragma unroll
        for (int i = 0; i < 4; ++i) {
            const int lr = srow + 32 * i;
            const int grow = g.lrows ? g.lrows[lr] : (m0 + lr);
            ag[i] = g.A + (size_t)grow * g.lda + sch * 8;
            bg[i] = g.Bt + (size_t)(n0 + lr) * g.ldb + sch * 8;
        }
#define GLDS_STAGE(BUF, KO) do { unsigned char* _d = (BUF) + wave * 1024; \
        _Pragma("unroll") for (int i = 0; i < 4; ++i) { \
            __builtin_amdgcn_global_load_lds((const unsigned*)(ag[i] + (KO)), (LAS unsigned*)(_d + i * 4096), 16, 0, 0); \
            __builtin_amdgcn_global_load_lds((const unsigned*)(bg[i] + (KO)), (LAS unsigned*)(_d + TB + i * 4096), 16, 0, 0); } } while (0)
        __syncthreads();
        GLDS_STAGE(smem, 0);
        const int y16 = (h ^ ((r >> 1) & 7)) << 4;
        const int o0 = y16, o1 = 32 ^ y16, o2 = 64 ^ y16, o3 = 96 ^ y16;
        const int arow = (wr * 64 + r) * 128, brow = TB + (wc * 64 + r) * 128;
        __syncthreads();
        for (int kt = 0; kt < nk; ++kt) {
            const unsigned char* cur = smem + (kt & 1) * STG;
            if (kt + 1 < nk) GLDS_STAGE(smem + ((kt + 1) & 1) * STG, (kt + 1) * 64);
#define KSTEP(OFF) do { \
                const bf16x8 a0 = *(const bf16x8*)(cur + arow + (OFF)); \
                const bf16x8 a1 = *(const bf16x8*)(cur + arow + 32 * 128 + (OFF)); \
                const bf16x8 b0 = *(const bf16x8*)(cur + brow + (OFF)); \
                const bf16x8 b1 = *(const bf16x8*)(cur + brow + 32 * 128 + (OFF)); \
                acc[0][0] = MFMA32(a0, b0, acc[0][0]); acc[0][1] = MFMA32(a0, b1, acc[0][1]); \
                acc[1][0] = MFMA32(a1, b0, acc[1][0]); acc[1][1] = MFMA32(a1, b1, acc[1][1]); } while (0)
            KSTEP(o0); KSTEP(o1); KSTEP(o2); KSTEP(o3);
#undef KSTEP
            __syncthreads();
        }
#undef GLDS_STAGE
    }
#else
    {
        const int srow = tid >> 3, sch = tid & 7;
        const bf16_t* ag[4]; const bf16_t* bg[4];
#pragma unroll
        for (int i = 0; i < 4; ++i) {
            const int lr = srow + 32 * i;
            const int grow = g.lrows ? g.lrows[lr] : (m0 + lr);
            ag[i] = g.A + (size_t)grow * g.lda + sch * 8;
            bg[i] = g.Bt + (size_t)(n0 + lr) * g.ldb + sch * 8;
        }
        const int soff = srow * LDS_ROW + sch * 16;
        uint4 ra0, ra1, ra2, ra3, rb0, rb1, rb2, rb3;
#define G_LOAD(KO) do { ra0 = *(const uint4*)(ag[0] + (KO)); ra1 = *(const uint4*)(ag[1] + (KO)); ra2 = *(const uint4*)(ag[2] + (KO)); ra3 = *(const uint4*)(ag[3] + (KO)); \
                        rb0 = *(const uint4*)(bg[0] + (KO)); rb1 = *(const uint4*)(bg[1] + (KO)); rb2 = *(const uint4*)(bg[2] + (KO)); rb3 = *(const uint4*)(bg[3] + (KO)); } while (0)
#define L_STORE(BUF) do { unsigned char* _d = (BUF) + soff; \
        *(uint4*)(_d) = ra0; *(uint4*)(_d + 32 * LDS_ROW) = ra1; *(uint4*)(_d + 64 * LDS_ROW) = ra2; *(uint4*)(_d + 96 * LDS_ROW) = ra3; \
        *(uint4*)(_d + TILE_BYTES) = rb0; *(uint4*)(_d + TILE_BYTES + 32 * LDS_ROW) = rb1; *(uint4*)(_d + TILE_BYTES + 64 * LDS_ROW) = rb2; *(uint4*)(_d + TILE_BYTES + 96 * LDS_ROW) = rb3; } while (0)
        G_LOAD(0);
        __syncthreads();
        L_STORE(smem);
        __syncthreads();
        const int aoff = (wr * 64 + r) * LDS_ROW + h * 16;
        const int boff = TILE_BYTES + (wc * 64 + r) * LDS_ROW + h * 16;
        for (int kt = 0; kt < nk; ++kt) {
            const unsigned char* cur = smem + (kt & 1) * 2 * TILE_BYTES;
            unsigned char* nxt = smem + ((kt + 1) & 1) * 2 * TILE_BYTES;
            const bool more = (kt + 1 < nk);
            if (more) G_LOAD((kt + 1) * 64);
#pragma unroll
            for (int ks = 0; ks < 4; ++ks) {
                const bf16x8 a0 = *(const bf16x8*)(cur + aoff + ks * 32);
                const bf16x8 a1 = *(const bf16x8*)(cur + aoff + 32 * LDS_ROW + ks * 32);
                const bf16x8 b0 = *(const bf16x8*)(cur + boff + ks * 32);
                const bf16x8 b1 = *(const bf16x8*)(cur + boff + 32 * LDS_ROW + ks * 32);
                acc[0][0] = MFMA32(a0, b0, acc[0][0]); acc[0][1] = MFMA32(a0, b1, acc[0][1]);
                acc[1][0] = MFMA32(a1, b0, acc[1][0]); acc[1][1] = MFMA32(a1, b1, acc[1][1]);
            }
            if (more) L_STORE(nxt);
            __syncthreads();
        }
#undef G_LOAD
#undef L_STORE
    }
#endif
    float* Cs = (float*)smem;
#if GEMM_DIRECT
    __syncthreads();
#endif
#pragma unroll
    for (int i = 0; i < 2; ++i)
#pragma unroll
        for (int j = 0; j < 2; ++j)
#pragma unroll
            for (int e = 0; e < 16; ++e) Cs[(wr * 64 + i * 32 + crow(e, h)) * CS_LD + wc * 64 + j * 32 + r] = acc[i][j][e];
    __syncthreads();
    epi(Cs, m0, n0, tid);
}

DI int vbid(int bid, int nb) { return (nb % 8 == 0) ? (bid % 8) * (nb / 8) + bid / 8 : bid; }

DI int colmap_in(int n) {
    if (n < 384) return n;
    if (n < 896) return 416 + (n - 384);
    if (n < 1920) return 928 + (n - 896);
    if (n < 1952) return 384 + (n - 1920);
    if (n < 1960) return n;
    return -1;
}
template <int KIND>
DI void tconv_tile(const float* src, const float* src2, int ldsrc, bf16_t* dst, int K, int k0, int n0, const float* scale, int scale_from, unsigned char* smem) {
    float* tile = (float*)smem;
    const int t = tidx();
    __syncthreads();
#pragma unroll 4
    for (int i = 0; i < 16; ++i) {
        const int k = i * 4 + (t >> 6), n = t & 63;
        const int nd = n0 + n;
        float v = 0.f;
        if (KIND == 1) { const int c = colmap_in(nd); if (c >= 0) v = src[(size_t)(k0 + k) * ldsrc + c]; }
        else if (KIND == 2) {
            const int j = nd >> 7, wc = (nd >> 6) & 1, isup = (nd >> 5) & 1, ii = nd & 31;
            const int c = 64 * j + 32 * wc + ii;
            v = (isup ? src2 : src)[(size_t)(k0 + k) * ldsrc + c];
        } else v = src[(size_t)(k0 + k) * ldsrc + nd];
        if (scale && (k0 + k) >= scale_from) v *= scale[k0 + k - scale_from];
        tile[k * 65 + n] = v;
    }
    __syncthreads();
#pragma unroll 4
    for (int i = 0; i < 16; ++i) {
        const int n = i * 4 + (t >> 6), k = t & 63;
        dst[(size_t)(n0 + n) * K + k0 + k] = f2bf(tile[k * 65 + n]);
    }
}

DI void phase_prep(const P& p, int bid, int nb, unsigned char* smem) {
    unsigned char* ws = p.ws;
    const int tid = tidx();
    constexpr int J0 = 512, J1 = J0 + 48, J2 = J1 + 32, J3 = J2 + 256, J4 = J3 + 256, J5 = J4 + 256, J6 = J5 + 256, J7 = J6 + 256, J8 = J7 + 4096, J9 = J8 + 2048;
    for (int t = bid; t < J9; t += nb) {
        if (t < J0) { const int kt = t >> 5, ntl = t & 31; tconv_tile<1>(p.in[2], nullptr, 1960, (bf16_t*)(ws + W_IN), 1024, kt * 64, ntl * 64, nullptr, 0, smem); }
        else if (t < J1) { const int u = t - J0, kt = u / 12, ntl = u % 12; tconv_tile<0>(p.in[4], nullptr, 768, (bf16_t*)(ws + W_QUP), 256, kt * 64, ntl * 64, p.in[3], 0, smem); }
        else if (t < J2) { const int u = t - J1, kt = u >> 4, ntl = u & 15; tconv_tile<0>(p.in[6], nullptr, 1024, (bf16_t*)(ws + W_KVUP), 128, kt * 64, ntl * 64, p.in[5], 0, smem); }
        else if (t < J3) { const int u = t - J2, kt = u >> 4, ntl = u & 15; tconv_tile<0>(p.in[13], nullptr, 1024, (bf16_t*)(ws + W_OUT), 1024, kt * 64, ntl * 64, p.in[12], 512, smem); }
        else if (t < J4) { const int u = t - J3, kt = u >> 4, ntl = u & 15; tconv_tile<0>(p.in[16], nullptr, 1024, (bf16_t*)(ws + W_XQ), 1024, kt * 64, ntl * 64, nullptr, 0, smem); }
        else if (t < J5) { const int u = t - J4, kt = u >> 4, ntl = u & 15; tconv_tile<0>(p.in[17], nullptr, 1024, (bf16_t*)(ws + W_XKV), 1024, kt * 64, ntl * 64, nullptr, 0, smem); }
        else if (t < J6) { const int u = t - J5, kt = u >> 4, ntl = u & 15; tconv_tile<0>(p.in[18], nullptr, 1024, (bf16_t*)(ws + W_XKV) + (size_t)1024 * 1024, 1024, kt * 64, ntl * 64, nullptr, 0, smem); }
        else if (t < J7) { const int u = t - J6, kt = u >> 4, ntl = u & 15; tconv_tile<0>(p.in[19], nullptr, 1024, (bf16_t*)(ws + W_XO), 1024, kt * 64, ntl * 64, nullptr, 0, smem); }
        else if (t < J8) { const int u = t - J7, e = u >> 7, v = u & 127, kt = v >> 3, ntl = v & 7;
            tconv_tile<2>(p.in[26] + (size_t)e * 1024 * 256, p.in[27] + (size_t)e * 1024 * 256, 256, (bf16_t*)(ws + W_GU) + (size_t)e * 512 * 1024, 1024, kt * 64, ntl * 64, nullptr, 0, smem); }
        else { const int u = t - J8, e = u >> 6, v = u & 63, kt = v >> 4, ntl = v & 15;
            tconv_tile<0>(p.in[28] + (size_t)e * 256 * 1024, nullptr, 1024, (bf16_t*)(ws + W_DN) + (size_t)e * 1024 * 256, 256, kt * 64, ntl * 64, nullptr, 0, smem); }
    }
    {
        const size_t gsz = (size_t)nb * 256, g0 = (size_t)bid * 256 + tid;
        bf16_t* xb = (bf16_t*)(ws + XB);
        const float4* x4 = (const float4*)p.in[0];
        for (size_t i = g0; i < (size_t)T * D / 4; i += gsz) { const float4 v = x4[i]; uint2 o; o.x = pack2(v.x, v.y); o.y = pack2(v.z, v.w); ((uint2*)xb)[i] = o; }
        bf16_t* mb = (bf16_t*)(ws + MEMB);
        const float4* m4 = (const float4*)p.in[1];
        for (size_t i = g0; i < (size_t)Bn * NMEM * D / 4; i += gsz) { const float4 v = m4[i]; uint2 o; o.x = pack2(v.x, v.y); o.y = pack2(v.z, v.w); ((uint2*)mb)[i] = o; }
        float* wrt = (float*)(ws + W_RT);
        for (size_t i = g0; i < 48 * 1024; i += gsz) {
            const int j = (int)(i >> 10), k = (int)(i & 1023);
            float v = 0.f;
            if (j < 4) v = p.in[22][k * 4 + j]; else if (j < 36) v = p.in[24][k * 32 + (j - 4)];
            wrt[i] = v;
        }
        float* rc = (float*)(ws + ROPE_C); float* rs = (float*)(ws + ROPE_S);
        for (size_t i = g0; i < 2048 * 16; i += gsz) {
            const int pos = (int)(i >> 4), f = (int)(i & 15);
            const float inv = powf(10000.f, -(float)f / 16.f);
            const float ang = (float)pos * inv;
            const double a = (double)ang;
            const double k2 = rint(a * 0.15915494309189535);
            const float rr = (float)(a - k2 * 6.283185307179586);
            rc[i] = cosf(rr); rs[i] = sinf(rr);
        }
    }
}

struct EpiProj {
    bf16_t *cq, *ckv, *z, *xbc, *krope; float* dt; const float *rc, *rs, *dtb;
    DI void operator()(const float* Cs, int m0, int n0, int tid) const {
        const int c4 = (tid & 31) * 4, r0 = tid >> 5;
        if (n0 < 1920) {
            bf16_t* dst; int ld, cofs;
            if (n0 < 256) { dst = cq; ld = 256; cofs = n0; } else if (n0 < 384) { dst = ckv; ld = 128; cofs = n0 - 256; }
            else if (n0 < 896) { dst = z; ld = 512; cofs = n0 - 384; } else { dst = xbc; ld = 1024; cofs = n0 - 896; }
#pragma unroll 4
            for (int ps = 0; ps < 16; ++ps) { const int row = ps * 8 + r0; *(uint2*)(dst + (size_t)(m0 + row) * ld + cofs + c4) = pack4(cs4(Cs, row, c4)); }
        } else {
#pragma unroll
            for (int ps = 0; ps < 4; ++ps) {
                const int it = ps * 256 + tid, row = it >> 3, cc = (it & 7) * 4, grow = m0 + row;
                const float4 v = cs4(Cs, row, cc), pv = cs4(Cs, row, cc ^ 16);
                const int pos = grow & 2047, f = cc & 15;
                const float4 c = *(const float4*)(rc + pos * 16 + f), s = *(const float4*)(rs + pos * 16 + f);
                float4 o;
                if (cc < 16) { o.x = v.x * c.x - pv.x * s.x; o.y = v.y * c.y - pv.y * s.y; o.z = v.z * c.z - pv.z * s.z; o.w = v.w * c.w - pv.w * s.w; }
                else { o.x = v.x * c.x + pv.x * s.x; o.y = v.y * c.y + pv.y * s.y; o.z = v.z * c.z + pv.z * s.z; o.w = v.w * c.w + pv.w * s.w; }
                *(uint2*)(krope + (size_t)grow * 32 + cc) = pack4(o);
            }
#pragma unroll
            for (int ps = 0; ps < 4; ++ps) {
                const int it = ps * 256 + tid, row = it >> 3, cc = it & 7;
                dt[(size_t)(m0 + row) * 8 + cc] = softplusf(Cs[row * CS_LD + 32 + cc] + dtb[cc]);
            }
        }
    }
};
struct EpiMemKV {
    bf16_t *kx, *vxt;
    DI void operator()(const float* Cs, int m0, int n0, int tid) const {
        const int b = m0 >> 8, mm0 = m0 & 255;
        if (n0 < 1024) {
            const int c4 = (tid & 31) * 4, r0 = tid >> 5, hd = n0 >> 8, d = (n0 & 255) + c4;
#pragma unroll 4
            for (int ps = 0; ps < 16; ++ps) { const int row = ps * 8 + r0; *(uint2*)(kx + ((size_t)(b * 4 + hd) * 256 + mm0 + row) * 256 + d) = pack4(cs4(Cs, row, c4)); }
        } else {
            const int c2 = n0 - 1024, hd = c2 >> 8;
#pragma unroll 2
            for (int ps = 0; ps < 8; ++ps) {
                const int it = ps * 256 + tid, col = it & 127, rg = it >> 7, d = (c2 & 255) + col;
                uint4 w;
                w.x = pack2(Cs[(rg * 8 + 0) * CS_LD + col], Cs[(rg * 8 + 1) * CS_LD + col]); w.y = pack2(Cs[(rg * 8 + 2) * CS_LD + col], Cs[(rg * 8 + 3) * CS_LD + col]);
                w.z = pack2(Cs[(rg * 8 + 4) * CS_LD + col], Cs[(rg * 8 + 5) * CS_LD + col]); w.w = pack2(Cs[(rg * 8 + 6) * CS_LD + col], Cs[(rg * 8 + 7) * CS_LD + col]);
                *(uint4*)(vxt + ((size_t)(b * 4 + hd) * 256 + d) * 256 + mm0 + rg * 8) = w;
            }
        }
    }
};
DI void phase_proj(const P& p, int bid, int nb, unsigned char* smem, int rep = 0) {
    unsigned char* ws = p.ws;
    const int v = vbid(bid, nb);
    const bf16_t* xb = (const bf16_t*)(ws + XB);
    EpiProj e1{(bf16_t*)(ws + CQ), (bf16_t*)(ws + CKV), (bf16_t*)(ws + ZB), (bf16_t*)(ws + XBC), (bf16_t*)(ws + KROPE), (float*)(ws + DTB),
               (const float*)(ws + ROPE_C), (const float*)(ws + ROPE_S), p.in[9]};
    EpiMemKV e2{(bf16_t*)(ws + KX), (bf16_t*)(ws + VXT)};
    constexpr int NT1 = 256 * 16, NT2 = 32 * 16;
    for (int t = v; t < NT1 + NT2; t += nb) {
        if (rep && REP_MODE == 1 && t >= NT1) continue;
        if (rep && REP_MODE == 2 && t < NT1) continue;
        if (rep && REP_MODE == 3 && !(t < NT1 && (t & 7) == 7 && ((t >> 6) & 1))) continue;
        if (rep && REP_MODE == 4 && !(t < NT1 && ((t >> 6) & 1) == 0)) continue;
        const int u = t < NT1 ? t : t - NT1, c = u >> 6, j = u & 63, mt = (c >> 1) * 8 + (j >> 3), ntl = (c & 1) * 8 + (j & 7);
        if (t < NT1) { GemmArgs g{xb, 1024, (const bf16_t*)(ws + W_IN), 1024, 1024, nullptr}; gemm_tile(g, mt * 128, ntl * 128, e1, smem); }
        else { GemmArgs g{(const bf16_t*)(ws + MEMB), 1024, (const bf16_t*)(ws + W_XKV), 1024, 1024, nullptr}; gemm_tile(g, mt * 128, ntl * 128, e2, smem); }
    }
}

struct EpiQup {
    bf16_t* q; const float *rc, *rs; const float* rms;
    DI void operator()(const float* Cs, int m0, int n0, int tid) const {
        const int c4 = (tid & 31) * 4, r0 = tid >> 5;
        const int col = n0 + c4, head = col / 96, d = col - head * 96;
        const bool rope = d >= 64;
        const int b = m0 >> 11, s0 = m0 & 2047;
#pragma unroll 4
        for (int ps = 0; ps < 16; ++ps) {
            const int row = ps * 8 + r0;
            const float sc = rms[row] * QSCALE;
            float4 v = cs4(Cs, row, c4);
            if (rope) {
                const float4 pv = cs4(Cs, row, c4 ^ 16);
                const int pos = s0 + row, f = d & 15;
                const float4 c = *(const float4*)(rc + pos * 16 + f), s = *(const float4*)(rs + pos * 16 + f);
                if (d < 80) { v.x = v.x * c.x - pv.x * s.x; v.y = v.y * c.y - pv.y * s.y; v.z = v.z * c.z - pv.z * s.z; v.w = v.w * c.w - pv.w * s.w; }
                else { v.x = v.x * c.x + pv.x * s.x; v.y = v.y * c.y + pv.y * s.y; v.z = v.z * c.z + pv.z * s.z; v.w = v.w * c.w + pv.w * s.w; }
            }
            v.x *= sc; v.y *= sc; v.z *= sc; v.w *= sc;
            *(uint2*)(q + ((size_t)(b * 8 + head) * 2048 + s0 + row) * 96 + d) = pack4(v);
        }
    }
};
struct EpiKVup {
    bf16_t *kn, *vt; const float* rms;
    DI void operator()(const float* Cs, int m0, int n0, int tid) const {
        const int head = n0 >> 7, b = m0 >> 11, s0 = m0 & 2047;
#pragma unroll 4
        for (int ps = 0; ps < 8; ++ps) {
            const int it = ps * 256 + tid, row = it >> 4, c4 = (it & 15) * 4;
            const float sc = rms[row];
            float4 v = cs4(Cs, row, c4); v.x *= sc; v.y *= sc; v.z *= sc; v.w *= sc;
            *(uint2*)(kn + ((size_t)(b * 8 + head) * 2048 + s0 + row) * 64 + c4) = pack4(v);
        }
#pragma unroll 2
        for (int ps = 0; ps < 4; ++ps) {
            const int it = ps * 256 + tid, dv = it & 63, rg = it >> 6;
            const float* cp = Cs + (rg * 8) * CS_LD + 64 + dv; const float* rp = rms + rg * 8;
            uint4 w;
            w.x = pack2(cp[0] * rp[0], cp[CS_LD] * rp[1]); w.y = pack2(cp[2 * CS_LD] * rp[2], cp[3 * CS_LD] * rp[3]);
            w.z = pack2(cp[4 * CS_LD] * rp[4], cp[5 * CS_LD] * rp[5]); w.w = pack2(cp[6 * CS_LD] * rp[6], cp[7 * CS_LD] * rp[7]);
            *(uint4*)(vt + ((size_t)(b * 8 + head) * 64 + dv) * 2048 + s0 + rg * 8) = w;
        }
    }
};
template <int K>
DI void row_rms(const bf16_t* src, int m0, float* rms) {
    const int t = tidx(), row = t >> 1, half = t & 1;
    const uint4* s4 = (const uint4*)(src + (size_t)(m0 + row) * K + half * (K / 2));
    float ss = 0.f;
#pragma unroll
    for (int i = 0; i < K / 16; ++i) {
        const uint4 w = s4[i];
        const unsigned ww[4] = {w.x, w.y, w.z, w.w};
#pragma unroll
        for (int k = 0; k < 4; ++k) { const float a = bflo(ww[k]), b = bfhi(ww[k]); ss += a * a + b * b; }
    }
    ss += __shfl_xor(ss, 1);
    __syncthreads();
    if (half == 0) rms[row] = rsqrtf(ss * (1.f / K) + EPS);
    __syncthreads();
}
DI void phase_up(const P& p, int bid, int nb, unsigned char* smem) {
    unsigned char* ws = p.ws;
    const int v = vbid(bid, nb);
    float* rms = (float*)(smem + GEMM_LDS);
    constexpr int NTQ = 256 * 6, NTKV = 256 * 8;
    for (int t = v; t < NTQ + NTKV; t += nb) {
        if (t < NTQ) {
            const int mt = t / 6, ntl = t % 6;
            row_rms<256>((const bf16_t*)(ws + CQ), mt * 128, rms);
            EpiQup e{(bf16_t*)(ws + QB), (const float*)(ws + ROPE_C), (const float*)(ws + ROPE_S), rms};
            GemmArgs g{(const bf16_t*)(ws + CQ), 256, (const bf16_t*)(ws + W_QUP), 256, 256, nullptr};
            gemm_tile(g, mt * 128, ntl * 128, e, smem);
        } else {
            const int u = t - NTQ, mt = u >> 3, ntl = u & 7;
            row_rms<128>((const bf16_t*)(ws + CKV), mt * 128, rms);
            EpiKVup e{(bf16_t*)(ws + KNB), (bf16_t*)(ws + VTB), rms};
            GemmArgs g{(const bf16_t*)(ws + CKV), 128, (const bf16_t*)(ws + W_KVUP), 128, 128, nullptr};
            gemm_tile(g, mt * 128, ntl * 128, e, smem);
        }
    }
    {
        const bf16_t* xbc = (const bf16_t*)(ws + XBC); bf16_t* xa = (bf16_t*)(ws + XBCA);
        const float* cw = p.in[7]; const float* cb = p.in[8];
        const size_t gsz = (size_t)nb * 256;
        for (size_t i = (size_t)bid * 256 + tidx(); i < (size_t)T * 128; i += gsz) {
            const int tkn = (int)(i >> 7), c0 = (int)(i & 127) * 8, s_ = tkn & 2047;
            float accv[8];
#pragma unroll
            for (int k = 0; k < 8; ++k) accv[k] = cb[c0 + k];
#pragma unroll
            for (int j = 0; j < 4; ++j) {
                if (s_ + j - 3 >= 0) {
                    const uint4 w = *(const uint4*)(xbc + (size_t)(tkn + j - 3) * 1024 + c0);
                    const unsigned ww[4] = {w.x, w.y, w.z, w.w};
#pragma unroll
                    for (int k = 0; k < 4; ++k) {
                        accv[2 * k] += cw[j * 1024 + c0 + 2 * k] * bflo(ww[k]);
                        accv[2 * k + 1] += cw[j * 1024 + c0 + 2 * k + 1] * bfhi(ww[k]);
                    }
                }
            }
            uint4 o;
            o.x = pack2(siluf(accv[0]), siluf(accv[1])); o.y = pack2(siluf(accv[2]), siluf(accv[3]));
            o.z = pack2(siluf(accv[4]), siluf(accv[5])); o.w = pack2(siluf(accv[6]), siluf(accv[7]));
            *(uint4*)(xa + (size_t)tkn * 1024 + c0) = o;
        }
    }
}

DI int perm16(int k) { return (k & ~12) | ((k & 4) << 1) | ((k & 8) >> 1); }
template <int DQK, int DVW, int KT, int NQG, int NDV>
struct FlashCfg {
    static constexpr int KSTR = (DQK + 8) * 2;
    static constexpr int VSTR = (KT + 8) * 2;
    static constexpr int DV = DVW * NDV;
    static constexpr int KBYTES = KT * KSTR, VBYTES = DV * VSTR, STAGE = KBYTES + VBYTES;
    static constexpr int KCH = KT * DQK / 8 / 256;
    static constexpr int VCH = DV * KT / 8 / 256;
    static_assert(KT * DQK / 8 % 256 == 0 && DV * KT / 8 % 256 == 0, "chunk split");
    static_assert(2 * STAGE <= GEMM_LDS + 2048 - 16, "flash LDS");
};
template <int DQK, int DVW, int KT, int NQG, int NDV, class Src>
DI void flash_item(const Src& src, int ntiles, int nskip  , unsigned char* smem) {
    typedef FlashCfg<DQK, DVW, KT, NQG, NDV> C;
    constexpr int NKS = DQK / 16, NKB = KT / 32, NDB = DVW / 32;
    int tid = tidx(); asm volatile("" : "+v"(tid));
    const int lane = tid & 63, wave = __builtin_amdgcn_readfirstlane(tid >> 6), r = lane & 31, h = lane >> 5;
    const int qg = wave / NDV, dvh = wave % NDV;
    bf16x8 qf[NKS];
    {
        const bf16_t* qp = src.qrow(qg * 32 + r) + 8 * h;
#pragma unroll
        for (int ks = 0; ks < NKS; ++ks) qf[ks] = *(const bf16x8*)(qp + 16 * ks);
    }
    f32x16 o[NDB];
#pragma unroll
    for (int d = 0; d < NDB; ++d)
#pragma unroll
        for (int e = 0; e < 16; ++e) o[d][e] = 0.f;
    float m = -1e30f, l = 0.f;
    uint4 kr[C::KCH], vr[C::VCH];
    auto gload = [&](int t) {
#pragma unroll
        for (int i = 0; i < C::KCH; ++i) { const int idx = tid + 256 * i; kr[i] = src.kload(t, idx / (DQK / 8), idx % (DQK / 8)); }
#pragma unroll
        for (int i = 0; i < C::VCH; ++i) { const int idx = tid + 256 * i; vr[i] = src.vload(t, idx / (KT / 8), idx % (KT / 8)); }
    };
    auto lstore = [&](unsigned char* buf) {
#pragma unroll
        for (int i = 0; i < C::KCH; ++i) { const int idx = tid + 256 * i; *(uint4*)(buf + (idx / (DQK / 8)) * C::KSTR + (idx % (DQK / 8)) * 16) = kr[i]; }
#pragma unroll
        for (int i = 0; i < C::VCH; ++i) {
            const int idx = tid + 256 * i, dv = idx / (KT / 8), c = idx % (KT / 8);
            unsigned char* row = buf + C::KBYTES + dv * C::VSTR + (c >> 1) * 32;
            const int a = c & 1;
            *(uint2*)(row + (4 * a) * 2) = make_uint2(vr[i].x, vr[i].y);
            *(uint2*)(row + (8 + 4 * a) * 2) = make_uint2(vr[i].z, vr[i].w);
        }
    };
    gload(0);
    __syncthreads();
    lstore(smem);
    __syncthreads();
    for (int t = 0; t < ntiles; ++t) {
        const unsigned char* cur = smem + (t & 1) * C::STAGE;
        const bool more = (t + 1 < ntiles);
        if (more) gload(t + 1);
        if (!(t == ntiles - 1 && qg < nskip)) {
            f32x16 s[NKB];
#pragma unroll
            for (int kb = 0; kb < NKB; ++kb) {
#pragma unroll
                for (int e = 0; e < 16; ++e) s[kb][e] = 0.f;
                const unsigned char* kp = cur + (kb * 32 + r) * C::KSTR + h * 16;
#pragma unroll
                for (int ks = 0; ks < NKS; ++ks) s[kb] = MFMA32(*(const bf16x8*)(kp + ks * 32), qf[ks], s[kb]);
            }
            float mx = s[0][0];
#pragma unroll
            for (int kb = 0; kb < NKB; ++kb)
#pragma unroll
                for (int e = 0; e < 16; ++e) mx = fmaxf(mx, s[kb][e]);
            mx = fmaxf(mx, __shfl_xor(mx, 32));
            const float mn = fmaxf(m, mx);
            const float alpha = exp2f(m - mn);
            m = mn;
            float ps = 0.f;
#pragma unroll
            for (int kb = 0; kb < NKB; ++kb)
#pragma unroll
                for (int e = 0; e < 16; ++e) { const float pv = exp2f(s[kb][e] - mn); s[kb][e] = pv; ps += pv; }
            l = l * alpha + ps;
#pragma unroll
            for (int d = 0; d < NDB; ++d)
#pragma unroll
                for (int e = 0; e < 16; ++e) o[d][e] *= alpha;
#pragma unroll
            for (int kb = 0; kb < NKB; ++kb)
#pragma unroll
                for (int s2 = 0; s2 < 2; ++s2) {
                    uint4 pk;
                    pk.x = pack2(s[kb][8 * s2], s[kb][8 * s2 + 1]); pk.y = pack2(s[kb][8 * s2 + 2], s[kb][8 * s2 + 3]);
                    pk.z = pack2(s[kb][8 * s2 + 4], s[kb][8 * s2 + 5]); pk.w = pack2(s[kb][8 * s2 + 6], s[kb][8 * s2 + 7]);
                    const bf16x8 pf = __builtin_bit_cast(bf16x8, pk);
                    const unsigned char* vp = cur + C::KBYTES + (dvh * DVW + r) * C::VSTR + (kb * 32 + s2 * 16 + 8 * h) * 2;
#pragma unroll
                    for (int d = 0; d < NDB; ++d) o[d] = MFMA32(*(const bf16x8*)(vp + d * 32 * C::VSTR), pf, o[d]);
                }
        }
        if (more) lstore(smem + ((t + 1) & 1) * C::STAGE);
        __syncthreads();
    }
    l += __shfl_xor(l, 32);
    const float il = 1.f / l;
#pragma unroll
    for (int d = 0; d < NDB; ++d)
#pragma unroll
        for (int g4 = 0; g4 < 4; ++g4) {
            uint2 w; w.x = pack2(o[d][4 * g4] * il, o[d][4 * g4 + 1] * il); w.y = pack2(o[d][4 * g4 + 2] * il, o[d][4 * g4 + 3] * il);
            src.store(qg * 32 + r, dvh * DVW + d * 32 + 8 * g4 + 4 * h, w);
        }
}
struct SelfSrc {
    const bf16_t *q, *kn, *kr, *vt; bf16_t* mix; int b, hd, bh, q0;
    DI const bf16_t* qrow(int rr) const { return q + ((size_t)bh * 2048 + q0 + rr) * 96; }
    DI uint4 kload(int t, int key, int c) const {
        const int kg = t * 64 + key;
        return c < 8 ? *(const uint4*)(kn + ((size_t)bh * 2048 + kg) * 64 + c * 8) : *(const uint4*)(kr + ((size_t)b * 2048 + kg) * 32 + (c - 8) * 8);
    }
    DI uint4 vload(int t, int dv, int c) const { return *(const uint4*)(vt + ((size_t)bh * 64 + dv) * 2048 + t * 64 + c * 8); }
    DI void store(int rr, int dv, uint2 w) const { *(uint2*)(mix + ((size_t)b * 2048 + q0 + rr) * 1024 + hd * 64 + dv) = w; }
};
struct CrossSrc {
    const bf16_t *qx, *kx, *vxt; bf16_t* ox; int b, hd, q0;
    DI const bf16_t* qrow(int rr) const { return qx + ((size_t)(b * 4 + hd) * 2048 + q0 + rr) * 256; }
    DI uint4 kload(int t, int key, int c) const { return *(const uint4*)(kx + ((size_t)(b * 4 + hd) * 256 + t * 32 + key) * 256 + c * 8); }
    DI uint4 vload(int t, int dv, int c) const { return *(const uint4*)(vxt + ((size_t)(b * 4 + hd) * 256 + dv) * 256 + t * 32 + c * 8); }
    DI void store(int rr, int dv, uint2 w) const { *(uint2*)(ox + ((size_t)b * 2048 + q0 + rr) * 1024 + hd * 256 + dv) = w; }
};
DI void attn_fast(const P& p, int bid, int nb, unsigned char* smem) {
    unsigned char* ws = p.ws;
    const int nround = (2048 + nb - 1) / nb;
    for (int rd = 0; rd < nround; ++rd) {
        const int idx = rd * nb + ((rd & 1) ? (nb - 1 - bid) : bid);
        if (idx >= 2048) continue;
        const int qb = 15 - (idx >> 7), bh = idx & 127;
        SelfSrc s{(const bf16_t*)(ws + QB), (const bf16_t*)(ws + KNB), (const bf16_t*)(ws + KROPE), (const bf16_t*)(ws + VTB), (bf16_t*)(ws + MIX), bh >> 3, bh & 7, bh, qb * 128};
        flash_item<96, 64, 64, 4, 1>(s, 2 * qb + 2, 2, smem);
    }
}
DI void xattn_fast(const P& p, int bid, int nb, unsigned char* smem) {
    unsigned char* ws = p.ws;
    for (int it = bid; it < 2048; it += nb) {
        const int bhd = it >> 5, qt = it & 31;
        CrossSrc s{(const bf16_t*)(ws + QX), (const bf16_t*)(ws + KX), (const bf16_t*)(ws + VXT), (bf16_t*)(ws + OX), bhd >> 2, bhd & 3, qt * 64};
        flash_item<256, 128, 32, 2, 2>(s, 8, 0, smem);
    }
}

constexpr int SSD_XT = 0, SSD_BM = 8192, SSD_CM = SSD_BM + 16384, SSD_BWT = SSD_CM + 16384, SSD_PS = SSD_BWT + 16384, SSD_F = SSD_PS + 16384;
static_assert(SSD_F + 1024 <= GEMM_LDS + 2048 - 16, "ssd LDS");
DI int off256(int row, int el) { return row * 256 + (((el >> 3) ^ (row & 15)) << 4) + ((el & 7) << 1); }
DI int off128(int row, int el) { return row * 128 + (((el >> 3) ^ ((row >> 1) & 7)) << 4) + ((el & 7) << 1); }
DI void ssd_item(const P& p, int bh, unsigned char* smem) {
    unsigned char* ws = p.ws;
    const bf16_t* xa = (const bf16_t*)(ws + XBCA); const float* dtg = (const float*)(ws + DTB); const bf16_t* zg = (const bf16_t*)(ws + ZB);
    bf16_t* mix = (bf16_t*)(ws + MIX);
    int tid0 = tidx(); asm volatile("" : "+v"(tid0));
    const int wave = __builtin_amdgcn_readfirstlane(tid0 >> 6);
    const int b = bh >> 3, hd = bh & 7, g = hd >> 2;
    const int lb = wave >> 1, pb = wave & 1;
    const float a_h = -__expf(p.in[10][hd]), Dh = p.in[11][hd];
    float* F = (float*)(smem + SSD_F);
    __syncthreads();
    for (int i = tid0; i < 16384 / 16; i += 256) *(uint4*)(smem + SSD_PS + i * 16) = make_uint4(0u, 0u, 0u, 0u);
    f32x16 st[2];
#pragma unroll
    for (int i = 0; i < 2; ++i)
#pragma unroll
        for (int e = 0; e < 16; ++e) st[i][e] = 0.f;
    uint4 xr0, xr1, br0, br1, br2, br3, cr0, cr1, cr2, cr3; float dtr = 0.f;
#define SSD_XLD(i) (*(const uint4*)(xa + (t0_ + ((tid + 256 * (i)) >> 3)) * 1024 + hd * 64 + ((tid + 256 * (i)) & 7) * 8))
#define SSD_BLD(i, o) (*(const uint4*)(xa + (t0_ + ((tid + 256 * (i)) >> 4)) * 1024 + (o) + g * 128 + ((tid + 256 * (i)) & 15) * 8))
#define SSD_GLOAD(c_) do { const size_t t0_ = (size_t)b * 2048 + (c_) * 64; xr0 = SSD_XLD(0); xr1 = SSD_XLD(1); \
        br0 = SSD_BLD(0, 512); br1 = SSD_BLD(1, 512); br2 = SSD_BLD(2, 512); br3 = SSD_BLD(3, 512); \
        cr0 = SSD_BLD(0, 768); cr1 = SSD_BLD(1, 768); cr2 = SSD_BLD(2, 768); cr3 = SSD_BLD(3, 768); \
        if (tid < 64) dtr = dtg[(t0_ + tid) * 8 + hd]; } while (0)
    { const int tid = tid0; SSD_GLOAD(0); }
    for (int c = 0; c < 32; ++c) {
        int tid = tid0; asm volatile("" : "+v"(tid));
        const int lane = tid & 63, r = lane & 31, h = lane >> 5;
        const size_t t0 = (size_t)b * 2048 + c * 64;
        if (wave == 0) {
            float v = dtr * a_h;
#pragma unroll
            for (int o = 1; o < 64; o <<= 1) { const float u = __shfl_up(v, o); if (lane >= o) v += u; }
            const float a63 = __shfl(v, 63);
            F[lane] = v; F[64 + lane] = __expf(v); F[128 + lane] = dtr; F[192 + lane] = __expf(a63 - v) * dtr;
        }
        __syncthreads();
#define SSD_XIMG(i, XR) do { const int idx = tid + 256 * (i), l = idx >> 3, p0 = (idx & 7) * 8, lp = perm16(l); \
            const unsigned ww[4] = {XR.x, XR.y, XR.z, XR.w}; \
            _Pragma("unroll") for (int k = 0; k < 4; ++k) { \
                *(bf16_t*)(smem + SSD_XT + off128(p0 + 2 * k, lp)) = (bf16_t)(ww[k] & 0xffffu); \
                *(bf16_t*)(smem + SSD_XT + off128(p0 + 2 * k + 1, lp)) = (bf16_t)(ww[k] >> 16); } } while (0)
#define SSD_BIMG(i, BR, CR) do { const int idx = tid + 256 * (i), l = idx >> 4, n0 = (idx & 15) * 8, lp = perm16(l); \
            *(uint4*)(smem + SSD_BM + off256(l, n0)) = BR; *(uint4*)(smem + SSD_CM + off256(l, n0)) = CR; \
            const float wl = F[192 + l]; const unsigned ww[4] = {BR.x, BR.y, BR.z, BR.w}; \
            _Pragma("unroll") for (int k = 0; k < 4; ++k) { \
                *(bf16_t*)(smem + SSD_BWT + off128(n0 + 2 * k, lp)) = f2bf(bflo(ww[k]) * wl); \
                *(bf16_t*)(smem + SSD_BWT + off128(n0 + 2 * k + 1, lp)) = f2bf(bfhi(ww[k]) * wl); } } while (0)
        SSD_XIMG(0, xr0); SSD_XIMG(1, xr1);
        SSD_BIMG(0, br0, cr0); SSD_BIMG(1, br1, cr1); SSD_BIMG(2, br2, cr2); SSD_BIMG(3, br3, cr3);
        __syncthreads();
        if (c + 1 < 32) SSD_GLOAD(c + 1);
        bf16_t zr[16];
        {
            const bf16_t* zp = zg + (t0 + lb * 32 + 4 * h) * 512 + hd * 64 + pb * 32 + r;
#pragma unroll
            for (int e = 0; e < 16; ++e) zr[e] = zp[(size_t)((e & 3) + 8 * (e >> 2)) * 512];
        }
        f32x16 yd;
#pragma unroll
        for (int e = 0; e < 16; ++e) yd[e] = 0.f;
        const float acs_l = F[lb * 32 + r];
        const int lrow = lb * 32 + r;
        for (int sb = 0; sb <= lb; ++sb) {
            f32x16 cb;
#pragma unroll
            for (int e = 0; e < 16; ++e) cb[e] = 0.f;
#pragma unroll
            for (int ks = 0; ks < 8; ++ks) {
                const bf16x8 av = *(const bf16x8*)(smem + SSD_BM + off256(sb * 32 + r, 16 * ks + 8 * h));
                const bf16x8 bv = *(const bf16x8*)(smem + SSD_CM + off256(lb * 32 + r, 16 * ks + 8 * h));
                cb = MFMA32(av, bv, cb);
            }
            float mv[16];
#pragma unroll
            for (int q4 = 0; q4 < 4; ++q4) {
                const int s0 = sb * 32 + 8 * q4 + 4 * h;
                const float4 as4 = *(const float4*)(F + s0), dt4 = *(const float4*)(F + 128 + s0);
                const float asv[4] = {as4.x, as4.y, as4.z, as4.w}, dtv[4] = {dt4.x, dt4.y, dt4.z, dt4.w};
#pragma unroll
                for (int k = 0; k < 4; ++k) mv[4 * q4 + k] = (s0 + k <= lrow) ? cb[4 * q4 + k] * __expf(acs_l - asv[k]) * dtv[k] : 0.f;
            }
#pragma unroll
            for (int s2 = 0; s2 < 2; ++s2) {
                uint4 pk;
                pk.x = pack2(mv[8 * s2], mv[8 * s2 + 1]); pk.y = pack2(mv[8 * s2 + 2], mv[8 * s2 + 3]);
                pk.z = pack2(mv[8 * s2 + 4], mv[8 * s2 + 5]); pk.w = pack2(mv[8 * s2 + 6], mv[8 * s2 + 7]);
                const bf16x8 xb = *(const bf16x8*)(smem + SSD_XT + off128(pb * 32 + r, sb * 32 + 16 * s2 + 8 * h));
                yd = MFMA32(__builtin_bit_cast(bf16x8, pk), xb, yd);
            }
        }
        f32x16 yo;
#pragma unroll
        for (int e = 0; e < 16; ++e) yo[e] = 0.f;
#pragma unroll
        for (int ks = 0; ks < 8; ++ks) {
            const bf16x8 av = *(const bf16x8*)(smem + SSD_CM + off256(lb * 32 + r, 16 * ks + 8 * h));
            const bf16x8 bv = *(const bf16x8*)(smem + SSD_PS + off256(pb * 32 + r, 16 * ks + 8 * h));
            yo = MFMA32(av, bv, yo);
        }
        {
            const uint4 x0 = *(const uint4*)(smem + SSD_XT + off128(pb * 32 + r, lb * 32 + 8 * h));
            const uint4 x1 = *(const uint4*)(smem + SSD_XT + off128(pb * 32 + r, lb * 32 + 16 + 8 * h));
            const unsigned xw[8] = {x0.x, x0.y, x0.z, x0.w, x1.x, x1.y, x1.z, x1.w};
            bf16_t* op = mix + (t0 + lb * 32 + 4 * h) * 1024 + 512 + hd * 64 + pb * 32 + r;
#pragma unroll
            for (int q4 = 0; q4 < 4; ++q4) {
                const float4 ea4 = *(const float4*)(F + 64 + lb * 32 + 8 * q4 + 4 * h);
                const float eav[4] = {ea4.x, ea4.y, ea4.z, ea4.w};
#pragma unroll
                for (int k = 0; k < 4; ++k) {
                    const int e = 4 * q4 + k;
                    const float xv = (e & 1) ? bfhi(xw[e >> 1]) : bflo(xw[e >> 1]);
                    const float y = yd[e] + eav[k] * yo[e] + Dh * xv;
                    op[(size_t)(k + 8 * q4) * 1024] = f2bf(y * siluf(bf2f(zr[e])));
                }
            }
        }
        {
            const float dec = F[64 + 63];
#pragma unroll
            for (int i = 0; i < 2; ++i) {
#pragma unroll
                for (int e = 0; e < 16; ++e) st[i][e] *= dec;
                const int nblk = 2 * (wave >> 1) + i;
#pragma unroll
                for (int ks = 0; ks < 4; ++ks) {
                    const bf16x8 av = *(const bf16x8*)(smem + SSD_XT + off128(pb * 32 + r, 16 * ks + 8 * h));
                    const bf16x8 bv = *(const bf16x8*)(smem + SSD_BWT + off128(nblk * 32 + r, 16 * ks + 8 * h));
                    st[i] = MFMA32(av, bv, st[i]);
                }
            }
        }
        __syncthreads();
#pragma unroll
        for (int i = 0; i < 2; ++i) {
            const int n = (2 * (wave >> 1) + i) * 32 + r;
#pragma unroll
            for (int e = 0; e < 16; ++e) *(bf16_t*)(smem + SSD_PS + off256(pb * 32 + crow(e, h), n)) = f2bf(st[i][e]);
        }
    }
    __syncthreads();
}

#if ATTN_NAIVE
DI void attn_naive(const P& p, int bid, int nb) {
    unsigned char* ws = p.ws;
    const bf16_t* Q = (const bf16_t*)(ws + QB); const bf16_t* Kn = (const bf16_t*)(ws + KNB); const bf16_t* Vt = (const bf16_t*)(ws + VTB);
    const bf16_t* Kr = (const bf16_t*)(ws + KROPE); bf16_t* mix = (bf16_t*)(ws + MIX);
    for (int item = bid; item < 128 * 8; item += nb) {
        const int bh = item >> 3, s_ = (item & 7) * 256 + tidx(), b = bh >> 3, hd = bh & 7;
        float q[96];
        {
            const uint4* q4 = (const uint4*)(Q + ((size_t)bh * 2048 + s_) * 96);
#pragma unroll
            for (int i = 0; i < 12; ++i) { const uint4 w = q4[i]; q[8 * i] = bflo(w.x); q[8 * i + 1] = bfhi(w.x); q[8 * i + 2] = bflo(w.y); q[8 * i + 3] = bfhi(w.y);
                q[8 * i + 4] = bflo(w.z); q[8 * i + 5] = bfhi(w.z); q[8 * i + 6] = bflo(w.w); q[8 * i + 7] = bfhi(w.w); }
        }
        float o[64];
#pragma unroll
        for (int d = 0; d < 64; ++d) o[d] = 0.f;
        float m = -1e30f, l = 0.f;
        const int nkeys = __builtin_amdgcn_readfirstlane(((s_ >> 6) + 1) * 64);
        for (int j0 = 0; j0 < nkeys; j0 += 8) {
            float sc[8];
#pragma unroll
            for (int jj = 0; jj < 8; ++jj) {
                const int j = j0 + jj;
                const uint4* k4 = (const uint4*)(Kn + ((size_t)bh * 2048 + j) * 64);
                const uint4* r4 = (const uint4*)(Kr + ((size_t)b * 2048 + j) * 32);
                float a = 0.f;
#pragma unroll
                for (int i = 0; i < 8; ++i) { const uint4 w = k4[i]; a += q[8 * i] * bflo(w.x) + q[8 * i + 1] * bfhi(w.x) + q[8 * i + 2] * bflo(w.y) + q[8 * i + 3] * bfhi(w.y)
                    + q[8 * i + 4] * bflo(w.z) + q[8 * i + 5] * bfhi(w.z) + q[8 * i + 6] * bflo(w.w) + q[8 * i + 7] * bfhi(w.w); }
#pragma unroll
                for (int i = 0; i < 4; ++i) { const uint4 w = r4[i]; const int o8 = 64 + 8 * i; a += q[o8] * bflo(w.x) + q[o8 + 1] * bfhi(w.x) + q[o8 + 2] * bflo(w.y) + q[o8 + 3] * bfhi(w.y)
                    + q[o8 + 4] * bflo(w.z) + q[o8 + 5] * bfhi(w.z) + q[o8 + 6] * bflo(w.w) + q[o8 + 7] * bfhi(w.w); }
                sc[jj] = a;
            }
            float mx = m;
#pragma unroll
            for (int jj = 0; jj < 8; ++jj) mx = fmaxf(mx, sc[jj]);
            const float al = exp2f(m - mx);
            float ps = 0.f;
#pragma unroll
            for (int jj = 0; jj < 8; ++jj) { sc[jj] = exp2f(sc[jj] - mx); ps += sc[jj]; }
            l = l * al + ps; m = mx;
#pragma unroll
            for (int d = 0; d < 64; ++d) {
                const uint4 w = *(const uint4*)(Vt + ((size_t)bh * 64 + d) * 2048 + j0);
                o[d] = o[d] * al + sc[0] * bflo(w.x) + sc[1] * bfhi(w.x) + sc[2] * bflo(w.y) + sc[3] * bfhi(w.y) + sc[4] * bflo(w.z) + sc[5] * bfhi(w.z) + sc[6] * bflo(w.w) + sc[7] * bfhi(w.w);
            }
        }
        const float il = 1.f / l;
        bf16_t* dst = mix + ((size_t)b * 2048 + s_) * 1024 + hd * 64;
#pragma unroll
        for (int d = 0; d < 64; d += 2) *(unsigned*)(dst + d) = pack2(o[d] * il, o[d + 1] * il);
    }
}
#endif
#if SSD_NAIVE
DI void ssd_naive(const P& p, int bid, int nb) {
    unsigned char* ws = p.ws;
    const bf16_t* xa = (const bf16_t*)(ws + XBCA); const float* dt = (const float*)(ws + DTB); const bf16_t* z = (const bf16_t*)(ws + ZB);
    bf16_t* mix = (bf16_t*)(ws + MIX);
    const int wave = tidx() >> 6, pp = tidx() & 63;
    for (int item = bid; item < 32; item += nb) {
        const int bh = item * 4 + wave, b = bh >> 3, hd = bh & 7, g = hd >> 2;
        const float a = -__expf(p.in[10][hd]), Dh = p.in[11][hd];
        float st[128];
#pragma unroll
        for (int n = 0; n < 128; ++n) st[n] = 0.f;
        for (int t = 0; t < 2048; ++t) {
            const size_t row = (size_t)b * 2048 + t;
            const float dtv = dt[row * 8 + hd];
            const float da = __expf(dtv * a);
            const float xv = bf2f(xa[row * 1024 + hd * 64 + pp]);
            const float xd = dtv * xv;
            const uint4* b4 = (const uint4*)(xa + row * 1024 + 512 + g * 128);
            const uint4* c4 = (const uint4*)(xa + row * 1024 + 768 + g * 128);
            float y = 0.f;
#pragma unroll
            for (int i = 0; i < 16; ++i) {
                const uint4 bw = b4[i], cw = c4[i];
                const unsigned bb[4] = {bw.x, bw.y, bw.z, bw.w}, cc[4] = {cw.x, cw.y, cw.z, cw.w};
#pragma unroll
                for (int k = 0; k < 4; ++k) {
                    const int n = 8 * i + 2 * k;
                    st[n] = da * st[n] + xd * bflo(bb[k]); y += bflo(cc[k]) * st[n];
                    st[n + 1] = da * st[n + 1] + xd * bfhi(bb[k]); y += bfhi(cc[k]) * st[n + 1];
                }
            }
            y += Dh * xv;
            const float zv = bf2f(z[row * 512 + hd * 64 + pp]);
            mix[row * 1024 + 512 + hd * 64 + pp] = f2bf(y * siluf(zv));
        }
    }
}
#endif
DI void phase_mixer(const P& p, int bid, int nb, unsigned char* smem, int rep = 0) {
#if SSD_NAIVE
    ssd_naive(p, bid, nb);
    attn_fast(p, bid, nb, smem);
#else
    unsigned* ctr = (unsigned*)(p.ws + CTL + CTL_CNT + 256) + 64 * rep;
    int* slot = (int*)(smem + GEMM_LDS + 2048 - 32);
    for (;;) {
        __syncthreads();
        if (tidx() == 0) *slot = (int)atomicAdd(ctr, 1u);
        __syncthreads();
        const int it = *slot;
        if (it >= 128 + 2048) break;
        if (it < 128) { if (!NO_SSD) ssd_item(p, it, smem); }
        else {
            const int idx = it - 128, qb = 15 - (idx >> 7), bh = idx & 127;
            unsigned char* ws = p.ws;
            SelfSrc s{(const bf16_t*)(ws + QB), (const bf16_t*)(ws + KNB), (const bf16_t*)(ws + KROPE), (const bf16_t*)(ws + VTB), (bf16_t*)(ws + MIX), bh >> 3, bh & 7, bh, qb * 128};
            if (!NO_FLASH) flash_item<96, 64, 64, 4, 1>(s, 2 * qb + 2, 2, smem);
        }
    }
#endif
}

DI void phase_ssdnorm(const P& p, int bid, int nb, unsigned char* smem) {
    bf16_t* mix = (bf16_t*)(p.ws + MIX);
    const int lane = tidx() & 63, wave = tidx() >> 6;
    for (int tk = bid * 4 + wave; tk < T; tk += nb * 4) {
        uint4* ptr = (uint4*)(mix + (size_t)tk * 1024 + 512 + lane * 8);
        const uint4 w = *ptr;
        const unsigned ww[4] = {w.x, w.y, w.z, w.w};
        float v[8]; float ss = 0.f;
#pragma unroll
        for (int k = 0; k < 4; ++k) { v[2 * k] = bflo(ww[k]); v[2 * k + 1] = bfhi(ww[k]); ss += v[2 * k] * v[2 * k] + v[2 * k + 1] * v[2 * k + 1]; }
#pragma unroll
        for (int o = 16; o >= 1; o >>= 1) ss += __shfl_xor(ss, o);
        const float rr = rsqrtf(ss * (1.f / 256.f) + EPS);
        uint4 o4; o4.x = pack2(v[0] * rr, v[1] * rr); o4.y = pack2(v[2] * rr, v[3] * rr); o4.z = pack2(v[4] * rr, v[5] * rr); o4.w = pack2(v[6] * rr, v[7] * rr);
        *ptr = o4;
    }
}

struct EpiResid {
    float* pre; const float* res;
    DI void operator()(const float* Cs, int m0, int n0, int tid) const {
        const int c4 = (tid & 31) * 4, r0 = tid >> 5;
#pragma unroll 4
        for (int ps = 0; ps < 16; ++ps) {
            const int row = ps * 8 + r0;
            const size_t idx = (size_t)(m0 + row) * 1024 + n0 + c4;
            const float4 v = cs4(Cs, row, c4), rr = *(const float4*)(res + idx);
            *(float4*)(pre + idx) = make_float4(ALPHA * rr.x + v.x, ALPHA * rr.y + v.y, ALPHA * rr.z + v.z, ALPHA * rr.w + v.w);
        }
    }
};
DI void phase_wout(const P& p, int bid, int nb, unsigned char* smem) {
    const int v = vbid(bid, nb);
    EpiResid e{p.out, p.in[0]};
    GemmArgs g{(const bf16_t*)(p.ws + MIX), 1024, (const bf16_t*)(p.ws + W_OUT), 1024, 1024, nullptr};
    for (int t = v; t < 256 * 8; t += nb) gemm_tile(g, (t >> 3) * 128, (t & 7) * 128, e, smem);
}
DI void ln_row(const float* src, const float* gam, const float* bet, int lane, float (&o)[16]) {
    float v[16];
#pragma unroll
    for (int i = 0; i < 4; ++i) { const float4 t4 = *(const float4*)(src + i * 256 + lane * 4); v[4 * i] = t4.x; v[4 * i + 1] = t4.y; v[4 * i + 2] = t4.z; v[4 * i + 3] = t4.w; }
    float s = 0.f;
#pragma unroll
    for (int i = 0; i < 16; ++i) s += v[i];
    const float mu = wave_sum(s) * (1.f / 1024.f);
    float q = 0.f;
#pragma unroll
    for (int i = 0; i < 16; ++i) { const float d = v[i] - mu; q += d * d; }
    const float rstd = rsqrtf(wave_sum(q) * (1.f / 1024.f) + EPS);
#pragma unroll
    for (int i = 0; i < 4; ++i) {
        const float4 g4 = *(const float4*)(gam + i * 256 + lane * 4), b4 = *(const float4*)(bet + i * 256 + lane * 4);
        o[4 * i] = (v[4 * i] - mu) * rstd * g4.x + b4.x; o[4 * i + 1] = (v[4 * i + 1] - mu) * rstd * g4.y + b4.y;
        o[4 * i + 2] = (v[4 * i + 2] - mu) * rstd * g4.z + b4.z; o[4 * i + 3] = (v[4 * i + 3] - mu) * rstd * g4.w + b4.w;
    }
}
DI void phase_ln1(const P& p, int bid, int nb, unsigned char* smem) {
    const int lane = tidx() & 63, wave = tidx() >> 6;
    float* hf = (float*)(p.ws + H1); bf16_t* hb = (bf16_t*)(p.ws + H1B);
    for (int tk = bid * 4 + wave; tk < T; tk += nb * 4) {
        float o[16];
        ln_row(p.out + (size_t)tk * 1024, p.in[14], p.in[15], lane, o);
#pragma unroll
        for (int i = 0; i < 4; ++i) {
            *(float4*)(hf + (size_t)tk * 1024 + i * 256 + lane * 4) = make_float4(o[4 * i], o[4 * i + 1], o[4 * i + 2], o[4 * i + 3]);
            uint2 w; w.x = pack2(o[4 * i], o[4 * i + 1]); w.y = pack2(o[4 * i + 2], o[4 * i + 3]);
            *(uint2*)(hb + (size_t)tk * 1024 + i * 256 + lane * 4) = w;
        }
    }
}
struct EpiXq {
    bf16_t* qx;
    DI void operator()(const float* Cs, int m0, int n0, int tid) const {
        const int c4 = (tid & 31) * 4, r0 = tid >> 5, hd = n0 >> 8, d = (n0 & 255) + c4, b = m0 >> 11, s0 = m0 & 2047;
#pragma unroll 4
        for (int ps = 0; ps < 16; ++ps) {
            const int row = ps * 8 + r0;
            float4 v = cs4(Cs, row, c4); v.x *= XSCALE; v.y *= XSCALE; v.z *= XSCALE; v.w *= XSCALE;
            *(uint2*)(qx + ((size_t)(b * 4 + hd) * 2048 + s0 + row) * 256 + d) = pack4(v);
        }
    }
};
DI void phase_xq(const P& p, int bid, int nb, unsigned char* smem) {
    const int v = vbid(bid, nb);
    EpiXq e{(bf16_t*)(p.ws + QX)};
    GemmArgs g{(const bf16_t*)(p.ws + H1B), 1024, (const bf16_t*)(p.ws + W_XQ), 1024, 1024, nullptr};
    for (int t = v; t < 256 * 8; t += nb) gemm_tile(g, (t >> 3) * 128, (t & 7) * 128, e, smem);
}
DI void phase_xattn(const P& p, int bid, int nb, unsigned char* smem) {
#if !XATTN_NAIVE
    xattn_fast(p, bid, nb, smem); return;
#endif
    unsigned char* ws = p.ws;
    const bf16_t* qx = (const bf16_t*)(ws + QX); const bf16_t* kx = (const bf16_t*)(ws + KX); const bf16_t* vxt = (const bf16_t*)(ws + VXT);
    bf16_t* ox = (bf16_t*)(ws + OX);
    const int lane = tidx() & 63, hd = tidx() >> 6;
    float* qs = (float*)smem + hd * 512; float* ps = qs + 256;
    for (int tk = bid; tk < T; tk += nb) {
        const int b = tk >> 11, s_ = tk & 2047;
        __syncthreads();
        {
            const uint2 w = *(const uint2*)(qx + ((size_t)(b * 4 + hd) * 2048 + s_) * 256 + lane * 4);
            qs[lane * 4] = bflo(w.x); qs[lane * 4 + 1] = bfhi(w.x); qs[lane * 4 + 2] = bflo(w.y); qs[lane * 4 + 3] = bfhi(w.y);
        }
        __syncthreads();
        float sc[4];
#pragma unroll
        for (int i = 0; i < 4; ++i) {
            const int m = lane + 64 * i;
            const uint4* k4 = (const uint4*)(kx + ((size_t)(b * 4 + hd) * 256 + m) * 256);
            float a = 0.f;
#pragma unroll 8
            for (int c = 0; c < 32; ++c) {
                const uint4 w = k4[c];
                const float4 q0 = *(const float4*)(qs + 8 * c), q1 = *(const float4*)(qs + 8 * c + 4);
                a += q0.x * bflo(w.x) + q0.y * bfhi(w.x) + q0.z * bflo(w.y) + q0.w * bfhi(w.y) + q1.x * bflo(w.z) + q1.y * bfhi(w.z) + q1.z * bflo(w.w) + q1.w * bfhi(w.w);
            }
            sc[i] = a;
        }
        const float mx = wave_max(fmaxf(fmaxf(sc[0], sc[1]), fmaxf(sc[2], sc[3])));
        float sum = 0.f;
#pragma unroll
        for (int i = 0; i < 4; ++i) { sc[i] = exp2f(sc[i] - mx); sum += sc[i]; }
        const float il = 1.f / wave_sum(sum);
#pragma unroll
        for (int i = 0; i < 4; ++i) ps[lane + 64 * i] = sc[i] * il;
        __syncthreads();
        float o[4];
#pragma unroll
        for (int dd = 0; dd < 4; ++dd) {
            const int d = lane * 4 + dd;
            const uint4* v4 = (const uint4*)(vxt + ((size_t)(b * 4 + hd) * 256 + d) * 256);
            float a = 0.f;
#pragma unroll 8
            for (int c = 0; c < 32; ++c) {
                const uint4 w = v4[c];
                const float4 q0 = *(const float4*)(ps + 8 * c), q1 = *(const float4*)(ps + 8 * c + 4);
                a += q0.x * bflo(w.x) + q0.y * bfhi(w.x) + q0.z * bflo(w.y) + q0.w * bfhi(w.y) + q1.x * bflo(w.z) + q1.y * bfhi(w.z) + q1.z * bflo(w.w) + q1.w * bfhi(w.w);
            }
            o[dd] = a;
        }
        uint2 w; w.x = pack2(o[0], o[1]); w.y = pack2(o[2], o[3]);
        *(uint2*)(ox + (size_t)tk * 1024 + hd * 256 + lane * 4) = w;
    }
}
DI void phase_xo(const P& p, int bid, int nb, unsigned char* smem) {
    const int v = vbid(bid, nb);
    EpiResid e{p.out, (const float*)(p.ws + H1)};
    GemmArgs g{(const bf16_t*)(p.ws + OX), 1024, (const bf16_t*)(p.ws + W_XO), 1024, 1024, nullptr};
    for (int t = v; t < 256 * 8; t += nb) gemm_tile(g, (t >> 3) * 128, (t & 7) * 128, e, smem);
}
typedef float f32x4v __attribute__((ext_vector_type(4)));
DI void phase_ln2_router(const P& p, int bid, int nb, unsigned char* smem) {
    unsigned char* ws = p.ws;
    const int lane = tidx() & 63, wave = tidx() >> 6;
    float* hf = (float*)(ws + H2); bf16_t* hb = (bf16_t*)(ws + H2B);
    const float* wrt = (const float*)(ws + W_RT);
    const float* gam = p.in[20]; const float* bet = p.in[21];
    unsigned* cnt = (unsigned*)(ws + CTL + CTL_CNT); int* lists = (int*)(ws + LISTS); float* tgate = (float*)(ws + TOK_GATE);
    float* lg = (float*)smem + wave * (16 * 52 + 32);
    float* stt = lg + 16 * 52;
    for (int grp = bid; grp < T / 64; grp += nb) {
        const int t0 = grp * 64 + wave * 16;
        for (int rr = 0; rr < 16; ++rr) {
            const int tk = t0 + rr;
            const float* srcp = p.out + (size_t)tk * 1024;
            float v[16];
#pragma unroll
            for (int i = 0; i < 4; ++i) { const float4 t4 = *(const float4*)(srcp + i * 256 + lane * 4); v[4 * i] = t4.x; v[4 * i + 1] = t4.y; v[4 * i + 2] = t4.z; v[4 * i + 3] = t4.w; }
            float s = 0.f;
#pragma unroll
            for (int i = 0; i < 16; ++i) s += v[i];
            const float mu = wave_sum(s) * (1.f / 1024.f);
            float q = 0.f;
#pragma unroll
            for (int i = 0; i < 16; ++i) { const float d = v[i] - mu; q += d * d; }
            const float rstd = rsqrtf(wave_sum(q) * (1.f / 1024.f) + EPS);
            if (lane == 0) { stt[2 * rr] = mu; stt[2 * rr + 1] = rstd; }
#pragma unroll
            for (int i = 0; i < 4; ++i) {
                const float4 g4 = *(const float4*)(gam + i * 256 + lane * 4), b4 = *(const float4*)(bet + i * 256 + lane * 4);
                const float o0 = (v[4 * i] - mu) * rstd * g4.x + b4.x, o1 = (v[4 * i + 1] - mu) * rstd * g4.y + b4.y;
                const float o2 = (v[4 * i + 2] - mu) * rstd * g4.z + b4.z, o3 = (v[4 * i + 3] - mu) * rstd * g4.w + b4.w;
                *(float4*)(hf + (size_t)tk * 1024 + i * 256 + lane * 4) = make_float4(o0, o1, o2, o3);
                uint2 w; w.x = pack2(o0, o1); w.y = pack2(o2, o3);
                *(uint2*)(hb + (size_t)tk * 1024 + i * 256 + lane * 4) = w;
            }
        }
        __builtin_amdgcn_wave_barrier();
        {
            const int i16 = lane & 15, g4i = lane >> 4;
            const float mu = stt[2 * i16], rstd = stt[2 * i16 + 1];
            const float* arow = p.out + (size_t)(t0 + i16) * 1024 + 4 * g4i;
            const float* brow = wrt + (size_t)i16 * 1024 + 4 * g4i;
            const float* grow = gam + 4 * g4i; const float* berow = bet + 4 * g4i;
            f32x4v acc0 = {0.f, 0.f, 0.f, 0.f}, acc1 = acc0, acc2 = acc0;
#pragma unroll 2
            for (int S = 0; S < 64; ++S) {
                const float4 x4 = *(const float4*)(arow + 16 * S), g4 = *(const float4*)(grow + 16 * S), e4 = *(const float4*)(berow + 16 * S);
                const float4 b0 = *(const float4*)(brow + 16 * S), b1 = *(const float4*)(brow + 16 * 1024 + 16 * S), b2 = *(const float4*)(brow + 32 * 1024 + 16 * S);
                const float a0 = (x4.x - mu) * rstd * g4.x + e4.x, a1 = (x4.y - mu) * rstd * g4.y + e4.y, a2 = (x4.z - mu) * rstd * g4.z + e4.z, a3 = (x4.w - mu) * rstd * g4.w + e4.w;
                acc0 = __builtin_amdgcn_mfma_f32_16x16x4f32(a0, b0.x, acc0, 0, 0, 0); acc1 = __builtin_amdgcn_mfma_f32_16x16x4f32(a0, b1.x, acc1, 0, 0, 0); acc2 = __builtin_amdgcn_mfma_f32_16x16x4f32(a0, b2.x, acc2, 0, 0, 0);
                acc0 = __builtin_amdgcn_mfma_f32_16x16x4f32(a1, b0.y, acc0, 0, 0, 0); acc1 = __builtin_amdgcn_mfma_f32_16x16x4f32(a1, b1.y, acc1, 0, 0, 0); acc2 = __builtin_amdgcn_mfma_f32_16x16x4f32(a1, b2.y, acc2, 0, 0, 0);
                acc0 = __builtin_amdgcn_mfma_f32_16x16x4f32(a2, b0.z, acc0, 0, 0, 0); acc1 = __builtin_amdgcn_mfma_f32_16x16x4f32(a2, b1.z, acc1, 0, 0, 0); acc2 = __builtin_amdgcn_mfma_f32_16x16x4f32(a2, b2.z, acc2, 0, 0, 0);
                acc0 = __builtin_amdgcn_mfma_f32_16x16x4f32(a3, b0.w, acc0, 0, 0, 0); acc1 = __builtin_amdgcn_mfma_f32_16x16x4f32(a3, b1.w, acc1, 0, 0, 0); acc2 = __builtin_amdgcn_mfma_f32_16x16x4f32(a3, b2.w, acc2, 0, 0, 0);
            }
#pragma unroll
            for (int e = 0; e < 4; ++e) {
                float* rowp = lg + (4 * g4i + e) * 52 + i16;
                rowp[0] = acc0[e]; rowp[16] = acc1[e]; rowp[32] = acc2[e];
            }
        }
        __builtin_amdgcn_wave_barrier();
        if (lane < 16) {
            const int tk = t0 + lane;
            const float* lr = lg + lane * 52;
            float gl[4], el[32];
#pragma unroll
            for (int j = 0; j < 4; ++j) gl[j] = lr[j] + p.in[23][j];
#pragma unroll
            for (int j = 0; j < 32; ++j) el[j] = lr[4 + j] + p.in[25][j];
            int gi = 0; float gm = gl[0];
#pragma unroll
            for (int j = 1; j < 4; ++j) if (gl[j] > gm) { gm = gl[j]; gi = j; }
            float gs = 0.f;
#pragma unroll
            for (int j = 0; j < 4; ++j) gs += __expf(gl[j] - gm);
            const float ggate = 1.f / gs;
            float ev[8];
#pragma unroll
            for (int j = 0; j < 8; ++j) ev[j] = gi == 0 ? el[j] : gi == 1 ? el[8 + j] : gi == 2 ? el[16 + j] : el[24 + j];
            int i1 = 0; float v1 = ev[0];
#pragma unroll
            for (int j = 1; j < 8; ++j) if (ev[j] > v1) { v1 = ev[j]; i1 = j; }
            int i2 = -1; float v2 = -3.0e38f;
#pragma unroll
            for (int j = 0; j < 8; ++j) if (j != i1 && ev[j] > v2) { v2 = ev[j]; i2 = j; }
            const float e2 = __expf(v2 - v1);
            const float g1 = ggate / (1.f + e2), g2 = ggate * e2 / (1.f + e2);
            const int ex1 = gi * 8 + i1, ex2 = gi * 8 + i2;
            const unsigned p1 = atomicAdd(&cnt[ex1], 1u); lists[(size_t)ex1 * T + p1] = tk * 2;
            const unsigned p2 = atomicAdd(&cnt[ex2], 1u); lists[(size_t)ex2 * T + p2] = tk * 2 + 1;
            tgate[tk * 2] = g1; tgate[tk * 2 + 1] = g2;
        }
        __builtin_amdgcn_wave_barrier();
    }
}
struct MoeMap { int off[33]; };
DI int moe_tiles(const unsigned* cnt, int* offs  ) {
    __syncthreads();
    if (tidx() == 0) { int o = 0; for (int e = 0; e < 32; ++e) { offs[e] = o; o += (((int)cnt[e] + 127) >> 7) << 7; } offs[32] = o; }
    __syncthreads();
    return offs[32] >> 7;
}
struct EpiGU {
    bf16_t* hdn;
    DI void operator()(const float* Cs, int m0, int n0, int tid) const {
#pragma unroll 4
        for (int ps = 0; ps < 8; ++ps) {
            const int it = ps * 256 + tid, row = it >> 4, qd = it & 15, c = (qd >> 3) * 64 + (qd & 7) * 4;
            const float4 g = cs4(Cs, row, c), u = cs4(Cs, row, c + 32);
            const int hc = ((n0 & 511) >> 7) * 64 + (qd >> 3) * 32 + (qd & 7) * 4;
            *(uint2*)(hdn + (size_t)(m0 + row) * 256 + hc) = pack4(make_float4(siluf(g.x) * u.x, siluf(g.y) * u.y, siluf(g.z) * u.z, siluf(g.w) * u.w));
        }
    }
};
struct EpiDown {
    bf16_t* y; const int* ltok; const float* lgate;
    DI void operator()(const float* Cs, int m0, int n0, int tid) const {
        const int c4 = (tid & 31) * 4, r0 = tid >> 5;
#pragma unroll 4
        for (int ps = 0; ps < 16; ++ps) {
            const int row = ps * 8 + r0, tk2 = ltok[row];
            if (tk2 >= 0) {
                const float gt = lgate[row];
                float4 v = cs4(Cs, row, c4); v.x *= gt; v.y *= gt; v.z *= gt; v.w *= gt;
                *(uint2*)(y + (size_t)tk2 * 1024 + n0 + c4) = pack4(v);
            }
        }
    }
};
template <int WHICH>
DI void phase_moe(const P& p, int bid, int nb, unsigned char* smem) {
    unsigned char* ws = p.ws;
    const unsigned* cnt = (const unsigned*)(ws + CTL + CTL_CNT); const int* lists = (const int*)(ws + LISTS); const float* tgate = (const float*)(ws + TOK_GATE);
    int* offs = (int*)(smem + GEMM_LDS); int* ltok = offs + 64; int* lrow = ltok + 128; float* lgate = (float*)(lrow + 128);
    const int nmt = moe_tiles(cnt, offs);
    constexpr int NNT = WHICH == 0 ? 4 : 8;
    const int v = vbid(bid, nb);
    for (int t = v; t < nmt * NNT; t += nb) {
        const int mt = t / NNT, ntl = t % NNT;
        const int slot0 = mt * 128;
        int e = 0;
        while (offs[e + 1] <= slot0) ++e;
        __syncthreads();
        if (tidx() < 128) {
            const int pos = slot0 - offs[e] + tidx();
            const int tk2 = pos < (int)cnt[e] ? lists[(size_t)e * T + pos] : -1;
            ltok[tidx()] = tk2; lrow[tidx()] = tk2 < 0 ? 0 : (tk2 >> 1); lgate[tidx()] = tk2 < 0 ? 0.f : tgate[tk2];
        }
        __syncthreads();
        if (WHICH == 0) {
            EpiGU ep{(bf16_t*)(ws + HDN)};
            GemmArgs g{(const bf16_t*)(ws + H2B), 1024, (const bf16_t*)(ws + W_GU) + (size_t)e * 512 * 1024, 1024, 1024, lrow};
            gemm_tile(g, slot0, ntl * 128, ep, smem);
        } else {
            EpiDown ep{(bf16_t*)(ws + YB), ltok, lgate};
            GemmArgs g{(const bf16_t*)(ws + HDN), 256, (const bf16_t*)(ws + W_DN) + (size_t)e * 1024 * 256, 256, 256, nullptr};
            gemm_tile(g, slot0, ntl * 128, ep, smem);
        }
    }
}
DI void phase_final(const P& p, int bid, int nb, unsigned char* smem) {
    const int lane = tidx() & 63, wave = tidx() >> 6;
    const float* hf = (const float*)(p.ws + H2); const bf16_t* y = (const bf16_t*)(p.ws + YB);
    const float* gam = p.in[29]; const float* bet = p.in[30];
    for (int tk = bid * 4 + wave; tk < T; tk += nb * 4) {
        float v[16];
#pragma unroll
        for (int i = 0; i < 4; ++i) {
            const float4 t4 = *(const float4*)(hf + (size_t)tk * 1024 + i * 256 + lane * 4);
            const uint2 a = *(const uint2*)(y + (size_t)(tk * 2) * 1024 + i * 256 + lane * 4), b = *(const uint2*)(y + (size_t)(tk * 2 + 1) * 1024 + i * 256 + lane * 4);
            v[4 * i] = ALPHA * t4.x + bflo(a.x) + bflo(b.x); v[4 * i + 1] = ALPHA * t4.y + bfhi(a.x) + bfhi(b.x);
            v[4 * i + 2] = ALPHA * t4.z + bflo(a.y) + bflo(b.y); v[4 * i + 3] = ALPHA * t4.w + bfhi(a.y) + bfhi(b.y);
        }
        float s = 0.f;
#pragma unroll
        for (int i = 0; i < 16; ++i) s += v[i];
        const float mu = wave_sum(s) * (1.f / 1024.f);
        float q = 0.f;
#pragma unroll
        for (int i = 0; i < 16; ++i) { const float d = v[i] - mu; q += d * d; }
        const float rstd = rsqrtf(wave_sum(q) * (1.f / 1024.f) + EPS);
#pragma unroll
        for (int i = 0; i < 4; ++i) {
            const float4 g4 = *(const float4*)(gam + i * 256 + lane * 4), b4 = *(const float4*)(bet + i * 256 + lane * 4);
            *(float4*)(p.out + (size_t)tk * 1024 + i * 256 + lane * 4) = make_float4((v[4 * i] - mu) * rstd * g4.x + b4.x, (v[4 * i + 1] - mu) * rstd * g4.y + b4.y,
                                                                                    (v[4 * i + 2] - mu) * rstd * g4.z + b4.z, (v[4 * i + 3] - mu) * rstd * g4.w + b4.w);
        }
    }
}

#define XB_TMO      128
#define XB_XCNT(j)  (256  + 64 * (j))
#define XB_XSUB(j)  (1280 + 64 * (j))
#define XB_XGEN(j)  (2304 + 64 * (j))
#define XB_TOP      3328
#define XB_TOPGEN   3392
#define XCD_BAR_WORDS 3456
#define XB_SPIN_CAP (1u << 25)
DI unsigned xb_ld(unsigned* p) { return __hip_atomic_load(p, __ATOMIC_RELAXED, __HIP_MEMORY_SCOPE_AGENT); }
DI unsigned xb_add(unsigned* p, unsigned v) { return __hip_atomic_fetch_add(p, v, __ATOMIC_RELAXED, __HIP_MEMORY_SCOPE_AGENT); }
DI unsigned xb_xcc_id() { return (unsigned)__builtin_amdgcn_s_getreg((3 << 11) | 20) & 0xFu; }
#define XB_SPIN(cond, bar) do { unsigned _sp = 0; while (cond) { __builtin_amdgcn_s_sleep(1); \
    if ((++_sp & 255u) == 0u) { if (xb_ld(&(bar)[XB_TMO])) break; if (_sp > XB_SPIN_CAP) { atomicAdd(&(bar)[XB_TMO], 1u); break; } } } } while (0)
struct XcdBarrier { unsigned* bar; unsigned x; volatile LAS unsigned* st; };
DI XcdBarrier xcd_barrier_post(unsigned* bar, volatile LAS unsigned* st) {
    XcdBarrier b; b.bar = bar; b.x = xb_xcc_id(); b.st = st;
    if (threadIdx.x == 0) (void)xb_add(&bar[XB_XCNT(b.x)], 1u);
    return b;
}
DI void xcd_barrier_complete(unsigned* bar, unsigned x, unsigned& nloc, unsigned& nx) {
    const unsigned G = gridDim.x * gridDim.y * gridDim.z;
    unsigned sum, cnt, mine, sp = 0u;
    for (;;) {
        sum = 0u; cnt = 0u; mine = 0u;
#pragma unroll
        for (unsigned j = 0; j < 16; ++j) { const unsigned c = xb_ld(&bar[XB_XCNT(j)]); sum += c; cnt += (c > 0u) ? 1u : 0u; mine = (j == x) ? c : mine; }
        if (sum == G) break;
        __builtin_amdgcn_s_sleep(1);
        if ((++sp & 255u) == 0u) { if (xb_ld(&bar[XB_TMO])) break; if (sp > XB_SPIN_CAP) { atomicAdd(&bar[XB_TMO], 1u); break; } }
    }
    nloc = mine > 0u ? mine : 1u; nx = cnt > 0u ? cnt : 1u;
}
DI void xcd_barrier(const XcdBarrier& b) {
    asm volatile("s_waitcnt vmcnt(0)" ::: "memory");
    __syncthreads();
    if (threadIdx.x == 0) {
        unsigned* bar = b.bar;
        __builtin_amdgcn_s_waitcnt(0);
        unsigned nloc = b.st[0], nx = b.st[1];
        if (nloc == 0u) { xcd_barrier_complete(bar, b.x, nloc, nx); b.st[0] = nloc; b.st[1] = nx; }
        const unsigned old = xb_add(&bar[XB_XSUB(b.x)], 1u);
        const unsigned gen = old / nloc;
        if (old + 1u == (gen + 1u) * nloc) {
            __builtin_amdgcn_fence(__ATOMIC_RELEASE, "agent");
            asm volatile("s_waitcnt vmcnt(0)" ::: "memory");
            const unsigned og = xb_add(&bar[XB_TOP], 1u);
            const unsigned tg = og / nx;
            if (og + 1u == (tg + 1u) * nx) xb_add(&bar[XB_TOPGEN], 1u);
            else XB_SPIN(xb_ld(&bar[XB_TOPGEN]) == tg, bar);
            __builtin_amdgcn_fence(__ATOMIC_ACQUIRE, "agent");
            xb_add(&bar[XB_XGEN(b.x)], 1u);
            asm volatile("s_waitcnt vmcnt(0)" ::: "memory");
        } else {
            XB_SPIN(xb_ld(&bar[XB_XGEN(b.x)]) == gen, bar);
            __builtin_amdgcn_fence(__ATOMIC_ACQUIRE, "agent");
            asm volatile("s_waitcnt vmcnt(0)" ::: "memory");
        }
    }
    __syncthreads();
}

constexpr int NPHASE = 14;
template <int PH>
DI void run_phase(const P& p, int bid, int nb, unsigned char* smem, int rep = 0) {
    if (PH == 0) phase_prep(p, bid, nb, smem);
    else if (PH == 1) phase_proj(p, bid, nb, smem, rep);
    else if (PH == 2) phase_up(p, bid, nb, smem);
    else if (PH == 3) phase_mixer(p, bid, nb, smem, rep);
    else if (PH == 4) phase_ssdnorm(p, bid, nb, smem);
    else if (PH == 5) phase_wout(p, bid, nb, smem);
    else if (PH == 6) phase_ln1(p, bid, nb, smem);
    else if (PH == 7) phase_xq(p, bid, nb, smem);
    else if (PH == 8) phase_xattn(p, bid, nb, smem);
    else if (PH == 9) phase_xo(p, bid, nb, smem);
    else if (PH == 10) phase_ln2_router(p, bid, nb, smem);
    else if (PH == 11) phase_moe<0>(p, bid, nb, smem);
    else if (PH == 12) phase_moe<1>(p, bid, nb, smem);
    else if (PH == 13) phase_final(p, bid, nb, smem);
}
template <int PH>
__global__ void __launch_bounds__(256, 2) k_phase(P p) {
    __shared__ __attribute__((aligned(16))) unsigned char smem[SMEM_BYTES];
    run_phase<PH>(p, blockIdx.x, gridDim.x, smem);
}

#if MEGA
#ifndef MEGA_WAVES
#define MEGA_WAVES 2
#endif
template <int PH>
DI void mega_steps(const P& p, const XcdBarrier& bar, unsigned char* smem) {
    run_phase<PH>(p, blockIdx.x, gridDim.x, smem);
    if constexpr (((REPEAT_MASK >> PH) & 1) != 0) { xcd_barrier(bar); run_phase<PH>(p, blockIdx.x, gridDim.x, smem, 1); }
    if constexpr (PH + 1 < NPHASE) { xcd_barrier(bar); mega_steps<PH + 1>(p, bar, smem); }
}
__global__ void __launch_bounds__(256, MEGA_WAVES) k_mega(P p) {
    __shared__ __attribute__((aligned(16))) unsigned char smem[SMEM_BYTES];
    volatile LAS unsigned* st = (volatile LAS unsigned*)(smem + SMEM_BYTES - 16);
    if (threadIdx.x < 4) st[threadIdx.x] = 0u;
    __syncthreads();
    const XcdBarrier bar = xcd_barrier_post((unsigned*)(p.ws + CTL), st);
    mega_steps<0>(p, bar, smem);
}
#endif
template <int PH>
__global__ void __launch_bounds__(256, 1) k_phase_big(P p) {
    __shared__ __attribute__((aligned(16))) unsigned char smem[SMEM_BYTES];
    run_phase<PH>(p, blockIdx.x, gridDim.x, smem);
}
template <int PH>
static void launch_phase(const P& p, int grid, hipStream_t st) {
    if constexpr (PH == 3 && !P3_SMALL) hipLaunchKernelGGL((k_phase_big<PH>), dim3(grid), dim3(256), 0, st, p);
    else hipLaunchKernelGGL((k_phase<PH>), dim3(grid), dim3(256), 0, st, p);
}

extern "C" void kernel_launch(void* const* d_in, const int* in_sizes, int n_in, void* d_out, int out_size, void* d_ws, size_t ws_size, hipStream_t stream) {
    if (n_in != 31 || out_size != T * D || ws_size < WS_NEED) {
        fprintf(stderr, "kernel_launch: unexpected shapes: n_in %d out %d ws %zu (need %zu)\n", n_in, out_size, ws_size, (size_t)WS_NEED);
        return;
    }
    P p{};
    for (int i = 0; i < 31; ++i) p.in[i] = (const float*)d_in[i];
    p.out = (float*)d_out; p.ws = (unsigned char*)d_ws;
    (void)hipMemsetAsync((unsigned char*)d_ws + CTL, 0, CTL_BYTES, stream);
#if MEGA
    static int grid = 0;
    if (grid == 0) {
        int dev = 0, cus = 0, per_cu = 0;
        (void)hipGetDevice(&dev);
        (void)hipDeviceGetAttribute(&cus, hipDeviceAttributeMultiprocessorCount, dev);
        if (hipOccupancyMaxActiveBlocksPerMultiprocessor(&per_cu, (const void*)k_mega, 256, 0) != hipSuccess || per_cu < 1) { fprintf(stderr, "kernel_launch: occupancy query failed\n"); per_cu = 1; }
        if (per_cu > 2) per_cu = 2;
        grid = cus * per_cu;
        fprintf(stderr, "kernel_launch: mega grid %d (%d CUs x %d)\n", grid, cus, per_cu);
    }
    void* args[] = {(void*)&p};
    const hipError_t le = hipLaunchCooperativeKernel((const void*)k_mega, dim3(grid), dim3(256), args, 0, stream);
    if (le != hipSuccess) fprintf(stderr, "kernel_launch: cooperative launch failed: %s (grid %d)\n", hipGetErrorString(le), grid);
#else
    const int grid = 1024;
    launch_phase<0>(p, grid, stream); launch_phase<1>(p, grid, stream); launch_phase<2>(p, grid, stream); launch_phase<3>(p, grid, stream);
    launch_phase<4>(p, grid, stream); launch_phase<5>(p, grid, stream); launch_phase<6>(p, grid, stream); launch_phase<7>(p, grid, stream);
    launch_phase<8>(p, grid, stream); launch_phase<9>(p, grid, stream); launch_phase<10>(p, grid, stream); launch_phase<11>(p, grid, stream);
    launch_phase<12>(p, grid, stream); launch_phase<13>(p, grid, stream);
#endif
}
```

```cpp
#include <hip/hip_runtime.h>
#include <stdint.h>
#include <stdio.h>

#ifndef MEGA
#define MEGA 1
#endif
#ifndef ATTN_NAIVE
#define ATTN_NAIVE 0
#endif
#ifndef XATTN_NAIVE
#define XATTN_NAIVE 0
#endif
#ifndef SSD_NAIVE
#define SSD_NAIVE 0
#endif
#ifndef P3_SMALL
#define P3_SMALL 1
#endif
#ifndef NO_SSD
#define NO_SSD 0
#endif
#ifndef NO_FLASH
#define NO_FLASH 0
#endif
#ifndef GEMM_GLDS
#define GEMM_GLDS 1
#endif
#ifndef REPEAT_MASK
#define REPEAT_MASK 0
#endif
#ifndef REP_MODE
#define REP_MODE 0
#endif
#ifndef GEMM_DIRECT
#define GEMM_DIRECT 0
#endif

typedef unsigned short bf16_t;
typedef short bf16x8 __attribute__((ext_vector_type(8)));
typedef float f32x16 __attribute__((ext_vector_type(16)));
#define DI __device__ __forceinline__
#define LAS __attribute__((address_space(3)))
#define MFMA32(a, b, c) __builtin_amdgcn_mfma_f32_32x32x16_bf16((a), (b), (c), 0, 0, 0)

constexpr int Bn = 16, S = 2048, T = Bn * S, D = 1024;
constexpr int NMEM = 256;
constexpr float EPS = 1e-5f;
constexpr float ALPHA = 1.189207115002721f;
constexpr float LOG2E = 1.4426950408889634f;
constexpr float QSCALE = 0.10206207261596577f * LOG2E;
constexpr float XSCALE = 0.0625f * LOG2E;
constexpr int NEXP = 32;
constexpr int MAXSLOTS = 69632;

constexpr size_t MiB = 1u << 20;
constexpr size_t W_IN = 0;
constexpr size_t W_QUP = W_IN + 4 * MiB;
constexpr size_t W_KVUP = W_QUP + 768 * 256 * 2;
constexpr size_t W_OUT = W_KVUP + 1024 * 128 * 2;
constexpr size_t W_XQ = W_OUT + 2 * MiB;
constexpr size_t W_XKV = W_XQ + 2 * MiB;
constexpr size_t W_XO = W_XKV + 4 * MiB;
constexpr size_t W_GU = W_XO + 2 * MiB;
constexpr size_t W_DN = W_GU + 32 * MiB;
constexpr size_t W_RT = W_DN + 16 * MiB;
constexpr size_t ROPE_C = W_RT + 48 * 1024 * 4;
constexpr size_t ROPE_S = ROPE_C + 2048 * 16 * 4;
constexpr size_t TOK_GATE = ROPE_S + 2048 * 16 * 4;
constexpr size_t CTL = TOK_GATE + (size_t)T * 2 * 4;
constexpr size_t CTL_BYTES = 32768;
constexpr size_t CTL_CNT = 16384;
static_assert(CTL + CTL_BYTES <= 64 * MiB, "weights region overflow");
constexpr size_t RA = 64 * MiB, RB = 192 * MiB, RC = 320 * MiB, RD = 448 * MiB, WS_NEED = 512 * MiB;
constexpr size_t XBC = RA;
constexpr size_t KX = RA + 64 * MiB;
constexpr size_t VXT = KX + 8 * MiB;
constexpr size_t YB = RA;
constexpr size_t QB = RB;
constexpr size_t KNB = RB + 48 * MiB;
constexpr size_t VTB = KNB + 32 * MiB;
constexpr size_t H1 = RB;
constexpr size_t H2 = RB;
constexpr size_t XB = RC;
constexpr size_t MEMB = RB;
constexpr size_t XBCA = RC;
constexpr size_t MIX = RC + 64 * MiB;
constexpr size_t H1B = RC;
constexpr size_t QX = RC + 64 * MiB;
constexpr size_t OX = RC;
constexpr size_t H2B = RC;
constexpr size_t HDN = RC + 64 * MiB;
constexpr size_t CQ = RD;
constexpr size_t CKV = CQ + 16 * MiB;
constexpr size_t KROPE = CKV + 8 * MiB;
constexpr size_t DTB = KROPE + 2 * MiB;
constexpr size_t ZB = DTB + 1 * MiB;
constexpr size_t LISTS = RD;
static_assert(ZB + 32 * MiB <= WS_NEED, "region D overflow");

struct P {
    const float* in[31];
    float* out;
    unsigned char* ws;
};

typedef __bf16 hbf16x2 __attribute__((ext_vector_type(2)));
typedef float f32x2 __attribute__((ext_vector_type(2)));
DI bf16_t f2bf(float x) { return __builtin_bit_cast(bf16_t, (__bf16)x); }
DI float bf2f(bf16_t b) { return __uint_as_float(((unsigned)b) << 16); }
DI float bflo(unsigned w) { return __uint_as_float(w << 16); }
DI float bfhi(unsigned w) { return __uint_as_float(w & 0xffff0000u); }
DI unsigned pack2(float a, float b) { f32x2 v = {a, b}; return __builtin_bit_cast(unsigned, __builtin_convertvector(v, hbf16x2)); }
DI float siluf(float x) { return x / (1.f + __expf(-x)); }
DI float softplusf(float x) {
    const float zz = __expf(-fabsf(x));
    const float l1p = zz < 0.01f ? zz * (1.f - zz * (0.5f - zz * (1.f / 3.f))) : __logf(1.f + zz);
    return fmaxf(x, 0.f) + l1p;
}
DI int tidx() { int t = __builtin_amdgcn_workitem_id_x(); asm volatile("" : "+v"(t)); return t; }
DI int crow(int reg, int h) { return (reg & 3) + 8 * (reg >> 2) + 4 * h; }
constexpr int CS_LD = 132;
DI float4 cs4(const float* Cs, int row, int col) { return *(const float4*)(Cs + row * CS_LD + col); }
DI uint2 pack4(float4 v) { uint2 w; w.x = pack2(v.x, v.y); w.y = pack2(v.z, v.w); return w; }
DI float wave_sum(float v) {
#pragma unroll
    for (int o = 32; o >= 1; o >>= 1) v += __shfl_xor(v, o);
    return v;
}
DI float wave_max(float v) {
#pragma unroll
    for (int o = 32; o >= 1; o >>= 1) v = fmaxf(v, __shfl_xor(v, o));
    return v;
}

constexpr int LDS_ROW = 144;
constexpr int TILE_BYTES = 128 * LDS_ROW;
constexpr int GEMM_LDS = 4 * TILE_BYTES;
constexpr int SMEM_BYTES = GEMM_LDS + 2048;
static_assert(128 * CS_LD * 4 <= GEMM_LDS, "epilogue tile");

struct GemmArgs {
    const bf16_t* A; int lda;
    const bf16_t* Bt; int ldb;
    int K;
    const int* lrows;
};

template <class Epi>
DI void gemm_tile(const GemmArgs& g, int m0, int n0, Epi& epi, unsigned char* smem) {
    const int tid = tidx(), lane = tid & 63, wave = tid >> 6, wr = wave >> 1, wc = wave & 1;
    const int r = lane & 31, h = lane >> 5;
    f32x16 acc[2][2];
#pragma unroll
    for (int i = 0; i < 2; ++i)
#pragma unroll
        for (int j = 0; j < 2; ++j)
#pragma unroll
            for (int e = 0; e < 16; ++e) acc[i][j][e] = 0.f;
    const int nk = g.K >> 6;
#if GEMM_DIRECT
    {
        const bf16_t* ap[2]; const bf16_t* bp[2];
#pragma unroll
        for (int i = 0; i < 2; ++i) {
            const int lr = wr * 64 + i * 32 + r;
            const int grow = g.lrows ? g.lrows[lr] : (m0 + lr);
            ap[i] = g.A + (size_t)grow * g.lda + 8 * h;
            bp[i] = g.Bt + (size_t)(n0 + wc * 64 + i * 32 + r) * g.ldb + 8 * h;
        }
        for (int k = 0; k < g.K; k += 16) {
            bf16x8 a[2], b[2];
#pragma unroll
            for (int i = 0; i < 2; ++i) { a[i] = *(const bf16x8*)(ap[i] + k); b[i] = *(const bf16x8*)(bp[i] + k); }
#pragma unroll
            for (int i = 0; i < 2; ++i)
#pragma unroll
                for (int j = 0; j < 2; ++j) acc[i][j] = MFMA32(a[i], b[j], acc[i][j]);
        }
    }
#elif GEMM_GLDS
    {
        constexpr int STG = 32768, TB = 16384;
        const int srow = tid >> 3, sch = (tid & 7) ^ ((srow >> 1) & 7);
        const bf16_t* ag[4]; const bf16_t* bg[4];
#pragma unroll
        for (int i = 0; i < 4; ++i) {
            const int lr = srow + 32 * i;
            const int grow = g.lrows ? g.lrows[lr] : (m0 + lr);
            ag[i] = g.A + (size_t)grow * g.lda + sch * 8;
            bg[i] = g.Bt + (size_t)(n0 + lr) * g.ldb + sch * 8;
        }
#define GLDS_STAGE(BUF, KO) do { unsigned char* _d = (BUF) + wave * 1024; \
        _Pragma("unroll") for (int i = 0; i < 4; ++i) { \
            __builtin_amdgcn_global_load_lds((const unsigned*)(ag[i] + (KO)), (LAS unsigned*)(_d + i * 4096), 16, 0, 0); \
            __builtin_amdgcn_global_load_lds((const unsigned*)(bg[i] + (KO)), (LAS unsigned*)(_d + TB + i * 4096), 16, 0, 0); } } while (0)
        __syncthreads();
        GLDS_STAGE(smem, 0);
        const int y16 = (h ^ ((r >> 1) & 7)) << 4;
        const int o0 = y16, o1 = 32 ^ y16, o2 = 64 ^ y16, o3 = 96 ^ y16;
        const int arow = (wr * 64 + r) * 128, brow = TB + (wc * 64 + r) * 128;
        __syncthreads();
        for (int kt = 0; kt < nk; ++kt) {
            const unsigned char* cur = smem + (kt & 1) * STG;
            if (kt + 1 < nk) GLDS_STAGE(smem + ((kt + 1) & 1) * STG, (kt + 1) * 64);
#define KSTEP(OFF) do { \
                const bf16x8 a0 = *(const bf16x8*)(cur + arow + (OFF)); \
                const bf16x8 a1 = *(const bf16x8*)(cur + arow + 32 * 128 + (OFF)); \
                const bf16x8 b0 = *(const bf16x8*)(cur + brow + (OFF)); \
                const bf16x8 b1 = *(const bf16x8*)(cur + brow + 32 * 128 + (OFF)); \
                acc[0][0] = MFMA32(a0, b0, acc[0][0]); acc[0][1] = MFMA32(a0, b1, acc[0][1]); \
                acc[1][0] = MFMA32(a1, b0, acc[1][0]); acc[1][1] = MFMA32(a1, b1, acc[1][1]); } while (0)
            KSTEP(o0); KSTEP(o1); KSTEP(o2); KSTEP(o3);
#undef KSTEP
            __syncthreads();
        }
#undef GLDS_STAGE
    }
#else
    {
        const int srow = tid >> 3, sch = tid & 7;
        const bf16_t* ag[4]; const bf16_t* bg[4];
#pragma unroll
        for (int i = 0; i < 4; ++i) {
            const int lr = srow + 32 * i;
            const int grow = g.lrows ? g.lrows[lr] : (m0 + lr);
            ag[i] = g.A + (size_t)grow * g.lda + sch * 8;
            bg[i] = g.Bt + (size_t)(n0 + lr) * g.ldb + sch * 8;
        }
        const int soff = srow * LDS_ROW + sch * 16;
        uint4 ra0, ra1, ra2, ra3, rb0, rb1, rb2, rb3;
#define G_LOAD(KO) do { ra0 = *(const uint4*)(ag[0] + (KO)); ra1 = *(const uint4*)(ag[1] + (KO)); ra2 = *(const uint4*)(ag[2] + (KO)); ra3 = *(const uint4*)(ag[3] + (KO)); \
                        rb0 = *(const uint4*)(bg[0] + (KO)); rb1 = *(const uint4*)(bg[1] + (KO)); rb2 = *(const uint4*)(bg[2] + (KO)); rb3 = *(const uint4*)(bg[3] + (KO)); } while (0)
#define L_STORE(BUF) do { unsigned char* _d = (BUF) + soff; \
        *(uint4*)(_d) = ra0; *(uint4*)(_d + 32 * LDS_ROW) = ra1; *(uint4*)(_d + 64 * LDS_ROW) = ra2; *(uint4*)(_d + 96 * LDS_ROW) = ra3; \
        *(uint4*)(_d + TILE_BYTES) = rb0; *(uint4*)(_d + TILE_BYTES + 32 * LDS_ROW) = rb1; *(uint4*)(_d + TILE_BYTES + 64 * LDS_ROW) = rb2; *(uint4*)(_d + TILE_BYTES + 96 * LDS_ROW) = rb3; } while (0)
        G_LOAD(0);
        __syncthreads();
        L_STORE(smem);
        __syncthreads();
        const int aoff = (wr * 64 + r) * LDS_ROW + h * 16;
        const int boff = TILE_BYTES + (wc * 64 + r) * LDS_ROW + h * 16;
        for (int kt = 0; kt < nk; ++kt) {
            const unsigned char* cur = smem + (kt & 1) * 2 * TILE_BYTES;
            unsigned char* nxt = smem + ((kt + 1) & 1) * 2 * TILE_BYTES;
            const bool more = (kt + 1 < nk);
            if (more) G_LOAD((kt + 1) * 64);
#pragma unroll
            for (int ks = 0; ks < 4; ++ks) {
                const bf16x8 a0 = *(const bf16x8*)(cur + aoff + ks * 32);
                const bf16x8 a1 = *(const bf16x8*)(cur + aoff + 32 * LDS_ROW + ks * 32);
                const bf16x8 b0 = *(const bf16x8*)(cur + boff + ks * 32);
                const bf16x8 b1 = *(const bf16x8*)(cur + boff + 32 * LDS_ROW + ks * 32);
                acc[0][0] = MFMA32(a0, b0, acc[0][0]); acc[0][1] = MFMA32(a0, b1, acc[0][1]);
                acc[1][0] = MFMA32(a1, b0, acc[1][0]); acc[1][1] = MFMA32(a1, b1, acc[1][1]);
            }
            if (more) L_STORE(nxt);
            __syncthreads();
        }
#undef G_LOAD
#undef L_STORE
    }
#endif
    float* Cs = (float*)smem;
#if GEMM_DIRECT
    __syncthreads();
#endif
#pragma unroll
    for (int i = 0; i < 2; ++i)
#pragma unroll
        for (int j = 0; j < 2; ++j)
#pragma unroll
            for (int e = 0; e < 16; ++e) Cs[(wr * 64 + i * 32 + crow(e, h)) * CS_LD + wc * 64 + j * 32 + r] = acc[i][j][e];
    __syncthreads();
    epi(Cs, m0, n0, tid);
}

DI int vbid(int bid, int nb) { return (nb % 8 == 0) ? (bid % 8) * (nb / 8) + bid / 8 : bid; }

DI int colmap_in(int n) {
    if (n < 384) return n;
    if (n < 896) return 416 + (n - 384);
    if (n < 1920) return 928 + (n - 896);
    if (n < 1952) return 384 + (n - 1920);
    if (n < 1960) return n;
    return -1;
}
template <int KIND>
DI void tconv_tile(const float* src, const float* src2, int ldsrc, bf16_t* dst, int K, int k0, int n0, const float* scale, int scale_from, unsigned char* smem) {
    float* tile = (float*)smem;
    const int t = tidx();
    __syncthreads();
#pragma unroll 4
    for (int i = 0; i < 16; ++i) {
        const int k = i * 4 + (t >> 6), n = t & 63;
        const int nd = n0 + n;
        float v = 0.f;
        if (KIND == 1) { const int c = colmap_in(nd); if (c >= 0) v = src[(size_t)(k0 + k) * ldsrc + c]; }
        else if (KIND == 2) {
            const int j = nd >> 7, wc = (nd >> 6) & 1, isup = (nd >> 5) & 1, ii = nd & 31;
            const int c = 64 * j + 32 * wc + ii;
            v = (isup ? src2 : src)[(size_t)(k0 + k) * ldsrc + c];
        } else v = src[(size_t)(k0 + k) * ldsrc + nd];
        if (scale && (k0 + k) >= scale_from) v *= scale[k0 + k - scale_from];
        tile[k * 65 + n] = v;
    }
    __syncthreads();
#pragma unroll 4
    for (int i = 0; i < 16; ++i) {
        const int n = i * 4 + (t >> 6), k = t & 63;
        dst[(size_t)(n0 + n) * K + k0 + k] = f2bf(tile[k * 65 + n]);
    }
}

DI void phase_prep(const P& p, int bid, int nb, unsigned char* smem) {
    unsigned char* ws = p.ws;
    const int tid = tidx();
    constexpr int J0 = 512, J1 = J0 + 48, J2 = J1 + 32, J3 = J2 + 256, J4 = J3 + 256, J5 = J4 + 256, J6 = J5 + 256, J7 = J6 + 256, J8 = J7 + 4096, J9 = J8 + 2048;
    for (int t = bid; t < J9; t += nb) {
        if (t < J0) { const int kt = t >> 5, ntl = t & 31; tconv_tile<1>(p.in[2], nullptr, 1960, (bf16_t*)(ws + W_IN), 1024, kt * 64, ntl * 64, nullptr, 0, smem); }
        else if (t < J1) { const int u = t - J0, kt = u / 12, ntl = u % 12; tconv_tile<0>(p.in[4], nullptr, 768, (bf16_t*)(ws + W_QUP), 256, kt * 64, ntl * 64, p.in[3], 0, smem); }
        else if (t < J2) { const int u = t - J1, kt = u >> 4, ntl = u & 15; tconv_tile<0>(p.in[6], nullptr, 1024, (bf16_t*)(ws + W_KVUP), 128, kt * 64, ntl * 64, p.in[5], 0, smem); }
        else if (t < J3) { const int u = t - J2, kt = u >> 4, ntl = u & 15; tconv_tile<0>(p.in[13], nullptr, 1024, (bf16_t*)(ws + W_OUT), 1024, kt * 64, ntl * 64, p.in[12], 512, smem); }
        else if (t < J4) { const int u = t - J3, kt = u >> 4, ntl = u & 15; tconv_tile<0>(p.in[16], nullptr, 1024, (bf16_t*)(ws + W_XQ), 1024, kt * 64, ntl * 64, nullptr, 0, smem); }
        else if (t < J5) { const int u = t - J4, kt = u >> 4, ntl = u & 15; tconv_tile<0>(p.in[17], nullptr, 1024, (bf16_t*)(ws + W_XKV), 1024, kt * 64, ntl * 64, nullptr, 0, smem); }
        else if (t < J6) { const int u = t - J5, kt = u >> 4, ntl = u & 15; tconv_tile<0>(p.in[18], nullptr, 1024, (bf16_t*)(ws + W_XKV) + (size_t)1024 * 1024, 1024, kt * 64, ntl * 64, nullptr, 0, smem); }
        else if (t < J7) { const int u = t - J6, kt = u >> 4, ntl = u & 15; tconv_tile<0>(p.in[19], nullptr, 1024, (bf16_t*)(ws + W_XO), 1024, kt * 64, ntl * 64, nullptr, 0, smem); }
        else if (t < J8) { const int u = t - J7, e = u >> 7, v = u & 127, kt = v >> 3, ntl = v & 7;
            tconv_tile<2>(p.in[26] + (size_t)e * 1024 * 256, p.in[27] + (size_t)e * 1024 * 256, 256, (bf16_t*)(ws + W_GU) + (size_t)e * 512 * 1024, 1024, kt * 64, ntl * 64, nullptr, 0, smem); }
        else { const int u = t - J8, e = u >> 6, v = u & 63, kt = v >> 4, ntl = v & 15;
            tconv_tile<0>(p.in[28] + (size_t)e * 256 * 1024, nullptr, 1024, (bf16_t*)(ws + W_DN) + (size_t)e * 1024 * 256, 256, kt * 64, ntl * 64, nullptr, 0, smem); }
    }
    {
        const size_t gsz = (size_t)nb * 256, g0 = (size_t)bid * 256 + tid;
        bf16_t* xb = (bf16_t*)(ws + XB);
        const float4* x4 = (const float4*)p.in[0];
        for (size_t i = g0; i < (size_t)T * D / 4; i += gsz) { const float4 v = x4[i]; uint2 o; o.x = pack2(v.x, v.y); o.y = pack2(v.z, v.w); ((uint2*)xb)[i] = o; }
        bf16_t* mb = (bf16_t*)(ws + MEMB);
        const float4* m4 = (const float4*)p.in[1];
        for (size_t i = g0; i < (size_t)Bn * NMEM * D / 4; i += gsz) { const float4 v = m4[i]; uint2 o; o.x = pack2(v.x, v.y); o.y = pack2(v.z, v.w); ((uint2*)mb)[i] = o; }
        float* wrt = (float*)(ws + W_RT);
        for (size_t i = g0; i < 48 * 1024; i += gsz) {
            const int j = (int)(i >> 10), k = (int)(i & 1023);
            float v = 0.f;
            if (j < 4) v = p.in[22][k * 4 + j]; else if (j < 36) v = p.in[24][k * 32 + (j - 4)];
            wrt[i] = v;
        }
        float* rc = (float*)(ws + ROPE_C); float* rs = (float*)(ws + ROPE_S);
        for (size_t i = g0; i < 2048 * 16; i += gsz) {
            const int pos = (int)(i >> 4), f = (int)(i & 15);
            const float inv = powf(10000.f, -(float)f / 16.f);
            const float ang = (float)pos * inv;
            const double a = (double)ang;
            const double k2 = rint(a * 0.15915494309189535);
            const float rr = (float)(a - k2 * 6.283185307179586);
            rc[i] = cosf(rr); rs[i] = sinf(rr);
        }
    }
}

struct EpiProj {
    bf16_t *cq, *ckv, *z, *xbc, *krope; float* dt; const float *rc, *rs, *dtb;
    DI void operator()(const float* Cs, int m0, int n0, int tid) const {
        const int c4 = (tid & 31) * 4, r0 = tid >> 5;
        if (n0 < 1920) {
            bf16_t* dst; int ld, cofs;
            if (n0 < 256) { dst = cq; ld = 256; cofs = n0; } else if (n0 < 384) { dst = ckv; ld = 128; cofs = n0 - 256; }
            else if (n0 < 896) { dst = z; ld = 512; cofs = n0 - 384; } else { dst = xbc; ld = 1024; cofs = n0 - 896; }
#pragma unroll 4
            for (int ps = 0; ps < 16; ++ps) { const int row = ps * 8 + r0; *(uint2*)(dst + (size_t)(m0 + row) * ld + cofs + c4) = pack4(cs4(Cs, row, c4)); }
        } else {
#pragma unroll
            for (int ps = 0; ps < 4; ++ps) {
                const int it = ps * 256 + tid, row = it >> 3, cc = (it & 7) * 4, grow = m0 + row;
                const float4 v = cs4(Cs, row, cc), pv = cs4(Cs, row, cc ^ 16);
                const int pos = grow & 2047, f = cc & 15;
                const float4 c = *(const float4*)(rc + pos * 16 + f), s = *(const float4*)(rs + pos * 16 + f);
                float4 o;
                if (cc < 16) { o.x = v.x * c.x - pv.x * s.x; o.y = v.y * c.y - pv.y * s.y; o.z = v.z * c.z - pv.z * s.z; o.w = v.w * c.w - pv.w * s.w; }
                else { o.x = v.x * c.x + pv.x * s.x; o.y = v.y * c.y + pv.y * s.y; o.z = v.z * c.z + pv.z * s.z; o.w = v.w * c.w + pv.w * s.w; }
                *(uint2*)(krope + (size_t)grow * 32 + cc) = pack4(o);
            }
#pragma unroll
            for (int ps = 0; ps < 4; ++ps) {
                const int it = ps * 256 + tid, row = it >> 3, cc = it & 7;
                dt[(size_t)(m0 + row) * 8 + cc] = softplusf(Cs[row * CS_LD + 32 + cc] + dtb[cc]);
            }
        }
    }
};
struct EpiMemKV {
    bf16_t *kx, *vxt;
    DI void operator()(const float* Cs, int m0, int n0, int tid) const {
        const int b = m0 >> 8, mm0 = m0 & 255;
        if (n0 < 1024) {
            const int c4 = (tid & 31) * 4, r0 = tid >> 5, hd = n0 >> 8, d = (n0 & 255) + c4;
#pragma unroll 4
            for (int ps = 0; ps < 16; ++ps) { const int row = ps * 8 + r0; *(uint2*)(kx + ((size_t)(b * 4 + hd) * 256 + mm0 + row) * 256 + d) = pack4(cs4(Cs, row, c4)); }
        } else {
            const int c2 = n0 - 1024, hd = c2 >> 8;
#pragma unroll 2
            for (int ps = 0; ps < 8; ++ps) {
                const int it = ps * 256 + tid, col = it & 127, rg = it >> 7, d = (c2 & 255) + col;
                uint4 w;
                w.x = pack2(Cs[(rg * 8 + 0) * CS_LD + col], Cs[(rg * 8 + 1) * CS_LD + col]); w.y = pack2(Cs[(rg * 8 + 2) * CS_LD + col], Cs[(rg * 8 + 3) * CS_LD + col]);
                w.z = pack2(Cs[(rg * 8 + 4) * CS_LD + col], Cs[(rg * 8 + 5) * CS_LD + col]); w.w = pack2(Cs[(rg * 8 + 6) * CS_LD + col], Cs[(rg * 8 + 7) * CS_LD + col]);
                *(uint4*)(vxt + ((size_t)(b * 4 + hd) * 256 + d) * 256 + mm0 + rg * 8) = w;
            }
        }
    }
};
DI void phase_proj(const P& p, int bid, int nb, unsigned char* smem, int rep = 0) {
    unsigned char* ws = p.ws;
    const int v = vbid(bid, nb);
    const bf16_t* xb = (const bf16_t*)(ws + XB);
    EpiProj e1{(bf16_t*)(ws + CQ), (bf16_t*)(ws + CKV), (bf16_t*)(ws + ZB), (bf16_t*)(ws + XBC), (bf16_t*)(ws + KROPE), (float*)(ws + DTB),
               (const float*)(ws + ROPE_C), (const float*)(ws + ROPE_S), p.in[9]};
    EpiMemKV e2{(bf16_t*)(ws + KX), (bf16_t*)(ws + VXT)};
    constexpr int NT1 = 256 * 16, NT2 = 32 * 16;
    for (int t = v; t < NT1 + NT2; t += nb) {
        if (rep && REP_MODE == 1 && t >= NT1) continue;
        if (rep && REP_MODE == 2 && t < NT1) continue;
        if (rep && REP_MODE == 3 && !(t < NT1 && (t & 7) == 7 && ((t >> 6) & 1))) continue;
        if (rep && REP_MODE == 4 && !(t < NT1 && ((t >> 6) & 1) == 0)) continue;
        const int u = t < NT1 ? t : t - NT1, c = u >> 6, j = u & 63, mt = (c >> 1) * 8 + (j >> 3), ntl = (c & 1) * 8 + (j & 7);
        if (t < NT1) { GemmArgs g{xb, 1024, (const bf16_t*)(ws + W_IN), 1024, 1024, nullptr}; gemm_tile(g, mt * 128, ntl * 128, e1, smem); }
        else { GemmArgs g{(const bf16_t*)(ws + MEMB), 1024, (const bf16_t*)(ws + W_XKV), 1024, 1024, nullptr}; gemm_tile(g, mt * 128, ntl * 128, e2, smem); }
    }
}

struct EpiQup {
    bf16_t* q; const float *rc, *rs; const float* rms;
    DI void operator()(const float* Cs, int m0, int n0, int tid) const {
        const int c4 = (tid & 31) * 4, r0 = tid >> 5;
        const int col = n0 + c4, head = col / 96, d = col - head * 96;
        const bool rope = d >= 64;
        const int b = m0 >> 11, s0 = m0 & 2047;
#pragma unroll 4
        for (int ps = 0; ps < 16; ++ps) {
            const int row = ps * 8 + r0;
            const float sc = rms[row] * QSCALE;
            float4 v = cs4(Cs, row, c4);
            if (rope) {
                const float4 pv = cs4(Cs, row, c4 ^ 16);
                const int pos = s0 + row, f = d & 15;
                const float4 c = *(const float4*)(rc + pos * 16 + f), s = *(const float4*)(rs + pos * 16 + f);
                if (d < 80) { v.x = v.x * c.x - pv.x * s.x; v.y = v.y * c.y - pv.y * s.y; v.z = v.z * c.z - pv.z * s.z; v.w = v.w * c.w - pv.w * s.w; }
                else { v.x = v.x * c.x + pv.x * s.x; v.y = v.y * c.y + pv.y * s.y; v.z = v.z * c.z + pv.z * s.z; v.w = v.w * c.w + pv.w * s.w; }
            }
            v.x *= sc; v.y *= sc; v.z *= sc; v.w *= sc;
            *(uint2*)(q + ((size_t)(b * 8 + head) * 2048 + s0 + row) * 96 + d) = pack4(v);
        }
    }
};
struct EpiKVup {
    bf16_t *kn, *vt; const float* rms;
    DI void operator()(const float* Cs, int m0, int n0, int tid) const {
        const int head = n0 >> 7, b = m0 >> 11, s0 = m0 & 2047;
#pragma unroll 4
        for (int ps = 0; ps < 8; ++ps) {
            const int it = ps * 256 + tid, row = it >> 4, c4 = (it & 15) * 4;
            const float sc = rms[row];
            float4 v = cs4(Cs, row, c4); v.x *= sc; v.y *= sc; v.z *= sc; v.w *= sc;
            *(uint2*)(kn + ((size_t)(b * 8 + head) * 2048 + s0 + row) * 64 + c4) = pack4(v);
        }
#pragma unroll 2
        for (int ps = 0; ps < 4; ++ps) {
            const int it = ps * 256 + tid, dv = it & 63, rg = it >> 6;
            const float* cp = Cs + (rg * 8) * CS_LD + 64 + dv; const float* rp = rms + rg * 8;
            uint4 w;
            w.x = pack2(cp[0] * rp[0], cp[CS_LD] * rp[1]); w.y = pack2(cp[2 * CS_LD] * rp[2], cp[3 * CS_LD] * rp[3]);
            w.z = pack2(cp[4 * CS_LD] * rp[4], cp[5 * CS_LD] * rp[5]); w.w = pack2(cp[6 * CS_LD] * rp[6], cp[7 * CS_LD] * rp[7]);
            *(uint4*)(vt + ((size_t)(b * 8 + head) * 64 + dv) * 2048 + s0 + rg * 8) = w;
        }
    }
};
template <int K>
DI void row_rms(const bf16_t* src, int m0, float* rms) {
    const int t = tidx(), row = t >> 1, half = t & 1;
    const uint4* s4 = (const uint4*)(src + (size_t)(m0 + row) * K + half * (K / 2));
    float ss = 0.f;
#pragma unroll
    for (int i = 0; i < K / 16; ++i) {
        const uint4 w = s4[i];
        const unsigned ww[4] = {w.x, w.y, w.z, w.w};
#pragma unroll
        for (int k = 0; k < 4; ++k) { const float a = bflo(ww[k]), b = bfhi(ww[k]); ss += a * a + b * b; }
    }
    ss += __shfl_xor(ss, 1);
    __syncthreads();
    if (half == 0) rms[row] = rsqrtf(ss * (1.f / K) + EPS);
    __syncthreads();
}
DI void phase_up(const P& p, int bid, int nb, unsigned char* smem) {
    unsigned char* ws = p.ws;
    const int v = vbid(bid, nb);
    float* rms = (float*)(smem + GEMM_LDS);
    constexpr int NTQ = 256 * 6, NTKV = 256 * 8;
    for (int t = v; t < NTQ + NTKV; t += nb) {
        if (t < NTQ) {
            const int mt = t / 6, ntl = t % 6;
            row_rms<256>((const bf16_t*)(ws + CQ), mt * 128, rms);
            EpiQup e{(bf16_t*)(ws + QB), (const float*)(ws + ROPE_C), (const float*)(ws + ROPE_S), rms};
            GemmArgs g{(const bf16_t*)(ws + CQ), 256, (const bf16_t*)(ws + W_QUP), 256, 256, nullptr};
            gemm_tile(g, mt * 128, ntl * 128, e, smem);
        } else {
            const int u = t - NTQ, mt = u >> 3, ntl = u & 7;
            row_rms<128>((const bf16_t*)(ws + CKV), mt * 128, rms);
            EpiKVup e{(bf16_t*)(ws + KNB), (bf16_t*)(ws + VTB), rms};
            GemmArgs g{(const bf16_t*)(ws + CKV), 128, (const bf16_t*)(ws + W_KVUP), 128, 128, nullptr};
            gemm_tile(g, mt * 128, ntl * 128, e, smem);
        }
    }
    {
        const bf16_t* xbc = (const bf16_t*)(ws + XBC); bf16_t* xa = (bf16_t*)(ws + XBCA);
        const float* cw = p.in[7]; const float* cb = p.in[8];
        const size_t gsz = (size_t)nb * 256;
        for (size_t i = (size_t)bid * 256 + tidx(); i < (size_t)T * 128; i += gsz) {
            const int tkn = (int)(i >> 7), c0 = (int)(i & 127) * 8, s_ = tkn & 2047;
            float accv[8];
#pragma unroll
            for (int k = 0; k < 8; ++k) accv[k] = cb[c0 + k];
#pragma unroll
            for (int j = 0; j < 4; ++j) {
                if (s_ + j - 3 >= 0) {
                    const uint4 w = *(const uint4*)(xbc + (size_t)(tkn + j - 3) * 1024 + c0);
                    const unsigned ww[4] = {w.x, w.y, w.z, w.w};
#pragma unroll
                    for (int k = 0; k < 4; ++k) {
                        accv[2 * k] += cw[j * 1024 + c0 + 2 * k] * bflo(ww[k]);
                        accv[2 * k + 1] += cw[j * 1024 + c0 + 2 * k + 1] * bfhi(ww[k]);
                    }
                }
            }
            uint4 o;
            o.x = pack2(siluf(accv[0]), siluf(accv[1])); o.y = pack2(siluf(accv[2]), siluf(accv[3]));
            o.z = pack2(siluf(accv[4]), siluf(accv[5])); o.w = pack2(siluf(accv[6]), siluf(accv[7]));
            *(uint4*)(xa + (size_t)tkn * 1024 + c0) = o;
        }
    }
}

DI int perm16(int k) { return (k & ~12) | ((k & 4) << 1) | ((k & 8) >> 1); }
template <int DQK, int DVW, int KT, int NQG, int NDV>
struct FlashCfg {
    static constexpr int KSTR = (DQK + 8) * 2;
    static constexpr int VSTR = (KT + 8) * 2;
    static constexpr int DV = DVW * NDV;
    static constexpr int KBYTES = KT * KSTR, VBYTES = DV * VSTR, STAGE = KBYTES + VBYTES;
    static constexpr int KCH = KT * DQK / 8 / 256;
    static constexpr int VCH = DV * KT / 8 / 256;
    static_assert(KT * DQK / 8 % 256 == 0 && DV * KT / 8 % 256 == 0, "chunk split");
    static_assert(2 * STAGE <= GEMM_LDS + 2048 - 16, "flash LDS");
};
template <int DQK, int DVW, int KT, int NQG, int NDV, class Src>
DI void flash_item(const Src& src, int ntiles, int nskip  , unsigned char* smem) {
    typedef FlashCfg<DQK, DVW, KT, NQG, NDV> C;
    constexpr int NKS = DQK / 16, NKB = KT / 32, NDB = DVW / 32;
    int tid = tidx(); asm volatile("" : "+v"(tid));
    const int lane = tid & 63, wave = __builtin_amdgcn_readfirstlane(tid >> 6), r = lane & 31, h = lane >> 5;
    const int qg = wave / NDV, dvh = wave % NDV;
    bf16x8 qf[NKS];
    {
        const bf16_t* qp = src.qrow(qg * 32 + r) + 8 * h;
#pragma unroll
        for (int ks = 0; ks < NKS; ++ks) qf[ks] = *(const bf16x8*)(qp + 16 * ks);
    }
    f32x16 o[NDB];
#pragma unroll
    for (int d = 0; d < NDB; ++d)
#pragma unroll
        for (int e = 0; e < 16; ++e) o[d][e] = 0.f;
    float m = -1e30f, l = 0.f;
    uint4 kr[C::KCH], vr[C::VCH];
    auto gload = [&](int t) {
#pragma unroll
        for (int i = 0; i < C::KCH; ++i) { const int idx = tid + 256 * i; kr[i] = src.kload(t, idx / (DQK / 8), idx % (DQK / 8)); }
#pragma unroll
        for (int i = 0; i < C::VCH; ++i) { const int idx = tid + 256 * i; vr[i] = src.vload(t, idx / (KT / 8), idx % (KT / 8)); }
    };
    auto lstore = [&](unsigned char* buf) {
#pragma unroll
        for (int i = 0; i < C::KCH; ++i) { const int idx = tid + 256 * i; *(uint4*)(buf + (idx / (DQK / 8)) * C::KSTR + (idx % (DQK / 8)) * 16) = kr[i]; }
#pragma unroll
        for (int i = 0; i < C::VCH; ++i) {
            const int idx = tid + 256 * i, dv = idx / (KT / 8), c = idx % (KT / 8);
            unsigned char* row = buf + C::KBYTES + dv * C::VSTR + (c >> 1) * 32;
            const int a = c & 1;
            *(uint2*)(row + (4 * a) * 2) = make_uint2(vr[i].x, vr[i].y);
            *(uint2*)(row + (8 + 4 * a) * 2) = make_uint2(vr[i].z, vr[i].w);
        }
    };
    gload(0);
    __syncthreads();
    lstore(smem);
    __syncthreads();
    for (int t = 0; t < ntiles; ++t) {
        const unsigned char* cur = smem + (t & 1) * C::STAGE;
        const bool more = (t + 1 < ntiles);
        if (more) gload(t + 1);
        if (!(t == ntiles - 1 && qg < nskip)) {
            f32x16 s[NKB];
#pragma unroll
            for (int kb = 0; kb < NKB; ++kb) {
#pragma unroll
                for (int e = 0; e < 16; ++e) s[kb][e] = 0.f;
                const unsigned char* kp = cur + (kb * 32 + r) * C::KSTR + h * 16;
#pragma unroll
                for (int ks = 0; ks < NKS; ++ks) s[kb] = MFMA32(*(const bf16x8*)(kp + ks * 32), qf[ks], s[kb]);
            }
            float mx = s[0][0];
#pragma unroll
            for (int kb = 0; kb < NKB; ++kb)
#pragma unroll
                for (int e = 0; e < 16; ++e) mx = fmaxf(mx, s[kb][e]);
            mx = fmaxf(mx, __shfl_xor(mx, 32));
            const float mn = fmaxf(m, mx);
            const float alpha = __builtin_amdgcn_exp2f(m - mn);
            m = mn;
            float ps = 0.f;
#pragma unroll
            for (int kb = 0; kb < NKB; ++kb)
#pragma unroll
                for (int e = 0; e < 16; ++e) { const float pv = __builtin_amdgcn_exp2f(s[kb][e] - mn); s[kb][e] = pv; ps += pv; }
            l = l * alpha + ps;
#pragma unroll
            for (int d = 0; d < NDB; ++d)
#pragma unroll
                for (int e = 0; e < 16; ++e) o[d][e] *= alpha;
#pragma unroll
            for (int kb = 0; kb < NKB; ++kb)
#pragma unroll
                for (int s2 = 0; s2 < 2; ++s2) {
                    uint4 pk;
                    pk.x = pack2(s[kb][8 * s2], s[kb][8 * s2 + 1]); pk.y = pack2(s[kb][8 * s2 + 2], s[kb][8 * s2 + 3]);
                    pk.z = pack2(s[kb][8 * s2 + 4], s[kb][8 * s2 + 5]); pk.w = pack2(s[kb][8 * s2 + 6], s[kb][8 * s2 + 7]);
                    const bf16x8 pf = __builtin_bit_cast(bf16x8, pk);
                    const unsigned char* vp = cur + C::KBYTES + (dvh * DVW + r) * C::VSTR + (kb * 32 + s2 * 16 + 8 * h) * 2;
#pragma unroll
                    for (int d = 0; d < NDB; ++d) o[d] = MFMA32(*(const bf16x8*)(vp + d * 32 * C::VSTR), pf, o[d]);
                }
        }
        if (more) lstore(smem + ((t + 1) & 1) * C::STAGE);
        __syncthreads();
    }
    l += __shfl_xor(l, 32);
    const float il = 1.f / l;
#pragma unroll
    for (int d = 0; d < NDB; ++d)
#pragma unroll
        for (int g4 = 0; g4 < 4; ++g4) {
            uint2 w; w.x = pack2(o[d][4 * g4] * il, o[d][4 * g4 + 1] * il); w.y = pack2(o[d][4 * g4 + 2] * il, o[d][4 * g4 + 3] * il);
            src.store(qg * 32 + r, dvh * DVW + d * 32 + 8 * g4 + 4 * h, w);
        }
}
struct SelfSrc {
    const bf16_t *q, *kn, *kr, *vt; bf16_t* mix; int b, hd, bh, q0;
    DI const bf16_t* qrow(int rr) const { return q + ((size_t)bh * 2048 + q0 + rr) * 96; }
    DI uint4 kload(int t, int key, int c) const {
        const int kg = t * 64 + key;
        return c < 8 ? *(const uint4*)(kn + ((size_t)bh * 2048 + kg) * 64 + c * 8) : *(const uint4*)(kr + ((size_t)b * 2048 + kg) * 32 + (c - 8) * 8);
    }
    DI uint4 vload(int t, int dv, int c) const { return *(const uint4*)(vt + ((size_t)bh * 64 + dv) * 2048 + t * 64 + c * 8); }
    DI void store(int rr, int dv, uint2 w) const { *(uint2*)(mix + ((size_t)b * 2048 + q0 + rr) * 1024 + hd * 64 + dv) = w; }
};
struct CrossSrc {
    const bf16_t *qx, *kx, *vxt; bf16_t* ox; int b, hd, q0;
    DI const bf16_t* qrow(int rr) const { return qx + ((size_t)(b * 4 + hd) * 2048 + q0 + rr) * 256; }
    DI uint4 kload(int t, int key, int c) const { return *(const uint4*)(kx + ((size_t)(b * 4 + hd) * 256 + t * 32 + key) * 256 + c * 8); }
    DI uint4 vload(int t, int dv, int c) const { return *(const uint4*)(vxt + ((size_t)(b * 4 + hd) * 256 + dv) * 256 + t * 32 + c * 8); }
    DI void store(int rr, int dv, uint2 w) const { *(uint2*)(ox + ((size_t)b * 2048 + q0 + rr) * 1024 + hd * 256 + dv) = w; }
};
DI void attn_fast(const P& p, int bid, int nb, unsigned char* smem) {
    unsigned char* ws = p.ws;
    const int nround = (2048 + nb - 1) / nb;
    for (int rd = 0; rd < nround; ++rd) {
        const int idx = rd * nb + ((rd & 1) ? (nb - 1 - bid) : bid);
        if (idx >= 2048) continue;
        const int qb = 15 - (idx >> 7), bh = idx & 127;
        SelfSrc s{(const bf16_t*)(ws + QB), (const bf16_t*)(ws + KNB), (const bf16_t*)(ws + KROPE), (const bf16_t*)(ws + VTB), (bf16_t*)(ws + MIX), bh >> 3, bh & 7, bh, qb * 128};
        flash_item<96, 64, 64, 4, 1>(s, 2 * qb + 2, 2, smem);
    }
}
DI void xattn_fast(const P& p, int bid, int nb, unsigned char* smem) {
    unsigned char* ws = p.ws;
    for (int it = bid; it < 2048; it += nb) {
        const int bhd = it >> 5, qt = it & 31;
        CrossSrc s{(const bf16_t*)(ws + QX), (const bf16_t*)(ws + KX), (const bf16_t*)(ws + VXT), (bf16_t*)(ws + OX), bhd >> 2, bhd & 3, qt * 64};
        flash_item<256, 128, 32, 2, 2>(s, 8, 0, smem);
    }
}

constexpr int SSD_XT = 0, SSD_BM = 8192, SSD_CM = SSD_BM + 16384, SSD_BWT = SSD_CM + 16384, SSD_PS = SSD_BWT + 16384, SSD_F = SSD_PS + 16384;
static_assert(SSD_F + 1024 <= GEMM_LDS + 2048 - 16, "ssd LDS");
DI int off256(int row, int el) { return row * 256 + (((el >> 3) ^ (row & 15)) << 4) + ((el & 7) << 1); }
DI int off128(int row, int el) { return row * 128 + (((el >> 3) ^ ((row >> 1) & 7)) << 4) + ((el & 7) << 1); }
DI void ssd_item(const P& p, int bh, unsigned char* smem) {
    unsigned char* ws = p.ws;
    const bf16_t* xa = (const bf16_t*)(ws + XBCA); const float* dtg = (const float*)(ws + DTB);
    bf16_t* mix = (bf16_t*)(ws + MIX);
    int tid0 = tidx(); asm volatile("" : "+v"(tid0));
    const int wave = __builtin_amdgcn_readfirstlane(tid0 >> 6);
    const int b = bh >> 3, hd = bh & 7, g = hd >> 2;
    const int lb = wave >> 1, pb = wave & 1;
    const float a_h = -__expf(p.in[10][hd]), Dh = p.in[11][hd];
    float* F = (float*)(smem + SSD_F);
    __syncthreads();
    for (int i = tid0; i < 16384 / 16; i += 256) *(uint4*)(smem + SSD_PS + i * 16) = make_uint4(0u, 0u, 0u, 0u);
    f32x16 st[2];
#pragma unroll
    for (int i = 0; i < 2; ++i)
#pragma unroll
        for (int e = 0; e < 16; ++e) st[i][e] = 0.f;
    uint4 xr0, xr1, br0, br1, br2, br3, cr0, cr1, cr2, cr3; float dtr = 0.f;
#define SSD_XLD(i) (*(const uint4*)(xa + (t0_ + ((tid + 256 * (i)) >> 3)) * 1024 + hd * 64 + ((tid + 256 * (i)) & 7) * 8))
#define SSD_BLD(i, o) (*(const uint4*)(xa + (t0_ + ((tid + 256 * (i)) >> 4)) * 1024 + (o) + g * 128 + ((tid + 256 * (i)) & 15) * 8))
#define SSD_GLOAD(c_) do { const size_t t0_ = (size_t)b * 2048 + (c_) * 64; xr0 = SSD_XLD(0); xr1 = SSD_XLD(1); \
        br0 = SSD_BLD(0, 512); br1 = SSD_BLD(1, 512); br2 = SSD_BLD(2, 512); br3 = SSD_BLD(3, 512); \
        cr0 = SSD_BLD(0, 768); cr1 = SSD_BLD(1, 768); cr2 = SSD_BLD(2, 768); cr3 = SSD_BLD(3, 768); \
        if (tid < 64) dtr = dtg[(t0_ + tid) * 8 + hd]; } while (0)
    { const int tid = tid0; SSD_GLOAD(0); }
    for (int c = 0; c < 32; ++c) {
        int tid = tid0; asm volatile("" : "+v"(tid));
        const int lane = tid & 63, r = lane & 31, h = lane >> 5;
        const size_t t0 = (size_t)b * 2048 + c * 64;
        if (wave == 0) {
            float v = dtr * a_h;
#pragma unroll
            for (int o = 1; o < 64; o <<= 1) { const float u = __shfl_up(v, o); if (lane >= o) v += u; }
            const float a63 = __shfl(v, 63);
            F[lane] = v; F[64 + lane] = __expf(v); F[128 + lane] = dtr; F[192 + lane] = __expf(a63 - v) * dtr;
        }
        __syncthreads();
#define SSD_XIMG(i, XR) do { const int idx = tid + 256 * (i), l = idx >> 3, p0 = (idx & 7) * 8, lp = perm16(l); \
            const unsigned ww[4] = {XR.x, XR.y, XR.z, XR.w}; \
            _Pragma("unroll") for (int k = 0; k < 4; ++k) { \
                *(bf16_t*)(smem + SSD_XT + off128(p0 + 2 * k, lp)) = (bf16_t)(ww[k] & 0xffffu); \
                *(bf16_t*)(smem + SSD_XT + off128(p0 + 2 * k + 1, lp)) = (bf16_t)(ww[k] >> 16); } } while (0)
#define SSD_BIMG(i, BR, CR) do { const int idx = tid + 256 * (i), l = idx >> 4, n0 = (idx & 15) * 8, lp = perm16(l); \
            *(uint4*)(smem + SSD_BM + off256(l, n0)) = BR; *(uint4*)(smem + SSD_CM + off256(l, n0)) = CR; \
            const float wl = F[192 + l]; const unsigned ww[4] = {BR.x, BR.y, BR.z, BR.w}; \
            _Pragma("unroll") for (int k = 0; k < 4; ++k) { \
                *(bf16_t*)(smem + SSD_BWT + off128(n0 + 2 * k, lp)) = f2bf(bflo(ww[k]) * wl); \
                *(bf16_t*)(smem + SSD_BWT + off128(n0 + 2 * k + 1, lp)) = f2bf(bfhi(ww[k]) * wl); } } while (0)
        SSD_XIMG(0, xr0); SSD_XIMG(1, xr1);
        SSD_BIMG(0, br0, cr0); SSD_BIMG(1, br1, cr1); SSD_BIMG(2, br2, cr2); SSD_BIMG(3, br3, cr3);
        __syncthreads();
        if (c + 1 < 32) SSD_GLOAD(c + 1);
        f32x16 yd;
#pragma unroll
        for (int e = 0; e < 16; ++e) yd[e] = 0.f;
        const float acs_l = F[lb * 32 + r];
        const int lrow = lb * 32 + r;
        for (int sb = 0; sb <= lb; ++sb) {
            f32x16 cb;
#pragma unroll
            for (int e = 0; e < 16; ++e) cb[e] = 0.f;
#pragma unroll
            for (int ks = 0; ks < 8; ++ks) {
                const bf16x8 av = *(const bf16x8*)(smem + SSD_BM + off256(sb * 32 + r, 16 * ks + 8 * h));
                const bf16x8 bv = *(const bf16x8*)(smem + SSD_CM + off256(lb * 32 + r, 16 * ks + 8 * h));
                cb = MFMA32(av, bv, cb);
            }
            float mv[16];
#pragma unroll
            for (int q4 = 0; q4 < 4; ++q4) {
                const int s0 = sb * 32 + 8 * q4 + 4 * h;
                const float4 as4 = *(const float4*)(F + s0), dt4 = *(const float4*)(F + 128 + s0);
                const float asv[4] = {as4.x, as4.y, as4.z, as4.w}, dtv[4] = {dt4.x, dt4.y, dt4.z, dt4.w};
#pragma unroll
                for (int k = 0; k < 4; ++k) mv[4 * q4 + k] = (s0 + k <= lrow) ? cb[4 * q4 + k] * __expf(acs_l - asv[k]) * dtv[k] : 0.f;
            }
#pragma unroll
            for (int s2 = 0; s2 < 2; ++s2) {
                uint4 pk;
                pk.x = pack2(mv[8 * s2], mv[8 * s2 + 1]); pk.y = pack2(mv[8 * s2 + 2], mv[8 * s2 + 3]);
                pk.z = pack2(mv[8 * s2 + 4], mv[8 * s2 + 5]); pk.w = pack2(mv[8 * s2 + 6], mv[8 * s2 + 7]);
                const bf16x8 xb = *(const bf16x8*)(smem + SSD_XT + off128(pb * 32 + r, sb * 32 + 16 * s2 + 8 * h));
                yd = MFMA32(__builtin_bit_cast(bf16x8, pk), xb, yd);
            }
        }
        f32x16 yo;
#pragma unroll
        for (int e = 0; e < 16; ++e) yo[e] = 0.f;
#pragma unroll
        for (int ks = 0; ks < 8; ++ks) {
            const bf16x8 av = *(const bf16x8*)(smem + SSD_CM + off256(lb * 32 + r, 16 * ks + 8 * h));
            const bf16x8 bv = *(const bf16x8*)(smem + SSD_PS + off256(pb * 32 + r, 16 * ks + 8 * h));
            yo = MFMA32(av, bv, yo);
        }
        {
            const uint4 x0 = *(const uint4*)(smem + SSD_XT + off128(pb * 32 + r, lb * 32 + 8 * h));
            const uint4 x1 = *(const uint4*)(smem + SSD_XT + off128(pb * 32 + r, lb * 32 + 16 + 8 * h));
            const unsigned xw[8] = {x0.x, x0.y, x0.z, x0.w, x1.x, x1.y, x1.z, x1.w};
            bf16_t* op = mix + (t0 + lb * 32 + 4 * h) * 1024 + 512 + hd * 64 + pb * 32 + r;
#pragma unroll
            for (int q4 = 0; q4 < 4; ++q4) {
                const float4 ea4 = *(const float4*)(F + 64 + lb * 32 + 8 * q4 + 4 * h);
                const float eav[4] = {ea4.x, ea4.y, ea4.z, ea4.w};
#pragma unroll
                for (int k = 0; k < 4; ++k) {
                    const int e = 4 * q4 + k;
                    const float xv = (e & 1) ? bfhi(xw[e >> 1]) : bflo(xw[e >> 1]);
                    const float y = yd[e] + eav[k] * yo[e] + Dh * xv;
                    op[(size_t)(k + 8 * q4) * 1024] = f2bf(y);
                }
            }
        }
        {
            const float dec = F[64 + 63];
#pragma unroll
            for (int i = 0; i < 2; ++i) {
#pragma unroll
                for (int e = 0; e < 16; ++e) st[i][e] *= dec;
                const int nblk = 2 * (wave >> 1) + i;
#pragma unroll
                for (int ks = 0; ks < 4; ++ks) {
                    const bf16x8 av = *(const bf16x8*)(smem + SSD_XT + off128(pb * 32 + r, 16 * ks + 8 * h));
                    const bf16x8 bv = *(const bf16x8*)(smem + SSD_BWT + off128(nblk * 32 + r, 16 * ks + 8 * h));
                    st[i] = MFMA32(av, bv, st[i]);
                }
            }
        }
        __syncthreads();
#pragma unroll
        for (int i = 0; i < 2; ++i) {
            const int n = (2 * (wave >> 1) + i) * 32 + r;
#pragma unroll
            for (int e = 0; e < 16; ++e) *(bf16_t*)(smem + SSD_PS + off256(pb * 32 + crow(e, h), n)) = f2bf(st[i][e]);
        }
    }
    __syncthreads();
}

#if ATTN_NAIVE
DI void attn_naive(const P& p, int bid, int nb) {
    unsigned char* ws = p.ws;
    const bf16_t* Q = (const bf16_t*)(ws + QB); const bf16_t* Kn = (const bf16_t*)(ws + KNB); const bf16_t* Vt = (const bf16_t*)(ws + VTB);
    const bf16_t* Kr = (const bf16_t*)(ws + KROPE); bf16_t* mix = (bf16_t*)(ws + MIX);
    for (int item = bid; item < 128 * 8; item += nb) {
        const int bh = item >> 3, s_ = (item & 7) * 256 + tidx(), b = bh >> 3, hd = bh & 7;
        float q[96];
        {
            const uint4* q4 = (const uint4*)(Q + ((size_t)bh * 2048 + s_) * 96);
#pragma unroll
            for (int i = 0; i < 12; ++i) { const uint4 w = q4[i]; q[8 * i] = bflo(w.x); q[8 * i + 1] = bfhi(w.x); q[8 * i + 2] = bflo(w.y); q[8 * i + 3] = bfhi(w.y);
                q[8 * i + 4] = bflo(w.z); q[8 * i + 5] = bfhi(w.z); q[8 * i + 6] = bflo(w.w); q[8 * i + 7] = bfhi(w.w); }
        }
        float o[64];
#pragma unroll
        for (int d = 0; d < 64; ++d) o[d] = 0.f;
        float m = -1e30f, l = 0.f;
        const int nkeys = __builtin_amdgcn_readfirstlane(((s_ >> 6) + 1) * 64);
        for (int j0 = 0; j0 < nkeys; j0 += 8) {
            float sc[8];
#pragma unroll
            for (int jj = 0; jj < 8; ++jj) {
                const int j = j0 + jj;
                const uint4* k4 = (const uint4*)(Kn + ((size_t)bh * 2048 + j) * 64);
                const uint4* r4 = (const uint4*)(Kr + ((size_t)b * 2048 + j) * 32);
                float a = 0.f;
#pragma unroll
                for (int i = 0; i < 8; ++i) { const uint4 w = k4[i]; a += q[8 * i] * bflo(w.x) + q[8 * i + 1] * bfhi(w.x) + q[8 * i + 2] * bflo(w.y) + q[8 * i + 3] * bfhi(w.y)
                    + q[8 * i + 4] * bflo(w.z) + q[8 * i + 5] * bfhi(w.z) + q[8 * i + 6] * bflo(w.w) + q[8 * i + 7] * bfhi(w.w); }
#pragma unroll
                for (int i = 0; i < 4; ++i) { const uint4 w = r4[i]; const int o8 = 64 + 8 * i; a += q[o8] * bflo(w.x) + q[o8 + 1] * bfhi(w.x) + q[o8 + 2] * bflo(w.y) + q[o8 + 3] * bfhi(w.y)
                    + q[o8 + 4] * bflo(w.z) + q[o8 + 5] * bfhi(w.z) + q[o8 + 6] * bflo(w.w) + q[o8 + 7] * bfhi(w.w); }
                sc[jj] = a;
            }
            float mx = m;
#pragma unroll
            for (int jj = 0; jj < 8; ++jj) mx = fmaxf(mx, sc[jj]);
            const float al = exp2f(m - mx);
            float ps = 0.f;
#pragma unroll
            for (int jj = 0; jj < 8; ++jj) { sc[jj] = exp2f(sc[jj] - mx); ps += sc[jj]; }
            l = l * al + ps; m = mx;
#pragma unroll
            for (int d = 0; d < 64; ++d) {
                const uint4 w = *(const uint4*)(Vt + ((size_t)bh * 64 + d) * 2048 + j0);
                o[d] = o[d] * al + sc[0] * bflo(w.x) + sc[1] * bfhi(w.x) + sc[2] * bflo(w.y) + sc[3] * bfhi(w.y) + sc[4] * bflo(w.z) + sc[5] * bfhi(w.z) + sc[6] * bflo(w.w) + sc[7] * bfhi(w.w);
            }
        }
        const float il = 1.f / l;
        bf16_t* dst = mix + ((size_t)b * 2048 + s_) * 1024 + hd * 64;
#pragma unroll
        for (int d = 0; d < 64; d += 2) *(unsigned*)(dst + d) = pack2(o[d] * il, o[d + 1] * il);
    }
}
#endif
#if SSD_NAIVE
DI void ssd_naive(const P& p, int bid, int nb) {
    unsigned char* ws = p.ws;
    const bf16_t* xa = (const bf16_t*)(ws + XBCA); const float* dt = (const float*)(ws + DTB); const bf16_t* z = (const bf16_t*)(ws + ZB);
    bf16_t* mix = (bf16_t*)(ws + MIX);
    const int wave = tidx() >> 6, pp = tidx() & 63;
    for (int item = bid; item < 32; item += nb) {
        const int bh = item * 4 + wave, b = bh >> 3, hd = bh & 7, g = hd >> 2;
        const float a = -__expf(p.in[10][hd]), Dh = p.in[11][hd];
        float st[128];
#pragma unroll
        for (int n = 0; n < 128; ++n) st[n] = 0.f;
        for (int t = 0; t < 2048; ++t) {
            const size_t row = (size_t)b * 2048 + t;
            const float dtv = dt[row * 8 + hd];
            const float da = __expf(dtv * a);
            const float xv = bf2f(xa[row * 1024 + hd * 64 + pp]);
            const float xd = dtv * xv;
            const uint4* b4 = (const uint4*)(xa + row * 1024 + 512 + g * 128);
            const uint4* c4 = (const uint4*)(xa + row * 1024 + 768 + g * 128);
            float y = 0.f;
#pragma unroll
            for (int i = 0; i < 16; ++i) {
                const uint4 bw = b4[i], cw = c4[i];
                const unsigned bb[4] = {bw.x, bw.y, bw.z, bw.w}, cc[4] = {cw.x, cw.y, cw.z, cw.w};
#pragma unroll
                for (int k = 0; k < 4; ++k) {
                    const int n = 8 * i + 2 * k;
                    st[n] = da * st[n] + xd * bflo(bb[k]); y += bflo(cc[k]) * st[n];
                    st[n + 1] = da * st[n + 1] + xd * bfhi(bb[k]); y += bfhi(cc[k]) * st[n + 1];
                }
            }
            y += Dh * xv;
            const float zv = bf2f(z[row * 512 + hd * 64 + pp]);
            mix[row * 1024 + 512 + hd * 64 + pp] = f2bf(y * siluf(zv));
        }
    }
}
#endif
DI void phase_mixer(const P& p, int bid, int nb, unsigned char* smem, int rep = 0) {
#if SSD_NAIVE
    ssd_naive(p, bid, nb);
    attn_fast(p, bid, nb, smem);
#else
    unsigned* ctr = (unsigned*)(p.ws + CTL + CTL_CNT + 256) + 64 * rep;
    int* slot = (int*)(smem + GEMM_LDS + 2048 - 32);
    for (;;) {
        __syncthreads();
        if (tidx() == 0) *slot = (int)atomicAdd(ctr, 1u);
        __syncthreads();
        const int it = *slot;
        if (it >= 128 + 2048) break;
        if (it < 128) { if (!NO_SSD && !(rep && REP_MODE == 2)) ssd_item(p, it, smem); }
        else if (rep && REP_MODE == 1) {   }
        else {
            const int idx = it - 128, qb = 15 - (idx >> 7), bh = idx & 127;
            unsigned char* ws = p.ws;
            SelfSrc s{(const bf16_t*)(ws + QB), (const bf16_t*)(ws + KNB), (const bf16_t*)(ws + KROPE), (const bf16_t*)(ws + VTB), (bf16_t*)(ws + MIX), bh >> 3, bh & 7, bh, qb * 128};
            if (!NO_FLASH) flash_item<96, 64, 64, 4, 1>(s, 2 * qb + 2, 2, smem);
        }
    }
#endif
}

DI void phase_ssdnorm(const P& p, int bid, int nb, unsigned char* smem) {
    bf16_t* mix = (bf16_t*)(p.ws + MIX); const bf16_t* z = (const bf16_t*)(p.ws + ZB);
    const int lane = tidx() & 63, wave = tidx() >> 6;
    for (int tk = bid * 4 + wave; tk < T; tk += nb * 4) {
        uint4* ptr = (uint4*)(mix + (size_t)tk * 1024 + 512 + lane * 8);
        const uint4 w = *ptr, zz = *(const uint4*)(z + (size_t)tk * 512 + lane * 8);
        const unsigned ww[4] = {w.x, w.y, w.z, w.w}, zw[4] = {zz.x, zz.y, zz.z, zz.w};
        float v[8]; float ss = 0.f;
#pragma unroll
        for (int k = 0; k < 4; ++k) {
            v[2 * k] = bflo(ww[k]) * siluf(bflo(zw[k])); v[2 * k + 1] = bfhi(ww[k]) * siluf(bfhi(zw[k]));
            ss += v[2 * k] * v[2 * k] + v[2 * k + 1] * v[2 * k + 1];
        }
#pragma unroll
        for (int o = 16; o >= 1; o >>= 1) ss += __shfl_xor(ss, o);
        const float rr = rsqrtf(ss * (1.f / 256.f) + EPS);
        uint4 o4; o4.x = pack2(v[0] * rr, v[1] * rr); o4.y = pack2(v[2] * rr, v[3] * rr); o4.z = pack2(v[4] * rr, v[5] * rr); o4.w = pack2(v[6] * rr, v[7] * rr);
        *ptr = o4;
    }
}

struct EpiResid {
    float* pre; const float* res;
    DI void operator()(const float* Cs, int m0, int n0, int tid) const {
        const int c4 = (tid & 31) * 4, r0 = tid >> 5;
#pragma unroll 4
        for (int ps = 0; ps < 16; ++ps) {
            const int row = ps * 8 + r0;
            const size_t idx = (size_t)(m0 + row) * 1024 + n0 + c4;
            const float4 v = cs4(Cs, row, c4), rr = *(const float4*)(res + idx);
            *(float4*)(pre + idx) = make_float4(ALPHA * rr.x + v.x, ALPHA * rr.y + v.y, ALPHA * rr.z + v.z, ALPHA * rr.w + v.w);
        }
    }
};
DI void phase_wout(const P& p, int bid, int nb, unsigned char* smem) {
    const int v = vbid(bid, nb);
    EpiResid e{p.out, p.in[0]};
    GemmArgs g{(const bf16_t*)(p.ws + MIX), 1024, (const bf16_t*)(p.ws + W_OUT), 1024, 1024, nullptr};
    for (int t = v; t < 256 * 8; t += nb) gemm_tile(g, (t >> 3) * 128, (t & 7) * 128, e, smem);
}
DI void ln_row(const float* src, const float* gam, const float* bet, int lane, float (&o)[16]) {
    float v[16];
#pragma unroll
    for (int i = 0; i < 4; ++i) { const float4 t4 = *(const float4*)(src + i * 256 + lane * 4); v[4 * i] = t4.x; v[4 * i + 1] = t4.y; v[4 * i + 2] = t4.z; v[4 * i + 3] = t4.w; }
    float s = 0.f;
#pragma unroll
    for (int i = 0; i < 16; ++i) s += v[i];
    const float mu = wave_sum(s) * (1.f / 1024.f);
    float q = 0.f;
#pragma unroll
    for (int i = 0; i < 16; ++i) { const float d = v[i] - mu; q += d * d; }
    const float rstd = rsqrtf(wave_sum(q) * (1.f / 1024.f) + EPS);
#pragma unroll
    for (int i = 0; i < 4; ++i) {
        const float4 g4 = *(const float4*)(gam + i * 256 + lane * 4), b4 = *(const float4*)(bet + i * 256 + lane * 4);
        o[4 * i] = (v[4 * i] - mu) * rstd * g4.x + b4.x; o[4 * i + 1] = (v[4 * i + 1] - mu) * rstd * g4.y + b4.y;
        o[4 * i + 2] = (v[4 * i + 2] - mu) * rstd * g4.z + b4.z; o[4 * i + 3] = (v[4 * i + 3] - mu) * rstd * g4.w + b4.w;
    }
}
DI void phase_ln1(const P& p, int bid, int nb, unsigned char* smem) {
    const int lane = tidx() & 63, wave = tidx() >> 6;
    float* hf = (float*)(p.ws + H1); bf16_t* hb = (bf16_t*)(p.ws + H1B);
    for (int tk = bid * 4 + wave; tk < T; tk += nb * 4) {
        float o[16];
        ln_row(p.out + (size_t)tk * 1024, p.in[14], p.in[15], lane, o);
#pragma unroll
        for (int i = 0; i < 4; ++i) {
            *(float4*)(hf + (size_t)tk * 1024 + i * 256 + lane * 4) = make_float4(o[4 * i], o[4 * i + 1], o[4 * i + 2], o[4 * i + 3]);
            uint2 w; w.x = pack2(o[4 * i], o[4 * i + 1]); w.y = pack2(o[4 * i + 2], o[4 * i + 3]);
            *(uint2*)(hb + (size_t)tk * 1024 + i * 256 + lane * 4) = w;
        }
    }
}
struct EpiXq {
    bf16_t* qx;
    DI void operator()(const float* Cs, int m0, int n0, int tid) const {
        const int c4 = (tid & 31) * 4, r0 = tid >> 5, hd = n0 >> 8, d = (n0 & 255) + c4, b = m0 >> 11, s0 = m0 & 2047;
#pragma unroll 4
        for (int ps = 0; ps < 16; ++ps) {
            const int row = ps * 8 + r0;
            float4 v = cs4(Cs, row, c4); v.x *= XSCALE; v.y *= XSCALE; v.z *= XSCALE; v.w *= XSCALE;
            *(uint2*)(qx + ((size_t)(b * 4 + hd) * 2048 + s0 + row) * 256 + d) = pack4(v);
        }
    }
};
DI void phase_xq(const P& p, int bid, int nb, unsigned char* smem) {
    const int v = vbid(bid, nb);
    EpiXq e{(bf16_t*)(p.ws + QX)};
    GemmArgs g{(const bf16_t*)(p.ws + H1B), 1024, (const bf16_t*)(p.ws + W_XQ), 1024, 1024, nullptr};
    for (int t = v; t < 256 * 8; t += nb) gemm_tile(g, (t >> 3) * 128, (t & 7) * 128, e, smem);
}
DI void phase_xattn(const P& p, int bid, int nb, unsigned char* smem) {
#if !XATTN_NAIVE
    xattn_fast(p, bid, nb, smem); return;
#endif
    unsigned char* ws = p.ws;
    const bf16_t* qx = (const bf16_t*)(ws + QX); const bf16_t* kx = (const bf16_t*)(ws + KX); const bf16_t* vxt = (const bf16_t*)(ws + VXT);
    bf16_t* ox = (bf16_t*)(ws + OX);
    const int lane = tidx() & 63, hd = tidx() >> 6;
    float* qs = (float*)smem + hd * 512; float* ps = qs + 256;
    for (int tk = bid; tk < T; tk += nb) {
        const int b = tk >> 11, s_ = tk & 2047;
        __syncthreads();
        {
            const uint2 w = *(const uint2*)(qx + ((size_t)(b * 4 + hd) * 2048 + s_) * 256 + lane * 4);
            qs[lane * 4] = bflo(w.x); qs[lane * 4 + 1] = bfhi(w.x); qs[lane * 4 + 2] = bflo(w.y); qs[lane * 4 + 3] = bfhi(w.y);
        }
        __syncthreads();
        float sc[4];
#pragma unroll
        for (int i = 0; i < 4; ++i) {
            const int m = lane + 64 * i;
            const uint4* k4 = (const uint4*)(kx + ((size_t)(b * 4 + hd) * 256 + m) * 256);
            float a = 0.f;
#pragma unroll 8
            for (int c = 0; c < 32; ++c) {
                const uint4 w = k4[c];
                const float4 q0 = *(const float4*)(qs + 8 * c), q1 = *(const float4*)(qs + 8 * c + 4);
                a += q0.x * bflo(w.x) + q0.y * bfhi(w.x) + q0.z * bflo(w.y) + q0.w * bfhi(w.y) + q1.x * bflo(w.z) + q1.y * bfhi(w.z) + q1.z * bflo(w.w) + q1.w * bfhi(w.w);
            }
            sc[i] = a;
        }
        const float mx = wave_max(fmaxf(fmaxf(sc[0], sc[1]), fmaxf(sc[2], sc[3])));
        float sum = 0.f;
#pragma unroll
        for (int i = 0; i < 4; ++i) { sc[i] = exp2f(sc[i] - mx); sum += sc[i]; }
        const float il = 1.f / wave_sum(sum);
#pragma unroll
        for (int i = 0; i < 4; ++i) ps[lane + 64 * i] = sc[i] * il;
        __syncthreads();
        float o[4];
#pragma unroll
        for (int dd = 0; dd < 4; ++dd) {
            const int d = lane * 4 + dd;
            const uint4* v4 = (const uint4*)(vxt + ((size_t)(b * 4 + hd) * 256 + d) * 256);
            float a = 0.f;
#pragma unroll 8
            for (int c = 0; c < 32; ++c) {
                const uint4 w = v4[c];
                const float4 q0 = *(const float4*)(ps + 8 * c), q1 = *(const float4*)(ps + 8 * c + 4);
                a += q0.x * bflo(w.x) + q0.y * bfhi(w.x) + q0.z * bflo(w.y) + q0.w * bfhi(w.y) + q1.x * bflo(w.z) + q1.y * bfhi(w.z) + q1.z * bflo(w.w) + q1.w * bfhi(w.w);
            }
            o[dd] = a;
        }
        uint2 w; w.x = pack2(o[0], o[1]); w.y = pack2(o[2], o[3]);
        *(uint2*)(ox + (size_t)tk * 1024 + hd * 256 + lane * 4) = w;
    }
}
DI void phase_xo(const P& p, int bid, int nb, unsigned char* smem) {
    const int v = vbid(bid, nb);
    EpiResid e{p.out, (const float*)(p.ws + H1)};
    GemmArgs g{(const bf16_t*)(p.ws + OX), 1024, (const bf16_t*)(p.ws + W_XO), 1024, 1024, nullptr};
    for (int t = v; t < 256 * 8; t += nb) gemm_tile(g, (t >> 3) * 128, (t & 7) * 128, e, smem);
}
typedef float f32x4v __attribute__((ext_vector_type(4)));
DI void phase_ln2_router(const P& p, int bid, int nb, unsigned char* smem) {
    unsigned char* ws = p.ws;
    const int lane = tidx() & 63, wave = tidx() >> 6;
    float* hf = (float*)(ws + H2); bf16_t* hb = (bf16_t*)(ws + H2B);
    const float* wrt = (const float*)(ws + W_RT);
    const float* gam = p.in[20]; const float* bet = p.in[21];
    unsigned* cnt = (unsigned*)(ws + CTL + CTL_CNT); int* lists = (int*)(ws + LISTS); float* tgate = (float*)(ws + TOK_GATE);
    float* lg = (float*)smem + wave * (16 * 52 + 32);
    float* stt = lg + 16 * 52;
    for (int grp = bid; grp < T / 64; grp += nb) {
        const int t0 = grp * 64 + wave * 16;
        for (int rr = 0; rr < 16; ++rr) {
            const int tk = t0 + rr;
            const float* srcp = p.out + (size_t)tk * 1024;
            float v[16];
#pragma unroll
            for (int i = 0; i < 4; ++i) { const float4 t4 = *(const float4*)(srcp + i * 256 + lane * 4); v[4 * i] = t4.x; v[4 * i + 1] = t4.y; v[4 * i + 2] = t4.z; v[4 * i + 3] = t4.w; }
            float s = 0.f;
#pragma unroll
            for (int i = 0; i < 16; ++i) s += v[i];
            const float mu = wave_sum(s) * (1.f / 1024.f);
            float q = 0.f;
#pragma unroll
            for (int i = 0; i < 16; ++i) { const float d = v[i] - mu; q += d * d; }
            const float rstd = rsqrtf(wave_sum(q) * (1.f / 1024.f) + EPS);
            if (lane == 0) { stt[2 * rr] = mu; stt[2 * rr + 1] = rstd; }
#pragma unroll
            for (int i = 0; i < 4; ++i) {
                const float4 g4 = *(const float4*)(gam + i * 256 + lane * 4), b4 = *(const float4*)(bet + i * 256 + lane * 4);
                const float o0 = (v[4 * i] - mu) * rstd * g4.x + b4.x, o1 = (v[4 * i + 1] - mu) * rstd * g4.y + b4.y;
                const float o2 = (v[4 * i + 2] - mu) * rstd * g4.z + b4.z, o3 = (v[4 * i + 3] - mu) * rstd * g4.w + b4.w;
                *(float4*)(hf + (size_t)tk * 1024 + i * 256 + lane * 4) = make_float4(o0, o1, o2, o3);
                uint2 w; w.x = pack2(o0, o1); w.y = pack2(o2, o3);
                *(uint2*)(hb + (size_t)tk * 1024 + i * 256 + lane * 4) = w;
            }
        }
        __builtin_amdgcn_wave_barrier();
        {
            const int i16 = lane & 15, g4i = lane >> 4;
            const float mu = stt[2 * i16], rstd = stt[2 * i16 + 1];
            const float* arow = p.out + (size_t)(t0 + i16) * 1024 + 4 * g4i;
            const float* brow = wrt + (size_t)i16 * 1024 + 4 * g4i;
            const float* grow = gam + 4 * g4i; const float* berow = bet + 4 * g4i;
            f32x4v acc0 = {0.f, 0.f, 0.f, 0.f}, acc1 = acc0, acc2 = acc0;
#pragma unroll 2
            for (int S = 0; S < 64; ++S) {
                const float4 x4 = *(const float4*)(arow + 16 * S), g4 = *(const float4*)(grow + 16 * S), e4 = *(const float4*)(berow + 16 * S);
                const float4 b0 = *(const float4*)(brow + 16 * S), b1 = *(const float4*)(brow + 16 * 1024 + 16 * S), b2 = *(const float4*)(brow + 32 * 1024 + 16 * S);
                const float a0 = (x4.x - mu) * rstd * g4.x + e4.x, a1 = (x4.y - mu) * rstd * g4.y + e4.y, a2 = (x4.z - mu) * rstd * g4.z + e4.z, a3 = (x4.w - mu) * rstd * g4.w + e4.w;
                acc0 = __builtin_amdgcn_mfma_f32_16x16x4f32(a0, b0.x, acc0, 0, 0, 0); acc1 = __builtin_amdgcn_mfma_f32_16x16x4f32(a0, b1.x, acc1, 0, 0, 0); acc2 = __builtin_amdgcn_mfma_f32_16x16x4f32(a0, b2.x, acc2, 0, 0, 0);
                acc0 = __builtin_amdgcn_mfma_f32_16x16x4f32(a1, b0.y, acc0, 0, 0, 0); acc1 = __builtin_amdgcn_mfma_f32_16x16x4f32(a1, b1.y, acc1, 0, 0, 0); acc2 = __builtin_amdgcn_mfma_f32_16x16x4f32(a1, b2.y, acc2, 0, 0, 0);
                acc0 = __builtin_amdgcn_mfma_f32_16x16x4f32(a2, b0.z, acc0, 0, 0, 0); acc1 = __builtin_amdgcn_mfma_f32_16x16x4f32(a2, b1.z, acc1, 0, 0, 0); acc2 = __builtin_amdgcn_mfma_f32_16x16x4f32(a2, b2.z, acc2, 0, 0, 0);
                acc0 = __builtin_amdgcn_mfma_f32_16x16x4f32(a3, b0.w, acc0, 0, 0, 0); acc1 = __builtin_amdgcn_mfma_f32_16x16x4f32(a3, b1.w, acc1, 0, 0, 0); acc2 = __builtin_amdgcn_mfma_f32_16x16x4f32(a3, b2.w, acc2, 0, 0, 0);
            }
#pragma unroll
            for (int e = 0; e < 4; ++e) {
                float* rowp = lg + (4 * g4i + e) * 52 + i16;
                rowp[0] = acc0[e]; rowp[16] = acc1[e]; rowp[32] = acc2[e];
            }
        }
        __builtin_amdgcn_wave_barrier();
        if (lane < 16) {
            const int tk = t0 + lane;
            const float* lr = lg + lane * 52;
            float gl[4], el[32];
#pragma unroll
            for (int j = 0; j < 4; ++j) gl[j] = lr[j] + p.in[23][j];
#pragma unroll
            for (int j = 0; j < 32; ++j) el[j] = lr[4 + j] + p.in[25][j];
            int gi = 0; float gm = gl[0];
#pragma unroll
            for (int j = 1; j < 4; ++j) if (gl[j] > gm) { gm = gl[j]; gi = j; }
            float gs = 0.f;
#pragma unroll
            for (int j = 0; j < 4; ++j) gs += __expf(gl[j] - gm);
            const float ggate = 1.f / gs;
            float ev[8];
#pragma unroll
            for (int j = 0; j < 8; ++j) ev[j] = gi == 0 ? el[j] : gi == 1 ? el[8 + j] : gi == 2 ? el[16 + j] : el[24 + j];
            int i1 = 0; float v1 = ev[0];
#pragma unroll
            for (int j = 1; j < 8; ++j) if (ev[j] > v1) { v1 = ev[j]; i1 = j; }
            int i2 = -1; float v2 = -3.0e38f;
#pragma unroll
            for (int j = 0; j < 8; ++j) if (j != i1 && ev[j] > v2) { v2 = ev[j]; i2 = j; }
            const float e2 = __expf(v2 - v1);
            const float g1 = ggate / (1.f + e2), g2 = ggate * e2 / (1.f + e2);
            const int ex1 = gi * 8 + i1, ex2 = gi * 8 + i2;
            const unsigned p1 = atomicAdd(&cnt[ex1], 1u); lists[(size_t)ex1 * T + p1] = tk * 2;
            const unsigned p2 = atomicAdd(&cnt[ex2], 1u); lists[(size_t)ex2 * T + p2] = tk * 2 + 1;
            tgate[tk * 2] = g1; tgate[tk * 2 + 1] = g2;
        }
        __builtin_amdgcn_wave_barrier();
    }
}
struct MoeMap { int off[33]; };
DI int moe_tiles(const unsigned* cnt, int* offs  ) {
    __syncthreads();
    if (tidx() == 0) { int o = 0; for (int e = 0; e < 32; ++e) { offs[e] = o; o += (((int)cnt[e] + 127) >> 7) << 7; } offs[32] = o; }
    __syncthreads();
    return offs[32] >> 7;
}
struct EpiGU {
    bf16_t* hdn;
    DI void operator()(const float* Cs, int m0, int n0, int tid) const {
#pragma unroll 4
        for (int ps = 0; ps < 8; ++ps) {
            const int it = ps * 256 + tid, row = it >> 4, qd = it & 15, c = (qd >> 3) * 64 + (qd & 7) * 4;
            const float4 g = cs4(Cs, row, c), u = cs4(Cs, row, c + 32);
            const int hc = ((n0 & 511) >> 7) * 64 + (qd >> 3) * 32 + (qd & 7) * 4;
            *(uint2*)(hdn + (size_t)(m0 + row) * 256 + hc) = pack4(make_float4(siluf(g.x) * u.x, siluf(g.y) * u.y, siluf(g.z) * u.z, siluf(g.w) * u.w));
        }
    }
};
struct EpiDown {
    bf16_t* y; const int* ltok; const float* lgate;
    DI void operator()(const float* Cs, int m0, int n0, int tid) const {
        const int c4 = (tid & 31) * 4, r0 = tid >> 5;
#pragma unroll 4
        for (int ps = 0; ps < 16; ++ps) {
            const int row = ps * 8 + r0, tk2 = ltok[row];
            if (tk2 >= 0) {
                const float gt = lgate[row];
                float4 v = cs4(Cs, row, c4); v.x *= gt; v.y *= gt; v.z *= gt; v.w *= gt;
                *(uint2*)(y + (size_t)tk2 * 1024 + n0 + c4) = pack4(v);
            }
        }
    }
};
template <int WHICH>
DI void phase_moe(const P& p, int bid, int nb, unsigned char* smem) {
    unsigned char* ws = p.ws;
    const unsigned* cnt = (const unsigned*)(ws + CTL + CTL_CNT); const int* lists = (const int*)(ws + LISTS); const float* tgate = (const float*)(ws + TOK_GATE);
    int* offs = (int*)(smem + GEMM_LDS); int* ltok = offs + 64; int* lrow = ltok + 128; float* lgate = (float*)(lrow + 128);
    const int nmt = moe_tiles(cnt, offs);
    constexpr int NNT = WHICH == 0 ? 4 : 8;
    const int v = vbid(bid, nb);
    for (int t = v; t < nmt * NNT; t += nb) {
        const int mt = t / NNT, ntl = t % NNT;
        const int slot0 = mt * 128;
        int e = 0;
        while (offs[e + 1] <= slot0) ++e;
        __syncthreads();
        if (tidx() < 128) {
            const int pos = slot0 - offs[e] + tidx();
            const int tk2 = pos < (int)cnt[e] ? lists[(size_t)e * T + pos] : -1;
            ltok[tidx()] = tk2; lrow[tidx()] = tk2 < 0 ? 0 : (tk2 >> 1); lgate[tidx()] = tk2 < 0 ? 0.f : tgate[tk2];
        }
        __syncthreads();
        if (WHICH == 0) {
            EpiGU ep{(bf16_t*)(ws + HDN)};
            GemmArgs g{(const bf16_t*)(ws + H2B), 1024, (const bf16_t*)(ws + W_GU) + (size_t)e * 512 * 1024, 1024, 1024, lrow};
            gemm_tile(g, slot0, ntl * 128, ep, smem);
        } else {
            EpiDown ep{(bf16_t*)(ws + YB), ltok, lgate};
            GemmArgs g{(const bf16_t*)(ws + HDN), 256, (const bf16_t*)(ws + W_DN) + (size_t)e * 1024 * 256, 256, 256, nullptr};
            gemm_tile(g, slot0, ntl * 128, ep, smem);
        }
    }
}
DI void phase_final(const P& p, int bid, int nb, unsigned char* smem) {
    const int lane = tidx() & 63, wave = tidx() >> 6;
    const float* hf = (const float*)(p.ws + H2); const bf16_t* y = (const bf16_t*)(p.ws + YB);
    const float* gam = p.in[29]; const float* bet = p.in[30];
    for (int tk = bid * 4 + wave; tk < T; tk += nb * 4) {
        float v[16];
#pragma unroll
        for (int i = 0; i < 4; ++i) {
            const float4 t4 = *(const float4*)(hf + (size_t)tk * 1024 + i * 256 + lane * 4);
            const uint2 a = *(const uint2*)(y + (size_t)(tk * 2) * 1024 + i * 256 + lane * 4), b = *(const uint2*)(y + (size_t)(tk * 2 + 1) * 1024 + i * 256 + lane * 4);
            v[4 * i] = ALPHA * t4.x + bflo(a.x) + bflo(b.x); v[4 * i + 1] = ALPHA * t4.y + bfhi(a.x) + bfhi(b.x);
            v[4 * i + 2] = ALPHA * t4.z + bflo(a.y) + bflo(b.y); v[4 * i + 3] = ALPHA * t4.w + bfhi(a.y) + bfhi(b.y);
        }
        float s = 0.f;
#pragma unroll
        for (int i = 0; i < 16; ++i) s += v[i];
        const float mu = wave_sum(s) * (1.f / 1024.f);
        float q = 0.f;
#pragma unroll
        for (int i = 0; i < 16; ++i) { const float d = v[i] - mu; q += d * d; }
        const float rstd = rsqrtf(wave_sum(q) * (1.f / 1024.f) + EPS);
#pragma unroll
        for (int i = 0; i < 4; ++i) {
            const float4 g4 = *(const float4*)(gam + i * 256 + lane * 4), b4 = *(const float4*)(bet + i * 256 + lane * 4);
            *(float4*)(p.out + (size_t)tk * 1024 + i * 256 + lane * 4) = make_float4((v[4 * i] - mu) * rstd * g4.x + b4.x, (v[4 * i + 1] - mu) * rstd * g4.y + b4.y,
                                                                                    (v[4 * i + 2] - mu) * rstd * g4.z + b4.z, (v[4 * i + 3] - mu) * rstd * g4.w + b4.w);
        }
    }
}

#define XB_TMO      128
#define XB_XCNT(j)  (256  + 64 * (j))
#define XB_XSUB(j)  (1280 + 64 * (j))
#define XB_XGEN(j)  (2304 + 64 * (j))
#define XB_TOP      3328
#define XB_TOPGEN   3392
#define XCD_BAR_WORDS 3456
#define XB_SPIN_CAP (1u << 25)
DI unsigned xb_ld(unsigned* p) { return __hip_atomic_load(p, __ATOMIC_RELAXED, __HIP_MEMORY_SCOPE_AGENT); }
DI unsigned xb_add(unsigned* p, unsigned v) { return __hip_atomic_fetch_add(p, v, __ATOMIC_RELAXED, __HIP_MEMORY_SCOPE_AGENT); }
DI unsigned xb_xcc_id() { return (unsigned)__builtin_amdgcn_s_getreg((3 << 11) | 20) & 0xFu; }
#define XB_SPIN(cond, bar) do { unsigned _sp = 0; while (cond) { __builtin_amdgcn_s_sleep(1); \
    if ((++_sp & 255u) == 0u) { if (xb_ld(&(bar)[XB_TMO])) break; if (_sp > XB_SPIN_CAP) { atomicAdd(&(bar)[XB_TMO], 1u); break; } } } } while (0)
struct XcdBarrier { unsigned* bar; unsigned x; volatile LAS unsigned* st; };
DI XcdBarrier xcd_barrier_post(unsigned* bar, volatile LAS unsigned* st) {
    XcdBarrier b; b.bar = bar; b.x = xb_xcc_id(); b.st = st;
    if (threadIdx.x == 0) (void)xb_add(&bar[XB_XCNT(b.x)], 1u);
    return b;
}
DI void xcd_barrier_complete(unsigned* bar, unsigned x, unsigned& nloc, unsigned& nx) {
    const unsigned G = gridDim.x * gridDim.y * gridDim.z;
    unsigned sum, cnt, mine, sp = 0u;
    for (;;) {
        sum = 0u; cnt = 0u; mine = 0u;
#pragma unroll
        for (unsigned j = 0; j < 16; ++j) { const unsigned c = xb_ld(&bar[XB_XCNT(j)]); sum += c; cnt += (c > 0u) ? 1u : 0u; mine = (j == x) ? c : mine; }
        if (sum == G) break;
        __builtin_amdgcn_s_sleep(1);
        if ((++sp & 255u) == 0u) { if (xb_ld(&bar[XB_TMO])) break; if (sp > XB_SPIN_CAP) { atomicAdd(&bar[XB_TMO], 1u); break; } }
    }
    nloc = mine > 0u ? mine : 1u; nx = cnt > 0u ? cnt : 1u;
}
DI void xcd_barrier(const XcdBarrier& b) {
    asm volatile("s_waitcnt vmcnt(0)" ::: "memory");
    __syncthreads();
    if (threadIdx.x == 0) {
        unsigned* bar = b.bar;
        __builtin_amdgcn_s_waitcnt(0);
        unsigned nloc = b.st[0], nx = b.st[1];
        if (nloc == 0u) { xcd_barrier_complete(bar, b.x, nloc, nx); b.st[0] = nloc; b.st[1] = nx; }
        const unsigned old = xb_add(&bar[XB_XSUB(b.x)], 1u);
        const unsigned gen = old / nloc;
        if (old + 1u == (gen + 1u) * nloc) {
            __builtin_amdgcn_fence(__ATOMIC_RELEASE, "agent");
            asm volatile("s_waitcnt vmcnt(0)" ::: "memory");
            const unsigned og = xb_add(&bar[XB_TOP], 1u);
            const unsigned tg = og / nx;
            if (og + 1u == (tg + 1u) * nx) xb_add(&bar[XB_TOPGEN], 1u);
            else XB_SPIN(xb_ld(&bar[XB_TOPGEN]) == tg, bar);
            __builtin_amdgcn_fence(__ATOMIC_ACQUIRE, "agent");
            xb_add(&bar[XB_XGEN(b.x)], 1u);
            asm volatile("s_waitcnt vmcnt(0)" ::: "memory");
        } else {
            XB_SPIN(xb_ld(&bar[XB_XGEN(b.x)]) == gen, bar);
            __builtin_amdgcn_fence(__ATOMIC_ACQUIRE, "agent");
            asm volatile("s_waitcnt vmcnt(0)" ::: "memory");
        }
    }
    __syncthreads();
}

constexpr int NPHASE = 14;
template <int PH>
DI void run_phase(const P& p, int bid, int nb, unsigned char* smem, int rep = 0) {
    if (PH == 0) phase_prep(p, bid, nb, smem);
    else if (PH == 1) phase_proj(p, bid, nb, smem, rep);
    else if (PH == 2) phase_up(p, bid, nb, smem);
    else if (PH == 3) phase_mixer(p, bid, nb, smem, rep);
    else if (PH == 4) phase_ssdnorm(p, bid, nb, smem);
    else if (PH == 5) phase_wout(p, bid, nb, smem);
    else if (PH == 6) phase_ln1(p, bid, nb, smem);
    else if (PH == 7) phase_xq(p, bid, nb, smem);
    else if (PH == 8) phase_xattn(p, bid, nb, smem);
    else if (PH == 9) phase_xo(p, bid, nb, smem);
    else if (PH == 10) phase_ln2_router(p, bid, nb, smem);
    else if (PH == 11) phase_moe<0>(p, bid, nb, smem);
    else if (PH == 12) phase_moe<1>(p, bid, nb, smem);
    else if (PH == 13) phase_final(p, bid, nb, smem);
}
template <int PH>
__global__ void __launch_bounds__(256, 2) k_phase(P p) {
    __shared__ __attribute__((aligned(16))) unsigned char smem[SMEM_BYTES];
    run_phase<PH>(p, blockIdx.x, gridDim.x, smem);
}

#if MEGA
#ifndef MEGA_WAVES
#define MEGA_WAVES 2
#endif
template <int PH>
DI void mega_steps(const P& p, const XcdBarrier& bar, unsigned char* smem) {
    run_phase<PH>(p, blockIdx.x, gridDim.x, smem);
    if constexpr (((REPEAT_MASK >> PH) & 1) != 0) { xcd_barrier(bar); run_phase<PH>(p, blockIdx.x, gridDim.x, smem, 1); }
    if constexpr (PH + 1 < NPHASE) { xcd_barrier(bar); mega_steps<PH + 1>(p, bar, smem); }
}
__global__ void __launch_bounds__(256, MEGA_WAVES) k_mega(P p) {
    __shared__ __attribute__((aligned(16))) unsigned char smem[SMEM_BYTES];
    volatile LAS unsigned* st = (volatile LAS unsigned*)(smem + SMEM_BYTES - 16);
    if (threadIdx.x < 4) st[threadIdx.x] = 0u;
    __syncthreads();
    const XcdBarrier bar = xcd_barrier_post((unsigned*)(p.ws + CTL), st);
    mega_steps<0>(p, bar, smem);
}
#endif
template <int PH>
__global__ void __launch_bounds__(256, 1) k_phase_big(P p) {
    __shared__ __attribute__((aligned(16))) unsigned char smem[SMEM_BYTES];
    run_phase<PH>(p, blockIdx.x, gridDim.x, smem);
}
template <int PH>
static void launch_phase(const P& p, int grid, hipStream_t st) {
    if constexpr (PH == 3 && !P3_SMALL) hipLaunchKernelGGL((k_phase_big<PH>), dim3(grid), dim3(256), 0, st, p);
    else hipLaunchKernelGGL((k_phase<PH>), dim3(grid), dim3(256), 0, st, p);
}

extern "C" void kernel_launch(void* const* d_in, const int* in_sizes, int n_in, void* d_out, int out_size, void* d_ws, size_t ws_size, hipStream_t stream) {
    if (n_in != 31 || out_size != T * D || ws_size < WS_NEED) {
        fprintf(stderr, "kernel_launch: unexpected shapes: n_in %d out %d ws %zu (need %zu)\n", n_in, out_size, ws_size, (size_t)WS_NEED);
        return;
    }
    P p{};
    for (int i = 0; i < 31; ++i) p.in[i] = (const float*)d_in[i];
    p.out = (float*)d_out; p.ws = (unsigned char*)d_ws;
    (void)hipMemsetAsync((unsigned char*)d_ws + CTL, 0, CTL_BYTES, stream);
#if MEGA
    static int grid = 0;
    if (grid == 0) {
        int dev = 0, cus = 0, per_cu = 0;
        (void)hipGetDevice(&dev);
        (void)hipDeviceGetAttribute(&cus, hipDeviceAttributeMultiprocessorCount, dev);
        if (hipOccupancyMaxActiveBlocksPerMultiprocessor(&per_cu, (const void*)k_mega, 256, 0) != hipSuccess || per_cu < 1) { fprintf(stderr, "kernel_launch: occupancy query failed\n"); per_cu = 1; }
        if (per_cu > 2) per_cu = 2;
        grid = cus * per_cu;
        fprintf(stderr, "kernel_launch: mega grid %d (%d CUs x %d)\n", grid, cus, per_cu);
    }
    void* args[] = {(void*)&p};
    const hipError_t le = hipLaunchCooperativeKernel((const void*)k_mega, dim3(grid), dim3(256), args, 0, stream);
    if (le != hipSuccess) fprintf(stderr, "kernel_launch: cooperative launch failed: %s (grid %d)\n", hipGetErrorString(le), grid);
#else
    const int grid = 1024;
    launch_phase<0>(p, grid, stream); launch_phase<1>(p, grid, stream); launch_phase<2>(p, grid, stream); launch_phase<3>(p, grid, stream);
    launch_phase<4>(p, grid, stream); launch_phase<5>(p, grid, stream); launch_phase<6>(p, grid, stream); launch_phase<7>(p, grid, stream);
    launch_phase<8>(p, grid, stream); launch_phase<9>(p, grid, stream); launch_phase<10>(p, grid, stream); launch_phase<11>(p, grid, stream);
    launch_phase<12>(p, grid, stream); launch_phase<13>(p, grid, stream);
#endif
}
```

```cpp
#include <hip/hip_runtime.h>
#include <stdint.h>
#include <stdio.h>

#ifndef MEGA
#define MEGA 1
#endif
#ifndef ATTN_NAIVE
#define ATTN_NAIVE 0
#endif
#ifndef XATTN_NAIVE
#define XATTN_NAIVE 0
#endif
#ifndef SSD_NAIVE
#define SSD_NAIVE 0
#endif
#ifndef P3_SMALL
#define P3_SMALL 1
#endif
#ifndef NO_SSD
#define NO_SSD 0
#endif
#ifndef NO_FLASH
#define NO_FLASH 0
#endif
#ifndef GEMM_GLDS
#define GEMM_GLDS 1
#endif
#ifndef REPEAT_MASK
#define REPEAT_MASK 0
#endif
#ifndef REP_MODE
#define REP_MODE 0
#endif
#ifndef GEMM_DIRECT
#define GEMM_DIRECT 0
#endif

typedef unsigned short bf16_t;
typedef short bf16x8 __attribute__((ext_vector_type(8)));
typedef float f32x16 __attribute__((ext_vector_type(16)));
#define DI __device__ __forceinline__
#define LAS __attribute__((address_space(3)))
#define MFMA32(a, b, c) __builtin_amdgcn_mfma_f32_32x32x16_bf16((a), (b), (c), 0, 0, 0)

constexpr int Bn = 16, S = 2048, T = Bn * S, D = 1024;
constexpr int NMEM = 256;
constexpr float EPS = 1e-5f;
constexpr float ALPHA = 1.189207115002721f;
constexpr float LOG2E = 1.4426950408889634f;
constexpr float QSCALE = 0.10206207261596577f * LOG2E;
constexpr float XSCALE = 0.0625f * LOG2E;
constexpr int NEXP = 32;
constexpr int MAXSLOTS = 69632;

constexpr size_t MiB = 1u << 20;
constexpr size_t W_IN = 0;
constexpr size_t W_QUP = W_IN + 4 * MiB;
constexpr size_t W_KVUP = W_QUP + 768 * 256 * 2;
constexpr size_t W_OUT = W_KVUP + 1024 * 128 * 2;
constexpr size_t W_XQ = W_OUT + 2 * MiB;
constexpr size_t W_XKV = W_XQ + 2 * MiB;
constexpr size_t W_XO = W_XKV + 4 * MiB;
constexpr size_t W_GU = W_XO + 2 * MiB;
constexpr size_t W_DN = W_GU + 32 * MiB;
constexpr size_t W_RT = W_DN + 16 * MiB;
constexpr size_t ROPE_C = W_RT + 48 * 1024 * 4;
constexpr size_t ROPE_S = ROPE_C + 2048 * 16 * 4;
constexpr size_t TOK_GATE = ROPE_S + 2048 * 16 * 4;
constexpr size_t CTL = TOK_GATE + (size_t)T * 2 * 4;
constexpr size_t CTL_BYTES = 32768;
constexpr size_t CTL_CNT = 16384;
constexpr int CNT_STRIDE = 64;
constexpr size_t CTL_QUEUE = 28672;
static_assert(CTL + CTL_BYTES <= 64 * MiB, "weights region overflow");
constexpr size_t RA = 64 * MiB, RB = 192 * MiB, RC = 320 * MiB, RD = 448 * MiB, WS_NEED = 512 * MiB;
constexpr size_t XBC = RA;
constexpr size_t KX = RA + 64 * MiB;
constexpr size_t VXT = KX + 8 * MiB;
constexpr size_t YB = RA;
constexpr size_t QB = RB;
constexpr size_t KNB = RB + 48 * MiB;
constexpr size_t VTB = KNB + 32 * MiB;
constexpr size_t H1 = RB;
constexpr size_t H2 = RB;
constexpr size_t XB = RC;
constexpr size_t MEMB = RB;
constexpr size_t XBCA = RC;
constexpr size_t MIX = RC + 64 * MiB;
constexpr size_t H1B = RC;
constexpr size_t QX = RC + 64 * MiB;
constexpr size_t OX = RC;
constexpr size_t H2B = RC;
constexpr size_t HDN = RC + 64 * MiB;
constexpr size_t CQ = RD;
constexpr size_t CKV = CQ + 16 * MiB;
constexpr size_t KROPE = CKV + 8 * MiB;
constexpr size_t DTB = KROPE + 2 * MiB;
constexpr size_t ZB = DTB + 1 * MiB;
constexpr size_t LISTS = RD;
static_assert(ZB + 32 * MiB <= WS_NEED, "region D overflow");

struct P {
    const float* in[31];
    float* out;
    unsigned char* ws;
};

typedef __bf16 hbf16x2 __attribute__((ext_vector_type(2)));
typedef float f32x2 __attribute__((ext_vector_type(2)));
DI bf16_t f2bf(float x) { return __builtin_bit_cast(bf16_t, (__bf16)x); }
DI float bf2f(bf16_t b) { return __uint_as_float(((unsigned)b) << 16); }
DI float bflo(unsigned w) { return __uint_as_float(w << 16); }
DI float bfhi(unsigned w) { return __uint_as_float(w & 0xffff0000u); }
DI unsigned pack2(float a, float b) { f32x2 v = {a, b}; return __builtin_bit_cast(unsigned, __builtin_convertvector(v, hbf16x2)); }
DI float siluf(float x) { return x / (1.f + __expf(-x)); }
DI float softplusf(float x) {
    const float zz = __expf(-fabsf(x));
    const float l1p = zz < 0.01f ? zz * (1.f - zz * (0.5f - zz * (1.f / 3.f))) : __logf(1.f + zz);
    return fmaxf(x, 0.f) + l1p;
}
DI int tidx() { int t = __builtin_amdgcn_workitem_id_x(); asm volatile("" : "+v"(t)); return t; }
DI int crow(int reg, int h) { return (reg & 3) + 8 * (reg >> 2) + 4 * h; }
constexpr int CS_LD = 132;
DI float4 cs4(const float* Cs, int row, int col) { return *(const float4*)(Cs + row * CS_LD + col); }
DI uint2 pack4(float4 v) { uint2 w; w.x = pack2(v.x, v.y); w.y = pack2(v.z, v.w); return w; }
DI float wave_sum(float v) {
#pragma unroll
    for (int o = 32; o >= 1; o >>= 1) v += __shfl_xor(v, o);
    return v;
}
DI float wave_max(float v) {
#pragma unroll
    for (int o = 32; o >= 1; o >>= 1) v = fmaxf(v, __shfl_xor(v, o));
    return v;
}

constexpr int LDS_ROW = 144;
constexpr int TILE_BYTES = 128 * LDS_ROW;
constexpr int GEMM_LDS = 4 * TILE_BYTES;
constexpr int SMEM_BYTES = GEMM_LDS + 2048;
static_assert(128 * CS_LD * 4 <= GEMM_LDS, "epilogue tile");

struct GemmArgs {
    const bf16_t* A; int lda;
    const bf16_t* Bt; int ldb;
    int K;
    const int* lrows;
};

template <class Epi>
DI void gemm_tile(const GemmArgs& g, int m0, int n0, Epi& epi, unsigned char* smem) {
    const int tid = tidx(), lane = tid & 63, wave = tid >> 6, wr = wave >> 1, wc = wave & 1;
    const int r = lane & 31, h = lane >> 5;
    f32x16 acc[2][2];
#pragma unroll
    for (int i = 0; i < 2; ++i)
#pragma unroll
        for (int j = 0; j < 2; ++j)
#pragma unroll
            for (int e = 0; e < 16; ++e) acc[i][j][e] = 0.f;
    const int nk = g.K >> 6;
    epi.prefetch(m0, n0, tid);
#if GEMM_DIRECT
    {
        const bf16_t* ap[2]; const bf16_t* bp[2];
#pragma unroll
        for (int i = 0; i < 2; ++i) {
            const int lr = wr * 64 + i * 32 + r;
            const int grow = g.lrows ? g.lrows[lr] : (m0 + lr);
            ap[i] = g.A + (size_t)grow * g.lda + 8 * h;
            bp[i] = g.Bt + (size_t)(n0 + wc * 64 + i * 32 + r) * g.ldb + 8 * h;
        }
        for (int k = 0; k < g.K; k += 16) {
            bf16x8 a[2], b[2];
#pragma unroll
            for (int i = 0; i < 2; ++i) { a[i] = *(const bf16x8*)(ap[i] + k); b[i] = *(const bf16x8*)(bp[i] + k); }
#pragma unroll
            for (int i = 0; i < 2; ++i)
#pragma unroll
                for (int j = 0; j < 2; ++j) acc[i][j] = MFMA32(a[i], b[j], acc[i][j]);
        }
    }
#elif GEMM_GLDS
    {
        constexpr int STG = 32768, TB = 16384;
        const int srow = tid >> 3, sch = (tid & 7) ^ ((srow >> 1) & 7);
        const bf16_t* ag[4]; const bf16_t* bg[4];
#pragma unroll
        for (int i = 0; i < 4; ++i) {
            const int lr = srow + 32 * i;
            const int grow = g.lrows ? g.lrows[lr] : (m0 + lr);
            ag[i] = g.A + (size_t)grow * g.lda + sch * 8;
            bg[i] = g.Bt + (size_t)(n0 + lr) * g.ldb + sch * 8;
        }
#define GLDS_STAGE(BUF, KO) do { unsigned char* _d = (BUF) + wave * 1024; \
        _Pragma("unroll") for (int i = 0; i < 4; ++i) { \
            __builtin_amdgcn_global_load_lds((const unsigned*)(ag[i] + (KO)), (LAS unsigned*)(_d + i * 4096), 16, 0, 0); \
            __builtin_amdgcn_global_load_lds((const unsigned*)(bg[i] + (KO)), (LAS unsigned*)(_d + TB + i * 4096), 16, 0, 0); } } while (0)
        __syncthreads();
        GLDS_STAGE(smem, 0);
        const int y16 = (h ^ ((r >> 1) & 7)) << 4;
        const int o0 = y16, o1 = 32 ^ y16, o2 = 64 ^ y16, o3 = 96 ^ y16;
        const int arow = (wr * 64 + r) * 128, brow = TB + (wc * 64 + r) * 128;
        __syncthreads();
        for (int kt = 0; kt < nk; ++kt) {
            const unsigned char* cur = smem + (kt & 1) * STG;
            if (kt + 1 < nk) GLDS_STAGE(smem + ((kt + 1) & 1) * STG, (kt + 1) * 64);
#define KSTEP(OFF) do { \
                const bf16x8 a0 = *(const bf16x8*)(cur + arow + (OFF)); \
                const bf16x8 a1 = *(const bf16x8*)(cur + arow + 32 * 128 + (OFF)); \
                const bf16x8 b0 = *(const bf16x8*)(cur + brow + (OFF)); \
                const bf16x8 b1 = *(const bf16x8*)(cur + brow + 32 * 128 + (OFF)); \
                acc[0][0] = MFMA32(a0, b0, acc[0][0]); acc[0][1] = MFMA32(a0, b1, acc[0][1]); \
                acc[1][0] = MFMA32(a1, b0, acc[1][0]); acc[1][1] = MFMA32(a1, b1, acc[1][1]); } while (0)
            KSTEP(o0); KSTEP(o1); KSTEP(o2); KSTEP(o3);
#undef KSTEP
            __syncthreads();
        }
#undef GLDS_STAGE
    }
#else
    {
        const int srow = tid >> 3, sch = tid & 7;
        const bf16_t* ag[4]; const bf16_t* bg[4];
#pragma unroll
        for (int i = 0; i < 4; ++i) {
            const int lr = srow + 32 * i;
            const int grow = g.lrows ? g.lrows[lr] : (m0 + lr);
            ag[i] = g.A + (size_t)grow * g.lda + sch * 8;
            bg[i] = g.Bt + (size_t)(n0 + lr) * g.ldb + sch * 8;
        }
        const int soff = srow * LDS_ROW + sch * 16;
        uint4 ra0, ra1, ra2, ra3, rb0, rb1, rb2, rb3;
#define G_LOAD(KO) do { ra0 = *(const uint4*)(ag[0] + (KO)); ra1 = *(const uint4*)(ag[1] + (KO)); ra2 = *(const uint4*)(ag[2] + (KO)); ra3 = *(const uint4*)(ag[3] + (KO)); \
                        rb0 = *(const uint4*)(bg[0] + (KO)); rb1 = *(const uint4*)(bg[1] + (KO)); rb2 = *(const uint4*)(bg[2] + (KO)); rb3 = *(const uint4*)(bg[3] + (KO)); } while (0)
#define L_STORE(BUF) do { unsigned char* _d = (BUF) + soff; \
        *(uint4*)(_d) = ra0; *(uint4*)(_d + 32 * LDS_ROW) = ra1; *(uint4*)(_d + 64 * LDS_ROW) = ra2; *(uint4*)(_d + 96 * LDS_ROW) = ra3; \
        *(uint4*)(_d + TILE_BYTES) = rb0; *(uint4*)(_d + TILE_BYTES + 32 * LDS_ROW) = rb1; *(uint4*)(_d + TILE_BYTES + 64 * LDS_ROW) = rb2; *(uint4*)(_d + TILE_BYTES + 96 * LDS_ROW) = rb3; } while (0)
        G_LOAD(0);
        __syncthreads();
        L_STORE(smem);
        __syncthreads();
        const int aoff = (wr * 64 + r) * LDS_ROW + h * 16;
        const int boff = TILE_BYTES + (wc * 64 + r) * LDS_ROW + h * 16;
        for (int kt = 0; kt < nk; ++kt) {
            const unsigned char* cur = smem + (kt & 1) * 2 * TILE_BYTES;
            unsigned char* nxt = smem + ((kt + 1) & 1) * 2 * TILE_BYTES;
            const bool more = (kt + 1 < nk);
            if (more) G_LOAD((kt + 1) * 64);
#pragma unroll
            for (int ks = 0; ks < 4; ++ks) {
                const bf16x8 a0 = *(const bf16x8*)(cur + aoff + ks * 32);
                const bf16x8 a1 = *(const bf16x8*)(cur + aoff + 32 * LDS_ROW + ks * 32);
                const bf16x8 b0 = *(const bf16x8*)(cur + boff + ks * 32);
                const bf16x8 b1 = *(const bf16x8*)(cur + boff + 32 * LDS_ROW + ks * 32);
                acc[0][0] = MFMA32(a0, b0, acc[0][0]); acc[0][1] = MFMA32(a0, b1, acc[0][1]);
                acc[1][0] = MFMA32(a1, b0, acc[1][0]); acc[1][1] = MFMA32(a1, b1, acc[1][1]);
            }
            if (more) L_STORE(nxt);
            __syncthreads();
        }
#undef G_LOAD
#undef L_STORE
    }
#endif
    float* Cs = (float*)smem;
#if GEMM_DIRECT
    __syncthreads();
#endif
#pragma unroll
    for (int i = 0; i < 2; ++i)
#pragma unroll
        for (int j = 0; j < 2; ++j)
#pragma unroll
            for (int e = 0; e < 16; ++e) Cs[(wr * 64 + i * 32 + crow(e, h)) * CS_LD + wc * 64 + j * 32 + r] = acc[i][j][e];
    __syncthreads();
    epi(Cs, m0, n0, tid);
}

DI int vbid(int bid, int nb) { return (nb % 8 == 0) ? (bid % 8) * (nb / 8) + bid / 8 : bid; }

DI int colmap_in(int n) {
    if (n < 384) return n;
    if (n < 896) return 416 + (n - 384);
    if (n < 1920) return 928 + (n - 896);
    if (n < 1952) return 384 + (n - 1920);
    if (n < 1960) return n;
    return -1;
}
template <int KIND>
DI void tconv_tile(const float* src, const float* src2, int ldsrc, bf16_t* dst, int K, int k0, int n0, const float* scale, int scale_from, unsigned char* smem) {
    float* tile = (float*)smem;
    const int t = tidx();
    __syncthreads();
#pragma unroll 4
    for (int i = 0; i < 16; ++i) {
        const int k = i * 4 + (t >> 6), n = t & 63;
        const int nd = n0 + n;
        float v = 0.f;
        if (KIND == 1) { const int c = colmap_in(nd); if (c >= 0) v = src[(size_t)(k0 + k) * ldsrc + c]; }
        else if (KIND == 2) {
            const int j = nd >> 7, wc = (nd >> 6) & 1, isup = (nd >> 5) & 1, ii = nd & 31;
            const int c = 64 * j + 32 * wc + ii;
            v = (isup ? src2 : src)[(size_t)(k0 + k) * ldsrc + c];
        } else v = src[(size_t)(k0 + k) * ldsrc + nd];
        if (scale && (k0 + k) >= scale_from) v *= scale[k0 + k - scale_from];
        tile[k * 65 + n] = v;
    }
    __syncthreads();
#pragma unroll 4
    for (int i = 0; i < 16; ++i) {
        const int n = i * 4 + (t >> 6), k = t & 63;
        dst[(size_t)(n0 + n) * K + k0 + k] = f2bf(tile[k * 65 + n]);
    }
}

DI void phase_prep(const P& p, int bid, int nb, unsigned char* smem) {
    unsigned char* ws = p.ws;
    const int tid = tidx();
    constexpr int J0 = 512, J1 = J0 + 48, J2 = J1 + 32, J3 = J2 + 256, J4 = J3 + 256, J5 = J4 + 256, J6 = J5 + 256, J7 = J6 + 256, J8 = J7 + 4096, J9 = J8 + 2048;
    for (int t = bid; t < J9; t += nb) {
        if (t < J0) { const int kt = t >> 5, ntl = t & 31; tconv_tile<1>(p.in[2], nullptr, 1960, (bf16_t*)(ws + W_IN), 1024, kt * 64, ntl * 64, nullptr, 0, smem); }
        else if (t < J1) { const int u = t - J0, kt = u / 12, ntl = u % 12; tconv_tile<0>(p.in[4], nullptr, 768, (bf16_t*)(ws + W_QUP), 256, kt * 64, ntl * 64, p.in[3], 0, smem); }
        else if (t < J2) { const int u = t - J1, kt = u >> 4, ntl = u & 15; tconv_tile<0>(p.in[6], nullptr, 1024, (bf16_t*)(ws + W_KVUP), 128, kt * 64, ntl * 64, p.in[5], 0, smem); }
        else if (t < J3) { const int u = t - J2, kt = u >> 4, ntl = u & 15; tconv_tile<0>(p.in[13], nullptr, 1024, (bf16_t*)(ws + W_OUT), 1024, kt * 64, ntl * 64, p.in[12], 512, smem); }
        else if (t < J4) { const int u = t - J3, kt = u >> 4, ntl = u & 15; tconv_tile<0>(p.in[16], nullptr, 1024, (bf16_t*)(ws + W_XQ), 1024, kt * 64, ntl * 64, nullptr, 0, smem); }
        else if (t < J5) { const int u = t - J4, kt = u >> 4, ntl = u & 15; tconv_tile<0>(p.in[17], nullptr, 1024, (bf16_t*)(ws + W_XKV), 1024, kt * 64, ntl * 64, nullptr, 0, smem); }
        else if (t < J6) { const int u = t - J5, kt = u >> 4, ntl = u & 15; tconv_tile<0>(p.in[18], nullptr, 1024, (bf16_t*)(ws + W_XKV) + (size_t)1024 * 1024, 1024, kt * 64, ntl * 64, nullptr, 0, smem); }
        else if (t < J7) { const int u = t - J6, kt = u >> 4, ntl = u & 15; tconv_tile<0>(p.in[19], nullptr, 1024, (bf16_t*)(ws + W_XO), 1024, kt * 64, ntl * 64, nullptr, 0, smem); }
        else if (t < J8) { const int u = t - J7, e = u >> 7, v = u & 127, kt = v >> 3, ntl = v & 7;
            tconv_tile<2>(p.in[26] + (size_t)e * 1024 * 256, p.in[27] + (size_t)e * 1024 * 256, 256, (bf16_t*)(ws + W_GU) + (size_t)e * 512 * 1024, 1024, kt * 64, ntl * 64, nullptr, 0, smem); }
        else { const int u = t - J8, e = u >> 6, v = u & 63, kt = v >> 4, ntl = v & 15;
            tconv_tile<0>(p.in[28] + (size_t)e * 256 * 1024, nullptr, 1024, (bf16_t*)(ws + W_DN) + (size_t)e * 1024 * 256, 256, kt * 64, ntl * 64, nullptr, 0, smem); }
    }
    {
        const size_t gsz = (size_t)nb * 256, g0 = (size_t)bid * 256 + tid;
        bf16_t* xb = (bf16_t*)(ws + XB);
        const float4* x4 = (const float4*)p.in[0];
        for (size_t i = g0; i < (size_t)T * D / 4; i += gsz) { const float4 v = x4[i]; uint2 o; o.x = pack2(v.x, v.y); o.y = pack2(v.z, v.w); ((uint2*)xb)[i] = o; }
        bf16_t* mb = (bf16_t*)(ws + MEMB);
        const float4* m4 = (const float4*)p.in[1];
        for (size_t i = g0; i < (size_t)Bn * NMEM * D / 4; i += gsz) { const float4 v = m4[i]; uint2 o; o.x = pack2(v.x, v.y); o.y = pack2(v.z, v.w); ((uint2*)mb)[i] = o; }
        float* wrt = (float*)(ws + W_RT);
        for (size_t i = g0; i < 48 * 1024; i += gsz) {
            const int j = (int)(i >> 10), k = (int)(i & 1023);
            float v = 0.f;
            if (j < 4) v = p.in[22][k * 4 + j]; else if (j < 36) v = p.in[24][k * 32 + (j - 4)];
            wrt[i] = v;
        }
        float* rc = (float*)(ws + ROPE_C); float* rs = (float*)(ws + ROPE_S);
        for (size_t i = g0; i < 2048 * 16; i += gsz) {
            const int pos = (int)(i >> 4), f = (int)(i & 15);
            const float inv = powf(10000.f, -(float)f / 16.f);
            const float ang = (float)pos * inv;
            const double a = (double)ang;
            const double k2 = rint(a * 0.15915494309189535);
            const float rr = (float)(a - k2 * 6.283185307179586);
            rc[i] = cosf(rr); rs[i] = sinf(rr);
        }
    }
}

struct EpiProj {
    bf16_t *cq, *ckv, *z, *xbc, *krope; float* dt; const float *rc, *rs, *dtb;
    DI void prefetch(int, int, int) {}
    DI void operator()(const float* Cs, int m0, int n0, int tid) const {
        const int c4 = (tid & 31) * 4, r0 = tid >> 5;
        if (n0 < 1920) {
            bf16_t* dst; int ld, cofs;
            if (n0 < 256) { dst = cq; ld = 256; cofs = n0; } else if (n0 < 384) { dst = ckv; ld = 128; cofs = n0 - 256; }
            else if (n0 < 896) { dst = z; ld = 512; cofs = n0 - 384; } else { dst = xbc; ld = 1024; cofs = n0 - 896; }
#pragma unroll 4
            for (int ps = 0; ps < 16; ++ps) { const int row = ps * 8 + r0; *(uint2*)(dst + (size_t)(m0 + row) * ld + cofs + c4) = pack4(cs4(Cs, row, c4)); }
        } else {
#pragma unroll
            for (int ps = 0; ps < 4; ++ps) {
                const int it = ps * 256 + tid, row = it >> 3, cc = (it & 7) * 4, grow = m0 + row;
                const float4 v = cs4(Cs, row, cc), pv = cs4(Cs, row, cc ^ 16);
                const int pos = grow & 2047, f = cc & 15;
                const float4 c = *(const float4*)(rc + pos * 16 + f), s = *(const float4*)(rs + pos * 16 + f);
                float4 o;
                if (cc < 16) { o.x = v.x * c.x - pv.x * s.x; o.y = v.y * c.y - pv.y * s.y; o.z = v.z * c.z - pv.z * s.z; o.w = v.w * c.w - pv.w * s.w; }
                else { o.x = v.x * c.x + pv.x * s.x; o.y = v.y * c.y + pv.y * s.y; o.z = v.z * c.z + pv.z * s.z; o.w = v.w * c.w + pv.w * s.w; }
                *(uint2*)(krope + (size_t)grow * 32 + cc) = pack4(o);
            }
#pragma unroll
            for (int ps = 0; ps < 4; ++ps) {
                const int it = ps * 256 + tid, row = it >> 3, cc = it & 7;
                dt[(size_t)(m0 + row) * 8 + cc] = softplusf(Cs[row * CS_LD + 32 + cc] + dtb[cc]);
            }
        }
    }
};
struct EpiMemKV {
    bf16_t *kx, *vxt;
    DI void prefetch(int, int, int) {}
    DI void operator()(const float* Cs, int m0, int n0, int tid) const {
        const int b = m0 >> 8, mm0 = m0 & 255;
        if (n0 < 1024) {
            const int c4 = (tid & 31) * 4, r0 = tid >> 5, hd = n0 >> 8, d = (n0 & 255) + c4;
#pragma unroll 4
            for (int ps = 0; ps < 16; ++ps) { const int row = ps * 8 + r0; *(uint2*)(kx + ((size_t)(b * 4 + hd) * 256 + mm0 + row) * 256 + d) = pack4(cs4(Cs, row, c4)); }
        } else {
            const int c2 = n0 - 1024, hd = c2 >> 8;
#pragma unroll 2
            for (int ps = 0; ps < 8; ++ps) {
                const int it = ps * 256 + tid, col = it & 127, rg = it >> 7, d = (c2 & 255) + col;
                uint4 w;
                w.x = pack2(Cs[(rg * 8 + 0) * CS_LD + col], Cs[(rg * 8 + 1) * CS_LD + col]); w.y = pack2(Cs[(rg * 8 + 2) * CS_LD + col], Cs[(rg * 8 + 3) * CS_LD + col]);
                w.z = pack2(Cs[(rg * 8 + 4) * CS_LD + col], Cs[(rg * 8 + 5) * CS_LD + col]); w.w = pack2(Cs[(rg * 8 + 6) * CS_LD + col], Cs[(rg * 8 + 7) * CS_LD + col]);
                *(uint4*)(vxt + ((size_t)(b * 4 + hd) * 256 + d) * 256 + mm0 + rg * 8) = w;
            }
        }
    }
};
DI void phase_proj(const P& p, int bid, int nb, unsigned char* smem, int rep = 0) {
    unsigned char* ws = p.ws;
    const int v = vbid(bid, nb);
    const bf16_t* xb = (const bf16_t*)(ws + XB);
    EpiProj e1{(bf16_t*)(ws + CQ), (bf16_t*)(ws + CKV), (bf16_t*)(ws + ZB), (bf16_t*)(ws + XBC), (bf16_t*)(ws + KROPE), (float*)(ws + DTB),
               (const float*)(ws + ROPE_C), (const float*)(ws + ROPE_S), p.in[9]};
    EpiMemKV e2{(bf16_t*)(ws + KX), (bf16_t*)(ws + VXT)};
    constexpr int NT1 = 256 * 16, NT2 = 32 * 16;
    for (int t = v; t < NT1 + NT2; t += nb) {
        if (rep && REP_MODE == 1 && t >= NT1) continue;
        if (rep && REP_MODE == 2 && t < NT1) continue;
        if (rep && REP_MODE == 3 && !(t < NT1 && (t & 7) == 7 && ((t >> 6) & 1))) continue;
        if (rep && REP_MODE == 4 && !(t < NT1 && ((t >> 6) & 1) == 0)) continue;
        const int u = t < NT1 ? t : t - NT1, c = u >> 6, j = u & 63, mt = (c >> 1) * 8 + (j >> 3), ntl = (c & 1) * 8 + (j & 7);
        if (t < NT1) { GemmArgs g{xb, 1024, (const bf16_t*)(ws + W_IN), 1024, 1024, nullptr}; gemm_tile(g, mt * 128, ntl * 128, e1, smem); }
        else { GemmArgs g{(const bf16_t*)(ws + MEMB), 1024, (const bf16_t*)(ws + W_XKV), 1024, 1024, nullptr}; gemm_tile(g, mt * 128, ntl * 128, e2, smem); }
    }
}

struct EpiQup {
    bf16_t* q; const float *rc, *rs; const float* rms;
    DI void prefetch(int, int, int) {}
    DI void operator()(const float* Cs, int m0, int n0, int tid) const {
        const int c4 = (tid & 31) * 4, r0 = tid >> 5;
        const int col = n0 + c4, head = col / 96, d = col - head * 96;
        const bool rope = d >= 64;
        const int b = m0 >> 11, s0 = m0 & 2047;
#pragma unroll 4
        for (int ps = 0; ps < 16; ++ps) {
            const int row = ps * 8 + r0;
            const float sc = rms[row] * QSCALE;
            float4 v = cs4(Cs, row, c4);
            if (rope) {
                const float4 pv = cs4(Cs, row, c4 ^ 16);
                const int pos = s0 + row, f = d & 15;
                const float4 c = *(const float4*)(rc + pos * 16 + f), s = *(const float4*)(rs + pos * 16 + f);
                if (d < 80) { v.x = v.x * c.x - pv.x * s.x; v.y = v.y * c.y - pv.y * s.y; v.z = v.z * c.z - pv.z * s.z; v.w = v.w * c.w - pv.w * s.w; }
                else { v.x = v.x * c.x + pv.x * s.x; v.y = v.y * c.y + pv.y * s.y; v.z = v.z * c.z + pv.z * s.z; v.w = v.w * c.w + pv.w * s.w; }
            }
            v.x *= sc; v.y *= sc; v.z *= sc; v.w *= sc;
            *(uint2*)(q + ((size_t)(b * 8 + head) * 2048 + s0 + row) * 96 + d) = pack4(v);
        }
    }
};
struct EpiKVup {
    bf16_t *kn, *vt; const float* rms;
    DI void prefetch(int, int, int) {}
    DI void operator()(const float* Cs, int m0, int n0, int tid) const {
        const int head = n0 >> 7, b = m0 >> 11, s0 = m0 & 2047;
#pragma unroll 4
        for (int ps = 0; ps < 8; ++ps) {
            const int it = ps * 256 + tid, row = it >> 4, c4 = (it & 15) * 4;
            const float sc = rms[row];
            float4 v = cs4(Cs, row, c4); v.x *= sc; v.y *= sc; v.z *= sc; v.w *= sc;
            *(uint2*)(kn + ((size_t)(b * 8 + head) * 2048 + s0 + row) * 64 + c4) = pack4(v);
        }
#pragma unroll 2
        for (int ps = 0; ps < 4; ++ps) {
            const int it = ps * 256 + tid, dv = it & 63, rg = it >> 6;
            const float* cp = Cs + (rg * 8) * CS_LD + 64 + dv; const float* rp = rms + rg * 8;
            uint4 w;
            w.x = pack2(cp[0] * rp[0], cp[CS_LD] * rp[1]); w.y = pack2(cp[2 * CS_LD] * rp[2], cp[3 * CS_LD] * rp[3]);
            w.z = pack2(cp[4 * CS_LD] * rp[4], cp[5 * CS_LD] * rp[5]); w.w = pack2(cp[6 * CS_LD] * rp[6], cp[7 * CS_LD] * rp[7]);
            *(uint4*)(vt + ((size_t)(b * 8 + head) * 64 + dv) * 2048 + s0 + rg * 8) = w;
        }
    }
};
template <int K>
DI void row_rms(const bf16_t* src, int m0, float* rms) {
    const int t = tidx(), row = t >> 1, half = t & 1;
    const uint4* s4 = (const uint4*)(src + (size_t)(m0 + row) * K + half * (K / 2));
    float ss = 0.f;
#pragma unroll
    for (int i = 0; i < K / 16; ++i) {
        const uint4 w = s4[i];
        const unsigned ww[4] = {w.x, w.y, w.z, w.w};
#pragma unroll
        for (int k = 0; k < 4; ++k) { const float a = bflo(ww[k]), b = bfhi(ww[k]); ss += a * a + b * b; }
    }
    ss += __shfl_xor(ss, 1);
    __syncthreads();
    if (half == 0) rms[row] = rsqrtf(ss * (1.f / K) + EPS);
    __syncthreads();
}
DI void phase_up(const P& p, int bid, int nb, unsigned char* smem) {
    unsigned char* ws = p.ws;
    const int v = vbid(bid, nb);
    float* rms = (float*)(smem + GEMM_LDS);
    constexpr int NTQ = 256 * 6, NTKV = 256 * 8;
    for (int t = v; t < NTQ + NTKV; t += nb) {
        if (t < NTQ) {
            const int mt = t / 6, ntl = t % 6;
            row_rms<256>((const bf16_t*)(ws + CQ), mt * 128, rms);
            EpiQup e{(bf16_t*)(ws + QB), (const float*)(ws + ROPE_C), (const float*)(ws + ROPE_S), rms};
            GemmArgs g{(const bf16_t*)(ws + CQ), 256, (const bf16_t*)(ws + W_QUP), 256, 256, nullptr};
            gemm_tile(g, mt * 128, ntl * 128, e, smem);
        } else {
            const int u = t - NTQ, mt = u >> 3, ntl = u & 7;
            row_rms<128>((const bf16_t*)(ws + CKV), mt * 128, rms);
            EpiKVup e{(bf16_t*)(ws + KNB), (bf16_t*)(ws + VTB), rms};
            GemmArgs g{(const bf16_t*)(ws + CKV), 128, (const bf16_t*)(ws + W_KVUP), 128, 128, nullptr};
            gemm_tile(g, mt * 128, ntl * 128, e, smem);
        }
    }
    {
        const bf16_t* xbc = (const bf16_t*)(ws + XBC); bf16_t* xa = (bf16_t*)(ws + XBCA);
        const float* cw = p.in[7]; const float* cb = p.in[8];
        const size_t gsz = (size_t)nb * 256;
        for (size_t i = (size_t)bid * 256 + tidx(); i < (size_t)T * 128; i += gsz) {
            const int tkn = (int)(i >> 7), c0 = (int)(i & 127) * 8, s_ = tkn & 2047;
            float accv[8];
#pragma unroll
            for (int k = 0; k < 8; ++k) accv[k] = cb[c0 + k];
#pragma unroll
            for (int j = 0; j < 4; ++j) {
                if (s_ + j - 3 >= 0) {
                    const uint4 w = *(const uint4*)(xbc + (size_t)(tkn + j - 3) * 1024 + c0);
                    const unsigned ww[4] = {w.x, w.y, w.z, w.w};
#pragma unroll
                    for (int k = 0; k < 4; ++k) {
                        accv[2 * k] += cw[j * 1024 + c0 + 2 * k] * bflo(ww[k]);
                        accv[2 * k + 1] += cw[j * 1024 + c0 + 2 * k + 1] * bfhi(ww[k]);
                    }
                }
            }
            uint4 o;
            o.x = pack2(siluf(accv[0]), siluf(accv[1])); o.y = pack2(siluf(accv[2]), siluf(accv[3]));
            o.z = pack2(siluf(accv[4]), siluf(accv[5])); o.w = pack2(siluf(accv[6]), siluf(accv[7]));
            *(uint4*)(xa + (size_t)tkn * 1024 + c0) = o;
        }
    }
}

DI int perm16(int k) { return (k & ~12) | ((k & 4) << 1) | ((k & 8) >> 1); }
template <int DQK, int DVW, int KT, int NQG, int NDV>
struct FlashCfg {
    static constexpr int KSTR = (DQK + 8) * 2;
    static constexpr int VSTR = (KT + 8) * 2;
    static constexpr int DV = DVW * NDV;
    static constexpr int KBYTES = KT * KSTR, VBYTES = DV * VSTR, STAGE = KBYTES + VBYTES;
    static constexpr int KCH = KT * DQK / 8 / 256;
    static constexpr int VCH = DV * KT / 8 / 256;
    static_assert(KT * DQK / 8 % 256 == 0 && DV * KT / 8 % 256 == 0, "chunk split");
    static_assert(2 * STAGE <= GEMM_LDS + 2048 - 16, "flash LDS");
};
template <int DQK, int DVW, int KT, int NQG, int NDV, class Src>
DI void flash_item(const Src& src, int ntiles, int nskip  , unsigned char* smem) {
    typedef FlashCfg<DQK, DVW, KT, NQG, NDV> C;
    constexpr int NKS = DQK / 16, NKB = KT / 32, NDB = DVW / 32;
    int tid = tidx(); asm volatile("" : "+v"(tid));
    const int lane = tid & 63, wave = __builtin_amdgcn_readfirstlane(tid >> 6), r = lane & 31, h = lane >> 5;
    const int qg = wave / NDV, dvh = wave % NDV;
    bf16x8 qf[NKS];
    {
        const bf16_t* qp = src.qrow(qg * 32 + r) + 8 * h;
#pragma unroll
        for (int ks = 0; ks < NKS; ++ks) qf[ks] = *(const bf16x8*)(qp + 16 * ks);
    }
    f32x16 o[NDB];
#pragma unroll
    for (int d = 0; d < NDB; ++d)
#pragma unroll
        for (int e = 0; e < 16; ++e) o[d][e] = 0.f;
    float m = -1e30f, l = 0.f;
    uint4 kr[C::KCH], vr[C::VCH];
    auto gload = [&](int t) {
#pragma unroll
        for (int i = 0; i < C::KCH; ++i) { const int idx = tid + 256 * i; kr[i] = src.kload(t, idx / (DQK / 8), idx % (DQK / 8)); }
#pragma unroll
        for (int i = 0; i < C::VCH; ++i) { const int idx = tid + 256 * i; vr[i] = src.vload(t, idx / (KT / 8), idx % (KT / 8)); }
    };
    auto lstore = [&](unsigned char* buf) {
#pragma unroll
        for (int i = 0; i < C::KCH; ++i) { const int idx = tid + 256 * i; *(uint4*)(buf + (idx / (DQK / 8)) * C::KSTR + (idx % (DQK / 8)) * 16) = kr[i]; }
#pragma unroll
        for (int i = 0; i < C::VCH; ++i) {
            const int idx = tid + 256 * i, dv = idx / (KT / 8), c = idx % (KT / 8);
            unsigned char* row = buf + C::KBYTES + dv * C::VSTR + (c >> 1) * 32;
            const int a = c & 1;
            *(uint2*)(row + (4 * a) * 2) = make_uint2(vr[i].x, vr[i].y);
            *(uint2*)(row + (8 + 4 * a) * 2) = make_uint2(vr[i].z, vr[i].w);
        }
    };
    gload(0);
    __syncthreads();
    lstore(smem);
    __syncthreads();
    for (int t = 0; t < ntiles; ++t) {
        const unsigned char* cur = smem + (t & 1) * C::STAGE;
        const bool more = (t + 1 < ntiles);
        if (more) gload(t + 1);
        if (!(t == ntiles - 1 && qg < nskip)) {
            f32x16 s[NKB];
#pragma unroll
            for (int kb = 0; kb < NKB; ++kb) {
#pragma unroll
                for (int e = 0; e < 16; ++e) s[kb][e] = 0.f;
                const unsigned char* kp = cur + (kb * 32 + r) * C::KSTR + h * 16;
#pragma unroll
                for (int ks = 0; ks < NKS; ++ks) s[kb] = MFMA32(*(const bf16x8*)(kp + ks * 32), qf[ks], s[kb]);
            }
            float mx = s[0][0];
#pragma unroll
            for (int kb = 0; kb < NKB; ++kb)
#pragma unroll
                for (int e = 0; e < 16; ++e) mx = fmaxf(mx, s[kb][e]);
            mx = fmaxf(mx, __shfl_xor(mx, 32));
            const float mn = fmaxf(m, mx);
            const float alpha = __builtin_amdgcn_exp2f(m - mn);
            m = mn;
            float ps = 0.f;
#pragma unroll
            for (int kb = 0; kb < NKB; ++kb)
#pragma unroll
                for (int e = 0; e < 16; ++e) { const float pv = __builtin_amdgcn_exp2f(s[kb][e] - mn); s[kb][e] = pv; ps += pv; }
            l = l * alpha + ps;
#pragma unroll
            for (int d = 0; d < NDB; ++d)
#pragma unroll
                for (int e = 0; e < 16; ++e) o[d][e] *= alpha;
#pragma unroll
            for (int kb = 0; kb < NKB; ++kb)
#pragma unroll
                for (int s2 = 0; s2 < 2; ++s2) {
                    uint4 pk;
                    pk.x = pack2(s[kb][8 * s2], s[kb][8 * s2 + 1]); pk.y = pack2(s[kb][8 * s2 + 2], s[kb][8 * s2 + 3]);
                    pk.z = pack2(s[kb][8 * s2 + 4], s[kb][8 * s2 + 5]); pk.w = pack2(s[kb][8 * s2 + 6], s[kb][8 * s2 + 7]);
                    const bf16x8 pf = __builtin_bit_cast(bf16x8, pk);
                    const unsigned char* vp = cur + C::KBYTES + (dvh * DVW + r) * C::VSTR + (kb * 32 + s2 * 16 + 8 * h) * 2;
#pragma unroll
                    for (int d = 0; d < NDB; ++d) o[d] = MFMA32(*(const bf16x8*)(vp + d * 32 * C::VSTR), pf, o[d]);
                }
        }
        if (more) lstore(smem + ((t + 1) & 1) * C::STAGE);
        __syncthreads();
    }
    l += __shfl_xor(l, 32);
    const float il = 1.f / l;
#pragma unroll
    for (int d = 0; d < NDB; ++d)
#pragma unroll
        for (int g4 = 0; g4 < 4; ++g4) {
            uint2 w; w.x = pack2(o[d][4 * g4] * il, o[d][4 * g4 + 1] * il); w.y = pack2(o[d][4 * g4 + 2] * il, o[d][4 * g4 + 3] * il);
            src.store(qg * 32 + r, dvh * DVW + d * 32 + 8 * g4 + 4 * h, w);
        }
}
struct SelfSrc {
    const bf16_t *q, *kn, *kr, *vt; bf16_t* mix; int b, hd, bh, q0;
    DI const bf16_t* qrow(int rr) const { return q + ((size_t)bh * 2048 + q0 + rr) * 96; }
    DI uint4 kload(int t, int key, int c) const {
        const int kg = t * 64 + key;
        return c < 8 ? *(const uint4*)(kn + ((size_t)bh * 2048 + kg) * 64 + c * 8) : *(const uint4*)(kr + ((size_t)b * 2048 + kg) * 32 + (c - 8) * 8);
    }
    DI uint4 vload(int t, int dv, int c) const { return *(const uint4*)(vt + ((size_t)bh * 64 + dv) * 2048 + t * 64 + c * 8); }
    DI void store(int rr, int dv, uint2 w) const { *(uint2*)(mix + ((size_t)b * 2048 + q0 + rr) * 1024 + hd * 64 + dv) = w; }
};
struct CrossSrc {
    const bf16_t *qx, *kx, *vxt; bf16_t* ox; int b, hd, q0;
    DI const bf16_t* qrow(int rr) const { return qx + ((size_t)(b * 4 + hd) * 2048 + q0 + rr) * 256; }
    DI uint4 kload(int t, int key, int c) const { return *(const uint4*)(kx + ((size_t)(b * 4 + hd) * 256 + t * 32 + key) * 256 + c * 8); }
    DI uint4 vload(int t, int dv, int c) const { return *(const uint4*)(vxt + ((size_t)(b * 4 + hd) * 256 + dv) * 256 + t * 32 + c * 8); }
    DI void store(int rr, int dv, uint2 w) const { *(uint2*)(ox + ((size_t)b * 2048 + q0 + rr) * 1024 + hd * 256 + dv) = w; }
};
DI void attn_fast(const P& p, int bid, int nb, unsigned char* smem) {
    unsigned char* ws = p.ws;
    const int nround = (2048 + nb - 1) / nb;
    for (int rd = 0; rd < nround; ++rd) {
        const int idx = rd * nb + ((rd & 1) ? (nb - 1 - bid) : bid);
        if (idx >= 2048) continue;
        const int qb = 15 - (idx >> 7), bh = idx & 127;
        SelfSrc s{(const bf16_t*)(ws + QB), (const bf16_t*)(ws + KNB), (const bf16_t*)(ws + KROPE), (const bf16_t*)(ws + VTB), (bf16_t*)(ws + MIX), bh >> 3, bh & 7, bh, qb * 128};
        flash_item<96, 64, 64, 4, 1>(s, 2 * qb + 2, 2, smem);
    }
}
DI void xattn_fast(const P& p, int bid, int nb, unsigned char* smem) {
    unsigned char* ws = p.ws;
    for (int it = bid; it < 2048; it += nb) {
        const int bhd = it >> 5, qt = it & 31;
        CrossSrc s{(const bf16_t*)(ws + QX), (const bf16_t*)(ws + KX), (const bf16_t*)(ws + VXT), (bf16_t*)(ws + OX), bhd >> 2, bhd & 3, qt * 64};
        flash_item<256, 128, 32, 2, 2>(s, 8, 0, smem);
    }
}

constexpr int SSD_XT = 0, SSD_BM = 8192, SSD_CM = SSD_BM + 16384, SSD_BWT = SSD_CM + 16384, SSD_PS = SSD_BWT + 16384, SSD_F = SSD_PS + 16384;
static_assert(SSD_F + 1024 <= GEMM_LDS + 2048 - 16, "ssd LDS");
DI int off256(int row, int el) { return row * 256 + (((el >> 3) ^ (row & 15)) << 4) + ((el & 7) << 1); }
DI int off128(int row, int el) { return row * 128 + (((el >> 3) ^ ((row >> 1) & 7)) << 4) + ((el & 7) << 1); }
DI void ssd_item(const P& p, int bh, unsigned char* smem) {
    unsigned char* ws = p.ws;
    const bf16_t* xa = (const bf16_t*)(ws + XBCA); const float* dtg = (const float*)(ws + DTB);
    bf16_t* mix = (bf16_t*)(ws + MIX);
    int tid0 = tidx(); asm volatile("" : "+v"(tid0));
    const int wave = __builtin_amdgcn_readfirstlane(tid0 >> 6);
    const int b = bh >> 3, hd = bh & 7, g = hd >> 2;
    const int lb = wave >> 1, pb = wave & 1;
    const float a_h = -__expf(p.in[10][hd]), Dh = p.in[11][hd];
    float* F = (float*)(smem + SSD_F);
    __syncthreads();
    for (int i = tid0; i < 16384 / 16; i += 256) *(uint4*)(smem + SSD_PS + i * 16) = make_uint4(0u, 0u, 0u, 0u);
    f32x16 st[2];
#pragma unroll
    for (int i = 0; i < 2; ++i)
#pragma unroll
        for (int e = 0; e < 16; ++e) st[i][e] = 0.f;
    uint4 xr0, xr1, br0, br1, br2, br3, cr0, cr1, cr2, cr3; float dtr = 0.f;
#define SSD_XLD(i) (*(const uint4*)(xa + (t0_ + ((tid + 256 * (i)) >> 3)) * 1024 + hd * 64 + ((tid + 256 * (i)) & 7) * 8))
#define SSD_BLD(i, o) (*(const uint4*)(xa + (t0_ + ((tid + 256 * (i)) >> 4)) * 1024 + (o) + g * 128 + ((tid + 256 * (i)) & 15) * 8))
#define SSD_GLOAD(c_) do { const size_t t0_ = (size_t)b * 2048 + (c_) * 64; xr0 = SSD_XLD(0); xr1 = SSD_XLD(1); \
        br0 = SSD_BLD(0, 512); br1 = SSD_BLD(1, 512); br2 = SSD_BLD(2, 512); br3 = SSD_BLD(3, 512); \
        cr0 = SSD_BLD(0, 768); cr1 = SSD_BLD(1, 768); cr2 = SSD_BLD(2, 768); cr3 = SSD_BLD(3, 768); \
        if (tid < 64) dtr = dtg[(t0_ + tid) * 8 + hd]; } while (0)
    { const int tid = tid0; SSD_GLOAD(0); }
    for (int c = 0; c < 32; ++c) {
        int tid = tid0; asm volatile("" : "+v"(tid));
        const int lane = tid & 63, r = lane & 31, h = lane >> 5;
        const size_t t0 = (size_t)b * 2048 + c * 64;
        if (wave == 0) {
            float v = dtr * a_h;
#pragma unroll
            for (int o = 1; o < 64; o <<= 1) { const float u = __shfl_up(v, o); if (lane >= o) v += u; }
            const float a63 = __shfl(v, 63);
            F[lane] = v; F[64 + lane] = __expf(v); F[128 + lane] = dtr; F[192 + lane] = __expf(a63 - v) * dtr;
        }
        __syncthreads();
#define SSD_XIMG(i, XR) do { const int idx = tid + 256 * (i), l = idx >> 3, p0 = (idx & 7) * 8, lp = perm16(l); \
            const unsigned ww[4] = {XR.x, XR.y, XR.z, XR.w}; \
            _Pragma("unroll") for (int k = 0; k < 4; ++k) { \
                *(bf16_t*)(smem + SSD_XT + off128(p0 + 2 * k, lp)) = (bf16_t)(ww[k] & 0xffffu); \
                *(bf16_t*)(smem + SSD_XT + off128(p0 + 2 * k + 1, lp)) = (bf16_t)(ww[k] >> 16); } } while (0)
#define SSD_BIMG(i, BR, CR) do { const int idx = tid + 256 * (i), l = idx >> 4, n0 = (idx & 15) * 8, lp = perm16(l); \
            *(uint4*)(smem + SSD_BM + off256(l, n0)) = BR; *(uint4*)(smem + SSD_CM + off256(l, n0)) = CR; \
            const float wl = F[192 + l]; const unsigned ww[4] = {BR.x, BR.y, BR.z, BR.w}; \
            _Pragma("unroll") for (int k = 0; k < 4; ++k) { \
                *(bf16_t*)(smem + SSD_BWT + off128(n0 + 2 * k, lp)) = f2bf(bflo(ww[k]) * wl); \
                *(bf16_t*)(smem + SSD_BWT + off128(n0 + 2 * k + 1, lp)) = f2bf(bfhi(ww[k]) * wl); } } while (0)
        SSD_XIMG(0, xr0); SSD_XIMG(1, xr1);
        SSD_BIMG(0, br0, cr0); SSD_BIMG(1, br1, cr1); SSD_BIMG(2, br2, cr2); SSD_BIMG(3, br3, cr3);
        __syncthreads();
        if (c + 1 < 32) SSD_GLOAD(c + 1);
        f32x16 yd;
#pragma unroll
        for (int e = 0; e < 16; ++e) yd[e] = 0.f;
        const float acs_l = F[lb * 32 + r];
        const int lrow = lb * 32 + r;
        for (int sb = 0; sb <= lb; ++sb) {
            f32x16 cb;
#pragma unroll
            for (int e = 0; e < 16; ++e) cb[e] = 0.f;
#pragma unroll
            for (int ks = 0; ks < 8; ++ks) {
                const bf16x8 av = *(const bf16x8*)(smem + SSD_BM + off256(sb * 32 + r, 16 * ks + 8 * h));
                const bf16x8 bv = *(const bf16x8*)(smem + SSD_CM + off256(lb * 32 + r, 16 * ks + 8 * h));
                cb = MFMA32(av, bv, cb);
            }
            float mv[16];
#pragma unroll
            for (int q4 = 0; q4 < 4; ++q4) {
                const int s0 = sb * 32 + 8 * q4 + 4 * h;
                const float4 as4 = *(const float4*)(F + s0), dt4 = *(const float4*)(F + 128 + s0);
                const float asv[4] = {as4.x, as4.y, as4.z, as4.w}, dtv[4] = {dt4.x, dt4.y, dt4.z, dt4.w};
#pragma unroll
                for (int k = 0; k < 4; ++k) mv[4 * q4 + k] = (s0 + k <= lrow) ? cb[4 * q4 + k] * __expf(acs_l - asv[k]) * dtv[k] : 0.f;
            }
#pragma unroll
            for (int s2 = 0; s2 < 2; ++s2) {
                uint4 pk;
                pk.x = pack2(mv[8 * s2], mv[8 * s2 + 1]); pk.y = pack2(mv[8 * s2 + 2], mv[8 * s2 + 3]);
                pk.z = pack2(mv[8 * s2 + 4], mv[8 * s2 + 5]); pk.w = pack2(mv[8 * s2 + 6], mv[8 * s2 + 7]);
                const bf16x8 xb = *(const bf16x8*)(smem + SSD_XT + off128(pb * 32 + r, sb * 32 + 16 * s2 + 8 * h));
                yd = MFMA32(__builtin_bit_cast(bf16x8, pk), xb, yd);
            }
        }
        f32x16 yo;
#pragma unroll
        for (int e = 0; e < 16; ++e) yo[e] = 0.f;
#pragma unroll
        for (int ks = 0; ks < 8; ++ks) {
            const bf16x8 av = *(const bf16x8*)(smem + SSD_CM + off256(lb * 32 + r, 16 * ks + 8 * h));
            const bf16x8 bv = *(const bf16x8*)(smem + SSD_PS + off256(pb * 32 + r, 16 * ks + 8 * h));
            yo = MFMA32(av, bv, yo);
        }
        {
            const uint4 x0 = *(const uint4*)(smem + SSD_XT + off128(pb * 32 + r, lb * 32 + 8 * h));
            const uint4 x1 = *(const uint4*)(smem + SSD_XT + off128(pb * 32 + r, lb * 32 + 16 + 8 * h));
            const unsigned xw[8] = {x0.x, x0.y, x0.z, x0.w, x1.x, x1.y, x1.z, x1.w};
            bf16_t* op = mix + (t0 + lb * 32 + 4 * h) * 1024 + 512 + hd * 64 + pb * 32 + r;
#pragma unroll
            for (int q4 = 0; q4 < 4; ++q4) {
                const float4 ea4 = *(const float4*)(F + 64 + lb * 32 + 8 * q4 + 4 * h);
                const float eav[4] = {ea4.x, ea4.y, ea4.z, ea4.w};
#pragma unroll
                for (int k = 0; k < 4; ++k) {
                    const int e = 4 * q4 + k;
                    const float xv = (e & 1) ? bfhi(xw[e >> 1]) : bflo(xw[e >> 1]);
                    const float y = yd[e] + eav[k] * yo[e] + Dh * xv;
                    op[(size_t)(k + 8 * q4) * 1024] = f2bf(y);
                }
            }
        }
        {
            const float dec = F[64 + 63];
#pragma unroll
            for (int i = 0; i < 2; ++i) {
#pragma unroll
                for (int e = 0; e < 16; ++e) st[i][e] *= dec;
                const int nblk = 2 * (wave >> 1) + i;
#pragma unroll
                for (int ks = 0; ks < 4; ++ks) {
                    const bf16x8 av = *(const bf16x8*)(smem + SSD_XT + off128(pb * 32 + r, 16 * ks + 8 * h));
                    const bf16x8 bv = *(const bf16x8*)(smem + SSD_BWT + off128(nblk * 32 + r, 16 * ks + 8 * h));
                    st[i] = MFMA32(av, bv, st[i]);
                }
            }
        }
        __syncthreads();
#pragma unroll
        for (int i = 0; i < 2; ++i) {
            const int n = (2 * (wave >> 1) + i) * 32 + r;
#pragma unroll
            for (int e = 0; e < 16; ++e) *(bf16_t*)(smem + SSD_PS + off256(pb * 32 + crow(e, h), n)) = f2bf(st[i][e]);
        }
    }
    __syncthreads();
}

#if ATTN_NAIVE
DI void attn_naive(const P& p, int bid, int nb) {
    unsigned char* ws = p.ws;
    const bf16_t* Q = (const bf16_t*)(ws + QB); const bf16_t* Kn = (const bf16_t*)(ws + KNB); const bf16_t* Vt = (const bf16_t*)(ws + VTB);
    const bf16_t* Kr = (const bf16_t*)(ws + KROPE); bf16_t* mix = (bf16_t*)(ws + MIX);
    for (int item = bid; item < 128 * 8; item += nb) {
        const int bh = item >> 3, s_ = (item & 7) * 256 + tidx(), b = bh >> 3, hd = bh & 7;
        float q[96];
        {
            const uint4* q4 = (const uint4*)(Q + ((size_t)bh * 2048 + s_) * 96);
#pragma unroll
            for (int i = 0; i < 12; ++i) { const uint4 w = q4[i]; q[8 * i] = bflo(w.x); q[8 * i + 1] = bfhi(w.x); q[8 * i + 2] = bflo(w.y); q[8 * i + 3] = bfhi(w.y);
                q[8 * i + 4] = bflo(w.z); q[8 * i + 5] = bfhi(w.z); q[8 * i + 6] = bflo(w.w); q[8 * i + 7] = bfhi(w.w); }
        }
        float o[64];
#pragma unroll
        for (int d = 0; d < 64; ++d) o[d] = 0.f;
        float m = -1e30f, l = 0.f;
        const int nkeys = __builtin_amdgcn_readfirstlane(((s_ >> 6) + 1) * 64);
        for (int j0 = 0; j0 < nkeys; j0 += 8) {
            float sc[8];
#pragma unroll
            for (int jj = 0; jj < 8; ++jj) {
                const int j = j0 + jj;
                const uint4* k4 = (const uint4*)(Kn + ((size_t)bh * 2048 + j) * 64);
                const uint4* r4 = (const uint4*)(Kr + ((size_t)b * 2048 + j) * 32);
                float a = 0.f;
#pragma unroll
                for (int i = 0; i < 8; ++i) { const uint4 w = k4[i]; a += q[8 * i] * bflo(w.x) + q[8 * i + 1] * bfhi(w.x) + q[8 * i + 2] * bflo(w.y) + q[8 * i + 3] * bfhi(w.y)
                    + q[8 * i + 4] * bflo(w.z) + q[8 * i + 5] * bfhi(w.z) + q[8 * i + 6] * bflo(w.w) + q[8 * i + 7] * bfhi(w.w); }
#pragma unroll
                for (int i = 0; i < 4; ++i) { const uint4 w = r4[i]; const int o8 = 64 + 8 * i; a += q[o8] * bflo(w.x) + q[o8 + 1] * bfhi(w.x) + q[o8 + 2] * bflo(w.y) + q[o8 + 3] * bfhi(w.y)
                    + q[o8 + 4] * bflo(w.z) + q[o8 + 5] * bfhi(w.z) + q[o8 + 6] * bflo(w.w) + q[o8 + 7] * bfhi(w.w); }
                sc[jj] = a;
            }
            float mx = m;
#pragma unroll
            for (int jj = 0; jj < 8; ++jj) mx = fmaxf(mx, sc[jj]);
            const float al = exp2f(m - mx);
            float ps = 0.f;
#pragma unroll
            for (int jj = 0; jj < 8; ++jj) { sc[jj] = exp2f(sc[jj] - mx); ps += sc[jj]; }
            l = l * al + ps; m = mx;
#pragma unroll
            for (int d = 0; d < 64; ++d) {
                const uint4 w = *(const uint4*)(Vt + ((size_t)bh * 64 + d) * 2048 + j0);
                o[d] = o[d] * al + sc[0] * bflo(w.x) + sc[1] * bfhi(w.x) + sc[2] * bflo(w.y) + sc[3] * bfhi(w.y) + sc[4] * bflo(w.z) + sc[5] * bfhi(w.z) + sc[6] * bflo(w.w) + sc[7] * bfhi(w.w);
            }
        }
        const float il = 1.f / l;
        bf16_t* dst = mix + ((size_t)b * 2048 + s_) * 1024 + hd * 64;
#pragma unroll
        for (int d = 0; d < 64; d += 2) *(unsigned*)(dst + d) = pack2(o[d] * il, o[d + 1] * il);
    }
}
#endif
#if SSD_NAIVE
DI void ssd_naive(const P& p, int bid, int nb) {
    unsigned char* ws = p.ws;
    const bf16_t* xa = (const bf16_t*)(ws + XBCA); const float* dt = (const float*)(ws + DTB); const bf16_t* z = (const bf16_t*)(ws + ZB);
    bf16_t* mix = (bf16_t*)(ws + MIX);
    const int wave = tidx() >> 6, pp = tidx() & 63;
    for (int item = bid; item < 32; item += nb) {
        const int bh = item * 4 + wave, b = bh >> 3, hd = bh & 7, g = hd >> 2;
        const float a = -__expf(p.in[10][hd]), Dh = p.in[11][hd];
        float st[128];
#pragma unroll
        for (int n = 0; n < 128; ++n) st[n] = 0.f;
        for (int t = 0; t < 2048; ++t) {
            const size_t row = (size_t)b * 2048 + t;
            const float dtv = dt[row * 8 + hd];
            const float da = __expf(dtv * a);
            const float xv = bf2f(xa[row * 1024 + hd * 64 + pp]);
            const float xd = dtv * xv;
            const uint4* b4 = (const uint4*)(xa + row * 1024 + 512 + g * 128);
            const uint4* c4 = (const uint4*)(xa + row * 1024 + 768 + g * 128);
            float y = 0.f;
#pragma unroll
            for (int i = 0; i < 16; ++i) {
                const uint4 bw = b4[i], cw = c4[i];
                const unsigned bb[4] = {bw.x, bw.y, bw.z, bw.w}, cc[4] = {cw.x, cw.y, cw.z, cw.w};
#pragma unroll
                for (int k = 0; k < 4; ++k) {
                    const int n = 8 * i + 2 * k;
                    st[n] = da * st[n] + xd * bflo(bb[k]); y += bflo(cc[k]) * st[n];
                    st[n + 1] = da * st[n + 1] + xd * bfhi(bb[k]); y += bfhi(cc[k]) * st[n + 1];
                }
            }
            y += Dh * xv;
            const float zv = bf2f(z[row * 512 + hd * 64 + pp]);
            mix[row * 1024 + 512 + hd * 64 + pp] = f2bf(y * siluf(zv));
        }
    }
}
#endif
DI void phase_mixer(const P& p, int bid, int nb, unsigned char* smem, int rep = 0) {
#if SSD_NAIVE
    ssd_naive(p, bid, nb);
    attn_fast(p, bid, nb, smem);
#else
    unsigned* ctr = (unsigned*)(p.ws + CTL + CTL_QUEUE) + 64 * rep;
    int* slot = (int*)(smem + GEMM_LDS + 2048 - 32);
    for (;;) {
        __syncthreads();
        if (tidx() == 0) *slot = (int)atomicAdd(ctr, 1u);
        __syncthreads();
        const int it = *slot;
        if (it >= 128 + 2048) break;
        if (it < 128) { if (!NO_SSD && !(rep && REP_MODE == 2)) ssd_item(p, it, smem); }
        else if (rep && REP_MODE == 1) {   }
        else {
            const int idx = it - 128, qb = 15 - (idx >> 7), bh = idx & 127;
            unsigned char* ws = p.ws;
            SelfSrc s{(const bf16_t*)(ws + QB), (const bf16_t*)(ws + KNB), (const bf16_t*)(ws + KROPE), (const bf16_t*)(ws + VTB), (bf16_t*)(ws + MIX), bh >> 3, bh & 7, bh, qb * 128};
            if (!NO_FLASH) flash_item<96, 64, 64, 4, 1>(s, 2 * qb + 2, 2, smem);
        }
    }
#endif
}

DI void phase_ssdnorm(const P& p, int bid, int nb, unsigned char* smem) {
    bf16_t* mix = (bf16_t*)(p.ws + MIX); const bf16_t* z = (const bf16_t*)(p.ws + ZB);
    const int lane = tidx() & 63, wave = tidx() >> 6;
    for (int tk = bid * 4 + wave; tk < T; tk += nb * 4) {
        uint4* ptr = (uint4*)(mix + (size_t)tk * 1024 + 512 + lane * 8);
        const uint4 w = *ptr, zz = *(const uint4*)(z + (size_t)tk * 512 + lane * 8);
        const unsigned ww[4] = {w.x, w.y, w.z, w.w}, zw[4] = {zz.x, zz.y, zz.z, zz.w};
        float v[8]; float ss = 0.f;
#pragma unroll
        for (int k = 0; k < 4; ++k) {
            v[2 * k] = bflo(ww[k]) * siluf(bflo(zw[k])); v[2 * k + 1] = bfhi(ww[k]) * siluf(bfhi(zw[k]));
            ss += v[2 * k] * v[2 * k] + v[2 * k + 1] * v[2 * k + 1];
        }
#pragma unroll
        for (int o = 16; o >= 1; o >>= 1) ss += __shfl_xor(ss, o);
        const float rr = rsqrtf(ss * (1.f / 256.f) + EPS);
        uint4 o4; o4.x = pack2(v[0] * rr, v[1] * rr); o4.y = pack2(v[2] * rr, v[3] * rr); o4.z = pack2(v[4] * rr, v[5] * rr); o4.w = pack2(v[6] * rr, v[7] * rr);
        *ptr = o4;
    }
}

struct EpiResid {
    float* pre; const float* res;
    float4 pf[16];
    DI void prefetch(int m0, int n0, int tid) {
        const int c4 = (tid & 31) * 4, r0 = tid >> 5;
#pragma unroll
        for (int ps = 0; ps < 16; ++ps) pf[ps] = *(const float4*)(res + (size_t)(m0 + ps * 8 + r0) * 1024 + n0 + c4);
    }
    DI void operator()(const float* Cs, int m0, int n0, int tid) const {
        const int c4 = (tid & 31) * 4, r0 = tid >> 5;
#pragma unroll
        for (int ps = 0; ps < 16; ++ps) {
            const int row = ps * 8 + r0;
            const float4 v = cs4(Cs, row, c4), rr = pf[ps];
            *(float4*)(pre + (size_t)(m0 + row) * 1024 + n0 + c4) = make_float4(ALPHA * rr.x + v.x, ALPHA * rr.y + v.y, ALPHA * rr.z + v.z, ALPHA * rr.w + v.w);
        }
    }
};
DI void phase_wout(const P& p, int bid, int nb, unsigned char* smem) {
    const int v = vbid(bid, nb);
    EpiResid e; e.pre = p.out; e.res = p.in[0];
    GemmArgs g{(const bf16_t*)(p.ws + MIX), 1024, (const bf16_t*)(p.ws + W_OUT), 1024, 1024, nullptr};
    for (int t = v; t < 256 * 8; t += nb) gemm_tile(g, (t >> 3) * 128, (t & 7) * 128, e, smem);
}
DI void ln_row(const float* src, const float* gam, const float* bet, int lane, float (&o)[16]) {
    float v[16];
#pragma unroll
    for (int i = 0; i < 4; ++i) { const float4 t4 = *(const float4*)(src + i * 256 + lane * 4); v[4 * i] = t4.x; v[4 * i + 1] = t4.y; v[4 * i + 2] = t4.z; v[4 * i + 3] = t4.w; }
    float s = 0.f;
#pragma unroll
    for (int i = 0; i < 16; ++i) s += v[i];
    const float mu = wave_sum(s) * (1.f / 1024.f);
    float q = 0.f;
#pragma unroll
    for (int i = 0; i < 16; ++i) { const float d = v[i] - mu; q += d * d; }
    const float rstd = rsqrtf(wave_sum(q) * (1.f / 1024.f) + EPS);
#pragma unroll
    for (int i = 0; i < 4; ++i) {
        const float4 g4 = *(const float4*)(gam + i * 256 + lane * 4), b4 = *(const float4*)(bet + i * 256 + lane * 4);
        o[4 * i] = (v[4 * i] - mu) * rstd * g4.x + b4.x; o[4 * i + 1] = (v[4 * i + 1] - mu) * rstd * g4.y + b4.y;
        o[4 * i + 2] = (v[4 * i + 2] - mu) * rstd * g4.z + b4.z; o[4 * i + 3] = (v[4 * i + 3] - mu) * rstd * g4.w + b4.w;
    }
}
DI void ln_stats2(const float (&va)[16], const float (&vb)[16], float& mua, float& rsa, float& mub, float& rsb) {
    float sa = 0.f, sb = 0.f;
#pragma unroll
    for (int i = 0; i < 16; ++i) { sa += va[i]; sb += vb[i]; }
#pragma unroll
    for (int o = 32; o >= 1; o >>= 1) { sa += __shfl_xor(sa, o); sb += __shfl_xor(sb, o); }
    mua = sa * (1.f / 1024.f); mub = sb * (1.f / 1024.f);
    float qa = 0.f, qb = 0.f;
#pragma unroll
    for (int i = 0; i < 16; ++i) { const float da = va[i] - mua, db = vb[i] - mub; qa += da * da; qb += db * db; }
#pragma unroll
    for (int o = 32; o >= 1; o >>= 1) { qa += __shfl_xor(qa, o); qb += __shfl_xor(qb, o); }
    rsa = rsqrtf(qa * (1.f / 1024.f) + EPS); rsb = rsqrtf(qb * (1.f / 1024.f) + EPS);
}
DI void load_row16(const float* src, int lane, float (&v)[16]) {
#pragma unroll
    for (int i = 0; i < 4; ++i) { const float4 t4 = *(const float4*)(src + i * 256 + lane * 4); v[4 * i] = t4.x; v[4 * i + 1] = t4.y; v[4 * i + 2] = t4.z; v[4 * i + 3] = t4.w; }
}
DI void phase_ln1(const P& p, int bid, int nb, unsigned char* smem) {
    const int lane = tidx() & 63, wave = tidx() >> 6;
    float* hf = (float*)(p.ws + H1); bf16_t* hb = (bf16_t*)(p.ws + H1B);
    const float* gam = p.in[14]; const float* bet = p.in[15];
    for (int tk = bid * 4 + wave; tk < T; tk += nb * 8) {
        const int tk2 = tk + nb * 4;
        float va[16], vb[16], mua, rsa, mub, rsb;
        load_row16(p.out + (size_t)tk * 1024, lane, va); load_row16(p.out + (size_t)tk2 * 1024, lane, vb);
        ln_stats2(va, vb, mua, rsa, mub, rsb);
#pragma unroll
        for (int i = 0; i < 4; ++i) {
            const float4 g4 = *(const float4*)(gam + i * 256 + lane * 4), b4 = *(const float4*)(bet + i * 256 + lane * 4);
            const float4 oa = make_float4((va[4 * i] - mua) * rsa * g4.x + b4.x, (va[4 * i + 1] - mua) * rsa * g4.y + b4.y, (va[4 * i + 2] - mua) * rsa * g4.z + b4.z, (va[4 * i + 3] - mua) * rsa * g4.w + b4.w);
            const float4 ob = make_float4((vb[4 * i] - mub) * rsb * g4.x + b4.x, (vb[4 * i + 1] - mub) * rsb * g4.y + b4.y, (vb[4 * i + 2] - mub) * rsb * g4.z + b4.z, (vb[4 * i + 3] - mub) * rsb * g4.w + b4.w);
            *(float4*)(hf + (size_t)tk * 1024 + i * 256 + lane * 4) = oa; *(float4*)(hf + (size_t)tk2 * 1024 + i * 256 + lane * 4) = ob;
            *(uint2*)(hb + (size_t)tk * 1024 + i * 256 + lane * 4) = pack4(oa); *(uint2*)(hb + (size_t)tk2 * 1024 + i * 256 + lane * 4) = pack4(ob);
        }
    }
}
struct EpiXq {
    bf16_t* qx;
    DI void prefetch(int, int, int) {}
    DI void operator()(const float* Cs, int m0, int n0, int tid) const {
        const int c4 = (tid & 31) * 4, r0 = tid >> 5, hd = n0 >> 8, d = (n0 & 255) + c4, b = m0 >> 11, s0 = m0 & 2047;
#pragma unroll 4
        for (int ps = 0; ps < 16; ++ps) {
            const int row = ps * 8 + r0;
            float4 v = cs4(Cs, row, c4); v.x *= XSCALE; v.y *= XSCALE; v.z *= XSCALE; v.w *= XSCALE;
            *(uint2*)(qx + ((size_t)(b * 4 + hd) * 2048 + s0 + row) * 256 + d) = pack4(v);
        }
    }
};
DI void phase_xq(const P& p, int bid, int nb, unsigned char* smem) {
    const int v = vbid(bid, nb);
    EpiXq e{(bf16_t*)(p.ws + QX)};
    GemmArgs g{(const bf16_t*)(p.ws + H1B), 1024, (const bf16_t*)(p.ws + W_XQ), 1024, 1024, nullptr};
    for (int t = v; t < 256 * 8; t += nb) gemm_tile(g, (t >> 3) * 128, (t & 7) * 128, e, smem);
}
DI void phase_xattn(const P& p, int bid, int nb, unsigned char* smem) {
#if !XATTN_NAIVE
    xattn_fast(p, bid, nb, smem); return;
#endif
    unsigned char* ws = p.ws;
    const bf16_t* qx = (const bf16_t*)(ws + QX); const bf16_t* kx = (const bf16_t*)(ws + KX); const bf16_t* vxt = (const bf16_t*)(ws + VXT);
    bf16_t* ox = (bf16_t*)(ws + OX);
    const int lane = tidx() & 63, hd = tidx() >> 6;
    float* qs = (float*)smem + hd * 512; float* ps = qs + 256;
    for (int tk = bid; tk < T; tk += nb) {
        const int b = tk >> 11, s_ = tk & 2047;
        __syncthreads();
        {
            const uint2 w = *(const uint2*)(qx + ((size_t)(b * 4 + hd) * 2048 + s_) * 256 + lane * 4);
            qs[lane * 4] = bflo(w.x); qs[lane * 4 + 1] = bfhi(w.x); qs[lane * 4 + 2] = bflo(w.y); qs[lane * 4 + 3] = bfhi(w.y);
        }
        __syncthreads();
        float sc[4];
#pragma unroll
        for (int i = 0; i < 4; ++i) {
            const int m = lane + 64 * i;
            const uint4* k4 = (const uint4*)(kx + ((size_t)(b * 4 + hd) * 256 + m) * 256);
            float a = 0.f;
#pragma unroll 8
            for (int c = 0; c < 32; ++c) {
                const uint4 w = k4[c];
                const float4 q0 = *(const float4*)(qs + 8 * c), q1 = *(const float4*)(qs + 8 * c + 4);
                a += q0.x * bflo(w.x) + q0.y * bfhi(w.x) + q0.z * bflo(w.y) + q0.w * bfhi(w.y) + q1.x * bflo(w.z) + q1.y * bfhi(w.z) + q1.z * bflo(w.w) + q1.w * bfhi(w.w);
            }
            sc[i] = a;
        }
        const float mx = wave_max(fmaxf(fmaxf(sc[0], sc[1]), fmaxf(sc[2], sc[3])));
        float sum = 0.f;
#pragma unroll
        for (int i = 0; i < 4; ++i) { sc[i] = exp2f(sc[i] - mx); sum += sc[i]; }
        const float il = 1.f / wave_sum(sum);
#pragma unroll
        for (int i = 0; i < 4; ++i) ps[lane + 64 * i] = sc[i] * il;
        __syncthreads();
        float o[4];
#pragma unroll
        for (int dd = 0; dd < 4; ++dd) {
            const int d = lane * 4 + dd;
            const uint4* v4 = (const uint4*)(vxt + ((size_t)(b * 4 + hd) * 256 + d) * 256);
            float a = 0.f;
#pragma unroll 8
            for (int c = 0; c < 32; ++c) {
                const uint4 w = v4[c];
                const float4 q0 = *(const float4*)(ps + 8 * c), q1 = *(const float4*)(ps + 8 * c + 4);
                a += q0.x * bflo(w.x) + q0.y * bfhi(w.x) + q0.z * bflo(w.y) + q0.w * bfhi(w.y) + q1.x * bflo(w.z) + q1.y * bfhi(w.z) + q1.z * bflo(w.w) + q1.w * bfhi(w.w);
            }
            o[dd] = a;
        }
        uint2 w; w.x = pack2(o[0], o[1]); w.y = pack2(o[2], o[3]);
        *(uint2*)(ox + (size_t)tk * 1024 + hd * 256 + lane * 4) = w;
    }
}
DI void phase_xo(const P& p, int bid, int nb, unsigned char* smem) {
    const int v = vbid(bid, nb);
    EpiResid e; e.pre = p.out; e.res = (const float*)(p.ws + H1);
    GemmArgs g{(const bf16_t*)(p.ws + OX), 1024, (const bf16_t*)(p.ws + W_XO), 1024, 1024, nullptr};
    for (int t = v; t < 256 * 8; t += nb) gemm_tile(g, (t >> 3) * 128, (t & 7) * 128, e, smem);
}
typedef float f32x4v __attribute__((ext_vector_type(4)));
DI void phase_ln2_router(const P& p, int bid, int nb, unsigned char* smem, int rep = 0) {
    unsigned char* ws = p.ws;
    const int lane = tidx() & 63, wave = tidx() >> 6;
    float* hf = (float*)(ws + H2); bf16_t* hb = (bf16_t*)(ws + H2B);
    const float* wrt = (const float*)(ws + W_RT);
    const float* gam = p.in[20]; const float* bet = p.in[21];
    unsigned* cnt = (unsigned*)(ws + CTL + CTL_CNT); int* lists = (int*)(ws + LISTS); float* tgate = (float*)(ws + TOK_GATE);
    float* lg = (float*)smem + wave * (16 * 52 + 32);
    float* stt = lg + 16 * 52;
    for (int grp = bid; grp < T / 64; grp += nb) {
        const int t0 = grp * 64 + wave * 16;
        for (int rr = 0; rr < 16; rr += 2) {
            if (rep && REP_MODE == 3) break;
            const int tk = t0 + rr;
            float va[16], vb[16], mua, rsa, mub, rsb;
            load_row16(p.out + (size_t)tk * 1024, lane, va); load_row16(p.out + (size_t)(tk + 1) * 1024, lane, vb);
            ln_stats2(va, vb, mua, rsa, mub, rsb);
            if (lane == 0) { stt[2 * rr] = mua; stt[2 * rr + 1] = rsa; stt[2 * rr + 2] = mub; stt[2 * rr + 3] = rsb; }
#pragma unroll
            for (int i = 0; i < 4; ++i) {
                const float4 g4 = *(const float4*)(gam + i * 256 + lane * 4), b4 = *(const float4*)(bet + i * 256 + lane * 4);
                const float4 oa = make_float4((va[4 * i] - mua) * rsa * g4.x + b4.x, (va[4 * i + 1] - mua) * rsa * g4.y + b4.y, (va[4 * i + 2] - mua) * rsa * g4.z + b4.z, (va[4 * i + 3] - mua) * rsa * g4.w + b4.w);
                const float4 ob = make_float4((vb[4 * i] - mub) * rsb * g4.x + b4.x, (vb[4 * i + 1] - mub) * rsb * g4.y + b4.y, (vb[4 * i + 2] - mub) * rsb * g4.z + b4.z, (vb[4 * i + 3] - mub) * rsb * g4.w + b4.w);
                *(float4*)(hf + (size_t)tk * 1024 + i * 256 + lane * 4) = oa; *(float4*)(hf + (size_t)(tk + 1) * 1024 + i * 256 + lane * 4) = ob;
                *(uint2*)(hb + (size_t)tk * 1024 + i * 256 + lane * 4) = pack4(oa); *(uint2*)(hb + (size_t)(tk + 1) * 1024 + i * 256 + lane * 4) = pack4(ob);
            }
        }
        __builtin_amdgcn_wave_barrier();
        if (!(rep && REP_MODE == 2)) {
            const int i16 = lane & 15, g4i = lane >> 4;
            const float mu = stt[2 * i16], rstd = stt[2 * i16 + 1];
            const float* arow = p.out + (size_t)(t0 + i16) * 1024 + 4 * g4i;
            const float* brow = wrt + (size_t)i16 * 1024 + 4 * g4i;
            const float* grow = gam + 4 * g4i; const float* berow = bet + 4 * g4i;
            f32x4v acc0 = {0.f, 0.f, 0.f, 0.f}, acc1 = acc0, acc2 = acc0;
#pragma unroll 2
            for (int S = 0; S < 64; ++S) {
                const float4 x4 = *(const float4*)(arow + 16 * S), g4 = *(const float4*)(grow + 16 * S), e4 = *(const float4*)(berow + 16 * S);
                const float4 b0 = *(const float4*)(brow + 16 * S), b1 = *(const float4*)(brow + 16 * 1024 + 16 * S), b2 = *(const float4*)(brow + 32 * 1024 + 16 * S);
                const float a0 = (x4.x - mu) * rstd * g4.x + e4.x, a1 = (x4.y - mu) * rstd * g4.y + e4.y, a2 = (x4.z - mu) * rstd * g4.z + e4.z, a3 = (x4.w - mu) * rstd * g4.w + e4.w;
                acc0 = __builtin_amdgcn_mfma_f32_16x16x4f32(a0, b0.x, acc0, 0, 0, 0); acc1 = __builtin_amdgcn_mfma_f32_16x16x4f32(a0, b1.x, acc1, 0, 0, 0); acc2 = __builtin_amdgcn_mfma_f32_16x16x4f32(a0, b2.x, acc2, 0, 0, 0);
                acc0 = __builtin_amdgcn_mfma_f32_16x16x4f32(a1, b0.y, acc0, 0, 0, 0); acc1 = __builtin_amdgcn_mfma_f32_16x16x4f32(a1, b1.y, acc1, 0, 0, 0); acc2 = __builtin_amdgcn_mfma_f32_16x16x4f32(a1, b2.y, acc2, 0, 0, 0);
                acc0 = __builtin_amdgcn_mfma_f32_16x16x4f32(a2, b0.z, acc0, 0, 0, 0); acc1 = __builtin_amdgcn_mfma_f32_16x16x4f32(a2, b1.z, acc1, 0, 0, 0); acc2 = __builtin_amdgcn_mfma_f32_16x16x4f32(a2, b2.z, acc2, 0, 0, 0);
                acc0 = __builtin_amdgcn_mfma_f32_16x16x4f32(a3, b0.w, acc0, 0, 0, 0); acc1 = __builtin_amdgcn_mfma_f32_16x16x4f32(a3, b1.w, acc1, 0, 0, 0); acc2 = __builtin_amdgcn_mfma_f32_16x16x4f32(a3, b2.w, acc2, 0, 0, 0);
            }
#pragma unroll
            for (int e = 0; e < 4; ++e) {
                float* rowp = lg + (4 * g4i + e) * 52 + i16;
                rowp[0] = acc0[e]; rowp[16] = acc1[e]; rowp[32] = acc2[e];
            }
        }
        __builtin_amdgcn_wave_barrier();
        unsigned* lcount = (unsigned*)((float*)smem + 4 * (16 * 52 + 32));
        unsigned* lbase = lcount + 32;
        if (tidx() < 32) lcount[tidx()] = 0u;
        __syncthreads();
        int ex1 = 0, ex2 = 0; unsigned lp1 = 0, lp2 = 0;
        if (lane < 16) {
            const int tk = t0 + lane;
            const float* lr = lg + lane * 52;
            float gl[4], el[32];
#pragma unroll
            for (int j = 0; j < 4; ++j) gl[j] = lr[j] + p.in[23][j];
#pragma unroll
            for (int j = 0; j < 32; ++j) el[j] = lr[4 + j] + p.in[25][j];
            int gi = 0; float gm = gl[0];
#pragma unroll
            for (int j = 1; j < 4; ++j) if (gl[j] > gm) { gm = gl[j]; gi = j; }
            float gs = 0.f;
#pragma unroll
            for (int j = 0; j < 4; ++j) gs += __expf(gl[j] - gm);
            const float ggate = 1.f / gs;
            float ev[8];
#pragma unroll
            for (int j = 0; j < 8; ++j) ev[j] = gi == 0 ? el[j] : gi == 1 ? el[8 + j] : gi == 2 ? el[16 + j] : el[24 + j];
            int i1 = 0; float v1 = ev[0];
#pragma unroll
            for (int j = 1; j < 8; ++j) if (ev[j] > v1) { v1 = ev[j]; i1 = j; }
            int i2 = -1; float v2 = -3.0e38f;
#pragma unroll
            for (int j = 0; j < 8; ++j) if (j != i1 && ev[j] > v2) { v2 = ev[j]; i2 = j; }
            const float e2 = __expf(v2 - v1);
            tgate[tk * 2] = ggate / (1.f + e2); tgate[tk * 2 + 1] = ggate * e2 / (1.f + e2);
            ex1 = gi * 8 + i1; ex2 = gi * 8 + i2;
            if (!rep) { lp1 = atomicAdd(&lcount[ex1], 1u); lp2 = atomicAdd(&lcount[ex2], 1u); }
        }
        __syncthreads();
        if (tidx() < 32 && !rep) { const unsigned c = lcount[tidx()]; lbase[tidx()] = c ? atomicAdd(&cnt[tidx() * CNT_STRIDE], c) : 0u; }
        __syncthreads();
        if (lane < 16 && !rep) {
            const int tk = t0 + lane;
            lists[(size_t)ex1 * T + lbase[ex1] + lp1] = tk * 2;
            lists[(size_t)ex2 * T + lbase[ex2] + lp2] = tk * 2 + 1;
        }
        __syncthreads();
    }
}
struct MoeMap { int off[33]; };
DI int moe_tiles(const unsigned* cnt, int* offs  ) {
    __syncthreads();
    if (tidx() == 0) { int o = 0; for (int e = 0; e < 32; ++e) { offs[e] = o; o += (((int)cnt[e * CNT_STRIDE] + 127) >> 7) << 7; } offs[32] = o; }
    __syncthreads();
    return offs[32] >> 7;
}
struct EpiGU {
    bf16_t* hdn;
    DI void prefetch(int, int, int) {}
    DI void operator()(const float* Cs, int m0, int n0, int tid) const {
#pragma unroll 4
        for (int ps = 0; ps < 8; ++ps) {
            const int it = ps * 256 + tid, row = it >> 4, qd = it & 15, c = (qd >> 3) * 64 + (qd & 7) * 4;
            const float4 g = cs4(Cs, row, c), u = cs4(Cs, row, c + 32);
            const int hc = ((n0 & 511) >> 7) * 64 + (qd >> 3) * 32 + (qd & 7) * 4;
            *(uint2*)(hdn + (size_t)(m0 + row) * 256 + hc) = pack4(make_float4(siluf(g.x) * u.x, siluf(g.y) * u.y, siluf(g.z) * u.z, siluf(g.w) * u.w));
        }
    }
};
struct EpiDown {
    bf16_t* y; const int* ltok; const float* lgate;
    DI void prefetch(int, int, int) {}
    DI void operator()(const float* Cs, int m0, int n0, int tid) const {
        const int c4 = (tid & 31) * 4, r0 = tid >> 5;
#pragma unroll 4
        for (int ps = 0; ps < 16; ++ps) {
            const int row = ps * 8 + r0, tk2 = ltok[row];
            if (tk2 >= 0) {
                const float gt = lgate[row];
                float4 v = cs4(Cs, row, c4); v.x *= gt; v.y *= gt; v.z *= gt; v.w *= gt;
                *(uint2*)(y + (size_t)tk2 * 1024 + n0 + c4) = pack4(v);
            }
        }
    }
};
template <int WHICH>
DI void phase_moe(const P& p, int bid, int nb, unsigned char* smem) {
    unsigned char* ws = p.ws;
    const unsigned* cnt = (const unsigned*)(ws + CTL + CTL_CNT); const int* lists = (const int*)(ws + LISTS); const float* tgate = (const float*)(ws + TOK_GATE);
    int* offs = (int*)(smem + GEMM_LDS); int* ltok = offs + 64; int* lrow = ltok + 128; float* lgate = (float*)(lrow + 128);
    const int nmt = moe_tiles(cnt, offs);
    constexpr int NNT = WHICH == 0 ? 4 : 8;
    const int v = vbid(bid, nb);
    for (int t = v; t < nmt * NNT; t += nb) {
        const int mt = t / NNT, ntl = t % NNT;
        const int slot0 = mt * 128;
        int e = 0;
        while (offs[e + 1] <= slot0) ++e;
        __syncthreads();
        if (tidx() < 128) {
            const int pos = slot0 - offs[e] + tidx();
            const int tk2 = pos < (int)cnt[e * CNT_STRIDE] ? lists[(size_t)e * T + pos] : -1;
            ltok[tidx()] = tk2; lrow[tidx()] = tk2 < 0 ? 0 : (tk2 >> 1); lgate[tidx()] = tk2 < 0 ? 0.f : tgate[tk2];
        }
        __syncthreads();
        if (WHICH == 0) {
            EpiGU ep{(bf16_t*)(ws + HDN)};
            GemmArgs g{(const bf16_t*)(ws + H2B), 1024, (const bf16_t*)(ws + W_GU) + (size_t)e * 512 * 1024, 1024, 1024, lrow};
            gemm_tile(g, slot0, ntl * 128, ep, smem);
        } else {
            EpiDown ep{(bf16_t*)(ws + YB), ltok, lgate};
            GemmArgs g{(const bf16_t*)(ws + HDN), 256, (const bf16_t*)(ws + W_DN) + (size_t)e * 1024 * 256, 256, 256, nullptr};
            gemm_tile(g, slot0, ntl * 128, ep, smem);
        }
    }
}
DI void phase_final(const P& p, int bid, int nb, unsigned char* smem) {
    const int lane = tidx() & 63, wave = tidx() >> 6;
    const float* hf = (const float*)(p.ws + H2); const bf16_t* y = (const bf16_t*)(p.ws + YB);
    const float* gam = p.in[29]; const float* bet = p.in[30];
    for (int tk = bid * 4 + wave; tk < T; tk += nb * 8) {
        const int tk2 = tk + nb * 4;
        float va[16], vb[16], mua, rsa, mub, rsb;
#pragma unroll
        for (int i = 0; i < 4; ++i) {
            const float4 ta = *(const float4*)(hf + (size_t)tk * 1024 + i * 256 + lane * 4), tb = *(const float4*)(hf + (size_t)tk2 * 1024 + i * 256 + lane * 4);
            const uint2 a0 = *(const uint2*)(y + (size_t)(tk * 2) * 1024 + i * 256 + lane * 4), a1 = *(const uint2*)(y + (size_t)(tk * 2 + 1) * 1024 + i * 256 + lane * 4);
            const uint2 b0 = *(const uint2*)(y + (size_t)(tk2 * 2) * 1024 + i * 256 + lane * 4), b1 = *(const uint2*)(y + (size_t)(tk2 * 2 + 1) * 1024 + i * 256 + lane * 4);
            va[4 * i] = ALPHA * ta.x + bflo(a0.x) + bflo(a1.x); va[4 * i + 1] = ALPHA * ta.y + bfhi(a0.x) + bfhi(a1.x); va[4 * i + 2] = ALPHA * ta.z + bflo(a0.y) + bflo(a1.y); va[4 * i + 3] = ALPHA * ta.w + bfhi(a0.y) + bfhi(a1.y);
            vb[4 * i] = ALPHA * tb.x + bflo(b0.x) + bflo(b1.x); vb[4 * i + 1] = ALPHA * tb.y + bfhi(b0.x) + bfhi(b1.x); vb[4 * i + 2] = ALPHA * tb.z + bflo(b0.y) + bflo(b1.y); vb[4 * i + 3] = ALPHA * tb.w + bfhi(b0.y) + bfhi(b1.y);
        }
        ln_stats2(va, vb, mua, rsa, mub, rsb);
#pragma unroll
        for (int i = 0; i < 4; ++i) {
            const float4 g4 = *(const float4*)(gam + i * 256 + lane * 4), b4 = *(const float4*)(bet + i * 256 + lane * 4);
            *(float4*)(p.out + (size_t)tk * 1024 + i * 256 + lane * 4) = make_float4((va[4 * i] - mua) * rsa * g4.x + b4.x, (va[4 * i + 1] - mua) * rsa * g4.y + b4.y, (va[4 * i + 2] - mua) * rsa * g4.z + b4.z, (va[4 * i + 3] - mua) * rsa * g4.w + b4.w);
            *(float4*)(p.out + (size_t)tk2 * 1024 + i * 256 + lane * 4) = make_float4((vb[4 * i] - mub) * rsb * g4.x + b4.x, (vb[4 * i + 1] - mub) * rsb * g4.y + b4.y, (vb[4 * i + 2] - mub) * rsb * g4.z + b4.z, (vb[4 * i + 3] - mub) * rsb * g4.w + b4.w);
        }
    }
}

#define XB_TMO      128
#define XB_XCNT(j)  (256  + 64 * (j))
#define XB_XSUB(j)  (1280 + 64 * (j))
#define XB_XGEN(j)  (2304 + 64 * (j))
#define XB_TOP      3328
#define XB_TOPGEN   3392
#define XCD_BAR_WORDS 3456
#define XB_SPIN_CAP (1u << 25)
DI unsigned xb_ld(unsigned* p) { return __hip_atomic_load(p, __ATOMIC_RELAXED, __HIP_MEMORY_SCOPE_AGENT); }
DI unsigned xb_add(unsigned* p, unsigned v) { return __hip_atomic_fetch_add(p, v, __ATOMIC_RELAXED, __HIP_MEMORY_SCOPE_AGENT); }
DI unsigned xb_xcc_id() { return (unsigned)__builtin_amdgcn_s_getreg((3 << 11) | 20) & 0xFu; }
#define XB_SPIN(cond, bar) do { unsigned _sp = 0; while (cond) { __builtin_amdgcn_s_sleep(1); \
    if ((++_sp & 255u) == 0u) { if (xb_ld(&(bar)[XB_TMO])) break; if (_sp > XB_SPIN_CAP) { atomicAdd(&(bar)[XB_TMO], 1u); break; } } } } while (0)
struct XcdBarrier { unsigned* bar; unsigned x; volatile LAS unsigned* st; };
DI XcdBarrier xcd_barrier_post(unsigned* bar, volatile LAS unsigned* st) {
    XcdBarrier b; b.bar = bar; b.x = xb_xcc_id(); b.st = st;
    if (threadIdx.x == 0) (void)xb_add(&bar[XB_XCNT(b.x)], 1u);
    return b;
}
DI void xcd_barrier_complete(unsigned* bar, unsigned x, unsigned& nloc, unsigned& nx) {
    const unsigned G = gridDim.x * gridDim.y * gridDim.z;
    unsigned sum, cnt, mine, sp = 0u;
    for (;;) {
        sum = 0u; cnt = 0u; mine = 0u;
#pragma unroll
        for (unsigned j = 0; j < 16; ++j) { const unsigned c = xb_ld(&bar[XB_XCNT(j)]); sum += c; cnt += (c > 0u) ? 1u : 0u; mine = (j == x) ? c : mine; }
        if (sum == G) break;
        __builtin_amdgcn_s_sleep(1);
        if ((++sp & 255u) == 0u) { if (xb_ld(&bar[XB_TMO])) break; if (sp > XB_SPIN_CAP) { atomicAdd(&bar[XB_TMO], 1u); break; } }
    }
    nloc = mine > 0u ? mine : 1u; nx = cnt > 0u ? cnt : 1u;
}
DI void xcd_barrier(const XcdBarrier& b) {
    asm volatile("s_waitcnt vmcnt(0)" ::: "memory");
    __syncthreads();
    if (threadIdx.x == 0) {
        unsigned* bar = b.bar;
        __builtin_amdgcn_s_waitcnt(0);
        unsigned nloc = b.st[0], nx = b.st[1];
        if (nloc == 0u) { xcd_barrier_complete(bar, b.x, nloc, nx); b.st[0] = nloc; b.st[1] = nx; }
        const unsigned old = xb_add(&bar[XB_XSUB(b.x)], 1u);
        const unsigned gen = old / nloc;
        if (old + 1u == (gen + 1u) * nloc) {
            __builtin_amdgcn_fence(__ATOMIC_RELEASE, "agent");
            asm volatile("s_waitcnt vmcnt(0)" ::: "memory");
            const unsigned og = xb_add(&bar[XB_TOP], 1u);
            const unsigned tg = og / nx;
            if (og + 1u == (tg + 1u) * nx) xb_add(&bar[XB_TOPGEN], 1u);
            else XB_SPIN(xb_ld(&bar[XB_TOPGEN]) == tg, bar);
            __builtin_amdgcn_fence(__ATOMIC_ACQUIRE, "agent");
            xb_add(&bar[XB_XGEN(b.x)], 1u);
            asm volatile("s_waitcnt vmcnt(0)" ::: "memory");
        } else {
            XB_SPIN(xb_ld(&bar[XB_XGEN(b.x)]) == gen, bar);
            __builtin_amdgcn_fence(__ATOMIC_ACQUIRE, "agent");
            asm volatile("s_waitcnt vmcnt(0)" ::: "memory");
        }
    }
    __syncthreads();
}

constexpr int NPHASE = 14;
template <int PH>
DI void run_phase(const P& p, int bid, int nb, unsigned char* smem, int rep = 0) {
    if (PH == 0) phase_prep(p, bid, nb, smem);
    else if (PH == 1) phase_proj(p, bid, nb, smem, rep);
    else if (PH == 2) phase_up(p, bid, nb, smem);
    else if (PH == 3) phase_mixer(p, bid, nb, smem, rep);
    else if (PH == 4) phase_ssdnorm(p, bid, nb, smem);
    else if (PH == 5) phase_wout(p, bid, nb, smem);
    else if (PH == 6) phase_ln1(p, bid, nb, smem);
    else if (PH == 7) phase_xq(p, bid, nb, smem);
    else if (PH == 8) phase_xattn(p, bid, nb, smem);
    else if (PH == 9) phase_xo(p, bid, nb, smem);
    else if (PH == 10) phase_ln2_router(p, bid, nb, smem, rep);
    else if (PH == 11) phase_moe<0>(p, bid, nb, smem);
    else if (PH == 12) phase_moe<1>(p, bid, nb, smem);
    else if (PH == 13) phase_final(p, bid, nb, smem);
}
template <int PH>
__global__ void __launch_bounds__(256, 2) k_phase(P p) {
    __shared__ __attribute__((aligned(16))) unsigned char smem[SMEM_BYTES];
    run_phase<PH>(p, blockIdx.x, gridDim.x, smem);
}

#if MEGA
#ifndef MEGA_WAVES
#define MEGA_WAVES 2
#endif
template <int PH>
DI void mega_steps(const P& p, const XcdBarrier& bar, unsigned char* smem) {
    run_phase<PH>(p, blockIdx.x, gridDim.x, smem);
    if constexpr (((REPEAT_MASK >> PH) & 1) != 0) { xcd_barrier(bar); run_phase<PH>(p, blockIdx.x, gridDim.x, smem, 1); }
    if constexpr (PH + 1 < NPHASE) { xcd_barrier(bar); mega_steps<PH + 1>(p, bar, smem); }
}
__global__ void __launch_bounds__(256, MEGA_WAVES) k_mega(P p) {
    __shared__ __attribute__((aligned(16))) unsigned char smem[SMEM_BYTES];
    volatile LAS unsigned* st = (volatile LAS unsigned*)(smem + SMEM_BYTES - 16);
    if (threadIdx.x < 4) st[threadIdx.x] = 0u;
    __syncthreads();
    const XcdBarrier bar = xcd_barrier_post((unsigned*)(p.ws + CTL), st);
    mega_steps<0>(p, bar, smem);
}
#endif
template <int PH>
__global__ void __launch_bounds__(256, 1) k_phase_big(P p) {
    __shared__ __attribute__((aligned(16))) unsigned char smem[SMEM_BYTES];
    run_phase<PH>(p, blockIdx.x, gridDim.x, smem);
}
template <int PH>
static void launch_phase(const P& p, int grid, hipStream_t st) {
    if constexpr (PH == 3 && !P3_SMALL) hipLaunchKernelGGL((k_phase_big<PH>), dim3(grid), dim3(256), 0, st, p);
    else hipLaunchKernelGGL((k_phase<PH>), dim3(grid), dim3(256), 0, st, p);
}

extern "C" void kernel_launch(void* const* d_in, const int* in_sizes, int n_in, void* d_out, int out_size, void* d_ws, size_t ws_size, hipStream_t stream) {
    if (n_in != 31 || out_size != T * D || ws_size < WS_NEED) {
        fprintf(stderr, "kernel_launch: unexpected shapes: n_in %d out %d ws %zu (need %zu)\n", n_in, out_size, ws_size, (size_t)WS_NEED);
        return;
    }
    P p{};
    for (int i = 0; i < 31; ++i) p.in[i] = (const float*)d_in[i];
    p.out = (float*)d_out; p.ws = (unsigned char*)d_ws;
    (void)hipMemsetAsync((unsigned char*)d_ws + CTL, 0, CTL_BYTES, stream);
#if MEGA
    static int grid = 0;
    if (grid == 0) {
        int dev = 0, cus = 0, per_cu = 0;
        (void)hipGetDevice(&dev);
        (void)hipDeviceGetAttribute(&cus, hipDeviceAttributeMultiprocessorCount, dev);
        if (hipOccupancyMaxActiveBlocksPerMultiprocessor(&per_cu, (const void*)k_mega, 256, 0) != hipSuccess || per_cu < 1) { fprintf(stderr, "kernel_launch: occupancy query failed\n"); per_cu = 1; }
        if (per_cu > 2) per_cu = 2;
        grid = cus * per_cu;
        fprintf(stderr, "kernel_launch: mega grid %d (%d CUs x %d)\n", grid, cus, per_cu);
    }
    void* args[] = {(void*)&p};
    const hipError_t le = hipLaunchCooperativeKernel((const void*)k_mega, dim3(grid), dim3(256), args, 0, stream);
    if (le != hipSuccess) fprintf(stderr, "kernel_launch: cooperative launch failed: %s (grid %d)\n", hipGetErrorString(le), grid);
#else
    const int grid = 1024;
    launch_phase<0>(p, grid, stream); launch_phase<1>(p, grid, stream); launch_phase<2>(p, grid, stream); launch_phase<3>(p, grid, stream);
    launch_phase<4>(p, grid, stream); launch_phase<5>(p, grid, stream); launch_phase<6>(p, grid, stream); launch_phase<7>(p, grid, stream);
    launch_phase<8>(p, grid, stream); launch_phase<9>(p, grid, stream); launch_phase<10>(p, grid, stream); launch_phase<11>(p, grid, stream);
    launch_phase<12>(p, grid, stream); launch_phase<13>(p, grid, stream);
#endif
}
```

```cpp
#include <hip/hip_runtime.h>
#include <stdint.h>
#include <stdio.h>

#ifndef MEGA
#define MEGA 1
#endif
#ifndef ATTN_NAIVE
#define ATTN_NAIVE 0
#endif
#ifndef XATTN_NAIVE
#define XATTN_NAIVE 0
#endif
#ifndef SSD_NAIVE
#define SSD_NAIVE 0
#endif
#ifndef P3_SMALL
#define P3_SMALL 1
#endif
#ifndef NO_SSD
#define NO_SSD 0
#endif
#ifndef NO_FLASH
#define NO_FLASH 0
#endif
#ifndef GEMM_GLDS
#define GEMM_GLDS 1
#endif
#ifndef EXTRA_BARRIERS
#define EXTRA_BARRIERS 0
#endif
#ifndef SSD_PM
#define SSD_PM 0
#endif
#ifndef REPEAT_MASK
#define REPEAT_MASK 0
#endif
#ifndef REP_MODE
#define REP_MODE 0
#endif
#ifndef GEMM_DIRECT
#define GEMM_DIRECT 0
#endif

typedef unsigned short bf16_t;
typedef short bf16x8 __attribute__((ext_vector_type(8)));
typedef float f32x16 __attribute__((ext_vector_type(16)));
#define DI __device__ __forceinline__
#define LAS __attribute__((address_space(3)))
#define MFMA32(a, b, c) __builtin_amdgcn_mfma_f32_32x32x16_bf16((a), (b), (c), 0, 0, 0)

constexpr int Bn = 16, S = 2048, T = Bn * S, D = 1024;
constexpr int NMEM = 256;
constexpr float EPS = 1e-5f;
constexpr float ALPHA = 1.189207115002721f;
constexpr float LOG2E = 1.4426950408889634f;
constexpr float QSCALE = 0.10206207261596577f * LOG2E;
constexpr float XSCALE = 0.0625f * LOG2E;
constexpr int NEXP = 32;
constexpr int MAXSLOTS = 69632;

constexpr size_t MiB = 1u << 20;
constexpr size_t W_IN = 0;
constexpr size_t W_QUP = W_IN + 4 * MiB;
constexpr size_t W_KVUP = W_QUP + 768 * 256 * 2;
constexpr size_t W_OUT = W_KVUP + 1024 * 128 * 2;
constexpr size_t W_XQ = W_OUT + 2 * MiB;
constexpr size_t W_XKV = W_XQ + 2 * MiB;
constexpr size_t W_XO = W_XKV + 4 * MiB;
constexpr size_t W_GU = W_XO + 2 * MiB;
constexpr size_t W_DN = W_GU + 32 * MiB;
constexpr size_t W_RT = W_DN + 16 * MiB;
constexpr size_t ROPE_C = W_RT + 48 * 1024 * 4;
constexpr size_t ROPE_S = ROPE_C + 2048 * 16 * 4;
constexpr size_t TOK_GATE = ROPE_S + 2048 * 16 * 4;
constexpr size_t CTL = TOK_GATE + (size_t)T * 2 * 4;
constexpr size_t CTL_BYTES = 32768;
constexpr size_t CTL_CNT = 16384;
constexpr int CNT_STRIDE = 64;
constexpr size_t CTL_QUEUE = 28672;
static_assert(CTL + CTL_BYTES <= 64 * MiB, "weights region overflow");
constexpr size_t RA = 64 * MiB, RB = 192 * MiB, RC = 320 * MiB, RD = 448 * MiB, WS_NEED = 512 * MiB;
constexpr size_t XBC = RA;
constexpr size_t KX = RA + 64 * MiB;
constexpr size_t VXT = KX + 8 * MiB;
constexpr size_t YB = RA;
constexpr size_t QB = RB;
constexpr size_t KNB = RB + 48 * MiB;
constexpr size_t VTB = KNB + 32 * MiB;
constexpr size_t H1 = RB;
constexpr size_t H2 = RB;
constexpr size_t XB = RC;
constexpr size_t MEMB = RB;
constexpr size_t XBCA = RC;
constexpr size_t MIX = RC + 64 * MiB;
constexpr size_t H1B = RC;
constexpr size_t QX = RC + 64 * MiB;
constexpr size_t OX = RC;
constexpr size_t H2B = RC;
constexpr size_t HDN = RC + 64 * MiB;
constexpr size_t CQ = RD;
constexpr size_t CKV = CQ + 16 * MiB;
constexpr size_t KROPE = CKV + 8 * MiB;
constexpr size_t DTB = KROPE + 2 * MiB;
constexpr size_t ZB = DTB + 1 * MiB;
constexpr size_t LISTS = RD;
static_assert(ZB + 32 * MiB <= WS_NEED, "region D overflow");

struct P {
    const float* in[31];
    float* out;
    unsigned char* ws;
};

typedef __bf16 hbf16x2 __attribute__((ext_vector_type(2)));
typedef float f32x2 __attribute__((ext_vector_type(2)));
DI bf16_t f2bf(float x) { return __builtin_bit_cast(bf16_t, (__bf16)x); }
DI float bf2f(bf16_t b) { return __uint_as_float(((unsigned)b) << 16); }
DI float bflo(unsigned w) { return __uint_as_float(w << 16); }
DI float bfhi(unsigned w) { return __uint_as_float(w & 0xffff0000u); }
DI unsigned pack2(float a, float b) { f32x2 v = {a, b}; return __builtin_bit_cast(unsigned, __builtin_convertvector(v, hbf16x2)); }
DI float siluf(float x) { return x / (1.f + __expf(-x)); }
DI float softplusf(float x) {
    const float zz = __expf(-fabsf(x));
    const float l1p = zz < 0.01f ? zz * (1.f - zz * (0.5f - zz * (1.f / 3.f))) : __logf(1.f + zz);
    return fmaxf(x, 0.f) + l1p;
}
DI int tidx() { int t = __builtin_amdgcn_workitem_id_x(); asm volatile("" : "+v"(t)); return t; }
DI int crow(int reg, int h) { return (reg & 3) + 8 * (reg >> 2) + 4 * h; }
constexpr int CS_LD = 132;
DI float4 cs4(const float* Cs, int row, int col) { return *(const float4*)(Cs + row * CS_LD + col); }
DI uint2 pack4(float4 v) { uint2 w; w.x = pack2(v.x, v.y); w.y = pack2(v.z, v.w); return w; }
DI float wave_sum(float v) {
#pragma unroll
    for (int o = 32; o >= 1; o >>= 1) v += __shfl_xor(v, o);
    return v;
}
DI float wave_max(float v) {
#pragma unroll
    for (int o = 32; o >= 1; o >>= 1) v = fmaxf(v, __shfl_xor(v, o));
    return v;
}

constexpr int LDS_ROW = 144;
constexpr int TILE_BYTES = 128 * LDS_ROW;
constexpr int GEMM_LDS = 4 * TILE_BYTES;
constexpr int SMEM_BYTES = GEMM_LDS + 3072;
static_assert(128 * CS_LD * 4 <= GEMM_LDS, "epilogue tile");

struct GemmArgs {
    const bf16_t* A; int lda;
    const bf16_t* Bt; int ldb;
    int K;
    const int* lrows;
};

template <class Epi>
DI void gemm_tile(const GemmArgs& g, int m0, int n0, Epi& epi, unsigned char* smem) {
    const int tid = tidx(), lane = tid & 63, wave = tid >> 6, wr = wave >> 1, wc = wave & 1;
    const int r = lane & 31, h = lane >> 5;
    f32x16 acc[2][2];
#pragma unroll
    for (int i = 0; i < 2; ++i)
#pragma unroll
        for (int j = 0; j < 2; ++j)
#pragma unroll
            for (int e = 0; e < 16; ++e) acc[i][j][e] = 0.f;
    const int nk = g.K >> 6;
    epi.prefetch(m0, n0, tid);
#if GEMM_DIRECT
    {
        const bf16_t* ap[2]; const bf16_t* bp[2];
#pragma unroll
        for (int i = 0; i < 2; ++i) {
            const int lr = wr * 64 + i * 32 + r;
            const int grow = g.lrows ? g.lrows[lr] : (m0 + lr);
            ap[i] = g.A + (size_t)grow * g.lda + 8 * h;
            bp[i] = g.Bt + (size_t)(n0 + wc * 64 + i * 32 + r) * g.ldb + 8 * h;
        }
        for (int k = 0; k < g.K; k += 16) {
            bf16x8 a[2], b[2];
#pragma unroll
            for (int i = 0; i < 2; ++i) { a[i] = *(const bf16x8*)(ap[i] + k); b[i] = *(const bf16x8*)(bp[i] + k); }
#pragma unroll
            for (int i = 0; i < 2; ++i)
#pragma unroll
                for (int j = 0; j < 2; ++j) acc[i][j] = MFMA32(a[i], b[j], acc[i][j]);
        }
    }
#elif GEMM_GLDS
    {
        constexpr int STG = 32768, TB = 16384;
        const int srow = tid >> 3, sch = (tid & 7) ^ ((srow >> 1) & 7);
        const bf16_t* ag[4]; const bf16_t* bg[4];
#pragma unroll
        for (int i = 0; i < 4; ++i) {
            const int lr = srow + 32 * i;
            const int grow = g.lrows ? g.lrows[lr] : (m0 + lr);
            ag[i] = g.A + (size_t)grow * g.lda + sch * 8;
            bg[i] = g.Bt + (size_t)(n0 + lr) * g.ldb + sch * 8;
        }
#define GLDS_STAGE(BUF, KO) do { unsigned char* _d = (BUF) + wave * 1024; \
        _Pragma("unroll") for (int i = 0; i < 4; ++i) { \
            __builtin_amdgcn_global_load_lds((const unsigned*)(ag[i] + (KO)), (LAS unsigned*)(_d + i * 4096), 16, 0, 0); \
            __builtin_amdgcn_global_load_lds((const unsigned*)(bg[i] + (KO)), (LAS unsigned*)(_d + TB + i * 4096), 16, 0, 0); } } while (0)
        __syncthreads();
        GLDS_STAGE(smem, 0);
        const int y16 = (h ^ ((r >> 1) & 7)) << 4;
        const int o0 = y16, o1 = 32 ^ y16, o2 = 64 ^ y16, o3 = 96 ^ y16;
        const int arow = (wr * 64 + r) * 128, brow = TB + (wc * 64 + r) * 128;
        __syncthreads();
        for (int kt = 0; kt < nk; ++kt) {
            const unsigned char* cur = smem + (kt & 1) * STG;
            if (kt + 1 < nk) GLDS_STAGE(smem + ((kt + 1) & 1) * STG, (kt + 1) * 64);
            bf16x8 fa[4][2], fb[4][2];
#define KLOAD(S, OFF) do { \
                fa[S][0] = *(const bf16x8*)(cur + arow + (OFF)); fa[S][1] = *(const bf16x8*)(cur + arow + 32 * 128 + (OFF)); \
                fb[S][0] = *(const bf16x8*)(cur + brow + (OFF)); fb[S][1] = *(const bf16x8*)(cur + brow + 32 * 128 + (OFF)); } while (0)
            KLOAD(0, o0); KLOAD(1, o1); KLOAD(2, o2); KLOAD(3, o3);
#undef KLOAD
#pragma unroll
            for (int s = 0; s < 4; ++s) {
                acc[0][0] = MFMA32(fa[s][0], fb[s][0], acc[0][0]); acc[0][1] = MFMA32(fa[s][0], fb[s][1], acc[0][1]);
                acc[1][0] = MFMA32(fa[s][1], fb[s][0], acc[1][0]); acc[1][1] = MFMA32(fa[s][1], fb[s][1], acc[1][1]);
            }
            __builtin_amdgcn_sched_group_barrier(0x100, 8, 0); __builtin_amdgcn_sched_group_barrier(0x8, 4, 0);
            __builtin_amdgcn_sched_group_barrier(0x100, 4, 0); __builtin_amdgcn_sched_group_barrier(0x8, 4, 0);
            __builtin_amdgcn_sched_group_barrier(0x100, 4, 0); __builtin_amdgcn_sched_group_barrier(0x8, 8, 0);
#define KSTEP(OFF)
#undef KSTEP
            __syncthreads();
        }
#undef GLDS_STAGE
    }
#else
    {
        const int srow = tid >> 3, sch = tid & 7;
        const bf16_t* ag[4]; const bf16_t* bg[4];
#pragma unroll
        for (int i = 0; i < 4; ++i) {
            const int lr = srow + 32 * i;
            const int grow = g.lrows ? g.lrows[lr] : (m0 + lr);
            ag[i] = g.A + (size_t)grow * g.lda + sch * 8;
            bg[i] = g.Bt + (size_t)(n0 + lr) * g.ldb + sch * 8;
        }
        const int soff = srow * LDS_ROW + sch * 16;
        uint4 ra0, ra1, ra2, ra3, rb0, rb1, rb2, rb3;
#define G_LOAD(KO) do { ra0 = *(const uint4*)(ag[0] + (KO)); ra1 = *(const uint4*)(ag[1] + (KO)); ra2 = *(const uint4*)(ag[2] + (KO)); ra3 = *(const uint4*)(ag[3] + (KO)); \
                        rb0 = *(const uint4*)(bg[0] + (KO)); rb1 = *(const uint4*)(bg[1] + (KO)); rb2 = *(const uint4*)(bg[2] + (KO)); rb3 = *(const uint4*)(bg[3] + (KO)); } while (0)
#define L_STORE(BUF) do { unsigned char* _d = (BUF) + soff; \
        *(uint4*)(_d) = ra0; *(uint4*)(_d + 32 * LDS_ROW) = ra1; *(uint4*)(_d + 64 * LDS_ROW) = ra2; *(uint4*)(_d + 96 * LDS_ROW) = ra3; \
        *(uint4*)(_d + TILE_BYTES) = rb0; *(uint4*)(_d + TILE_BYTES + 32 * LDS_ROW) = rb1; *(uint4*)(_d + TILE_BYTES + 64 * LDS_ROW) = rb2; *(uint4*)(_d + TILE_BYTES + 96 * LDS_ROW) = rb3; } while (0)
        G_LOAD(0);
        __syncthreads();
        L_STORE(smem);
        __syncthreads();
        const int aoff = (wr * 64 + r) * LDS_ROW + h * 16;
        const int boff = TILE_BYTES + (wc * 64 + r) * LDS_ROW + h * 16;
        for (int kt = 0; kt < nk; ++kt) {
            const unsigned char* cur = smem + (kt & 1) * 2 * TILE_BYTES;
            unsigned char* nxt = smem + ((kt + 1) & 1) * 2 * TILE_BYTES;
            const bool more = (kt + 1 < nk);
            if (more) G_LOAD((kt + 1) * 64);
#pragma unroll
            for (int ks = 0; ks < 4; ++ks) {
                const bf16x8 a0 = *(const bf16x8*)(cur + aoff + ks * 32);
                const bf16x8 a1 = *(const bf16x8*)(cur + aoff + 32 * LDS_ROW + ks * 32);
                const bf16x8 b0 = *(const bf16x8*)(cur + boff + ks * 32);
                const bf16x8 b1 = *(const bf16x8*)(cur + boff + 32 * LDS_ROW + ks * 32);
                acc[0][0] = MFMA32(a0, b0, acc[0][0]); acc[0][1] = MFMA32(a0, b1, acc[0][1]);
                acc[1][0] = MFMA32(a1, b0, acc[1][0]); acc[1][1] = MFMA32(a1, b1, acc[1][1]);
            }
            if (more) L_STORE(nxt);
            __syncthreads();
        }
#undef G_LOAD
#undef L_STORE
    }
#endif
    float* Cs = (float*)smem;
#if GEMM_DIRECT
    __syncthreads();
#endif
#pragma unroll
    for (int i = 0; i < 2; ++i)
#pragma unroll
        for (int j = 0; j < 2; ++j)
#pragma unroll
            for (int e = 0; e < 16; ++e) Cs[(wr * 64 + i * 32 + crow(e, h)) * CS_LD + wc * 64 + j * 32 + r] = acc[i][j][e];
    __syncthreads();
    epi(Cs, m0, n0, tid);
}

DI int vbid(int bid, int nb) { return (nb % 8 == 0) ? (bid % 8) * (nb / 8) + bid / 8 : bid; }

DI int colmap_in(int n) {
    if (n < 384) return n;
    if (n < 896) return 416 + (n - 384);
    if (n < 1920) return 928 + (n - 896);
    if (n < 1952) return 384 + (n - 1920);
    if (n < 1960) return n;
    return -1;
}
template <int KIND>
DI void tconv_tile(const float* src, const float* src2, int ldsrc, bf16_t* dst, int K, int k0, int n0, const float* scale, int scale_from, unsigned char* smem) {
    float* tile = (float*)smem;
    const int t = tidx();
    __syncthreads();
#pragma unroll 4
    for (int i = 0; i < 16; ++i) {
        const int k = i * 4 + (t >> 6), n = t & 63;
        const int nd = n0 + n;
        float v = 0.f;
        if (KIND == 1) { const int c = colmap_in(nd); if (c >= 0) v = src[(size_t)(k0 + k) * ldsrc + c]; }
        else if (KIND == 2) {
            const int j = nd >> 7, wc = (nd >> 6) & 1, isup = (nd >> 5) & 1, ii = nd & 31;
            const int c = 64 * j + 32 * wc + ii;
            v = (isup ? src2 : src)[(size_t)(k0 + k) * ldsrc + c];
        } else v = src[(size_t)(k0 + k) * ldsrc + nd];
        if (scale && (k0 + k) >= scale_from) v *= scale[k0 + k - scale_from];
        tile[k * 65 + n] = v;
    }
    __syncthreads();
#pragma unroll 4
    for (int i = 0; i < 16; ++i) {
        const int n = i * 4 + (t >> 6), k = t & 63;
        dst[(size_t)(n0 + n) * K + k0 + k] = f2bf(tile[k * 65 + n]);
    }
}

DI void phase_prep(const P& p, int bid, int nb, unsigned char* smem) {
    unsigned char* ws = p.ws;
    const int tid = tidx();
    constexpr int J0 = 512, J1 = J0 + 48, J2 = J1 + 32, J3 = J2 + 256, J4 = J3 + 256, J5 = J4 + 256, J6 = J5 + 256, J7 = J6 + 256, J8 = J7 + 4096, J9 = J8 + 2048;
    for (int t = bid; t < J9; t += nb) {
        if (t < J0) { const int kt = t >> 5, ntl = t & 31; tconv_tile<1>(p.in[2], nullptr, 1960, (bf16_t*)(ws + W_IN), 1024, kt * 64, ntl * 64, nullptr, 0, smem); }
        else if (t < J1) { const int u = t - J0, kt = u / 12, ntl = u % 12; tconv_tile<0>(p.in[4], nullptr, 768, (bf16_t*)(ws + W_QUP), 256, kt * 64, ntl * 64, p.in[3], 0, smem); }
        else if (t < J2) { const int u = t - J1, kt = u >> 4, ntl = u & 15; tconv_tile<0>(p.in[6], nullptr, 1024, (bf16_t*)(ws + W_KVUP), 128, kt * 64, ntl * 64, p.in[5], 0, smem); }
        else if (t < J3) { const int u = t - J2, kt = u >> 4, ntl = u & 15; tconv_tile<0>(p.in[13], nullptr, 1024, (bf16_t*)(ws + W_OUT), 1024, kt * 64, ntl * 64, p.in[12], 512, smem); }
        else if (t < J4) { const int u = t - J3, kt = u >> 4, ntl = u & 15; tconv_tile<0>(p.in[16], nullptr, 1024, (bf16_t*)(ws + W_XQ), 1024, kt * 64, ntl * 64, nullptr, 0, smem); }
        else if (t < J5) { const int u = t - J4, kt = u >> 4, ntl = u & 15; tconv_tile<0>(p.in[17], nullptr, 1024, (bf16_t*)(ws + W_XKV), 1024, kt * 64, ntl * 64, nullptr, 0, smem); }
        else if (t < J6) { const int u = t - J5, kt = u >> 4, ntl = u & 15; tconv_tile<0>(p.in[18], nullptr, 1024, (bf16_t*)(ws + W_XKV) + (size_t)1024 * 1024, 1024, kt * 64, ntl * 64, nullptr, 0, smem); }
        else if (t < J7) { const int u = t - J6, kt = u >> 4, ntl = u & 15; tconv_tile<0>(p.in[19], nullptr, 1024, (bf16_t*)(ws + W_XO), 1024, kt * 64, ntl * 64, nullptr, 0, smem); }
        else if (t < J8) { const int u = t - J7, e = u >> 7, v = u & 127, kt = v >> 3, ntl = v & 7;
            tconv_tile<2>(p.in[26] + (size_t)e * 1024 * 256, p.in[27] + (size_t)e * 1024 * 256, 256, (bf16_t*)(ws + W_GU) + (size_t)e * 512 * 1024, 1024, kt * 64, ntl * 64, nullptr, 0, smem); }
        else { const int u = t - J8, e = u >> 6, v = u & 63, kt = v >> 4, ntl = v & 15;
            tconv_tile<0>(p.in[28] + (size_t)e * 256 * 1024, nullptr, 1024, (bf16_t*)(ws + W_DN) + (size_t)e * 1024 * 256, 256, kt * 64, ntl * 64, nullptr, 0, smem); }
    }
    {
        const size_t gsz = (size_t)nb * 256, g0 = (size_t)bid * 256 + tid;
        bf16_t* xb = (bf16_t*)(ws + XB);
        const float4* x4 = (const float4*)p.in[0];
        for (size_t i = g0; i < (size_t)T * D / 4; i += gsz) { const float4 v = x4[i]; uint2 o; o.x = pack2(v.x, v.y); o.y = pack2(v.z, v.w); ((uint2*)xb)[i] = o; }
        bf16_t* mb = (bf16_t*)(ws + MEMB);
        const float4* m4 = (const float4*)p.in[1];
        for (size_t i = g0; i < (size_t)Bn * NMEM * D / 4; i += gsz) { const float4 v = m4[i]; uint2 o; o.x = pack2(v.x, v.y); o.y = pack2(v.z, v.w); ((uint2*)mb)[i] = o; }
        float* wrt = (float*)(ws + W_RT);
        for (size_t i = g0; i < 48 * 1024; i += gsz) {
            const int j = (int)(i >> 10), k = (int)(i & 1023);
            float v = 0.f;
            if (j < 4) v = p.in[22][k * 4 + j]; else if (j < 36) v = p.in[24][k * 32 + (j - 4)];
            wrt[i] = v;
        }
        float* rc = (float*)(ws + ROPE_C); float* rs = (float*)(ws + ROPE_S);
        for (size_t i = g0; i < 2048 * 16; i += gsz) {
            const int pos = (int)(i >> 4), f = (int)(i & 15);
            const float inv = powf(10000.f, -(float)f / 16.f);
            const float ang = (float)pos * inv;
            const double a = (double)ang;
            const double k2 = rint(a * 0.15915494309189535);
            const float rr = (float)(a - k2 * 6.283185307179586);
            rc[i] = cosf(rr); rs[i] = sinf(rr);
        }
    }
}

struct EpiProj {
    bf16_t *cq, *ckv, *z, *xbc, *krope; float* dt; const float *rc, *rs, *dtb;
    DI void prefetch(int, int, int) {}
    DI void operator()(const float* Cs, int m0, int n0, int tid) const {
        const int c4 = (tid & 31) * 4, r0 = tid >> 5;
        if (n0 < 1920) {
            bf16_t* dst; int ld, cofs;
            if (n0 < 256) { dst = cq; ld = 256; cofs = n0; } else if (n0 < 384) { dst = ckv; ld = 128; cofs = n0 - 256; }
            else if (n0 < 896) { dst = z; ld = 512; cofs = n0 - 384; } else { dst = xbc; ld = 1024; cofs = n0 - 896; }
#pragma unroll 4
            for (int ps = 0; ps < 16; ++ps) { const int row = ps * 8 + r0; *(uint2*)(dst + (size_t)(m0 + row) * ld + cofs + c4) = pack4(cs4(Cs, row, c4)); }
        } else {
#pragma unroll
            for (int ps = 0; ps < 4; ++ps) {
                const int it = ps * 256 + tid, row = it >> 3, cc = (it & 7) * 4, grow = m0 + row;
                const float4 v = cs4(Cs, row, cc), pv = cs4(Cs, row, cc ^ 16);
                const int pos = grow & 2047, f = cc & 15;
                const float4 c = *(const float4*)(rc + pos * 16 + f), s = *(const float4*)(rs + pos * 16 + f);
                float4 o;
                if (cc < 16) { o.x = v.x * c.x - pv.x * s.x; o.y = v.y * c.y - pv.y * s.y; o.z = v.z * c.z - pv.z * s.z; o.w = v.w * c.w - pv.w * s.w; }
                else { o.x = v.x * c.x + pv.x * s.x; o.y = v.y * c.y + pv.y * s.y; o.z = v.z * c.z + pv.z * s.z; o.w = v.w * c.w + pv.w * s.w; }
                *(uint2*)(krope + (size_t)grow * 32 + cc) = pack4(o);
            }
#pragma unroll
            for (int ps = 0; ps < 4; ++ps) {
                const int it = ps * 256 + tid, row = it >> 3, cc = it & 7;
                dt[(size_t)(m0 + row) * 8 + cc] = softplusf(Cs[row * CS_LD + 32 + cc] + dtb[cc]);
            }
        }
    }
};
struct EpiMemKV {
    bf16_t *kx, *vxt;
    DI void prefetch(int, int, int) {}
    DI void operator()(const float* Cs, int m0, int n0, int tid) const {
        const int b = m0 >> 8, mm0 = m0 & 255;
        if (n0 < 1024) {
            const int c4 = (tid & 31) * 4, r0 = tid >> 5, hd = n0 >> 8, d = (n0 & 255) + c4;
#pragma unroll 4
            for (int ps = 0; ps < 16; ++ps) { const int row = ps * 8 + r0; *(uint2*)(kx + ((size_t)(b * 4 + hd) * 256 + mm0 + row) * 256 + d) = pack4(cs4(Cs, row, c4)); }
        } else {
            const int c2 = n0 - 1024, hd = c2 >> 8;
#pragma unroll 2
            for (int ps = 0; ps < 8; ++ps) {
                const int it = ps * 256 + tid, col = it & 127, rg = it >> 7, d = (c2 & 255) + col;
                uint4 w;
                w.x = pack2(Cs[(rg * 8 + 0) * CS_LD + col], Cs[(rg * 8 + 1) * CS_LD + col]); w.y = pack2(Cs[(rg * 8 + 2) * CS_LD + col], Cs[(rg * 8 + 3) * CS_LD + col]);
                w.z = pack2(Cs[(rg * 8 + 4) * CS_LD + col], Cs[(rg * 8 + 5) * CS_LD + col]); w.w = pack2(Cs[(rg * 8 + 6) * CS_LD + col], Cs[(rg * 8 + 7) * CS_LD + col]);
                *(uint4*)(vxt + ((size_t)(b * 4 + hd) * 256 + d) * 256 + mm0 + rg * 8) = w;
            }
        }
    }
};
DI void phase_proj(const P& p, int bid, int nb, unsigned char* smem, int rep = 0) {
    unsigned char* ws = p.ws;
    const int v = vbid(bid, nb);
    const bf16_t* xb = (const bf16_t*)(ws + XB);
    EpiProj e1{(bf16_t*)(ws + CQ), (bf16_t*)(ws + CKV), (bf16_t*)(ws + ZB), (bf16_t*)(ws + XBC), (bf16_t*)(ws + KROPE), (float*)(ws + DTB),
               (const float*)(ws + ROPE_C), (const float*)(ws + ROPE_S), p.in[9]};
    EpiMemKV e2{(bf16_t*)(ws + KX), (bf16_t*)(ws + VXT)};
    constexpr int NT1 = 256 * 16, NT2 = 32 * 16;
    for (int t = v; t < NT1 + NT2; t += nb) {
        if (rep && REP_MODE == 1 && t >= NT1) continue;
        if (rep && REP_MODE == 2 && t < NT1) continue;
        if (rep && REP_MODE == 3 && !(t < NT1 && (t & 7) == 7 && ((t >> 6) & 1))) continue;
        if (rep && REP_MODE == 4 && !(t < NT1 && ((t >> 6) & 1) == 0)) continue;
        const int u = t < NT1 ? t : t - NT1, c = u >> 6, j = u & 63, mt = (c >> 1) * 8 + (j >> 3), ntl = (c & 1) * 8 + (j & 7);
        if (t < NT1) { GemmArgs g{xb, 1024, (const bf16_t*)(ws + W_IN), 1024, 1024, nullptr}; gemm_tile(g, mt * 128, ntl * 128, e1, smem); }
        else { GemmArgs g{(const bf16_t*)(ws + MEMB), 1024, (const bf16_t*)(ws + W_XKV), 1024, 1024, nullptr}; gemm_tile(g, mt * 128, ntl * 128, e2, smem); }
    }
}

struct EpiQup {
    bf16_t* q; const float *rc, *rs; const float* rms;
    DI void prefetch(int, int, int) {}
    DI void operator()(const float* Cs, int m0, int n0, int tid) const {
        const int c4 = (tid & 31) * 4, r0 = tid >> 5;
        const int col = n0 + c4, head = col / 96, d = col - head * 96;
        const bool rope = d >= 64;
        const int b = m0 >> 11, s0 = m0 & 2047;
#pragma unroll 4
        for (int ps = 0; ps < 16; ++ps) {
            const int row = ps * 8 + r0;
            const float sc = rms[row] * QSCALE;
            float4 v = cs4(Cs, row, c4);
            if (rope) {
                const float4 pv = cs4(Cs, row, c4 ^ 16);
                const int pos = s0 + row, f = d & 15;
                const float4 c = *(const float4*)(rc + pos * 16 + f), s = *(const float4*)(rs + pos * 16 + f);
                if (d < 80) { v.x = v.x * c.x - pv.x * s.x; v.y = v.y * c.y - pv.y * s.y; v.z = v.z * c.z - pv.z * s.z; v.w = v.w * c.w - pv.w * s.w; }
                else { v.x = v.x * c.x + pv.x * s.x; v.y = v.y * c.y + pv.y * s.y; v.z = v.z * c.z + pv.z * s.z; v.w = v.w * c.w + pv.w * s.w; }
            }
            v.x *= sc; v.y *= sc; v.z *= sc; v.w *= sc;
            *(uint2*)(q + ((size_t)(b * 8 + head) * 2048 + s0 + row) * 96 + d) = pack4(v);
        }
    }
};
struct EpiKVup {
    bf16_t *kn, *vt; const float* rms;
    DI void prefetch(int, int, int) {}
    DI void operator()(const float* Cs, int m0, int n0, int tid) const {
        const int head = n0 >> 7, b = m0 >> 11, s0 = m0 & 2047;
#pragma unroll 4
        for (int ps = 0; ps < 8; ++ps) {
            const int it = ps * 256 + tid, row = it >> 4, c4 = (it & 15) * 4;
            const float sc = rms[row];
            float4 v = cs4(Cs, row, c4); v.x *= sc; v.y *= sc; v.z *= sc; v.w *= sc;
            *(uint2*)(kn + ((size_t)(b * 8 + head) * 2048 + s0 + row) * 64 + c4) = pack4(v);
        }
#pragma unroll 2
        for (int ps = 0; ps < 4; ++ps) {
            const int it = ps * 256 + tid, dv = it & 63, rg = it >> 6;
            const float* cp = Cs + (rg * 8) * CS_LD + 64 + dv; const float* rp = rms + rg * 8;
            uint4 w;
            w.x = pack2(cp[0] * rp[0], cp[CS_LD] * rp[1]); w.y = pack2(cp[2 * CS_LD] * rp[2], cp[3 * CS_LD] * rp[3]);
            w.z = pack2(cp[4 * CS_LD] * rp[4], cp[5 * CS_LD] * rp[5]); w.w = pack2(cp[6 * CS_LD] * rp[6], cp[7 * CS_LD] * rp[7]);
            *(uint4*)(vt + ((size_t)(b * 8 + head) * 64 + dv) * 2048 + s0 + rg * 8) = w;
        }
    }
};
template <int K>
DI void row_rms(const bf16_t* src, int m0, float* rms) {
    const int t = tidx(), row = t >> 1, half = t & 1;
    const uint4* s4 = (const uint4*)(src + (size_t)(m0 + row) * K + half * (K / 2));
    float ss = 0.f;
#pragma unroll
    for (int i = 0; i < K / 16; ++i) {
        const uint4 w = s4[i];
        const unsigned ww[4] = {w.x, w.y, w.z, w.w};
#pragma unroll
        for (int k = 0; k < 4; ++k) { const float a = bflo(ww[k]), b = bfhi(ww[k]); ss += a * a + b * b; }
    }
    ss += __shfl_xor(ss, 1);
    __syncthreads();
    if (half == 0) rms[row] = rsqrtf(ss * (1.f / K) + EPS);
    __syncthreads();
}
DI void phase_up(const P& p, int bid, int nb, unsigned char* smem) {
    unsigned char* ws = p.ws;
    const int v = vbid(bid, nb);
    float* rms = (float*)(smem + GEMM_LDS);
    constexpr int NTQ = 256 * 6, NTKV = 256 * 8;
    for (int t = v; t < NTQ + NTKV; t += nb) {
        if (t < NTQ) {
            const int mt = t / 6, ntl = t % 6;
            row_rms<256>((const bf16_t*)(ws + CQ), mt * 128, rms);
            EpiQup e{(bf16_t*)(ws + QB), (const float*)(ws + ROPE_C), (const float*)(ws + ROPE_S), rms};
            GemmArgs g{(const bf16_t*)(ws + CQ), 256, (const bf16_t*)(ws + W_QUP), 256, 256, nullptr};
            gemm_tile(g, mt * 128, ntl * 128, e, smem);
        } else {
            const int u = t - NTQ, mt = u >> 3, ntl = u & 7;
            row_rms<128>((const bf16_t*)(ws + CKV), mt * 128, rms);
            EpiKVup e{(bf16_t*)(ws + KNB), (bf16_t*)(ws + VTB), rms};
            GemmArgs g{(const bf16_t*)(ws + CKV), 128, (const bf16_t*)(ws + W_KVUP), 128, 128, nullptr};
            gemm_tile(g, mt * 128, ntl * 128, e, smem);
        }
    }
    {
        const bf16_t* xbc = (const bf16_t*)(ws + XBC); bf16_t* xa = (bf16_t*)(ws + XBCA);
        const float* cw = p.in[7]; const float* cb = p.in[8];
        const size_t gsz = (size_t)nb * 256;
        for (size_t i = (size_t)bid * 256 + tidx(); i < (size_t)T * 128; i += gsz) {
            const int tkn = (int)(i >> 7), c0 = (int)(i & 127) * 8, s_ = tkn & 2047;
            float accv[8];
#pragma unroll
            for (int k = 0; k < 8; ++k) accv[k] = cb[c0 + k];
#pragma unroll
            for (int j = 0; j < 4; ++j) {
                if (s_ + j - 3 >= 0) {
                    const uint4 w = *(const uint4*)(xbc + (size_t)(tkn + j - 3) * 1024 + c0);
                    const unsigned ww[4] = {w.x, w.y, w.z, w.w};
#pragma unroll
                    for (int k = 0; k < 4; ++k) {
                        accv[2 * k] += cw[j * 1024 + c0 + 2 * k] * bflo(ww[k]);
                        accv[2 * k + 1] += cw[j * 1024 + c0 + 2 * k + 1] * bfhi(ww[k]);
                    }
                }
            }
            uint4 o;
            o.x = pack2(siluf(accv[0]), siluf(accv[1])); o.y = pack2(siluf(accv[2]), siluf(accv[3]));
            o.z = pack2(siluf(accv[4]), siluf(accv[5])); o.w = pack2(siluf(accv[6]), siluf(accv[7]));
            *(uint4*)(xa + (size_t)tkn * 1024 + c0) = o;
        }
    }
}

DI int perm16(int k) { return (k & ~12) | ((k & 4) << 1) | ((k & 8) >> 1); }
template <int DQK, int DVW, int KT, int NQG, int NDV>
struct FlashCfg {
    static constexpr int KSTR = (DQK + 8) * 2;
    static constexpr int VSTR = (KT + 8) * 2;
    static constexpr int DV = DVW * NDV;
    static constexpr int KBYTES = KT * KSTR, VBYTES = DV * VSTR, STAGE = KBYTES + VBYTES;
    static constexpr int KCH = KT * DQK / 8 / 256;
    static constexpr int VCH = DV * KT / 8 / 256;
    static_assert(KT * DQK / 8 % 256 == 0 && DV * KT / 8 % 256 == 0, "chunk split");
    static_assert(2 * STAGE <= SMEM_BYTES - 32, "flash LDS");
};
template <int DQK, int DVW, int KT, int NQG, int NDV, class Src>
DI void flash_item(const Src& src, int ntiles, int nskip  , unsigned char* smem, bool noload = false) {
    typedef FlashCfg<DQK, DVW, KT, NQG, NDV> C;
    constexpr int NKS = DQK / 16, NKB = KT / 32, NDB = DVW / 32;
    int tid = tidx(); asm volatile("" : "+v"(tid));
    const int lane = tid & 63, wave = __builtin_amdgcn_readfirstlane(tid >> 6), r = lane & 31, h = lane >> 5;
    const int qg = wave / NDV, dvh = wave % NDV;
    bf16x8 qf[NKS];
    {
        const bf16_t* qp = src.qrow(qg * 32 + r) + 8 * h;
#pragma unroll
        for (int ks = 0; ks < NKS; ++ks) qf[ks] = *(const bf16x8*)(qp + 16 * ks);
    }
    f32x16 o[NDB];
#pragma unroll
    for (int d = 0; d < NDB; ++d)
#pragma unroll
        for (int e = 0; e < 16; ++e) o[d][e] = 0.f;
    float m = -1e30f, l = 0.f;
    uint4 kr[C::KCH], vr[C::VCH];
    auto gload = [&](int t) {
#pragma unroll
        for (int i = 0; i < C::KCH; ++i) { const int idx = tid + 256 * i; kr[i] = src.kload(t, idx / (DQK / 8), idx % (DQK / 8)); }
#pragma unroll
        for (int i = 0; i < C::VCH; ++i) { const int idx = tid + 256 * i; vr[i] = src.vload(t, idx / (KT / 8), idx % (KT / 8)); }
    };
    auto lstore = [&](unsigned char* buf) {
#pragma unroll
        for (int i = 0; i < C::KCH; ++i) { const int idx = tid + 256 * i; *(uint4*)(buf + (idx / (DQK / 8)) * C::KSTR + (idx % (DQK / 8)) * 16) = kr[i]; }
#pragma unroll
        for (int i = 0; i < C::VCH; ++i) {
            const int idx = tid + 256 * i, dv = idx / (KT / 8), c = idx % (KT / 8);
            unsigned char* row = buf + C::KBYTES + dv * C::VSTR + (c >> 1) * 32;
            const int a = c & 1;
            *(uint2*)(row + (4 * a) * 2) = make_uint2(vr[i].x, vr[i].y);
            *(uint2*)(row + (8 + 4 * a) * 2) = make_uint2(vr[i].z, vr[i].w);
        }
    };
    gload(0);
    __syncthreads();
    lstore(smem);
    __syncthreads();
    for (int t = 0; t < ntiles; ++t) {
        const unsigned char* cur = smem + (t & 1) * C::STAGE;
        const bool more = (t + 1 < ntiles);
        if (more && !noload) gload(t + 1);
        if (!(t == ntiles - 1 && qg < nskip)) {
            f32x16 s[NKB];
#pragma unroll
            for (int kb = 0; kb < NKB; ++kb) {
#pragma unroll
                for (int e = 0; e < 16; ++e) s[kb][e] = 0.f;
                const unsigned char* kp = cur + (kb * 32 + r) * C::KSTR + h * 16;
#pragma unroll
                for (int ks = 0; ks < NKS; ++ks) s[kb] = MFMA32(*(const bf16x8*)(kp + ks * 32), qf[ks], s[kb]);
            }
            float mx = s[0][0];
#pragma unroll
            for (int kb = 0; kb < NKB; ++kb)
#pragma unroll
                for (int e = 0; e < 16; ++e) mx = fmaxf(mx, s[kb][e]);
            mx = fmaxf(mx, __shfl_xor(mx, 32));
            const float mn = fmaxf(m, mx);
            const float alpha = __builtin_amdgcn_exp2f(m - mn);
            m = mn;
            float ps = 0.f;
#pragma unroll
            for (int kb = 0; kb < NKB; ++kb)
#pragma unroll
                for (int e = 0; e < 16; ++e) { const float pv = __builtin_amdgcn_exp2f(s[kb][e] - mn); s[kb][e] = pv; ps += pv; }
            l = l * alpha + ps;
#pragma unroll
            for (int d = 0; d < NDB; ++d)
#pragma unroll
                for (int e = 0; e < 16; ++e) o[d][e] *= alpha;
#pragma unroll
            for (int kb = 0; kb < NKB; ++kb)
#pragma unroll
                for (int s2 = 0; s2 < 2; ++s2) {
                    uint4 pk;
                    pk.x = pack2(s[kb][8 * s2], s[kb][8 * s2 + 1]); pk.y = pack2(s[kb][8 * s2 + 2], s[kb][8 * s2 + 3]);
                    pk.z = pack2(s[kb][8 * s2 + 4], s[kb][8 * s2 + 5]); pk.w = pack2(s[kb][8 * s2 + 6], s[kb][8 * s2 + 7]);
                    const bf16x8 pf = __builtin_bit_cast(bf16x8, pk);
                    const unsigned char* vp = cur + C::KBYTES + (dvh * DVW + r) * C::VSTR + (kb * 32 + s2 * 16 + 8 * h) * 2;
#pragma unroll
                    for (int d = 0; d < NDB; ++d) o[d] = MFMA32(*(const bf16x8*)(vp + d * 32 * C::VSTR), pf, o[d]);
                }
        }
        if (more) lstore(smem + ((t + 1) & 1) * C::STAGE);
        __syncthreads();
    }
    l += __shfl_xor(l, 32);
    const float il = 1.f / l;
#pragma unroll
    for (int d = 0; d < NDB; ++d)
#pragma unroll
        for (int g4 = 0; g4 < 4; ++g4) {
            uint2 w; w.x = pack2(o[d][4 * g4] * il, o[d][4 * g4 + 1] * il); w.y = pack2(o[d][4 * g4 + 2] * il, o[d][4 * g4 + 3] * il);
            src.store(qg * 32 + r, dvh * DVW + d * 32 + 8 * g4 + 4 * h, w);
        }
}
struct SelfSrc {
    const bf16_t *q, *kn, *kr, *vt; bf16_t* mix; int b, hd, bh, q0;
    DI const bf16_t* qrow(int rr) const { return q + ((size_t)bh * 2048 + q0 + rr) * 96; }
    DI uint4 kload(int t, int key, int c) const {
        const int kg = t * 64 + key;
        return c < 8 ? *(const uint4*)(kn + ((size_t)bh * 2048 + kg) * 64 + c * 8) : *(const uint4*)(kr + ((size_t)b * 2048 + kg) * 32 + (c - 8) * 8);
    }
    DI uint4 vload(int t, int dv, int c) const { return *(const uint4*)(vt + ((size_t)bh * 64 + dv) * 2048 + t * 64 + c * 8); }
    DI void store(int rr, int dv, uint2 w) const { *(uint2*)(mix + ((size_t)b * 2048 + q0 + rr) * 1024 + hd * 64 + dv) = w; }
};
struct CrossSrc {
    const bf16_t *qx, *kx, *vxt; bf16_t* ox; int b, hd, q0;
    DI const bf16_t* qrow(int rr) const { return qx + ((size_t)(b * 4 + hd) * 2048 + q0 + rr) * 256; }
    DI uint4 kload(int t, int key, int c) const { return *(const uint4*)(kx + ((size_t)(b * 4 + hd) * 256 + t * 32 + key) * 256 + c * 8); }
    DI uint4 vload(int t, int dv, int c) const { return *(const uint4*)(vxt + ((size_t)(b * 4 + hd) * 256 + dv) * 256 + t * 32 + c * 8); }
    DI void store(int rr, int dv, uint2 w) const { *(uint2*)(ox + ((size_t)b * 2048 + q0 + rr) * 1024 + hd * 256 + dv) = w; }
};
DI void attn_fast(const P& p, int bid, int nb, unsigned char* smem) {
    unsigned char* ws = p.ws;
    const int nround = (2048 + nb - 1) / nb;
    for (int rd = 0; rd < nround; ++rd) {
        const int idx = rd * nb + ((rd & 1) ? (nb - 1 - bid) : bid);
        if (idx >= 2048) continue;
        const int qb = 15 - (idx >> 7), bh = idx & 127;
        SelfSrc s{(const bf16_t*)(ws + QB), (const bf16_t*)(ws + KNB), (const bf16_t*)(ws + KROPE), (const bf16_t*)(ws + VTB), (bf16_t*)(ws + MIX), bh >> 3, bh & 7, bh, qb * 128};
        flash_item<96, 64, 64, 4, 1>(s, 2 * qb + 2, 2, smem);
    }
}
DI void xattn_fast(const P& p, int bid, int nb, unsigned char* smem) {
    unsigned char* ws = p.ws;
    for (int it = bid; it < 2048; it += nb) {
        const int bhd = it >> 5, qt = it & 31;
        CrossSrc s{(const bf16_t*)(ws + QX), (const bf16_t*)(ws + KX), (const bf16_t*)(ws + VXT), (bf16_t*)(ws + OX), bhd >> 2, bhd & 3, qt * 64};
        flash_item<256, 128, 32, 2, 2>(s, 8, 0, smem);
    }
}

constexpr int SSD_XT = 0, SSD_BM = 8192, SSD_CM = SSD_BM + 16384, SSD_BWT = SSD_CM + 16384, SSD_PS = SSD_BWT + 16384, SSD_F = SSD_PS + 16384;
static_assert(SSD_F + 2048 <= SMEM_BYTES - 32, "ssd LDS");
DI int off256(int row, int el) { return row * 256 + (((el >> 3) ^ (row & 15)) << 4) + ((el & 7) << 1); }
DI int off128(int row, int el) { return row * 128 + (((el >> 3) ^ ((row ^ (row >> 3)) & 7)) << 4) + ((el & 7) << 1); }
template <int pm>
DI void ssd_item(const P& p, int bh, unsigned char* smem) {
    unsigned char* ws = p.ws;
    const bf16_t* xa = (const bf16_t*)(ws + XBCA); const float* dtg = (const float*)(ws + DTB);
    bf16_t* mix = pm ? (bf16_t*)(ws + XBC) : (bf16_t*)(ws + MIX);
    int tid0 = tidx(); asm volatile("" : "+v"(tid0));
    const int wave = __builtin_amdgcn_readfirstlane(tid0 >> 6);
    const int b = bh >> 3, hd = bh & 7, g = hd >> 2;
    const int lb = wave >> 1, pb = wave & 1;
    const float a_h = -__expf(p.in[10][hd]), Dh = p.in[11][hd];
    float* F = (float*)(smem + SSD_F);
    __syncthreads();
    for (int i = tid0; i < 16384 / 16; i += 256) *(uint4*)(smem + SSD_PS + i * 16) = make_uint4(0u, 0u, 0u, 0u);
    f32x16 st[2];
#pragma unroll
    for (int i = 0; i < 2; ++i)
#pragma unroll
        for (int e = 0; e < 16; ++e) st[i][e] = 0.f;
    uint4 xr0, xr1, br0, br1, br2, br3, cr0, cr1, cr2, cr3; float dtr = 0.f;
#define SSD_XLD(i) (*(const uint4*)(xa + (t0_ + ((tid + 256 * (i)) >> 3)) * 1024 + hd * 64 + ((tid + 256 * (i)) & 7) * 8))
#define SSD_BLD(i, o) (*(const uint4*)(xa + (t0_ + ((tid + 256 * (i)) >> 4)) * 1024 + (o) + g * 128 + ((tid + 256 * (i)) & 15) * 8))
#define SSD_GLOAD(c_) do { const size_t t0_ = (size_t)b * 2048 + (c_) * 64; xr0 = SSD_XLD(0); xr1 = SSD_XLD(1); \
        br0 = SSD_BLD(0, 512); br1 = SSD_BLD(1, 512); br2 = SSD_BLD(2, 512); br3 = SSD_BLD(3, 512); \
        cr0 = SSD_BLD(0, 768); cr1 = SSD_BLD(1, 768); cr2 = SSD_BLD(2, 768); cr3 = SSD_BLD(3, 768); \
        if (tid < 64) dtr = dtg[(t0_ + tid) * 8 + hd]; } while (0)
    { const int tid = tid0; SSD_GLOAD(0); }
#define SSD_SCAN(FP) do { const int ln_ = tid0 & 63; float v = dtr * a_h; \
        _Pragma("unroll") for (int o = 1; o < 64; o <<= 1) { const float u = __shfl_up(v, o); if (ln_ >= o) v += u; } \
        const float a63 = __shfl(v, 63); \
        (FP)[ln_] = v; (FP)[64 + ln_] = __expf(v); (FP)[128 + ln_] = dtr; (FP)[192 + ln_] = __expf(a63 - v) * dtr; } while (0)
    if (wave == 0) SSD_SCAN(F);
    __syncthreads();
    for (int c = 0; c < 32; ++c) {
        int tid = tid0; asm volatile("" : "+v"(tid));
        const int lane = tid & 63, r = lane & 31, h = lane >> 5;
        const size_t t0 = (size_t)b * 2048 + c * 64;
        const float* Fc = F + (c & 1) * 256; float* Fn = F + ((c + 1) & 1) * 256;
#define SSD_XIMG(i, XR) do { const int idx = tid + 256 * (i), l = idx >> 3, p0 = (idx & 7) * 8, lp = perm16(l); \
            const unsigned ww[4] = {XR.x, XR.y, XR.z, XR.w}; \
            _Pragma("unroll") for (int k = 0; k < 4; ++k) { \
                *(bf16_t*)(smem + SSD_XT + off128(p0 + 2 * k, lp)) = (bf16_t)(ww[k] & 0xffffu); \
                *(bf16_t*)(smem + SSD_XT + off128(p0 + 2 * k + 1, lp)) = (bf16_t)(ww[k] >> 16); } } while (0)
#define SSD_BIMG(i, BR, CR) do { const int idx = tid + 256 * (i), l = idx >> 4, n0 = (idx & 15) * 8, lp = perm16(l); \
            *(uint4*)(smem + SSD_BM + off256(l, n0)) = BR; *(uint4*)(smem + SSD_CM + off256(l, n0)) = CR; \
            const float wl = Fc[192 + l]; const unsigned ww[4] = {BR.x, BR.y, BR.z, BR.w}; \
            _Pragma("unroll") for (int k = 0; k < 4; ++k) { \
                *(bf16_t*)(smem + SSD_BWT + off128(n0 + 2 * k, lp)) = f2bf(bflo(ww[k]) * wl); \
                *(bf16_t*)(smem + SSD_BWT + off128(n0 + 2 * k + 1, lp)) = f2bf(bfhi(ww[k]) * wl); } } while (0)
        if (!(pm & 2)) {
        SSD_XIMG(0, xr0); SSD_XIMG(1, xr1);
        SSD_BIMG(0, br0, cr0); SSD_BIMG(1, br1, cr1); SSD_BIMG(2, br2, cr2); SSD_BIMG(3, br3, cr3);
        } else { asm volatile("" :: "v"(xr0.x), "v"(xr1.x), "v"(br0.x), "v"(br1.x), "v"(br2.x), "v"(br3.x), "v"(cr0.x), "v"(cr1.x), "v"(cr2.x), "v"(cr3.x)); }
        __syncthreads();
        if (c + 1 < 32) SSD_GLOAD(c + 1);
        if (!(pm & 1)) {
        const float acs_l = Fc[lb * 32 + r];
        const int lrow = lb * 32 + r;
        f32x16 cb0, cb1, yo;
#pragma unroll
        for (int e = 0; e < 16; ++e) { cb0[e] = 0.f; cb1[e] = 0.f; yo[e] = 0.f; }
#pragma unroll
        for (int ks = 0; ks < 8; ++ks) {
            const bf16x8 cv = *(const bf16x8*)(smem + SSD_CM + off256(lb * 32 + r, 16 * ks + 8 * h));
            const bf16x8 b0v = *(const bf16x8*)(smem + SSD_BM + off256(r, 16 * ks + 8 * h));
            const bf16x8 b1v = *(const bf16x8*)(smem + SSD_BM + off256(32 + r, 16 * ks + 8 * h));
            const bf16x8 pv = *(const bf16x8*)(smem + SSD_PS + off256(pb * 32 + r, 16 * ks + 8 * h));
            cb0 = MFMA32(b0v, cv, cb0); cb1 = MFMA32(b1v, cv, cb1); yo = MFMA32(cv, pv, yo);
        }
        f32x16 yd;
#pragma unroll
        for (int e = 0; e < 16; ++e) yd[e] = 0.f;
#pragma unroll
        for (int sb = 0; sb < 2; ++sb) {
            float mv[16];
#pragma unroll
            for (int q4 = 0; q4 < 4; ++q4) {
                const int s0 = sb * 32 + 8 * q4 + 4 * h;
                const float4 as4 = *(const float4*)(Fc + s0), dt4 = *(const float4*)(Fc + 128 + s0);
                const float asv[4] = {as4.x, as4.y, as4.z, as4.w}, dtv[4] = {dt4.x, dt4.y, dt4.z, dt4.w};
#pragma unroll
                for (int k = 0; k < 4; ++k) { const float cbv = sb ? cb1[4 * q4 + k] : cb0[4 * q4 + k]; mv[4 * q4 + k] = (s0 + k <= lrow) ? cbv * __expf(acs_l - asv[k]) * dtv[k] : 0.f; }
            }
#pragma unroll
            for (int s2 = 0; s2 < 2; ++s2) {
                uint4 pk;
                pk.x = pack2(mv[8 * s2], mv[8 * s2 + 1]); pk.y = pack2(mv[8 * s2 + 2], mv[8 * s2 + 3]);
                pk.z = pack2(mv[8 * s2 + 4], mv[8 * s2 + 5]); pk.w = pack2(mv[8 * s2 + 6], mv[8 * s2 + 7]);
                const bf16x8 xb = *(const bf16x8*)(smem + SSD_XT + off128(pb * 32 + r, sb * 32 + 16 * s2 + 8 * h));
                yd = MFMA32(__builtin_bit_cast(bf16x8, pk), xb, yd);
            }
        }
        {
            const uint4 x0 = *(const uint4*)(smem + SSD_XT + off128(pb * 32 + r, lb * 32 + 8 * h));
            const uint4 x1 = *(const uint4*)(smem + SSD_XT + off128(pb * 32 + r, lb * 32 + 16 + 8 * h));
            const unsigned xw[8] = {x0.x, x0.y, x0.z, x0.w, x1.x, x1.y, x1.z, x1.w};
            bf16_t* op = mix + (t0 + lb * 32 + 4 * h) * 1024 + 512 + hd * 64 + pb * 32 + r;
#pragma unroll
            for (int q4 = 0; q4 < 4; ++q4) {
                const float4 ea4 = *(const float4*)(Fc + 64 + lb * 32 + 8 * q4 + 4 * h);
                const float eav[4] = {ea4.x, ea4.y, ea4.z, ea4.w};
#pragma unroll
                for (int k = 0; k < 4; ++k) {
                    const int e = 4 * q4 + k;
                    const float xv = (e & 1) ? bfhi(xw[e >> 1]) : bflo(xw[e >> 1]);
                    const float y = yd[e] + eav[k] * yo[e] + Dh * xv;
                    op[(size_t)(k + 8 * q4) * 1024] = f2bf(y);
                }
            }
        }
        {
            const float dec = Fc[64 + 63];
#pragma unroll
            for (int e = 0; e < 16; ++e) { st[0][e] *= dec; st[1][e] *= dec; }
            const int nblk = 2 * (wave >> 1);
#pragma unroll
            for (int ks = 0; ks < 4; ++ks) {
                const bf16x8 av = *(const bf16x8*)(smem + SSD_XT + off128(pb * 32 + r, 16 * ks + 8 * h));
                const bf16x8 bv0 = *(const bf16x8*)(smem + SSD_BWT + off128(nblk * 32 + r, 16 * ks + 8 * h));
                const bf16x8 bv1 = *(const bf16x8*)(smem + SSD_BWT + off128(nblk * 32 + 32 + r, 16 * ks + 8 * h));
                st[0] = MFMA32(av, bv0, st[0]); st[1] = MFMA32(av, bv1, st[1]);
            }
        }
        }
        if (wave == 0 && c + 1 < 32) SSD_SCAN(Fn);
        __syncthreads();
#pragma unroll
        for (int i = 0; i < 2; ++i) {
            const int n = (2 * (wave >> 1) + i) * 32 + r;
#pragma unroll
            for (int e = 0; e < 16; ++e) *(bf16_t*)(smem + SSD_PS + off256(pb * 32 + crow(e, h), n)) = f2bf(st[i][e]);
        }
    }
    __syncthreads();
}

#if ATTN_NAIVE
DI void attn_naive(const P& p, int bid, int nb) {
    unsigned char* ws = p.ws;
    const bf16_t* Q = (const bf16_t*)(ws + QB); const bf16_t* Kn = (const bf16_t*)(ws + KNB); const bf16_t* Vt = (const bf16_t*)(ws + VTB);
    const bf16_t* Kr = (const bf16_t*)(ws + KROPE); bf16_t* mix = (bf16_t*)(ws + MIX);
    for (int item = bid; item < 128 * 8; item += nb) {
        const int bh = item >> 3, s_ = (item & 7) * 256 + tidx(), b = bh >> 3, hd = bh & 7;
        float q[96];
        {
            const uint4* q4 = (const uint4*)(Q + ((size_t)bh * 2048 + s_) * 96);
#pragma unroll
            for (int i = 0; i < 12; ++i) { const uint4 w = q4[i]; q[8 * i] = bflo(w.x); q[8 * i + 1] = bfhi(w.x); q[8 * i + 2] = bflo(w.y); q[8 * i + 3] = bfhi(w.y);
                q[8 * i + 4] = bflo(w.z); q[8 * i + 5] = bfhi(w.z); q[8 * i + 6] = bflo(w.w); q[8 * i + 7] = bfhi(w.w); }
        }
        float o[64];
#pragma unroll
        for (int d = 0; d < 64; ++d) o[d] = 0.f;
        float m = -1e30f, l = 0.f;
        const int nkeys = __builtin_amdgcn_readfirstlane(((s_ >> 6) + 1) * 64);
        for (int j0 = 0; j0 < nkeys; j0 += 8) {
            float sc[8];
#pragma unroll
            for (int jj = 0; jj < 8; ++jj) {
                const int j = j0 + jj;
                const uint4* k4 = (const uint4*)(Kn + ((size_t)bh * 2048 + j) * 64);
                const uint4* r4 = (const uint4*)(Kr + ((size_t)b * 2048 + j) * 32);
                float a = 0.f;
#pragma unroll
                for (int i = 0; i < 8; ++i) { const uint4 w = k4[i]; a += q[8 * i] * bflo(w.x) + q[8 * i + 1] * bfhi(w.x) + q[8 * i + 2] * bflo(w.y) + q[8 * i + 3] * bfhi(w.y)
                    + q[8 * i + 4] * bflo(w.z) + q[8 * i + 5] * bfhi(w.z) + q[8 * i + 6] * bflo(w.w) + q[8 * i + 7] * bfhi(w.w); }
#pragma unroll
                for (int i = 0; i < 4; ++i) { const uint4 w = r4[i]; const int o8 = 64 + 8 * i; a += q[o8] * bflo(w.x) + q[o8 + 1] * bfhi(w.x) + q[o8 + 2] * bflo(w.y) + q[o8 + 3] * bfhi(w.y)
                    + q[o8 + 4] * bflo(w.z) + q[o8 + 5] * bfhi(w.z) + q[o8 + 6] * bflo(w.w) + q[o8 + 7] * bfhi(w.w); }
                sc[jj] = a;
            }
            float mx = m;
#pragma unroll
            for (int jj = 0; jj < 8; ++jj) mx = fmaxf(mx, sc[jj]);
            const float al = exp2f(m - mx);
            float ps = 0.f;
#pragma unroll
            for (int jj = 0; jj < 8; ++jj) { sc[jj] = exp2f(sc[jj] - mx); ps += sc[jj]; }
            l = l * al + ps; m = mx;
#pragma unroll
            for (int d = 0; d < 64; ++d) {
                const uint4 w = *(const uint4*)(Vt + ((size_t)bh * 64 + d) * 2048 + j0);
                o[d] = o[d] * al + sc[0] * bflo(w.x) + sc[1] * bfhi(w.x) + sc[2] * bflo(w.y) + sc[3] * bfhi(w.y) + sc[4] * bflo(w.z) + sc[5] * bfhi(w.z) + sc[6] * bflo(w.w) + sc[7] * bfhi(w.w);
            }
        }
        const float il = 1.f / l;
        bf16_t* dst = mix + ((size_t)b * 2048 + s_) * 1024 + hd * 64;
#pragma unroll
        for (int d = 0; d < 64; d += 2) *(unsigned*)(dst + d) = pack2(o[d] * il, o[d + 1] * il);
    }
}
#endif
#if SSD_NAIVE
DI void ssd_naive(const P& p, int bid, int nb) {
    unsigned char* ws = p.ws;
    const bf16_t* xa = (const bf16_t*)(ws + XBCA); const float* dt = (const float*)(ws + DTB); const bf16_t* z = (const bf16_t*)(ws + ZB);
    bf16_t* mix = (bf16_t*)(ws + MIX);
    const int wave = tidx() >> 6, pp = tidx() & 63;
    for (int item = bid; item < 32; item += nb) {
        const int bh = item * 4 + wave, b = bh >> 3, hd = bh & 7, g = hd >> 2;
        const float a = -__expf(p.in[10][hd]), Dh = p.in[11][hd];
        float st[128];
#pragma unroll
        for (int n = 0; n < 128; ++n) st[n] = 0.f;
        for (int t = 0; t < 2048; ++t) {
            const size_t row = (size_t)b * 2048 + t;
            const float dtv = dt[row * 8 + hd];
            const float da = __expf(dtv * a);
            const float xv = bf2f(xa[row * 1024 + hd * 64 + pp]);
            const float xd = dtv * xv;
            const uint4* b4 = (const uint4*)(xa + row * 1024 + 512 + g * 128);
            const uint4* c4 = (const uint4*)(xa + row * 1024 + 768 + g * 128);
            float y = 0.f;
#pragma unroll
            for (int i = 0; i < 16; ++i) {
                const uint4 bw = b4[i], cw = c4[i];
                const unsigned bb[4] = {bw.x, bw.y, bw.z, bw.w}, cc[4] = {cw.x, cw.y, cw.z, cw.w};
#pragma unroll
                for (int k = 0; k < 4; ++k) {
                    const int n = 8 * i + 2 * k;
                    st[n] = da * st[n] + xd * bflo(bb[k]); y += bflo(cc[k]) * st[n];
                    st[n + 1] = da * st[n + 1] + xd * bfhi(bb[k]); y += bfhi(cc[k]) * st[n + 1];
                }
            }
            y += Dh * xv;
            const float zv = bf2f(z[row * 512 + hd * 64 + pp]);
            mix[row * 1024 + 512 + hd * 64 + pp] = f2bf(y * siluf(zv));
        }
    }
}
#endif
DI void phase_mixer(const P& p, int bid, int nb, unsigned char* smem, int rep = 0) {
#if SSD_NAIVE
    ssd_naive(p, bid, nb);
    attn_fast(p, bid, nb, smem);
#else
    unsigned* ctr = (unsigned*)(p.ws + CTL + CTL_QUEUE) + 64 * rep;
    int* slot = (int*)(smem + SMEM_BYTES - 32);
    for (;;) {
        __syncthreads();
        if (tidx() == 0) *slot = (int)atomicAdd(ctr, 1u);
        __syncthreads();
        const int it = *slot;
        if (it >= 128 + 2048) break;
        if (it < 128) { if (!NO_SSD && !(rep && REP_MODE == 2)) { if (rep) ssd_item<SSD_PM>(p, it, smem); else ssd_item<0>(p, it, smem); } }
        else if (rep && REP_MODE >= 1) { }
        else {
            const int idx = it - 128, qb = 15 - (idx >> 7), bh = idx & 127;
            unsigned char* ws = p.ws;
            SelfSrc s{(const bf16_t*)(ws + QB), (const bf16_t*)(ws + KNB), (const bf16_t*)(ws + KROPE), (const bf16_t*)(ws + VTB), (bf16_t*)(ws + MIX), bh >> 3, bh & 7, bh, qb * 128};
            if (rep) s.mix = (bf16_t*)(ws + XBC);
            if (!NO_FLASH) flash_item<96, 64, 64, 4, 1>(s, 2 * qb + 2, 2, smem, rep && REP_MODE == 5);
        }
    }
#endif
}

DI void phase_ssdnorm(const P& p, int bid, int nb, unsigned char* smem) {
    bf16_t* mix = (bf16_t*)(p.ws + MIX); const bf16_t* z = (const bf16_t*)(p.ws + ZB);
    const int lane = tidx() & 63, wave = tidx() >> 6;
    for (int tk = bid * 4 + wave; tk < T; tk += nb * 4) {
        uint4* ptr = (uint4*)(mix + (size_t)tk * 1024 + 512 + lane * 8);
        const uint4 w = *ptr, zz = *(const uint4*)(z + (size_t)tk * 512 + lane * 8);
        const unsigned ww[4] = {w.x, w.y, w.z, w.w}, zw[4] = {zz.x, zz.y, zz.z, zz.w};
        float v[8]; float ss = 0.f;
#pragma unroll
        for (int k = 0; k < 4; ++k) {
            v[2 * k] = bflo(ww[k]) * siluf(bflo(zw[k])); v[2 * k + 1] = bfhi(ww[k]) * siluf(bfhi(zw[k]));
            ss += v[2 * k] * v[2 * k] + v[2 * k + 1] * v[2 * k + 1];
        }
#pragma unroll
        for (int o = 16; o >= 1; o >>= 1) ss += __shfl_xor(ss, o);
        const float rr = rsqrtf(ss * (1.f / 256.f) + EPS);
        uint4 o4; o4.x = pack2(v[0] * rr, v[1] * rr); o4.y = pack2(v[2] * rr, v[3] * rr); o4.z = pack2(v[4] * rr, v[5] * rr); o4.w = pack2(v[6] * rr, v[7] * rr);
        *ptr = o4;
    }
}

struct EpiResid {
    float* pre; const float* res;
    float4 pf[16];
    DI void prefetch(int m0, int n0, int tid) {
        const int c4 = (tid & 31) * 4, r0 = tid >> 5;
#pragma unroll
        for (int ps = 0; ps < 16; ++ps) pf[ps] = *(const float4*)(res + (size_t)(m0 + ps * 8 + r0) * 1024 + n0 + c4);
    }
    DI void operator()(const float* Cs, int m0, int n0, int tid) const {
        const int c4 = (tid & 31) * 4, r0 = tid >> 5;
#pragma unroll
        for (int ps = 0; ps < 16; ++ps) {
            const int row = ps * 8 + r0;
            const float4 v = cs4(Cs, row, c4), rr = pf[ps];
            *(float4*)(pre + (size_t)(m0 + row) * 1024 + n0 + c4) = make_float4(ALPHA * rr.x + v.x, ALPHA * rr.y + v.y, ALPHA * rr.z + v.z, ALPHA * rr.w + v.w);
        }
    }
};
DI void phase_wout(const P& p, int bid, int nb, unsigned char* smem) {
    const int v = vbid(bid, nb);
    EpiResid e; e.pre = p.out; e.res = p.in[0];
    GemmArgs g{(const bf16_t*)(p.ws + MIX), 1024, (const bf16_t*)(p.ws + W_OUT), 1024, 1024, nullptr};
    for (int t = v; t < 256 * 8; t += nb) gemm_tile(g, (t >> 3) * 128, (t & 7) * 128, e, smem);
}
DI void ln_row(const float* src, const float* gam, const float* bet, int lane, float (&o)[16]) {
    float v[16];
#pragma unroll
    for (int i = 0; i < 4; ++i) { const float4 t4 = *(const float4*)(src + i * 256 + lane * 4); v[4 * i] = t4.x; v[4 * i + 1] = t4.y; v[4 * i + 2] = t4.z; v[4 * i + 3] = t4.w; }
    float s = 0.f;
#pragma unroll
    for (int i = 0; i < 16; ++i) s += v[i];
    const float mu = wave_sum(s) * (1.f / 1024.f);
    float q = 0.f;
#pragma unroll
    for (int i = 0; i < 16; ++i) { const float d = v[i] - mu; q += d * d; }
    const float rstd = rsqrtf(wave_sum(q) * (1.f / 1024.f) + EPS);
#pragma unroll
    for (int i = 0; i < 4; ++i) {
        const float4 g4 = *(const float4*)(gam + i * 256 + lane * 4), b4 = *(const float4*)(bet + i * 256 + lane * 4);
        o[4 * i] = (v[4 * i] - mu) * rstd * g4.x + b4.x; o[4 * i + 1] = (v[4 * i + 1] - mu) * rstd * g4.y + b4.y;
        o[4 * i + 2] = (v[4 * i + 2] - mu) * rstd * g4.z + b4.z; o[4 * i + 3] = (v[4 * i + 3] - mu) * rstd * g4.w + b4.w;
    }
}
DI void ln_stats2(const float (&va)[16], const float (&vb)[16], float& mua, float& rsa, float& mub, float& rsb) {
    float sa = 0.f, sb = 0.f;
#pragma unroll
    for (int i = 0; i < 16; ++i) { sa += va[i]; sb += vb[i]; }
#pragma unroll
    for (int o = 32; o >= 1; o >>= 1) { sa += __shfl_xor(sa, o); sb += __shfl_xor(sb, o); }
    mua = sa * (1.f / 1024.f); mub = sb * (1.f / 1024.f);
    float qa = 0.f, qb = 0.f;
#pragma unroll
    for (int i = 0; i < 16; ++i) { const float da = va[i] - mua, db = vb[i] - mub; qa += da * da; qb += db * db; }
#pragma unroll
    for (int o = 32; o >= 1; o >>= 1) { qa += __shfl_xor(qa, o); qb += __shfl_xor(qb, o); }
    rsa = rsqrtf(qa * (1.f / 1024.f) + EPS); rsb = rsqrtf(qb * (1.f / 1024.f) + EPS);
}
DI void load_row16(const float* src, int lane, float (&v)[16]) {
#pragma unroll
    for (int i = 0; i < 4; ++i) { const float4 t4 = *(const float4*)(src + i * 256 + lane * 4); v[4 * i] = t4.x; v[4 * i + 1] = t4.y; v[4 * i + 2] = t4.z; v[4 * i + 3] = t4.w; }
}
DI void phase_ln1(const P& p, int bid, int nb, unsigned char* smem) {
    const int lane = tidx() & 63, wave = tidx() >> 6;
    float* hf = (float*)(p.ws + H1); bf16_t* hb = (bf16_t*)(p.ws + H1B);
    const float* gam = p.in[14]; const float* bet = p.in[15];
    for (int tk = bid * 4 + wave; tk < T; tk += nb * 8) {
        const int tk2 = tk + nb * 4;
        float va[16], vb[16], mua, rsa, mub, rsb;
        load_row16(p.out + (size_t)tk * 1024, lane, va); load_row16(p.out + (size_t)tk2 * 1024, lane, vb);
        ln_stats2(va, vb, mua, rsa, mub, rsb);
#pragma unroll
        for (int i = 0; i < 4; ++i) {
            const float4 g4 = *(const float4*)(gam + i * 256 + lane * 4), b4 = *(const float4*)(bet + i * 256 + lane * 4);
            const float4 oa = make_float4((va[4 * i] - mua) * rsa * g4.x + b4.x, (va[4 * i + 1] - mua) * rsa * g4.y + b4.y, (va[4 * i + 2] - mua) * rsa * g4.z + b4.z, (va[4 * i + 3] - mua) * rsa * g4.w + b4.w);
            const float4 ob = make_float4((vb[4 * i] - mub) * rsb * g4.x + b4.x, (vb[4 * i + 1] - mub) * rsb * g4.y + b4.y, (vb[4 * i + 2] - mub) * rsb * g4.z + b4.z, (vb[4 * i + 3] - mub) * rsb * g4.w + b4.w);
            *(float4*)(hf + (size_t)tk * 1024 + i * 256 + lane * 4) = oa; *(float4*)(hf + (size_t)tk2 * 1024 + i * 256 + lane * 4) = ob;
            *(uint2*)(hb + (size_t)tk * 1024 + i * 256 + lane * 4) = pack4(oa); *(uint2*)(hb + (size_t)tk2 * 1024 + i * 256 + lane * 4) = pack4(ob);
        }
    }
}
struct EpiXq {
    bf16_t* qx;
    DI void prefetch(int, int, int) {}
    DI void operator()(const float* Cs, int m0, int n0, int tid) const {
        const int c4 = (tid & 31) * 4, r0 = tid >> 5, hd = n0 >> 8, d = (n0 & 255) + c4, b = m0 >> 11, s0 = m0 & 2047;
#pragma unroll 4
        for (int ps = 0; ps < 16; ++ps) {
            const int row = ps * 8 + r0;
            float4 v = cs4(Cs, row, c4); v.x *= XSCALE; v.y *= XSCALE; v.z *= XSCALE; v.w *= XSCALE;
            *(uint2*)(qx + ((size_t)(b * 4 + hd) * 2048 + s0 + row) * 256 + d) = pack4(v);
        }
    }
};
DI void phase_xq(const P& p, int bid, int nb, unsigned char* smem) {
    const int v = vbid(bid, nb);
    EpiXq e{(bf16_t*)(p.ws + QX)};
    GemmArgs g{(const bf16_t*)(p.ws + H1B), 1024, (const bf16_t*)(p.ws + W_XQ), 1024, 1024, nullptr};
    for (int t = v; t < 256 * 8; t += nb) gemm_tile(g, (t >> 3) * 128, (t & 7) * 128, e, smem);
}
DI void phase_xattn(const P& p, int bid, int nb, unsigned char* smem) {
#if !XATTN_NAIVE
    xattn_fast(p, bid, nb, smem); return;
#endif
    unsigned char* ws = p.ws;
    const bf16_t* qx = (const bf16_t*)(ws + QX); const bf16_t* kx = (const bf16_t*)(ws + KX); const bf16_t* vxt = (const bf16_t*)(ws + VXT);
    bf16_t* ox = (bf16_t*)(ws + OX);
    const int lane = tidx() & 63, hd = tidx() >> 6;
    float* qs = (float*)smem + hd * 512; float* ps = qs + 256;
    for (int tk = bid; tk < T; tk += nb) {
        const int b = tk >> 11, s_ = tk & 2047;
        __syncthreads();
        {
            const uint2 w = *(const uint2*)(qx + ((size_t)(b * 4 + hd) * 2048 + s_) * 256 + lane * 4);
            qs[lane * 4] = bflo(w.x); qs[lane * 4 + 1] = bfhi(w.x); qs[lane * 4 + 2] = bflo(w.y); qs[lane * 4 + 3] = bfhi(w.y);
        }
        __syncthreads();
        float sc[4];
#pragma unroll
        for (int i = 0; i < 4; ++i) {
            const int m = lane + 64 * i;
            const uint4* k4 = (const uint4*)(kx + ((size_t)(b * 4 + hd) * 256 + m) * 256);
            float a = 0.f;
#pragma unroll 8
            for (int c = 0; c < 32; ++c) {
                const uint4 w = k4[c];
                const float4 q0 = *(const float4*)(qs + 8 * c), q1 = *(const float4*)(qs + 8 * c + 4);
                a += q0.x * bflo(w.x) + q0.y * bfhi(w.x) + q0.z * bflo(w.y) + q0.w * bfhi(w.y) + q1.x * bflo(w.z) + q1.y * bfhi(w.z) + q1.z * bflo(w.w) + q1.w * bfhi(w.w);
            }
            sc[i] = a;
        }
        const float mx = wave_max(fmaxf(fmaxf(sc[0], sc[1]), fmaxf(sc[2], sc[3])));
        float sum = 0.f;
#pragma unroll
        for (int i = 0; i < 4; ++i) { sc[i] = exp2f(sc[i] - mx); sum += sc[i]; }
        const float il = 1.f / wave_sum(sum);
#pragma unroll
        for (int i = 0; i < 4; ++i) ps[lane + 64 * i] = sc[i] * il;
        __syncthreads();
        float o[4];
#pragma unroll
        for (int dd = 0; dd < 4; ++dd) {
            const int d = lane * 4 + dd;
            const uint4* v4 = (const uint4*)(vxt + ((size_t)(b * 4 + hd) * 256 + d) * 256);
            float a = 0.f;
#pragma unroll 8
            for (int c = 0; c < 32; ++c) {
                const uint4 w = v4[c];
                const float4 q0 = *(const float4*)(ps + 8 * c), q1 = *(const float4*)(ps + 8 * c + 4);
                a += q0.x * bflo(w.x) + q0.y * bfhi(w.x) + q0.z * bflo(w.y) + q0.w * bfhi(w.y) + q1.x * bflo(w.z) + q1.y * bfhi(w.z) + q1.z * bflo(w.w) + q1.w * bfhi(w.w);
            }
            o[dd] = a;
        }
        uint2 w; w.x = pack2(o[0], o[1]); w.y = pack2(o[2], o[3]);
        *(uint2*)(ox + (size_t)tk * 1024 + hd * 256 + lane * 4) = w;
    }
}
DI void phase_xo(const P& p, int bid, int nb, unsigned char* smem) {
    const int v = vbid(bid, nb);
    EpiResid e; e.pre = p.out; e.res = (const float*)(p.ws + H1);
    GemmArgs g{(const bf16_t*)(p.ws + OX), 1024, (const bf16_t*)(p.ws + W_XO), 1024, 1024, nullptr};
    for (int t = v; t < 256 * 8; t += nb) gemm_tile(g, (t >> 3) * 128, (t & 7) * 128, e, smem);
}
typedef float f32x4v __attribute__((ext_vector_type(4)));
DI void phase_ln2_router(const P& p, int bid, int nb, unsigned char* smem, int rep = 0) {
    unsigned char* ws = p.ws;
    const int lane = tidx() & 63, wave = tidx() >> 6;
    float* hf = (float*)(ws + H2); bf16_t* hb = (bf16_t*)(ws + H2B);
    const float* wrt = (const float*)(ws + W_RT);
    const float* gam = p.in[20]; const float* bet = p.in[21];
    unsigned* cnt = (unsigned*)(ws + CTL + CTL_CNT); int* lists = (int*)(ws + LISTS); float* tgate = (float*)(ws + TOK_GATE);
    float* lg = (float*)smem + wave * (16 * 52 + 32);
    float* stt = lg + 16 * 52;
    for (int grp = bid; grp < T / 64; grp += nb) {
        const int t0 = grp * 64 + wave * 16;
        for (int rr = 0; rr < 16; rr += 2) {
            if (rep && REP_MODE == 3) break;
            const int tk = t0 + rr;
            float va[16], vb[16], mua, rsa, mub, rsb;
            load_row16(p.out + (size_t)tk * 1024, lane, va); load_row16(p.out + (size_t)(tk + 1) * 1024, lane, vb);
            ln_stats2(va, vb, mua, rsa, mub, rsb);
            if (lane == 0) { stt[2 * rr] = mua; stt[2 * rr + 1] = rsa; stt[2 * rr + 2] = mub; stt[2 * rr + 3] = rsb; }
#pragma unroll
            for (int i = 0; i < 4; ++i) {
                const float4 g4 = *(const float4*)(gam + i * 256 + lane * 4), b4 = *(const float4*)(bet + i * 256 + lane * 4);
                const float4 oa = make_float4((va[4 * i] - mua) * rsa * g4.x + b4.x, (va[4 * i + 1] - mua) * rsa * g4.y + b4.y, (va[4 * i + 2] - mua) * rsa * g4.z + b4.z, (va[4 * i + 3] - mua) * rsa * g4.w + b4.w);
                const float4 ob = make_float4((vb[4 * i] - mub) * rsb * g4.x + b4.x, (vb[4 * i + 1] - mub) * rsb * g4.y + b4.y, (vb[4 * i + 2] - mub) * rsb * g4.z + b4.z, (vb[4 * i + 3] - mub) * rsb * g4.w + b4.w);
                *(float4*)(hf + (size_t)tk * 1024 + i * 256 + lane * 4) = oa; *(float4*)(hf + (size_t)(tk + 1) * 1024 + i * 256 + lane * 4) = ob;
                *(uint2*)(hb + (size_t)tk * 1024 + i * 256 + lane * 4) = pack4(oa); *(uint2*)(hb + (size_t)(tk + 1) * 1024 + i * 256 + lane * 4) = pack4(ob);
            }
        }
        __builtin_amdgcn_wave_barrier();
        if (!(rep && REP_MODE == 2)) {
            const int i16 = lane & 15, g4i = lane >> 4;
            const float mu = stt[2 * i16], rstd = stt[2 * i16 + 1];
            const float* arow = p.out + (size_t)(t0 + i16) * 1024 + 4 * g4i;
            const float* brow = wrt + (size_t)i16 * 1024 + 4 * g4i;
            const float* grow = gam + 4 * g4i; const float* berow = bet + 4 * g4i;
            f32x4v acc0 = {0.f, 0.f, 0.f, 0.f}, acc1 = acc0, acc2 = acc0;
#pragma unroll 2
            for (int S = 0; S < 64; ++S) {
                const float4 x4 = *(const float4*)(arow + 16 * S), g4 = *(const float4*)(grow + 16 * S), e4 = *(const float4*)(berow + 16 * S);
                const float4 b0 = *(const float4*)(brow + 16 * S), b1 = *(const float4*)(brow + 16 * 1024 + 16 * S), b2 = *(const float4*)(brow + 32 * 1024 + 16 * S);
                const float a0 = (x4.x - mu) * rstd * g4.x + e4.x, a1 = (x4.y - mu) * rstd * g4.y + e4.y, a2 = (x4.z - mu) * rstd * g4.z + e4.z, a3 = (x4.w - mu) * rstd * g4.w + e4.w;
                acc0 = __builtin_amdgcn_mfma_f32_16x16x4f32(a0, b0.x, acc0, 0, 0, 0); acc1 = __builtin_amdgcn_mfma_f32_16x16x4f32(a0, b1.x, acc1, 0, 0, 0); acc2 = __builtin_amdgcn_mfma_f32_16x16x4f32(a0, b2.x, acc2, 0, 0, 0);
                acc0 = __builtin_amdgcn_mfma_f32_16x16x4f32(a1, b0.y, acc0, 0, 0, 0); acc1 = __builtin_amdgcn_mfma_f32_16x16x4f32(a1, b1.y, acc1, 0, 0, 0); acc2 = __builtin_amdgcn_mfma_f32_16x16x4f32(a1, b2.y, acc2, 0, 0, 0);
                acc0 = __builtin_amdgcn_mfma_f32_16x16x4f32(a2, b0.z, acc0, 0, 0, 0); acc1 = __builtin_amdgcn_mfma_f32_16x16x4f32(a2, b1.z, acc1, 0, 0, 0); acc2 = __builtin_amdgcn_mfma_f32_16x16x4f32(a2, b2.z, acc2, 0, 0, 0);
                acc0 = __builtin_amdgcn_mfma_f32_16x16x4f32(a3, b0.w, acc0, 0, 0, 0); acc1 = __builtin_amdgcn_mfma_f32_16x16x4f32(a3, b1.w, acc1, 0, 0, 0); acc2 = __builtin_amdgcn_mfma_f32_16x16x4f32(a3, b2.w, acc2, 0, 0, 0);
            }
#pragma unroll
            for (int e = 0; e < 4; ++e) {
                float* rowp = lg + (4 * g4i + e) * 52 + i16;
                rowp[0] = acc0[e]; rowp[16] = acc1[e]; rowp[32] = acc2[e];
            }
        }
        __builtin_amdgcn_wave_barrier();
        unsigned* lcount = (unsigned*)((float*)smem + 4 * (16 * 52 + 32));
        unsigned* lbase = lcount + 32;
        if (tidx() < 32) lcount[tidx()] = 0u;
        __syncthreads();
        int ex1 = 0, ex2 = 0; unsigned lp1 = 0, lp2 = 0;
        if (lane < 16) {
            const int tk = t0 + lane;
            const float* lr = lg + lane * 52;
            float gl[4], el[32];
#pragma unroll
            for (int j = 0; j < 4; ++j) gl[j] = lr[j] + p.in[23][j];
#pragma unroll
            for (int j = 0; j < 32; ++j) el[j] = lr[4 + j] + p.in[25][j];
            int gi = 0; float gm = gl[0];
#pragma unroll
            for (int j = 1; j < 4; ++j) if (gl[j] > gm) { gm = gl[j]; gi = j; }
            float gs = 0.f;
#pragma unroll
            for (int j = 0; j < 4; ++j) gs += __expf(gl[j] - gm);
            const float ggate = 1.f / gs;
            float ev[8];
#pragma unroll
            for (int j = 0; j < 8; ++j) ev[j] = gi == 0 ? el[j] : gi == 1 ? el[8 + j] : gi == 2 ? el[16 + j] : el[24 + j];
            int i1 = 0; float v1 = ev[0];
#pragma unroll
            for (int j = 1; j < 8; ++j) if (ev[j] > v1) { v1 = ev[j]; i1 = j; }
            int i2 = -1; float v2 = -3.0e38f;
#pragma unroll
            for (int j = 0; j < 8; ++j) if (j != i1 && ev[j] > v2) { v2 = ev[j]; i2 = j; }
            const float e2 = __expf(v2 - v1);
            tgate[tk * 2] = ggate / (1.f + e2); tgate[tk * 2 + 1] = ggate * e2 / (1.f + e2);
            ex1 = gi * 8 + i1; ex2 = gi * 8 + i2;
            if (!rep) { lp1 = atomicAdd(&lcount[ex1], 1u); lp2 = atomicAdd(&lcount[ex2], 1u); }
        }
        __syncthreads();
        if (tidx() < 32 && !rep) { const unsigned c = lcount[tidx()]; lbase[tidx()] = c ? atomicAdd(&cnt[tidx() * CNT_STRIDE], c) : 0u; }
        __syncthreads();
        if (lane < 16 && !rep) {
            const int tk = t0 + lane;
            lists[(size_t)ex1 * T + lbase[ex1] + lp1] = tk * 2;
            lists[(size_t)ex2 * T + lbase[ex2] + lp2] = tk * 2 + 1;
        }
        __syncthreads();
    }
}
struct MoeMap { int off[33]; };
DI int moe_tiles(const unsigned* cnt, int* offs  ) {
    __syncthreads();
    if (tidx() == 0) { int o = 0; for (int e = 0; e < 32; ++e) { offs[e] = o; o += (((int)cnt[e * CNT_STRIDE] + 127) >> 7) << 7; } offs[32] = o; }
    __syncthreads();
    return offs[32] >> 7;
}
struct EpiGU {
    bf16_t* hdn;
    DI void prefetch(int, int, int) {}
    DI void operator()(const float* Cs, int m0, int n0, int tid) const {
#pragma unroll 4
        for (int ps = 0; ps < 8; ++ps) {
            const int it = ps * 256 + tid, row = it >> 4, qd = it & 15, c = (qd >> 3) * 64 + (qd & 7) * 4;
            const float4 g = cs4(Cs, row, c), u = cs4(Cs, row, c + 32);
            const int hc = ((n0 & 511) >> 7) * 64 + (qd >> 3) * 32 + (qd & 7) * 4;
            *(uint2*)(hdn + (size_t)(m0 + row) * 256 + hc) = pack4(make_float4(siluf(g.x) * u.x, siluf(g.y) * u.y, siluf(g.z) * u.z, siluf(g.w) * u.w));
        }
    }
};
struct EpiDown {
    bf16_t* y; const int* ltok; const float* lgate;
    DI void prefetch(int, int, int) {}
    DI void operator()(const float* Cs, int m0, int n0, int tid) const {
        const int c4 = (tid & 31) * 4, r0 = tid >> 5;
#pragma unroll 4
        for (int ps = 0; ps < 16; ++ps) {
            const int row = ps * 8 + r0, tk2 = ltok[row];
            if (tk2 >= 0) {
                const float gt = lgate[row];
                float4 v = cs4(Cs, row, c4); v.x *= gt; v.y *= gt; v.z *= gt; v.w *= gt;
                *(uint2*)(y + (size_t)tk2 * 1024 + n0 + c4) = pack4(v);
            }
        }
    }
};
template <int WHICH>
DI void phase_moe(const P& p, int bid, int nb, unsigned char* smem) {
    unsigned char* ws = p.ws;
    const unsigned* cnt = (const unsigned*)(ws + CTL + CTL_CNT); const int* lists = (const int*)(ws + LISTS); const float* tgate = (const float*)(ws + TOK_GATE);
    int* offs = (int*)(smem + GEMM_LDS); int* ltok = offs + 64; int* lrow = ltok + 128; float* lgate = (float*)(lrow + 128);
    const int nmt = moe_tiles(cnt, offs);
    constexpr int NNT = WHICH == 0 ? 4 : 8;
    const int v = vbid(bid, nb);
    for (int t = v; t < nmt * NNT; t += nb) {
        const int mt = t / NNT, ntl = t % NNT;
        const int slot0 = mt * 128;
        int e = 0;
        while (offs[e + 1] <= slot0) ++e;
        __syncthreads();
        if (tidx() < 128) {
            const int pos = slot0 - offs[e] + tidx();
            const int tk2 = pos < (int)cnt[e * CNT_STRIDE] ? lists[(size_t)e * T + pos] : -1;
            ltok[tidx()] = tk2; lrow[tidx()] = tk2 < 0 ? 0 : (tk2 >> 1); lgate[tidx()] = tk2 < 0 ? 0.f : tgate[tk2];
        }
        __syncthreads();
        if (WHICH == 0) {
            EpiGU ep{(bf16_t*)(ws + HDN)};
            GemmArgs g{(const bf16_t*)(ws + H2B), 1024, (const bf16_t*)(ws + W_GU) + (size_t)e * 512 * 1024, 1024, 1024, lrow};
            gemm_tile(g, slot0, ntl * 128, ep, smem);
        } else {
            EpiDown ep{(bf16_t*)(ws + YB), ltok, lgate};
            GemmArgs g{(const bf16_t*)(ws + HDN), 256, (const bf16_t*)(ws + W_DN) + (size_t)e * 1024 * 256, 256, 256, nullptr};
            gemm_tile(g, slot0, ntl * 128, ep, smem);
        }
    }
}
DI void phase_final(const P& p, int bid, int nb, unsigned char* smem) {
    const int lane = tidx() & 63, wave = tidx() >> 6;
    const float* hf = (const float*)(p.ws + H2); const bf16_t* y = (const bf16_t*)(p.ws + YB);
    const float* gam = p.in[29]; const float* bet = p.in[30];
    for (int tk = bid * 4 + wave; tk < T; tk += nb * 8) {
        const int tk2 = tk + nb * 4;
        float va[16], vb[16], mua, rsa, mub, rsb;
#pragma unroll
        for (int i = 0; i < 4; ++i) {
            const float4 ta = *(const float4*)(hf + (size_t)tk * 1024 + i * 256 + lane * 4), tb = *(const float4*)(hf + (size_t)tk2 * 1024 + i * 256 + lane * 4);
            const uint2 a0 = *(const uint2*)(y + (size_t)(tk * 2) * 1024 + i * 256 + lane * 4), a1 = *(const uint2*)(y + (size_t)(tk * 2 + 1) * 1024 + i * 256 + lane * 4);
            const uint2 b0 = *(const uint2*)(y + (size_t)(tk2 * 2) * 1024 + i * 256 + lane * 4), b1 = *(const uint2*)(y + (size_t)(tk2 * 2 + 1) * 1024 + i * 256 + lane * 4);
            va[4 * i] = ALPHA * ta.x + bflo(a0.x) + bflo(a1.x); va[4 * i + 1] = ALPHA * ta.y + bfhi(a0.x) + bfhi(a1.x); va[4 * i + 2] = ALPHA * ta.z + bflo(a0.y) + bflo(a1.y); va[4 * i + 3] = ALPHA * ta.w + bfhi(a0.y) + bfhi(a1.y);
            vb[4 * i] = ALPHA * tb.x + bflo(b0.x) + bflo(b1.x); vb[4 * i + 1] = ALPHA * tb.y + bfhi(b0.x) + bfhi(b1.x); vb[4 * i + 2] = ALPHA * tb.z + bflo(b0.y) + bflo(b1.y); vb[4 * i + 3] = ALPHA * tb.w + bfhi(b0.y) + bfhi(b1.y);
        }
        ln_stats2(va, vb, mua, rsa, mub, rsb);
#pragma unroll
        for (int i = 0; i < 4; ++i) {
            const float4 g4 = *(const float4*)(gam + i * 256 + lane * 4), b4 = *(const float4*)(bet + i * 256 + lane * 4);
            *(float4*)(p.out + (size_t)tk * 1024 + i * 256 + lane * 4) = make_float4((va[4 * i] - mua) * rsa * g4.x + b4.x, (va[4 * i + 1] - mua) * rsa * g4.y + b4.y, (va[4 * i + 2] - mua) * rsa * g4.z + b4.z, (va[4 * i + 3] - mua) * rsa * g4.w + b4.w);
            *(float4*)(p.out + (size_t)tk2 * 1024 + i * 256 + lane * 4) = make_float4((vb[4 * i] - mub) * rsb * g4.x + b4.x, (vb[4 * i + 1] - mub) * rsb * g4.y + b4.y, (vb[4 * i + 2] - mub) * rsb * g4.z + b4.z, (vb[4 * i + 3] - mub) * rsb * g4.w + b4.w);
        }
    }
}

#define XB_TMO      128
#define XB_XCNT(j)  (256  + 64 * (j))
#define XB_XSUB(j)  (1280 + 64 * (j))
#define XB_XGEN(j)  (2304 + 64 * (j))
#define XB_TOP      3328
#define XB_TOPGEN   3392
#define XCD_BAR_WORDS 3456
#define XB_SPIN_CAP (1u << 25)
DI unsigned xb_ld(unsigned* p) { return __hip_atomic_load(p, __ATOMIC_RELAXED, __HIP_MEMORY_SCOPE_AGENT); }
DI unsigned xb_add(unsigned* p, unsigned v) { return __hip_atomic_fetch_add(p, v, __ATOMIC_RELAXED, __HIP_MEMORY_SCOPE_AGENT); }
DI unsigned xb_xcc_id() { return (unsigned)__builtin_amdgcn_s_getreg((3 << 11) | 20) & 0xFu; }
#define XB_SPIN(cond, bar) do { unsigned _sp = 0; while (cond) { __builtin_amdgcn_s_sleep(1); \
    if ((++_sp & 255u) == 0u) { if (xb_ld(&(bar)[XB_TMO])) break; if (_sp > XB_SPIN_CAP) { atomicAdd(&(bar)[XB_TMO], 1u); break; } } } } while (0)
struct XcdBarrier { unsigned* bar; unsigned x; volatile LAS unsigned* st; };
DI XcdBarrier xcd_barrier_post(unsigned* bar, volatile LAS unsigned* st) {
    XcdBarrier b; b.bar = bar; b.x = xb_xcc_id(); b.st = st;
    if (threadIdx.x == 0) (void)xb_add(&bar[XB_XCNT(b.x)], 1u);
    return b;
}
DI void xcd_barrier_complete(unsigned* bar, unsigned x, unsigned& nloc, unsigned& nx) {
    const unsigned G = gridDim.x * gridDim.y * gridDim.z;
    unsigned sum, cnt, mine, sp = 0u;
    for (;;) {
        sum = 0u; cnt = 0u; mine = 0u;
#pragma unroll
        for (unsigned j = 0; j < 16; ++j) { const unsigned c = xb_ld(&bar[XB_XCNT(j)]); sum += c; cnt += (c > 0u) ? 1u : 0u; mine = (j == x) ? c : mine; }
        if (sum == G) break;
        __builtin_amdgcn_s_sleep(1);
        if ((++sp & 255u) == 0u) { if (xb_ld(&bar[XB_TMO])) break; if (sp > XB_SPIN_CAP) { atomicAdd(&bar[XB_TMO], 1u); break; } }
    }
    nloc = mine > 0u ? mine : 1u; nx = cnt > 0u ? cnt : 1u;
}
DI void xcd_barrier(const XcdBarrier& b) {
    asm volatile("s_waitcnt vmcnt(0)" ::: "memory");
    __syncthreads();
    if (threadIdx.x == 0) {
        unsigned* bar = b.bar;
        __builtin_amdgcn_s_waitcnt(0);
        unsigned nloc = b.st[0], nx = b.st[1];
        if (nloc == 0u) { xcd_barrier_complete(bar, b.x, nloc, nx); b.st[0] = nloc; b.st[1] = nx; }
        const unsigned old = xb_add(&bar[XB_XSUB(b.x)], 1u);
        const unsigned gen = old / nloc;
        if (old + 1u == (gen + 1u) * nloc) {
            __builtin_amdgcn_fence(__ATOMIC_RELEASE, "agent");
            asm volatile("s_waitcnt vmcnt(0)" ::: "memory");
            const unsigned og = xb_add(&bar[XB_TOP], 1u);
            const unsigned tg = og / nx;
            if (og + 1u == (tg + 1u) * nx) xb_add(&bar[XB_TOPGEN], 1u);
            else XB_SPIN(xb_ld(&bar[XB_TOPGEN]) == tg, bar);
            __builtin_amdgcn_fence(__ATOMIC_ACQUIRE, "agent");
            xb_add(&bar[XB_XGEN(b.x)], 1u);
            asm volatile("s_waitcnt vmcnt(0)" ::: "memory");
        } else {
            XB_SPIN(xb_ld(&bar[XB_XGEN(b.x)]) == gen, bar);
            __builtin_amdgcn_fence(__ATOMIC_ACQUIRE, "agent");
            asm volatile("s_waitcnt vmcnt(0)" ::: "memory");
        }
    }
    __syncthreads();
}

constexpr int NPHASE = 14;
template <int PH>
DI void run_phase(const P& p, int bid, int nb, unsigned char* smem, int rep = 0) {
    if (PH == 0) phase_prep(p, bid, nb, smem);
    else if (PH == 1) phase_proj(p, bid, nb, smem, rep);
    else if (PH == 2) phase_up(p, bid, nb, smem);
    else if (PH == 3) phase_mixer(p, bid, nb, smem, rep);
    else if (PH == 4) phase_ssdnorm(p, bid, nb, smem);
    else if (PH == 5) phase_wout(p, bid, nb, smem);
    else if (PH == 6) phase_ln1(p, bid, nb, smem);
    else if (PH == 7) phase_xq(p, bid, nb, smem);
    else if (PH == 8) phase_xattn(p, bid, nb, smem);
    else if (PH == 9) phase_xo(p, bid, nb, smem);
    else if (PH == 10) phase_ln2_router(p, bid, nb, smem, rep);
    else if (PH == 11) phase_moe<0>(p, bid, nb, smem);
    else if (PH == 12) phase_moe<1>(p, bid, nb, smem);
    else if (PH == 13) phase_final(p, bid, nb, smem);
}
template <int PH>
__global__ void __launch_bounds__(256, 2) k_phase(P p) {
    __shared__ __attribute__((aligned(16))) unsigned char smem[SMEM_BYTES];
    run_phase<PH>(p, blockIdx.x, gridDim.x, smem);
}

#if MEGA
#ifndef MEGA_WAVES
#define MEGA_WAVES 2
#endif
template <int PH>
DI void mega_steps(const P& p, const XcdBarrier& bar, unsigned char* smem) {
    run_phase<PH>(p, blockIdx.x, gridDim.x, smem);
    if constexpr (((REPEAT_MASK >> PH) & 1) != 0) { xcd_barrier(bar); run_phase<PH>(p, blockIdx.x, gridDim.x, smem, 1); }
    if constexpr (PH == 6 && EXTRA_BARRIERS > 0) { for (int i = 0; i < EXTRA_BARRIERS; ++i) xcd_barrier(bar); }
    if constexpr (PH + 1 < NPHASE) { xcd_barrier(bar); mega_steps<PH + 1>(p, bar, smem); }
}
__global__ void __launch_bounds__(256, MEGA_WAVES) k_mega(P p) {
    __shared__ __attribute__((aligned(16))) unsigned char smem[SMEM_BYTES];
    volatile LAS unsigned* st = (volatile LAS unsigned*)(smem + SMEM_BYTES - 16);
    if (threadIdx.x < 4) st[threadIdx.x] = 0u;
    __syncthreads();
    const XcdBarrier bar = xcd_barrier_post((unsigned*)(p.ws + CTL), st);
    mega_steps<0>(p, bar, smem);
}
#endif
template <int PH>
__global__ void __launch_bounds__(256, 1) k_phase_big(P p) {
    __shared__ __attribute__((aligned(16))) unsigned char smem[SMEM_BYTES];
    run_phase<PH>(p, blockIdx.x, gridDim.x, smem);
}
template <int PH>
static void launch_phase(const P& p, int grid, hipStream_t st) {
    if constexpr (PH == 3 && !P3_SMALL) hipLaunchKernelGGL((k_phase_big<PH>), dim3(grid), dim3(256), 0, st, p);
    else hipLaunchKernelGGL((k_phase<PH>), dim3(grid), dim3(256), 0, st, p);
}

extern "C" void kernel_launch(void* const* d_in, const int* in_sizes, int n_in, void* d_out, int out_size, void* d_ws, size_t ws_size, hipStream_t stream) {
    if (n_in != 31 || out_size != T * D || ws_size < WS_NEED) {
        fprintf(stderr, "kernel_launch: unexpected shapes: n_in %d out %d ws %zu (need %zu)\n", n_in, out_size, ws_size, (size_t)WS_NEED);
        return;
    }
    P p{};
    for (int i = 0; i < 31; ++i) p.in[i] = (const float*)d_in[i];
    p.out = (float*)d_out; p.ws = (unsigned char*)d_ws;
    (void)hipMemsetAsync((unsigned char*)d_ws + CTL, 0, CTL_BYTES, stream);
#if MEGA
    static int grid = 0;
    if (grid == 0) {
        int dev = 0, cus = 0, per_cu = 0;
        (void)hipGetDevice(&dev);
        (void)hipDeviceGetAttribute(&cus, hipDeviceAttributeMultiprocessorCount, dev);
        if (hipOccupancyMaxActiveBlocksPerMultiprocessor(&per_cu, (const void*)k_mega, 256, 0) != hipSuccess || per_cu < 1) { fprintf(stderr, "kernel_launch: occupancy query failed\n"); per_cu = 1; }
        if (per_cu > 2) per_cu = 2;
        grid = cus * per_cu;
        fprintf(stderr, "kernel_launch: mega grid %d (%d CUs x %d)\n", grid, cus, per_cu);
    }
    void* args[] = {(void*)&p};
    const hipError_t le = hipLaunchCooperativeKernel((const void*)k_mega, dim3(grid), dim3(256), args, 0, stream);
    if (le != hipSuccess) fprintf(stderr, "kernel_launch: cooperative launch failed: %s (grid %d)\n", hipGetErrorString(le), grid);
#else
    const int grid = 1024;
    launch_phase<0>(p, grid, stream); launch_phase<1>(p, grid, stream); launch_phase<2>(p, grid, stream); launch_phase<3>(p, grid, stream);
    launch_phase<4>(p, grid, stream); launch_phase<5>(p, grid, stream); launch_phase<6>(p, grid, stream); launch_phase<7>(p, grid, stream);
    launch_phase<8>(p, grid, stream); launch_phase<9>(p, grid, stream); launch_phase<10>(p, grid, stream); launch_phase<11>(p, grid, stream);
    launch_phase<12>(p, grid, stream); launch_phase<13>(p, grid, stream);
#endif
}
```

```cpp
#include <hip/hip_runtime.h>
#include <stdint.h>
#include <stdio.h>

#ifndef MEGA
#define MEGA 1
#endif
#ifndef ATTN_NAIVE
#define ATTN_NAIVE 0
#endif
#ifndef XATTN_NAIVE
#define XATTN_NAIVE 0
#endif
#ifndef SSD_NAIVE
#define SSD_NAIVE 0
#endif
#ifndef P3_SMALL
#define P3_SMALL 1
#endif
#ifndef NO_SSD
#define NO_SSD 0
#endif
#ifndef NO_FLASH
#define NO_FLASH 0
#endif
#ifndef GEMM_GLDS
#define GEMM_GLDS 1
#endif
#ifndef EXTRA_BARRIERS
#define EXTRA_BARRIERS 0
#endif
#ifndef SSD_PM
#define SSD_PM 0
#endif
#ifndef REPEAT_MASK
#define REPEAT_MASK 0
#endif
#ifndef REP_MODE
#define REP_MODE 0
#endif
#ifndef GEMM_DIRECT
#define GEMM_DIRECT 0
#endif

typedef unsigned short bf16_t;
typedef short bf16x8 __attribute__((ext_vector_type(8)));
typedef float f32x16 __attribute__((ext_vector_type(16)));
#define DI __device__ __forceinline__
#define LAS __attribute__((address_space(3)))
#define MFMA32(a, b, c) __builtin_amdgcn_mfma_f32_32x32x16_bf16((a), (b), (c), 0, 0, 0)

constexpr int Bn = 16, S = 2048, T = Bn * S, D = 1024;
constexpr int NMEM = 256;
constexpr float EPS = 1e-5f;
constexpr float ALPHA = 1.189207115002721f;
constexpr float LOG2E = 1.4426950408889634f;
constexpr float QSCALE = 0.10206207261596577f * LOG2E;
constexpr float XSCALE = 0.0625f * LOG2E;
constexpr int NEXP = 32;
constexpr int MAXSLOTS = 69632;

constexpr size_t MiB = 1u << 20;
constexpr size_t W_IN = 0;
constexpr size_t W_QUP = W_IN + 4 * MiB;
constexpr size_t W_KVUP = W_QUP + 768 * 256 * 2;
constexpr size_t W_OUT = W_KVUP + 1024 * 128 * 2;
constexpr size_t W_XQ = W_OUT + 2 * MiB;
constexpr size_t W_XKV = W_XQ + 2 * MiB;
constexpr size_t W_XO = W_XKV + 4 * MiB;
constexpr size_t W_GU = W_XO + 2 * MiB;
constexpr size_t W_DN = W_GU + 32 * MiB;
constexpr size_t W_RT = W_DN + 16 * MiB;
constexpr size_t ROPE_C = W_RT + 48 * 1024 * 4;
constexpr size_t ROPE_S = ROPE_C + 2048 * 16 * 4;
constexpr size_t TOK_GATE = ROPE_S + 2048 * 16 * 4;
constexpr size_t CTL = TOK_GATE + (size_t)T * 2 * 4;
constexpr size_t CTL_BYTES = 32768;
constexpr size_t CTL_CNT = 16384;
constexpr int CNT_STRIDE = 64;
constexpr size_t CTL_QUEUE = 28672;
static_assert(CTL + CTL_BYTES <= 64 * MiB, "weights region overflow");
constexpr size_t RA = 64 * MiB, RB = 192 * MiB, RC = 320 * MiB, RD = 448 * MiB, WS_NEED = 512 * MiB;
constexpr size_t XBC = RA;
constexpr size_t KX = RA + 64 * MiB;
constexpr size_t VXT = KX + 8 * MiB;
constexpr size_t YB = RA;
constexpr size_t QB = RB;
constexpr size_t KNB = RB + 48 * MiB;
constexpr size_t VTB = KNB + 32 * MiB;
constexpr size_t H1 = RB;
constexpr size_t H2 = RB;
constexpr size_t XB = RC;
constexpr size_t MEMB = RB;
constexpr size_t XBCA = RC;
constexpr size_t MIX = RC + 64 * MiB;
constexpr size_t H1B = RC;
constexpr size_t QX = RC + 64 * MiB;
constexpr size_t OX = RB;
constexpr size_t H2B = RC;
constexpr size_t HDN = RC + 64 * MiB;
constexpr size_t CQ = RD;
constexpr size_t CKV = CQ + 16 * MiB;
constexpr size_t KROPE = CKV + 8 * MiB;
constexpr size_t DTB = KROPE + 2 * MiB;
constexpr size_t ZB = DTB + 1 * MiB;
constexpr size_t LISTS = RD;
static_assert(ZB + 32 * MiB <= WS_NEED, "region D overflow");

struct P {
    const float* in[31];
    float* out;
    unsigned char* ws;
};

typedef __bf16 hbf16x2 __attribute__((ext_vector_type(2)));
typedef float f32x2 __attribute__((ext_vector_type(2)));
DI bf16_t f2bf(float x) { return __builtin_bit_cast(bf16_t, (__bf16)x); }
DI float bf2f(bf16_t b) { return __uint_as_float(((unsigned)b) << 16); }
DI float bflo(unsigned w) { return __uint_as_float(w << 16); }
DI float bfhi(unsigned w) { return __uint_as_float(w & 0xffff0000u); }
DI unsigned pack2(float a, float b) { f32x2 v = {a, b}; return __builtin_bit_cast(unsigned, __builtin_convertvector(v, hbf16x2)); }
DI float siluf(float x) { return x / (1.f + __expf(-x)); }
DI float softplusf(float x) {
    const float zz = __expf(-fabsf(x));
    const float l1p = zz < 0.01f ? zz * (1.f - zz * (0.5f - zz * (1.f / 3.f))) : __logf(1.f + zz);
    return fmaxf(x, 0.f) + l1p;
}
DI int tidx() { int t = __builtin_amdgcn_workitem_id_x(); asm volatile("" : "+v"(t)); return t; }
DI int crow(int reg, int h) { return (reg & 3) + 8 * (reg >> 2) + 4 * h; }
constexpr int CS_LD = 132;
DI float4 cs4(const float* Cs, int row, int col) { return *(const float4*)(Cs + row * CS_LD + col); }
DI uint2 pack4(float4 v) { uint2 w; w.x = pack2(v.x, v.y); w.y = pack2(v.z, v.w); return w; }
DI float wave_sum(float v) {
#pragma unroll
    for (int o = 32; o >= 1; o >>= 1) v += __shfl_xor(v, o);
    return v;
}
DI float wave_max(float v) {
#pragma unroll
    for (int o = 32; o >= 1; o >>= 1) v = fmaxf(v, __shfl_xor(v, o));
    return v;
}

constexpr int LDS_ROW = 144;
constexpr int TILE_BYTES = 128 * LDS_ROW;
constexpr int GEMM_LDS = 4 * TILE_BYTES;
constexpr int SMEM_BYTES = GEMM_LDS + 3072;
static_assert(128 * CS_LD * 4 <= GEMM_LDS, "epilogue tile");

struct GemmArgs {
    const bf16_t* A; int lda;
    const bf16_t* Bt; int ldb;
    int K;
    const int* lrows;
};

template <class Epi>
DI void gemm_tile(const GemmArgs& g, int m0, int n0, Epi& epi, unsigned char* smem) {
    const int tid = tidx(), lane = tid & 63, wave = tid >> 6, wr = wave >> 1, wc = wave & 1;
    const int r = lane & 31, h = lane >> 5;
    f32x16 acc[2][2];
#pragma unroll
    for (int i = 0; i < 2; ++i)
#pragma unroll
        for (int j = 0; j < 2; ++j)
#pragma unroll
            for (int e = 0; e < 16; ++e) acc[i][j][e] = 0.f;
    const int nk = g.K >> 6;
    epi.prefetch(m0, n0, tid);
#if GEMM_DIRECT
    {
        const bf16_t* ap[2]; const bf16_t* bp[2];
#pragma unroll
        for (int i = 0; i < 2; ++i) {
            const int lr = wr * 64 + i * 32 + r;
            const int grow = g.lrows ? g.lrows[lr] : (m0 + lr);
            ap[i] = g.A + (size_t)grow * g.lda + 8 * h;
            bp[i] = g.Bt + (size_t)(n0 + wc * 64 + i * 32 + r) * g.ldb + 8 * h;
        }
        for (int k = 0; k < g.K; k += 16) {
            bf16x8 a[2], b[2];
#pragma unroll
            for (int i = 0; i < 2; ++i) { a[i] = *(const bf16x8*)(ap[i] + k); b[i] = *(const bf16x8*)(bp[i] + k); }
#pragma unroll
            for (int i = 0; i < 2; ++i)
#pragma unroll
                for (int j = 0; j < 2; ++j) acc[i][j] = MFMA32(a[i], b[j], acc[i][j]);
        }
    }
#elif GEMM_GLDS
    {
        constexpr int STG = 32768, TB = 16384;
        const int srow = tid >> 3, sch = (tid & 7) ^ ((srow >> 1) & 7);
        const bf16_t* ag[4]; const bf16_t* bg[4];
#pragma unroll
        for (int i = 0; i < 4; ++i) {
            const int lr = srow + 32 * i;
            const int grow = g.lrows ? g.lrows[lr] : (m0 + lr);
            ag[i] = g.A + (size_t)grow * g.lda + sch * 8;
            bg[i] = g.Bt + (size_t)(n0 + lr) * g.ldb + sch * 8;
        }
#define GLDS_STAGE(BUF, KO) do { unsigned char* _d = (BUF) + wave * 1024; \
        _Pragma("unroll") for (int i = 0; i < 4; ++i) { \
            __builtin_amdgcn_global_load_lds((const unsigned*)(ag[i] + (KO)), (LAS unsigned*)(_d + i * 4096), 16, 0, 0); \
            __builtin_amdgcn_global_load_lds((const unsigned*)(bg[i] + (KO)), (LAS unsigned*)(_d + TB + i * 4096), 16, 0, 0); } } while (0)
        __syncthreads();
        GLDS_STAGE(smem, 0);
        const int y16 = (h ^ ((r >> 1) & 7)) << 4;
        const int o0 = y16, o1 = 32 ^ y16, o2 = 64 ^ y16, o3 = 96 ^ y16;
        const int arow = (wr * 64 + r) * 128, brow = TB + (wc * 64 + r) * 128;
        __syncthreads();
        for (int kt = 0; kt < nk; ++kt) {
            const unsigned char* cur = smem + (kt & 1) * STG;
            if (kt + 1 < nk) GLDS_STAGE(smem + ((kt + 1) & 1) * STG, (kt + 1) * 64);
            bf16x8 fa[4][2], fb[4][2];
#define KLOAD(S, OFF) do { \
                fa[S][0] = *(const bf16x8*)(cur + arow + (OFF)); fa[S][1] = *(const bf16x8*)(cur + arow + 32 * 128 + (OFF)); \
                fb[S][0] = *(const bf16x8*)(cur + brow + (OFF)); fb[S][1] = *(const bf16x8*)(cur + brow + 32 * 128 + (OFF)); } while (0)
            KLOAD(0, o0); KLOAD(1, o1); KLOAD(2, o2); KLOAD(3, o3);
#undef KLOAD
#pragma unroll
            for (int s = 0; s < 4; ++s) {
                acc[0][0] = MFMA32(fa[s][0], fb[s][0], acc[0][0]); acc[0][1] = MFMA32(fa[s][0], fb[s][1], acc[0][1]);
                acc[1][0] = MFMA32(fa[s][1], fb[s][0], acc[1][0]); acc[1][1] = MFMA32(fa[s][1], fb[s][1], acc[1][1]);
            }
            __builtin_amdgcn_sched_group_barrier(0x100, 8, 0); __builtin_amdgcn_sched_group_barrier(0x8, 4, 0);
            __builtin_amdgcn_sched_group_barrier(0x100, 4, 0); __builtin_amdgcn_sched_group_barrier(0x8, 4, 0);
            __builtin_amdgcn_sched_group_barrier(0x100, 4, 0); __builtin_amdgcn_sched_group_barrier(0x8, 8, 0);
#define KSTEP(OFF)
#undef KSTEP
            __syncthreads();
        }
#undef GLDS_STAGE
    }
#else
    {
        const int srow = tid >> 3, sch = tid & 7;
        const bf16_t* ag[4]; const bf16_t* bg[4];
#pragma unroll
        for (int i = 0; i < 4; ++i) {
            const int lr = srow + 32 * i;
            const int grow = g.lrows ? g.lrows[lr] : (m0 + lr);
            ag[i] = g.A + (size_t)grow * g.lda + sch * 8;
            bg[i] = g.Bt + (size_t)(n0 + lr) * g.ldb + sch * 8;
        }
        const int soff = srow * LDS_ROW + sch * 16;
        uint4 ra0, ra1, ra2, ra3, rb0, rb1, rb2, rb3;
#define G_LOAD(KO) do { ra0 = *(const uint4*)(ag[0] + (KO)); ra1 = *(const uint4*)(ag[1] + (KO)); ra2 = *(const uint4*)(ag[2] + (KO)); ra3 = *(const uint4*)(ag[3] + (KO)); \
                        rb0 = *(const uint4*)(bg[0] + (KO)); rb1 = *(const uint4*)(bg[1] + (KO)); rb2 = *(const uint4*)(bg[2] + (KO)); rb3 = *(const uint4*)(bg[3] + (KO)); } while (0)
#define L_STORE(BUF) do { unsigned char* _d = (BUF) + soff; \
        *(uint4*)(_d) = ra0; *(uint4*)(_d + 32 * LDS_ROW) = ra1; *(uint4*)(_d + 64 * LDS_ROW) = ra2; *(uint4*)(_d + 96 * LDS_ROW) = ra3; \
        *(uint4*)(_d + TILE_BYTES) = rb0; *(uint4*)(_d + TILE_BYTES + 32 * LDS_ROW) = rb1; *(uint4*)(_d + TILE_BYTES + 64 * LDS_ROW) = rb2; *(uint4*)(_d + TILE_BYTES + 96 * LDS_ROW) = rb3; } while (0)
        G_LOAD(0);
        __syncthreads();
        L_STORE(smem);
        __syncthreads();
        const int aoff = (wr * 64 + r) * LDS_ROW + h * 16;
        const int boff = TILE_BYTES + (wc * 64 + r) * LDS_ROW + h * 16;
        for (int kt = 0; kt < nk; ++kt) {
            const unsigned char* cur = smem + (kt & 1) * 2 * TILE_BYTES;
            unsigned char* nxt = smem + ((kt + 1) & 1) * 2 * TILE_BYTES;
            const bool more = (kt + 1 < nk);
            if (more) G_LOAD((kt + 1) * 64);
#pragma unroll
            for (int ks = 0; ks < 4; ++ks) {
                const bf16x8 a0 = *(const bf16x8*)(cur + aoff + ks * 32);
                const bf16x8 a1 = *(const bf16x8*)(cur + aoff + 32 * LDS_ROW + ks * 32);
                const bf16x8 b0 = *(const bf16x8*)(cur + boff + ks * 32);
                const bf16x8 b1 = *(const bf16x8*)(cur + boff + 32 * LDS_ROW + ks * 32);
                acc[0][0] = MFMA32(a0, b0, acc[0][0]); acc[0][1] = MFMA32(a0, b1, acc[0][1]);
                acc[1][0] = MFMA32(a1, b0, acc[1][0]); acc[1][1] = MFMA32(a1, b1, acc[1][1]);
            }
            if (more) L_STORE(nxt);
            __syncthreads();
        }
#undef G_LOAD
#undef L_STORE
    }
#endif
    float* Cs = (float*)smem;
#if GEMM_DIRECT
    __syncthreads();
#endif
#pragma unroll
    for (int i = 0; i < 2; ++i)
#pragma unroll
        for (int j = 0; j < 2; ++j)
#pragma unroll
            for (int e = 0; e < 16; ++e) Cs[(wr * 64 + i * 32 + crow(e, h)) * CS_LD + wc * 64 + j * 32 + r] = acc[i][j][e];
    __syncthreads();
    epi(Cs, m0, n0, tid);
}

DI int vbid(int bid, int nb) { return (nb % 8 == 0) ? (bid % 8) * (nb / 8) + bid / 8 : bid; }

DI int colmap_in(int n) {
    if (n < 384) return n;
    if (n < 896) return 416 + (n - 384);
    if (n < 1920) return 928 + (n - 896);
    if (n < 1952) return 384 + (n - 1920);
    if (n < 1960) return n;
    return -1;
}
template <int KIND>
DI void tconv_tile(const float* src, const float* src2, int ldsrc, bf16_t* dst, int K, int k0, int n0, const float* scale, int scale_from, unsigned char* smem) {
    float* tile = (float*)smem;
    const int t = tidx();
    __syncthreads();
#pragma unroll 4
    for (int i = 0; i < 16; ++i) {
        const int k = i * 4 + (t >> 6), n = t & 63;
        const int nd = n0 + n;
        float v = 0.f;
        if (KIND == 1) { const int c = colmap_in(nd); if (c >= 0) v = src[(size_t)(k0 + k) * ldsrc + c]; }
        else if (KIND == 2) {
            const int j = nd >> 7, wc = (nd >> 6) & 1, isup = (nd >> 5) & 1, ii = nd & 31;
            const int c = 64 * j + 32 * wc + ii;
            v = (isup ? src2 : src)[(size_t)(k0 + k) * ldsrc + c];
        } else v = src[(size_t)(k0 + k) * ldsrc + nd];
        if (scale && (k0 + k) >= scale_from) v *= scale[k0 + k - scale_from];
        tile[k * 65 + n] = v;
    }
    __syncthreads();
#pragma unroll 4
    for (int i = 0; i < 16; ++i) {
        const int n = i * 4 + (t >> 6), k = t & 63;
        dst[(size_t)(n0 + n) * K + k0 + k] = f2bf(tile[k * 65 + n]);
    }
}

DI void phase_prep(const P& p, int bid, int nb, unsigned char* smem) {
    unsigned char* ws = p.ws;
    const int tid = tidx();
    constexpr int J0 = 512, J1 = J0 + 48, J2 = J1 + 32, J3 = J2 + 256, J4 = J3 + 256, J5 = J4 + 256, J6 = J5 + 256, J7 = J6 + 256, J8 = J7 + 4096, J9 = J8 + 2048;
    for (int t = bid; t < J9; t += nb) {
        if (t < J0) { const int kt = t >> 5, ntl = t & 31; tconv_tile<1>(p.in[2], nullptr, 1960, (bf16_t*)(ws + W_IN), 1024, kt * 64, ntl * 64, nullptr, 0, smem); }
        else if (t < J1) { const int u = t - J0, kt = u / 12, ntl = u % 12; tconv_tile<0>(p.in[4], nullptr, 768, (bf16_t*)(ws + W_QUP), 256, kt * 64, ntl * 64, p.in[3], 0, smem); }
        else if (t < J2) { const int u = t - J1, kt = u >> 4, ntl = u & 15; tconv_tile<0>(p.in[6], nullptr, 1024, (bf16_t*)(ws + W_KVUP), 128, kt * 64, ntl * 64, p.in[5], 0, smem); }
        else if (t < J3) { const int u = t - J2, kt = u >> 4, ntl = u & 15; tconv_tile<0>(p.in[13], nullptr, 1024, (bf16_t*)(ws + W_OUT), 1024, kt * 64, ntl * 64, p.in[12], 512, smem); }
        else if (t < J4) { const int u = t - J3, kt = u >> 4, ntl = u & 15; tconv_tile<0>(p.in[16], nullptr, 1024, (bf16_t*)(ws + W_XQ), 1024, kt * 64, ntl * 64, nullptr, 0, smem); }
        else if (t < J5) { const int u = t - J4, kt = u >> 4, ntl = u & 15; tconv_tile<0>(p.in[17], nullptr, 1024, (bf16_t*)(ws + W_XKV), 1024, kt * 64, ntl * 64, nullptr, 0, smem); }
        else if (t < J6) { const int u = t - J5, kt = u >> 4, ntl = u & 15; tconv_tile<0>(p.in[18], nullptr, 1024, (bf16_t*)(ws + W_XKV) + (size_t)1024 * 1024, 1024, kt * 64, ntl * 64, nullptr, 0, smem); }
        else if (t < J7) { const int u = t - J6, kt = u >> 4, ntl = u & 15; tconv_tile<0>(p.in[19], nullptr, 1024, (bf16_t*)(ws + W_XO), 1024, kt * 64, ntl * 64, nullptr, 0, smem); }
        else if (t < J8) { const int u = t - J7, e = u >> 7, v = u & 127, kt = v >> 3, ntl = v & 7;
            tconv_tile<2>(p.in[26] + (size_t)e * 1024 * 256, p.in[27] + (size_t)e * 1024 * 256, 256, (bf16_t*)(ws + W_GU) + (size_t)e * 512 * 1024, 1024, kt * 64, ntl * 64, nullptr, 0, smem); }
        else { const int u = t - J8, e = u >> 6, v = u & 63, kt = v >> 4, ntl = v & 15;
            tconv_tile<0>(p.in[28] + (size_t)e * 256 * 1024, nullptr, 1024, (bf16_t*)(ws + W_DN) + (size_t)e * 1024 * 256, 256, kt * 64, ntl * 64, nullptr, 0, smem); }
    }
    {
        const size_t gsz = (size_t)nb * 256, g0 = (size_t)bid * 256 + tid;
        bf16_t* xb = (bf16_t*)(ws + XB);
        const float4* x4 = (const float4*)p.in[0];
        for (size_t i = g0; i < (size_t)T * D / 4; i += gsz) { const float4 v = x4[i]; uint2 o; o.x = pack2(v.x, v.y); o.y = pack2(v.z, v.w); ((uint2*)xb)[i] = o; }
        bf16_t* mb = (bf16_t*)(ws + MEMB);
        const float4* m4 = (const float4*)p.in[1];
        for (size_t i = g0; i < (size_t)Bn * NMEM * D / 4; i += gsz) { const float4 v = m4[i]; uint2 o; o.x = pack2(v.x, v.y); o.y = pack2(v.z, v.w); ((uint2*)mb)[i] = o; }
        float* wrt = (float*)(ws + W_RT);
        for (size_t i = g0; i < 48 * 1024; i += gsz) {
            const int j = (int)(i >> 10), k = (int)(i & 1023);
            float v = 0.f;
            if (j < 4) v = p.in[22][k * 4 + j]; else if (j < 36) v = p.in[24][k * 32 + (j - 4)];
            wrt[i] = v;
        }
        float* rc = (float*)(ws + ROPE_C); float* rs = (float*)(ws + ROPE_S);
        for (size_t i = g0; i < 2048 * 16; i += gsz) {
            const int pos = (int)(i >> 4), f = (int)(i & 15);
            const float inv = powf(10000.f, -(float)f / 16.f);
            const float ang = (float)pos * inv;
            const double a = (double)ang;
            const double k2 = rint(a * 0.15915494309189535);
            const float rr = (float)(a - k2 * 6.283185307179586);
            rc[i] = cosf(rr); rs[i] = sinf(rr);
        }
    }
}

struct EpiProj {
    bf16_t *cq, *ckv, *z, *xbc, *krope; float* dt; const float *rc, *rs, *dtb;
    DI void prefetch(int, int, int) {}
    DI void operator()(const float* Cs, int m0, int n0, int tid) const {
        const int c4 = (tid & 31) * 4, r0 = tid >> 5;
        if (n0 < 1920) {
            bf16_t* dst; int ld, cofs;
            if (n0 < 256) { dst = cq; ld = 256; cofs = n0; } else if (n0 < 384) { dst = ckv; ld = 128; cofs = n0 - 256; }
            else if (n0 < 896) { dst = z; ld = 512; cofs = n0 - 384; } else { dst = xbc; ld = 1024; cofs = n0 - 896; }
#pragma unroll 4
            for (int ps = 0; ps < 16; ++ps) { const int row = ps * 8 + r0; *(uint2*)(dst + (size_t)(m0 + row) * ld + cofs + c4) = pack4(cs4(Cs, row, c4)); }
        } else {
#pragma unroll
            for (int ps = 0; ps < 4; ++ps) {
                const int it = ps * 256 + tid, row = it >> 3, cc = (it & 7) * 4, grow = m0 + row;
                const float4 v = cs4(Cs, row, cc), pv = cs4(Cs, row, cc ^ 16);
                const int pos = grow & 2047, f = cc & 15;
                const float4 c = *(const float4*)(rc + pos * 16 + f), s = *(const float4*)(rs + pos * 16 + f);
                float4 o;
                if (cc < 16) { o.x = v.x * c.x - pv.x * s.x; o.y = v.y * c.y - pv.y * s.y; o.z = v.z * c.z - pv.z * s.z; o.w = v.w * c.w - pv.w * s.w; }
                else { o.x = v.x * c.x + pv.x * s.x; o.y = v.y * c.y + pv.y * s.y; o.z = v.z * c.z + pv.z * s.z; o.w = v.w * c.w + pv.w * s.w; }
                *(uint2*)(krope + (size_t)grow * 32 + cc) = pack4(o);
            }
#pragma unroll
            for (int ps = 0; ps < 4; ++ps) {
                const int it = ps * 256 + tid, row = it >> 3, cc = it & 7;
                dt[(size_t)(m0 + row) * 8 + cc] = softplusf(Cs[row * CS_LD + 32 + cc] + dtb[cc]);
            }
        }
    }
};
struct EpiMemKV {
    bf16_t *kx, *vxt;
    DI void prefetch(int, int, int) {}
    DI void operator()(const float* Cs, int m0, int n0, int tid) const {
        const int b = m0 >> 8, mm0 = m0 & 255;
        if (n0 < 1024) {
            const int c4 = (tid & 31) * 4, r0 = tid >> 5, hd = n0 >> 8, d = (n0 & 255) + c4;
#pragma unroll 4
            for (int ps = 0; ps < 16; ++ps) { const int row = ps * 8 + r0; *(uint2*)(kx + ((size_t)(b * 4 + hd) * 256 + mm0 + row) * 256 + d) = pack4(cs4(Cs, row, c4)); }
        } else {
            const int c2 = n0 - 1024, hd = c2 >> 8;
#pragma unroll 2
            for (int ps = 0; ps < 8; ++ps) {
                const int it = ps * 256 + tid, col = it & 127, rg = it >> 7, d = (c2 & 255) + col;
                uint4 w;
                w.x = pack2(Cs[(rg * 8 + 0) * CS_LD + col], Cs[(rg * 8 + 1) * CS_LD + col]); w.y = pack2(Cs[(rg * 8 + 2) * CS_LD + col], Cs[(rg * 8 + 3) * CS_LD + col]);
                w.z = pack2(Cs[(rg * 8 + 4) * CS_LD + col], Cs[(rg * 8 + 5) * CS_LD + col]); w.w = pack2(Cs[(rg * 8 + 6) * CS_LD + col], Cs[(rg * 8 + 7) * CS_LD + col]);
                *(uint4*)(vxt + ((size_t)(b * 4 + hd) * 256 + d) * 256 + mm0 + rg * 8) = w;
            }
        }
    }
};
DI void phase_proj(const P& p, int bid, int nb, unsigned char* smem, int rep = 0) {
    unsigned char* ws = p.ws;
    const int v = vbid(bid, nb);
    const bf16_t* xb = (const bf16_t*)(ws + XB);
    EpiProj e1{(bf16_t*)(ws + CQ), (bf16_t*)(ws + CKV), (bf16_t*)(ws + ZB), (bf16_t*)(ws + XBC), (bf16_t*)(ws + KROPE), (float*)(ws + DTB),
               (const float*)(ws + ROPE_C), (const float*)(ws + ROPE_S), p.in[9]};
    EpiMemKV e2{(bf16_t*)(ws + KX), (bf16_t*)(ws + VXT)};
    constexpr int NT1 = 256 * 16, NT2 = 32 * 16;
    for (int t = v; t < NT1 + NT2; t += nb) {
        if (rep && REP_MODE == 1 && t >= NT1) continue;
        if (rep && REP_MODE == 2 && t < NT1) continue;
        if (rep && REP_MODE == 3 && !(t < NT1 && (t & 7) == 7 && ((t >> 6) & 1))) continue;
        if (rep && REP_MODE == 4 && !(t < NT1 && ((t >> 6) & 1) == 0)) continue;
        const int u = t < NT1 ? t : t - NT1, c = u >> 6, j = u & 63, mt = (c >> 1) * 8 + (j >> 3), ntl = (c & 1) * 8 + (j & 7);
        if (t < NT1) { GemmArgs g{xb, 1024, (const bf16_t*)(ws + W_IN), 1024, 1024, nullptr}; gemm_tile(g, mt * 128, ntl * 128, e1, smem); }
        else { GemmArgs g{(const bf16_t*)(ws + MEMB), 1024, (const bf16_t*)(ws + W_XKV), 1024, 1024, nullptr}; gemm_tile(g, mt * 128, ntl * 128, e2, smem); }
    }
}

struct EpiQup {
    bf16_t* q; const float *rc, *rs; const float* rms;
    DI void prefetch(int, int, int) {}
    DI void operator()(const float* Cs, int m0, int n0, int tid) const {
        const int c4 = (tid & 31) * 4, r0 = tid >> 5;
        const int col = n0 + c4, head = col / 96, d = col - head * 96;
        const bool rope = d >= 64;
        const int b = m0 >> 11, s0 = m0 & 2047;
#pragma unroll 4
        for (int ps = 0; ps < 16; ++ps) {
            const int row = ps * 8 + r0;
            const float sc = rms[row] * QSCALE;
            float4 v = cs4(Cs, row, c4);
            if (rope) {
                const float4 pv = cs4(Cs, row, c4 ^ 16);
                const int pos = s0 + row, f = d & 15;
                const float4 c = *(const float4*)(rc + pos * 16 + f), s = *(const float4*)(rs + pos * 16 + f);
                if (d < 80) { v.x = v.x * c.x - pv.x * s.x; v.y = v.y * c.y - pv.y * s.y; v.z = v.z * c.z - pv.z * s.z; v.w = v.w * c.w - pv.w * s.w; }
                else { v.x = v.x * c.x + pv.x * s.x; v.y = v.y * c.y + pv.y * s.y; v.z = v.z * c.z + pv.z * s.z; v.w = v.w * c.w + pv.w * s.w; }
            }
            v.x *= sc; v.y *= sc; v.z *= sc; v.w *= sc;
            *(uint2*)(q + ((size_t)(b * 8 + head) * 2048 + s0 + row) * 96 + d) = pack4(v);
        }
    }
};
struct EpiKVup {
    bf16_t *kn, *vt; const float* rms;
    DI void prefetch(int, int, int) {}
    DI void operator()(const float* Cs, int m0, int n0, int tid) const {
        const int head = n0 >> 7, b = m0 >> 11, s0 = m0 & 2047;
#pragma unroll 4
        for (int ps = 0; ps < 8; ++ps) {
            const int it = ps * 256 + tid, row = it >> 4, c4 = (it & 15) * 4;
            const float sc = rms[row];
            float4 v = cs4(Cs, row, c4); v.x *= sc; v.y *= sc; v.z *= sc; v.w *= sc;
            *(uint2*)(kn + ((size_t)(b * 8 + head) * 2048 + s0 + row) * 64 + c4) = pack4(v);
        }
#pragma unroll 2
        for (int ps = 0; ps < 4; ++ps) {
            const int it = ps * 256 + tid, dv = it & 63, rg = it >> 6;
            const float* cp = Cs + (rg * 8) * CS_LD + 64 + dv; const float* rp = rms + rg * 8;
            uint4 w;
            w.x = pack2(cp[0] * rp[0], cp[CS_LD] * rp[1]); w.y = pack2(cp[2 * CS_LD] * rp[2], cp[3 * CS_LD] * rp[3]);
            w.z = pack2(cp[4 * CS_LD] * rp[4], cp[5 * CS_LD] * rp[5]); w.w = pack2(cp[6 * CS_LD] * rp[6], cp[7 * CS_LD] * rp[7]);
            *(uint4*)(vt + ((size_t)(b * 8 + head) * 64 + dv) * 2048 + s0 + rg * 8) = w;
        }
    }
};
template <int K>
DI void row_rms(const bf16_t* src, int m0, float* rms) {
    const int t = tidx(), row = t >> 1, half = t & 1;
    const uint4* s4 = (const uint4*)(src + (size_t)(m0 + row) * K + half * (K / 2));
    float ss = 0.f;
#pragma unroll
    for (int i = 0; i < K / 16; ++i) {
        const uint4 w = s4[i];
        const unsigned ww[4] = {w.x, w.y, w.z, w.w};
#pragma unroll
        for (int k = 0; k < 4; ++k) { const float a = bflo(ww[k]), b = bfhi(ww[k]); ss += a * a + b * b; }
    }
    ss += __shfl_xor(ss, 1);
    __syncthreads();
    if (half == 0) rms[row] = rsqrtf(ss * (1.f / K) + EPS);
    __syncthreads();
}
DI void phase_up(const P& p, int bid, int nb, unsigned char* smem) {
    unsigned char* ws = p.ws;
    const int v = vbid(bid, nb);
    float* rms = (float*)(smem + GEMM_LDS);
    constexpr int NTQ = 256 * 6, NTKV = 256 * 8;
    for (int t = v; t < NTQ + NTKV; t += nb) {
        if (t < NTQ) {
            const int mt = t / 6, ntl = t % 6;
            row_rms<256>((const bf16_t*)(ws + CQ), mt * 128, rms);
            EpiQup e{(bf16_t*)(ws + QB), (const float*)(ws + ROPE_C), (const float*)(ws + ROPE_S), rms};
            GemmArgs g{(const bf16_t*)(ws + CQ), 256, (const bf16_t*)(ws + W_QUP), 256, 256, nullptr};
            gemm_tile(g, mt * 128, ntl * 128, e, smem);
        } else {
            const int u = t - NTQ, mt = u >> 3, ntl = u & 7;
            row_rms<128>((const bf16_t*)(ws + CKV), mt * 128, rms);
            EpiKVup e{(bf16_t*)(ws + KNB), (bf16_t*)(ws + VTB), rms};
            GemmArgs g{(const bf16_t*)(ws + CKV), 128, (const bf16_t*)(ws + W_KVUP), 128, 128, nullptr};
            gemm_tile(g, mt * 128, ntl * 128, e, smem);
        }
    }
    {
        const bf16_t* xbc = (const bf16_t*)(ws + XBC); bf16_t* xa = (bf16_t*)(ws + XBCA);
        const float* cw = p.in[7]; const float* cb = p.in[8];
        const size_t gsz = (size_t)nb * 256;
        for (size_t i = (size_t)bid * 256 + tidx(); i < (size_t)T * 128; i += gsz) {
            const int tkn = (int)(i >> 7), c0 = (int)(i & 127) * 8, s_ = tkn & 2047;
            float accv[8];
#pragma unroll
            for (int k = 0; k < 8; ++k) accv[k] = cb[c0 + k];
#pragma unroll
            for (int j = 0; j < 4; ++j) {
                if (s_ + j - 3 >= 0) {
                    const uint4 w = *(const uint4*)(xbc + (size_t)(tkn + j - 3) * 1024 + c0);
                    const unsigned ww[4] = {w.x, w.y, w.z, w.w};
#pragma unroll
                    for (int k = 0; k < 4; ++k) {
                        accv[2 * k] += cw[j * 1024 + c0 + 2 * k] * bflo(ww[k]);
                        accv[2 * k + 1] += cw[j * 1024 + c0 + 2 * k + 1] * bfhi(ww[k]);
                    }
                }
            }
            uint4 o;
            o.x = pack2(siluf(accv[0]), siluf(accv[1])); o.y = pack2(siluf(accv[2]), siluf(accv[3]));
            o.z = pack2(siluf(accv[4]), siluf(accv[5])); o.w = pack2(siluf(accv[6]), siluf(accv[7]));
            *(uint4*)(xa + (size_t)tkn * 1024 + c0) = o;
        }
    }
}

DI int perm16(int k) { return (k & ~12) | ((k & 4) << 1) | ((k & 8) >> 1); }
template <int DQK, int DVW, int KT, int NQG, int NDV>
struct FlashCfg {
    static constexpr int KSTR = (DQK + 8) * 2;
    static constexpr int VSTR = (KT + 8) * 2;
    static constexpr int DV = DVW * NDV;
    static constexpr int KBYTES = KT * KSTR, VBYTES = DV * VSTR, STAGE = KBYTES + VBYTES;
    static constexpr int KCH = KT * DQK / 8 / 256;
    static constexpr int VCH = DV * KT / 8 / 256;
    static_assert(KT * DQK / 8 % 256 == 0 && DV * KT / 8 % 256 == 0, "chunk split");
    static_assert(2 * STAGE <= SMEM_BYTES - 32, "flash LDS");
};
template <int DQK, int DVW, int KT, int NQG, int NDV, class Src>
DI void flash_item(const Src& src, int ntiles, int nskip  , unsigned char* smem, bool noload = false) {
    typedef FlashCfg<DQK, DVW, KT, NQG, NDV> C;
    constexpr int NKS = DQK / 16, NKB = KT / 32, NDB = DVW / 32;
    int tid = tidx(); asm volatile("" : "+v"(tid));
    const int lane = tid & 63, wave = __builtin_amdgcn_readfirstlane(tid >> 6), r = lane & 31, h = lane >> 5;
    const int qg = wave / NDV, dvh = wave % NDV;
    bf16x8 qf[NKS];
    {
        const bf16_t* qp = src.qrow(qg * 32 + r) + 8 * h;
#pragma unroll
        for (int ks = 0; ks < NKS; ++ks) qf[ks] = *(const bf16x8*)(qp + 16 * ks);
    }
    f32x16 o[NDB];
#pragma unroll
    for (int d = 0; d < NDB; ++d)
#pragma unroll
        for (int e = 0; e < 16; ++e) o[d][e] = 0.f;
    float m = -1e30f, l = 0.f;
    uint4 kr[C::KCH], vr[C::VCH];
    auto gload = [&](int t) {
#pragma unroll
        for (int i = 0; i < C::KCH; ++i) { const int idx = tid + 256 * i; kr[i] = src.kload(t, idx / (DQK / 8), idx % (DQK / 8)); }
#pragma unroll
        for (int i = 0; i < C::VCH; ++i) { const int idx = tid + 256 * i; vr[i] = src.vload(t, idx / (KT / 8), idx % (KT / 8)); }
    };
    auto lstore = [&](unsigned char* buf) {
#pragma unroll
        for (int i = 0; i < C::KCH; ++i) { const int idx = tid + 256 * i; *(uint4*)(buf + (idx / (DQK / 8)) * C::KSTR + (idx % (DQK / 8)) * 16) = kr[i]; }
#pragma unroll
        for (int i = 0; i < C::VCH; ++i) {
            const int idx = tid + 256 * i, dv = idx / (KT / 8), c = idx % (KT / 8);
            unsigned char* row = buf + C::KBYTES + dv * C::VSTR + (c >> 1) * 32;
            const int a = c & 1;
            *(uint2*)(row + (4 * a) * 2) = make_uint2(vr[i].x, vr[i].y);
            *(uint2*)(row + (8 + 4 * a) * 2) = make_uint2(vr[i].z, vr[i].w);
        }
    };
    gload(0);
    __syncthreads();
    lstore(smem);
    __syncthreads();
    for (int t = 0; t < ntiles; ++t) {
        const unsigned char* cur = smem + (t & 1) * C::STAGE;
        const bool more = (t + 1 < ntiles);
        if (more && !noload) gload(t + 1);
        if (!(t == ntiles - 1 && qg < nskip)) {
            f32x16 s[NKB];
#pragma unroll
            for (int kb = 0; kb < NKB; ++kb) {
#pragma unroll
                for (int e = 0; e < 16; ++e) s[kb][e] = 0.f;
                const unsigned char* kp = cur + (kb * 32 + r) * C::KSTR + h * 16;
#pragma unroll
                for (int ks = 0; ks < NKS; ++ks) s[kb] = MFMA32(*(const bf16x8*)(kp + ks * 32), qf[ks], s[kb]);
            }
            float mx = s[0][0];
#pragma unroll
            for (int kb = 0; kb < NKB; ++kb)
#pragma unroll
                for (int e = 0; e < 16; ++e) mx = fmaxf(mx, s[kb][e]);
            mx = fmaxf(mx, __shfl_xor(mx, 32));
            const float mn = fmaxf(m, mx);
            const float alpha = __builtin_amdgcn_exp2f(m - mn);
            m = mn;
            float ps = 0.f;
#pragma unroll
            for (int kb = 0; kb < NKB; ++kb)
#pragma unroll
                for (int e = 0; e < 16; ++e) { const float pv = __builtin_amdgcn_exp2f(s[kb][e] - mn); s[kb][e] = pv; ps += pv; }
            l = l * alpha + ps;
#pragma unroll
            for (int d = 0; d < NDB; ++d)
#pragma unroll
                for (int e = 0; e < 16; ++e) o[d][e] *= alpha;
#pragma unroll
            for (int kb = 0; kb < NKB; ++kb)
#pragma unroll
                for (int s2 = 0; s2 < 2; ++s2) {
                    uint4 pk;
                    pk.x = pack2(s[kb][8 * s2], s[kb][8 * s2 + 1]); pk.y = pack2(s[kb][8 * s2 + 2], s[kb][8 * s2 + 3]);
                    pk.z = pack2(s[kb][8 * s2 + 4], s[kb][8 * s2 + 5]); pk.w = pack2(s[kb][8 * s2 + 6], s[kb][8 * s2 + 7]);
                    const bf16x8 pf = __builtin_bit_cast(bf16x8, pk);
                    const unsigned char* vp = cur + C::KBYTES + (dvh * DVW + r) * C::VSTR + (kb * 32 + s2 * 16 + 8 * h) * 2;
#pragma unroll
                    for (int d = 0; d < NDB; ++d) o[d] = MFMA32(*(const bf16x8*)(vp + d * 32 * C::VSTR), pf, o[d]);
                }
        }
        if (more) lstore(smem + ((t + 1) & 1) * C::STAGE);
        __syncthreads();
    }
    l += __shfl_xor(l, 32);
    const float il = 1.f / l;
#pragma unroll
    for (int d = 0; d < NDB; ++d)
#pragma unroll
        for (int g4 = 0; g4 < 4; ++g4) {
            uint2 w; w.x = pack2(o[d][4 * g4] * il, o[d][4 * g4 + 1] * il); w.y = pack2(o[d][4 * g4 + 2] * il, o[d][4 * g4 + 3] * il);
            src.store(qg * 32 + r, dvh * DVW + d * 32 + 8 * g4 + 4 * h, w);
        }
}
struct SelfSrc {
    const bf16_t *q, *kn, *kr, *vt; bf16_t* mix; int b, hd, bh, q0;
    DI const bf16_t* qrow(int rr) const { return q + ((size_t)bh * 2048 + q0 + rr) * 96; }
    DI uint4 kload(int t, int key, int c) const {
        const int kg = t * 64 + key;
        return c < 8 ? *(const uint4*)(kn + ((size_t)bh * 2048 + kg) * 64 + c * 8) : *(const uint4*)(kr + ((size_t)b * 2048 + kg) * 32 + (c - 8) * 8);
    }
    DI uint4 vload(int t, int dv, int c) const { return *(const uint4*)(vt + ((size_t)bh * 64 + dv) * 2048 + t * 64 + c * 8); }
    DI void store(int rr, int dv, uint2 w) const { *(uint2*)(mix + ((size_t)b * 2048 + q0 + rr) * 1024 + hd * 64 + dv) = w; }
};
struct CrossSrc {
    const bf16_t *qx, *kx, *vxt; bf16_t* ox; int b, hd, q0;
    DI const bf16_t* qrow(int rr) const { return qx + ((size_t)(b * 4 + hd) * 2048 + q0 + rr) * 256; }
    DI uint4 kload(int t, int key, int c) const { return *(const uint4*)(kx + ((size_t)(b * 4 + hd) * 256 + t * 32 + key) * 256 + c * 8); }
    DI uint4 vload(int t, int dv, int c) const { return *(const uint4*)(vxt + ((size_t)(b * 4 + hd) * 256 + dv) * 256 + t * 32 + c * 8); }
    DI void store(int rr, int dv, uint2 w) const { *(uint2*)(ox + ((size_t)b * 2048 + q0 + rr) * 1024 + hd * 256 + dv) = w; }
};
DI void attn_fast(const P& p, int bid, int nb, unsigned char* smem) {
    unsigned char* ws = p.ws;
    const int nround = (2048 + nb - 1) / nb;
    for (int rd = 0; rd < nround; ++rd) {
        const int idx = rd * nb + ((rd & 1) ? (nb - 1 - bid) : bid);
        if (idx >= 2048) continue;
        const int qb = 15 - (idx >> 7), bh = idx & 127;
        SelfSrc s{(const bf16_t*)(ws + QB), (const bf16_t*)(ws + KNB), (const bf16_t*)(ws + KROPE), (const bf16_t*)(ws + VTB), (bf16_t*)(ws + MIX), bh >> 3, bh & 7, bh, qb * 128};
        flash_item<96, 64, 64, 4, 1>(s, 2 * qb + 2, 2, smem);
    }
}
DI void xattn_fast(const P& p, int bid, int nb, unsigned char* smem) {
    unsigned char* ws = p.ws;
    for (int it = bid; it < 2048; it += nb) {
        const int bhd = it >> 5, qt = it & 31;
        CrossSrc s{(const bf16_t*)(ws + QX), (const bf16_t*)(ws + KX), (const bf16_t*)(ws + VXT), (bf16_t*)(ws + OX), bhd >> 2, bhd & 3, qt * 64};
        flash_item<256, 128, 32, 2, 2>(s, 8, 0, smem);
    }
}

constexpr int SSD_XT = 0, SSD_BM = 8192, SSD_CM = SSD_BM + 16384, SSD_BWT = SSD_CM + 16384, SSD_PS = SSD_BWT + 16384, SSD_F = SSD_PS + 16384;
static_assert(SSD_F + 2048 <= SMEM_BYTES - 32, "ssd LDS");
DI int off256(int row, int el) { return row * 256 + (((el >> 3) ^ (row & 15)) << 4) + ((el & 7) << 1); }
DI int off128(int row, int el) { return row * 128 + (((el >> 3) ^ ((row ^ (row >> 3)) & 7)) << 4) + ((el & 7) << 1); }
template <int pm>
DI void ssd_item(const P& p, int bh, unsigned char* smem) {
    unsigned char* ws = p.ws;
    const bf16_t* xa = (const bf16_t*)(ws + XBCA); const float* dtg = (const float*)(ws + DTB);
    bf16_t* mix = pm ? (bf16_t*)(ws + XBC) : (bf16_t*)(ws + MIX);
    int tid0 = tidx(); asm volatile("" : "+v"(tid0));
    const int wave = __builtin_amdgcn_readfirstlane(tid0 >> 6);
    const int b = bh >> 3, hd = bh & 7, g = hd >> 2;
    const int lb = wave >> 1, pb = wave & 1;
    const float a_h = -__expf(p.in[10][hd]), Dh = p.in[11][hd];
    float* F = (float*)(smem + SSD_F);
    __syncthreads();
    for (int i = tid0; i < 16384 / 16; i += 256) *(uint4*)(smem + SSD_PS + i * 16) = make_uint4(0u, 0u, 0u, 0u);
    f32x16 st[2];
#pragma unroll
    for (int i = 0; i < 2; ++i)
#pragma unroll
        for (int e = 0; e < 16; ++e) st[i][e] = 0.f;
    uint4 xr0, xr1, br0, br1, br2, br3, cr0, cr1, cr2, cr3; float dtr = 0.f;
#define SSD_XLD(i) (*(const uint4*)(xa + (t0_ + ((tid + 256 * (i)) >> 3)) * 1024 + hd * 64 + ((tid + 256 * (i)) & 7) * 8))
#define SSD_BLD(i, o) (*(const uint4*)(xa + (t0_ + ((tid + 256 * (i)) >> 4)) * 1024 + (o) + g * 128 + ((tid + 256 * (i)) & 15) * 8))
#define SSD_GLOAD(c_) do { const size_t t0_ = (size_t)b * 2048 + (c_) * 64; xr0 = SSD_XLD(0); xr1 = SSD_XLD(1); \
        br0 = SSD_BLD(0, 512); br1 = SSD_BLD(1, 512); br2 = SSD_BLD(2, 512); br3 = SSD_BLD(3, 512); \
        cr0 = SSD_BLD(0, 768); cr1 = SSD_BLD(1, 768); cr2 = SSD_BLD(2, 768); cr3 = SSD_BLD(3, 768); \
        if (tid < 64) dtr = dtg[(t0_ + tid) * 8 + hd]; } while (0)
    { const int tid = tid0; SSD_GLOAD(0); }
#define SSD_SCAN(FP) do { const int ln_ = tid0 & 63; float v = dtr * a_h; \
        _Pragma("unroll") for (int o = 1; o < 64; o <<= 1) { const float u = __shfl_up(v, o); if (ln_ >= o) v += u; } \
        const float a63 = __shfl(v, 63); \
        (FP)[ln_] = v; (FP)[64 + ln_] = __expf(v); (FP)[128 + ln_] = dtr; (FP)[192 + ln_] = __expf(a63 - v) * dtr; } while (0)
    if (wave == 0) SSD_SCAN(F);
    __syncthreads();
    for (int c = 0; c < 32; ++c) {
        int tid = tid0; asm volatile("" : "+v"(tid));
        const int lane = tid & 63, r = lane & 31, h = lane >> 5;
        const size_t t0 = (size_t)b * 2048 + c * 64;
        const float* Fc = F + (c & 1) * 256; float* Fn = F + ((c + 1) & 1) * 256;
#define SSD_XIMG(i, XR) do { const int idx = tid + 256 * (i), l = idx >> 3, p0 = (idx & 7) * 8, lp = perm16(l); \
            const unsigned ww[4] = {XR.x, XR.y, XR.z, XR.w}; \
            _Pragma("unroll") for (int k = 0; k < 4; ++k) { \
                *(bf16_t*)(smem + SSD_XT + off128(p0 + 2 * k, lp)) = (bf16_t)(ww[k] & 0xffffu); \
                *(bf16_t*)(smem + SSD_XT + off128(p0 + 2 * k + 1, lp)) = (bf16_t)(ww[k] >> 16); } } while (0)
#define SSD_BIMG(i, BR, CR) do { const int idx = tid + 256 * (i), l = idx >> 4, n0 = (idx & 15) * 8, lp = perm16(l); \
            *(uint4*)(smem + SSD_BM + off256(l, n0)) = BR; *(uint4*)(smem + SSD_CM + off256(l, n0)) = CR; \
            const float wl = Fc[192 + l]; const unsigned ww[4] = {BR.x, BR.y, BR.z, BR.w}; \
            _Pragma("unroll") for (int k = 0; k < 4; ++k) { \
                *(bf16_t*)(smem + SSD_BWT + off128(n0 + 2 * k, lp)) = f2bf(bflo(ww[k]) * wl); \
                *(bf16_t*)(smem + SSD_BWT + off128(n0 + 2 * k + 1, lp)) = f2bf(bfhi(ww[k]) * wl); } } while (0)
        if (!(pm & 2)) {
        SSD_XIMG(0, xr0); SSD_XIMG(1, xr1);
        SSD_BIMG(0, br0, cr0); SSD_BIMG(1, br1, cr1); SSD_BIMG(2, br2, cr2); SSD_BIMG(3, br3, cr3);
        } else { asm volatile("" :: "v"(xr0.x), "v"(xr1.x), "v"(br0.x), "v"(br1.x), "v"(br2.x), "v"(br3.x), "v"(cr0.x), "v"(cr1.x), "v"(cr2.x), "v"(cr3.x)); }
        __syncthreads();
        if (c + 1 < 32) SSD_GLOAD(c + 1);
        if (!(pm & 1)) {
        const float acs_l = Fc[lb * 32 + r];
        const int lrow = lb * 32 + r;
        f32x16 cb0, cb1, yo;
#pragma unroll
        for (int e = 0; e < 16; ++e) { cb0[e] = 0.f; cb1[e] = 0.f; yo[e] = 0.f; }
#pragma unroll
        for (int ks = 0; ks < 8; ++ks) {
            const bf16x8 cv = *(const bf16x8*)(smem + SSD_CM + off256(lb * 32 + r, 16 * ks + 8 * h));
            const bf16x8 b0v = *(const bf16x8*)(smem + SSD_BM + off256(r, 16 * ks + 8 * h));
            const bf16x8 b1v = *(const bf16x8*)(smem + SSD_BM + off256(32 + r, 16 * ks + 8 * h));
            const bf16x8 pv = *(const bf16x8*)(smem + SSD_PS + off256(pb * 32 + r, 16 * ks + 8 * h));
            cb0 = MFMA32(b0v, cv, cb0); cb1 = MFMA32(b1v, cv, cb1); yo = MFMA32(cv, pv, yo);
        }
        f32x16 yd;
#pragma unroll
        for (int e = 0; e < 16; ++e) yd[e] = 0.f;
#pragma unroll
        for (int sb = 0; sb < 2; ++sb) {
            float mv[16];
#pragma unroll
            for (int q4 = 0; q4 < 4; ++q4) {
                const int s0 = sb * 32 + 8 * q4 + 4 * h;
                const float4 as4 = *(const float4*)(Fc + s0), dt4 = *(const float4*)(Fc + 128 + s0);
                const float asv[4] = {as4.x, as4.y, as4.z, as4.w}, dtv[4] = {dt4.x, dt4.y, dt4.z, dt4.w};
#pragma unroll
                for (int k = 0; k < 4; ++k) { const float cbv = sb ? cb1[4 * q4 + k] : cb0[4 * q4 + k]; mv[4 * q4 + k] = (s0 + k <= lrow) ? cbv * __expf(acs_l - asv[k]) * dtv[k] : 0.f; }
            }
#pragma unroll
            for (int s2 = 0; s2 < 2; ++s2) {
                uint4 pk;
                pk.x = pack2(mv[8 * s2], mv[8 * s2 + 1]); pk.y = pack2(mv[8 * s2 + 2], mv[8 * s2 + 3]);
                pk.z = pack2(mv[8 * s2 + 4], mv[8 * s2 + 5]); pk.w = pack2(mv[8 * s2 + 6], mv[8 * s2 + 7]);
                const bf16x8 xb = *(const bf16x8*)(smem + SSD_XT + off128(pb * 32 + r, sb * 32 + 16 * s2 + 8 * h));
                yd = MFMA32(__builtin_bit_cast(bf16x8, pk), xb, yd);
            }
        }
        {
            const uint4 x0 = *(const uint4*)(smem + SSD_XT + off128(pb * 32 + r, lb * 32 + 8 * h));
            const uint4 x1 = *(const uint4*)(smem + SSD_XT + off128(pb * 32 + r, lb * 32 + 16 + 8 * h));
            const unsigned xw[8] = {x0.x, x0.y, x0.z, x0.w, x1.x, x1.y, x1.z, x1.w};
            bf16_t* op = mix + (t0 + lb * 32 + 4 * h) * 1024 + 512 + hd * 64 + pb * 32 + r;
#pragma unroll
            for (int q4 = 0; q4 < 4; ++q4) {
                const float4 ea4 = *(const float4*)(Fc + 64 + lb * 32 + 8 * q4 + 4 * h);
                const float eav[4] = {ea4.x, ea4.y, ea4.z, ea4.w};
#pragma unroll
                for (int k = 0; k < 4; ++k) {
                    const int e = 4 * q4 + k;
                    const float xv = (e & 1) ? bfhi(xw[e >> 1]) : bflo(xw[e >> 1]);
                    const float y = yd[e] + eav[k] * yo[e] + Dh * xv;
                    op[(size_t)(k + 8 * q4) * 1024] = f2bf(y);
                }
            }
        }
        {
            const float dec = Fc[64 + 63];
#pragma unroll
            for (int e = 0; e < 16; ++e) { st[0][e] *= dec; st[1][e] *= dec; }
            const int nblk = 2 * (wave >> 1);
#pragma unroll
            for (int ks = 0; ks < 4; ++ks) {
                const bf16x8 av = *(const bf16x8*)(smem + SSD_XT + off128(pb * 32 + r, 16 * ks + 8 * h));
                const bf16x8 bv0 = *(const bf16x8*)(smem + SSD_BWT + off128(nblk * 32 + r, 16 * ks + 8 * h));
                const bf16x8 bv1 = *(const bf16x8*)(smem + SSD_BWT + off128(nblk * 32 + 32 + r, 16 * ks + 8 * h));
                st[0] = MFMA32(av, bv0, st[0]); st[1] = MFMA32(av, bv1, st[1]);
            }
        }
        }
        if (wave == 0 && c + 1 < 32) SSD_SCAN(Fn);
        __syncthreads();
#pragma unroll
        for (int i = 0; i < 2; ++i) {
            const int n = (2 * (wave >> 1) + i) * 32 + r;
#pragma unroll
            for (int e = 0; e < 16; ++e) *(bf16_t*)(smem + SSD_PS + off256(pb * 32 + crow(e, h), n)) = f2bf(st[i][e]);
        }
    }
    __syncthreads();
}

#if ATTN_NAIVE
DI void attn_naive(const P& p, int bid, int nb) {
    unsigned char* ws = p.ws;
    const bf16_t* Q = (const bf16_t*)(ws + QB); const bf16_t* Kn = (const bf16_t*)(ws + KNB); const bf16_t* Vt = (const bf16_t*)(ws + VTB);
    const bf16_t* Kr = (const bf16_t*)(ws + KROPE); bf16_t* mix = (bf16_t*)(ws + MIX);
    for (int item = bid; item < 128 * 8; item += nb) {
        const int bh = item >> 3, s_ = (item & 7) * 256 + tidx(), b = bh >> 3, hd = bh & 7;
        float q[96];
        {
            const uint4* q4 = (const uint4*)(Q + ((size_t)bh * 2048 + s_) * 96);
#pragma unroll
            for (int i = 0; i < 12; ++i) { const uint4 w = q4[i]; q[8 * i] = bflo(w.x); q[8 * i + 1] = bfhi(w.x); q[8 * i + 2] = bflo(w.y); q[8 * i + 3] = bfhi(w.y);
                q[8 * i + 4] = bflo(w.z); q[8 * i + 5] = bfhi(w.z); q[8 * i + 6] = bflo(w.w); q[8 * i + 7] = bfhi(w.w); }
        }
        float o[64];
#pragma unroll
        for (int d = 0; d < 64; ++d) o[d] = 0.f;
        float m = -1e30f, l = 0.f;
        const int nkeys = __builtin_amdgcn_readfirstlane(((s_ >> 6) + 1) * 64);
        for (int j0 = 0; j0 < nkeys; j0 += 8) {
            float sc[8];
#pragma unroll
            for (int jj = 0; jj < 8; ++jj) {
                const int j = j0 + jj;
                const uint4* k4 = (const uint4*)(Kn + ((size_t)bh * 2048 + j) * 64);
                const uint4* r4 = (const uint4*)(Kr + ((size_t)b * 2048 + j) * 32);
                float a = 0.f;
#pragma unroll
                for (int i = 0; i < 8; ++i) { const uint4 w = k4[i]; a += q[8 * i] * bflo(w.x) + q[8 * i + 1] * bfhi(w.x) + q[8 * i + 2] * bflo(w.y) + q[8 * i + 3] * bfhi(w.y)
                    + q[8 * i + 4] * bflo(w.z) + q[8 * i + 5] * bfhi(w.z) + q[8 * i + 6] * bflo(w.w) + q[8 * i + 7] * bfhi(w.w); }
#pragma unroll
                for (int i = 0; i < 4; ++i) { const uint4 w = r4[i]; const int o8 = 64 + 8 * i; a += q[o8] * bflo(w.x) + q[o8 + 1] * bfhi(w.x) + q[o8 + 2] * bflo(w.y) + q[o8 + 3] * bfhi(w.y)
                    + q[o8 + 4] * bflo(w.z) + q[o8 + 5] * bfhi(w.z) + q[o8 + 6] * bflo(w.w) + q[o8 + 7] * bfhi(w.w); }
                sc[jj] = a;
            }
            float mx = m;
#pragma unroll
            for (int jj = 0; jj < 8; ++jj) mx = fmaxf(mx, sc[jj]);
            const float al = exp2f(m - mx);
            float ps = 0.f;
#pragma unroll
            for (int jj = 0; jj < 8; ++jj) { sc[jj] = exp2f(sc[jj] - mx); ps += sc[jj]; }
            l = l * al + ps; m = mx;
#pragma unroll
            for (int d = 0; d < 64; ++d) {
                const uint4 w = *(const uint4*)(Vt + ((size_t)bh * 64 + d) * 2048 + j0);
                o[d] = o[d] * al + sc[0] * bflo(w.x) + sc[1] * bfhi(w.x) + sc[2] * bflo(w.y) + sc[3] * bfhi(w.y) + sc[4] * bflo(w.z) + sc[5] * bfhi(w.z) + sc[6] * bflo(w.w) + sc[7] * bfhi(w.w);
            }
        }
        const float il = 1.f / l;
        bf16_t* dst = mix + ((size_t)b * 2048 + s_) * 1024 + hd * 64;
#pragma unroll
        for (int d = 0; d < 64; d += 2) *(unsigned*)(dst + d) = pack2(o[d] * il, o[d + 1] * il);
    }
}
#endif
#if SSD_NAIVE
DI void ssd_naive(const P& p, int bid, int nb) {
    unsigned char* ws = p.ws;
    const bf16_t* xa = (const bf16_t*)(ws + XBCA); const float* dt = (const float*)(ws + DTB); const bf16_t* z = (const bf16_t*)(ws + ZB);
    bf16_t* mix = (bf16_t*)(ws + MIX);
    const int wave = tidx() >> 6, pp = tidx() & 63;
    for (int item = bid; item < 32; item += nb) {
        const int bh = item * 4 + wave, b = bh >> 3, hd = bh & 7, g = hd >> 2;
        const float a = -__expf(p.in[10][hd]), Dh = p.in[11][hd];
        float st[128];
#pragma unroll
        for (int n = 0; n < 128; ++n) st[n] = 0.f;
        for (int t = 0; t < 2048; ++t) {
            const size_t row = (size_t)b * 2048 + t;
            const float dtv = dt[row * 8 + hd];
            const float da = __expf(dtv * a);
            const float xv = bf2f(xa[row * 1024 + hd * 64 + pp]);
            const float xd = dtv * xv;
            const uint4* b4 = (const uint4*)(xa + row * 1024 + 512 + g * 128);
            const uint4* c4 = (const uint4*)(xa + row * 1024 + 768 + g * 128);
            float y = 0.f;
#pragma unroll
            for (int i = 0; i < 16; ++i) {
                const uint4 bw = b4[i], cw = c4[i];
                const unsigned bb[4] = {bw.x, bw.y, bw.z, bw.w}, cc[4] = {cw.x, cw.y, cw.z, cw.w};
#pragma unroll
                for (int k = 0; k < 4; ++k) {
                    const int n = 8 * i + 2 * k;
                    st[n] = da * st[n] + xd * bflo(bb[k]); y += bflo(cc[k]) * st[n];
                    st[n + 1] = da * st[n + 1] + xd * bfhi(bb[k]); y += bfhi(cc[k]) * st[n + 1];
                }
            }
            y += Dh * xv;
            const float zv = bf2f(z[row * 512 + hd * 64 + pp]);
            mix[row * 1024 + 512 + hd * 64 + pp] = f2bf(y * siluf(zv));
        }
    }
}
#endif
DI void phase_mixer(const P& p, int bid, int nb, unsigned char* smem, int rep = 0) {
#if SSD_NAIVE
    ssd_naive(p, bid, nb);
    attn_fast(p, bid, nb, smem);
#else
    unsigned* ctr = (unsigned*)(p.ws + CTL + CTL_QUEUE) + 64 * rep;
    int* slot = (int*)(smem + SMEM_BYTES - 32);
    for (;;) {
        __syncthreads();
        if (tidx() == 0) *slot = (int)atomicAdd(ctr, 1u);
        __syncthreads();
        const int it = *slot;
        if (it >= 128 + 2048) break;
        if (it < 128) { if (!NO_SSD && !(rep && REP_MODE == 2)) { if (rep) ssd_item<SSD_PM>(p, it, smem); else ssd_item<0>(p, it, smem); } }
        else if (rep && REP_MODE >= 1) { }
        else {
            const int idx = it - 128, qb = 15 - (idx >> 7), bh = idx & 127;
            unsigned char* ws = p.ws;
            SelfSrc s{(const bf16_t*)(ws + QB), (const bf16_t*)(ws + KNB), (const bf16_t*)(ws + KROPE), (const bf16_t*)(ws + VTB), (bf16_t*)(ws + MIX), bh >> 3, bh & 7, bh, qb * 128};
            if (rep) s.mix = (bf16_t*)(ws + XBC);
            if (!NO_FLASH) flash_item<96, 64, 64, 4, 1>(s, 2 * qb + 2, 2, smem, rep && REP_MODE == 5);
        }
    }
#endif
}

DI void phase_ssdnorm(const P& p, int bid, int nb, unsigned char* smem) {
    bf16_t* mix = (bf16_t*)(p.ws + MIX); const bf16_t* z = (const bf16_t*)(p.ws + ZB);
    const int lane = tidx() & 63, wave = tidx() >> 6;
    for (int tk = bid * 4 + wave; tk < T; tk += nb * 4) {
        uint4* ptr = (uint4*)(mix + (size_t)tk * 1024 + 512 + lane * 8);
        const uint4 w = *ptr, zz = *(const uint4*)(z + (size_t)tk * 512 + lane * 8);
        const unsigned ww[4] = {w.x, w.y, w.z, w.w}, zw[4] = {zz.x, zz.y, zz.z, zz.w};
        float v[8]; float ss = 0.f;
#pragma unroll
        for (int k = 0; k < 4; ++k) {
            v[2 * k] = bflo(ww[k]) * siluf(bflo(zw[k])); v[2 * k + 1] = bfhi(ww[k]) * siluf(bfhi(zw[k]));
            ss += v[2 * k] * v[2 * k] + v[2 * k + 1] * v[2 * k + 1];
        }
#pragma unroll
        for (int o = 16; o >= 1; o >>= 1) ss += __shfl_xor(ss, o);
        const float rr = rsqrtf(ss * (1.f / 256.f) + EPS);
        uint4 o4; o4.x = pack2(v[0] * rr, v[1] * rr); o4.y = pack2(v[2] * rr, v[3] * rr); o4.z = pack2(v[4] * rr, v[5] * rr); o4.w = pack2(v[6] * rr, v[7] * rr);
        *ptr = o4;
    }
}

template <bool RES_BF16>
struct EpiResid {
    bf16_t* pre; const void* res;
    float4 pf[RES_BF16 ? 1 : 16]; uint2 pb[RES_BF16 ? 16 : 1];
    DI void prefetch(int m0, int n0, int tid) {
        const int c4 = (tid & 31) * 4, r0 = tid >> 5;
#pragma unroll
        for (int ps = 0; ps < 16; ++ps) {
            const size_t idx = (size_t)(m0 + ps * 8 + r0) * 1024 + n0 + c4;
            if (RES_BF16) pb[ps] = *(const uint2*)((const bf16_t*)res + idx); else pf[ps] = *(const float4*)((const float*)res + idx);
        }
    }
    DI void operator()(const float* Cs, int m0, int n0, int tid) const {
        const int c4 = (tid & 31) * 4, r0 = tid >> 5;
#pragma unroll
        for (int ps = 0; ps < 16; ++ps) {
            const int row = ps * 8 + r0;
            const float4 v = cs4(Cs, row, c4);
            float4 rr;
            if (RES_BF16) rr = make_float4(bflo(pb[ps].x), bfhi(pb[ps].x), bflo(pb[ps].y), bfhi(pb[ps].y)); else rr = pf[ps];
            *(uint2*)(pre + (size_t)(m0 + row) * 1024 + n0 + c4) = pack4(make_float4(ALPHA * rr.x + v.x, ALPHA * rr.y + v.y, ALPHA * rr.z + v.z, ALPHA * rr.w + v.w));
        }
    }
};
DI void phase_wout(const P& p, int bid, int nb, unsigned char* smem) {
    const int v = vbid(bid, nb);
    EpiResid<false> e; e.pre = (bf16_t*)p.out; e.res = p.in[0];
    GemmArgs g{(const bf16_t*)(p.ws + MIX), 1024, (const bf16_t*)(p.ws + W_OUT), 1024, 1024, nullptr};
    for (int t = v; t < 256 * 8; t += nb) gemm_tile(g, (t >> 3) * 128, (t & 7) * 128, e, smem);
}
DI void ln_row(const float* src, const float* gam, const float* bet, int lane, float (&o)[16]) {
    float v[16];
#pragma unroll
    for (int i = 0; i < 4; ++i) { const float4 t4 = *(const float4*)(src + i * 256 + lane * 4); v[4 * i] = t4.x; v[4 * i + 1] = t4.y; v[4 * i + 2] = t4.z; v[4 * i + 3] = t4.w; }
    float s = 0.f;
#pragma unroll
    for (int i = 0; i < 16; ++i) s += v[i];
    const float mu = wave_sum(s) * (1.f / 1024.f);
    float q = 0.f;
#pragma unroll
    for (int i = 0; i < 16; ++i) { const float d = v[i] - mu; q += d * d; }
    const float rstd = rsqrtf(wave_sum(q) * (1.f / 1024.f) + EPS);
#pragma unroll
    for (int i = 0; i < 4; ++i) {
        const float4 g4 = *(const float4*)(gam + i * 256 + lane * 4), b4 = *(const float4*)(bet + i * 256 + lane * 4);
        o[4 * i] = (v[4 * i] - mu) * rstd * g4.x + b4.x; o[4 * i + 1] = (v[4 * i + 1] - mu) * rstd * g4.y + b4.y;
        o[4 * i + 2] = (v[4 * i + 2] - mu) * rstd * g4.z + b4.z; o[4 * i + 3] = (v[4 * i + 3] - mu) * rstd * g4.w + b4.w;
    }
}
DI void ln_stats2(const float (&va)[16], const float (&vb)[16], float& mua, float& rsa, float& mub, float& rsb) {
    float sa = 0.f, sb = 0.f;
#pragma unroll
    for (int i = 0; i < 16; ++i) { sa += va[i]; sb += vb[i]; }
#pragma unroll
    for (int o = 32; o >= 1; o >>= 1) { sa += __shfl_xor(sa, o); sb += __shfl_xor(sb, o); }
    mua = sa * (1.f / 1024.f); mub = sb * (1.f / 1024.f);
    float qa = 0.f, qb = 0.f;
#pragma unroll
    for (int i = 0; i < 16; ++i) { const float da = va[i] - mua, db = vb[i] - mub; qa += da * da; qb += db * db; }
#pragma unroll
    for (int o = 32; o >= 1; o >>= 1) { qa += __shfl_xor(qa, o); qb += __shfl_xor(qb, o); }
    rsa = rsqrtf(qa * (1.f / 1024.f) + EPS); rsb = rsqrtf(qb * (1.f / 1024.f) + EPS);
}
DI void load_row16(const bf16_t* src, int lane, float (&v)[16]) {
#pragma unroll
    for (int i = 0; i < 4; ++i) { const uint2 t2 = *(const uint2*)(src + i * 256 + lane * 4); v[4 * i] = bflo(t2.x); v[4 * i + 1] = bfhi(t2.x); v[4 * i + 2] = bflo(t2.y); v[4 * i + 3] = bfhi(t2.y); }
}
DI void phase_ln1(const P& p, int bid, int nb, unsigned char* smem) {
    const int lane = tidx() & 63, wave = tidx() >> 6;
    const bf16_t* pre = (const bf16_t*)p.out; bf16_t* hb = (bf16_t*)(p.ws + H1B);
    const float* gam = p.in[14]; const float* bet = p.in[15];
    for (int tk = bid * 4 + wave; tk < T; tk += nb * 8) {
        const int tk2 = tk + nb * 4;
        float va[16], vb[16], mua, rsa, mub, rsb;
        load_row16(pre + (size_t)tk * 1024, lane, va); load_row16(pre + (size_t)tk2 * 1024, lane, vb);
        ln_stats2(va, vb, mua, rsa, mub, rsb);
#pragma unroll
        for (int i = 0; i < 4; ++i) {
            const float4 g4 = *(const float4*)(gam + i * 256 + lane * 4), b4 = *(const float4*)(bet + i * 256 + lane * 4);
            const float4 oa = make_float4((va[4 * i] - mua) * rsa * g4.x + b4.x, (va[4 * i + 1] - mua) * rsa * g4.y + b4.y, (va[4 * i + 2] - mua) * rsa * g4.z + b4.z, (va[4 * i + 3] - mua) * rsa * g4.w + b4.w);
            const float4 ob = make_float4((vb[4 * i] - mub) * rsb * g4.x + b4.x, (vb[4 * i + 1] - mub) * rsb * g4.y + b4.y, (vb[4 * i + 2] - mub) * rsb * g4.z + b4.z, (vb[4 * i + 3] - mub) * rsb * g4.w + b4.w);
            *(uint2*)(hb + (size_t)tk * 1024 + i * 256 + lane * 4) = pack4(oa); *(uint2*)(hb + (size_t)tk2 * 1024 + i * 256 + lane * 4) = pack4(ob);
        }
    }
}
struct EpiXq {
    bf16_t* qx;
    DI void prefetch(int, int, int) {}
    DI void operator()(const float* Cs, int m0, int n0, int tid) const {
        const int c4 = (tid & 31) * 4, r0 = tid >> 5, hd = n0 >> 8, d = (n0 & 255) + c4, b = m0 >> 11, s0 = m0 & 2047;
#pragma unroll 4
        for (int ps = 0; ps < 16; ++ps) {
            const int row = ps * 8 + r0;
            float4 v = cs4(Cs, row, c4); v.x *= XSCALE; v.y *= XSCALE; v.z *= XSCALE; v.w *= XSCALE;
            *(uint2*)(qx + ((size_t)(b * 4 + hd) * 2048 + s0 + row) * 256 + d) = pack4(v);
        }
    }
};
DI void phase_xq(const P& p, int bid, int nb, unsigned char* smem) {
    const int v = vbid(bid, nb);
    EpiXq e{(bf16_t*)(p.ws + QX)};
    GemmArgs g{(const bf16_t*)(p.ws + H1B), 1024, (const bf16_t*)(p.ws + W_XQ), 1024, 1024, nullptr};
    for (int t = v; t < 256 * 8; t += nb) gemm_tile(g, (t >> 3) * 128, (t & 7) * 128, e, smem);
}
DI void phase_xattn(const P& p, int bid, int nb, unsigned char* smem) {
#if !XATTN_NAIVE
    xattn_fast(p, bid, nb, smem); return;
#endif
    unsigned char* ws = p.ws;
    const bf16_t* qx = (const bf16_t*)(ws + QX); const bf16_t* kx = (const bf16_t*)(ws + KX); const bf16_t* vxt = (const bf16_t*)(ws + VXT);
    bf16_t* ox = (bf16_t*)(ws + OX);
    const int lane = tidx() & 63, hd = tidx() >> 6;
    float* qs = (float*)smem + hd * 512; float* ps = qs + 256;
    for (int tk = bid; tk < T; tk += nb) {
        const int b = tk >> 11, s_ = tk & 2047;
        __syncthreads();
        {
            const uint2 w = *(const uint2*)(qx + ((size_t)(b * 4 + hd) * 2048 + s_) * 256 + lane * 4);
            qs[lane * 4] = bflo(w.x); qs[lane * 4 + 1] = bfhi(w.x); qs[lane * 4 + 2] = bflo(w.y); qs[lane * 4 + 3] = bfhi(w.y);
        }
        __syncthreads();
        float sc[4];
#pragma unroll
        for (int i = 0; i < 4; ++i) {
            const int m = lane + 64 * i;
            const uint4* k4 = (const uint4*)(kx + ((size_t)(b * 4 + hd) * 256 + m) * 256);
            float a = 0.f;
#pragma unroll 8
            for (int c = 0; c < 32; ++c) {
                const uint4 w = k4[c];
                const float4 q0 = *(const float4*)(qs + 8 * c), q1 = *(const float4*)(qs + 8 * c + 4);
                a += q0.x * bflo(w.x) + q0.y * bfhi(w.x) + q0.z * bflo(w.y) + q0.w * bfhi(w.y) + q1.x * bflo(w.z) + q1.y * bfhi(w.z) + q1.z * bflo(w.w) + q1.w * bfhi(w.w);
            }
            sc[i] = a;
        }
        const float mx = wave_max(fmaxf(fmaxf(sc[0], sc[1]), fmaxf(sc[2], sc[3])));
        float sum = 0.f;
#pragma unroll
        for (int i = 0; i < 4; ++i) { sc[i] = exp2f(sc[i] - mx); sum += sc[i]; }
        const float il = 1.f / wave_sum(sum);
#pragma unroll
        for (int i = 0; i < 4; ++i) ps[lane + 64 * i] = sc[i] * il;
        __syncthreads();
        float o[4];
#pragma unroll
        for (int dd = 0; dd < 4; ++dd) {
            const int d = lane * 4 + dd;
            const uint4* v4 = (const uint4*)(vxt + ((size_t)(b * 4 + hd) * 256 + d) * 256);
            float a = 0.f;
#pragma unroll 8
            for (int c = 0; c < 32; ++c) {
                const uint4 w = v4[c];
                const float4 q0 = *(const float4*)(ps + 8 * c), q1 = *(const float4*)(ps + 8 * c + 4);
                a += q0.x * bflo(w.x) + q0.y * bfhi(w.x) + q0.z * bflo(w.y) + q0.w * bfhi(w.y) + q1.x * bflo(w.z) + q1.y * bfhi(w.z) + q1.z * bflo(w.w) + q1.w * bfhi(w.w);
            }
            o[dd] = a;
        }
        uint2 w; w.x = pack2(o[0], o[1]); w.y = pack2(o[2], o[3]);
        *(uint2*)(ox + (size_t)tk * 1024 + hd * 256 + lane * 4) = w;
    }
}
DI void phase_xo(const P& p, int bid, int nb, unsigned char* smem) {
    const int v = vbid(bid, nb);
    EpiResid<true> e; e.pre = (bf16_t*)p.out; e.res = p.ws + H1B;
    GemmArgs g{(const bf16_t*)(p.ws + OX), 1024, (const bf16_t*)(p.ws + W_XO), 1024, 1024, nullptr};
    for (int t = v; t < 256 * 8; t += nb) gemm_tile(g, (t >> 3) * 128, (t & 7) * 128, e, smem);
}
typedef float f32x4v __attribute__((ext_vector_type(4)));
DI void phase_ln2_router(const P& p, int bid, int nb, unsigned char* smem, int rep = 0) {
    unsigned char* ws = p.ws;
    const int lane = tidx() & 63, wave = tidx() >> 6;
    const bf16_t* pre = (const bf16_t*)p.out; bf16_t* hb = (bf16_t*)(ws + H2B);
    const float* wrt = (const float*)(ws + W_RT);
    const float* gam = p.in[20]; const float* bet = p.in[21];
    unsigned* cnt = (unsigned*)(ws + CTL + CTL_CNT); int* lists = (int*)(ws + LISTS); float* tgate = (float*)(ws + TOK_GATE);
    float* lg = (float*)smem + wave * (16 * 52 + 32);
    float* stt = lg + 16 * 52;
    for (int grp = bid; grp < T / 64; grp += nb) {
        const int t0 = grp * 64 + wave * 16;
        for (int rr = 0; rr < 16; rr += 2) {
            if (rep && REP_MODE == 3) break;
            const int tk = t0 + rr;
            float va[16], vb[16], mua, rsa, mub, rsb;
            load_row16(pre + (size_t)tk * 1024, lane, va); load_row16(pre + (size_t)(tk + 1) * 1024, lane, vb);
            ln_stats2(va, vb, mua, rsa, mub, rsb);
            if (lane == 0) { stt[2 * rr] = mua; stt[2 * rr + 1] = rsa; stt[2 * rr + 2] = mub; stt[2 * rr + 3] = rsb; }
#pragma unroll
            for (int i = 0; i < 4; ++i) {
                const float4 g4 = *(const float4*)(gam + i * 256 + lane * 4), b4 = *(const float4*)(bet + i * 256 + lane * 4);
                const float4 oa = make_float4((va[4 * i] - mua) * rsa * g4.x + b4.x, (va[4 * i + 1] - mua) * rsa * g4.y + b4.y, (va[4 * i + 2] - mua) * rsa * g4.z + b4.z, (va[4 * i + 3] - mua) * rsa * g4.w + b4.w);
                const float4 ob = make_float4((vb[4 * i] - mub) * rsb * g4.x + b4.x, (vb[4 * i + 1] - mub) * rsb * g4.y + b4.y, (vb[4 * i + 2] - mub) * rsb * g4.z + b4.z, (vb[4 * i + 3] - mub) * rsb * g4.w + b4.w);
                *(uint2*)(hb + (size_t)tk * 1024 + i * 256 + lane * 4) = pack4(oa); *(uint2*)(hb + (size_t)(tk + 1) * 1024 + i * 256 + lane * 4) = pack4(ob);
            }
        }
        __builtin_amdgcn_wave_barrier();
        if (!(rep && REP_MODE == 2)) {
            const int i16 = lane & 15, g4i = lane >> 4;
            const float mu = stt[2 * i16], rstd = stt[2 * i16 + 1];
            const bf16_t* arow = pre + (size_t)(t0 + i16) * 1024 + 4 * g4i;
            const float* brow = wrt + (size_t)i16 * 1024 + 4 * g4i;
            const float* grow = gam + 4 * g4i; const float* berow = bet + 4 * g4i;
            f32x4v acc0 = {0.f, 0.f, 0.f, 0.f}, acc1 = acc0, acc2 = acc0;
#pragma unroll 4
            for (int S = 0; S < 64; ++S) {
                const uint2 xw = *(const uint2*)(arow + 16 * S); const float4 x4 = make_float4(bflo(xw.x), bfhi(xw.x), bflo(xw.y), bfhi(xw.y));
                const float4 g4 = *(const float4*)(grow + 16 * S), e4 = *(const float4*)(berow + 16 * S);
                const float4 b0 = *(const float4*)(brow + 16 * S), b1 = *(const float4*)(brow + 16 * 1024 + 16 * S), b2 = *(const float4*)(brow + 32 * 1024 + 16 * S);
                const float a0 = (x4.x - mu) * rstd * g4.x + e4.x, a1 = (x4.y - mu) * rstd * g4.y + e4.y, a2 = (x4.z - mu) * rstd * g4.z + e4.z, a3 = (x4.w - mu) * rstd * g4.w + e4.w;
                acc0 = __builtin_amdgcn_mfma_f32_16x16x4f32(a0, b0.x, acc0, 0, 0, 0); acc1 = __builtin_amdgcn_mfma_f32_16x16x4f32(a0, b1.x, acc1, 0, 0, 0); acc2 = __builtin_amdgcn_mfma_f32_16x16x4f32(a0, b2.x, acc2, 0, 0, 0);
                acc0 = __builtin_amdgcn_mfma_f32_16x16x4f32(a1, b0.y, acc0, 0, 0, 0); acc1 = __builtin_amdgcn_mfma_f32_16x16x4f32(a1, b1.y, acc1, 0, 0, 0); acc2 = __builtin_amdgcn_mfma_f32_16x16x4f32(a1, b2.y, acc2, 0, 0, 0);
                acc0 = __builtin_amdgcn_mfma_f32_16x16x4f32(a2, b0.z, acc0, 0, 0, 0); acc1 = __builtin_amdgcn_mfma_f32_16x16x4f32(a2, b1.z, acc1, 0, 0, 0); acc2 = __builtin_amdgcn_mfma_f32_16x16x4f32(a2, b2.z, acc2, 0, 0, 0);
                acc0 = __builtin_amdgcn_mfma_f32_16x16x4f32(a3, b0.w, acc0, 0, 0, 0); acc1 = __builtin_amdgcn_mfma_f32_16x16x4f32(a3, b1.w, acc1, 0, 0, 0); acc2 = __builtin_amdgcn_mfma_f32_16x16x4f32(a3, b2.w, acc2, 0, 0, 0);
            }
#pragma unroll
            for (int e = 0; e < 4; ++e) {
                float* rowp = lg + (4 * g4i + e) * 52 + i16;
                rowp[0] = acc0[e]; rowp[16] = acc1[e]; rowp[32] = acc2[e];
            }
        }
        __builtin_amdgcn_wave_barrier();
        unsigned* lcount = (unsigned*)((float*)smem + 4 * (16 * 52 + 32));
        unsigned* lbase = lcount + 32;
        if (tidx() < 32) lcount[tidx()] = 0u;
        __syncthreads();
        int ex1 = 0, ex2 = 0; unsigned lp1 = 0, lp2 = 0;
        if (lane < 16) {
            const int tk = t0 + lane;
            const float* lr = lg + lane * 52;
            float gl[4], el[32];
#pragma unroll
            for (int j = 0; j < 4; ++j) gl[j] = lr[j] + p.in[23][j];
#pragma unroll
            for (int j = 0; j < 32; ++j) el[j] = lr[4 + j] + p.in[25][j];
            int gi = 0; float gm = gl[0];
#pragma unroll
            for (int j = 1; j < 4; ++j) if (gl[j] > gm) { gm = gl[j]; gi = j; }
            float gs = 0.f;
#pragma unroll
            for (int j = 0; j < 4; ++j) gs += __expf(gl[j] - gm);
            const float ggate = 1.f / gs;
            float ev[8];
#pragma unroll
            for (int j = 0; j < 8; ++j) ev[j] = gi == 0 ? el[j] : gi == 1 ? el[8 + j] : gi == 2 ? el[16 + j] : el[24 + j];
            int i1 = 0; float v1 = ev[0];
#pragma unroll
            for (int j = 1; j < 8; ++j) if (ev[j] > v1) { v1 = ev[j]; i1 = j; }
            int i2 = -1; float v2 = -3.0e38f;
#pragma unroll
            for (int j = 0; j < 8; ++j) if (j != i1 && ev[j] > v2) { v2 = ev[j]; i2 = j; }
            const float e2 = __expf(v2 - v1);
            tgate[tk * 2] = ggate / (1.f + e2); tgate[tk * 2 + 1] = ggate * e2 / (1.f + e2);
            ex1 = gi * 8 + i1; ex2 = gi * 8 + i2;
            if (!rep) { lp1 = atomicAdd(&lcount[ex1], 1u); lp2 = atomicAdd(&lcount[ex2], 1u); }
        }
        __syncthreads();
        if (tidx() < 32 && !rep) { const unsigned c = lcount[tidx()]; lbase[tidx()] = c ? atomicAdd(&cnt[tidx() * CNT_STRIDE], c) : 0u; }
        __syncthreads();
        if (lane < 16 && !rep) {
            const int tk = t0 + lane;
            lists[(size_t)ex1 * T + lbase[ex1] + lp1] = tk * 2;
            lists[(size_t)ex2 * T + lbase[ex2] + lp2] = tk * 2 + 1;
        }
        __syncthreads();
    }
}
struct MoeMap { int off[33]; };
DI int moe_tiles(const unsigned* cnt, int* offs  ) {
    __syncthreads();
    if (tidx() == 0) { int o = 0; for (int e = 0; e < 32; ++e) { offs[e] = o; o += (((int)cnt[e * CNT_STRIDE] + 127) >> 7) << 7; } offs[32] = o; }
    __syncthreads();
    return offs[32] >> 7;
}
struct EpiGU {
    bf16_t* hdn;
    DI void prefetch(int, int, int) {}
    DI void operator()(const float* Cs, int m0, int n0, int tid) const {
#pragma unroll 4
        for (int ps = 0; ps < 8; ++ps) {
            const int it = ps * 256 + tid, row = it >> 4, qd = it & 15, c = (qd >> 3) * 64 + (qd & 7) * 4;
            const float4 g = cs4(Cs, row, c), u = cs4(Cs, row, c + 32);
            const int hc = ((n0 & 511) >> 7) * 64 + (qd >> 3) * 32 + (qd & 7) * 4;
            *(uint2*)(hdn + (size_t)(m0 + row) * 256 + hc) = pack4(make_float4(siluf(g.x) * u.x, siluf(g.y) * u.y, siluf(g.z) * u.z, siluf(g.w) * u.w));
        }
    }
};
struct EpiDown {
    bf16_t* y; const int* ltok; const float* lgate;
    DI void prefetch(int, int, int) {}
    DI void operator()(const float* Cs, int m0, int n0, int tid) const {
        const int c4 = (tid & 31) * 4, r0 = tid >> 5;
#pragma unroll 4
        for (int ps = 0; ps < 16; ++ps) {
            const int row = ps * 8 + r0, tk2 = ltok[row];
            if (tk2 >= 0) {
                const float gt = lgate[row];
                float4 v = cs4(Cs, row, c4); v.x *= gt; v.y *= gt; v.z *= gt; v.w *= gt;
                *(uint2*)(y + (size_t)tk2 * 1024 + n0 + c4) = pack4(v);
            }
        }
    }
};
template <int WHICH>
DI void phase_moe(const P& p, int bid, int nb, unsigned char* smem) {
    unsigned char* ws = p.ws;
    const unsigned* cnt = (const unsigned*)(ws + CTL + CTL_CNT); const int* lists = (const int*)(ws + LISTS); const float* tgate = (const float*)(ws + TOK_GATE);
    int* offs = (int*)(smem + GEMM_LDS); int* ltok = offs + 64; int* lrow = ltok + 128; float* lgate = (float*)(lrow + 128);
    const int nmt = moe_tiles(cnt, offs);
    constexpr int NNT = WHICH == 0 ? 4 : 8;
    const int v = vbid(bid, nb);
    for (int t = v; t < nmt * NNT; t += nb) {
        const int mt = t / NNT, ntl = t % NNT;
        const int slot0 = mt * 128;
        int e = 0;
        while (offs[e + 1] <= slot0) ++e;
        __syncthreads();
        if (tidx() < 128) {
            const int pos = slot0 - offs[e] + tidx();
            const int tk2 = pos < (int)cnt[e * CNT_STRIDE] ? lists[(size_t)e * T + pos] : -1;
            ltok[tidx()] = tk2; lrow[tidx()] = tk2 < 0 ? 0 : (tk2 >> 1); lgate[tidx()] = tk2 < 0 ? 0.f : tgate[tk2];
        }
        __syncthreads();
        if (WHICH == 0) {
            EpiGU ep{(bf16_t*)(ws + HDN)};
            GemmArgs g{(const bf16_t*)(ws + H2B), 1024, (const bf16_t*)(ws + W_GU) + (size_t)e * 512 * 1024, 1024, 1024, lrow};
            gemm_tile(g, slot0, ntl * 128, ep, smem);
        } else {
            EpiDown ep{(bf16_t*)(ws + YB), ltok, lgate};
            GemmArgs g{(const bf16_t*)(ws + HDN), 256, (const bf16_t*)(ws + W_DN) + (size_t)e * 1024 * 256, 256, 256, nullptr};
            gemm_tile(g, slot0, ntl * 128, ep, smem);
        }
    }
}
DI void phase_final(const P& p, int bid, int nb, unsigned char* smem) {
    const int lane = tidx() & 63, wave = tidx() >> 6;
    const bf16_t* hb2 = (const bf16_t*)(p.ws + H2B); const bf16_t* y = (const bf16_t*)(p.ws + YB);
    const float* gam = p.in[29]; const float* bet = p.in[30];
    for (int tk = bid * 4 + wave; tk < T; tk += nb * 8) {
        const int tk2 = tk + nb * 4;
        float va[16], vb[16], mua, rsa, mub, rsb;
#pragma unroll
        for (int i = 0; i < 4; ++i) {
            const uint2 ha = *(const uint2*)(hb2 + (size_t)tk * 1024 + i * 256 + lane * 4), hbv = *(const uint2*)(hb2 + (size_t)tk2 * 1024 + i * 256 + lane * 4);
            const float4 ta = make_float4(bflo(ha.x), bfhi(ha.x), bflo(ha.y), bfhi(ha.y)), tb = make_float4(bflo(hbv.x), bfhi(hbv.x), bflo(hbv.y), bfhi(hbv.y));
            const uint2 a0 = *(const uint2*)(y + (size_t)(tk * 2) * 1024 + i * 256 + lane * 4), a1 = *(const uint2*)(y + (size_t)(tk * 2 + 1) * 1024 + i * 256 + lane * 4);
            const uint2 b0 = *(const uint2*)(y + (size_t)(tk2 * 2) * 1024 + i * 256 + lane * 4), b1 = *(const uint2*)(y + (size_t)(tk2 * 2 + 1) * 1024 + i * 256 + lane * 4);
            va[4 * i] = ALPHA * ta.x + bflo(a0.x) + bflo(a1.x); va[4 * i + 1] = ALPHA * ta.y + bfhi(a0.x) + bfhi(a1.x); va[4 * i + 2] = ALPHA * ta.z + bflo(a0.y) + bflo(a1.y); va[4 * i + 3] = ALPHA * ta.w + bfhi(a0.y) + bfhi(a1.y);
            vb[4 * i] = ALPHA * tb.x + bflo(b0.x) + bflo(b1.x); vb[4 * i + 1] = ALPHA * tb.y + bfhi(b0.x) + bfhi(b1.x); vb[4 * i + 2] = ALPHA * tb.z + bflo(b0.y) + bflo(b1.y); vb[4 * i + 3] = ALPHA * tb.w + bfhi(b0.y) + bfhi(b1.y);
        }
        ln_stats2(va, vb, mua, rsa, mub, rsb);
#pragma unroll
        for (int i = 0; i < 4; ++i) {
            const float4 g4 = *(const float4*)(gam + i * 256 + lane * 4), b4 = *(const float4*)(bet + i * 256 + lane * 4);
            *(float4*)(p.out + (size_t)tk * 1024 + i * 256 + lane * 4) = make_float4((va[4 * i] - mua) * rsa * g4.x + b4.x, (va[4 * i + 1] - mua) * rsa * g4.y + b4.y, (va[4 * i + 2] - mua) * rsa * g4.z + b4.z, (va[4 * i + 3] - mua) * rsa * g4.w + b4.w);
            *(float4*)(p.out + (size_t)tk2 * 1024 + i * 256 + lane * 4) = make_float4((vb[4 * i] - mub) * rsb * g4.x + b4.x, (vb[4 * i + 1] - mub) * rsb * g4.y + b4.y, (vb[4 * i + 2] - mub) * rsb * g4.z + b4.z, (vb[4 * i + 3] - mub) * rsb * g4.w + b4.w);
        }
    }
}

#define XB_TMO      128
#define XB_XCNT(j)  (256  + 64 * (j))
#define XB_XSUB(j)  (1280 + 64 * (j))
#define XB_XGEN(j)  (2304 + 64 * (j))
#define XB_TOP      3328
#define XB_TOPGEN   3392
#define XCD_BAR_WORDS 3456
#define XB_SPIN_CAP (1u << 25)
DI unsigned xb_ld(unsigned* p) { return __hip_atomic_load(p, __ATOMIC_RELAXED, __HIP_MEMORY_SCOPE_AGENT); }
DI unsigned xb_add(unsigned* p, unsigned v) { return __hip_atomic_fetch_add(p, v, __ATOMIC_RELAXED, __HIP_MEMORY_SCOPE_AGENT); }
DI unsigned xb_xcc_id() { return (unsigned)__builtin_amdgcn_s_getreg((3 << 11) | 20) & 0xFu; }
#define XB_SPIN(cond, bar) do { unsigned _sp = 0; while (cond) { __builtin_amdgcn_s_sleep(1); \
    if ((++_sp & 255u) == 0u) { if (xb_ld(&(bar)[XB_TMO])) break; if (_sp > XB_SPIN_CAP) { atomicAdd(&(bar)[XB_TMO], 1u); break; } } } } while (0)
struct XcdBarrier { unsigned* bar; unsigned x; volatile LAS unsigned* st; };
DI XcdBarrier xcd_barrier_post(unsigned* bar, volatile LAS unsigned* st) {
    XcdBarrier b; b.bar = bar; b.x = xb_xcc_id(); b.st = st;
    if (threadIdx.x == 0) (void)xb_add(&bar[XB_XCNT(b.x)], 1u);
    return b;
}
DI void xcd_barrier_complete(unsigned* bar, unsigned x, unsigned& nloc, unsigned& nx) {
    const unsigned G = gridDim.x * gridDim.y * gridDim.z;
    unsigned sum, cnt, mine, sp = 0u;
    for (;;) {
        sum = 0u; cnt = 0u; mine = 0u;
#pragma unroll
        for (unsigned j = 0; j < 16; ++j) { const unsigned c = xb_ld(&bar[XB_XCNT(j)]); sum += c; cnt += (c > 0u) ? 1u : 0u; mine = (j == x) ? c : mine; }
        if (sum == G) break;
        __builtin_amdgcn_s_sleep(1);
        if ((++sp & 255u) == 0u) { if (xb_ld(&bar[XB_TMO])) break; if (sp > XB_SPIN_CAP) { atomicAdd(&bar[XB_TMO], 1u); break; } }
    }
    nloc = mine > 0u ? mine : 1u; nx = cnt > 0u ? cnt : 1u;
}
DI void xcd_barrier(const XcdBarrier& b) {
    asm volatile("s_waitcnt vmcnt(0)" ::: "memory");
    __syncthreads();
    if (threadIdx.x == 0) {
        unsigned* bar = b.bar;
        __builtin_amdgcn_s_waitcnt(0);
        unsigned nloc = b.st[0], nx = b.st[1];
        if (nloc == 0u) { xcd_barrier_complete(bar, b.x, nloc, nx); b.st[0] = nloc; b.st[1] = nx; }
        const unsigned old = xb_add(&bar[XB_XSUB(b.x)], 1u);
        const unsigned gen = old / nloc;
        if (old + 1u == (gen + 1u) * nloc) {
            __builtin_amdgcn_fence(__ATOMIC_RELEASE, "agent");
            asm volatile("s_waitcnt vmcnt(0)" ::: "memory");
            const unsigned og = xb_add(&bar[XB_TOP], 1u);
            const unsigned tg = og / nx;
            if (og + 1u == (tg + 1u) * nx) xb_add(&bar[XB_TOPGEN], 1u);
            else XB_SPIN(xb_ld(&bar[XB_TOPGEN]) == tg, bar);
            __builtin_amdgcn_fence(__ATOMIC_ACQUIRE, "agent");
            xb_add(&bar[XB_XGEN(b.x)], 1u);
            asm volatile("s_waitcnt vmcnt(0)" ::: "memory");
        } else {
            XB_SPIN(xb_ld(&bar[XB_XGEN(b.x)]) == gen, bar);
            __builtin_amdgcn_fence(__ATOMIC_ACQUIRE, "agent");
            asm volatile("s_waitcnt vmcnt(0)" ::: "memory");
        }
    }
    __syncthreads();
}

constexpr int NPHASE = 14;
template <int PH>
DI void run_phase(const P& p, int bid, int nb, unsigned char* smem, int rep = 0) {
    if (PH == 0) phase_prep(p, bid, nb, smem);
    else if (PH == 1) phase_proj(p, bid, nb, smem, rep);
    else if (PH == 2) phase_up(p, bid, nb, smem);
    else if (PH == 3) phase_mixer(p, bid, nb, smem, rep);
    else if (PH == 4) phase_ssdnorm(p, bid, nb, smem);
    else if (PH == 5) phase_wout(p, bid, nb, smem);
    else if (PH == 6) phase_ln1(p, bid, nb, smem);
    else if (PH == 7) phase_xq(p, bid, nb, smem);
    else if (PH == 8) phase_xattn(p, bid, nb, smem);
    else if (PH == 9) phase_xo(p, bid, nb, smem);
    else if (PH == 10) phase_ln2_router(p, bid, nb, smem, rep);
    else if (PH == 11) phase_moe<0>(p, bid, nb, smem);
    else if (PH == 12) phase_moe<1>(p, bid, nb, smem);
    else if (PH == 13) phase_final(p, bid, nb, smem);
}
template <int PH>
__global__ void __launch_bounds__(256, 2) k_phase(P p) {
    __shared__ __attribute__((aligned(16))) unsigned char smem[SMEM_BYTES];
    run_phase<PH>(p, blockIdx.x, gridDim.x, smem);
}

#if MEGA
#ifndef MEGA_WAVES
#define MEGA_WAVES 2
#endif
template <int PH>
DI void mega_steps(const P& p, const XcdBarrier& bar, unsigned char* smem) {
    run_phase<PH>(p, blockIdx.x, gridDim.x, smem);
    if constexpr (((REPEAT_MASK >> PH) & 1) != 0) { xcd_barrier(bar); run_phase<PH>(p, blockIdx.x, gridDim.x, smem, 1); }
    if constexpr (PH == 6 && EXTRA_BARRIERS > 0) { for (int i = 0; i < EXTRA_BARRIERS; ++i) xcd_barrier(bar); }
    if constexpr (PH + 1 < NPHASE) { xcd_barrier(bar); mega_steps<PH + 1>(p, bar, smem); }
}
__global__ void __launch_bounds__(256, MEGA_WAVES) k_mega(P p) {
    __shared__ __attribute__((aligned(16))) unsigned char smem[SMEM_BYTES];
    volatile LAS unsigned* st = (volatile LAS unsigned*)(smem + SMEM_BYTES - 16);
    if (threadIdx.x < 4) st[threadIdx.x] = 0u;
    __syncthreads();
    const XcdBarrier bar = xcd_barrier_post((unsigned*)(p.ws + CTL), st);
    mega_steps<0>(p, bar, smem);
}
#endif
template <int PH>
__global__ void __launch_bounds__(256, 1) k_phase_big(P p) {
    __shared__ __attribute__((aligned(16))) unsigned char smem[SMEM_BYTES];
    run_phase<PH>(p, blockIdx.x, gridDim.x, smem);
}
template <int PH>
static void launch_phase(const P& p, int grid, hipStream_t st) {
    if constexpr (PH == 3 && !P3_SMALL) hipLaunchKernelGGL((k_phase_big<PH>), dim3(grid), dim3(256), 0, st, p);
    else hipLaunchKernelGGL((k_phase<PH>), dim3(grid), dim3(256), 0, st, p);
}

extern "C" void kernel_launch(void* const* d_in, const int* in_sizes, int n_in, void* d_out, int out_size, void* d_ws, size_t ws_size, hipStream_t stream) {
    if (n_in != 31 || out_size != T * D || ws_size < WS_NEED) {
        fprintf(stderr, "kernel_launch: unexpected shapes: n_in %d out %d ws %zu (need %zu)\n", n_in, out_size, ws_size, (size_t)WS_NEED);
        return;
    }
    P p{};
    for (int i = 0; i < 31; ++i) p.in[i] = (const float*)d_in[i];
    p.out = (float*)d_out; p.ws = (unsigned char*)d_ws;
    (void)hipMemsetAsync((unsigned char*)d_ws + CTL, 0, CTL_BYTES, stream);
#if MEGA
    static int grid = 0;
    if (grid == 0) {
        int dev = 0, cus = 0, per_cu = 0;
        (void)hipGetDevice(&dev);
        (void)hipDeviceGetAttribute(&cus, hipDeviceAttributeMultiprocessorCount, dev);
        if (hipOccupancyMaxActiveBlocksPerMultiprocessor(&per_cu, (const void*)k_mega, 256, 0) != hipSuccess || per_cu < 1) { fprintf(stderr, "kernel_launch: occupancy query failed\n"); per_cu = 1; }
        if (per_cu > 2) per_cu = 2;
        grid = cus * per_cu;
        fprintf(stderr, "kernel_launch: mega grid %d (%d CUs x %d)\n", grid, cus, per_cu);
    }
    void* args[] = {(void*)&p};
    const hipError_t le = hipLaunchCooperativeKernel((const void*)k_mega, dim3(grid), dim3(256), args, 0, stream);
    if (le != hipSuccess) fprintf(stderr, "kernel_launch: cooperative launch failed: %s (grid %d)\n", hipGetErrorString(le), grid);
#else
    const int grid = 1024;
    launch_phase<0>(p, grid, stream); launch_phase<1>(p, grid, stream); launch_phase<2>(p, grid, stream); launch_phase<3>(p, grid, stream);
    launch_phase<4>(p, grid, stream); launch_phase<5>(p, grid, stream); launch_phase<6>(p, grid, stream); launch_phase<7>(p, grid, stream);
    launch_phase<8>(p, grid, stream); launch_phase<9>(p, grid, stream); launch_phase<10>(p, grid, stream); launch_phase<11>(p, grid, stream);
    launch_phase<12>(p, grid, stream); launch_phase<13>(p, grid, stream);
#endif
}
```

```cpp
#include <hip/hip_runtime.h>
#include <stdint.h>
#include <stdio.h>

#ifndef MEGA
#define MEGA 1
#endif
#ifndef ATTN_NAIVE
#define ATTN_NAIVE 0
#endif
#ifndef XATTN_NAIVE
#define XATTN_NAIVE 0
#endif
#ifndef SSD_NAIVE
#define SSD_NAIVE 0
#endif
#ifndef P3_SMALL
#define P3_SMALL 1
#endif
#ifndef NO_SSD
#define NO_SSD 0
#endif
#ifndef NO_FLASH
#define NO_FLASH 0
#endif
#ifndef GEMM_GLDS
#define GEMM_GLDS 1
#endif
#ifndef EXTRA_BARRIERS
#define EXTRA_BARRIERS 0
#endif
#ifndef SSD_PM
#define SSD_PM 0
#endif
#ifndef REPEAT_MASK
#define REPEAT_MASK 0
#endif
#ifndef REP_MODE
#define REP_MODE 0
#endif
#ifndef GEMM_DIRECT
#define GEMM_DIRECT 0
#endif

typedef unsigned short bf16_t;
typedef short bf16x8 __attribute__((ext_vector_type(8)));
typedef float f32x16 __attribute__((ext_vector_type(16)));
#define DI __device__ __forceinline__
#define LAS __attribute__((address_space(3)))
#define MFMA32(a, b, c) __builtin_amdgcn_mfma_f32_32x32x16_bf16((a), (b), (c), 0, 0, 0)

constexpr int Bn = 16, S = 2048, T = Bn * S, D = 1024;
constexpr int NMEM = 256;
constexpr float EPS = 1e-5f;
constexpr float ALPHA = 1.189207115002721f;
constexpr float LOG2E = 1.4426950408889634f;
constexpr float QSCALE = 0.10206207261596577f * LOG2E;
constexpr float XSCALE = 0.0625f * LOG2E;
constexpr int NEXP = 32;
constexpr int MAXSLOTS = 69632;

constexpr size_t MiB = 1u << 20;
constexpr size_t W_IN = 0;
constexpr size_t W_QUP = W_IN + 4 * MiB;
constexpr size_t W_KVUP = W_QUP + 768 * 256 * 2;
constexpr size_t W_OUT = W_KVUP + 1024 * 128 * 2;
constexpr size_t W_XQ = W_OUT + 2 * MiB;
constexpr size_t W_XKV = W_XQ + 2 * MiB;
constexpr size_t W_XO = W_XKV + 4 * MiB;
constexpr size_t W_GU = W_XO + 2 * MiB;
constexpr size_t W_DN = W_GU + 32 * MiB;
constexpr size_t W_RT = W_DN + 16 * MiB;
constexpr size_t ROPE_C = W_RT + 48 * 1024 * 4;
constexpr size_t ROPE_S = ROPE_C + 2048 * 16 * 4;
constexpr size_t TOK_GATE = ROPE_S + 2048 * 16 * 4;
constexpr size_t CTL = TOK_GATE + (size_t)T * 2 * 4;
constexpr size_t CTL_BYTES = 32768;
constexpr size_t CTL_CNT = 16384;
constexpr int CNT_STRIDE = 64;
constexpr size_t CTL_QUEUE = 28672;
static_assert(CTL + CTL_BYTES <= 64 * MiB, "weights region overflow");
constexpr size_t RA = 64 * MiB, RB = 192 * MiB, RC = 320 * MiB, RD = 448 * MiB, WS_NEED = 512 * MiB;
constexpr size_t XBC = RA;
constexpr size_t KX = RA + 64 * MiB;
constexpr size_t VXT = KX + 8 * MiB;
constexpr size_t YB = RA;
constexpr size_t QB = RB;
constexpr size_t KNB = RB + 48 * MiB;
constexpr size_t VTB = KNB + 32 * MiB;
constexpr size_t H1 = RB;
constexpr size_t H2 = RB;
constexpr size_t XB = RC;
constexpr size_t MEMB = RB;
constexpr size_t XBCA = RC;
constexpr size_t MIX = RC + 64 * MiB;
constexpr size_t H1B = RC;
constexpr size_t QX = RC + 64 * MiB;
constexpr size_t OX = RB;
constexpr size_t H2B = RC;
constexpr size_t HDN = RC + 64 * MiB;
constexpr size_t CQ = RD;
constexpr size_t CKV = CQ + 16 * MiB;
constexpr size_t KROPE = CKV + 8 * MiB;
constexpr size_t DTB = KROPE + 2 * MiB;
constexpr size_t ZB = DTB + 1 * MiB;
constexpr size_t LISTS = RD;
static_assert(ZB + 32 * MiB <= WS_NEED, "region D overflow");

struct P {
    const float* in[31];
    float* out;
    unsigned char* ws;
};

typedef __bf16 hbf16x2 __attribute__((ext_vector_type(2)));
typedef float f32x2 __attribute__((ext_vector_type(2)));
DI bf16_t f2bf(float x) { return __builtin_bit_cast(bf16_t, (__bf16)x); }
DI float bf2f(bf16_t b) { return __uint_as_float(((unsigned)b) << 16); }
DI float bflo(unsigned w) { return __uint_as_float(w << 16); }
DI float bfhi(unsigned w) { return __uint_as_float(w & 0xffff0000u); }
DI unsigned pack2(float a, float b) { f32x2 v = {a, b}; return __builtin_bit_cast(unsigned, __builtin_convertvector(v, hbf16x2)); }
DI float siluf(float x) { return x * __builtin_amdgcn_rcpf(1.f + __expf(-x)); }
DI float softplusf(float x) {
    const float zz = __expf(-fabsf(x));
    const float l1p = zz < 0.01f ? zz * (1.f - zz * (0.5f - zz * (1.f / 3.f))) : __logf(1.f + zz);
    return fmaxf(x, 0.f) + l1p;
}
DI int tidx() { int t = __builtin_amdgcn_workitem_id_x(); asm volatile("" : "+v"(t)); return t; }
DI int crow(int reg, int h) { return (reg & 3) + 8 * (reg >> 2) + 4 * h; }
constexpr int CS_LD = 132;
DI float4 cs4(const float* Cs, int row, int col) { return *(const float4*)(Cs + row * CS_LD + col); }
DI uint2 pack4(float4 v) { uint2 w; w.x = pack2(v.x, v.y); w.y = pack2(v.z, v.w); return w; }
DI float wave_sum(float v) {
#pragma unroll
    for (int o = 32; o >= 1; o >>= 1) v += __shfl_xor(v, o);
    return v;
}
DI float wave_max(float v) {
#pragma unroll
    for (int o = 32; o >= 1; o >>= 1) v = fmaxf(v, __shfl_xor(v, o));
    return v;
}

constexpr int LDS_ROW = 144;
constexpr int TILE_BYTES = 128 * LDS_ROW;
constexpr int GEMM_LDS = 4 * TILE_BYTES;
constexpr int SMEM_BYTES = GEMM_LDS + 3072;
static_assert(128 * CS_LD * 4 <= GEMM_LDS, "epilogue tile");

struct GemmArgs {
    const bf16_t* A; int lda;
    const bf16_t* Bt; int ldb;
    int K;
    const int* lrows;
};

template <class Epi>
DI void gemm_tile(const GemmArgs& g, int m0, int n0, Epi& epi, unsigned char* smem) {
    const int tid = tidx(), lane = tid & 63, wave = tid >> 6, wr = wave >> 1, wc = wave & 1;
    const int r = lane & 31, h = lane >> 5;
    f32x16 acc[2][2];
#pragma unroll
    for (int i = 0; i < 2; ++i)
#pragma unroll
        for (int j = 0; j < 2; ++j)
#pragma unroll
            for (int e = 0; e < 16; ++e) acc[i][j][e] = 0.f;
    const int nk = g.K >> 6;
    epi.prefetch(m0, n0, tid);
#if GEMM_DIRECT
    {
        const bf16_t* ap[2]; const bf16_t* bp[2];
#pragma unroll
        for (int i = 0; i < 2; ++i) {
            const int lr = wr * 64 + i * 32 + r;
            const int grow = g.lrows ? g.lrows[lr] : (m0 + lr);
            ap[i] = g.A + (size_t)grow * g.lda + 8 * h;
            bp[i] = g.Bt + (size_t)(n0 + wc * 64 + i * 32 + r) * g.ldb + 8 * h;
        }
        for (int k = 0; k < g.K; k += 16) {
            bf16x8 a[2], b[2];
#pragma unroll
            for (int i = 0; i < 2; ++i) { a[i] = *(const bf16x8*)(ap[i] + k); b[i] = *(const bf16x8*)(bp[i] + k); }
#pragma unroll
            for (int i = 0; i < 2; ++i)
#pragma unroll
                for (int j = 0; j < 2; ++j) acc[i][j] = MFMA32(a[i], b[j], acc[i][j]);
        }
    }
#elif GEMM_GLDS
    {
        constexpr int STG = 32768, TB = 16384;
        const int srow = tid >> 3, sch = (tid & 7) ^ ((srow >> 1) & 7);
        const bf16_t* ag[4]; const bf16_t* bg[4];
#pragma unroll
        for (int i = 0; i < 4; ++i) {
            const int lr = srow + 32 * i;
            const int grow = g.lrows ? g.lrows[lr] : (m0 + lr);
            ag[i] = g.A + (size_t)grow * g.lda + sch * 8;
            bg[i] = g.Bt + (size_t)(n0 + lr) * g.ldb + sch * 8;
        }
#define GLDS_STAGE(BUF, KO) do { unsigned char* _d = (BUF) + wave * 1024; \
        _Pragma("unroll") for (int i = 0; i < 4; ++i) { \
            __builtin_amdgcn_global_load_lds((const unsigned*)(ag[i] + (KO)), (LAS unsigned*)(_d + i * 4096), 16, 0, 0); \
            __builtin_amdgcn_global_load_lds((const unsigned*)(bg[i] + (KO)), (LAS unsigned*)(_d + TB + i * 4096), 16, 0, 0); } } while (0)
        __syncthreads();
        GLDS_STAGE(smem, 0);
        const int y16 = (h ^ ((r >> 1) & 7)) << 4;
        const int o0 = y16, o1 = 32 ^ y16, o2 = 64 ^ y16, o3 = 96 ^ y16;
        const int arow = (wr * 64 + r) * 128, brow = TB + (wc * 64 + r) * 128;
        __syncthreads();
        for (int kt = 0; kt < nk; ++kt) {
            const unsigned char* cur = smem + (kt & 1) * STG;
            if (kt + 1 < nk) GLDS_STAGE(smem + ((kt + 1) & 1) * STG, (kt + 1) * 64);
            bf16x8 fa[4][2], fb[4][2];
#define KLOAD(S, OFF) do { \
                fa[S][0] = *(const bf16x8*)(cur + arow + (OFF)); fa[S][1] = *(const bf16x8*)(cur + arow + 32 * 128 + (OFF)); \
                fb[S][0] = *(const bf16x8*)(cur + brow + (OFF)); fb[S][1] = *(const bf16x8*)(cur + brow + 32 * 128 + (OFF)); } while (0)
            KLOAD(0, o0); KLOAD(1, o1); KLOAD(2, o2); KLOAD(3, o3);
#undef KLOAD
#pragma unroll
            for (int s = 0; s < 4; ++s) {
                acc[0][0] = MFMA32(fa[s][0], fb[s][0], acc[0][0]); acc[0][1] = MFMA32(fa[s][0], fb[s][1], acc[0][1]);
                acc[1][0] = MFMA32(fa[s][1], fb[s][0], acc[1][0]); acc[1][1] = MFMA32(fa[s][1], fb[s][1], acc[1][1]);
            }
            __builtin_amdgcn_sched_group_barrier(0x100, 8, 0); __builtin_amdgcn_sched_group_barrier(0x8, 4, 0);
            __builtin_amdgcn_sched_group_barrier(0x100, 4, 0); __builtin_amdgcn_sched_group_barrier(0x8, 4, 0);
            __builtin_amdgcn_sched_group_barrier(0x100, 4, 0); __builtin_amdgcn_sched_group_barrier(0x8, 8, 0);
#define KSTEP(OFF)
#undef KSTEP
            __syncthreads();
        }
#undef GLDS_STAGE
    }
#else
    {
        const int srow = tid >> 3, sch = tid & 7;
        const bf16_t* ag[4]; const bf16_t* bg[4];
#pragma unroll
        for (int i = 0; i < 4; ++i) {
            const int lr = srow + 32 * i;
            const int grow = g.lrows ? g.lrows[lr] : (m0 + lr);
            ag[i] = g.A + (size_t)grow * g.lda + sch * 8;
            bg[i] = g.Bt + (size_t)(n0 + lr) * g.ldb + sch * 8;
        }
        const int soff = srow * LDS_ROW + sch * 16;
        uint4 ra0, ra1, ra2, ra3, rb0, rb1, rb2, rb3;
#define G_LOAD(KO) do { ra0 = *(const uint4*)(ag[0] + (KO)); ra1 = *(const uint4*)(ag[1] + (KO)); ra2 = *(const uint4*)(ag[2] + (KO)); ra3 = *(const uint4*)(ag[3] + (KO)); \
                        rb0 = *(const uint4*)(bg[0] + (KO)); rb1 = *(const uint4*)(bg[1] + (KO)); rb2 = *(const uint4*)(bg[2] + (KO)); rb3 = *(const uint4*)(bg[3] + (KO)); } while (0)
#define L_STORE(BUF) do { unsigned char* _d = (BUF) + soff; \
        *(uint4*)(_d) = ra0; *(uint4*)(_d + 32 * LDS_ROW) = ra1; *(uint4*)(_d + 64 * LDS_ROW) = ra2; *(uint4*)(_d + 96 * LDS_ROW) = ra3; \
        *(uint4*)(_d + TILE_BYTES) = rb0; *(uint4*)(_d + TILE_BYTES + 32 * LDS_ROW) = rb1; *(uint4*)(_d + TILE_BYTES + 64 * LDS_ROW) = rb2; *(uint4*)(_d + TILE_BYTES + 96 * LDS_ROW) = rb3; } while (0)
        G_LOAD(0);
        __syncthreads();
        L_STORE(smem);
        __syncthreads();
        const int aoff = (wr * 64 + r) * LDS_ROW + h * 16;
        const int boff = TILE_BYTES + (wc * 64 + r) * LDS_ROW + h * 16;
        for (int kt = 0; kt < nk; ++kt) {
            const unsigned char* cur = smem + (kt & 1) * 2 * TILE_BYTES;
            unsigned char* nxt = smem + ((kt + 1) & 1) * 2 * TILE_BYTES;
            const bool more = (kt + 1 < nk);
            if (more) G_LOAD((kt + 1) * 64);
#pragma unroll
            for (int ks = 0; ks < 4; ++ks) {
                const bf16x8 a0 = *(const bf16x8*)(cur + aoff + ks * 32);
                const bf16x8 a1 = *(const bf16x8*)(cur + aoff + 32 * LDS_ROW + ks * 32);
                const bf16x8 b0 = *(const bf16x8*)(cur + boff + ks * 32);
                const bf16x8 b1 = *(const bf16x8*)(cur + boff + 32 * LDS_ROW + ks * 32);
                acc[0][0] = MFMA32(a0, b0, acc[0][0]); acc[0][1] = MFMA32(a0, b1, acc[0][1]);
                acc[1][0] = MFMA32(a1, b0, acc[1][0]); acc[1][1] = MFMA32(a1, b1, acc[1][1]);
            }
            if (more) L_STORE(nxt);
            __syncthreads();
        }
#undef G_LOAD
#undef L_STORE
    }
#endif
    float* Cs = (float*)smem;
#if GEMM_DIRECT
    __syncthreads();
#endif
#pragma unroll
    for (int i = 0; i < 2; ++i)
#pragma unroll
        for (int j = 0; j < 2; ++j)
#pragma unroll
            for (int e = 0; e < 16; ++e) Cs[(wr * 64 + i * 32 + crow(e, h)) * CS_LD + wc * 64 + j * 32 + r] = acc[i][j][e];
    __syncthreads();
    epi(Cs, m0, n0, tid);
}

DI int vbid(int bid, int nb) { return (nb % 8 == 0) ? (bid % 8) * (nb / 8) + bid / 8 : bid; }

DI int colmap_in(int n) {
    if (n < 384) return n;
    if (n < 896) return 416 + (n - 384);
    if (n < 1920) return 928 + (n - 896);
    if (n < 1952) return 384 + (n - 1920);
    if (n < 1960) return n;
    return -1;
}
template <int KIND>
DI void tconv_tile(const float* src, const float* src2, int ldsrc, bf16_t* dst, int K, int k0, int n0, const float* scale, int scale_from, unsigned char* smem) {
    float* tile = (float*)smem;
    const int t = tidx();
    __syncthreads();
#pragma unroll 4
    for (int i = 0; i < 16; ++i) {
        const int k = i * 4 + (t >> 6), n = t & 63;
        const int nd = n0 + n;
        float v = 0.f;
        if (KIND == 1) { const int c = colmap_in(nd); if (c >= 0) v = src[(size_t)(k0 + k) * ldsrc + c]; }
        else if (KIND == 2) {
            const int j = nd >> 7, wc = (nd >> 6) & 1, isup = (nd >> 5) & 1, ii = nd & 31;
            const int c = 64 * j + 32 * wc + ii;
            v = (isup ? src2 : src)[(size_t)(k0 + k) * ldsrc + c];
        } else v = src[(size_t)(k0 + k) * ldsrc + nd];
        if (scale && (k0 + k) >= scale_from) v *= scale[k0 + k - scale_from];
        tile[k * 65 + n] = v;
    }
    __syncthreads();
#pragma unroll 4
    for (int i = 0; i < 16; ++i) {
        const int n = i * 4 + (t >> 6), k = t & 63;
        dst[(size_t)(n0 + n) * K + k0 + k] = f2bf(tile[k * 65 + n]);
    }
}

DI void phase_prep(const P& p, int bid, int nb, unsigned char* smem) {
    unsigned char* ws = p.ws;
    const int tid = tidx();
    constexpr int J0 = 512, J1 = J0 + 48, J2 = J1 + 32, J3 = J2 + 256, J4 = J3 + 256, J5 = J4 + 256, J6 = J5 + 256, J7 = J6 + 256, J8 = J7 + 4096, J9 = J8 + 2048;
    for (int t = bid; t < J9; t += nb) {
        if (t < J0) { const int kt = t >> 5, ntl = t & 31; tconv_tile<1>(p.in[2], nullptr, 1960, (bf16_t*)(ws + W_IN), 1024, kt * 64, ntl * 64, nullptr, 0, smem); }
        else if (t < J1) { const int u = t - J0, kt = u / 12, ntl = u % 12; tconv_tile<0>(p.in[4], nullptr, 768, (bf16_t*)(ws + W_QUP), 256, kt * 64, ntl * 64, p.in[3], 0, smem); }
        else if (t < J2) { const int u = t - J1, kt = u >> 4, ntl = u & 15; tconv_tile<0>(p.in[6], nullptr, 1024, (bf16_t*)(ws + W_KVUP), 128, kt * 64, ntl * 64, p.in[5], 0, smem); }
        else if (t < J3) { const int u = t - J2, kt = u >> 4, ntl = u & 15; tconv_tile<0>(p.in[13], nullptr, 1024, (bf16_t*)(ws + W_OUT), 1024, kt * 64, ntl * 64, p.in[12], 512, smem); }
        else if (t < J4) { const int u = t - J3, kt = u >> 4, ntl = u & 15; tconv_tile<0>(p.in[16], nullptr, 1024, (bf16_t*)(ws + W_XQ), 1024, kt * 64, ntl * 64, nullptr, 0, smem); }
        else if (t < J5) { const int u = t - J4, kt = u >> 4, ntl = u & 15; tconv_tile<0>(p.in[17], nullptr, 1024, (bf16_t*)(ws + W_XKV), 1024, kt * 64, ntl * 64, nullptr, 0, smem); }
        else if (t < J6) { const int u = t - J5, kt = u >> 4, ntl = u & 15; tconv_tile<0>(p.in[18], nullptr, 1024, (bf16_t*)(ws + W_XKV) + (size_t)1024 * 1024, 1024, kt * 64, ntl * 64, nullptr, 0, smem); }
        else if (t < J7) { const int u = t - J6, kt = u >> 4, ntl = u & 15; tconv_tile<0>(p.in[19], nullptr, 1024, (bf16_t*)(ws + W_XO), 1024, kt * 64, ntl * 64, nullptr, 0, smem); }
        else if (t < J8) { const int u = t - J7, e = u >> 7, v = u & 127, kt = v >> 3, ntl = v & 7;
            tconv_tile<2>(p.in[26] + (size_t)e * 1024 * 256, p.in[27] + (size_t)e * 1024 * 256, 256, (bf16_t*)(ws + W_GU) + (size_t)e * 512 * 1024, 1024, kt * 64, ntl * 64, nullptr, 0, smem); }
        else { const int u = t - J8, e = u >> 6, v = u & 63, kt = v >> 4, ntl = v & 15;
            tconv_tile<0>(p.in[28] + (size_t)e * 256 * 1024, nullptr, 1024, (bf16_t*)(ws + W_DN) + (size_t)e * 1024 * 256, 256, kt * 64, ntl * 64, nullptr, 0, smem); }
    }
    {
        const size_t gsz = (size_t)nb * 256, g0 = (size_t)bid * 256 + tid;
        bf16_t* xb = (bf16_t*)p.out;
        const float4* x4 = (const float4*)p.in[0];
        for (size_t i = g0; i < (size_t)T * D / 4; i += gsz) { const float4 v = x4[i]; uint2 o; o.x = pack2(v.x, v.y); o.y = pack2(v.z, v.w); ((uint2*)xb)[i] = o; }
        bf16_t* mb = (bf16_t*)(ws + MEMB);
        const float4* m4 = (const float4*)p.in[1];
        for (size_t i = g0; i < (size_t)Bn * NMEM * D / 4; i += gsz) { const float4 v = m4[i]; uint2 o; o.x = pack2(v.x, v.y); o.y = pack2(v.z, v.w); ((uint2*)mb)[i] = o; }
        float* wrt = (float*)(ws + W_RT);
        for (size_t i = g0; i < 48 * 1024; i += gsz) {
            const int j = (int)(i >> 10), k = (int)(i & 1023);
            float v = 0.f;
            if (j < 4) v = p.in[22][k * 4 + j]; else if (j < 36) v = p.in[24][k * 32 + (j - 4)];
            wrt[i] = v;
        }
        float* rc = (float*)(ws + ROPE_C); float* rs = (float*)(ws + ROPE_S);
        for (size_t i = g0; i < 2048 * 16; i += gsz) {
            const int pos = (int)(i >> 4), f = (int)(i & 15);
            const float inv = powf(10000.f, -(float)f / 16.f);
            const float ang = (float)pos * inv;
            const double a = (double)ang;
            const double k2 = rint(a * 0.15915494309189535);
            const float rr = (float)(a - k2 * 6.283185307179586);
            rc[i] = cosf(rr); rs[i] = sinf(rr);
        }
    }
}

struct EpiProj {
    bf16_t *cq, *ckv, *z, *xbc, *krope; float* dt; const float *rc, *rs, *dtb;
    DI void prefetch(int, int, int) {}
    DI void operator()(const float* Cs, int m0, int n0, int tid) const {
        const int c4 = (tid & 31) * 4, r0 = tid >> 5;
        if (n0 < 1920) {
            bf16_t* dst; int ld, cofs;
            if (n0 < 256) { dst = cq; ld = 256; cofs = n0; } else if (n0 < 384) { dst = ckv; ld = 128; cofs = n0 - 256; }
            else if (n0 < 896) { dst = z; ld = 512; cofs = n0 - 384; } else { dst = xbc; ld = 1024; cofs = n0 - 896; }
#pragma unroll 4
            for (int ps = 0; ps < 16; ++ps) { const int row = ps * 8 + r0; *(uint2*)(dst + (size_t)(m0 + row) * ld + cofs + c4) = pack4(cs4(Cs, row, c4)); }
        } else {
#pragma unroll
            for (int ps = 0; ps < 4; ++ps) {
                const int it = ps * 256 + tid, row = it >> 3, cc = (it & 7) * 4, grow = m0 + row;
                const float4 v = cs4(Cs, row, cc), pv = cs4(Cs, row, cc ^ 16);
                const int pos = grow & 2047, f = cc & 15;
                const float4 c = *(const float4*)(rc + pos * 16 + f), s = *(const float4*)(rs + pos * 16 + f);
                float4 o;
                if (cc < 16) { o.x = v.x * c.x - pv.x * s.x; o.y = v.y * c.y - pv.y * s.y; o.z = v.z * c.z - pv.z * s.z; o.w = v.w * c.w - pv.w * s.w; }
                else { o.x = v.x * c.x + pv.x * s.x; o.y = v.y * c.y + pv.y * s.y; o.z = v.z * c.z + pv.z * s.z; o.w = v.w * c.w + pv.w * s.w; }
                *(uint2*)(krope + (size_t)grow * 32 + cc) = pack4(o);
            }
#pragma unroll
            for (int ps = 0; ps < 4; ++ps) {
                const int it = ps * 256 + tid, row = it >> 3, cc = it & 7;
                dt[(size_t)(m0 + row) * 8 + cc] = softplusf(Cs[row * CS_LD + 32 + cc] + dtb[cc]);
            }
        }
    }
};
struct EpiMemKV {
    bf16_t *kx, *vxt;
    DI void prefetch(int, int, int) {}
    DI void operator()(const float* Cs, int m0, int n0, int tid) const {
        const int b = m0 >> 8, mm0 = m0 & 255;
        if (n0 < 1024) {
            const int c4 = (tid & 31) * 4, r0 = tid >> 5, hd = n0 >> 8, d = (n0 & 255) + c4;
#pragma unroll 4
            for (int ps = 0; ps < 16; ++ps) { const int row = ps * 8 + r0; *(uint2*)(kx + ((size_t)(b * 4 + hd) * 256 + mm0 + row) * 256 + d) = pack4(cs4(Cs, row, c4)); }
        } else {
            const int c2 = n0 - 1024, hd = c2 >> 8;
#pragma unroll 2
            for (int ps = 0; ps < 8; ++ps) {
                const int it = ps * 256 + tid, col = it & 127, rg = it >> 7, d = (c2 & 255) + col;
                uint4 w;
                w.x = pack2(Cs[(rg * 8 + 0) * CS_LD + col], Cs[(rg * 8 + 1) * CS_LD + col]); w.y = pack2(Cs[(rg * 8 + 2) * CS_LD + col], Cs[(rg * 8 + 3) * CS_LD + col]);
                w.z = pack2(Cs[(rg * 8 + 4) * CS_LD + col], Cs[(rg * 8 + 5) * CS_LD + col]); w.w = pack2(Cs[(rg * 8 + 6) * CS_LD + col], Cs[(rg * 8 + 7) * CS_LD + col]);
                *(uint4*)(vxt + ((size_t)(b * 4 + hd) * 256 + d) * 256 + mm0 + rg * 8) = w;
            }
        }
    }
};
DI void phase_proj(const P& p, int bid, int nb, unsigned char* smem, int rep = 0) {
    unsigned char* ws = p.ws;
    const int v = vbid(bid, nb);
    const bf16_t* xb = (const bf16_t*)p.out;
    EpiProj e1{(bf16_t*)(ws + CQ), (bf16_t*)(ws + CKV), (bf16_t*)(ws + ZB), (bf16_t*)(ws + XBC), (bf16_t*)(ws + KROPE), (float*)(ws + DTB),
               (const float*)(ws + ROPE_C), (const float*)(ws + ROPE_S), p.in[9]};
    EpiMemKV e2{(bf16_t*)(ws + KX), (bf16_t*)(ws + VXT)};
    constexpr int NT1 = 256 * 16, NT2 = 32 * 16;
    for (int t = v; t < NT1 + NT2; t += nb) {
        if (rep && REP_MODE == 1 && t >= NT1) continue;
        if (rep && REP_MODE == 2 && t < NT1) continue;
        if (rep && REP_MODE == 3 && !(t < NT1 && (t & 7) == 7 && ((t >> 6) & 1))) continue;
        if (rep && REP_MODE == 4 && !(t < NT1 && ((t >> 6) & 1) == 0)) continue;
        const int u = t < NT1 ? t : t - NT1, c = u >> 6, j = u & 63, mt = (c >> 1) * 8 + (j >> 3), ntl = (c & 1) * 8 + (j & 7);
        if (t < NT1) { GemmArgs g{xb, 1024, (const bf16_t*)(ws + W_IN), 1024, 1024, nullptr}; gemm_tile(g, mt * 128, ntl * 128, e1, smem); }
        else { GemmArgs g{(const bf16_t*)(ws + MEMB), 1024, (const bf16_t*)(ws + W_XKV), 1024, 1024, nullptr}; gemm_tile(g, mt * 128, ntl * 128, e2, smem); }
    }
}

struct EpiQup {
    bf16_t* q; const float *rc, *rs; const float* rms;
    DI void prefetch(int, int, int) {}
    DI void operator()(const float* Cs, int m0, int n0, int tid) const {
        const int c4 = (tid & 31) * 4, r0 = tid >> 5;
        const int col = n0 + c4, head = col / 96, d = col - head * 96;
        const bool rope = d >= 64;
        const int b = m0 >> 11, s0 = m0 & 2047;
#pragma unroll 4
        for (int ps = 0; ps < 16; ++ps) {
            const int row = ps * 8 + r0;
            const float sc = rms[row] * QSCALE;
            float4 v = cs4(Cs, row, c4);
            if (rope) {
                const float4 pv = cs4(Cs, row, c4 ^ 16);
                const int pos = s0 + row, f = d & 15;
                const float4 c = *(const float4*)(rc + pos * 16 + f), s = *(const float4*)(rs + pos * 16 + f);
                if (d < 80) { v.x = v.x * c.x - pv.x * s.x; v.y = v.y * c.y - pv.y * s.y; v.z = v.z * c.z - pv.z * s.z; v.w = v.w * c.w - pv.w * s.w; }
                else { v.x = v.x * c.x + pv.x * s.x; v.y = v.y * c.y + pv.y * s.y; v.z = v.z * c.z + pv.z * s.z; v.w = v.w * c.w + pv.w * s.w; }
            }
            v.x *= sc; v.y *= sc; v.z *= sc; v.w *= sc;
            *(uint2*)(q + ((size_t)(b * 8 + head) * 2048 + s0 + row) * 96 + d) = pack4(v);
        }
    }
};
struct EpiKVup {
    bf16_t *kn, *vt; const float* rms;
    DI void prefetch(int, int, int) {}
    DI void operator()(const float* Cs, int m0, int n0, int tid) const {
        const int head = n0 >> 7, b = m0 >> 11, s0 = m0 & 2047;
#pragma unroll 4
        for (int ps = 0; ps < 8; ++ps) {
            const int it = ps * 256 + tid, row = it >> 4, c4 = (it & 15) * 4;
            const float sc = rms[row];
            float4 v = cs4(Cs, row, c4); v.x *= sc; v.y *= sc; v.z *= sc; v.w *= sc;
            *(uint2*)(kn + ((size_t)(b * 8 + head) * 2048 + s0 + row) * 64 + c4) = pack4(v);
        }
#pragma unroll 2
        for (int ps = 0; ps < 4; ++ps) {
            const int it = ps * 256 + tid, dv = it & 63, rg = it >> 6;
            const float* cp = Cs + (rg * 8) * CS_LD + 64 + dv; const float* rp = rms + rg * 8;
            uint4 w;
            w.x = pack2(cp[0] * rp[0], cp[CS_LD] * rp[1]); w.y = pack2(cp[2 * CS_LD] * rp[2], cp[3 * CS_LD] * rp[3]);
            w.z = pack2(cp[4 * CS_LD] * rp[4], cp[5 * CS_LD] * rp[5]); w.w = pack2(cp[6 * CS_LD] * rp[6], cp[7 * CS_LD] * rp[7]);
            *(uint4*)(vt + ((size_t)(b * 8 + head) * 64 + dv) * 2048 + s0 + rg * 8) = w;
        }
    }
};
template <int K>
DI void row_rms(const bf16_t* src, int m0, float* rms) {
    const int t = tidx(), row = t >> 1, half = t & 1;
    const uint4* s4 = (const uint4*)(src + (size_t)(m0 + row) * K + half * (K / 2));
    float ss = 0.f;
#pragma unroll
    for (int i = 0; i < K / 16; ++i) {
        const uint4 w = s4[i];
        const unsigned ww[4] = {w.x, w.y, w.z, w.w};
#pragma unroll
        for (int k = 0; k < 4; ++k) { const float a = bflo(ww[k]), b = bfhi(ww[k]); ss += a * a + b * b; }
    }
    ss += __shfl_xor(ss, 1);
    __syncthreads();
    if (half == 0) rms[row] = rsqrtf(ss * (1.f / K) + EPS);
    __syncthreads();
}
DI void phase_up(const P& p, int bid, int nb, unsigned char* smem, int rep = 0) {
    unsigned char* ws = p.ws;
    const int v = vbid(bid, nb);
    float* rms = (float*)(smem + GEMM_LDS);
    constexpr int NTQ = 256 * 6, NTKV = 256 * 8;
    for (int t = v; t < NTQ + NTKV; t += nb) {
        if (rep && REP_MODE == 1) break;
        if (rep && REP_MODE == 2 && t >= NTQ) break;
        if (rep && REP_MODE == 3 && t < NTQ) continue;
        if (t < NTQ) {
            const int mt = t / 6, ntl = t % 6;
            row_rms<256>((const bf16_t*)(ws + CQ), mt * 128, rms);
            EpiQup e{(bf16_t*)(ws + QB), (const float*)(ws + ROPE_C), (const float*)(ws + ROPE_S), rms};
            GemmArgs g{(const bf16_t*)(ws + CQ), 256, (const bf16_t*)(ws + W_QUP), 256, 256, nullptr};
            gemm_tile(g, mt * 128, ntl * 128, e, smem);
        } else {
            const int u = t - NTQ, mt = u >> 3, ntl = u & 7;
            row_rms<128>((const bf16_t*)(ws + CKV), mt * 128, rms);
            EpiKVup e{(bf16_t*)(ws + KNB), (bf16_t*)(ws + VTB), rms};
            GemmArgs g{(const bf16_t*)(ws + CKV), 128, (const bf16_t*)(ws + W_KVUP), 128, 128, nullptr};
            gemm_tile(g, mt * 128, ntl * 128, e, smem);
        }
    }
    if (!(rep && REP_MODE >= 2)) {
        const bf16_t* xbc = (const bf16_t*)(ws + XBC); bf16_t* xa = (bf16_t*)(ws + XBCA);
        const float* cw = p.in[7]; const float* cb = p.in[8];
        const size_t gsz = (size_t)nb * 256;
        for (size_t i = (size_t)bid * 256 + tidx(); i < (size_t)(T / 4) * 128; i += gsz) {
            const int tk0 = (int)(i >> 7) * 4, c0 = (int)(i & 127) * 8, s0 = tk0 & 2047;
            float w[4][8], bias[8];
#pragma unroll
            for (int j = 0; j < 4; ++j) { const float4 w0 = *(const float4*)(cw + j * 1024 + c0), w1 = *(const float4*)(cw + j * 1024 + c0 + 4);
                w[j][0] = w0.x; w[j][1] = w0.y; w[j][2] = w0.z; w[j][3] = w0.w; w[j][4] = w1.x; w[j][5] = w1.y; w[j][6] = w1.z; w[j][7] = w1.w; }
            { const float4 b0 = *(const float4*)(cb + c0), b1 = *(const float4*)(cb + c0 + 4); bias[0] = b0.x; bias[1] = b0.y; bias[2] = b0.z; bias[3] = b0.w; bias[4] = b1.x; bias[5] = b1.y; bias[6] = b1.z; bias[7] = b1.w; }
            float xin[7][8];
#pragma unroll
            for (int rr = 0; rr < 7; ++rr) {
                uint4 wv = make_uint4(0u, 0u, 0u, 0u);
                if (s0 + rr - 3 >= 0) wv = *(const uint4*)(xbc + (size_t)(tk0 + rr - 3) * 1024 + c0);
                xin[rr][0] = bflo(wv.x); xin[rr][1] = bfhi(wv.x); xin[rr][2] = bflo(wv.y); xin[rr][3] = bfhi(wv.y); xin[rr][4] = bflo(wv.z); xin[rr][5] = bfhi(wv.z); xin[rr][6] = bflo(wv.w); xin[rr][7] = bfhi(wv.w);
            }
#pragma unroll
            for (int o = 0; o < 4; ++o) {
                float accv[8];
#pragma unroll
                for (int k = 0; k < 8; ++k) accv[k] = bias[k] + w[0][k] * xin[o][k] + w[1][k] * xin[o + 1][k] + w[2][k] * xin[o + 2][k] + w[3][k] * xin[o + 3][k];
                uint4 ov;
                ov.x = pack2(siluf(accv[0]), siluf(accv[1])); ov.y = pack2(siluf(accv[2]), siluf(accv[3]));
                ov.z = pack2(siluf(accv[4]), siluf(accv[5])); ov.w = pack2(siluf(accv[6]), siluf(accv[7]));
                *(uint4*)(xa + (size_t)(tk0 + o) * 1024 + c0) = ov;
            }
        }
    }
}

DI int perm16(int k) { return (k & ~12) | ((k & 4) << 1) | ((k & 8) >> 1); }
template <int DQK, int DVW, int KT, int NQG, int NDV>
struct FlashCfg {
    static constexpr int KSTR = (DQK + 8) * 2;
    static constexpr int VSTR = (KT + 8) * 2;
    static constexpr int DV = DVW * NDV;
    static constexpr int KBYTES = KT * KSTR, VBYTES = DV * VSTR, STAGE = KBYTES + VBYTES;
    static constexpr int KCH = KT * DQK / 8 / 256;
    static constexpr int VCH = DV * KT / 8 / 256;
    static_assert(KT * DQK / 8 % 256 == 0 && DV * KT / 8 % 256 == 0, "chunk split");
    static_assert(2 * STAGE <= SMEM_BYTES - 32, "flash LDS");
};
template <int DQK, int DVW, int KT, int NQG, int NDV, class Src>
DI void flash_item(const Src& src, int ntiles, int nskip  , unsigned char* smem, bool noload = false) {
    typedef FlashCfg<DQK, DVW, KT, NQG, NDV> C;
    constexpr int NKS = DQK / 16, NKB = KT / 32, NDB = DVW / 32;
    int tid = tidx(); asm volatile("" : "+v"(tid));
    const int lane = tid & 63, wave = __builtin_amdgcn_readfirstlane(tid >> 6), r = lane & 31, h = lane >> 5;
    const int qg = wave / NDV, dvh = wave % NDV;
    bf16x8 qf[NKS];
    {
        const bf16_t* qp = src.qrow(qg * 32 + r) + 8 * h;
#pragma unroll
        for (int ks = 0; ks < NKS; ++ks) qf[ks] = *(const bf16x8*)(qp + 16 * ks);
    }
    f32x16 o[NDB];
#pragma unroll
    for (int d = 0; d < NDB; ++d)
#pragma unroll
        for (int e = 0; e < 16; ++e) o[d][e] = 0.f;
    float m = -1e30f, l = 0.f;
    uint4 kr[C::KCH], vr[C::VCH];
    auto gload = [&](int t) {
#pragma unroll
        for (int i = 0; i < C::KCH; ++i) { const int idx = tid + 256 * i; kr[i] = src.kload(t, idx / (DQK / 8), idx % (DQK / 8)); }
#pragma unroll
        for (int i = 0; i < C::VCH; ++i) { const int idx = tid + 256 * i; vr[i] = src.vload(t, idx / (KT / 8), idx % (KT / 8)); }
    };
    auto lstore = [&](unsigned char* buf) {
#pragma unroll
        for (int i = 0; i < C::KCH; ++i) { const int idx = tid + 256 * i; *(uint4*)(buf + (idx / (DQK / 8)) * C::KSTR + (idx % (DQK / 8)) * 16) = kr[i]; }
#pragma unroll
        for (int i = 0; i < C::VCH; ++i) {
            const int idx = tid + 256 * i, dv = idx / (KT / 8), c = idx % (KT / 8);
            unsigned char* row = buf + C::KBYTES + dv * C::VSTR + (c >> 1) * 32;
            const int a = c & 1;
            *(uint2*)(row + (4 * a) * 2) = make_uint2(vr[i].x, vr[i].y);
            *(uint2*)(row + (8 + 4 * a) * 2) = make_uint2(vr[i].z, vr[i].w);
        }
    };
    gload(0);
    __syncthreads();
    lstore(smem);
    __syncthreads();
    for (int t = 0; t < ntiles; ++t) {
        const unsigned char* cur = smem + (t & 1) * C::STAGE;
        const bool more = (t + 1 < ntiles);
        if (more && !noload) gload(t + 1);
        if (!(t == ntiles - 1 && qg < nskip)) {
            f32x16 s[NKB];
#pragma unroll
            for (int kb = 0; kb < NKB; ++kb) {
                const unsigned char* kp = cur + (kb * 32 + r) * C::KSTR + h * 16;
                if (NKB == 1) {
                    constexpr int NCH = 2;
                    f32x16 sp[NCH];
#pragma unroll
                    for (int c = 0; c < NCH; ++c)
#pragma unroll
                        for (int e = 0; e < 16; ++e) sp[c][e] = 0.f;
#pragma unroll
                    for (int ks = 0; ks < NKS; ++ks) sp[ks % NCH] = MFMA32(*(const bf16x8*)(kp + ks * 32), qf[ks], sp[ks % NCH]);
#pragma unroll
                    for (int e = 0; e < 16; ++e) s[kb][e] = sp[0][e] + sp[1][e];
                } else {
#pragma unroll
                    for (int e = 0; e < 16; ++e) s[kb][e] = 0.f;
#pragma unroll
                    for (int ks = 0; ks < NKS; ++ks) s[kb] = MFMA32(*(const bf16x8*)(kp + ks * 32), qf[ks], s[kb]);
                }
            }
            float mx = s[0][0];
#pragma unroll
            for (int kb = 0; kb < NKB; ++kb)
#pragma unroll
                for (int e = 0; e < 16; ++e) mx = fmaxf(mx, s[kb][e]);
            mx = fmaxf(mx, __shfl_xor(mx, 32));
            const float mn = fmaxf(m, mx);
            const float alpha = __builtin_amdgcn_exp2f(m - mn);
            m = mn;
            float ps = 0.f;
#pragma unroll
            for (int kb = 0; kb < NKB; ++kb)
#pragma unroll
                for (int e = 0; e < 16; ++e) { const float pv = __builtin_amdgcn_exp2f(s[kb][e] - mn); s[kb][e] = pv; ps += pv; }
            l = l * alpha + ps;
#pragma unroll
            for (int d = 0; d < NDB; ++d)
#pragma unroll
                for (int e = 0; e < 16; ++e) o[d][e] *= alpha;
#pragma unroll
            for (int kb = 0; kb < NKB; ++kb)
#pragma unroll
                for (int s2 = 0; s2 < 2; ++s2) {
                    uint4 pk;
                    pk.x = pack2(s[kb][8 * s2], s[kb][8 * s2 + 1]); pk.y = pack2(s[kb][8 * s2 + 2], s[kb][8 * s2 + 3]);
                    pk.z = pack2(s[kb][8 * s2 + 4], s[kb][8 * s2 + 5]); pk.w = pack2(s[kb][8 * s2 + 6], s[kb][8 * s2 + 7]);
                    const bf16x8 pf = __builtin_bit_cast(bf16x8, pk);
                    const unsigned char* vp = cur + C::KBYTES + (dvh * DVW + r) * C::VSTR + (kb * 32 + s2 * 16 + 8 * h) * 2;
#pragma unroll
                    for (int d = 0; d < NDB; ++d) o[d] = MFMA32(*(const bf16x8*)(vp + d * 32 * C::VSTR), pf, o[d]);
                }
        }
        if (more) lstore(smem + ((t + 1) & 1) * C::STAGE);
        __syncthreads();
    }
    l += __shfl_xor(l, 32);
    const float il = 1.f / l;
#pragma unroll
    for (int d = 0; d < NDB; ++d)
#pragma unroll
        for (int g4 = 0; g4 < 4; ++g4) {
            uint2 w; w.x = pack2(o[d][4 * g4] * il, o[d][4 * g4 + 1] * il); w.y = pack2(o[d][4 * g4 + 2] * il, o[d][4 * g4 + 3] * il);
            src.store(qg * 32 + r, dvh * DVW + d * 32 + 8 * g4 + 4 * h, w);
        }
}
struct SelfSrc {
    const bf16_t *q, *kn, *kr, *vt; bf16_t* mix; int b, hd, bh, q0;
    DI const bf16_t* qrow(int rr) const { return q + ((size_t)bh * 2048 + q0 + rr) * 96; }
    DI uint4 kload(int t, int key, int c) const {
        const int kg = t * 64 + key;
        return c < 8 ? *(const uint4*)(kn + ((size_t)bh * 2048 + kg) * 64 + c * 8) : *(const uint4*)(kr + ((size_t)b * 2048 + kg) * 32 + (c - 8) * 8);
    }
    DI uint4 vload(int t, int dv, int c) const { return *(const uint4*)(vt + ((size_t)bh * 64 + dv) * 2048 + t * 64 + c * 8); }
    DI void store(int rr, int dv, uint2 w) const { *(uint2*)(mix + ((size_t)b * 2048 + q0 + rr) * 1024 + hd * 64 + dv) = w; }
};
struct CrossSrc {
    const bf16_t *qx, *kx, *vxt; bf16_t* ox; int b, hd, q0;
    DI const bf16_t* qrow(int rr) const { return qx + ((size_t)(b * 4 + hd) * 2048 + q0 + rr) * 256; }
    DI uint4 kload(int t, int key, int c) const { return *(const uint4*)(kx + ((size_t)(b * 4 + hd) * 256 + t * 32 + key) * 256 + c * 8); }
    DI uint4 vload(int t, int dv, int c) const { return *(const uint4*)(vxt + ((size_t)(b * 4 + hd) * 256 + dv) * 256 + t * 32 + c * 8); }
    DI void store(int rr, int dv, uint2 w) const { *(uint2*)(ox + ((size_t)b * 2048 + q0 + rr) * 1024 + hd * 256 + dv) = w; }
};
DI void attn_fast(const P& p, int bid, int nb, unsigned char* smem) {
    unsigned char* ws = p.ws;
    const int nround = (2048 + nb - 1) / nb;
    for (int rd = 0; rd < nround; ++rd) {
        const int idx = rd * nb + ((rd & 1) ? (nb - 1 - bid) : bid);
        if (idx >= 2048) continue;
        const int qb = 15 - (idx >> 7), bh = idx & 127;
        SelfSrc s{(const bf16_t*)(ws + QB), (const bf16_t*)(ws + KNB), (const bf16_t*)(ws + KROPE), (const bf16_t*)(ws + VTB), (bf16_t*)(ws + MIX), bh >> 3, bh & 7, bh, qb * 128};
        flash_item<96, 64, 64, 4, 1>(s, 2 * qb + 2, 2, smem);
    }
}
DI void xattn_fast(const P& p, int bid, int nb, unsigned char* smem, int rep = 0) {
    unsigned char* ws = p.ws;
    for (int it = bid; it < 2048; it += nb) {
        const int bhd = it >> 5, qt = it & 31;
        CrossSrc s{(const bf16_t*)(ws + QX), (const bf16_t*)(ws + KX), (const bf16_t*)(ws + VXT), (bf16_t*)(ws + OX), bhd >> 2, bhd & 3, qt * 64};
        if (rep) s.ox = (bf16_t*)(ws + RD);
        flash_item<256, 128, 32, 2, 2>(s, 8, 0, smem, rep && REP_MODE == 5);
    }
}

constexpr int SSD_XT = 0, SSD_BM = 8192, SSD_CM = SSD_BM + 16384, SSD_BWT = SSD_CM + 16384, SSD_PS = SSD_BWT + 16384, SSD_F = SSD_PS + 16384;
static_assert(SSD_F + 2048 <= SMEM_BYTES - 32, "ssd LDS");
DI int off256(int row, int el) { return row * 256 + (((el >> 3) ^ (row & 15)) << 4) + ((el & 7) << 1); }
DI int off128(int row, int el) { return row * 128 + (((el >> 3) ^ ((row ^ (row >> 3)) & 7)) << 4) + ((el & 7) << 1); }
template <int pm>
DI void ssd_item(const P& p, int bh, unsigned char* smem) {
    unsigned char* ws = p.ws;
    const bf16_t* xa = (const bf16_t*)(ws + XBCA); const float* dtg = (const float*)(ws + DTB);
    bf16_t* mix = pm ? (bf16_t*)(ws + XBC) : (bf16_t*)(ws + MIX);
    int tid0 = tidx(); asm volatile("" : "+v"(tid0));
    const int wave = __builtin_amdgcn_readfirstlane(tid0 >> 6);
    const int b = bh >> 3, hd = bh & 7, g = hd >> 2;
    const int lb = wave >> 1, pb = wave & 1;
    const float a_h = -__expf(p.in[10][hd]), Dh = p.in[11][hd];
    float* F = (float*)(smem + SSD_F);
    __syncthreads();
    for (int i = tid0; i < 16384 / 16; i += 256) *(uint4*)(smem + SSD_PS + i * 16) = make_uint4(0u, 0u, 0u, 0u);
    f32x16 st[2];
#pragma unroll
    for (int i = 0; i < 2; ++i)
#pragma unroll
        for (int e = 0; e < 16; ++e) st[i][e] = 0.f;
    uint4 xr0, xr1, br0, br1, br2, br3, cr0, cr1, cr2, cr3; float dtr = 0.f;
#define SSD_XLD(i) (*(const uint4*)(xa + (t0_ + ((tid + 256 * (i)) >> 3)) * 1024 + hd * 64 + ((tid + 256 * (i)) & 7) * 8))
#define SSD_BLD(i, o) (*(const uint4*)(xa + (t0_ + ((tid + 256 * (i)) >> 4)) * 1024 + (o) + g * 128 + ((tid + 256 * (i)) & 15) * 8))
#define SSD_GLOAD(c_) do { const size_t t0_ = (size_t)b * 2048 + (c_) * 64; xr0 = SSD_XLD(0); xr1 = SSD_XLD(1); \
        br0 = SSD_BLD(0, 512); br1 = SSD_BLD(1, 512); br2 = SSD_BLD(2, 512); br3 = SSD_BLD(3, 512); \
        cr0 = SSD_BLD(0, 768); cr1 = SSD_BLD(1, 768); cr2 = SSD_BLD(2, 768); cr3 = SSD_BLD(3, 768); \
        if (tid < 64) dtr = dtg[(t0_ + tid) * 8 + hd]; } while (0)
    { const int tid = tid0; SSD_GLOAD(0); }
#define SSD_SCAN(FP) do { const int ln_ = tid0 & 63; float v = dtr * a_h; \
        _Pragma("unroll") for (int o = 1; o < 64; o <<= 1) { const float u = __shfl_up(v, o); if (ln_ >= o) v += u; } \
        const float a63 = __shfl(v, 63); \
        (FP)[ln_] = v; (FP)[64 + ln_] = __expf(v); (FP)[128 + ln_] = dtr; (FP)[192 + ln_] = __expf(a63 - v) * dtr; } while (0)
    if (wave == 0) SSD_SCAN(F);
    __syncthreads();
    for (int c = 0; c < 32; ++c) {
        int tid = tid0; asm volatile("" : "+v"(tid));
        const int lane = tid & 63, r = lane & 31, h = lane >> 5;
        const size_t t0 = (size_t)b * 2048 + c * 64;
        const float* Fc = F + (c & 1) * 256; float* Fn = F + ((c + 1) & 1) * 256;
#define SSD_XIMG(i, XR) do { const int idx = tid + 256 * (i), l = idx >> 3, p0 = (idx & 7) * 8, lp = perm16(l); \
            const unsigned ww[4] = {XR.x, XR.y, XR.z, XR.w}; \
            _Pragma("unroll") for (int k = 0; k < 4; ++k) { \
                *(bf16_t*)(smem + SSD_XT + off128(p0 + 2 * k, lp)) = (bf16_t)(ww[k] & 0xffffu); \
                *(bf16_t*)(smem + SSD_XT + off128(p0 + 2 * k + 1, lp)) = (bf16_t)(ww[k] >> 16); } } while (0)
#define SSD_BIMG(i, BR, CR) do { const int idx = tid + 256 * (i), l = idx >> 4, n0 = (idx & 15) * 8, lp = perm16(l); \
            *(uint4*)(smem + SSD_BM + off256(l, n0)) = BR; *(uint4*)(smem + SSD_CM + off256(l, n0)) = CR; \
            const float wl = Fc[192 + l]; const unsigned ww[4] = {BR.x, BR.y, BR.z, BR.w}; \
            _Pragma("unroll") for (int k = 0; k < 4; ++k) { \
                *(bf16_t*)(smem + SSD_BWT + off128(n0 + 2 * k, lp)) = f2bf(bflo(ww[k]) * wl); \
                *(bf16_t*)(smem + SSD_BWT + off128(n0 + 2 * k + 1, lp)) = f2bf(bfhi(ww[k]) * wl); } } while (0)
        if (!(pm & 2)) {
        SSD_XIMG(0, xr0); SSD_XIMG(1, xr1);
        SSD_BIMG(0, br0, cr0); SSD_BIMG(1, br1, cr1); SSD_BIMG(2, br2, cr2); SSD_BIMG(3, br3, cr3);
        } else { asm volatile("" :: "v"(xr0.x), "v"(xr1.x), "v"(br0.x), "v"(br1.x), "v"(br2.x), "v"(br3.x), "v"(cr0.x), "v"(cr1.x), "v"(cr2.x), "v"(cr3.x)); }
        __syncthreads();
        if (c + 1 < 32) SSD_GLOAD(c + 1);
        if (!(pm & 1)) {
        const float acs_l = Fc[lb * 32 + r];
        const int lrow = lb * 32 + r;
        f32x16 cb0, cb1, yo;
#pragma unroll
        for (int e = 0; e < 16; ++e) { cb0[e] = 0.f; cb1[e] = 0.f; yo[e] = 0.f; }
#pragma unroll
        for (int ks = 0; ks < 8; ++ks) {
            const bf16x8 cv = *(const bf16x8*)(smem + SSD_CM + off256(lb * 32 + r, 16 * ks + 8 * h));
            const bf16x8 b0v = *(const bf16x8*)(smem + SSD_BM + off256(r, 16 * ks + 8 * h));
            const bf16x8 b1v = *(const bf16x8*)(smem + SSD_BM + off256(32 + r, 16 * ks + 8 * h));
            const bf16x8 pv = *(const bf16x8*)(smem + SSD_PS + off256(pb * 32 + r, 16 * ks + 8 * h));
            cb0 = MFMA32(b0v, cv, cb0); cb1 = MFMA32(b1v, cv, cb1); yo = MFMA32(cv, pv, yo);
        }
        f32x16 yd;
#pragma unroll
        for (int e = 0; e < 16; ++e) yd[e] = 0.f;
#pragma unroll
        for (int sb = 0; sb < 2; ++sb) {
            float mv[16];
#pragma unroll
            for (int q4 = 0; q4 < 4; ++q4) {
                const int s0 = sb * 32 + 8 * q4 + 4 * h;
                const float4 as4 = *(const float4*)(Fc + s0), dt4 = *(const float4*)(Fc + 128 + s0);
                const float asv[4] = {as4.x, as4.y, as4.z, as4.w}, dtv[4] = {dt4.x, dt4.y, dt4.z, dt4.w};
#pragma unroll
                for (int k = 0; k < 4; ++k) { const float cbv = sb ? cb1[4 * q4 + k] : cb0[4 * q4 + k]; mv[4 * q4 + k] = (s0 + k <= lrow) ? cbv * __expf(acs_l - asv[k]) * dtv[k] : 0.f; }
            }
#pragma unroll
            for (int s2 = 0; s2 < 2; ++s2) {
                uint4 pk;
                pk.x = pack2(mv[8 * s2], mv[8 * s2 + 1]); pk.y = pack2(mv[8 * s2 + 2], mv[8 * s2 + 3]);
                pk.z = pack2(mv[8 * s2 + 4], mv[8 * s2 + 5]); pk.w = pack2(mv[8 * s2 + 6], mv[8 * s2 + 7]);
                const bf16x8 xb = *(const bf16x8*)(smem + SSD_XT + off128(pb * 32 + r, sb * 32 + 16 * s2 + 8 * h));
                yd = MFMA32(__builtin_bit_cast(bf16x8, pk), xb, yd);
            }
        }
        {
            const uint4 x0 = *(const uint4*)(smem + SSD_XT + off128(pb * 32 + r, lb * 32 + 8 * h));
            const uint4 x1 = *(const uint4*)(smem + SSD_XT + off128(pb * 32 + r, lb * 32 + 16 + 8 * h));
            const unsigned xw[8] = {x0.x, x0.y, x0.z, x0.w, x1.x, x1.y, x1.z, x1.w};
            bf16_t* op = mix + (t0 + lb * 32 + 4 * h) * 1024 + 512 + hd * 64 + pb * 32 + r;
#pragma unroll
            for (int q4 = 0; q4 < 4; ++q4) {
                const float4 ea4 = *(const float4*)(Fc + 64 + lb * 32 + 8 * q4 + 4 * h);
                const float eav[4] = {ea4.x, ea4.y, ea4.z, ea4.w};
#pragma unroll
                for (int k = 0; k < 4; ++k) {
                    const int e = 4 * q4 + k;
                    const float xv = (e & 1) ? bfhi(xw[e >> 1]) : bflo(xw[e >> 1]);
                    const float y = yd[e] + eav[k] * yo[e] + Dh * xv;
                    op[(size_t)(k + 8 * q4) * 1024] = f2bf(y);
                }
            }
        }
        {
            const float dec = Fc[64 + 63];
#pragma unroll
            for (int e = 0; e < 16; ++e) { st[0][e] *= dec; st[1][e] *= dec; }
            const int nblk = 2 * (wave >> 1);
#pragma unroll
            for (int ks = 0; ks < 4; ++ks) {
                const bf16x8 av = *(const bf16x8*)(smem + SSD_XT + off128(pb * 32 + r, 16 * ks + 8 * h));
                const bf16x8 bv0 = *(const bf16x8*)(smem + SSD_BWT + off128(nblk * 32 + r, 16 * ks + 8 * h));
                const bf16x8 bv1 = *(const bf16x8*)(smem + SSD_BWT + off128(nblk * 32 + 32 + r, 16 * ks + 8 * h));
                st[0] = MFMA32(av, bv0, st[0]); st[1] = MFMA32(av, bv1, st[1]);
            }
        }
        }
        if (wave == 0 && c + 1 < 32) SSD_SCAN(Fn);
        __syncthreads();
#pragma unroll
        for (int i = 0; i < 2; ++i) {
            const int n = (2 * (wave >> 1) + i) * 32 + r;
#pragma unroll
            for (int e = 0; e < 16; ++e) *(bf16_t*)(smem + SSD_PS + off256(pb * 32 + crow(e, h), n)) = f2bf(st[i][e]);
        }
    }
    __syncthreads();
}

#if ATTN_NAIVE
DI void attn_naive(const P& p, int bid, int nb) {
    unsigned char* ws = p.ws;
    const bf16_t* Q = (const bf16_t*)(ws + QB); const bf16_t* Kn = (const bf16_t*)(ws + KNB); const bf16_t* Vt = (const bf16_t*)(ws + VTB);
    const bf16_t* Kr = (const bf16_t*)(ws + KROPE); bf16_t* mix = (bf16_t*)(ws + MIX);
    for (int item = bid; item < 128 * 8; item += nb) {
        const int bh = item >> 3, s_ = (item & 7) * 256 + tidx(), b = bh >> 3, hd = bh & 7;
        float q[96];
        {
            const uint4* q4 = (const uint4*)(Q + ((size_t)bh * 2048 + s_) * 96);
#pragma unroll
            for (int i = 0; i < 12; ++i) { const uint4 w = q4[i]; q[8 * i] = bflo(w.x); q[8 * i + 1] = bfhi(w.x); q[8 * i + 2] = bflo(w.y); q[8 * i + 3] = bfhi(w.y);
                q[8 * i + 4] = bflo(w.z); q[8 * i + 5] = bfhi(w.z); q[8 * i + 6] = bflo(w.w); q[8 * i + 7] = bfhi(w.w); }
        }
        float o[64];
#pragma unroll
        for (int d = 0; d < 64; ++d) o[d] = 0.f;
        float m = -1e30f, l = 0.f;
        const int nkeys = __builtin_amdgcn_readfirstlane(((s_ >> 6) + 1) * 64);
        for (int j0 = 0; j0 < nkeys; j0 += 8) {
            float sc[8];
#pragma unroll
            for (int jj = 0; jj < 8; ++jj) {
                const int j = j0 + jj;
                const uint4* k4 = (const uint4*)(Kn + ((size_t)bh * 2048 + j) * 64);
                const uint4* r4 = (const uint4*)(Kr + ((size_t)b * 2048 + j) * 32);
                float a = 0.f;
#pragma unroll
                for (int i = 0; i < 8; ++i) { const uint4 w = k4[i]; a += q[8 * i] * bflo(w.x) + q[8 * i + 1] * bfhi(w.x) + q[8 * i + 2] * bflo(w.y) + q[8 * i + 3] * bfhi(w.y)
                    + q[8 * i + 4] * bflo(w.z) + q[8 * i + 5] * bfhi(w.z) + q[8 * i + 6] * bflo(w.w) + q[8 * i + 7] * bfhi(w.w); }
#pragma unroll
                for (int i = 0; i < 4; ++i) { const uint4 w = r4[i]; const int o8 = 64 + 8 * i; a += q[o8] * bflo(w.x) + q[o8 + 1] * bfhi(w.x) + q[o8 + 2] * bflo(w.y) + q[o8 + 3] * bfhi(w.y)
                    + q[o8 + 4] * bflo(w.z) + q[o8 + 5] * bfhi(w.z) + q[o8 + 6] * bflo(w.w) + q[o8 + 7] * bfhi(w.w); }
                sc[jj] = a;
            }
            float mx = m;
#pragma unroll
            for (int jj = 0; jj < 8; ++jj) mx = fmaxf(mx, sc[jj]);
            const float al = exp2f(m - mx);
            float ps = 0.f;
#pragma unroll
            for (int jj = 0; jj < 8; ++jj) { sc[jj] = exp2f(sc[jj] - mx); ps += sc[jj]; }
            l = l * al + ps; m = mx;
#pragma unroll
            for (int d = 0; d < 64; ++d) {
                const uint4 w = *(const uint4*)(Vt + ((size_t)bh * 64 + d) * 2048 + j0);
                o[d] = o[d] * al + sc[0] * bflo(w.x) + sc[1] * bfhi(w.x) + sc[2] * bflo(w.y) + sc[3] * bfhi(w.y) + sc[4] * bflo(w.z) + sc[5] * bfhi(w.z) + sc[6] * bflo(w.w) + sc[7] * bfhi(w.w);
            }
        }
        const float il = 1.f / l;
        bf16_t* dst = mix + ((size_t)b * 2048 + s_) * 1024 + hd * 64;
#pragma unroll
        for (int d = 0; d < 64; d += 2) *(unsigned*)(dst + d) = pack2(o[d] * il, o[d + 1] * il);
    }
}
#endif
#if SSD_NAIVE
DI void ssd_naive(const P& p, int bid, int nb) {
    unsigned char* ws = p.ws;
    const bf16_t* xa = (const bf16_t*)(ws + XBCA); const float* dt = (const float*)(ws + DTB); const bf16_t* z = (const bf16_t*)(ws + ZB);
    bf16_t* mix = (bf16_t*)(ws + MIX);
    const int wave = tidx() >> 6, pp = tidx() & 63;
    for (int item = bid; item < 32; item += nb) {
        const int bh = item * 4 + wave, b = bh >> 3, hd = bh & 7, g = hd >> 2;
        const float a = -__expf(p.in[10][hd]), Dh = p.in[11][hd];
        float st[128];
#pragma unroll
        for (int n = 0; n < 128; ++n) st[n] = 0.f;
        for (int t = 0; t < 2048; ++t) {
            const size_t row = (size_t)b * 2048 + t;
            const float dtv = dt[row * 8 + hd];
            const float da = __expf(dtv * a);
            const float xv = bf2f(xa[row * 1024 + hd * 64 + pp]);
            const float xd = dtv * xv;
            const uint4* b4 = (const uint4*)(xa + row * 1024 + 512 + g * 128);
            const uint4* c4 = (const uint4*)(xa + row * 1024 + 768 + g * 128);
            float y = 0.f;
#pragma unroll
            for (int i = 0; i < 16; ++i) {
                const uint4 bw = b4[i], cw = c4[i];
                const unsigned bb[4] = {bw.x, bw.y, bw.z, bw.w}, cc[4] = {cw.x, cw.y, cw.z, cw.w};
#pragma unroll
                for (int k = 0; k < 4; ++k) {
                    const int n = 8 * i + 2 * k;
                    st[n] = da * st[n] + xd * bflo(bb[k]); y += bflo(cc[k]) * st[n];
                    st[n + 1] = da * st[n + 1] + xd * bfhi(bb[k]); y += bfhi(cc[k]) * st[n + 1];
                }
            }
            y += Dh * xv;
            const float zv = bf2f(z[row * 512 + hd * 64 + pp]);
            mix[row * 1024 + 512 + hd * 64 + pp] = f2bf(y * siluf(zv));
        }
    }
}
#endif
DI void phase_mixer(const P& p, int bid, int nb, unsigned char* smem, int rep = 0) {
#if SSD_NAIVE
    ssd_naive(p, bid, nb);
    attn_fast(p, bid, nb, smem);
#else
    unsigned* ctr = (unsigned*)(p.ws + CTL + CTL_QUEUE) + 64 * rep;
    int* slot = (int*)(smem + SMEM_BYTES - 32);
    for (;;) {
        __syncthreads();
        if (tidx() == 0) *slot = (int)atomicAdd(ctr, 1u);
        __syncthreads();
        const int it = *slot;
        if (it >= 128 + 2048) break;
        if (it < 128) { if (!NO_SSD && !(rep && REP_MODE == 2)) { if (rep) ssd_item<SSD_PM>(p, it, smem); else ssd_item<0>(p, it, smem); } }
        else if (rep && REP_MODE >= 1) { }
        else {
            const int idx = it - 128, qb = 15 - (idx >> 7), bh = idx & 127;
            unsigned char* ws = p.ws;
            SelfSrc s{(const bf16_t*)(ws + QB), (const bf16_t*)(ws + KNB), (const bf16_t*)(ws + KROPE), (const bf16_t*)(ws + VTB), (bf16_t*)(ws + MIX), bh >> 3, bh & 7, bh, qb * 128};
            if (rep) s.mix = (bf16_t*)(ws + XBC);
            if (!NO_FLASH) flash_item<96, 64, 64, 4, 1>(s, 2 * qb + 2, 2, smem, rep && REP_MODE == 5);
        }
    }
#endif
}

DI void phase_ssdnorm(const P& p, int bid, int nb, unsigned char* smem) {
    bf16_t* mix = (bf16_t*)(p.ws + MIX); const bf16_t* z = (const bf16_t*)(p.ws + ZB);
    const int lane = tidx() & 63, wave = tidx() >> 6;
    for (int tk = bid * 4 + wave; tk < T; tk += nb * 4) {
        uint4* ptr = (uint4*)(mix + (size_t)tk * 1024 + 512 + lane * 8);
        const uint4 w = *ptr, zz = *(const uint4*)(z + (size_t)tk * 512 + lane * 8);
        const unsigned ww[4] = {w.x, w.y, w.z, w.w}, zw[4] = {zz.x, zz.y, zz.z, zz.w};
        float v[8]; float ss = 0.f;
#pragma unroll
        for (int k = 0; k < 4; ++k) {
            v[2 * k] = bflo(ww[k]) * siluf(bflo(zw[k])); v[2 * k + 1] = bfhi(ww[k]) * siluf(bfhi(zw[k]));
            ss += v[2 * k] * v[2 * k] + v[2 * k + 1] * v[2 * k + 1];
        }
#pragma unroll
        for (int o = 16; o >= 1; o >>= 1) ss += __shfl_xor(ss, o);
        const float rr = rsqrtf(ss * (1.f / 256.f) + EPS);
        uint4 o4; o4.x = pack2(v[0] * rr, v[1] * rr); o4.y = pack2(v[2] * rr, v[3] * rr); o4.z = pack2(v[4] * rr, v[5] * rr); o4.w = pack2(v[6] * rr, v[7] * rr);
        *ptr = o4;
    }
}

template <bool RES_BF16>
struct EpiResid {
    bf16_t* pre; const void* res;
    float4 pf[RES_BF16 ? 1 : 16]; uint2 pb[RES_BF16 ? 16 : 1];
    DI void prefetch(int m0, int n0, int tid) {
        const int c4 = (tid & 31) * 4, r0 = tid >> 5;
#pragma unroll
        for (int ps = 0; ps < 16; ++ps) {
            const size_t idx = (size_t)(m0 + ps * 8 + r0) * 1024 + n0 + c4;
            if (RES_BF16) pb[ps] = *(const uint2*)((const bf16_t*)res + idx); else pf[ps] = *(const float4*)((const float*)res + idx);
        }
    }
    DI void operator()(const float* Cs, int m0, int n0, int tid) const {
        const int c4 = (tid & 31) * 4, r0 = tid >> 5;
#pragma unroll
        for (int ps = 0; ps < 16; ++ps) {
            const int row = ps * 8 + r0;
            const float4 v = cs4(Cs, row, c4);
            float4 rr;
            if (RES_BF16) rr = make_float4(bflo(pb[ps].x), bfhi(pb[ps].x), bflo(pb[ps].y), bfhi(pb[ps].y)); else rr = pf[ps];
            *(uint2*)(pre + (size_t)(m0 + row) * 1024 + n0 + c4) = pack4(make_float4(ALPHA * rr.x + v.x, ALPHA * rr.y + v.y, ALPHA * rr.z + v.z, ALPHA * rr.w + v.w));
        }
    }
};
DI void phase_wout(const P& p, int bid, int nb, unsigned char* smem) {
    const int v = vbid(bid, nb);
    EpiResid<true> e; e.pre = (bf16_t*)p.out; e.res = p.out;
    GemmArgs g{(const bf16_t*)(p.ws + MIX), 1024, (const bf16_t*)(p.ws + W_OUT), 1024, 1024, nullptr};
    for (int t = v; t < 256 * 8; t += nb) gemm_tile(g, (t >> 3) * 128, (t & 7) * 128, e, smem);
}
DI void ln_row(const float* src, const float* gam, const float* bet, int lane, float (&o)[16]) {
    float v[16];
#pragma unroll
    for (int i = 0; i < 4; ++i) { const float4 t4 = *(const float4*)(src + i * 256 + lane * 4); v[4 * i] = t4.x; v[4 * i + 1] = t4.y; v[4 * i + 2] = t4.z; v[4 * i + 3] = t4.w; }
    float s = 0.f;
#pragma unroll
    for (int i = 0; i < 16; ++i) s += v[i];
    const float mu = wave_sum(s) * (1.f / 1024.f);
    float q = 0.f;
#pragma unroll
    for (int i = 0; i < 16; ++i) { const float d = v[i] - mu; q += d * d; }
    const float rstd = rsqrtf(wave_sum(q) * (1.f / 1024.f) + EPS);
#pragma unroll
    for (int i = 0; i < 4; ++i) {
        const float4 g4 = *(const float4*)(gam + i * 256 + lane * 4), b4 = *(const float4*)(bet + i * 256 + lane * 4);
        o[4 * i] = (v[4 * i] - mu) * rstd * g4.x + b4.x; o[4 * i + 1] = (v[4 * i + 1] - mu) * rstd * g4.y + b4.y;
        o[4 * i + 2] = (v[4 * i + 2] - mu) * rstd * g4.z + b4.z; o[4 * i + 3] = (v[4 * i + 3] - mu) * rstd * g4.w + b4.w;
    }
}
DI void ln_stats2(const float (&va)[16], const float (&vb)[16], float& mua, float& rsa, float& mub, float& rsb) {
    float sa = 0.f, sb = 0.f;
#pragma unroll
    for (int i = 0; i < 16; ++i) { sa += va[i]; sb += vb[i]; }
#pragma unroll
    for (int o = 32; o >= 1; o >>= 1) { sa += __shfl_xor(sa, o); sb += __shfl_xor(sb, o); }
    mua = sa * (1.f / 1024.f); mub = sb * (1.f / 1024.f);
    float qa = 0.f, qb = 0.f;
#pragma unroll
    for (int i = 0; i < 16; ++i) { const float da = va[i] - mua, db = vb[i] - mub; qa += da * da; qb += db * db; }
#pragma unroll
    for (int o = 32; o >= 1; o >>= 1) { qa += __shfl_xor(qa, o); qb += __shfl_xor(qb, o); }
    rsa = rsqrtf(qa * (1.f / 1024.f) + EPS); rsb = rsqrtf(qb * (1.f / 1024.f) + EPS);
}
DI void load_row16(const bf16_t* src, int lane, float (&v)[16]) {
#pragma unroll
    for (int i = 0; i < 4; ++i) { const uint2 t2 = *(const uint2*)(src + i * 256 + lane * 4); v[4 * i] = bflo(t2.x); v[4 * i + 1] = bfhi(t2.x); v[4 * i + 2] = bflo(t2.y); v[4 * i + 3] = bfhi(t2.y); }
}
DI void phase_ln1(const P& p, int bid, int nb, unsigned char* smem) {
    const int lane = tidx() & 63, wave = tidx() >> 6;
    const bf16_t* pre = (const bf16_t*)p.out; bf16_t* hb = (bf16_t*)(p.ws + H1B);
    const float* gam = p.in[14]; const float* bet = p.in[15];
    for (int tk = bid * 4 + wave; tk < T; tk += nb * 8) {
        const int tk2 = tk + nb * 4;
        float va[16], vb[16], mua, rsa, mub, rsb;
        load_row16(pre + (size_t)tk * 1024, lane, va); load_row16(pre + (size_t)tk2 * 1024, lane, vb);
        ln_stats2(va, vb, mua, rsa, mub, rsb);
#pragma unroll
        for (int i = 0; i < 4; ++i) {
            const float4 g4 = *(const float4*)(gam + i * 256 + lane * 4), b4 = *(const float4*)(bet + i * 256 + lane * 4);
            const float4 oa = make_float4((va[4 * i] - mua) * rsa * g4.x + b4.x, (va[4 * i + 1] - mua) * rsa * g4.y + b4.y, (va[4 * i + 2] - mua) * rsa * g4.z + b4.z, (va[4 * i + 3] - mua) * rsa * g4.w + b4.w);
            const float4 ob = make_float4((vb[4 * i] - mub) * rsb * g4.x + b4.x, (vb[4 * i + 1] - mub) * rsb * g4.y + b4.y, (vb[4 * i + 2] - mub) * rsb * g4.z + b4.z, (vb[4 * i + 3] - mub) * rsb * g4.w + b4.w);
            *(uint2*)(hb + (size_t)tk * 1024 + i * 256 + lane * 4) = pack4(oa); *(uint2*)(hb + (size_t)tk2 * 1024 + i * 256 + lane * 4) = pack4(ob);
        }
    }
}
struct EpiXq {
    bf16_t* qx;
    DI void prefetch(int, int, int) {}
    DI void operator()(const float* Cs, int m0, int n0, int tid) const {
        const int c4 = (tid & 31) * 4, r0 = tid >> 5, hd = n0 >> 8, d = (n0 & 255) + c4, b = m0 >> 11, s0 = m0 & 2047;
#pragma unroll 4
        for (int ps = 0; ps < 16; ++ps) {
            const int row = ps * 8 + r0;
            float4 v = cs4(Cs, row, c4); v.x *= XSCALE; v.y *= XSCALE; v.z *= XSCALE; v.w *= XSCALE;
            *(uint2*)(qx + ((size_t)(b * 4 + hd) * 2048 + s0 + row) * 256 + d) = pack4(v);
        }
    }
};
DI void phase_xq(const P& p, int bid, int nb, unsigned char* smem) {
    const int v = vbid(bid, nb);
    EpiXq e{(bf16_t*)(p.ws + QX)};
    GemmArgs g{(const bf16_t*)(p.ws + H1B), 1024, (const bf16_t*)(p.ws + W_XQ), 1024, 1024, nullptr};
    for (int t = v; t < 256 * 8; t += nb) gemm_tile(g, (t >> 3) * 128, (t & 7) * 128, e, smem);
}
DI void phase_xattn(const P& p, int bid, int nb, unsigned char* smem, int rep = 0) {
#if !XATTN_NAIVE
    xattn_fast(p, bid, nb, smem, rep); return;
#endif
    unsigned char* ws = p.ws;
    const bf16_t* qx = (const bf16_t*)(ws + QX); const bf16_t* kx = (const bf16_t*)(ws + KX); const bf16_t* vxt = (const bf16_t*)(ws + VXT);
    bf16_t* ox = (bf16_t*)(ws + OX);
    const int lane = tidx() & 63, hd = tidx() >> 6;
    float* qs = (float*)smem + hd * 512; float* ps = qs + 256;
    for (int tk = bid; tk < T; tk += nb) {
        const int b = tk >> 11, s_ = tk & 2047;
        __syncthreads();
        {
            const uint2 w = *(const uint2*)(qx + ((size_t)(b * 4 + hd) * 2048 + s_) * 256 + lane * 4);
            qs[lane * 4] = bflo(w.x); qs[lane * 4 + 1] = bfhi(w.x); qs[lane * 4 + 2] = bflo(w.y); qs[lane * 4 + 3] = bfhi(w.y);
        }
        __syncthreads();
        float sc[4];
#pragma unroll
        for (int i = 0; i < 4; ++i) {
            const int m = lane + 64 * i;
            const uint4* k4 = (const uint4*)(kx + ((size_t)(b * 4 + hd) * 256 + m) * 256);
            float a = 0.f;
#pragma unroll 8
            for (int c = 0; c < 32; ++c) {
                const uint4 w = k4[c];
                const float4 q0 = *(const float4*)(qs + 8 * c), q1 = *(const float4*)(qs + 8 * c + 4);
                a += q0.x * bflo(w.x) + q0.y * bfhi(w.x) + q0.z * bflo(w.y) + q0.w * bfhi(w.y) + q1.x * bflo(w.z) + q1.y * bfhi(w.z) + q1.z * bflo(w.w) + q1.w * bfhi(w.w);
            }
            sc[i] = a;
        }
        const float mx = wave_max(fmaxf(fmaxf(sc[0], sc[1]), fmaxf(sc[2], sc[3])));
        float sum = 0.f;
#pragma unroll
        for (int i = 0; i < 4; ++i) { sc[i] = exp2f(sc[i] - mx); sum += sc[i]; }
        const float il = 1.f / wave_sum(sum);
#pragma unroll
        for (int i = 0; i < 4; ++i) ps[lane + 64 * i] = sc[i] * il;
        __syncthreads();
        float o[4];
#pragma unroll
        for (int dd = 0; dd < 4; ++dd) {
            const int d = lane * 4 + dd;
            const uint4* v4 = (const uint4*)(vxt + ((size_t)(b * 4 + hd) * 256 + d) * 256);
            float a = 0.f;
#pragma unroll 8
            for (int c = 0; c < 32; ++c) {
                const uint4 w = v4[c];
                const float4 q0 = *(const float4*)(ps + 8 * c), q1 = *(const float4*)(ps + 8 * c + 4);
                a += q0.x * bflo(w.x) + q0.y * bfhi(w.x) + q0.z * bflo(w.y) + q0.w * bfhi(w.y) + q1.x * bflo(w.z) + q1.y * bfhi(w.z) + q1.z * bflo(w.w) + q1.w * bfhi(w.w);
            }
            o[dd] = a;
        }
        uint2 w; w.x = pack2(o[0], o[1]); w.y = pack2(o[2], o[3]);
        *(uint2*)(ox + (size_t)tk * 1024 + hd * 256 + lane * 4) = w;
    }
}
DI void phase_xo(const P& p, int bid, int nb, unsigned char* smem) {
    const int v = vbid(bid, nb);
    EpiResid<true> e; e.pre = (bf16_t*)p.out; e.res = p.ws + H1B;
    GemmArgs g{(const bf16_t*)(p.ws + OX), 1024, (const bf16_t*)(p.ws + W_XO), 1024, 1024, nullptr};
    for (int t = v; t < 256 * 8; t += nb) gemm_tile(g, (t >> 3) * 128, (t & 7) * 128, e, smem);
}
typedef float f32x4v __attribute__((ext_vector_type(4)));
DI void phase_ln2_router(const P& p, int bid, int nb, unsigned char* smem, int rep = 0) {
    unsigned char* ws = p.ws;
    const int lane = tidx() & 63, wave = tidx() >> 6;
    const bf16_t* pre = (const bf16_t*)p.out; bf16_t* hb = (bf16_t*)(ws + H2B);
    const float* wrt = (const float*)(ws + W_RT);
    const float* gam = p.in[20]; const float* bet = p.in[21];
    unsigned* cnt = (unsigned*)(ws + CTL + CTL_CNT); int* lists = (int*)(ws + LISTS); float* tgate = (float*)(ws + TOK_GATE);
    float* lg = (float*)smem + wave * (16 * 52 + 32);
    float* stt = lg + 16 * 52;
    for (int grp = bid; grp < T / 64; grp += nb) {
        const int t0 = grp * 64 + wave * 16;
        for (int rr = 0; rr < 16; rr += 2) {
            if (rep && REP_MODE == 3) break;
            const int tk = t0 + rr;
            float va[16], vb[16], mua, rsa, mub, rsb;
            load_row16(pre + (size_t)tk * 1024, lane, va); load_row16(pre + (size_t)(tk + 1) * 1024, lane, vb);
            ln_stats2(va, vb, mua, rsa, mub, rsb);
            if (lane == 0) { stt[2 * rr] = mua; stt[2 * rr + 1] = rsa; stt[2 * rr + 2] = mub; stt[2 * rr + 3] = rsb; }
#pragma unroll
            for (int i = 0; i < 4; ++i) {
                const float4 g4 = *(const float4*)(gam + i * 256 + lane * 4), b4 = *(const float4*)(bet + i * 256 + lane * 4);
                const float4 oa = make_float4((va[4 * i] - mua) * rsa * g4.x + b4.x, (va[4 * i + 1] - mua) * rsa * g4.y + b4.y, (va[4 * i + 2] - mua) * rsa * g4.z + b4.z, (va[4 * i + 3] - mua) * rsa * g4.w + b4.w);
                const float4 ob = make_float4((vb[4 * i] - mub) * rsb * g4.x + b4.x, (vb[4 * i + 1] - mub) * rsb * g4.y + b4.y, (vb[4 * i + 2] - mub) * rsb * g4.z + b4.z, (vb[4 * i + 3] - mub) * rsb * g4.w + b4.w);
                *(uint2*)(hb + (size_t)tk * 1024 + i * 256 + lane * 4) = pack4(oa); *(uint2*)(hb + (size_t)(tk + 1) * 1024 + i * 256 + lane * 4) = pack4(ob);
            }
        }
        __builtin_amdgcn_wave_barrier();
        if (!(rep && REP_MODE == 2)) {
            const int i16 = lane & 15, g4i = lane >> 4;
            const float mu = stt[2 * i16], rstd = stt[2 * i16 + 1];
            const bf16_t* arow = pre + (size_t)(t0 + i16) * 1024 + 4 * g4i;
            const float* brow = wrt + (size_t)i16 * 1024 + 4 * g4i;
            const float* grow = gam + 4 * g4i; const float* berow = bet + 4 * g4i;
            f32x4v acc0 = {0.f, 0.f, 0.f, 0.f}, acc1 = acc0, acc2 = acc0;
#pragma unroll 4
            for (int S = 0; S < 64; ++S) {
                const uint2 xw = *(const uint2*)(arow + 16 * S); const float4 x4 = make_float4(bflo(xw.x), bfhi(xw.x), bflo(xw.y), bfhi(xw.y));
                const float4 g4 = *(const float4*)(grow + 16 * S), e4 = *(const float4*)(berow + 16 * S);
                const float4 b0 = *(const float4*)(brow + 16 * S), b1 = *(const float4*)(brow + 16 * 1024 + 16 * S), b2 = *(const float4*)(brow + 32 * 1024 + 16 * S);
                const float a0 = (x4.x - mu) * rstd * g4.x + e4.x, a1 = (x4.y - mu) * rstd * g4.y + e4.y, a2 = (x4.z - mu) * rstd * g4.z + e4.z, a3 = (x4.w - mu) * rstd * g4.w + e4.w;
                acc0 = __builtin_amdgcn_mfma_f32_16x16x4f32(a0, b0.x, acc0, 0, 0, 0); acc1 = __builtin_amdgcn_mfma_f32_16x16x4f32(a0, b1.x, acc1, 0, 0, 0); acc2 = __builtin_amdgcn_mfma_f32_16x16x4f32(a0, b2.x, acc2, 0, 0, 0);
                acc0 = __builtin_amdgcn_mfma_f32_16x16x4f32(a1, b0.y, acc0, 0, 0, 0); acc1 = __builtin_amdgcn_mfma_f32_16x16x4f32(a1, b1.y, acc1, 0, 0, 0); acc2 = __builtin_amdgcn_mfma_f32_16x16x4f32(a1, b2.y, acc2, 0, 0, 0);
                acc0 = __builtin_amdgcn_mfma_f32_16x16x4f32(a2, b0.z, acc0, 0, 0, 0); acc1 = __builtin_amdgcn_mfma_f32_16x16x4f32(a2, b1.z, acc1, 0, 0, 0); acc2 = __builtin_amdgcn_mfma_f32_16x16x4f32(a2, b2.z, acc2, 0, 0, 0);
                acc0 = __builtin_amdgcn_mfma_f32_16x16x4f32(a3, b0.w, acc0, 0, 0, 0); acc1 = __builtin_amdgcn_mfma_f32_16x16x4f32(a3, b1.w, acc1, 0, 0, 0); acc2 = __builtin_amdgcn_mfma_f32_16x16x4f32(a3, b2.w, acc2, 0, 0, 0);
            }
#pragma unroll
            for (int e = 0; e < 4; ++e) {
                float* rowp = lg + (4 * g4i + e) * 52 + i16;
                rowp[0] = acc0[e]; rowp[16] = acc1[e]; rowp[32] = acc2[e];
            }
        }
        __builtin_amdgcn_wave_barrier();
        unsigned* lcount = (unsigned*)((float*)smem + 4 * (16 * 52 + 32));
        unsigned* lbase = lcount + 32;
        if (tidx() < 32) lcount[tidx()] = 0u;
        __syncthreads();
        int ex1 = 0, ex2 = 0; unsigned lp1 = 0, lp2 = 0;
        if (lane < 16) {
            const int tk = t0 + lane;
            const float* lr = lg + lane * 52;
            float gl[4], el[32];
#pragma unroll
            for (int j = 0; j < 4; ++j) gl[j] = lr[j] + p.in[23][j];
#pragma unroll
            for (int j = 0; j < 32; ++j) el[j] = lr[4 + j] + p.in[25][j];
            int gi = 0; float gm = gl[0];
#pragma unroll
            for (int j = 1; j < 4; ++j) if (gl[j] > gm) { gm = gl[j]; gi = j; }
            float gs = 0.f;
#pragma unroll
            for (int j = 0; j < 4; ++j) gs += __expf(gl[j] - gm);
            const float ggate = 1.f / gs;
            float ev[8];
#pragma unroll
            for (int j = 0; j < 8; ++j) ev[j] = gi == 0 ? el[j] : gi == 1 ? el[8 + j] : gi == 2 ? el[16 + j] : el[24 + j];
            int i1 = 0; float v1 = ev[0];
#pragma unroll
            for (int j = 1; j < 8; ++j) if (ev[j] > v1) { v1 = ev[j]; i1 = j; }
            int i2 = -1; float v2 = -3.0e38f;
#pragma unroll
            for (int j = 0; j < 8; ++j) if (j != i1 && ev[j] > v2) { v2 = ev[j]; i2 = j; }
            const float e2 = __expf(v2 - v1);
            tgate[tk * 2] = ggate / (1.f + e2); tgate[tk * 2 + 1] = ggate * e2 / (1.f + e2);
            ex1 = gi * 8 + i1; ex2 = gi * 8 + i2;
            if (!rep) { lp1 = atomicAdd(&lcount[ex1], 1u); lp2 = atomicAdd(&lcount[ex2], 1u); }
        }
        __syncthreads();
        if (tidx() < 32 && !rep) { const unsigned c = lcount[tidx()]; lbase[tidx()] = c ? atomicAdd(&cnt[tidx() * CNT_STRIDE], c) : 0u; }
        __syncthreads();
        if (lane < 16 && !rep) {
            const int tk = t0 + lane;
            lists[(size_t)ex1 * T + lbase[ex1] + lp1] = tk * 2;
            lists[(size_t)ex2 * T + lbase[ex2] + lp2] = tk * 2 + 1;
        }
        __syncthreads();
    }
}
struct MoeMap { int off[33]; };
DI int moe_tiles(const unsigned* cnt, int* offs  ) {
    __syncthreads();
    if (tidx() == 0) { int o = 0; for (int e = 0; e < 32; ++e) { offs[e] = o; o += (((int)cnt[e * CNT_STRIDE] + 127) >> 7) << 7; } offs[32] = o; }
    __syncthreads();
    return offs[32] >> 7;
}
struct EpiGU {
    bf16_t* hdn;
    DI void prefetch(int, int, int) {}
    DI void operator()(const float* Cs, int m0, int n0, int tid) const {
#pragma unroll 4
        for (int ps = 0; ps < 8; ++ps) {
            const int it = ps * 256 + tid, row = it >> 4, qd = it & 15, c = (qd >> 3) * 64 + (qd & 7) * 4;
            const float4 g = cs4(Cs, row, c), u = cs4(Cs, row, c + 32);
            const int hc = ((n0 & 511) >> 7) * 64 + (qd >> 3) * 32 + (qd & 7) * 4;
            *(uint2*)(hdn + (size_t)(m0 + row) * 256 + hc) = pack4(make_float4(siluf(g.x) * u.x, siluf(g.y) * u.y, siluf(g.z) * u.z, siluf(g.w) * u.w));
        }
    }
};
struct EpiDown {
    bf16_t* y; const int* ltok; const float* lgate;
    DI void prefetch(int, int, int) {}
    DI void operator()(const float* Cs, int m0, int n0, int tid) const {
        const int c4 = (tid & 31) * 4, r0 = tid >> 5;
#pragma unroll 4
        for (int ps = 0; ps < 16; ++ps) {
            const int row = ps * 8 + r0, tk2 = ltok[row];
            if (tk2 >= 0) {
                const float gt = lgate[row];
                float4 v = cs4(Cs, row, c4); v.x *= gt; v.y *= gt; v.z *= gt; v.w *= gt;
                *(uint2*)(y + (size_t)tk2 * 1024 + n0 + c4) = pack4(v);
            }
        }
    }
};
template <int WHICH>
DI void phase_moe(const P& p, int bid, int nb, unsigned char* smem) {
    unsigned char* ws = p.ws;
    const unsigned* cnt = (const unsigned*)(ws + CTL + CTL_CNT); const int* lists = (const int*)(ws + LISTS); const float* tgate = (const float*)(ws + TOK_GATE);
    int* offs = (int*)(smem + GEMM_LDS); int* ltok = offs + 64; int* lrow = ltok + 128; float* lgate = (float*)(lrow + 128);
    const int nmt = moe_tiles(cnt, offs);
    constexpr int NNT = WHICH == 0 ? 4 : 8;
    const int v = vbid(bid, nb);
    for (int t = v; t < nmt * NNT; t += nb) {
        const int mt = t / NNT, ntl = t % NNT;
        const int slot0 = mt * 128;
        int e = 0;
        while (offs[e + 1] <= slot0) ++e;
        __syncthreads();
        if (tidx() < 128) {
            const int pos = slot0 - offs[e] + tidx();
            const int tk2 = pos < (int)cnt[e * CNT_STRIDE] ? lists[(size_t)e * T + pos] : -1;
            ltok[tidx()] = tk2; lrow[tidx()] = tk2 < 0 ? 0 : (tk2 >> 1); lgate[tidx()] = tk2 < 0 ? 0.f : tgate[tk2];
        }
        __syncthreads();
        if (WHICH == 0) {
            EpiGU ep{(bf16_t*)(ws + HDN)};
            GemmArgs g{(const bf16_t*)(ws + H2B), 1024, (const bf16_t*)(ws + W_GU) + (size_t)e * 512 * 1024, 1024, 1024, lrow};
            gemm_tile(g, slot0, ntl * 128, ep, smem);
        } else {
            EpiDown ep{(bf16_t*)(ws + YB), ltok, lgate};
            GemmArgs g{(const bf16_t*)(ws + HDN), 256, (const bf16_t*)(ws + W_DN) + (size_t)e * 1024 * 256, 256, 256, nullptr};
            gemm_tile(g, slot0, ntl * 128, ep, smem);
        }
    }
}
DI void phase_final(const P& p, int bid, int nb, unsigned char* smem) {
    const int lane = tidx() & 63, wave = tidx() >> 6;
    const bf16_t* hb2 = (const bf16_t*)(p.ws + H2B); const bf16_t* y = (const bf16_t*)(p.ws + YB);
    const float* gam = p.in[29]; const float* bet = p.in[30];
    for (int tk = bid * 4 + wave; tk < T; tk += nb * 8) {
        const int tk2 = tk + nb * 4;
        float va[16], vb[16], mua, rsa, mub, rsb;
#pragma unroll
        for (int i = 0; i < 4; ++i) {
            const uint2 ha = *(const uint2*)(hb2 + (size_t)tk * 1024 + i * 256 + lane * 4), hbv = *(const uint2*)(hb2 + (size_t)tk2 * 1024 + i * 256 + lane * 4);
            const float4 ta = make_float4(bflo(ha.x), bfhi(ha.x), bflo(ha.y), bfhi(ha.y)), tb = make_float4(bflo(hbv.x), bfhi(hbv.x), bflo(hbv.y), bfhi(hbv.y));
            const uint2 a0 = *(const uint2*)(y + (size_t)(tk * 2) * 1024 + i * 256 + lane * 4), a1 = *(const uint2*)(y + (size_t)(tk * 2 + 1) * 1024 + i * 256 + lane * 4);
            const uint2 b0 = *(const uint2*)(y + (size_t)(tk2 * 2) * 1024 + i * 256 + lane * 4), b1 = *(const uint2*)(y + (size_t)(tk2 * 2 + 1) * 1024 + i * 256 + lane * 4);
            va[4 * i] = ALPHA * ta.x + bflo(a0.x) + bflo(a1.x); va[4 * i + 1] = ALPHA * ta.y + bfhi(a0.x) + bfhi(a1.x); va[4 * i + 2] = ALPHA * ta.z + bflo(a0.y) + bflo(a1.y); va[4 * i + 3] = ALPHA * ta.w + bfhi(a0.y) + bfhi(a1.y);
            vb[4 * i] = ALPHA * tb.x + bflo(b0.x) + bflo(b1.x); vb[4 * i + 1] = ALPHA * tb.y + bfhi(b0.x) + bfhi(b1.x); vb[4 * i + 2] = ALPHA * tb.z + bflo(b0.y) + bflo(b1.y); vb[4 * i + 3] = ALPHA * tb.w + bfhi(b0.y) + bfhi(b1.y);
        }
        ln_stats2(va, vb, mua, rsa, mub, rsb);
#pragma unroll
        for (int i = 0; i < 4; ++i) {
            const float4 g4 = *(const float4*)(gam + i * 256 + lane * 4), b4 = *(const float4*)(bet + i * 256 + lane * 4);
            *(float4*)(p.out + (size_t)tk * 1024 + i * 256 + lane * 4) = make_float4((va[4 * i] - mua) * rsa * g4.x + b4.x, (va[4 * i + 1] - mua) * rsa * g4.y + b4.y, (va[4 * i + 2] - mua) * rsa * g4.z + b4.z, (va[4 * i + 3] - mua) * rsa * g4.w + b4.w);
            *(float4*)(p.out + (size_t)tk2 * 1024 + i * 256 + lane * 4) = make_float4((vb[4 * i] - mub) * rsb * g4.x + b4.x, (vb[4 * i + 1] - mub) * rsb * g4.y + b4.y, (vb[4 * i + 2] - mub) * rsb * g4.z + b4.z, (vb[4 * i + 3] - mub) * rsb * g4.w + b4.w);
        }
    }
}

#define XB_TMO      128
#define XB_XCNT(j)  (256  + 64 * (j))
#define XB_XSUB(j)  (1280 + 64 * (j))
#define XB_XGEN(j)  (2304 + 64 * (j))
#define XB_TOP      3328
#define XB_TOPGEN   3392
#define XCD_BAR_WORDS 3456
#define XB_SPIN_CAP (1u << 25)
DI unsigned xb_ld(unsigned* p) { return __hip_atomic_load(p, __ATOMIC_RELAXED, __HIP_MEMORY_SCOPE_AGENT); }
DI unsigned xb_add(unsigned* p, unsigned v) { return __hip_atomic_fetch_add(p, v, __ATOMIC_RELAXED, __HIP_MEMORY_SCOPE_AGENT); }
DI unsigned xb_xcc_id() { return (unsigned)__builtin_amdgcn_s_getreg((3 << 11) | 20) & 0xFu; }
#define XB_SPIN(cond, bar) do { unsigned _sp = 0; while (cond) { __builtin_amdgcn_s_sleep(1); \
    if ((++_sp & 255u) == 0u) { if (xb_ld(&(bar)[XB_TMO])) break; if (_sp > XB_SPIN_CAP) { atomicAdd(&(bar)[XB_TMO], 1u); break; } } } } while (0)
struct XcdBarrier { unsigned* bar; unsigned x; volatile LAS unsigned* st; };
DI XcdBarrier xcd_barrier_post(unsigned* bar, volatile LAS unsigned* st) {
    XcdBarrier b; b.bar = bar; b.x = xb_xcc_id(); b.st = st;
    if (threadIdx.x == 0) (void)xb_add(&bar[XB_XCNT(b.x)], 1u);
    return b;
}
DI void xcd_barrier_complete(unsigned* bar, unsigned x, unsigned& nloc, unsigned& nx) {
    const unsigned G = gridDim.x * gridDim.y * gridDim.z;
    unsigned sum, cnt, mine, sp = 0u;
    for (;;) {
        sum = 0u; cnt = 0u; mine = 0u;
#pragma unroll
        for (unsigned j = 0; j < 16; ++j) { const unsigned c = xb_ld(&bar[XB_XCNT(j)]); sum += c; cnt += (c > 0u) ? 1u : 0u; mine = (j == x) ? c : mine; }
        if (sum == G) break;
        __builtin_amdgcn_s_sleep(1);
        if ((++sp & 255u) == 0u) { if (xb_ld(&bar[XB_TMO])) break; if (sp > XB_SPIN_CAP) { atomicAdd(&bar[XB_TMO], 1u); break; } }
    }
    nloc = mine > 0u ? mine : 1u; nx = cnt > 0u ? cnt : 1u;
}
DI void xcd_barrier(const XcdBarrier& b) {
    asm volatile("s_waitcnt vmcnt(0)" ::: "memory");
    __syncthreads();
    if (threadIdx.x == 0) {
        unsigned* bar = b.bar;
        __builtin_amdgcn_s_waitcnt(0);
        unsigned nloc = b.st[0], nx = b.st[1];
        if (nloc == 0u) { xcd_barrier_complete(bar, b.x, nloc, nx); b.st[0] = nloc; b.st[1] = nx; }
        const unsigned old = xb_add(&bar[XB_XSUB(b.x)], 1u);
        const unsigned gen = old / nloc;
        if (old + 1u == (gen + 1u) * nloc) {
            __builtin_amdgcn_fence(__ATOMIC_RELEASE, "agent");
            asm volatile("s_waitcnt vmcnt(0)" ::: "memory");
            const unsigned og = xb_add(&bar[XB_TOP], 1u);
            const unsigned tg = og / nx;
            if (og + 1u == (tg + 1u) * nx) xb_add(&bar[XB_TOPGEN], 1u);
            else XB_SPIN(xb_ld(&bar[XB_TOPGEN]) == tg, bar);
            __builtin_amdgcn_fence(__ATOMIC_ACQUIRE, "agent");
            xb_add(&bar[XB_XGEN(b.x)], 1u);
            asm volatile("s_waitcnt vmcnt(0)" ::: "memory");
        } else {
            XB_SPIN(xb_ld(&bar[XB_XGEN(b.x)]) == gen, bar);
            __builtin_amdgcn_fence(__ATOMIC_ACQUIRE, "agent");
            asm volatile("s_waitcnt vmcnt(0)" ::: "memory");
        }
    }
    __syncthreads();
}

constexpr int NPHASE = 14;
template <int PH>
DI void run_phase(const P& p, int bid, int nb, unsigned char* smem, int rep = 0) {
    if (PH == 0) phase_prep(p, bid, nb, smem);
    else if (PH == 1) phase_proj(p, bid, nb, smem, rep);
    else if (PH == 2) phase_up(p, bid, nb, smem, rep);
    else if (PH == 3) phase_mixer(p, bid, nb, smem, rep);
    else if (PH == 4) phase_ssdnorm(p, bid, nb, smem);
    else if (PH == 5) phase_wout(p, bid, nb, smem);
    else if (PH == 6) phase_ln1(p, bid, nb, smem);
    else if (PH == 7) phase_xq(p, bid, nb, smem);
    else if (PH == 8) phase_xattn(p, bid, nb, smem, rep);
    else if (PH == 9) phase_xo(p, bid, nb, smem);
    else if (PH == 10) phase_ln2_router(p, bid, nb, smem, rep);
    else if (PH == 11) phase_moe<0>(p, bid, nb, smem);
    else if (PH == 12) phase_moe<1>(p, bid, nb, smem);
    else if (PH == 13) phase_final(p, bid, nb, smem);
}
template <int PH>
__global__ void __launch_bounds__(256, 2) k_phase(P p) {
    __shared__ __attribute__((aligned(16))) unsigned char smem[SMEM_BYTES];
    run_phase<PH>(p, blockIdx.x, gridDim.x, smem);
}

#if MEGA
#ifndef MEGA_WAVES
#define MEGA_WAVES 2
#endif
template <int PH>
DI void mega_steps(const P& p, const XcdBarrier& bar, unsigned char* smem) {
    run_phase<PH>(p, blockIdx.x, gridDim.x, smem);
    if constexpr (((REPEAT_MASK >> PH) & 1) != 0) { xcd_barrier(bar); run_phase<PH>(p, blockIdx.x, gridDim.x, smem, 1); }
    if constexpr (PH == 6 && EXTRA_BARRIERS > 0) { for (int i = 0; i < EXTRA_BARRIERS; ++i) xcd_barrier(bar); }
    if constexpr (PH + 1 < NPHASE) { xcd_barrier(bar); mega_steps<PH + 1>(p, bar, smem); }
}
__global__ void __launch_bounds__(256, MEGA_WAVES) k_mega(P p) {
    __shared__ __attribute__((aligned(16))) unsigned char smem[SMEM_BYTES];
    volatile LAS unsigned* st = (volatile LAS unsigned*)(smem + SMEM_BYTES - 16);
    if (threadIdx.x < 4) st[threadIdx.x] = 0u;
    __syncthreads();
    const XcdBarrier bar = xcd_barrier_post((unsigned*)(p.ws + CTL), st);
    mega_steps<0>(p, bar, smem);
}
#endif
template <int PH>
__global__ void __launch_bounds__(256, 1) k_phase_big(P p) {
    __shared__ __attribute__((aligned(16))) unsigned char smem[SMEM_BYTES];
    run_phase<PH>(p, blockIdx.x, gridDim.x, smem);
}
template <int PH>
static void launch_phase(const P& p, int grid, hipStream_t st) {
    if constexpr (PH == 3 && !P3_SMALL) hipLaunchKernelGGL((k_phase_big<PH>), dim3(grid), dim3(256), 0, st, p);
    else hipLaunchKernelGGL((k_phase<PH>), dim3(grid), dim3(256), 0, st, p);
}

extern "C" void kernel_launch(void* const* d_in, const int* in_sizes, int n_in, void* d_out, int out_size, void* d_ws, size_t ws_size, hipStream_t stream) {
    if (n_in != 31 || out_size != T * D || ws_size < WS_NEED) {
        fprintf(stderr, "kernel_launch: unexpected shapes: n_in %d out %d ws %zu (need %zu)\n", n_in, out_size, ws_size, (size_t)WS_NEED);
        return;
    }
    P p{};
    for (int i = 0; i < 31; ++i) p.in[i] = (const float*)d_in[i];
    p.out = (float*)d_out; p.ws = (unsigned char*)d_ws;
    (void)hipMemsetAsync((unsigned char*)d_ws + CTL, 0, CTL_BYTES, stream);
#if MEGA
    static int grid = 0;
    if (grid == 0) {
        int dev = 0, cus = 0, per_cu = 0;
        (void)hipGetDevice(&dev);
        (void)hipDeviceGetAttribute(&cus, hipDeviceAttributeMultiprocessorCount, dev);
        if (hipOccupancyMaxActiveBlocksPerMultiprocessor(&per_cu, (const void*)k_mega, 256, 0) != hipSuccess || per_cu < 1) { fprintf(stderr, "kernel_launch: occupancy query failed\n"); per_cu = 1; }
        if (per_cu > 2) per_cu = 2;
        grid = cus * per_cu;
        fprintf(stderr, "kernel_launch: mega grid %d (%d CUs x %d)\n", grid, cus, per_cu);
    }
    void* args[] = {(void*)&p};
    const hipError_t le = hipLaunchCooperativeKernel((const void*)k_mega, dim3(grid), dim3(256), args, 0, stream);
    if (le != hipSuccess) fprintf(stderr, "kernel_launch: cooperative launch failed: %s (grid %d)\n", hipGetErrorString(le), grid);
#else
    const int grid = 1024;
    launch_phase<0>(p, grid, stream); launch_phase<1>(p, grid, stream); launch_phase<2>(p, grid, stream); launch_phase<3>(p, grid, stream);
    launch_phase<4>(p, grid, stream); launch_phase<5>(p, grid, stream); launch_phase<6>(p, grid, stream); launch_phase<7>(p, grid, stream);
    launch_phase<8>(p, grid, stream); launch_phase<9>(p, grid, stream); launch_phase<10>(p, grid, stream); launch_phase<11>(p, grid, stream);
    launch_phase<12>(p, grid, stream); launch_phase<13>(p, grid, stream);
#endif
}
```

```cpp
#include <hip/hip_runtime.h>
#include <stdint.h>
#include <stdio.h>

#ifndef MEGA
#define MEGA 1
#endif
#ifndef ATTN_NAIVE
#define ATTN_NAIVE 0
#endif
#ifndef XATTN_NAIVE
#define XATTN_NAIVE 0
#endif
#ifndef SSD_NAIVE
#define SSD_NAIVE 0
#endif
#ifndef P3_SMALL
#define P3_SMALL 1
#endif
#ifndef NO_SSD
#define NO_SSD 0
#endif
#ifndef NO_FLASH
#define NO_FLASH 0
#endif
#ifndef GEMM_GLDS
#define GEMM_GLDS 1
#endif
#ifndef EXTRA_BARRIERS
#define EXTRA_BARRIERS 0
#endif
#ifndef SSD_PM
#define SSD_PM 0
#endif
#ifndef REPEAT_MASK
#define REPEAT_MASK 0
#endif
#ifndef REP_MODE
#define REP_MODE 0
#endif
#ifndef GEMM_DIRECT
#define GEMM_DIRECT 0
#endif

typedef unsigned short bf16_t;
typedef short bf16x8 __attribute__((ext_vector_type(8)));
typedef float f32x16 __attribute__((ext_vector_type(16)));
#define DI __device__ __forceinline__
#define LAS __attribute__((address_space(3)))
#define MFMA32(a, b, c) __builtin_amdgcn_mfma_f32_32x32x16_bf16((a), (b), (c), 0, 0, 0)

constexpr int Bn = 16, S = 2048, T = Bn * S, D = 1024;
constexpr int NMEM = 256;
constexpr float EPS = 1e-5f;
constexpr float ALPHA = 1.189207115002721f;
constexpr float LOG2E = 1.4426950408889634f;
constexpr float QSCALE = 0.10206207261596577f * LOG2E;
constexpr float XSCALE = 0.0625f * LOG2E;
constexpr int NEXP = 32;
constexpr int MAXSLOTS = 69632;

constexpr size_t MiB = 1u << 20;
constexpr size_t W_IN = 0;
constexpr size_t W_QUP = W_IN + 4 * MiB;
constexpr size_t W_KVUP = W_QUP + 768 * 256 * 2;
constexpr size_t W_OUT = W_KVUP + 1024 * 128 * 2;
constexpr size_t W_XQ = W_OUT + 2 * MiB;
constexpr size_t W_XKV = W_XQ + 2 * MiB;
constexpr size_t W_XO = W_XKV + 4 * MiB;
constexpr size_t W_GU = W_XO + 2 * MiB;
constexpr size_t W_DN = W_GU + 32 * MiB;
constexpr size_t W_RT = W_DN + 16 * MiB;
constexpr size_t ROPE_C = W_RT + 48 * 1024 * 4;
constexpr size_t ROPE_S = ROPE_C + 2048 * 16 * 4;
constexpr size_t TOK_GATE = ROPE_S + 2048 * 16 * 4;
constexpr size_t CTL = TOK_GATE + (size_t)T * 2 * 4;
constexpr size_t CTL_BYTES = 32768;
constexpr size_t CTL_CNT = 16384;
constexpr int CNT_STRIDE = 64;
constexpr size_t CTL_QUEUE = 28672;
static_assert(CTL + CTL_BYTES <= 64 * MiB, "weights region overflow");
constexpr size_t RA = 64 * MiB, RB = 192 * MiB, RC = 320 * MiB, RD = 448 * MiB, WS_NEED = 512 * MiB;
constexpr size_t XBC = RA;
constexpr size_t KX = RA + 64 * MiB;
constexpr size_t VXT = KX + 8 * MiB;
constexpr size_t YB = RA;
constexpr size_t QB = RB;
constexpr size_t KNB = RB + 48 * MiB;
constexpr size_t VTB = KNB + 32 * MiB;
constexpr size_t H1 = RB;
constexpr size_t H2 = RB;
constexpr size_t XB = RC;
constexpr size_t MEMB = RB;
constexpr size_t XBCA = RC;
constexpr size_t MIX = RC + 64 * MiB;
constexpr size_t H1B = RC;
constexpr size_t QX = RC + 64 * MiB;
constexpr size_t OX = RB;
constexpr size_t H2B = RC;
constexpr size_t HDN = RC + 64 * MiB;
constexpr size_t CQ = RD;
constexpr size_t CKV = CQ + 16 * MiB;
constexpr size_t KROPE = CKV + 8 * MiB;
constexpr size_t DTB = KROPE + 2 * MiB;
constexpr size_t ZB = DTB + 1 * MiB;
constexpr size_t SSQ = ZB + 32 * MiB;
constexpr size_t LISTS = RD;
static_assert(SSQ + 3 * (size_t)T * 4 <= WS_NEED, "region D overflow");

struct P {
    const float* in[31];
    float* out;
    unsigned char* ws;
};

typedef __bf16 hbf16x2 __attribute__((ext_vector_type(2)));
typedef float f32x2 __attribute__((ext_vector_type(2)));
DI bf16_t f2bf(float x) { return __builtin_bit_cast(bf16_t, (__bf16)x); }
DI float bf2f(bf16_t b) { return __uint_as_float(((unsigned)b) << 16); }
DI float bflo(unsigned w) { return __uint_as_float(w << 16); }
DI float bfhi(unsigned w) { return __uint_as_float(w & 0xffff0000u); }
DI unsigned pack2(float a, float b) { f32x2 v = {a, b}; return __builtin_bit_cast(unsigned, __builtin_convertvector(v, hbf16x2)); }
DI float siluf(float x) { return x * __builtin_amdgcn_rcpf(1.f + __expf(-x)); }
DI float softplusf(float x) {
    const float zz = __expf(-fabsf(x));
    const float l1p = zz < 0.01f ? zz * (1.f - zz * (0.5f - zz * (1.f / 3.f))) : __logf(1.f + zz);
    return fmaxf(x, 0.f) + l1p;
}
DI int tidx() { int t = __builtin_amdgcn_workitem_id_x(); asm volatile("" : "+v"(t)); return t; }
DI int crow(int reg, int h) { return (reg & 3) + 8 * (reg >> 2) + 4 * h; }
constexpr int CS_LD = 132;
DI float4 cs4(const float* Cs, int row, int col) { return *(const float4*)(Cs + row * CS_LD + col); }
DI uint2 pack4(float4 v) { uint2 w; w.x = pack2(v.x, v.y); w.y = pack2(v.z, v.w); return w; }
DI float wave_sum(float v) {
#pragma unroll
    for (int o = 32; o >= 1; o >>= 1) v += __shfl_xor(v, o);
    return v;
}
DI float wave_max(float v) {
#pragma unroll
    for (int o = 32; o >= 1; o >>= 1) v = fmaxf(v, __shfl_xor(v, o));
    return v;
}

constexpr int LDS_ROW = 144;
constexpr int TILE_BYTES = 128 * LDS_ROW;
constexpr int GEMM_LDS = 4 * TILE_BYTES;
constexpr int SMEM_BYTES = GEMM_LDS + 3072;
static_assert(128 * CS_LD * 4 <= GEMM_LDS, "epilogue tile");

struct GemmArgs {
    const bf16_t* A; int lda;
    const bf16_t* Bt; int ldb;
    int K;
    const int* lrows;
};

template <class Epi>
DI void gemm_tile(const GemmArgs& g, int m0, int n0, Epi& epi, unsigned char* smem) {
    const int tid = tidx(), lane = tid & 63, wave = tid >> 6, wr = wave >> 1, wc = wave & 1;
    const int r = lane & 31, h = lane >> 5;
    f32x16 acc[2][2];
#pragma unroll
    for (int i = 0; i < 2; ++i)
#pragma unroll
        for (int j = 0; j < 2; ++j)
#pragma unroll
            for (int e = 0; e < 16; ++e) acc[i][j][e] = 0.f;
    const int nk = g.K >> 6;
#if GEMM_DIRECT
    {
        const bf16_t* ap[2]; const bf16_t* bp[2];
#pragma unroll
        for (int i = 0; i < 2; ++i) {
            const int lr = wr * 64 + i * 32 + r;
            const int grow = g.lrows ? g.lrows[lr] : (m0 + lr);
            ap[i] = g.A + (size_t)grow * g.lda + 8 * h;
            bp[i] = g.Bt + (size_t)(n0 + wc * 64 + i * 32 + r) * g.ldb + 8 * h;
        }
        for (int k = 0; k < g.K; k += 16) {
            bf16x8 a[2], b[2];
#pragma unroll
            for (int i = 0; i < 2; ++i) { a[i] = *(const bf16x8*)(ap[i] + k); b[i] = *(const bf16x8*)(bp[i] + k); }
#pragma unroll
            for (int i = 0; i < 2; ++i)
#pragma unroll
                for (int j = 0; j < 2; ++j) acc[i][j] = MFMA32(a[i], b[j], acc[i][j]);
        }
    }
#elif GEMM_GLDS
    {
        constexpr int STG = 32768, TB = 16384;
        const int srow = tid >> 3, sch = (tid & 7) ^ ((srow >> 1) & 7);
        const bf16_t* ag[4]; const bf16_t* bg[4];
#pragma unroll
        for (int i = 0; i < 4; ++i) {
            const int lr = srow + 32 * i;
            const int grow = g.lrows ? g.lrows[lr] : (m0 + lr);
            ag[i] = g.A + (size_t)grow * g.lda + sch * 8;
            bg[i] = g.Bt + (size_t)(n0 + lr) * g.ldb + sch * 8;
        }
#define GLDS_STAGE(BUF, KO) do { unsigned char* _d = (BUF) + wave * 1024; \
        _Pragma("unroll") for (int i = 0; i < 4; ++i) { \
            __builtin_amdgcn_global_load_lds((const unsigned*)(ag[i] + (KO)), (LAS unsigned*)(_d + i * 4096), 16, 0, 0); \
            __builtin_amdgcn_global_load_lds((const unsigned*)(bg[i] + (KO)), (LAS unsigned*)(_d + TB + i * 4096), 16, 0, 0); } } while (0)
        __syncthreads();
        GLDS_STAGE(smem, 0);
        epi.prefetch(m0, n0, tid);
        const int y16 = (h ^ ((r >> 1) & 7)) << 4;
        const int o0 = y16, o1 = 32 ^ y16, o2 = 64 ^ y16, o3 = 96 ^ y16;
        const int arow = (wr * 64 + r) * 128, brow = TB + (wc * 64 + r) * 128;
        __syncthreads();
        for (int kt = 0; kt < nk; ++kt) {
            const unsigned char* cur = smem + (kt & 1) * STG;
            if (kt + 1 < nk) GLDS_STAGE(smem + ((kt + 1) & 1) * STG, (kt + 1) * 64);
            bf16x8 fa[4][2], fb[4][2];
#define KLOAD(S, OFF) do { \
                fa[S][0] = *(const bf16x8*)(cur + arow + (OFF)); fa[S][1] = *(const bf16x8*)(cur + arow + 32 * 128 + (OFF)); \
                fb[S][0] = *(const bf16x8*)(cur + brow + (OFF)); fb[S][1] = *(const bf16x8*)(cur + brow + 32 * 128 + (OFF)); } while (0)
            KLOAD(0, o0); KLOAD(1, o1); KLOAD(2, o2); KLOAD(3, o3);
#undef KLOAD
#pragma unroll
            for (int s = 0; s < 4; ++s) {
                acc[0][0] = MFMA32(fa[s][0], fb[s][0], acc[0][0]); acc[0][1] = MFMA32(fa[s][0], fb[s][1], acc[0][1]);
                acc[1][0] = MFMA32(fa[s][1], fb[s][0], acc[1][0]); acc[1][1] = MFMA32(fa[s][1], fb[s][1], acc[1][1]);
            }
            __builtin_amdgcn_sched_group_barrier(0x100, 8, 0); __builtin_amdgcn_sched_group_barrier(0x8, 4, 0);
            __builtin_amdgcn_sched_group_barrier(0x100, 4, 0); __builtin_amdgcn_sched_group_barrier(0x8, 4, 0);
            __builtin_amdgcn_sched_group_barrier(0x100, 4, 0); __builtin_amdgcn_sched_group_barrier(0x8, 8, 0);
#define KSTEP(OFF)
#undef KSTEP
            __syncthreads();
        }
#undef GLDS_STAGE
    }
#else
    {
        const int srow = tid >> 3, sch = tid & 7;
        const bf16_t* ag[4]; const bf16_t* bg[4];
#pragma unroll
        for (int i = 0; i < 4; ++i) {
            const int lr = srow + 32 * i;
            const int grow = g.lrows ? g.lrows[lr] : (m0 + lr);
            ag[i] = g.A + (size_t)grow * g.lda + sch * 8;
            bg[i] = g.Bt + (size_t)(n0 + lr) * g.ldb + sch * 8;
        }
        const int soff = srow * LDS_ROW + sch * 16;
        uint4 ra0, ra1, ra2, ra3, rb0, rb1, rb2, rb3;
#define G_LOAD(KO) do { ra0 = *(const uint4*)(ag[0] + (KO)); ra1 = *(const uint4*)(ag[1] + (KO)); ra2 = *(const uint4*)(ag[2] + (KO)); ra3 = *(const uint4*)(ag[3] + (KO)); \
                        rb0 = *(const uint4*)(bg[0] + (KO)); rb1 = *(const uint4*)(bg[1] + (KO)); rb2 = *(const uint4*)(bg[2] + (KO)); rb3 = *(const uint4*)(bg[3] + (KO)); } while (0)
#define L_STORE(BUF) do { unsigned char* _d = (BUF) + soff; \
        *(uint4*)(_d) = ra0; *(uint4*)(_d + 32 * LDS_ROW) = ra1; *(uint4*)(_d + 64 * LDS_ROW) = ra2; *(uint4*)(_d + 96 * LDS_ROW) = ra3; \
        *(uint4*)(_d + TILE_BYTES) = rb0; *(uint4*)(_d + TILE_BYTES + 32 * LDS_ROW) = rb1; *(uint4*)(_d + TILE_BYTES + 64 * LDS_ROW) = rb2; *(uint4*)(_d + TILE_BYTES + 96 * LDS_ROW) = rb3; } while (0)
        G_LOAD(0);
        __syncthreads();
        L_STORE(smem);
        __syncthreads();
        const int aoff = (wr * 64 + r) * LDS_ROW + h * 16;
        const int boff = TILE_BYTES + (wc * 64 + r) * LDS_ROW + h * 16;
        for (int kt = 0; kt < nk; ++kt) {
            const unsigned char* cur = smem + (kt & 1) * 2 * TILE_BYTES;
            unsigned char* nxt = smem + ((kt + 1) & 1) * 2 * TILE_BYTES;
            const bool more = (kt + 1 < nk);
            if (more) G_LOAD((kt + 1) * 64);
#pragma unroll
            for (int ks = 0; ks < 4; ++ks) {
                const bf16x8 a0 = *(const bf16x8*)(cur + aoff + ks * 32);
                const bf16x8 a1 = *(const bf16x8*)(cur + aoff + 32 * LDS_ROW + ks * 32);
                const bf16x8 b0 = *(const bf16x8*)(cur + boff + ks * 32);
                const bf16x8 b1 = *(const bf16x8*)(cur + boff + 32 * LDS_ROW + ks * 32);
                acc[0][0] = MFMA32(a0, b0, acc[0][0]); acc[0][1] = MFMA32(a0, b1, acc[0][1]);
                acc[1][0] = MFMA32(a1, b0, acc[1][0]); acc[1][1] = MFMA32(a1, b1, acc[1][1]);
            }
            if (more) L_STORE(nxt);
            __syncthreads();
        }
#undef G_LOAD
#undef L_STORE
    }
#endif
    float* Cs = (float*)smem;
#if GEMM_DIRECT
    __syncthreads();
#endif
#pragma unroll
    for (int i = 0; i < 2; ++i)
#pragma unroll
        for (int j = 0; j < 2; ++j)
#pragma unroll
            for (int e = 0; e < 16; ++e) Cs[(wr * 64 + i * 32 + crow(e, h)) * CS_LD + wc * 64 + j * 32 + r] = acc[i][j][e];
    __syncthreads();
    epi(Cs, m0, n0, tid);
}

DI int vbid(int bid, int nb) { return (nb % 8 == 0) ? (bid % 8) * (nb / 8) + bid / 8 : bid; }

DI int colmap_in(int n) {
    if (n < 384) return n;
    if (n < 896) return 416 + (n - 384);
    if (n < 1920) return 928 + (n - 896);
    if (n < 1952) return 384 + (n - 1920);
    if (n < 1960) return n;
    return -1;
}
template <int KIND>
DI void tconv_tile(const float* src, const float* src2, int ldsrc, bf16_t* dst, int K, int k0, int n0, const float* scale, int scale_from, unsigned char* smem) {
    float* tile = (float*)smem;
    const int t = tidx();
    __syncthreads();
#pragma unroll 4
    for (int i = 0; i < 16; ++i) {
        const int k = i * 4 + (t >> 6), n = t & 63;
        const int nd = n0 + n;
        float v = 0.f;
        if (KIND == 1) { const int c = colmap_in(nd); if (c >= 0) v = src[(size_t)(k0 + k) * ldsrc + c]; }
        else if (KIND == 2) {
            const int j = nd >> 7, wc = (nd >> 6) & 1, isup = (nd >> 5) & 1, ii = nd & 31;
            const int c = 64 * j + 32 * wc + ii;
            v = (isup ? src2 : src)[(size_t)(k0 + k) * ldsrc + c];
        } else v = src[(size_t)(k0 + k) * ldsrc + nd];
        if (scale && (k0 + k) >= scale_from) v *= scale[k0 + k - scale_from];
        tile[k * 65 + n] = v;
    }
    __syncthreads();
#pragma unroll 4
    for (int i = 0; i < 16; ++i) {
        const int n = i * 4 + (t >> 6), k = t & 63;
        dst[(size_t)(n0 + n) * K + k0 + k] = f2bf(tile[k * 65 + n]);
    }
}

DI void phase_prep(const P& p, int bid, int nb, unsigned char* smem) {
    unsigned char* ws = p.ws;
    const int tid = tidx();
    constexpr int J0 = 512, J1 = J0 + 48, J2 = J1 + 32, J3 = J2 + 256, J4 = J3 + 256, J5 = J4 + 256, J6 = J5 + 256, J7 = J6 + 256, J8 = J7 + 4096, J9 = J8 + 2048;
    for (int t = bid; t < J9; t += nb) {
        if (t < J0) { const int kt = t >> 5, ntl = t & 31; tconv_tile<1>(p.in[2], nullptr, 1960, (bf16_t*)(ws + W_IN), 1024, kt * 64, ntl * 64, nullptr, 0, smem); }
        else if (t < J1) { const int u = t - J0, kt = u / 12, ntl = u % 12; tconv_tile<0>(p.in[4], nullptr, 768, (bf16_t*)(ws + W_QUP), 256, kt * 64, ntl * 64, p.in[3], 0, smem); }
        else if (t < J2) { const int u = t - J1, kt = u >> 4, ntl = u & 15; tconv_tile<0>(p.in[6], nullptr, 1024, (bf16_t*)(ws + W_KVUP), 128, kt * 64, ntl * 64, p.in[5], 0, smem); }
        else if (t < J3) { const int u = t - J2, kt = u >> 4, ntl = u & 15; tconv_tile<0>(p.in[13], nullptr, 1024, (bf16_t*)(ws + W_OUT), 1024, kt * 64, ntl * 64, p.in[12], 512, smem); }
        else if (t < J4) { const int u = t - J3, kt = u >> 4, ntl = u & 15; tconv_tile<0>(p.in[16], nullptr, 1024, (bf16_t*)(ws + W_XQ), 1024, kt * 64, ntl * 64, nullptr, 0, smem); }
        else if (t < J5) { const int u = t - J4, kt = u >> 4, ntl = u & 15; tconv_tile<0>(p.in[17], nullptr, 1024, (bf16_t*)(ws + W_XKV), 1024, kt * 64, ntl * 64, nullptr, 0, smem); }
        else if (t < J6) { const int u = t - J5, kt = u >> 4, ntl = u & 15; tconv_tile<0>(p.in[18], nullptr, 1024, (bf16_t*)(ws + W_XKV) + (size_t)1024 * 1024, 1024, kt * 64, ntl * 64, nullptr, 0, smem); }
        else if (t < J7) { const int u = t - J6, kt = u >> 4, ntl = u & 15; tconv_tile<0>(p.in[19], nullptr, 1024, (bf16_t*)(ws + W_XO), 1024, kt * 64, ntl * 64, nullptr, 0, smem); }
        else if (t < J8) { const int u = t - J7, e = u >> 7, v = u & 127, kt = v >> 3, ntl = v & 7;
            tconv_tile<2>(p.in[26] + (size_t)e * 1024 * 256, p.in[27] + (size_t)e * 1024 * 256, 256, (bf16_t*)(ws + W_GU) + (size_t)e * 512 * 1024, 1024, kt * 64, ntl * 64, nullptr, 0, smem); }
        else { const int u = t - J8, e = u >> 6, v = u & 63, kt = v >> 4, ntl = v & 15;
            tconv_tile<0>(p.in[28] + (size_t)e * 256 * 1024, nullptr, 1024, (bf16_t*)(ws + W_DN) + (size_t)e * 1024 * 256, 256, kt * 64, ntl * 64, nullptr, 0, smem); }
    }
    {
        const size_t gsz = (size_t)nb * 256, g0 = (size_t)bid * 256 + tid;
        bf16_t* xb = (bf16_t*)p.out;
        const float4* x4 = (const float4*)p.in[0];
        for (size_t i = g0; i < (size_t)T * D / 4; i += gsz) { const float4 v = x4[i]; uint2 o; o.x = pack2(v.x, v.y); o.y = pack2(v.z, v.w); ((uint2*)xb)[i] = o; }
        bf16_t* mb = (bf16_t*)(ws + MEMB);
        const float4* m4 = (const float4*)p.in[1];
        for (size_t i = g0; i < (size_t)Bn * NMEM * D / 4; i += gsz) { const float4 v = m4[i]; uint2 o; o.x = pack2(v.x, v.y); o.y = pack2(v.z, v.w); ((uint2*)mb)[i] = o; }
        float* wrt = (float*)(ws + W_RT);
        for (size_t i = g0; i < 48 * 1024; i += gsz) {
            const int j = (int)(i >> 10), k = (int)(i & 1023);
            float v = 0.f;
            if (j < 4) v = p.in[22][k * 4 + j]; else if (j < 36) v = p.in[24][k * 32 + (j - 4)];
            wrt[i] = v;
        }
        float* rc = (float*)(ws + ROPE_C); float* rs = (float*)(ws + ROPE_S);
        for (size_t i = g0; i < 2048 * 16; i += gsz) {
            const int pos = (int)(i >> 4), f = (int)(i & 15);
            const float inv = powf(10000.f, -(float)f / 16.f);
            const float ang = (float)pos * inv;
            const double a = (double)ang;
            const double k2 = rint(a * 0.15915494309189535);
            const float rr = (float)(a - k2 * 6.283185307179586);
            rc[i] = cosf(rr); rs[i] = sinf(rr);
        }
    }
}

struct EpiProj {
    bf16_t *cq, *ckv, *z, *xbc, *krope; float* dt; const float *rc, *rs, *dtb; float* ssq;
    DI void prefetch(int, int, int) {}
    DI void operator()(const float* Cs, int m0, int n0, int tid) const {
        const int c4 = (tid & 31) * 4, r0 = tid >> 5;
        if (n0 < 1920) {
            bf16_t* dst; int ld, cofs;
            if (n0 < 256) { dst = cq; ld = 256; cofs = n0; } else if (n0 < 384) { dst = ckv; ld = 128; cofs = n0 - 256; }
            else if (n0 < 896) { dst = z; ld = 512; cofs = n0 - 384; } else { dst = xbc; ld = 1024; cofs = n0 - 896; }
            if (n0 < 384) {
                float* sq = ssq + (size_t)(n0 >> 7) * T + m0;
#pragma unroll 4
                for (int ps = 0; ps < 16; ++ps) {
                    const int row = ps * 8 + r0; const float4 v = cs4(Cs, row, c4);
                    *(uint2*)(dst + (size_t)(m0 + row) * ld + cofs + c4) = pack4(v);
                    float ss = (v.x * v.x + v.y * v.y) + (v.z * v.z + v.w * v.w);
#pragma unroll
                    for (int o = 16; o >= 1; o >>= 1) ss += __shfl_xor(ss, o);
                    if ((tid & 31) == 0) sq[row] = ss;
                }
            } else {
#pragma unroll 4
            for (int ps = 0; ps < 16; ++ps) { const int row = ps * 8 + r0; *(uint2*)(dst + (size_t)(m0 + row) * ld + cofs + c4) = pack4(cs4(Cs, row, c4)); }
            }
        } else {
#pragma unroll
            for (int ps = 0; ps < 4; ++ps) {
                const int it = ps * 256 + tid, row = it >> 3, cc = (it & 7) * 4, grow = m0 + row;
                const float4 v = cs4(Cs, row, cc), pv = cs4(Cs, row, cc ^ 16);
                const int pos = grow & 2047, f = cc & 15;
                const float4 c = *(const float4*)(rc + pos * 16 + f), s = *(const float4*)(rs + pos * 16 + f);
                float4 o;
                if (cc < 16) { o.x = v.x * c.x - pv.x * s.x; o.y = v.y * c.y - pv.y * s.y; o.z = v.z * c.z - pv.z * s.z; o.w = v.w * c.w - pv.w * s.w; }
                else { o.x = v.x * c.x + pv.x * s.x; o.y = v.y * c.y + pv.y * s.y; o.z = v.z * c.z + pv.z * s.z; o.w = v.w * c.w + pv.w * s.w; }
                *(uint2*)(krope + (size_t)grow * 32 + cc) = pack4(o);
            }
#pragma unroll
            for (int ps = 0; ps < 4; ++ps) {
                const int it = ps * 256 + tid, row = it >> 3, cc = it & 7;
                dt[(size_t)(m0 + row) * 8 + cc] = softplusf(Cs[row * CS_LD + 32 + cc] + dtb[cc]);
            }
        }
    }
};
struct EpiMemKV {
    bf16_t *kx, *vxt;
    DI void prefetch(int, int, int) {}
    DI void operator()(const float* Cs, int m0, int n0, int tid) const {
        const int b = m0 >> 8, mm0 = m0 & 255;
        if (n0 < 1024) {
            const int c4 = (tid & 31) * 4, r0 = tid >> 5, hd = n0 >> 8, d = (n0 & 255) + c4;
#pragma unroll 4
            for (int ps = 0; ps < 16; ++ps) { const int row = ps * 8 + r0; *(uint2*)(kx + ((size_t)(b * 4 + hd) * 256 + mm0 + row) * 256 + d) = pack4(cs4(Cs, row, c4)); }
        } else {
            const int c2 = n0 - 1024, hd = c2 >> 8;
#pragma unroll 2
            for (int ps = 0; ps < 8; ++ps) {
                const int it = ps * 256 + tid, col = it & 127, rg = it >> 7, d = (c2 & 255) + col;
                uint4 w;
                w.x = pack2(Cs[(rg * 8 + 0) * CS_LD + col], Cs[(rg * 8 + 1) * CS_LD + col]); w.y = pack2(Cs[(rg * 8 + 2) * CS_LD + col], Cs[(rg * 8 + 3) * CS_LD + col]);
                w.z = pack2(Cs[(rg * 8 + 4) * CS_LD + col], Cs[(rg * 8 + 5) * CS_LD + col]); w.w = pack2(Cs[(rg * 8 + 6) * CS_LD + col], Cs[(rg * 8 + 7) * CS_LD + col]);
                *(uint4*)(vxt + ((size_t)(b * 4 + hd) * 256 + d) * 256 + mm0 + rg * 8) = w;
            }
        }
    }
};
DI void phase_proj(const P& p, int bid, int nb, unsigned char* smem, int rep = 0) {
    unsigned char* ws = p.ws;
    const int v = vbid(bid, nb);
    const bf16_t* xb = (const bf16_t*)p.out;
    EpiProj e1{(bf16_t*)(ws + CQ), (bf16_t*)(ws + CKV), (bf16_t*)(ws + ZB), (bf16_t*)(ws + XBC), (bf16_t*)(ws + KROPE), (float*)(ws + DTB),
               (const float*)(ws + ROPE_C), (const float*)(ws + ROPE_S), p.in[9], (float*)(ws + SSQ)};
    EpiMemKV e2{(bf16_t*)(ws + KX), (bf16_t*)(ws + VXT)};
    constexpr int NT1 = 256 * 16, NT2 = 32 * 16;
    for (int t = v; t < NT1 + NT2; t += nb) {
        if (rep && REP_MODE == 1 && t >= NT1) continue;
        if (rep && REP_MODE == 2 && t < NT1) continue;
        if (rep && REP_MODE == 3 && !(t < NT1 && (t & 7) == 7 && ((t >> 6) & 1))) continue;
        if (rep && REP_MODE == 4 && !(t < NT1 && ((t >> 6) & 1) == 0)) continue;
        const int u = t < NT1 ? t : t - NT1, c = u >> 6, j = u & 63, mt = (c >> 1) * 8 + (j >> 3), ntl = (c & 1) * 8 + (j & 7);
        if (t < NT1) { GemmArgs g{xb, 1024, (const bf16_t*)(ws + W_IN), 1024, 1024, nullptr}; gemm_tile(g, mt * 128, ntl * 128, e1, smem); }
        else { GemmArgs g{(const bf16_t*)(ws + MEMB), 1024, (const bf16_t*)(ws + W_XKV), 1024, 1024, nullptr}; gemm_tile(g, mt * 128, ntl * 128, e2, smem); }
    }
}

struct EpiQup {
    bf16_t* q; const float* ssq; float* rms;
    DI void prefetch(int m0, int, int tid) { if (tid < 128) rms[tid] = rsqrtf((ssq[m0 + tid] + ssq[(size_t)T + m0 + tid]) * (1.f / 256.f) + EPS); }
    DI void operator()(const float* Cs, int m0, int n0, int tid) const {
        const int c4 = (tid & 31) * 4, r0 = tid >> 5;
        const int col = n0 + c4, head = col / 96, d = col - head * 96;
        const int b = m0 >> 11, s0 = m0 & 2047;
#pragma unroll 4
        for (int ps = 0; ps < 16; ++ps) {
            const int row = ps * 8 + r0;
            const float sc = rms[row] * QSCALE;
            float4 v = cs4(Cs, row, c4);
            v.x *= sc; v.y *= sc; v.z *= sc; v.w *= sc;
            *(uint2*)(q + ((size_t)(b * 8 + head) * 2048 + s0 + row) * 96 + d) = pack4(v);
        }
    }
};
struct EpiKVup {
    bf16_t *kn, *vt; const float* ssq; float* rms;
    DI void prefetch(int m0, int, int tid) { if (tid < 128) rms[tid] = rsqrtf(ssq[2 * (size_t)T + m0 + tid] * (1.f / 128.f) + EPS); }
    DI void operator()(const float* Cs, int m0, int n0, int tid) const {
        const int head = n0 >> 7, b = m0 >> 11, s0 = m0 & 2047;
#pragma unroll 4
        for (int ps = 0; ps < 8; ++ps) {
            const int it = ps * 256 + tid, row = it >> 4, c4 = (it & 15) * 4;
            const float sc = rms[row];
            float4 v = cs4(Cs, row, c4); v.x *= sc; v.y *= sc; v.z *= sc; v.w *= sc;
            *(uint2*)(kn + ((size_t)(b * 8 + head) * 2048 + s0 + row) * 64 + c4) = pack4(v);
        }
#pragma unroll 2
        for (int ps = 0; ps < 4; ++ps) {
            const int it = ps * 256 + tid, dv = it & 63, rg = it >> 6;
            const float* cp = Cs + (rg * 8) * CS_LD + 64 + dv; const float* rp = rms + rg * 8;
            uint4 w;
            w.x = pack2(cp[0] * rp[0], cp[CS_LD] * rp[1]); w.y = pack2(cp[2 * CS_LD] * rp[2], cp[3 * CS_LD] * rp[3]);
            w.z = pack2(cp[4 * CS_LD] * rp[4], cp[5 * CS_LD] * rp[5]); w.w = pack2(cp[6 * CS_LD] * rp[6], cp[7 * CS_LD] * rp[7]);
            *(uint4*)(vt + ((size_t)(b * 8 + head) * 64 + dv) * 2048 + s0 + rg * 8) = w;
        }
    }
};
DI void phase_up(const P& p, int bid, int nb, unsigned char* smem, int rep = 0) {
    unsigned char* ws = p.ws;
    const int v = vbid(bid, nb);
    float* rms = (float*)(smem + GEMM_LDS);
    constexpr int NTQ = 256 * 6, NTKV = 256 * 8;
    for (int t = v; t < NTQ + NTKV; t += nb) {
        if (rep && REP_MODE == 1) break;
        if (rep && REP_MODE == 2 && t >= NTQ) break;
        if (rep && REP_MODE == 3 && t < NTQ) continue;
        if (t < NTQ) {
            const int mt = t / 6, ntl = t % 6;
            EpiQup e{(bf16_t*)(ws + QB), (const float*)(ws + SSQ), rms};
            GemmArgs g{(const bf16_t*)(ws + CQ), 256, (const bf16_t*)(ws + W_QUP), 256, 256, nullptr};
            gemm_tile(g, mt * 128, ntl * 128, e, smem);
        } else {
            const int u = t - NTQ, mt = u >> 3, ntl = u & 7;
            EpiKVup e{(bf16_t*)(ws + KNB), (bf16_t*)(ws + VTB), (const float*)(ws + SSQ), rms};
            GemmArgs g{(const bf16_t*)(ws + CKV), 128, (const bf16_t*)(ws + W_KVUP), 128, 128, nullptr};
            gemm_tile(g, mt * 128, ntl * 128, e, smem);
        }
    }
    if (!(rep && REP_MODE >= 2)) {
        const bf16_t* xbc = (const bf16_t*)(ws + XBC); bf16_t* xa = (bf16_t*)(ws + XBCA);
        const float* cw = p.in[7]; const float* cb = p.in[8];
        const size_t gsz = (size_t)nb * 256;
        for (size_t i = (size_t)bid * 256 + tidx(); i < (size_t)(T / 4) * 128; i += gsz) {
            const int tk0 = (int)(i >> 7) * 4, c0 = (int)(i & 127) * 8, s0 = tk0 & 2047;
            float w[4][8], bias[8];
#pragma unroll
            for (int j = 0; j < 4; ++j) { const float4 w0 = *(const float4*)(cw + j * 1024 + c0), w1 = *(const float4*)(cw + j * 1024 + c0 + 4);
                w[j][0] = w0.x; w[j][1] = w0.y; w[j][2] = w0.z; w[j][3] = w0.w; w[j][4] = w1.x; w[j][5] = w1.y; w[j][6] = w1.z; w[j][7] = w1.w; }
            { const float4 b0 = *(const float4*)(cb + c0), b1 = *(const float4*)(cb + c0 + 4); bias[0] = b0.x; bias[1] = b0.y; bias[2] = b0.z; bias[3] = b0.w; bias[4] = b1.x; bias[5] = b1.y; bias[6] = b1.z; bias[7] = b1.w; }
            float xin[7][8];
#pragma unroll
            for (int rr = 0; rr < 7; ++rr) {
                uint4 wv = make_uint4(0u, 0u, 0u, 0u);
                if (s0 + rr - 3 >= 0) wv = *(const uint4*)(xbc + (size_t)(tk0 + rr - 3) * 1024 + c0);
                xin[rr][0] = bflo(wv.x); xin[rr][1] = bfhi(wv.x); xin[rr][2] = bflo(wv.y); xin[rr][3] = bfhi(wv.y); xin[rr][4] = bflo(wv.z); xin[rr][5] = bfhi(wv.z); xin[rr][6] = bflo(wv.w); xin[rr][7] = bfhi(wv.w);
            }
#pragma unroll
            for (int o = 0; o < 4; ++o) {
                float accv[8];
#pragma unroll
                for (int k = 0; k < 8; ++k) accv[k] = bias[k] + w[0][k] * xin[o][k] + w[1][k] * xin[o + 1][k] + w[2][k] * xin[o + 2][k] + w[3][k] * xin[o + 3][k];
                uint4 ov;
                ov.x = pack2(siluf(accv[0]), siluf(accv[1])); ov.y = pack2(siluf(accv[2]), siluf(accv[3]));
                ov.z = pack2(siluf(accv[4]), siluf(accv[5])); ov.w = pack2(siluf(accv[6]), siluf(accv[7]));
                *(uint4*)(xa + (size_t)(tk0 + o) * 1024 + c0) = ov;
            }
        }
    }
}

DI int perm16(int k) { return (k & ~12) | ((k & 4) << 1) | ((k & 8) >> 1); }
template <int DQK, int DVW, int KT, int NQG, int NDV>
struct FlashCfg {
    static constexpr int KSTR = (DQK + 8) * 2;
    static constexpr int VSTR = (KT + 8) * 2;
    static constexpr int DV = DVW * NDV;
    static constexpr int KBYTES = KT * KSTR, VBYTES = DV * VSTR, STAGE = KBYTES + VBYTES;
    static constexpr int KCH = KT * DQK / 8 / 256;
    static constexpr int VCH = DV * KT / 8 / 256;
    static_assert(KT * DQK / 8 % 256 == 0 && DV * KT / 8 % 256 == 0, "chunk split");
    static_assert(2 * STAGE <= SMEM_BYTES - 32, "flash LDS");
};
template <int DQK, int DVW, int KT, int NQG, int NDV, class Src>
DI void flash_item(const Src& src, int ntiles, int nskip  , unsigned char* smem, bool noload = false) {
    typedef FlashCfg<DQK, DVW, KT, NQG, NDV> C;
    constexpr int NKS = DQK / 16, NKB = KT / 32, NDB = DVW / 32;
    int tid = tidx(); asm volatile("" : "+v"(tid));
    const int lane = tid & 63, wave = __builtin_amdgcn_readfirstlane(tid >> 6), r = lane & 31, h = lane >> 5;
    const int qg = wave / NDV, dvh = wave % NDV;
    bf16x8 qf[NKS];
    {
        const bf16_t* qp = src.qrow(qg * 32 + r) + 8 * h;
#pragma unroll
        for (int ks = 0; ks < NKS; ++ks) qf[ks] = *(const bf16x8*)(qp + 16 * ks);
        if (Src::ROPE) {
            const float* cp = src.rope_c(qg * 32 + r) + 8 * h; const float* sp = src.rope_s(qg * 32 + r) + 8 * h;
            const float4 c0 = *(const float4*)cp, c1 = *(const float4*)(cp + 4), s0 = *(const float4*)sp, s1 = *(const float4*)(sp + 4);
            const float cc[8] = {c0.x, c0.y, c0.z, c0.w, c1.x, c1.y, c1.z, c1.w}, ss[8] = {s0.x, s0.y, s0.z, s0.w, s1.x, s1.y, s1.z, s1.w};
            bf16x8 x1 = qf[NKS - 2], x2 = qf[NKS - 1];
#pragma unroll
            for (int j = 0; j < 8; ++j) {
                const float a = bf2f((bf16_t)x1[j]), b2 = bf2f((bf16_t)x2[j]);
                x1[j] = (short)f2bf(a * cc[j] - b2 * ss[j]); x2[j] = (short)f2bf(b2 * cc[j] + a * ss[j]);
            }
            qf[NKS - 2] = x1; qf[NKS - 1] = x2;
        }
    }
    f32x16 o[NDB];
#pragma unroll
    for (int d = 0; d < NDB; ++d)
#pragma unroll
        for (int e = 0; e < 16; ++e) o[d][e] = 0.f;
    float m = -1e30f, l = 0.f;
    uint4 kr[C::KCH], vr[C::VCH];
    auto gload = [&](int t) {
#pragma unroll
        for (int i = 0; i < C::KCH; ++i) { const int idx = tid + 256 * i; kr[i] = src.kload(t, idx / (DQK / 8), idx % (DQK / 8)); }
#pragma unroll
        for (int i = 0; i < C::VCH; ++i) { const int idx = tid + 256 * i; vr[i] = src.vload(t, idx / (KT / 8), idx % (KT / 8)); }
    };
    auto lstore = [&](unsigned char* buf) {
#pragma unroll
        for (int i = 0; i < C::KCH; ++i) { const int idx = tid + 256 * i; *(uint4*)(buf + (idx / (DQK / 8)) * C::KSTR + (idx % (DQK / 8)) * 16) = kr[i]; }
#pragma unroll
        for (int i = 0; i < C::VCH; ++i) {
            const int idx = tid + 256 * i, dv = idx / (KT / 8), c = idx % (KT / 8);
            unsigned char* row = buf + C::KBYTES + dv * C::VSTR + (c >> 1) * 32;
            const int a = c & 1;
            *(uint2*)(row + (4 * a) * 2) = make_uint2(vr[i].x, vr[i].y);
            *(uint2*)(row + (8 + 4 * a) * 2) = make_uint2(vr[i].z, vr[i].w);
        }
    };
    gload(0);
    __syncthreads();
    lstore(smem);
    __syncthreads();
    for (int t = 0; t < ntiles; ++t) {
        const unsigned char* cur = smem + (t & 1) * C::STAGE;
        const bool more = (t + 1 < ntiles);
        if (more && !noload) gload(t + 1);
        if (!(t == ntiles - 1 && qg < nskip)) {
            f32x16 s[NKB];
#pragma unroll
            for (int kb = 0; kb < NKB; ++kb) {
                const unsigned char* kp = cur + (kb * 32 + r) * C::KSTR + h * 16;
                if (NKB == 1) {
                    constexpr int NCH = 2;
                    f32x16 sp[NCH];
#pragma unroll
                    for (int c = 0; c < NCH; ++c)
#pragma unroll
                        for (int e = 0; e < 16; ++e) sp[c][e] = 0.f;
#pragma unroll
                    for (int ks = 0; ks < NKS; ++ks) sp[ks % NCH] = MFMA32(*(const bf16x8*)(kp + ks * 32), qf[ks], sp[ks % NCH]);
#pragma unroll
                    for (int e = 0; e < 16; ++e) s[kb][e] = sp[0][e] + sp[1][e];
                } else {
#pragma unroll
                    for (int e = 0; e < 16; ++e) s[kb][e] = 0.f;
#pragma unroll
                    for (int ks = 0; ks < NKS; ++ks) s[kb] = MFMA32(*(const bf16x8*)(kp + ks * 32), qf[ks], s[kb]);
                }
            }
            float mx = s[0][0];
#pragma unroll
            for (int kb = 0; kb < NKB; ++kb)
#pragma unroll
                for (int e = 0; e < 16; ++e) mx = fmaxf(mx, s[kb][e]);
            mx = fmaxf(mx, __shfl_xor(mx, 32));
            const float mn = fmaxf(m, mx);
            const float alpha = __builtin_amdgcn_exp2f(m - mn);
            m = mn;
            float ps = 0.f;
#pragma unroll
            for (int kb = 0; kb < NKB; ++kb)
#pragma unroll
                for (int e = 0; e < 16; ++e) { const float pv = __builtin_amdgcn_exp2f(s[kb][e] - mn); s[kb][e] = pv; ps += pv; }
            l = l * alpha + ps;
#pragma unroll
            for (int d = 0; d < NDB; ++d)
#pragma unroll
                for (int e = 0; e < 16; ++e) o[d][e] *= alpha;
#pragma unroll
            for (int kb = 0; kb < NKB; ++kb)
#pragma unroll
                for (int s2 = 0; s2 < 2; ++s2) {
                    uint4 pk;
                    pk.x = pack2(s[kb][8 * s2], s[kb][8 * s2 + 1]); pk.y = pack2(s[kb][8 * s2 + 2], s[kb][8 * s2 + 3]);
                    pk.z = pack2(s[kb][8 * s2 + 4], s[kb][8 * s2 + 5]); pk.w = pack2(s[kb][8 * s2 + 6], s[kb][8 * s2 + 7]);
                    const bf16x8 pf = __builtin_bit_cast(bf16x8, pk);
                    const unsigned char* vp = cur + C::KBYTES + (dvh * DVW + r) * C::VSTR + (kb * 32 + s2 * 16 + 8 * h) * 2;
#pragma unroll
                    for (int d = 0; d < NDB; ++d) o[d] = MFMA32(*(const bf16x8*)(vp + d * 32 * C::VSTR), pf, o[d]);
                }
        }
        if (more) lstore(smem + ((t + 1) & 1) * C::STAGE);
        __syncthreads();
    }
    l += __shfl_xor(l, 32);
    const float il = 1.f / l;
#pragma unroll
    for (int d = 0; d < NDB; ++d)
#pragma unroll
        for (int g4 = 0; g4 < 4; ++g4) {
            uint2 w; w.x = pack2(o[d][4 * g4] * il, o[d][4 * g4 + 1] * il); w.y = pack2(o[d][4 * g4 + 2] * il, o[d][4 * g4 + 3] * il);
            src.store(qg * 32 + r, dvh * DVW + d * 32 + 8 * g4 + 4 * h, w);
        }
}
struct SelfSrc {
    static constexpr bool ROPE = true;
    const bf16_t *q, *kn, *kr, *vt; bf16_t* mix; int b, hd, bh, q0; const float *rc, *rs;
    DI const float* rope_c(int rr) const { return rc + (q0 + rr) * 16; }
    DI const float* rope_s(int rr) const { return rs + (q0 + rr) * 16; }
    DI const bf16_t* qrow(int rr) const { return q + ((size_t)bh * 2048 + q0 + rr) * 96; }
    DI uint4 kload(int t, int key, int c) const {
        const int kg = t * 64 + key;
        return c < 8 ? *(const uint4*)(kn + ((size_t)bh * 2048 + kg) * 64 + c * 8) : *(const uint4*)(kr + ((size_t)b * 2048 + kg) * 32 + (c - 8) * 8);
    }
    DI uint4 vload(int t, int dv, int c) const { return *(const uint4*)(vt + ((size_t)bh * 64 + dv) * 2048 + t * 64 + c * 8); }
    DI void store(int rr, int dv, uint2 w) const { *(uint2*)(mix + ((size_t)b * 2048 + q0 + rr) * 1024 + hd * 64 + dv) = w; }
};
struct CrossSrc {
    static constexpr bool ROPE = false;
    const bf16_t *qx, *kx, *vxt; bf16_t* ox; int b, hd, q0;
    DI const float* rope_c(int) const { return nullptr; }
    DI const float* rope_s(int) const { return nullptr; }
    DI const bf16_t* qrow(int rr) const { return qx + ((size_t)(b * 4 + hd) * 2048 + q0 + rr) * 256; }
    DI uint4 kload(int t, int key, int c) const { return *(const uint4*)(kx + ((size_t)(b * 4 + hd) * 256 + t * 32 + key) * 256 + c * 8); }
    DI uint4 vload(int t, int dv, int c) const { return *(const uint4*)(vxt + ((size_t)(b * 4 + hd) * 256 + dv) * 256 + t * 32 + c * 8); }
    DI void store(int rr, int dv, uint2 w) const { *(uint2*)(ox + ((size_t)b * 2048 + q0 + rr) * 1024 + hd * 256 + dv) = w; }
};
DI void attn_fast(const P& p, int bid, int nb, unsigned char* smem) {
    unsigned char* ws = p.ws;
    const int nround = (2048 + nb - 1) / nb;
    for (int rd = 0; rd < nround; ++rd) {
        const int idx = rd * nb + ((rd & 1) ? (nb - 1 - bid) : bid);
        if (idx >= 2048) continue;
        const int qb = 15 - (idx >> 7), bh = idx & 127;
        SelfSrc s{(const bf16_t*)(ws + QB), (const bf16_t*)(ws + KNB), (const bf16_t*)(ws + KROPE), (const bf16_t*)(ws + VTB), (bf16_t*)(ws + MIX), bh >> 3, bh & 7, bh, qb * 128, (const float*)(ws + ROPE_C), (const float*)(ws + ROPE_S)};
        flash_item<96, 64, 64, 4, 1>(s, 2 * qb + 2, 2, smem);
    }
}
DI void xattn_fast(const P& p, int bid, int nb, unsigned char* smem, int rep = 0) {
    unsigned char* ws = p.ws;
    for (int it = bid; it < 2048; it += nb) {
        const int bhd = it >> 5, qt = it & 31;
        CrossSrc s{(const bf16_t*)(ws + QX), (const bf16_t*)(ws + KX), (const bf16_t*)(ws + VXT), (bf16_t*)(ws + OX), bhd >> 2, bhd & 3, qt * 64};
        if (rep) s.ox = (bf16_t*)(ws + RD);
        flash_item<256, 128, 32, 2, 2>(s, 8, 0, smem, rep && REP_MODE == 5);
    }
}

constexpr int SSD_XT = 0, SSD_BM = 8192, SSD_CM = SSD_BM + 16384, SSD_BWT = SSD_CM + 16384, SSD_PS = SSD_BWT + 16384, SSD_F = SSD_PS + 16384;
static_assert(SSD_F + 2048 <= SMEM_BYTES - 32, "ssd LDS");
DI int off256(int row, int el) { return row * 256 + (((el >> 3) ^ (row & 15)) << 4) + ((el & 7) << 1); }
DI int off128(int row, int el) { return row * 128 + (((el >> 3) ^ ((row ^ (row >> 3)) & 7)) << 4) + ((el & 7) << 1); }
template <int pm>
DI void ssd_item(const P& p, int bh, unsigned char* smem) {
    unsigned char* ws = p.ws;
    const bf16_t* xa = (const bf16_t*)(ws + XBCA); const float* dtg = (const float*)(ws + DTB);
    bf16_t* mix = pm ? (bf16_t*)(ws + XBC) : (bf16_t*)(ws + MIX);
    int tid0 = tidx(); asm volatile("" : "+v"(tid0));
    const int wave = __builtin_amdgcn_readfirstlane(tid0 >> 6);
    const int b = bh >> 3, hd = bh & 7, g = hd >> 2;
    const int lb = wave >> 1, pb = wave & 1;
    const float a_h = -__expf(p.in[10][hd]), Dh = p.in[11][hd];
    float* F = (float*)(smem + SSD_F);
    __syncthreads();
    for (int i = tid0; i < 16384 / 16; i += 256) *(uint4*)(smem + SSD_PS + i * 16) = make_uint4(0u, 0u, 0u, 0u);
    f32x16 st[2];
#pragma unroll
    for (int i = 0; i < 2; ++i)
#pragma unroll
        for (int e = 0; e < 16; ++e) st[i][e] = 0.f;
    uint4 xr0, xr1, br0, br1, br2, br3, cr0, cr1, cr2, cr3; float dtr = 0.f;
#define SSD_XLD(i) (*(const uint4*)(xa + (t0_ + ((tid + 256 * (i)) >> 3)) * 1024 + hd * 64 + ((tid + 256 * (i)) & 7) * 8))
#define SSD_BLD(i, o) (*(const uint4*)(xa + (t0_ + ((tid + 256 * (i)) >> 4)) * 1024 + (o) + g * 128 + ((tid + 256 * (i)) & 15) * 8))
#define SSD_GLOAD(c_) do { const size_t t0_ = (size_t)b * 2048 + (c_) * 64; xr0 = SSD_XLD(0); xr1 = SSD_XLD(1); \
        br0 = SSD_BLD(0, 512); br1 = SSD_BLD(1, 512); br2 = SSD_BLD(2, 512); br3 = SSD_BLD(3, 512); \
        cr0 = SSD_BLD(0, 768); cr1 = SSD_BLD(1, 768); cr2 = SSD_BLD(2, 768); cr3 = SSD_BLD(3, 768); \
        if (tid < 64) dtr = dtg[(t0_ + tid) * 8 + hd]; } while (0)
    { const int tid = tid0; SSD_GLOAD(0); }
#define SSD_SCAN(FP) do { const int ln_ = tid0 & 63; float v = dtr * a_h; \
        _Pragma("unroll") for (int o = 1; o < 64; o <<= 1) { const float u = __shfl_up(v, o); if (ln_ >= o) v += u; } \
        const float a63 = __shfl(v, 63); \
        (FP)[ln_] = v; (FP)[64 + ln_] = __expf(v); (FP)[128 + ln_] = dtr; (FP)[192 + ln_] = __expf(a63 - v) * dtr; } while (0)
    if (wave == 0) SSD_SCAN(F);
    __syncthreads();
    for (int c = 0; c < 32; ++c) {
        int tid = tid0; asm volatile("" : "+v"(tid));
        const int lane = tid & 63, r = lane & 31, h = lane >> 5;
        const size_t t0 = (size_t)b * 2048 + c * 64;
        const float* Fc = F + (c & 1) * 256; float* Fn = F + ((c + 1) & 1) * 256;
#define SSD_XIMG(i, XR) do { const int idx = tid + 256 * (i), l = idx >> 3, p0 = (idx & 7) * 8, lp = perm16(l); \
            const unsigned ww[4] = {XR.x, XR.y, XR.z, XR.w}; \
            _Pragma("unroll") for (int k = 0; k < 4; ++k) { \
                *(bf16_t*)(smem + SSD_XT + off128(p0 + 2 * k, lp)) = (bf16_t)(ww[k] & 0xffffu); \
                *(bf16_t*)(smem + SSD_XT + off128(p0 + 2 * k + 1, lp)) = (bf16_t)(ww[k] >> 16); } } while (0)
#define SSD_BIMG(i, BR, CR) do { const int idx = tid + 256 * (i), l = idx >> 4, n0 = (idx & 15) * 8, lp = perm16(l); \
            *(uint4*)(smem + SSD_BM + off256(l, n0)) = BR; *(uint4*)(smem + SSD_CM + off256(l, n0)) = CR; \
            const float wl = Fc[192 + l]; const unsigned ww[4] = {BR.x, BR.y, BR.z, BR.w}; \
            _Pragma("unroll") for (int k = 0; k < 4; ++k) { \
                *(bf16_t*)(smem + SSD_BWT + off128(n0 + 2 * k, lp)) = f2bf(bflo(ww[k]) * wl); \
                *(bf16_t*)(smem + SSD_BWT + off128(n0 + 2 * k + 1, lp)) = f2bf(bfhi(ww[k]) * wl); } } while (0)
        if (!(pm & 2)) {
        SSD_XIMG(0, xr0); SSD_XIMG(1, xr1);
        SSD_BIMG(0, br0, cr0); SSD_BIMG(1, br1, cr1); SSD_BIMG(2, br2, cr2); SSD_BIMG(3, br3, cr3);
        } else { asm volatile("" :: "v"(xr0.x), "v"(xr1.x), "v"(br0.x), "v"(br1.x), "v"(br2.x), "v"(br3.x), "v"(cr0.x), "v"(cr1.x), "v"(cr2.x), "v"(cr3.x)); }
        __syncthreads();
        if (c + 1 < 32) SSD_GLOAD(c + 1);
        if (!(pm & 1)) {
        const float acs_l = Fc[lb * 32 + r];
        const int lrow = lb * 32 + r;
        f32x16 cb0, cb1, yo;
#pragma unroll
        for (int e = 0; e < 16; ++e) { cb0[e] = 0.f; cb1[e] = 0.f; yo[e] = 0.f; }
#pragma unroll
        for (int ks = 0; ks < 8; ++ks) {
            const bf16x8 cv = *(const bf16x8*)(smem + SSD_CM + off256(lb * 32 + r, 16 * ks + 8 * h));
            const bf16x8 b0v = *(const bf16x8*)(smem + SSD_BM + off256(r, 16 * ks + 8 * h));
            const bf16x8 b1v = *(const bf16x8*)(smem + SSD_BM + off256(32 + r, 16 * ks + 8 * h));
            const bf16x8 pv = *(const bf16x8*)(smem + SSD_PS + off256(pb * 32 + r, 16 * ks + 8 * h));
            cb0 = MFMA32(b0v, cv, cb0); cb1 = MFMA32(b1v, cv, cb1); yo = MFMA32(cv, pv, yo);
        }
        f32x16 yd;
#pragma unroll
        for (int e = 0; e < 16; ++e) yd[e] = 0.f;
#pragma unroll
        for (int sb = 0; sb < 2; ++sb) {
            float mv[16];
#pragma unroll
            for (int q4 = 0; q4 < 4; ++q4) {
                const int s0 = sb * 32 + 8 * q4 + 4 * h;
                const float4 as4 = *(const float4*)(Fc + s0), dt4 = *(const float4*)(Fc + 128 + s0);
                const float asv[4] = {as4.x, as4.y, as4.z, as4.w}, dtv[4] = {dt4.x, dt4.y, dt4.z, dt4.w};
#pragma unroll
                for (int k = 0; k < 4; ++k) { const float cbv = sb ? cb1[4 * q4 + k] : cb0[4 * q4 + k]; mv[4 * q4 + k] = (s0 + k <= lrow) ? cbv * __expf(acs_l - asv[k]) * dtv[k] : 0.f; }
            }
#pragma unroll
            for (int s2 = 0; s2 < 2; ++s2) {
                uint4 pk;
                pk.x = pack2(mv[8 * s2], mv[8 * s2 + 1]); pk.y = pack2(mv[8 * s2 + 2], mv[8 * s2 + 3]);
                pk.z = pack2(mv[8 * s2 + 4], mv[8 * s2 + 5]); pk.w = pack2(mv[8 * s2 + 6], mv[8 * s2 + 7]);
                const bf16x8 xb = *(const bf16x8*)(smem + SSD_XT + off128(pb * 32 + r, sb * 32 + 16 * s2 + 8 * h));
                yd = MFMA32(__builtin_bit_cast(bf16x8, pk), xb, yd);
            }
        }
        {
            const uint4 x0 = *(const uint4*)(smem + SSD_XT + off128(pb * 32 + r, lb * 32 + 8 * h));
            const uint4 x1 = *(const uint4*)(smem + SSD_XT + off128(pb * 32 + r, lb * 32 + 16 + 8 * h));
            const unsigned xw[8] = {x0.x, x0.y, x0.z, x0.w, x1.x, x1.y, x1.z, x1.w};
            bf16_t* op = mix + (t0 + lb * 32 + 4 * h) * 1024 + 512 + hd * 64 + pb * 32 + r;
#pragma unroll
            for (int q4 = 0; q4 < 4; ++q4) {
                const float4 ea4 = *(const float4*)(Fc + 64 + lb * 32 + 8 * q4 + 4 * h);
                const float eav[4] = {ea4.x, ea4.y, ea4.z, ea4.w};
#pragma unroll
                for (int k = 0; k < 4; ++k) {
                    const int e = 4 * q4 + k;
                    const float xv = (e & 1) ? bfhi(xw[e >> 1]) : bflo(xw[e >> 1]);
                    const float y = yd[e] + eav[k] * yo[e] + Dh * xv;
                    op[(size_t)(k + 8 * q4) * 1024] = f2bf(y);
                }
            }
        }
        {
            const float dec = Fc[64 + 63];
#pragma unroll
            for (int e = 0; e < 16; ++e) { st[0][e] *= dec; st[1][e] *= dec; }
            const int nblk = 2 * (wave >> 1);
#pragma unroll
            for (int ks = 0; ks < 4; ++ks) {
                const bf16x8 av = *(const bf16x8*)(smem + SSD_XT + off128(pb * 32 + r, 16 * ks + 8 * h));
                const bf16x8 bv0 = *(const bf16x8*)(smem + SSD_BWT + off128(nblk * 32 + r, 16 * ks + 8 * h));
                const bf16x8 bv1 = *(const bf16x8*)(smem + SSD_BWT + off128(nblk * 32 + 32 + r, 16 * ks + 8 * h));
                st[0] = MFMA32(av, bv0, st[0]); st[1] = MFMA32(av, bv1, st[1]);
            }
        }
        }
        if (wave == 0 && c + 1 < 32) SSD_SCAN(Fn);
        __syncthreads();
#pragma unroll
        for (int i = 0; i < 2; ++i) {
            const int n = (2 * (wave >> 1) + i) * 32 + r;
#pragma unroll
            for (int e = 0; e < 16; ++e) *(bf16_t*)(smem + SSD_PS + off256(pb * 32 + crow(e, h), n)) = f2bf(st[i][e]);
        }
    }
    __syncthreads();
}

#if ATTN_NAIVE
DI void attn_naive(const P& p, int bid, int nb) {
    unsigned char* ws = p.ws;
    const bf16_t* Q = (const bf16_t*)(ws + QB); const bf16_t* Kn = (const bf16_t*)(ws + KNB); const bf16_t* Vt = (const bf16_t*)(ws + VTB);
    const bf16_t* Kr = (const bf16_t*)(ws + KROPE); bf16_t* mix = (bf16_t*)(ws + MIX);
    for (int item = bid; item < 128 * 8; item += nb) {
        const int bh = item >> 3, s_ = (item & 7) * 256 + tidx(), b = bh >> 3, hd = bh & 7;
        float q[96];
        {
            const uint4* q4 = (const uint4*)(Q + ((size_t)bh * 2048 + s_) * 96);
#pragma unroll
            for (int i = 0; i < 12; ++i) { const uint4 w = q4[i]; q[8 * i] = bflo(w.x); q[8 * i + 1] = bfhi(w.x); q[8 * i + 2] = bflo(w.y); q[8 * i + 3] = bfhi(w.y);
                q[8 * i + 4] = bflo(w.z); q[8 * i + 5] = bfhi(w.z); q[8 * i + 6] = bflo(w.w); q[8 * i + 7] = bfhi(w.w); }
        }
        float o[64];
#pragma unroll
        for (int d = 0; d < 64; ++d) o[d] = 0.f;
        float m = -1e30f, l = 0.f;
        const int nkeys = __builtin_amdgcn_readfirstlane(((s_ >> 6) + 1) * 64);
        for (int j0 = 0; j0 < nkeys; j0 += 8) {
            float sc[8];
#pragma unroll
            for (int jj = 0; jj < 8; ++jj) {
                const int j = j0 + jj;
                const uint4* k4 = (const uint4*)(Kn + ((size_t)bh * 2048 + j) * 64);
                const uint4* r4 = (const uint4*)(Kr + ((size_t)b * 2048 + j) * 32);
                float a = 0.f;
#pragma unroll
                for (int i = 0; i < 8; ++i) { const uint4 w = k4[i]; a += q[8 * i] * bflo(w.x) + q[8 * i + 1] * bfhi(w.x) + q[8 * i + 2] * bflo(w.y) + q[8 * i + 3] * bfhi(w.y)
                    + q[8 * i + 4] * bflo(w.z) + q[8 * i + 5] * bfhi(w.z) + q[8 * i + 6] * bflo(w.w) + q[8 * i + 7] * bfhi(w.w); }
#pragma unroll
                for (int i = 0; i < 4; ++i) { const uint4 w = r4[i]; const int o8 = 64 + 8 * i; a += q[o8] * bflo(w.x) + q[o8 + 1] * bfhi(w.x) + q[o8 + 2] * bflo(w.y) + q[o8 + 3] * bfhi(w.y)
                    + q[o8 + 4] * bflo(w.z) + q[o8 + 5] * bfhi(w.z) + q[o8 + 6] * bflo(w.w) + q[o8 + 7] * bfhi(w.w); }
                sc[jj] = a;
            }
            float mx = m;
#pragma unroll
            for (int jj = 0; jj < 8; ++jj) mx = fmaxf(mx, sc[jj]);
            const float al = exp2f(m - mx);
            float ps = 0.f;
#pragma unroll
            for (int jj = 0; jj < 8; ++jj) { sc[jj] = exp2f(sc[jj] - mx); ps += sc[jj]; }
            l = l * al + ps; m = mx;
#pragma unroll
            for (int d = 0; d < 64; ++d) {
                const uint4 w = *(const uint4*)(Vt + ((size_t)bh * 64 + d) * 2048 + j0);
                o[d] = o[d] * al + sc[0] * bflo(w.x) + sc[1] * bfhi(w.x) + sc[2] * bflo(w.y) + sc[3] * bfhi(w.y) + sc[4] * bflo(w.z) + sc[5] * bfhi(w.z) + sc[6] * bflo(w.w) + sc[7] * bfhi(w.w);
            }
        }
        const float il = 1.f / l;
        bf16_t* dst = mix + ((size_t)b * 2048 + s_) * 1024 + hd * 64;
#pragma unroll
        for (int d = 0; d < 64; d += 2) *(unsigned*)(dst + d) = pack2(o[d] * il, o[d + 1] * il);
    }
}
#endif
#if SSD_NAIVE
DI void ssd_naive(const P& p, int bid, int nb) {
    unsigned char* ws = p.ws;
    const bf16_t* xa = (const bf16_t*)(ws + XBCA); const float* dt = (const float*)(ws + DTB); const bf16_t* z = (const bf16_t*)(ws + ZB);
    bf16_t* mix = (bf16_t*)(ws + MIX);
    const int wave = tidx() >> 6, pp = tidx() & 63;
    for (int item = bid; item < 32; item += nb) {
        const int bh = item * 4 + wave, b = bh >> 3, hd = bh & 7, g = hd >> 2;
        const float a = -__expf(p.in[10][hd]), Dh = p.in[11][hd];
        float st[128];
#pragma unroll
        for (int n = 0; n < 128; ++n) st[n] = 0.f;
        for (int t = 0; t < 2048; ++t) {
            const size_t row = (size_t)b * 2048 + t;
            const float dtv = dt[row * 8 + hd];
            const float da = __expf(dtv * a);
            const float xv = bf2f(xa[row * 1024 + hd * 64 + pp]);
            const float xd = dtv * xv;
            const uint4* b4 = (const uint4*)(xa + row * 1024 + 512 + g * 128);
            const uint4* c4 = (const uint4*)(xa + row * 1024 + 768 + g * 128);
            float y = 0.f;
#pragma unroll
            for (int i = 0; i < 16; ++i) {
                const uint4 bw = b4[i], cw = c4[i];
                const unsigned bb[4] = {bw.x, bw.y, bw.z, bw.w}, cc[4] = {cw.x, cw.y, cw.z, cw.w};
#pragma unroll
                for (int k = 0; k < 4; ++k) {
                    const int n = 8 * i + 2 * k;
                    st[n] = da * st[n] + xd * bflo(bb[k]); y += bflo(cc[k]) * st[n];
                    st[n + 1] = da * st[n + 1] + xd * bfhi(bb[k]); y += bfhi(cc[k]) * st[n + 1];
                }
            }
            y += Dh * xv;
            const float zv = bf2f(z[row * 512 + hd * 64 + pp]);
            mix[row * 1024 + 512 + hd * 64 + pp] = f2bf(y * siluf(zv));
        }
    }
}
#endif
DI void phase_mixer(const P& p, int bid, int nb, unsigned char* smem, int rep = 0) {
#if SSD_NAIVE
    ssd_naive(p, bid, nb);
    attn_fast(p, bid, nb, smem);
#else
    unsigned* ctr = (unsigned*)(p.ws + CTL + CTL_QUEUE) + 64 * rep;
    int* slot = (int*)(smem + SMEM_BYTES - 32);
    for (;;) {
        __syncthreads();
        if (tidx() == 0) *slot = (int)atomicAdd(ctr, 1u);
        __syncthreads();
        const int it = *slot;
        if (it >= 128 + 2048) break;
        if (it < 128) { if (!NO_SSD && !(rep && REP_MODE == 2)) { if (rep) ssd_item<SSD_PM>(p, it, smem); else ssd_item<0>(p, it, smem); } }
        else if (rep && REP_MODE >= 1) { }
        else {
            const int idx = it - 128, qb = 15 - (idx >> 7), bh = idx & 127;
            unsigned char* ws = p.ws;
            SelfSrc s{(const bf16_t*)(ws + QB), (const bf16_t*)(ws + KNB), (const bf16_t*)(ws + KROPE), (const bf16_t*)(ws + VTB), (bf16_t*)(ws + MIX), bh >> 3, bh & 7, bh, qb * 128, (const float*)(ws + ROPE_C), (const float*)(ws + ROPE_S)};
            if (rep) s.mix = (bf16_t*)(ws + XBC);
            if (!NO_FLASH) flash_item<96, 64, 64, 4, 1>(s, 2 * qb + 2, 2, smem, rep && REP_MODE == 5);
        }
    }
#endif
}

DI void phase_ssdnorm(const P& p, int bid, int nb, unsigned char* smem) {
    bf16_t* mix = (bf16_t*)(p.ws + MIX); const bf16_t* z = (const bf16_t*)(p.ws + ZB);
    const int lane = tidx() & 63, wave = tidx() >> 6;
    for (int tk = bid * 4 + wave; tk < T; tk += nb * 4) {
        uint4* ptr = (uint4*)(mix + (size_t)tk * 1024 + 512 + lane * 8);
        const uint4 w = *ptr, zz = *(const uint4*)(z + (size_t)tk * 512 + lane * 8);
        const unsigned ww[4] = {w.x, w.y, w.z, w.w}, zw[4] = {zz.x, zz.y, zz.z, zz.w};
        float v[8]; float ss = 0.f;
#pragma unroll
        for (int k = 0; k < 4; ++k) {
            v[2 * k] = bflo(ww[k]) * siluf(bflo(zw[k])); v[2 * k + 1] = bfhi(ww[k]) * siluf(bfhi(zw[k]));
            ss += v[2 * k] * v[2 * k] + v[2 * k + 1] * v[2 * k + 1];
        }
#pragma unroll
        for (int o = 16; o >= 1; o >>= 1) ss += __shfl_xor(ss, o);
        const float rr = rsqrtf(ss * (1.f / 256.f) + EPS);
        uint4 o4; o4.x = pack2(v[0] * rr, v[1] * rr); o4.y = pack2(v[2] * rr, v[3] * rr); o4.z = pack2(v[4] * rr, v[5] * rr); o4.w = pack2(v[6] * rr, v[7] * rr);
        *ptr = o4;
    }
}

template <bool RES_BF16>
struct EpiResid {
    bf16_t* pre; const void* res;
    float4 pf[RES_BF16 ? 1 : 16]; uint2 pb[RES_BF16 ? 16 : 1];
    DI void prefetch(int m0, int n0, int tid) {
        const int c4 = (tid & 31) * 4, r0 = tid >> 5;
#pragma unroll
        for (int ps = 0; ps < 16; ++ps) {
            const size_t idx = (size_t)(m0 + ps * 8 + r0) * 1024 + n0 + c4;
            if (RES_BF16) pb[ps] = *(const uint2*)((const bf16_t*)res + idx); else pf[ps] = *(const float4*)((const float*)res + idx);
        }
    }
    DI void operator()(const float* Cs, int m0, int n0, int tid) const {
        const int c4 = (tid & 31) * 4, r0 = tid >> 5;
#pragma unroll
        for (int ps = 0; ps < 16; ++ps) {
            const int row = ps * 8 + r0;
            const float4 v = cs4(Cs, row, c4);
            float4 rr;
            if (RES_BF16) rr = make_float4(bflo(pb[ps].x), bfhi(pb[ps].x), bflo(pb[ps].y), bfhi(pb[ps].y)); else rr = pf[ps];
            *(uint2*)(pre + (size_t)(m0 + row) * 1024 + n0 + c4) = pack4(make_float4(ALPHA * rr.x + v.x, ALPHA * rr.y + v.y, ALPHA * rr.z + v.z, ALPHA * rr.w + v.w));
        }
    }
};
DI void phase_wout(const P& p, int bid, int nb, unsigned char* smem) {
    const int v = vbid(bid, nb);
    EpiResid<true> e; e.pre = (bf16_t*)p.out; e.res = p.out;
    GemmArgs g{(const bf16_t*)(p.ws + MIX), 1024, (const bf16_t*)(p.ws + W_OUT), 1024, 1024, nullptr};
    for (int t = v; t < 256 * 8; t += nb) gemm_tile(g, (t >> 3) * 128, (t & 7) * 128, e, smem);
}
DI void ln_row(const float* src, const float* gam, const float* bet, int lane, float (&o)[16]) {
    float v[16];
#pragma unroll
    for (int i = 0; i < 4; ++i) { const float4 t4 = *(const float4*)(src + i * 256 + lane * 4); v[4 * i] = t4.x; v[4 * i + 1] = t4.y; v[4 * i + 2] = t4.z; v[4 * i + 3] = t4.w; }
    float s = 0.f;
#pragma unroll
    for (int i = 0; i < 16; ++i) s += v[i];
    const float mu = wave_sum(s) * (1.f / 1024.f);
    float q = 0.f;
#pragma unroll
    for (int i = 0; i < 16; ++i) { const float d = v[i] - mu; q += d * d; }
    const float rstd = rsqrtf(wave_sum(q) * (1.f / 1024.f) + EPS);
#pragma unroll
    for (int i = 0; i < 4; ++i) {
        const float4 g4 = *(const float4*)(gam + i * 256 + lane * 4), b4 = *(const float4*)(bet + i * 256 + lane * 4);
        o[4 * i] = (v[4 * i] - mu) * rstd * g4.x + b4.x; o[4 * i + 1] = (v[4 * i + 1] - mu) * rstd * g4.y + b4.y;
        o[4 * i + 2] = (v[4 * i + 2] - mu) * rstd * g4.z + b4.z; o[4 * i + 3] = (v[4 * i + 3] - mu) * rstd * g4.w + b4.w;
    }
}
DI void ln_stats2(const float (&va)[16], const float (&vb)[16], float& mua, float& rsa, float& mub, float& rsb) {
    float sa = 0.f, sb = 0.f;
#pragma unroll
    for (int i = 0; i < 16; ++i) { sa += va[i]; sb += vb[i]; }
#pragma unroll
    for (int o = 32; o >= 1; o >>= 1) { sa += __shfl_xor(sa, o); sb += __shfl_xor(sb, o); }
    mua = sa * (1.f / 1024.f); mub = sb * (1.f / 1024.f);
    float qa = 0.f, qb = 0.f;
#pragma unroll
    for (int i = 0; i < 16; ++i) { const float da = va[i] - mua, db = vb[i] - mub; qa += da * da; qb += db * db; }
#pragma unroll
    for (int o = 32; o >= 1; o >>= 1) { qa += __shfl_xor(qa, o); qb += __shfl_xor(qb, o); }
    rsa = rsqrtf(qa * (1.f / 1024.f) + EPS); rsb = rsqrtf(qb * (1.f / 1024.f) + EPS);
}
DI void load_row16(const bf16_t* src, int lane, float (&v)[16]) {
#pragma unroll
    for (int i = 0; i < 4; ++i) { const uint2 t2 = *(const uint2*)(src + i * 256 + lane * 4); v[4 * i] = bflo(t2.x); v[4 * i + 1] = bfhi(t2.x); v[4 * i + 2] = bflo(t2.y); v[4 * i + 3] = bfhi(t2.y); }
}
DI void phase_ln1(const P& p, int bid, int nb, unsigned char* smem) {
    const int lane = tidx() & 63, wave = tidx() >> 6;
    const bf16_t* pre = (const bf16_t*)p.out; bf16_t* hb = (bf16_t*)(p.ws + H1B);
    const float* gam = p.in[14]; const float* bet = p.in[15];
    for (int tk = bid * 4 + wave; tk < T; tk += nb * 8) {
        const int tk2 = tk + nb * 4;
        float va[16], vb[16], mua, rsa, mub, rsb;
        load_row16(pre + (size_t)tk * 1024, lane, va); load_row16(pre + (size_t)tk2 * 1024, lane, vb);
        ln_stats2(va, vb, mua, rsa, mub, rsb);
#pragma unroll
        for (int i = 0; i < 4; ++i) {
            const float4 g4 = *(const float4*)(gam + i * 256 + lane * 4), b4 = *(const float4*)(bet + i * 256 + lane * 4);
            const float4 oa = make_float4((va[4 * i] - mua) * rsa * g4.x + b4.x, (va[4 * i + 1] - mua) * rsa * g4.y + b4.y, (va[4 * i + 2] - mua) * rsa * g4.z + b4.z, (va[4 * i + 3] - mua) * rsa * g4.w + b4.w);
            const float4 ob = make_float4((vb[4 * i] - mub) * rsb * g4.x + b4.x, (vb[4 * i + 1] - mub) * rsb * g4.y + b4.y, (vb[4 * i + 2] - mub) * rsb * g4.z + b4.z, (vb[4 * i + 3] - mub) * rsb * g4.w + b4.w);
            *(uint2*)(hb + (size_t)tk * 1024 + i * 256 + lane * 4) = pack4(oa); *(uint2*)(hb + (size_t)tk2 * 1024 + i * 256 + lane * 4) = pack4(ob);
        }
    }
}
struct EpiXq {
    bf16_t* qx;
    DI void prefetch(int, int, int) {}
    DI void operator()(const float* Cs, int m0, int n0, int tid) const {
        const int c4 = (tid & 31) * 4, r0 = tid >> 5, hd = n0 >> 8, d = (n0 & 255) + c4, b = m0 >> 11, s0 = m0 & 2047;
#pragma unroll 4
        for (int ps = 0; ps < 16; ++ps) {
            const int row = ps * 8 + r0;
            float4 v = cs4(Cs, row, c4); v.x *= XSCALE; v.y *= XSCALE; v.z *= XSCALE; v.w *= XSCALE;
            *(uint2*)(qx + ((size_t)(b * 4 + hd) * 2048 + s0 + row) * 256 + d) = pack4(v);
        }
    }
};
DI void phase_xq(const P& p, int bid, int nb, unsigned char* smem) {
    const int v = vbid(bid, nb);
    EpiXq e{(bf16_t*)(p.ws + QX)};
    GemmArgs g{(const bf16_t*)(p.ws + H1B), 1024, (const bf16_t*)(p.ws + W_XQ), 1024, 1024, nullptr};
    for (int t = v; t < 256 * 8; t += nb) gemm_tile(g, (t >> 3) * 128, (t & 7) * 128, e, smem);
}
DI void phase_xattn(const P& p, int bid, int nb, unsigned char* smem, int rep = 0) {
#if !XATTN_NAIVE
    xattn_fast(p, bid, nb, smem, rep); return;
#endif
    unsigned char* ws = p.ws;
    const bf16_t* qx = (const bf16_t*)(ws + QX); const bf16_t* kx = (const bf16_t*)(ws + KX); const bf16_t* vxt = (const bf16_t*)(ws + VXT);
    bf16_t* ox = (bf16_t*)(ws + OX);
    const int lane = tidx() & 63, hd = tidx() >> 6;
    float* qs = (float*)smem + hd * 512; float* ps = qs + 256;
    for (int tk = bid; tk < T; tk += nb) {
        const int b = tk >> 11, s_ = tk & 2047;
        __syncthreads();
        {
            const uint2 w = *(const uint2*)(qx + ((size_t)(b * 4 + hd) * 2048 + s_) * 256 + lane * 4);
            qs[lane * 4] = bflo(w.x); qs[lane * 4 + 1] = bfhi(w.x); qs[lane * 4 + 2] = bflo(w.y); qs[lane * 4 + 3] = bfhi(w.y);
        }
        __syncthreads();
        float sc[4];
#pragma unroll
        for (int i = 0; i < 4; ++i) {
            const int m = lane + 64 * i;
            const uint4* k4 = (const uint4*)(kx + ((size_t)(b * 4 + hd) * 256 + m) * 256);
            float a = 0.f;
#pragma unroll 8
            for (int c = 0; c < 32; ++c) {
                const uint4 w = k4[c];
                const float4 q0 = *(const float4*)(qs + 8 * c), q1 = *(const float4*)(qs + 8 * c + 4);
                a += q0.x * bflo(w.x) + q0.y * bfhi(w.x) + q0.z * bflo(w.y) + q0.w * bfhi(w.y) + q1.x * bflo(w.z) + q1.y * bfhi(w.z) + q1.z * bflo(w.w) + q1.w * bfhi(w.w);
            }
            sc[i] = a;
        }
        const float mx = wave_max(fmaxf(fmaxf(sc[0], sc[1]), fmaxf(sc[2], sc[3])));
        float sum = 0.f;
#pragma unroll
        for (int i = 0; i < 4; ++i) { sc[i] = exp2f(sc[i] - mx); sum += sc[i]; }
        const float il = 1.f / wave_sum(sum);
#pragma unroll
        for (int i = 0; i < 4; ++i) ps[lane + 64 * i] = sc[i] * il;
        __syncthreads();
        float o[4];
#pragma unroll
        for (int dd = 0; dd < 4; ++dd) {
            const int d = lane * 4 + dd;
            const uint4* v4 = (const uint4*)(vxt + ((size_t)(b * 4 + hd) * 256 + d) * 256);
            float a = 0.f;
#pragma unroll 8
            for (int c = 0; c < 32; ++c) {
                const uint4 w = v4[c];
                const float4 q0 = *(const float4*)(ps + 8 * c), q1 = *(const float4*)(ps + 8 * c + 4);
                a += q0.x * bflo(w.x) + q0.y * bfhi(w.x) + q0.z * bflo(w.y) + q0.w * bfhi(w.y) + q1.x * bflo(w.z) + q1.y * bfhi(w.z) + q1.z * bflo(w.w) + q1.w * bfhi(w.w);
            }
            o[dd] = a;
        }
        uint2 w; w.x = pack2(o[0], o[1]); w.y = pack2(o[2], o[3]);
        *(uint2*)(ox + (size_t)tk * 1024 + hd * 256 + lane * 4) = w;
    }
}
DI void phase_xo(const P& p, int bid, int nb, unsigned char* smem) {
    const int v = vbid(bid, nb);
    EpiResid<true> e; e.pre = (bf16_t*)p.out; e.res = p.ws + H1B;
    GemmArgs g{(const bf16_t*)(p.ws + OX), 1024, (const bf16_t*)(p.ws + W_XO), 1024, 1024, nullptr};
    for (int t = v; t < 256 * 8; t += nb) gemm_tile(g, (t >> 3) * 128, (t & 7) * 128, e, smem);
}
typedef float f32x4v __attribute__((ext_vector_type(4)));
DI void phase_ln2_router(const P& p, int bid, int nb, unsigned char* smem, int rep = 0) {
    unsigned char* ws = p.ws;
    const int lane = tidx() & 63, wave = tidx() >> 6;
    const bf16_t* pre = (const bf16_t*)p.out; bf16_t* hb = (bf16_t*)(ws + H2B);
    const float* wrt = (const float*)(ws + W_RT);
    const float* gam = p.in[20]; const float* bet = p.in[21];
    unsigned* cnt = (unsigned*)(ws + CTL + CTL_CNT); int* lists = (int*)(ws + LISTS); float* tgate = (float*)(ws + TOK_GATE);
    float* lg = (float*)smem + wave * (16 * 52 + 32);
    float* stt = lg + 16 * 52;
    for (int grp = bid; grp < T / 64; grp += nb) {
        const int t0 = grp * 64 + wave * 16;
        for (int rr = 0; rr < 16; rr += 2) {
            if (rep && REP_MODE == 3) break;
            const int tk = t0 + rr;
            float va[16], vb[16], mua, rsa, mub, rsb;
            load_row16(pre + (size_t)tk * 1024, lane, va); load_row16(pre + (size_t)(tk + 1) * 1024, lane, vb);
            ln_stats2(va, vb, mua, rsa, mub, rsb);
            if (lane == 0) { stt[2 * rr] = mua; stt[2 * rr + 1] = rsa; stt[2 * rr + 2] = mub; stt[2 * rr + 3] = rsb; }
#pragma unroll
            for (int i = 0; i < 4; ++i) {
                const float4 g4 = *(const float4*)(gam + i * 256 + lane * 4), b4 = *(const float4*)(bet + i * 256 + lane * 4);
                const float4 oa = make_float4((va[4 * i] - mua) * rsa * g4.x + b4.x, (va[4 * i + 1] - mua) * rsa * g4.y + b4.y, (va[4 * i + 2] - mua) * rsa * g4.z + b4.z, (va[4 * i + 3] - mua) * rsa * g4.w + b4.w);
                const float4 ob = make_float4((vb[4 * i] - mub) * rsb * g4.x + b4.x, (vb[4 * i + 1] - mub) * rsb * g4.y + b4.y, (vb[4 * i + 2] - mub) * rsb * g4.z + b4.z, (vb[4 * i + 3] - mub) * rsb * g4.w + b4.w);
                *(uint2*)(hb + (size_t)tk * 1024 + i * 256 + lane * 4) = pack4(oa); *(uint2*)(hb + (size_t)(tk + 1) * 1024 + i * 256 + lane * 4) = pack4(ob);
            }
        }
        __builtin_amdgcn_wave_barrier();
        if (!(rep && REP_MODE == 2)) {
            const int i16 = lane & 15, g4i = lane >> 4;
            const float mu = stt[2 * i16], rstd = stt[2 * i16 + 1];
            const bf16_t* arow = pre + (size_t)(t0 + i16) * 1024 + 4 * g4i;
            const float* brow = wrt + (size_t)i16 * 1024 + 4 * g4i;
            const float* grow = gam + 4 * g4i; const float* berow = bet + 4 * g4i;
            f32x4v acc0 = {0.f, 0.f, 0.f, 0.f}, acc1 = acc0, acc2 = acc0;
#pragma unroll 4
            for (int S = 0; S < 64; ++S) {
                const uint2 xw = *(const uint2*)(arow + 16 * S); const float4 x4 = make_float4(bflo(xw.x), bfhi(xw.x), bflo(xw.y), bfhi(xw.y));
                const float4 g4 = *(const float4*)(grow + 16 * S), e4 = *(const float4*)(berow + 16 * S);
                const float4 b0 = *(const float4*)(brow + 16 * S), b1 = *(const float4*)(brow + 16 * 1024 + 16 * S), b2 = *(const float4*)(brow + 32 * 1024 + 16 * S);
                const float a0 = (x4.x - mu) * rstd * g4.x + e4.x, a1 = (x4.y - mu) * rstd * g4.y + e4.y, a2 = (x4.z - mu) * rstd * g4.z + e4.z, a3 = (x4.w - mu) * rstd * g4.w + e4.w;
                acc0 = __builtin_amdgcn_mfma_f32_16x16x4f32(a0, b0.x, acc0, 0, 0, 0); acc1 = __builtin_amdgcn_mfma_f32_16x16x4f32(a0, b1.x, acc1, 0, 0, 0); acc2 = __builtin_amdgcn_mfma_f32_16x16x4f32(a0, b2.x, acc2, 0, 0, 0);
                acc0 = __builtin_amdgcn_mfma_f32_16x16x4f32(a1, b0.y, acc0, 0, 0, 0); acc1 = __builtin_amdgcn_mfma_f32_16x16x4f32(a1, b1.y, acc1, 0, 0, 0); acc2 = __builtin_amdgcn_mfma_f32_16x16x4f32(a1, b2.y, acc2, 0, 0, 0);
                acc0 = __builtin_amdgcn_mfma_f32_16x16x4f32(a2, b0.z, acc0, 0, 0, 0); acc1 = __builtin_amdgcn_mfma_f32_16x16x4f32(a2, b1.z, acc1, 0, 0, 0); acc2 = __builtin_amdgcn_mfma_f32_16x16x4f32(a2, b2.z, acc2, 0, 0, 0);
                acc0 = __builtin_amdgcn_mfma_f32_16x16x4f32(a3, b0.w, acc0, 0, 0, 0); acc1 = __builtin_amdgcn_mfma_f32_16x16x4f32(a3, b1.w, acc1, 0, 0, 0); acc2 = __builtin_amdgcn_mfma_f32_16x16x4f32(a3, b2.w, acc2, 0, 0, 0);
            }
#pragma unroll
            for (int e = 0; e < 4; ++e) {
                float* rowp = lg + (4 * g4i + e) * 52 + i16;
                rowp[0] = acc0[e]; rowp[16] = acc1[e]; rowp[32] = acc2[e];
            }
        }
        __builtin_amdgcn_wave_barrier();
        unsigned* lcount = (unsigned*)((float*)smem + 4 * (16 * 52 + 32));
        unsigned* lbase = lcount + 32;
        if (tidx() < 32) lcount[tidx()] = 0u;
        __syncthreads();
        int ex1 = 0, ex2 = 0; unsigned lp1 = 0, lp2 = 0;
        if (lane < 16) {
            const int tk = t0 + lane;
            const float* lr = lg + lane * 52;
            float gl[4], el[32];
#pragma unroll
            for (int j = 0; j < 4; ++j) gl[j] = lr[j] + p.in[23][j];
#pragma unroll
            for (int j = 0; j < 32; ++j) el[j] = lr[4 + j] + p.in[25][j];
            int gi = 0; float gm = gl[0];
#pragma unroll
            for (int j = 1; j < 4; ++j) if (gl[j] > gm) { gm = gl[j]; gi = j; }
            float gs = 0.f;
#pragma unroll
            for (int j = 0; j < 4; ++j) gs += __expf(gl[j] - gm);
            const float ggate = 1.f / gs;
            float ev[8];
#pragma unroll
            for (int j = 0; j < 8; ++j) ev[j] = gi == 0 ? el[j] : gi == 1 ? el[8 + j] : gi == 2 ? el[16 + j] : el[24 + j];
            int i1 = 0; float v1 = ev[0];
#pragma unroll
            for (int j = 1; j < 8; ++j) if (ev[j] > v1) { v1 = ev[j]; i1 = j; }
            int i2 = -1; float v2 = -3.0e38f;
#pragma unroll
            for (int j = 0; j < 8; ++j) if (j != i1 && ev[j] > v2) { v2 = ev[j]; i2 = j; }
            const float e2 = __expf(v2 - v1);
            tgate[tk * 2] = ggate / (1.f + e2); tgate[tk * 2 + 1] = ggate * e2 / (1.f + e2);
            ex1 = gi * 8 + i1; ex2 = gi * 8 + i2;
            if (!rep) { lp1 = atomicAdd(&lcount[ex1], 1u); lp2 = atomicAdd(&lcount[ex2], 1u); }
        }
        __syncthreads();
        if (tidx() < 32 && !rep) { const unsigned c = lcount[tidx()]; lbase[tidx()] = c ? atomicAdd(&cnt[tidx() * CNT_STRIDE], c) : 0u; }
        __syncthreads();
        if (lane < 16 && !rep) {
            const int tk = t0 + lane;
            lists[(size_t)ex1 * T + lbase[ex1] + lp1] = tk * 2;
            lists[(size_t)ex2 * T + lbase[ex2] + lp2] = tk * 2 + 1;
        }
        __syncthreads();
    }
}
struct MoeMap { int off[33]; };
DI int moe_tiles(const unsigned* cnt, int* offs  ) {
    __syncthreads();
    if (tidx() == 0) { int o = 0; for (int e = 0; e < 32; ++e) { offs[e] = o; o += (((int)cnt[e * CNT_STRIDE] + 127) >> 7) << 7; } offs[32] = o; }
    __syncthreads();
    return offs[32] >> 7;
}
struct EpiGU {
    bf16_t* hdn;
    DI void prefetch(int, int, int) {}
    DI void operator()(const float* Cs, int m0, int n0, int tid) const {
#pragma unroll 4
        for (int ps = 0; ps < 8; ++ps) {
            const int it = ps * 256 + tid, row = it >> 4, qd = it & 15, c = (qd >> 3) * 64 + (qd & 7) * 4;
            const float4 g = cs4(Cs, row, c), u = cs4(Cs, row, c + 32);
            const int hc = ((n0 & 511) >> 7) * 64 + (qd >> 3) * 32 + (qd & 7) * 4;
            *(uint2*)(hdn + (size_t)(m0 + row) * 256 + hc) = pack4(make_float4(siluf(g.x) * u.x, siluf(g.y) * u.y, siluf(g.z) * u.z, siluf(g.w) * u.w));
        }
    }
};
struct EpiDown {
    bf16_t* y; int* ltok; float* lgate; const int* lst; int nvalid; const float* tgate;
    DI void prefetch(int, int, int tid) {
        if (tid < 128) { const int tk2 = tid < nvalid ? lst[tid] : -1; ltok[tid] = tk2; lgate[tid] = tk2 < 0 ? 0.f : tgate[tk2]; }
    }
    DI void operator()(const float* Cs, int m0, int n0, int tid) const {
        const int c4 = (tid & 31) * 4, r0 = tid >> 5;
#pragma unroll 4
        for (int ps = 0; ps < 16; ++ps) {
            const int row = ps * 8 + r0, tk2 = ltok[row];
            if (tk2 >= 0) {
                const float gt = lgate[row];
                float4 v = cs4(Cs, row, c4); v.x *= gt; v.y *= gt; v.z *= gt; v.w *= gt;
                *(uint2*)(y + (size_t)tk2 * 1024 + n0 + c4) = pack4(v);
            }
        }
    }
};
template <int WHICH>
DI void phase_moe(const P& p, int bid, int nb, unsigned char* smem) {
    unsigned char* ws = p.ws;
    const unsigned* cnt = (const unsigned*)(ws + CTL + CTL_CNT); const int* lists = (const int*)(ws + LISTS); const float* tgate = (const float*)(ws + TOK_GATE);
    int* offs = (int*)(smem + GEMM_LDS); int* ltok = offs + 64; int* lrow = ltok + 128; float* lgate = (float*)(lrow + 128);
    const int nmt = moe_tiles(cnt, offs);
    constexpr int NNT = WHICH == 0 ? 4 : 8;
    const int v = vbid(bid, nb);
    for (int t = v; t < nmt * NNT; t += nb) {
        const int mt = t / NNT, ntl = t % NNT;
        const int slot0 = mt * 128;
        int e = 0;
        while (offs[e + 1] <= slot0) ++e;
        if (WHICH == 0) {
            __syncthreads();
            if (tidx() < 128) {
                const int pos = slot0 - offs[e] + tidx();
                const int tk2 = pos < (int)cnt[e * CNT_STRIDE] ? lists[(size_t)e * T + pos] : -1;
                lrow[tidx()] = tk2 < 0 ? 0 : (tk2 >> 1);
            }
            __syncthreads();
        }
        if (WHICH == 0) {
            EpiGU ep{(bf16_t*)(ws + HDN)};
            GemmArgs g{(const bf16_t*)(ws + H2B), 1024, (const bf16_t*)(ws + W_GU) + (size_t)e * 512 * 1024, 1024, 1024, lrow};
            gemm_tile(g, slot0, ntl * 128, ep, smem);
        } else {
            EpiDown ep{(bf16_t*)(ws + YB), ltok, lgate, lists + (size_t)e * T + (slot0 - offs[e]), (int)cnt[e * CNT_STRIDE] - (slot0 - offs[e]), tgate};
            GemmArgs g{(const bf16_t*)(ws + HDN), 256, (const bf16_t*)(ws + W_DN) + (size_t)e * 1024 * 256, 256, 256, nullptr};
            gemm_tile(g, slot0, ntl * 128, ep, smem);
        }
    }
}
DI void phase_final(const P& p, int bid, int nb, unsigned char* smem) {
    const int lane = tidx() & 63, wave = tidx() >> 6;
    const bf16_t* hb2 = (const bf16_t*)(p.ws + H2B); const bf16_t* y = (const bf16_t*)(p.ws + YB);
    const float* gam = p.in[29]; const float* bet = p.in[30];
    for (int tk = bid * 4 + wave; tk < T; tk += nb * 8) {
        const int tk2 = tk + nb * 4;
        float va[16], vb[16], mua, rsa, mub, rsb;
#pragma unroll
        for (int i = 0; i < 4; ++i) {
            const uint2 ha = *(const uint2*)(hb2 + (size_t)tk * 1024 + i * 256 + lane * 4), hbv = *(const uint2*)(hb2 + (size_t)tk2 * 1024 + i * 256 + lane * 4);
            const float4 ta = make_float4(bflo(ha.x), bfhi(ha.x), bflo(ha.y), bfhi(ha.y)), tb = make_float4(bflo(hbv.x), bfhi(hbv.x), bflo(hbv.y), bfhi(hbv.y));
            const uint2 a0 = *(const uint2*)(y + (size_t)(tk * 2) * 1024 + i * 256 + lane * 4), a1 = *(const uint2*)(y + (size_t)(tk * 2 + 1) * 1024 + i * 256 + lane * 4);
            const uint2 b0 = *(const uint2*)(y + (size_t)(tk2 * 2) * 1024 + i * 256 + lane * 4), b1 = *(const uint2*)(y + (size_t)(tk2 * 2 + 1) * 1024 + i * 256 + lane * 4);
            va[4 * i] = ALPHA * ta.x + bflo(a0.x) + bflo(a1.x); va[4 * i + 1] = ALPHA * ta.y + bfhi(a0.x) + bfhi(a1.x); va[4 * i + 2] = ALPHA * ta.z + bflo(a0.y) + bflo(a1.y); va[4 * i + 3] = ALPHA * ta.w + bfhi(a0.y) + bfhi(a1.y);
            vb[4 * i] = ALPHA * tb.x + bflo(b0.x) + bflo(b1.x); vb[4 * i + 1] = ALPHA * tb.y + bfhi(b0.x) + bfhi(b1.x); vb[4 * i + 2] = ALPHA * tb.z + bflo(b0.y) + bflo(b1.y); vb[4 * i + 3] = ALPHA * tb.w + bfhi(b0.y) + bfhi(b1.y);
        }
        ln_stats2(va, vb, mua, rsa, mub, rsb);
#pragma unroll
        for (int i = 0; i < 4; ++i) {
            const float4 g4 = *(const float4*)(gam + i * 256 + lane * 4), b4 = *(const float4*)(bet + i * 256 + lane * 4);
            *(float4*)(p.out + (size_t)tk * 1024 + i * 256 + lane * 4) = make_float4((va[4 * i] - mua) * rsa * g4.x + b4.x, (va[4 * i + 1] - mua) * rsa * g4.y + b4.y, (va[4 * i + 2] - mua) * rsa * g4.z + b4.z, (va[4 * i + 3] - mua) * rsa * g4.w + b4.w);
            *(float4*)(p.out + (size_t)tk2 * 1024 + i * 256 + lane * 4) = make_float4((vb[4 * i] - mub) * rsb * g4.x + b4.x, (vb[4 * i + 1] - mub) * rsb * g4.y + b4.y, (vb[4 * i + 2] - mub) * rsb * g4.z + b4.z, (vb[4 * i + 3] - mub) * rsb * g4.w + b4.w);
        }
    }
}

#define XB_TMO      128
#define XB_XCNT(j)  (256  + 64 * (j))
#define XB_XSUB(j)  (1280 + 64 * (j))
#define XB_XGEN(j)  (2304 + 64 * (j))
#define XB_TOP      3328
#define XB_TOPGEN   3392
#define XCD_BAR_WORDS 3456
#define XB_SPIN_CAP (1u << 25)
DI unsigned xb_ld(unsigned* p) { return __hip_atomic_load(p, __ATOMIC_RELAXED, __HIP_MEMORY_SCOPE_AGENT); }
DI unsigned xb_add(unsigned* p, unsigned v) { return __hip_atomic_fetch_add(p, v, __ATOMIC_RELAXED, __HIP_MEMORY_SCOPE_AGENT); }
DI unsigned xb_xcc_id() { return (unsigned)__builtin_amdgcn_s_getreg((3 << 11) | 20) & 0xFu; }
#define XB_SPIN(cond, bar) do { unsigned _sp = 0; while (cond) { __builtin_amdgcn_s_sleep(1); \
    if ((++_sp & 255u) == 0u) { if (xb_ld(&(bar)[XB_TMO])) break; if (_sp > XB_SPIN_CAP) { atomicAdd(&(bar)[XB_TMO], 1u); break; } } } } while (0)
struct XcdBarrier { unsigned* bar; unsigned x; volatile LAS unsigned* st; };
DI XcdBarrier xcd_barrier_post(unsigned* bar, volatile LAS unsigned* st) {
    XcdBarrier b; b.bar = bar; b.x = xb_xcc_id(); b.st = st;
    if (threadIdx.x == 0) (void)xb_add(&bar[XB_XCNT(b.x)], 1u);
    return b;
}
DI void xcd_barrier_complete(unsigned* bar, unsigned x, unsigned& nloc, unsigned& nx) {
    const unsigned G = gridDim.x * gridDim.y * gridDim.z;
    unsigned sum, cnt, mine, sp = 0u;
    for (;;) {
        sum = 0u; cnt = 0u; mine = 0u;
#pragma unroll
        for (unsigned j = 0; j < 16; ++j) { const unsigned c = xb_ld(&bar[XB_XCNT(j)]); sum += c; cnt += (c > 0u) ? 1u : 0u; mine = (j == x) ? c : mine; }
        if (sum == G) break;
        __builtin_amdgcn_s_sleep(1);
        if ((++sp & 255u) == 0u) { if (xb_ld(&bar[XB_TMO])) break; if (sp > XB_SPIN_CAP) { atomicAdd(&bar[XB_TMO], 1u); break; } }
    }
    nloc = mine > 0u ? mine : 1u; nx = cnt > 0u ? cnt : 1u;
}
DI void xcd_barrier(const XcdBarrier& b) {
    asm volatile("s_waitcnt vmcnt(0)" ::: "memory");
    __syncthreads();
    if (threadIdx.x == 0) {
        unsigned* bar = b.bar;
        __builtin_amdgcn_s_waitcnt(0);
        unsigned nloc = b.st[0], nx = b.st[1];
        if (nloc == 0u) { xcd_barrier_complete(bar, b.x, nloc, nx); b.st[0] = nloc; b.st[1] = nx; }
        const unsigned old = xb_add(&bar[XB_XSUB(b.x)], 1u);
        const unsigned gen = old / nloc;
        if (old + 1u == (gen + 1u) * nloc) {
            __builtin_amdgcn_fence(__ATOMIC_RELEASE, "agent");
            asm volatile("s_waitcnt vmcnt(0)" ::: "memory");
            const unsigned og = xb_add(&bar[XB_TOP], 1u);
            const unsigned tg = og / nx;
            if (og + 1u == (tg + 1u) * nx) xb_add(&bar[XB_TOPGEN], 1u);
            else XB_SPIN(xb_ld(&bar[XB_TOPGEN]) == tg, bar);
            __builtin_amdgcn_fence(__ATOMIC_ACQUIRE, "agent");
            xb_add(&bar[XB_XGEN(b.x)], 1u);
            asm volatile("s_waitcnt vmcnt(0)" ::: "memory");
        } else {
            XB_SPIN(xb_ld(&bar[XB_XGEN(b.x)]) == gen, bar);
            __builtin_amdgcn_fence(__ATOMIC_ACQUIRE, "agent");
            asm volatile("s_waitcnt vmcnt(0)" ::: "memory");
        }
    }
    __syncthreads();
}

constexpr int NPHASE = 14;
template <int PH>
DI void run_phase(const P& p, int bid, int nb, unsigned char* smem, int rep = 0) {
    if (PH == 0) phase_prep(p, bid, nb, smem);
    else if (PH == 1) phase_proj(p, bid, nb, smem, rep);
    else if (PH == 2) phase_up(p, bid, nb, smem, rep);
    else if (PH == 3) phase_mixer(p, bid, nb, smem, rep);
    else if (PH == 4) phase_ssdnorm(p, bid, nb, smem);
    else if (PH == 5) phase_wout(p, bid, nb, smem);
    else if (PH == 6) phase_ln1(p, bid, nb, smem);
    else if (PH == 7) phase_xq(p, bid, nb, smem);
    else if (PH == 8) phase_xattn(p, bid, nb, smem, rep);
    else if (PH == 9) phase_xo(p, bid, nb, smem);
    else if (PH == 10) phase_ln2_router(p, bid, nb, smem, rep);
    else if (PH == 11) phase_moe<0>(p, bid, nb, smem);
    else if (PH == 12) phase_moe<1>(p, bid, nb, smem);
    else if (PH == 13) phase_final(p, bid, nb, smem);
}
template <int PH>
__global__ void __launch_bounds__(256, 2) k_phase(P p) {
    __shared__ __attribute__((aligned(16))) unsigned char smem[SMEM_BYTES];
    run_phase<PH>(p, blockIdx.x, gridDim.x, smem);
}

#if MEGA
#ifndef MEGA_WAVES
#define MEGA_WAVES 2
#endif
template <int PH>
DI void mega_steps(const P& p, const XcdBarrier& bar, unsigned char* smem) {
    run_phase<PH>(p, blockIdx.x, gridDim.x, smem);
    if constexpr (((REPEAT_MASK >> PH) & 1) != 0) { xcd_barrier(bar); run_phase<PH>(p, blockIdx.x, gridDim.x, smem, 1); }
    if constexpr (PH == 6 && EXTRA_BARRIERS > 0) { for (int i = 0; i < EXTRA_BARRIERS; ++i) xcd_barrier(bar); }
    if constexpr (PH + 1 < NPHASE) { xcd_barrier(bar); mega_steps<PH + 1>(p, bar, smem); }
}
__global__ void __launch_bounds__(256, MEGA_WAVES) k_mega(P p) {
    __shared__ __attribute__((aligned(16))) unsigned char smem[SMEM_BYTES];
    volatile LAS unsigned* st = (volatile LAS unsigned*)(smem + SMEM_BYTES - 16);
    if (threadIdx.x < 4) st[threadIdx.x] = 0u;
    __syncthreads();
    const XcdBarrier bar = xcd_barrier_post((unsigned*)(p.ws + CTL), st);
    mega_steps<0>(p, bar, smem);
}
#endif
template <int PH>
__global__ void __launch_bounds__(256, 1) k_phase_big(P p) {
    __shared__ __attribute__((aligned(16))) unsigned char smem[SMEM_BYTES];
    run_phase<PH>(p, blockIdx.x, gridDim.x, smem);
}
template <int PH>
static void launch_phase(const P& p, int grid, hipStream_t st) {
    if constexpr (PH == 3 && !P3_SMALL) hipLaunchKernelGGL((k_phase_big<PH>), dim3(grid), dim3(256), 0, st, p);
    else hipLaunchKernelGGL((k_phase<PH>), dim3(grid), dim3(256), 0, st, p);
}

extern "C" void kernel_launch(void* const* d_in, const int* in_sizes, int n_in, void* d_out, int out_size, void* d_ws, size_t ws_size, hipStream_t stream) {
    if (n_in != 31 || out_size != T * D || ws_size < WS_NEED) {
        fprintf(stderr, "kernel_launch: unexpected shapes: n_in %d out %d ws %zu (need %zu)\n", n_in, out_size, ws_size, (size_t)WS_NEED);
        return;
    }
    P p{};
    for (int i = 0; i < 31; ++i) p.in[i] = (const float*)d_in[i];
    p.out = (float*)d_out; p.ws = (unsigned char*)d_ws;
    (void)hipMemsetAsync((unsigned char*)d_ws + CTL, 0, CTL_BYTES, stream);
#if MEGA
    static int grid = 0;
    if (grid == 0) {
        int dev = 0, cus = 0, per_cu = 0;
        (void)hipGetDevice(&dev);
        (void)hipDeviceGetAttribute(&cus, hipDeviceAttributeMultiprocessorCount, dev);
        if (hipOccupancyMaxActiveBlocksPerMultiprocessor(&per_cu, (const void*)k_mega, 256, 0) != hipSuccess || per_cu < 1) { fprintf(stderr, "kernel_launch: occupancy query failed\n"); per_cu = 1; }
        if (per_cu > 2) per_cu = 2;
        grid = cus * per_cu;
        fprintf(stderr, "kernel_launch: mega grid %d (%d CUs x %d)\n", grid, cus, per_cu);
    }
    void* args[] = {(void*)&p};
    const hipError_t le = hipLaunchCooperativeKernel((const void*)k_mega, dim3(grid), dim3(256), args, 0, stream);
    if (le != hipSuccess) fprintf(stderr, "kernel_launch: cooperative launch failed: %s (grid %d)\n", hipGetErrorString(le), grid);
#else
    const int grid = 1024;
    launch_phase<0>(p, grid, stream); launch_phase<1>(p, grid, stream); launch_phase<2>(p, grid, stream); launch_phase<3>(p, grid, stream);
    launch_phase<4>(p, grid, stream); launch_phase<5>(p, grid, stream); launch_phase<6>(p, grid, stream); launch_phase<7>(p, grid, stream);
    launch_phase<8>(p, grid, stream); launch_phase<9>(p, grid, stream); launch_phase<10>(p, grid, stream); launch_phase<11>(p, grid, stream);
    launch_phase<12>(p, grid, stream); launch_phase<13>(p, grid, stream);
#endif
}
```

```cpp
#include <hip/hip_runtime.h>
#include <stdint.h>
#include <stdio.h>

#ifndef MEGA
#define MEGA 1
#endif
#ifndef ATTN_NAIVE
#define ATTN_NAIVE 0
#endif
#ifndef XATTN_NAIVE
#define XATTN_NAIVE 0
#endif
#ifndef SSD_NAIVE
#define SSD_NAIVE 0
#endif
#ifndef P3_SMALL
#define P3_SMALL 1
#endif
#ifndef NO_SSD
#define NO_SSD 0
#endif
#ifndef NO_FLASH
#define NO_FLASH 0
#endif
#ifndef GEMM_GLDS
#define GEMM_GLDS 1
#endif
#ifndef EXTRA_BARRIERS
#define EXTRA_BARRIERS 0
#endif
#ifndef SSD_PM
#define SSD_PM 0
#endif
#ifndef REPEAT_MASK
#define REPEAT_MASK 0
#endif
#ifndef REP_MODE
#define REP_MODE 0
#endif
#ifndef MFMA16
#define MFMA16 1
#endif
#ifndef GEMM_DIRECT
#define GEMM_DIRECT 0
#endif

typedef unsigned short bf16_t;
typedef short bf16x8 __attribute__((ext_vector_type(8)));
typedef float f32x16 __attribute__((ext_vector_type(16)));
typedef float f32x4v __attribute__((ext_vector_type(4)));
#define DI __device__ __forceinline__
#define LAS __attribute__((address_space(3)))
#define MFMA32(a, b, c) __builtin_amdgcn_mfma_f32_32x32x16_bf16((a), (b), (c), 0, 0, 0)

constexpr int Bn = 16, S = 2048, T = Bn * S, D = 1024;
constexpr int NMEM = 256;
constexpr float EPS = 1e-5f;
constexpr float ALPHA = 1.189207115002721f;
constexpr float LOG2E = 1.4426950408889634f;
constexpr float QSCALE = 0.10206207261596577f * LOG2E;
constexpr float XSCALE = 0.0625f * LOG2E;
constexpr int NEXP = 32;
constexpr int MAXSLOTS = 69632;

constexpr size_t MiB = 1u << 20;
constexpr size_t W_IN = 0;
constexpr size_t W_QUP = W_IN + 4 * MiB;
constexpr size_t W_KVUP = W_QUP + 768 * 256 * 2;
constexpr size_t W_OUT = W_KVUP + 1024 * 128 * 2;
constexpr size_t W_XQ = W_OUT + 2 * MiB;
constexpr size_t W_XKV = W_XQ + 2 * MiB;
constexpr size_t W_XO = W_XKV + 4 * MiB;
constexpr size_t W_GU = W_XO + 2 * MiB;
constexpr size_t W_DN = W_GU + 32 * MiB;
constexpr size_t W_RT = W_DN + 16 * MiB;
constexpr size_t ROPE_C = W_RT + 48 * 1024 * 4;
constexpr size_t ROPE_S = ROPE_C + 2048 * 16 * 4;
constexpr size_t TOK_GATE = ROPE_S + 2048 * 16 * 4;
constexpr size_t CTL = TOK_GATE + (size_t)T * 2 * 4;
constexpr size_t CTL_BYTES = 32768;
constexpr size_t CTL_CNT = 16384;
constexpr int CNT_STRIDE = 64;
constexpr size_t CTL_QUEUE = 28672;
static_assert(CTL + CTL_BYTES <= 64 * MiB, "weights region overflow");
constexpr size_t RA = 64 * MiB, RB = 192 * MiB, RC = 320 * MiB, RD = 448 * MiB, WS_NEED = 512 * MiB;
constexpr size_t XBC = RA;
constexpr size_t KX = RA + 64 * MiB;
constexpr size_t VXT = KX + 8 * MiB;
constexpr size_t YB = RA;
constexpr size_t QB = RB;
constexpr size_t KNB = RB + 48 * MiB;
constexpr size_t VTB = KNB + 32 * MiB;
constexpr size_t H1 = RB;
constexpr size_t H2 = RB;
constexpr size_t XB = RC;
constexpr size_t MEMB = RB;
constexpr size_t XBCA = RC;
constexpr size_t MIX = RC + 64 * MiB;
constexpr size_t H1B = RC;
constexpr size_t QX = RC + 64 * MiB;
constexpr size_t OX = RB;
constexpr size_t H2B = RC;
constexpr size_t HDN = RC + 64 * MiB;
constexpr size_t CQ = RD;
constexpr size_t CKV = CQ + 16 * MiB;
constexpr size_t KROPE = CKV + 8 * MiB;
constexpr size_t DTB = KROPE + 2 * MiB;
constexpr size_t ZB = DTB + 1 * MiB;
constexpr size_t SSQ = ZB + 32 * MiB;
constexpr size_t LISTS = RD;
static_assert(SSQ + 3 * (size_t)T * 4 <= WS_NEED, "region D overflow");

struct P {
    const float* in[31];
    float* out;
    unsigned char* ws;
};

typedef __bf16 hbf16x2 __attribute__((ext_vector_type(2)));
typedef float f32x2 __attribute__((ext_vector_type(2)));
DI bf16_t f2bf(float x) { return __builtin_bit_cast(bf16_t, (__bf16)x); }
DI float bf2f(bf16_t b) { return __uint_as_float(((unsigned)b) << 16); }
DI float bflo(unsigned w) { return __uint_as_float(w << 16); }
DI float bfhi(unsigned w) { return __uint_as_float(w & 0xffff0000u); }
DI unsigned pack2(float a, float b) { f32x2 v = {a, b}; return __builtin_bit_cast(unsigned, __builtin_convertvector(v, hbf16x2)); }
DI float siluf(float x) { return x * __builtin_amdgcn_rcpf(1.f + __expf(-x)); }
DI float softplusf(float x) {
    const float zz = __expf(-fabsf(x));
    const float l1p = zz < 0.01f ? zz * (1.f - zz * (0.5f - zz * (1.f / 3.f))) : __logf(1.f + zz);
    return fmaxf(x, 0.f) + l1p;
}
DI int tidx() { int t = __builtin_amdgcn_workitem_id_x(); asm volatile("" : "+v"(t)); return t; }
DI int crow(int reg, int h) { return (reg & 3) + 8 * (reg >> 2) + 4 * h; }
constexpr int CS_LD = 132;
DI float4 cs4(const float* Cs, int row, int col) { return *(const float4*)(Cs + row * CS_LD + col); }
DI uint2 pack4(float4 v) { uint2 w; w.x = pack2(v.x, v.y); w.y = pack2(v.z, v.w); return w; }
DI float wave_sum(float v) {
#pragma unroll
    for (int o = 32; o >= 1; o >>= 1) v += __shfl_xor(v, o);
    return v;
}
DI float wave_max(float v) {
#pragma unroll
    for (int o = 32; o >= 1; o >>= 1) v = fmaxf(v, __shfl_xor(v, o));
    return v;
}

constexpr int LDS_ROW = 144;
constexpr int TILE_BYTES = 128 * LDS_ROW;
constexpr int GEMM_LDS = 4 * TILE_BYTES;
constexpr int SMEM_BYTES = GEMM_LDS + 3072;
static_assert(128 * CS_LD * 4 <= GEMM_LDS, "epilogue tile");

struct GemmArgs {
    const bf16_t* A; int lda;
    const bf16_t* Bt; int ldb;
    int K;
    const int* lrows;
};

template <class Epi>
DI void gemm_tile(const GemmArgs& g, int m0, int n0, Epi& epi, unsigned char* smem) {
    const int tid = tidx(), lane = tid & 63, wave = tid >> 6, wr = wave >> 1, wc = wave & 1;
    const int r = lane & 31, h = lane >> 5;
    f32x16 acc[2][2];
#pragma unroll
    for (int i = 0; i < 2; ++i)
#pragma unroll
        for (int j = 0; j < 2; ++j)
#pragma unroll
            for (int e = 0; e < 16; ++e) acc[i][j][e] = 0.f;
    const int nk = g.K >> 6;
#if MFMA16
    f32x4v acc16[4][4];
#pragma unroll
    for (int m = 0; m < 4; ++m)
#pragma unroll
        for (int n = 0; n < 4; ++n) acc16[m][n] = (f32x4v){0.f, 0.f, 0.f, 0.f};
#endif
#if GEMM_DIRECT
    {
        const bf16_t* ap[2]; const bf16_t* bp[2];
#pragma unroll
        for (int i = 0; i < 2; ++i) {
            const int lr = wr * 64 + i * 32 + r;
            const int grow = g.lrows ? g.lrows[lr] : (m0 + lr);
            ap[i] = g.A + (size_t)grow * g.lda + 8 * h;
            bp[i] = g.Bt + (size_t)(n0 + wc * 64 + i * 32 + r) * g.ldb + 8 * h;
        }
        for (int k = 0; k < g.K; k += 16) {
            bf16x8 a[2], b[2];
#pragma unroll
            for (int i = 0; i < 2; ++i) { a[i] = *(const bf16x8*)(ap[i] + k); b[i] = *(const bf16x8*)(bp[i] + k); }
#pragma unroll
            for (int i = 0; i < 2; ++i)
#pragma unroll
                for (int j = 0; j < 2; ++j) acc[i][j] = MFMA32(a[i], b[j], acc[i][j]);
        }
    }
#elif GEMM_GLDS
    {
        constexpr int STG = 32768, TB = 16384;
        const int srow = tid >> 3, sch = (tid & 7) ^ ((srow >> 1) & 7);
        const bf16_t* ag[4]; const bf16_t* bg[4];
#pragma unroll
        for (int i = 0; i < 4; ++i) {
            const int lr = srow + 32 * i;
            const int grow = g.lrows ? g.lrows[lr] : (m0 + lr);
            ag[i] = g.A + (size_t)grow * g.lda + sch * 8;
            bg[i] = g.Bt + (size_t)(n0 + lr) * g.ldb + sch * 8;
        }
#define GLDS_STAGE(BUF, KO) do { unsigned char* _d = (BUF) + wave * 1024; \
        _Pragma("unroll") for (int i = 0; i < 4; ++i) { \
            __builtin_amdgcn_global_load_lds((const unsigned*)(ag[i] + (KO)), (LAS unsigned*)(_d + i * 4096), 16, 0, 0); \
            __builtin_amdgcn_global_load_lds((const unsigned*)(bg[i] + (KO)), (LAS unsigned*)(_d + TB + i * 4096), 16, 0, 0); } } while (0)
        __syncthreads();
        GLDS_STAGE(smem, 0);
        epi.prefetch(m0, n0, tid);
        const int y16 = (h ^ ((r >> 1) & 7)) << 4;
        const int o0 = y16, o1 = 32 ^ y16, o2 = 64 ^ y16, o3 = 96 ^ y16;
        const int arow = (wr * 64 + r) * 128, brow = TB + (wc * 64 + r) * 128;
        __syncthreads();
#if MFMA16
        const int i16 = lane & 15, g16 = lane >> 4;
        const int p0 = ((g16 ^ (i16 >> 1)) << 4), p1 = p0 ^ 64;
        const int arow16 = (wr * 64 + i16) * 128, brow16 = TB + (wc * 64 + i16) * 128;
        for (int kt = 0; kt < nk; ++kt) {
            const unsigned char* cur = smem + (kt & 1) * STG;
            if (kt + 1 < nk) GLDS_STAGE(smem + ((kt + 1) & 1) * STG, (kt + 1) * 64);
#pragma unroll
            for (int s = 0; s < 2; ++s) {
                const int po = s ? p1 : p0;
                bf16x8 fa[4], fb[4];
#pragma unroll
                for (int m = 0; m < 4; ++m) { fa[m] = *(const bf16x8*)(cur + arow16 + m * 16 * 128 + po); fb[m] = *(const bf16x8*)(cur + brow16 + m * 16 * 128 + po); }
#pragma unroll
                for (int m = 0; m < 4; ++m)
#pragma unroll
                    for (int n = 0; n < 4; ++n) acc16[m][n] = __builtin_amdgcn_mfma_f32_16x16x32_bf16(fa[m], fb[n], acc16[m][n], 0, 0, 0);
            }
            __syncthreads();
        }
#else
        for (int kt = 0; kt < nk; ++kt) {
            const unsigned char* cur = smem + (kt & 1) * STG;
            if (kt + 1 < nk) GLDS_STAGE(smem + ((kt + 1) & 1) * STG, (kt + 1) * 64);
            bf16x8 fa[4][2], fb[4][2];
#define KLOAD(S, OFF) do { \
                fa[S][0] = *(const bf16x8*)(cur + arow + (OFF)); fa[S][1] = *(const bf16x8*)(cur + arow + 32 * 128 + (OFF)); \
                fb[S][0] = *(const bf16x8*)(cur + brow + (OFF)); fb[S][1] = *(const bf16x8*)(cur + brow + 32 * 128 + (OFF)); } while (0)
            KLOAD(0, o0); KLOAD(1, o1); KLOAD(2, o2); KLOAD(3, o3);
#undef KLOAD
#pragma unroll
            for (int s = 0; s < 4; ++s) {
                acc[0][0] = MFMA32(fa[s][0], fb[s][0], acc[0][0]); acc[0][1] = MFMA32(fa[s][0], fb[s][1], acc[0][1]);
                acc[1][0] = MFMA32(fa[s][1], fb[s][0], acc[1][0]); acc[1][1] = MFMA32(fa[s][1], fb[s][1], acc[1][1]);
            }
            __builtin_amdgcn_sched_group_barrier(0x100, 8, 0); __builtin_amdgcn_sched_group_barrier(0x8, 4, 0);
            __builtin_amdgcn_sched_group_barrier(0x100, 4, 0); __builtin_amdgcn_sched_group_barrier(0x8, 4, 0);
            __builtin_amdgcn_sched_group_barrier(0x100, 4, 0); __builtin_amdgcn_sched_group_barrier(0x8, 8, 0);
#define KSTEP(OFF)
#undef KSTEP
            __syncthreads();
        }
#endif
#undef GLDS_STAGE
    }
#else
    {
        const int srow = tid >> 3, sch = tid & 7;
        const bf16_t* ag[4]; const bf16_t* bg[4];
#pragma unroll
        for (int i = 0; i < 4; ++i) {
            const int lr = srow + 32 * i;
            const int grow = g.lrows ? g.lrows[lr] : (m0 + lr);
            ag[i] = g.A + (size_t)grow * g.lda + sch * 8;
            bg[i] = g.Bt + (size_t)(n0 + lr) * g.ldb + sch * 8;
        }
        const int soff = srow * LDS_ROW + sch * 16;
        uint4 ra0, ra1, ra2, ra3, rb0, rb1, rb2, rb3;
#define G_LOAD(KO) do { ra0 = *(const uint4*)(ag[0] + (KO)); ra1 = *(const uint4*)(ag[1] + (KO)); ra2 = *(const uint4*)(ag[2] + (KO)); ra3 = *(const uint4*)(ag[3] + (KO)); \
                        rb0 = *(const uint4*)(bg[0] + (KO)); rb1 = *(const uint4*)(bg[1] + (KO)); rb2 = *(const uint4*)(bg[2] + (KO)); rb3 = *(const uint4*)(bg[3] + (KO)); } while (0)
#define L_STORE(BUF) do { unsigned char* _d = (BUF) + soff; \
        *(uint4*)(_d) = ra0; *(uint4*)(_d + 32 * LDS_ROW) = ra1; *(uint4*)(_d + 64 * LDS_ROW) = ra2; *(uint4*)(_d + 96 * LDS_ROW) = ra3; \
        *(uint4*)(_d + TILE_BYTES) = rb0; *(uint4*)(_d + TILE_BYTES + 32 * LDS_ROW) = rb1; *(uint4*)(_d + TILE_BYTES + 64 * LDS_ROW) = rb2; *(uint4*)(_d + TILE_BYTES + 96 * LDS_ROW) = rb3; } while (0)
        G_LOAD(0);
        __syncthreads();
        L_STORE(smem);
        __syncthreads();
        const int aoff = (wr * 64 + r) * LDS_ROW + h * 16;
        const int boff = TILE_BYTES + (wc * 64 + r) * LDS_ROW + h * 16;
        for (int kt = 0; kt < nk; ++kt) {
            const unsigned char* cur = smem + (kt & 1) * 2 * TILE_BYTES;
            unsigned char* nxt = smem + ((kt + 1) & 1) * 2 * TILE_BYTES;
            const bool more = (kt + 1 < nk);
            if (more) G_LOAD((kt + 1) * 64);
#pragma unroll
            for (int ks = 0; ks < 4; ++ks) {
                const bf16x8 a0 = *(const bf16x8*)(cur + aoff + ks * 32);
                const bf16x8 a1 = *(const bf16x8*)(cur + aoff + 32 * LDS_ROW + ks * 32);
                const bf16x8 b0 = *(const bf16x8*)(cur + boff + ks * 32);
                const bf16x8 b1 = *(const bf16x8*)(cur + boff + 32 * LDS_ROW + ks * 32);
                acc[0][0] = MFMA32(a0, b0, acc[0][0]); acc[0][1] = MFMA32(a0, b1, acc[0][1]);
                acc[1][0] = MFMA32(a1, b0, acc[1][0]); acc[1][1] = MFMA32(a1, b1, acc[1][1]);
            }
            if (more) L_STORE(nxt);
            __syncthreads();
        }
#undef G_LOAD
#undef L_STORE
    }
#endif
    float* Cs = (float*)smem;
#if GEMM_DIRECT
    __syncthreads();
#endif
#if !MFMA16
#pragma unroll
    for (int i = 0; i < 2; ++i)
#pragma unroll
        for (int j = 0; j < 2; ++j)
#pragma unroll
            for (int e = 0; e < 16; ++e) Cs[(wr * 64 + i * 32 + crow(e, h)) * CS_LD + wc * 64 + j * 32 + r] = acc[i][j][e];
#else
#pragma unroll
    for (int m = 0; m < 4; ++m)
#pragma unroll
        for (int n = 0; n < 4; ++n)
#pragma unroll
            for (int e = 0; e < 4; ++e) Cs[(wr * 64 + m * 16 + 4 * (lane >> 4) + e) * CS_LD + wc * 64 + n * 16 + (lane & 15)] = acc16[m][n][e];
#endif
    __syncthreads();
    epi(Cs, m0, n0, tid);
}

DI int vbid(int bid, int nb) { return (nb % 8 == 0) ? (bid % 8) * (nb / 8) + bid / 8 : bid; }

DI int colmap_in(int n) {
    if (n < 384) return n;
    if (n < 896) return 416 + (n - 384);
    if (n < 1920) return 928 + (n - 896);
    if (n < 1952) return 384 + (n - 1920);
    if (n < 1960) return n;
    return -1;
}
template <int KIND>
DI void tconv_tile(const float* src, const float* src2, int ldsrc, bf16_t* dst, int K, int k0, int n0, const float* scale, int scale_from, unsigned char* smem) {
    float* tile = (float*)smem;
    const int t = tidx();
    __syncthreads();
#pragma unroll 4
    for (int i = 0; i < 16; ++i) {
        const int k = i * 4 + (t >> 6), n = t & 63;
        const int nd = n0 + n;
        float v = 0.f;
        if (KIND == 1) { const int c = colmap_in(nd); if (c >= 0) v = src[(size_t)(k0 + k) * ldsrc + c]; }
        else if (KIND == 2) {
            const int j = nd >> 7, wc = (nd >> 6) & 1, isup = (nd >> 5) & 1, ii = nd & 31;
            const int c = 64 * j + 32 * wc + ii;
            v = (isup ? src2 : src)[(size_t)(k0 + k) * ldsrc + c];
        } else v = src[(size_t)(k0 + k) * ldsrc + nd];
        if (scale && (k0 + k) >= scale_from) v *= scale[k0 + k - scale_from];
        tile[k * 65 + n] = v;
    }
    __syncthreads();
#pragma unroll 4
    for (int i = 0; i < 16; ++i) {
        const int n = i * 4 + (t >> 6), k = t & 63;
        dst[(size_t)(n0 + n) * K + k0 + k] = f2bf(tile[k * 65 + n]);
    }
}

DI void phase_prep(const P& p, int bid, int nb, unsigned char* smem) {
    unsigned char* ws = p.ws;
    const int tid = tidx();
    constexpr int J0 = 512, J1 = J0 + 48, J2 = J1 + 32, J3 = J2 + 256, J4 = J3 + 256, J5 = J4 + 256, J6 = J5 + 256, J7 = J6 + 256, J8 = J7 + 4096, J9 = J8 + 2048;
    for (int t = bid; t < J9; t += nb) {
        if (t < J0) { const int kt = t >> 5, ntl = t & 31; tconv_tile<1>(p.in[2], nullptr, 1960, (bf16_t*)(ws + W_IN), 1024, kt * 64, ntl * 64, nullptr, 0, smem); }
        else if (t < J1) { const int u = t - J0, kt = u / 12, ntl = u % 12; tconv_tile<0>(p.in[4], nullptr, 768, (bf16_t*)(ws + W_QUP), 256, kt * 64, ntl * 64, p.in[3], 0, smem); }
        else if (t < J2) { const int u = t - J1, kt = u >> 4, ntl = u & 15; tconv_tile<0>(p.in[6], nullptr, 1024, (bf16_t*)(ws + W_KVUP), 128, kt * 64, ntl * 64, p.in[5], 0, smem); }
        else if (t < J3) { const int u = t - J2, kt = u >> 4, ntl = u & 15; tconv_tile<0>(p.in[13], nullptr, 1024, (bf16_t*)(ws + W_OUT), 1024, kt * 64, ntl * 64, p.in[12], 512, smem); }
        else if (t < J4) { const int u = t - J3, kt = u >> 4, ntl = u & 15; tconv_tile<0>(p.in[16], nullptr, 1024, (bf16_t*)(ws + W_XQ), 1024, kt * 64, ntl * 64, nullptr, 0, smem); }
        else if (t < J5) { const int u = t - J4, kt = u >> 4, ntl = u & 15; tconv_tile<0>(p.in[17], nullptr, 1024, (bf16_t*)(ws + W_XKV), 1024, kt * 64, ntl * 64, nullptr, 0, smem); }
        else if (t < J6) { const int u = t - J5, kt = u >> 4, ntl = u & 15; tconv_tile<0>(p.in[18], nullptr, 1024, (bf16_t*)(ws + W_XKV) + (size_t)1024 * 1024, 1024, kt * 64, ntl * 64, nullptr, 0, smem); }
        else if (t < J7) { const int u = t - J6, kt = u >> 4, ntl = u & 15; tconv_tile<0>(p.in[19], nullptr, 1024, (bf16_t*)(ws + W_XO), 1024, kt * 64, ntl * 64, nullptr, 0, smem); }
        else if (t < J8) { const int u = t - J7, e = u >> 7, v = u & 127, kt = v >> 3, ntl = v & 7;
            tconv_tile<2>(p.in[26] + (size_t)e * 1024 * 256, p.in[27] + (size_t)e * 1024 * 256, 256, (bf16_t*)(ws + W_GU) + (size_t)e * 512 * 1024, 1024, kt * 64, ntl * 64, nullptr, 0, smem); }
        else { const int u = t - J8, e = u >> 6, v = u & 63, kt = v >> 4, ntl = v & 15;
            tconv_tile<0>(p.in[28] + (size_t)e * 256 * 1024, nullptr, 1024, (bf16_t*)(ws + W_DN) + (size_t)e * 1024 * 256, 256, kt * 64, ntl * 64, nullptr, 0, smem); }
    }
    {
        const size_t gsz = (size_t)nb * 256, g0 = (size_t)bid * 256 + tid;
        bf16_t* xb = (bf16_t*)p.out;
        const float4* x4 = (const float4*)p.in[0];
        for (size_t i = g0; i < (size_t)T * D / 4; i += gsz) { const float4 v = x4[i]; uint2 o; o.x = pack2(v.x, v.y); o.y = pack2(v.z, v.w); ((uint2*)xb)[i] = o; }
        bf16_t* mb = (bf16_t*)(ws + MEMB);
        const float4* m4 = (const float4*)p.in[1];
        for (size_t i = g0; i < (size_t)Bn * NMEM * D / 4; i += gsz) { const float4 v = m4[i]; uint2 o; o.x = pack2(v.x, v.y); o.y = pack2(v.z, v.w); ((uint2*)mb)[i] = o; }
        float* wrt = (float*)(ws + W_RT);
        for (size_t i = g0; i < 48 * 1024; i += gsz) {
            const int j = (int)(i >> 10), k = (int)(i & 1023);
            float v = 0.f;
            if (j < 4) v = p.in[22][k * 4 + j]; else if (j < 36) v = p.in[24][k * 32 + (j - 4)];
            wrt[i] = v;
        }
        float* rc = (float*)(ws + ROPE_C); float* rs = (float*)(ws + ROPE_S);
        for (size_t i = g0; i < 2048 * 16; i += gsz) {
            const int pos = (int)(i >> 4), f = (int)(i & 15);
            const float inv = powf(10000.f, -(float)f / 16.f);
            const float ang = (float)pos * inv;
            const double a = (double)ang;
            const double k2 = rint(a * 0.15915494309189535);
            const float rr = (float)(a - k2 * 6.283185307179586);
            rc[i] = cosf(rr); rs[i] = sinf(rr);
        }
    }
}

struct EpiProj {
    bf16_t *cq, *ckv, *z, *xbc, *krope; float* dt; const float *rc, *rs, *dtb; float* ssq;
    DI void prefetch(int, int, int) {}
    DI void operator()(const float* Cs, int m0, int n0, int tid) const {
        const int c4 = (tid & 31) * 4, r0 = tid >> 5;
        if (n0 < 1920) {
            bf16_t* dst; int ld, cofs;
            if (n0 < 256) { dst = cq; ld = 256; cofs = n0; } else if (n0 < 384) { dst = ckv; ld = 128; cofs = n0 - 256; }
            else if (n0 < 896) { dst = z; ld = 512; cofs = n0 - 384; } else { dst = xbc; ld = 1024; cofs = n0 - 896; }
            if (n0 < 384) {
                float* sq = ssq + (size_t)(n0 >> 7) * T + m0;
#pragma unroll 4
                for (int ps = 0; ps < 16; ++ps) {
                    const int row = ps * 8 + r0; const float4 v = cs4(Cs, row, c4);
                    *(uint2*)(dst + (size_t)(m0 + row) * ld + cofs + c4) = pack4(v);
                    float ss = (v.x * v.x + v.y * v.y) + (v.z * v.z + v.w * v.w);
#pragma unroll
                    for (int o = 16; o >= 1; o >>= 1) ss += __shfl_xor(ss, o);
                    if ((tid & 31) == 0) sq[row] = ss;
                }
            } else {
#pragma unroll 4
            for (int ps = 0; ps < 16; ++ps) { const int row = ps * 8 + r0; *(uint2*)(dst + (size_t)(m0 + row) * ld + cofs + c4) = pack4(cs4(Cs, row, c4)); }
            }
        } else {
#pragma unroll
            for (int ps = 0; ps < 4; ++ps) {
                const int it = ps * 256 + tid, row = it >> 3, cc = (it & 7) * 4, grow = m0 + row;
                const float4 v = cs4(Cs, row, cc), pv = cs4(Cs, row, cc ^ 16);
                const int pos = grow & 2047, f = cc & 15;
                const float4 c = *(const float4*)(rc + pos * 16 + f), s = *(const float4*)(rs + pos * 16 + f);
                float4 o;
                if (cc < 16) { o.x = v.x * c.x - pv.x * s.x; o.y = v.y * c.y - pv.y * s.y; o.z = v.z * c.z - pv.z * s.z; o.w = v.w * c.w - pv.w * s.w; }
                else { o.x = v.x * c.x + pv.x * s.x; o.y = v.y * c.y + pv.y * s.y; o.z = v.z * c.z + pv.z * s.z; o.w = v.w * c.w + pv.w * s.w; }
                *(uint2*)(krope + (size_t)grow * 32 + cc) = pack4(o);
            }
#pragma unroll
            for (int ps = 0; ps < 4; ++ps) {
                const int it = ps * 256 + tid, row = it >> 3, cc = it & 7;
                dt[(size_t)(m0 + row) * 8 + cc] = softplusf(Cs[row * CS_LD + 32 + cc] + dtb[cc]);
            }
        }
    }
};
struct EpiMemKV {
    bf16_t *kx, *vxt;
    DI void prefetch(int, int, int) {}
    DI void operator()(const float* Cs, int m0, int n0, int tid) const {
        const int b = m0 >> 8, mm0 = m0 & 255;
        if (n0 < 1024) {
            const int c4 = (tid & 31) * 4, r0 = tid >> 5, hd = n0 >> 8, d = (n0 & 255) + c4;
#pragma unroll 4
            for (int ps = 0; ps < 16; ++ps) { const int row = ps * 8 + r0; *(uint2*)(kx + ((size_t)(b * 4 + hd) * 256 + mm0 + row) * 256 + d) = pack4(cs4(Cs, row, c4)); }
        } else {
            const int c2 = n0 - 1024, hd = c2 >> 8;
#pragma unroll 2
            for (int ps = 0; ps < 8; ++ps) {
                const int it = ps * 256 + tid, col = it & 127, rg = it >> 7, d = (c2 & 255) + col;
                uint4 w;
                w.x = pack2(Cs[(rg * 8 + 0) * CS_LD + col], Cs[(rg * 8 + 1) * CS_LD + col]); w.y = pack2(Cs[(rg * 8 + 2) * CS_LD + col], Cs[(rg * 8 + 3) * CS_LD + col]);
                w.z = pack2(Cs[(rg * 8 + 4) * CS_LD + col], Cs[(rg * 8 + 5) * CS_LD + col]); w.w = pack2(Cs[(rg * 8 + 6) * CS_LD + col], Cs[(rg * 8 + 7) * CS_LD + col]);
                *(uint4*)(vxt + ((size_t)(b * 4 + hd) * 256 + d) * 256 + mm0 + rg * 8) = w;
            }
        }
    }
};
DI void phase_proj(const P& p, int bid, int nb, unsigned char* smem, int rep = 0) {
    unsigned char* ws = p.ws;
    const int v = vbid(bid, nb);
    const bf16_t* xb = (const bf16_t*)p.out;
    EpiProj e1{(bf16_t*)(ws + CQ), (bf16_t*)(ws + CKV), (bf16_t*)(ws + ZB), (bf16_t*)(ws + XBC), (bf16_t*)(ws + KROPE), (float*)(ws + DTB),
               (const float*)(ws + ROPE_C), (const float*)(ws + ROPE_S), p.in[9], (float*)(ws + SSQ)};
    EpiMemKV e2{(bf16_t*)(ws + KX), (bf16_t*)(ws + VXT)};
    constexpr int NT1 = 256 * 16, NT2 = 32 * 16;
    for (int t = v; t < NT1 + NT2; t += nb) {
        if (rep && REP_MODE == 1 && t >= NT1) continue;
        if (rep && REP_MODE == 2 && t < NT1) continue;
        if (rep && REP_MODE == 3 && !(t < NT1 && (t & 7) == 7 && ((t >> 6) & 1))) continue;
        if (rep && REP_MODE == 4 && !(t < NT1 && ((t >> 6) & 1) == 0)) continue;
        const int u = t < NT1 ? t : t - NT1, c = u >> 6, j = u & 63, mt = (c >> 1) * 8 + (j >> 3), ntl = (c & 1) * 8 + (j & 7);
        if (t < NT1) { GemmArgs g{xb, 1024, (const bf16_t*)(ws + W_IN), 1024, 1024, nullptr}; gemm_tile(g, mt * 128, ntl * 128, e1, smem); }
        else { GemmArgs g{(const bf16_t*)(ws + MEMB), 1024, (const bf16_t*)(ws + W_XKV), 1024, 1024, nullptr}; gemm_tile(g, mt * 128, ntl * 128, e2, smem); }
    }
}

struct EpiQup {
    bf16_t* q; const float* ssq; float* rms;
    DI void prefetch(int m0, int, int tid) { if (tid < 128) rms[tid] = rsqrtf((ssq[m0 + tid] + ssq[(size_t)T + m0 + tid]) * (1.f / 256.f) + EPS); }
    DI void operator()(const float* Cs, int m0, int n0, int tid) const {
        const int c4 = (tid & 31) * 4, r0 = tid >> 5;
        const int col = n0 + c4, head = col / 96, d = col - head * 96;
        const int b = m0 >> 11, s0 = m0 & 2047;
#pragma unroll 4
        for (int ps = 0; ps < 16; ++ps) {
            const int row = ps * 8 + r0;
            const float sc = rms[row] * QSCALE;
            float4 v = cs4(Cs, row, c4);
            v.x *= sc; v.y *= sc; v.z *= sc; v.w *= sc;
            *(uint2*)(q + ((size_t)(b * 8 + head) * 2048 + s0 + row) * 96 + d) = pack4(v);
        }
    }
};
struct EpiKVup {
    bf16_t *kn, *vt; const float* ssq; float* rms;
    DI void prefetch(int m0, int, int tid) { if (tid < 128) rms[tid] = rsqrtf(ssq[2 * (size_t)T + m0 + tid] * (1.f / 128.f) + EPS); }
    DI void operator()(const float* Cs, int m0, int n0, int tid) const {
        const int head = n0 >> 7, b = m0 >> 11, s0 = m0 & 2047;
#pragma unroll 4
        for (int ps = 0; ps < 8; ++ps) {
            const int it = ps * 256 + tid, row = it >> 4, c4 = (it & 15) * 4;
            const float sc = rms[row];
            float4 v = cs4(Cs, row, c4); v.x *= sc; v.y *= sc; v.z *= sc; v.w *= sc;
            *(uint2*)(kn + ((size_t)(b * 8 + head) * 2048 + s0 + row) * 64 + c4) = pack4(v);
        }
#pragma unroll 2
        for (int ps = 0; ps < 4; ++ps) {
            const int it = ps * 256 + tid, dv = it & 63, rg = it >> 6;
            const float* cp = Cs + (rg * 8) * CS_LD + 64 + dv; const float* rp = rms + rg * 8;
            uint4 w;
            w.x = pack2(cp[0] * rp[0], cp[CS_LD] * rp[1]); w.y = pack2(cp[2 * CS_LD] * rp[2], cp[3 * CS_LD] * rp[3]);
            w.z = pack2(cp[4 * CS_LD] * rp[4], cp[5 * CS_LD] * rp[5]); w.w = pack2(cp[6 * CS_LD] * rp[6], cp[7 * CS_LD] * rp[7]);
            *(uint4*)(vt + ((size_t)(b * 8 + head) * 64 + dv) * 2048 + s0 + rg * 8) = w;
        }
    }
};
DI void phase_up(const P& p, int bid, int nb, unsigned char* smem, int rep = 0) {
    unsigned char* ws = p.ws;
    const int v = vbid(bid, nb);
    float* rms = (float*)(smem + GEMM_LDS);
    constexpr int NTQ = 256 * 6, NTKV = 256 * 8;
    for (int t = v; t < NTQ + NTKV; t += nb) {
        if (rep && REP_MODE == 1) break;
        if (rep && REP_MODE == 2 && t >= NTQ) break;
        if (rep && REP_MODE == 3 && t < NTQ) continue;
        if (t < NTQ) {
            const int mt = t / 6, ntl = t % 6;
            EpiQup e{(bf16_t*)(ws + QB), (const float*)(ws + SSQ), rms};
            GemmArgs g{(const bf16_t*)(ws + CQ), 256, (const bf16_t*)(ws + W_QUP), 256, 256, nullptr};
            gemm_tile(g, mt * 128, ntl * 128, e, smem);
        } else {
            const int u = t - NTQ, mt = u >> 3, ntl = u & 7;
            EpiKVup e{(bf16_t*)(ws + KNB), (bf16_t*)(ws + VTB), (const float*)(ws + SSQ), rms};
            GemmArgs g{(const bf16_t*)(ws + CKV), 128, (const bf16_t*)(ws + W_KVUP), 128, 128, nullptr};
            gemm_tile(g, mt * 128, ntl * 128, e, smem);
        }
    }
    if (!(rep && REP_MODE >= 2)) {
        const bf16_t* xbc = (const bf16_t*)(ws + XBC); bf16_t* xa = (bf16_t*)(ws + XBCA);
        const float* cw = p.in[7]; const float* cb = p.in[8];
        const size_t gsz = (size_t)nb * 256;
        for (size_t i = (size_t)bid * 256 + tidx(); i < (size_t)(T / 4) * 128; i += gsz) {
            const int tk0 = (int)(i >> 7) * 4, c0 = (int)(i & 127) * 8, s0 = tk0 & 2047;
            float w[4][8], bias[8];
#pragma unroll
            for (int j = 0; j < 4; ++j) { const float4 w0 = *(const float4*)(cw + j * 1024 + c0), w1 = *(const float4*)(cw + j * 1024 + c0 + 4);
                w[j][0] = w0.x; w[j][1] = w0.y; w[j][2] = w0.z; w[j][3] = w0.w; w[j][4] = w1.x; w[j][5] = w1.y; w[j][6] = w1.z; w[j][7] = w1.w; }
            { const float4 b0 = *(const float4*)(cb + c0), b1 = *(const float4*)(cb + c0 + 4); bias[0] = b0.x; bias[1] = b0.y; bias[2] = b0.z; bias[3] = b0.w; bias[4] = b1.x; bias[5] = b1.y; bias[6] = b1.z; bias[7] = b1.w; }
            float xin[7][8];
#pragma unroll
            for (int rr = 0; rr < 7; ++rr) {
                uint4 wv = make_uint4(0u, 0u, 0u, 0u);
                if (s0 + rr - 3 >= 0) wv = *(const uint4*)(xbc + (size_t)(tk0 + rr - 3) * 1024 + c0);
                xin[rr][0] = bflo(wv.x); xin[rr][1] = bfhi(wv.x); xin[rr][2] = bflo(wv.y); xin[rr][3] = bfhi(wv.y); xin[rr][4] = bflo(wv.z); xin[rr][5] = bfhi(wv.z); xin[rr][6] = bflo(wv.w); xin[rr][7] = bfhi(wv.w);
            }
#pragma unroll
            for (int o = 0; o < 4; ++o) {
                float accv[8];
#pragma unroll
                for (int k = 0; k < 8; ++k) accv[k] = bias[k] + w[0][k] * xin[o][k] + w[1][k] * xin[o + 1][k] + w[2][k] * xin[o + 2][k] + w[3][k] * xin[o + 3][k];
                uint4 ov;
                ov.x = pack2(siluf(accv[0]), siluf(accv[1])); ov.y = pack2(siluf(accv[2]), siluf(accv[3]));
                ov.z = pack2(siluf(accv[4]), siluf(accv[5])); ov.w = pack2(siluf(accv[6]), siluf(accv[7]));
                *(uint4*)(xa + (size_t)(tk0 + o) * 1024 + c0) = ov;
            }
        }
    }
}

DI int perm16(int k) { return (k & ~12) | ((k & 4) << 1) | ((k & 8) >> 1); }
template <int DQK, int DVW, int KT, int NQG, int NDV>
struct FlashCfg {
    static constexpr int KSTR = (DQK + 8) * 2;
    static constexpr int VSTR = (KT + 8) * 2;
    static constexpr int DV = DVW * NDV;
    static constexpr int KBYTES = KT * KSTR, VBYTES = DV * VSTR, STAGE = KBYTES + VBYTES;
    static constexpr int KCH = KT * DQK / 8 / 256;
    static constexpr int VCH = DV * KT / 8 / 256;
    static_assert(KT * DQK / 8 % 256 == 0 && DV * KT / 8 % 256 == 0, "chunk split");
    static_assert(2 * STAGE <= SMEM_BYTES - 32, "flash LDS");
};
template <int DQK, int DVW, int KT, int NQG, int NDV, class Src>
DI void flash_item(const Src& src, int ntiles, int nskip  , unsigned char* smem, bool noload = false) {
    typedef FlashCfg<DQK, DVW, KT, NQG, NDV> C;
    constexpr int NKS = DQK / 16, NKB = KT / 32, NDB = DVW / 32;
    int tid = tidx(); asm volatile("" : "+v"(tid));
    const int lane = tid & 63, wave = __builtin_amdgcn_readfirstlane(tid >> 6), r = lane & 31, h = lane >> 5;
    const int qg = wave / NDV, dvh = wave % NDV;
    bf16x8 qf[NKS];
    {
        const bf16_t* qp = src.qrow(qg * 32 + r) + 8 * h;
#pragma unroll
        for (int ks = 0; ks < NKS; ++ks) qf[ks] = *(const bf16x8*)(qp + 16 * ks);
        if (Src::ROPE) {
            const float* cp = src.rope_c(qg * 32 + r) + 8 * h; const float* sp = src.rope_s(qg * 32 + r) + 8 * h;
            const float4 c0 = *(const float4*)cp, c1 = *(const float4*)(cp + 4), s0 = *(const float4*)sp, s1 = *(const float4*)(sp + 4);
            const float cc[8] = {c0.x, c0.y, c0.z, c0.w, c1.x, c1.y, c1.z, c1.w}, ss[8] = {s0.x, s0.y, s0.z, s0.w, s1.x, s1.y, s1.z, s1.w};
            bf16x8 x1 = qf[NKS - 2], x2 = qf[NKS - 1];
#pragma unroll
            for (int j = 0; j < 8; ++j) {
                const float a = bf2f((bf16_t)x1[j]), b2 = bf2f((bf16_t)x2[j]);
                x1[j] = (short)f2bf(a * cc[j] - b2 * ss[j]); x2[j] = (short)f2bf(b2 * cc[j] + a * ss[j]);
            }
            qf[NKS - 2] = x1; qf[NKS - 1] = x2;
        }
    }
    f32x16 o[NDB];
#pragma unroll
    for (int d = 0; d < NDB; ++d)
#pragma unroll
        for (int e = 0; e < 16; ++e) o[d][e] = 0.f;
    float m = -1e30f, l = 0.f;
    uint4 kr[C::KCH], vr[C::VCH];
    auto gload = [&](int t) {
#pragma unroll
        for (int i = 0; i < C::KCH; ++i) { const int idx = tid + 256 * i; kr[i] = src.kload(t, idx / (DQK / 8), idx % (DQK / 8)); }
#pragma unroll
        for (int i = 0; i < C::VCH; ++i) { const int idx = tid + 256 * i; vr[i] = src.vload(t, idx / (KT / 8), idx % (KT / 8)); }
    };
    auto lstore = [&](unsigned char* buf) {
#pragma unroll
        for (int i = 0; i < C::KCH; ++i) { const int idx = tid + 256 * i; *(uint4*)(buf + (idx / (DQK / 8)) * C::KSTR + (idx % (DQK / 8)) * 16) = kr[i]; }
#pragma unroll
        for (int i = 0; i < C::VCH; ++i) {
            const int idx = tid + 256 * i, dv = idx / (KT / 8), c = idx % (KT / 8);
            unsigned char* row = buf + C::KBYTES + dv * C::VSTR + (c >> 1) * 32;
            const int a = c & 1;
            *(uint2*)(row + (4 * a) * 2) = make_uint2(vr[i].x, vr[i].y);
            *(uint2*)(row + (8 + 4 * a) * 2) = make_uint2(vr[i].z, vr[i].w);
        }
    };
    gload(0);
    __syncthreads();
    lstore(smem);
    __syncthreads();
    for (int t = 0; t < ntiles; ++t) {
        const unsigned char* cur = smem + (t & 1) * C::STAGE;
        const bool more = (t + 1 < ntiles);
        if (more && !noload) gload(t + 1);
        if (!(t == ntiles - 1 && qg < nskip)) {
            f32x16 s[NKB];
#pragma unroll
            for (int kb = 0; kb < NKB; ++kb) {
                const unsigned char* kp = cur + (kb * 32 + r) * C::KSTR + h * 16;
                if (NKB == 1) {
                    constexpr int NCH = 2;
                    f32x16 sp[NCH];
#pragma unroll
                    for (int c = 0; c < NCH; ++c)
#pragma unroll
                        for (int e = 0; e < 16; ++e) sp[c][e] = 0.f;
#pragma unroll
                    for (int ks = 0; ks < NKS; ++ks) sp[ks % NCH] = MFMA32(*(const bf16x8*)(kp + ks * 32), qf[ks], sp[ks % NCH]);
#pragma unroll
                    for (int e = 0; e < 16; ++e) s[kb][e] = sp[0][e] + sp[1][e];
                } else {
#pragma unroll
                    for (int e = 0; e < 16; ++e) s[kb][e] = 0.f;
#pragma unroll
                    for (int ks = 0; ks < NKS; ++ks) s[kb] = MFMA32(*(const bf16x8*)(kp + ks * 32), qf[ks], s[kb]);
                }
            }
            float mx = s[0][0];
#pragma unroll
            for (int kb = 0; kb < NKB; ++kb)
#pragma unroll
                for (int e = 0; e < 16; ++e) mx = fmaxf(mx, s[kb][e]);
            mx = fmaxf(mx, __shfl_xor(mx, 32));
            const float mn = fmaxf(m, mx);
            const float alpha = __builtin_amdgcn_exp2f(m - mn);
            m = mn;
            float ps = 0.f;
#pragma unroll
            for (int kb = 0; kb < NKB; ++kb)
#pragma unroll
                for (int e = 0; e < 16; ++e) { const float pv = __builtin_amdgcn_exp2f(s[kb][e] - mn); s[kb][e] = pv; ps += pv; }
            l = l * alpha + ps;
#pragma unroll
            for (int d = 0; d < NDB; ++d)
#pragma unroll
                for (int e = 0; e < 16; ++e) o[d][e] *= alpha;
#pragma unroll
            for (int kb = 0; kb < NKB; ++kb)
#pragma unroll
                for (int s2 = 0; s2 < 2; ++s2) {
                    uint4 pk;
                    pk.x = pack2(s[kb][8 * s2], s[kb][8 * s2 + 1]); pk.y = pack2(s[kb][8 * s2 + 2], s[kb][8 * s2 + 3]);
                    pk.z = pack2(s[kb][8 * s2 + 4], s[kb][8 * s2 + 5]); pk.w = pack2(s[kb][8 * s2 + 6], s[kb][8 * s2 + 7]);
                    const bf16x8 pf = __builtin_bit_cast(bf16x8, pk);
                    const unsigned char* vp = cur + C::KBYTES + (dvh * DVW + r) * C::VSTR + (kb * 32 + s2 * 16 + 8 * h) * 2;
#pragma unroll
                    for (int d = 0; d < NDB; ++d) o[d] = MFMA32(*(const bf16x8*)(vp + d * 32 * C::VSTR), pf, o[d]);
                }
        }
        if (more) lstore(smem + ((t + 1) & 1) * C::STAGE);
        __syncthreads();
    }
    l += __shfl_xor(l, 32);
    const float il = 1.f / l;
#pragma unroll
    for (int d = 0; d < NDB; ++d)
#pragma unroll
        for (int g4 = 0; g4 < 4; ++g4) {
            uint2 w; w.x = pack2(o[d][4 * g4] * il, o[d][4 * g4 + 1] * il); w.y = pack2(o[d][4 * g4 + 2] * il, o[d][4 * g4 + 3] * il);
            src.store(qg * 32 + r, dvh * DVW + d * 32 + 8 * g4 + 4 * h, w);
        }
}
struct SelfSrc {
    static constexpr bool ROPE = true;
    const bf16_t *q, *kn, *kr, *vt; bf16_t* mix; int b, hd, bh, q0; const float *rc, *rs;
    DI const float* rope_c(int rr) const { return rc + (q0 + rr) * 16; }
    DI const float* rope_s(int rr) const { return rs + (q0 + rr) * 16; }
    DI const bf16_t* qrow(int rr) const { return q + ((size_t)bh * 2048 + q0 + rr) * 96; }
    DI uint4 kload(int t, int key, int c) const {
        const int kg = t * 64 + key;
        return c < 8 ? *(const uint4*)(kn + ((size_t)bh * 2048 + kg) * 64 + c * 8) : *(const uint4*)(kr + ((size_t)b * 2048 + kg) * 32 + (c - 8) * 8);
    }
    DI uint4 vload(int t, int dv, int c) const { return *(const uint4*)(vt + ((size_t)bh * 64 + dv) * 2048 + t * 64 + c * 8); }
    DI void store(int rr, int dv, uint2 w) const { *(uint2*)(mix + ((size_t)b * 2048 + q0 + rr) * 1024 + hd * 64 + dv) = w; }
};
struct CrossSrc {
    static constexpr bool ROPE = false;
    const bf16_t *qx, *kx, *vxt; bf16_t* ox; int b, hd, q0;
    DI const float* rope_c(int) const { return nullptr; }
    DI const float* rope_s(int) const { return nullptr; }
    DI const bf16_t* qrow(int rr) const { return qx + ((size_t)(b * 4 + hd) * 2048 + q0 + rr) * 256; }
    DI uint4 kload(int t, int key, int c) const { return *(const uint4*)(kx + ((size_t)(b * 4 + hd) * 256 + t * 32 + key) * 256 + c * 8); }
    DI uint4 vload(int t, int dv, int c) const { return *(const uint4*)(vxt + ((size_t)(b * 4 + hd) * 256 + dv) * 256 + t * 32 + c * 8); }
    DI void store(int rr, int dv, uint2 w) const { *(uint2*)(ox + ((size_t)b * 2048 + q0 + rr) * 1024 + hd * 256 + dv) = w; }
};
DI void attn_fast(const P& p, int bid, int nb, unsigned char* smem) {
    unsigned char* ws = p.ws;
    const int nround = (2048 + nb - 1) / nb;
    for (int rd = 0; rd < nround; ++rd) {
        const int idx = rd * nb + ((rd & 1) ? (nb - 1 - bid) : bid);
        if (idx >= 2048) continue;
        const int qb = 15 - (idx >> 7), bh = idx & 127;
        SelfSrc s{(const bf16_t*)(ws + QB), (const bf16_t*)(ws + KNB), (const bf16_t*)(ws + KROPE), (const bf16_t*)(ws + VTB), (bf16_t*)(ws + MIX), bh >> 3, bh & 7, bh, qb * 128, (const float*)(ws + ROPE_C), (const float*)(ws + ROPE_S)};
        flash_item<96, 64, 64, 4, 1>(s, 2 * qb + 2, 2, smem);
    }
}
DI void xattn_fast(const P& p, int bid, int nb, unsigned char* smem, int rep = 0) {
    unsigned char* ws = p.ws;
    for (int it = bid; it < 2048; it += nb) {
        const int bhd = it >> 5, qt = it & 31;
        CrossSrc s{(const bf16_t*)(ws + QX), (const bf16_t*)(ws + KX), (const bf16_t*)(ws + VXT), (bf16_t*)(ws + OX), bhd >> 2, bhd & 3, qt * 64};
        if (rep) s.ox = (bf16_t*)(ws + RD);
        flash_item<256, 128, 32, 2, 2>(s, 8, 0, smem, rep && REP_MODE == 5);
    }
}

constexpr int SSD_XT = 0, SSD_BM = 8192, SSD_CM = SSD_BM + 16384, SSD_BWT = SSD_CM + 16384, SSD_PS = SSD_BWT + 16384, SSD_F = SSD_PS + 16384;
static_assert(SSD_F + 2048 <= SMEM_BYTES - 32, "ssd LDS");
DI int off256(int row, int el) { return row * 256 + (((el >> 3) ^ (row & 15)) << 4) + ((el & 7) << 1); }
DI int off128(int row, int el) { return row * 128 + (((el >> 3) ^ ((row ^ (row >> 3)) & 7)) << 4) + ((el & 7) << 1); }
template <int pm>
DI void ssd_item(const P& p, int bh, unsigned char* smem) {
    unsigned char* ws = p.ws;
    const bf16_t* xa = (const bf16_t*)(ws + XBCA); const float* dtg = (const float*)(ws + DTB);
    bf16_t* mix = pm ? (bf16_t*)(ws + XBC) : (bf16_t*)(ws + MIX);
    int tid0 = tidx(); asm volatile("" : "+v"(tid0));
    const int wave = __builtin_amdgcn_readfirstlane(tid0 >> 6);
    const int b = bh >> 3, hd = bh & 7, g = hd >> 2;
    const int lb = wave >> 1, pb = wave & 1;
    const float a_h = -__expf(p.in[10][hd]), Dh = p.in[11][hd];
    float* F = (float*)(smem + SSD_F);
    __syncthreads();
    for (int i = tid0; i < 16384 / 16; i += 256) *(uint4*)(smem + SSD_PS + i * 16) = make_uint4(0u, 0u, 0u, 0u);
    f32x16 st[2];
#pragma unroll
    for (int i = 0; i < 2; ++i)
#pragma unroll
        for (int e = 0; e < 16; ++e) st[i][e] = 0.f;
    uint4 xr0, xr1, br0, br1, br2, br3, cr0, cr1, cr2, cr3; float dtr = 0.f;
#define SSD_XLD(i) (*(const uint4*)(xa + (t0_ + ((tid + 256 * (i)) >> 3)) * 1024 + hd * 64 + ((tid + 256 * (i)) & 7) * 8))
#define SSD_BLD(i, o) (*(const uint4*)(xa + (t0_ + ((tid + 256 * (i)) >> 4)) * 1024 + (o) + g * 128 + ((tid + 256 * (i)) & 15) * 8))
#define SSD_GLOAD(c_) do { const size_t t0_ = (size_t)b * 2048 + (c_) * 64; xr0 = SSD_XLD(0); xr1 = SSD_XLD(1); \
        br0 = SSD_BLD(0, 512); br1 = SSD_BLD(1, 512); br2 = SSD_BLD(2, 512); br3 = SSD_BLD(3, 512); \
        cr0 = SSD_BLD(0, 768); cr1 = SSD_BLD(1, 768); cr2 = SSD_BLD(2, 768); cr3 = SSD_BLD(3, 768); \
        if (tid < 64) dtr = dtg[(t0_ + tid) * 8 + hd]; } while (0)
    { const int tid = tid0; SSD_GLOAD(0); }
#define SSD_SCAN(FP) do { const int ln_ = tid0 & 63; float v = dtr * a_h; \
        _Pragma("unroll") for (int o = 1; o < 64; o <<= 1) { const float u = __shfl_up(v, o); if (ln_ >= o) v += u; } \
        const float a63 = __shfl(v, 63); \
        (FP)[ln_] = v; (FP)[64 + ln_] = __expf(v); (FP)[128 + ln_] = dtr; (FP)[192 + ln_] = __expf(a63 - v) * dtr; } while (0)
    if (wave == 0) SSD_SCAN(F);
    __syncthreads();
    for (int c = 0; c < 32; ++c) {
        int tid = tid0; asm volatile("" : "+v"(tid));
        const int lane = tid & 63, r = lane & 31, h = lane >> 5;
        const size_t t0 = (size_t)b * 2048 + c * 64;
        const float* Fc = F + (c & 1) * 256; float* Fn = F + ((c + 1) & 1) * 256;
#define SSD_XIMG(i, XR) do { const int idx = tid + 256 * (i), l = idx >> 3, p0 = (idx & 7) * 8, lp = perm16(l); \
            const unsigned ww[4] = {XR.x, XR.y, XR.z, XR.w}; \
            _Pragma("unroll") for (int k = 0; k < 4; ++k) { \
                *(bf16_t*)(smem + SSD_XT + off128(p0 + 2 * k, lp)) = (bf16_t)(ww[k] & 0xffffu); \
                *(bf16_t*)(smem + SSD_XT + off128(p0 + 2 * k + 1, lp)) = (bf16_t)(ww[k] >> 16); } } while (0)
#define SSD_BIMG(i, BR, CR) do { const int idx = tid + 256 * (i), l = idx >> 4, n0 = (idx & 15) * 8, lp = perm16(l); \
            *(uint4*)(smem + SSD_BM + off256(l, n0)) = BR; *(uint4*)(smem + SSD_CM + off256(l, n0)) = CR; \
            const float wl = Fc[192 + l]; const unsigned ww[4] = {BR.x, BR.y, BR.z, BR.w}; \
            _Pragma("unroll") for (int k = 0; k < 4; ++k) { \
                *(bf16_t*)(smem + SSD_BWT + off128(n0 + 2 * k, lp)) = f2bf(bflo(ww[k]) * wl); \
                *(bf16_t*)(smem + SSD_BWT + off128(n0 + 2 * k + 1, lp)) = f2bf(bfhi(ww[k]) * wl); } } while (0)
        if (!(pm & 2)) {
        SSD_XIMG(0, xr0); SSD_XIMG(1, xr1);
        SSD_BIMG(0, br0, cr0); SSD_BIMG(1, br1, cr1); SSD_BIMG(2, br2, cr2); SSD_BIMG(3, br3, cr3);
        } else { asm volatile("" :: "v"(xr0.x), "v"(xr1.x), "v"(br0.x), "v"(br1.x), "v"(br2.x), "v"(br3.x), "v"(cr0.x), "v"(cr1.x), "v"(cr2.x), "v"(cr3.x)); }
        __syncthreads();
        if (c + 1 < 32) SSD_GLOAD(c + 1);
        if (!(pm & 1)) {
        const float acs_l = Fc[lb * 32 + r];
        const int lrow = lb * 32 + r;
        f32x16 cb0, cb1, yo;
#pragma unroll
        for (int e = 0; e < 16; ++e) { cb0[e] = 0.f; cb1[e] = 0.f; yo[e] = 0.f; }
#pragma unroll
        for (int ks = 0; ks < 8; ++ks) {
            const bf16x8 cv = *(const bf16x8*)(smem + SSD_CM + off256(lb * 32 + r, 16 * ks + 8 * h));
            const bf16x8 b0v = *(const bf16x8*)(smem + SSD_BM + off256(r, 16 * ks + 8 * h));
            const bf16x8 b1v = *(const bf16x8*)(smem + SSD_BM + off256(32 + r, 16 * ks + 8 * h));
            const bf16x8 pv = *(const bf16x8*)(smem + SSD_PS + off256(pb * 32 + r, 16 * ks + 8 * h));
            cb0 = MFMA32(b0v, cv, cb0); cb1 = MFMA32(b1v, cv, cb1); yo = MFMA32(cv, pv, yo);
        }
        f32x16 yd;
#pragma unroll
        for (int e = 0; e < 16; ++e) yd[e] = 0.f;
#pragma unroll
        for (int sb = 0; sb < 2; ++sb) {
            float mv[16];
#pragma unroll
            for (int q4 = 0; q4 < 4; ++q4) {
                const int s0 = sb * 32 + 8 * q4 + 4 * h;
                const float4 as4 = *(const float4*)(Fc + s0), dt4 = *(const float4*)(Fc + 128 + s0);
                const float asv[4] = {as4.x, as4.y, as4.z, as4.w}, dtv[4] = {dt4.x, dt4.y, dt4.z, dt4.w};
#pragma unroll
                for (int k = 0; k < 4; ++k) { const float cbv = sb ? cb1[4 * q4 + k] : cb0[4 * q4 + k]; mv[4 * q4 + k] = (s0 + k <= lrow) ? cbv * __expf(acs_l - asv[k]) * dtv[k] : 0.f; }
            }
#pragma unroll
            for (int s2 = 0; s2 < 2; ++s2) {
                uint4 pk;
                pk.x = pack2(mv[8 * s2], mv[8 * s2 + 1]); pk.y = pack2(mv[8 * s2 + 2], mv[8 * s2 + 3]);
                pk.z = pack2(mv[8 * s2 + 4], mv[8 * s2 + 5]); pk.w = pack2(mv[8 * s2 + 6], mv[8 * s2 + 7]);
                const bf16x8 xb = *(const bf16x8*)(smem + SSD_XT + off128(pb * 32 + r, sb * 32 + 16 * s2 + 8 * h));
                yd = MFMA32(__builtin_bit_cast(bf16x8, pk), xb, yd);
            }
        }
        {
            const uint4 x0 = *(const uint4*)(smem + SSD_XT + off128(pb * 32 + r, lb * 32 + 8 * h));
            const uint4 x1 = *(const uint4*)(smem + SSD_XT + off128(pb * 32 + r, lb * 32 + 16 + 8 * h));
            const unsigned xw[8] = {x0.x, x0.y, x0.z, x0.w, x1.x, x1.y, x1.z, x1.w};
            bf16_t* op = mix + (t0 + lb * 32 + 4 * h) * 1024 + 512 + hd * 64 + pb * 32 + r;
#pragma unroll
            for (int q4 = 0; q4 < 4; ++q4) {
                const float4 ea4 = *(const float4*)(Fc + 64 + lb * 32 + 8 * q4 + 4 * h);
                const float eav[4] = {ea4.x, ea4.y, ea4.z, ea4.w};
#pragma unroll
                for (int k = 0; k < 4; ++k) {
                    const int e = 4 * q4 + k;
                    const float xv = (e & 1) ? bfhi(xw[e >> 1]) : bflo(xw[e >> 1]);
                    const float y = yd[e] + eav[k] * yo[e] + Dh * xv;
                    op[(size_t)(k + 8 * q4) * 1024] = f2bf(y);
                }
            }
        }
        {
            const float dec = Fc[64 + 63];
#pragma unroll
            for (int e = 0; e < 16; ++e) { st[0][e] *= dec; st[1][e] *= dec; }
            const int nblk = 2 * (wave >> 1);
#pragma unroll
            for (int ks = 0; ks < 4; ++ks) {
                const bf16x8 av = *(const bf16x8*)(smem + SSD_XT + off128(pb * 32 + r, 16 * ks + 8 * h));
                const bf16x8 bv0 = *(const bf16x8*)(smem + SSD_BWT + off128(nblk * 32 + r, 16 * ks + 8 * h));
                const bf16x8 bv1 = *(const bf16x8*)(smem + SSD_BWT + off128(nblk * 32 + 32 + r, 16 * ks + 8 * h));
                st[0] = MFMA32(av, bv0, st[0]); st[1] = MFMA32(av, bv1, st[1]);
            }
        }
        }
        if (wave == 0 && c + 1 < 32) SSD_SCAN(Fn);
        __syncthreads();
#pragma unroll
        for (int i = 0; i < 2; ++i) {
            const int n = (2 * (wave >> 1) + i) * 32 + r;
#pragma unroll
            for (int e = 0; e < 16; ++e) *(bf16_t*)(smem + SSD_PS + off256(pb * 32 + crow(e, h), n)) = f2bf(st[i][e]);
        }
    }
    __syncthreads();
}

#if ATTN_NAIVE
DI void attn_naive(const P& p, int bid, int nb) {
    unsigned char* ws = p.ws;
    const bf16_t* Q = (const bf16_t*)(ws + QB); const bf16_t* Kn = (const bf16_t*)(ws + KNB); const bf16_t* Vt = (const bf16_t*)(ws + VTB);
    const bf16_t* Kr = (const bf16_t*)(ws + KROPE); bf16_t* mix = (bf16_t*)(ws + MIX);
    for (int item = bid; item < 128 * 8; item += nb) {
        const int bh = item >> 3, s_ = (item & 7) * 256 + tidx(), b = bh >> 3, hd = bh & 7;
        float q[96];
        {
            const uint4* q4 = (const uint4*)(Q + ((size_t)bh * 2048 + s_) * 96);
#pragma unroll
            for (int i = 0; i < 12; ++i) { const uint4 w = q4[i]; q[8 * i] = bflo(w.x); q[8 * i + 1] = bfhi(w.x); q[8 * i + 2] = bflo(w.y); q[8 * i + 3] = bfhi(w.y);
                q[8 * i + 4] = bflo(w.z); q[8 * i + 5] = bfhi(w.z); q[8 * i + 6] = bflo(w.w); q[8 * i + 7] = bfhi(w.w); }
        }
        float o[64];
#pragma unroll
        for (int d = 0; d < 64; ++d) o[d] = 0.f;
        float m = -1e30f, l = 0.f;
        const int nkeys = __builtin_amdgcn_readfirstlane(((s_ >> 6) + 1) * 64);
        for (int j0 = 0; j0 < nkeys; j0 += 8) {
            float sc[8];
#pragma unroll
            for (int jj = 0; jj < 8; ++jj) {
                const int j = j0 + jj;
                const uint4* k4 = (const uint4*)(Kn + ((size_t)bh * 2048 + j) * 64);
                const uint4* r4 = (const uint4*)(Kr + ((size_t)b * 2048 + j) * 32);
                float a = 0.f;
#pragma unroll
                for (int i = 0; i < 8; ++i) { const uint4 w = k4[i]; a += q[8 * i] * bflo(w.x) + q[8 * i + 1] * bfhi(w.x) + q[8 * i + 2] * bflo(w.y) + q[8 * i + 3] * bfhi(w.y)
                    + q[8 * i + 4] * bflo(w.z) + q[8 * i + 5] * bfhi(w.z) + q[8 * i + 6] * bflo(w.w) + q[8 * i + 7] * bfhi(w.w); }
#pragma unroll
                for (int i = 0; i < 4; ++i) { const uint4 w = r4[i]; const int o8 = 64 + 8 * i; a += q[o8] * bflo(w.x) + q[o8 + 1] * bfhi(w.x) + q[o8 + 2] * bflo(w.y) + q[o8 + 3] * bfhi(w.y)
                    + q[o8 + 4] * bflo(w.z) + q[o8 + 5] * bfhi(w.z) + q[o8 + 6] * bflo(w.w) + q[o8 + 7] * bfhi(w.w); }
                sc[jj] = a;
            }
            float mx = m;
#pragma unroll
            for (int jj = 0; jj < 8; ++jj) mx = fmaxf(mx, sc[jj]);
            const float al = exp2f(m - mx);
            float ps = 0.f;
#pragma unroll
            for (int jj = 0; jj < 8; ++jj) { sc[jj] = exp2f(sc[jj] - mx); ps += sc[jj]; }
            l = l * al + ps; m = mx;
#pragma unroll
            for (int d = 0; d < 64; ++d) {
                const uint4 w = *(const uint4*)(Vt + ((size_t)bh * 64 + d) * 2048 + j0);
                o[d] = o[d] * al + sc[0] * bflo(w.x) + sc[1] * bfhi(w.x) + sc[2] * bflo(w.y) + sc[3] * bfhi(w.y) + sc[4] * bflo(w.z) + sc[5] * bfhi(w.z) + sc[6] * bflo(w.w) + sc[7] * bfhi(w.w);
            }
        }
        const float il = 1.f / l;
        bf16_t* dst = mix + ((size_t)b * 2048 + s_) * 1024 + hd * 64;
#pragma unroll
        for (int d = 0; d < 64; d += 2) *(unsigned*)(dst + d) = pack2(o[d] * il, o[d + 1] * il);
    }
}
#endif
#if SSD_NAIVE
DI void ssd_naive(const P& p, int bid, int nb) {
    unsigned char* ws = p.ws;
    const bf16_t* xa = (const bf16_t*)(ws + XBCA); const float* dt = (const float*)(ws + DTB); const bf16_t* z = (const bf16_t*)(ws + ZB);
    bf16_t* mix = (bf16_t*)(ws + MIX);
    const int wave = tidx() >> 6, pp = tidx() & 63;
    for (int item = bid; item < 32; item += nb) {
        const int bh = item * 4 + wave, b = bh >> 3, hd = bh & 7, g = hd >> 2;
        const float a = -__expf(p.in[10][hd]), Dh = p.in[11][hd];
        float st[128];
#pragma unroll
        for (int n = 0; n < 128; ++n) st[n] = 0.f;
        for (int t = 0; t < 2048; ++t) {
            const size_t row = (size_t)b * 2048 + t;
            const float dtv = dt[row * 8 + hd];
            const float da = __expf(dtv * a);
            const float xv = bf2f(xa[row * 1024 + hd * 64 + pp]);
            const float xd = dtv * xv;
            const uint4* b4 = (const uint4*)(xa + row * 1024 + 512 + g * 128);
            const uint4* c4 = (const uint4*)(xa + row * 1024 + 768 + g * 128);
            float y = 0.f;
#pragma unroll
            for (int i = 0; i < 16; ++i) {
                const uint4 bw = b4[i], cw = c4[i];
                const unsigned bb[4] = {bw.x, bw.y, bw.z, bw.w}, cc[4] = {cw.x, cw.y, cw.z, cw.w};
#pragma unroll
                for (int k = 0; k < 4; ++k) {
                    const int n = 8 * i + 2 * k;
                    st[n] = da * st[n] + xd * bflo(bb[k]); y += bflo(cc[k]) * st[n];
                    st[n + 1] = da * st[n + 1] + xd * bfhi(bb[k]); y += bfhi(cc[k]) * st[n + 1];
                }
            }
            y += Dh * xv;
            const float zv = bf2f(z[row * 512 + hd * 64 + pp]);
            mix[row * 1024 + 512 + hd * 64 + pp] = f2bf(y * siluf(zv));
        }
    }
}
#endif
DI void phase_mixer(const P& p, int bid, int nb, unsigned char* smem, int rep = 0) {
#if SSD_NAIVE
    ssd_naive(p, bid, nb);
    attn_fast(p, bid, nb, smem);
#else
    unsigned* ctr = (unsigned*)(p.ws + CTL + CTL_QUEUE) + 64 * rep;
    int* slot = (int*)(smem + SMEM_BYTES - 32);
    for (;;) {
        __syncthreads();
        if (tidx() == 0) *slot = (int)atomicAdd(ctr, 1u);
        __syncthreads();
        const int it = *slot;
        if (it >= 128 + 2048) break;
        if (it < 128) { if (!NO_SSD && !(rep && REP_MODE == 2)) { if (rep) ssd_item<SSD_PM>(p, it, smem); else ssd_item<0>(p, it, smem); } }
        else if (rep && REP_MODE >= 1) { }
        else {
            const int idx = it - 128, qb = 15 - (idx >> 7), bh = idx & 127;
            unsigned char* ws = p.ws;
            SelfSrc s{(const bf16_t*)(ws + QB), (const bf16_t*)(ws + KNB), (const bf16_t*)(ws + KROPE), (const bf16_t*)(ws + VTB), (bf16_t*)(ws + MIX), bh >> 3, bh & 7, bh, qb * 128, (const float*)(ws + ROPE_C), (const float*)(ws + ROPE_S)};
            if (rep) s.mix = (bf16_t*)(ws + XBC);
            if (!NO_FLASH) flash_item<96, 64, 64, 4, 1>(s, 2 * qb + 2, 2, smem, rep && REP_MODE == 5);
        }
    }
#endif
}

DI void phase_ssdnorm(const P& p, int bid, int nb, unsigned char* smem) {
    bf16_t* mix = (bf16_t*)(p.ws + MIX); const bf16_t* z = (const bf16_t*)(p.ws + ZB);
    const int lane = tidx() & 63, wave = tidx() >> 6;
    for (int tk = bid * 4 + wave; tk < T; tk += nb * 4) {
        uint4* ptr = (uint4*)(mix + (size_t)tk * 1024 + 512 + lane * 8);
        const uint4 w = *ptr, zz = *(const uint4*)(z + (size_t)tk * 512 + lane * 8);
        const unsigned ww[4] = {w.x, w.y, w.z, w.w}, zw[4] = {zz.x, zz.y, zz.z, zz.w};
        float v[8]; float ss = 0.f;
#pragma unroll
        for (int k = 0; k < 4; ++k) {
            v[2 * k] = bflo(ww[k]) * siluf(bflo(zw[k])); v[2 * k + 1] = bfhi(ww[k]) * siluf(bfhi(zw[k]));
            ss += v[2 * k] * v[2 * k] + v[2 * k + 1] * v[2 * k + 1];
        }
#pragma unroll
        for (int o = 16; o >= 1; o >>= 1) ss += __shfl_xor(ss, o);
        const float rr = rsqrtf(ss * (1.f / 256.f) + EPS);
        uint4 o4; o4.x = pack2(v[0] * rr, v[1] * rr); o4.y = pack2(v[2] * rr, v[3] * rr); o4.z = pack2(v[4] * rr, v[5] * rr); o4.w = pack2(v[6] * rr, v[7] * rr);
        *ptr = o4;
    }
}

template <bool RES_BF16>
struct EpiResid {
    bf16_t* pre; const void* res;
    float4 pf[RES_BF16 ? 1 : 16]; uint2 pb[RES_BF16 ? 16 : 1];
    DI void prefetch(int m0, int n0, int tid) {
        const int c4 = (tid & 31) * 4, r0 = tid >> 5;
#pragma unroll
        for (int ps = 0; ps < 16; ++ps) {
            const size_t idx = (size_t)(m0 + ps * 8 + r0) * 1024 + n0 + c4;
            if (RES_BF16) pb[ps] = *(const uint2*)((const bf16_t*)res + idx); else pf[ps] = *(const float4*)((const float*)res + idx);
        }
    }
    DI void operator()(const float* Cs, int m0, int n0, int tid) const {
        const int c4 = (tid & 31) * 4, r0 = tid >> 5;
#pragma unroll
        for (int ps = 0; ps < 16; ++ps) {
            const int row = ps * 8 + r0;
            const float4 v = cs4(Cs, row, c4);
            float4 rr;
            if (RES_BF16) rr = make_float4(bflo(pb[ps].x), bfhi(pb[ps].x), bflo(pb[ps].y), bfhi(pb[ps].y)); else rr = pf[ps];
            *(uint2*)(pre + (size_t)(m0 + row) * 1024 + n0 + c4) = pack4(make_float4(ALPHA * rr.x + v.x, ALPHA * rr.y + v.y, ALPHA * rr.z + v.z, ALPHA * rr.w + v.w));
        }
    }
};
DI void phase_wout(const P& p, int bid, int nb, unsigned char* smem) {
    const int v = vbid(bid, nb);
    EpiResid<true> e; e.pre = (bf16_t*)p.out; e.res = p.out;
    GemmArgs g{(const bf16_t*)(p.ws + MIX), 1024, (const bf16_t*)(p.ws + W_OUT), 1024, 1024, nullptr};
    for (int t = v; t < 256 * 8; t += nb) gemm_tile(g, (t >> 3) * 128, (t & 7) * 128, e, smem);
}
DI void ln_row(const float* src, const float* gam, const float* bet, int lane, float (&o)[16]) {
    float v[16];
#pragma unroll
    for (int i = 0; i < 4; ++i) { const float4 t4 = *(const float4*)(src + i * 256 + lane * 4); v[4 * i] = t4.x; v[4 * i + 1] = t4.y; v[4 * i + 2] = t4.z; v[4 * i + 3] = t4.w; }
    float s = 0.f;
#pragma unroll
    for (int i = 0; i < 16; ++i) s += v[i];
    const float mu = wave_sum(s) * (1.f / 1024.f);
    float q = 0.f;
#pragma unroll
    for (int i = 0; i < 16; ++i) { const float d = v[i] - mu; q += d * d; }
    const float rstd = rsqrtf(wave_sum(q) * (1.f / 1024.f) + EPS);
#pragma unroll
    for (int i = 0; i < 4; ++i) {
        const float4 g4 = *(const float4*)(gam + i * 256 + lane * 4), b4 = *(const float4*)(bet + i * 256 + lane * 4);
        o[4 * i] = (v[4 * i] - mu) * rstd * g4.x + b4.x; o[4 * i + 1] = (v[4 * i + 1] - mu) * rstd * g4.y + b4.y;
        o[4 * i + 2] = (v[4 * i + 2] - mu) * rstd * g4.z + b4.z; o[4 * i + 3] = (v[4 * i + 3] - mu) * rstd * g4.w + b4.w;
    }
}
DI void ln_stats2(const float (&va)[16], const float (&vb)[16], float& mua, float& rsa, float& mub, float& rsb) {
    float sa = 0.f, sb = 0.f;
#pragma unroll
    for (int i = 0; i < 16; ++i) { sa += va[i]; sb += vb[i]; }
#pragma unroll
    for (int o = 32; o >= 1; o >>= 1) { sa += __shfl_xor(sa, o); sb += __shfl_xor(sb, o); }
    mua = sa * (1.f / 1024.f); mub = sb * (1.f / 1024.f);
    float qa = 0.f, qb = 0.f;
#pragma unroll
    for (int i = 0; i < 16; ++i) { const float da = va[i] - mua, db = vb[i] - mub; qa += da * da; qb += db * db; }
#pragma unroll
    for (int o = 32; o >= 1; o >>= 1) { qa += __shfl_xor(qa, o); qb += __shfl_xor(qb, o); }
    rsa = rsqrtf(qa * (1.f / 1024.f) + EPS); rsb = rsqrtf(qb * (1.f / 1024.f) + EPS);
}
DI void load_row16(const bf16_t* src, int lane, float (&v)[16]) {
#pragma unroll
    for (int i = 0; i < 4; ++i) { const uint2 t2 = *(const uint2*)(src + i * 256 + lane * 4); v[4 * i] = bflo(t2.x); v[4 * i + 1] = bfhi(t2.x); v[4 * i + 2] = bflo(t2.y); v[4 * i + 3] = bfhi(t2.y); }
}
DI void phase_ln1(const P& p, int bid, int nb, unsigned char* smem) {
    const int lane = tidx() & 63, wave = tidx() >> 6;
    const bf16_t* pre = (const bf16_t*)p.out; bf16_t* hb = (bf16_t*)(p.ws + H1B);
    const float* gam = p.in[14]; const float* bet = p.in[15];
    for (int tk = bid * 4 + wave; tk < T; tk += nb * 8) {
        const int tk2 = tk + nb * 4;
        float va[16], vb[16], mua, rsa, mub, rsb;
        load_row16(pre + (size_t)tk * 1024, lane, va); load_row16(pre + (size_t)tk2 * 1024, lane, vb);
        ln_stats2(va, vb, mua, rsa, mub, rsb);
#pragma unroll
        for (int i = 0; i < 4; ++i) {
            const float4 g4 = *(const float4*)(gam + i * 256 + lane * 4), b4 = *(const float4*)(bet + i * 256 + lane * 4);
            const float4 oa = make_float4((va[4 * i] - mua) * rsa * g4.x + b4.x, (va[4 * i + 1] - mua) * rsa * g4.y + b4.y, (va[4 * i + 2] - mua) * rsa * g4.z + b4.z, (va[4 * i + 3] - mua) * rsa * g4.w + b4.w);
            const float4 ob = make_float4((vb[4 * i] - mub) * rsb * g4.x + b4.x, (vb[4 * i + 1] - mub) * rsb * g4.y + b4.y, (vb[4 * i + 2] - mub) * rsb * g4.z + b4.z, (vb[4 * i + 3] - mub) * rsb * g4.w + b4.w);
            *(uint2*)(hb + (size_t)tk * 1024 + i * 256 + lane * 4) = pack4(oa); *(uint2*)(hb + (size_t)tk2 * 1024 + i * 256 + lane * 4) = pack4(ob);
        }
    }
}
struct EpiXq {
    bf16_t* qx;
    DI void prefetch(int, int, int) {}
    DI void operator()(const float* Cs, int m0, int n0, int tid) const {
        const int c4 = (tid & 31) * 4, r0 = tid >> 5, hd = n0 >> 8, d = (n0 & 255) + c4, b = m0 >> 11, s0 = m0 & 2047;
#pragma unroll 4
        for (int ps = 0; ps < 16; ++ps) {
            const int row = ps * 8 + r0;
            float4 v = cs4(Cs, row, c4); v.x *= XSCALE; v.y *= XSCALE; v.z *= XSCALE; v.w *= XSCALE;
            *(uint2*)(qx + ((size_t)(b * 4 + hd) * 2048 + s0 + row) * 256 + d) = pack4(v);
        }
    }
};
DI void phase_xq(const P& p, int bid, int nb, unsigned char* smem) {
    const int v = vbid(bid, nb);
    EpiXq e{(bf16_t*)(p.ws + QX)};
    GemmArgs g{(const bf16_t*)(p.ws + H1B), 1024, (const bf16_t*)(p.ws + W_XQ), 1024, 1024, nullptr};
    for (int t = v; t < 256 * 8; t += nb) gemm_tile(g, (t >> 3) * 128, (t & 7) * 128, e, smem);
}
DI void phase_xattn(const P& p, int bid, int nb, unsigned char* smem, int rep = 0) {
#if !XATTN_NAIVE
    xattn_fast(p, bid, nb, smem, rep); return;
#endif
    unsigned char* ws = p.ws;
    const bf16_t* qx = (const bf16_t*)(ws + QX); const bf16_t* kx = (const bf16_t*)(ws + KX); const bf16_t* vxt = (const bf16_t*)(ws + VXT);
    bf16_t* ox = (bf16_t*)(ws + OX);
    const int lane = tidx() & 63, hd = tidx() >> 6;
    float* qs = (float*)smem + hd * 512; float* ps = qs + 256;
    for (int tk = bid; tk < T; tk += nb) {
        const int b = tk >> 11, s_ = tk & 2047;
        __syncthreads();
        {
            const uint2 w = *(const uint2*)(qx + ((size_t)(b * 4 + hd) * 2048 + s_) * 256 + lane * 4);
            qs[lane * 4] = bflo(w.x); qs[lane * 4 + 1] = bfhi(w.x); qs[lane * 4 + 2] = bflo(w.y); qs[lane * 4 + 3] = bfhi(w.y);
        }
        __syncthreads();
        float sc[4];
#pragma unroll
        for (int i = 0; i < 4; ++i) {
            const int m = lane + 64 * i;
            const uint4* k4 = (const uint4*)(kx + ((size_t)(b * 4 + hd) * 256 + m) * 256);
            float a = 0.f;
#pragma unroll 8
            for (int c = 0; c < 32; ++c) {
                const uint4 w = k4[c];
                const float4 q0 = *(const float4*)(qs + 8 * c), q1 = *(const float4*)(qs + 8 * c + 4);
                a += q0.x * bflo(w.x) + q0.y * bfhi(w.x) + q0.z * bflo(w.y) + q0.w * bfhi(w.y) + q1.x * bflo(w.z) + q1.y * bfhi(w.z) + q1.z * bflo(w.w) + q1.w * bfhi(w.w);
            }
            sc[i] = a;
        }
        const float mx = wave_max(fmaxf(fmaxf(sc[0], sc[1]), fmaxf(sc[2], sc[3])));
        float sum = 0.f;
#pragma unroll
        for (int i = 0; i < 4; ++i) { sc[i] = exp2f(sc[i] - mx); sum += sc[i]; }
        const float il = 1.f / wave_sum(sum);
#pragma unroll
        for (int i = 0; i < 4; ++i) ps[lane + 64 * i] = sc[i] * il;
        __syncthreads();
        float o[4];
#pragma unroll
        for (int dd = 0; dd < 4; ++dd) {
            const int d = lane * 4 + dd;
            const uint4* v4 = (const uint4*)(vxt + ((size_t)(b * 4 + hd) * 256 + d) * 256);
            float a = 0.f;
#pragma unroll 8
            for (int c = 0; c < 32; ++c) {
                const uint4 w = v4[c];
                const float4 q0 = *(const float4*)(ps + 8 * c), q1 = *(const float4*)(ps + 8 * c + 4);
                a += q0.x * bflo(w.x) + q0.y * bfhi(w.x) + q0.z * bflo(w.y) + q0.w * bfhi(w.y) + q1.x * bflo(w.z) + q1.y * bfhi(w.z) + q1.z * bflo(w.w) + q1.w * bfhi(w.w);
            }
            o[dd] = a;
        }
        uint2 w; w.x = pack2(o[0], o[1]); w.y = pack2(o[2], o[3]);
        *(uint2*)(ox + (size_t)tk * 1024 + hd * 256 + lane * 4) = w;
    }
}
DI void phase_xo(const P& p, int bid, int nb, unsigned char* smem) {
    const int v = vbid(bid, nb);
    EpiResid<true> e; e.pre = (bf16_t*)p.out; e.res = p.ws + H1B;
    GemmArgs g{(const bf16_t*)(p.ws + OX), 1024, (const bf16_t*)(p.ws + W_XO), 1024, 1024, nullptr};
    for (int t = v; t < 256 * 8; t += nb) gemm_tile(g, (t >> 3) * 128, (t & 7) * 128, e, smem);
}
DI void phase_ln2_router(const P& p, int bid, int nb, unsigned char* smem, int rep = 0) {
    unsigned char* ws = p.ws;
    const int lane = tidx() & 63, wave = tidx() >> 6;
    const bf16_t* pre = (const bf16_t*)p.out; bf16_t* hb = (bf16_t*)(ws + H2B);
    const float* wrt = (const float*)(ws + W_RT);
    const float* gam = p.in[20]; const float* bet = p.in[21];
    unsigned* cnt = (unsigned*)(ws + CTL + CTL_CNT); int* lists = (int*)(ws + LISTS); float* tgate = (float*)(ws + TOK_GATE);
    float* lg = (float*)smem + wave * (16 * 52 + 32);
    float* stt = lg + 16 * 52;
    for (int grp = bid; grp < T / 64; grp += nb) {
        const int t0 = grp * 64 + wave * 16;
        for (int rr = 0; rr < 16; rr += 2) {
            if (rep && REP_MODE == 3) break;
            const int tk = t0 + rr;
            float va[16], vb[16], mua, rsa, mub, rsb;
            load_row16(pre + (size_t)tk * 1024, lane, va); load_row16(pre + (size_t)(tk + 1) * 1024, lane, vb);
            ln_stats2(va, vb, mua, rsa, mub, rsb);
            if (lane == 0) { stt[2 * rr] = mua; stt[2 * rr + 1] = rsa; stt[2 * rr + 2] = mub; stt[2 * rr + 3] = rsb; }
#pragma unroll
            for (int i = 0; i < 4; ++i) {
                const float4 g4 = *(const float4*)(gam + i * 256 + lane * 4), b4 = *(const float4*)(bet + i * 256 + lane * 4);
                const float4 oa = make_float4((va[4 * i] - mua) * rsa * g4.x + b4.x, (va[4 * i + 1] - mua) * rsa * g4.y + b4.y, (va[4 * i + 2] - mua) * rsa * g4.z + b4.z, (va[4 * i + 3] - mua) * rsa * g4.w + b4.w);
                const float4 ob = make_float4((vb[4 * i] - mub) * rsb * g4.x + b4.x, (vb[4 * i + 1] - mub) * rsb * g4.y + b4.y, (vb[4 * i + 2] - mub) * rsb * g4.z + b4.z, (vb[4 * i + 3] - mub) * rsb * g4.w + b4.w);
                *(uint2*)(hb + (size_t)tk * 1024 + i * 256 + lane * 4) = pack4(oa); *(uint2*)(hb + (size_t)(tk + 1) * 1024 + i * 256 + lane * 4) = pack4(ob);
            }
        }
        __builtin_amdgcn_wave_barrier();
        if (!(rep && REP_MODE == 2)) {
            const int i16 = lane & 15, g4i = lane >> 4;
            const float mu = stt[2 * i16], rstd = stt[2 * i16 + 1];
            const bf16_t* arow = pre + (size_t)(t0 + i16) * 1024 + 4 * g4i;
            const float* brow = wrt + (size_t)i16 * 1024 + 4 * g4i;
            const float* grow = gam + 4 * g4i; const float* berow = bet + 4 * g4i;
            f32x4v acc0 = {0.f, 0.f, 0.f, 0.f}, acc1 = acc0, acc2 = acc0;
#pragma unroll 4
            for (int S = 0; S < 64; ++S) {
                const uint2 xw = *(const uint2*)(arow + 16 * S); const float4 x4 = make_float4(bflo(xw.x), bfhi(xw.x), bflo(xw.y), bfhi(xw.y));
                const float4 g4 = *(const float4*)(grow + 16 * S), e4 = *(const float4*)(berow + 16 * S);
                const float4 b0 = *(const float4*)(brow + 16 * S), b1 = *(const float4*)(brow + 16 * 1024 + 16 * S), b2 = *(const float4*)(brow + 32 * 1024 + 16 * S);
                const float a0 = (x4.x - mu) * rstd * g4.x + e4.x, a1 = (x4.y - mu) * rstd * g4.y + e4.y, a2 = (x4.z - mu) * rstd * g4.z + e4.z, a3 = (x4.w - mu) * rstd * g4.w + e4.w;
                acc0 = __builtin_amdgcn_mfma_f32_16x16x4f32(a0, b0.x, acc0, 0, 0, 0); acc1 = __builtin_amdgcn_mfma_f32_16x16x4f32(a0, b1.x, acc1, 0, 0, 0); acc2 = __builtin_amdgcn_mfma_f32_16x16x4f32(a0, b2.x, acc2, 0, 0, 0);
                acc0 = __builtin_amdgcn_mfma_f32_16x16x4f32(a1, b0.y, acc0, 0, 0, 0); acc1 = __builtin_amdgcn_mfma_f32_16x16x4f32(a1, b1.y, acc1, 0, 0, 0); acc2 = __builtin_amdgcn_mfma_f32_16x16x4f32(a1, b2.y, acc2, 0, 0, 0);
                acc0 = __builtin_amdgcn_mfma_f32_16x16x4f32(a2, b0.z, acc0, 0, 0, 0); acc1 = __builtin_amdgcn_mfma_f32_16x16x4f32(a2, b1.z, acc1, 0, 0, 0); acc2 = __builtin_amdgcn_mfma_f32_16x16x4f32(a2, b2.z, acc2, 0, 0, 0);
                acc0 = __builtin_amdgcn_mfma_f32_16x16x4f32(a3, b0.w, acc0, 0, 0, 0); acc1 = __builtin_amdgcn_mfma_f32_16x16x4f32(a3, b1.w, acc1, 0, 0, 0); acc2 = __builtin_amdgcn_mfma_f32_16x16x4f32(a3, b2.w, acc2, 0, 0, 0);
            }
#pragma unroll
            for (int e = 0; e < 4; ++e) {
                float* rowp = lg + (4 * g4i + e) * 52 + i16;
                rowp[0] = acc0[e]; rowp[16] = acc1[e]; rowp[32] = acc2[e];
            }
        }
        __builtin_amdgcn_wave_barrier();
        unsigned* lcount = (unsigned*)((float*)smem + 4 * (16 * 52 + 32));
        unsigned* lbase = lcount + 32;
        if (tidx() < 32) lcount[tidx()] = 0u;
        __syncthreads();
        int ex1 = 0, ex2 = 0; unsigned lp1 = 0, lp2 = 0;
        if (lane < 16) {
            const int tk = t0 + lane;
            const float* lr = lg + lane * 52;
            float gl[4], el[32];
#pragma unroll
            for (int j = 0; j < 4; ++j) gl[j] = lr[j] + p.in[23][j];
#pragma unroll
            for (int j = 0; j < 32; ++j) el[j] = lr[4 + j] + p.in[25][j];
            int gi = 0; float gm = gl[0];
#pragma unroll
            for (int j = 1; j < 4; ++j) if (gl[j] > gm) { gm = gl[j]; gi = j; }
            float gs = 0.f;
#pragma unroll
            for (int j = 0; j < 4; ++j) gs += __expf(gl[j] - gm);
            const float ggate = 1.f / gs;
            float ev[8];
#pragma unroll
            for (int j = 0; j < 8; ++j) ev[j] = gi == 0 ? el[j] : gi == 1 ? el[8 + j] : gi == 2 ? el[16 + j] : el[24 + j];
            int i1 = 0; float v1 = ev[0];
#pragma unroll
            for (int j = 1; j < 8; ++j) if (ev[j] > v1) { v1 = ev[j]; i1 = j; }
            int i2 = -1; float v2 = -3.0e38f;
#pragma unroll
            for (int j = 0; j < 8; ++j) if (j != i1 && ev[j] > v2) { v2 = ev[j]; i2 = j; }
            const float e2 = __expf(v2 - v1);
            tgate[tk * 2] = ggate / (1.f + e2); tgate[tk * 2 + 1] = ggate * e2 / (1.f + e2);
            ex1 = gi * 8 + i1; ex2 = gi * 8 + i2;
            if (!rep) { lp1 = atomicAdd(&lcount[ex1], 1u); lp2 = atomicAdd(&lcount[ex2], 1u); }
        }
        __syncthreads();
        if (tidx() < 32 && !rep) { const unsigned c = lcount[tidx()]; lbase[tidx()] = c ? atomicAdd(&cnt[tidx() * CNT_STRIDE], c) : 0u; }
        __syncthreads();
        if (lane < 16 && !rep) {
            const int tk = t0 + lane;
            lists[(size_t)ex1 * T + lbase[ex1] + lp1] = tk * 2;
            lists[(size_t)ex2 * T + lbase[ex2] + lp2] = tk * 2 + 1;
        }
        __syncthreads();
    }
}
struct MoeMap { int off[33]; };
DI int moe_tiles(const unsigned* cnt, int* offs  ) {
    __syncthreads();
    if (tidx() == 0) { int o = 0; for (int e = 0; e < 32; ++e) { offs[e] = o; o += (((int)cnt[e * CNT_STRIDE] + 127) >> 7) << 7; } offs[32] = o; }
    __syncthreads();
    return offs[32] >> 7;
}
struct EpiGU {
    bf16_t* hdn;
    DI void prefetch(int, int, int) {}
    DI void operator()(const float* Cs, int m0, int n0, int tid) const {
#pragma unroll 4
        for (int ps = 0; ps < 8; ++ps) {
            const int it = ps * 256 + tid, row = it >> 4, qd = it & 15, c = (qd >> 3) * 64 + (qd & 7) * 4;
            const float4 g = cs4(Cs, row, c), u = cs4(Cs, row, c + 32);
            const int hc = ((n0 & 511) >> 7) * 64 + (qd >> 3) * 32 + (qd & 7) * 4;
            *(uint2*)(hdn + (size_t)(m0 + row) * 256 + hc) = pack4(make_float4(siluf(g.x) * u.x, siluf(g.y) * u.y, siluf(g.z) * u.z, siluf(g.w) * u.w));
        }
    }
};
struct EpiDown {
    bf16_t* y; int* ltok; float* lgate; const int* lst; int nvalid; const float* tgate;
    DI void prefetch(int, int, int tid) {
        if (tid < 128) { const int tk2 = tid < nvalid ? lst[tid] : -1; ltok[tid] = tk2; lgate[tid] = tk2 < 0 ? 0.f : tgate[tk2]; }
    }
    DI void operator()(const float* Cs, int m0, int n0, int tid) const {
        const int c4 = (tid & 31) * 4, r0 = tid >> 5;
#pragma unroll 4
        for (int ps = 0; ps < 16; ++ps) {
            const int row = ps * 8 + r0, tk2 = ltok[row];
            if (tk2 >= 0) {
                const float gt = lgate[row];
                float4 v = cs4(Cs, row, c4); v.x *= gt; v.y *= gt; v.z *= gt; v.w *= gt;
                *(uint2*)(y + (size_t)tk2 * 1024 + n0 + c4) = pack4(v);
            }
        }
    }
};
template <int WHICH>
DI void phase_moe(const P& p, int bid, int nb, unsigned char* smem) {
    unsigned char* ws = p.ws;
    const unsigned* cnt = (const unsigned*)(ws + CTL + CTL_CNT); const int* lists = (const int*)(ws + LISTS); const float* tgate = (const float*)(ws + TOK_GATE);
    int* offs = (int*)(smem + GEMM_LDS); int* ltok = offs + 64; int* lrow = ltok + 128; float* lgate = (float*)(lrow + 128);
    const int nmt = moe_tiles(cnt, offs);
    constexpr int NNT = WHICH == 0 ? 4 : 8;
    const int v = vbid(bid, nb);
    for (int t = v; t < nmt * NNT; t += nb) {
        const int mt = t / NNT, ntl = t % NNT;
        const int slot0 = mt * 128;
        int e = 0;
        while (offs[e + 1] <= slot0) ++e;
        if (WHICH == 0) {
            __syncthreads();
            if (tidx() < 128) {
                const int pos = slot0 - offs[e] + tidx();
                const int tk2 = pos < (int)cnt[e * CNT_STRIDE] ? lists[(size_t)e * T + pos] : -1;
                lrow[tidx()] = tk2 < 0 ? 0 : (tk2 >> 1);
            }
            __syncthreads();
        }
        if (WHICH == 0) {
            EpiGU ep{(bf16_t*)(ws + HDN)};
            GemmArgs g{(const bf16_t*)(ws + H2B), 1024, (const bf16_t*)(ws + W_GU) + (size_t)e * 512 * 1024, 1024, 1024, lrow};
            gemm_tile(g, slot0, ntl * 128, ep, smem);
        } else {
            EpiDown ep{(bf16_t*)(ws + YB), ltok, lgate, lists + (size_t)e * T + (slot0 - offs[e]), (int)cnt[e * CNT_STRIDE] - (slot0 - offs[e]), tgate};
            GemmArgs g{(const bf16_t*)(ws + HDN), 256, (const bf16_t*)(ws + W_DN) + (size_t)e * 1024 * 256, 256, 256, nullptr};
            gemm_tile(g, slot0, ntl * 128, ep, smem);
        }
    }
}
DI void phase_final(const P& p, int bid, int nb, unsigned char* smem) {
    const int lane = tidx() & 63, wave = tidx() >> 6;
    const bf16_t* hb2 = (const bf16_t*)(p.ws + H2B); const bf16_t* y = (const bf16_t*)(p.ws + YB);
    const float* gam = p.in[29]; const float* bet = p.in[30];
    for (int tk = bid * 4 + wave; tk < T; tk += nb * 8) {
        const int tk2 = tk + nb * 4;
        float va[16], vb[16], mua, rsa, mub, rsb;
#pragma unroll
        for (int i = 0; i < 4; ++i) {
            const uint2 ha = *(const uint2*)(hb2 + (size_t)tk * 1024 + i * 256 + lane * 4), hbv = *(const uint2*)(hb2 + (size_t)tk2 * 1024 + i * 256 + lane * 4);
            const float4 ta = make_float4(bflo(ha.x), bfhi(ha.x), bflo(ha.y), bfhi(ha.y)), tb = make_float4(bflo(hbv.x), bfhi(hbv.x), bflo(hbv.y), bfhi(hbv.y));
            const uint2 a0 = *(const uint2*)(y + (size_t)(tk * 2) * 1024 + i * 256 + lane * 4), a1 = *(const uint2*)(y + (size_t)(tk * 2 + 1) * 1024 + i * 256 + lane * 4);
            const uint2 b0 = *(const uint2*)(y + (size_t)(tk2 * 2) * 1024 + i * 256 + lane * 4), b1 = *(const uint2*)(y + (size_t)(tk2 * 2 + 1) * 1024 + i * 256 + lane * 4);
            va[4 * i] = ALPHA * ta.x + bflo(a0.x) + bflo(a1.x); va[4 * i + 1] = ALPHA * ta.y + bfhi(a0.x) + bfhi(a1.x); va[4 * i + 2] = ALPHA * ta.z + bflo(a0.y) + bflo(a1.y); va[4 * i + 3] = ALPHA * ta.w + bfhi(a0.y) + bfhi(a1.y);
            vb[4 * i] = ALPHA * tb.x + bflo(b0.x) + bflo(b1.x); vb[4 * i + 1] = ALPHA * tb.y + bfhi(b0.x) + bfhi(b1.x); vb[4 * i + 2] = ALPHA * tb.z + bflo(b0.y) + bflo(b1.y); vb[4 * i + 3] = ALPHA * tb.w + bfhi(b0.y) + bfhi(b1.y);
        }
        ln_stats2(va, vb, mua, rsa, mub, rsb);
#pragma unroll
        for (int i = 0; i < 4; ++i) {
            const float4 g4 = *(const float4*)(gam + i * 256 + lane * 4), b4 = *(const float4*)(bet + i * 256 + lane * 4);
            *(float4*)(p.out + (size_t)tk * 1024 + i * 256 + lane * 4) = make_float4((va[4 * i] - mua) * rsa * g4.x + b4.x, (va[4 * i + 1] - mua) * rsa * g4.y + b4.y, (va[4 * i + 2] - mua) * rsa * g4.z + b4.z, (va[4 * i + 3] - mua) * rsa * g4.w + b4.w);
            *(float4*)(p.out + (size_t)tk2 * 1024 + i * 256 + lane * 4) = make_float4((vb[4 * i] - mub) * rsb * g4.x + b4.x, (vb[4 * i + 1] - mub) * rsb * g4.y + b4.y, (vb[4 * i + 2] - mub) * rsb * g4.z + b4.z, (vb[4 * i + 3] - mub) * rsb * g4.w + b4.w);
        }
    }
}

#define XB_TMO      128
#define XB_XCNT(j)  (256  + 64 * (j))
#define XB_XSUB(j)  (1280 + 64 * (j))
#define XB_XGEN(j)  (2304 + 64 * (j))
#define XB_TOP      3328
#define XB_TOPGEN   3392
#define XCD_BAR_WORDS 3456
#define XB_SPIN_CAP (1u << 25)
DI unsigned xb_ld(unsigned* p) { return __hip_atomic_load(p, __ATOMIC_RELAXED, __HIP_MEMORY_SCOPE_AGENT); }
DI unsigned xb_add(unsigned* p, unsigned v) { return __hip_atomic_fetch_add(p, v, __ATOMIC_RELAXED, __HIP_MEMORY_SCOPE_AGENT); }
DI unsigned xb_xcc_id() { return (unsigned)__builtin_amdgcn_s_getreg((3 << 11) | 20) & 0xFu; }
#define XB_SPIN(cond, bar) do { unsigned _sp = 0; while (cond) { __builtin_amdgcn_s_sleep(1); \
    if ((++_sp & 255u) == 0u) { if (xb_ld(&(bar)[XB_TMO])) break; if (_sp > XB_SPIN_CAP) { atomicAdd(&(bar)[XB_TMO], 1u); break; } } } } while (0)
struct XcdBarrier { unsigned* bar; unsigned x; volatile LAS unsigned* st; };
DI XcdBarrier xcd_barrier_post(unsigned* bar, volatile LAS unsigned* st) {
    XcdBarrier b; b.bar = bar; b.x = xb_xcc_id(); b.st = st;
    if (threadIdx.x == 0) (void)xb_add(&bar[XB_XCNT(b.x)], 1u);
    return b;
}
DI void xcd_barrier_complete(unsigned* bar, unsigned x, unsigned& nloc, unsigned& nx) {
    const unsigned G = gridDim.x * gridDim.y * gridDim.z;
    unsigned sum, cnt, mine, sp = 0u;
    for (;;) {
        sum = 0u; cnt = 0u; mine = 0u;
#pragma unroll
        for (unsigned j = 0; j < 16; ++j) { const unsigned c = xb_ld(&bar[XB_XCNT(j)]); sum += c; cnt += (c > 0u) ? 1u : 0u; mine = (j == x) ? c : mine; }
        if (sum == G) break;
        __builtin_amdgcn_s_sleep(1);
        if ((++sp & 255u) == 0u) { if (xb_ld(&bar[XB_TMO])) break; if (sp > XB_SPIN_CAP) { atomicAdd(&bar[XB_TMO], 1u); break; } }
    }
    nloc = mine > 0u ? mine : 1u; nx = cnt > 0u ? cnt : 1u;
}
DI void xcd_barrier(const XcdBarrier& b) {
    asm volatile("s_waitcnt vmcnt(0)" ::: "memory");
    __syncthreads();
    if (threadIdx.x == 0) {
        unsigned* bar = b.bar;
        __builtin_amdgcn_s_waitcnt(0);
        unsigned nloc = b.st[0], nx = b.st[1];
        if (nloc == 0u) { xcd_barrier_complete(bar, b.x, nloc, nx); b.st[0] = nloc; b.st[1] = nx; }
        const unsigned old = xb_add(&bar[XB_XSUB(b.x)], 1u);
        const unsigned gen = old / nloc;
        if (old + 1u == (gen + 1u) * nloc) {
            __builtin_amdgcn_fence(__ATOMIC_RELEASE, "agent");
            asm volatile("s_waitcnt vmcnt(0)" ::: "memory");
            const unsigned og = xb_add(&bar[XB_TOP], 1u);
            const unsigned tg = og / nx;
            if (og + 1u == (tg + 1u) * nx) xb_add(&bar[XB_TOPGEN], 1u);
            else XB_SPIN(xb_ld(&bar[XB_TOPGEN]) == tg, bar);
            __builtin_amdgcn_fence(__ATOMIC_ACQUIRE, "agent");
            xb_add(&bar[XB_XGEN(b.x)], 1u);
            asm volatile("s_waitcnt vmcnt(0)" ::: "memory");
        } else {
            XB_SPIN(xb_ld(&bar[XB_XGEN(b.x)]) == gen, bar);
            __builtin_amdgcn_fence(__ATOMIC_ACQUIRE, "agent");
            asm volatile("s_waitcnt vmcnt(0)" ::: "memory");
        }
    }
    __syncthreads();
}

constexpr int NPHASE = 14;
template <int PH>
DI void run_phase(const P& p, int bid, int nb, unsigned char* smem, int rep = 0) {
    if (PH == 0) phase_prep(p, bid, nb, smem);
    else if (PH == 1) phase_proj(p, bid, nb, smem, rep);
    else if (PH == 2) phase_up(p, bid, nb, smem, rep);
    else if (PH == 3) phase_mixer(p, bid, nb, smem, rep);
    else if (PH == 4) phase_ssdnorm(p, bid, nb, smem);
    else if (PH == 5) phase_wout(p, bid, nb, smem);
    else if (PH == 6) phase_ln1(p, bid, nb, smem);
    else if (PH == 7) phase_xq(p, bid, nb, smem);
    else if (PH == 8) phase_xattn(p, bid, nb, smem, rep);
    else if (PH == 9) phase_xo(p, bid, nb, smem);
    else if (PH == 10) phase_ln2_router(p, bid, nb, smem, rep);
    else if (PH == 11) phase_moe<0>(p, bid, nb, smem);
    else if (PH == 12) phase_moe<1>(p, bid, nb, smem);
    else if (PH == 13) phase_final(p, bid, nb, smem);
}
template <int PH>
__global__ void __launch_bounds__(256, 2) k_phase(P p) {
    __shared__ __attribute__((aligned(16))) unsigned char smem[SMEM_BYTES];
    run_phase<PH>(p, blockIdx.x, gridDim.x, smem);
}

#if MEGA
#ifndef MEGA_WAVES
#define MEGA_WAVES 2
#endif
template <int PH>
DI void mega_steps(const P& p, const XcdBarrier& bar, unsigned char* smem) {
    run_phase<PH>(p, blockIdx.x, gridDim.x, smem);
    if constexpr (((REPEAT_MASK >> PH) & 1) != 0) { xcd_barrier(bar); run_phase<PH>(p, blockIdx.x, gridDim.x, smem, 1); }
    if constexpr (PH == 6 && EXTRA_BARRIERS > 0) { for (int i = 0; i < EXTRA_BARRIERS; ++i) xcd_barrier(bar); }
    if constexpr (PH + 1 < NPHASE) { xcd_barrier(bar); mega_steps<PH + 1>(p, bar, smem); }
}
__global__ void __launch_bounds__(256, MEGA_WAVES) k_mega(P p) {
    __shared__ __attribute__((aligned(16))) unsigned char smem[SMEM_BYTES];
    volatile LAS unsigned* st = (volatile LAS unsigned*)(smem + SMEM_BYTES - 16);
    if (threadIdx.x < 4) st[threadIdx.x] = 0u;
    __syncthreads();
    const XcdBarrier bar = xcd_barrier_post((unsigned*)(p.ws + CTL), st);
    mega_steps<0>(p, bar, smem);
}
#endif
template <int PH>
__global__ void __launch_bounds__(256, 1) k_phase_big(P p) {
    __shared__ __attribute__((aligned(16))) unsigned char smem[SMEM_BYTES];
    run_phase<PH>(p, blockIdx.x, gridDim.x, smem);
}
template <int PH>
static void launch_phase(const P& p, int grid, hipStream_t st) {
    if constexpr (PH == 3 && !P3_SMALL) hipLaunchKernelGGL((k_phase_big<PH>), dim3(grid), dim3(256), 0, st, p);
    else hipLaunchKernelGGL((k_phase<PH>), dim3(grid), dim3(256), 0, st, p);
}

extern "C" void kernel_launch(void* const* d_in, const int* in_sizes, int n_in, void* d_out, int out_size, void* d_ws, size_t ws_size, hipStream_t stream) {
    if (n_in != 31 || out_size != T * D || ws_size < WS_NEED) {
        fprintf(stderr, "kernel_launch: unexpected shapes: n_in %d out %d ws %zu (need %zu)\n", n_in, out_size, ws_size, (size_t)WS_NEED);
        return;
    }
    P p{};
    for (int i = 0; i < 31; ++i) p.in[i] = (const float*)d_in[i];
    p.out = (float*)d_out; p.ws = (unsigned char*)d_ws;
    (void)hipMemsetAsync((unsigned char*)d_ws + CTL, 0, CTL_BYTES, stream);
#if MEGA
    static int grid = 0;
    if (grid == 0) {
        int dev = 0, cus = 0, per_cu = 0;
        (void)hipGetDevice(&dev);
        (void)hipDeviceGetAttribute(&cus, hipDeviceAttributeMultiprocessorCount, dev);
        if (hipOccupancyMaxActiveBlocksPerMultiprocessor(&per_cu, (const void*)k_mega, 256, 0) != hipSuccess || per_cu < 1) { fprintf(stderr, "kernel_launch: occupancy query failed\n"); per_cu = 1; }
        if (per_cu > 2) per_cu = 2;
        grid = cus * per_cu;
        fprintf(stderr, "kernel_launch: mega grid %d (%d CUs x %d)\n", grid, cus, per_cu);
    }
    void* args[] = {(void*)&p};
    const hipError_t le = hipLaunchCooperativeKernel((const void*)k_mega, dim3(grid), dim3(256), args, 0, stream);
    if (le != hipSuccess) fprintf(stderr, "kernel_launch: cooperative launch failed: %s (grid %d)\n", hipGetErrorString(le), grid);
#else
    const int grid = 1024;
    launch_phase<0>(p, grid, stream); launch_phase<1>(p, grid, stream); launch_phase<2>(p, grid, stream); launch_phase<3>(p, grid, stream);
    launch_phase<4>(p, grid, stream); launch_phase<5>(p, grid, stream); launch_phase<6>(p, grid, stream); launch_phase<7>(p, grid, stream);
    launch_phase<8>(p, grid, stream); launch_phase<9>(p, grid, stream); launch_phase<10>(p, grid, stream); launch_phase<11>(p, grid, stream);
    launch_phase<12>(p, grid, stream); launch_phase<13>(p, grid, stream);
#endif
}
```

```cpp
#include <hip/hip_runtime.h>
#include <stdint.h>
#include <stdio.h>

#ifndef MEGA
#define MEGA 1
#endif
#ifndef ATTN_NAIVE
#define ATTN_NAIVE 0
#endif
#ifndef XATTN_NAIVE
#define XATTN_NAIVE 0
#endif
#ifndef SSD_NAIVE
#define SSD_NAIVE 0
#endif
#ifndef P3_SMALL
#define P3_SMALL 1
#endif
#ifndef NO_SSD
#define NO_SSD 0
#endif
#ifndef NO_FLASH
#define NO_FLASH 0
#endif
#ifndef GEMM_GLDS
#define GEMM_GLDS 1
#endif
#ifndef EXTRA_BARRIERS
#define EXTRA_BARRIERS 0
#endif
#ifndef SSD_PM
#define SSD_PM 0
#endif
#ifndef REPEAT_MASK
#define REPEAT_MASK 0
#endif
#ifndef REP_MODE
#define REP_MODE 0
#endif
#ifndef MFMA16
#define MFMA16 1
#endif
#ifndef GEMM_DIRECT
#define GEMM_DIRECT 0
#endif

typedef unsigned short bf16_t;
typedef short bf16x8 __attribute__((ext_vector_type(8)));
typedef float f32x16 __attribute__((ext_vector_type(16)));
typedef float f32x4v __attribute__((ext_vector_type(4)));
#define DI __device__ __forceinline__
#define LAS __attribute__((address_space(3)))
#define MFMA32(a, b, c) __builtin_amdgcn_mfma_f32_32x32x16_bf16((a), (b), (c), 0, 0, 0)

constexpr int Bn = 16, S = 2048, T = Bn * S, D = 1024;
constexpr int NMEM = 256;
constexpr float EPS = 1e-5f;
constexpr float ALPHA = 1.189207115002721f;
constexpr float LOG2E = 1.4426950408889634f;
constexpr float QSCALE = 0.10206207261596577f * LOG2E;
constexpr float XSCALE = 0.0625f * LOG2E;
constexpr int NEXP = 32;
constexpr int MAXSLOTS = 69632;

constexpr size_t MiB = 1u << 20;
constexpr size_t W_IN = 0;
constexpr size_t W_QUP = W_IN + 4 * MiB;
constexpr size_t W_KVUP = W_QUP + 768 * 256 * 2;
constexpr size_t W_OUT = W_KVUP + 1024 * 128 * 2;
constexpr size_t W_XQ = W_OUT + 2 * MiB;
constexpr size_t W_XKV = W_XQ + 2 * MiB;
constexpr size_t W_XO = W_XKV + 4 * MiB;
constexpr size_t W_GU = W_XO + 2 * MiB;
constexpr size_t W_DN = W_GU + 32 * MiB;
constexpr size_t W_RT = W_DN + 16 * MiB;
constexpr size_t ROPE_C = W_RT + 48 * 1024 * 4;
constexpr size_t ROPE_S = ROPE_C + 2048 * 16 * 4;
constexpr size_t TOK_GATE = ROPE_S + 2048 * 16 * 4;
constexpr size_t CTL = TOK_GATE + (size_t)T * 2 * 4;
constexpr size_t CTL_BYTES = 32768;
constexpr size_t CTL_CNT = 16384;
constexpr int CNT_STRIDE = 64;
constexpr size_t CTL_QUEUE = 28672;
static_assert(CTL + CTL_BYTES <= 64 * MiB, "weights region overflow");
constexpr size_t RA = 64 * MiB, RB = 192 * MiB, RC = 320 * MiB, RD = 448 * MiB, WS_NEED = 512 * MiB;
constexpr size_t XBC = RA;
constexpr size_t KX = RA + 64 * MiB;
constexpr size_t VXT = KX + 8 * MiB;
constexpr size_t YB = RA;
constexpr size_t QB = RB;
constexpr size_t KNB = RB + 48 * MiB;
constexpr size_t VTB = KNB + 32 * MiB;
constexpr size_t H1 = RB;
constexpr size_t H2 = RB;
constexpr size_t XB = RC;
constexpr size_t MEMB = RB;
constexpr size_t XBCA = RC;
constexpr size_t MIX = RC + 64 * MiB;
constexpr size_t H1B = RC;
constexpr size_t QX = RC + 64 * MiB;
constexpr size_t OX = RB;
constexpr size_t H2B = RC;
constexpr size_t HDN = RC + 64 * MiB;
constexpr size_t CQ = RD;
constexpr size_t CKV = CQ + 16 * MiB;
constexpr size_t KROPE = CKV + 8 * MiB;
constexpr size_t DTB = KROPE + 2 * MiB;
constexpr size_t ZB = DTB + 1 * MiB;
constexpr size_t SSQ = ZB + 32 * MiB;
constexpr size_t LISTS = RD;
static_assert(SSQ + 3 * (size_t)T * 4 <= WS_NEED, "region D overflow");

struct P {
    const float* in[31];
    float* out;
    unsigned char* ws;
};

typedef __bf16 hbf16x2 __attribute__((ext_vector_type(2)));
typedef float f32x2 __attribute__((ext_vector_type(2)));
DI bf16_t f2bf(float x) { return __builtin_bit_cast(bf16_t, (__bf16)x); }
DI float bf2f(bf16_t b) { return __uint_as_float(((unsigned)b) << 16); }
DI float bflo(unsigned w) { return __uint_as_float(w << 16); }
DI float bfhi(unsigned w) { return __uint_as_float(w & 0xffff0000u); }
DI unsigned pack2(float a, float b) { f32x2 v = {a, b}; return __builtin_bit_cast(unsigned, __builtin_convertvector(v, hbf16x2)); }
DI float siluf(float x) { return x * __builtin_amdgcn_rcpf(1.f + __expf(-x)); }
DI float softplusf(float x) {
    const float zz = __expf(-fabsf(x));
    const float l1p = zz < 0.01f ? zz * (1.f - zz * (0.5f - zz * (1.f / 3.f))) : __logf(1.f + zz);
    return fmaxf(x, 0.f) + l1p;
}
DI int tidx() { int t = __builtin_amdgcn_workitem_id_x(); asm volatile("" : "+v"(t)); return t; }
DI int crow(int reg, int h) { return (reg & 3) + 8 * (reg >> 2) + 4 * h; }
constexpr int CS_LD = 132;
DI float4 cs4(const float* Cs, int row, int col) { return *(const float4*)(Cs + row * CS_LD + col); }
DI uint2 pack4(float4 v) { uint2 w; w.x = pack2(v.x, v.y); w.y = pack2(v.z, v.w); return w; }
DI float wave_sum(float v) {
#pragma unroll
    for (int o = 32; o >= 1; o >>= 1) v += __shfl_xor(v, o);
    return v;
}
DI float wave_max(float v) {
#pragma unroll
    for (int o = 32; o >= 1; o >>= 1) v = fmaxf(v, __shfl_xor(v, o));
    return v;
}

constexpr int LDS_ROW = 144;
constexpr int TILE_BYTES = 128 * LDS_ROW;
constexpr int GEMM_LDS = 4 * TILE_BYTES;
constexpr int SMEM_BYTES = GEMM_LDS + 3072;
static_assert(128 * CS_LD * 4 <= GEMM_LDS, "epilogue tile");

struct GemmArgs {
    const bf16_t* A; int lda;
    const bf16_t* Bt; int ldb;
    int K;
    const int* lrows;
};

template <class Epi>
DI void gemm_tile(const GemmArgs& g, int m0, int n0, Epi& epi, unsigned char* smem) {
    const int tid = tidx(), lane = tid & 63, wave = tid >> 6, wr = wave >> 1, wc = wave & 1;
    const int r = lane & 31, h = lane >> 5;
    f32x16 acc[2][2];
#pragma unroll
    for (int i = 0; i < 2; ++i)
#pragma unroll
        for (int j = 0; j < 2; ++j)
#pragma unroll
            for (int e = 0; e < 16; ++e) acc[i][j][e] = 0.f;
    const int nk = g.K >> 6;
#if MFMA16
    f32x4v acc16[4][4];
#pragma unroll
    for (int m = 0; m < 4; ++m)
#pragma unroll
        for (int n = 0; n < 4; ++n) acc16[m][n] = (f32x4v){0.f, 0.f, 0.f, 0.f};
#endif
#if GEMM_DIRECT
    {
        const bf16_t* ap[2]; const bf16_t* bp[2];
#pragma unroll
        for (int i = 0; i < 2; ++i) {
            const int lr = wr * 64 + i * 32 + r;
            const int grow = g.lrows ? g.lrows[lr] : (m0 + lr);
            ap[i] = g.A + (size_t)grow * g.lda + 8 * h;
            bp[i] = g.Bt + (size_t)(n0 + wc * 64 + i * 32 + r) * g.ldb + 8 * h;
        }
        for (int k = 0; k < g.K; k += 16) {
            bf16x8 a[2], b[2];
#pragma unroll
            for (int i = 0; i < 2; ++i) { a[i] = *(const bf16x8*)(ap[i] + k); b[i] = *(const bf16x8*)(bp[i] + k); }
#pragma unroll
            for (int i = 0; i < 2; ++i)
#pragma unroll
                for (int j = 0; j < 2; ++j) acc[i][j] = MFMA32(a[i], b[j], acc[i][j]);
        }
    }
#elif GEMM_GLDS
    {
        constexpr int STG = 32768, TB = 16384;
        const int srow = tid >> 3, sch = (tid & 7) ^ ((srow >> 1) & 7);
        const bf16_t* ag[4]; const bf16_t* bg[4];
#pragma unroll
        for (int i = 0; i < 4; ++i) {
            const int lr = srow + 32 * i;
            const int grow = g.lrows ? g.lrows[lr] : (m0 + lr);
            ag[i] = g.A + (size_t)grow * g.lda + sch * 8;
            bg[i] = g.Bt + (size_t)(n0 + lr) * g.ldb + sch * 8;
        }
#define GLDS_STAGE(BUF, KO) do { unsigned char* _d = (BUF) + wave * 1024; \
        _Pragma("unroll") for (int i = 0; i < 4; ++i) { \
            __builtin_amdgcn_global_load_lds((const unsigned*)(ag[i] + (KO)), (LAS unsigned*)(_d + i * 4096), 16, 0, 0); \
            __builtin_amdgcn_global_load_lds((const unsigned*)(bg[i] + (KO)), (LAS unsigned*)(_d + TB + i * 4096), 16, 0, 0); } } while (0)
        __syncthreads();
        GLDS_STAGE(smem, 0);
        epi.prefetch(m0, n0, tid);
        const int y16 = (h ^ ((r >> 1) & 7)) << 4;
        const int o0 = y16, o1 = 32 ^ y16, o2 = 64 ^ y16, o3 = 96 ^ y16;
        const int arow = (wr * 64 + r) * 128, brow = TB + (wc * 64 + r) * 128;
        __syncthreads();
#if MFMA16
        const int i16 = lane & 15, g16 = lane >> 4;
        const int p0 = ((g16 ^ (i16 >> 1)) << 4), p1 = p0 ^ 64;
        const int arow16 = (wr * 64 + i16) * 128, brow16 = TB + (wc * 64 + i16) * 128;
        for (int kt = 0; kt < nk; ++kt) {
            const unsigned char* cur = smem + (kt & 1) * STG;
            if (kt + 1 < nk) GLDS_STAGE(smem + ((kt + 1) & 1) * STG, (kt + 1) * 64);
#pragma unroll
            for (int s = 0; s < 2; ++s) {
                const int po = s ? p1 : p0;
                bf16x8 fa[4], fb[4];
#pragma unroll
                for (int m = 0; m < 4; ++m) { fa[m] = *(const bf16x8*)(cur + arow16 + m * 16 * 128 + po); fb[m] = *(const bf16x8*)(cur + brow16 + m * 16 * 128 + po); }
#pragma unroll
                for (int m = 0; m < 4; ++m)
#pragma unroll
                    for (int n = 0; n < 4; ++n) acc16[m][n] = __builtin_amdgcn_mfma_f32_16x16x32_bf16(fa[m], fb[n], acc16[m][n], 0, 0, 0);
            }
            __syncthreads();
        }
#else
        for (int kt = 0; kt < nk; ++kt) {
            const unsigned char* cur = smem + (kt & 1) * STG;
            if (kt + 1 < nk) GLDS_STAGE(smem + ((kt + 1) & 1) * STG, (kt + 1) * 64);
            bf16x8 fa[4][2], fb[4][2];
#define KLOAD(S, OFF) do { \
                fa[S][0] = *(const bf16x8*)(cur + arow + (OFF)); fa[S][1] = *(const bf16x8*)(cur + arow + 32 * 128 + (OFF)); \
                fb[S][0] = *(const bf16x8*)(cur + brow + (OFF)); fb[S][1] = *(const bf16x8*)(cur + brow + 32 * 128 + (OFF)); } while (0)
            KLOAD(0, o0); KLOAD(1, o1); KLOAD(2, o2); KLOAD(3, o3);
#undef KLOAD
#pragma unroll
            for (int s = 0; s < 4; ++s) {
                acc[0][0] = MFMA32(fa[s][0], fb[s][0], acc[0][0]); acc[0][1] = MFMA32(fa[s][0], fb[s][1], acc[0][1]);
                acc[1][0] = MFMA32(fa[s][1], fb[s][0], acc[1][0]); acc[1][1] = MFMA32(fa[s][1], fb[s][1], acc[1][1]);
            }
            __builtin_amdgcn_sched_group_barrier(0x100, 8, 0); __builtin_amdgcn_sched_group_barrier(0x8, 4, 0);
            __builtin_amdgcn_sched_group_barrier(0x100, 4, 0); __builtin_amdgcn_sched_group_barrier(0x8, 4, 0);
            __builtin_amdgcn_sched_group_barrier(0x100, 4, 0); __builtin_amdgcn_sched_group_barrier(0x8, 8, 0);
#define KSTEP(OFF)
#undef KSTEP
            __syncthreads();
        }
#endif
#undef GLDS_STAGE
    }
#else
    {
        const int srow = tid >> 3, sch = tid & 7;
        const bf16_t* ag[4]; const bf16_t* bg[4];
#pragma unroll
        for (int i = 0; i < 4; ++i) {
            const int lr = srow + 32 * i;
            const int grow = g.lrows ? g.lrows[lr] : (m0 + lr);
            ag[i] = g.A + (size_t)grow * g.lda + sch * 8;
            bg[i] = g.Bt + (size_t)(n0 + lr) * g.ldb + sch * 8;
        }
        const int soff = srow * LDS_ROW + sch * 16;
        uint4 ra0, ra1, ra2, ra3, rb0, rb1, rb2, rb3;
#define G_LOAD(KO) do { ra0 = *(const uint4*)(ag[0] + (KO)); ra1 = *(const uint4*)(ag[1] + (KO)); ra2 = *(const uint4*)(ag[2] + (KO)); ra3 = *(const uint4*)(ag[3] + (KO)); \
                        rb0 = *(const uint4*)(bg[0] + (KO)); rb1 = *(const uint4*)(bg[1] + (KO)); rb2 = *(const uint4*)(bg[2] + (KO)); rb3 = *(const uint4*)(bg[3] + (KO)); } while (0)
#define L_STORE(BUF) do { unsigned char* _d = (BUF) + soff; \
        *(uint4*)(_d) = ra0; *(uint4*)(_d + 32 * LDS_ROW) = ra1; *(uint4*)(_d + 64 * LDS_ROW) = ra2; *(uint4*)(_d + 96 * LDS_ROW) = ra3; \
        *(uint4*)(_d + TILE_BYTES) = rb0; *(uint4*)(_d + TILE_BYTES + 32 * LDS_ROW) = rb1; *(uint4*)(_d + TILE_BYTES + 64 * LDS_ROW) = rb2; *(uint4*)(_d + TILE_BYTES + 96 * LDS_ROW) = rb3; } while (0)
        G_LOAD(0);
        __syncthreads();
        L_STORE(smem);
        __syncthreads();
        const int aoff = (wr * 64 + r) * LDS_ROW + h * 16;
        const int boff = TILE_BYTES + (wc * 64 + r) * LDS_ROW + h * 16;
        for (int kt = 0; kt < nk; ++kt) {
            const unsigned char* cur = smem + (kt & 1) * 2 * TILE_BYTES;
            unsigned char* nxt = smem + ((kt + 1) & 1) * 2 * TILE_BYTES;
            const bool more = (kt + 1 < nk);
            if (more) G_LOAD((kt + 1) * 64);
#pragma unroll
            for (int ks = 0; ks < 4; ++ks) {
                const bf16x8 a0 = *(const bf16x8*)(cur + aoff + ks * 32);
                const bf16x8 a1 = *(const bf16x8*)(cur + aoff + 32 * LDS_ROW + ks * 32);
                const bf16x8 b0 = *(const bf16x8*)(cur + boff + ks * 32);
                const bf16x8 b1 = *(const bf16x8*)(cur + boff + 32 * LDS_ROW + ks * 32);
                acc[0][0] = MFMA32(a0, b0, acc[0][0]); acc[0][1] = MFMA32(a0, b1, acc[0][1]);
                acc[1][0] = MFMA32(a1, b0, acc[1][0]); acc[1][1] = MFMA32(a1, b1, acc[1][1]);
            }
            if (more) L_STORE(nxt);
            __syncthreads();
        }
#undef G_LOAD
#undef L_STORE
    }
#endif
    float* Cs = (float*)smem;
#if GEMM_DIRECT
    __syncthreads();
#endif
#if !MFMA16
#pragma unroll
    for (int i = 0; i < 2; ++i)
#pragma unroll
        for (int j = 0; j < 2; ++j)
#pragma unroll
            for (int e = 0; e < 16; ++e) Cs[(wr * 64 + i * 32 + crow(e, h)) * CS_LD + wc * 64 + j * 32 + r] = acc[i][j][e];
#else
#pragma unroll
    for (int m = 0; m < 4; ++m)
#pragma unroll
        for (int n = 0; n < 4; ++n)
#pragma unroll
            for (int e = 0; e < 4; ++e) Cs[(wr * 64 + m * 16 + 4 * (lane >> 4) + e) * CS_LD + wc * 64 + n * 16 + (lane & 15)] = acc16[m][n][e];
#endif
    __syncthreads();
    epi(Cs, m0, n0, tid);
}

DI int vbid(int bid, int nb) { return (nb % 8 == 0) ? (bid % 8) * (nb / 8) + bid / 8 : bid; }

DI int colmap_in(int n) {
    if (n < 384) return n;
    if (n < 896) return 416 + (n - 384);
    if (n < 1920) return 928 + (n - 896);
    if (n < 1952) return 384 + (n - 1920);
    if (n < 1960) return n;
    return -1;
}
template <int KIND>
DI void tconv_tile(const float* src, const float* src2, int ldsrc, bf16_t* dst, int K, int k0, int n0, const float* scale, int scale_from, unsigned char* smem) {
    float* tile = (float*)smem;
    const int t = tidx();
    __syncthreads();
#pragma unroll 4
    for (int i = 0; i < 16; ++i) {
        const int k = i * 4 + (t >> 6), n = t & 63;
        const int nd = n0 + n;
        float v = 0.f;
        if (KIND == 1) { const int c = colmap_in(nd); if (c >= 0) v = src[(size_t)(k0 + k) * ldsrc + c]; }
        else if (KIND == 2) {
            const int j = nd >> 7, wc = (nd >> 6) & 1, isup = (nd >> 5) & 1, ii = nd & 31;
            const int c = 64 * j + 32 * wc + ii;
            v = (isup ? src2 : src)[(size_t)(k0 + k) * ldsrc + c];
        } else v = src[(size_t)(k0 + k) * ldsrc + nd];
        if (scale && (k0 + k) >= scale_from) v *= scale[k0 + k - scale_from];
        tile[k * 65 + n] = v;
    }
    __syncthreads();
#pragma unroll 4
    for (int i = 0; i < 16; ++i) {
        const int n = i * 4 + (t >> 6), k = t & 63;
        dst[(size_t)(n0 + n) * K + k0 + k] = f2bf(tile[k * 65 + n]);
    }
}

DI void phase_prep(const P& p, int bid, int nb, unsigned char* smem) {
    unsigned char* ws = p.ws;
    const int tid = tidx();
    constexpr int J0 = 512, J1 = J0 + 48, J2 = J1 + 32, J3 = J2 + 256, J4 = J3 + 256, J5 = J4 + 256, J6 = J5 + 256, J7 = J6 + 256, J8 = J7 + 4096, J9 = J8 + 2048;
    for (int t = bid; t < J9; t += nb) {
        if (t < J0) { const int kt = t >> 5, ntl = t & 31; tconv_tile<1>(p.in[2], nullptr, 1960, (bf16_t*)(ws + W_IN), 1024, kt * 64, ntl * 64, nullptr, 0, smem); }
        else if (t < J1) { const int u = t - J0, kt = u / 12, ntl = u % 12; tconv_tile<0>(p.in[4], nullptr, 768, (bf16_t*)(ws + W_QUP), 256, kt * 64, ntl * 64, p.in[3], 0, smem); }
        else if (t < J2) { const int u = t - J1, kt = u >> 4, ntl = u & 15; tconv_tile<0>(p.in[6], nullptr, 1024, (bf16_t*)(ws + W_KVUP), 128, kt * 64, ntl * 64, p.in[5], 0, smem); }
        else if (t < J3) { const int u = t - J2, kt = u >> 4, ntl = u & 15; tconv_tile<0>(p.in[13], nullptr, 1024, (bf16_t*)(ws + W_OUT), 1024, kt * 64, ntl * 64, p.in[12], 512, smem); }
        else if (t < J4) { const int u = t - J3, kt = u >> 4, ntl = u & 15; tconv_tile<0>(p.in[16], nullptr, 1024, (bf16_t*)(ws + W_XQ), 1024, kt * 64, ntl * 64, nullptr, 0, smem); }
        else if (t < J5) { const int u = t - J4, kt = u >> 4, ntl = u & 15; tconv_tile<0>(p.in[17], nullptr, 1024, (bf16_t*)(ws + W_XKV), 1024, kt * 64, ntl * 64, nullptr, 0, smem); }
        else if (t < J6) { const int u = t - J5, kt = u >> 4, ntl = u & 15; tconv_tile<0>(p.in[18], nullptr, 1024, (bf16_t*)(ws + W_XKV) + (size_t)1024 * 1024, 1024, kt * 64, ntl * 64, nullptr, 0, smem); }
        else if (t < J7) { const int u = t - J6, kt = u >> 4, ntl = u & 15; tconv_tile<0>(p.in[19], nullptr, 1024, (bf16_t*)(ws + W_XO), 1024, kt * 64, ntl * 64, nullptr, 0, smem); }
        else if (t < J8) { const int u = t - J7, e = u >> 7, v = u & 127, kt = v >> 3, ntl = v & 7;
            tconv_tile<2>(p.in[26] + (size_t)e * 1024 * 256, p.in[27] + (size_t)e * 1024 * 256, 256, (bf16_t*)(ws + W_GU) + (size_t)e * 512 * 1024, 1024, kt * 64, ntl * 64, nullptr, 0, smem); }
        else { const int u = t - J8, e = u >> 6, v = u & 63, kt = v >> 4, ntl = v & 15;
            tconv_tile<0>(p.in[28] + (size_t)e * 256 * 1024, nullptr, 1024, (bf16_t*)(ws + W_DN) + (size_t)e * 1024 * 256, 256, kt * 64, ntl * 64, nullptr, 0, smem); }
    }
    {
        const size_t gsz = (size_t)nb * 256, g0 = (size_t)bid * 256 + tid;
        bf16_t* xb = (bf16_t*)p.out;
        const float4* x4 = (const float4*)p.in[0];
        for (size_t i = g0; i < (size_t)T * D / 4; i += gsz) { const float4 v = x4[i]; uint2 o; o.x = pack2(v.x, v.y); o.y = pack2(v.z, v.w); ((uint2*)xb)[i] = o; }
        bf16_t* mb = (bf16_t*)(ws + MEMB);
        const float4* m4 = (const float4*)p.in[1];
        for (size_t i = g0; i < (size_t)Bn * NMEM * D / 4; i += gsz) { const float4 v = m4[i]; uint2 o; o.x = pack2(v.x, v.y); o.y = pack2(v.z, v.w); ((uint2*)mb)[i] = o; }
        float* wrt = (float*)(ws + W_RT);
        for (size_t i = g0; i < 48 * 1024; i += gsz) {
            const int j = (int)(i >> 10), k = (int)(i & 1023);
            float v = 0.f;
            if (j < 4) v = p.in[22][k * 4 + j]; else if (j < 36) v = p.in[24][k * 32 + (j - 4)];
            wrt[i] = v;
        }
        float* rc = (float*)(ws + ROPE_C); float* rs = (float*)(ws + ROPE_S);
        for (size_t i = g0; i < 2048 * 16; i += gsz) {
            const int pos = (int)(i >> 4), f = (int)(i & 15);
            const float inv = powf(10000.f, -(float)f / 16.f);
            const float ang = (float)pos * inv;
            const double a = (double)ang;
            const double k2 = rint(a * 0.15915494309189535);
            const float rr = (float)(a - k2 * 6.283185307179586);
            rc[i] = cosf(rr); rs[i] = sinf(rr);
        }
    }
}

struct EpiProj {
    bf16_t *cq, *ckv, *z, *xbc, *krope; float* dt; const float *rc, *rs, *dtb; float* ssq;
    DI void prefetch(int, int, int) {}
    DI void operator()(const float* Cs, int m0, int n0, int tid) const {
        const int c4 = (tid & 31) * 4, r0 = tid >> 5;
        if (n0 < 1920) {
            bf16_t* dst; int ld, cofs;
            if (n0 < 256) { dst = cq; ld = 256; cofs = n0; } else if (n0 < 384) { dst = ckv; ld = 128; cofs = n0 - 256; }
            else if (n0 < 896) { dst = z; ld = 512; cofs = n0 - 384; } else { dst = xbc; ld = 1024; cofs = n0 - 896; }
            if (n0 < 384) {
                float* sq = ssq + (size_t)(n0 >> 7) * T + m0;
#pragma unroll 4
                for (int ps = 0; ps < 16; ++ps) {
                    const int row = ps * 8 + r0; const float4 v = cs4(Cs, row, c4);
                    *(uint2*)(dst + (size_t)(m0 + row) * ld + cofs + c4) = pack4(v);
                    float ss = (v.x * v.x + v.y * v.y) + (v.z * v.z + v.w * v.w);
#pragma unroll
                    for (int o = 16; o >= 1; o >>= 1) ss += __shfl_xor(ss, o);
                    if ((tid & 31) == 0) sq[row] = ss;
                }
            } else {
#pragma unroll 4
            for (int ps = 0; ps < 16; ++ps) { const int row = ps * 8 + r0; *(uint2*)(dst + (size_t)(m0 + row) * ld + cofs + c4) = pack4(cs4(Cs, row, c4)); }
            }
        } else {
#pragma unroll
            for (int ps = 0; ps < 4; ++ps) {
                const int it = ps * 256 + tid, row = it >> 3, cc = (it & 7) * 4, grow = m0 + row;
                const float4 v = cs4(Cs, row, cc), pv = cs4(Cs, row, cc ^ 16);
                const int pos = grow & 2047, f = cc & 15;
                const float4 c = *(const float4*)(rc + pos * 16 + f), s = *(const float4*)(rs + pos * 16 + f);
                float4 o;
                if (cc < 16) { o.x = v.x * c.x - pv.x * s.x; o.y = v.y * c.y - pv.y * s.y; o.z = v.z * c.z - pv.z * s.z; o.w = v.w * c.w - pv.w * s.w; }
                else { o.x = v.x * c.x + pv.x * s.x; o.y = v.y * c.y + pv.y * s.y; o.z = v.z * c.z + pv.z * s.z; o.w = v.w * c.w + pv.w * s.w; }
                *(uint2*)(krope + (size_t)grow * 32 + cc) = pack4(o);
            }
#pragma unroll
            for (int ps = 0; ps < 4; ++ps) {
                const int it = ps * 256 + tid, row = it >> 3, cc = it & 7;
                dt[(size_t)(m0 + row) * 8 + cc] = softplusf(Cs[row * CS_LD + 32 + cc] + dtb[cc]);
            }
        }
    }
};
struct EpiMemKV {
    bf16_t *kx, *vxt;
    DI void prefetch(int, int, int) {}
    DI void operator()(const float* Cs, int m0, int n0, int tid) const {
        const int b = m0 >> 8, mm0 = m0 & 255;
        if (n0 < 1024) {
            const int c4 = (tid & 31) * 4, r0 = tid >> 5, hd = n0 >> 8, d = (n0 & 255) + c4;
#pragma unroll 4
            for (int ps = 0; ps < 16; ++ps) { const int row = ps * 8 + r0; *(uint2*)(kx + ((size_t)(b * 4 + hd) * 256 + mm0 + row) * 256 + d) = pack4(cs4(Cs, row, c4)); }
        } else {
            const int c2 = n0 - 1024, hd = c2 >> 8;
#pragma unroll 2
            for (int ps = 0; ps < 8; ++ps) {
                const int it = ps * 256 + tid, col = it & 127, rg = it >> 7, d = (c2 & 255) + col;
                uint4 w;
                w.x = pack2(Cs[(rg * 8 + 0) * CS_LD + col], Cs[(rg * 8 + 1) * CS_LD + col]); w.y = pack2(Cs[(rg * 8 + 2) * CS_LD + col], Cs[(rg * 8 + 3) * CS_LD + col]);
                w.z = pack2(Cs[(rg * 8 + 4) * CS_LD + col], Cs[(rg * 8 + 5) * CS_LD + col]); w.w = pack2(Cs[(rg * 8 + 6) * CS_LD + col], Cs[(rg * 8 + 7) * CS_LD + col]);
                *(uint4*)(vxt + ((size_t)(b * 4 + hd) * 256 + d) * 256 + mm0 + rg * 8) = w;
            }
        }
    }
};
DI void phase_proj(const P& p, int bid, int nb, unsigned char* smem, int rep = 0) {
    unsigned char* ws = p.ws;
    const int v = vbid(bid, nb);
    const bf16_t* xb = (const bf16_t*)p.out;
    EpiProj e1{(bf16_t*)(ws + CQ), (bf16_t*)(ws + CKV), (bf16_t*)(ws + ZB), (bf16_t*)(ws + XBC), (bf16_t*)(ws + KROPE), (float*)(ws + DTB),
               (const float*)(ws + ROPE_C), (const float*)(ws + ROPE_S), p.in[9], (float*)(ws + SSQ)};
    EpiMemKV e2{(bf16_t*)(ws + KX), (bf16_t*)(ws + VXT)};
    constexpr int NT1 = 256 * 16, NT2 = 32 * 16;
    for (int t = v; t < NT1 + NT2; t += nb) {
        if (rep && REP_MODE == 1 && t >= NT1) continue;
        if (rep && REP_MODE == 2 && t < NT1) continue;
        if (rep && REP_MODE == 3 && !(t < NT1 && (t & 7) == 7 && ((t >> 6) & 1))) continue;
        if (rep && REP_MODE == 4 && !(t < NT1 && ((t >> 6) & 1) == 0)) continue;
        const int u = t < NT1 ? t : t - NT1, c = u >> 6, j = u & 63, mt = (c >> 1) * 8 + (j >> 3), ntl = (c & 1) * 8 + (j & 7);
        if (t < NT1) { GemmArgs g{xb, 1024, (const bf16_t*)(ws + W_IN), 1024, 1024, nullptr}; gemm_tile(g, mt * 128, ntl * 128, e1, smem); }
        else { GemmArgs g{(const bf16_t*)(ws + MEMB), 1024, (const bf16_t*)(ws + W_XKV), 1024, 1024, nullptr}; gemm_tile(g, mt * 128, ntl * 128, e2, smem); }
    }
}

struct EpiQup {
    bf16_t* q; const float* ssq; float* rms;
    DI void prefetch(int m0, int, int tid) { if (tid < 128) rms[tid] = rsqrtf((ssq[m0 + tid] + ssq[(size_t)T + m0 + tid]) * (1.f / 256.f) + EPS); }
    DI void operator()(const float* Cs, int m0, int n0, int tid) const {
        const int c4 = (tid & 31) * 4, r0 = tid >> 5;
        const int col = n0 + c4, head = col / 96, d = col - head * 96;
        const int b = m0 >> 11, s0 = m0 & 2047;
#pragma unroll 4
        for (int ps = 0; ps < 16; ++ps) {
            const int row = ps * 8 + r0;
            const float sc = rms[row] * QSCALE;
            float4 v = cs4(Cs, row, c4);
            v.x *= sc; v.y *= sc; v.z *= sc; v.w *= sc;
            *(uint2*)(q + ((size_t)(b * 8 + head) * 2048 + s0 + row) * 96 + d) = pack4(v);
        }
    }
};
struct EpiKVup {
    bf16_t *kn, *vt; const float* ssq; float* rms;
    DI void prefetch(int m0, int, int tid) { if (tid < 128) rms[tid] = rsqrtf(ssq[2 * (size_t)T + m0 + tid] * (1.f / 128.f) + EPS); }
    DI void operator()(const float* Cs, int m0, int n0, int tid) const {
        const int head = n0 >> 7, b = m0 >> 11, s0 = m0 & 2047;
#pragma unroll 4
        for (int ps = 0; ps < 8; ++ps) {
            const int it = ps * 256 + tid, row = it >> 4, c4 = (it & 15) * 4;
            const float sc = rms[row];
            float4 v = cs4(Cs, row, c4); v.x *= sc; v.y *= sc; v.z *= sc; v.w *= sc;
            *(uint2*)(kn + ((size_t)(b * 8 + head) * 2048 + s0 + row) * 64 + c4) = pack4(v);
        }
#pragma unroll 2
        for (int ps = 0; ps < 4; ++ps) {
            const int it = ps * 256 + tid, dv = it & 63, rg = it >> 6;
            const float* cp = Cs + (rg * 8) * CS_LD + 64 + dv; const float* rp = rms + rg * 8;
            uint4 w;
            w.x = pack2(cp[0] * rp[0], cp[CS_LD] * rp[1]); w.y = pack2(cp[2 * CS_LD] * rp[2], cp[3 * CS_LD] * rp[3]);
            w.z = pack2(cp[4 * CS_LD] * rp[4], cp[5 * CS_LD] * rp[5]); w.w = pack2(cp[6 * CS_LD] * rp[6], cp[7 * CS_LD] * rp[7]);
            *(uint4*)(vt + ((size_t)(b * 8 + head) * 64 + dv) * 2048 + s0 + rg * 8) = w;
        }
    }
};
DI void phase_up(const P& p, int bid, int nb, unsigned char* smem, int rep = 0) {
    unsigned char* ws = p.ws;
    const int v = vbid(bid, nb);
    float* rms = (float*)(smem + GEMM_LDS);
    constexpr int NTQ = 256 * 6, NTKV = 256 * 8;
    for (int t = v; t < NTQ + NTKV; t += nb) {
        if (rep && REP_MODE == 1) break;
        if (rep && REP_MODE == 2 && t >= NTQ) break;
        if (rep && REP_MODE == 3 && t < NTQ) continue;
        if (t < NTQ) {
            const int mt = t / 6, ntl = t % 6;
            EpiQup e{(bf16_t*)(ws + QB), (const float*)(ws + SSQ), rms};
            GemmArgs g{(const bf16_t*)(ws + CQ), 256, (const bf16_t*)(ws + W_QUP), 256, 256, nullptr};
            gemm_tile(g, mt * 128, ntl * 128, e, smem);
        } else {
            const int u = t - NTQ, mt = u >> 3, ntl = u & 7;
            EpiKVup e{(bf16_t*)(ws + KNB), (bf16_t*)(ws + VTB), (const float*)(ws + SSQ), rms};
            GemmArgs g{(const bf16_t*)(ws + CKV), 128, (const bf16_t*)(ws + W_KVUP), 128, 128, nullptr};
            gemm_tile(g, mt * 128, ntl * 128, e, smem);
        }
    }
    if (!(rep && REP_MODE >= 2)) {
        const bf16_t* xbc = (const bf16_t*)(ws + XBC); bf16_t* xa = (bf16_t*)(ws + XBCA);
        const float* cw = p.in[7]; const float* cb = p.in[8];
        const size_t gsz = (size_t)nb * 256;
        for (size_t i = (size_t)bid * 256 + tidx(); i < (size_t)(T / 4) * 128; i += gsz) {
            const int tk0 = (int)(i >> 7) * 4, c0 = (int)(i & 127) * 8, s0 = tk0 & 2047;
            float w[4][8], bias[8];
#pragma unroll
            for (int j = 0; j < 4; ++j) { const float4 w0 = *(const float4*)(cw + j * 1024 + c0), w1 = *(const float4*)(cw + j * 1024 + c0 + 4);
                w[j][0] = w0.x; w[j][1] = w0.y; w[j][2] = w0.z; w[j][3] = w0.w; w[j][4] = w1.x; w[j][5] = w1.y; w[j][6] = w1.z; w[j][7] = w1.w; }
            { const float4 b0 = *(const float4*)(cb + c0), b1 = *(const float4*)(cb + c0 + 4); bias[0] = b0.x; bias[1] = b0.y; bias[2] = b0.z; bias[3] = b0.w; bias[4] = b1.x; bias[5] = b1.y; bias[6] = b1.z; bias[7] = b1.w; }
            float xin[7][8];
#pragma unroll
            for (int rr = 0; rr < 7; ++rr) {
                uint4 wv = make_uint4(0u, 0u, 0u, 0u);
                if (s0 + rr - 3 >= 0) wv = *(const uint4*)(xbc + (size_t)(tk0 + rr - 3) * 1024 + c0);
                xin[rr][0] = bflo(wv.x); xin[rr][1] = bfhi(wv.x); xin[rr][2] = bflo(wv.y); xin[rr][3] = bfhi(wv.y); xin[rr][4] = bflo(wv.z); xin[rr][5] = bfhi(wv.z); xin[rr][6] = bflo(wv.w); xin[rr][7] = bfhi(wv.w);
            }
#pragma unroll
            for (int o = 0; o < 4; ++o) {
                float accv[8];
#pragma unroll
                for (int k = 0; k < 8; ++k) accv[k] = bias[k] + w[0][k] * xin[o][k] + w[1][k] * xin[o + 1][k] + w[2][k] * xin[o + 2][k] + w[3][k] * xin[o + 3][k];
                uint4 ov;
                ov.x = pack2(siluf(accv[0]), siluf(accv[1])); ov.y = pack2(siluf(accv[2]), siluf(accv[3]));
                ov.z = pack2(siluf(accv[4]), siluf(accv[5])); ov.w = pack2(siluf(accv[6]), siluf(accv[7]));
                *(uint4*)(xa + (size_t)(tk0 + o) * 1024 + c0) = ov;
            }
        }
    }
}

DI int perm16(int k) { return (k & ~12) | ((k & 4) << 1) | ((k & 8) >> 1); }
template <int DQK, int DVW, int KT, int NQG, int NDV>
struct FlashCfg {
    static constexpr int KSTR = (DQK + 8) * 2;
    static constexpr int VSTR = (KT + 8) * 2;
    static constexpr int DV = DVW * NDV;
    static constexpr int KBYTES = KT * KSTR, VBYTES = DV * VSTR, STAGE = KBYTES + VBYTES;
    static constexpr int KCH = KT * DQK / 8 / 256;
    static constexpr int VCH = DV * KT / 8 / 256;
    static_assert(KT * DQK / 8 % 256 == 0 && DV * KT / 8 % 256 == 0, "chunk split");
    static_assert(2 * STAGE <= SMEM_BYTES - 32, "flash LDS");
};
template <int DQK, int DVW, int KT, int NQG, int NDV, class Src>
DI void flash_item(const Src& src, int ntiles, int nskip  , unsigned char* smem, bool noload = false) {
    typedef FlashCfg<DQK, DVW, KT, NQG, NDV> C;
    constexpr int NKS = DQK / 16, NKB = KT / 32, NDB = DVW / 32;
    int tid = tidx(); asm volatile("" : "+v"(tid));
    const int lane = tid & 63, wave = __builtin_amdgcn_readfirstlane(tid >> 6), r = lane & 31, h = lane >> 5;
    const int qg = wave / NDV, dvh = wave % NDV;
    bf16x8 qf[NKS];
    {
        const bf16_t* qp = src.qrow(qg * 32 + r) + 8 * h;
#pragma unroll
        for (int ks = 0; ks < NKS; ++ks) qf[ks] = *(const bf16x8*)(qp + 16 * ks);
        if (Src::ROPE) {
            const float* cp = src.rope_c(qg * 32 + r) + 8 * h; const float* sp = src.rope_s(qg * 32 + r) + 8 * h;
            const float4 c0 = *(const float4*)cp, c1 = *(const float4*)(cp + 4), s0 = *(const float4*)sp, s1 = *(const float4*)(sp + 4);
            const float cc[8] = {c0.x, c0.y, c0.z, c0.w, c1.x, c1.y, c1.z, c1.w}, ss[8] = {s0.x, s0.y, s0.z, s0.w, s1.x, s1.y, s1.z, s1.w};
            bf16x8 x1 = qf[NKS - 2], x2 = qf[NKS - 1];
#pragma unroll
            for (int j = 0; j < 8; ++j) {
                const float a = bf2f((bf16_t)x1[j]), b2 = bf2f((bf16_t)x2[j]);
                x1[j] = (short)f2bf(a * cc[j] - b2 * ss[j]); x2[j] = (short)f2bf(b2 * cc[j] + a * ss[j]);
            }
            qf[NKS - 2] = x1; qf[NKS - 1] = x2;
        }
    }
    f32x16 o[NDB];
#pragma unroll
    for (int d = 0; d < NDB; ++d)
#pragma unroll
        for (int e = 0; e < 16; ++e) o[d][e] = 0.f;
    float m = -1e30f, l = 0.f;
    uint4 kr[C::KCH], vr[C::VCH];
    auto gload = [&](int t) {
#pragma unroll
        for (int i = 0; i < C::KCH; ++i) { const int idx = tid + 256 * i; kr[i] = src.kload(t, idx / (DQK / 8), idx % (DQK / 8)); }
#pragma unroll
        for (int i = 0; i < C::VCH; ++i) { const int idx = tid + 256 * i; vr[i] = src.vload(t, idx / (KT / 8), idx % (KT / 8)); }
    };
    auto lstore = [&](unsigned char* buf) {
#pragma unroll
        for (int i = 0; i < C::KCH; ++i) { const int idx = tid + 256 * i; *(uint4*)(buf + (idx / (DQK / 8)) * C::KSTR + (idx % (DQK / 8)) * 16) = kr[i]; }
#pragma unroll
        for (int i = 0; i < C::VCH; ++i) {
            const int idx = tid + 256 * i, dv = idx / (KT / 8), c = idx % (KT / 8);
            unsigned char* row = buf + C::KBYTES + dv * C::VSTR + (c >> 1) * 32;
            const int a = c & 1;
            *(uint2*)(row + (4 * a) * 2) = make_uint2(vr[i].x, vr[i].y);
            *(uint2*)(row + (8 + 4 * a) * 2) = make_uint2(vr[i].z, vr[i].w);
        }
    };
    gload(0);
    __syncthreads();
    lstore(smem);
    __syncthreads();
    for (int t = 0; t < ntiles; ++t) {
        const unsigned char* cur = smem + (t & 1) * C::STAGE;
        const bool more = (t + 1 < ntiles);
        if (more && !noload) gload(t + 1);
        if (!(t == ntiles - 1 && qg < nskip)) {
            f32x16 s[NKB];
#pragma unroll
            for (int kb = 0; kb < NKB; ++kb) {
                const unsigned char* kp = cur + (kb * 32 + r) * C::KSTR + h * 16;
                if (NKB == 1) {
                    constexpr int NCH = 2;
                    f32x16 sp[NCH];
#pragma unroll
                    for (int c = 0; c < NCH; ++c)
#pragma unroll
                        for (int e = 0; e < 16; ++e) sp[c][e] = 0.f;
#pragma unroll
                    for (int ks = 0; ks < NKS; ++ks) sp[ks % NCH] = MFMA32(*(const bf16x8*)(kp + ks * 32), qf[ks], sp[ks % NCH]);
#pragma unroll
                    for (int e = 0; e < 16; ++e) s[kb][e] = sp[0][e] + sp[1][e];
                } else {
#pragma unroll
                    for (int e = 0; e < 16; ++e) s[kb][e] = 0.f;
#pragma unroll
                    for (int ks = 0; ks < NKS; ++ks) s[kb] = MFMA32(*(const bf16x8*)(kp + ks * 32), qf[ks], s[kb]);
                }
            }
            float mx = s[0][0];
#pragma unroll
            for (int kb = 0; kb < NKB; ++kb)
#pragma unroll
                for (int e = 0; e < 16; ++e) mx = fmaxf(mx, s[kb][e]);
            mx = fmaxf(mx, __shfl_xor(mx, 32));
            if (!__all(mx <= m + 8.f)) {
                const float mn = fmaxf(m, mx);
                const float alpha = __builtin_amdgcn_exp2f(m - mn);
                m = mn;
                l *= alpha;
#pragma unroll
                for (int d = 0; d < NDB; ++d)
#pragma unroll
                    for (int e = 0; e < 16; ++e) o[d][e] *= alpha;
            }
            float ps = 0.f;
#pragma unroll
            for (int kb = 0; kb < NKB; ++kb)
#pragma unroll
                for (int e = 0; e < 16; ++e) { const float pv = __builtin_amdgcn_exp2f(s[kb][e] - m); s[kb][e] = pv; ps += pv; }
            l += ps;
#pragma unroll
            for (int kb = 0; kb < NKB; ++kb)
#pragma unroll
                for (int s2 = 0; s2 < 2; ++s2) {
                    uint4 pk;
                    pk.x = pack2(s[kb][8 * s2], s[kb][8 * s2 + 1]); pk.y = pack2(s[kb][8 * s2 + 2], s[kb][8 * s2 + 3]);
                    pk.z = pack2(s[kb][8 * s2 + 4], s[kb][8 * s2 + 5]); pk.w = pack2(s[kb][8 * s2 + 6], s[kb][8 * s2 + 7]);
                    const bf16x8 pf = __builtin_bit_cast(bf16x8, pk);
                    const unsigned char* vp = cur + C::KBYTES + (dvh * DVW + r) * C::VSTR + (kb * 32 + s2 * 16 + 8 * h) * 2;
#pragma unroll
                    for (int d = 0; d < NDB; ++d) o[d] = MFMA32(*(const bf16x8*)(vp + d * 32 * C::VSTR), pf, o[d]);
                }
        }
        if (more) lstore(smem + ((t + 1) & 1) * C::STAGE);
        __syncthreads();
    }
    l += __shfl_xor(l, 32);
    const float il = 1.f / l;
#pragma unroll
    for (int d = 0; d < NDB; ++d)
#pragma unroll
        for (int g4 = 0; g4 < 4; ++g4) {
            uint2 w; w.x = pack2(o[d][4 * g4] * il, o[d][4 * g4 + 1] * il); w.y = pack2(o[d][4 * g4 + 2] * il, o[d][4 * g4 + 3] * il);
            src.store(qg * 32 + r, dvh * DVW + d * 32 + 8 * g4 + 4 * h, w);
        }
}
struct SelfSrc {
    static constexpr bool ROPE = true;
    const bf16_t *q, *kn, *kr, *vt; bf16_t* mix; int b, hd, bh, q0; const float *rc, *rs;
    DI const float* rope_c(int rr) const { return rc + (q0 + rr) * 16; }
    DI const float* rope_s(int rr) const { return rs + (q0 + rr) * 16; }
    DI const bf16_t* qrow(int rr) const { return q + ((size_t)bh * 2048 + q0 + rr) * 96; }
    DI uint4 kload(int t, int key, int c) const {
        const int kg = t * 64 + key;
        return c < 8 ? *(const uint4*)(kn + ((size_t)bh * 2048 + kg) * 64 + c * 8) : *(const uint4*)(kr + ((size_t)b * 2048 + kg) * 32 + (c - 8) * 8);
    }
    DI uint4 vload(int t, int dv, int c) const { return *(const uint4*)(vt + ((size_t)bh * 64 + dv) * 2048 + t * 64 + c * 8); }
    DI void store(int rr, int dv, uint2 w) const { *(uint2*)(mix + ((size_t)b * 2048 + q0 + rr) * 1024 + hd * 64 + dv) = w; }
};
struct CrossSrc {
    static constexpr bool ROPE = false;
    const bf16_t *qx, *kx, *vxt; bf16_t* ox; int b, hd, q0;
    DI const float* rope_c(int) const { return nullptr; }
    DI const float* rope_s(int) const { return nullptr; }
    DI const bf16_t* qrow(int rr) const { return qx + ((size_t)(b * 4 + hd) * 2048 + q0 + rr) * 256; }
    DI uint4 kload(int t, int key, int c) const { return *(const uint4*)(kx + ((size_t)(b * 4 + hd) * 256 + t * 32 + key) * 256 + c * 8); }
    DI uint4 vload(int t, int dv, int c) const { return *(const uint4*)(vxt + ((size_t)(b * 4 + hd) * 256 + dv) * 256 + t * 32 + c * 8); }
    DI void store(int rr, int dv, uint2 w) const { *(uint2*)(ox + ((size_t)b * 2048 + q0 + rr) * 1024 + hd * 256 + dv) = w; }
};
DI void attn_fast(const P& p, int bid, int nb, unsigned char* smem) {
    unsigned char* ws = p.ws;
    const int nround = (2048 + nb - 1) / nb;
    for (int rd = 0; rd < nround; ++rd) {
        const int idx = rd * nb + ((rd & 1) ? (nb - 1 - bid) : bid);
        if (idx >= 2048) continue;
        const int qb = 15 - (idx >> 7), bh = idx & 127;
        SelfSrc s{(const bf16_t*)(ws + QB), (const bf16_t*)(ws + KNB), (const bf16_t*)(ws + KROPE), (const bf16_t*)(ws + VTB), (bf16_t*)(ws + MIX), bh >> 3, bh & 7, bh, qb * 128, (const float*)(ws + ROPE_C), (const float*)(ws + ROPE_S)};
        flash_item<96, 64, 64, 4, 1>(s, 2 * qb + 2, 2, smem);
    }
}
DI void xattn_fast(const P& p, int bid, int nb, unsigned char* smem, int rep = 0) {
    unsigned char* ws = p.ws;
    for (int it = bid; it < 2048; it += nb) {
        const int bhd = it >> 5, qt = it & 31;
        CrossSrc s{(const bf16_t*)(ws + QX), (const bf16_t*)(ws + KX), (const bf16_t*)(ws + VXT), (bf16_t*)(ws + OX), bhd >> 2, bhd & 3, qt * 64};
        if (rep) s.ox = (bf16_t*)(ws + RD);
        flash_item<256, 128, 32, 2, 2>(s, 8, 0, smem, rep && REP_MODE == 5);
    }
}

constexpr int SSD_XT = 0, SSD_BM = 8192, SSD_CM = SSD_BM + 16384, SSD_BWT = SSD_CM + 16384, SSD_PS = SSD_BWT + 16384, SSD_F = SSD_PS + 16384;
static_assert(SSD_F + 2048 <= SMEM_BYTES - 32, "ssd LDS");
DI int off256(int row, int el) { return row * 256 + (((el >> 3) ^ (row & 15)) << 4) + ((el & 7) << 1); }
DI int off128(int row, int el) { return row * 128 + (((el >> 3) ^ ((row ^ (row >> 3)) & 7)) << 4) + ((el & 7) << 1); }
template <int pm>
DI void ssd_item(const P& p, int bh, unsigned char* smem) {
    unsigned char* ws = p.ws;
    const bf16_t* xa = (const bf16_t*)(ws + XBCA); const float* dtg = (const float*)(ws + DTB);
    bf16_t* mix = pm ? (bf16_t*)(ws + XBC) : (bf16_t*)(ws + MIX);
    int tid0 = tidx(); asm volatile("" : "+v"(tid0));
    const int wave = __builtin_amdgcn_readfirstlane(tid0 >> 6);
    const int b = bh >> 3, hd = bh & 7, g = hd >> 2;
    const int lb = wave >> 1, pb = wave & 1;
    const float a_h = -__expf(p.in[10][hd]), Dh = p.in[11][hd];
    float* F = (float*)(smem + SSD_F);
    __syncthreads();
    for (int i = tid0; i < 16384 / 16; i += 256) *(uint4*)(smem + SSD_PS + i * 16) = make_uint4(0u, 0u, 0u, 0u);
    f32x16 st[2];
#pragma unroll
    for (int i = 0; i < 2; ++i)
#pragma unroll
        for (int e = 0; e < 16; ++e) st[i][e] = 0.f;
    uint4 xr0, xr1, br0, br1, br2, br3, cr0, cr1, cr2, cr3; float dtr = 0.f;
#define SSD_XLD(i) (*(const uint4*)(xa + (t0_ + ((tid + 256 * (i)) >> 3)) * 1024 + hd * 64 + ((tid + 256 * (i)) & 7) * 8))
#define SSD_BLD(i, o) (*(const uint4*)(xa + (t0_ + ((tid + 256 * (i)) >> 4)) * 1024 + (o) + g * 128 + ((tid + 256 * (i)) & 15) * 8))
#define SSD_GLOAD(c_) do { const size_t t0_ = (size_t)b * 2048 + (c_) * 64; xr0 = SSD_XLD(0); xr1 = SSD_XLD(1); \
        br0 = SSD_BLD(0, 512); br1 = SSD_BLD(1, 512); br2 = SSD_BLD(2, 512); br3 = SSD_BLD(3, 512); \
        cr0 = SSD_BLD(0, 768); cr1 = SSD_BLD(1, 768); cr2 = SSD_BLD(2, 768); cr3 = SSD_BLD(3, 768); \
        if (tid < 64) dtr = dtg[(t0_ + tid) * 8 + hd]; } while (0)
    { const int tid = tid0; SSD_GLOAD(0); }
#define SSD_SCAN(FP) do { const int ln_ = tid0 & 63; float v = dtr * a_h; \
        _Pragma("unroll") for (int o = 1; o < 64; o <<= 1) { const float u = __shfl_up(v, o); if (ln_ >= o) v += u; } \
        const float a63 = __shfl(v, 63); \
        (FP)[ln_] = v; (FP)[64 + ln_] = __expf(v); (FP)[128 + ln_] = dtr; (FP)[192 + ln_] = __expf(a63 - v) * dtr; } while (0)
    if (wave == 0) SSD_SCAN(F);
    __syncthreads();
    for (int c = 0; c < 32; ++c) {
        int tid = tid0; asm volatile("" : "+v"(tid));
        const int lane = tid & 63, r = lane & 31, h = lane >> 5;
        const size_t t0 = (size_t)b * 2048 + c * 64;
        const float* Fc = F + (c & 1) * 256; float* Fn = F + ((c + 1) & 1) * 256;
#define SSD_XIMG(i, XR) do { const int idx = tid + 256 * (i), l = idx >> 3, p0 = (idx & 7) * 8, lp = perm16(l); \
            const unsigned ww[4] = {XR.x, XR.y, XR.z, XR.w}; \
            _Pragma("unroll") for (int k = 0; k < 4; ++k) { \
                *(bf16_t*)(smem + SSD_XT + off128(p0 + 2 * k, lp)) = (bf16_t)(ww[k] & 0xffffu); \
                *(bf16_t*)(smem + SSD_XT + off128(p0 + 2 * k + 1, lp)) = (bf16_t)(ww[k] >> 16); } } while (0)
#define SSD_BIMG(i, BR, CR) do { const int idx = tid + 256 * (i), l = idx >> 4, n0 = (idx & 15) * 8, lp = perm16(l); \
            *(uint4*)(smem + SSD_BM + off256(l, n0)) = BR; *(uint4*)(smem + SSD_CM + off256(l, n0)) = CR; \
            const float wl = Fc[192 + l]; const unsigned ww[4] = {BR.x, BR.y, BR.z, BR.w}; \
            _Pragma("unroll") for (int k = 0; k < 4; ++k) { \
                *(bf16_t*)(smem + SSD_BWT + off128(n0 + 2 * k, lp)) = f2bf(bflo(ww[k]) * wl); \
                *(bf16_t*)(smem + SSD_BWT + off128(n0 + 2 * k + 1, lp)) = f2bf(bfhi(ww[k]) * wl); } } while (0)
        if (!(pm & 2)) {
        SSD_XIMG(0, xr0); SSD_XIMG(1, xr1);
        SSD_BIMG(0, br0, cr0); SSD_BIMG(1, br1, cr1); SSD_BIMG(2, br2, cr2); SSD_BIMG(3, br3, cr3);
        } else { asm volatile("" :: "v"(xr0.x), "v"(xr1.x), "v"(br0.x), "v"(br1.x), "v"(br2.x), "v"(br3.x), "v"(cr0.x), "v"(cr1.x), "v"(cr2.x), "v"(cr3.x)); }
        __syncthreads();
        if (c + 1 < 32) SSD_GLOAD(c + 1);
        if (!(pm & 1)) {
        const float acs_l = Fc[lb * 32 + r];
        const int lrow = lb * 32 + r;
        f32x16 cb0, cb1, yo;
#pragma unroll
        for (int e = 0; e < 16; ++e) { cb0[e] = 0.f; cb1[e] = 0.f; yo[e] = 0.f; }
#pragma unroll
        for (int ks = 0; ks < 8; ++ks) {
            const bf16x8 cv = *(const bf16x8*)(smem + SSD_CM + off256(lb * 32 + r, 16 * ks + 8 * h));
            const bf16x8 b0v = *(const bf16x8*)(smem + SSD_BM + off256(r, 16 * ks + 8 * h));
            const bf16x8 b1v = *(const bf16x8*)(smem + SSD_BM + off256(32 + r, 16 * ks + 8 * h));
            const bf16x8 pv = *(const bf16x8*)(smem + SSD_PS + off256(pb * 32 + r, 16 * ks + 8 * h));
            cb0 = MFMA32(b0v, cv, cb0); cb1 = MFMA32(b1v, cv, cb1); yo = MFMA32(cv, pv, yo);
        }
        f32x16 yd;
#pragma unroll
        for (int e = 0; e < 16; ++e) yd[e] = 0.f;
#pragma unroll
        for (int sb = 0; sb < 2; ++sb) {
            float mv[16];
#pragma unroll
            for (int q4 = 0; q4 < 4; ++q4) {
                const int s0 = sb * 32 + 8 * q4 + 4 * h;
                const float4 as4 = *(const float4*)(Fc + s0), dt4 = *(const float4*)(Fc + 128 + s0);
                const float asv[4] = {as4.x, as4.y, as4.z, as4.w}, dtv[4] = {dt4.x, dt4.y, dt4.z, dt4.w};
#pragma unroll
                for (int k = 0; k < 4; ++k) { const float cbv = sb ? cb1[4 * q4 + k] : cb0[4 * q4 + k]; mv[4 * q4 + k] = (s0 + k <= lrow) ? cbv * __expf(acs_l - asv[k]) * dtv[k] : 0.f; }
            }
#pragma unroll
            for (int s2 = 0; s2 < 2; ++s2) {
                uint4 pk;
                pk.x = pack2(mv[8 * s2], mv[8 * s2 + 1]); pk.y = pack2(mv[8 * s2 + 2], mv[8 * s2 + 3]);
                pk.z = pack2(mv[8 * s2 + 4], mv[8 * s2 + 5]); pk.w = pack2(mv[8 * s2 + 6], mv[8 * s2 + 7]);
                const bf16x8 xb = *(const bf16x8*)(smem + SSD_XT + off128(pb * 32 + r, sb * 32 + 16 * s2 + 8 * h));
                yd = MFMA32(__builtin_bit_cast(bf16x8, pk), xb, yd);
            }
        }
        {
            const uint4 x0 = *(const uint4*)(smem + SSD_XT + off128(pb * 32 + r, lb * 32 + 8 * h));
            const uint4 x1 = *(const uint4*)(smem + SSD_XT + off128(pb * 32 + r, lb * 32 + 16 + 8 * h));
            const unsigned xw[8] = {x0.x, x0.y, x0.z, x0.w, x1.x, x1.y, x1.z, x1.w};
            bf16_t* op = mix + (t0 + lb * 32 + 4 * h) * 1024 + 512 + hd * 64 + pb * 32 + r;
#pragma unroll
            for (int q4 = 0; q4 < 4; ++q4) {
                const float4 ea4 = *(const float4*)(Fc + 64 + lb * 32 + 8 * q4 + 4 * h);
                const float eav[4] = {ea4.x, ea4.y, ea4.z, ea4.w};
#pragma unroll
                for (int k = 0; k < 4; ++k) {
                    const int e = 4 * q4 + k;
                    const float xv = (e & 1) ? bfhi(xw[e >> 1]) : bflo(xw[e >> 1]);
                    const float y = yd[e] + eav[k] * yo[e] + Dh * xv;
                    op[(size_t)(k + 8 * q4) * 1024] = f2bf(y);
                }
            }
        }
        {
            const float dec = Fc[64 + 63];
#pragma unroll
            for (int e = 0; e < 16; ++e) { st[0][e] *= dec; st[1][e] *= dec; }
            const int nblk = 2 * (wave >> 1);
#pragma unroll
            for (int ks = 0; ks < 4; ++ks) {
                const bf16x8 av = *(const bf16x8*)(smem + SSD_XT + off128(pb * 32 + r, 16 * ks + 8 * h));
                const bf16x8 bv0 = *(const bf16x8*)(smem + SSD_BWT + off128(nblk * 32 + r, 16 * ks + 8 * h));
                const bf16x8 bv1 = *(const bf16x8*)(smem + SSD_BWT + off128(nblk * 32 + 32 + r, 16 * ks + 8 * h));
                st[0] = MFMA32(av, bv0, st[0]); st[1] = MFMA32(av, bv1, st[1]);
            }
        }
        }
        if (wave == 0 && c + 1 < 32) SSD_SCAN(Fn);
        __syncthreads();
#pragma unroll
        for (int i = 0; i < 2; ++i) {
            const int n = (2 * (wave >> 1) + i) * 32 + r;
#pragma unroll
            for (int e = 0; e < 16; ++e) *(bf16_t*)(smem + SSD_PS + off256(pb * 32 + crow(e, h), n)) = f2bf(st[i][e]);
        }
    }
    __syncthreads();
}

#if ATTN_NAIVE
DI void attn_naive(const P& p, int bid, int nb) {
    unsigned char* ws = p.ws;
    const bf16_t* Q = (const bf16_t*)(ws + QB); const bf16_t* Kn = (const bf16_t*)(ws + KNB); const bf16_t* Vt = (const bf16_t*)(ws + VTB);
    const bf16_t* Kr = (const bf16_t*)(ws + KROPE); bf16_t* mix = (bf16_t*)(ws + MIX);
    for (int item = bid; item < 128 * 8; item += nb) {
        const int bh = item >> 3, s_ = (item & 7) * 256 + tidx(), b = bh >> 3, hd = bh & 7;
        float q[96];
        {
            const uint4* q4 = (const uint4*)(Q + ((size_t)bh * 2048 + s_) * 96);
#pragma unroll
            for (int i = 0; i < 12; ++i) { const uint4 w = q4[i]; q[8 * i] = bflo(w.x); q[8 * i + 1] = bfhi(w.x); q[8 * i + 2] = bflo(w.y); q[8 * i + 3] = bfhi(w.y);
                q[8 * i + 4] = bflo(w.z); q[8 * i + 5] = bfhi(w.z); q[8 * i + 6] = bflo(w.w); q[8 * i + 7] = bfhi(w.w); }
        }
        float o[64];
#pragma unroll
        for (int d = 0; d < 64; ++d) o[d] = 0.f;
        float m = -1e30f, l = 0.f;
        const int nkeys = __builtin_amdgcn_readfirstlane(((s_ >> 6) + 1) * 64);
        for (int j0 = 0; j0 < nkeys; j0 += 8) {
            float sc[8];
#pragma unroll
            for (int jj = 0; jj < 8; ++jj) {
                const int j = j0 + jj;
                const uint4* k4 = (const uint4*)(Kn + ((size_t)bh * 2048 + j) * 64);
                const uint4* r4 = (const uint4*)(Kr + ((size_t)b * 2048 + j) * 32);
                float a = 0.f;
#pragma unroll
                for (int i = 0; i < 8; ++i) { const uint4 w = k4[i]; a += q[8 * i] * bflo(w.x) + q[8 * i + 1] * bfhi(w.x) + q[8 * i + 2] * bflo(w.y) + q[8 * i + 3] * bfhi(w.y)
                    + q[8 * i + 4] * bflo(w.z) + q[8 * i + 5] * bfhi(w.z) + q[8 * i + 6] * bflo(w.w) + q[8 * i + 7] * bfhi(w.w); }
#pragma unroll
                for (int i = 0; i < 4; ++i) { const uint4 w = r4[i]; const int o8 = 64 + 8 * i; a += q[o8] * bflo(w.x) + q[o8 + 1] * bfhi(w.x) + q[o8 + 2] * bflo(w.y) + q[o8 + 3] * bfhi(w.y)
                    + q[o8 + 4] * bflo(w.z) + q[o8 + 5] * bfhi(w.z) + q[o8 + 6] * bflo(w.w) + q[o8 + 7] * bfhi(w.w); }
                sc[jj] = a;
            }
            float mx = m;
#pragma unroll
            for (int jj = 0; jj < 8; ++jj) mx = fmaxf(mx, sc[jj]);
            const float al = exp2f(m - mx);
            float ps = 0.f;
#pragma unroll
            for (int jj = 0; jj < 8; ++jj) { sc[jj] = exp2f(sc[jj] - mx); ps += sc[jj]; }
            l = l * al + ps; m = mx;
#pragma unroll
            for (int d = 0; d < 64; ++d) {
                const uint4 w = *(const uint4*)(Vt + ((size_t)bh * 64 + d) * 2048 + j0);
                o[d] = o[d] * al + sc[0] * bflo(w.x) + sc[1] * bfhi(w.x) + sc[2] * bflo(w.y) + sc[3] * bfhi(w.y) + sc[4] * bflo(w.z) + sc[5] * bfhi(w.z) + sc[6] * bflo(w.w) + sc[7] * bfhi(w.w);
            }
        }
        const float il = 1.f / l;
        bf16_t* dst = mix + ((size_t)b * 2048 + s_) * 1024 + hd * 64;
#pragma unroll
        for (int d = 0; d < 64; d += 2) *(unsigned*)(dst + d) = pack2(o[d] * il, o[d + 1] * il);
    }
}
#endif
#if SSD_NAIVE
DI void ssd_naive(const P& p, int bid, int nb) {
    unsigned char* ws = p.ws;
    const bf16_t* xa = (const bf16_t*)(ws + XBCA); const float* dt = (const float*)(ws + DTB); const bf16_t* z = (const bf16_t*)(ws + ZB);
    bf16_t* mix = (bf16_t*)(ws + MIX);
    const int wave = tidx() >> 6, pp = tidx() & 63;
    for (int item = bid; item < 32; item += nb) {
        const int bh = item * 4 + wave, b = bh >> 3, hd = bh & 7, g = hd >> 2;
        const float a = -__expf(p.in[10][hd]), Dh = p.in[11][hd];
        float st[128];
#pragma unroll
        for (int n = 0; n < 128; ++n) st[n] = 0.f;
        for (int t = 0; t < 2048; ++t) {
            const size_t row = (size_t)b * 2048 + t;
            const float dtv = dt[row * 8 + hd];
            const float da = __expf(dtv * a);
            const float xv = bf2f(xa[row * 1024 + hd * 64 + pp]);
            const float xd = dtv * xv;
            const uint4* b4 = (const uint4*)(xa + row * 1024 + 512 + g * 128);
            const uint4* c4 = (const uint4*)(xa + row * 1024 + 768 + g * 128);
            float y = 0.f;
#pragma unroll
            for (int i = 0; i < 16; ++i) {
                const uint4 bw = b4[i], cw = c4[i];
                const unsigned bb[4] = {bw.x, bw.y, bw.z, bw.w}, cc[4] = {cw.x, cw.y, cw.z, cw.w};
#pragma unroll
                for (int k = 0; k < 4; ++k) {
                    const int n = 8 * i + 2 * k;
                    st[n] = da * st[n] + xd * bflo(bb[k]); y += bflo(cc[k]) * st[n];
                    st[n + 1] = da * st[n + 1] + xd * bfhi(bb[k]); y += bfhi(cc[k]) * st[n + 1];
                }
            }
            y += Dh * xv;
            const float zv = bf2f(z[row * 512 + hd * 64 + pp]);
            mix[row * 1024 + 512 + hd * 64 + pp] = f2bf(y * siluf(zv));
        }
    }
}
#endif
DI void phase_mixer(const P& p, int bid, int nb, unsigned char* smem, int rep = 0) {
#if SSD_NAIVE
    ssd_naive(p, bid, nb);
    attn_fast(p, bid, nb, smem);
#else
    unsigned* ctr = (unsigned*)(p.ws + CTL + CTL_QUEUE) + 64 * rep;
    int* slot = (int*)(smem + SMEM_BYTES - 32);
    for (;;) {
        __syncthreads();
        if (tidx() == 0) *slot = (int)atomicAdd(ctr, 1u);
        __syncthreads();
        const int it = *slot;
        if (it >= 128 + 2048) break;
        if (it < 128) { if (!NO_SSD && !(rep && REP_MODE == 2)) { if (rep) ssd_item<SSD_PM>(p, it, smem); else ssd_item<0>(p, it, smem); } }
        else if (rep && REP_MODE >= 1) { }
        else {
            const int idx = it - 128, qb = 15 - (idx >> 7), bh = idx & 127;
            unsigned char* ws = p.ws;
            SelfSrc s{(const bf16_t*)(ws + QB), (const bf16_t*)(ws + KNB), (const bf16_t*)(ws + KROPE), (const bf16_t*)(ws + VTB), (bf16_t*)(ws + MIX), bh >> 3, bh & 7, bh, qb * 128, (const float*)(ws + ROPE_C), (const float*)(ws + ROPE_S)};
            if (rep) s.mix = (bf16_t*)(ws + XBC);
            if (!NO_FLASH) flash_item<96, 64, 64, 4, 1>(s, 2 * qb + 2, 2, smem, rep && REP_MODE == 5);
        }
    }
#endif
}

DI void phase_ssdnorm(const P& p, int bid, int nb, unsigned char* smem) {
    bf16_t* mix = (bf16_t*)(p.ws + MIX); const bf16_t* z = (const bf16_t*)(p.ws + ZB);
    const int lane = tidx() & 63, wave = tidx() >> 6;
    for (int tk = bid * 4 + wave; tk < T; tk += nb * 4) {
        uint4* ptr = (uint4*)(mix + (size_t)tk * 1024 + 512 + lane * 8);
        const uint4 w = *ptr, zz = *(const uint4*)(z + (size_t)tk * 512 + lane * 8);
        const unsigned ww[4] = {w.x, w.y, w.z, w.w}, zw[4] = {zz.x, zz.y, zz.z, zz.w};
        float v[8]; float ss = 0.f;
#pragma unroll
        for (int k = 0; k < 4; ++k) {
            v[2 * k] = bflo(ww[k]) * siluf(bflo(zw[k])); v[2 * k + 1] = bfhi(ww[k]) * siluf(bfhi(zw[k]));
            ss += v[2 * k] * v[2 * k] + v[2 * k + 1] * v[2 * k + 1];
        }
#pragma unroll
        for (int o = 16; o >= 1; o >>= 1) ss += __shfl_xor(ss, o);
        const float rr = rsqrtf(ss * (1.f / 256.f) + EPS);
        uint4 o4; o4.x = pack2(v[0] * rr, v[1] * rr); o4.y = pack2(v[2] * rr, v[3] * rr); o4.z = pack2(v[4] * rr, v[5] * rr); o4.w = pack2(v[6] * rr, v[7] * rr);
        *ptr = o4;
    }
}

template <bool RES_BF16>
struct EpiResid {
    bf16_t* pre; const void* res;
    float4 pf[RES_BF16 ? 1 : 16]; uint2 pb[RES_BF16 ? 16 : 1];
    DI void prefetch(int m0, int n0, int tid) {
        const int c4 = (tid & 31) * 4, r0 = tid >> 5;
#pragma unroll
        for (int ps = 0; ps < 16; ++ps) {
            const size_t idx = (size_t)(m0 + ps * 8 + r0) * 1024 + n0 + c4;
            if (RES_BF16) pb[ps] = *(const uint2*)((const bf16_t*)res + idx); else pf[ps] = *(const float4*)((const float*)res + idx);
        }
    }
    DI void operator()(const float* Cs, int m0, int n0, int tid) const {
        const int c4 = (tid & 31) * 4, r0 = tid >> 5;
#pragma unroll
        for (int ps = 0; ps < 16; ++ps) {
            const int row = ps * 8 + r0;
            const float4 v = cs4(Cs, row, c4);
            float4 rr;
            if (RES_BF16) rr = make_float4(bflo(pb[ps].x), bfhi(pb[ps].x), bflo(pb[ps].y), bfhi(pb[ps].y)); else rr = pf[ps];
            *(uint2*)(pre + (size_t)(m0 + row) * 1024 + n0 + c4) = pack4(make_float4(ALPHA * rr.x + v.x, ALPHA * rr.y + v.y, ALPHA * rr.z + v.z, ALPHA * rr.w + v.w));
        }
    }
};
DI void phase_wout(const P& p, int bid, int nb, unsigned char* smem) {
    const int v = vbid(bid, nb);
    EpiResid<true> e; e.pre = (bf16_t*)p.out; e.res = p.out;
    GemmArgs g{(const bf16_t*)(p.ws + MIX), 1024, (const bf16_t*)(p.ws + W_OUT), 1024, 1024, nullptr};
    for (int t = v; t < 256 * 8; t += nb) gemm_tile(g, (t >> 3) * 128, (t & 7) * 128, e, smem);
}
DI void ln_row(const float* src, const float* gam, const float* bet, int lane, float (&o)[16]) {
    float v[16];
#pragma unroll
    for (int i = 0; i < 4; ++i) { const float4 t4 = *(const float4*)(src + i * 256 + lane * 4); v[4 * i] = t4.x; v[4 * i + 1] = t4.y; v[4 * i + 2] = t4.z; v[4 * i + 3] = t4.w; }
    float s = 0.f;
#pragma unroll
    for (int i = 0; i < 16; ++i) s += v[i];
    const float mu = wave_sum(s) * (1.f / 1024.f);
    float q = 0.f;
#pragma unroll
    for (int i = 0; i < 16; ++i) { const float d = v[i] - mu; q += d * d; }
    const float rstd = rsqrtf(wave_sum(q) * (1.f / 1024.f) + EPS);
#pragma unroll
    for (int i = 0; i < 4; ++i) {
        const float4 g4 = *(const float4*)(gam + i * 256 + lane * 4), b4 = *(const float4*)(bet + i * 256 + lane * 4);
        o[4 * i] = (v[4 * i] - mu) * rstd * g4.x + b4.x; o[4 * i + 1] = (v[4 * i + 1] - mu) * rstd * g4.y + b4.y;
        o[4 * i + 2] = (v[4 * i + 2] - mu) * rstd * g4.z + b4.z; o[4 * i + 3] = (v[4 * i + 3] - mu) * rstd * g4.w + b4.w;
    }
}
DI void ln_stats2(const float (&va)[16], const float (&vb)[16], float& mua, float& rsa, float& mub, float& rsb) {
    float sa = 0.f, sb = 0.f;
#pragma unroll
    for (int i = 0; i < 16; ++i) { sa += va[i]; sb += vb[i]; }
#pragma unroll
    for (int o = 32; o >= 1; o >>= 1) { sa += __shfl_xor(sa, o); sb += __shfl_xor(sb, o); }
    mua = sa * (1.f / 1024.f); mub = sb * (1.f / 1024.f);
    float qa = 0.f, qb = 0.f;
#pragma unroll
    for (int i = 0; i < 16; ++i) { const float da = va[i] - mua, db = vb[i] - mub; qa += da * da; qb += db * db; }
#pragma unroll
    for (int o = 32; o >= 1; o >>= 1) { qa += __shfl_xor(qa, o); qb += __shfl_xor(qb, o); }
    rsa = rsqrtf(qa * (1.f / 1024.f) + EPS); rsb = rsqrtf(qb * (1.f / 1024.f) + EPS);
}
DI void load_row16(const bf16_t* src, int lane, float (&v)[16]) {
#pragma unroll
    for (int i = 0; i < 4; ++i) { const uint2 t2 = *(const uint2*)(src + i * 256 + lane * 4); v[4 * i] = bflo(t2.x); v[4 * i + 1] = bfhi(t2.x); v[4 * i + 2] = bflo(t2.y); v[4 * i + 3] = bfhi(t2.y); }
}
DI void phase_ln1(const P& p, int bid, int nb, unsigned char* smem) {
    const int lane = tidx() & 63, wave = tidx() >> 6;
    const bf16_t* pre = (const bf16_t*)p.out; bf16_t* hb = (bf16_t*)(p.ws + H1B);
    const float* gam = p.in[14]; const float* bet = p.in[15];
    for (int tk = bid * 4 + wave; tk < T; tk += nb * 8) {
        const int tk2 = tk + nb * 4;
        float va[16], vb[16], mua, rsa, mub, rsb;
        load_row16(pre + (size_t)tk * 1024, lane, va); load_row16(pre + (size_t)tk2 * 1024, lane, vb);
        ln_stats2(va, vb, mua, rsa, mub, rsb);
#pragma unroll
        for (int i = 0; i < 4; ++i) {
            const float4 g4 = *(const float4*)(gam + i * 256 + lane * 4), b4 = *(const float4*)(bet + i * 256 + lane * 4);
            const float4 oa = make_float4((va[4 * i] - mua) * rsa * g4.x + b4.x, (va[4 * i + 1] - mua) * rsa * g4.y + b4.y, (va[4 * i + 2] - mua) * rsa * g4.z + b4.z, (va[4 * i + 3] - mua) * rsa * g4.w + b4.w);
            const float4 ob = make_float4((vb[4 * i] - mub) * rsb * g4.x + b4.x, (vb[4 * i + 1] - mub) * rsb * g4.y + b4.y, (vb[4 * i + 2] - mub) * rsb * g4.z + b4.z, (vb[4 * i + 3] - mub) * rsb * g4.w + b4.w);
            *(uint2*)(hb + (size_t)tk * 1024 + i * 256 + lane * 4) = pack4(oa); *(uint2*)(hb + (size_t)tk2 * 1024 + i * 256 + lane * 4) = pack4(ob);
        }
    }
}
struct EpiXq {
    bf16_t* qx;
    DI void prefetch(int, int, int) {}
    DI void operator()(const float* Cs, int m0, int n0, int tid) const {
        const int c4 = (tid & 31) * 4, r0 = tid >> 5, hd = n0 >> 8, d = (n0 & 255) + c4, b = m0 >> 11, s0 = m0 & 2047;
#pragma unroll 4
        for (int ps = 0; ps < 16; ++ps) {
            const int row = ps * 8 + r0;
            float4 v = cs4(Cs, row, c4); v.x *= XSCALE; v.y *= XSCALE; v.z *= XSCALE; v.w *= XSCALE;
            *(uint2*)(qx + ((size_t)(b * 4 + hd) * 2048 + s0 + row) * 256 + d) = pack4(v);
        }
    }
};
DI void phase_xq(const P& p, int bid, int nb, unsigned char* smem) {
    const int v = vbid(bid, nb);
    EpiXq e{(bf16_t*)(p.ws + QX)};
    GemmArgs g{(const bf16_t*)(p.ws + H1B), 1024, (const bf16_t*)(p.ws + W_XQ), 1024, 1024, nullptr};
    for (int t = v; t < 256 * 8; t += nb) gemm_tile(g, (t >> 3) * 128, (t & 7) * 128, e, smem);
}
DI void phase_xattn(const P& p, int bid, int nb, unsigned char* smem, int rep = 0) {
#if !XATTN_NAIVE
    xattn_fast(p, bid, nb, smem, rep); return;
#endif
    unsigned char* ws = p.ws;
    const bf16_t* qx = (const bf16_t*)(ws + QX); const bf16_t* kx = (const bf16_t*)(ws + KX); const bf16_t* vxt = (const bf16_t*)(ws + VXT);
    bf16_t* ox = (bf16_t*)(ws + OX);
    const int lane = tidx() & 63, hd = tidx() >> 6;
    float* qs = (float*)smem + hd * 512; float* ps = qs + 256;
    for (int tk = bid; tk < T; tk += nb) {
        const int b = tk >> 11, s_ = tk & 2047;
        __syncthreads();
        {
            const uint2 w = *(const uint2*)(qx + ((size_t)(b * 4 + hd) * 2048 + s_) * 256 + lane * 4);
            qs[lane * 4] = bflo(w.x); qs[lane * 4 + 1] = bfhi(w.x); qs[lane * 4 + 2] = bflo(w.y); qs[lane * 4 + 3] = bfhi(w.y);
        }
        __syncthreads();
        float sc[4];
#pragma unroll
        for (int i = 0; i < 4; ++i) {
            const int m = lane + 64 * i;
            const uint4* k4 = (const uint4*)(kx + ((size_t)(b * 4 + hd) * 256 + m) * 256);
            float a = 0.f;
#pragma unroll 8
            for (int c = 0; c < 32; ++c) {
                const uint4 w = k4[c];
                const float4 q0 = *(const float4*)(qs + 8 * c), q1 = *(const float4*)(qs + 8 * c + 4);
                a += q0.x * bflo(w.x) + q0.y * bfhi(w.x) + q0.z * bflo(w.y) + q0.w * bfhi(w.y) + q1.x * bflo(w.z) + q1.y * bfhi(w.z) + q1.z * bflo(w.w) + q1.w * bfhi(w.w);
            }
            sc[i] = a;
        }
        const float mx = wave_max(fmaxf(fmaxf(sc[0], sc[1]), fmaxf(sc[2], sc[3])));
        float sum = 0.f;
#pragma unroll
        for (int i = 0; i < 4; ++i) { sc[i] = exp2f(sc[i] - mx); sum += sc[i]; }
        const float il = 1.f / wave_sum(sum);
#pragma unroll
        for (int i = 0; i < 4; ++i) ps[lane + 64 * i] = sc[i] * il;
        __syncthreads();
        float o[4];
#pragma unroll
        for (int dd = 0; dd < 4; ++dd) {
            const int d = lane * 4 + dd;
            const uint4* v4 = (const uint4*)(vxt + ((size_t)(b * 4 + hd) * 256 + d) * 256);
            float a = 0.f;
#pragma unroll 8
            for (int c = 0; c < 32; ++c) {
                const uint4 w = v4[c];
                const float4 q0 = *(const float4*)(ps + 8 * c), q1 = *(const float4*)(ps + 8 * c + 4);
                a += q0.x * bflo(w.x) + q0.y * bfhi(w.x) + q0.z * bflo(w.y) + q0.w * bfhi(w.y) + q1.x * bflo(w.z) + q1.y * bfhi(w.z) + q1.z * bflo(w.w) + q1.w * bfhi(w.w);
            }
            o[dd] = a;
        }
        uint2 w; w.x = pack2(o[0], o[1]); w.y = pack2(o[2], o[3]);
        *(uint2*)(ox + (size_t)tk * 1024 + hd * 256 + lane * 4) = w;
    }
}
DI void phase_xo(const P& p, int bid, int nb, unsigned char* smem) {
    const int v = vbid(bid, nb);
    EpiResid<true> e; e.pre = (bf16_t*)p.out; e.res = p.ws + H1B;
    GemmArgs g{(const bf16_t*)(p.ws + OX), 1024, (const bf16_t*)(p.ws + W_XO), 1024, 1024, nullptr};
    for (int t = v; t < 256 * 8; t += nb) gemm_tile(g, (t >> 3) * 128, (t & 7) * 128, e, smem);
}
DI void phase_ln2_router(const P& p, int bid, int nb, unsigned char* smem, int rep = 0) {
    unsigned char* ws = p.ws;
    const int lane = tidx() & 63, wave = tidx() >> 6;
    const bf16_t* pre = (const bf16_t*)p.out; bf16_t* hb = (bf16_t*)(ws + H2B);
    const float* wrt = (const float*)(ws + W_RT);
    const float* gam = p.in[20]; const float* bet = p.in[21];
    unsigned* cnt = (unsigned*)(ws + CTL + CTL_CNT); int* lists = (int*)(ws + LISTS); float* tgate = (float*)(ws + TOK_GATE);
    float* lg = (float*)smem + wave * (16 * 52 + 32);
    float* stt = lg + 16 * 52;
    for (int grp = bid; grp < T / 64; grp += nb) {
        const int t0 = grp * 64 + wave * 16;
        for (int rr = 0; rr < 16; rr += 2) {
            if (rep && REP_MODE == 3) break;
            const int tk = t0 + rr;
            float va[16], vb[16], mua, rsa, mub, rsb;
            load_row16(pre + (size_t)tk * 1024, lane, va); load_row16(pre + (size_t)(tk + 1) * 1024, lane, vb);
            ln_stats2(va, vb, mua, rsa, mub, rsb);
            if (lane == 0) { stt[2 * rr] = mua; stt[2 * rr + 1] = rsa; stt[2 * rr + 2] = mub; stt[2 * rr + 3] = rsb; }
#pragma unroll
            for (int i = 0; i < 4; ++i) {
                const float4 g4 = *(const float4*)(gam + i * 256 + lane * 4), b4 = *(const float4*)(bet + i * 256 + lane * 4);
                const float4 oa = make_float4((va[4 * i] - mua) * rsa * g4.x + b4.x, (va[4 * i + 1] - mua) * rsa * g4.y + b4.y, (va[4 * i + 2] - mua) * rsa * g4.z + b4.z, (va[4 * i + 3] - mua) * rsa * g4.w + b4.w);
                const float4 ob = make_float4((vb[4 * i] - mub) * rsb * g4.x + b4.x, (vb[4 * i + 1] - mub) * rsb * g4.y + b4.y, (vb[4 * i + 2] - mub) * rsb * g4.z + b4.z, (vb[4 * i + 3] - mub) * rsb * g4.w + b4.w);
                *(uint2*)(hb + (size_t)tk * 1024 + i * 256 + lane * 4) = pack4(oa); *(uint2*)(hb + (size_t)(tk + 1) * 1024 + i * 256 + lane * 4) = pack4(ob);
            }
        }
        __builtin_amdgcn_wave_barrier();
        if (!(rep && REP_MODE == 2)) {
            const int i16 = lane & 15, g4i = lane >> 4;
            const float mu = stt[2 * i16], rstd = stt[2 * i16 + 1];
            const bf16_t* arow = pre + (size_t)(t0 + i16) * 1024 + 4 * g4i;
            const float* brow = wrt + (size_t)i16 * 1024 + 4 * g4i;
            const float* grow = gam + 4 * g4i; const float* berow = bet + 4 * g4i;
            f32x4v acc0 = {0.f, 0.f, 0.f, 0.f}, acc1 = acc0, acc2 = acc0;
#pragma unroll 4
            for (int S = 0; S < 64; ++S) {
                const uint2 xw = *(const uint2*)(arow + 16 * S); const float4 x4 = make_float4(bflo(xw.x), bfhi(xw.x), bflo(xw.y), bfhi(xw.y));
                const float4 g4 = *(const float4*)(grow + 16 * S), e4 = *(const float4*)(berow + 16 * S);
                const float4 b0 = *(const float4*)(brow + 16 * S), b1 = *(const float4*)(brow + 16 * 1024 + 16 * S), b2 = *(const float4*)(brow + 32 * 1024 + 16 * S);
                const float a0 = (x4.x - mu) * rstd * g4.x + e4.x, a1 = (x4.y - mu) * rstd * g4.y + e4.y, a2 = (x4.z - mu) * rstd * g4.z + e4.z, a3 = (x4.w - mu) * rstd * g4.w + e4.w;
                acc0 = __builtin_amdgcn_mfma_f32_16x16x4f32(a0, b0.x, acc0, 0, 0, 0); acc1 = __builtin_amdgcn_mfma_f32_16x16x4f32(a0, b1.x, acc1, 0, 0, 0); acc2 = __builtin_amdgcn_mfma_f32_16x16x4f32(a0, b2.x, acc2, 0, 0, 0);
                acc0 = __builtin_amdgcn_mfma_f32_16x16x4f32(a1, b0.y, acc0, 0, 0, 0); acc1 = __builtin_amdgcn_mfma_f32_16x16x4f32(a1, b1.y, acc1, 0, 0, 0); acc2 = __builtin_amdgcn_mfma_f32_16x16x4f32(a1, b2.y, acc2, 0, 0, 0);
                acc0 = __builtin_amdgcn_mfma_f32_16x16x4f32(a2, b0.z, acc0, 0, 0, 0); acc1 = __builtin_amdgcn_mfma_f32_16x16x4f32(a2, b1.z, acc1, 0, 0, 0); acc2 = __builtin_amdgcn_mfma_f32_16x16x4f32(a2, b2.z, acc2, 0, 0, 0);
                acc0 = __builtin_amdgcn_mfma_f32_16x16x4f32(a3, b0.w, acc0, 0, 0, 0); acc1 = __builtin_amdgcn_mfma_f32_16x16x4f32(a3, b1.w, acc1, 0, 0, 0); acc2 = __builtin_amdgcn_mfma_f32_16x16x4f32(a3, b2.w, acc2, 0, 0, 0);
            }
#pragma unroll
            for (int e = 0; e < 4; ++e) {
                float* rowp = lg + (4 * g4i + e) * 52 + i16;
                rowp[0] = acc0[e]; rowp[16] = acc1[e]; rowp[32] = acc2[e];
            }
        }
        __builtin_amdgcn_wave_barrier();
        unsigned* lcount = (unsigned*)((float*)smem + 4 * (16 * 52 + 32));
        unsigned* lbase = lcount + 32;
        if (tidx() < 32) lcount[tidx()] = 0u;
        __syncthreads();
        int ex1 = 0, ex2 = 0; unsigned lp1 = 0, lp2 = 0;
        if (lane < 16) {
            const int tk = t0 + lane;
            const float* lr = lg + lane * 52;
            float gl[4], el[32];
#pragma unroll
            for (int j = 0; j < 4; ++j) gl[j] = lr[j] + p.in[23][j];
#pragma unroll
            for (int j = 0; j < 32; ++j) el[j] = lr[4 + j] + p.in[25][j];
            int gi = 0; float gm = gl[0];
#pragma unroll
            for (int j = 1; j < 4; ++j) if (gl[j] > gm) { gm = gl[j]; gi = j; }
            float gs = 0.f;
#pragma unroll
            for (int j = 0; j < 4; ++j) gs += __expf(gl[j] - gm);
            const float ggate = 1.f / gs;
            float ev[8];
#pragma unroll
            for (int j = 0; j < 8; ++j) ev[j] = gi == 0 ? el[j] : gi == 1 ? el[8 + j] : gi == 2 ? el[16 + j] : el[24 + j];
            int i1 = 0; float v1 = ev[0];
#pragma unroll
            for (int j = 1; j < 8; ++j) if (ev[j] > v1) { v1 = ev[j]; i1 = j; }
            int i2 = -1; float v2 = -3.0e38f;
#pragma unroll
            for (int j = 0; j < 8; ++j) if (j != i1 && ev[j] > v2) { v2 = ev[j]; i2 = j; }
            const float e2 = __expf(v2 - v1);
            tgate[tk * 2] = ggate / (1.f + e2); tgate[tk * 2 + 1] = ggate * e2 / (1.f + e2);
            ex1 = gi * 8 + i1; ex2 = gi * 8 + i2;
            if (!rep) { lp1 = atomicAdd(&lcount[ex1], 1u); lp2 = atomicAdd(&lcount[ex2], 1u); }
        }
        __syncthreads();
        if (tidx() < 32 && !rep) { const unsigned c = lcount[tidx()]; lbase[tidx()] = c ? atomicAdd(&cnt[tidx() * CNT_STRIDE], c) : 0u; }
        __syncthreads();
        if (lane < 16 && !rep) {
            const int tk = t0 + lane;
            lists[(size_t)ex1 * T + lbase[ex1] + lp1] = tk * 2;
            lists[(size_t)ex2 * T + lbase[ex2] + lp2] = tk * 2 + 1;
        }
        __syncthreads();
    }
}
struct MoeMap { int off[33]; };
DI int moe_tiles(const unsigned* cnt, int* offs  ) {
    __syncthreads();
    if (tidx() == 0) { int o = 0; for (int e = 0; e < 32; ++e) { offs[e] = o; o += (((int)cnt[e * CNT_STRIDE] + 127) >> 7) << 7; } offs[32] = o; }
    __syncthreads();
    return offs[32] >> 7;
}
struct EpiGU {
    bf16_t* hdn;
    DI void prefetch(int, int, int) {}
    DI void operator()(const float* Cs, int m0, int n0, int tid) const {
#pragma unroll 4
        for (int ps = 0; ps < 8; ++ps) {
            const int it = ps * 256 + tid, row = it >> 4, qd = it & 15, c = (qd >> 3) * 64 + (qd & 7) * 4;
            const float4 g = cs4(Cs, row, c), u = cs4(Cs, row, c + 32);
            const int hc = ((n0 & 511) >> 7) * 64 + (qd >> 3) * 32 + (qd & 7) * 4;
            *(uint2*)(hdn + (size_t)(m0 + row) * 256 + hc) = pack4(make_float4(siluf(g.x) * u.x, siluf(g.y) * u.y, siluf(g.z) * u.z, siluf(g.w) * u.w));
        }
    }
};
struct EpiDown {
    bf16_t* y; int* ltok; float* lgate; const int* lst; int nvalid; const float* tgate;
    DI void prefetch(int, int, int tid) {
        if (tid < 128) { const int tk2 = tid < nvalid ? lst[tid] : -1; ltok[tid] = tk2; lgate[tid] = tk2 < 0 ? 0.f : tgate[tk2]; }
    }
    DI void operator()(const float* Cs, int m0, int n0, int tid) const {
        const int c4 = (tid & 31) * 4, r0 = tid >> 5;
#pragma unroll 4
        for (int ps = 0; ps < 16; ++ps) {
            const int row = ps * 8 + r0, tk2 = ltok[row];
            if (tk2 >= 0) {
                const float gt = lgate[row];
                float4 v = cs4(Cs, row, c4); v.x *= gt; v.y *= gt; v.z *= gt; v.w *= gt;
                *(uint2*)(y + (size_t)tk2 * 1024 + n0 + c4) = pack4(v);
            }
        }
    }
};
template <int WHICH>
DI void phase_moe(const P& p, int bid, int nb, unsigned char* smem) {
    unsigned char* ws = p.ws;
    const unsigned* cnt = (const unsigned*)(ws + CTL + CTL_CNT); const int* lists = (const int*)(ws + LISTS); const float* tgate = (const float*)(ws + TOK_GATE);
    int* offs = (int*)(smem + GEMM_LDS); int* ltok = offs + 64; int* lrow = ltok + 128; float* lgate = (float*)(lrow + 128);
    const int nmt = moe_tiles(cnt, offs);
    constexpr int NNT = WHICH == 0 ? 4 : 8;
    const int v = vbid(bid, nb);
    for (int t = v; t < nmt * NNT; t += nb) {
        const int mt = t / NNT, ntl = t % NNT;
        const int slot0 = mt * 128;
        int e = 0;
        while (offs[e + 1] <= slot0) ++e;
        if (WHICH == 0) {
            __syncthreads();
            if (tidx() < 128) {
                const int pos = slot0 - offs[e] + tidx();
                const int tk2 = pos < (int)cnt[e * CNT_STRIDE] ? lists[(size_t)e * T + pos] : -1;
                lrow[tidx()] = tk2 < 0 ? 0 : (tk2 >> 1);
            }
            __syncthreads();
        }
        if (WHICH == 0) {
            EpiGU ep{(bf16_t*)(ws + HDN)};
            GemmArgs g{(const bf16_t*)(ws + H2B), 1024, (const bf16_t*)(ws + W_GU) + (size_t)e * 512 * 1024, 1024, 1024, lrow};
            gemm_tile(g, slot0, ntl * 128, ep, smem);
        } else {
            EpiDown ep{(bf16_t*)(ws + YB), ltok, lgate, lists + (size_t)e * T + (slot0 - offs[e]), (int)cnt[e * CNT_STRIDE] - (slot0 - offs[e]), tgate};
            GemmArgs g{(const bf16_t*)(ws + HDN), 256, (const bf16_t*)(ws + W_DN) + (size_t)e * 1024 * 256, 256, 256, nullptr};
            gemm_tile(g, slot0, ntl * 128, ep, smem);
        }
    }
}
DI void phase_final(const P& p, int bid, int nb, unsigned char* smem) {
    const int lane = tidx() & 63, wave = tidx() >> 6;
    const bf16_t* hb2 = (const bf16_t*)(p.ws + H2B); const bf16_t* y = (const bf16_t*)(p.ws + YB);
    const float* gam = p.in[29]; const float* bet = p.in[30];
    for (int tk = bid * 4 + wave; tk < T; tk += nb * 8) {
        const int tk2 = tk + nb * 4;
        float va[16], vb[16], mua, rsa, mub, rsb;
#pragma unroll
        for (int i = 0; i < 4; ++i) {
            const uint2 ha = *(const uint2*)(hb2 + (size_t)tk * 1024 + i * 256 + lane * 4), hbv = *(const uint2*)(hb2 + (size_t)tk2 * 1024 + i * 256 + lane * 4);
            const float4 ta = make_float4(bflo(ha.x), bfhi(ha.x), bflo(ha.y), bfhi(ha.y)), tb = make_float4(bflo(hbv.x), bfhi(hbv.x), bflo(hbv.y), bfhi(hbv.y));
            const uint2 a0 = *(const uint2*)(y + (size_t)(tk * 2) * 1024 + i * 256 + lane * 4), a1 = *(const uint2*)(y + (size_t)(tk * 2 + 1) * 1024 + i * 256 + lane * 4);
            const uint2 b0 = *(const uint2*)(y + (size_t)(tk2 * 2) * 1024 + i * 256 + lane * 4), b1 = *(const uint2*)(y + (size_t)(tk2 * 2 + 1) * 1024 + i * 256 + lane * 4);
            va[4 * i] = ALPHA * ta.x + bflo(a0.x) + bflo(a1.x); va[4 * i + 1] = ALPHA * ta.y + bfhi(a0.x) + bfhi(a1.x); va[4 * i + 2] = ALPHA * ta.z + bflo(a0.y) + bflo(a1.y); va[4 * i + 3] = ALPHA * ta.w + bfhi(a0.y) + bfhi(a1.y);
            vb[4 * i] = ALPHA * tb.x + bflo(b0.x) + bflo(b1.x); vb[4 * i + 1] = ALPHA * tb.y + bfhi(b0.x) + bfhi(b1.x); vb[4 * i + 2] = ALPHA * tb.z + bflo(b0.y) + bflo(b1.y); vb[4 * i + 3] = ALPHA * tb.w + bfhi(b0.y) + bfhi(b1.y);
        }
        ln_stats2(va, vb, mua, rsa, mub, rsb);
#pragma unroll
        for (int i = 0; i < 4; ++i) {
            const float4 g4 = *(const float4*)(gam + i * 256 + lane * 4), b4 = *(const float4*)(bet + i * 256 + lane * 4);
            *(float4*)(p.out + (size_t)tk * 1024 + i * 256 + lane * 4) = make_float4((va[4 * i] - mua) * rsa * g4.x + b4.x, (va[4 * i + 1] - mua) * rsa * g4.y + b4.y, (va[4 * i + 2] - mua) * rsa * g4.z + b4.z, (va[4 * i + 3] - mua) * rsa * g4.w + b4.w);
            *(float4*)(p.out + (size_t)tk2 * 1024 + i * 256 + lane * 4) = make_float4((vb[4 * i] - mub) * rsb * g4.x + b4.x, (vb[4 * i + 1] - mub) * rsb * g4.y + b4.y, (vb[4 * i + 2] - mub) * rsb * g4.z + b4.z, (vb[4 * i + 3] - mub) * rsb * g4.w + b4.w);
        }
    }
}

#define XB_TMO      128
#define XB_XCNT(j)  (256  + 64 * (j))
#define XB_XSUB(j)  (1280 + 64 * (j))
#define XB_XGEN(j)  (2304 + 64 * (j))
#define XB_TOP      3328
#define XB_TOPGEN   3392
#define XCD_BAR_WORDS 3456
#define XB_SPIN_CAP (1u << 25)
DI unsigned xb_ld(unsigned* p) { return __hip_atomic_load(p, __ATOMIC_RELAXED, __HIP_MEMORY_SCOPE_AGENT); }
DI unsigned xb_add(unsigned* p, unsigned v) { return __hip_atomic_fetch_add(p, v, __ATOMIC_RELAXED, __HIP_MEMORY_SCOPE_AGENT); }
DI unsigned xb_xcc_id() { return (unsigned)__builtin_amdgcn_s_getreg((3 << 11) | 20) & 0xFu; }
#define XB_SPIN(cond, bar) do { unsigned _sp = 0; while (cond) { __builtin_amdgcn_s_sleep(1); \
    if ((++_sp & 255u) == 0u) { if (xb_ld(&(bar)[XB_TMO])) break; if (_sp > XB_SPIN_CAP) { atomicAdd(&(bar)[XB_TMO], 1u); break; } } } } while (0)
struct XcdBarrier { unsigned* bar; unsigned x; volatile LAS unsigned* st; };
DI XcdBarrier xcd_barrier_post(unsigned* bar, volatile LAS unsigned* st) {
    XcdBarrier b; b.bar = bar; b.x = xb_xcc_id(); b.st = st;
    if (threadIdx.x == 0) (void)xb_add(&bar[XB_XCNT(b.x)], 1u);
    return b;
}
DI void xcd_barrier_complete(unsigned* bar, unsigned x, unsigned& nloc, unsigned& nx) {
    const unsigned G = gridDim.x * gridDim.y * gridDim.z;
    unsigned sum, cnt, mine, sp = 0u;
    for (;;) {
        sum = 0u; cnt = 0u; mine = 0u;
#pragma unroll
        for (unsigned j = 0; j < 16; ++j) { const unsigned c = xb_ld(&bar[XB_XCNT(j)]); sum += c; cnt += (c > 0u) ? 1u : 0u; mine = (j == x) ? c : mine; }
        if (sum == G) break;
        __builtin_amdgcn_s_sleep(1);
        if ((++sp & 255u) == 0u) { if (xb_ld(&bar[XB_TMO])) break; if (sp > XB_SPIN_CAP) { atomicAdd(&bar[XB_TMO], 1u); break; } }
    }
    nloc = mine > 0u ? mine : 1u; nx = cnt > 0u ? cnt : 1u;
}
DI void xcd_barrier(const XcdBarrier& b) {
    asm volatile("s_waitcnt vmcnt(0)" ::: "memory");
    __syncthreads();
    if (threadIdx.x == 0) {
        unsigned* bar = b.bar;
        __builtin_amdgcn_s_waitcnt(0);
        unsigned nloc = b.st[0], nx = b.st[1];
        if (nloc == 0u) { xcd_barrier_complete(bar, b.x, nloc, nx); b.st[0] = nloc; b.st[1] = nx; }
        const unsigned old = xb_add(&bar[XB_XSUB(b.x)], 1u);
        const unsigned gen = old / nloc;
        if (old + 1u == (gen + 1u) * nloc) {
            __builtin_amdgcn_fence(__ATOMIC_RELEASE, "agent");
            asm volatile("s_waitcnt vmcnt(0)" ::: "memory");
            const unsigned og = xb_add(&bar[XB_TOP], 1u);
            const unsigned tg = og / nx;
            if (og + 1u == (tg + 1u) * nx) xb_add(&bar[XB_TOPGEN], 1u);
            else XB_SPIN(xb_ld(&bar[XB_TOPGEN]) == tg, bar);
            __builtin_amdgcn_fence(__ATOMIC_ACQUIRE, "agent");
            xb_add(&bar[XB_XGEN(b.x)], 1u);
            asm volatile("s_waitcnt vmcnt(0)" ::: "memory");
        } else {
            XB_SPIN(xb_ld(&bar[XB_XGEN(b.x)]) == gen, bar);
            __builtin_amdgcn_fence(__ATOMIC_ACQUIRE, "agent");
            asm volatile("s_waitcnt vmcnt(0)" ::: "memory");
        }
    }
    __syncthreads();
}

constexpr int NPHASE = 14;
template <int PH>
DI void run_phase(const P& p, int bid, int nb, unsigned char* smem, int rep = 0) {
    if (PH == 0) phase_prep(p, bid, nb, smem);
    else if (PH == 1) phase_proj(p, bid, nb, smem, rep);
    else if (PH == 2) phase_up(p, bid, nb, smem, rep);
    else if (PH == 3) phase_mixer(p, bid, nb, smem, rep);
    else if (PH == 4) phase_ssdnorm(p, bid, nb, smem);
    else if (PH == 5) phase_wout(p, bid, nb, smem);
    else if (PH == 6) phase_ln1(p, bid, nb, smem);
    else if (PH == 7) phase_xq(p, bid, nb, smem);
    else if (PH == 8) phase_xattn(p, bid, nb, smem, rep);
    else if (PH == 9) phase_xo(p, bid, nb, smem);
    else if (PH == 10) phase_ln2_router(p, bid, nb, smem, rep);
    else if (PH == 11) phase_moe<0>(p, bid, nb, smem);
    else if (PH == 12) phase_moe<1>(p, bid, nb, smem);
    else if (PH == 13) phase_final(p, bid, nb, smem);
}
template <int PH>
__global__ void __launch_bounds__(256, 2) k_phase(P p) {
    __shared__ __attribute__((aligned(16))) unsigned char smem[SMEM_BYTES];
    run_phase<PH>(p, blockIdx.x, gridDim.x, smem);
}

#if MEGA
#ifndef MEGA_WAVES
#define MEGA_WAVES 2
#endif
template <int PH>
DI void mega_steps(const P& p, const XcdBarrier& bar, unsigned char* smem) {
    run_phase<PH>(p, blockIdx.x, gridDim.x, smem);
    if constexpr (((REPEAT_MASK >> PH) & 1) != 0) { xcd_barrier(bar); run_phase<PH>(p, blockIdx.x, gridDim.x, smem, 1); }
    if constexpr (PH == 6 && EXTRA_BARRIERS > 0) { for (int i = 0; i < EXTRA_BARRIERS; ++i) xcd_barrier(bar); }
    if constexpr (PH + 1 < NPHASE) { xcd_barrier(bar); mega_steps<PH + 1>(p, bar, smem); }
}
__global__ void __launch_bounds__(256, MEGA_WAVES) k_mega(P p) {
    __shared__ __attribute__((aligned(16))) unsigned char smem[SMEM_BYTES];
    volatile LAS unsigned* st = (volatile LAS unsigned*)(smem + SMEM_BYTES - 16);
    if (threadIdx.x < 4) st[threadIdx.x] = 0u;
    __syncthreads();
    const XcdBarrier bar = xcd_barrier_post((unsigned*)(p.ws + CTL), st);
    mega_steps<0>(p, bar, smem);
}
#endif
template <int PH>
__global__ void __launch_bounds__(256, 1) k_phase_big(P p) {
    __shared__ __attribute__((aligned(16))) unsigned char smem[SMEM_BYTES];
    run_phase<PH>(p, blockIdx.x, gridDim.x, smem);
}
template <int PH>
static void launch_phase(const P& p, int grid, hipStream_t st) {
    if constexpr (PH == 3 && !P3_SMALL) hipLaunchKernelGGL((k_phase_big<PH>), dim3(grid), dim3(256), 0, st, p);
    else hipLaunchKernelGGL((k_phase<PH>), dim3(grid), dim3(256), 0, st, p);
}

extern "C" void kernel_launch(void* const* d_in, const int* in_sizes, int n_in, void* d_out, int out_size, void* d_ws, size_t ws_size, hipStream_t stream) {
    if (n_in != 31 || out_size != T * D || ws_size < WS_NEED) {
        fprintf(stderr, "kernel_launch: unexpected shapes: n_in %d out %d ws %zu (need %zu)\n", n_in, out_size, ws_size, (size_t)WS_NEED);
        return;
    }
    P p{};
    for (int i = 0; i < 31; ++i) p.in[i] = (const float*)d_in[i];
    p.out = (float*)d_out; p.ws = (unsigned char*)d_ws;
    (void)hipMemsetAsync((unsigned char*)d_ws + CTL, 0, CTL_BYTES, stream);
#if MEGA
    static int grid = 0;
    if (grid == 0) {
        int dev = 0, cus = 0, per_cu = 0;
        (void)hipGetDevice(&dev);
        (void)hipDeviceGetAttribute(&cus, hipDeviceAttributeMultiprocessorCount, dev);
        if (hipOccupancyMaxActiveBlocksPerMultiprocessor(&per_cu, (const void*)k_mega, 256, 0) != hipSuccess || per_cu < 1) { fprintf(stderr, "kernel_launch: occupancy query failed\n"); per_cu = 1; }
        if (per_cu > 2) per_cu = 2;
        grid = cus * per_cu;
        fprintf(stderr, "kernel_launch: mega grid %d (%d CUs x %d)\n", grid, cus, per_cu);
    }
    void* args[] = {(void*)&p};
    const hipError_t le = hipLaunchCooperativeKernel((const void*)k_mega, dim3(grid), dim3(256), args, 0, stream);
    if (le != hipSuccess) fprintf(stderr, "kernel_launch: cooperative launch failed: %s (grid %d)\n", hipGetErrorString(le), grid);
#else
    const int grid = 1024;
    launch_phase<0>(p, grid, stream); launch_phase<1>(p, grid, stream); launch_phase<2>(p, grid, stream); launch_phase<3>(p, grid, stream);
    launch_phase<4>(p, grid, stream); launch_phase<5>(p, grid, stream); launch_phase<6>(p, grid, stream); launch_phase<7>(p, grid, stream);
    launch_phase<8>(p, grid, stream); launch_phase<9>(p, grid, stream); launch_phase<10>(p, grid, stream); launch_phase<11>(p, grid, stream);
    launch_phase<12>(p, grid, stream); launch_phase<13>(p, grid, stream);
#endif
}
```

```cpp
#include <hip/hip_runtime.h>
#include <stdint.h>
#include <stdio.h>

#ifndef MEGA
#define MEGA 1
#endif
#ifndef ATTN_NAIVE
#define ATTN_NAIVE 0
#endif
#ifndef XATTN_NAIVE
#define XATTN_NAIVE 0
#endif
#ifndef SSD_NAIVE
#define SSD_NAIVE 0
#endif
#ifndef P3_SMALL
#define P3_SMALL 1
#endif
#ifndef NO_SSD
#define NO_SSD 0
#endif
#ifndef NO_FLASH
#define NO_FLASH 0
#endif
#ifndef GEMM_GLDS
#define GEMM_GLDS 1
#endif
#ifndef EXTRA_BARRIERS
#define EXTRA_BARRIERS 0
#endif
#ifndef SSD_PM
#define SSD_PM 0
#endif
#ifndef REPEAT_MASK
#define REPEAT_MASK 0
#endif
#ifndef REP_MODE
#define REP_MODE 0
#endif
#ifndef MFMA16
#define MFMA16 1
#endif
#ifndef GEMM_DIRECT
#define GEMM_DIRECT 0
#endif

typedef unsigned short bf16_t;
typedef short bf16x8 __attribute__((ext_vector_type(8)));
typedef float f32x16 __attribute__((ext_vector_type(16)));
typedef float f32x4v __attribute__((ext_vector_type(4)));
#define DI __device__ __forceinline__
#define LAS __attribute__((address_space(3)))
#define MFMA32(a, b, c) __builtin_amdgcn_mfma_f32_32x32x16_bf16((a), (b), (c), 0, 0, 0)

constexpr int Bn = 16, S = 2048, T = Bn * S, D = 1024;
constexpr int NMEM = 256;
constexpr float EPS = 1e-5f;
constexpr float ALPHA = 1.189207115002721f;
constexpr float LOG2E = 1.4426950408889634f;
constexpr float QSCALE = 0.10206207261596577f * LOG2E;
constexpr float XSCALE = 0.0625f * LOG2E;
constexpr int NEXP = 32;
constexpr int MAXSLOTS = 69632;

constexpr size_t MiB = 1u << 20;
constexpr size_t W_IN = 0;
constexpr size_t W_QUP = W_IN + 4 * MiB;
constexpr size_t W_KVUP = W_QUP + 768 * 256 * 2;
constexpr size_t W_OUT = W_KVUP + 1024 * 128 * 2;
constexpr size_t W_XQ = W_OUT + 2 * MiB;
constexpr size_t W_XKV = W_XQ + 2 * MiB;
constexpr size_t W_XO = W_XKV + 4 * MiB;
constexpr size_t W_GU = W_XO + 2 * MiB;
constexpr size_t W_DN = W_GU + 32 * MiB;
constexpr size_t W_RT = W_DN + 16 * MiB;
constexpr size_t ROPE_C = W_RT + 48 * 1024 * 4;
constexpr size_t ROPE_S = ROPE_C + 2048 * 16 * 4;
constexpr size_t TOK_GATE = ROPE_S + 2048 * 16 * 4;
constexpr size_t CTL = TOK_GATE + (size_t)T * 2 * 4;
constexpr size_t CTL_BYTES = 32768;
constexpr size_t CTL_CNT = 16384;
constexpr int CNT_STRIDE = 64;
constexpr size_t CTL_QUEUE = 28672;
constexpr size_t CTL_RTAUX = 30720;
static_assert(CTL + CTL_BYTES <= 64 * MiB, "weights region overflow");
constexpr size_t RA = 64 * MiB, RB = 192 * MiB, RC = 320 * MiB, RD = 448 * MiB, WS_NEED = 512 * MiB;
constexpr size_t XBC = RA;
constexpr size_t KX = RA + 64 * MiB;
constexpr size_t VXT = KX + 8 * MiB;
constexpr size_t YB = RA;
constexpr size_t QB = RB;
constexpr size_t KNB = RB + 48 * MiB;
constexpr size_t VTB = KNB + 32 * MiB;
constexpr size_t H1 = RB;
constexpr size_t H2 = RB;
constexpr size_t XB = RC;
constexpr size_t MEMB = RB;
constexpr size_t XBCA = RC;
constexpr size_t MIX = RC + 64 * MiB;
constexpr size_t H1B = RC;
constexpr size_t QX = RC + 64 * MiB;
constexpr size_t OX = RB;
constexpr size_t H2B = RC;
constexpr size_t HDN = RC + 64 * MiB;
constexpr size_t CQ = RD;
constexpr size_t CKV = CQ + 16 * MiB;
constexpr size_t KROPE = CKV + 8 * MiB;
constexpr size_t DTB = KROPE + 2 * MiB;
constexpr size_t ZB = DTB + 1 * MiB;
constexpr size_t SSQ = ZB + 32 * MiB;
constexpr size_t LISTS = RD;
static_assert(SSQ + 3 * (size_t)T * 4 <= WS_NEED, "region D overflow");

struct P {
    const float* in[31];
    float* out;
    unsigned char* ws;
};

typedef __bf16 hbf16x2 __attribute__((ext_vector_type(2)));
typedef float f32x2 __attribute__((ext_vector_type(2)));
DI bf16_t f2bf(float x) { return __builtin_bit_cast(bf16_t, (__bf16)x); }
DI float bf2f(bf16_t b) { return __uint_as_float(((unsigned)b) << 16); }
DI float bflo(unsigned w) { return __uint_as_float(w << 16); }
DI float bfhi(unsigned w) { return __uint_as_float(w & 0xffff0000u); }
DI unsigned pack2(float a, float b) { f32x2 v = {a, b}; return __builtin_bit_cast(unsigned, __builtin_convertvector(v, hbf16x2)); }
DI float siluf(float x) { return x * __builtin_amdgcn_rcpf(1.f + __expf(-x)); }
DI float softplusf(float x) {
    const float zz = __expf(-fabsf(x));
    const float l1p = zz < 0.01f ? zz * (1.f - zz * (0.5f - zz * (1.f / 3.f))) : __logf(1.f + zz);
    return fmaxf(x, 0.f) + l1p;
}
DI int tidx() { int t = __builtin_amdgcn_workitem_id_x(); asm volatile("" : "+v"(t)); return t; }
DI int crow(int reg, int h) { return (reg & 3) + 8 * (reg >> 2) + 4 * h; }
constexpr int CS_LD = 132;
DI float4 cs4(const float* Cs, int row, int col) { return *(const float4*)(Cs + row * CS_LD + col); }
DI uint2 pack4(float4 v) { uint2 w; w.x = pack2(v.x, v.y); w.y = pack2(v.z, v.w); return w; }
DI float wave_sum(float v) {
#pragma unroll
    for (int o = 32; o >= 1; o >>= 1) v += __shfl_xor(v, o);
    return v;
}
DI float wave_max(float v) {
#pragma unroll
    for (int o = 32; o >= 1; o >>= 1) v = fmaxf(v, __shfl_xor(v, o));
    return v;
}

constexpr int LDS_ROW = 144;
constexpr int TILE_BYTES = 128 * LDS_ROW;
constexpr int GEMM_LDS = 4 * TILE_BYTES;
constexpr int SMEM_BYTES = GEMM_LDS + 3072;
static_assert(128 * CS_LD * 4 <= GEMM_LDS, "epilogue tile");

struct GemmArgs {
    const bf16_t* A; int lda;
    const bf16_t* Bt; int ldb;
    int K;
    const int* lrows;
};

template <class Epi>
DI void gemm_tile(const GemmArgs& g, int m0, int n0, Epi& epi, unsigned char* smem) {
    const int tid = tidx(), lane = tid & 63, wave = tid >> 6, wr = wave >> 1, wc = wave & 1;
    const int r = lane & 31, h = lane >> 5;
    f32x16 acc[2][2];
#pragma unroll
    for (int i = 0; i < 2; ++i)
#pragma unroll
        for (int j = 0; j < 2; ++j)
#pragma unroll
            for (int e = 0; e < 16; ++e) acc[i][j][e] = 0.f;
    const int nk = g.K >> 6;
#if MFMA16
    f32x4v acc16[4][4];
#pragma unroll
    for (int m = 0; m < 4; ++m)
#pragma unroll
        for (int n = 0; n < 4; ++n) acc16[m][n] = (f32x4v){0.f, 0.f, 0.f, 0.f};
#endif
#if GEMM_DIRECT
    {
        const bf16_t* ap[2]; const bf16_t* bp[2];
#pragma unroll
        for (int i = 0; i < 2; ++i) {
            const int lr = wr * 64 + i * 32 + r;
            const int grow = g.lrows ? g.lrows[lr] : (m0 + lr);
            ap[i] = g.A + (size_t)grow * g.lda + 8 * h;
            bp[i] = g.Bt + (size_t)(n0 + wc * 64 + i * 32 + r) * g.ldb + 8 * h;
        }
        for (int k = 0; k < g.K; k += 16) {
            bf16x8 a[2], b[2];
#pragma unroll
            for (int i = 0; i < 2; ++i) { a[i] = *(const bf16x8*)(ap[i] + k); b[i] = *(const bf16x8*)(bp[i] + k); }
#pragma unroll
            for (int i = 0; i < 2; ++i)
#pragma unroll
                for (int j = 0; j < 2; ++j) acc[i][j] = MFMA32(a[i], b[j], acc[i][j]);
        }
    }
#elif GEMM_GLDS
    {
        constexpr int STG = 32768, TB = 16384;
        const int srow = tid >> 3, sch = (tid & 7) ^ ((srow >> 1) & 7);
        const bf16_t* ag[4]; const bf16_t* bg[4];
#pragma unroll
        for (int i = 0; i < 4; ++i) {
            const int lr = srow + 32 * i;
            const int grow = g.lrows ? g.lrows[lr] : (m0 + lr);
            ag[i] = g.A + (size_t)grow * g.lda + sch * 8;
            bg[i] = g.Bt + (size_t)(n0 + lr) * g.ldb + sch * 8;
        }
#define GLDS_STAGE(BUF, KO) do { unsigned char* _d = (BUF) + wave * 1024; \
        _Pragma("unroll") for (int i = 0; i < 4; ++i) { \
            __builtin_amdgcn_global_load_lds((const unsigned*)(ag[i] + (KO)), (LAS unsigned*)(_d + i * 4096), 16, 0, 0); \
            __builtin_amdgcn_global_load_lds((const unsigned*)(bg[i] + (KO)), (LAS unsigned*)(_d + TB + i * 4096), 16, 0, 0); } } while (0)
        __syncthreads();
        GLDS_STAGE(smem, 0);
        epi.prefetch(m0, n0, tid);
        const int y16 = (h ^ ((r >> 1) & 7)) << 4;
        const int o0 = y16, o1 = 32 ^ y16, o2 = 64 ^ y16, o3 = 96 ^ y16;
        const int arow = (wr * 64 + r) * 128, brow = TB + (wc * 64 + r) * 128;
        __syncthreads();
#if MFMA16
        const int i16 = lane & 15, g16 = lane >> 4;
        const int p0 = ((g16 ^ (i16 >> 1)) << 4), p1 = p0 ^ 64;
        const int arow16 = (wr * 64 + i16) * 128, brow16 = TB + (wc * 64 + i16) * 128;
        for (int kt = 0; kt < nk; ++kt) {
            const unsigned char* cur = smem + (kt & 1) * STG;
            if (kt + 1 < nk) GLDS_STAGE(smem + ((kt + 1) & 1) * STG, (kt + 1) * 64);
#pragma unroll
            for (int s = 0; s < 2; ++s) {
                const int po = s ? p1 : p0;
                bf16x8 fa[4], fb[4];
#pragma unroll
                for (int m = 0; m < 4; ++m) { fa[m] = *(const bf16x8*)(cur + arow16 + m * 16 * 128 + po); fb[m] = *(const bf16x8*)(cur + brow16 + m * 16 * 128 + po); }
#pragma unroll
                for (int m = 0; m < 4; ++m)
#pragma unroll
                    for (int n = 0; n < 4; ++n) acc16[m][n] = __builtin_amdgcn_mfma_f32_16x16x32_bf16(fa[m], fb[n], acc16[m][n], 0, 0, 0);
            }
            __syncthreads();
        }
#else
        for (int kt = 0; kt < nk; ++kt) {
            const unsigned char* cur = smem + (kt & 1) * STG;
            if (kt + 1 < nk) GLDS_STAGE(smem + ((kt + 1) & 1) * STG, (kt + 1) * 64);
            bf16x8 fa[4][2], fb[4][2];
#define KLOAD(S, OFF) do { \
                fa[S][0] = *(const bf16x8*)(cur + arow + (OFF)); fa[S][1] = *(const bf16x8*)(cur + arow + 32 * 128 + (OFF)); \
                fb[S][0] = *(const bf16x8*)(cur + brow + (OFF)); fb[S][1] = *(const bf16x8*)(cur + brow + 32 * 128 + (OFF)); } while (0)
            KLOAD(0, o0); KLOAD(1, o1); KLOAD(2, o2); KLOAD(3, o3);
#undef KLOAD
#pragma unroll
            for (int s = 0; s < 4; ++s) {
                acc[0][0] = MFMA32(fa[s][0], fb[s][0], acc[0][0]); acc[0][1] = MFMA32(fa[s][0], fb[s][1], acc[0][1]);
                acc[1][0] = MFMA32(fa[s][1], fb[s][0], acc[1][0]); acc[1][1] = MFMA32(fa[s][1], fb[s][1], acc[1][1]);
            }
            __builtin_amdgcn_sched_group_barrier(0x100, 8, 0); __builtin_amdgcn_sched_group_barrier(0x8, 4, 0);
            __builtin_amdgcn_sched_group_barrier(0x100, 4, 0); __builtin_amdgcn_sched_group_barrier(0x8, 4, 0);
            __builtin_amdgcn_sched_group_barrier(0x100, 4, 0); __builtin_amdgcn_sched_group_barrier(0x8, 8, 0);
#define KSTEP(OFF)
#undef KSTEP
            __syncthreads();
        }
#endif
#undef GLDS_STAGE
    }
#else
    {
        const int srow = tid >> 3, sch = tid & 7;
        const bf16_t* ag[4]; const bf16_t* bg[4];
#pragma unroll
        for (int i = 0; i < 4; ++i) {
            const int lr = srow + 32 * i;
            const int grow = g.lrows ? g.lrows[lr] : (m0 + lr);
            ag[i] = g.A + (size_t)grow * g.lda + sch * 8;
            bg[i] = g.Bt + (size_t)(n0 + lr) * g.ldb + sch * 8;
        }
        const int soff = srow * LDS_ROW + sch * 16;
        uint4 ra0, ra1, ra2, ra3, rb0, rb1, rb2, rb3;
#define G_LOAD(KO) do { ra0 = *(const uint4*)(ag[0] + (KO)); ra1 = *(const uint4*)(ag[1] + (KO)); ra2 = *(const uint4*)(ag[2] + (KO)); ra3 = *(const uint4*)(ag[3] + (KO)); \
                        rb0 = *(const uint4*)(bg[0] + (KO)); rb1 = *(const uint4*)(bg[1] + (KO)); rb2 = *(const uint4*)(bg[2] + (KO)); rb3 = *(const uint4*)(bg[3] + (KO)); } while (0)
#define L_STORE(BUF) do { unsigned char* _d = (BUF) + soff; \
        *(uint4*)(_d) = ra0; *(uint4*)(_d + 32 * LDS_ROW) = ra1; *(uint4*)(_d + 64 * LDS_ROW) = ra2; *(uint4*)(_d + 96 * LDS_ROW) = ra3; \
        *(uint4*)(_d + TILE_BYTES) = rb0; *(uint4*)(_d + TILE_BYTES + 32 * LDS_ROW) = rb1; *(uint4*)(_d + TILE_BYTES + 64 * LDS_ROW) = rb2; *(uint4*)(_d + TILE_BYTES + 96 * LDS_ROW) = rb3; } while (0)
        G_LOAD(0);
        __syncthreads();
        L_STORE(smem);
        __syncthreads();
        const int aoff = (wr * 64 + r) * LDS_ROW + h * 16;
        const int boff = TILE_BYTES + (wc * 64 + r) * LDS_ROW + h * 16;
        for (int kt = 0; kt < nk; ++kt) {
            const unsigned char* cur = smem + (kt & 1) * 2 * TILE_BYTES;
            unsigned char* nxt = smem + ((kt + 1) & 1) * 2 * TILE_BYTES;
            const bool more = (kt + 1 < nk);
            if (more) G_LOAD((kt + 1) * 64);
#pragma unroll
            for (int ks = 0; ks < 4; ++ks) {
                const bf16x8 a0 = *(const bf16x8*)(cur + aoff + ks * 32);
                const bf16x8 a1 = *(const bf16x8*)(cur + aoff + 32 * LDS_ROW + ks * 32);
                const bf16x8 b0 = *(const bf16x8*)(cur + boff + ks * 32);
                const bf16x8 b1 = *(const bf16x8*)(cur + boff + 32 * LDS_ROW + ks * 32);
                acc[0][0] = MFMA32(a0, b0, acc[0][0]); acc[0][1] = MFMA32(a0, b1, acc[0][1]);
                acc[1][0] = MFMA32(a1, b0, acc[1][0]); acc[1][1] = MFMA32(a1, b1, acc[1][1]);
            }
            if (more) L_STORE(nxt);
            __syncthreads();
        }
#undef G_LOAD
#undef L_STORE
    }
#endif
    float* Cs = (float*)smem;
#if GEMM_DIRECT
    __syncthreads();
#endif
#if !MFMA16
#pragma unroll
    for (int i = 0; i < 2; ++i)
#pragma unroll
        for (int j = 0; j < 2; ++j)
#pragma unroll
            for (int e = 0; e < 16; ++e) Cs[(wr * 64 + i * 32 + crow(e, h)) * CS_LD + wc * 64 + j * 32 + r] = acc[i][j][e];
#else
#pragma unroll
    for (int m = 0; m < 4; ++m)
#pragma unroll
        for (int n = 0; n < 4; ++n)
#pragma unroll
            for (int e = 0; e < 4; ++e) Cs[(wr * 64 + m * 16 + 4 * (lane >> 4) + e) * CS_LD + wc * 64 + n * 16 + (lane & 15)] = acc16[m][n][e];
#endif
    __syncthreads();
    epi(Cs, m0, n0, tid);
}

DI int vbid(int bid, int nb) { return (nb % 8 == 0) ? (bid % 8) * (nb / 8) + bid / 8 : bid; }

DI int colmap_in(int n) {
    if (n < 384) return n;
    if (n < 896) return 416 + (n - 384);
    if (n < 1920) return 928 + (n - 896);
    if (n < 1952) return 384 + (n - 1920);
    if (n < 1960) return n;
    return -1;
}
template <int KIND>
DI void tconv_tile(const float* src, const float* src2, int ldsrc, bf16_t* dst, int K, int k0, int n0, const float* scale, int scale_from, unsigned char* smem) {
    float* tile = (float*)smem;
    const int t = tidx();
    __syncthreads();
#pragma unroll 4
    for (int i = 0; i < 16; ++i) {
        const int k = i * 4 + (t >> 6), n = t & 63;
        const int nd = n0 + n;
        float v = 0.f;
        if (KIND == 1) { const int c = colmap_in(nd); if (c >= 0) v = src[(size_t)(k0 + k) * ldsrc + c]; }
        else if (KIND == 2) {
            const int j = nd >> 7, wc = (nd >> 6) & 1, isup = (nd >> 5) & 1, ii = nd & 31;
            const int c = 64 * j + 32 * wc + ii;
            v = (isup ? src2 : src)[(size_t)(k0 + k) * ldsrc + c];
        } else v = src[(size_t)(k0 + k) * ldsrc + nd];
        if (scale && (k0 + k) >= scale_from) v *= scale[k0 + k - scale_from];
        tile[k * 65 + n] = v;
    }
    __syncthreads();
#pragma unroll 4
    for (int i = 0; i < 16; ++i) {
        const int n = i * 4 + (t >> 6), k = t & 63;
        dst[(size_t)(n0 + n) * K + k0 + k] = f2bf(tile[k * 65 + n]);
    }
}

constexpr int PJ0 = 512, PJ1 = PJ0 + 48, PJ2 = PJ1 + 32, PJ3 = PJ2 + 256, PJ4 = PJ3 + 256, PJ5 = PJ4 + 256, PJ6 = PJ5 + 256, PJ7 = PJ6 + 256, PJ8 = PJ7 + 4096, PJ9 = PJ8 + 2048;
DI void prep_tile(const P& p, int t, unsigned char* smem) {
    unsigned char* ws = p.ws;
    if (t < PJ0) { const int kt = t >> 5, ntl = t & 31; tconv_tile<1>(p.in[2], nullptr, 1960, (bf16_t*)(ws + W_IN), 1024, kt * 64, ntl * 64, nullptr, 0, smem); }
    else if (t < PJ1) { const int u = t - PJ0, kt = u / 12, ntl = u % 12; tconv_tile<0>(p.in[4], nullptr, 768, (bf16_t*)(ws + W_QUP), 256, kt * 64, ntl * 64, p.in[3], 0, smem); }
    else if (t < PJ2) { const int u = t - PJ1, kt = u >> 4, ntl = u & 15; tconv_tile<0>(p.in[6], nullptr, 1024, (bf16_t*)(ws + W_KVUP), 128, kt * 64, ntl * 64, p.in[5], 0, smem); }
    else if (t < PJ3) { const int u = t - PJ2, kt = u >> 4, ntl = u & 15; tconv_tile<0>(p.in[13], nullptr, 1024, (bf16_t*)(ws + W_OUT), 1024, kt * 64, ntl * 64, p.in[12], 512, smem); }
    else if (t < PJ4) { const int u = t - PJ3, kt = u >> 4, ntl = u & 15; tconv_tile<0>(p.in[16], nullptr, 1024, (bf16_t*)(ws + W_XQ), 1024, kt * 64, ntl * 64, nullptr, 0, smem); }
    else if (t < PJ5) { const int u = t - PJ4, kt = u >> 4, ntl = u & 15; tconv_tile<0>(p.in[17], nullptr, 1024, (bf16_t*)(ws + W_XKV), 1024, kt * 64, ntl * 64, nullptr, 0, smem); }
    else if (t < PJ6) { const int u = t - PJ5, kt = u >> 4, ntl = u & 15; tconv_tile<0>(p.in[18], nullptr, 1024, (bf16_t*)(ws + W_XKV) + (size_t)1024 * 1024, 1024, kt * 64, ntl * 64, nullptr, 0, smem); }
    else if (t < PJ7) { const int u = t - PJ6, kt = u >> 4, ntl = u & 15; tconv_tile<0>(p.in[19], nullptr, 1024, (bf16_t*)(ws + W_XO), 1024, kt * 64, ntl * 64, nullptr, 0, smem); }
    else if (t < PJ8) { const int u = t - PJ7, e = u >> 7, v = u & 127, kt = v >> 3, ntl = v & 7;
        tconv_tile<2>(p.in[26] + (size_t)e * 1024 * 256, p.in[27] + (size_t)e * 1024 * 256, 256, (bf16_t*)(ws + W_GU) + (size_t)e * 512 * 1024, 1024, kt * 64, ntl * 64, nullptr, 0, smem); }
    else { const int u = t - PJ8, e = u >> 6, v = u & 63, kt = v >> 4, ntl = v & 15;
        tconv_tile<0>(p.in[28] + (size_t)e * 256 * 1024, nullptr, 1024, (bf16_t*)(ws + W_DN) + (size_t)e * 1024 * 256, 256, kt * 64, ntl * 64, nullptr, 0, smem); }
}
constexpr int LATE_A0 = PJ2, LATE_A1 = PJ4, LATE_B0 = PJ6, LATE_B1 = PJ9, N_LATE = (LATE_A1 - LATE_A0) + (LATE_B1 - LATE_B0), LATE_GROUP = 4, N_LATE_ITEMS = (N_LATE + LATE_GROUP - 1) / LATE_GROUP;
DI void phase_prep(const P& p, int bid, int nb, unsigned char* smem) {
    unsigned char* ws = p.ws;
    const int tid = tidx();
    constexpr int N_EARLY = LATE_A0 + (LATE_B0 - LATE_A1);
    for (int u = bid; u < N_EARLY; u += nb) prep_tile(p, u < LATE_A0 ? u : u - LATE_A0 + LATE_A1, smem);
    {
        const size_t gsz = (size_t)nb * 256, g0 = (size_t)bid * 256 + tid;
        bf16_t* xb = (bf16_t*)p.out;
        const float4* x4 = (const float4*)p.in[0];
        for (size_t i = g0; i < (size_t)T * D / 4; i += gsz) { const float4 v = x4[i]; uint2 o; o.x = pack2(v.x, v.y); o.y = pack2(v.z, v.w); ((uint2*)xb)[i] = o; }
        bf16_t* mb = (bf16_t*)(ws + MEMB);
        const float4* m4 = (const float4*)p.in[1];
        for (size_t i = g0; i < (size_t)Bn * NMEM * D / 4; i += gsz) { const float4 v = m4[i]; uint2 o; o.x = pack2(v.x, v.y); o.y = pack2(v.z, v.w); ((uint2*)mb)[i] = o; }
        float* wrt = (float*)(ws + W_RT);
        for (size_t i = g0; i < 48 * 1024; i += gsz) {
            const int j = (int)(i >> 10), k = (int)(i & 1023);
            float v = 0.f;
            if (j < 4) v = p.in[22][k * 4 + j]; else if (j < 36) v = p.in[24][k * 32 + (j - 4)];
            v *= p.in[20][k];
            const bf16_t hi = f2bf(v), lo = f2bf(v - bf2f(hi));
            ((bf16_t*)wrt)[i] = hi; ((bf16_t*)wrt)[48 * 1024 + i] = lo;
        }
        {
            float* aux = (float*)(ws + CTL + CTL_RTAUX);
            const int lane = tid & 63, wave = tid >> 6;
            for (int j = bid * 4 + wave; j < 48; j += nb * 4) {
                float sw = 0.f, cbv = 0.f;
                for (int k = lane; k < 1024; k += 64) {
                    float w = 0.f;
                    if (j < 4) w = p.in[22][k * 4 + j]; else if (j < 36) w = p.in[24][k * 32 + (j - 4)];
                    sw += w * p.in[20][k]; cbv += w * p.in[21][k];
                }
                sw = wave_sum(sw); cbv = wave_sum(cbv);
                if (lane == 0) { aux[j] = sw; aux[48 + j] = cbv + (j < 4 ? p.in[23][j] : j < 36 ? p.in[25][j - 4] : 0.f); }
            }
        }
        float* rc = (float*)(ws + ROPE_C); float* rs = (float*)(ws + ROPE_S);
        for (size_t i = g0; i < 2048 * 16; i += gsz) {
            const int pos = (int)(i >> 4), f = (int)(i & 15);
            const float inv = powf(10000.f, -(float)f / 16.f);
            const float ang = (float)pos * inv;
            const double a = (double)ang;
            const double k2 = rint(a * 0.15915494309189535);
            const float rr = (float)(a - k2 * 6.283185307179586);
            rc[i] = cosf(rr); rs[i] = sinf(rr);
        }
    }
}

struct EpiProj {
    bf16_t *cq, *ckv, *z, *xbc, *krope; float* dt; const float *rc, *rs, *dtb; float* ssq;
    DI void prefetch(int, int, int) {}
    DI void operator()(const float* Cs, int m0, int n0, int tid) const {
        const int c4 = (tid & 31) * 4, r0 = tid >> 5;
        if (n0 < 1920) {
            bf16_t* dst; int ld, cofs;
            if (n0 < 256) { dst = cq; ld = 256; cofs = n0; } else if (n0 < 384) { dst = ckv; ld = 128; cofs = n0 - 256; }
            else if (n0 < 896) { dst = z; ld = 512; cofs = n0 - 384; } else { dst = xbc; ld = 1024; cofs = n0 - 896; }
            if (n0 < 384) {
                float* sq = ssq + (size_t)(n0 >> 7) * T + m0;
#pragma unroll 4
                for (int ps = 0; ps < 16; ++ps) {
                    const int row = ps * 8 + r0; const float4 v = cs4(Cs, row, c4);
                    *(uint2*)(dst + (size_t)(m0 + row) * ld + cofs + c4) = pack4(v);
                    float ss = (v.x * v.x + v.y * v.y) + (v.z * v.z + v.w * v.w);
#pragma unroll
                    for (int o = 16; o >= 1; o >>= 1) ss += __shfl_xor(ss, o);
                    if ((tid & 31) == 0) sq[row] = ss;
                }
            } else {
#pragma unroll 4
            for (int ps = 0; ps < 16; ++ps) { const int row = ps * 8 + r0; *(uint2*)(dst + (size_t)(m0 + row) * ld + cofs + c4) = pack4(cs4(Cs, row, c4)); }
            }
        } else {
#pragma unroll
            for (int ps = 0; ps < 4; ++ps) {
                const int it = ps * 256 + tid, row = it >> 3, cc = (it & 7) * 4, grow = m0 + row;
                const float4 v = cs4(Cs, row, cc), pv = cs4(Cs, row, cc ^ 16);
                const int pos = grow & 2047, f = cc & 15;
                const float4 c = *(const float4*)(rc + pos * 16 + f), s = *(const float4*)(rs + pos * 16 + f);
                float4 o;
                if (cc < 16) { o.x = v.x * c.x - pv.x * s.x; o.y = v.y * c.y - pv.y * s.y; o.z = v.z * c.z - pv.z * s.z; o.w = v.w * c.w - pv.w * s.w; }
                else { o.x = v.x * c.x + pv.x * s.x; o.y = v.y * c.y + pv.y * s.y; o.z = v.z * c.z + pv.z * s.z; o.w = v.w * c.w + pv.w * s.w; }
                *(uint2*)(krope + (size_t)grow * 32 + cc) = pack4(o);
            }
#pragma unroll
            for (int ps = 0; ps < 4; ++ps) {
                const int it = ps * 256 + tid, row = it >> 3, cc = it & 7;
                dt[(size_t)(m0 + row) * 8 + cc] = softplusf(Cs[row * CS_LD + 32 + cc] + dtb[cc]);
            }
        }
    }
};
struct EpiMemKV {
    bf16_t *kx, *vxt;
    DI void prefetch(int, int, int) {}
    DI void operator()(const float* Cs, int m0, int n0, int tid) const {
        const int b = m0 >> 8, mm0 = m0 & 255;
        if (n0 < 1024) {
            const int c4 = (tid & 31) * 4, r0 = tid >> 5, hd = n0 >> 8, d = (n0 & 255) + c4;
#pragma unroll 4
            for (int ps = 0; ps < 16; ++ps) { const int row = ps * 8 + r0; *(uint2*)(kx + ((size_t)(b * 4 + hd) * 256 + mm0 + row) * 256 + d) = pack4(cs4(Cs, row, c4)); }
        } else {
            const int c2 = n0 - 1024, hd = c2 >> 8;
#pragma unroll 2
            for (int ps = 0; ps < 8; ++ps) {
                const int it = ps * 256 + tid, col = it & 127, rg = it >> 7, d = (c2 & 255) + col;
                uint4 w;
                w.x = pack2(Cs[(rg * 8 + 0) * CS_LD + col], Cs[(rg * 8 + 1) * CS_LD + col]); w.y = pack2(Cs[(rg * 8 + 2) * CS_LD + col], Cs[(rg * 8 + 3) * CS_LD + col]);
                w.z = pack2(Cs[(rg * 8 + 4) * CS_LD + col], Cs[(rg * 8 + 5) * CS_LD + col]); w.w = pack2(Cs[(rg * 8 + 6) * CS_LD + col], Cs[(rg * 8 + 7) * CS_LD + col]);
                *(uint4*)(vxt + ((size_t)(b * 4 + hd) * 256 + d) * 256 + mm0 + rg * 8) = w;
            }
        }
    }
};
DI void phase_proj(const P& p, int bid, int nb, unsigned char* smem, int rep = 0) {
    unsigned char* ws = p.ws;
    const int v = vbid(bid, nb);
    const bf16_t* xb = (const bf16_t*)p.out;
    EpiProj e1{(bf16_t*)(ws + CQ), (bf16_t*)(ws + CKV), (bf16_t*)(ws + ZB), (bf16_t*)(ws + XBC), (bf16_t*)(ws + KROPE), (float*)(ws + DTB),
               (const float*)(ws + ROPE_C), (const float*)(ws + ROPE_S), p.in[9], (float*)(ws + SSQ)};
    EpiMemKV e2{(bf16_t*)(ws + KX), (bf16_t*)(ws + VXT)};
    constexpr int NT1 = 256 * 16, NT2 = 32 * 16;
    for (int t = v; t < NT1 + NT2; t += nb) {
        if (rep && REP_MODE == 1 && t >= NT1) continue;
        if (rep && REP_MODE == 2 && t < NT1) continue;
        if (rep && REP_MODE == 3 && !(t < NT1 && (t & 7) == 7 && ((t >> 6) & 1))) continue;
        if (rep && REP_MODE == 4 && !(t < NT1 && ((t >> 6) & 1) == 0)) continue;
        const int u = t < NT1 ? t : t - NT1, c = u >> 6, j = u & 63, mt = (c >> 1) * 8 + (j >> 3), ntl = (c & 1) * 8 + (j & 7);
        if (t < NT1) { GemmArgs g{xb, 1024, (const bf16_t*)(ws + W_IN), 1024, 1024, nullptr}; gemm_tile(g, mt * 128, ntl * 128, e1, smem); }
        else { GemmArgs g{(const bf16_t*)(ws + MEMB), 1024, (const bf16_t*)(ws + W_XKV), 1024, 1024, nullptr}; gemm_tile(g, mt * 128, ntl * 128, e2, smem); }
    }
}

struct EpiQup {
    bf16_t* q; const float* ssq; float* rms;
    DI void prefetch(int m0, int, int tid) { if (tid < 128) rms[tid] = rsqrtf((ssq[m0 + tid] + ssq[(size_t)T + m0 + tid]) * (1.f / 256.f) + EPS); }
    DI void operator()(const float* Cs, int m0, int n0, int tid) const {
        const int c4 = (tid & 31) * 4, r0 = tid >> 5;
        const int col = n0 + c4, head = col / 96, d = col - head * 96;
        const int b = m0 >> 11, s0 = m0 & 2047;
#pragma unroll 4
        for (int ps = 0; ps < 16; ++ps) {
            const int row = ps * 8 + r0;
            const float sc = rms[row] * QSCALE;
            float4 v = cs4(Cs, row, c4);
            v.x *= sc; v.y *= sc; v.z *= sc; v.w *= sc;
            *(uint2*)(q + ((size_t)(b * 8 + head) * 2048 + s0 + row) * 96 + d) = pack4(v);
        }
    }
};
struct EpiKVup {
    bf16_t *kn, *vt; const float* ssq; float* rms;
    DI void prefetch(int m0, int, int tid) { if (tid < 128) rms[tid] = rsqrtf(ssq[2 * (size_t)T + m0 + tid] * (1.f / 128.f) + EPS); }
    DI void operator()(const float* Cs, int m0, int n0, int tid) const {
        const int head = n0 >> 7, b = m0 >> 11, s0 = m0 & 2047;
#pragma unroll 4
        for (int ps = 0; ps < 8; ++ps) {
            const int it = ps * 256 + tid, row = it >> 4, c4 = (it & 15) * 4;
            const float sc = rms[row];
            float4 v = cs4(Cs, row, c4); v.x *= sc; v.y *= sc; v.z *= sc; v.w *= sc;
            *(uint2*)(kn + ((size_t)(b * 8 + head) * 2048 + s0 + row) * 64 + c4) = pack4(v);
        }
#pragma unroll 2
        for (int ps = 0; ps < 4; ++ps) {
            const int it = ps * 256 + tid, dv = it & 63, rg = it >> 6;
            const float* cp = Cs + (rg * 8) * CS_LD + 64 + dv; const float* rp = rms + rg * 8;
            uint4 w;
            w.x = pack2(cp[0] * rp[0], cp[CS_LD] * rp[1]); w.y = pack2(cp[2 * CS_LD] * rp[2], cp[3 * CS_LD] * rp[3]);
            w.z = pack2(cp[4 * CS_LD] * rp[4], cp[5 * CS_LD] * rp[5]); w.w = pack2(cp[6 * CS_LD] * rp[6], cp[7 * CS_LD] * rp[7]);
            *(uint4*)(vt + ((size_t)(b * 8 + head) * 64 + dv) * 2048 + s0 + rg * 8) = w;
        }
    }
};
DI void phase_up(const P& p, int bid, int nb, unsigned char* smem, int rep = 0) {
    unsigned char* ws = p.ws;
    const int v = vbid(bid, nb);
    float* rms = (float*)(smem + GEMM_LDS);
    constexpr int NTQ = 256 * 6, NTKV = 256 * 8;
    for (int t = v; t < NTQ + NTKV; t += nb) {
        if (rep && REP_MODE == 1) break;
        if (rep && REP_MODE == 2 && t >= NTQ) break;
        if (rep && REP_MODE == 3 && t < NTQ) continue;
        if (t < NTQ) {
            const int mt = t / 6, ntl = t % 6;
            EpiQup e{(bf16_t*)(ws + QB), (const float*)(ws + SSQ), rms};
            GemmArgs g{(const bf16_t*)(ws + CQ), 256, (const bf16_t*)(ws + W_QUP), 256, 256, nullptr};
            gemm_tile(g, mt * 128, ntl * 128, e, smem);
        } else {
            const int u = t - NTQ, mt = u >> 3, ntl = u & 7;
            EpiKVup e{(bf16_t*)(ws + KNB), (bf16_t*)(ws + VTB), (const float*)(ws + SSQ), rms};
            GemmArgs g{(const bf16_t*)(ws + CKV), 128, (const bf16_t*)(ws + W_KVUP), 128, 128, nullptr};
            gemm_tile(g, mt * 128, ntl * 128, e, smem);
        }
    }
    if (!(rep && REP_MODE >= 2)) {
        const bf16_t* xbc = (const bf16_t*)(ws + XBC); bf16_t* xa = (bf16_t*)(ws + XBCA);
        const float* cw = p.in[7]; const float* cb = p.in[8];
        const size_t gsz = (size_t)nb * 256;
        for (size_t i = (size_t)bid * 256 + tidx(); i < (size_t)(T / 4) * 128; i += gsz) {
            const int tk0 = (int)(i >> 7) * 4, c0 = (int)(i & 127) * 8, s0 = tk0 & 2047;
            float w[4][8], bias[8];
#pragma unroll
            for (int j = 0; j < 4; ++j) { const float4 w0 = *(const float4*)(cw + j * 1024 + c0), w1 = *(const float4*)(cw + j * 1024 + c0 + 4);
                w[j][0] = w0.x; w[j][1] = w0.y; w[j][2] = w0.z; w[j][3] = w0.w; w[j][4] = w1.x; w[j][5] = w1.y; w[j][6] = w1.z; w[j][7] = w1.w; }
            { const float4 b0 = *(const float4*)(cb + c0), b1 = *(const float4*)(cb + c0 + 4); bias[0] = b0.x; bias[1] = b0.y; bias[2] = b0.z; bias[3] = b0.w; bias[4] = b1.x; bias[5] = b1.y; bias[6] = b1.z; bias[7] = b1.w; }
            float xin[7][8];
#pragma unroll
            for (int rr = 0; rr < 7; ++rr) {
                uint4 wv = make_uint4(0u, 0u, 0u, 0u);
                if (s0 + rr - 3 >= 0) wv = *(const uint4*)(xbc + (size_t)(tk0 + rr - 3) * 1024 + c0);
                xin[rr][0] = bflo(wv.x); xin[rr][1] = bfhi(wv.x); xin[rr][2] = bflo(wv.y); xin[rr][3] = bfhi(wv.y); xin[rr][4] = bflo(wv.z); xin[rr][5] = bfhi(wv.z); xin[rr][6] = bflo(wv.w); xin[rr][7] = bfhi(wv.w);
            }
#pragma unroll
            for (int o = 0; o < 4; ++o) {
                float accv[8];
#pragma unroll
                for (int k = 0; k < 8; ++k) accv[k] = bias[k] + w[0][k] * xin[o][k] + w[1][k] * xin[o + 1][k] + w[2][k] * xin[o + 2][k] + w[3][k] * xin[o + 3][k];
                uint4 ov;
                ov.x = pack2(siluf(accv[0]), siluf(accv[1])); ov.y = pack2(siluf(accv[2]), siluf(accv[3]));
                ov.z = pack2(siluf(accv[4]), siluf(accv[5])); ov.w = pack2(siluf(accv[6]), siluf(accv[7]));
                *(uint4*)(xa + (size_t)(tk0 + o) * 1024 + c0) = ov;
            }
        }
    }
}

DI int perm16(int k) { return (k & ~12) | ((k & 4) << 1) | ((k & 8) >> 1); }
template <int DQK, int DVW, int KT, int NQG, int NDV>
struct FlashCfg {
    static constexpr int KSTR = (DQK + 8) * 2;
    static constexpr int VSTR = (KT + 8) * 2;
    static constexpr int DV = DVW * NDV;
    static constexpr int KBYTES = KT * KSTR, VBYTES = DV * VSTR, STAGE = KBYTES + VBYTES;
    static constexpr int KCH = KT * DQK / 8 / 256;
    static constexpr int VCH = DV * KT / 8 / 256;
    static_assert(KT * DQK / 8 % 256 == 0 && DV * KT / 8 % 256 == 0, "chunk split");
    static_assert(2 * STAGE <= SMEM_BYTES - 32, "flash LDS");
};
template <int DQK, int DVW, int KT, int NQG, int NDV, class Src>
DI void flash_item(const Src& src, int ntiles, int nskip  , unsigned char* smem, bool noload = false) {
    typedef FlashCfg<DQK, DVW, KT, NQG, NDV> C;
    constexpr int NKS = DQK / 16, NKB = KT / 32, NDB = DVW / 32;
    int tid = tidx(); asm volatile("" : "+v"(tid));
    const int lane = tid & 63, wave = __builtin_amdgcn_readfirstlane(tid >> 6), r = lane & 31, h = lane >> 5;
    const int qg = wave / NDV, dvh = wave % NDV;
    bf16x8 qf[NKS];
    {
        const bf16_t* qp = src.qrow(qg * 32 + r) + 8 * h;
#pragma unroll
        for (int ks = 0; ks < NKS; ++ks) qf[ks] = *(const bf16x8*)(qp + 16 * ks);
        if (Src::ROPE) {
            const float* cp = src.rope_c(qg * 32 + r) + 8 * h; const float* sp = src.rope_s(qg * 32 + r) + 8 * h;
            const float4 c0 = *(const float4*)cp, c1 = *(const float4*)(cp + 4), s0 = *(const float4*)sp, s1 = *(const float4*)(sp + 4);
            const float cc[8] = {c0.x, c0.y, c0.z, c0.w, c1.x, c1.y, c1.z, c1.w}, ss[8] = {s0.x, s0.y, s0.z, s0.w, s1.x, s1.y, s1.z, s1.w};
            bf16x8 x1 = qf[NKS - 2], x2 = qf[NKS - 1];
#pragma unroll
            for (int j = 0; j < 8; ++j) {
                const float a = bf2f((bf16_t)x1[j]), b2 = bf2f((bf16_t)x2[j]);
                x1[j] = (short)f2bf(a * cc[j] - b2 * ss[j]); x2[j] = (short)f2bf(b2 * cc[j] + a * ss[j]);
            }
            qf[NKS - 2] = x1; qf[NKS - 1] = x2;
        }
    }
    f32x16 o[NDB];
#pragma unroll
    for (int d = 0; d < NDB; ++d)
#pragma unroll
        for (int e = 0; e < 16; ++e) o[d][e] = 0.f;
    float m = -1e30f, l = 0.f;
    uint4 kr[C::KCH], vr[C::VCH];
    auto gload = [&](int t) {
#pragma unroll
        for (int i = 0; i < C::KCH; ++i) { const int idx = tid + 256 * i; kr[i] = src.kload(t, idx / (DQK / 8), idx % (DQK / 8)); }
#pragma unroll
        for (int i = 0; i < C::VCH; ++i) { const int idx = tid + 256 * i; vr[i] = src.vload(t, idx / (KT / 8), idx % (KT / 8)); }
    };
    auto lstore = [&](unsigned char* buf) {
#pragma unroll
        for (int i = 0; i < C::KCH; ++i) { const int idx = tid + 256 * i; *(uint4*)(buf + (idx / (DQK / 8)) * C::KSTR + (idx % (DQK / 8)) * 16) = kr[i]; }
#pragma unroll
        for (int i = 0; i < C::VCH; ++i) {
            const int idx = tid + 256 * i, dv = idx / (KT / 8), c = idx % (KT / 8);
            unsigned char* row = buf + C::KBYTES + dv * C::VSTR + (c >> 1) * 32;
            const int a = c & 1;
            *(uint2*)(row + (4 * a) * 2) = make_uint2(vr[i].x, vr[i].y);
            *(uint2*)(row + (8 + 4 * a) * 2) = make_uint2(vr[i].z, vr[i].w);
        }
    };
    gload(0);
    __syncthreads();
    lstore(smem);
    __syncthreads();
    for (int t = 0; t < ntiles; ++t) {
        const unsigned char* cur = smem + (t & 1) * C::STAGE;
        const bool more = (t + 1 < ntiles);
        if (more && !noload) gload(t + 1);
        if (!(t == ntiles - 1 && qg < nskip)) {
            f32x16 s[NKB];
#pragma unroll
            for (int kb = 0; kb < NKB; ++kb) {
                const unsigned char* kp = cur + (kb * 32 + r) * C::KSTR + h * 16;
                if (NKB == 1) {
                    constexpr int NCH = 2;
                    f32x16 sp[NCH];
#pragma unroll
                    for (int c = 0; c < NCH; ++c)
#pragma unroll
                        for (int e = 0; e < 16; ++e) sp[c][e] = 0.f;
#pragma unroll
                    for (int ks = 0; ks < NKS; ++ks) sp[ks % NCH] = MFMA32(*(const bf16x8*)(kp + ks * 32), qf[ks], sp[ks % NCH]);
#pragma unroll
                    for (int e = 0; e < 16; ++e) s[kb][e] = sp[0][e] + sp[1][e];
                } else {
#pragma unroll
                    for (int e = 0; e < 16; ++e) s[kb][e] = 0.f;
#pragma unroll
                    for (int ks = 0; ks < NKS; ++ks) s[kb] = MFMA32(*(const bf16x8*)(kp + ks * 32), qf[ks], s[kb]);
                }
            }
            float mx = s[0][0];
#pragma unroll
            for (int kb = 0; kb < NKB; ++kb)
#pragma unroll
                for (int e = 0; e < 16; ++e) mx = fmaxf(mx, s[kb][e]);
            mx = fmaxf(mx, __shfl_xor(mx, 32));
            if (!__all(mx <= m + 8.f)) {
                const float mn = fmaxf(m, mx);
                const float alpha = __builtin_amdgcn_exp2f(m - mn);
                m = mn;
                l *= alpha;
#pragma unroll
                for (int d = 0; d < NDB; ++d)
#pragma unroll
                    for (int e = 0; e < 16; ++e) o[d][e] *= alpha;
            }
            float ps = 0.f;
#pragma unroll
            for (int kb = 0; kb < NKB; ++kb)
#pragma unroll
                for (int e = 0; e < 16; ++e) { const float pv = __builtin_amdgcn_exp2f(s[kb][e] - m); s[kb][e] = pv; ps += pv; }
            l += ps;
#pragma unroll
            for (int kb = 0; kb < NKB; ++kb)
#pragma unroll
                for (int s2 = 0; s2 < 2; ++s2) {
                    uint4 pk;
                    pk.x = pack2(s[kb][8 * s2], s[kb][8 * s2 + 1]); pk.y = pack2(s[kb][8 * s2 + 2], s[kb][8 * s2 + 3]);
                    pk.z = pack2(s[kb][8 * s2 + 4], s[kb][8 * s2 + 5]); pk.w = pack2(s[kb][8 * s2 + 6], s[kb][8 * s2 + 7]);
                    const bf16x8 pf = __builtin_bit_cast(bf16x8, pk);
                    const unsigned char* vp = cur + C::KBYTES + (dvh * DVW + r) * C::VSTR + (kb * 32 + s2 * 16 + 8 * h) * 2;
#pragma unroll
                    for (int d = 0; d < NDB; ++d) o[d] = MFMA32(*(const bf16x8*)(vp + d * 32 * C::VSTR), pf, o[d]);
                }
        }
        if (more) lstore(smem + ((t + 1) & 1) * C::STAGE);
        __syncthreads();
    }
    l += __shfl_xor(l, 32);
    const float il = 1.f / l;
#pragma unroll
    for (int d = 0; d < NDB; ++d)
#pragma unroll
        for (int g4 = 0; g4 < 4; ++g4) {
            uint2 w; w.x = pack2(o[d][4 * g4] * il, o[d][4 * g4 + 1] * il); w.y = pack2(o[d][4 * g4 + 2] * il, o[d][4 * g4 + 3] * il);
            src.store(qg * 32 + r, dvh * DVW + d * 32 + 8 * g4 + 4 * h, w);
        }
}
struct SelfSrc {
    static constexpr bool ROPE = true;
    const bf16_t *q, *kn, *kr, *vt; bf16_t* mix; int b, hd, bh, q0; const float *rc, *rs;
    DI const float* rope_c(int rr) const { return rc + (q0 + rr) * 16; }
    DI const float* rope_s(int rr) const { return rs + (q0 + rr) * 16; }
    DI const bf16_t* qrow(int rr) const { return q + ((size_t)bh * 2048 + q0 + rr) * 96; }
    DI uint4 kload(int t, int key, int c) const {
        const int kg = t * 64 + key;
        return c < 8 ? *(const uint4*)(kn + ((size_t)bh * 2048 + kg) * 64 + c * 8) : *(const uint4*)(kr + ((size_t)b * 2048 + kg) * 32 + (c - 8) * 8);
    }
    DI uint4 vload(int t, int dv, int c) const { return *(const uint4*)(vt + ((size_t)bh * 64 + dv) * 2048 + t * 64 + c * 8); }
    DI void store(int rr, int dv, uint2 w) const { *(uint2*)(mix + ((size_t)b * 2048 + q0 + rr) * 1024 + hd * 64 + dv) = w; }
};
struct CrossSrc {
    static constexpr bool ROPE = false;
    const bf16_t *qx, *kx, *vxt; bf16_t* ox; int b, hd, q0;
    DI const float* rope_c(int) const { return nullptr; }
    DI const float* rope_s(int) const { return nullptr; }
    DI const bf16_t* qrow(int rr) const { return qx + ((size_t)(b * 4 + hd) * 2048 + q0 + rr) * 256; }
    DI uint4 kload(int t, int key, int c) const { return *(const uint4*)(kx + ((size_t)(b * 4 + hd) * 256 + t * 32 + key) * 256 + c * 8); }
    DI uint4 vload(int t, int dv, int c) const { return *(const uint4*)(vxt + ((size_t)(b * 4 + hd) * 256 + dv) * 256 + t * 32 + c * 8); }
    DI void store(int rr, int dv, uint2 w) const { *(uint2*)(ox + ((size_t)b * 2048 + q0 + rr) * 1024 + hd * 256 + dv) = w; }
};
DI void attn_fast(const P& p, int bid, int nb, unsigned char* smem) {
    unsigned char* ws = p.ws;
    const int nround = (2048 + nb - 1) / nb;
    for (int rd = 0; rd < nround; ++rd) {
        const int idx = rd * nb + ((rd & 1) ? (nb - 1 - bid) : bid);
        if (idx >= 2048) continue;
        const int qb = 15 - (idx >> 7), bh = idx & 127;
        SelfSrc s{(const bf16_t*)(ws + QB), (const bf16_t*)(ws + KNB), (const bf16_t*)(ws + KROPE), (const bf16_t*)(ws + VTB), (bf16_t*)(ws + MIX), bh >> 3, bh & 7, bh, qb * 128, (const float*)(ws + ROPE_C), (const float*)(ws + ROPE_S)};
        flash_item<96, 64, 64, 4, 1>(s, 2 * qb + 2, 2, smem);
    }
}
DI void xattn_fast(const P& p, int bid, int nb, unsigned char* smem, int rep = 0) {
    unsigned char* ws = p.ws;
    for (int it = bid; it < 2048; it += nb) {
        const int bhd = it >> 5, qt = it & 31;
        CrossSrc s{(const bf16_t*)(ws + QX), (const bf16_t*)(ws + KX), (const bf16_t*)(ws + VXT), (bf16_t*)(ws + OX), bhd >> 2, bhd & 3, qt * 64};
        if (rep) s.ox = (bf16_t*)(ws + RD);
        flash_item<256, 128, 32, 2, 2>(s, 8, 0, smem, rep && REP_MODE == 5);
    }
}

constexpr int SSD_XT = 0, SSD_BM = 8192, SSD_CM = SSD_BM + 16384, SSD_BWT = SSD_CM + 16384, SSD_PS = SSD_BWT + 16384, SSD_F = SSD_PS + 16384;
static_assert(SSD_F + 2048 <= SMEM_BYTES - 32, "ssd LDS");
DI int off256(int row, int el) { return row * 256 + (((el >> 3) ^ (row & 15)) << 4) + ((el & 7) << 1); }
DI int off128(int row, int el) { return row * 128 + (((el >> 3) ^ ((row ^ (row >> 3)) & 7)) << 4) + ((el & 7) << 1); }
template <int pm>
DI void ssd_item(const P& p, int bh, unsigned char* smem) {
    unsigned char* ws = p.ws;
    const bf16_t* xa = (const bf16_t*)(ws + XBCA); const float* dtg = (const float*)(ws + DTB);
    bf16_t* mix = pm ? (bf16_t*)(ws + XBC) : (bf16_t*)(ws + MIX);
    int tid0 = tidx(); asm volatile("" : "+v"(tid0));
    const int wave = __builtin_amdgcn_readfirstlane(tid0 >> 6);
    const int b = bh >> 3, hd = bh & 7, g = hd >> 2;
    const int lb = wave >> 1, pb = wave & 1;
    const float a_h = -__expf(p.in[10][hd]), Dh = p.in[11][hd];
    float* F = (float*)(smem + SSD_F);
    __syncthreads();
    for (int i = tid0; i < 16384 / 16; i += 256) *(uint4*)(smem + SSD_PS + i * 16) = make_uint4(0u, 0u, 0u, 0u);
    f32x16 st[2];
#pragma unroll
    for (int i = 0; i < 2; ++i)
#pragma unroll
        for (int e = 0; e < 16; ++e) st[i][e] = 0.f;
    uint4 xr0, xr1, br0, br1, br2, br3, cr0, cr1, cr2, cr3; float dtr = 0.f;
#define SSD_XLD(i) (*(const uint4*)(xa + (t0_ + ((tid + 256 * (i)) >> 3)) * 1024 + hd * 64 + ((tid + 256 * (i)) & 7) * 8))
#define SSD_BLD(i, o) (*(const uint4*)(xa + (t0_ + ((tid + 256 * (i)) >> 4)) * 1024 + (o) + g * 128 + ((tid + 256 * (i)) & 15) * 8))
#define SSD_GLOAD(c_) do { const size_t t0_ = (size_t)b * 2048 + (c_) * 64; xr0 = SSD_XLD(0); xr1 = SSD_XLD(1); \
        br0 = SSD_BLD(0, 512); br1 = SSD_BLD(1, 512); br2 = SSD_BLD(2, 512); br3 = SSD_BLD(3, 512); \
        cr0 = SSD_BLD(0, 768); cr1 = SSD_BLD(1, 768); cr2 = SSD_BLD(2, 768); cr3 = SSD_BLD(3, 768); \
        if (tid < 64) dtr = dtg[(t0_ + tid) * 8 + hd]; } while (0)
    { const int tid = tid0; SSD_GLOAD(0); }
#define SSD_SCAN(FP) do { const int ln_ = tid0 & 63; float v = dtr * a_h; \
        _Pragma("unroll") for (int o = 1; o < 64; o <<= 1) { const float u = __shfl_up(v, o); if (ln_ >= o) v += u; } \
        const float a63 = __shfl(v, 63); \
        (FP)[ln_] = v; (FP)[64 + ln_] = __expf(v); (FP)[128 + ln_] = dtr; (FP)[192 + ln_] = __expf(a63 - v) * dtr; } while (0)
    if (wave == 0) SSD_SCAN(F);
    __syncthreads();
    for (int c = 0; c < 32; ++c) {
        int tid = tid0; asm volatile("" : "+v"(tid));
        const int lane = tid & 63, r = lane & 31, h = lane >> 5;
        const size_t t0 = (size_t)b * 2048 + c * 64;
        const float* Fc = F + (c & 1) * 256; float* Fn = F + ((c + 1) & 1) * 256;
#define SSD_XIMG(i, XR) do { const int idx = tid + 256 * (i), l = idx >> 3, p0 = (idx & 7) * 8, lp = perm16(l); \
            const unsigned ww[4] = {XR.x, XR.y, XR.z, XR.w}; \
            _Pragma("unroll") for (int k = 0; k < 4; ++k) { \
                *(bf16_t*)(smem + SSD_XT + off128(p0 + 2 * k, lp)) = (bf16_t)(ww[k] & 0xffffu); \
                *(bf16_t*)(smem + SSD_XT + off128(p0 + 2 * k + 1, lp)) = (bf16_t)(ww[k] >> 16); } } while (0)
#define SSD_BIMG(i, BR, CR) do { const int idx = tid + 256 * (i), l = idx >> 4, n0 = (idx & 15) * 8, lp = perm16(l); \
            *(uint4*)(smem + SSD_BM + off256(l, n0)) = BR; *(uint4*)(smem + SSD_CM + off256(l, n0)) = CR; \
            const float wl = Fc[192 + l]; const unsigned ww[4] = {BR.x, BR.y, BR.z, BR.w}; \
            _Pragma("unroll") for (int k = 0; k < 4; ++k) { \
                *(bf16_t*)(smem + SSD_BWT + off128(n0 + 2 * k, lp)) = f2bf(bflo(ww[k]) * wl); \
                *(bf16_t*)(smem + SSD_BWT + off128(n0 + 2 * k + 1, lp)) = f2bf(bfhi(ww[k]) * wl); } } while (0)
        if (!(pm & 2)) {
        SSD_XIMG(0, xr0); SSD_XIMG(1, xr1);
        SSD_BIMG(0, br0, cr0); SSD_BIMG(1, br1, cr1); SSD_BIMG(2, br2, cr2); SSD_BIMG(3, br3, cr3);
        } else { asm volatile("" :: "v"(xr0.x), "v"(xr1.x), "v"(br0.x), "v"(br1.x), "v"(br2.x), "v"(br3.x), "v"(cr0.x), "v"(cr1.x), "v"(cr2.x), "v"(cr3.x)); }
        __syncthreads();
        if (c + 1 < 32) SSD_GLOAD(c + 1);
        if (!(pm & 1)) {
        const float acs_l = Fc[lb * 32 + r];
        const int lrow = lb * 32 + r;
        f32x16 cb0, cb1, yo;
#pragma unroll
        for (int e = 0; e < 16; ++e) { cb0[e] = 0.f; cb1[e] = 0.f; yo[e] = 0.f; }
#pragma unroll
        for (int ks = 0; ks < 8; ++ks) {
            const bf16x8 cv = *(const bf16x8*)(smem + SSD_CM + off256(lb * 32 + r, 16 * ks + 8 * h));
            const bf16x8 b0v = *(const bf16x8*)(smem + SSD_BM + off256(r, 16 * ks + 8 * h));
            const bf16x8 b1v = *(const bf16x8*)(smem + SSD_BM + off256(32 + r, 16 * ks + 8 * h));
            const bf16x8 pv = *(const bf16x8*)(smem + SSD_PS + off256(pb * 32 + r, 16 * ks + 8 * h));
            cb0 = MFMA32(b0v, cv, cb0); cb1 = MFMA32(b1v, cv, cb1); yo = MFMA32(cv, pv, yo);
        }
        f32x16 yd;
#pragma unroll
        for (int e = 0; e < 16; ++e) yd[e] = 0.f;
#pragma unroll
        for (int sb = 0; sb < 2; ++sb) {
            float mv[16];
#pragma unroll
            for (int q4 = 0; q4 < 4; ++q4) {
                const int s0 = sb * 32 + 8 * q4 + 4 * h;
                const float4 as4 = *(const float4*)(Fc + s0), dt4 = *(const float4*)(Fc + 128 + s0);
                const float asv[4] = {as4.x, as4.y, as4.z, as4.w}, dtv[4] = {dt4.x, dt4.y, dt4.z, dt4.w};
#pragma unroll
                for (int k = 0; k < 4; ++k) { const float cbv = sb ? cb1[4 * q4 + k] : cb0[4 * q4 + k]; mv[4 * q4 + k] = (s0 + k <= lrow) ? cbv * __expf(acs_l - asv[k]) * dtv[k] : 0.f; }
            }
#pragma unroll
            for (int s2 = 0; s2 < 2; ++s2) {
                uint4 pk;
                pk.x = pack2(mv[8 * s2], mv[8 * s2 + 1]); pk.y = pack2(mv[8 * s2 + 2], mv[8 * s2 + 3]);
                pk.z = pack2(mv[8 * s2 + 4], mv[8 * s2 + 5]); pk.w = pack2(mv[8 * s2 + 6], mv[8 * s2 + 7]);
                const bf16x8 xb = *(const bf16x8*)(smem + SSD_XT + off128(pb * 32 + r, sb * 32 + 16 * s2 + 8 * h));
                yd = MFMA32(__builtin_bit_cast(bf16x8, pk), xb, yd);
            }
        }
        {
            const uint4 x0 = *(const uint4*)(smem + SSD_XT + off128(pb * 32 + r, lb * 32 + 8 * h));
            const uint4 x1 = *(const uint4*)(smem + SSD_XT + off128(pb * 32 + r, lb * 32 + 16 + 8 * h));
            const unsigned xw[8] = {x0.x, x0.y, x0.z, x0.w, x1.x, x1.y, x1.z, x1.w};
            bf16_t* op = mix + (t0 + lb * 32 + 4 * h) * 1024 + 512 + hd * 64 + pb * 32 + r;
#pragma unroll
            for (int q4 = 0; q4 < 4; ++q4) {
                const float4 ea4 = *(const float4*)(Fc + 64 + lb * 32 + 8 * q4 + 4 * h);
                const float eav[4] = {ea4.x, ea4.y, ea4.z, ea4.w};
#pragma unroll
                for (int k = 0; k < 4; ++k) {
                    const int e = 4 * q4 + k;
                    const float xv = (e & 1) ? bfhi(xw[e >> 1]) : bflo(xw[e >> 1]);
                    const float y = yd[e] + eav[k] * yo[e] + Dh * xv;
                    op[(size_t)(k + 8 * q4) * 1024] = f2bf(y);
                }
            }
        }
        {
            const float dec = Fc[64 + 63];
#pragma unroll
            for (int e = 0; e < 16; ++e) { st[0][e] *= dec; st[1][e] *= dec; }
            const int nblk = 2 * (wave >> 1);
#pragma unroll
            for (int ks = 0; ks < 4; ++ks) {
                const bf16x8 av = *(const bf16x8*)(smem + SSD_XT + off128(pb * 32 + r, 16 * ks + 8 * h));
                const bf16x8 bv0 = *(const bf16x8*)(smem + SSD_BWT + off128(nblk * 32 + r, 16 * ks + 8 * h));
                const bf16x8 bv1 = *(const bf16x8*)(smem + SSD_BWT + off128(nblk * 32 + 32 + r, 16 * ks + 8 * h));
                st[0] = MFMA32(av, bv0, st[0]); st[1] = MFMA32(av, bv1, st[1]);
            }
        }
        }
        if (wave == 0 && c + 1 < 32) SSD_SCAN(Fn);
        __syncthreads();
#pragma unroll
        for (int i = 0; i < 2; ++i) {
            const int n = (2 * (wave >> 1) + i) * 32 + r;
#pragma unroll
            for (int e = 0; e < 16; ++e) *(bf16_t*)(smem + SSD_PS + off256(pb * 32 + crow(e, h), n)) = f2bf(st[i][e]);
        }
    }
    __syncthreads();
}

#if ATTN_NAIVE
DI void attn_naive(const P& p, int bid, int nb) {
    unsigned char* ws = p.ws;
    const bf16_t* Q = (const bf16_t*)(ws + QB); const bf16_t* Kn = (const bf16_t*)(ws + KNB); const bf16_t* Vt = (const bf16_t*)(ws + VTB);
    const bf16_t* Kr = (const bf16_t*)(ws + KROPE); bf16_t* mix = (bf16_t*)(ws + MIX);
    for (int item = bid; item < 128 * 8; item += nb) {
        const int bh = item >> 3, s_ = (item & 7) * 256 + tidx(), b = bh >> 3, hd = bh & 7;
        float q[96];
        {
            const uint4* q4 = (const uint4*)(Q + ((size_t)bh * 2048 + s_) * 96);
#pragma unroll
            for (int i = 0; i < 12; ++i) { const uint4 w = q4[i]; q[8 * i] = bflo(w.x); q[8 * i + 1] = bfhi(w.x); q[8 * i + 2] = bflo(w.y); q[8 * i + 3] = bfhi(w.y);
                q[8 * i + 4] = bflo(w.z); q[8 * i + 5] = bfhi(w.z); q[8 * i + 6] = bflo(w.w); q[8 * i + 7] = bfhi(w.w); }
        }
        float o[64];
#pragma unroll
        for (int d = 0; d < 64; ++d) o[d] = 0.f;
        float m = -1e30f, l = 0.f;
        const int nkeys = __builtin_amdgcn_readfirstlane(((s_ >> 6) + 1) * 64);
        for (int j0 = 0; j0 < nkeys; j0 += 8) {
            float sc[8];
#pragma unroll
            for (int jj = 0; jj < 8; ++jj) {
                const int j = j0 + jj;
                const uint4* k4 = (const uint4*)(Kn + ((size_t)bh * 2048 + j) * 64);
                const uint4* r4 = (const uint4*)(Kr + ((size_t)b * 2048 + j) * 32);
                float a = 0.f;
#pragma unroll
                for (int i = 0; i < 8; ++i) { const uint4 w = k4[i]; a += q[8 * i] * bflo(w.x) + q[8 * i + 1] * bfhi(w.x) + q[8 * i + 2] * bflo(w.y) + q[8 * i + 3] * bfhi(w.y)
                    + q[8 * i + 4] * bflo(w.z) + q[8 * i + 5] * bfhi(w.z) + q[8 * i + 6] * bflo(w.w) + q[8 * i + 7] * bfhi(w.w); }
#pragma unroll
                for (int i = 0; i < 4; ++i) { const uint4 w = r4[i]; const int o8 = 64 + 8 * i; a += q[o8] * bflo(w.x) + q[o8 + 1] * bfhi(w.x) + q[o8 + 2] * bflo(w.y) + q[o8 + 3] * bfhi(w.y)
                    + q[o8 + 4] * bflo(w.z) + q[o8 + 5] * bfhi(w.z) + q[o8 + 6] * bflo(w.w) + q[o8 + 7] * bfhi(w.w); }
                sc[jj] = a;
            }
            float mx = m;
#pragma unroll
            for (int jj = 0; jj < 8; ++jj) mx = fmaxf(mx, sc[jj]);
            const float al = exp2f(m - mx);
            float ps = 0.f;
#pragma unroll
            for (int jj = 0; jj < 8; ++jj) { sc[jj] = exp2f(sc[jj] - mx); ps += sc[jj]; }
            l = l * al + ps; m = mx;
#pragma unroll
            for (int d = 0; d < 64; ++d) {
                const uint4 w = *(const uint4*)(Vt + ((size_t)bh * 64 + d) * 2048 + j0);
                o[d] = o[d] * al + sc[0] * bflo(w.x) + sc[1] * bfhi(w.x) + sc[2] * bflo(w.y) + sc[3] * bfhi(w.y) + sc[4] * bflo(w.z) + sc[5] * bfhi(w.z) + sc[6] * bflo(w.w) + sc[7] * bfhi(w.w);
            }
        }
        const float il = 1.f / l;
        bf16_t* dst = mix + ((size_t)b * 2048 + s_) * 1024 + hd * 64;
#pragma unroll
        for (int d = 0; d < 64; d += 2) *(unsigned*)(dst + d) = pack2(o[d] * il, o[d + 1] * il);
    }
}
#endif
#if SSD_NAIVE
DI void ssd_naive(const P& p, int bid, int nb) {
    unsigned char* ws = p.ws;
    const bf16_t* xa = (const bf16_t*)(ws + XBCA); const float* dt = (const float*)(ws + DTB); const bf16_t* z = (const bf16_t*)(ws + ZB);
    bf16_t* mix = (bf16_t*)(ws + MIX);
    const int wave = tidx() >> 6, pp = tidx() & 63;
    for (int item = bid; item < 32; item += nb) {
        const int bh = item * 4 + wave, b = bh >> 3, hd = bh & 7, g = hd >> 2;
        const float a = -__expf(p.in[10][hd]), Dh = p.in[11][hd];
        float st[128];
#pragma unroll
        for (int n = 0; n < 128; ++n) st[n] = 0.f;
        for (int t = 0; t < 2048; ++t) {
            const size_t row = (size_t)b * 2048 + t;
            const float dtv = dt[row * 8 + hd];
            const float da = __expf(dtv * a);
            const float xv = bf2f(xa[row * 1024 + hd * 64 + pp]);
            const float xd = dtv * xv;
            const uint4* b4 = (const uint4*)(xa + row * 1024 + 512 + g * 128);
            const uint4* c4 = (const uint4*)(xa + row * 1024 + 768 + g * 128);
            float y = 0.f;
#pragma unroll
            for (int i = 0; i < 16; ++i) {
                const uint4 bw = b4[i], cw = c4[i];
                const unsigned bb[4] = {bw.x, bw.y, bw.z, bw.w}, cc[4] = {cw.x, cw.y, cw.z, cw.w};
#pragma unroll
                for (int k = 0; k < 4; ++k) {
                    const int n = 8 * i + 2 * k;
                    st[n] = da * st[n] + xd * bflo(bb[k]); y += bflo(cc[k]) * st[n];
                    st[n + 1] = da * st[n + 1] + xd * bfhi(bb[k]); y += bfhi(cc[k]) * st[n + 1];
                }
            }
            y += Dh * xv;
            const float zv = bf2f(z[row * 512 + hd * 64 + pp]);
            mix[row * 1024 + 512 + hd * 64 + pp] = f2bf(y * siluf(zv));
        }
    }
}
#endif
DI void phase_mixer(const P& p, int bid, int nb, unsigned char* smem, int rep = 0) {
#if SSD_NAIVE
    ssd_naive(p, bid, nb);
    attn_fast(p, bid, nb, smem);
#else
    unsigned* ctr = (unsigned*)(p.ws + CTL + CTL_QUEUE) + 64 * rep;
    int* slot = (int*)(smem + SMEM_BYTES - 32);
    for (;;) {
        __syncthreads();
        if (tidx() == 0) *slot = (int)atomicAdd(ctr, 1u);
        __syncthreads();
        const int it = *slot;
        if (it >= 128 + 2048 + N_LATE_ITEMS) break;
        if (it >= 128 + 2048) {
            if (!rep) for (int k = 0; k < LATE_GROUP; ++k) { const int u = (it - 128 - 2048) * LATE_GROUP + k; if (u < N_LATE) prep_tile(p, u < LATE_A1 - LATE_A0 ? LATE_A0 + u : u - (LATE_A1 - LATE_A0) + LATE_B0, smem); }
            continue;
        }
        if (it < 128) { if (!NO_SSD && !(rep && REP_MODE == 2)) { if (rep) ssd_item<SSD_PM>(p, it, smem); else ssd_item<0>(p, it, smem); } }
        else if (rep && REP_MODE >= 1) { }
        else {
            const int idx = it - 128, qb = 15 - (idx >> 7), bh = idx & 127;
            unsigned char* ws = p.ws;
            SelfSrc s{(const bf16_t*)(ws + QB), (const bf16_t*)(ws + KNB), (const bf16_t*)(ws + KROPE), (const bf16_t*)(ws + VTB), (bf16_t*)(ws + MIX), bh >> 3, bh & 7, bh, qb * 128, (const float*)(ws + ROPE_C), (const float*)(ws + ROPE_S)};
            if (rep) s.mix = (bf16_t*)(ws + XBC);
            if (!NO_FLASH) flash_item<96, 64, 64, 4, 1>(s, 2 * qb + 2, 2, smem, rep && REP_MODE == 5);
        }
    }
#endif
}

DI void phase_ssdnorm(const P& p, int bid, int nb, unsigned char* smem) {
    bf16_t* mix = (bf16_t*)(p.ws + MIX); const bf16_t* z = (const bf16_t*)(p.ws + ZB);
    const int lane = tidx() & 63, wave = tidx() >> 6;
    for (int tk = bid * 4 + wave; tk < T; tk += nb * 4) {
        uint4* ptr = (uint4*)(mix + (size_t)tk * 1024 + 512 + lane * 8);
        const uint4 w = *ptr, zz = *(const uint4*)(z + (size_t)tk * 512 + lane * 8);
        const unsigned ww[4] = {w.x, w.y, w.z, w.w}, zw[4] = {zz.x, zz.y, zz.z, zz.w};
        float v[8]; float ss = 0.f;
#pragma unroll
        for (int k = 0; k < 4; ++k) {
            v[2 * k] = bflo(ww[k]) * siluf(bflo(zw[k])); v[2 * k + 1] = bfhi(ww[k]) * siluf(bfhi(zw[k]));
            ss += v[2 * k] * v[2 * k] + v[2 * k + 1] * v[2 * k + 1];
        }
#pragma unroll
        for (int o = 16; o >= 1; o >>= 1) ss += __shfl_xor(ss, o);
        const float rr = rsqrtf(ss * (1.f / 256.f) + EPS);
        uint4 o4; o4.x = pack2(v[0] * rr, v[1] * rr); o4.y = pack2(v[2] * rr, v[3] * rr); o4.z = pack2(v[4] * rr, v[5] * rr); o4.w = pack2(v[6] * rr, v[7] * rr);
        *ptr = o4;
    }
}

template <bool RES_BF16>
struct EpiResid {
    bf16_t* pre; const void* res;
    float4 pf[RES_BF16 ? 1 : 16]; uint2 pb[RES_BF16 ? 16 : 1];
    DI void prefetch(int m0, int n0, int tid) {
        const int c4 = (tid & 31) * 4, r0 = tid >> 5;
#pragma unroll
        for (int ps = 0; ps < 16; ++ps) {
            const size_t idx = (size_t)(m0 + ps * 8 + r0) * 1024 + n0 + c4;
            if (RES_BF16) pb[ps] = *(const uint2*)((const bf16_t*)res + idx); else pf[ps] = *(const float4*)((const float*)res + idx);
        }
    }
    DI void operator()(const float* Cs, int m0, int n0, int tid) const {
        const int c4 = (tid & 31) * 4, r0 = tid >> 5;
#pragma unroll
        for (int ps = 0; ps < 16; ++ps) {
            const int row = ps * 8 + r0;
            const float4 v = cs4(Cs, row, c4);
            float4 rr;
            if (RES_BF16) rr = make_float4(bflo(pb[ps].x), bfhi(pb[ps].x), bflo(pb[ps].y), bfhi(pb[ps].y)); else rr = pf[ps];
            *(uint2*)(pre + (size_t)(m0 + row) * 1024 + n0 + c4) = pack4(make_float4(ALPHA * rr.x + v.x, ALPHA * rr.y + v.y, ALPHA * rr.z + v.z, ALPHA * rr.w + v.w));
        }
    }
};
DI void phase_wout(const P& p, int bid, int nb, unsigned char* smem) {
    const int v = vbid(bid, nb);
    EpiResid<true> e; e.pre = (bf16_t*)p.out; e.res = p.out;
    GemmArgs g{(const bf16_t*)(p.ws + MIX), 1024, (const bf16_t*)(p.ws + W_OUT), 1024, 1024, nullptr};
    for (int t = v; t < 256 * 8; t += nb) gemm_tile(g, (t >> 3) * 128, (t & 7) * 128, e, smem);
}
DI void ln_row(const float* src, const float* gam, const float* bet, int lane, float (&o)[16]) {
    float v[16];
#pragma unroll
    for (int i = 0; i < 4; ++i) { const float4 t4 = *(const float4*)(src + i * 256 + lane * 4); v[4 * i] = t4.x; v[4 * i + 1] = t4.y; v[4 * i + 2] = t4.z; v[4 * i + 3] = t4.w; }
    float s = 0.f;
#pragma unroll
    for (int i = 0; i < 16; ++i) s += v[i];
    const float mu = wave_sum(s) * (1.f / 1024.f);
    float q = 0.f;
#pragma unroll
    for (int i = 0; i < 16; ++i) { const float d = v[i] - mu; q += d * d; }
    const float rstd = rsqrtf(wave_sum(q) * (1.f / 1024.f) + EPS);
#pragma unroll
    for (int i = 0; i < 4; ++i) {
        const float4 g4 = *(const float4*)(gam + i * 256 + lane * 4), b4 = *(const float4*)(bet + i * 256 + lane * 4);
        o[4 * i] = (v[4 * i] - mu) * rstd * g4.x + b4.x; o[4 * i + 1] = (v[4 * i + 1] - mu) * rstd * g4.y + b4.y;
        o[4 * i + 2] = (v[4 * i + 2] - mu) * rstd * g4.z + b4.z; o[4 * i + 3] = (v[4 * i + 3] - mu) * rstd * g4.w + b4.w;
    }
}
DI void ln_stats2(const float (&va)[16], const float (&vb)[16], float& mua, float& rsa, float& mub, float& rsb) {
    float sa = 0.f, sb = 0.f;
#pragma unroll
    for (int i = 0; i < 16; ++i) { sa += va[i]; sb += vb[i]; }
#pragma unroll
    for (int o = 32; o >= 1; o >>= 1) { sa += __shfl_xor(sa, o); sb += __shfl_xor(sb, o); }
    mua = sa * (1.f / 1024.f); mub = sb * (1.f / 1024.f);
    float qa = 0.f, qb = 0.f;
#pragma unroll
    for (int i = 0; i < 16; ++i) { const float da = va[i] - mua, db = vb[i] - mub; qa += da * da; qb += db * db; }
#pragma unroll
    for (int o = 32; o >= 1; o >>= 1) { qa += __shfl_xor(qa, o); qb += __shfl_xor(qb, o); }
    rsa = rsqrtf(qa * (1.f / 1024.f) + EPS); rsb = rsqrtf(qb * (1.f / 1024.f) + EPS);
}
DI void load_row16(const bf16_t* src, int lane, float (&v)[16]) {
#pragma unroll
    for (int i = 0; i < 4; ++i) { const uint2 t2 = *(const uint2*)(src + i * 256 + lane * 4); v[4 * i] = bflo(t2.x); v[4 * i + 1] = bfhi(t2.x); v[4 * i + 2] = bflo(t2.y); v[4 * i + 3] = bfhi(t2.y); }
}
DI void phase_ln1(const P& p, int bid, int nb, unsigned char* smem) {
    const int lane = tidx() & 63, wave = tidx() >> 6;
    const bf16_t* pre = (const bf16_t*)p.out; bf16_t* hb = (bf16_t*)(p.ws + H1B);
    const float* gam = p.in[14]; const float* bet = p.in[15];
    for (int tk = bid * 4 + wave; tk < T; tk += nb * 8) {
        const int tk2 = tk + nb * 4;
        float va[16], vb[16], mua, rsa, mub, rsb;
        load_row16(pre + (size_t)tk * 1024, lane, va); load_row16(pre + (size_t)tk2 * 1024, lane, vb);
        ln_stats2(va, vb, mua, rsa, mub, rsb);
#pragma unroll
        for (int i = 0; i < 4; ++i) {
            const float4 g4 = *(const float4*)(gam + i * 256 + lane * 4), b4 = *(const float4*)(bet + i * 256 + lane * 4);
            const float4 oa = make_float4((va[4 * i] - mua) * rsa * g4.x + b4.x, (va[4 * i + 1] - mua) * rsa * g4.y + b4.y, (va[4 * i + 2] - mua) * rsa * g4.z + b4.z, (va[4 * i + 3] - mua) * rsa * g4.w + b4.w);
            const float4 ob = make_float4((vb[4 * i] - mub) * rsb * g4.x + b4.x, (vb[4 * i + 1] - mub) * rsb * g4.y + b4.y, (vb[4 * i + 2] - mub) * rsb * g4.z + b4.z, (vb[4 * i + 3] - mub) * rsb * g4.w + b4.w);
            *(uint2*)(hb + (size_t)tk * 1024 + i * 256 + lane * 4) = pack4(oa); *(uint2*)(hb + (size_t)tk2 * 1024 + i * 256 + lane * 4) = pack4(ob);
        }
    }
}
struct EpiXq {
    bf16_t* qx;
    DI void prefetch(int, int, int) {}
    DI void operator()(const float* Cs, int m0, int n0, int tid) const {
        const int c4 = (tid & 31) * 4, r0 = tid >> 5, hd = n0 >> 8, d = (n0 & 255) + c4, b = m0 >> 11, s0 = m0 & 2047;
#pragma unroll 4
        for (int ps = 0; ps < 16; ++ps) {
            const int row = ps * 8 + r0;
            float4 v = cs4(Cs, row, c4); v.x *= XSCALE; v.y *= XSCALE; v.z *= XSCALE; v.w *= XSCALE;
            *(uint2*)(qx + ((size_t)(b * 4 + hd) * 2048 + s0 + row) * 256 + d) = pack4(v);
        }
    }
};
DI void phase_xq(const P& p, int bid, int nb, unsigned char* smem) {
    const int v = vbid(bid, nb);
    EpiXq e{(bf16_t*)(p.ws + QX)};
    GemmArgs g{(const bf16_t*)(p.ws + H1B), 1024, (const bf16_t*)(p.ws + W_XQ), 1024, 1024, nullptr};
    for (int t = v; t < 256 * 8; t += nb) gemm_tile(g, (t >> 3) * 128, (t & 7) * 128, e, smem);
}
DI void phase_xattn(const P& p, int bid, int nb, unsigned char* smem, int rep = 0) {
#if !XATTN_NAIVE
    xattn_fast(p, bid, nb, smem, rep); return;
#endif
    unsigned char* ws = p.ws;
    const bf16_t* qx = (const bf16_t*)(ws + QX); const bf16_t* kx = (const bf16_t*)(ws + KX); const bf16_t* vxt = (const bf16_t*)(ws + VXT);
    bf16_t* ox = (bf16_t*)(ws + OX);
    const int lane = tidx() & 63, hd = tidx() >> 6;
    float* qs = (float*)smem + hd * 512; float* ps = qs + 256;
    for (int tk = bid; tk < T; tk += nb) {
        const int b = tk >> 11, s_ = tk & 2047;
        __syncthreads();
        {
            const uint2 w = *(const uint2*)(qx + ((size_t)(b * 4 + hd) * 2048 + s_) * 256 + lane * 4);
            qs[lane * 4] = bflo(w.x); qs[lane * 4 + 1] = bfhi(w.x); qs[lane * 4 + 2] = bflo(w.y); qs[lane * 4 + 3] = bfhi(w.y);
        }
        __syncthreads();
        float sc[4];
#pragma unroll
        for (int i = 0; i < 4; ++i) {
            const int m = lane + 64 * i;
            const uint4* k4 = (const uint4*)(kx + ((size_t)(b * 4 + hd) * 256 + m) * 256);
            float a = 0.f;
#pragma unroll 8
            for (int c = 0; c < 32; ++c) {
                const uint4 w = k4[c];
                const float4 q0 = *(const float4*)(qs + 8 * c), q1 = *(const float4*)(qs + 8 * c + 4);
                a += q0.x * bflo(w.x) + q0.y * bfhi(w.x) + q0.z * bflo(w.y) + q0.w * bfhi(w.y) + q1.x * bflo(w.z) + q1.y * bfhi(w.z) + q1.z * bflo(w.w) + q1.w * bfhi(w.w);
            }
            sc[i] = a;
        }
        const float mx = wave_max(fmaxf(fmaxf(sc[0], sc[1]), fmaxf(sc[2], sc[3])));
        float sum = 0.f;
#pragma unroll
        for (int i = 0; i < 4; ++i) { sc[i] = exp2f(sc[i] - mx); sum += sc[i]; }
        const float il = 1.f / wave_sum(sum);
#pragma unroll
        for (int i = 0; i < 4; ++i) ps[lane + 64 * i] = sc[i] * il;
        __syncthreads();
        float o[4];
#pragma unroll
        for (int dd = 0; dd < 4; ++dd) {
            const int d = lane * 4 + dd;
            const uint4* v4 = (const uint4*)(vxt + ((size_t)(b * 4 + hd) * 256 + d) * 256);
            float a = 0.f;
#pragma unroll 8
            for (int c = 0; c < 32; ++c) {
                const uint4 w = v4[c];
                const float4 q0 = *(const float4*)(ps + 8 * c), q1 = *(const float4*)(ps + 8 * c + 4);
                a += q0.x * bflo(w.x) + q0.y * bfhi(w.x) + q0.z * bflo(w.y) + q0.w * bfhi(w.y) + q1.x * bflo(w.z) + q1.y * bfhi(w.z) + q1.z * bflo(w.w) + q1.w * bfhi(w.w);
            }
            o[dd] = a;
        }
        uint2 w; w.x = pack2(o[0], o[1]); w.y = pack2(o[2], o[3]);
        *(uint2*)(ox + (size_t)tk * 1024 + hd * 256 + lane * 4) = w;
    }
}
DI void phase_xo(const P& p, int bid, int nb, unsigned char* smem) {
    const int v = vbid(bid, nb);
    EpiResid<true> e; e.pre = (bf16_t*)p.out; e.res = p.ws + H1B;
    GemmArgs g{(const bf16_t*)(p.ws + OX), 1024, (const bf16_t*)(p.ws + W_XO), 1024, 1024, nullptr};
    for (int t = v; t < 256 * 8; t += nb) gemm_tile(g, (t >> 3) * 128, (t & 7) * 128, e, smem);
}
DI void phase_ln2_router(const P& p, int bid, int nb, unsigned char* smem, int rep = 0) {
    unsigned char* ws = p.ws;
    const int lane = tidx() & 63, wave = tidx() >> 6;
    const bf16_t* pre = (const bf16_t*)p.out; bf16_t* hb = (bf16_t*)(ws + H2B);
    const float* wrt = (const float*)(ws + W_RT);
    const float* gam = p.in[20]; const float* bet = p.in[21];
    unsigned* cnt = (unsigned*)(ws + CTL + CTL_CNT); int* lists = (int*)(ws + LISTS); float* tgate = (float*)(ws + TOK_GATE);
    float* lg = (float*)smem + wave * (16 * 52 + 32);
    float* stt = lg + 16 * 52;
    for (int grp = bid; grp < T / 64; grp += nb) {
        const int t0 = grp * 64 + wave * 16;
        for (int rr = 0; rr < 16; rr += 2) {
            if (rep && REP_MODE == 3) break;
            const int tk = t0 + rr;
            float va[16], vb[16], mua, rsa, mub, rsb;
            load_row16(pre + (size_t)tk * 1024, lane, va); load_row16(pre + (size_t)(tk + 1) * 1024, lane, vb);
            ln_stats2(va, vb, mua, rsa, mub, rsb);
            if (lane == 0) { stt[2 * rr] = mua; stt[2 * rr + 1] = rsa; stt[2 * rr + 2] = mub; stt[2 * rr + 3] = rsb; }
#pragma unroll
            for (int i = 0; i < 4; ++i) {
                const float4 g4 = *(const float4*)(gam + i * 256 + lane * 4), b4 = *(const float4*)(bet + i * 256 + lane * 4);
                const float4 oa = make_float4((va[4 * i] - mua) * rsa * g4.x + b4.x, (va[4 * i + 1] - mua) * rsa * g4.y + b4.y, (va[4 * i + 2] - mua) * rsa * g4.z + b4.z, (va[4 * i + 3] - mua) * rsa * g4.w + b4.w);
                const float4 ob = make_float4((vb[4 * i] - mub) * rsb * g4.x + b4.x, (vb[4 * i + 1] - mub) * rsb * g4.y + b4.y, (vb[4 * i + 2] - mub) * rsb * g4.z + b4.z, (vb[4 * i + 3] - mub) * rsb * g4.w + b4.w);
                *(uint2*)(hb + (size_t)tk * 1024 + i * 256 + lane * 4) = pack4(oa); *(uint2*)(hb + (size_t)(tk + 1) * 1024 + i * 256 + lane * 4) = pack4(ob);
            }
        }
        __builtin_amdgcn_wave_barrier();
        if (!(rep && REP_MODE == 2)) {
            const int i16 = lane & 15, g4i = lane >> 4;
            const bf16_t* arow = pre + (size_t)(t0 + i16) * 1024 + 8 * g4i;
            const bf16_t* brow = (const bf16_t*)wrt + (size_t)i16 * 1024 + 8 * g4i;
            f32x4v acc0 = {0.f, 0.f, 0.f, 0.f}, acc1 = acc0, acc2 = acc0;
#pragma unroll 4
            for (int S = 0; S < 32; ++S) {
                const bf16x8 av = *(const bf16x8*)(arow + 32 * S);
                const bf16x8 h0 = *(const bf16x8*)(brow + 32 * S), h1 = *(const bf16x8*)(brow + 16 * 1024 + 32 * S), h2 = *(const bf16x8*)(brow + 32 * 1024 + 32 * S);
                const bf16x8 l0 = *(const bf16x8*)(brow + 48 * 1024 + 32 * S), l1 = *(const bf16x8*)(brow + 64 * 1024 + 32 * S), l2 = *(const bf16x8*)(brow + 80 * 1024 + 32 * S);
                acc0 = __builtin_amdgcn_mfma_f32_16x16x32_bf16(av, h0, acc0, 0, 0, 0); acc1 = __builtin_amdgcn_mfma_f32_16x16x32_bf16(av, h1, acc1, 0, 0, 0); acc2 = __builtin_amdgcn_mfma_f32_16x16x32_bf16(av, h2, acc2, 0, 0, 0);
                acc0 = __builtin_amdgcn_mfma_f32_16x16x32_bf16(av, l0, acc0, 0, 0, 0); acc1 = __builtin_amdgcn_mfma_f32_16x16x32_bf16(av, l1, acc1, 0, 0, 0); acc2 = __builtin_amdgcn_mfma_f32_16x16x32_bf16(av, l2, acc2, 0, 0, 0);
            }
            const float* aux = (const float*)(ws + CTL + CTL_RTAUX);
            const float sw0 = aux[i16], sw1 = aux[16 + i16], sw2 = aux[32 + i16], cb0 = aux[48 + i16], cb1 = aux[64 + i16], cb2 = aux[80 + i16];
#pragma unroll
            for (int e = 0; e < 4; ++e) {
                const float mur = stt[2 * (4 * g4i + e)], rsr = stt[2 * (4 * g4i + e) + 1];
                float* rowp = lg + (4 * g4i + e) * 52 + i16;
                rowp[0] = rsr * (acc0[e] - mur * sw0) + cb0; rowp[16] = rsr * (acc1[e] - mur * sw1) + cb1; rowp[32] = rsr * (acc2[e] - mur * sw2) + cb2;
            }
        }
        __builtin_amdgcn_wave_barrier();
        unsigned* lcount = (unsigned*)((float*)smem + 4 * (16 * 52 + 32));
        unsigned* lbase = lcount + 32;
        if (tidx() < 32) lcount[tidx()] = 0u;
        __syncthreads();
        int ex1 = 0, ex2 = 0; unsigned lp1 = 0, lp2 = 0;
        if (lane < 16) {
            const int tk = t0 + lane;
            const float* lr = lg + lane * 52;
            float gl[4], el[32];
#pragma unroll
            for (int j = 0; j < 4; ++j) gl[j] = lr[j];
#pragma unroll
            for (int j = 0; j < 32; ++j) el[j] = lr[4 + j];
            int gi = 0; float gm = gl[0];
#pragma unroll
            for (int j = 1; j < 4; ++j) if (gl[j] > gm) { gm = gl[j]; gi = j; }
            float gs = 0.f;
#pragma unroll
            for (int j = 0; j < 4; ++j) gs += __expf(gl[j] - gm);
            const float ggate = 1.f / gs;
            float ev[8];
#pragma unroll
            for (int j = 0; j < 8; ++j) ev[j] = gi == 0 ? el[j] : gi == 1 ? el[8 + j] : gi == 2 ? el[16 + j] : el[24 + j];
            int i1 = 0; float v1 = ev[0];
#pragma unroll
            for (int j = 1; j < 8; ++j) if (ev[j] > v1) { v1 = ev[j]; i1 = j; }
            int i2 = -1; float v2 = -3.0e38f;
#pragma unroll
            for (int j = 0; j < 8; ++j) if (j != i1 && ev[j] > v2) { v2 = ev[j]; i2 = j; }
            const float e2 = __expf(v2 - v1);
            tgate[tk * 2] = ggate / (1.f + e2); tgate[tk * 2 + 1] = ggate * e2 / (1.f + e2);
            ex1 = gi * 8 + i1; ex2 = gi * 8 + i2;
            if (!rep) { lp1 = atomicAdd(&lcount[ex1], 1u); lp2 = atomicAdd(&lcount[ex2], 1u); }
        }
        __syncthreads();
        if (tidx() < 32 && !rep) { const unsigned c = lcount[tidx()]; lbase[tidx()] = c ? atomicAdd(&cnt[tidx() * CNT_STRIDE], c) : 0u; }
        __syncthreads();
        if (lane < 16 && !rep) {
            const int tk = t0 + lane;
            lists[(size_t)ex1 * T + lbase[ex1] + lp1] = tk * 2;
            lists[(size_t)ex2 * T + lbase[ex2] + lp2] = tk * 2 + 1;
        }
        __syncthreads();
    }
}
struct MoeMap { int off[33]; };
DI int moe_tiles(const unsigned* cnt, int* offs  ) {
    __syncthreads();
    if (tidx() == 0) { int o = 0; for (int e = 0; e < 32; ++e) { offs[e] = o; o += (((int)cnt[e * CNT_STRIDE] + 127) >> 7) << 7; } offs[32] = o; }
    __syncthreads();
    return offs[32] >> 7;
}
struct EpiGU {
    bf16_t* hdn;
    DI void prefetch(int, int, int) {}
    DI void operator()(const float* Cs, int m0, int n0, int tid) const {
#pragma unroll 4
        for (int ps = 0; ps < 8; ++ps) {
            const int it = ps * 256 + tid, row = it >> 4, qd = it & 15, c = (qd >> 3) * 64 + (qd & 7) * 4;
            const float4 g = cs4(Cs, row, c), u = cs4(Cs, row, c + 32);
            const int hc = ((n0 & 511) >> 7) * 64 + (qd >> 3) * 32 + (qd & 7) * 4;
            *(uint2*)(hdn + (size_t)(m0 + row) * 256 + hc) = pack4(make_float4(siluf(g.x) * u.x, siluf(g.y) * u.y, siluf(g.z) * u.z, siluf(g.w) * u.w));
        }
    }
};
struct EpiDown {
    bf16_t* y; int* ltok; float* lgate; const int* lst; int nvalid; const float* tgate;
    DI void prefetch(int, int, int tid) {
        if (tid < 128) { const int tk2 = tid < nvalid ? lst[tid] : -1; ltok[tid] = tk2; lgate[tid] = tk2 < 0 ? 0.f : tgate[tk2]; }
    }
    DI void operator()(const float* Cs, int m0, int n0, int tid) const {
        const int c4 = (tid & 31) * 4, r0 = tid >> 5;
#pragma unroll 4
        for (int ps = 0; ps < 16; ++ps) {
            const int row = ps * 8 + r0, tk2 = ltok[row];
            if (tk2 >= 0) {
                const float gt = lgate[row];
                float4 v = cs4(Cs, row, c4); v.x *= gt; v.y *= gt; v.z *= gt; v.w *= gt;
                *(uint2*)(y + (size_t)tk2 * 1024 + n0 + c4) = pack4(v);
            }
        }
    }
};
template <int WHICH>
DI void phase_moe(const P& p, int bid, int nb, unsigned char* smem) {
    unsigned char* ws = p.ws;
    const unsigned* cnt = (const unsigned*)(ws + CTL + CTL_CNT); const int* lists = (const int*)(ws + LISTS); const float* tgate = (const float*)(ws + TOK_GATE);
    int* offs = (int*)(smem + GEMM_LDS); int* ltok = offs + 64; int* lrow = ltok + 128; float* lgate = (float*)(lrow + 128);
    const int nmt = moe_tiles(cnt, offs);
    constexpr int NNT = WHICH == 0 ? 4 : 8;
    const int v = vbid(bid, nb);
    for (int t = v; t < nmt * NNT; t += nb) {
        const int mt = t / NNT, ntl = t % NNT;
        const int slot0 = mt * 128;
        int e = 0;
        while (offs[e + 1] <= slot0) ++e;
        if (WHICH == 0) {
            __syncthreads();
            if (tidx() < 128) {
                const int pos = slot0 - offs[e] + tidx();
                const int tk2 = pos < (int)cnt[e * CNT_STRIDE] ? lists[(size_t)e * T + pos] : -1;
                lrow[tidx()] = tk2 < 0 ? 0 : (tk2 >> 1);
            }
            __syncthreads();
        }
        if (WHICH == 0) {
            EpiGU ep{(bf16_t*)(ws + HDN)};
            GemmArgs g{(const bf16_t*)(ws + H2B), 1024, (const bf16_t*)(ws + W_GU) + (size_t)e * 512 * 1024, 1024, 1024, lrow};
            gemm_tile(g, slot0, ntl * 128, ep, smem);
        } else {
            EpiDown ep{(bf16_t*)(ws + YB), ltok, lgate, lists + (size_t)e * T + (slot0 - offs[e]), (int)cnt[e * CNT_STRIDE] - (slot0 - offs[e]), tgate};
            GemmArgs g{(const bf16_t*)(ws + HDN), 256, (const bf16_t*)(ws + W_DN) + (size_t)e * 1024 * 256, 256, 256, nullptr};
            gemm_tile(g, slot0, ntl * 128, ep, smem);
        }
    }
}
DI void phase_final(const P& p, int bid, int nb, unsigned char* smem) {
    const int lane = tidx() & 63, wave = tidx() >> 6;
    const bf16_t* hb2 = (const bf16_t*)(p.ws + H2B); const bf16_t* y = (const bf16_t*)(p.ws + YB);
    const float* gam = p.in[29]; const float* bet = p.in[30];
    for (int tk = bid * 4 + wave; tk < T; tk += nb * 8) {
        const int tk2 = tk + nb * 4;
        float va[16], vb[16], mua, rsa, mub, rsb;
#pragma unroll
        for (int i = 0; i < 4; ++i) {
            const uint2 ha = *(const uint2*)(hb2 + (size_t)tk * 1024 + i * 256 + lane * 4), hbv = *(const uint2*)(hb2 + (size_t)tk2 * 1024 + i * 256 + lane * 4);
            const float4 ta = make_float4(bflo(ha.x), bfhi(ha.x), bflo(ha.y), bfhi(ha.y)), tb = make_float4(bflo(hbv.x), bfhi(hbv.x), bflo(hbv.y), bfhi(hbv.y));
            const uint2 a0 = *(const uint2*)(y + (size_t)(tk * 2) * 1024 + i * 256 + lane * 4), a1 = *(const uint2*)(y + (size_t)(tk * 2 + 1) * 1024 + i * 256 + lane * 4);
            const uint2 b0 = *(const uint2*)(y + (size_t)(tk2 * 2) * 1024 + i * 256 + lane * 4), b1 = *(const uint2*)(y + (size_t)(tk2 * 2 + 1) * 1024 + i * 256 + lane * 4);
            va[4 * i] = ALPHA * ta.x + bflo(a0.x) + bflo(a1.x); va[4 * i + 1] = ALPHA * ta.y + bfhi(a0.x) + bfhi(a1.x); va[4 * i + 2] = ALPHA * ta.z + bflo(a0.y) + bflo(a1.y); va[4 * i + 3] = ALPHA * ta.w + bfhi(a0.y) + bfhi(a1.y);
            vb[4 * i] = ALPHA * tb.x + bflo(b0.x) + bflo(b1.x); vb[4 * i + 1] = ALPHA * tb.y + bfhi(b0.x) + bfhi(b1.x); vb[4 * i + 2] = ALPHA * tb.z + bflo(b0.y) + bflo(b1.y); vb[4 * i + 3] = ALPHA * tb.w + bfhi(b0.y) + bfhi(b1.y);
        }
        ln_stats2(va, vb, mua, rsa, mub, rsb);
#pragma unroll
        for (int i = 0; i < 4; ++i) {
            const float4 g4 = *(const float4*)(gam + i * 256 + lane * 4), b4 = *(const float4*)(bet + i * 256 + lane * 4);
            *(float4*)(p.out + (size_t)tk * 1024 + i * 256 + lane * 4) = make_float4((va[4 * i] - mua) * rsa * g4.x + b4.x, (va[4 * i + 1] - mua) * rsa * g4.y + b4.y, (va[4 * i + 2] - mua) * rsa * g4.z + b4.z, (va[4 * i + 3] - mua) * rsa * g4.w + b4.w);
            *(float4*)(p.out + (size_t)tk2 * 1024 + i * 256 + lane * 4) = make_float4((vb[4 * i] - mub) * rsb * g4.x + b4.x, (vb[4 * i + 1] - mub) * rsb * g4.y + b4.y, (vb[4 * i + 2] - mub) * rsb * g4.z + b4.z, (vb[4 * i + 3] - mub) * rsb * g4.w + b4.w);
        }
    }
}

#define XB_TMO      128
#define XB_XCNT(j)  (256  + 64 * (j))
#define XB_XSUB(j)  (1280 + 64 * (j))
#define XB_XGEN(j)  (2304 + 64 * (j))
#define XB_TOP      3328
#define XB_TOPGEN   3392
#define XCD_BAR_WORDS 3456
#define XB_SPIN_CAP (1u << 25)
DI unsigned xb_ld(unsigned* p) { return __hip_atomic_load(p, __ATOMIC_RELAXED, __HIP_MEMORY_SCOPE_AGENT); }
DI unsigned xb_add(unsigned* p, unsigned v) { return __hip_atomic_fetch_add(p, v, __ATOMIC_RELAXED, __HIP_MEMORY_SCOPE_AGENT); }
DI unsigned xb_xcc_id() { return (unsigned)__builtin_amdgcn_s_getreg((3 << 11) | 20) & 0xFu; }
#define XB_SPIN(cond, bar) do { unsigned _sp = 0; while (cond) { __builtin_amdgcn_s_sleep(1); \
    if ((++_sp & 255u) == 0u) { if (xb_ld(&(bar)[XB_TMO])) break; if (_sp > XB_SPIN_CAP) { atomicAdd(&(bar)[XB_TMO], 1u); break; } } } } while (0)
struct XcdBarrier { unsigned* bar; unsigned x; volatile LAS unsigned* st; };
DI XcdBarrier xcd_barrier_post(unsigned* bar, volatile LAS unsigned* st) {
    XcdBarrier b; b.bar = bar; b.x = xb_xcc_id(); b.st = st;
    if (threadIdx.x == 0) (void)xb_add(&bar[XB_XCNT(b.x)], 1u);
    return b;
}
DI void xcd_barrier_complete(unsigned* bar, unsigned x, unsigned& nloc, unsigned& nx) {
    const unsigned G = gridDim.x * gridDim.y * gridDim.z;
    unsigned sum, cnt, mine, sp = 0u;
    for (;;) {
        sum = 0u; cnt = 0u; mine = 0u;
#pragma unroll
        for (unsigned j = 0; j < 16; ++j) { const unsigned c = xb_ld(&bar[XB_XCNT(j)]); sum += c; cnt += (c > 0u) ? 1u : 0u; mine = (j == x) ? c : mine; }
        if (sum == G) break;
        __builtin_amdgcn_s_sleep(1);
        if ((++sp & 255u) == 0u) { if (xb_ld(&bar[XB_TMO])) break; if (sp > XB_SPIN_CAP) { atomicAdd(&bar[XB_TMO], 1u); break; } }
    }
    nloc = mine > 0u ? mine : 1u; nx = cnt > 0u ? cnt : 1u;
}
DI void xcd_barrier(const XcdBarrier& b) {
    asm volatile("s_waitcnt vmcnt(0)" ::: "memory");
    __syncthreads();
    if (threadIdx.x == 0) {
        unsigned* bar = b.bar;
        __builtin_amdgcn_s_waitcnt(0);
        unsigned nloc = b.st[0], nx = b.st[1];
        if (nloc == 0u) { xcd_barrier_complete(bar, b.x, nloc, nx); b.st[0] = nloc; b.st[1] = nx; }
        const unsigned old = xb_add(&bar[XB_XSUB(b.x)], 1u);
        const unsigned gen = old / nloc;
        if (old + 1u == (gen + 1u) * nloc) {
            __builtin_amdgcn_fence(__ATOMIC_RELEASE, "agent");
            asm volatile("s_waitcnt vmcnt(0)" ::: "memory");
            const unsigned og = xb_add(&bar[XB_TOP], 1u);
            const unsigned tg = og / nx;
            if (og + 1u == (tg + 1u) * nx) xb_add(&bar[XB_TOPGEN], 1u);
            else XB_SPIN(xb_ld(&bar[XB_TOPGEN]) == tg, bar);
            __builtin_amdgcn_fence(__ATOMIC_ACQUIRE, "agent");
            xb_add(&bar[XB_XGEN(b.x)], 1u);
            asm volatile("s_waitcnt vmcnt(0)" ::: "memory");
        } else {
            XB_SPIN(xb_ld(&bar[XB_XGEN(b.x)]) == gen, bar);
            __builtin_amdgcn_fence(__ATOMIC_ACQUIRE, "agent");
            asm volatile("s_waitcnt vmcnt(0)" ::: "memory");
        }
    }
    __syncthreads();
}

constexpr int NPHASE = 14;
template <int PH>
DI void run_phase(const P& p, int bid, int nb, unsigned char* smem, int rep = 0) {
    if (PH == 0) phase_prep(p, bid, nb, smem);
    else if (PH == 1) phase_proj(p, bid, nb, smem, rep);
    else if (PH == 2) phase_up(p, bid, nb, smem, rep);
    else if (PH == 3) phase_mixer(p, bid, nb, smem, rep);
    else if (PH == 4) phase_ssdnorm(p, bid, nb, smem);
    else if (PH == 5) phase_wout(p, bid, nb, smem);
    else if (PH == 6) phase_ln1(p, bid, nb, smem);
    else if (PH == 7) phase_xq(p, bid, nb, smem);
    else if (PH == 8) phase_xattn(p, bid, nb, smem, rep);
    else if (PH == 9) phase_xo(p, bid, nb, smem);
    else if (PH == 10) phase_ln2_router(p, bid, nb, smem, rep);
    else if (PH == 11) phase_moe<0>(p, bid, nb, smem);
    else if (PH == 12) phase_moe<1>(p, bid, nb, smem);
    else if (PH == 13) phase_final(p, bid, nb, smem);
}
template <int PH>
__global__ void __launch_bounds__(256, 2) k_phase(P p) {
    __shared__ __attribute__((aligned(16))) unsigned char smem[SMEM_BYTES];
    run_phase<PH>(p, blockIdx.x, gridDim.x, smem);
}

#if MEGA
#ifndef MEGA_WAVES
#define MEGA_WAVES 2
#endif
template <int PH>
DI void mega_steps(const P& p, const XcdBarrier& bar, unsigned char* smem) {
    run_phase<PH>(p, blockIdx.x, gridDim.x, smem);
    if constexpr (((REPEAT_MASK >> PH) & 1) != 0) { xcd_barrier(bar); run_phase<PH>(p, blockIdx.x, gridDim.x, smem, 1); }
    if constexpr (PH == 6 && EXTRA_BARRIERS > 0) { for (int i = 0; i < EXTRA_BARRIERS; ++i) xcd_barrier(bar); }
    if constexpr (PH + 1 < NPHASE) { xcd_barrier(bar); mega_steps<PH + 1>(p, bar, smem); }
}
__global__ void __launch_bounds__(256, MEGA_WAVES) k_mega(P p) {
    __shared__ __attribute__((aligned(16))) unsigned char smem[SMEM_BYTES];
    volatile LAS unsigned* st = (volatile LAS unsigned*)(smem + SMEM_BYTES - 16);
    if (threadIdx.x < 4) st[threadIdx.x] = 0u;
    __syncthreads();
    const XcdBarrier bar = xcd_barrier_post((unsigned*)(p.ws + CTL), st);
    mega_steps<0>(p, bar, smem);
}
#endif
template <int PH>
__global__ void __launch_bounds__(256, 1) k_phase_big(P p) {
    __shared__ __attribute__((aligned(16))) unsigned char smem[SMEM_BYTES];
    run_phase<PH>(p, blockIdx.x, gridDim.x, smem);
}
template <int PH>
static void launch_phase(const P& p, int grid, hipStream_t st) {
    if constexpr (PH == 3 && !P3_SMALL) hipLaunchKernelGGL((k_phase_big<PH>), dim3(grid), dim3(256), 0, st, p);
    else hipLaunchKernelGGL((k_phase<PH>), dim3(grid), dim3(256), 0, st, p);
}

extern "C" void kernel_launch(void* const* d_in, const int* in_sizes, int n_in, void* d_out, int out_size, void* d_ws, size_t ws_size, hipStream_t stream) {
    if (n_in != 31 || out_size != T * D || ws_size < WS_NEED) {
        fprintf(stderr, "kernel_launch: unexpected shapes: n_in %d out %d ws %zu (need %zu)\n", n_in, out_size, ws_size, (size_t)WS_NEED);
        return;
    }
    P p{};
    for (int i = 0; i < 31; ++i) p.in[i] = (const float*)d_in[i];
    p.out = (float*)d_out; p.ws = (unsigned char*)d_ws;
    (void)hipMemsetAsync((unsigned char*)d_ws + CTL, 0, CTL_BYTES, stream);
#if MEGA
    static int grid = 0;
    if (grid == 0) {
        int dev = 0, cus = 0, per_cu = 0;
        (void)hipGetDevice(&dev);
        (void)hipDeviceGetAttribute(&cus, hipDeviceAttributeMultiprocessorCount, dev);
        if (hipOccupancyMaxActiveBlocksPerMultiprocessor(&per_cu, (const void*)k_mega, 256, 0) != hipSuccess || per_cu < 1) { fprintf(stderr, "kernel_launch: occupancy query failed\n"); per_cu = 1; }
        if (per_cu > 2) per_cu = 2;
        grid = cus * per_cu;
        fprintf(stderr, "kernel_launch: mega grid %d (%d CUs x %d)\n", grid, cus, per_cu);
    }
    void* args[] = {(void*)&p};
    const hipError_t le = hipLaunchCooperativeKernel((const void*)k_mega, dim3(grid), dim3(256), args, 0, stream);
    if (le != hipSuccess) fprintf(stderr, "kernel_launch: cooperative launch failed: %s (grid %d)\n", hipGetErrorString(le), grid);
#else
    const int grid = 1024;
    launch_phase<0>(p, grid, stream); launch_phase<1>(p, grid, stream); launch_phase<2>(p, grid, stream); launch_phase<3>(p, grid, stream);
    launch_phase<4>(p, grid, stream); launch_phase<5>(p, grid, stream); launch_phase<6>(p, grid, stream); launch_phase<7>(p, grid, stream);
    launch_phase<8>(p, grid, stream); launch_phase<9>(p, grid, stream); launch_phase<10>(p, grid, stream); launch_phase<11>(p, grid, stream);
    launch_phase<12>(p, grid, stream); launch_phase<13>(p, grid, stream);
#endif
}
```

```cpp
#include <hip/hip_runtime.h>
#include <stdint.h>
#include <stdio.h>

#ifndef MEGA
#define MEGA 1
#endif
#ifndef ATTN_NAIVE
#define ATTN_NAIVE 0
#endif
#ifndef XATTN_NAIVE
#define XATTN_NAIVE 0
#endif
#ifndef SSD_NAIVE
#define SSD_NAIVE 0
#endif
#ifndef P3_SMALL
#define P3_SMALL 1
#endif
#ifndef NO_SSD
#define NO_SSD 0
#endif
#ifndef NO_FLASH
#define NO_FLASH 0
#endif
#ifndef GEMM_GLDS
#define GEMM_GLDS 1
#endif
#ifndef EXTRA_BARRIERS
#define EXTRA_BARRIERS 0
#endif
#ifndef SSD_PM
#define SSD_PM 0
#endif
#ifndef REPEAT_MASK
#define REPEAT_MASK 0
#endif
#ifndef REP_MODE
#define REP_MODE 0
#endif
#ifndef MFMA16
#define MFMA16 1
#endif
#ifndef GEMM_DIRECT
#define GEMM_DIRECT 0
#endif

typedef unsigned short bf16_t;
typedef short bf16x8 __attribute__((ext_vector_type(8)));
typedef float f32x16 __attribute__((ext_vector_type(16)));
typedef float f32x4v __attribute__((ext_vector_type(4)));
#define DI __device__ __forceinline__
#define LAS __attribute__((address_space(3)))
#define MFMA32(a, b, c) __builtin_amdgcn_mfma_f32_32x32x16_bf16((a), (b), (c), 0, 0, 0)

constexpr int Bn = 16, S = 2048, T = Bn * S, D = 1024;
constexpr int NMEM = 256;
constexpr float EPS = 1e-5f;
constexpr float ALPHA = 1.189207115002721f;
constexpr float LOG2E = 1.4426950408889634f;
constexpr float QSCALE = 0.10206207261596577f * LOG2E;
constexpr float XSCALE = 0.0625f * LOG2E;
constexpr int NEXP = 32;
constexpr int MAXSLOTS = 69632;

constexpr size_t MiB = 1u << 20;
constexpr size_t W_IN = 0;
constexpr size_t W_QUP = W_IN + 4 * MiB;
constexpr size_t W_KVUP = W_QUP + 768 * 256 * 2;
constexpr size_t W_OUT = W_KVUP + 1024 * 128 * 2;
constexpr size_t W_XQ = W_OUT + 2 * MiB;
constexpr size_t W_XKV = W_XQ + 2 * MiB;
constexpr size_t W_XO = W_XKV + 4 * MiB;
constexpr size_t W_GU = W_XO + 2 * MiB;
constexpr size_t W_DN = W_GU + 32 * MiB;
constexpr size_t W_RT = W_DN + 16 * MiB;
constexpr size_t ROPE_C = W_RT + 48 * 1024 * 4;
constexpr size_t ROPE_S = ROPE_C + 2048 * 16 * 4;
constexpr size_t TOK_GATE = ROPE_S + 2048 * 16 * 4;
constexpr size_t CTL = TOK_GATE + (size_t)T * 2 * 4;
constexpr size_t CTL_BYTES = 32768;
constexpr size_t CTL_CNT = 16384;
constexpr int CNT_STRIDE = 64;
constexpr size_t CTL_QUEUE = 28672;
constexpr size_t CTL_RTAUX = 30720;
static_assert(CTL + CTL_BYTES <= 64 * MiB, "weights region overflow");
constexpr size_t RA = 64 * MiB, RB = 192 * MiB, RC = 320 * MiB, RD = 448 * MiB, WS_NEED = 512 * MiB;
constexpr size_t XBC = RA;
constexpr size_t KX = RA + 64 * MiB;
constexpr size_t VXT = KX + 8 * MiB;
constexpr size_t YB = RA;
constexpr size_t QB = RB;
constexpr size_t KNB = RB + 48 * MiB;
constexpr size_t VTB = KNB + 32 * MiB;
constexpr size_t H1 = RB;
constexpr size_t H2 = RB;
constexpr size_t XB = RC;
constexpr size_t MEMB = RB;
constexpr size_t XBCA = RC;
constexpr size_t MIX = RC + 64 * MiB;
constexpr size_t H1B = RC;
constexpr size_t QX = RC + 64 * MiB;
constexpr size_t OX = RB;
constexpr size_t H2B = RC;
constexpr size_t HDN = RC + 64 * MiB;
constexpr size_t CQ = RD;
constexpr size_t CKV = CQ + 16 * MiB;
constexpr size_t KROPE = CKV + 8 * MiB;
constexpr size_t DTB = KROPE + 2 * MiB;
constexpr size_t ZB = DTB + 1 * MiB;
constexpr size_t SSQ = ZB + 32 * MiB;
constexpr size_t LISTS = RD;
static_assert(SSQ + 3 * (size_t)T * 4 <= WS_NEED, "region D overflow");

struct P {
    const float* in[31];
    float* out;
    unsigned char* ws;
};

typedef __bf16 hbf16x2 __attribute__((ext_vector_type(2)));
typedef float f32x2 __attribute__((ext_vector_type(2)));
DI bf16_t f2bf(float x) { return __builtin_bit_cast(bf16_t, (__bf16)x); }
DI float bf2f(bf16_t b) { return __uint_as_float(((unsigned)b) << 16); }
DI float bflo(unsigned w) { return __uint_as_float(w << 16); }
DI float bfhi(unsigned w) { return __uint_as_float(w & 0xffff0000u); }
DI unsigned pack2(float a, float b) { f32x2 v = {a, b}; return __builtin_bit_cast(unsigned, __builtin_convertvector(v, hbf16x2)); }
DI float siluf(float x) { return x * __builtin_amdgcn_rcpf(1.f + __expf(-x)); }
DI float softplusf(float x) {
    const float zz = __expf(-fabsf(x));
    const float l1p = zz < 0.01f ? zz * (1.f - zz * (0.5f - zz * (1.f / 3.f))) : __logf(1.f + zz);
    return fmaxf(x, 0.f) + l1p;
}
DI int tidx() { int t = __builtin_amdgcn_workitem_id_x(); asm volatile("" : "+v"(t)); return t; }
DI int crow(int reg, int h) { return (reg & 3) + 8 * (reg >> 2) + 4 * h; }
constexpr int CS_LD = 132;
DI float4 cs4(const float* Cs, int row, int col) { return *(const float4*)(Cs + row * CS_LD + col); }
DI uint2 pack4(float4 v) { uint2 w; w.x = pack2(v.x, v.y); w.y = pack2(v.z, v.w); return w; }
DI float wave_sum(float v) {
#pragma unroll
    for (int o = 32; o >= 1; o >>= 1) v += __shfl_xor(v, o);
    return v;
}
DI float wave_max(float v) {
#pragma unroll
    for (int o = 32; o >= 1; o >>= 1) v = fmaxf(v, __shfl_xor(v, o));
    return v;
}

constexpr int LDS_ROW = 144;
constexpr int TILE_BYTES = 128 * LDS_ROW;
constexpr int GEMM_LDS = 4 * TILE_BYTES;
constexpr int SMEM_BYTES = GEMM_LDS + 3072;
static_assert(128 * CS_LD * 4 <= GEMM_LDS, "epilogue tile");

struct GemmArgs {
    const bf16_t* A; int lda;
    const bf16_t* Bt; int ldb;
    int K;
    const int* lrows;
};

template <class Epi>
DI void gemm_tile(const GemmArgs& g, int m0, int n0, Epi& epi, unsigned char* smem) {
    const int tid = tidx(), lane = tid & 63, wave = tid >> 6, wr = wave >> 1, wc = wave & 1;
    const int r = lane & 31, h = lane >> 5;
    f32x16 acc[2][2];
#pragma unroll
    for (int i = 0; i < 2; ++i)
#pragma unroll
        for (int j = 0; j < 2; ++j)
#pragma unroll
            for (int e = 0; e < 16; ++e) acc[i][j][e] = 0.f;
    const int nk = g.K >> 6;
#if MFMA16
    f32x4v acc16[4][4];
#pragma unroll
    for (int m = 0; m < 4; ++m)
#pragma unroll
        for (int n = 0; n < 4; ++n) acc16[m][n] = (f32x4v){0.f, 0.f, 0.f, 0.f};
#endif
#if GEMM_DIRECT
    {
        const bf16_t* ap[2]; const bf16_t* bp[2];
#pragma unroll
        for (int i = 0; i < 2; ++i) {
            const int lr = wr * 64 + i * 32 + r;
            const int grow = g.lrows ? g.lrows[lr] : (m0 + lr);
            ap[i] = g.A + (size_t)grow * g.lda + 8 * h;
            bp[i] = g.Bt + (size_t)(n0 + wc * 64 + i * 32 + r) * g.ldb + 8 * h;
        }
        for (int k = 0; k < g.K; k += 16) {
            bf16x8 a[2], b[2];
#pragma unroll
            for (int i = 0; i < 2; ++i) { a[i] = *(const bf16x8*)(ap[i] + k); b[i] = *(const bf16x8*)(bp[i] + k); }
#pragma unroll
            for (int i = 0; i < 2; ++i)
#pragma unroll
                for (int j = 0; j < 2; ++j) acc[i][j] = MFMA32(a[i], b[j], acc[i][j]);
        }
    }
#elif GEMM_GLDS
    {
        constexpr int STG = 32768, TB = 16384;
        const int srow = tid >> 3, sch = (tid & 7) ^ ((srow >> 1) & 7);
        const bf16_t* ag[4]; const bf16_t* bg[4];
#pragma unroll
        for (int i = 0; i < 4; ++i) {
            const int lr = srow + 32 * i;
            const int grow = g.lrows ? g.lrows[lr] : (m0 + lr);
            ag[i] = g.A + (size_t)grow * g.lda + sch * 8;
            bg[i] = g.Bt + (size_t)(n0 + lr) * g.ldb + sch * 8;
        }
#define GLDS_STAGE(BUF, KO) do { unsigned char* _d = (BUF) + wave * 1024; \
        _Pragma("unroll") for (int i = 0; i < 4; ++i) { \
            __builtin_amdgcn_global_load_lds((const unsigned*)(ag[i] + (KO)), (LAS unsigned*)(_d + i * 4096), 16, 0, 0); \
            __builtin_amdgcn_global_load_lds((const unsigned*)(bg[i] + (KO)), (LAS unsigned*)(_d + TB + i * 4096), 16, 0, 0); } } while (0)
        __syncthreads();
        GLDS_STAGE(smem, 0);
        epi.prefetch(m0, n0, tid);
        const int y16 = (h ^ ((r >> 1) & 7)) << 4;
        const int o0 = y16, o1 = 32 ^ y16, o2 = 64 ^ y16, o3 = 96 ^ y16;
        const int arow = (wr * 64 + r) * 128, brow = TB + (wc * 64 + r) * 128;
        __syncthreads();
#if MFMA16
        const int i16 = lane & 15, g16 = lane >> 4;
        const int p0 = ((g16 ^ (i16 >> 1)) << 4), p1 = p0 ^ 64;
        const int arow16 = (wr * 64 + i16) * 128, brow16 = TB + (wc * 64 + i16) * 128;
        for (int kt = 0; kt < nk; ++kt) {
            const unsigned char* cur = smem + (kt & 1) * STG;
            if (kt + 1 < nk) GLDS_STAGE(smem + ((kt + 1) & 1) * STG, (kt + 1) * 64);
#pragma unroll
            for (int s = 0; s < 2; ++s) {
                const int po = s ? p1 : p0;
                bf16x8 fa[4], fb[4];
#pragma unroll
                for (int m = 0; m < 4; ++m) { fa[m] = *(const bf16x8*)(cur + arow16 + m * 16 * 128 + po); fb[m] = *(const bf16x8*)(cur + brow16 + m * 16 * 128 + po); }
#pragma unroll
                for (int m = 0; m < 4; ++m)
#pragma unroll
                    for (int n = 0; n < 4; ++n) acc16[m][n] = __builtin_amdgcn_mfma_f32_16x16x32_bf16(fa[m], fb[n], acc16[m][n], 0, 0, 0);
            }
            __syncthreads();
        }
#else
        for (int kt = 0; kt < nk; ++kt) {
            const unsigned char* cur = smem + (kt & 1) * STG;
            if (kt + 1 < nk) GLDS_STAGE(smem + ((kt + 1) & 1) * STG, (kt + 1) * 64);
            bf16x8 fa[4][2], fb[4][2];
#define KLOAD(S, OFF) do { \
                fa[S][0] = *(const bf16x8*)(cur + arow + (OFF)); fa[S][1] = *(const bf16x8*)(cur + arow + 32 * 128 + (OFF)); \
                fb[S][0] = *(const bf16x8*)(cur + brow + (OFF)); fb[S][1] = *(const bf16x8*)(cur + brow + 32 * 128 + (OFF)); } while (0)
            KLOAD(0, o0); KLOAD(1, o1); KLOAD(2, o2); KLOAD(3, o3);
#undef KLOAD
#pragma unroll
            for (int s = 0; s < 4; ++s) {
                acc[0][0] = MFMA32(fa[s][0], fb[s][0], acc[0][0]); acc[0][1] = MFMA32(fa[s][0], fb[s][1], acc[0][1]);
                acc[1][0] = MFMA32(fa[s][1], fb[s][0], acc[1][0]); acc[1][1] = MFMA32(fa[s][1], fb[s][1], acc[1][1]);
            }
            __builtin_amdgcn_sched_group_barrier(0x100, 8, 0); __builtin_amdgcn_sched_group_barrier(0x8, 4, 0);
            __builtin_amdgcn_sched_group_barrier(0x100, 4, 0); __builtin_amdgcn_sched_group_barrier(0x8, 4, 0);
            __builtin_amdgcn_sched_group_barrier(0x100, 4, 0); __builtin_amdgcn_sched_group_barrier(0x8, 8, 0);
#define KSTEP(OFF)
#undef KSTEP
            __syncthreads();
        }
#endif
#undef GLDS_STAGE
    }
#else
    {
        const int srow = tid >> 3, sch = tid & 7;
        const bf16_t* ag[4]; const bf16_t* bg[4];
#pragma unroll
        for (int i = 0; i < 4; ++i) {
            const int lr = srow + 32 * i;
            const int grow = g.lrows ? g.lrows[lr] : (m0 + lr);
            ag[i] = g.A + (size_t)grow * g.lda + sch * 8;
            bg[i] = g.Bt + (size_t)(n0 + lr) * g.ldb + sch * 8;
        }
        const int soff = srow * LDS_ROW + sch * 16;
        uint4 ra0, ra1, ra2, ra3, rb0, rb1, rb2, rb3;
#define G_LOAD(KO) do { ra0 = *(const uint4*)(ag[0] + (KO)); ra1 = *(const uint4*)(ag[1] + (KO)); ra2 = *(const uint4*)(ag[2] + (KO)); ra3 = *(const uint4*)(ag[3] + (KO)); \
                        rb0 = *(const uint4*)(bg[0] + (KO)); rb1 = *(const uint4*)(bg[1] + (KO)); rb2 = *(const uint4*)(bg[2] + (KO)); rb3 = *(const uint4*)(bg[3] + (KO)); } while (0)
#define L_STORE(BUF) do { unsigned char* _d = (BUF) + soff; \
        *(uint4*)(_d) = ra0; *(uint4*)(_d + 32 * LDS_ROW) = ra1; *(uint4*)(_d + 64 * LDS_ROW) = ra2; *(uint4*)(_d + 96 * LDS_ROW) = ra3; \
        *(uint4*)(_d + TILE_BYTES) = rb0; *(uint4*)(_d + TILE_BYTES + 32 * LDS_ROW) = rb1; *(uint4*)(_d + TILE_BYTES + 64 * LDS_ROW) = rb2; *(uint4*)(_d + TILE_BYTES + 96 * LDS_ROW) = rb3; } while (0)
        G_LOAD(0);
        __syncthreads();
        L_STORE(smem);
        __syncthreads();
        const int aoff = (wr * 64 + r) * LDS_ROW + h * 16;
        const int boff = TILE_BYTES + (wc * 64 + r) * LDS_ROW + h * 16;
        for (int kt = 0; kt < nk; ++kt) {
            const unsigned char* cur = smem + (kt & 1) * 2 * TILE_BYTES;
            unsigned char* nxt = smem + ((kt + 1) & 1) * 2 * TILE_BYTES;
            const bool more = (kt + 1 < nk);
            if (more) G_LOAD((kt + 1) * 64);
#pragma unroll
            for (int ks = 0; ks < 4; ++ks) {
                const bf16x8 a0 = *(const bf16x8*)(cur + aoff + ks * 32);
                const bf16x8 a1 = *(const bf16x8*)(cur + aoff + 32 * LDS_ROW + ks * 32);
                const bf16x8 b0 = *(const bf16x8*)(cur + boff + ks * 32);
                const bf16x8 b1 = *(const bf16x8*)(cur + boff + 32 * LDS_ROW + ks * 32);
                acc[0][0] = MFMA32(a0, b0, acc[0][0]); acc[0][1] = MFMA32(a0, b1, acc[0][1]);
                acc[1][0] = MFMA32(a1, b0, acc[1][0]); acc[1][1] = MFMA32(a1, b1, acc[1][1]);
            }
            if (more) L_STORE(nxt);
            __syncthreads();
        }
#undef G_LOAD
#undef L_STORE
    }
#endif
    float* Cs = (float*)smem;
#if GEMM_DIRECT
    __syncthreads();
#endif
#if !MFMA16
#pragma unroll
    for (int i = 0; i < 2; ++i)
#pragma unroll
        for (int j = 0; j < 2; ++j)
#pragma unroll
            for (int e = 0; e < 16; ++e) Cs[(wr * 64 + i * 32 + crow(e, h)) * CS_LD + wc * 64 + j * 32 + r] = acc[i][j][e];
#else
#pragma unroll
    for (int m = 0; m < 4; ++m)
#pragma unroll
        for (int n = 0; n < 4; ++n)
#pragma unroll
            for (int e = 0; e < 4; ++e) Cs[(wr * 64 + m * 16 + 4 * (lane >> 4) + e) * CS_LD + wc * 64 + n * 16 + (lane & 15)] = acc16[m][n][e];
#endif
    __syncthreads();
    epi(Cs, m0, n0, tid);
}

DI int vbid(int bid, int nb) { return (nb % 8 == 0) ? (bid % 8) * (nb / 8) + bid / 8 : bid; }

DI int colmap_in(int n) {
    if (n < 384) return n;
    if (n < 896) return 416 + (n - 384);
    if (n < 1920) return 928 + (n - 896);
    if (n < 1952) return 384 + (n - 1920);
    if (n < 1960) return n;
    return -1;
}
template <int KIND>
DI void tconv_tile(const float* src, const float* src2, int ldsrc, bf16_t* dst, int K, int k0, int n0, const float* scale, int scale_from, unsigned char* smem) {
    float* tile = (float*)smem;
    const int t = tidx();
    __syncthreads();
#pragma unroll 4
    for (int i = 0; i < 16; ++i) {
        const int k = i * 4 + (t >> 6), n = t & 63;
        const int nd = n0 + n;
        float v = 0.f;
        if (KIND == 1) { const int c = colmap_in(nd); if (c >= 0) v = src[(size_t)(k0 + k) * ldsrc + c]; }
        else if (KIND == 2) {
            const int j = nd >> 7, wc = (nd >> 6) & 1, isup = (nd >> 5) & 1, ii = nd & 31;
            const int c = 64 * j + 32 * wc + ii;
            v = (isup ? src2 : src)[(size_t)(k0 + k) * ldsrc + c];
        } else v = src[(size_t)(k0 + k) * ldsrc + nd];
        if (scale && (k0 + k) >= scale_from) v *= scale[k0 + k - scale_from];
        tile[k * 65 + n] = v;
    }
    __syncthreads();
#pragma unroll 4
    for (int i = 0; i < 16; ++i) {
        const int n = i * 4 + (t >> 6), k = t & 63;
        dst[(size_t)(n0 + n) * K + k0 + k] = f2bf(tile[k * 65 + n]);
    }
}

constexpr int PJ0 = 512, PJ1 = PJ0 + 48, PJ2 = PJ1 + 32, PJ3 = PJ2 + 256, PJ4 = PJ3 + 256, PJ5 = PJ4 + 256, PJ6 = PJ5 + 256, PJ7 = PJ6 + 256, PJ8 = PJ7 + 4096, PJ9 = PJ8 + 2048;
DI void prep_tile(const P& p, int t, unsigned char* smem) {
    unsigned char* ws = p.ws;
    if (t < PJ0) { const int kt = t >> 5, ntl = t & 31; tconv_tile<1>(p.in[2], nullptr, 1960, (bf16_t*)(ws + W_IN), 1024, kt * 64, ntl * 64, nullptr, 0, smem); }
    else if (t < PJ1) { const int u = t - PJ0, kt = u / 12, ntl = u % 12; tconv_tile<0>(p.in[4], nullptr, 768, (bf16_t*)(ws + W_QUP), 256, kt * 64, ntl * 64, p.in[3], 0, smem); }
    else if (t < PJ2) { const int u = t - PJ1, kt = u >> 4, ntl = u & 15; tconv_tile<0>(p.in[6], nullptr, 1024, (bf16_t*)(ws + W_KVUP), 128, kt * 64, ntl * 64, p.in[5], 0, smem); }
    else if (t < PJ3) { const int u = t - PJ2, kt = u >> 4, ntl = u & 15; tconv_tile<0>(p.in[13], nullptr, 1024, (bf16_t*)(ws + W_OUT), 1024, kt * 64, ntl * 64, p.in[12], 512, smem); }
    else if (t < PJ4) { const int u = t - PJ3, kt = u >> 4, ntl = u & 15; tconv_tile<0>(p.in[16], nullptr, 1024, (bf16_t*)(ws + W_XQ), 1024, kt * 64, ntl * 64, nullptr, 0, smem); }
    else if (t < PJ5) { const int u = t - PJ4, kt = u >> 4, ntl = u & 15; tconv_tile<0>(p.in[17], nullptr, 1024, (bf16_t*)(ws + W_XKV), 1024, kt * 64, ntl * 64, nullptr, 0, smem); }
    else if (t < PJ6) { const int u = t - PJ5, kt = u >> 4, ntl = u & 15; tconv_tile<0>(p.in[18], nullptr, 1024, (bf16_t*)(ws + W_XKV) + (size_t)1024 * 1024, 1024, kt * 64, ntl * 64, nullptr, 0, smem); }
    else if (t < PJ7) { const int u = t - PJ6, kt = u >> 4, ntl = u & 15; tconv_tile<0>(p.in[19], nullptr, 1024, (bf16_t*)(ws + W_XO), 1024, kt * 64, ntl * 64, nullptr, 0, smem); }
    else if (t < PJ8) { const int u = t - PJ7, e = u >> 7, v = u & 127, kt = v >> 3, ntl = v & 7;
        tconv_tile<2>(p.in[26] + (size_t)e * 1024 * 256, p.in[27] + (size_t)e * 1024 * 256, 256, (bf16_t*)(ws + W_GU) + (size_t)e * 512 * 1024, 1024, kt * 64, ntl * 64, nullptr, 0, smem); }
    else { const int u = t - PJ8, e = u >> 6, v = u & 63, kt = v >> 4, ntl = v & 15;
        tconv_tile<0>(p.in[28] + (size_t)e * 256 * 1024, nullptr, 1024, (bf16_t*)(ws + W_DN) + (size_t)e * 1024 * 256, 256, kt * 64, ntl * 64, nullptr, 0, smem); }
}
constexpr int LATE_A0 = PJ2, LATE_A1 = PJ4, LATE_B0 = PJ6, LATE_B1 = PJ9, N_LATE = (LATE_A1 - LATE_A0) + (LATE_B1 - LATE_B0), LATE_GROUP = 4, N_LATE_ITEMS = (N_LATE + LATE_GROUP - 1) / LATE_GROUP;
DI void phase_prep(const P& p, int bid, int nb, unsigned char* smem) {
    unsigned char* ws = p.ws;
    const int tid = tidx();
    constexpr int N_EARLY = LATE_A0 + (LATE_B0 - LATE_A1);
    for (int u = bid; u < N_EARLY; u += nb) prep_tile(p, u < LATE_A0 ? u : u - LATE_A0 + LATE_A1, smem);
    {
        const size_t gsz = (size_t)nb * 256, g0 = (size_t)bid * 256 + tid;
        bf16_t* xb = (bf16_t*)p.out;
        const float4* x4 = (const float4*)p.in[0];
        for (size_t i = g0; i < (size_t)T * D / 4; i += gsz) { const float4 v = x4[i]; uint2 o; o.x = pack2(v.x, v.y); o.y = pack2(v.z, v.w); ((uint2*)xb)[i] = o; }
        bf16_t* mb = (bf16_t*)(ws + MEMB);
        const float4* m4 = (const float4*)p.in[1];
        for (size_t i = g0; i < (size_t)Bn * NMEM * D / 4; i += gsz) { const float4 v = m4[i]; uint2 o; o.x = pack2(v.x, v.y); o.y = pack2(v.z, v.w); ((uint2*)mb)[i] = o; }
        float* wrt = (float*)(ws + W_RT);
        for (size_t i = g0; i < 48 * 1024; i += gsz) {
            const int j = (int)(i >> 10), k = (int)(i & 1023);
            float v = 0.f;
            if (j < 4) v = p.in[22][k * 4 + j]; else if (j < 36) v = p.in[24][k * 32 + (j - 4)];
            v *= p.in[20][k];
            const bf16_t hi = f2bf(v), lo = f2bf(v - bf2f(hi));
            ((bf16_t*)wrt)[i] = hi; ((bf16_t*)wrt)[48 * 1024 + i] = lo;
        }
        {
            float* aux = (float*)(ws + CTL + CTL_RTAUX);
            const int lane = tid & 63, wave = tid >> 6;
            for (int j = bid * 4 + wave; j < 48; j += nb * 4) {
                float sw = 0.f, cbv = 0.f;
                for (int k = lane; k < 1024; k += 64) {
                    float w = 0.f;
                    if (j < 4) w = p.in[22][k * 4 + j]; else if (j < 36) w = p.in[24][k * 32 + (j - 4)];
                    sw += w * p.in[20][k]; cbv += w * p.in[21][k];
                }
                sw = wave_sum(sw); cbv = wave_sum(cbv);
                if (lane == 0) { aux[j] = sw; aux[48 + j] = cbv + (j < 4 ? p.in[23][j] : j < 36 ? p.in[25][j - 4] : 0.f); }
            }
        }
        float* rc = (float*)(ws + ROPE_C); float* rs = (float*)(ws + ROPE_S);
        for (size_t i = g0; i < 2048 * 16; i += gsz) {
            const int pos = (int)(i >> 4), f = (int)(i & 15);
            const float inv = powf(10000.f, -(float)f / 16.f);
            const float ang = (float)pos * inv;
            const double a = (double)ang;
            const double k2 = rint(a * 0.15915494309189535);
            const float rr = (float)(a - k2 * 6.283185307179586);
            rc[i] = cosf(rr); rs[i] = sinf(rr);
        }
    }
}

struct EpiProj {
    bf16_t *cq, *ckv, *z, *xbc, *krope; float* dt; const float *rc, *rs, *dtb; float* ssq;
    DI void prefetch(int, int, int) {}
    DI void operator()(const float* Cs, int m0, int n0, int tid) const {
        const int c4 = (tid & 31) * 4, r0 = tid >> 5;
        if (n0 < 1920) {
            bf16_t* dst; int ld, cofs;
            if (n0 < 256) { dst = cq; ld = 256; cofs = n0; } else if (n0 < 384) { dst = ckv; ld = 128; cofs = n0 - 256; }
            else if (n0 < 896) { dst = z; ld = 512; cofs = n0 - 384; } else { dst = xbc; ld = 1024; cofs = n0 - 896; }
            if (n0 < 384) {
                float* sq = ssq + (size_t)(n0 >> 7) * T + m0;
#pragma unroll 4
                for (int ps = 0; ps < 16; ++ps) {
                    const int row = ps * 8 + r0; const float4 v = cs4(Cs, row, c4);
                    *(uint2*)(dst + (size_t)(m0 + row) * ld + cofs + c4) = pack4(v);
                    float ss = (v.x * v.x + v.y * v.y) + (v.z * v.z + v.w * v.w);
#pragma unroll
                    for (int o = 16; o >= 1; o >>= 1) ss += __shfl_xor(ss, o);
                    if ((tid & 31) == 0) sq[row] = ss;
                }
            } else {
#pragma unroll 4
            for (int ps = 0; ps < 16; ++ps) { const int row = ps * 8 + r0; *(uint2*)(dst + (size_t)(m0 + row) * ld + cofs + c4) = pack4(cs4(Cs, row, c4)); }
            }
        } else {
#pragma unroll
            for (int ps = 0; ps < 4; ++ps) {
                const int it = ps * 256 + tid, row = it >> 3, cc = (it & 7) * 4, grow = m0 + row;
                const float4 v = cs4(Cs, row, cc), pv = cs4(Cs, row, cc ^ 16);
                const int pos = grow & 2047, f = cc & 15;
                const float4 c = *(const float4*)(rc + pos * 16 + f), s = *(const float4*)(rs + pos * 16 + f);
                float4 o;
                if (cc < 16) { o.x = v.x * c.x - pv.x * s.x; o.y = v.y * c.y - pv.y * s.y; o.z = v.z * c.z - pv.z * s.z; o.w = v.w * c.w - pv.w * s.w; }
                else { o.x = v.x * c.x + pv.x * s.x; o.y = v.y * c.y + pv.y * s.y; o.z = v.z * c.z + pv.z * s.z; o.w = v.w * c.w + pv.w * s.w; }
                *(uint2*)(krope + (size_t)grow * 32 + cc) = pack4(o);
            }
#pragma unroll
            for (int ps = 0; ps < 4; ++ps) {
                const int it = ps * 256 + tid, row = it >> 3, cc = it & 7;
                dt[(size_t)(m0 + row) * 8 + cc] = softplusf(Cs[row * CS_LD + 32 + cc] + dtb[cc]);
            }
        }
    }
};
struct EpiMemKV {
    bf16_t *kx, *vxt;
    DI void prefetch(int, int, int) {}
    DI void operator()(const float* Cs, int m0, int n0, int tid) const {
        const int b = m0 >> 8, mm0 = m0 & 255;
        if (n0 < 1024) {
            const int c4 = (tid & 31) * 4, r0 = tid >> 5, hd = n0 >> 8, d = (n0 & 255) + c4;
#pragma unroll 4
            for (int ps = 0; ps < 16; ++ps) { const int row = ps * 8 + r0; *(uint2*)(kx + ((size_t)(b * 4 + hd) * 256 + mm0 + row) * 256 + d) = pack4(cs4(Cs, row, c4)); }
        } else {
            const int c2 = n0 - 1024, hd = c2 >> 8;
#pragma unroll 2
            for (int ps = 0; ps < 8; ++ps) {
                const int it = ps * 256 + tid, col = it & 127, rg = it >> 7, d = (c2 & 255) + col;
                uint4 w;
                w.x = pack2(Cs[(rg * 8 + 0) * CS_LD + col], Cs[(rg * 8 + 1) * CS_LD + col]); w.y = pack2(Cs[(rg * 8 + 2) * CS_LD + col], Cs[(rg * 8 + 3) * CS_LD + col]);
                w.z = pack2(Cs[(rg * 8 + 4) * CS_LD + col], Cs[(rg * 8 + 5) * CS_LD + col]); w.w = pack2(Cs[(rg * 8 + 6) * CS_LD + col], Cs[(rg * 8 + 7) * CS_LD + col]);
                *(uint4*)(vxt + ((size_t)(b * 4 + hd) * 256 + d) * 256 + mm0 + rg * 8) = w;
            }
        }
    }
};
DI void phase_proj(const P& p, int bid, int nb, unsigned char* smem, int rep = 0) {
    unsigned char* ws = p.ws;
    const int v = vbid(bid, nb);
    const bf16_t* xb = (const bf16_t*)p.out;
    EpiProj e1{(bf16_t*)(ws + CQ), (bf16_t*)(ws + CKV), (bf16_t*)(ws + ZB), (bf16_t*)(ws + XBC), (bf16_t*)(ws + KROPE), (float*)(ws + DTB),
               (const float*)(ws + ROPE_C), (const float*)(ws + ROPE_S), p.in[9], (float*)(ws + SSQ)};
    EpiMemKV e2{(bf16_t*)(ws + KX), (bf16_t*)(ws + VXT)};
    constexpr int NT1 = 256 * 16, NT2 = 32 * 16;
    for (int t = v; t < NT1 + NT2; t += nb) {
        if (rep && REP_MODE == 1 && t >= NT1) continue;
        if (rep && REP_MODE == 2 && t < NT1) continue;
        if (rep && REP_MODE == 3 && !(t < NT1 && (t & 7) == 7 && ((t >> 6) & 1))) continue;
        if (rep && REP_MODE == 4 && !(t < NT1 && ((t >> 6) & 1) == 0)) continue;
        const int u = t < NT1 ? t : t - NT1, c = u >> 6, j = u & 63, mt = (c >> 1) * 8 + (j >> 3), ntl = (c & 1) * 8 + (j & 7);
        if (t < NT1) { GemmArgs g{xb, 1024, (const bf16_t*)(ws + W_IN), 1024, 1024, nullptr}; gemm_tile(g, mt * 128, ntl * 128, e1, smem); }
        else { GemmArgs g{(const bf16_t*)(ws + MEMB), 1024, (const bf16_t*)(ws + W_XKV), 1024, 1024, nullptr}; gemm_tile(g, mt * 128, ntl * 128, e2, smem); }
    }
}

struct EpiQup {
    bf16_t* q; const float* ssq; float* rms;
    DI void prefetch(int m0, int, int tid) { if (tid < 128) rms[tid] = rsqrtf((ssq[m0 + tid] + ssq[(size_t)T + m0 + tid]) * (1.f / 256.f) + EPS); }
    DI void operator()(const float* Cs, int m0, int n0, int tid) const {
        const int c4 = (tid & 31) * 4, r0 = tid >> 5;
        const int col = n0 + c4, head = col / 96, d = col - head * 96;
        const int b = m0 >> 11, s0 = m0 & 2047;
#pragma unroll 4
        for (int ps = 0; ps < 16; ++ps) {
            const int row = ps * 8 + r0;
            const float sc = rms[row] * QSCALE;
            float4 v = cs4(Cs, row, c4);
            v.x *= sc; v.y *= sc; v.z *= sc; v.w *= sc;
            *(uint2*)(q + ((size_t)(b * 8 + head) * 2048 + s0 + row) * 96 + d) = pack4(v);
        }
    }
};
struct EpiKVup {
    bf16_t *kn, *vt; const float* ssq; float* rms;
    DI void prefetch(int m0, int, int tid) { if (tid < 128) rms[tid] = rsqrtf(ssq[2 * (size_t)T + m0 + tid] * (1.f / 128.f) + EPS); }
    DI void operator()(const float* Cs, int m0, int n0, int tid) const {
        const int head = n0 >> 7, b = m0 >> 11, s0 = m0 & 2047;
#pragma unroll 4
        for (int ps = 0; ps < 8; ++ps) {
            const int it = ps * 256 + tid, row = it >> 4, c4 = (it & 15) * 4;
            const float sc = rms[row];
            float4 v = cs4(Cs, row, c4); v.x *= sc; v.y *= sc; v.z *= sc; v.w *= sc;
            *(uint2*)(kn + ((size_t)(b * 8 + head) * 2048 + s0 + row) * 64 + c4) = pack4(v);
        }
#pragma unroll 2
        for (int ps = 0; ps < 4; ++ps) {
            const int it = ps * 256 + tid, dv = it & 63, rg = it >> 6;
            const float* cp = Cs + (rg * 8) * CS_LD + 64 + dv; const float* rp = rms + rg * 8;
            uint4 w;
            w.x = pack2(cp[0] * rp[0], cp[CS_LD] * rp[1]); w.y = pack2(cp[2 * CS_LD] * rp[2], cp[3 * CS_LD] * rp[3]);
            w.z = pack2(cp[4 * CS_LD] * rp[4], cp[5 * CS_LD] * rp[5]); w.w = pack2(cp[6 * CS_LD] * rp[6], cp[7 * CS_LD] * rp[7]);
            *(uint4*)(vt + ((size_t)(b * 8 + head) * 64 + dv) * 2048 + s0 + rg * 8) = w;
        }
    }
};
DI void phase_up(const P& p, int bid, int nb, unsigned char* smem, int rep = 0) {
    unsigned char* ws = p.ws;
    const int v = vbid(bid, nb);
    float* rms = (float*)(smem + GEMM_LDS);
    constexpr int NTQ = 256 * 6, NTKV = 256 * 8;
    for (int t = v; t < NTQ + NTKV; t += nb) {
        if (rep && REP_MODE == 1) break;
        if (rep && REP_MODE == 2 && t >= NTQ) break;
        if (rep && REP_MODE == 3 && t < NTQ) continue;
        if (t < NTQ) {
            const int mt = t / 6, ntl = t % 6;
            EpiQup e{(bf16_t*)(ws + QB), (const float*)(ws + SSQ), rms};
            GemmArgs g{(const bf16_t*)(ws + CQ), 256, (const bf16_t*)(ws + W_QUP), 256, 256, nullptr};
            gemm_tile(g, mt * 128, ntl * 128, e, smem);
        } else {
            const int u = t - NTQ, mt = u >> 3, ntl = u & 7;
            EpiKVup e{(bf16_t*)(ws + KNB), (bf16_t*)(ws + VTB), (const float*)(ws + SSQ), rms};
            GemmArgs g{(const bf16_t*)(ws + CKV), 128, (const bf16_t*)(ws + W_KVUP), 128, 128, nullptr};
            gemm_tile(g, mt * 128, ntl * 128, e, smem);
        }
    }
    if (!(rep && REP_MODE >= 2)) {
        const bf16_t* xbc = (const bf16_t*)(ws + XBC); bf16_t* xa = (bf16_t*)(ws + XBCA);
        const float* cw = p.in[7]; const float* cb = p.in[8];
        const size_t gsz = (size_t)nb * 256;
        for (size_t i = (size_t)bid * 256 + tidx(); i < (size_t)(T / 4) * 128; i += gsz) {
            const int tk0 = (int)(i >> 7) * 4, c0 = (int)(i & 127) * 8, s0 = tk0 & 2047;
            float w[4][8], bias[8];
#pragma unroll
            for (int j = 0; j < 4; ++j) { const float4 w0 = *(const float4*)(cw + j * 1024 + c0), w1 = *(const float4*)(cw + j * 1024 + c0 + 4);
                w[j][0] = w0.x; w[j][1] = w0.y; w[j][2] = w0.z; w[j][3] = w0.w; w[j][4] = w1.x; w[j][5] = w1.y; w[j][6] = w1.z; w[j][7] = w1.w; }
            { const float4 b0 = *(const float4*)(cb + c0), b1 = *(const float4*)(cb + c0 + 4); bias[0] = b0.x; bias[1] = b0.y; bias[2] = b0.z; bias[3] = b0.w; bias[4] = b1.x; bias[5] = b1.y; bias[6] = b1.z; bias[7] = b1.w; }
            float xin[7][8];
#pragma unroll
            for (int rr = 0; rr < 7; ++rr) {
                uint4 wv = make_uint4(0u, 0u, 0u, 0u);
                if (s0 + rr - 3 >= 0) wv = *(const uint4*)(xbc + (size_t)(tk0 + rr - 3) * 1024 + c0);
                xin[rr][0] = bflo(wv.x); xin[rr][1] = bfhi(wv.x); xin[rr][2] = bflo(wv.y); xin[rr][3] = bfhi(wv.y); xin[rr][4] = bflo(wv.z); xin[rr][5] = bfhi(wv.z); xin[rr][6] = bflo(wv.w); xin[rr][7] = bfhi(wv.w);
            }
#pragma unroll
            for (int o = 0; o < 4; ++o) {
                float accv[8];
#pragma unroll
                for (int k = 0; k < 8; ++k) accv[k] = bias[k] + w[0][k] * xin[o][k] + w[1][k] * xin[o + 1][k] + w[2][k] * xin[o + 2][k] + w[3][k] * xin[o + 3][k];
                uint4 ov;
                ov.x = pack2(siluf(accv[0]), siluf(accv[1])); ov.y = pack2(siluf(accv[2]), siluf(accv[3]));
                ov.z = pack2(siluf(accv[4]), siluf(accv[5])); ov.w = pack2(siluf(accv[6]), siluf(accv[7]));
                *(uint4*)(xa + (size_t)(tk0 + o) * 1024 + c0) = ov;
            }
        }
    }
}

DI int perm16(int k) { return (k & ~12) | ((k & 4) << 1) | ((k & 8) >> 1); }
template <int DQK, int DVW, int KT, int NQG, int NDV>
struct FlashCfg {
    static constexpr int KSTR = (DQK + 8) * 2;
    static constexpr int VSTR = (KT + 8) * 2;
    static constexpr int DV = DVW * NDV;
    static constexpr int KBYTES = KT * KSTR, VBYTES = DV * VSTR, STAGE = KBYTES + VBYTES;
    static constexpr int KCH = KT * DQK / 8 / 256;
    static constexpr int VCH = DV * KT / 8 / 256;
    static_assert(KT * DQK / 8 % 256 == 0 && DV * KT / 8 % 256 == 0, "chunk split");
    static_assert(2 * STAGE <= SMEM_BYTES - 32, "flash LDS");
};
template <int DQK, int DVW, int KT, int NQG, int NDV, class Src>
DI void flash_item(const Src& src, int ntiles, int nskip  , unsigned char* smem, bool noload = false) {
    typedef FlashCfg<DQK, DVW, KT, NQG, NDV> C;
    constexpr int NKS = DQK / 16, NKB = KT / 32, NDB = DVW / 32;
    int tid = tidx(); asm volatile("" : "+v"(tid));
    const int lane = tid & 63, wave = __builtin_amdgcn_readfirstlane(tid >> 6), r = lane & 31, h = lane >> 5;
    const int qg = wave / NDV, dvh = wave % NDV;
    bf16x8 qf[NKS];
    {
        const bf16_t* qp = src.qrow(qg * 32 + r) + 8 * h;
#pragma unroll
        for (int ks = 0; ks < NKS; ++ks) qf[ks] = *(const bf16x8*)(qp + 16 * ks);
        if (Src::ROPE) {
            const float* cp = src.rope_c(qg * 32 + r) + 8 * h; const float* sp = src.rope_s(qg * 32 + r) + 8 * h;
            const float4 c0 = *(const float4*)cp, c1 = *(const float4*)(cp + 4), s0 = *(const float4*)sp, s1 = *(const float4*)(sp + 4);
            const float cc[8] = {c0.x, c0.y, c0.z, c0.w, c1.x, c1.y, c1.z, c1.w}, ss[8] = {s0.x, s0.y, s0.z, s0.w, s1.x, s1.y, s1.z, s1.w};
            bf16x8 x1 = qf[NKS - 2], x2 = qf[NKS - 1];
#pragma unroll
            for (int j = 0; j < 8; ++j) {
                const float a = bf2f((bf16_t)x1[j]), b2 = bf2f((bf16_t)x2[j]);
                x1[j] = (short)f2bf(a * cc[j] - b2 * ss[j]); x2[j] = (short)f2bf(b2 * cc[j] + a * ss[j]);
            }
            qf[NKS - 2] = x1; qf[NKS - 1] = x2;
        }
    }
    f32x16 o[NDB];
#pragma unroll
    for (int d = 0; d < NDB; ++d)
#pragma unroll
        for (int e = 0; e < 16; ++e) o[d][e] = 0.f;
    float m = -1e30f, l = 0.f;
    uint4 kr[C::KCH], vr[C::VCH];
    auto gload = [&](int t) {
#pragma unroll
        for (int i = 0; i < C::KCH; ++i) { const int idx = tid + 256 * i; kr[i] = src.kload(t, idx / (DQK / 8), idx % (DQK / 8)); }
#pragma unroll
        for (int i = 0; i < C::VCH; ++i) { const int idx = tid + 256 * i; vr[i] = src.vload(t, idx / (KT / 8), idx % (KT / 8)); }
    };
    auto lstore = [&](unsigned char* buf) {
#pragma unroll
        for (int i = 0; i < C::KCH; ++i) { const int idx = tid + 256 * i; *(uint4*)(buf + (idx / (DQK / 8)) * C::KSTR + (idx % (DQK / 8)) * 16) = kr[i]; }
#pragma unroll
        for (int i = 0; i < C::VCH; ++i) {
            const int idx = tid + 256 * i, dv = idx / (KT / 8), c = idx % (KT / 8);
            unsigned char* row = buf + C::KBYTES + dv * C::VSTR + (c >> 1) * 32;
            const int a = c & 1;
            *(uint2*)(row + (4 * a) * 2) = make_uint2(vr[i].x, vr[i].y);
            *(uint2*)(row + (8 + 4 * a) * 2) = make_uint2(vr[i].z, vr[i].w);
        }
    };
    gload(0);
    __syncthreads();
    lstore(smem);
    __syncthreads();
    for (int t = 0; t < ntiles; ++t) {
        const unsigned char* cur = smem + (t & 1) * C::STAGE;
        const bool more = (t + 1 < ntiles);
        if (more && !noload) gload(t + 1);
        if (!(t == ntiles - 1 && qg < nskip)) {
            f32x16 s[NKB];
#pragma unroll
            for (int kb = 0; kb < NKB; ++kb) {
                const unsigned char* kp = cur + (kb * 32 + r) * C::KSTR + h * 16;
                if (NKB == 1) {
                    constexpr int NCH = 2;
                    f32x16 sp[NCH];
#pragma unroll
                    for (int c = 0; c < NCH; ++c)
#pragma unroll
                        for (int e = 0; e < 16; ++e) sp[c][e] = 0.f;
#pragma unroll
                    for (int ks = 0; ks < NKS; ++ks) sp[ks % NCH] = MFMA32(*(const bf16x8*)(kp + ks * 32), qf[ks], sp[ks % NCH]);
#pragma unroll
                    for (int e = 0; e < 16; ++e) s[kb][e] = sp[0][e] + sp[1][e];
                } else {
#pragma unroll
                    for (int e = 0; e < 16; ++e) s[kb][e] = 0.f;
#pragma unroll
                    for (int ks = 0; ks < NKS; ++ks) s[kb] = MFMA32(*(const bf16x8*)(kp + ks * 32), qf[ks], s[kb]);
                }
            }
            float mx = s[0][0];
#pragma unroll
            for (int kb = 0; kb < NKB; ++kb)
#pragma unroll
                for (int e = 0; e < 16; ++e) mx = fmaxf(mx, s[kb][e]);
            mx = fmaxf(mx, __shfl_xor(mx, 32));
            if (!__all(mx <= m + 8.f)) {
                const float mn = fmaxf(m, mx);
                const float alpha = __builtin_amdgcn_exp2f(m - mn);
                m = mn;
                l *= alpha;
#pragma unroll
                for (int d = 0; d < NDB; ++d)
#pragma unroll
                    for (int e = 0; e < 16; ++e) o[d][e] *= alpha;
            }
            float ps = 0.f;
#pragma unroll
            for (int kb = 0; kb < NKB; ++kb)
#pragma unroll
                for (int e = 0; e < 16; ++e) { const float pv = __builtin_amdgcn_exp2f(s[kb][e] - m); s[kb][e] = pv; ps += pv; }
            l += ps;
#pragma unroll
            for (int kb = 0; kb < NKB; ++kb)
#pragma unroll
                for (int s2 = 0; s2 < 2; ++s2) {
                    uint4 pk;
                    pk.x = pack2(s[kb][8 * s2], s[kb][8 * s2 + 1]); pk.y = pack2(s[kb][8 * s2 + 2], s[kb][8 * s2 + 3]);
                    pk.z = pack2(s[kb][8 * s2 + 4], s[kb][8 * s2 + 5]); pk.w = pack2(s[kb][8 * s2 + 6], s[kb][8 * s2 + 7]);
                    const bf16x8 pf = __builtin_bit_cast(bf16x8, pk);
                    const unsigned char* vp = cur + C::KBYTES + (dvh * DVW + r) * C::VSTR + (kb * 32 + s2 * 16 + 8 * h) * 2;
#pragma unroll
                    for (int d = 0; d < NDB; ++d) o[d] = MFMA32(*(const bf16x8*)(vp + d * 32 * C::VSTR), pf, o[d]);
                }
        }
        if (more) lstore(smem + ((t + 1) & 1) * C::STAGE);
        __syncthreads();
    }
    l += __shfl_xor(l, 32);
    const float il = 1.f / l;
#pragma unroll
    for (int d = 0; d < NDB; ++d)
#pragma unroll
        for (int g4 = 0; g4 < 4; ++g4) {
            uint2 w; w.x = pack2(o[d][4 * g4] * il, o[d][4 * g4 + 1] * il); w.y = pack2(o[d][4 * g4 + 2] * il, o[d][4 * g4 + 3] * il);
            src.store(qg * 32 + r, dvh * DVW + d * 32 + 8 * g4 + 4 * h, w);
        }
}
struct SelfSrc {
    static constexpr bool ROPE = true;
    const bf16_t *q, *kn, *kr, *vt; bf16_t* mix; int b, hd, bh, q0; const float *rc, *rs;
    DI const float* rope_c(int rr) const { return rc + (q0 + rr) * 16; }
    DI const float* rope_s(int rr) const { return rs + (q0 + rr) * 16; }
    DI const bf16_t* qrow(int rr) const { return q + ((size_t)bh * 2048 + q0 + rr) * 96; }
    DI uint4 kload(int t, int key, int c) const {
        const int kg = t * 64 + key;
        return c < 8 ? *(const uint4*)(kn + ((size_t)bh * 2048 + kg) * 64 + c * 8) : *(const uint4*)(kr + ((size_t)b * 2048 + kg) * 32 + (c - 8) * 8);
    }
    DI uint4 vload(int t, int dv, int c) const { return *(const uint4*)(vt + ((size_t)bh * 64 + dv) * 2048 + t * 64 + c * 8); }
    DI void store(int rr, int dv, uint2 w) const { *(uint2*)(mix + ((size_t)b * 2048 + q0 + rr) * 1024 + hd * 64 + dv) = w; }
};
struct CrossSrc {
    static constexpr bool ROPE = false;
    const bf16_t *qx, *kx, *vxt; bf16_t* ox; int b, hd, q0;
    DI const float* rope_c(int) const { return nullptr; }
    DI const float* rope_s(int) const { return nullptr; }
    DI const bf16_t* qrow(int rr) const { return qx + ((size_t)(b * 4 + hd) * 2048 + q0 + rr) * 256; }
    DI uint4 kload(int t, int key, int c) const { return *(const uint4*)(kx + ((size_t)(b * 4 + hd) * 256 + t * 32 + key) * 256 + c * 8); }
    DI uint4 vload(int t, int dv, int c) const { return *(const uint4*)(vxt + ((size_t)(b * 4 + hd) * 256 + dv) * 256 + t * 32 + c * 8); }
    DI void store(int rr, int dv, uint2 w) const { *(uint2*)(ox + ((size_t)b * 2048 + q0 + rr) * 1024 + hd * 256 + dv) = w; }
};
DI void attn_fast(const P& p, int bid, int nb, unsigned char* smem) {
    unsigned char* ws = p.ws;
    const int nround = (2048 + nb - 1) / nb;
    for (int rd = 0; rd < nround; ++rd) {
        const int idx = rd * nb + ((rd & 1) ? (nb - 1 - bid) : bid);
        if (idx >= 2048) continue;
        const int qb = 15 - (idx >> 7), bh = idx & 127;
        SelfSrc s{(const bf16_t*)(ws + QB), (const bf16_t*)(ws + KNB), (const bf16_t*)(ws + KROPE), (const bf16_t*)(ws + VTB), (bf16_t*)(ws + MIX), bh >> 3, bh & 7, bh, qb * 128, (const float*)(ws + ROPE_C), (const float*)(ws + ROPE_S)};
        flash_item<96, 64, 64, 4, 1>(s, 2 * qb + 2, 2, smem);
    }
}
DI void xattn_fast(const P& p, int bid, int nb, unsigned char* smem, int rep = 0) {
    unsigned char* ws = p.ws;
    for (int it = bid; it < 2048; it += nb) {
        const int bhd = it >> 5, qt = it & 31;
        CrossSrc s{(const bf16_t*)(ws + QX), (const bf16_t*)(ws + KX), (const bf16_t*)(ws + VXT), (bf16_t*)(ws + OX), bhd >> 2, bhd & 3, qt * 64};
        if (rep) s.ox = (bf16_t*)(ws + RD);
        flash_item<256, 128, 32, 2, 2>(s, 8, 0, smem, rep && REP_MODE == 5);
    }
}

constexpr int SSD_XT = 0, SSD_BM = 8192, SSD_CM = SSD_BM + 16384, SSD_BWT = SSD_CM + 16384, SSD_PS = SSD_BWT + 16384, SSD_F = SSD_PS + 16384;
static_assert(SSD_F + 2048 <= SMEM_BYTES - 32, "ssd LDS");
DI int off256(int row, int el) { return row * 256 + (((el >> 3) ^ (row & 15)) << 4) + ((el & 7) << 1); }
DI int off128(int row, int el) { return row * 128 + (((el >> 3) ^ ((row ^ (row >> 3)) & 7)) << 4) + ((el & 7) << 1); }
template <int pm>
DI void ssd_item(const P& p, int bh, unsigned char* smem) {
    unsigned char* ws = p.ws;
    const bf16_t* xa = (const bf16_t*)(ws + XBCA); const float* dtg = (const float*)(ws + DTB);
    bf16_t* mix = pm ? (bf16_t*)(ws + XBC) : (bf16_t*)(ws + MIX);
    int tid0 = tidx(); asm volatile("" : "+v"(tid0));
    const int wave = __builtin_amdgcn_readfirstlane(tid0 >> 6);
    const int b = bh >> 3, hd = bh & 7, g = hd >> 2;
    const int lb = wave >> 1, pb = wave & 1;
    const float a_h = -__expf(p.in[10][hd]), Dh = p.in[11][hd];
    float* F = (float*)(smem + SSD_F);
    __syncthreads();
    for (int i = tid0; i < 16384 / 16; i += 256) *(uint4*)(smem + SSD_PS + i * 16) = make_uint4(0u, 0u, 0u, 0u);
    f32x16 st[2];
#pragma unroll
    for (int i = 0; i < 2; ++i)
#pragma unroll
        for (int e = 0; e < 16; ++e) st[i][e] = 0.f;
    uint4 xr0, xr1, br0, br1, br2, br3, cr0, cr1, cr2, cr3; float dtr = 0.f;
#define SSD_XLD(i) (*(const uint4*)(xa + (t0_ + ((tid + 256 * (i)) >> 3)) * 1024 + hd * 64 + ((tid + 256 * (i)) & 7) * 8))
#define SSD_BLD(i, o) (*(const uint4*)(xa + (t0_ + ((tid + 256 * (i)) >> 4)) * 1024 + (o) + g * 128 + ((tid + 256 * (i)) & 15) * 8))
#define SSD_GLOAD(c_) do { const size_t t0_ = (size_t)b * 2048 + (c_) * 64; xr0 = SSD_XLD(0); xr1 = SSD_XLD(1); \
        br0 = SSD_BLD(0, 512); br1 = SSD_BLD(1, 512); br2 = SSD_BLD(2, 512); br3 = SSD_BLD(3, 512); \
        cr0 = SSD_BLD(0, 768); cr1 = SSD_BLD(1, 768); cr2 = SSD_BLD(2, 768); cr3 = SSD_BLD(3, 768); \
        if (tid < 64) dtr = dtg[(t0_ + tid) * 8 + hd]; } while (0)
    { const int tid = tid0; SSD_GLOAD(0); }
#define SSD_SCAN(FP) do { const int ln_ = tid0 & 63; float v = dtr * a_h; \
        _Pragma("unroll") for (int o = 1; o < 64; o <<= 1) { const float u = __shfl_up(v, o); if (ln_ >= o) v += u; } \
        const float a63 = __shfl(v, 63); \
        (FP)[ln_] = v; (FP)[64 + ln_] = __expf(v); (FP)[128 + ln_] = dtr; (FP)[192 + ln_] = __expf(a63 - v) * dtr; } while (0)
    if (wave == 0) SSD_SCAN(F);
    __syncthreads();
    for (int c = 0; c < 32; ++c) {
        int tid = tid0; asm volatile("" : "+v"(tid));
        const int lane = tid & 63, r = lane & 31, h = lane >> 5;
        const size_t t0 = (size_t)b * 2048 + c * 64;
        const float* Fc = F + (c & 1) * 256; float* Fn = F + ((c + 1) & 1) * 256;
#define SSD_XIMG(i, XR) do { const int idx = tid + 256 * (i), l = idx >> 3, p0 = (idx & 7) * 8, lp = perm16(l); \
            const unsigned ww[4] = {XR.x, XR.y, XR.z, XR.w}; \
            _Pragma("unroll") for (int k = 0; k < 4; ++k) { \
                *(bf16_t*)(smem + SSD_XT + off128(p0 + 2 * k, lp)) = (bf16_t)(ww[k] & 0xffffu); \
                *(bf16_t*)(smem + SSD_XT + off128(p0 + 2 * k + 1, lp)) = (bf16_t)(ww[k] >> 16); } } while (0)
#define SSD_BIMG(i, BR, CR) do { const int idx = tid + 256 * (i), l = idx >> 4, n0 = (idx & 15) * 8, lp = perm16(l); \
            *(uint4*)(smem + SSD_BM + off256(l, n0)) = BR; *(uint4*)(smem + SSD_CM + off256(l, n0)) = CR; \
            const float wl = Fc[192 + l]; const unsigned ww[4] = {BR.x, BR.y, BR.z, BR.w}; \
            _Pragma("unroll") for (int k = 0; k < 4; ++k) { \
                *(bf16_t*)(smem + SSD_BWT + off128(n0 + 2 * k, lp)) = f2bf(bflo(ww[k]) * wl); \
                *(bf16_t*)(smem + SSD_BWT + off128(n0 + 2 * k + 1, lp)) = f2bf(bfhi(ww[k]) * wl); } } while (0)
        if (!(pm & 2)) {
        SSD_XIMG(0, xr0); SSD_XIMG(1, xr1);
        SSD_BIMG(0, br0, cr0); SSD_BIMG(1, br1, cr1); SSD_BIMG(2, br2, cr2); SSD_BIMG(3, br3, cr3);
        } else { asm volatile("" :: "v"(xr0.x), "v"(xr1.x), "v"(br0.x), "v"(br1.x), "v"(br2.x), "v"(br3.x), "v"(cr0.x), "v"(cr1.x), "v"(cr2.x), "v"(cr3.x)); }
        __syncthreads();
        if (c + 1 < 32) SSD_GLOAD(c + 1);
        if (!(pm & 1)) {
        const float acs_l = Fc[lb * 32 + r];
        const int lrow = lb * 32 + r;
        f32x16 cb0, cb1, yo;
#pragma unroll
        for (int e = 0; e < 16; ++e) { cb0[e] = 0.f; cb1[e] = 0.f; yo[e] = 0.f; }
#pragma unroll
        for (int ks = 0; ks < 8; ++ks) {
            const bf16x8 cv = *(const bf16x8*)(smem + SSD_CM + off256(lb * 32 + r, 16 * ks + 8 * h));
            const bf16x8 b0v = *(const bf16x8*)(smem + SSD_BM + off256(r, 16 * ks + 8 * h));
            const bf16x8 b1v = *(const bf16x8*)(smem + SSD_BM + off256(32 + r, 16 * ks + 8 * h));
            const bf16x8 pv = *(const bf16x8*)(smem + SSD_PS + off256(pb * 32 + r, 16 * ks + 8 * h));
            cb0 = MFMA32(b0v, cv, cb0); cb1 = MFMA32(b1v, cv, cb1); yo = MFMA32(cv, pv, yo);
        }
        f32x16 yd;
#pragma unroll
        for (int e = 0; e < 16; ++e) yd[e] = 0.f;
#pragma unroll
        for (int sb = 0; sb < 2; ++sb) {
            float mv[16];
#pragma unroll
            for (int q4 = 0; q4 < 4; ++q4) {
                const int s0 = sb * 32 + 8 * q4 + 4 * h;
                const float4 as4 = *(const float4*)(Fc + s0), dt4 = *(const float4*)(Fc + 128 + s0);
                const float asv[4] = {as4.x, as4.y, as4.z, as4.w}, dtv[4] = {dt4.x, dt4.y, dt4.z, dt4.w};
#pragma unroll
                for (int k = 0; k < 4; ++k) { const float cbv = sb ? cb1[4 * q4 + k] : cb0[4 * q4 + k]; mv[4 * q4 + k] = (s0 + k <= lrow) ? cbv * __expf(acs_l - asv[k]) * dtv[k] : 0.f; }
            }
#pragma unroll
            for (int s2 = 0; s2 < 2; ++s2) {
                uint4 pk;
                pk.x = pack2(mv[8 * s2], mv[8 * s2 + 1]); pk.y = pack2(mv[8 * s2 + 2], mv[8 * s2 + 3]);
                pk.z = pack2(mv[8 * s2 + 4], mv[8 * s2 + 5]); pk.w = pack2(mv[8 * s2 + 6], mv[8 * s2 + 7]);
                const bf16x8 xb = *(const bf16x8*)(smem + SSD_XT + off128(pb * 32 + r, sb * 32 + 16 * s2 + 8 * h));
                yd = MFMA32(__builtin_bit_cast(bf16x8, pk), xb, yd);
            }
        }
        {
            const uint4 x0 = *(const uint4*)(smem + SSD_XT + off128(pb * 32 + r, lb * 32 + 8 * h));
            const uint4 x1 = *(const uint4*)(smem + SSD_XT + off128(pb * 32 + r, lb * 32 + 16 + 8 * h));
            const unsigned xw[8] = {x0.x, x0.y, x0.z, x0.w, x1.x, x1.y, x1.z, x1.w};
            bf16_t* op = mix + (t0 + lb * 32 + 4 * h) * 1024 + 512 + hd * 64 + pb * 32 + r;
#pragma unroll
            for (int q4 = 0; q4 < 4; ++q4) {
                const float4 ea4 = *(const float4*)(Fc + 64 + lb * 32 + 8 * q4 + 4 * h);
                const float eav[4] = {ea4.x, ea4.y, ea4.z, ea4.w};
#pragma unroll
                for (int k = 0; k < 4; ++k) {
                    const int e = 4 * q4 + k;
                    const float xv = (e & 1) ? bfhi(xw[e >> 1]) : bflo(xw[e >> 1]);
                    const float y = yd[e] + eav[k] * yo[e] + Dh * xv;
                    op[(size_t)(k + 8 * q4) * 1024] = f2bf(y);
                }
            }
        }
        {
            const float dec = Fc[64 + 63];
#pragma unroll
            for (int e = 0; e < 16; ++e) { st[0][e] *= dec; st[1][e] *= dec; }
            const int nblk = 2 * (wave >> 1);
#pragma unroll
            for (int ks = 0; ks < 4; ++ks) {
                const bf16x8 av = *(const bf16x8*)(smem + SSD_XT + off128(pb * 32 + r, 16 * ks + 8 * h));
                const bf16x8 bv0 = *(const bf16x8*)(smem + SSD_BWT + off128(nblk * 32 + r, 16 * ks + 8 * h));
                const bf16x8 bv1 = *(const bf16x8*)(smem + SSD_BWT + off128(nblk * 32 + 32 + r, 16 * ks + 8 * h));
                st[0] = MFMA32(av, bv0, st[0]); st[1] = MFMA32(av, bv1, st[1]);
            }
        }
        }
        if (wave == 0 && c + 1 < 32) SSD_SCAN(Fn);
        __syncthreads();
#pragma unroll
        for (int i = 0; i < 2; ++i) {
            const int n = (2 * (wave >> 1) + i) * 32 + r;
#pragma unroll
            for (int e = 0; e < 16; ++e) *(bf16_t*)(smem + SSD_PS + off256(pb * 32 + crow(e, h), n)) = f2bf(st[i][e]);
        }
    }
    __syncthreads();
}

#if ATTN_NAIVE
DI void attn_naive(const P& p, int bid, int nb) {
    unsigned char* ws = p.ws;
    const bf16_t* Q = (const bf16_t*)(ws + QB); const bf16_t* Kn = (const bf16_t*)(ws + KNB); const bf16_t* Vt = (const bf16_t*)(ws + VTB);
    const bf16_t* Kr = (const bf16_t*)(ws + KROPE); bf16_t* mix = (bf16_t*)(ws + MIX);
    for (int item = bid; item < 128 * 8; item += nb) {
        const int bh = item >> 3, s_ = (item & 7) * 256 + tidx(), b = bh >> 3, hd = bh & 7;
        float q[96];
        {
            const uint4* q4 = (const uint4*)(Q + ((size_t)bh * 2048 + s_) * 96);
#pragma unroll
            for (int i = 0; i < 12; ++i) { const uint4 w = q4[i]; q[8 * i] = bflo(w.x); q[8 * i + 1] = bfhi(w.x); q[8 * i + 2] = bflo(w.y); q[8 * i + 3] = bfhi(w.y);
                q[8 * i + 4] = bflo(w.z); q[8 * i + 5] = bfhi(w.z); q[8 * i + 6] = bflo(w.w); q[8 * i + 7] = bfhi(w.w); }
        }
        float o[64];
#pragma unroll
        for (int d = 0; d < 64; ++d) o[d] = 0.f;
        float m = -1e30f, l = 0.f;
        const int nkeys = __builtin_amdgcn_readfirstlane(((s_ >> 6) + 1) * 64);
        for (int j0 = 0; j0 < nkeys; j0 += 8) {
            float sc[8];
#pragma unroll
            for (int jj = 0; jj < 8; ++jj) {
                const int j = j0 + jj;
                const uint4* k4 = (const uint4*)(Kn + ((size_t)bh * 2048 + j) * 64);
                const uint4* r4 = (const uint4*)(Kr + ((size_t)b * 2048 + j) * 32);
                float a = 0.f;
#pragma unroll
                for (int i = 0; i < 8; ++i) { const uint4 w = k4[i]; a += q[8 * i] * bflo(w.x) + q[8 * i + 1] * bfhi(w.x) + q[8 * i + 2] * bflo(w.y) + q[8 * i + 3] * bfhi(w.y)
                    + q[8 * i + 4] * bflo(w.z) + q[8 * i + 5] * bfhi(w.z) + q[8 * i + 6] * bflo(w.w) + q[8 * i + 7] * bfhi(w.w); }
#pragma unroll
                for (int i = 0; i < 4; ++i) { const uint4 w = r4[i]; const int o8 = 64 + 8 * i; a += q[o8] * bflo(w.x) + q[o8 + 1] * bfhi(w.x) + q[o8 + 2] * bflo(w.y) + q[o8 + 3] * bfhi(w.y)
                    + q[o8 + 4] * bflo(w.z) + q[o8 + 5] * bfhi(w.z) + q[o8 + 6] * bflo(w.w) + q[o8 + 7] * bfhi(w.w); }
                sc[jj] = a;
            }
            float mx = m;
#pragma unroll
            for (int jj = 0; jj < 8; ++jj) mx = fmaxf(mx, sc[jj]);
            const float al = exp2f(m - mx);
            float ps = 0.f;
#pragma unroll
            for (int jj = 0; jj < 8; ++jj) { sc[jj] = exp2f(sc[jj] - mx); ps += sc[jj]; }
            l = l * al + ps; m = mx;
#pragma unroll
            for (int d = 0; d < 64; ++d) {
                const uint4 w = *(const uint4*)(Vt + ((size_t)bh * 64 + d) * 2048 + j0);
                o[d] = o[d] * al + sc[0] * bflo(w.x) + sc[1] * bfhi(w.x) + sc[2] * bflo(w.y) + sc[3] * bfhi(w.y) + sc[4] * bflo(w.z) + sc[5] * bfhi(w.z) + sc[6] * bflo(w.w) + sc[7] * bfhi(w.w);
            }
        }
        const float il = 1.f / l;
        bf16_t* dst = mix + ((size_t)b * 2048 + s_) * 1024 + hd * 64;
#pragma unroll
        for (int d = 0; d < 64; d += 2) *(unsigned*)(dst + d) = pack2(o[d] * il, o[d + 1] * il);
    }
}
#endif
#if SSD_NAIVE
DI void ssd_naive(const P& p, int bid, int nb) {
    unsigned char* ws = p.ws;
    const bf16_t* xa = (const bf16_t*)(ws + XBCA); const float* dt = (const float*)(ws + DTB); const bf16_t* z = (const bf16_t*)(ws + ZB);
    bf16_t* mix = (bf16_t*)(ws + MIX);
    const int wave = tidx() >> 6, pp = tidx() & 63;
    for (int item = bid; item < 32; item += nb) {
        const int bh = item * 4 + wave, b = bh >> 3, hd = bh & 7, g = hd >> 2;
        const float a = -__expf(p.in[10][hd]), Dh = p.in[11][hd];
        float st[128];
#pragma unroll
        for (int n = 0; n < 128; ++n) st[n] = 0.f;
        for (int t = 0; t < 2048; ++t) {
            const size_t row = (size_t)b * 2048 + t;
            const float dtv = dt[row * 8 + hd];
            const float da = __expf(dtv * a);
            const float xv = bf2f(xa[row * 1024 + hd * 64 + pp]);
            const float xd = dtv * xv;
            const uint4* b4 = (const uint4*)(xa + row * 1024 + 512 + g * 128);
            const uint4* c4 = (const uint4*)(xa + row * 1024 + 768 + g * 128);
            float y = 0.f;
#pragma unroll
            for (int i = 0; i < 16; ++i) {
                const uint4 bw = b4[i], cw = c4[i];
                const unsigned bb[4] = {bw.x, bw.y, bw.z, bw.w}, cc[4] = {cw.x, cw.y, cw.z, cw.w};
#pragma unroll
                for (int k = 0; k < 4; ++k) {
                    const int n = 8 * i + 2 * k;
                    st[n] = da * st[n] + xd * bflo(bb[k]); y += bflo(cc[k]) * st[n];
                    st[n + 1] = da * st[n + 1] + xd * bfhi(bb[k]); y += bfhi(cc[k]) * st[n + 1];
                }
            }
            y += Dh * xv;
            const float zv = bf2f(z[row * 512 + hd * 64 + pp]);
            mix[row * 1024 + 512 + hd * 64 + pp] = f2bf(y * siluf(zv));
        }
    }
}
#endif
DI void phase_mixer(const P& p, int bid, int nb, unsigned char* smem, int rep = 0) {
#if SSD_NAIVE
    ssd_naive(p, bid, nb);
    attn_fast(p, bid, nb, smem);
#else
    unsigned* ctr = (unsigned*)(p.ws + CTL + CTL_QUEUE) + 64 * rep;
    int* slot = (int*)(smem + SMEM_BYTES - 32);
    for (;;) {
        __syncthreads();
        if (tidx() == 0) *slot = (int)atomicAdd(ctr, 1u);
        __syncthreads();
        const int it = *slot;
        if (it >= 128 + 2048 + N_LATE_ITEMS) break;
        if (it >= 128 + 2048) {
            if (!rep) for (int k = 0; k < LATE_GROUP; ++k) { const int u = (it - 128 - 2048) * LATE_GROUP + k; if (u < N_LATE) prep_tile(p, u < LATE_A1 - LATE_A0 ? LATE_A0 + u : u - (LATE_A1 - LATE_A0) + LATE_B0, smem); }
            continue;
        }
        if (it < 128) { if (!NO_SSD && !(rep && REP_MODE == 2)) { __builtin_amdgcn_s_setprio(3);
            if (rep) ssd_item<SSD_PM>(p, it, smem); else ssd_item<0>(p, it, smem); __builtin_amdgcn_s_setprio(0); } }
        else if (rep && REP_MODE >= 1) { }
        else {
            const int idx = it - 128, qb = 15 - (idx >> 7), bh = idx & 127;
            unsigned char* ws = p.ws;
            SelfSrc s{(const bf16_t*)(ws + QB), (const bf16_t*)(ws + KNB), (const bf16_t*)(ws + KROPE), (const bf16_t*)(ws + VTB), (bf16_t*)(ws + MIX), bh >> 3, bh & 7, bh, qb * 128, (const float*)(ws + ROPE_C), (const float*)(ws + ROPE_S)};
            if (rep) s.mix = (bf16_t*)(ws + XBC);
            if (!NO_FLASH) flash_item<96, 64, 64, 4, 1>(s, 2 * qb + 2, 2, smem, rep && REP_MODE == 5);
        }
    }
#endif
}

DI void phase_ssdnorm(const P& p, int bid, int nb, unsigned char* smem) {
    bf16_t* mix = (bf16_t*)(p.ws + MIX); const bf16_t* z = (const bf16_t*)(p.ws + ZB);
    const int lane = tidx() & 63, wave = tidx() >> 6;
    for (int tk = bid * 4 + wave; tk < T; tk += nb * 4) {
        uint4* ptr = (uint4*)(mix + (size_t)tk * 1024 + 512 + lane * 8);
        const uint4 w = *ptr, zz = *(const uint4*)(z + (size_t)tk * 512 + lane * 8);
        const unsigned ww[4] = {w.x, w.y, w.z, w.w}, zw[4] = {zz.x, zz.y, zz.z, zz.w};
        float v[8]; float ss = 0.f;
#pragma unroll
        for (int k = 0; k < 4; ++k) {
            v[2 * k] = bflo(ww[k]) * siluf(bflo(zw[k])); v[2 * k + 1] = bfhi(ww[k]) * siluf(bfhi(zw[k]));
            ss += v[2 * k] * v[2 * k] + v[2 * k + 1] * v[2 * k + 1];
        }
#pragma unroll
        for (int o = 16; o >= 1; o >>= 1) ss += __shfl_xor(ss, o);
        const float rr = rsqrtf(ss * (1.f / 256.f) + EPS);
        uint4 o4; o4.x = pack2(v[0] * rr, v[1] * rr); o4.y = pack2(v[2] * rr, v[3] * rr); o4.z = pack2(v[4] * rr, v[5] * rr); o4.w = pack2(v[6] * rr, v[7] * rr);
        *ptr = o4;
    }
}

template <bool RES_BF16>
struct EpiResid {
    bf16_t* pre; const void* res;
    float4 pf[RES_BF16 ? 1 : 16]; uint2 pb[RES_BF16 ? 16 : 1];
    DI void prefetch(int m0, int n0, int tid) {
        const int c4 = (tid & 31) * 4, r0 = tid >> 5;
#pragma unroll
        for (int ps = 0; ps < 16; ++ps) {
            const size_t idx = (size_t)(m0 + ps * 8 + r0) * 1024 + n0 + c4;
            if (RES_BF16) pb[ps] = *(const uint2*)((const bf16_t*)res + idx); else pf[ps] = *(const float4*)((const float*)res + idx);
        }
    }
    DI void operator()(const float* Cs, int m0, int n0, int tid) const {
        const int c4 = (tid & 31) * 4, r0 = tid >> 5;
#pragma unroll
        for (int ps = 0; ps < 16; ++ps) {
            const int row = ps * 8 + r0;
            const float4 v = cs4(Cs, row, c4);
            float4 rr;
            if (RES_BF16) rr = make_float4(bflo(pb[ps].x), bfhi(pb[ps].x), bflo(pb[ps].y), bfhi(pb[ps].y)); else rr = pf[ps];
            *(uint2*)(pre + (size_t)(m0 + row) * 1024 + n0 + c4) = pack4(make_float4(ALPHA * rr.x + v.x, ALPHA * rr.y + v.y, ALPHA * rr.z + v.z, ALPHA * rr.w + v.w));
        }
    }
};
DI void phase_wout(const P& p, int bid, int nb, unsigned char* smem) {
    const int v = vbid(bid, nb);
    EpiResid<true> e; e.pre = (bf16_t*)p.out; e.res = p.out;
    GemmArgs g{(const bf16_t*)(p.ws + MIX), 1024, (const bf16_t*)(p.ws + W_OUT), 1024, 1024, nullptr};
    for (int t = v; t < 256 * 8; t += nb) gemm_tile(g, (t >> 3) * 128, (t & 7) * 128, e, smem);
}
DI void ln_row(const float* src, const float* gam, const float* bet, int lane, float (&o)[16]) {
    float v[16];
#pragma unroll
    for (int i = 0; i < 4; ++i) { const float4 t4 = *(const float4*)(src + i * 256 + lane * 4); v[4 * i] = t4.x; v[4 * i + 1] = t4.y; v[4 * i + 2] = t4.z; v[4 * i + 3] = t4.w; }
    float s = 0.f;
#pragma unroll
    for (int i = 0; i < 16; ++i) s += v[i];
    const float mu = wave_sum(s) * (1.f / 1024.f);
    float q = 0.f;
#pragma unroll
    for (int i = 0; i < 16; ++i) { const float d = v[i] - mu; q += d * d; }
    const float rstd = rsqrtf(wave_sum(q) * (1.f / 1024.f) + EPS);
#pragma unroll
    for (int i = 0; i < 4; ++i) {
        const float4 g4 = *(const float4*)(gam + i * 256 + lane * 4), b4 = *(const float4*)(bet + i * 256 + lane * 4);
        o[4 * i] = (v[4 * i] - mu) * rstd * g4.x + b4.x; o[4 * i + 1] = (v[4 * i + 1] - mu) * rstd * g4.y + b4.y;
        o[4 * i + 2] = (v[4 * i + 2] - mu) * rstd * g4.z + b4.z; o[4 * i + 3] = (v[4 * i + 3] - mu) * rstd * g4.w + b4.w;
    }
}
DI void ln_stats2(const float (&va)[16], const float (&vb)[16], float& mua, float& rsa, float& mub, float& rsb) {
    float sa = 0.f, sb = 0.f;
#pragma unroll
    for (int i = 0; i < 16; ++i) { sa += va[i]; sb += vb[i]; }
#pragma unroll
    for (int o = 32; o >= 1; o >>= 1) { sa += __shfl_xor(sa, o); sb += __shfl_xor(sb, o); }
    mua = sa * (1.f / 1024.f); mub = sb * (1.f / 1024.f);
    float qa = 0.f, qb = 0.f;
#pragma unroll
    for (int i = 0; i < 16; ++i) { const float da = va[i] - mua, db = vb[i] - mub; qa += da * da; qb += db * db; }
#pragma unroll
    for (int o = 32; o >= 1; o >>= 1) { qa += __shfl_xor(qa, o); qb += __shfl_xor(qb, o); }
    rsa = rsqrtf(qa * (1.f / 1024.f) + EPS); rsb = rsqrtf(qb * (1.f / 1024.f) + EPS);
}
DI void load_row16(const bf16_t* src, int lane, float (&v)[16]) {
#pragma unroll
    for (int i = 0; i < 4; ++i) { const uint2 t2 = *(const uint2*)(src + i * 256 + lane * 4); v[4 * i] = bflo(t2.x); v[4 * i + 1] = bfhi(t2.x); v[4 * i + 2] = bflo(t2.y); v[4 * i + 3] = bfhi(t2.y); }
}
DI void phase_ln1(const P& p, int bid, int nb, unsigned char* smem) {
    const int lane = tidx() & 63, wave = tidx() >> 6;
    const bf16_t* pre = (const bf16_t*)p.out; bf16_t* hb = (bf16_t*)(p.ws + H1B);
    const float* gam = p.in[14]; const float* bet = p.in[15];
    for (int tk = bid * 4 + wave; tk < T; tk += nb * 8) {
        const int tk2 = tk + nb * 4;
        float va[16], vb[16], mua, rsa, mub, rsb;
        load_row16(pre + (size_t)tk * 1024, lane, va); load_row16(pre + (size_t)tk2 * 1024, lane, vb);
        ln_stats2(va, vb, mua, rsa, mub, rsb);
#pragma unroll
        for (int i = 0; i < 4; ++i) {
            const float4 g4 = *(const float4*)(gam + i * 256 + lane * 4), b4 = *(const float4*)(bet + i * 256 + lane * 4);
            const float4 oa = make_float4((va[4 * i] - mua) * rsa * g4.x + b4.x, (va[4 * i + 1] - mua) * rsa * g4.y + b4.y, (va[4 * i + 2] - mua) * rsa * g4.z + b4.z, (va[4 * i + 3] - mua) * rsa * g4.w + b4.w);
            const float4 ob = make_float4((vb[4 * i] - mub) * rsb * g4.x + b4.x, (vb[4 * i + 1] - mub) * rsb * g4.y + b4.y, (vb[4 * i + 2] - mub) * rsb * g4.z + b4.z, (vb[4 * i + 3] - mub) * rsb * g4.w + b4.w);
            *(uint2*)(hb + (size_t)tk * 1024 + i * 256 + lane * 4) = pack4(oa); *(uint2*)(hb + (size_t)tk2 * 1024 + i * 256 + lane * 4) = pack4(ob);
        }
    }
}
struct EpiXq {
    bf16_t* qx;
    DI void prefetch(int, int, int) {}
    DI void operator()(const float* Cs, int m0, int n0, int tid) const {
        const int c4 = (tid & 31) * 4, r0 = tid >> 5, hd = n0 >> 8, d = (n0 & 255) + c4, b = m0 >> 11, s0 = m0 & 2047;
#pragma unroll 4
        for (int ps = 0; ps < 16; ++ps) {
            const int row = ps * 8 + r0;
            float4 v = cs4(Cs, row, c4); v.x *= XSCALE; v.y *= XSCALE; v.z *= XSCALE; v.w *= XSCALE;
            *(uint2*)(qx + ((size_t)(b * 4 + hd) * 2048 + s0 + row) * 256 + d) = pack4(v);
        }
    }
};
DI void phase_xq(const P& p, int bid, int nb, unsigned char* smem) {
    const int v = vbid(bid, nb);
    EpiXq e{(bf16_t*)(p.ws + QX)};
    GemmArgs g{(const bf16_t*)(p.ws + H1B), 1024, (const bf16_t*)(p.ws + W_XQ), 1024, 1024, nullptr};
    for (int t = v; t < 256 * 8; t += nb) gemm_tile(g, (t >> 3) * 128, (t & 7) * 128, e, smem);
}
DI void phase_xattn(const P& p, int bid, int nb, unsigned char* smem, int rep = 0) {
#if !XATTN_NAIVE
    xattn_fast(p, bid, nb, smem, rep); return;
#endif
    unsigned char* ws = p.ws;
    const bf16_t* qx = (const bf16_t*)(ws + QX); const bf16_t* kx = (const bf16_t*)(ws + KX); const bf16_t* vxt = (const bf16_t*)(ws + VXT);
    bf16_t* ox = (bf16_t*)(ws + OX);
    const int lane = tidx() & 63, hd = tidx() >> 6;
    float* qs = (float*)smem + hd * 512; float* ps = qs + 256;
    for (int tk = bid; tk < T; tk += nb) {
        const int b = tk >> 11, s_ = tk & 2047;
        __syncthreads();
        {
            const uint2 w = *(const uint2*)(qx + ((size_t)(b * 4 + hd) * 2048 + s_) * 256 + lane * 4);
            qs[lane * 4] = bflo(w.x); qs[lane * 4 + 1] = bfhi(w.x); qs[lane * 4 + 2] = bflo(w.y); qs[lane * 4 + 3] = bfhi(w.y);
        }
        __syncthreads();
        float sc[4];
#pragma unroll
        for (int i = 0; i < 4; ++i) {
            const int m = lane + 64 * i;
            const uint4* k4 = (const uint4*)(kx + ((size_t)(b * 4 + hd) * 256 + m) * 256);
            float a = 0.f;
#pragma unroll 8
            for (int c = 0; c < 32; ++c) {
                const uint4 w = k4[c];
                const float4 q0 = *(const float4*)(qs + 8 * c), q1 = *(const float4*)(qs + 8 * c + 4);
                a += q0.x * bflo(w.x) + q0.y * bfhi(w.x) + q0.z * bflo(w.y) + q0.w * bfhi(w.y) + q1.x * bflo(w.z) + q1.y * bfhi(w.z) + q1.z * bflo(w.w) + q1.w * bfhi(w.w);
            }
            sc[i] = a;
        }
        const float mx = wave_max(fmaxf(fmaxf(sc[0], sc[1]), fmaxf(sc[2], sc[3])));
        float sum = 0.f;
#pragma unroll
        for (int i = 0; i < 4; ++i) { sc[i] = exp2f(sc[i] - mx); sum += sc[i]; }
        const float il = 1.f / wave_sum(sum);
#pragma unroll
        for (int i = 0; i < 4; ++i) ps[lane + 64 * i] = sc[i] * il;
        __syncthreads();
        float o[4];
#pragma unroll
        for (int dd = 0; dd < 4; ++dd) {
            const int d = lane * 4 + dd;
            const uint4* v4 = (const uint4*)(vxt + ((size_t)(b * 4 + hd) * 256 + d) * 256);
            float a = 0.f;
#pragma unroll 8
            for (int c = 0; c < 32; ++c) {
                const uint4 w = v4[c];
                const float4 q0 = *(const float4*)(ps + 8 * c), q1 = *(const float4*)(ps + 8 * c + 4);
                a += q0.x * bflo(w.x) + q0.y * bfhi(w.x) + q0.z * bflo(w.y) + q0.w * bfhi(w.y) + q1.x * bflo(w.z) + q1.y * bfhi(w.z) + q1.z * bflo(w.w) + q1.w * bfhi(w.w);
            }
            o[dd] = a;
        }
        uint2 w; w.x = pack2(o[0], o[1]); w.y = pack2(o[2], o[3]);
        *(uint2*)(ox + (size_t)tk * 1024 + hd * 256 + lane * 4) = w;
    }
}
DI void phase_xo(const P& p, int bid, int nb, unsigned char* smem) {
    const int v = vbid(bid, nb);
    EpiResid<true> e; e.pre = (bf16_t*)p.out; e.res = p.ws + H1B;
    GemmArgs g{(const bf16_t*)(p.ws + OX), 1024, (const bf16_t*)(p.ws + W_XO), 1024, 1024, nullptr};
    for (int t = v; t < 256 * 8; t += nb) gemm_tile(g, (t >> 3) * 128, (t & 7) * 128, e, smem);
}
DI void phase_ln2_router(const P& p, int bid, int nb, unsigned char* smem, int rep = 0) {
    unsigned char* ws = p.ws;
    const int lane = tidx() & 63, wave = tidx() >> 6;
    const bf16_t* pre = (const bf16_t*)p.out; bf16_t* hb = (bf16_t*)(ws + H2B);
    const float* wrt = (const float*)(ws + W_RT);
    const float* gam = p.in[20]; const float* bet = p.in[21];
    unsigned* cnt = (unsigned*)(ws + CTL + CTL_CNT); int* lists = (int*)(ws + LISTS); float* tgate = (float*)(ws + TOK_GATE);
    float* lg = (float*)smem + wave * (16 * 52 + 32);
    float* stt = lg + 16 * 52;
    for (int grp = bid; grp < T / 64; grp += nb) {
        const int t0 = grp * 64 + wave * 16;
        for (int rr = 0; rr < 16; rr += 2) {
            if (rep && REP_MODE == 3) break;
            const int tk = t0 + rr;
            float va[16], vb[16], mua, rsa, mub, rsb;
            load_row16(pre + (size_t)tk * 1024, lane, va); load_row16(pre + (size_t)(tk + 1) * 1024, lane, vb);
            ln_stats2(va, vb, mua, rsa, mub, rsb);
            if (lane == 0) { stt[2 * rr] = mua; stt[2 * rr + 1] = rsa; stt[2 * rr + 2] = mub; stt[2 * rr + 3] = rsb; }
#pragma unroll
            for (int i = 0; i < 4; ++i) {
                const float4 g4 = *(const float4*)(gam + i * 256 + lane * 4), b4 = *(const float4*)(bet + i * 256 + lane * 4);
                const float4 oa = make_float4((va[4 * i] - mua) * rsa * g4.x + b4.x, (va[4 * i + 1] - mua) * rsa * g4.y + b4.y, (va[4 * i + 2] - mua) * rsa * g4.z + b4.z, (va[4 * i + 3] - mua) * rsa * g4.w + b4.w);
                const float4 ob = make_float4((vb[4 * i] - mub) * rsb * g4.x + b4.x, (vb[4 * i + 1] - mub) * rsb * g4.y + b4.y, (vb[4 * i + 2] - mub) * rsb * g4.z + b4.z, (vb[4 * i + 3] - mub) * rsb * g4.w + b4.w);
                *(uint2*)(hb + (size_t)tk * 1024 + i * 256 + lane * 4) = pack4(oa); *(uint2*)(hb + (size_t)(tk + 1) * 1024 + i * 256 + lane * 4) = pack4(ob);
            }
        }
        __builtin_amdgcn_wave_barrier();
        if (!(rep && REP_MODE == 2)) {
            const int i16 = lane & 15, g4i = lane >> 4;
            const bf16_t* arow = pre + (size_t)(t0 + i16) * 1024 + 8 * g4i;
            const bf16_t* brow = (const bf16_t*)wrt + (size_t)i16 * 1024 + 8 * g4i;
            f32x4v acc0 = {0.f, 0.f, 0.f, 0.f}, acc1 = acc0, acc2 = acc0;
#pragma unroll 4
            for (int S = 0; S < 32; ++S) {
                const bf16x8 av = *(const bf16x8*)(arow + 32 * S);
                const bf16x8 h0 = *(const bf16x8*)(brow + 32 * S), h1 = *(const bf16x8*)(brow + 16 * 1024 + 32 * S), h2 = *(const bf16x8*)(brow + 32 * 1024 + 32 * S);
                const bf16x8 l0 = *(const bf16x8*)(brow + 48 * 1024 + 32 * S), l1 = *(const bf16x8*)(brow + 64 * 1024 + 32 * S), l2 = *(const bf16x8*)(brow + 80 * 1024 + 32 * S);
                acc0 = __builtin_amdgcn_mfma_f32_16x16x32_bf16(av, h0, acc0, 0, 0, 0); acc1 = __builtin_amdgcn_mfma_f32_16x16x32_bf16(av, h1, acc1, 0, 0, 0); acc2 = __builtin_amdgcn_mfma_f32_16x16x32_bf16(av, h2, acc2, 0, 0, 0);
                acc0 = __builtin_amdgcn_mfma_f32_16x16x32_bf16(av, l0, acc0, 0, 0, 0); acc1 = __builtin_amdgcn_mfma_f32_16x16x32_bf16(av, l1, acc1, 0, 0, 0); acc2 = __builtin_amdgcn_mfma_f32_16x16x32_bf16(av, l2, acc2, 0, 0, 0);
            }
            const float* aux = (const float*)(ws + CTL + CTL_RTAUX);
            const float sw0 = aux[i16], sw1 = aux[16 + i16], sw2 = aux[32 + i16], cb0 = aux[48 + i16], cb1 = aux[64 + i16], cb2 = aux[80 + i16];
#pragma unroll
            for (int e = 0; e < 4; ++e) {
                const float mur = stt[2 * (4 * g4i + e)], rsr = stt[2 * (4 * g4i + e) + 1];
                float* rowp = lg + (4 * g4i + e) * 52 + i16;
                rowp[0] = rsr * (acc0[e] - mur * sw0) + cb0; rowp[16] = rsr * (acc1[e] - mur * sw1) + cb1; rowp[32] = rsr * (acc2[e] - mur * sw2) + cb2;
            }
        }
        __builtin_amdgcn_wave_barrier();
        unsigned* lcount = (unsigned*)((float*)smem + 4 * (16 * 52 + 32));
        unsigned* lbase = lcount + 32;
        if (tidx() < 32) lcount[tidx()] = 0u;
        __syncthreads();
        int ex1 = 0, ex2 = 0; unsigned lp1 = 0, lp2 = 0;
        if (lane < 16) {
            const int tk = t0 + lane;
            const float* lr = lg + lane * 52;
            float gl[4], el[32];
#pragma unroll
            for (int j = 0; j < 4; ++j) gl[j] = lr[j];
#pragma unroll
            for (int j = 0; j < 32; ++j) el[j] = lr[4 + j];
            int gi = 0; float gm = gl[0];
#pragma unroll
            for (int j = 1; j < 4; ++j) if (gl[j] > gm) { gm = gl[j]; gi = j; }
            float gs = 0.f;
#pragma unroll
            for (int j = 0; j < 4; ++j) gs += __expf(gl[j] - gm);
            const float ggate = 1.f / gs;
            float ev[8];
#pragma unroll
            for (int j = 0; j < 8; ++j) ev[j] = gi == 0 ? el[j] : gi == 1 ? el[8 + j] : gi == 2 ? el[16 + j] : el[24 + j];
            int i1 = 0; float v1 = ev[0];
#pragma unroll
            for (int j = 1; j < 8; ++j) if (ev[j] > v1) { v1 = ev[j]; i1 = j; }
            int i2 = -1; float v2 = -3.0e38f;
#pragma unroll
            for (int j = 0; j < 8; ++j) if (j != i1 && ev[j] > v2) { v2 = ev[j]; i2 = j; }
            const float e2 = __expf(v2 - v1);
            tgate[tk * 2] = ggate / (1.f + e2); tgate[tk * 2 + 1] = ggate * e2 / (1.f + e2);
            ex1 = gi * 8 + i1; ex2 = gi * 8 + i2;
            if (!rep) { lp1 = atomicAdd(&lcount[ex1], 1u); lp2 = atomicAdd(&lcount[ex2], 1u); }
        }
        __syncthreads();
        if (tidx() < 32 && !rep) { const unsigned c = lcount[tidx()]; lbase[tidx()] = c ? atomicAdd(&cnt[tidx() * CNT_STRIDE], c) : 0u; }
        __syncthreads();
        if (lane < 16 && !rep) {
            const int tk = t0 + lane;
            lists[(size_t)ex1 * T + lbase[ex1] + lp1] = tk * 2;
            lists[(size_t)ex2 * T + lbase[ex2] + lp2] = tk * 2 + 1;
        }
        __syncthreads();
    }
}
struct MoeMap { int off[33]; };
DI int moe_tiles(const unsigned* cnt, int* offs  ) {
    __syncthreads();
    if (tidx() == 0) { int o = 0; for (int e = 0; e < 32; ++e) { offs[e] = o; o += (((int)cnt[e * CNT_STRIDE] + 127) >> 7) << 7; } offs[32] = o; }
    __syncthreads();
    return offs[32] >> 7;
}
struct EpiGU {
    bf16_t* hdn;
    DI void prefetch(int, int, int) {}
    DI void operator()(const float* Cs, int m0, int n0, int tid) const {
#pragma unroll 4
        for (int ps = 0; ps < 8; ++ps) {
            const int it = ps * 256 + tid, row = it >> 4, qd = it & 15, c = (qd >> 3) * 64 + (qd & 7) * 4;
            const float4 g = cs4(Cs, row, c), u = cs4(Cs, row, c + 32);
            const int hc = ((n0 & 511) >> 7) * 64 + (qd >> 3) * 32 + (qd & 7) * 4;
            *(uint2*)(hdn + (size_t)(m0 + row) * 256 + hc) = pack4(make_float4(siluf(g.x) * u.x, siluf(g.y) * u.y, siluf(g.z) * u.z, siluf(g.w) * u.w));
        }
    }
};
struct EpiDown {
    bf16_t* y; int* ltok; float* lgate; const int* lst; int nvalid; const float* tgate;
    DI void prefetch(int, int, int tid) {
        if (tid < 128) { const int tk2 = tid < nvalid ? lst[tid] : -1; ltok[tid] = tk2; lgate[tid] = tk2 < 0 ? 0.f : tgate[tk2]; }
    }
    DI void operator()(const float* Cs, int m0, int n0, int tid) const {
        const int c4 = (tid & 31) * 4, r0 = tid >> 5;
#pragma unroll 4
        for (int ps = 0; ps < 16; ++ps) {
            const int row = ps * 8 + r0, tk2 = ltok[row];
            if (tk2 >= 0) {
                const float gt = lgate[row];
                float4 v = cs4(Cs, row, c4); v.x *= gt; v.y *= gt; v.z *= gt; v.w *= gt;
                *(uint2*)(y + (size_t)tk2 * 1024 + n0 + c4) = pack4(v);
            }
        }
    }
};
template <int WHICH>
DI void phase_moe(const P& p, int bid, int nb, unsigned char* smem) {
    unsigned char* ws = p.ws;
    const unsigned* cnt = (const unsigned*)(ws + CTL + CTL_CNT); const int* lists = (const int*)(ws + LISTS); const float* tgate = (const float*)(ws + TOK_GATE);
    int* offs = (int*)(smem + GEMM_LDS); int* ltok = offs + 64; int* lrow = ltok + 128; float* lgate = (float*)(lrow + 128);
    const int nmt = moe_tiles(cnt, offs);
    constexpr int NNT = WHICH == 0 ? 4 : 8;
    const int v = vbid(bid, nb);
    for (int t = v; t < nmt * NNT; t += nb) {
        const int mt = t / NNT, ntl = t % NNT;
        const int slot0 = mt * 128;
        int e = 0;
        while (offs[e + 1] <= slot0) ++e;
        if (WHICH == 0) {
            __syncthreads();
            if (tidx() < 128) {
                const int pos = slot0 - offs[e] + tidx();
                const int tk2 = pos < (int)cnt[e * CNT_STRIDE] ? lists[(size_t)e * T + pos] : -1;
                lrow[tidx()] = tk2 < 0 ? 0 : (tk2 >> 1);
            }
            __syncthreads();
        }
        if (WHICH == 0) {
            EpiGU ep{(bf16_t*)(ws + HDN)};
            GemmArgs g{(const bf16_t*)(ws + H2B), 1024, (const bf16_t*)(ws + W_GU) + (size_t)e * 512 * 1024, 1024, 1024, lrow};
            gemm_tile(g, slot0, ntl * 128, ep, smem);
        } else {
            EpiDown ep{(bf16_t*)(ws + YB), ltok, lgate, lists + (size_t)e * T + (slot0 - offs[e]), (int)cnt[e * CNT_STRIDE] - (slot0 - offs[e]), tgate};
            GemmArgs g{(const bf16_t*)(ws + HDN), 256, (const bf16_t*)(ws + W_DN) + (size_t)e * 1024 * 256, 256, 256, nullptr};
            gemm_tile(g, slot0, ntl * 128, ep, smem);
        }
    }
}
DI void phase_final(const P& p, int bid, int nb, unsigned char* smem) {
    const int lane = tidx() & 63, wave = tidx() >> 6;
    const bf16_t* hb2 = (const bf16_t*)(p.ws + H2B); const bf16_t* y = (const bf16_t*)(p.ws + YB);
    const float* gam = p.in[29]; const float* bet = p.in[30];
    for (int tk = bid * 4 + wave; tk < T; tk += nb * 8) {
        const int tk2 = tk + nb * 4;
        float va[16], vb[16], mua, rsa, mub, rsb;
#pragma unroll
        for (int i = 0; i < 4; ++i) {
            const uint2 ha = *(const uint2*)(hb2 + (size_t)tk * 1024 + i * 256 + lane * 4), hbv = *(const uint2*)(hb2 + (size_t)tk2 * 1024 + i * 256 + lane * 4);
            const float4 ta = make_float4(bflo(ha.x), bfhi(ha.x), bflo(ha.y), bfhi(ha.y)), tb = make_float4(bflo(hbv.x), bfhi(hbv.x), bflo(hbv.y), bfhi(hbv.y));
            const uint2 a0 = *(const uint2*)(y + (size_t)(tk * 2) * 1024 + i * 256 + lane * 4), a1 = *(const uint2*)(y + (size_t)(tk * 2 + 1) * 1024 + i * 256 + lane * 4);
            const uint2 b0 = *(const uint2*)(y + (size_t)(tk2 * 2) * 1024 + i * 256 + lane * 4), b1 = *(const uint2*)(y + (size_t)(tk2 * 2 + 1) * 1024 + i * 256 + lane * 4);
            va[4 * i] = ALPHA * ta.x + bflo(a0.x) + bflo(a1.x); va[4 * i + 1] = ALPHA * ta.y + bfhi(a0.x) + bfhi(a1.x); va[4 * i + 2] = ALPHA * ta.z + bflo(a0.y) + bflo(a1.y); va[4 * i + 3] = ALPHA * ta.w + bfhi(a0.y) + bfhi(a1.y);
            vb[4 * i] = ALPHA * tb.x + bflo(b0.x) + bflo(b1.x); vb[4 * i + 1] = ALPHA * tb.y + bfhi(b0.x) + bfhi(b1.x); vb[4 * i + 2] = ALPHA * tb.z + bflo(b0.y) + bflo(b1.y); vb[4 * i + 3] = ALPHA * tb.w + bfhi(b0.y) + bfhi(b1.y);
        }
        ln_stats2(va, vb, mua, rsa, mub, rsb);
#pragma unroll
        for (int i = 0; i < 4; ++i) {
            const float4 g4 = *(const float4*)(gam + i * 256 + lane * 4), b4 = *(const float4*)(bet + i * 256 + lane * 4);
            *(float4*)(p.out + (size_t)tk * 1024 + i * 256 + lane * 4) = make_float4((va[4 * i] - mua) * rsa * g4.x + b4.x, (va[4 * i + 1] - mua) * rsa * g4.y + b4.y, (va[4 * i + 2] - mua) * rsa * g4.z + b4.z, (va[4 * i + 3] - mua) * rsa * g4.w + b4.w);
            *(float4*)(p.out + (size_t)tk2 * 1024 + i * 256 + lane * 4) = make_float4((vb[4 * i] - mub) * rsb * g4.x + b4.x, (vb[4 * i + 1] - mub) * rsb * g4.y + b4.y, (vb[4 * i + 2] - mub) * rsb * g4.z + b4.z, (vb[4 * i + 3] - mub) * rsb * g4.w + b4.w);
        }
    }
}

#define XB_TMO      128
#define XB_XCNT(j)  (256  + 64 * (j))
#define XB_XSUB(j)  (1280 + 64 * (j))
#define XB_XGEN(j)  (2304 + 64 * (j))
#define XB_TOP      3328
#define XB_TOPGEN   3392
#define XCD_BAR_WORDS 3456
#define XB_SPIN_CAP (1u << 25)
DI unsigned xb_ld(unsigned* p) { return __hip_atomic_load(p, __ATOMIC_RELAXED, __HIP_MEMORY_SCOPE_AGENT); }
DI unsigned xb_add(unsigned* p, unsigned v) { return __hip_atomic_fetch_add(p, v, __ATOMIC_RELAXED, __HIP_MEMORY_SCOPE_AGENT); }
DI unsigned xb_xcc_id() { return (unsigned)__builtin_amdgcn_s_getreg((3 << 11) | 20) & 0xFu; }
#define XB_SPIN(cond, bar) do { unsigned _sp = 0; while (cond) { __builtin_amdgcn_s_sleep(1); \
    if ((++_sp & 255u) == 0u) { if (xb_ld(&(bar)[XB_TMO])) break; if (_sp > XB_SPIN_CAP) { atomicAdd(&(bar)[XB_TMO], 1u); break; } } } } while (0)
struct XcdBarrier { unsigned* bar; unsigned x; volatile LAS unsigned* st; };
DI XcdBarrier xcd_barrier_post(unsigned* bar, volatile LAS unsigned* st) {
    XcdBarrier b; b.bar = bar; b.x = xb_xcc_id(); b.st = st;
    if (threadIdx.x == 0) (void)xb_add(&bar[XB_XCNT(b.x)], 1u);
    return b;
}
DI void xcd_barrier_complete(unsigned* bar, unsigned x, unsigned& nloc, unsigned& nx) {
    const unsigned G = gridDim.x * gridDim.y * gridDim.z;
    unsigned sum, cnt, mine, sp = 0u;
    for (;;) {
        sum = 0u; cnt = 0u; mine = 0u;
#pragma unroll
        for (unsigned j = 0; j < 16; ++j) { const unsigned c = xb_ld(&bar[XB_XCNT(j)]); sum += c; cnt += (c > 0u) ? 1u : 0u; mine = (j == x) ? c : mine; }
        if (sum == G) break;
        __builtin_amdgcn_s_sleep(1);
        if ((++sp & 255u) == 0u) { if (xb_ld(&bar[XB_TMO])) break; if (sp > XB_SPIN_CAP) { atomicAdd(&bar[XB_TMO], 1u); break; } }
    }
    nloc = mine > 0u ? mine : 1u; nx = cnt > 0u ? cnt : 1u;
}
DI void xcd_barrier(const XcdBarrier& b) {
    asm volatile("s_waitcnt vmcnt(0)" ::: "memory");
    __syncthreads();
    if (threadIdx.x == 0) {
        unsigned* bar = b.bar;
        __builtin_amdgcn_s_waitcnt(0);
        unsigned nloc = b.st[0], nx = b.st[1];
        if (nloc == 0u) { xcd_barrier_complete(bar, b.x, nloc, nx); b.st[0] = nloc; b.st[1] = nx; }
        const unsigned old = xb_add(&bar[XB_XSUB(b.x)], 1u);
        const unsigned gen = old / nloc;
        if (old + 1u == (gen + 1u) * nloc) {
            __builtin_amdgcn_fence(__ATOMIC_RELEASE, "agent");
            asm volatile("s_waitcnt vmcnt(0)" ::: "memory");
            const unsigned og = xb_add(&bar[XB_TOP], 1u);
            const unsigned tg = og / nx;
            if (og + 1u == (tg + 1u) * nx) xb_add(&bar[XB_TOPGEN], 1u);
            else XB_SPIN(xb_ld(&bar[XB_TOPGEN]) == tg, bar);
            __builtin_amdgcn_fence(__ATOMIC_ACQUIRE, "agent");
            xb_add(&bar[XB_XGEN(b.x)], 1u);
            asm volatile("s_waitcnt vmcnt(0)" ::: "memory");
        } else {
            XB_SPIN(xb_ld(&bar[XB_XGEN(b.x)]) == gen, bar);
            __builtin_amdgcn_fence(__ATOMIC_ACQUIRE, "agent");
            asm volatile("s_waitcnt vmcnt(0)" ::: "memory");
        }
    }
    __syncthreads();
}

constexpr int NPHASE = 14;
template <int PH>
DI void run_phase(const P& p, int bid, int nb, unsigned char* smem, int rep = 0) {
    if (PH == 0) phase_prep(p, bid, nb, smem);
    else if (PH == 1) phase_proj(p, bid, nb, smem, rep);
    else if (PH == 2) phase_up(p, bid, nb, smem, rep);
    else if (PH == 3) phase_mixer(p, bid, nb, smem, rep);
    else if (PH == 4) phase_ssdnorm(p, bid, nb, smem);
    else if (PH == 5) phase_wout(p, bid, nb, smem);
    else if (PH == 6) phase_ln1(p, bid, nb, smem);
    else if (PH == 7) phase_xq(p, bid, nb, smem);
    else if (PH == 8) phase_xattn(p, bid, nb, smem, rep);
    else if (PH == 9) phase_xo(p, bid, nb, smem);
    else if (PH == 10) phase_ln2_router(p, bid, nb, smem, rep);
    else if (PH == 11) phase_moe<0>(p, bid, nb, smem);
    else if (PH == 12) phase_moe<1>(p, bid, nb, smem);
    else if (PH == 13) phase_final(p, bid, nb, smem);
}
template <int PH>
__global__ void __launch_bounds__(256, 2) k_phase(P p) {
    __shared__ __attribute__((aligned(16))) unsigned char smem[SMEM_BYTES];
    run_phase<PH>(p, blockIdx.x, gridDim.x, smem);
}

#if MEGA
#ifndef MEGA_WAVES
#define MEGA_WAVES 2
#endif
template <int PH>
DI void mega_steps(const P& p, const XcdBarrier& bar, unsigned char* smem) {
    run_phase<PH>(p, blockIdx.x, gridDim.x, smem);
    if constexpr (((REPEAT_MASK >> PH) & 1) != 0) { xcd_barrier(bar); run_phase<PH>(p, blockIdx.x, gridDim.x, smem, 1); }
    if constexpr (PH == 6 && EXTRA_BARRIERS > 0) { for (int i = 0; i < EXTRA_BARRIERS; ++i) xcd_barrier(bar); }
    if constexpr (PH + 1 < NPHASE) { xcd_barrier(bar); mega_steps<PH + 1>(p, bar, smem); }
}
__global__ void __launch_bounds__(256, MEGA_WAVES) k_mega(P p) {
    __shared__ __attribute__((aligned(16))) unsigned char smem[SMEM_BYTES];
    volatile LAS unsigned* st = (volatile LAS unsigned*)(smem + SMEM_BYTES - 16);
    if (threadIdx.x < 4) st[threadIdx.x] = 0u;
    __syncthreads();
    const XcdBarrier bar = xcd_barrier_post((unsigned*)(p.ws + CTL), st);
    mega_steps<0>(p, bar, smem);
}
#endif
template <int PH>
__global__ void __launch_bounds__(256, 1) k_phase_big(P p) {
    __shared__ __attribute__((aligned(16))) unsigned char smem[SMEM_BYTES];
    run_phase<PH>(p, blockIdx.x, gridDim.x, smem);
}
template <int PH>
static void launch_phase(const P& p, int grid, hipStream_t st) {
    if constexpr (PH == 3 && !P3_SMALL) hipLaunchKernelGGL((k_phase_big<PH>), dim3(grid), dim3(256), 0, st, p);
    else hipLaunchKernelGGL((k_phase<PH>), dim3(grid), dim3(256), 0, st, p);
}

extern "C" void kernel_launch(void* const* d_in, const int* in_sizes, int n_in, void* d_out, int out_size, void* d_ws, size_t ws_size, hipStream_t stream) {
    if (n_in != 31 || out_size != T * D || ws_size < WS_NEED) {
        fprintf(stderr, "kernel_launch: unexpected shapes: n_in %d out %d ws %zu (need %zu)\n", n_in, out_size, ws_size, (size_t)WS_NEED);
        return;
    }
    P p{};
    for (int i = 0; i < 31; ++i) p.in[i] = (const float*)d_in[i];
    p.out = (float*)d_out; p.ws = (unsigned char*)d_ws;
    (void)hipMemsetAsync((unsigned char*)d_ws + CTL, 0, CTL_BYTES, stream);
#if MEGA
    static int grid = 0;
    if (grid == 0) {
        int dev = 0, cus = 0, per_cu = 0;
        (void)hipGetDevice(&dev);
        (void)hipDeviceGetAttribute(&cus, hipDeviceAttributeMultiprocessorCount, dev);
        if (hipOccupancyMaxActiveBlocksPerMultiprocessor(&per_cu, (const void*)k_mega, 256, 0) != hipSuccess || per_cu < 1) { fprintf(stderr, "kernel_launch: occupancy query failed\n"); per_cu = 1; }
        if (per_cu > 2) per_cu = 2;
        grid = cus * per_cu;
        fprintf(stderr, "kernel_launch: mega grid %d (%d CUs x %d)\n", grid, cus, per_cu);
    }
    void* args[] = {(void*)&p};
    const hipError_t le = hipLaunchCooperativeKernel((const void*)k_mega, dim3(grid), dim3(256), args, 0, stream);
    if (le != hipSuccess) fprintf(stderr, "kernel_launch: cooperative launch failed: %s (grid %d)\n", hipGetErrorString(le), grid);
#else
    const int grid = 1024;
    launch_phase<0>(p, grid, stream); launch_phase<1>(p, grid, stream); launch_phase<2>(p, grid, stream); launch_phase<3>(p, grid, stream);
    launch_phase<4>(p, grid, stream); launch_phase<5>(p, grid, stream); launch_phase<6>(p, grid, stream); launch_phase<7>(p, grid, stream);
    launch_phase<8>(p, grid, stream); launch_phase<9>(p, grid, stream); launch_phase<10>(p, grid, stream); launch_phase<11>(p, grid, stream);
    launch_phase<12>(p, grid, stream); launch_phase<13>(p, grid, stream);
#endif
}
```

```cpp
#include <hip/hip_runtime.h>
#include <stdint.h>
#include <stdio.h>

#ifndef MEGA
#define MEGA 1
#endif
#ifndef ATTN_NAIVE
#define ATTN_NAIVE 0
#endif
#ifndef XATTN_NAIVE
#define XATTN_NAIVE 0
#endif
#ifndef SSD_NAIVE
#define SSD_NAIVE 0
#endif
#ifndef P3_SMALL
#define P3_SMALL 1
#endif
#ifndef NO_SSD
#define NO_SSD 0
#endif
#ifndef NO_FLASH
#define NO_FLASH 0
#endif
#ifndef GEMM_GLDS
#define GEMM_GLDS 1
#endif
#ifndef EXTRA_BARRIERS
#define EXTRA_BARRIERS 0
#endif
#ifndef SSD_PM
#define SSD_PM 0
#endif
#ifndef REPEAT_MASK
#define REPEAT_MASK 0
#endif
#ifndef REP_MODE
#define REP_MODE 0
#endif
#ifndef MFMA16
#define MFMA16 1
#endif
#ifndef GEMM_DIRECT
#define GEMM_DIRECT 0
#endif

typedef unsigned short bf16_t;
typedef short bf16x8 __attribute__((ext_vector_type(8)));
typedef float f32x16 __attribute__((ext_vector_type(16)));
typedef float f32x4v __attribute__((ext_vector_type(4)));
#define DI __device__ __forceinline__
#define LAS __attribute__((address_space(3)))
#define MFMA32(a, b, c) __builtin_amdgcn_mfma_f32_32x32x16_bf16((a), (b), (c), 0, 0, 0)

constexpr int Bn = 16, S = 2048, T = Bn * S, D = 1024;
constexpr int NMEM = 256;
constexpr float EPS = 1e-5f;
constexpr float ALPHA = 1.189207115002721f;
constexpr float LOG2E = 1.4426950408889634f;
constexpr float QSCALE = 0.10206207261596577f * LOG2E;
constexpr float XSCALE = 0.0625f * LOG2E;
constexpr int NEXP = 32;
constexpr int MAXSLOTS = 69632;

constexpr size_t MiB = 1u << 20;
constexpr size_t W_IN = 0;
constexpr size_t W_QUP = W_IN + 4 * MiB;
constexpr size_t W_KVUP = W_QUP + 768 * 256 * 2;
constexpr size_t W_OUT = W_KVUP + 1024 * 128 * 2;
constexpr size_t W_XQ = W_OUT + 2 * MiB;
constexpr size_t W_XKV = W_XQ + 2 * MiB;
constexpr size_t W_XO = W_XKV + 4 * MiB;
constexpr size_t W_GU = W_XO + 2 * MiB;
constexpr size_t W_DN = W_GU + 32 * MiB;
constexpr size_t W_RT = W_DN + 16 * MiB;
constexpr size_t ROPE_C = W_RT + 48 * 1024 * 4;
constexpr size_t ROPE_S = ROPE_C + 2048 * 16 * 4;
constexpr size_t TOK_GATE = ROPE_S + 2048 * 16 * 4;
constexpr size_t CTL = TOK_GATE + (size_t)T * 2 * 4;
constexpr size_t CTL_BYTES = 32768;
constexpr size_t CTL_CNT = 16384;
constexpr int CNT_STRIDE = 64;
constexpr size_t CTL_QUEUE = 28672;
constexpr size_t CTL_RTAUX = 30720;
static_assert(CTL + CTL_BYTES <= 64 * MiB, "weights region overflow");
constexpr size_t RA = 64 * MiB, RB = 192 * MiB, RC = 320 * MiB, RD = 448 * MiB, WS_NEED = 512 * MiB;
constexpr size_t XBC = RA;
constexpr size_t KX = RA + 64 * MiB;
constexpr size_t VXT = KX + 8 * MiB;
constexpr size_t YB = RA;
constexpr size_t QB = RB;
constexpr size_t KNB = RB + 48 * MiB;
constexpr size_t VTB = KNB + 32 * MiB;
constexpr size_t H1 = RB;
constexpr size_t H2 = RB;
constexpr size_t XB = RC;
constexpr size_t MEMB = RB;
constexpr size_t XBCA = RC;
constexpr size_t MIX = RC + 64 * MiB;
constexpr size_t H1B = RC;
constexpr size_t QX = RC + 64 * MiB;
constexpr size_t OX = RB;
constexpr size_t H2B = RC;
constexpr size_t HDN = RC + 64 * MiB;
constexpr size_t CQ = RD;
constexpr size_t CKV = CQ + 16 * MiB;
constexpr size_t KROPE = CKV + 8 * MiB;
constexpr size_t DTB = KROPE + 2 * MiB;
constexpr size_t ZB = DTB + 1 * MiB;
constexpr size_t SSQ = ZB + 32 * MiB;
constexpr size_t DO_VW = 64 * MiB;
constexpr size_t DO_WQK = 96 * MiB;
constexpr size_t LISTS = RD;
static_assert(SSQ + 3 * (size_t)T * 4 <= WS_NEED, "region D overflow");

struct P {
    const float* in[31];
    float* out;
    unsigned char* ws;
};

typedef __bf16 hbf16x2 __attribute__((ext_vector_type(2)));
typedef float f32x2 __attribute__((ext_vector_type(2)));
DI bf16_t f2bf(float x) { return __builtin_bit_cast(bf16_t, (__bf16)x); }
DI float bf2f(bf16_t b) { return __uint_as_float(((unsigned)b) << 16); }
DI float bflo(unsigned w) { return __uint_as_float(w << 16); }
DI float bfhi(unsigned w) { return __uint_as_float(w & 0xffff0000u); }
DI unsigned pack2(float a, float b) { f32x2 v = {a, b}; return __builtin_bit_cast(unsigned, __builtin_convertvector(v, hbf16x2)); }
DI float siluf(float x) { return x * __builtin_amdgcn_rcpf(1.f + __expf(-x)); }
DI float softplusf(float x) {
    const float zz = __expf(-fabsf(x));
    const float l1p = zz < 0.01f ? zz * (1.f - zz * (0.5f - zz * (1.f / 3.f))) : __logf(1.f + zz);
    return fmaxf(x, 0.f) + l1p;
}
DI int tidx() { int t = __builtin_amdgcn_workitem_id_x(); asm volatile("" : "+v"(t)); return t; }
DI int crow(int reg, int h) { return (reg & 3) + 8 * (reg >> 2) + 4 * h; }
constexpr int CS_LD = 132;
DI float4 cs4(const float* Cs, int row, int col) { return *(const float4*)(Cs + row * CS_LD + col); }
DI uint2 pack4(float4 v) { uint2 w; w.x = pack2(v.x, v.y); w.y = pack2(v.z, v.w); return w; }
DI uint4 pack8(float4 a, float4 b) { uint4 w; w.x = pack2(a.x, a.y); w.y = pack2(a.z, a.w); w.z = pack2(b.x, b.y); w.w = pack2(b.z, b.w); return w; }
DI float wave_sum(float v) {
#pragma unroll
    for (int o = 32; o >= 1; o >>= 1) v += __shfl_xor(v, o);
    return v;
}
DI float wave_max(float v) {
#pragma unroll
    for (int o = 32; o >= 1; o >>= 1) v = fmaxf(v, __shfl_xor(v, o));
    return v;
}

constexpr int LDS_ROW = 144;
constexpr int TILE_BYTES = 128 * LDS_ROW;
constexpr int GEMM_LDS = 4 * TILE_BYTES;
constexpr int SMEM_BYTES = GEMM_LDS + 3072;
static_assert(128 * CS_LD * 4 <= GEMM_LDS, "epilogue tile");

struct GemmArgs {
    const bf16_t* A; int lda;
    const bf16_t* Bt; int ldb;
    int K;
    const int* lrows;
};

template <class Epi>
DI void gemm_tile(const GemmArgs& g, int m0, int n0, Epi& epi, unsigned char* smem) {
    const int tid = tidx(), lane = tid & 63, wave = tid >> 6, wr = wave >> 1, wc = wave & 1;
    const int r = lane & 31, h = lane >> 5;
    f32x16 acc[2][2];
#pragma unroll
    for (int i = 0; i < 2; ++i)
#pragma unroll
        for (int j = 0; j < 2; ++j)
#pragma unroll
            for (int e = 0; e < 16; ++e) acc[i][j][e] = 0.f;
    const int nk = g.K >> 6;
#if MFMA16
    f32x4v acc16[4][4];
#pragma unroll
    for (int m = 0; m < 4; ++m)
#pragma unroll
        for (int n = 0; n < 4; ++n) acc16[m][n] = (f32x4v){0.f, 0.f, 0.f, 0.f};
#endif
#if GEMM_DIRECT
    {
        const bf16_t* ap[2]; const bf16_t* bp[2];
#pragma unroll
        for (int i = 0; i < 2; ++i) {
            const int lr = wr * 64 + i * 32 + r;
            const int grow = g.lrows ? g.lrows[lr] : (m0 + lr);
            ap[i] = g.A + (size_t)grow * g.lda + 8 * h;
            bp[i] = g.Bt + (size_t)(n0 + wc * 64 + i * 32 + r) * g.ldb + 8 * h;
        }
        for (int k = 0; k < g.K; k += 16) {
            bf16x8 a[2], b[2];
#pragma unroll
            for (int i = 0; i < 2; ++i) { a[i] = *(const bf16x8*)(ap[i] + k); b[i] = *(const bf16x8*)(bp[i] + k); }
#pragma unroll
            for (int i = 0; i < 2; ++i)
#pragma unroll
                for (int j = 0; j < 2; ++j) acc[i][j] = MFMA32(a[i], b[j], acc[i][j]);
        }
    }
#elif GEMM_GLDS
    {
        constexpr int STG = 32768, TB = 16384;
        const int srow = tid >> 3, sch = (tid & 7) ^ ((srow >> 1) & 7);
        const __amdgpu_buffer_rsrc_t rsa = __builtin_amdgcn_make_buffer_rsrc((void*)g.A, (short)0, 0x7fffffff, 0x00020000);
        const __amdgpu_buffer_rsrc_t rsb = __builtin_amdgcn_make_buffer_rsrc((void*)g.Bt, (short)0, 0x7fffffff, 0x00020000);
        int ao[4], bo[4];
#pragma unroll
        for (int i = 0; i < 4; ++i) {
            const int lr = srow + 32 * i;
            const int grow = g.lrows ? g.lrows[lr] : (m0 + lr);
            ao[i] = (grow * g.lda + sch * 8) * 2;
            bo[i] = ((n0 + lr) * g.ldb + sch * 8) * 2;
        }
#define GLDS_STAGE(BUF, KO) do { unsigned char* _d = (BUF) + wave * 1024; \
        _Pragma("unroll") for (int i = 0; i < 4; ++i) { \
            __builtin_amdgcn_raw_ptr_buffer_load_lds(rsa, (LAS unsigned*)(_d + i * 4096), 16, ao[i], (KO) * 2, 0, 0); \
            __builtin_amdgcn_raw_ptr_buffer_load_lds(rsb, (LAS unsigned*)(_d + TB + i * 4096), 16, bo[i], (KO) * 2, 0, 0); } } while (0)
        __syncthreads();
        GLDS_STAGE(smem, 0);
        epi.prefetch(m0, n0, tid);
        const int y16 = (h ^ ((r >> 1) & 7)) << 4;
        const int o0 = y16, o1 = 32 ^ y16, o2 = 64 ^ y16, o3 = 96 ^ y16;
        const int arow = (wr * 64 + r) * 128, brow = TB + (wc * 64 + r) * 128;
        __syncthreads();
#if MFMA16
        const int i16 = lane & 15, g16 = lane >> 4;
        const int p0 = ((g16 ^ (i16 >> 1)) << 4), p1 = p0 ^ 64;
        const int arow16 = (wr * 64 + i16) * 128, brow16 = TB + (wc * 64 + i16) * 128;
        for (int kt = 0; kt < nk; ++kt) {
            const unsigned char* cur = smem + (kt & 1) * STG;
            if (kt + 1 < nk) GLDS_STAGE(smem + ((kt + 1) & 1) * STG, (kt + 1) * 64);
#pragma unroll
            for (int s = 0; s < 2; ++s) {
                const int po = s ? p1 : p0;
                bf16x8 fa[4], fb[4];
#pragma unroll
                for (int m = 0; m < 4; ++m) { fa[m] = *(const bf16x8*)(cur + arow16 + m * 16 * 128 + po); fb[m] = *(const bf16x8*)(cur + brow16 + m * 16 * 128 + po); }
#pragma unroll
                for (int m = 0; m < 4; ++m)
#pragma unroll
                    for (int n = 0; n < 4; ++n) acc16[m][n] = __builtin_amdgcn_mfma_f32_16x16x32_bf16(fa[m], fb[n], acc16[m][n], 0, 0, 0);
            }
            __syncthreads();
        }
#else
        for (int kt = 0; kt < nk; ++kt) {
            const unsigned char* cur = smem + (kt & 1) * STG;
            if (kt + 1 < nk) GLDS_STAGE(smem + ((kt + 1) & 1) * STG, (kt + 1) * 64);
            bf16x8 fa[4][2], fb[4][2];
#define KLOAD(S, OFF) do { \
                fa[S][0] = *(const bf16x8*)(cur + arow + (OFF)); fa[S][1] = *(const bf16x8*)(cur + arow + 32 * 128 + (OFF)); \
                fb[S][0] = *(const bf16x8*)(cur + brow + (OFF)); fb[S][1] = *(const bf16x8*)(cur + brow + 32 * 128 + (OFF)); } while (0)
            KLOAD(0, o0); KLOAD(1, o1); KLOAD(2, o2); KLOAD(3, o3);
#undef KLOAD
#pragma unroll
            for (int s = 0; s < 4; ++s) {
                acc[0][0] = MFMA32(fa[s][0], fb[s][0], acc[0][0]); acc[0][1] = MFMA32(fa[s][0], fb[s][1], acc[0][1]);
                acc[1][0] = MFMA32(fa[s][1], fb[s][0], acc[1][0]); acc[1][1] = MFMA32(fa[s][1], fb[s][1], acc[1][1]);
            }
            __builtin_amdgcn_sched_group_barrier(0x100, 8, 0); __builtin_amdgcn_sched_group_barrier(0x8, 4, 0);
            __builtin_amdgcn_sched_group_barrier(0x100, 4, 0); __builtin_amdgcn_sched_group_barrier(0x8, 4, 0);
            __builtin_amdgcn_sched_group_barrier(0x100, 4, 0); __builtin_amdgcn_sched_group_barrier(0x8, 8, 0);
#define KSTEP(OFF)
#undef KSTEP
            __syncthreads();
        }
#endif
#undef GLDS_STAGE
    }
#else
    {
        const int srow = tid >> 3, sch = tid & 7;
        const bf16_t* ag[4]; const bf16_t* bg[4];
#pragma unroll
        for (int i = 0; i < 4; ++i) {
            const int lr = srow + 32 * i;
            const int grow = g.lrows ? g.lrows[lr] : (m0 + lr);
            ag[i] = g.A + (size_t)grow * g.lda + sch * 8;
            bg[i] = g.Bt + (size_t)(n0 + lr) * g.ldb + sch * 8;
        }
        const int soff = srow * LDS_ROW + sch * 16;
        uint4 ra0, ra1, ra2, ra3, rb0, rb1, rb2, rb3;
#define G_LOAD(KO) do { ra0 = *(const uint4*)(ag[0] + (KO)); ra1 = *(const uint4*)(ag[1] + (KO)); ra2 = *(const uint4*)(ag[2] + (KO)); ra3 = *(const uint4*)(ag[3] + (KO)); \
                        rb0 = *(const uint4*)(bg[0] + (KO)); rb1 = *(const uint4*)(bg[1] + (KO)); rb2 = *(const uint4*)(bg[2] + (KO)); rb3 = *(const uint4*)(bg[3] + (KO)); } while (0)
#define L_STORE(BUF) do { unsigned char* _d = (BUF) + soff; \
        *(uint4*)(_d) = ra0; *(uint4*)(_d + 32 * LDS_ROW) = ra1; *(uint4*)(_d + 64 * LDS_ROW) = ra2; *(uint4*)(_d + 96 * LDS_ROW) = ra3; \
        *(uint4*)(_d + TILE_BYTES) = rb0; *(uint4*)(_d + TILE_BYTES + 32 * LDS_ROW) = rb1; *(uint4*)(_d + TILE_BYTES + 64 * LDS_ROW) = rb2; *(uint4*)(_d + TILE_BYTES + 96 * LDS_ROW) = rb3; } while (0)
        G_LOAD(0);
        __syncthreads();
        L_STORE(smem);
        __syncthreads();
        const int aoff = (wr * 64 + r) * LDS_ROW + h * 16;
        const int boff = TILE_BYTES + (wc * 64 + r) * LDS_ROW + h * 16;
        for (int kt = 0; kt < nk; ++kt) {
            const unsigned char* cur = smem + (kt & 1) * 2 * TILE_BYTES;
            unsigned char* nxt = smem + ((kt + 1) & 1) * 2 * TILE_BYTES;
            const bool more = (kt + 1 < nk);
            if (more) G_LOAD((kt + 1) * 64);
#pragma unroll
            for (int ks = 0; ks < 4; ++ks) {
                const bf16x8 a0 = *(const bf16x8*)(cur + aoff + ks * 32);
                const bf16x8 a1 = *(const bf16x8*)(cur + aoff + 32 * LDS_ROW + ks * 32);
                const bf16x8 b0 = *(const bf16x8*)(cur + boff + ks * 32);
                const bf16x8 b1 = *(const bf16x8*)(cur + boff + 32 * LDS_ROW + ks * 32);
                acc[0][0] = MFMA32(a0, b0, acc[0][0]); acc[0][1] = MFMA32(a0, b1, acc[0][1]);
                acc[1][0] = MFMA32(a1, b0, acc[1][0]); acc[1][1] = MFMA32(a1, b1, acc[1][1]);
            }
            if (more) L_STORE(nxt);
            __syncthreads();
        }
#undef G_LOAD
#undef L_STORE
    }
#endif
    float* Cs = (float*)smem;
#if GEMM_DIRECT
    __syncthreads();
#endif
#if !MFMA16
#pragma unroll
    for (int i = 0; i < 2; ++i)
#pragma unroll
        for (int j = 0; j < 2; ++j)
#pragma unroll
            for (int e = 0; e < 16; ++e) Cs[(wr * 64 + i * 32 + crow(e, h)) * CS_LD + wc * 64 + j * 32 + r] = acc[i][j][e];
#else
#pragma unroll
    for (int m = 0; m < 4; ++m)
#pragma unroll
        for (int n = 0; n < 4; ++n)
#pragma unroll
            for (int e = 0; e < 4; ++e) Cs[(wr * 64 + m * 16 + 4 * (lane >> 4) + e) * CS_LD + wc * 64 + n * 16 + (lane & 15)] = acc16[m][n][e];
#endif
    __syncthreads();
    epi(Cs, m0, n0, tid);
}

template <class Epi, bool TR = false, bool GA = false>
DI void gemm_tile256(const GemmArgs& g, int m0, int n0, Epi& epi, unsigned char* smem) {
    const int tid = tidx(), lane = tid & 63, wave = tid >> 6, wr = wave >> 1, wc = wave & 1;
    constexpr int STG = 24576, TB = 16384;
    f32x4v acc[8][4];
#pragma unroll
    for (int m = 0; m < 8; ++m)
#pragma unroll
        for (int n = 0; n < 4; ++n) acc[m][n] = (f32x4v){0.f, 0.f, 0.f, 0.f};
    const int nk = g.K >> 5;
    {
        const int srow = lane >> 2, sch = (lane & 3) ^ ((lane >> 5) << 1);
        const __amdgpu_buffer_rsrc_t rsa = __builtin_amdgcn_make_buffer_rsrc((void*)g.A, (short)0, 0x7fffffff, 0x00020000);
        const __amdgpu_buffer_rsrc_t rsb = __builtin_amdgcn_make_buffer_rsrc((void*)g.Bt, (short)0, 0x7fffffff, 0x00020000);
        int ao[4], bo[2];
#pragma unroll
        for (int i = 0; i < 4; ++i) ao[i] = ((GA ? g.lrows[wave * 16 + srow + 64 * i] : (m0 + wave * 16 + srow + 64 * i)) * g.lda + sch * 8) * 2;
#pragma unroll
        for (int i = 0; i < 2; ++i) bo[i] = ((n0 + wave * 16 + srow + 64 * i) * g.ldb + sch * 8) * 2;
#define STAGE256(BUF, KO) do { unsigned char* _d = (BUF) + wave * 1024; \
        _Pragma("unroll") for (int i = 0; i < 4; ++i) __builtin_amdgcn_raw_ptr_buffer_load_lds(rsa, (LAS unsigned*)(_d + i * 4096), 16, ao[i], (KO) * 2, 0, 0); \
        _Pragma("unroll") for (int i = 0; i < 2; ++i) __builtin_amdgcn_raw_ptr_buffer_load_lds(rsb, (LAS unsigned*)(_d + TB + i * 4096), 16, bo[i], (KO) * 2, 0, 0); } while (0)
        __syncthreads();
        STAGE256(smem, 0); STAGE256(smem + STG, 32);
        asm volatile("s_waitcnt vmcnt(6)" ::: "memory");
        asm volatile("s_waitcnt lgkmcnt(0)" ::: "memory"); __builtin_amdgcn_s_barrier();
        const int fr = lane & 15, fq = lane >> 4;
        const int rd = fr * 64 + ((fq ^ ((fr >> 3) << 1)) << 4);
        const int aoff = wr * 8192 + rd, boff = TB + wc * 4096 + rd;
        int cb = 0, nb2 = 2 * STG;
#pragma unroll
        for (int kt = 0; kt < nk; ++kt) {
            const unsigned char* cur = smem + cb;
            if (kt + 2 < nk) STAGE256(smem + nb2, (kt + 2) * 32);
            bf16x8 fa[8], fb[4];
#pragma unroll
            for (int n = 0; n < 4; ++n) fb[n] = *(const bf16x8*)(cur + boff + n * 1024);
#pragma unroll
            for (int m = 0; m < 8; ++m) fa[m] = *(const bf16x8*)(cur + aoff + m * 1024);
#pragma unroll
            for (int m = 0; m < 8; ++m)
#pragma unroll
                for (int n = 0; n < 4; ++n) acc[m][n] = __builtin_amdgcn_mfma_f32_16x16x32_bf16(fa[m], fb[n], acc[m][n], 0, 0, 0);
            __builtin_amdgcn_sched_group_barrier(0x100, 12, 0); __builtin_amdgcn_sched_group_barrier(0x8, 32, 0);
            if (kt + 2 < nk) asm volatile("s_waitcnt vmcnt(6)" ::: "memory"); else asm volatile("s_waitcnt vmcnt(0)" ::: "memory");
            asm volatile("s_waitcnt lgkmcnt(0)" ::: "memory"); __builtin_amdgcn_s_barrier();
            cb = (cb == 2 * STG) ? 0 : cb + STG; nb2 = (nb2 == 2 * STG) ? 0 : nb2 + STG;
        }
#undef STAGE256
    }
    float* Cs = (float*)smem;
    if constexpr (TR) {
#pragma unroll
        for (int hh = 0; hh < 2; ++hh) {
            if (hh) __syncthreads();
            if (wr == hh) {
#pragma unroll
                for (int m = 0; m < 8; ++m)
#pragma unroll
                    for (int n = 0; n < 4; ++n) *(float4*)&Cs[(wc * 64 + n * 16 + (lane & 15)) * CS_LD + m * 16 + 4 * (lane >> 4)] = make_float4(acc[m][n][0], acc[m][n][1], acc[m][n][2], acc[m][n][3]);
            }
            __syncthreads();
            epi.half(Cs, n0, hh, tid);
        }
    } else {
#pragma nounroll
    for (int hh = 0; hh < 2; ++hh) {
        if (hh) __syncthreads();
        epi.prefetch(m0 + hh * 128, n0, tid);
        if (wr == hh) {
#pragma unroll
            for (int m = 0; m < 8; ++m)
#pragma unroll
                for (int n = 0; n < 4; ++n)
#pragma unroll
                    for (int e = 0; e < 4; ++e) Cs[(m * 16 + 4 * (lane >> 4) + e) * CS_LD + wc * 64 + n * 16 + (lane & 15)] = acc[m][n][e];
        }
        __syncthreads();
        epi(Cs, m0 + hh * 128, n0, tid);
    }
    }
}

DI int vbid(int bid, int nb) { return (nb % 8 == 0) ? (bid % 8) * (nb / 8) + bid / 8 : bid; }

DI int colmap_in(int n) {
    if (n < 384) return n;
    if (n < 896) return 416 + (n - 384);
    if (n < 1920) return 928 + (n - 896);
    if (n < 1952) return 384 + (n - 1920);
    if (n < 1960) return n;
    return -1;
}
template <int KIND>
DI void tconv_tile(const float* src, const float* src2, int ldsrc, bf16_t* dst, int K, int k0, int n0, const float* scale, int scale_from, unsigned char* smem) {
    float* tile = (float*)smem;
    const int t = tidx();
    __syncthreads();
#pragma unroll
    for (int i = 0; i < 4; ++i) {
        const int k = i * 16 + (t >> 4), n4 = (t & 15) * 4;
        const int nd = n0 + n4;
        float4 v = make_float4(0.f, 0.f, 0.f, 0.f);
        if (KIND == 1) { const int c = colmap_in(nd); if (c >= 0) v = *(const float4*)(src + (size_t)(k0 + k) * ldsrc + c); }
        else if (KIND == 2) {
            const int j = nd >> 7, wc = (nd >> 6) & 1, isup = (nd >> 5) & 1, ii = nd & 31;
            const int c = 64 * j + 32 * wc + ii;
            v = *(const float4*)((isup ? src2 : src) + (size_t)(k0 + k) * ldsrc + c);
        } else v = *(const float4*)(src + (size_t)(k0 + k) * ldsrc + nd);
        if (scale && (k0 + k) >= scale_from) { const float s = scale[k0 + k - scale_from]; v.x *= s; v.y *= s; v.z *= s; v.w *= s; }
        float* tp = tile + k * 65 + n4;
        tp[0] = v.x; tp[1] = v.y; tp[2] = v.z; tp[3] = v.w;
    }
    __syncthreads();
#pragma unroll
    for (int i = 0; i < 2; ++i) {
        const int n = i * 32 + (t >> 3), k8 = (t & 7) * 8;
        const float* tp = tile + k8 * 65 + n;
        uint4 w;
        w.x = pack2(tp[0], tp[65]); w.y = pack2(tp[2 * 65], tp[3 * 65]); w.z = pack2(tp[4 * 65], tp[5 * 65]); w.w = pack2(tp[6 * 65], tp[7 * 65]);
        *(uint4*)(dst + (size_t)(n0 + n) * K + k0 + k8) = w;
    }
}

constexpr int PJ0 = 512, PJ1 = PJ0 + 48, PJ2 = PJ1 + 32, PJ3 = PJ2 + 256, PJ4 = PJ3 + 256, PJ5 = PJ4 + 256, PJ6 = PJ5 + 256, PJ7 = PJ6 + 256, PJ8 = PJ7 + 4096, PJ9 = PJ8 + 2048;
DI void prep_tile(const P& p, int t, unsigned char* smem) {
    unsigned char* ws = p.ws;
    if (t < PJ0) { const int kt = t >> 5, ntl = t & 31; tconv_tile<1>(p.in[2], nullptr, 1960, (bf16_t*)(ws + W_IN), 1024, kt * 64, ntl * 64, nullptr, 0, smem); }
    else if (t < PJ1) { const int u = t - PJ0, kt = u / 12, ntl = u % 12; tconv_tile<0>(p.in[4], nullptr, 768, (bf16_t*)(ws + W_QUP), 256, kt * 64, ntl * 64, p.in[3], 0, smem); }
    else if (t < PJ2) { const int u = t - PJ1, kt = u >> 4, ntl = u & 15; tconv_tile<0>(p.in[6], nullptr, 1024, (bf16_t*)(ws + W_KVUP), 128, kt * 64, ntl * 64, p.in[5], 0, smem); }
    else if (t < PJ3) { const int u = t - PJ2, kt = u >> 4, ntl = u & 15; tconv_tile<0>(p.in[13], nullptr, 1024, (bf16_t*)(ws + W_OUT), 1024, kt * 64, ntl * 64, p.in[12], 512, smem); }
    else if (t < PJ4) { }
    else if (t < PJ5) { const int u = t - PJ4, kt = u >> 4, ntl = u & 15; tconv_tile<0>(p.in[17], nullptr, 1024, (bf16_t*)(ws + W_XKV), 1024, kt * 64, ntl * 64, nullptr, 0, smem); }
    else if (t < PJ6) { const int u = t - PJ5, kt = u >> 4, ntl = u & 15; tconv_tile<0>(p.in[18], nullptr, 1024, (bf16_t*)(ws + W_XKV) + (size_t)1024 * 1024, 1024, kt * 64, ntl * 64, nullptr, 0, smem); }
    else if (t < PJ7) { const int u = t - PJ6, kt = u >> 4, ntl = u & 15; tconv_tile<0>(p.in[19], nullptr, 1024, (bf16_t*)(ws + W_XO), 1024, kt * 64, ntl * 64, nullptr, 0, smem); }
    else if (t < PJ8) { const int u = t - PJ7, e = u >> 7, v = u & 127, kt = v >> 3, ntl = v & 7;
        tconv_tile<2>(p.in[26] + (size_t)e * 1024 * 256, p.in[27] + (size_t)e * 1024 * 256, 256, (bf16_t*)(ws + W_GU) + (size_t)e * 512 * 1024, 1024, kt * 64, ntl * 64, nullptr, 0, smem); }
    else { const int u = t - PJ8, e = u >> 6, v = u & 63, kt = v >> 4, ntl = v & 15;
        tconv_tile<0>(p.in[28] + (size_t)e * 256 * 1024, nullptr, 1024, (bf16_t*)(ws + W_DN) + (size_t)e * 1024 * 256, 256, kt * 64, ntl * 64, nullptr, 0, smem); }
}
constexpr int LATE_A0 = PJ2, LATE_A1 = PJ3, LATE_B0 = PJ7, LATE_B1 = PJ9, N_LATE = (LATE_A1 - LATE_A0) + (LATE_B1 - LATE_B0), LATE_GROUP = 4, N_LATE_ITEMS = (N_LATE + LATE_GROUP - 1) / LATE_GROUP;
DI void phase_prep(const P& p, int bid, int nb, unsigned char* smem) {
    unsigned char* ws = p.ws;
    const int tid = tidx();
    constexpr int N_EARLY = LATE_A0 + (LATE_B0 - LATE_A1);
    for (int u = bid; u < N_EARLY; u += nb) prep_tile(p, u < LATE_A0 ? u : u - LATE_A0 + LATE_A1, smem);
    {
        const size_t gsz = (size_t)nb * 256, g0 = (size_t)bid * 256 + tid;
        bf16_t* xb = (bf16_t*)p.out;
        const float4* x4 = (const float4*)p.in[0];
        for (size_t i = g0; i < (size_t)T * D / 4; i += gsz) { const float4 v = x4[i]; uint2 o; o.x = pack2(v.x, v.y); o.y = pack2(v.z, v.w); ((uint2*)xb)[i] = o; }
        bf16_t* mb = (bf16_t*)(ws + MEMB);
        const float4* m4 = (const float4*)p.in[1];
        for (size_t i = g0; i < (size_t)Bn * NMEM * D / 4; i += gsz) { const float4 v = m4[i]; uint2 o; o.x = pack2(v.x, v.y); o.y = pack2(v.z, v.w); ((uint2*)mb)[i] = o; }
        { bf16_t* wq = (bf16_t*)(ws + W_XQ); const float4* s4 = (const float4*)p.in[16];
          for (size_t i = g0; i < 1024 * 1024 / 4; i += gsz) { const float4 v = s4[i]; uint2 o; o.x = pack2(v.x * XSCALE, v.y * XSCALE); o.y = pack2(v.z * XSCALE, v.w * XSCALE); ((uint2*)wq)[i] = o; } }
        float* wrt = (float*)(ws + W_RT);
        for (size_t i = g0; i < 48 * 1024; i += gsz) {
            const int j = (int)(i >> 10), k = (int)(i & 1023);
            float v = 0.f;
            if (j < 4) v = p.in[22][k * 4 + j]; else if (j < 36) v = p.in[24][k * 32 + (j - 4)];
            v *= p.in[20][k];
            const bf16_t hi = f2bf(v), lo = f2bf(v - bf2f(hi));
            ((bf16_t*)wrt)[i] = hi; ((bf16_t*)wrt)[48 * 1024 + i] = lo;
        }
        {
            float* aux = (float*)(ws + CTL + CTL_RTAUX);
            const int lane = tid & 63, wave = tid >> 6;
            for (int j = bid * 4 + wave; j < 48; j += nb * 4) {
                float sw = 0.f, cbv = 0.f;
                for (int k = lane; k < 1024; k += 64) {
                    float w = 0.f;
                    if (j < 4) w = p.in[22][k * 4 + j]; else if (j < 36) w = p.in[24][k * 32 + (j - 4)];
                    sw += w * p.in[20][k]; cbv += w * p.in[21][k];
                }
                sw = wave_sum(sw); cbv = wave_sum(cbv);
                if (lane == 0) { aux[j] = sw; aux[48 + j] = cbv + (j < 4 ? p.in[23][j] : j < 36 ? p.in[25][j - 4] : 0.f); }
            }
        }
        float* rc = (float*)(ws + ROPE_C); float* rs = (float*)(ws + ROPE_S);
        for (size_t i = g0; i < 2048 * 16; i += gsz) {
            const int pos = (int)(i >> 4), f = (int)(i & 15);
            const float inv = powf(10000.f, -(float)f / 16.f);
            const float ang = (float)pos * inv;
            const double a = (double)ang;
            const double k2 = rint(a * 0.15915494309189535);
            const float rr = (float)(a - k2 * 6.283185307179586);
            rc[i] = cosf(rr); rs[i] = sinf(rr);
        }
    }
}

struct EpiProj {
    bf16_t *cq, *ckv, *z, *xbc, *krope; float* dt; const float *rc, *rs, *dtb; float* ssq; unsigned char* wsb;
    DI void prefetch(int, int, int) {}
    DI void operator()(const float* Cs, int m0, int n0, int tid) const {
        const int c8 = (tid & 15) * 8, r0 = tid >> 4;
        if (n0 < 1920) {
            bf16_t* dst; int ld, cofs;
            size_t doff;
            if (n0 < 256) { doff = CQ; ld = 256; cofs = n0; } else if (n0 < 384) { doff = CKV; ld = 128; cofs = n0 - 256; }
            else if (n0 < 896) { doff = ZB; ld = 512; cofs = n0 - 384; } else { doff = XBC; ld = 1024; cofs = n0 - 896; }
            dst = (bf16_t*)(wsb + doff);
            if (n0 < 384) {
                float* sq = ssq + (size_t)(n0 >> 7) * T + m0;
#pragma unroll 4
                for (int ps = 0; ps < 8; ++ps) {
                    const int row = ps * 16 + r0; const float4 v = cs4(Cs, row, c8), w = cs4(Cs, row, c8 + 4);
                    *(uint4*)(dst + (size_t)(m0 + row) * ld + cofs + c8) = pack8(v, w);
                    float ss = ((v.x * v.x + v.y * v.y) + (v.z * v.z + v.w * v.w)) + ((w.x * w.x + w.y * w.y) + (w.z * w.z + w.w * w.w));
#pragma unroll
                    for (int o = 8; o >= 1; o >>= 1) ss += __shfl_xor(ss, o);
                    if ((tid & 15) == 0) sq[row] = ss;
                }
            } else {
#pragma unroll 4
            for (int ps = 0; ps < 8; ++ps) { const int row = ps * 16 + r0; *(uint4*)(dst + (size_t)(m0 + row) * ld + cofs + c8) = pack8(cs4(Cs, row, c8), cs4(Cs, row, c8 + 4)); }
            }
        } else {
#pragma unroll
            for (int ps = 0; ps < 4; ++ps) {
                const int it = ps * 256 + tid, row = it >> 3, cc = (it & 7) * 4, grow = m0 + row;
                const float4 v = cs4(Cs, row, cc), pv = cs4(Cs, row, cc ^ 16);
                const int pos = grow & 2047, f = cc & 15;
                const float4 c = *(const float4*)(rc + pos * 16 + f), s = *(const float4*)(rs + pos * 16 + f);
                float4 o;
                if (cc < 16) { o.x = v.x * c.x - pv.x * s.x; o.y = v.y * c.y - pv.y * s.y; o.z = v.z * c.z - pv.z * s.z; o.w = v.w * c.w - pv.w * s.w; }
                else { o.x = v.x * c.x + pv.x * s.x; o.y = v.y * c.y + pv.y * s.y; o.z = v.z * c.z + pv.z * s.z; o.w = v.w * c.w + pv.w * s.w; }
                *(uint2*)(krope + (size_t)grow * 32 + cc) = pack4(o);
            }
#pragma unroll
            for (int ps = 0; ps < 4; ++ps) {
                const int it = ps * 256 + tid, row = it >> 3, cc = it & 7;
                dt[(size_t)(m0 + row) * 8 + cc] = softplusf(Cs[row * CS_LD + 32 + cc] + dtb[cc]);
            }
        }
    }
};
struct EpiMemKV {
    bf16_t *kx, *vx;
    DI void prefetch(int, int, int) {}
    DI void operator()(const float* Cs, int m0, int n0, int tid) const {
        const int b = m0 >> 8, mm0 = m0 & 255;
        const int c8 = (tid & 15) * 8, r0 = tid >> 4, c2 = n0 & 1023, hd = c2 >> 8, d = (c2 & 255) + c8;
        bf16_t* dst = n0 < 1024 ? kx : vx;
#pragma unroll 4
        for (int ps = 0; ps < 8; ++ps) { const int row = ps * 16 + r0; *(uint4*)(dst + ((size_t)(b * 4 + hd) * 256 + mm0 + row) * 256 + d) = pack8(cs4(Cs, row, c8), cs4(Cs, row, c8 + 4)); }
    }
};
struct EpiStore {
    bf16_t* dst; int ld, roff, coff;
    DI void prefetch(int, int, int) {}
    DI void operator()(const float* Cs, int m0, int n0, int tid) const {
        const int c8 = (tid & 15) * 8, r0 = tid >> 4;
#pragma unroll 4
        for (int ps = 0; ps < 8; ++ps) { const int row = ps * 16 + r0; *(uint4*)(dst + (size_t)(roff + m0 + row) * ld + coff + n0 + c8) = pack8(cs4(Cs, row, c8), cs4(Cs, row, c8 + 4)); }
    }
};
DI void phase_proj(const P& p, int bid, int nb, unsigned char* smem, int rep = 0) {
    unsigned char* ws = p.ws;
    const int v = vbid(bid, nb);
    const bf16_t* xb = (const bf16_t*)p.out;
    EpiProj e1{(bf16_t*)(ws + CQ), (bf16_t*)(ws + CKV), (bf16_t*)(ws + ZB), (bf16_t*)(ws + XBC), (bf16_t*)(ws + KROPE), (float*)(ws + DTB),
               (const float*)(ws + ROPE_C), (const float*)(ws + ROPE_S), p.in[9], (float*)(ws + SSQ), ws};
    EpiMemKV e2{(bf16_t*)(ws + KX), (bf16_t*)(ws + VXT)};
    constexpr int NT1 = 128 * 16, NT2 = 32 * 16;
    for (int t = v; t < NT1 + NT2; t += nb) {
        if (t < NT1) {
            const int c = t >> 5, j = t & 31, mt = (c >> 1) * 4 + (j >> 3), ntl = (c & 1) * 8 + (j & 7);
            GemmArgs g{xb, 1024, (const bf16_t*)(ws + W_IN), 1024, 1024, nullptr}; gemm_tile256(g, mt * 256, ntl * 128, e1, smem);
        } else {
            const int u = t - NT1, mt = u >> 4, ntl = u & 15;
            GemmArgs g{(const bf16_t*)(ws + MEMB), 1024, (const bf16_t*)(ws + W_XKV), 1024, 1024, nullptr}; gemm_tile(g, mt * 128, ntl * 128, e2, smem);
        }
    }
}

struct EpiQup {
    bf16_t* q; const float* ssq; float* rms;
    DI void prefetch(int m0, int, int tid) { if (tid < 128) rms[tid] = rsqrtf((ssq[m0 + tid] + ssq[(size_t)T + m0 + tid]) * (1.f / 256.f) + EPS); }
    DI void operator()(const float* Cs, int m0, int n0, int tid) const {
        const int c8 = (tid & 15) * 8, r0 = tid >> 4;
        const int col = n0 + c8, head = col / 96, d = col - head * 96;
        const int b = m0 >> 11, s0 = m0 & 2047;
#pragma unroll 4
        for (int ps = 0; ps < 8; ++ps) {
            const int row = ps * 16 + r0;
            const float sc = rms[row] * QSCALE;
            float4 v = cs4(Cs, row, c8), w = cs4(Cs, row, c8 + 4);
            v.x *= sc; v.y *= sc; v.z *= sc; v.w *= sc; w.x *= sc; w.y *= sc; w.z *= sc; w.w *= sc;
            *(uint4*)(q + ((size_t)(b * 8 + head) * 2048 + s0 + row) * 96 + d) = pack8(v, w);
        }
    }
};
struct EpiKVup {
    bf16_t *kn, *vt; const float* ssq; float* rms;
    DI void prefetch(int m0, int, int tid) { if (tid < 128) rms[tid] = rsqrtf(ssq[2 * (size_t)T + m0 + tid] * (1.f / 128.f) + EPS); }
    DI void operator()(const float* Cs, int m0, int n0, int tid) const {
        const int head = n0 >> 7, b = m0 >> 11, s0 = m0 & 2047;
#pragma unroll 4
        for (int ps = 0; ps < 4; ++ps) {
            const int it = ps * 256 + tid, row = it >> 3, c8 = (it & 7) * 8;
            const float sc = rms[row];
            float4 v = cs4(Cs, row, c8), w = cs4(Cs, row, c8 + 4); v.x *= sc; v.y *= sc; v.z *= sc; v.w *= sc; w.x *= sc; w.y *= sc; w.z *= sc; w.w *= sc;
            *(uint4*)(kn + ((size_t)(b * 8 + head) * 2048 + s0 + row) * 64 + c8) = pack8(v, w);
        }
#pragma unroll 2
        for (int ps = 0; ps < 4; ++ps) {
            const int it = ps * 256 + tid, dv = it & 63, rg = it >> 6;
            const float* cp = Cs + (rg * 8) * CS_LD + 64 + dv; const float* rp = rms + rg * 8;
            uint4 w;
            w.x = pack2(cp[0] * rp[0], cp[CS_LD] * rp[1]); w.y = pack2(cp[2 * CS_LD] * rp[2], cp[3 * CS_LD] * rp[3]);
            w.z = pack2(cp[4 * CS_LD] * rp[4], cp[5 * CS_LD] * rp[5]); w.w = pack2(cp[6 * CS_LD] * rp[6], cp[7 * CS_LD] * rp[7]);
            *(uint4*)(vt + ((size_t)(b * 8 + head) * 64 + dv) * 2048 + s0 + rg * 8) = w;
        }
    }
};
DI void phase_up(const P& p, int bid, int nb, unsigned char* smem, int rep = 0) {
    unsigned char* ws = p.ws;
    const int v = vbid(bid, nb);
    float* rms = (float*)(smem + GEMM_LDS);
    constexpr int NTQ = 256 * 6, NTKV = 256 * 8;
    constexpr int NTABS = 64 * 16 * 2;
    for (int t = v; t < NTQ + NTKV + NTABS; t += nb) {
        if (t >= NTQ + NTKV) {
            if (rep) continue;
            const int u = t - NTQ - NTKV, which = u >> 10, w = u & 1023, bhd = w >> 4, tl = w & 15, b = bhd >> 2, hd = bhd & 3;
            if (which == 0) {
                EpiStore e{(bf16_t*)((unsigned char*)p.out + DO_WQK) + (size_t)b * 1024 * 1024, 1024, hd * 256, 0};
                GemmArgs g{(const bf16_t*)(ws + KX) + (size_t)bhd * 256 * 256, 256, (const bf16_t*)(ws + W_XQ) + hd * 256, 1024, 256, nullptr};
                gemm_tile(g, (tl >> 3) * 128, (tl & 7) * 128, e, smem);
            } else {
                EpiStore e{(bf16_t*)((unsigned char*)p.out + DO_VW) + (size_t)b * 1024 * 1024, 1024, 0, hd * 256};
                GemmArgs g{(const bf16_t*)(ws + W_XO) + hd * 256, 1024, (const bf16_t*)(ws + VXT) + (size_t)bhd * 256 * 256, 256, 256, nullptr};
                gemm_tile(g, (tl >> 1) * 128, (tl & 1) * 128, e, smem);
            }
            continue;
        }
        if (rep && REP_MODE == 1) break;
        if (rep && REP_MODE == 2 && t >= NTQ) break;
        if (rep && REP_MODE == 3 && t < NTQ) continue;
        if (t < NTQ) {
            const int mt = t / 6, ntl = t % 6;
            EpiQup e{(bf16_t*)(ws + QB), (const float*)(ws + SSQ), rms};
            GemmArgs g{(const bf16_t*)(ws + CQ), 256, (const bf16_t*)(ws + W_QUP), 256, 256, nullptr};
            gemm_tile(g, mt * 128, ntl * 128, e, smem);
        } else {
            const int u = t - NTQ, mt = u >> 3, ntl = u & 7;
            EpiKVup e{(bf16_t*)(ws + KNB), (bf16_t*)(ws + VTB), (const float*)(ws + SSQ), rms};
            GemmArgs g{(const bf16_t*)(ws + CKV), 128, (const bf16_t*)(ws + W_KVUP), 128, 128, nullptr};
            gemm_tile(g, mt * 128, ntl * 128, e, smem);
        }
    }
    if (!(rep && REP_MODE >= 2)) {
        const bf16_t* xbc = (const bf16_t*)(ws + XBC); bf16_t* xa = (bf16_t*)(ws + XBCA);
        const float* cw = p.in[7]; const float* cb = p.in[8];
        const size_t gsz = (size_t)nb * 256;
        for (size_t i = (size_t)bid * 256 + tidx(); i < (size_t)(T / 4) * 128; i += gsz) {
            const int tk0 = (int)(i >> 7) * 4, c0 = (int)(i & 127) * 8, s0 = tk0 & 2047;
            float w[4][8], bias[8];
#pragma unroll
            for (int j = 0; j < 4; ++j) { const float4 w0 = *(const float4*)(cw + j * 1024 + c0), w1 = *(const float4*)(cw + j * 1024 + c0 + 4);
                w[j][0] = w0.x; w[j][1] = w0.y; w[j][2] = w0.z; w[j][3] = w0.w; w[j][4] = w1.x; w[j][5] = w1.y; w[j][6] = w1.z; w[j][7] = w1.w; }
            { const float4 b0 = *(const float4*)(cb + c0), b1 = *(const float4*)(cb + c0 + 4); bias[0] = b0.x; bias[1] = b0.y; bias[2] = b0.z; bias[3] = b0.w; bias[4] = b1.x; bias[5] = b1.y; bias[6] = b1.z; bias[7] = b1.w; }
            float xin[7][8];
#pragma unroll
            for (int rr = 0; rr < 7; ++rr) {
                uint4 wv = make_uint4(0u, 0u, 0u, 0u);
                if (s0 + rr - 3 >= 0) wv = *(const uint4*)(xbc + (size_t)(tk0 + rr - 3) * 1024 + c0);
                xin[rr][0] = bflo(wv.x); xin[rr][1] = bfhi(wv.x); xin[rr][2] = bflo(wv.y); xin[rr][3] = bfhi(wv.y); xin[rr][4] = bflo(wv.z); xin[rr][5] = bfhi(wv.z); xin[rr][6] = bflo(wv.w); xin[rr][7] = bfhi(wv.w);
            }
#pragma unroll
            for (int o = 0; o < 4; ++o) {
                float accv[8];
#pragma unroll
                for (int k = 0; k < 8; ++k) accv[k] = bias[k] + w[0][k] * xin[o][k] + w[1][k] * xin[o + 1][k] + w[2][k] * xin[o + 2][k] + w[3][k] * xin[o + 3][k];
                uint4 ov;
                ov.x = pack2(siluf(accv[0]), siluf(accv[1])); ov.y = pack2(siluf(accv[2]), siluf(accv[3]));
                ov.z = pack2(siluf(accv[4]), siluf(accv[5])); ov.w = pack2(siluf(accv[6]), siluf(accv[7]));
                *(uint4*)(xa + (size_t)(tk0 + o) * 1024 + c0) = ov;
            }
        }
    }
}

DI int perm16(int k) { return (k & ~12) | ((k & 4) << 1) | ((k & 8) >> 1); }
template <int DQK, int DVW, int KT, int NQG, int NDV>
struct FlashCfg {
    static constexpr int KSTR = (DQK + 8) * 2;
    static constexpr int VSTR = (KT + 8) * 2;
    static constexpr int DV = DVW * NDV;
    static constexpr int KBYTES = KT * KSTR, VBYTES = DV * VSTR, STAGE = KBYTES + VBYTES;
    static constexpr int KCH = KT * DQK / 8 / 256;
    static constexpr int VCH = DV * KT / 8 / 256;
    static_assert(KT * DQK / 8 % 256 == 0 && DV * KT / 8 % 256 == 0, "chunk split");
    static_assert(2 * STAGE <= SMEM_BYTES - 32, "flash LDS");
};
template <int DQK, int DVW, int KT, int NQG, int NDV, class Src>
DI void flash_item(const Src& src, int ntiles, int nskip  , unsigned char* smem, bool noload = false) {
    typedef FlashCfg<DQK, DVW, KT, NQG, NDV> C;
    constexpr int NKS = DQK / 16, NKB = KT / 32, NDB = DVW / 32;
    int tid = tidx(); asm volatile("" : "+v"(tid));
    const int lane = tid & 63, wave = __builtin_amdgcn_readfirstlane(tid >> 6), r = lane & 31, h = lane >> 5;
    const int qg = wave / NDV, dvh = wave % NDV;
    bf16x8 qf[NKS];
    {
        const bf16_t* qp = src.qrow(qg * 32 + r) + 8 * h;
#pragma unroll
        for (int ks = 0; ks < NKS; ++ks) qf[ks] = *(const bf16x8*)(qp + 16 * ks);
        if (Src::ROPE) {
            const float* cp = src.rope_c(qg * 32 + r) + 8 * h; const float* sp = src.rope_s(qg * 32 + r) + 8 * h;
            const float4 c0 = *(const float4*)cp, c1 = *(const float4*)(cp + 4), s0 = *(const float4*)sp, s1 = *(const float4*)(sp + 4);
            const float cc[8] = {c0.x, c0.y, c0.z, c0.w, c1.x, c1.y, c1.z, c1.w}, ss[8] = {s0.x, s0.y, s0.z, s0.w, s1.x, s1.y, s1.z, s1.w};
            bf16x8 x1 = qf[NKS - 2], x2 = qf[NKS - 1];
#pragma unroll
            for (int j = 0; j < 8; ++j) {
                const float a = bf2f((bf16_t)x1[j]), b2 = bf2f((bf16_t)x2[j]);
                x1[j] = (short)f2bf(a * cc[j] - b2 * ss[j]); x2[j] = (short)f2bf(b2 * cc[j] + a * ss[j]);
            }
            qf[NKS - 2] = x1; qf[NKS - 1] = x2;
        }
    }
    f32x16 o[NDB];
#pragma unroll
    for (int d = 0; d < NDB; ++d)
#pragma unroll
        for (int e = 0; e < 16; ++e) o[d][e] = 0.f;
    float m = -1e30f, l = 0.f;
    uint4 kr[C::KCH], vr[C::VCH];
    auto gload = [&](int t) {
#pragma unroll
        for (int i = 0; i < C::KCH; ++i) { const int idx = tid + 256 * i; kr[i] = src.kload(t, idx / (DQK / 8), idx % (DQK / 8)); }
#pragma unroll
        for (int i = 0; i < C::VCH; ++i) { const int idx = tid + 256 * i; vr[i] = src.vload(t, idx / (KT / 8), idx % (KT / 8)); }
    };
    auto lstore = [&](unsigned char* buf) {
#pragma unroll
        for (int i = 0; i < C::KCH; ++i) { const int idx = tid + 256 * i; *(uint4*)(buf + (idx / (DQK / 8)) * C::KSTR + (idx % (DQK / 8)) * 16) = kr[i]; }
#pragma unroll
        for (int i = 0; i < C::VCH; ++i) {
            const int idx = tid + 256 * i, dv = idx / (KT / 8), c = idx % (KT / 8);
            unsigned char* row = buf + C::KBYTES + dv * C::VSTR + (c >> 1) * 32;
            const int a = c & 1;
            *(uint2*)(row + (4 * a) * 2) = make_uint2(vr[i].x, vr[i].y);
            *(uint2*)(row + (8 + 4 * a) * 2) = make_uint2(vr[i].z, vr[i].w);
        }
    };
    gload(0);
    __syncthreads();
    lstore(smem);
    __syncthreads();
    for (int t = 0; t < ntiles; ++t) {
        const unsigned char* cur = smem + (t & 1) * C::STAGE;
        const bool more = (t + 1 < ntiles);
        if (more && !noload) gload(t + 1);
        if (!(t == ntiles - 1 && qg < nskip)) {
            f32x16 s[NKB];
#pragma unroll
            for (int kb = 0; kb < NKB; ++kb) {
                const unsigned char* kp = cur + (kb * 32 + r) * C::KSTR + h * 16;
                if (NKB == 1) {
                    constexpr int NCH = 2;
                    f32x16 sp[NCH];
#pragma unroll
                    for (int c = 0; c < NCH; ++c)
#pragma unroll
                        for (int e = 0; e < 16; ++e) sp[c][e] = 0.f;
#pragma unroll
                    for (int ks = 0; ks < NKS; ++ks) sp[ks % NCH] = MFMA32(*(const bf16x8*)(kp + ks * 32), qf[ks], sp[ks % NCH]);
#pragma unroll
                    for (int e = 0; e < 16; ++e) s[kb][e] = sp[0][e] + sp[1][e];
                } else {
#pragma unroll
                    for (int e = 0; e < 16; ++e) s[kb][e] = 0.f;
#pragma unroll
                    for (int ks = 0; ks < NKS; ++ks) s[kb] = MFMA32(*(const bf16x8*)(kp + ks * 32), qf[ks], s[kb]);
                }
            }
            float mx = s[0][0];
#pragma unroll
            for (int kb = 0; kb < NKB; ++kb)
#pragma unroll
                for (int e = 0; e < 16; ++e) mx = fmaxf(mx, s[kb][e]);
            mx = fmaxf(mx, __shfl_xor(mx, 32));
            if (!__all(mx <= m + 8.f)) {
                const float mn = fmaxf(m, mx);
                const float alpha = __builtin_amdgcn_exp2f(m - mn);
                m = mn;
                l *= alpha;
#pragma unroll
                for (int d = 0; d < NDB; ++d)
#pragma unroll
                    for (int e = 0; e < 16; ++e) o[d][e] *= alpha;
            }
            float ps = 0.f;
#pragma unroll
            for (int kb = 0; kb < NKB; ++kb)
#pragma unroll
                for (int e = 0; e < 16; ++e) { const float pv = __builtin_amdgcn_exp2f(s[kb][e] - m); s[kb][e] = pv; ps += pv; }
            l += ps;
#pragma unroll
            for (int kb = 0; kb < NKB; ++kb)
#pragma unroll
                for (int s2 = 0; s2 < 2; ++s2) {
                    uint4 pk;
                    pk.x = pack2(s[kb][8 * s2], s[kb][8 * s2 + 1]); pk.y = pack2(s[kb][8 * s2 + 2], s[kb][8 * s2 + 3]);
                    pk.z = pack2(s[kb][8 * s2 + 4], s[kb][8 * s2 + 5]); pk.w = pack2(s[kb][8 * s2 + 6], s[kb][8 * s2 + 7]);
                    const bf16x8 pf = __builtin_bit_cast(bf16x8, pk);
                    const unsigned char* vp = cur + C::KBYTES + (dvh * DVW + r) * C::VSTR + (kb * 32 + s2 * 16 + 8 * h) * 2;
#pragma unroll
                    for (int d = 0; d < NDB; ++d) o[d] = MFMA32(*(const bf16x8*)(vp + d * 32 * C::VSTR), pf, o[d]);
                }
        }
        if (more) lstore(smem + ((t + 1) & 1) * C::STAGE);
        __syncthreads();
    }
    l += __shfl_xor(l, 32);
    const float il = 1.f / l;
#pragma unroll
    for (int d = 0; d < NDB; ++d)
#pragma unroll
        for (int g4 = 0; g4 < 4; ++g4) {
            uint2 w; w.x = pack2(o[d][4 * g4] * il, o[d][4 * g4 + 1] * il); w.y = pack2(o[d][4 * g4 + 2] * il, o[d][4 * g4 + 3] * il);
            src.store(qg * 32 + r, dvh * DVW + d * 32 + 8 * g4 + 4 * h, w);
        }
}
struct SelfSrc {
    static constexpr bool ROPE = true;
    const bf16_t *q, *kn, *kr, *vt; bf16_t* mix; int b, hd, bh, q0; const float *rc, *rs;
    DI const float* rope_c(int rr) const { return rc + (q0 + rr) * 16; }
    DI const float* rope_s(int rr) const { return rs + (q0 + rr) * 16; }
    DI const bf16_t* qrow(int rr) const { return q + ((size_t)bh * 2048 + q0 + rr) * 96; }
    DI uint4 kload(int t, int key, int c) const {
        const int kg = t * 64 + key;
        return c < 8 ? *(const uint4*)(kn + ((size_t)bh * 2048 + kg) * 64 + c * 8) : *(const uint4*)(kr + ((size_t)b * 2048 + kg) * 32 + (c - 8) * 8);
    }
    DI uint4 vload(int t, int dv, int c) const { return *(const uint4*)(vt + ((size_t)bh * 64 + dv) * 2048 + t * 64 + c * 8); }
    DI void store(int rr, int dv, uint2 w) const { *(uint2*)(mix + ((size_t)b * 2048 + q0 + rr) * 1024 + hd * 64 + dv) = w; }
};
struct CrossSrc {
    static constexpr bool ROPE = false;
    const bf16_t *qx, *kx, *vxt; bf16_t* ox; int b, hd, q0;
    DI const float* rope_c(int) const { return nullptr; }
    DI const float* rope_s(int) const { return nullptr; }
    DI const bf16_t* qrow(int rr) const { return qx + ((size_t)(b * 4 + hd) * 2048 + q0 + rr) * 256; }
    DI uint4 kload(int t, int key, int c) const { return *(const uint4*)(kx + ((size_t)(b * 4 + hd) * 256 + t * 32 + key) * 256 + c * 8); }
    DI uint4 vload(int t, int dv, int c) const { return *(const uint4*)(vxt + ((size_t)(b * 4 + hd) * 256 + dv) * 256 + t * 32 + c * 8); }
    DI void store(int rr, int dv, uint2 w) const { *(uint2*)(ox + ((size_t)b * 2048 + q0 + rr) * 1024 + hd * 256 + dv) = w; }
};
DI void attn_fast(const P& p, int bid, int nb, unsigned char* smem) {
    unsigned char* ws = p.ws;
    const int nround = (2048 + nb - 1) / nb;
    for (int rd = 0; rd < nround; ++rd) {
        const int idx = rd * nb + ((rd & 1) ? (nb - 1 - bid) : bid);
        if (idx >= 2048) continue;
        const int qb = 15 - (idx >> 7), bh = idx & 127;
        SelfSrc s{(const bf16_t*)(ws + QB), (const bf16_t*)(ws + KNB), (const bf16_t*)(ws + KROPE), (const bf16_t*)(ws + VTB), (bf16_t*)(ws + MIX), bh >> 3, bh & 7, bh, qb * 128, (const float*)(ws + ROPE_C), (const float*)(ws + ROPE_S)};
        flash_item<96, 64, 64, 4, 1>(s, 2 * qb + 2, 2, smem);
    }
}
DI void xattn_fast(const P& p, int bid, int nb, unsigned char* smem, int rep = 0) {
    unsigned char* ws = p.ws;
    for (int it = bid; it < 2048; it += nb) {
        const int bhd = it >> 5, qt = it & 31;
        CrossSrc s{(const bf16_t*)(ws + QX), (const bf16_t*)(ws + KX), (const bf16_t*)(ws + VXT), (bf16_t*)(ws + OX), bhd >> 2, bhd & 3, qt * 64};
        if (rep) s.ox = (bf16_t*)(ws + RD);
        flash_item<256, 128, 32, 2, 2>(s, 8, 0, smem, rep && REP_MODE == 5);
    }
}

constexpr int SSD_XT = 0, SSD_BM = 8192, SSD_CM = SSD_BM + 16384, SSD_BWT = SSD_CM + 16384, SSD_PS = SSD_BWT + 16384, SSD_F = SSD_PS + 16384;
static_assert(SSD_F + 2560 <= SMEM_BYTES - 32, "ssd LDS");
DI int off256(int row, int el) { return row * 256 + (((el >> 3) ^ (row & 15)) << 4) + ((el & 7) << 1); }
DI int off128(int row, int el) { return row * 128 + (((el >> 3) ^ ((row ^ (row >> 3)) & 7)) << 4) + ((el & 7) << 1); }
template <int pm>
DI void ssd_item(const P& p, int bh, unsigned char* smem) {
    unsigned char* ws = p.ws;
    const bf16_t* xa = (const bf16_t*)(ws + XBCA); const float* dtg = (const float*)(ws + DTB);
    bf16_t* mix = pm ? (bf16_t*)(ws + XBC) : (bf16_t*)(ws + MIX);
    int tid0 = tidx(); asm volatile("" : "+v"(tid0));
    const int wave = __builtin_amdgcn_readfirstlane(tid0 >> 6);
    const int b = bh >> 3, hd = bh & 7, g = hd >> 2;
    const int lb = wave >> 1, pb = wave & 1;
    const float a_h = -__expf(p.in[10][hd]), Dh = p.in[11][hd];
    float* F = (float*)(smem + SSD_F);
    __syncthreads();
    for (int i = tid0; i < 16384 / 16; i += 256) *(uint4*)(smem + SSD_PS + i * 16) = make_uint4(0u, 0u, 0u, 0u);
    f32x16 st[2];
#pragma unroll
    for (int i = 0; i < 2; ++i)
#pragma unroll
        for (int e = 0; e < 16; ++e) st[i][e] = 0.f;
    uint4 xr0, xr1, br0, br1, br2, br3, cr0, cr1, cr2, cr3; float dtr = 0.f;
#define SSD_XLD(i) (*(const uint4*)(xa + (t0_ + ((tid + 256 * (i)) >> 3)) * 1024 + hd * 64 + ((tid + 256 * (i)) & 7) * 8))
#define SSD_BLD(i, o) (*(const uint4*)(xa + (t0_ + ((tid + 256 * (i)) >> 4)) * 1024 + (o) + g * 128 + ((tid + 256 * (i)) & 15) * 8))
#define SSD_GLOAD(c_) do { const size_t t0_ = (size_t)b * 2048 + (c_) * 64; xr0 = SSD_XLD(0); xr1 = SSD_XLD(1); \
        br0 = SSD_BLD(0, 512); br1 = SSD_BLD(1, 512); br2 = SSD_BLD(2, 512); br3 = SSD_BLD(3, 512); \
        cr0 = SSD_BLD(0, 768); cr1 = SSD_BLD(1, 768); cr2 = SSD_BLD(2, 768); cr3 = SSD_BLD(3, 768); \
        if (tid < 64) dtr = dtg[(t0_ + tid) * 8 + hd]; } while (0)
    { const int tid = tid0; SSD_GLOAD(0); }
#define SSD_SCAN(FP) do { const int ln_ = tid0 & 63; float v = dtr * a_h; \
        _Pragma("unroll") for (int o = 1; o < 64; o <<= 1) { const float u = __shfl_up(v, o); if (ln_ >= o) v += u; } \
        const float a63 = __shfl(v, 63), r31_ = __shfl(v, 31), rlo_ = __shfl(v, 15), rhi_ = __shfl(v, 47), rm_ = ln_ < 32 ? rlo_ : rhi_; \
        (FP)[ln_] = __expf(fminf(v - rm_, 85.f)); (FP)[64 + ln_] = __expf(v); (FP)[128 + ln_] = dtr * __expf(fminf(rm_ - v, 85.f)); (FP)[192 + ln_] = __expf(a63 - v) * dtr; \
        (FP)[ln_ < 32 ? 288 + ln_ : 224 + ln_] = ln_ < 32 ? dtr * __expf(r31_ - v) : __expf(v - r31_); } while (0)
    if (wave == 0) SSD_SCAN(F);
    __syncthreads();
    for (int c = 0; c < 32; ++c) {
        int tid = tid0; asm volatile("" : "+v"(tid));
        const int lane = tid & 63, r = lane & 31, h = lane >> 5;
        const size_t t0 = (size_t)b * 2048 + c * 64;
        const float* Fc = F + (c & 1) * 320; float* Fn = F + ((c + 1) & 1) * 320;
#define SSD_XIMG(i, XR) do { const int idx = tid + 256 * (i), l = idx >> 3, p0 = (idx & 7) * 8, lp = perm16(l); \
            const unsigned ww[4] = {XR.x, XR.y, XR.z, XR.w}; \
            _Pragma("unroll") for (int k = 0; k < 4; ++k) { \
                *(bf16_t*)(smem + SSD_XT + off128(p0 + 2 * k, lp)) = (bf16_t)(ww[k] & 0xffffu); \
                *(bf16_t*)(smem + SSD_XT + off128(p0 + 2 * k + 1, lp)) = (bf16_t)(ww[k] >> 16); } } while (0)
#define SSD_BIMG(i, BR, CR) do { const int idx = tid + 256 * (i), l = idx >> 4, n0 = (idx & 15) * 8, lp = perm16(l); \
            *(uint4*)(smem + SSD_BM + off256(l, n0)) = BR; *(uint4*)(smem + SSD_CM + off256(l, n0)) = CR; \
            const float wl = Fc[192 + l]; const unsigned ww[4] = {BR.x, BR.y, BR.z, BR.w}; \
            _Pragma("unroll") for (int k = 0; k < 4; ++k) { \
                *(bf16_t*)(smem + SSD_BWT + off128(n0 + 2 * k, lp)) = f2bf(bflo(ww[k]) * wl); \
                *(bf16_t*)(smem + SSD_BWT + off128(n0 + 2 * k + 1, lp)) = f2bf(bfhi(ww[k]) * wl); } } while (0)
        if (!(pm & 2)) {
        SSD_XIMG(0, xr0); SSD_XIMG(1, xr1);
        SSD_BIMG(0, br0, cr0); SSD_BIMG(1, br1, cr1); SSD_BIMG(2, br2, cr2); SSD_BIMG(3, br3, cr3);
        } else { asm volatile("" :: "v"(xr0.x), "v"(xr1.x), "v"(br0.x), "v"(br1.x), "v"(br2.x), "v"(br3.x), "v"(cr0.x), "v"(cr1.x), "v"(cr2.x), "v"(cr3.x)); }
        __syncthreads();
        if (c + 1 < 32) SSD_GLOAD(c + 1);
        if (!(pm & 1)) {
        const int lrow = lb * 32 + r;
        f32x16 cb0, cb1, yo;
#pragma unroll
        for (int e = 0; e < 16; ++e) { cb0[e] = 0.f; cb1[e] = 0.f; yo[e] = 0.f; }
#pragma unroll
        for (int ks = 0; ks < 8; ++ks) {
            const bf16x8 cv = *(const bf16x8*)(smem + SSD_CM + off256(lb * 32 + r, 16 * ks + 8 * h));
            const bf16x8 b0v = *(const bf16x8*)(smem + SSD_BM + off256(r, 16 * ks + 8 * h));
            const bf16x8 b1v = *(const bf16x8*)(smem + SSD_BM + off256(32 + r, 16 * ks + 8 * h));
            const bf16x8 pv = *(const bf16x8*)(smem + SSD_PS + off256(pb * 32 + r, 16 * ks + 8 * h));
            cb0 = MFMA32(b0v, cv, cb0); cb1 = MFMA32(b1v, cv, cb1); yo = MFMA32(cv, pv, yo);
        }
        f32x16 yd;
#pragma unroll
        for (int e = 0; e < 16; ++e) yd[e] = 0.f;
#pragma unroll
        for (int sb = 0; sb < 2; ++sb) {
            float mv[16];
            const bool dg = (sb == lb);
            const float al = dg ? Fc[lrow] : Fc[256 + r];
            const float* bt = dg ? Fc + 128 + sb * 32 : Fc + 288;
#pragma unroll
            for (int q4 = 0; q4 < 4; ++q4) {
                const int s0 = sb * 32 + 8 * q4 + 4 * h;
                const float4 b4 = *(const float4*)(bt + 8 * q4 + 4 * h);
                const float bv4[4] = {b4.x, b4.y, b4.z, b4.w};
#pragma unroll
                for (int k = 0; k < 4; ++k) { const float cbv = sb ? cb1[4 * q4 + k] : cb0[4 * q4 + k]; mv[4 * q4 + k] = (s0 + k <= lrow) ? cbv * (al * bv4[k]) : 0.f; }
            }
#pragma unroll
            for (int s2 = 0; s2 < 2; ++s2) {
                uint4 pk;
                pk.x = pack2(mv[8 * s2], mv[8 * s2 + 1]); pk.y = pack2(mv[8 * s2 + 2], mv[8 * s2 + 3]);
                pk.z = pack2(mv[8 * s2 + 4], mv[8 * s2 + 5]); pk.w = pack2(mv[8 * s2 + 6], mv[8 * s2 + 7]);
                const bf16x8 xb = *(const bf16x8*)(smem + SSD_XT + off128(pb * 32 + r, sb * 32 + 16 * s2 + 8 * h));
                yd = MFMA32(__builtin_bit_cast(bf16x8, pk), xb, yd);
            }
        }
        {
            const uint4 x0 = *(const uint4*)(smem + SSD_XT + off128(pb * 32 + r, lb * 32 + 8 * h));
            const uint4 x1 = *(const uint4*)(smem + SSD_XT + off128(pb * 32 + r, lb * 32 + 16 + 8 * h));
            const unsigned xw[8] = {x0.x, x0.y, x0.z, x0.w, x1.x, x1.y, x1.z, x1.w};
            bf16_t* op = mix + (t0 + lb * 32 + 4 * h) * 1024 + 512 + hd * 64 + pb * 32 + r;
#pragma unroll
            for (int q4 = 0; q4 < 4; ++q4) {
                const float4 ea4 = *(const float4*)(Fc + 64 + lb * 32 + 8 * q4 + 4 * h);
                const float eav[4] = {ea4.x, ea4.y, ea4.z, ea4.w};
#pragma unroll
                for (int k = 0; k < 4; ++k) {
                    const int e = 4 * q4 + k;
                    const float xv = (e & 1) ? bfhi(xw[e >> 1]) : bflo(xw[e >> 1]);
                    const float y = yd[e] + eav[k] * yo[e] + Dh * xv;
                    op[(size_t)(k + 8 * q4) * 1024] = f2bf(y);
                }
            }
        }
        {
            const float dec = Fc[64 + 63];
#pragma unroll
            for (int e = 0; e < 16; ++e) { st[0][e] *= dec; st[1][e] *= dec; }
            const int nblk = 2 * (wave >> 1);
#pragma unroll
            for (int ks = 0; ks < 4; ++ks) {
                const bf16x8 av = *(const bf16x8*)(smem + SSD_XT + off128(pb * 32 + r, 16 * ks + 8 * h));
                const bf16x8 bv0 = *(const bf16x8*)(smem + SSD_BWT + off128(nblk * 32 + r, 16 * ks + 8 * h));
                const bf16x8 bv1 = *(const bf16x8*)(smem + SSD_BWT + off128(nblk * 32 + 32 + r, 16 * ks + 8 * h));
                st[0] = MFMA32(av, bv0, st[0]); st[1] = MFMA32(av, bv1, st[1]);
            }
        }
        }
        if (wave == 0 && c + 1 < 32) SSD_SCAN(Fn);
        __syncthreads();
#pragma unroll
        for (int i = 0; i < 2; ++i) {
            const int n = (2 * (wave >> 1) + i) * 32 + r;
#pragma unroll
            for (int e = 0; e < 16; ++e) *(bf16_t*)(smem + SSD_PS + off256(pb * 32 + crow(e, h), n)) = f2bf(st[i][e]);
        }
    }
    __syncthreads();
}

#if ATTN_NAIVE
DI void attn_naive(const P& p, int bid, int nb) {
    unsigned char* ws = p.ws;
    const bf16_t* Q = (const bf16_t*)(ws + QB); const bf16_t* Kn = (const bf16_t*)(ws + KNB); const bf16_t* Vt = (const bf16_t*)(ws + VTB);
    const bf16_t* Kr = (const bf16_t*)(ws + KROPE); bf16_t* mix = (bf16_t*)(ws + MIX);
    for (int item = bid; item < 128 * 8; item += nb) {
        const int bh = item >> 3, s_ = (item & 7) * 256 + tidx(), b = bh >> 3, hd = bh & 7;
        float q[96];
        {
            const uint4* q4 = (const uint4*)(Q + ((size_t)bh * 2048 + s_) * 96);
#pragma unroll
            for (int i = 0; i < 12; ++i) { const uint4 w = q4[i]; q[8 * i] = bflo(w.x); q[8 * i + 1] = bfhi(w.x); q[8 * i + 2] = bflo(w.y); q[8 * i + 3] = bfhi(w.y);
                q[8 * i + 4] = bflo(w.z); q[8 * i + 5] = bfhi(w.z); q[8 * i + 6] = bflo(w.w); q[8 * i + 7] = bfhi(w.w); }
        }
        float o[64];
#pragma unroll
        for (int d = 0; d < 64; ++d) o[d] = 0.f;
        float m = -1e30f, l = 0.f;
        const int nkeys = __builtin_amdgcn_readfirstlane(((s_ >> 6) + 1) * 64);
        for (int j0 = 0; j0 < nkeys; j0 += 8) {
            float sc[8];
#pragma unroll
            for (int jj = 0; jj < 8; ++jj) {
                const int j = j0 + jj;
                const uint4* k4 = (const uint4*)(Kn + ((size_t)bh * 2048 + j) * 64);
                const uint4* r4 = (const uint4*)(Kr + ((size_t)b * 2048 + j) * 32);
                float a = 0.f;
#pragma unroll
                for (int i = 0; i < 8; ++i) { const uint4 w = k4[i]; a += q[8 * i] * bflo(w.x) + q[8 * i + 1] * bfhi(w.x) + q[8 * i + 2] * bflo(w.y) + q[8 * i + 3] * bfhi(w.y)
                    + q[8 * i + 4] * bflo(w.z) + q[8 * i + 5] * bfhi(w.z) + q[8 * i + 6] * bflo(w.w) + q[8 * i + 7] * bfhi(w.w); }
#pragma unroll
                for (int i = 0; i < 4; ++i) { const uint4 w = r4[i]; const int o8 = 64 + 8 * i; a += q[o8] * bflo(w.x) + q[o8 + 1] * bfhi(w.x) + q[o8 + 2] * bflo(w.y) + q[o8 + 3] * bfhi(w.y)
                    + q[o8 + 4] * bflo(w.z) + q[o8 + 5] * bfhi(w.z) + q[o8 + 6] * bflo(w.w) + q[o8 + 7] * bfhi(w.w); }
                sc[jj] = a;
            }
            float mx = m;
#pragma unroll
            for (int jj = 0; jj < 8; ++jj) mx = fmaxf(mx, sc[jj]);
            const float al = exp2f(m - mx);
            float ps = 0.f;
#pragma unroll
            for (int jj = 0; jj < 8; ++jj) { sc[jj] = exp2f(sc[jj] - mx); ps += sc[jj]; }
            l = l * al + ps; m = mx;
#pragma unroll
            for (int d = 0; d < 64; ++d) {
                const uint4 w = *(const uint4*)(Vt + ((size_t)bh * 64 + d) * 2048 + j0);
                o[d] = o[d] * al + sc[0] * bflo(w.x) + sc[1] * bfhi(w.x) + sc[2] * bflo(w.y) + sc[3] * bfhi(w.y) + sc[4] * bflo(w.z) + sc[5] * bfhi(w.z) + sc[6] * bflo(w.w) + sc[7] * bfhi(w.w);
            }
        }
        const float il = 1.f / l;
        bf16_t* dst = mix + ((size_t)b * 2048 + s_) * 1024 + hd * 64;
#pragma unroll
        for (int d = 0; d < 64; d += 2) *(unsigned*)(dst + d) = pack2(o[d] * il, o[d + 1] * il);
    }
}
#endif
#if SSD_NAIVE
DI void ssd_naive(const P& p, int bid, int nb) {
    unsigned char* ws = p.ws;
    const bf16_t* xa = (const bf16_t*)(ws + XBCA); const float* dt = (const float*)(ws + DTB); const bf16_t* z = (const bf16_t*)(ws + ZB);
    bf16_t* mix = (bf16_t*)(ws + MIX);
    const int wave = tidx() >> 6, pp = tidx() & 63;
    for (int item = bid; item < 32; item += nb) {
        const int bh = item * 4 + wave, b = bh >> 3, hd = bh & 7, g = hd >> 2;
        const float a = -__expf(p.in[10][hd]), Dh = p.in[11][hd];
        float st[128];
#pragma unroll
        for (int n = 0; n < 128; ++n) st[n] = 0.f;
        for (int t = 0; t < 2048; ++t) {
            const size_t row = (size_t)b * 2048 + t;
            const float dtv = dt[row * 8 + hd];
            const float da = __expf(dtv * a);
            const float xv = bf2f(xa[row * 1024 + hd * 64 + pp]);
            const float xd = dtv * xv;
            const uint4* b4 = (const uint4*)(xa + row * 1024 + 512 + g * 128);
            const uint4* c4 = (const uint4*)(xa + row * 1024 + 768 + g * 128);
            float y = 0.f;
#pragma unroll
            for (int i = 0; i < 16; ++i) {
                const uint4 bw = b4[i], cw = c4[i];
                const unsigned bb[4] = {bw.x, bw.y, bw.z, bw.w}, cc[4] = {cw.x, cw.y, cw.z, cw.w};
#pragma unroll
                for (int k = 0; k < 4; ++k) {
                    const int n = 8 * i + 2 * k;
                    st[n] = da * st[n] + xd * bflo(bb[k]); y += bflo(cc[k]) * st[n];
                    st[n + 1] = da * st[n + 1] + xd * bfhi(bb[k]); y += bfhi(cc[k]) * st[n + 1];
                }
            }
            y += Dh * xv;
            const float zv = bf2f(z[row * 512 + hd * 64 + pp]);
            mix[row * 1024 + 512 + hd * 64 + pp] = f2bf(y * siluf(zv));
        }
    }
}
#endif
DI void phase_mixer(const P& p, int bid, int nb, unsigned char* smem, int rep = 0) {
#if SSD_NAIVE
    ssd_naive(p, bid, nb);
    attn_fast(p, bid, nb, smem);
#else
    unsigned* ctr = (unsigned*)(p.ws + CTL + CTL_QUEUE) + 64 * rep;
    int* slot = (int*)(smem + SMEM_BYTES - 32);
    for (bool first = true;; first = false) {
        __syncthreads();
        if (tidx() == 0) {
            int f = bid;
            if (nb == 512) f = bid < 64 ? bid : (bid >= 256 && bid < 320) ? 64 + (bid - 256) : 128 + (bid < 256 ? bid - 64 : bid - 128);
            *slot = first ? f : nb + (int)atomicAdd(ctr, 1u);
        }
        __syncthreads();
        const int it = *slot;
        if (it >= 128 + 2048 + N_LATE_ITEMS) break;
        if (it >= 128 + 2048) {
            if (!rep) for (int k = 0; k < LATE_GROUP; ++k) { const int u = (it - 128 - 2048) * LATE_GROUP + k; if (u < N_LATE) prep_tile(p, u < LATE_A1 - LATE_A0 ? LATE_A0 + u : u - (LATE_A1 - LATE_A0) + LATE_B0, smem); }
            continue;
        }
        if (it < 128) { if (!NO_SSD && !(rep && REP_MODE == 2)) { __builtin_amdgcn_s_setprio(3);
            if (rep) ssd_item<SSD_PM>(p, it, smem); else ssd_item<0>(p, it, smem); __builtin_amdgcn_s_setprio(0); } }
        else if (rep && REP_MODE >= 1) { }
        else {
            const int idx = it - 128, qb = 15 - (idx >> 7), bh = idx & 127;
            unsigned char* ws = p.ws;
            SelfSrc s{(const bf16_t*)(ws + QB), (const bf16_t*)(ws + KNB), (const bf16_t*)(ws + KROPE), (const bf16_t*)(ws + VTB), (bf16_t*)(ws + MIX), bh >> 3, bh & 7, bh, qb * 128, (const float*)(ws + ROPE_C), (const float*)(ws + ROPE_S)};
            if (rep) s.mix = (bf16_t*)(ws + XBC);
            if (!NO_FLASH) flash_item<96, 64, 64, 4, 1>(s, 2 * qb + 2, 2, smem, rep && REP_MODE == 5);
        }
    }
#endif
}

DI void phase_ssdnorm(const P& p, int bid, int nb, unsigned char* smem) {
    bf16_t* mix = (bf16_t*)(p.ws + MIX); const bf16_t* z = (const bf16_t*)(p.ws + ZB);
    const int lane = tidx() & 63, wave = tidx() >> 6;
    for (int tk = bid * 4 + wave; tk < T; tk += nb * 4) {
        uint4* ptr = (uint4*)(mix + (size_t)tk * 1024 + 512 + lane * 8);
        const uint4 w = *ptr, zz = *(const uint4*)(z + (size_t)tk * 512 + lane * 8);
        const unsigned ww[4] = {w.x, w.y, w.z, w.w}, zw[4] = {zz.x, zz.y, zz.z, zz.w};
        float v[8]; float ss = 0.f;
#pragma unroll
        for (int k = 0; k < 4; ++k) {
            v[2 * k] = bflo(ww[k]) * siluf(bflo(zw[k])); v[2 * k + 1] = bfhi(ww[k]) * siluf(bfhi(zw[k]));
            ss += v[2 * k] * v[2 * k] + v[2 * k + 1] * v[2 * k + 1];
        }
#pragma unroll
        for (int o = 16; o >= 1; o >>= 1) ss += __shfl_xor(ss, o);
        const float rr = rsqrtf(ss * (1.f / 256.f) + EPS);
        uint4 o4; o4.x = pack2(v[0] * rr, v[1] * rr); o4.y = pack2(v[2] * rr, v[3] * rr); o4.z = pack2(v[4] * rr, v[5] * rr); o4.w = pack2(v[6] * rr, v[7] * rr);
        *ptr = o4;
    }
}

template <bool RES_BF16>
struct EpiResid {
    bf16_t* pre; const void* res;
    float4 pf[RES_BF16 ? 1 : 16]; uint4 pb[RES_BF16 ? 8 : 1];
    DI void prefetch(int m0, int n0, int tid) {
        const int c8 = (tid & 15) * 8, r0 = tid >> 4;
#pragma unroll
        for (int ps = 0; ps < 8; ++ps) {
            const size_t idx = (size_t)(m0 + ps * 16 + r0) * 1024 + n0 + c8;
            if (RES_BF16) pb[ps] = *(const uint4*)((const bf16_t*)res + idx);
            else { pf[2 * ps] = *(const float4*)((const float*)res + idx); pf[2 * ps + 1] = *(const float4*)((const float*)res + idx + 4); }
        }
    }
    DI void operator()(const float* Cs, int m0, int n0, int tid) const {
        const int c8 = (tid & 15) * 8, r0 = tid >> 4;
#pragma unroll
        for (int ps = 0; ps < 8; ++ps) {
            const int row = ps * 16 + r0;
            const float4 v0 = cs4(Cs, row, c8), v1 = cs4(Cs, row, c8 + 4);
            float4 ra, rb;
            if (RES_BF16) { ra = make_float4(bflo(pb[ps].x), bfhi(pb[ps].x), bflo(pb[ps].y), bfhi(pb[ps].y)); rb = make_float4(bflo(pb[ps].z), bfhi(pb[ps].z), bflo(pb[ps].w), bfhi(pb[ps].w)); }
            else { ra = pf[2 * ps]; rb = pf[2 * ps + 1]; }
            *(uint4*)(pre + (size_t)(m0 + row) * 1024 + n0 + c8) = pack8(make_float4(ALPHA * ra.x + v0.x, ALPHA * ra.y + v0.y, ALPHA * ra.z + v0.z, ALPHA * ra.w + v0.w),
                                                                          make_float4(ALPHA * rb.x + v1.x, ALPHA * rb.y + v1.y, ALPHA * rb.z + v1.z, ALPHA * rb.w + v1.w));
        }
    }
};
DI void phase_wout(const P& p, int bid, int nb, unsigned char* smem) {
    const int v = vbid(bid, nb);
    EpiResid<true> e; e.pre = (bf16_t*)p.out; e.res = p.out;
    GemmArgs g{(const bf16_t*)(p.ws + MIX), 1024, (const bf16_t*)(p.ws + W_OUT), 1024, 1024, nullptr};
    for (int t = v; t < 128 * 8; t += nb) gemm_tile256(g, (t >> 3) * 256, (t & 7) * 128, e, smem);
}
DI void ln_row(const float* src, const float* gam, const float* bet, int lane, float (&o)[16]) {
    float v[16];
#pragma unroll
    for (int i = 0; i < 4; ++i) { const float4 t4 = *(const float4*)(src + i * 256 + lane * 4); v[4 * i] = t4.x; v[4 * i + 1] = t4.y; v[4 * i + 2] = t4.z; v[4 * i + 3] = t4.w; }
    float s = 0.f;
#pragma unroll
    for (int i = 0; i < 16; ++i) s += v[i];
    const float mu = wave_sum(s) * (1.f / 1024.f);
    float q = 0.f;
#pragma unroll
    for (int i = 0; i < 16; ++i) { const float d = v[i] - mu; q += d * d; }
    const float rstd = rsqrtf(wave_sum(q) * (1.f / 1024.f) + EPS);
#pragma unroll
    for (int i = 0; i < 4; ++i) {
        const float4 g4 = *(const float4*)(gam + i * 256 + lane * 4), b4 = *(const float4*)(bet + i * 256 + lane * 4);
        o[4 * i] = (v[4 * i] - mu) * rstd * g4.x + b4.x; o[4 * i + 1] = (v[4 * i + 1] - mu) * rstd * g4.y + b4.y;
        o[4 * i + 2] = (v[4 * i + 2] - mu) * rstd * g4.z + b4.z; o[4 * i + 3] = (v[4 * i + 3] - mu) * rstd * g4.w + b4.w;
    }
}
DI void ln_stats2(const float (&va)[16], const float (&vb)[16], float& mua, float& rsa, float& mub, float& rsb) {
    float sa = 0.f, sb = 0.f;
#pragma unroll
    for (int i = 0; i < 16; ++i) { sa += va[i]; sb += vb[i]; }
#pragma unroll
    for (int o = 32; o >= 1; o >>= 1) { sa += __shfl_xor(sa, o); sb += __shfl_xor(sb, o); }
    mua = sa * (1.f / 1024.f); mub = sb * (1.f / 1024.f);
    float qa = 0.f, qb = 0.f;
#pragma unroll
    for (int i = 0; i < 16; ++i) { const float da = va[i] - mua, db = vb[i] - mub; qa += da * da; qb += db * db; }
#pragma unroll
    for (int o = 32; o >= 1; o >>= 1) { qa += __shfl_xor(qa, o); qb += __shfl_xor(qb, o); }
    rsa = rsqrtf(qa * (1.f / 1024.f) + EPS); rsb = rsqrtf(qb * (1.f / 1024.f) + EPS);
}
DI void load_row16(const bf16_t* src, int lane, float (&v)[16]) {
#pragma unroll
    for (int i = 0; i < 4; ++i) { const uint2 t2 = *(const uint2*)(src + i * 256 + lane * 4); v[4 * i] = bflo(t2.x); v[4 * i + 1] = bfhi(t2.x); v[4 * i + 2] = bflo(t2.y); v[4 * i + 3] = bfhi(t2.y); }
}
DI void phase_ln1(const P& p, int bid, int nb, unsigned char* smem) {
    const int lane = tidx() & 63, wave = tidx() >> 6;
    const bf16_t* pre = (const bf16_t*)p.out; bf16_t* hb = (bf16_t*)(p.ws + H1B);
    const float* gam = p.in[14]; const float* bet = p.in[15];
    for (int tk = bid * 4 + wave; tk < T; tk += nb * 8) {
        const int tk2 = tk + nb * 4;
        float va[16], vb[16], mua, rsa, mub, rsb;
        load_row16(pre + (size_t)tk * 1024, lane, va); load_row16(pre + (size_t)tk2 * 1024, lane, vb);
        ln_stats2(va, vb, mua, rsa, mub, rsb);
#pragma unroll
        for (int i = 0; i < 4; ++i) {
            const float4 g4 = *(const float4*)(gam + i * 256 + lane * 4), b4 = *(const float4*)(bet + i * 256 + lane * 4);
            const float4 oa = make_float4((va[4 * i] - mua) * rsa * g4.x + b4.x, (va[4 * i + 1] - mua) * rsa * g4.y + b4.y, (va[4 * i + 2] - mua) * rsa * g4.z + b4.z, (va[4 * i + 3] - mua) * rsa * g4.w + b4.w);
            const float4 ob = make_float4((vb[4 * i] - mub) * rsb * g4.x + b4.x, (vb[4 * i + 1] - mub) * rsb * g4.y + b4.y, (vb[4 * i + 2] - mub) * rsb * g4.z + b4.z, (vb[4 * i + 3] - mub) * rsb * g4.w + b4.w);
            *(uint2*)(hb + (size_t)tk * 1024 + i * 256 + lane * 4) = pack4(oa); *(uint2*)(hb + (size_t)tk2 * 1024 + i * 256 + lane * 4) = pack4(ob);
        }
    }
}
struct EpiXQ {
    bf16_t* pm; int colbase; uint4 keep[8];
    DI void half(const float* Cs, int tok0, int hh, int tid) {
        const int c8 = (tid & 15) * 8, r0 = tid >> 4;
        if (hh == 0) {
#pragma unroll
            for (int ps = 0; ps < 8; ++ps) keep[ps] = pack8(cs4(Cs, ps * 16 + r0, c8), cs4(Cs, ps * 16 + r0, c8 + 4));
            return;
        }
#pragma unroll
        for (int ps = 0; ps < 8; ++ps) {
            const int row = ps * 16 + r0;
            const float4 b0 = cs4(Cs, row, c8), b1 = cs4(Cs, row, c8 + 4);
            float v[16] = {bflo(keep[ps].x), bfhi(keep[ps].x), bflo(keep[ps].y), bfhi(keep[ps].y), bflo(keep[ps].z), bfhi(keep[ps].z), bflo(keep[ps].w), bfhi(keep[ps].w),
                           b0.x, b0.y, b0.z, b0.w, b1.x, b1.y, b1.z, b1.w};
            float mx = v[0];
#pragma unroll
            for (int k = 1; k < 16; ++k) mx = fmaxf(mx, v[k]);
#pragma unroll
            for (int o = 8; o >= 1; o >>= 1) mx = fmaxf(mx, __shfl_xor(mx, o));
            float sum = 0.f;
#pragma unroll
            for (int k = 0; k < 16; ++k) { v[k] = __builtin_amdgcn_exp2f(v[k] - mx); sum += v[k]; }
#pragma unroll
            for (int o = 8; o >= 1; o >>= 1) sum += __shfl_xor(sum, o);
            const float il = 1.f / sum;
            bf16_t* dp = pm + (size_t)(tok0 + row) * 1024 + colbase + c8;
            *(uint4*)dp = pack8(make_float4(v[0] * il, v[1] * il, v[2] * il, v[3] * il), make_float4(v[4] * il, v[5] * il, v[6] * il, v[7] * il));
            *(uint4*)(dp + 128) = pack8(make_float4(v[8] * il, v[9] * il, v[10] * il, v[11] * il), make_float4(v[12] * il, v[13] * il, v[14] * il, v[15] * il));
        }
    }
};
DI void phase_xq(const P& p, int bid, int nb, unsigned char* smem) {
    const int v = vbid(bid, nb);
    for (int t = v; t < 256 * 4; t += nb) {
        const int mt = t >> 2, hd = t & 3;
        GemmArgs g{(const bf16_t*)((unsigned char*)p.out + DO_WQK) + (size_t)(mt >> 4) * 1024 * 1024, 1024, (const bf16_t*)(p.ws + H1B), 1024, 1024, nullptr};
        EpiXQ e; e.pm = (bf16_t*)(p.ws + OX); e.colbase = hd * 256;
        gemm_tile256<EpiXQ, true>(g, hd * 256, mt * 128, e, smem);
    }
}
DI void phase_xattn(const P& p, int bid, int nb, unsigned char* smem, int rep = 0) {}
DI void phase_xo(const P& p, int bid, int nb, unsigned char* smem) {
    const int v = vbid(bid, nb);
    EpiResid<true> e; e.pre = (bf16_t*)p.out; e.res = p.ws + H1B;
    for (int t = v; t < 128 * 8; t += nb) {
        const int mt = t >> 3;
        GemmArgs g{(const bf16_t*)(p.ws + OX), 1024, (const bf16_t*)((unsigned char*)p.out + DO_VW) + (size_t)(mt >> 3) * 1024 * 1024, 1024, 1024, nullptr};
        gemm_tile256(g, mt * 256, (t & 7) * 128, e, smem);
    }
}
DI void phase_ln2_router(const P& p, int bid, int nb, unsigned char* smem, int rep = 0) {
    unsigned char* ws = p.ws;
    const int lane = tidx() & 63, wave = tidx() >> 6;
    const bf16_t* pre = (const bf16_t*)p.out; bf16_t* hb = (bf16_t*)(ws + H2B);
    const float* wrt = (const float*)(ws + W_RT);
    const float* gam = p.in[20]; const float* bet = p.in[21];
    unsigned* cnt = (unsigned*)(ws + CTL + CTL_CNT); int* lists = (int*)(ws + LISTS); float* tgate = (float*)(ws + TOK_GATE);
    float* lg = (float*)smem + wave * (16 * 52 + 32);
    float* stt = lg + 16 * 52;
    for (int grp = bid; grp < T / 64; grp += nb) {
        const int t0 = grp * 64 + wave * 16;
        for (int rr = 0; rr < 16; rr += 2) {
            if (rep && REP_MODE == 3) break;
            const int tk = t0 + rr;
            float va[16], vb[16], mua, rsa, mub, rsb;
            load_row16(pre + (size_t)tk * 1024, lane, va); load_row16(pre + (size_t)(tk + 1) * 1024, lane, vb);
            ln_stats2(va, vb, mua, rsa, mub, rsb);
            if (lane == 0) { stt[2 * rr] = mua; stt[2 * rr + 1] = rsa; stt[2 * rr + 2] = mub; stt[2 * rr + 3] = rsb; }
#pragma unroll
            for (int i = 0; i < 4; ++i) {
                const float4 g4 = *(const float4*)(gam + i * 256 + lane * 4), b4 = *(const float4*)(bet + i * 256 + lane * 4);
                const float4 oa = make_float4((va[4 * i] - mua) * rsa * g4.x + b4.x, (va[4 * i + 1] - mua) * rsa * g4.y + b4.y, (va[4 * i + 2] - mua) * rsa * g4.z + b4.z, (va[4 * i + 3] - mua) * rsa * g4.w + b4.w);
                const float4 ob = make_float4((vb[4 * i] - mub) * rsb * g4.x + b4.x, (vb[4 * i + 1] - mub) * rsb * g4.y + b4.y, (vb[4 * i + 2] - mub) * rsb * g4.z + b4.z, (vb[4 * i + 3] - mub) * rsb * g4.w + b4.w);
                *(uint2*)(hb + (size_t)tk * 1024 + i * 256 + lane * 4) = pack4(oa); *(uint2*)(hb + (size_t)(tk + 1) * 1024 + i * 256 + lane * 4) = pack4(ob);
            }
        }
        __builtin_amdgcn_wave_barrier();
        if (!(rep && REP_MODE == 2)) {
            const int i16 = lane & 15, g4i = lane >> 4;
            const bf16_t* arow = pre + (size_t)(t0 + i16) * 1024 + 8 * g4i;
            const bf16_t* wtb = (const bf16_t*)wrt;
            unsigned char* slab = smem + 16384;
            const int tid_ = tidx();
            f32x4v acc0 = {0.f, 0.f, 0.f, 0.f}, acc1 = acc0, acc2 = acc0;
#pragma unroll 1
            for (int sl = 0; sl < 4; ++sl) {
#define RT_LD(i) (*(const uint4*)(wtb + (size_t)((tid_ + 256 * (i)) >> 5) * 1024 + sl * 256 + ((tid_ + 256 * (i)) & 31) * 8))
#define RT_ST(i, V) do { const int idx = tid_ + 256 * (i), row = idx >> 5, c = idx & 31; *(uint4*)(slab + row * 512 + ((c ^ (row & 15)) << 4)) = V; } while (0)
                const uint4 w0 = RT_LD(0), w1 = RT_LD(1), w2 = RT_LD(2), w3 = RT_LD(3), w4 = RT_LD(4), w5 = RT_LD(5), w6 = RT_LD(6), w7 = RT_LD(7), w8 = RT_LD(8), w9 = RT_LD(9), w10 = RT_LD(10), w11 = RT_LD(11);
                __syncthreads();
                RT_ST(0, w0); RT_ST(1, w1); RT_ST(2, w2); RT_ST(3, w3); RT_ST(4, w4); RT_ST(5, w5); RT_ST(6, w6); RT_ST(7, w7); RT_ST(8, w8); RT_ST(9, w9); RT_ST(10, w10); RT_ST(11, w11);
#undef RT_LD
#undef RT_ST
                __syncthreads();
#pragma unroll
                for (int S = 0; S < 8; ++S) {
                    const bf16x8 av = *(const bf16x8*)(arow + sl * 256 + 32 * S);
                    const int co = (((4 * S + g4i) ^ i16) << 4);
                    const unsigned char* bp = slab + i16 * 512 + co;
                    const bf16x8 h0 = *(const bf16x8*)(bp), h1 = *(const bf16x8*)(bp + 16 * 512), h2 = *(const bf16x8*)(bp + 32 * 512);
                    const bf16x8 l0 = *(const bf16x8*)(bp + 48 * 512), l1 = *(const bf16x8*)(bp + 64 * 512), l2 = *(const bf16x8*)(bp + 80 * 512);
                    acc0 = __builtin_amdgcn_mfma_f32_16x16x32_bf16(av, h0, acc0, 0, 0, 0); acc1 = __builtin_amdgcn_mfma_f32_16x16x32_bf16(av, h1, acc1, 0, 0, 0); acc2 = __builtin_amdgcn_mfma_f32_16x16x32_bf16(av, h2, acc2, 0, 0, 0);
                    acc0 = __builtin_amdgcn_mfma_f32_16x16x32_bf16(av, l0, acc0, 0, 0, 0); acc1 = __builtin_amdgcn_mfma_f32_16x16x32_bf16(av, l1, acc1, 0, 0, 0); acc2 = __builtin_amdgcn_mfma_f32_16x16x32_bf16(av, l2, acc2, 0, 0, 0);
                }
            }
            const float* aux = (const float*)(ws + CTL + CTL_RTAUX);
            const float sw0 = aux[i16], sw1 = aux[16 + i16], sw2 = aux[32 + i16], cb0 = aux[48 + i16], cb1 = aux[64 + i16], cb2 = aux[80 + i16];
#pragma unroll
            for (int e = 0; e < 4; ++e) {
                const float mur = stt[2 * (4 * g4i + e)], rsr = stt[2 * (4 * g4i + e) + 1];
                float* rowp = lg + (4 * g4i + e) * 52 + i16;
                rowp[0] = rsr * (acc0[e] - mur * sw0) + cb0; rowp[16] = rsr * (acc1[e] - mur * sw1) + cb1; rowp[32] = rsr * (acc2[e] - mur * sw2) + cb2;
            }
        }
        __builtin_amdgcn_wave_barrier();
        unsigned* lcount = (unsigned*)((float*)smem + 4 * (16 * 52 + 32));
        unsigned* lbase = lcount + 32;
        if (tidx() < 32) lcount[tidx()] = 0u;
        __syncthreads();
        int ex1 = 0, ex2 = 0; unsigned lp1 = 0, lp2 = 0;
        if (lane < 16) {
            const int tk = t0 + lane;
            const float* lr = lg + lane * 52;
            float gl[4], el[32];
#pragma unroll
            for (int j = 0; j < 4; ++j) gl[j] = lr[j];
#pragma unroll
            for (int j = 0; j < 32; ++j) el[j] = lr[4 + j];
            int gi = 0; float gm = gl[0];
#pragma unroll
            for (int j = 1; j < 4; ++j) if (gl[j] > gm) { gm = gl[j]; gi = j; }
            float gs = 0.f;
#pragma unroll
            for (int j = 0; j < 4; ++j) gs += __expf(gl[j] - gm);
            const float ggate = 1.f / gs;
            float ev[8];
#pragma unroll
            for (int j = 0; j < 8; ++j) ev[j] = gi == 0 ? el[j] : gi == 1 ? el[8 + j] : gi == 2 ? el[16 + j] : el[24 + j];
            int i1 = 0; float v1 = ev[0];
#pragma unroll
            for (int j = 1; j < 8; ++j) if (ev[j] > v1) { v1 = ev[j]; i1 = j; }
            int i2 = -1; float v2 = -3.0e38f;
#pragma unroll
            for (int j = 0; j < 8; ++j) if (j != i1 && ev[j] > v2) { v2 = ev[j]; i2 = j; }
            const float e2 = __expf(v2 - v1);
            tgate[tk * 2] = ggate / (1.f + e2); tgate[tk * 2 + 1] = ggate * e2 / (1.f + e2);
            ex1 = gi * 8 + i1; ex2 = gi * 8 + i2;
            if (!rep) { lp1 = atomicAdd(&lcount[ex1], 1u); lp2 = atomicAdd(&lcount[ex2], 1u); }
        }
        __syncthreads();
        if (tidx() < 32 && !rep) { const unsigned c = lcount[tidx()]; lbase[tidx()] = c ? atomicAdd(&cnt[tidx() * CNT_STRIDE], c) : 0u; }
        __syncthreads();
        if (lane < 16 && !rep) {
            const int tk = t0 + lane;
            lists[(size_t)ex1 * T + lbase[ex1] + lp1] = tk * 2;
            lists[(size_t)ex2 * T + lbase[ex2] + lp2] = tk * 2 + 1;
        }
        __syncthreads();
    }
}
struct MoeMap { int off[33]; };
DI int moe_tiles(const unsigned* cnt, int* offs  ) {
    __syncthreads();
    if (tidx() == 0) { int o = 0; for (int e = 0; e < 32; ++e) { offs[e] = o; o += (((int)cnt[e * CNT_STRIDE] + 127) >> 7) << 7; } offs[32] = o; }
    __syncthreads();
    return offs[32] >> 7;
}
struct EpiGU {
    bf16_t* hdn;
    DI void prefetch(int, int, int) {}
    DI void operator()(const float* Cs, int m0, int n0, int tid) const {
#pragma unroll 2
        for (int ps = 0; ps < 4; ++ps) {
            const int it = ps * 256 + tid, row = it >> 3, qd = it & 7, c = (qd >> 2) * 64 + (qd & 3) * 8;
            const float4 g0 = cs4(Cs, row, c), g1 = cs4(Cs, row, c + 4), u0 = cs4(Cs, row, c + 32), u1 = cs4(Cs, row, c + 36);
            const int hc = ((n0 & 511) >> 7) * 64 + (qd >> 2) * 32 + (qd & 3) * 8;
            *(uint4*)(hdn + (size_t)(m0 + row) * 256 + hc) = pack8(make_float4(siluf(g0.x) * u0.x, siluf(g0.y) * u0.y, siluf(g0.z) * u0.z, siluf(g0.w) * u0.w),
                                                                    make_float4(siluf(g1.x) * u1.x, siluf(g1.y) * u1.y, siluf(g1.z) * u1.z, siluf(g1.w) * u1.w));
        }
    }
};
struct EpiDown {
    bf16_t* y; int* ltok; float* lgate; const int* lst; int nvalid; const float* tgate;
    DI void prefetch(int, int, int tid) {
        if (tid < 128) { const int tk2 = tid < nvalid ? lst[tid] : -1; ltok[tid] = tk2; lgate[tid] = tk2 < 0 ? 0.f : tgate[tk2]; }
    }
    DI void operator()(const float* Cs, int m0, int n0, int tid) const {
        const int c8 = (tid & 15) * 8, r0 = tid >> 4;
#pragma unroll 4
        for (int ps = 0; ps < 8; ++ps) {
            const int row = ps * 16 + r0, tk2 = ltok[row];
            if (tk2 >= 0) {
                const float gt = lgate[row];
                float4 v = cs4(Cs, row, c8), w = cs4(Cs, row, c8 + 4); v.x *= gt; v.y *= gt; v.z *= gt; v.w *= gt; w.x *= gt; w.y *= gt; w.z *= gt; w.w *= gt;
                *(uint4*)(y + (size_t)tk2 * 1024 + n0 + c8) = pack8(v, w);
            }
        }
    }
};
DI void phase_moe_gu(const P& p, int bid, int nb, unsigned char* smem) {
    unsigned char* ws = p.ws;
    const unsigned* cnt = (const unsigned*)(ws + CTL + CTL_CNT); const int* lists = (const int*)(ws + LISTS);
    int* offs = (int*)(smem + GEMM_LDS); int* bigoff = offs + 64; int* smalloff = offs + 128; int* lrow = offs + 192;
    (void)moe_tiles(cnt, offs);
    if (tidx() == 0) { int nbg = 0, nsm = 0; for (int e = 0; e < 32; ++e) { const int nt = (offs[e + 1] - offs[e]) >> 7; bigoff[e] = nbg; smalloff[e] = nsm; nbg += nt >> 1; nsm += nt & 1; } bigoff[32] = nbg; smalloff[32] = nsm; }
    __syncthreads();
    const int nbig = bigoff[32] * 4, ntile = nbig + smalloff[32] * 4;
    const int v = vbid(bid, nb);
    const int full = ntile - ntile % nb, rem = ntile - full;
    int tail = -1;
    if (rem > 0) {
        if (nb == 512 && rem <= 256) { const int stride = 256 / rem; if (bid < 256 && bid % stride == 0 && bid / stride < rem) tail = full + bid / stride; }
        else if (v < rem) tail = full + v;
    }
    EpiGU ep{(bf16_t*)(ws + HDN)};
    for (int it = 0;; ++it) {
        int t = v + it * nb; bool last = false;
        if (t >= full) { if (tail < 0) break; t = tail; last = true; }
        const bool big = t < nbig;
        const int u = big ? t : t - nbig, mtl = u >> 2, ntl = u & 3;
        const int* po = big ? bigoff : smalloff;
        int e = 0;
        while (po[e + 1] <= mtl) ++e;
        const int slot0 = big ? offs[e] + (mtl - bigoff[e]) * 256 : offs[e + 1] - 128;
        __syncthreads();
        {
            const int pos = slot0 - offs[e] + tidx();
            if (big || tidx() < 128) { const int tk2 = pos < (int)cnt[e * CNT_STRIDE] ? lists[(size_t)e * T + pos] : -1; lrow[tidx()] = tk2 < 0 ? 0 : (tk2 >> 1); }
        }
        __syncthreads();
        GemmArgs g{(const bf16_t*)(ws + H2B), 1024, (const bf16_t*)(ws + W_GU) + (size_t)e * 512 * 1024, 1024, 1024, lrow};
        if (big) gemm_tile256<EpiGU, false, true>(g, slot0, ntl * 128, ep, smem);
        else gemm_tile(g, slot0, ntl * 128, ep, smem);
        if (last) break;
    }
}
template <int WHICH>
DI void phase_moe(const P& p, int bid, int nb, unsigned char* smem) {
    unsigned char* ws = p.ws;
    const unsigned* cnt = (const unsigned*)(ws + CTL + CTL_CNT); const int* lists = (const int*)(ws + LISTS); const float* tgate = (const float*)(ws + TOK_GATE);
    int* offs = (int*)(smem + GEMM_LDS); int* ltok = offs + 64; int* lrow = ltok + 128; float* lgate = (float*)(lrow + 128);
    const int nmt = moe_tiles(cnt, offs);
    constexpr int NNT = WHICH == 0 ? 4 : 8;
    const int v = vbid(bid, nb);
    const int ntile = nmt * NNT, full = ntile - ntile % nb, rem = ntile - full;
    int tail = -1;
    if (rem > 0) {
        if (nb == 512 && rem <= 256) { const int stride = 256 / rem; if (bid < 256 && bid % stride == 0 && bid / stride < rem) tail = full + bid / stride; }
        else if (v < rem) tail = full + v;
    }
    for (int it = 0;; ++it) {
        int t = v + it * nb; bool last = false;
        if (t >= full) { if (tail < 0) break; t = tail; last = true; }
        const int mt = t / NNT, ntl = t % NNT;
        const int slot0 = mt * 128;
        int e = 0;
        while (offs[e + 1] <= slot0) ++e;
        if (WHICH == 0) {
            __syncthreads();
            if (tidx() < 128) {
                const int pos = slot0 - offs[e] + tidx();
                const int tk2 = pos < (int)cnt[e * CNT_STRIDE] ? lists[(size_t)e * T + pos] : -1;
                lrow[tidx()] = tk2 < 0 ? 0 : (tk2 >> 1);
            }
            __syncthreads();
        }
        if (WHICH == 0) {
            EpiGU ep{(bf16_t*)(ws + HDN)};
            GemmArgs g{(const bf16_t*)(ws + H2B), 1024, (const bf16_t*)(ws + W_GU) + (size_t)e * 512 * 1024, 1024, 1024, lrow};
            gemm_tile(g, slot0, ntl * 128, ep, smem);
        } else {
            EpiDown ep{(bf16_t*)(ws + YB), ltok, lgate, lists + (size_t)e * T + (slot0 - offs[e]), (int)cnt[e * CNT_STRIDE] - (slot0 - offs[e]), tgate};
            GemmArgs g{(const bf16_t*)(ws + HDN), 256, (const bf16_t*)(ws + W_DN) + (size_t)e * 1024 * 256, 256, 256, nullptr};
            gemm_tile(g, slot0, ntl * 128, ep, smem);
        }
        if (last) break;
    }
}
DI void phase_final(const P& p, int bid, int nb, unsigned char* smem) {
    const int lane = tidx() & 63, wave = tidx() >> 6;
    const bf16_t* hb2 = (const bf16_t*)(p.ws + H2B); const bf16_t* y = (const bf16_t*)(p.ws + YB);
    const float* gam = p.in[29]; const float* bet = p.in[30];
    for (int tk = bid * 4 + wave; tk < T; tk += nb * 8) {
        const int tk2 = tk + nb * 4;
        float va[16], vb[16], mua, rsa, mub, rsb;
#pragma unroll
        for (int i = 0; i < 4; ++i) {
            const uint2 ha = *(const uint2*)(hb2 + (size_t)tk * 1024 + i * 256 + lane * 4), hbv = *(const uint2*)(hb2 + (size_t)tk2 * 1024 + i * 256 + lane * 4);
            const float4 ta = make_float4(bflo(ha.x), bfhi(ha.x), bflo(ha.y), bfhi(ha.y)), tb = make_float4(bflo(hbv.x), bfhi(hbv.x), bflo(hbv.y), bfhi(hbv.y));
            const uint2 a0 = *(const uint2*)(y + (size_t)(tk * 2) * 1024 + i * 256 + lane * 4), a1 = *(const uint2*)(y + (size_t)(tk * 2 + 1) * 1024 + i * 256 + lane * 4);
            const uint2 b0 = *(const uint2*)(y + (size_t)(tk2 * 2) * 1024 + i * 256 + lane * 4), b1 = *(const uint2*)(y + (size_t)(tk2 * 2 + 1) * 1024 + i * 256 + lane * 4);
            va[4 * i] = ALPHA * ta.x + bflo(a0.x) + bflo(a1.x); va[4 * i + 1] = ALPHA * ta.y + bfhi(a0.x) + bfhi(a1.x); va[4 * i + 2] = ALPHA * ta.z + bflo(a0.y) + bflo(a1.y); va[4 * i + 3] = ALPHA * ta.w + bfhi(a0.y) + bfhi(a1.y);
            vb[4 * i] = ALPHA * tb.x + bflo(b0.x) + bflo(b1.x); vb[4 * i + 1] = ALPHA * tb.y + bfhi(b0.x) + bfhi(b1.x); vb[4 * i + 2] = ALPHA * tb.z + bflo(b0.y) + bflo(b1.y); vb[4 * i + 3] = ALPHA * tb.w + bfhi(b0.y) + bfhi(b1.y);
        }
        ln_stats2(va, vb, mua, rsa, mub, rsb);
#pragma unroll
        for (int i = 0; i < 4; ++i) {
            const float4 g4 = *(const float4*)(gam + i * 256 + lane * 4), b4 = *(const float4*)(bet + i * 256 + lane * 4);
            *(float4*)(p.out + (size_t)tk * 1024 + i * 256 + lane * 4) = make_float4((va[4 * i] - mua) * rsa * g4.x + b4.x, (va[4 * i + 1] - mua) * rsa * g4.y + b4.y, (va[4 * i + 2] - mua) * rsa * g4.z + b4.z, (va[4 * i + 3] - mua) * rsa * g4.w + b4.w);
            *(float4*)(p.out + (size_t)tk2 * 1024 + i * 256 + lane * 4) = make_float4((vb[4 * i] - mub) * rsb * g4.x + b4.x, (vb[4 * i + 1] - mub) * rsb * g4.y + b4.y, (vb[4 * i + 2] - mub) * rsb * g4.z + b4.z, (vb[4 * i + 3] - mub) * rsb * g4.w + b4.w);
        }
    }
}

#define XB_TMO      128
#define XB_XCNT(j)  (256  + 64 * (j))
#define XB_XSUB(j)  (1280 + 64 * (j))
#define XB_XGEN(j)  (2304 + 64 * (j))
#define XB_TOP      3328
#define XB_TOPGEN   3392
#define XCD_BAR_WORDS 3456
#define XB_SPIN_CAP (1u << 25)
DI unsigned xb_ld(unsigned* p) { return __hip_atomic_load(p, __ATOMIC_RELAXED, __HIP_MEMORY_SCOPE_AGENT); }
DI unsigned xb_add(unsigned* p, unsigned v) { return __hip_atomic_fetch_add(p, v, __ATOMIC_RELAXED, __HIP_MEMORY_SCOPE_AGENT); }
DI unsigned xb_xcc_id() { return (unsigned)__builtin_amdgcn_s_getreg((3 << 11) | 20) & 0xFu; }
#define XB_SPIN(cond, bar) do { unsigned _sp = 0; while (cond) { __builtin_amdgcn_s_sleep(1); \
    if ((++_sp & 255u) == 0u) { if (xb_ld(&(bar)[XB_TMO])) break; if (_sp > XB_SPIN_CAP) { atomicAdd(&(bar)[XB_TMO], 1u); break; } } } } while (0)
struct XcdBarrier { unsigned* bar; unsigned x; volatile LAS unsigned* st; };
DI XcdBarrier xcd_barrier_post(unsigned* bar, volatile LAS unsigned* st) {
    XcdBarrier b; b.bar = bar; b.x = xb_xcc_id(); b.st = st;
    if (threadIdx.x == 0) (void)xb_add(&bar[XB_XCNT(b.x)], 1u);
    return b;
}
DI void xcd_barrier_complete(unsigned* bar, unsigned x, unsigned& nloc, unsigned& nx) {
    const unsigned G = gridDim.x * gridDim.y * gridDim.z;
    unsigned sum, cnt, mine, sp = 0u;
    for (;;) {
        sum = 0u; cnt = 0u; mine = 0u;
#pragma unroll
        for (unsigned j = 0; j < 16; ++j) { const unsigned c = xb_ld(&bar[XB_XCNT(j)]); sum += c; cnt += (c > 0u) ? 1u : 0u; mine = (j == x) ? c : mine; }
        if (sum == G) break;
        __builtin_amdgcn_s_sleep(1);
        if ((++sp & 255u) == 0u) { if (xb_ld(&bar[XB_TMO])) break; if (sp > XB_SPIN_CAP) { atomicAdd(&bar[XB_TMO], 1u); break; } }
    }
    nloc = mine > 0u ? mine : 1u; nx = cnt > 0u ? cnt : 1u;
}
DI void xcd_barrier(const XcdBarrier& b) {
    asm volatile("s_waitcnt vmcnt(0)" ::: "memory");
    __syncthreads();
    if (threadIdx.x == 0) {
        unsigned* bar = b.bar;
        __builtin_amdgcn_s_waitcnt(0);
        unsigned nloc = b.st[0], nx = b.st[1];
        if (nloc == 0u) { xcd_barrier_complete(bar, b.x, nloc, nx); b.st[0] = nloc; b.st[1] = nx; }
        const unsigned old = xb_add(&bar[XB_XSUB(b.x)], 1u);
        const unsigned gen = old / nloc;
        if (old + 1u == (gen + 1u) * nloc) {
            __builtin_amdgcn_fence(__ATOMIC_RELEASE, "agent");
            asm volatile("s_waitcnt vmcnt(0)" ::: "memory");
            const unsigned og = xb_add(&bar[XB_TOP], 1u);
            const unsigned tg = og / nx;
            if (og + 1u == (tg + 1u) * nx) xb_add(&bar[XB_TOPGEN], 1u);
            else XB_SPIN(xb_ld(&bar[XB_TOPGEN]) == tg, bar);
            __builtin_amdgcn_fence(__ATOMIC_ACQUIRE, "agent");
            xb_add(&bar[XB_XGEN(b.x)], 1u);
            asm volatile("s_waitcnt vmcnt(0)" ::: "memory");
        } else {
            XB_SPIN(xb_ld(&bar[XB_XGEN(b.x)]) == gen, bar);
            __builtin_amdgcn_fence(__ATOMIC_ACQUIRE, "agent");
            asm volatile("s_waitcnt vmcnt(0)" ::: "memory");
        }
    }
    __syncthreads();
}

constexpr int NPHASE = 14;
template <int PH>
DI void run_phase(const P& p, int bid, int nb, unsigned char* smem, int rep = 0) {
    if (PH == 0) phase_prep(p, bid, nb, smem);
    else if (PH == 1) phase_proj(p, bid, nb, smem, rep);
    else if (PH == 2) phase_up(p, bid, nb, smem, rep);
    else if (PH == 3) phase_mixer(p, bid, nb, smem, rep);
    else if (PH == 4) phase_ssdnorm(p, bid, nb, smem);
    else if (PH == 5) phase_wout(p, bid, nb, smem);
    else if (PH == 6) phase_ln1(p, bid, nb, smem);
    else if (PH == 7) phase_xq(p, bid, nb, smem);
    else if (PH == 8) phase_xattn(p, bid, nb, smem, rep);
    else if (PH == 9) phase_xo(p, bid, nb, smem);
    else if (PH == 10) phase_ln2_router(p, bid, nb, smem, rep);
    else if (PH == 11) phase_moe_gu(p, bid, nb, smem);
    else if (PH == 12) phase_moe<1>(p, bid, nb, smem);
    else if (PH == 13) phase_final(p, bid, nb, smem);
}
template <int PH>
__global__ void __launch_bounds__(256, 2) k_phase(P p) {
    __shared__ __attribute__((aligned(16))) unsigned char smem[SMEM_BYTES];
    run_phase<PH>(p, blockIdx.x, gridDim.x, smem);
}

#if MEGA
#ifndef MEGA_WAVES
#define MEGA_WAVES 2
#endif
template <int PH>
DI void mega_steps(const P& p, const XcdBarrier& bar, unsigned char* smem) {
    run_phase<PH>(p, blockIdx.x, gridDim.x, smem);
    if constexpr (((REPEAT_MASK >> PH) & 1) != 0) { xcd_barrier(bar); run_phase<PH>(p, blockIdx.x, gridDim.x, smem, 1); }
    if constexpr (PH == 6 && EXTRA_BARRIERS > 0) { for (int i = 0; i < EXTRA_BARRIERS; ++i) xcd_barrier(bar); }
    if constexpr (PH == 7) { xcd_barrier(bar); mega_steps<9>(p, bar, smem); }
    else if constexpr (PH + 1 < NPHASE) { xcd_barrier(bar); mega_steps<PH + 1>(p, bar, smem); }
}
__global__ void __launch_bounds__(256, MEGA_WAVES) k_mega(P p) {
    __shared__ __attribute__((aligned(16))) unsigned char smem[SMEM_BYTES];
    volatile LAS unsigned* st = (volatile LAS unsigned*)(smem + SMEM_BYTES - 16);
    if (threadIdx.x < 4) st[threadIdx.x] = 0u;
    __syncthreads();
    const XcdBarrier bar = xcd_barrier_post((unsigned*)(p.ws + CTL), st);
    mega_steps<0>(p, bar, smem);
}
#endif
template <int PH>
__global__ void __launch_bounds__(256, 1) k_phase_big(P p) {
    __shared__ __attribute__((aligned(16))) unsigned char smem[SMEM_BYTES];
    run_phase<PH>(p, blockIdx.x, gridDim.x, smem);
}
template <int PH>
static void launch_phase(const P& p, int grid, hipStream_t st) {
    if constexpr (PH == 3 && !P3_SMALL) hipLaunchKernelGGL((k_phase_big<PH>), dim3(grid), dim3(256), 0, st, p);
    else hipLaunchKernelGGL((k_phase<PH>), dim3(grid), dim3(256), 0, st, p);
}

extern "C" void kernel_launch(void* const* d_in, const int* in_sizes, int n_in, void* d_out, int out_size, void* d_ws, size_t ws_size, hipStream_t stream) {
    if (n_in != 31 || out_size != T * D || ws_size < WS_NEED) {
        fprintf(stderr, "kernel_launch: unexpected shapes: n_in %d out %d ws %zu (need %zu)\n", n_in, out_size, ws_size, (size_t)WS_NEED);
        return;
    }
    P p{};
    for (int i = 0; i < 31; ++i) p.in[i] = (const float*)d_in[i];
    p.out = (float*)d_out; p.ws = (unsigned char*)d_ws;
    (void)hipMemsetAsync((unsigned char*)d_ws + CTL, 0, CTL_BYTES, stream);
#if MEGA
    static int grid = 0;
    if (grid == 0) {
        int dev = 0, cus = 0, per_cu = 0;
        (void)hipGetDevice(&dev);
        (void)hipDeviceGetAttribute(&cus, hipDeviceAttributeMultiprocessorCount, dev);
        if (hipOccupancyMaxActiveBlocksPerMultiprocessor(&per_cu, (const void*)k_mega, 256, 0) != hipSuccess || per_cu < 1) { fprintf(stderr, "kernel_launch: occupancy query failed\n"); per_cu = 1; }
        if (per_cu > 2) per_cu = 2;
        grid = cus * per_cu;
        grid = grid >= 512 ? 512 : (grid >= 256 ? 256 : grid);
        fprintf(stderr, "kernel_launch: mega grid %d (%d CUs x %d)\n", grid, cus, per_cu);
    }
    void* args[] = {(void*)&p};
    const hipError_t le = hipLaunchCooperativeKernel((const void*)k_mega, dim3(grid), dim3(256), args, 0, stream);
    if (le != hipSuccess) fprintf(stderr, "kernel_launch: cooperative launch failed: %s (grid %d)\n", hipGetErrorString(le), grid);
#else
    const int grid = 1024;
    launch_phase<0>(p, grid, stream); launch_phase<1>(p, grid, stream); launch_phase<2>(p, grid, stream); launch_phase<3>(p, grid, stream);
    launch_phase<4>(p, grid, stream); launch_phase<5>(p, grid, stream); launch_phase<6>(p, grid, stream); launch_phase<7>(p, grid, stream);
    launch_phase<8>(p, grid, stream); launch_phase<9>(p, grid, stream); launch_phase<10>(p, grid, stream); launch_phase<11>(p, grid, stream);
    launch_phase<12>(p, grid, stream); launch_phase<13>(p, grid, stream);
#endif
}
```
